# Optimizing an MI355X kernel written in HIP

```python
import jax, jax.numpy as jnp
from jax import lax
import numpy as np

D_MODEL = 1024
BATCH = 8
SEQ = 4096
DEPTH = 2

N_EVEN = (DEPTH + 1) // 2
N_ODD = DEPTH // 2
EPS = 1e-6
GRID_W = 64

MEM_LEN = 256
MEM_HEADS = 4
MEM_HEAD_DIM = 64
MEM_WIDTH = MEM_HEADS * MEM_HEAD_DIM

NA_HEADS = 12
NA_HEAD_DIM = 64
NA_WIDTH = NA_HEADS * NA_HEAD_DIM
NA_WIN_ROWS = 8
NA_WIN_COLS = 16
NA_QBLOCK = 16
NA_BAND = 32

GLA_HEADS = 4
GLA_DK = 96
GLA_DV = 192
GLA_KW = GLA_HEADS * GLA_DK
GLA_VW = GLA_HEADS * GLA_DV
GLA_GATE_RANK = 16
GLA_GATE_NORM = 16.0
GLA_CHUNK = 64

D_FF = 2816
N_EXPERTS = 8
TOP_K = 2
D_FF_EXPERT = 3584
MOE_BLOCK = 256

MIX_WIDTH = NA_WIDTH + MEM_WIDTH
EVEN_IN = 3 * NA_WIDTH + MEM_WIDTH
ODD_IN = 2 * GLA_KW + 2 * GLA_VW + 2 * GLA_GATE_RANK + MEM_WIDTH

kernel_name = "hybrid_natten_gla_moe_encoder"


def rms_norm(x, g):
    xf = x.astype(jnp.float32)
    y = xf * lax.rsqrt(jnp.mean(xf * xf, axis=-1, keepdims=True) + EPS)
    return (y * g.astype(jnp.float32)).astype(x.dtype)


def swiglu(x, w_gate, w_up, w_down):
    return (jax.nn.silu(x @ w_gate) * (x @ w_up)) @ w_down


def memory_attention(q, mem_k, mem_v):
    s = jnp.einsum('bthd,bmhd->bhtm', q, mem_k).astype(jnp.float32) * (MEM_HEAD_DIM ** -0.5)
    p = jax.nn.softmax(s, axis=-1).astype(mem_v.dtype)
    o = jnp.einsum('bhtm,bmhd->bthd', p, mem_v)
    return o.reshape(q.shape[0], q.shape[1], MEM_WIDTH)


def neighbourhood_attention(q, k, v, rpb):
    B, T, H, dh = q.shape
    rows = T // GRID_W
    kr = min(NA_WIN_ROWS, rows)
    n_cb = GRID_W // NA_QBLOCK
    qc = np.arange(GRID_W).reshape(n_cb, NA_QBLOCK)
    band0 = np.clip(np.arange(n_cb) * NA_QBLOCK - NA_WIN_COLS // 2, 0, GRID_W - NA_BAND)
    kc = band0[:, None] + np.arange(NA_BAND)[None, :]
    cs = np.clip(qc - NA_WIN_COLS // 2, 0, GRID_W - NA_WIN_COLS)
    col_ok = (kc[:, None, :] >= cs[:, :, None]) & (kc[:, None, :] < cs[:, :, None] + NA_WIN_COLS)
    dc = np.clip(kc[:, None, :] - qc[:, :, None], -(NA_WIN_COLS - 1), NA_WIN_COLS - 1) + NA_WIN_COLS - 1
    col_mask = jnp.asarray(col_ok)
    bias_c = rpb[:, :, dc].astype(jnp.float32)
    kg = k.reshape(B, rows, GRID_W, H, dh)
    vg = v.reshape(B, rows, GRID_W, H, dh)
    qg = jnp.moveaxis(q.reshape(B, rows, n_cb, NA_QBLOCK, H, dh), 1, 0)
    scale = dh ** -0.5

    def row_step(args):
        q_r, r = args
        r0 = jnp.clip(r - kr // 2, 0, rows - kr)
        k_band = lax.dynamic_slice_in_dim(kg, r0, kr, axis=1)[:, :, kc]
        v_band = lax.dynamic_slice_in_dim(vg, r0, kr, axis=1)[:, :, kc]
        dr = r0 + jnp.arange(kr) - r + NA_WIN_ROWS - 1
        bias = jnp.transpose(bias_c[:, dr], (0, 2, 3, 1, 4))
        s = jnp.einsum('bjqhd,bajuhd->bhjqau', q_r, k_band).astype(jnp.float32) * scale + bias[None]
        s = jnp.where(col_mask[None, None, :, :, None, :], s, -jnp.inf)
        shp = s.shape
        p = jax.nn.softmax(s.reshape(shp[0], shp[1], shp[2], shp[3], kr * NA_BAND), axis=-1)
        p = p.reshape(shp).astype(v_band.dtype)
        return jnp.einsum('bhjqau,bajuhd->bjqhd', p, v_band)

    o = lax.map(row_step, (qg, jnp.arange(rows)))
    return jnp.moveaxis(o, 0, 1).reshape(B, T, H * dh)


def gla_direction(q, k, v, g, include_diag):
    C = q.shape[3]
    b = jnp.cumsum(g, axis=3)
    b_last = b[:, :, :, -1:, :]
    q_t = q * jnp.exp(b)
    k_t = k * jnp.exp(-b)
    mask = jnp.asarray(np.tril(np.ones((C, C), dtype=bool), 0 if include_diag else -1))
    a = jnp.where(mask, jnp.einsum('bhncd,bhnsd->bhncs', q_t, k_t), 0.0)
    o_intra = jnp.einsum('bhncs,bhnsv->bhncv', a, v)
    ds = jnp.einsum('bhncd,bhncv->bhndv', k * jnp.exp(b_last - b), v)
    decay = jnp.exp(b_last[:, :, :, 0, :])

    def step(s, inp):
        d_n, ds_n = inp
        return d_n[..., None] * s + ds_n, s

    s0 = jnp.zeros(ds.shape[:2] + ds.shape[3:], jnp.float32)
    _, s_in = lax.scan(step, s0, (jnp.moveaxis(decay, 2, 0), jnp.moveaxis(ds, 2, 0)))
    s_in = jnp.moveaxis(s_in, 0, 2)
    return o_intra + jnp.einsum('bhncd,bhndv->bhncv', q_t, s_in)


def gla_mixer(q, k, v, gk_f, gk_b, gate, g_norm):
    B, T, H, _ = q.shape
    n = T // GLA_CHUNK

    def to_chunks(a):
        return jnp.transpose(a.reshape(B, n, GLA_CHUNK, H, a.shape[-1]), (0, 3, 1, 2, 4)).astype(jnp.float32)

    def from_chunks(a):
        return jnp.transpose(a, (0, 2, 3, 1, 4)).reshape(B, T, H, a.shape[-1])

    def flip(a):
        return a[:, ::-1]

    qs = q * (GLA_DK ** -0.5)
    fwd = gla_direction(to_chunks(qs), to_chunks(k), to_chunks(v), to_chunks(gk_f), True)
    bwd = gla_direction(to_chunks(flip(qs)), to_chunks(flip(k)), to_chunks(flip(v)), to_chunks(flip(gk_b)), False)
    o = from_chunks(fwd) + flip(from_chunks(bwd))
    o = o * lax.rsqrt(jnp.mean(o * o, axis=-1, keepdims=True) + EPS) * g_norm.astype(jnp.float32)
    o = o.reshape(B, T, GLA_VW) * jax.nn.silu(gate.astype(jnp.float32))
    return o.astype(q.dtype)


def moe_swiglu(x, w_router, w_gate, w_up, w_down):
    B, T, D = x.shape
    xf = x.reshape(-1, D)
    n = xf.shape[0]
    logits = (xf @ w_router).astype(jnp.float32)
    top_val, top_idx = lax.top_k(logits, TOP_K)
    weights = jax.nn.softmax(top_val, axis=-1)
    e_flat = top_idx.reshape(-1)
    tok_flat = jnp.repeat(jnp.arange(n), TOP_K)
    w_flat = weights.reshape(-1)
    order = jnp.argsort(e_flat)
    e_s, tok_s, w_s = e_flat[order], tok_flat[order], w_flat[order]
    counts = jnp.bincount(e_flat, length=N_EXPERTS)
    start = jnp.cumsum(counts) - counts
    padded = (counts + MOE_BLOCK - 1) // MOE_BLOCK * MOE_BLOCK
    pend = jnp.cumsum(padded)
    pstart = pend - padded
    dest = pstart[e_s] + jnp.arange(n * TOP_K) - start[e_s]
    cap = n * TOP_K + N_EXPERTS * MOE_BLOCK
    n_blocks = cap // MOE_BLOCK
    x_pad = jnp.zeros((cap, D), x.dtype).at[dest].set(xf[tok_s])
    block_expert = jnp.clip(jnp.searchsorted(pend, jnp.arange(n_blocks) * MOE_BLOCK, side='right'), 0, N_EXPERTS - 1)

    def expert_block(args):
        xb, e = args
        return swiglu(xb, w_gate[e], w_up[e], w_down[e])

    y_pad = lax.map(expert_block, (x_pad.reshape(n_blocks, MOE_BLOCK, D), block_expert)).reshape(cap, D)
    y = y_pad[dest] * w_s[:, None].astype(x.dtype)
    return jax.ops.segment_sum(y, tok_s, num_segments=n).reshape(B, T, D)


def setup_inputs(seed: int = 0) -> dict:
    key = jax.random.key(seed)
    ks = iter(jax.random.split(key, 32))
    D = D_MODEL

    def nrm(shape, scale):
        return scale * jax.random.normal(next(ks), shape, jnp.float32)

    def gain(shape):
        return 1.0 + nrm(shape, 0.02)

    return {
        "x": nrm((BATCH, SEQ, D), 1.0),
        "mem": nrm((BATCH, MEM_LEN, D), 1.0),
        "even_norm1": gain((N_EVEN, D)),
        "even_w_in": nrm((N_EVEN, D, EVEN_IN), D ** -0.5),
        "even_rpb": nrm((N_EVEN, NA_HEADS, 2 * NA_WIN_ROWS - 1, 2 * NA_WIN_COLS - 1), 0.2),
        "even_w_out": nrm((N_EVEN, MIX_WIDTH, D), MIX_WIDTH ** -0.5),
        "even_norm2": gain((N_EVEN, D)),
        "even_w_gate": nrm((N_EVEN, D, D_FF), D ** -0.5),
        "even_w_up": nrm((N_EVEN, D, D_FF), D ** -0.5),
        "even_w_down": nrm((N_EVEN, D_FF, D), D_FF ** -0.5),
        "odd_norm1": gain((N_ODD, D)),
        "odd_w_in": nrm((N_ODD, D, ODD_IN), D ** -0.5),
        "odd_w_gk_fwd": nrm((N_ODD, GLA_GATE_RANK, GLA_KW), GLA_GATE_RANK ** -0.5),
        "odd_b_gk_fwd": nrm((N_ODD, GLA_KW), 0.1),
        "odd_w_gk_bwd": nrm((N_ODD, GLA_GATE_RANK, GLA_KW), GLA_GATE_RANK ** -0.5),
        "odd_b_gk_bwd": nrm((N_ODD, GLA_KW), 0.1),
        "odd_g_norm": gain((N_ODD, GLA_DV)),
        "odd_w_out": nrm((N_ODD, MIX_WIDTH, D), MIX_WIDTH ** -0.5),
        "odd_norm2": gain((N_ODD, D)),
        "odd_w_router": nrm((N_ODD, D, N_EXPERTS), D ** -0.5),
        "odd_w_gate": nrm((N_ODD, N_EXPERTS, D, D_FF_EXPERT), D ** -0.5),
        "odd_w_up": nrm((N_ODD, N_EXPERTS, D, D_FF_EXPERT), D ** -0.5),
        "odd_w_down": nrm((N_ODD, N_EXPERTS, D_FF_EXPERT, D), D_FF_EXPERT ** -0.5),
        "mem_norm": gain((D,)),
        "w_mem_kv": nrm((D, 2 * MEM_WIDTH), D ** -0.5),
        "final_norm": gain((D,)),
    }


def reference(x, mem, even_norm1, even_w_in, even_rpb, even_w_out, even_norm2, even_w_gate, even_w_up,
              even_w_down, odd_norm1, odd_w_in, odd_w_gk_fwd, odd_b_gk_fwd, odd_w_gk_bwd, odd_b_gk_bwd,
              odd_g_norm, odd_w_out, odd_norm2, odd_w_router, odd_w_gate, odd_w_up, odd_w_down,
              mem_norm, w_mem_kv, final_norm):
    B, T, _ = x.shape
    M = mem.shape[1]
    mem_kv = (rms_norm(mem, mem_norm) @ w_mem_kv).reshape(B, M, 2, MEM_HEADS, MEM_HEAD_DIM)
    mem_k, mem_v = mem_kv[:, :, 0], mem_kv[:, :, 1]
    h = x
    for i in range(DEPTH):
        j = i // 2
        if i % 2 == 0:
            u = rms_norm(h, even_norm1[j])
            q, k, v, qm = jnp.split(u @ even_w_in[j], [NA_WIDTH, 2 * NA_WIDTH, 3 * NA_WIDTH], axis=-1)
            mix = neighbourhood_attention(q.reshape(B, T, NA_HEADS, NA_HEAD_DIM),
                                          k.reshape(B, T, NA_HEADS, NA_HEAD_DIM),
                                          v.reshape(B, T, NA_HEADS, NA_HEAD_DIM), even_rpb[j])
            mo = memory_attention(qm.reshape(B, T, MEM_HEADS, MEM_HEAD_DIM), mem_k, mem_v)
            h = h + jnp.concatenate([mix, mo], axis=-1) @ even_w_out[j]
            h = h + swiglu(rms_norm(h, even_norm2[j]), even_w_gate[j], even_w_up[j], even_w_down[j])
        else:
            u = rms_norm(h, odd_norm1[j])
            splits = [GLA_KW, 2 * GLA_KW, 2 * GLA_KW + GLA_VW, 2 * GLA_KW + 2 * GLA_VW,
                      2 * GLA_KW + 2 * GLA_VW + GLA_GATE_RANK, 2 * GLA_KW + 2 * GLA_VW + 2 * GLA_GATE_RANK]
            q, k, v, g, zf, zb, qm = jnp.split(u @ odd_w_in[j], splits, axis=-1)
            gk_f = jax.nn.log_sigmoid((zf @ odd_w_gk_fwd[j] + odd_b_gk_fwd[j]).astype(jnp.float32)) / GLA_GATE_NORM
            gk_b = jax.nn.log_sigmoid((zb @ odd_w_gk_bwd[j] + odd_b_gk_bwd[j]).astype(jnp.float32)) / GLA_GATE_NORM
            mix = gla_mixer(q.reshape(B, T, GLA_HEADS, GLA_DK), k.reshape(B, T, GLA_HEADS, GLA_DK),
                            v.reshape(B, T, GLA_HEADS, GLA_DV),
                            gk_f.reshape(B, T, GLA_HEADS, GLA_DK), gk_b.reshape(B, T, GLA_HEADS, GLA_DK),
                            g, odd_g_norm[j])
            mo = memory_attention(qm.reshape(B, T, MEM_HEADS, MEM_HEAD_DIM), mem_k, mem_v)
            h = h + jnp.concatenate([mix, mo], axis=-1) @ odd_w_out[j]
            h = h + moe_swiglu(rms_norm(h, odd_norm2[j]), odd_w_router[j], odd_w_gate[j], odd_w_up[j], odd_w_down[j])
    return rms_norm(h, final_norm)
```

```cpp
#include <hip/hip_runtime.h>
#include <cstdio>
#include <cstdint>

#ifndef MK_FUSED
#define MK_FUSED 0
#endif
#ifndef FAST_GEMM
#define FAST_GEMM 0
#endif
#ifndef FAST_ATT
#define FAST_ATT 0
#endif
#ifndef FAST_GLA
#define FAST_GLA 0
#endif

#define GAS __attribute__((address_space(1)))
#define LAS __attribute__((address_space(3)))
typedef unsigned short bf16;
typedef unsigned v4u __attribute__((ext_vector_type(4)));
typedef unsigned v2u __attribute__((ext_vector_type(2)));
typedef float f32x4 __attribute__((ext_vector_type(4)));
typedef short bf16x8 __attribute__((ext_vector_type(8)));
typedef GAS unsigned gu32;
#define RLX_AGENT __ATOMIC_RELAXED, __HIP_MEMORY_SCOPE_AGENT
#define LDS_WAIT() asm volatile("s_waitcnt lgkmcnt(0)" ::: "memory")
#define VM_WAIT() asm volatile("s_waitcnt vmcnt(0)" ::: "memory")

constexpr int NT = 32768, DM = 1024, SEQ = 4096, NB = 8;
constexpr int MEM_ROWS = 2048;
constexpr int A0_LD = 1792;
constexpr int A1_LD = 2048;
constexpr int FF0 = 2816, FFE = 3584, NEXP = 8;
constexpr int SLOT_CAP = 34816;
constexpr float EPS = 1e-6f;
constexpr int NWAVES = 8, NTHR = 512;

constexpr size_t MiB = 1u << 20;
constexpr size_t WS_CTL = 0, CTL_ZERO_BYTES = 1 * MiB;
constexpr size_t WS_RSS = 1 * MiB;
constexpr size_t WS_MRSS = 3 * MiB;
constexpr size_t WS_CNT = 3 * MiB + 256 * 1024;
constexpr size_t WS_TOPI = 3 * MiB + 512 * 1024;
constexpr size_t WS_TOPW = 3 * MiB + 768 * 1024;
constexpr size_t WS_STOK = 4 * MiB;
constexpr size_t WS_SW = 4 * MiB + 512 * 1024;
constexpr size_t WS_BLK = 5 * MiB;
constexpr size_t WS_W0IN = 6 * MiB;
constexpr size_t WS_WV0 = WS_W0IN + 1792 * 2048;
constexpr size_t WS_W0OUT = 11 * MiB;
constexpr size_t WS_W0GU = 13 * MiB;
constexpr size_t WS_W0DN = 24 * MiB;
constexpr size_t WS_WMEM = WS_W0DN + 1024 * 2816 * 2;
constexpr size_t WS_W1IN = 31 * MiB;
constexpr size_t WS_WV1 = 35 * MiB;
constexpr size_t WS_W1OUT = 37 * MiB - 512 * 1024;
constexpr size_t WS_HBF = 39 * MiB;
constexpr size_t WS_MEMBF = 103 * MiB;
constexpr size_t WS_MEMK = 107 * MiB;
constexpr size_t WS_MEMVT = 108 * MiB;
constexpr size_t WS_ACT = 109 * MiB;
constexpr size_t WS_ACT0 = WS_ACT;
constexpr size_t WS_V0T = WS_ACT + 112 * MiB;
constexpr size_t WS_MIX = WS_ACT + 176 * MiB;
constexpr size_t WS_HMID0 = WS_ACT;
constexpr size_t WS_ACT1 = WS_ACT;
constexpr size_t WS_V1T = WS_ACT + 128 * MiB;
constexpr size_t WS_OF = WS_ACT + 240 * MiB;
constexpr size_t WS_OB = WS_ACT + 288 * MiB;
constexpr size_t WS_HMID1 = WS_ACT;
constexpr size_t WS_WGU = WS_ACT + 240 * MiB;
constexpr size_t WS_WDN = WS_ACT + 352 * MiB;
constexpr size_t WS_END = WS_ACT + 408 * MiB;
static_assert(WS_W1OUT + 2 * MiB <= WS_HBF && WS_WV1 + 768 * 2048 <= WS_W1OUT && WS_W1IN + 4 * MiB <= WS_WV1 && WS_WMEM + MiB <= WS_W1IN, "weight map");
static_assert(WS_W0GU + 11 * MiB <= WS_W0DN && WS_WV0 + 768 * 2048 <= WS_W0OUT, "weight map 2");
static_assert((size_t)SLOT_CAP * 3584 * 2 <= 240 * MiB, "hmid1");

constexpr int CW_TMO = 0, CW_CODE = 1, CW_BAR = 4096;

constexpr int RING_BYTES = 131072;
constexpr int LDSCTL_OFF = RING_BYTES, MISC_OFF = LDSCTL_OFF + 320;
constexpr int LDS_BYTES = 147456;

__device__ __forceinline__ unsigned f2bf(float f) { unsigned u = __builtin_bit_cast(unsigned, f); return (u + 0x7fffu + ((u >> 16) & 1u)) >> 16; }
__device__ __forceinline__ unsigned pk2(float lo, float hi) { return f2bf(lo) | (f2bf(hi) << 16); }
__device__ __forceinline__ float bf2f(bf16 b) { return __builtin_bit_cast(float, (unsigned)b << 16); }
__device__ __forceinline__ float bflo(unsigned u) { return __builtin_bit_cast(float, u << 16); }
__device__ __forceinline__ float bfhi(unsigned u) { return __builtin_bit_cast(float, u & 0xffff0000u); }
__device__ __forceinline__ float wave_sum(float v) {
#pragma unroll
    for (int o = 1; o < 64; o <<= 1) v += __shfl_xor(v, o);
    return v;
}
__device__ __forceinline__ float wave_max(float v) {
#pragma unroll
    for (int o = 1; o < 64; o <<= 1) v = fmaxf(v, __shfl_xor(v, o));
    return v;
}
__device__ __forceinline__ float rstd_from(const float* rss16) {
    const f32x4* p = (const f32x4*)rss16; f32x4 a = p[0], b = p[1], c = p[2], d = p[3];
    const float s = ((a.x + a.y) + (a.z + a.w)) + ((b.x + b.y) + (b.z + b.w)) + ((c.x + c.y) + (c.z + c.w)) + ((d.x + d.y) + (d.z + d.w));
    return 1.0f / sqrtf(s * (1.0f / DM) + EPS);
}

#define XB_TMO      128
#define XB_XCNT(j)  (256  + 64 * (j))
#define XB_XSUB(j)  (1280 + 64 * (j))
#define XB_XGEN(j)  (2304 + 64 * (j))
#define XB_TOP      3328
#define XB_TOPGEN   3392
#define XCD_BAR_WORDS 3456
#define XB_SPIN_CAP (1u << 22)

__device__ __forceinline__ unsigned xb_ld(unsigned* p)              { return __hip_atomic_load(p, __ATOMIC_RELAXED, __HIP_MEMORY_SCOPE_AGENT); }
__device__ __forceinline__ unsigned xb_add(unsigned* p, unsigned v) { return __hip_atomic_fetch_add(p, v, __ATOMIC_RELAXED, __HIP_MEMORY_SCOPE_AGENT); }
__device__ __forceinline__ unsigned xb_xcc_id() { return (unsigned)__builtin_amdgcn_s_getreg((3 << 11) | 20) & 0xFu; }
#define XB_SPIN(cond, bar) do { unsigned _sp = 0; while (cond) { __builtin_amdgcn_s_sleep(1); \
    if ((++_sp & 255u) == 0u) { if (xb_ld(&(bar)[XB_TMO])) break; if (_sp > XB_SPIN_CAP) { atomicAdd(&(bar)[XB_TMO], 1u); break; } } } } while (0)

struct XcdBarrier { unsigned* bar; unsigned x; volatile LAS unsigned* st; };

__device__ __forceinline__ XcdBarrier xcd_barrier_post(unsigned* bar, volatile LAS unsigned* st) {
    XcdBarrier b; b.bar = bar; b.x = xb_xcc_id(); b.st = st;
    if (threadIdx.x == 0) (void)xb_add(&bar[XB_XCNT(b.x)], 1u);
    return b;
}
__device__ __forceinline__ void xcd_barrier_complete(unsigned* bar, unsigned x, unsigned& nloc, unsigned& nx) {
    const unsigned G = gridDim.x * gridDim.y * gridDim.z;
    unsigned sum, cnt, mine, sp = 0u;
    for (;;) {
        sum = 0u; cnt = 0u; mine = 0u;
#pragma unroll
        for (unsigned j = 0; j < 16; ++j) { const unsigned c = xb_ld(&bar[XB_XCNT(j)]); sum += c; cnt += (c > 0u) ? 1u : 0u; mine = (j == x) ? c : mine; }
        if (sum == G) break;
        __builtin_amdgcn_s_sleep(1);
        if ((++sp & 255u) == 0u) { if (xb_ld(&bar[XB_TMO])) break; if (sp > XB_SPIN_CAP) { atomicAdd(&bar[XB_TMO], 1u); break; } }
    }
    nloc = mine > 0u ? mine : 1u; nx = cnt > 0u ? cnt : 1u;
}
__device__ __forceinline__ void xcd_barrier(const XcdBarrier& b) {
    asm volatile("s_waitcnt vmcnt(0)" ::: "memory");
    __syncthreads();
    if (threadIdx.x == 0) {
        unsigned* bar = b.bar;
        __builtin_amdgcn_s_waitcnt(0);
        unsigned nloc = b.st[0], nx = b.st[1];
        if (nloc == 0u) { xcd_barrier_complete(bar, b.x, nloc, nx); b.st[0] = nloc; b.st[1] = nx; }
        const unsigned old = xb_add(&bar[XB_XSUB(b.x)], 1u);
        const unsigned gen = old / nloc;
        if (old + 1u == (gen + 1u) * nloc) {
            __builtin_amdgcn_fence(__ATOMIC_RELEASE, "agent");
            asm volatile("s_waitcnt vmcnt(0)" ::: "memory");
            const unsigned og = xb_add(&bar[XB_TOP], 1u);
            const unsigned tg = og / nx;
            if (og + 1u == (tg + 1u) * nx) xb_add(&bar[XB_TOPGEN], 1u);
            else XB_SPIN(xb_ld(&bar[XB_TOPGEN]) == tg, bar);
            __builtin_amdgcn_fence(__ATOMIC_ACQUIRE, "agent");
            xb_add(&bar[XB_XGEN(b.x)], 1u);
            asm volatile("s_waitcnt vmcnt(0)" ::: "memory");
        } else {
            XB_SPIN(xb_ld(&bar[XB_XGEN(b.x)]) == gen, bar);
            __builtin_amdgcn_fence(__ATOMIC_ACQUIRE, "agent");
            asm volatile("s_waitcnt vmcnt(0)" ::: "memory");
        }
    }
    __syncthreads();
}

struct Args { const float* in[26]; float* out; unsigned char* ws; int ph_lo, ph_hi; };
enum { I_X = 0, I_MEM, I_EN1, I_EWIN, I_RPB, I_EWOUT, I_EN2, I_EWG, I_EWU, I_EWD, I_ON1, I_OWIN, I_WGKF, I_BGKF, I_WGKB, I_BGKB, I_GNORM, I_OWOUT, I_ON2, I_WR, I_OWG, I_OWU, I_OWD, I_MNORM, I_WMKV, I_FNORM };

struct Frame {
    LAS unsigned char* lds;
    int tid, lane, wave, G, bid;
    int gw, NGW;
    unsigned char* ws;
};

__device__ __forceinline__ void cvt_item(const float* W, int ldn, int k0, int n0, bf16* WT, int ldk, int drow0, const float* gain, float scale, LAS float* scr, int lane) {
#pragma unroll 8
    for (int i = 0; i < 32; ++i) { const int kk = 2 * i + (lane >> 5); float v = W[(size_t)(k0 + kk) * ldn + n0 + (lane & 31)];
        const float gg = gain ? gain[k0 + kk] : 1.0f; scr[kk * 33 + (lane & 31)] = v * gg * scale; }
    LDS_WAIT(); asm volatile("" ::: "memory");
    const int c = lane & 7;
#pragma unroll
    for (int j = 0; j < 4; ++j) { const int n = (lane >> 3) + 8 * j; const LAS float* s = scr + (8 * c) * 33 + n;
        v4u o; o.x = pk2(s[0 * 33], s[1 * 33]); o.y = pk2(s[2 * 33], s[3 * 33]); o.z = pk2(s[4 * 33], s[5 * 33]); o.w = pk2(s[6 * 33], s[7 * 33]);
        *(GAS v4u*)(WT + (size_t)(drow0 + n) * ldk + k0 + 8 * c) = o; }
    LDS_WAIT(); asm volatile("" ::: "memory");
}
struct CvtJob { const float* W; int K, N; bf16* WT; const float* gain; int kind; };
__device__ __forceinline__ bool cvt_map(int kind, int n0, int& drow, float& scale) {
    scale = 1.0f;
    switch (kind) {
    case 0: drow = n0; return true;
    case 1: if (n0 < 768) { drow = n0; scale = 0.125f; return true; } if (n0 < 1536) { drow = n0; return true; } if (n0 >= 2304) { drow = n0 - 768; scale = 0.125f; return true; } return false;
    case 2: if (n0 >= 1536 && n0 < 2304) { drow = n0 - 1536; return true; } return false;
    case 3: drow = (n0 >> 7) * 256 + (n0 & 127); return true;
    case 4: drow = (n0 >> 7) * 256 + 128 + (n0 & 127); return true;
    case 5: if (n0 < 768) { drow = n0; return true; } if (n0 < 1536) return false; if (n0 < 2304) { drow = n0 - 768; return true; }
            if (n0 < 2336) { drow = n0 - 512; return true; } drow = n0 - 800; scale = 0.125f; return true;
    case 6: if (n0 >= 768 && n0 < 1536) { drow = n0 - 768; return true; } return false;
    default: drow = n0; return true;
    }
}
__device__ __forceinline__ void cvt_job_item(const CvtJob& J, int item, LAS float* scr, int lane) {
    const int nblk = J.N / 32, kb = item / nblk, nb = item % nblk; int drow; float scale;
    if (!cvt_map(J.kind, nb * 32, drow, scale)) return;
    cvt_item(J.W, J.N, kb * 64, nb * 32, J.WT, J.K, drow, J.gain, scale, scr, lane);
}

__device__ __forceinline__ void row_to_bf16(const float* xrow, bf16* orow, float* rss16, int lane) {
    const GAS f32x4* xr = (const GAS f32x4*)xrow + lane;
    f32x4 v[4]; float s = 0.f;
#pragma unroll
    for (int j = 0; j < 4; ++j) { v[j] = xr[64 * j]; s += (v[j].x * v[j].x + v[j].y * v[j].y) + (v[j].z * v[j].z + v[j].w * v[j].w); }
    s = wave_sum(s);
    GAS unsigned long long* o8 = (GAS unsigned long long*)orow + lane;
#pragma unroll
    for (int j = 0; j < 4; ++j) o8[64 * j] = (unsigned long long)pk2(v[j].x, v[j].y) | ((unsigned long long)pk2(v[j].z, v[j].w) << 32);
    if (lane < 16) rss16[lane] = (lane == 0) ? s : 0.f;
}

struct Unit { int pm, pn; };
struct Sched {
    int nM, nN, nwg, G, c, K;
    const char* A; const char* B; const int* bexp; size_t estride;
    __device__ void init(const void* A_, const void* B_, int K_, int nM_, int nN_, int G_, int c_, const int* bexp_ = nullptr, size_t estride_ = 0) {
        A = (const char*)A_; B = (const char*)B_; K = K_; nM = nM_; nN = nN_; nwg = nM * nN; G = G_; c = c_; bexp = bexp_; estride = estride_; }
    __device__ bool next(int i, Unit& u) const {
        const long L = (long)i * G + c; if (L >= nwg) return false;
        int wgid = (int)L; { const int q = nwg / 8, r = nwg % 8, xcd = wgid % 8, off = wgid / 8; wgid = (xcd < r ? xcd * (q + 1) : r * (q + 1) + (xcd - r) * q) + off; }
        const int nig = 8 * nN, gid = wgid / nig, fm = gid * 8, gsz = (nM - fm) < 8 ? (nM - fm) : 8;
        u.pm = fm + ((wgid % nig) % gsz); u.pn = (wgid % nig) / gsz; return true;
    }
    __device__ const char* a_base(const Unit& u) const { return A + (size_t)u.pm * 512 * K; }
    __device__ const char* b_base(const Unit& u) const { return B + (bexp ? (size_t)bexp[u.pm] * estride : (size_t)0) + (size_t)u.pn * 512 * K; }
};

struct EpiRowScale {
    static constexpr bool NEED_SS = false;
    bf16* O; int ldc; const float* rss;
    __device__ __forceinline__ float apply(int row, int pn, int c128, const float (&a)[8], const float (&b)[8]) const {
        const float s = rstd_from(rss + (size_t)row * 16);
        bf16* p = O + (size_t)row * ldc + pn * 256 + c128;
        v4u w; w.x = pk2(a[0] * s, a[1] * s); w.y = pk2(a[2] * s, a[3] * s); w.z = pk2(a[4] * s, a[5] * s); w.w = pk2(a[6] * s, a[7] * s); *(v4u*)p = w;
        w.x = pk2(b[0] * s, b[1] * s); w.y = pk2(b[2] * s, b[3] * s); w.z = pk2(b[4] * s, b[5] * s); w.w = pk2(b[6] * s, b[7] * s); *(v4u*)(p + 128) = w;
        return 0.f;
    }
    __device__ __forceinline__ void row_done(int, int, int, float) const {}
};
struct EpiColScale {
    static constexpr bool NEED_SS = false;
    bf16* O; int ldc; const float* rss;
    __device__ __forceinline__ float apply(int row, int pn, int c128, const float (&a)[8], const float (&b)[8]) const {
        const int col = pn * 256 + c128; bf16* p = O + (size_t)row * ldc + col;
        float sa[8], sb[8]; const float* pa = rss + (size_t)col * 16; const float* pb = pa + 128 * 16;
#pragma unroll
        for (int j = 0; j < 8; ++j) { float r0 = rstd_from(pa + j * 16), r1 = rstd_from(pb + j * 16); asm volatile("" : "+v"(r0), "+v"(r1) :: "memory"); sa[j] = a[j] * r0; sb[j] = b[j] * r1; }
        v4u w; w.x = pk2(sa[0], sa[1]); w.y = pk2(sa[2], sa[3]); w.z = pk2(sa[4], sa[5]); w.w = pk2(sa[6], sa[7]); *(v4u*)p = w;
        w.x = pk2(sb[0], sb[1]); w.y = pk2(sb[2], sb[3]); w.z = pk2(sb[4], sb[5]); w.w = pk2(sb[6], sb[7]); *(v4u*)(p + 128) = w;
        return 0.f;
    }
    __device__ __forceinline__ void row_done(int, int, int, float) const {}
};
struct EpiResid {
    static constexpr bool NEED_SS = true;
    const float* R; float* H; bf16* HB; float* rss;
    __device__ __forceinline__ float apply(int row, int pn, int c128, const float (&a)[8], const float (&b)[8]) const {
        const size_t off = (size_t)row * DM + pn * 256 + c128; float ss = 0.f;
        {   const f32x4 r0 = *(const f32x4*)(R + off), r1 = *(const f32x4*)(R + off + 4);
            const f32x4 h0 = {r0.x + a[0], r0.y + a[1], r0.z + a[2], r0.w + a[3]}, h1 = {r1.x + a[4], r1.y + a[5], r1.z + a[6], r1.w + a[7]};
            *(f32x4*)(H + off) = h0; *(f32x4*)(H + off + 4) = h1;
            v4u w; w.x = pk2(h0.x, h0.y); w.y = pk2(h0.z, h0.w); w.z = pk2(h1.x, h1.y); w.w = pk2(h1.z, h1.w); *(v4u*)(HB + off) = w;
            ss += (h0.x * h0.x + h0.y * h0.y) + (h0.z * h0.z + h0.w * h0.w) + (h1.x * h1.x + h1.y * h1.y) + (h1.z * h1.z + h1.w * h1.w); }
        {   const size_t o2 = off + 128; const f32x4 r0 = *(const f32x4*)(R + o2), r1 = *(const f32x4*)(R + o2 + 4);
            const f32x4 h0 = {r0.x + b[0], r0.y + b[1], r0.z + b[2], r0.w + b[3]}, h1 = {r1.x + b[4], r1.y + b[5], r1.z + b[6], r1.w + b[7]};
            *(f32x4*)(H + o2) = h0; *(f32x4*)(H + o2 + 4) = h1;
            v4u w; w.x = pk2(h0.x, h0.y); w.y = pk2(h0.z, h0.w); w.z = pk2(h1.x, h1.y); w.w = pk2(h1.z, h1.w); *(v4u*)(HB + o2) = w;
            ss += (h0.x * h0.x + h0.y * h0.y) + (h0.z * h0.z + h0.w * h0.w) + (h1.x * h1.x + h1.y * h1.y) + (h1.z * h1.z + h1.w * h1.w); }
        return ss;
    }
    __device__ __forceinline__ void row_done(int row, int pn, int wc, float ss) const { rss[(size_t)row * 16 + pn * 4 + wc] = ss; }
};
__device__ __forceinline__ float silu_mul(float g, float u) { return g / (1.0f + __expf(-g)) * u; }
struct EpiSwiGLU {
    static constexpr bool NEED_SS = false;
    bf16* Hm; int ldh; const float* rss; const int* tok;
    __device__ __forceinline__ float apply(int row, int pn, int c128, const float (&a)[8], const float (&b)[8]) const {
        int t = row; if (tok) t = tok[row];
        float o[8];
        if (t >= 0) { const float s = rstd_from(rss + (size_t)t * 16);
#pragma unroll
            for (int j = 0; j < 8; ++j) o[j] = silu_mul(a[j] * s, b[j] * s);
        } else {
#pragma unroll
            for (int j = 0; j < 8; ++j) o[j] = 0.f; }
        v4u w; w.x = pk2(o[0], o[1]); w.y = pk2(o[2], o[3]); w.z = pk2(o[4], o[5]); w.w = pk2(o[6], o[7]);
        *(v4u*)(Hm + (size_t)row * ldh + pn * 128 + c128) = w;
        return 0.f;
    }
    __device__ __forceinline__ void row_done(int, int, int, float) const {}
};
struct EpiMoeDown {
    static constexpr bool NEED_SS = false;
    float* H; const int* tok; const float* w;
    __device__ __forceinline__ float apply(int row, int pn, int c128, const float (&a)[8], const float (&b)[8]) const {
        const int t = tok[row]; if (t < 0) return 0.f;
        const float s = w[row]; float* p = H + (size_t)t * DM + pn * 256 + c128;
        f32x4 h0 = *(f32x4*)p, h1 = *(f32x4*)(p + 4), h2 = *(f32x4*)(p + 128), h3 = *(f32x4*)(p + 132);
        h0.x += s * a[0]; h0.y += s * a[1]; h0.z += s * a[2]; h0.w += s * a[3]; h1.x += s * a[4]; h1.y += s * a[5]; h1.z += s * a[6]; h1.w += s * a[7];
        h2.x += s * b[0]; h2.y += s * b[1]; h2.z += s * b[2]; h2.w += s * b[3]; h3.x += s * b[4]; h3.y += s * b[5]; h3.z += s * b[6]; h3.w += s * b[7];
        *(f32x4*)p = h0; *(f32x4*)(p + 4) = h1; *(f32x4*)(p + 128) = h2; *(f32x4*)(p + 132) = h3;
        return 0.f;
    }
    __device__ __forceinline__ void row_done(int, int, int, float) const {}
};

template <class Epi, bool GATHER>
__device__ __forceinline__ void gemm_simple(LAS unsigned char* lds, const Sched& S, const Epi& E, const int* gtok) {
    LAS float* As = (LAS float*)lds;
    LAS float* Bs = (LAS float*)(lds + 16384);
    const int tid = threadIdx.x, wc = tid & 3, rr = tid >> 2, K = S.K;
    Unit u;
    for (int i = 0; S.next(i, u); ++i) {
        const char* bb = S.b_base(u);
        for (int h = 0; h < 2; ++h) {
            const int rowbase = u.pm * 256 + h * 128;
            const bf16* arow; { int r = rowbase + (tid >> 2); if (GATHER) { int t = gtok[r]; if (t < 0) t = 0; arow = (const bf16*)S.A + (size_t)t * K; } else arow = (const bf16*)S.A + (size_t)r * K; }
            const bf16* brow = (const bf16*)bb + (size_t)(tid >> 1) * K;
            float ca[32], cb[32];
#pragma unroll
            for (int j = 0; j < 32; ++j) { ca[j] = 0.f; cb[j] = 0.f; }
            for (int k0 = 0; k0 < K; k0 += 16) {
                const v2u av = *(const v2u*)(arow + k0 + (tid & 3) * 4);
                const v4u bv = *(const v4u*)(brow + k0 + (tid & 1) * 8);
                __syncthreads();
                { LAS float* d = As + (tid >> 2) * 17 + (tid & 3) * 4; d[0] = bflo(av.x); d[1] = bfhi(av.x); d[2] = bflo(av.y); d[3] = bfhi(av.y); }
                { const int kb = (tid & 1) * 8, n = tid >> 1; LAS float* d = Bs + n;
                  d[(kb + 0) * 260] = bflo(bv.x); d[(kb + 1) * 260] = bfhi(bv.x); d[(kb + 2) * 260] = bflo(bv.y); d[(kb + 3) * 260] = bfhi(bv.y);
                  d[(kb + 4) * 260] = bflo(bv.z); d[(kb + 5) * 260] = bfhi(bv.z); d[(kb + 6) * 260] = bflo(bv.w); d[(kb + 7) * 260] = bfhi(bv.w); }
                __syncthreads();
#pragma unroll 4
                for (int k = 0; k < 16; ++k) {
                    const float a = As[rr * 17 + k];
                    const LAS f32x4* b0 = (const LAS f32x4*)(Bs + k * 260 + 32 * wc);
                    const LAS f32x4* b1 = (const LAS f32x4*)(Bs + k * 260 + 128 + 32 * wc);
#pragma unroll
                    for (int j = 0; j < 8; ++j) { const f32x4 x = b0[j], y = b1[j];
                        ca[4 * j] += a * x.x; ca[4 * j + 1] += a * x.y; ca[4 * j + 2] += a * x.z; ca[4 * j + 3] += a * x.w;
                        cb[4 * j] += a * y.x; cb[4 * j + 1] += a * y.y; cb[4 * j + 2] += a * y.z; cb[4 * j + 3] += a * y.w; }
                }
            }
            const int row = rowbase + rr; float ss = 0.f;
#pragma unroll
            for (int g = 0; g < 4; ++g) { float a8[8], b8[8];
#pragma unroll
                for (int j = 0; j < 8; ++j) { a8[j] = ca[8 * g + j]; b8[j] = cb[8 * g + j]; }
                ss += E.apply(row, u.pn, 32 * wc + 8 * g, a8, b8); asm volatile("" ::: "memory"); }
            if (Epi::NEED_SS) E.row_done(row, u.pn, wc, ss);
        }
    }
    __syncthreads();
}

template <class Epi, bool GATHER>
__device__ __forceinline__ void gemm_run(LAS unsigned char* lds, const Sched& S, const Epi& E, const int* gtok) {
    gemm_simple<Epi, GATHER>(lds, S, E, gtok);
}

__device__ __forceinline__ void na_simple(const Frame& F, const bf16* act0, const bf16* v0t, const float* rpb, bf16* mix) {
    for (int it = F.gw; it < NT * 12; it += F.NGW) {
        const int token = it / 12, h = it % 12, lane = F.lane;
        const int b = token >> 12, p = token & 4095, r = p >> 6, c = p & 63;
        const int r0 = min(max(r - 4, 0), 56), cs = min(max(c - 8, 0), 48);
        const float q = bf2f(act0[(size_t)token * A0_LD + h * 64 + lane]);
        float m = -INFINITY, l = 0.f, o = 0.f;
        for (int a = 0; a < 8; ++a)
            for (int u = 0; u < 16; ++u) {
                const int kt = b * SEQ + (r0 + a) * 64 + cs + u;
                const float kv = bf2f(act0[(size_t)kt * A0_LD + 768 + h * 64 + lane]);
                const float sc = wave_sum(q * kv) + rpb[h * 465 + (r0 + a - r + 7) * 31 + (cs + u - c + 15)];
                const float mn = fmaxf(m, sc), corr = __expf(m - mn), pe = __expf(sc - mn);
                const float vv = bf2f(v0t[(size_t)(h * 64 + lane) * NT + kt]);
                l = l * corr + pe; o = o * corr + pe * vv; m = mn;
            }
        mix[(size_t)token * DM + h * 64 + lane] = (bf16)f2bf(o / l);
    }
}
__device__ __forceinline__ void memattn_simple(const Frame& F, int first, int stride, const bf16* act, int ld, int qoff, const bf16* memk, const bf16* memvt, bf16* mix) {
    for (int it = first; it < NT * 4; it += stride) {
        const int token = it >> 2, h = it & 3, lane = F.lane, b = token >> 12;
        const float q = bf2f(act[(size_t)token * ld + qoff + h * 64 + lane]);
        float m = -INFINITY, l = 0.f, o = 0.f;
        for (int j = 0; j < 256; ++j) {
            const float kv = bf2f(memk[(size_t)(b * 256 + j) * 256 + h * 64 + lane]);
            const float sc = wave_sum(q * kv);
            const float mn = fmaxf(m, sc), corr = __expf(m - mn), pe = __expf(sc - mn);
            const float vv = bf2f(memvt[(size_t)(h * 64 + lane) * MEM_ROWS + b * 256 + j]);
            l = l * corr + pe; o = o * corr + pe * vv; m = mn;
        }
        mix[(size_t)token * DM + 768 + h * 64 + lane] = (bf16)f2bf(o / l);
    }
}

__device__ __forceinline__ float logsigmoid(float x) { return fminf(x, 0.f) - log1pf(__expf(-fabsf(x))); }
__device__ __forceinline__ void gla_simple(const Frame& F, int item, const bf16* act1, const bf16* v1t, const float* wgk, const float* bgk, bf16* O) {
    const int b = item >> 3, h = (item >> 1) & 3, dir = item & 1, tid = F.tid;
    LAS float* sh = (LAS float*)F.lds;
    float S[96];
#pragma unroll
    for (int d = 0; d < 96; ++d) S[d] = 0.f;
    float wcol[16], bias = 0.f;
    if (tid < 96) {
#pragma unroll
        for (int r = 0; r < 16; ++r) wcol[r] = wgk[r * 384 + h * 96 + tid];
        bias = bgk[h * 96 + tid];
    }
    for (int tau = 0; tau < SEQ; ++tau) {
        const int token = b * SEQ + (dir ? (SEQ - 1 - tau) : tau);
        LAS float* cur = sh + (tau & 1) * 288;
        if (tid < 96) {
            const bf16* row = act1 + (size_t)token * A1_LD;
            float z = bias;
#pragma unroll
            for (int r = 0; r < 16; ++r) z += bf2f(row[1792 + dir * 16 + r]) * wcol[r];
            cur[tid] = __expf(logsigmoid(z) * (1.0f / 16.0f));
            cur[96 + tid] = bf2f(row[h * 96 + tid]) * 0.10206207261596575f;
            cur[192 + tid] = bf2f(row[384 + h * 96 + tid]);
        }
        __syncthreads();
        if (tid < 192) {
            const float v = bf2f(v1t[(size_t)(h * 192 + tid) * NT + token]);
            float o = 0.f;
            if (dir == 0) {
#pragma unroll
                for (int d = 0; d < 96; ++d) { S[d] = cur[d] * S[d] + cur[192 + d] * v; o += cur[96 + d] * S[d]; }
            } else {
#pragma unroll
                for (int d = 0; d < 96; ++d) { S[d] = cur[d] * S[d]; o += cur[96 + d] * S[d]; S[d] += cur[192 + d] * v; }
            }
            O[(size_t)token * 768 + h * 192 + tid] = (bf16)f2bf(o);
        }
    }
    __syncthreads();
}

__device__ __forceinline__ void gla_combine(const Frame& F, const bf16* OF, const bf16* OB, const bf16* act1, const float* gnorm, bf16* mix) {
    for (int token = F.gw; token < NT; token += F.NGW) {
        const int lane = F.lane;
#pragma unroll
        for (int h = 0; h < 4; ++h) {
            float o[3]; float ss = 0.f;
#pragma unroll
            for (int j = 0; j < 3; ++j) { const size_t idx = (size_t)token * 768 + h * 192 + j * 64 + lane; o[j] = bf2f(OF[idx]) + bf2f(OB[idx]); ss += o[j] * o[j]; }
            ss = wave_sum(ss);
            const float rs = 1.0f / sqrtf(ss * (1.0f / 192.0f) + EPS);
#pragma unroll
            for (int j = 0; j < 3; ++j) { const int dv = j * 64 + lane; const float g = bf2f(act1[(size_t)token * A1_LD + 768 + h * 192 + dv]);
                const float val = o[j] * rs * gnorm[dv] * (g / (1.0f + __expf(-g)));
                mix[(size_t)token * DM + h * 192 + dv] = (bf16)f2bf(val); }
        }
    }
}
__device__ __forceinline__ void route1(const Frame& F, const float* H, const float* gain, const float* wr, int* topi, float* topw, int* cnt) {
    LAS int* lc = (LAS int*)F.lds;
    if (F.tid < 16) lc[F.tid] = 0;
    __syncthreads();
    for (int j = 0; j < 16; ++j) {
        const int token = F.bid * 128 + F.wave * 16 + j, lane = F.lane;
        const float* hr = H + (size_t)token * DM;
        float acc[8], ss = 0.f;
#pragma unroll
        for (int e = 0; e < 8; ++e) acc[e] = 0.f;
#pragma unroll 4
        for (int i = 0; i < 16; ++i) { const int k = i * 64 + lane; const float x = hr[k]; ss += x * x; const float xg = x * gain[k];
            const f32x4 w0 = *(const f32x4*)(wr + k * 8), w1 = *(const f32x4*)(wr + k * 8 + 4);
            acc[0] += xg * w0.x; acc[1] += xg * w0.y; acc[2] += xg * w0.z; acc[3] += xg * w0.w; acc[4] += xg * w1.x; acc[5] += xg * w1.y; acc[6] += xg * w1.z; acc[7] += xg * w1.w; }
        ss = wave_sum(ss); const float rs = 1.0f / sqrtf(ss * (1.0f / DM) + EPS);
#pragma unroll
        for (int e = 0; e < 8; ++e) acc[e] = wave_sum(acc[e]) * rs;
        if (lane == 0) {
            int e0 = 0; float l0 = acc[0];
#pragma unroll
            for (int e = 1; e < 8; ++e) if (acc[e] > l0) { l0 = acc[e]; e0 = e; }
            int e1 = -1; float l1 = -INFINITY;
#pragma unroll
            for (int e = 0; e < 8; ++e) if (e != e0 && acc[e] > l1) { l1 = acc[e]; e1 = e; }
            const float w0 = 1.0f / (1.0f + __expf(l1 - l0));
            topi[token] = e0 | (e1 << 8); topw[2 * token] = w0; topw[2 * token + 1] = 1.0f - w0;
            atomicAdd((int*)&lc[e0], 1); atomicAdd((int*)&lc[8 + e1], 1);
        }
    }
    __syncthreads();
    if (F.tid < 16) cnt[F.bid * 16 + F.tid] = lc[F.tid];
    __syncthreads();
}
__device__ __forceinline__ void route2(const Frame& F, const int* topi, const float* topw, const int* cnt, int* stok, float* sw, int* blk) {
    LAS int* part = (LAS int*)F.lds;
    LAS int* base = part + 1024;
    LAS int* tk = base + 64;
    const int tid = F.tid, pe = tid & 15, jg = tid >> 4;
    int below = 0, tot = 0;
    for (int w = jg; w < F.G; w += 32) { const int v = cnt[w * 16 + pe]; tot += v; if (w < F.bid) below += v; }
    part[jg * 16 + pe] = below; part[512 + jg * 16 + pe] = tot;
    if (tid < 128) tk[tid] = topi[F.bid * 128 + tid];
    __syncthreads();
    if (tid < 16) { int b = 0, t = 0; for (int j = 0; j < 32; ++j) { b += part[j * 16 + tid]; t += part[512 + j * 16 + tid]; } base[tid] = b; base[16 + tid] = t; }
    __syncthreads();
    if (tid < 2) { int ps = 0; for (int e = 0; e < 8; ++e) { base[32 + tid * 8 + e] = ps; ps += (base[16 + tid * 8 + e] + 255) / 256 * 256; } base[48 + tid] = ps / 256; }
    __syncthreads();
    if (tid < 256) {
        const int p = tid >> 7, i = tid & 127; const int e = (tk[i] >> (8 * p)) & 0xff;
        int rank = 0; for (int j = 0; j < i; ++j) rank += (((tk[j] >> (8 * p)) & 0xff) == e) ? 1 : 0;
        const int slot = base[32 + p * 8 + e] + base[p * 8 + e] + rank; const int token = F.bid * 128 + i;
        stok[p * SLOT_CAP + slot] = token; sw[p * SLOT_CAP + slot] = topw[2 * token + p];
    }
    if (F.bid < 16) {
        const int p = F.bid >> 3, e = F.bid & 7, ps = base[32 + F.bid], t = base[16 + F.bid], pend = ps + (t + 255) / 256 * 256;
        for (int s = ps + t + tid; s < pend; s += NTHR) { stok[p * SLOT_CAP + s] = -1; sw[p * SLOT_CAP + s] = 0.f; }
        for (int bk = ps / 256 + tid; bk < pend / 256; bk += NTHR) blk[16 + p * 256 + bk] = e;
        if (e == 0 && tid == 0) blk[p] = base[48 + p];
    }
    __syncthreads();
}
__device__ __forceinline__ void final_norm(const Frame& F, float* H, const float* gain) {
    for (int row = F.gw; row < NT; row += F.NGW) {
        GAS f32x4* xr = (GAS f32x4*)(H + (size_t)row * DM) + F.lane; const f32x4* gr = (const f32x4*)gain + F.lane;
        f32x4 v[4]; float s = 0.f;
#pragma unroll
        for (int j = 0; j < 4; ++j) { v[j] = xr[64 * j]; s += (v[j].x * v[j].x + v[j].y * v[j].y) + (v[j].z * v[j].z + v[j].w * v[j].w); }
        s = wave_sum(s); const float rs = 1.0f / sqrtf(s * (1.0f / DM) + EPS);
#pragma unroll
        for (int j = 0; j < 4; ++j) { const f32x4 g = gr[64 * j]; f32x4 o = {v[j].x * rs * g.x, v[j].y * rs * g.y, v[j].z * rs * g.z, v[j].w * rs * g.w}; xr[64 * j] = o; }
    }
}

constexpr int N_PHASES = 17;
__global__ void __launch_bounds__(NTHR, 2) mega(Args args) {
    extern __shared__ __attribute__((aligned(16))) unsigned char lds_raw[];
    Frame F;
    F.lds = (LAS unsigned char*)lds_raw;
    F.tid = threadIdx.x; F.lane = F.tid & 63; F.wave = __builtin_amdgcn_readfirstlane(F.tid >> 6);
    F.G = gridDim.x; F.bid = blockIdx.x; F.gw = F.bid * NWAVES + F.wave; F.NGW = F.G * NWAVES; F.ws = args.ws;
    unsigned char* ws = args.ws;
    gu32* ctl = (gu32*)(ws + WS_CTL);
    volatile LAS unsigned* MISC = (volatile LAS unsigned*)(F.lds + MISC_OFF);
    for (int u = F.tid; u < (LDS_BYTES - LDSCTL_OFF) / 4; u += NTHR) ((LAS unsigned*)(F.lds + LDSCTL_OFF))[u] = 0u;
    __syncthreads();
    XcdBarrier bar = xcd_barrier_post((unsigned*)(ctl + CW_BAR), MISC + 8);
    const int lo = args.ph_lo, hi = args.ph_hi;
#ifndef PH_MASK
#define PH_MASK 0x1ffff
#endif
#define IN(k) (((PH_MASK >> (k)) & 1) && lo <= (k) && (k) < hi)
#define SEAM(k) do { if (IN(k) && IN((k) + 1)) xcd_barrier(bar); } while (0)

    float* H = args.out;
    float* rss = (float*)(ws + WS_RSS); float* mrss = (float*)(ws + WS_MRSS);
    bf16* hbf = (bf16*)(ws + WS_HBF); bf16* membf = (bf16*)(ws + WS_MEMBF); bf16* memk = (bf16*)(ws + WS_MEMK); bf16* memvt = (bf16*)(ws + WS_MEMVT);
    bf16* act0 = (bf16*)(ws + WS_ACT0); bf16* v0t = (bf16*)(ws + WS_V0T); bf16* mix = (bf16*)(ws + WS_MIX); bf16* hmid0 = (bf16*)(ws + WS_HMID0);
    bf16* act1 = (bf16*)(ws + WS_ACT1); bf16* v1t = (bf16*)(ws + WS_V1T); bf16* OF = (bf16*)(ws + WS_OF); bf16* OB = (bf16*)(ws + WS_OB);
    bf16* hmid1 = (bf16*)(ws + WS_HMID1); bf16* wgu = (bf16*)(ws + WS_WGU); bf16* wdn = (bf16*)(ws + WS_WDN);
    int* cnt = (int*)(ws + WS_CNT); int* topi = (int*)(ws + WS_TOPI); float* topw = (float*)(ws + WS_TOPW);
    int* stok = (int*)(ws + WS_STOK); float* sw = (float*)(ws + WS_SW); int* blk = (int*)(ws + WS_BLK);
    LAS float* scr = (LAS float*)(F.lds + F.wave * 16384);

    if (IN(0)) {
        int it = F.gw;
#define CVT(Wp, Kd, Nd, WTp, gainp, kind) do { const CvtJob J{Wp, Kd, Nd, (bf16*)(WTp), gainp, kind}; const int n_ = ((Kd) / 64) * ((Nd) / 32); \
            for (; it < n_; it += F.NGW) cvt_job_item(J, it, scr, F.lane); it -= n_; } while (0)
        CVT(args.in[I_EWIN], 1024, 2560, ws + WS_W0IN, args.in[I_EN1], 1);
        CVT(args.in[I_EWIN], 1024, 2560, ws + WS_WV0, args.in[I_EN1], 2);
        CVT(args.in[I_EWOUT], 1024, 1024, ws + WS_W0OUT, nullptr, 0);
        CVT(args.in[I_EWG], 1024, 2816, ws + WS_W0GU, args.in[I_EN2], 3);
        CVT(args.in[I_EWU], 1024, 2816, ws + WS_W0GU, args.in[I_EN2], 4);
        CVT(args.in[I_EWD], 2816, 1024, ws + WS_W0DN, nullptr, 0);
        CVT(args.in[I_WMKV], 1024, 512, ws + WS_WMEM, args.in[I_MNORM], 0);
        CVT(args.in[I_OWIN], 1024, 2592, ws + WS_W1IN, args.in[I_ON1], 5);
        CVT(args.in[I_OWIN], 1024, 2592, ws + WS_WV1, args.in[I_ON1], 6);
        CVT(args.in[I_OWOUT], 1024, 1024, ws + WS_W1OUT, nullptr, 0);
#undef CVT
        { v4u z = {0u, 0u, 0u, 0u}; v4u* p = (v4u*)(ws + WS_W1IN + (size_t)1824 * 2048); const int n16 = 224 * 2048 / 16;
          for (int i = F.bid * NTHR + F.tid; i < n16; i += F.G * NTHR) p[i] = z; }
        for (int m = F.gw; m < NT; m += F.NGW) row_to_bf16(args.in[I_X] + (size_t)m * DM, hbf + (size_t)m * DM, rss + (size_t)m * 16, F.lane);
        for (int m = F.gw; m < MEM_ROWS; m += F.NGW) row_to_bf16(args.in[I_MEM] + (size_t)m * DM, membf + (size_t)m * DM, mrss + (size_t)m * 16, F.lane);
    }
    SEAM(0);
    if (IN(1)) {
        { Sched S; S.init(hbf, ws + WS_W0IN, 1024, 128, 7, F.G, F.bid); EpiRowScale E{act0, A0_LD, rss}; gemm_run<EpiRowScale, false>(F.lds, S, E, nullptr); }
        { Sched S; S.init(ws + WS_WV0, hbf, 1024, 3, 128, F.G, (F.bid + 128) % F.G); EpiColScale E{v0t, NT, rss}; gemm_run<EpiColScale, false>(F.lds, S, E, nullptr); }
        { Sched S; S.init(membf, ws + WS_WMEM, 1024, 8, 1, F.G, F.bid); EpiRowScale E{memk, 256, mrss}; gemm_run<EpiRowScale, false>(F.lds, S, E, nullptr); }
        { Sched S; S.init(ws + WS_WMEM + 256 * 2048, membf, 1024, 1, 8, F.G, (F.bid + 248) % F.G); EpiColScale E{memvt, MEM_ROWS, mrss}; gemm_run<EpiColScale, false>(F.lds, S, E, nullptr); }
    }
    SEAM(1);
    if (IN(2)) {
        na_simple(F, act0, v0t, args.in[I_RPB], mix);
        memattn_simple(F, F.gw, F.NGW, act0, A0_LD, 1536, memk, memvt, mix);
    }
    SEAM(2);
    if (IN(3)) { Sched S; S.init(mix, ws + WS_W0OUT, 1024, 128, 4, F.G, F.bid); EpiResid E{args.in[I_X], H, hbf, rss}; gemm_run<EpiResid, false>(F.lds, S, E, nullptr); }
    SEAM(3);
    if (IN(4)) { Sched S; S.init(hbf, ws + WS_W0GU, 1024, 128, 22, F.G, F.bid); EpiSwiGLU E{hmid0, FF0, rss, nullptr}; gemm_run<EpiSwiGLU, false>(F.lds, S, E, nullptr); }
    SEAM(4);
    if (IN(5)) { Sched S; S.init(hmid0, ws + WS_W0DN, FF0, 128, 4, F.G, F.bid); EpiResid E{H, H, hbf, rss}; gemm_run<EpiResid, false>(F.lds, S, E, nullptr); }
    SEAM(5);
    if (IN(6)) {
        { Sched S; S.init(hbf, ws + WS_W1IN, 1024, 128, 8, F.G, F.bid); EpiRowScale E{act1, A1_LD, rss}; gemm_run<EpiRowScale, false>(F.lds, S, E, nullptr); }
        { Sched S; S.init(ws + WS_WV1, hbf, 1024, 3, 128, F.G, F.bid); EpiColScale E{v1t, NT, rss}; gemm_run<EpiColScale, false>(F.lds, S, E, nullptr); }
    }
    SEAM(6);
    if (IN(7)) {
        if (F.bid < 64) {
            const int dir = F.bid & 1;
            gla_simple(F, F.bid, act1, v1t, dir ? args.in[I_WGKB] : args.in[I_WGKF], dir ? args.in[I_BGKB] : args.in[I_BGKF], dir ? OB : OF);
        } else {
            memattn_simple(F, (F.bid - 64) * NWAVES + F.wave, (F.G - 64) * NWAVES, act1, A1_LD, 1536, memk, memvt, mix);
        }
    }
    SEAM(7);
    if (IN(8)) gla_combine(F, OF, OB, act1, args.in[I_GNORM], mix);
    SEAM(8);
    if (IN(9)) { Sched S; S.init(mix, ws + WS_W1OUT, 1024, 128, 4, F.G, F.bid); EpiResid E{H, H, hbf, rss}; gemm_run<EpiResid, false>(F.lds, S, E, nullptr); }
    SEAM(9);
    if (IN(10)) {
        route1(F, H, args.in[I_ON2], args.in[I_WR], topi, topw, cnt);
        for (int it = F.gw; it < 8 * 3 * 1792; it += F.NGW) {
            const int e = it / 5376, r = it % 5376, which = r / 1792, item = r % 1792;
            if (which == 0) { CvtJob J{args.in[I_OWG] + (size_t)e * 1024 * FFE, 1024, FFE, wgu + (size_t)e * 7168 * 1024, args.in[I_ON2], 3}; cvt_job_item(J, item, scr, F.lane); }
            else if (which == 1) { CvtJob J{args.in[I_OWU] + (size_t)e * 1024 * FFE, 1024, FFE, wgu + (size_t)e * 7168 * 1024, args.in[I_ON2], 4}; cvt_job_item(J, item, scr, F.lane); }
            else { CvtJob J{args.in[I_OWD] + (size_t)e * FFE * 1024, FFE, 1024, wdn + (size_t)e * 1024 * FFE, nullptr, 0}; cvt_job_item(J, item, scr, F.lane); }
        }
    }
    SEAM(10);
    if (IN(11)) route2(F, topi, topw, cnt, stok, sw, blk);
    SEAM(11);
    if (IN(12)) { const int nb = blk[0]; Sched S; S.init(hbf, wgu, 1024, nb, 28, F.G, F.bid, blk + 16, (size_t)7168 * 1024 * 2);
        EpiSwiGLU E{hmid1, FFE, rss, stok}; gemm_run<EpiSwiGLU, true>(F.lds, S, E, stok); }
    SEAM(12);
    if (IN(13)) { const int nb = blk[0]; Sched S; S.init(hmid1, wdn, FFE, nb, 4, F.G, F.bid, blk + 16, (size_t)1024 * FFE * 2);
        EpiMoeDown E{H, stok, sw}; gemm_run<EpiMoeDown, false>(F.lds, S, E, nullptr); }
    SEAM(13);
    if (IN(14)) { const int nb = blk[1]; Sched S; S.init(hbf, wgu, 1024, nb, 28, F.G, F.bid, blk + 16 + 256, (size_t)7168 * 1024 * 2);
        EpiSwiGLU E{hmid1, FFE, rss, stok + SLOT_CAP}; gemm_run<EpiSwiGLU, true>(F.lds, S, E, stok + SLOT_CAP); }
    SEAM(14);
    if (IN(15)) { const int nb = blk[1]; Sched S; S.init(hmid1, wdn, FFE, nb, 4, F.G, F.bid, blk + 16 + 256, (size_t)1024 * FFE * 2);
        EpiMoeDown E{H, stok + SLOT_CAP, sw + SLOT_CAP}; gemm_run<EpiMoeDown, false>(F.lds, S, E, nullptr); }
    SEAM(15);
    if (IN(16)) final_norm(F, H, args.in[I_FNORM]);
#undef IN
#undef SEAM
}

extern "C" void kernel_launch(void* const* d_in, const int* in_sizes, int n_in, void* d_out, int out_size, void* d_ws, size_t ws_size, hipStream_t stream) {
    static int grid = 0;
    if (grid == 0) {
        if (n_in != 26 || out_size != NT * DM || ws_size < WS_END) { fprintf(stderr, "kernel_launch: unexpected problem (n_in %d out %d ws %zu need %zu)\n", n_in, out_size, ws_size, (size_t)WS_END); grid = -1; return; }
        int dev = 0, cus = 0, per_cu = 0;
        if (hipGetDevice(&dev) != hipSuccess || hipDeviceGetAttribute(&cus, hipDeviceAttributeMultiprocessorCount, dev) != hipSuccess) { grid = -1; return; }
        if (hipFuncSetAttribute((const void*)mega, hipFuncAttributeMaxDynamicSharedMemorySize, LDS_BYTES) != hipSuccess) { fprintf(stderr, "kernel_launch: hipFuncSetAttribute failed\n"); grid = -1; return; }
        if (hipOccupancyMaxActiveBlocksPerMultiprocessor(&per_cu, (const void*)mega, NTHR, LDS_BYTES) != hipSuccess || per_cu < 1) fprintf(stderr, "kernel_launch: occupancy query reports %d\n", per_cu);
        (void)hipGetLastError();
        grid = cus;
        if (grid != 256) fprintf(stderr, "kernel_launch: note: %d CUs\n", grid);
    }
    if (grid < 0) return;
    if (hipMemsetAsync((char*)d_ws + WS_CTL, 0, CTL_ZERO_BYTES, stream) != hipSuccess) return;
    Args a{};
    for (int i = 0; i < 26; ++i) a.in[i] = (const float*)d_in[i];
    a.out = (float*)d_out; a.ws = (unsigned char*)d_ws;
#if MK_FUSED
    a.ph_lo = 0; a.ph_hi = N_PHASES;
    hipLaunchKernelGGL(mega, dim3(grid), dim3(NTHR), LDS_BYTES, stream, a);
#else
    for (int p = 0; p < N_PHASES; ++p) { a.ph_lo = p; a.ph_hi = p + 1; hipLaunchKernelGGL(mega, dim3(grid), dim3(NTHR), LDS_BYTES, stream, a); }
#endif
}
```

```cpp
#include <hip/hip_runtime.h>
#include <cstdio>
#include <cstdint>

#ifndef MK_FUSED
#define MK_FUSED 1
#endif
#ifndef FAST_GEMM
#define FAST_GEMM 0
#endif
#ifndef FAST_ATT
#define FAST_ATT 0
#endif
#ifndef FAST_GLA
#define FAST_GLA 0
#endif

#define GAS __attribute__((address_space(1)))
#define LAS __attribute__((address_space(3)))
typedef unsigned short bf16;
typedef unsigned v4u __attribute__((ext_vector_type(4)));
typedef unsigned v2u __attribute__((ext_vector_type(2)));
typedef float f32x4 __attribute__((ext_vector_type(4)));
typedef short bf16x8 __attribute__((ext_vector_type(8)));
typedef GAS unsigned gu32;
#define RLX_AGENT __ATOMIC_RELAXED, __HIP_MEMORY_SCOPE_AGENT
#define LDS_WAIT() asm volatile("s_waitcnt lgkmcnt(0)" ::: "memory")
#define VM_WAIT() asm volatile("s_waitcnt vmcnt(0)" ::: "memory")

constexpr int NT = 32768, DM = 1024, SEQ = 4096, NB = 8;
constexpr int MEM_ROWS = 2048;
constexpr int A0_LD = 1792;
constexpr int A1_LD = 2048;
constexpr int FF0 = 2816, FFE = 3584, NEXP = 8;
constexpr int SLOT_CAP = 34816;
constexpr float EPS = 1e-6f;
constexpr int NWAVES = 8, NTHR = 512;

constexpr size_t MiB = 1u << 20;
constexpr size_t WS_CTL = 0, CTL_ZERO_BYTES = 1 * MiB;
constexpr size_t WS_RSS = 1 * MiB;
constexpr size_t WS_MRSS = 3 * MiB;
constexpr size_t WS_CNT = 3 * MiB + 256 * 1024;
constexpr size_t WS_TOPI = 3 * MiB + 512 * 1024;
constexpr size_t WS_TOPW = 3 * MiB + 768 * 1024;
constexpr size_t WS_STOK = 4 * MiB;
constexpr size_t WS_SW = 4 * MiB + 512 * 1024;
constexpr size_t WS_BLK = 5 * MiB;
constexpr size_t WS_W0IN = 6 * MiB;
constexpr size_t WS_WV0 = WS_W0IN + 1792 * 2048;
constexpr size_t WS_W0OUT = 11 * MiB;
constexpr size_t WS_W0GU = 13 * MiB;
constexpr size_t WS_W0DN = 24 * MiB;
constexpr size_t WS_WMEM = WS_W0DN + 1024 * 2816 * 2;
constexpr size_t WS_W1IN = 31 * MiB;
constexpr size_t WS_WV1 = 35 * MiB;
constexpr size_t WS_W1OUT = 37 * MiB - 512 * 1024;
constexpr size_t WS_HBF = 39 * MiB;
constexpr size_t WS_MEMBF = 103 * MiB;
constexpr size_t WS_MEMK = 107 * MiB;
constexpr size_t WS_MEMVT = 108 * MiB;
constexpr size_t WS_ACT = 109 * MiB;
constexpr size_t WS_ACT0 = WS_ACT;
constexpr size_t WS_V0T = WS_ACT + 112 * MiB;
constexpr size_t WS_MIX = WS_ACT + 176 * MiB;
constexpr size_t WS_HMID0 = WS_ACT;
constexpr size_t WS_ACT1 = WS_ACT;
constexpr size_t WS_V1T = WS_ACT + 128 * MiB;
constexpr size_t WS_OF = WS_ACT + 240 * MiB;
constexpr size_t WS_OB = WS_ACT + 288 * MiB;
constexpr size_t WS_HMID1 = WS_ACT;
constexpr size_t WS_WGU = WS_ACT + 240 * MiB;
constexpr size_t WS_WDN = WS_ACT + 352 * MiB;
constexpr size_t WS_END = WS_ACT + 408 * MiB;
static_assert(WS_W1OUT + 2 * MiB <= WS_HBF && WS_WV1 + 768 * 2048 <= WS_W1OUT && WS_W1IN + 4 * MiB <= WS_WV1 && WS_WMEM + MiB <= WS_W1IN, "weight map");
static_assert(WS_W0GU + 11 * MiB <= WS_W0DN && WS_WV0 + 768 * 2048 <= WS_W0OUT, "weight map 2");
static_assert((size_t)SLOT_CAP * 3584 * 2 <= 240 * MiB, "hmid1");

constexpr int CW_TMO = 0, CW_CODE = 1, CW_BAR = 4096;

constexpr int RING_BYTES = 131072;
constexpr int LDSCTL_OFF = RING_BYTES, MISC_OFF = LDSCTL_OFF + 320;
constexpr int LDS_BYTES = 147456;

__device__ __forceinline__ unsigned f2bf(float f) { unsigned u = __builtin_bit_cast(unsigned, f); return (u + 0x7fffu + ((u >> 16) & 1u)) >> 16; }
__device__ __forceinline__ unsigned pk2(float lo, float hi) { return f2bf(lo) | (f2bf(hi) << 16); }
__device__ __forceinline__ float bf2f(bf16 b) { return __builtin_bit_cast(float, (unsigned)b << 16); }
__device__ __forceinline__ float bflo(unsigned u) { return __builtin_bit_cast(float, u << 16); }
__device__ __forceinline__ float bfhi(unsigned u) { return __builtin_bit_cast(float, u & 0xffff0000u); }
__device__ __forceinline__ float wave_sum(float v) {
#pragma unroll
    for (int o = 1; o < 64; o <<= 1) v += __shfl_xor(v, o);
    return v;
}
__device__ __forceinline__ float wave_max(float v) {
#pragma unroll
    for (int o = 1; o < 64; o <<= 1) v = fmaxf(v, __shfl_xor(v, o));
    return v;
}
__device__ __forceinline__ float rstd_from(const float* rss16) {
    const f32x4* p = (const f32x4*)rss16; f32x4 a = p[0], b = p[1], c = p[2], d = p[3];
    const float s = ((a.x + a.y) + (a.z + a.w)) + ((b.x + b.y) + (b.z + b.w)) + ((c.x + c.y) + (c.z + c.w)) + ((d.x + d.y) + (d.z + d.w));
    return 1.0f / sqrtf(s * (1.0f / DM) + EPS);
}

#define XB_TMO      128
#define XB_XCNT(j)  (256  + 64 * (j))
#define XB_XSUB(j)  (1280 + 64 * (j))
#define XB_XGEN(j)  (2304 + 64 * (j))
#define XB_TOP      3328
#define XB_TOPGEN   3392
#define XCD_BAR_WORDS 3456
#define XB_SPIN_CAP (1u << 22)

__device__ __forceinline__ unsigned xb_ld(unsigned* p)              { return __hip_atomic_load(p, __ATOMIC_RELAXED, __HIP_MEMORY_SCOPE_AGENT); }
__device__ __forceinline__ unsigned xb_add(unsigned* p, unsigned v) { return __hip_atomic_fetch_add(p, v, __ATOMIC_RELAXED, __HIP_MEMORY_SCOPE_AGENT); }
__device__ __forceinline__ unsigned xb_xcc_id() { return (unsigned)__builtin_amdgcn_s_getreg((3 << 11) | 20) & 0xFu; }
#define XB_SPIN(cond, bar) do { unsigned _sp = 0; while (cond) { __builtin_amdgcn_s_sleep(1); \
    if ((++_sp & 255u) == 0u) { if (xb_ld(&(bar)[XB_TMO])) break; if (_sp > XB_SPIN_CAP) { atomicAdd(&(bar)[XB_TMO], 1u); break; } } } } while (0)

struct XcdBarrier { unsigned* bar; unsigned x; volatile LAS unsigned* st; };

__device__ __forceinline__ XcdBarrier xcd_barrier_post(unsigned* bar, volatile LAS unsigned* st) {
    XcdBarrier b; b.bar = bar; b.x = xb_xcc_id(); b.st = st;
    if (threadIdx.x == 0) (void)xb_add(&bar[XB_XCNT(b.x)], 1u);
    return b;
}
__device__ __forceinline__ void xcd_barrier_complete(unsigned* bar, unsigned x, unsigned& nloc, unsigned& nx) {
    const unsigned G = gridDim.x * gridDim.y * gridDim.z;
    unsigned sum, cnt, mine, sp = 0u;
    for (;;) {
        sum = 0u; cnt = 0u; mine = 0u;
#pragma unroll
        for (unsigned j = 0; j < 16; ++j) { const unsigned c = xb_ld(&bar[XB_XCNT(j)]); sum += c; cnt += (c > 0u) ? 1u : 0u; mine = (j == x) ? c : mine; }
        if (sum == G) break;
        __builtin_amdgcn_s_sleep(1);
        if ((++sp & 255u) == 0u) { if (xb_ld(&bar[XB_TMO])) break; if (sp > XB_SPIN_CAP) { atomicAdd(&bar[XB_TMO], 1u); break; } }
    }
    nloc = mine > 0u ? mine : 1u; nx = cnt > 0u ? cnt : 1u;
}
__device__ __forceinline__ void xcd_barrier(const XcdBarrier& b) {
    asm volatile("s_waitcnt vmcnt(0)" ::: "memory");
    __syncthreads();
    if (threadIdx.x == 0) {
        unsigned* bar = b.bar;
        __builtin_amdgcn_s_waitcnt(0);
        unsigned nloc = b.st[0], nx = b.st[1];
        if (nloc == 0u) { xcd_barrier_complete(bar, b.x, nloc, nx); b.st[0] = nloc; b.st[1] = nx; }
        const unsigned old = xb_add(&bar[XB_XSUB(b.x)], 1u);
        const unsigned gen = old / nloc;
        if (old + 1u == (gen + 1u) * nloc) {
            __builtin_amdgcn_fence(__ATOMIC_RELEASE, "agent");
            asm volatile("s_waitcnt vmcnt(0)" ::: "memory");
            const unsigned og = xb_add(&bar[XB_TOP], 1u);
            const unsigned tg = og / nx;
            if (og + 1u == (tg + 1u) * nx) xb_add(&bar[XB_TOPGEN], 1u);
            else XB_SPIN(xb_ld(&bar[XB_TOPGEN]) == tg, bar);
            __builtin_amdgcn_fence(__ATOMIC_ACQUIRE, "agent");
            xb_add(&bar[XB_XGEN(b.x)], 1u);
            asm volatile("s_waitcnt vmcnt(0)" ::: "memory");
        } else {
            XB_SPIN(xb_ld(&bar[XB_XGEN(b.x)]) == gen, bar);
            __builtin_amdgcn_fence(__ATOMIC_ACQUIRE, "agent");
            asm volatile("s_waitcnt vmcnt(0)" ::: "memory");
        }
    }
    __syncthreads();
}

struct Args { const float* in[26]; float* out; unsigned char* ws; int ph_lo, ph_hi; };
enum { I_X = 0, I_MEM, I_EN1, I_EWIN, I_RPB, I_EWOUT, I_EN2, I_EWG, I_EWU, I_EWD, I_ON1, I_OWIN, I_WGKF, I_BGKF, I_WGKB, I_BGKB, I_GNORM, I_OWOUT, I_ON2, I_WR, I_OWG, I_OWU, I_OWD, I_MNORM, I_WMKV, I_FNORM };

struct Frame {
    LAS unsigned char* lds;
    int tid, lane, wave, G, bid;
    int gw, NGW;
    unsigned char* ws;
};

__device__ __forceinline__ void cvt_item(const float* W, int ldn, int k0, int n0, bf16* WT, int ldk, int drow0, const float* gain, float scale, LAS float* scr, int lane) {
#pragma unroll 8
    for (int i = 0; i < 32; ++i) { const int kk = 2 * i + (lane >> 5); float v = W[(size_t)(k0 + kk) * ldn + n0 + (lane & 31)];
        const float gg = gain ? gain[k0 + kk] : 1.0f; scr[kk * 33 + (lane & 31)] = v * gg * scale; }
    LDS_WAIT(); asm volatile("" ::: "memory");
    const int c = lane & 7;
#pragma unroll
    for (int j = 0; j < 4; ++j) { const int n = (lane >> 3) + 8 * j; const LAS float* s = scr + (8 * c) * 33 + n;
        v4u o; o.x = pk2(s[0 * 33], s[1 * 33]); o.y = pk2(s[2 * 33], s[3 * 33]); o.z = pk2(s[4 * 33], s[5 * 33]); o.w = pk2(s[6 * 33], s[7 * 33]);
        *(GAS v4u*)(WT + (size_t)(drow0 + n) * ldk + k0 + 8 * c) = o; }
    LDS_WAIT(); asm volatile("" ::: "memory");
}
struct CvtJob { const float* W; int K, N; bf16* WT; const float* gain; int kind; };
__device__ __forceinline__ bool cvt_map(int kind, int n0, int& drow, float& scale) {
    scale = 1.0f;
    switch (kind) {
    case 0: drow = n0; return true;
    case 1: if (n0 < 768) { drow = n0; scale = 0.125f; return true; } if (n0 < 1536) { drow = n0; return true; } if (n0 >= 2304) { drow = n0 - 768; scale = 0.125f; return true; } return false;
    case 2: if (n0 >= 1536 && n0 < 2304) { drow = n0 - 1536; return true; } return false;
    case 3: drow = (n0 >> 7) * 256 + (n0 & 127); return true;
    case 4: drow = (n0 >> 7) * 256 + 128 + (n0 & 127); return true;
    case 5: if (n0 < 768) { drow = n0; return true; } if (n0 < 1536) return false; if (n0 < 2304) { drow = n0 - 768; return true; }
            if (n0 < 2336) { drow = n0 - 512; return true; } drow = n0 - 800; scale = 0.125f; return true;
    case 6: if (n0 >= 768 && n0 < 1536) { drow = n0 - 768; return true; } return false;
    default: drow = n0; return true;
    }
}
__device__ __forceinline__ void cvt_job_item(const CvtJob& J, int item, LAS float* scr, int lane) {
    const int nblk = J.N / 32, kb = item / nblk, nb = item % nblk; int drow; float scale;
    if (!cvt_map(J.kind, nb * 32, drow, scale)) return;
    cvt_item(J.W, J.N, kb * 64, nb * 32, J.WT, J.K, drow, J.gain, scale, scr, lane);
}

__device__ __forceinline__ void row_to_bf16(const float* xrow, bf16* orow, float* rss16, int lane) {
    const GAS f32x4* xr = (const GAS f32x4*)xrow + lane;
    f32x4 v[4]; float s = 0.f;
#pragma unroll
    for (int j = 0; j < 4; ++j) { v[j] = xr[64 * j]; s += (v[j].x * v[j].x + v[j].y * v[j].y) + (v[j].z * v[j].z + v[j].w * v[j].w); }
    s = wave_sum(s);
    GAS unsigned long long* o8 = (GAS unsigned long long*)orow + lane;
#pragma unroll
    for (int j = 0; j < 4; ++j) o8[64 * j] = (unsigned long long)pk2(v[j].x, v[j].y) | ((unsigned long long)pk2(v[j].z, v[j].w) << 32);
    if (lane < 16) rss16[lane] = (lane == 0) ? s : 0.f;
}

struct Unit { int pm, pn; };
struct Sched {
    int nM, nN, nwg, G, c, K;
    const char* A; const char* B; const int* bexp; size_t estride;
    __device__ void init(const void* A_, const void* B_, int K_, int nM_, int nN_, int G_, int c_, const int* bexp_ = nullptr, size_t estride_ = 0) {
        A = (const char*)A_; B = (const char*)B_; K = K_; nM = nM_; nN = nN_; nwg = nM * nN; G = G_; c = c_; bexp = bexp_; estride = estride_; }
    __device__ bool next(int i, Unit& u) const {
        const long L = (long)i * G + c; if (L >= nwg) return false;
        int wgid = (int)L; { const int q = nwg / 8, r = nwg % 8, xcd = wgid % 8, off = wgid / 8; wgid = (xcd < r ? xcd * (q + 1) : r * (q + 1) + (xcd - r) * q) + off; }
        const int nig = 8 * nN, gid = wgid / nig, fm = gid * 8, gsz = (nM - fm) < 8 ? (nM - fm) : 8;
        u.pm = fm + ((wgid % nig) % gsz); u.pn = (wgid % nig) / gsz; return true;
    }
    __device__ const char* a_base(const Unit& u) const { return A + (size_t)u.pm * 512 * K; }
    __device__ const char* b_base(const Unit& u) const { return B + (bexp ? (size_t)bexp[u.pm] * estride : (size_t)0) + (size_t)u.pn * 512 * K; }
};

struct EpiRowScale {
    static constexpr bool NEED_SS = false;
    bf16* O; int ldc; const float* rss;
    __device__ __forceinline__ float apply(int row, int pn, int c128, const float (&a)[8], const float (&b)[8]) const {
        const float s = rstd_from(rss + (size_t)row * 16);
        bf16* p = O + (size_t)row * ldc + pn * 256 + c128;
        v4u w; w.x = pk2(a[0] * s, a[1] * s); w.y = pk2(a[2] * s, a[3] * s); w.z = pk2(a[4] * s, a[5] * s); w.w = pk2(a[6] * s, a[7] * s); *(v4u*)p = w;
        w.x = pk2(b[0] * s, b[1] * s); w.y = pk2(b[2] * s, b[3] * s); w.z = pk2(b[4] * s, b[5] * s); w.w = pk2(b[6] * s, b[7] * s); *(v4u*)(p + 128) = w;
        return 0.f;
    }
    __device__ __forceinline__ void row_done(int, int, int, float) const {}
};
struct EpiColScale {
    static constexpr bool NEED_SS = false;
    bf16* O; int ldc; const float* rss;
    __device__ __forceinline__ float apply(int row, int pn, int c128, const float (&a)[8], const float (&b)[8]) const {
        const int col = pn * 256 + c128; bf16* p = O + (size_t)row * ldc + col;
        float sa[8], sb[8]; const float* pa = rss + (size_t)col * 16; const float* pb = pa + 128 * 16;
#pragma unroll
        for (int j = 0; j < 8; ++j) { float r0 = rstd_from(pa + j * 16), r1 = rstd_from(pb + j * 16); asm volatile("" : "+v"(r0), "+v"(r1) :: "memory"); sa[j] = a[j] * r0; sb[j] = b[j] * r1; }
        v4u w; w.x = pk2(sa[0], sa[1]); w.y = pk2(sa[2], sa[3]); w.z = pk2(sa[4], sa[5]); w.w = pk2(sa[6], sa[7]); *(v4u*)p = w;
        w.x = pk2(sb[0], sb[1]); w.y = pk2(sb[2], sb[3]); w.z = pk2(sb[4], sb[5]); w.w = pk2(sb[6], sb[7]); *(v4u*)(p + 128) = w;
        return 0.f;
    }
    __device__ __forceinline__ void row_done(int, int, int, float) const {}
};
struct EpiResid {
    static constexpr bool NEED_SS = true;
    const float* R; float* H; bf16* HB; float* rss;
    __device__ __forceinline__ float apply(int row, int pn, int c128, const float (&a)[8], const float (&b)[8]) const {
        const size_t off = (size_t)row * DM + pn * 256 + c128; float ss = 0.f;
        {   const f32x4 r0 = *(const f32x4*)(R + off), r1 = *(const f32x4*)(R + off + 4);
            const f32x4 h0 = {r0.x + a[0], r0.y + a[1], r0.z + a[2], r0.w + a[3]}, h1 = {r1.x + a[4], r1.y + a[5], r1.z + a[6], r1.w + a[7]};
            *(f32x4*)(H + off) = h0; *(f32x4*)(H + off + 4) = h1;
            v4u w; w.x = pk2(h0.x, h0.y); w.y = pk2(h0.z, h0.w); w.z = pk2(h1.x, h1.y); w.w = pk2(h1.z, h1.w); *(v4u*)(HB + off) = w;
            ss += (h0.x * h0.x + h0.y * h0.y) + (h0.z * h0.z + h0.w * h0.w) + (h1.x * h1.x + h1.y * h1.y) + (h1.z * h1.z + h1.w * h1.w); }
        {   const size_t o2 = off + 128; const f32x4 r0 = *(const f32x4*)(R + o2), r1 = *(const f32x4*)(R + o2 + 4);
            const f32x4 h0 = {r0.x + b[0], r0.y + b[1], r0.z + b[2], r0.w + b[3]}, h1 = {r1.x + b[4], r1.y + b[5], r1.z + b[6], r1.w + b[7]};
            *(f32x4*)(H + o2) = h0; *(f32x4*)(H + o2 + 4) = h1;
            v4u w; w.x = pk2(h0.x, h0.y); w.y = pk2(h0.z, h0.w); w.z = pk2(h1.x, h1.y); w.w = pk2(h1.z, h1.w); *(v4u*)(HB + o2) = w;
            ss += (h0.x * h0.x + h0.y * h0.y) + (h0.z * h0.z + h0.w * h0.w) + (h1.x * h1.x + h1.y * h1.y) + (h1.z * h1.z + h1.w * h1.w); }
        return ss;
    }
    __device__ __forceinline__ void row_done(int row, int pn, int wc, float ss) const { rss[(size_t)row * 16 + pn * 4 + wc] = ss; }
};
__device__ __forceinline__ float silu_mul(float g, float u) { return g / (1.0f + __expf(-g)) * u; }
struct EpiSwiGLU {
    static constexpr bool NEED_SS = false;
    bf16* Hm; int ldh; const float* rss; const int* tok;
    __device__ __forceinline__ float apply(int row, int pn, int c128, const float (&a)[8], const float (&b)[8]) const {
        int t = row; if (tok) t = tok[row];
        float o[8];
        if (t >= 0) { const float s = rstd_from(rss + (size_t)t * 16);
#pragma unroll
            for (int j = 0; j < 8; ++j) o[j] = silu_mul(a[j] * s, b[j] * s);
        } else {
#pragma unroll
            for (int j = 0; j < 8; ++j) o[j] = 0.f; }
        v4u w; w.x = pk2(o[0], o[1]); w.y = pk2(o[2], o[3]); w.z = pk2(o[4], o[5]); w.w = pk2(o[6], o[7]);
        *(v4u*)(Hm + (size_t)row * ldh + pn * 128 + c128) = w;
        return 0.f;
    }
    __device__ __forceinline__ void row_done(int, int, int, float) const {}
};
struct EpiMoeDown {
    static constexpr bool NEED_SS = false;
    float* H; const int* tok; const float* w;
    __device__ __forceinline__ float apply(int row, int pn, int c128, const float (&a)[8], const float (&b)[8]) const {
        const int t = tok[row]; if (t < 0) return 0.f;
        const float s = w[row]; float* p = H + (size_t)t * DM + pn * 256 + c128;
        f32x4 h0 = *(f32x4*)p, h1 = *(f32x4*)(p + 4), h2 = *(f32x4*)(p + 128), h3 = *(f32x4*)(p + 132);
        h0.x += s * a[0]; h0.y += s * a[1]; h0.z += s * a[2]; h0.w += s * a[3]; h1.x += s * a[4]; h1.y += s * a[5]; h1.z += s * a[6]; h1.w += s * a[7];
        h2.x += s * b[0]; h2.y += s * b[1]; h2.z += s * b[2]; h2.w += s * b[3]; h3.x += s * b[4]; h3.y += s * b[5]; h3.z += s * b[6]; h3.w += s * b[7];
        *(f32x4*)p = h0; *(f32x4*)(p + 4) = h1; *(f32x4*)(p + 128) = h2; *(f32x4*)(p + 132) = h3;
        return 0.f;
    }
    __device__ __forceinline__ void row_done(int, int, int, float) const {}
};

template <class Epi, bool GATHER>
__device__ __forceinline__ void gemm_simple(LAS unsigned char* lds, const Sched& S, const Epi& E, const int* gtok) {
    LAS float* As = (LAS float*)lds;
    LAS float* Bs = (LAS float*)(lds + 16384);
    const int tid = threadIdx.x, wc = tid & 3, rr = tid >> 2, K = S.K;
    Unit u;
    for (int i = 0; S.next(i, u); ++i) {
        const char* bb = S.b_base(u);
        for (int h = 0; h < 2; ++h) {
            const int rowbase = u.pm * 256 + h * 128;
            const bf16* arow; { int r = rowbase + (tid >> 2); if (GATHER) { int t = gtok[r]; if (t < 0) t = 0; arow = (const bf16*)S.A + (size_t)t * K; } else arow = (const bf16*)S.A + (size_t)r * K; }
            const bf16* brow = (const bf16*)bb + (size_t)(tid >> 1) * K;
            float ca[32], cb[32];
#pragma unroll
            for (int j = 0; j < 32; ++j) { ca[j] = 0.f; cb[j] = 0.f; }
            for (int k0 = 0; k0 < K; k0 += 16) {
                const v2u av = *(const v2u*)(arow + k0 + (tid & 3) * 4);
                const v4u bv = *(const v4u*)(brow + k0 + (tid & 1) * 8);
                __syncthreads();
                { LAS float* d = As + (tid >> 2) * 17 + (tid & 3) * 4; d[0] = bflo(av.x); d[1] = bfhi(av.x); d[2] = bflo(av.y); d[3] = bfhi(av.y); }
                { const int kb = (tid & 1) * 8, n = tid >> 1; LAS float* d = Bs + n;
                  d[(kb + 0) * 260] = bflo(bv.x); d[(kb + 1) * 260] = bfhi(bv.x); d[(kb + 2) * 260] = bflo(bv.y); d[(kb + 3) * 260] = bfhi(bv.y);
                  d[(kb + 4) * 260] = bflo(bv.z); d[(kb + 5) * 260] = bfhi(bv.z); d[(kb + 6) * 260] = bflo(bv.w); d[(kb + 7) * 260] = bfhi(bv.w); }
                __syncthreads();
#pragma unroll 4
                for (int k = 0; k < 16; ++k) {
                    const float a = As[rr * 17 + k];
                    const LAS f32x4* b0 = (const LAS f32x4*)(Bs + k * 260 + 32 * wc);
                    const LAS f32x4* b1 = (const LAS f32x4*)(Bs + k * 260 + 128 + 32 * wc);
#pragma unroll
                    for (int j = 0; j < 8; ++j) { const f32x4 x = b0[j], y = b1[j];
                        ca[4 * j] += a * x.x; ca[4 * j + 1] += a * x.y; ca[4 * j + 2] += a * x.z; ca[4 * j + 3] += a * x.w;
                        cb[4 * j] += a * y.x; cb[4 * j + 1] += a * y.y; cb[4 * j + 2] += a * y.z; cb[4 * j + 3] += a * y.w; }
                }
            }
            const int row = rowbase + rr; float ss = 0.f;
#pragma unroll
            for (int g = 0; g < 4; ++g) { float a8[8], b8[8];
#pragma unroll
                for (int j = 0; j < 8; ++j) { a8[j] = ca[8 * g + j]; b8[j] = cb[8 * g + j]; }
                ss += E.apply(row, u.pn, 32 * wc + 8 * g, a8, b8); asm volatile("" ::: "memory"); }
            if (Epi::NEED_SS) E.row_done(row, u.pn, wc, ss);
        }
    }
    __syncthreads();
}

template <class Epi, bool GATHER>
__device__ __forceinline__ void gemm_run(LAS unsigned char* lds, const Sched& S, const Epi& E, const int* gtok) {
    gemm_simple<Epi, GATHER>(lds, S, E, gtok);
}

__device__ __forceinline__ void na_simple(const Frame& F, const bf16* act0, const bf16* v0t, const float* rpb, bf16* mix) {
    for (int it = F.gw; it < NT * 12; it += F.NGW) {
        const int token = it / 12, h = it % 12, lane = F.lane;
        const int b = token >> 12, p = token & 4095, r = p >> 6, c = p & 63;
        const int r0 = min(max(r - 4, 0), 56), cs = min(max(c - 8, 0), 48);
        const float q = bf2f(act0[(size_t)token * A0_LD + h * 64 + lane]);
        float m = -INFINITY, l = 0.f, o = 0.f;
        for (int a = 0; a < 8; ++a)
            for (int u = 0; u < 16; ++u) {
                const int kt = b * SEQ + (r0 + a) * 64 + cs + u;
                const float kv = bf2f(act0[(size_t)kt * A0_LD + 768 + h * 64 + lane]);
                const float sc = wave_sum(q * kv) + rpb[h * 465 + (r0 + a - r + 7) * 31 + (cs + u - c + 15)];
                const float mn = fmaxf(m, sc), corr = __expf(m - mn), pe = __expf(sc - mn);
                const float vv = bf2f(v0t[(size_t)(h * 64 + lane) * NT + kt]);
                l = l * corr + pe; o = o * corr + pe * vv; m = mn;
            }
        mix[(size_t)token * DM + h * 64 + lane] = (bf16)f2bf(o / l);
    }
}
__device__ __forceinline__ void memattn_simple(const Frame& F, int first, int stride, const bf16* act, int ld, int qoff, const bf16* memk, const bf16* memvt, bf16* mix) {
    for (int it = first; it < NT * 4; it += stride) {
        const int token = it >> 2, h = it & 3, lane = F.lane, b = token >> 12;
        const float q = bf2f(act[(size_t)token * ld + qoff + h * 64 + lane]);
        float m = -INFINITY, l = 0.f, o = 0.f;
        for (int j = 0; j < 256; ++j) {
            const float kv = bf2f(memk[(size_t)(b * 256 + j) * 256 + h * 64 + lane]);
            const float sc = wave_sum(q * kv);
            const float mn = fmaxf(m, sc), corr = __expf(m - mn), pe = __expf(sc - mn);
            const float vv = bf2f(memvt[(size_t)(h * 64 + lane) * MEM_ROWS + b * 256 + j]);
            l = l * corr + pe; o = o * corr + pe * vv; m = mn;
        }
        mix[(size_t)token * DM + 768 + h * 64 + lane] = (bf16)f2bf(o / l);
    }
}

__device__ __forceinline__ float logsigmoid(float x) { return fminf(x, 0.f) - log1pf(__expf(-fabsf(x))); }
__device__ __forceinline__ void gla_simple(const Frame& F, int item, const bf16* act1, const bf16* v1t, const float* wgk, const float* bgk, bf16* O) {
    const int b = item >> 3, h = (item >> 1) & 3, dir = item & 1, tid = F.tid;
    LAS float* sh = (LAS float*)F.lds;
    float S[96];
#pragma unroll
    for (int d = 0; d < 96; ++d) S[d] = 0.f;
    float wcol[16], bias = 0.f;
    if (tid < 96) {
#pragma unroll
        for (int r = 0; r < 16; ++r) wcol[r] = wgk[r * 384 + h * 96 + tid];
        bias = bgk[h * 96 + tid];
    }
    for (int tau = 0; tau < SEQ; ++tau) {
        const int token = b * SEQ + (dir ? (SEQ - 1 - tau) : tau);
        LAS float* cur = sh + (tau & 1) * 288;
        if (tid < 96) {
            const bf16* row = act1 + (size_t)token * A1_LD;
            float z = bias;
#pragma unroll
            for (int r = 0; r < 16; ++r) z += bf2f(row[1792 + dir * 16 + r]) * wcol[r];
            cur[tid] = __expf(logsigmoid(z) * (1.0f / 16.0f));
            cur[96 + tid] = bf2f(row[h * 96 + tid]) * 0.10206207261596575f;
            cur[192 + tid] = bf2f(row[384 + h * 96 + tid]);
        }
        __syncthreads();
        if (tid < 192) {
            const float v = bf2f(v1t[(size_t)(h * 192 + tid) * NT + token]);
            float o = 0.f;
            if (dir == 0) {
#pragma unroll
                for (int d = 0; d < 96; ++d) { S[d] = cur[d] * S[d] + cur[192 + d] * v; o += cur[96 + d] * S[d]; }
            } else {
#pragma unroll
                for (int d = 0; d < 96; ++d) { S[d] = cur[d] * S[d]; o += cur[96 + d] * S[d]; S[d] += cur[192 + d] * v; }
            }
            O[(size_t)token * 768 + h * 192 + tid] = (bf16)f2bf(o);
        }
    }
    __syncthreads();
}

__device__ __forceinline__ void gla_combine(const Frame& F, const bf16* OF, const bf16* OB, const bf16* act1, const float* gnorm, bf16* mix) {
    for (int token = F.gw; token < NT; token += F.NGW) {
        const int lane = F.lane;
#pragma unroll
        for (int h = 0; h < 4; ++h) {
            float o[3]; float ss = 0.f;
#pragma unroll
            for (int j = 0; j < 3; ++j) { const size_t idx = (size_t)token * 768 + h * 192 + j * 64 + lane; o[j] = bf2f(OF[idx]) + bf2f(OB[idx]); ss += o[j] * o[j]; }
            ss = wave_sum(ss);
            const float rs = 1.0f / sqrtf(ss * (1.0f / 192.0f) + EPS);
#pragma unroll
            for (int j = 0; j < 3; ++j) { const int dv = j * 64 + lane; const float g = bf2f(act1[(size_t)token * A1_LD + 768 + h * 192 + dv]);
                const float val = o[j] * rs * gnorm[dv] * (g / (1.0f + __expf(-g)));
                mix[(size_t)token * DM + h * 192 + dv] = (bf16)f2bf(val); }
        }
    }
}
__device__ __forceinline__ void route1(const Frame& F, const float* H, const float* gain, const float* wr, int* topi, float* topw, int* cnt) {
    LAS int* lc = (LAS int*)F.lds;
    if (F.tid < 16) lc[F.tid] = 0;
    __syncthreads();
    for (int j = 0; j < 16; ++j) {
        const int token = F.bid * 128 + F.wave * 16 + j, lane = F.lane;
        const float* hr = H + (size_t)token * DM;
        float acc[8], ss = 0.f;
#pragma unroll
        for (int e = 0; e < 8; ++e) acc[e] = 0.f;
#pragma unroll 4
        for (int i = 0; i < 16; ++i) { const int k = i * 64 + lane; const float x = hr[k]; ss += x * x; const float xg = x * gain[k];
            const f32x4 w0 = *(const f32x4*)(wr + k * 8), w1 = *(const f32x4*)(wr + k * 8 + 4);
            acc[0] += xg * w0.x; acc[1] += xg * w0.y; acc[2] += xg * w0.z; acc[3] += xg * w0.w; acc[4] += xg * w1.x; acc[5] += xg * w1.y; acc[6] += xg * w1.z; acc[7] += xg * w1.w; }
        ss = wave_sum(ss); const float rs = 1.0f / sqrtf(ss * (1.0f / DM) + EPS);
#pragma unroll
        for (int e = 0; e < 8; ++e) acc[e] = wave_sum(acc[e]) * rs;
        if (lane == 0) {
            int e0 = 0; float l0 = acc[0];
#pragma unroll
            for (int e = 1; e < 8; ++e) if (acc[e] > l0) { l0 = acc[e]; e0 = e; }
            int e1 = -1; float l1 = -INFINITY;
#pragma unroll
            for (int e = 0; e < 8; ++e) if (e != e0 && acc[e] > l1) { l1 = acc[e]; e1 = e; }
            const float w0 = 1.0f / (1.0f + __expf(l1 - l0));
            topi[token] = e0 | (e1 << 8); topw[2 * token] = w0; topw[2 * token + 1] = 1.0f - w0;
            atomicAdd((int*)&lc[e0], 1); atomicAdd((int*)&lc[8 + e1], 1);
        }
    }
    __syncthreads();
    if (F.tid < 16) cnt[F.bid * 16 + F.tid] = lc[F.tid];
    __syncthreads();
}
__device__ __forceinline__ void route2(const Frame& F, const int* topi, const float* topw, const int* cnt, int* stok, float* sw, int* blk) {
    LAS int* part = (LAS int*)F.lds;
    LAS int* base = part + 1024;
    LAS int* tk = base + 64;
    const int tid = F.tid, pe = tid & 15, jg = tid >> 4;
    int below = 0, tot = 0;
    for (int w = jg; w < F.G; w += 32) { const int v = cnt[w * 16 + pe]; tot += v; if (w < F.bid) below += v; }
    part[jg * 16 + pe] = below; part[512 + jg * 16 + pe] = tot;
    if (tid < 128) tk[tid] = topi[F.bid * 128 + tid];
    __syncthreads();
    if (tid < 16) { int b = 0, t = 0; for (int j = 0; j < 32; ++j) { b += part[j * 16 + tid]; t += part[512 + j * 16 + tid]; } base[tid] = b; base[16 + tid] = t; }
    __syncthreads();
    if (tid < 2) { int ps = 0; for (int e = 0; e < 8; ++e) { base[32 + tid * 8 + e] = ps; ps += (base[16 + tid * 8 + e] + 255) / 256 * 256; } base[48 + tid] = ps / 256; }
    __syncthreads();
    if (tid < 256) {
        const int p = tid >> 7, i = tid & 127; const int e = (tk[i] >> (8 * p)) & 0xff;
        int rank = 0; for (int j = 0; j < i; ++j) rank += (((tk[j] >> (8 * p)) & 0xff) == e) ? 1 : 0;
        const int slot = base[32 + p * 8 + e] + base[p * 8 + e] + rank; const int token = F.bid * 128 + i;
        stok[p * SLOT_CAP + slot] = token; sw[p * SLOT_CAP + slot] = topw[2 * token + p];
    }
    if (F.bid < 16) {
        const int p = F.bid >> 3, e = F.bid & 7, ps = base[32 + F.bid], t = base[16 + F.bid], pend = ps + (t + 255) / 256 * 256;
        for (int s = ps + t + tid; s < pend; s += NTHR) { stok[p * SLOT_CAP + s] = -1; sw[p * SLOT_CAP + s] = 0.f; }
        for (int bk = ps / 256 + tid; bk < pend / 256; bk += NTHR) blk[16 + p * 256 + bk] = e;
        if (e == 0 && tid == 0) blk[p] = base[48 + p];
    }
    __syncthreads();
}
__device__ __forceinline__ void final_norm(const Frame& F, float* H, const float* gain) {
    for (int row = F.gw; row < NT; row += F.NGW) {
        GAS f32x4* xr = (GAS f32x4*)(H + (size_t)row * DM) + F.lane; const f32x4* gr = (const f32x4*)gain + F.lane;
        f32x4 v[4]; float s = 0.f;
#pragma unroll
        for (int j = 0; j < 4; ++j) { v[j] = xr[64 * j]; s += (v[j].x * v[j].x + v[j].y * v[j].y) + (v[j].z * v[j].z + v[j].w * v[j].w); }
        s = wave_sum(s); const float rs = 1.0f / sqrtf(s * (1.0f / DM) + EPS);
#pragma unroll
        for (int j = 0; j < 4; ++j) { const f32x4 g = gr[64 * j]; f32x4 o = {v[j].x * rs * g.x, v[j].y * rs * g.y, v[j].z * rs * g.z, v[j].w * rs * g.w}; xr[64 * j] = o; }
    }
}

constexpr int N_PHASES = 17;
__global__ void __launch_bounds__(NTHR, 2) mega(Args args) {
    extern __shared__ __attribute__((aligned(16))) unsigned char lds_raw[];
    Frame F;
    F.lds = (LAS unsigned char*)lds_raw;
    F.tid = threadIdx.x; F.lane = F.tid & 63; F.wave = __builtin_amdgcn_readfirstlane(F.tid >> 6);
    F.G = gridDim.x; F.bid = blockIdx.x; F.gw = F.bid * NWAVES + F.wave; F.NGW = F.G * NWAVES; F.ws = args.ws;
    unsigned char* ws = args.ws;
    gu32* ctl = (gu32*)(ws + WS_CTL);
    volatile LAS unsigned* MISC = (volatile LAS unsigned*)(F.lds + MISC_OFF);
    for (int u = F.tid; u < (LDS_BYTES - LDSCTL_OFF) / 4; u += NTHR) ((LAS unsigned*)(F.lds + LDSCTL_OFF))[u] = 0u;
    __syncthreads();
    XcdBarrier bar = xcd_barrier_post((unsigned*)(ctl + CW_BAR), MISC + 8);
    const int lo = args.ph_lo, hi = args.ph_hi;
#ifndef PH_MASK
#define PH_MASK 0x1ffff
#endif
#define IN(k) (((PH_MASK >> (k)) & 1) && lo <= (k) && (k) < hi)
#define SEAM(k) do { if (IN(k) && IN((k) + 1)) xcd_barrier(bar); } while (0)

    float* H = args.out;
    float* rss = (float*)(ws + WS_RSS); float* mrss = (float*)(ws + WS_MRSS);
    bf16* hbf = (bf16*)(ws + WS_HBF); bf16* membf = (bf16*)(ws + WS_MEMBF); bf16* memk = (bf16*)(ws + WS_MEMK); bf16* memvt = (bf16*)(ws + WS_MEMVT);
    bf16* act0 = (bf16*)(ws + WS_ACT0); bf16* v0t = (bf16*)(ws + WS_V0T); bf16* mix = (bf16*)(ws + WS_MIX); bf16* hmid0 = (bf16*)(ws + WS_HMID0);
    bf16* act1 = (bf16*)(ws + WS_ACT1); bf16* v1t = (bf16*)(ws + WS_V1T); bf16* OF = (bf16*)(ws + WS_OF); bf16* OB = (bf16*)(ws + WS_OB);
    bf16* hmid1 = (bf16*)(ws + WS_HMID1); bf16* wgu = (bf16*)(ws + WS_WGU); bf16* wdn = (bf16*)(ws + WS_WDN);
    int* cnt = (int*)(ws + WS_CNT); int* topi = (int*)(ws + WS_TOPI); float* topw = (float*)(ws + WS_TOPW);
    int* stok = (int*)(ws + WS_STOK); float* sw = (float*)(ws + WS_SW); int* blk = (int*)(ws + WS_BLK);
    LAS float* scr = (LAS float*)(F.lds + F.wave * 16384);

    if (IN(0)) {
        int it = F.gw;
#define CVT(Wp, Kd, Nd, WTp, gainp, kind) do { const CvtJob J{Wp, Kd, Nd, (bf16*)(WTp), gainp, kind}; const int n_ = ((Kd) / 64) * ((Nd) / 32); \
            for (; it < n_; it += F.NGW) cvt_job_item(J, it, scr, F.lane); it -= n_; } while (0)
        CVT(args.in[I_EWIN], 1024, 2560, ws + WS_W0IN, args.in[I_EN1], 1);
        CVT(args.in[I_EWIN], 1024, 2560, ws + WS_WV0, args.in[I_EN1], 2);
        CVT(args.in[I_EWOUT], 1024, 1024, ws + WS_W0OUT, nullptr, 0);
        CVT(args.in[I_EWG], 1024, 2816, ws + WS_W0GU, args.in[I_EN2], 3);
        CVT(args.in[I_EWU], 1024, 2816, ws + WS_W0GU, args.in[I_EN2], 4);
        CVT(args.in[I_EWD], 2816, 1024, ws + WS_W0DN, nullptr, 0);
        CVT(args.in[I_WMKV], 1024, 512, ws + WS_WMEM, args.in[I_MNORM], 0);
        CVT(args.in[I_OWIN], 1024, 2592, ws + WS_W1IN, args.in[I_ON1], 5);
        CVT(args.in[I_OWIN], 1024, 2592, ws + WS_WV1, args.in[I_ON1], 6);
        CVT(args.in[I_OWOUT], 1024, 1024, ws + WS_W1OUT, nullptr, 0);
#undef CVT
        { v4u z = {0u, 0u, 0u, 0u}; v4u* p = (v4u*)(ws + WS_W1IN + (size_t)1824 * 2048); const int n16 = 224 * 2048 / 16;
          for (int i = F.bid * NTHR + F.tid; i < n16; i += F.G * NTHR) p[i] = z; }
        for (int m = F.gw; m < NT; m += F.NGW) row_to_bf16(args.in[I_X] + (size_t)m * DM, hbf + (size_t)m * DM, rss + (size_t)m * 16, F.lane);
        for (int m = F.gw; m < MEM_ROWS; m += F.NGW) row_to_bf16(args.in[I_MEM] + (size_t)m * DM, membf + (size_t)m * DM, mrss + (size_t)m * 16, F.lane);
    }
    SEAM(0);
    if (IN(1)) {
        { Sched S; S.init(hbf, ws + WS_W0IN, 1024, 128, 7, F.G, F.bid); EpiRowScale E{act0, A0_LD, rss}; gemm_run<EpiRowScale, false>(F.lds, S, E, nullptr); }
        { Sched S; S.init(ws + WS_WV0, hbf, 1024, 3, 128, F.G, (F.bid + 128) % F.G); EpiColScale E{v0t, NT, rss}; gemm_run<EpiColScale, false>(F.lds, S, E, nullptr); }
        { Sched S; S.init(membf, ws + WS_WMEM, 1024, 8, 1, F.G, F.bid); EpiRowScale E{memk, 256, mrss}; gemm_run<EpiRowScale, false>(F.lds, S, E, nullptr); }
        { Sched S; S.init(ws + WS_WMEM + 256 * 2048, membf, 1024, 1, 8, F.G, (F.bid + 248) % F.G); EpiColScale E{memvt, MEM_ROWS, mrss}; gemm_run<EpiColScale, false>(F.lds, S, E, nullptr); }
    }
    SEAM(1);
    if (IN(2)) {
        na_simple(F, act0, v0t, args.in[I_RPB], mix);
        memattn_simple(F, F.gw, F.NGW, act0, A0_LD, 1536, memk, memvt, mix);
    }
    SEAM(2);
    if (IN(3)) { Sched S; S.init(mix, ws + WS_W0OUT, 1024, 128, 4, F.G, F.bid); EpiResid E{args.in[I_X], H, hbf, rss}; gemm_run<EpiResid, false>(F.lds, S, E, nullptr); }
    SEAM(3);
    if (IN(4)) { Sched S; S.init(hbf, ws + WS_W0GU, 1024, 128, 22, F.G, F.bid); EpiSwiGLU E{hmid0, FF0, rss, nullptr}; gemm_run<EpiSwiGLU, false>(F.lds, S, E, nullptr); }
    SEAM(4);
    if (IN(5)) { Sched S; S.init(hmid0, ws + WS_W0DN, FF0, 128, 4, F.G, F.bid); EpiResid E{H, H, hbf, rss}; gemm_run<EpiResid, false>(F.lds, S, E, nullptr); }
    SEAM(5);
    if (IN(6)) {
        { Sched S; S.init(hbf, ws + WS_W1IN, 1024, 128, 8, F.G, F.bid); EpiRowScale E{act1, A1_LD, rss}; gemm_run<EpiRowScale, false>(F.lds, S, E, nullptr); }
        { Sched S; S.init(ws + WS_WV1, hbf, 1024, 3, 128, F.G, F.bid); EpiColScale E{v1t, NT, rss}; gemm_run<EpiColScale, false>(F.lds, S, E, nullptr); }
    }
    SEAM(6);
    if (IN(7)) {
        if (F.bid < 64) {
            const int dir = F.bid & 1;
            gla_simple(F, F.bid, act1, v1t, dir ? args.in[I_WGKB] : args.in[I_WGKF], dir ? args.in[I_BGKB] : args.in[I_BGKF], dir ? OB : OF);
        } else {
            memattn_simple(F, (F.bid - 64) * NWAVES + F.wave, (F.G - 64) * NWAVES, act1, A1_LD, 1536, memk, memvt, mix);
        }
    }
    SEAM(7);
    if (IN(8)) gla_combine(F, OF, OB, act1, args.in[I_GNORM], mix);
    SEAM(8);
    if (IN(9)) { Sched S; S.init(mix, ws + WS_W1OUT, 1024, 128, 4, F.G, F.bid); EpiResid E{H, H, hbf, rss}; gemm_run<EpiResid, false>(F.lds, S, E, nullptr); }
    SEAM(9);
    if (IN(10)) {
        route1(F, H, args.in[I_ON2], args.in[I_WR], topi, topw, cnt);
        for (int it = F.gw; it < 8 * 3 * 1792; it += F.NGW) {
            const int e = it / 5376, r = it % 5376, which = r / 1792, item = r % 1792;
            if (which == 0) { CvtJob J{args.in[I_OWG] + (size_t)e * 1024 * FFE, 1024, FFE, wgu + (size_t)e * 7168 * 1024, args.in[I_ON2], 3}; cvt_job_item(J, item, scr, F.lane); }
            else if (which == 1) { CvtJob J{args.in[I_OWU] + (size_t)e * 1024 * FFE, 1024, FFE, wgu + (size_t)e * 7168 * 1024, args.in[I_ON2], 4}; cvt_job_item(J, item, scr, F.lane); }
            else { CvtJob J{args.in[I_OWD] + (size_t)e * FFE * 1024, FFE, 1024, wdn + (size_t)e * 1024 * FFE, nullptr, 0}; cvt_job_item(J, item, scr, F.lane); }
        }
    }
    SEAM(10);
    if (IN(11)) route2(F, topi, topw, cnt, stok, sw, blk);
    SEAM(11);
    if (IN(12)) { const int nb = blk[0]; Sched S; S.init(hbf, wgu, 1024, nb, 28, F.G, F.bid, blk + 16, (size_t)7168 * 1024 * 2);
        EpiSwiGLU E{hmid1, FFE, rss, stok}; gemm_run<EpiSwiGLU, true>(F.lds, S, E, stok); }
    SEAM(12);
    if (IN(13)) { const int nb = blk[0]; Sched S; S.init(hmid1, wdn, FFE, nb, 4, F.G, F.bid, blk + 16, (size_t)1024 * FFE * 2);
        EpiMoeDown E{H, stok, sw}; gemm_run<EpiMoeDown, false>(F.lds, S, E, nullptr); }
    SEAM(13);
    if (IN(14)) { const int nb = blk[1]; Sched S; S.init(hbf, wgu, 1024, nb, 28, F.G, F.bid, blk + 16 + 256, (size_t)7168 * 1024 * 2);
        EpiSwiGLU E{hmid1, FFE, rss, stok + SLOT_CAP}; gemm_run<EpiSwiGLU, true>(F.lds, S, E, stok + SLOT_CAP); }
    SEAM(14);
    if (IN(15)) { const int nb = blk[1]; Sched S; S.init(hmid1, wdn, FFE, nb, 4, F.G, F.bid, blk + 16 + 256, (size_t)1024 * FFE * 2);
        EpiMoeDown E{H, stok + SLOT_CAP, sw + SLOT_CAP}; gemm_run<EpiMoeDown, false>(F.lds, S, E, nullptr); }
    SEAM(15);
    if (IN(16)) final_norm(F, H, args.in[I_FNORM]);
#undef IN
#undef SEAM
}

extern "C" void kernel_launch(void* const* d_in, const int* in_sizes, int n_in, void* d_out, int out_size, void* d_ws, size_t ws_size, hipStream_t stream) {
    static int grid = 0;
    if (grid == 0) {
        if (n_in != 26 || out_size != NT * DM || ws_size < WS_END) { fprintf(stderr, "kernel_launch: unexpected problem (n_in %d out %d ws %zu need %zu)\n", n_in, out_size, ws_size, (size_t)WS_END); grid = -1; return; }
        int dev = 0, cus = 0, per_cu = 0;
        if (hipGetDevice(&dev) != hipSuccess || hipDeviceGetAttribute(&cus, hipDeviceAttributeMultiprocessorCount, dev) != hipSuccess) { grid = -1; return; }
        if (hipFuncSetAttribute((const void*)mega, hipFuncAttributeMaxDynamicSharedMemorySize, LDS_BYTES) != hipSuccess) { fprintf(stderr, "kernel_launch: hipFuncSetAttribute failed\n"); grid = -1; return; }
        if (hipOccupancyMaxActiveBlocksPerMultiprocessor(&per_cu, (const void*)mega, NTHR, LDS_BYTES) != hipSuccess || per_cu < 1) fprintf(stderr, "kernel_launch: occupancy query reports %d\n", per_cu);
        (void)hipGetLastError();
        grid = cus;
        if (grid != 256) fprintf(stderr, "kernel_launch: note: %d CUs\n", grid);
    }
    if (grid < 0) return;
    if (hipMemsetAsync((char*)d_ws + WS_CTL, 0, CTL_ZERO_BYTES, stream) != hipSuccess) return;
    Args a{};
    for (int i = 0; i < 26; ++i) a.in[i] = (const float*)d_in[i];
    a.out = (float*)d_out; a.ws = (unsigned char*)d_ws;
#if MK_FUSED
    a.ph_lo = 0; a.ph_hi = N_PHASES;
    hipLaunchKernelGGL(mega, dim3(grid), dim3(NTHR), LDS_BYTES, stream, a);
#else
    for (int p = 0; p < N_PHASES; ++p) { a.ph_lo = p; a.ph_hi = p + 1; hipLaunchKernelGGL(mega, dim3(grid), dim3(NTHR), LDS_BYTES, stream, a); }
#endif
}
```

```cpp
#include <hip/hip_runtime.h>
#include <cstdio>
#include <cstdint>

#ifndef MK_FUSED
#define MK_FUSED 1
#endif
#ifndef FAST_GEMM
#define FAST_GEMM 1
#endif
#ifndef FAST_ATT
#define FAST_ATT 0
#endif
#ifndef FAST_GLA
#define FAST_GLA 0
#endif

#define GAS __attribute__((address_space(1)))
#define LAS __attribute__((address_space(3)))
typedef unsigned short bf16;
typedef unsigned v4u __attribute__((ext_vector_type(4)));
typedef unsigned v2u __attribute__((ext_vector_type(2)));
typedef float f32x4 __attribute__((ext_vector_type(4)));
typedef short bf16x8 __attribute__((ext_vector_type(8)));
typedef GAS unsigned gu32;
#define RLX_AGENT __ATOMIC_RELAXED, __HIP_MEMORY_SCOPE_AGENT
#define LDS_WAIT() asm volatile("s_waitcnt lgkmcnt(0)" ::: "memory")
#define VM_WAIT() asm volatile("s_waitcnt vmcnt(0)" ::: "memory")

constexpr int NT = 32768, DM = 1024, SEQ = 4096, NB = 8;
constexpr int MEM_ROWS = 2048;
constexpr int A0_LD = 1792;
constexpr int A1_LD = 2048;
constexpr int FF0 = 2816, FFE = 3584, NEXP = 8;
constexpr int SLOT_CAP = 34816;
constexpr float EPS = 1e-6f;
constexpr int NWAVES = 8, NTHR = 512;

constexpr size_t MiB = 1u << 20;
constexpr size_t WS_CTL = 0, CTL_ZERO_BYTES = 1 * MiB;
constexpr size_t WS_RSS = 1 * MiB;
constexpr size_t WS_MRSS = 3 * MiB;
constexpr size_t WS_CNT = 3 * MiB + 256 * 1024;
constexpr size_t WS_TOPI = 3 * MiB + 512 * 1024;
constexpr size_t WS_TOPW = 3 * MiB + 768 * 1024;
constexpr size_t WS_STOK = 4 * MiB;
constexpr size_t WS_SW = 4 * MiB + 512 * 1024;
constexpr size_t WS_BLK = 5 * MiB;
constexpr size_t WS_W0IN = 6 * MiB;
constexpr size_t WS_WV0 = WS_W0IN + 1792 * 2048;
constexpr size_t WS_W0OUT = 11 * MiB;
constexpr size_t WS_W0GU = 13 * MiB;
constexpr size_t WS_W0DN = 24 * MiB;
constexpr size_t WS_WMEM = WS_W0DN + 1024 * 2816 * 2;
constexpr size_t WS_W1IN = 31 * MiB;
constexpr size_t WS_WV1 = 35 * MiB;
constexpr size_t WS_W1OUT = 37 * MiB - 512 * 1024;
constexpr size_t WS_HBF = 39 * MiB;
constexpr size_t WS_MEMBF = 103 * MiB;
constexpr size_t WS_MEMK = 107 * MiB;
constexpr size_t WS_MEMVT = 108 * MiB;
constexpr size_t WS_ACT = 109 * MiB;
constexpr size_t WS_ACT0 = WS_ACT;
constexpr size_t WS_V0T = WS_ACT + 112 * MiB;
constexpr size_t WS_MIX = WS_ACT + 176 * MiB;
constexpr size_t WS_HMID0 = WS_ACT;
constexpr size_t WS_ACT1 = WS_ACT;
constexpr size_t WS_V1T = WS_ACT + 128 * MiB;
constexpr size_t WS_OF = WS_ACT + 240 * MiB;
constexpr size_t WS_OB = WS_ACT + 288 * MiB;
constexpr size_t WS_HMID1 = WS_ACT;
constexpr size_t WS_WGU = WS_ACT + 240 * MiB;
constexpr size_t WS_WDN = WS_ACT + 352 * MiB;
constexpr size_t WS_END = WS_ACT + 408 * MiB;
static_assert(WS_W1OUT + 2 * MiB <= WS_HBF && WS_WV1 + 768 * 2048 <= WS_W1OUT && WS_W1IN + 4 * MiB <= WS_WV1 && WS_WMEM + MiB <= WS_W1IN, "weight map");
static_assert(WS_W0GU + 11 * MiB <= WS_W0DN && WS_WV0 + 768 * 2048 <= WS_W0OUT, "weight map 2");
static_assert((size_t)SLOT_CAP * 3584 * 2 <= 240 * MiB, "hmid1");

constexpr int CW_TMO = 0, CW_CODE = 1, CW_BAR = 4096;

constexpr int RING_BYTES = 131072;
constexpr int LDSCTL_OFF = RING_BYTES, MISC_OFF = LDSCTL_OFF + 320;
constexpr int LDS_BYTES = 147456;

__device__ __forceinline__ unsigned f2bf(float f) { unsigned u = __builtin_bit_cast(unsigned, f); return (u + 0x7fffu + ((u >> 16) & 1u)) >> 16; }
__device__ __forceinline__ unsigned pk2(float lo, float hi) { return f2bf(lo) | (f2bf(hi) << 16); }
__device__ __forceinline__ float bf2f(bf16 b) { return __builtin_bit_cast(float, (unsigned)b << 16); }
__device__ __forceinline__ float bflo(unsigned u) { return __builtin_bit_cast(float, u << 16); }
__device__ __forceinline__ float bfhi(unsigned u) { return __builtin_bit_cast(float, u & 0xffff0000u); }
__device__ __forceinline__ float wave_sum(float v) {
#pragma unroll
    for (int o = 1; o < 64; o <<= 1) v += __shfl_xor(v, o);
    return v;
}
__device__ __forceinline__ float wave_max(float v) {
#pragma unroll
    for (int o = 1; o < 64; o <<= 1) v = fmaxf(v, __shfl_xor(v, o));
    return v;
}
__device__ __forceinline__ float rstd_from(const float* rss16) {
    const f32x4* p = (const f32x4*)rss16; f32x4 a = p[0], b = p[1], c = p[2], d = p[3];
    const float s = ((a.x + a.y) + (a.z + a.w)) + ((b.x + b.y) + (b.z + b.w)) + ((c.x + c.y) + (c.z + c.w)) + ((d.x + d.y) + (d.z + d.w));
    return 1.0f / sqrtf(s * (1.0f / DM) + EPS);
}

#define XB_TMO      128
#define XB_XCNT(j)  (256  + 64 * (j))
#define XB_XSUB(j)  (1280 + 64 * (j))
#define XB_XGEN(j)  (2304 + 64 * (j))
#define XB_TOP      3328
#define XB_TOPGEN   3392
#define XCD_BAR_WORDS 3456
#define XB_SPIN_CAP (1u << 22)

__device__ __forceinline__ unsigned xb_ld(unsigned* p)              { return __hip_atomic_load(p, __ATOMIC_RELAXED, __HIP_MEMORY_SCOPE_AGENT); }
__device__ __forceinline__ unsigned xb_add(unsigned* p, unsigned v) { return __hip_atomic_fetch_add(p, v, __ATOMIC_RELAXED, __HIP_MEMORY_SCOPE_AGENT); }
__device__ __forceinline__ unsigned xb_xcc_id() { return (unsigned)__builtin_amdgcn_s_getreg((3 << 11) | 20) & 0xFu; }
#define XB_SPIN(cond, bar) do { unsigned _sp = 0; while (cond) { __builtin_amdgcn_s_sleep(1); \
    if ((++_sp & 255u) == 0u) { if (xb_ld(&(bar)[XB_TMO])) break; if (_sp > XB_SPIN_CAP) { atomicAdd(&(bar)[XB_TMO], 1u); break; } } } } while (0)

struct XcdBarrier { unsigned* bar; unsigned x; volatile LAS unsigned* st; };

__device__ __forceinline__ XcdBarrier xcd_barrier_post(unsigned* bar, volatile LAS unsigned* st) {
    XcdBarrier b; b.bar = bar; b.x = xb_xcc_id(); b.st = st;
    if (threadIdx.x == 0) (void)xb_add(&bar[XB_XCNT(b.x)], 1u);
    return b;
}
__device__ __forceinline__ void xcd_barrier_complete(unsigned* bar, unsigned x, unsigned& nloc, unsigned& nx) {
    const unsigned G = gridDim.x * gridDim.y * gridDim.z;
    unsigned sum, cnt, mine, sp = 0u;
    for (;;) {
        sum = 0u; cnt = 0u; mine = 0u;
#pragma unroll
        for (unsigned j = 0; j < 16; ++j) { const unsigned c = xb_ld(&bar[XB_XCNT(j)]); sum += c; cnt += (c > 0u) ? 1u : 0u; mine = (j == x) ? c : mine; }
        if (sum == G) break;
        __builtin_amdgcn_s_sleep(1);
        if ((++sp & 255u) == 0u) { if (xb_ld(&bar[XB_TMO])) break; if (sp > XB_SPIN_CAP) { atomicAdd(&bar[XB_TMO], 1u); break; } }
    }
    nloc = mine > 0u ? mine : 1u; nx = cnt > 0u ? cnt : 1u;
}
__device__ __forceinline__ void xcd_barrier(const XcdBarrier& b) {
    asm volatile("s_waitcnt vmcnt(0)" ::: "memory");
    __syncthreads();
    if (threadIdx.x == 0) {
        unsigned* bar = b.bar;
        __builtin_amdgcn_s_waitcnt(0);
        unsigned nloc = b.st[0], nx = b.st[1];
        if (nloc == 0u) { xcd_barrier_complete(bar, b.x, nloc, nx); b.st[0] = nloc; b.st[1] = nx; }
        const unsigned old = xb_add(&bar[XB_XSUB(b.x)], 1u);
        const unsigned gen = old / nloc;
        if (old + 1u == (gen + 1u) * nloc) {
            __builtin_amdgcn_fence(__ATOMIC_RELEASE, "agent");
            asm volatile("s_waitcnt vmcnt(0)" ::: "memory");
            const unsigned og = xb_add(&bar[XB_TOP], 1u);
            const unsigned tg = og / nx;
            if (og + 1u == (tg + 1u) * nx) xb_add(&bar[XB_TOPGEN], 1u);
            else XB_SPIN(xb_ld(&bar[XB_TOPGEN]) == tg, bar);
            __builtin_amdgcn_fence(__ATOMIC_ACQUIRE, "agent");
            xb_add(&bar[XB_XGEN(b.x)], 1u);
            asm volatile("s_waitcnt vmcnt(0)" ::: "memory");
        } else {
            XB_SPIN(xb_ld(&bar[XB_XGEN(b.x)]) == gen, bar);
            __builtin_amdgcn_fence(__ATOMIC_ACQUIRE, "agent");
            asm volatile("s_waitcnt vmcnt(0)" ::: "memory");
        }
    }
    __syncthreads();
}

struct Args { const float* in[26]; float* out; unsigned char* ws; int ph_lo, ph_hi; };
enum { I_X = 0, I_MEM, I_EN1, I_EWIN, I_RPB, I_EWOUT, I_EN2, I_EWG, I_EWU, I_EWD, I_ON1, I_OWIN, I_WGKF, I_BGKF, I_WGKB, I_BGKB, I_GNORM, I_OWOUT, I_ON2, I_WR, I_OWG, I_OWU, I_OWD, I_MNORM, I_WMKV, I_FNORM };

struct Frame {
    LAS unsigned char* lds;
    int tid, lane, wave, G, bid;
    int gw, NGW;
    unsigned char* ws;
};

__device__ __forceinline__ void cvt_item(const float* W, int ldn, int k0, int n0, bf16* WT, int ldk, int drow0, const float* gain, float scale, LAS float* scr, int lane) {
#pragma unroll 8
    for (int i = 0; i < 32; ++i) { const int kk = 2 * i + (lane >> 5); float v = W[(size_t)(k0 + kk) * ldn + n0 + (lane & 31)];
        const float gg = gain ? gain[k0 + kk] : 1.0f; scr[kk * 33 + (lane & 31)] = v * gg * scale; }
    LDS_WAIT(); asm volatile("" ::: "memory");
    const int c = lane & 7;
#pragma unroll
    for (int j = 0; j < 4; ++j) { const int n = (lane >> 3) + 8 * j; const LAS float* s = scr + (8 * c) * 33 + n;
        v4u o; o.x = pk2(s[0 * 33], s[1 * 33]); o.y = pk2(s[2 * 33], s[3 * 33]); o.z = pk2(s[4 * 33], s[5 * 33]); o.w = pk2(s[6 * 33], s[7 * 33]);
        *(GAS v4u*)(WT + (size_t)(drow0 + n) * ldk + k0 + 8 * c) = o; }
    LDS_WAIT(); asm volatile("" ::: "memory");
}
struct CvtJob { const float* W; int K, N; bf16* WT; const float* gain; int kind; };
__device__ __forceinline__ bool cvt_map(int kind, int n0, int& drow, float& scale) {
    scale = 1.0f;
    switch (kind) {
    case 0: drow = n0; return true;
    case 1: if (n0 < 768) { drow = n0; scale = 0.125f; return true; } if (n0 < 1536) { drow = n0; return true; } if (n0 >= 2304) { drow = n0 - 768; scale = 0.125f; return true; } return false;
    case 2: if (n0 >= 1536 && n0 < 2304) { drow = n0 - 1536; return true; } return false;
    case 3: drow = (n0 >> 7) * 256 + (n0 & 127); return true;
    case 4: drow = (n0 >> 7) * 256 + 128 + (n0 & 127); return true;
    case 5: if (n0 < 768) { drow = n0; return true; } if (n0 < 1536) return false; if (n0 < 2304) { drow = n0 - 768; return true; }
            if (n0 < 2336) { drow = n0 - 512; return true; } drow = n0 - 800; scale = 0.125f; return true;
    case 6: if (n0 >= 768 && n0 < 1536) { drow = n0 - 768; return true; } return false;
    default: drow = n0; return true;
    }
}
__device__ __forceinline__ void cvt_job_item(const CvtJob& J, int item, LAS float* scr, int lane) {
    const int nblk = J.N / 32, kb = item / nblk, nb = item % nblk; int drow; float scale;
    if (!cvt_map(J.kind, nb * 32, drow, scale)) return;
    cvt_item(J.W, J.N, kb * 64, nb * 32, J.WT, J.K, drow, J.gain, scale, scr, lane);
}

__device__ __forceinline__ void row_to_bf16(const float* xrow, bf16* orow, float* rss16, int lane) {
    const GAS f32x4* xr = (const GAS f32x4*)xrow + lane;
    f32x4 v[4]; float s = 0.f;
#pragma unroll
    for (int j = 0; j < 4; ++j) { v[j] = xr[64 * j]; s += (v[j].x * v[j].x + v[j].y * v[j].y) + (v[j].z * v[j].z + v[j].w * v[j].w); }
    s = wave_sum(s);
    GAS unsigned long long* o8 = (GAS unsigned long long*)orow + lane;
#pragma unroll
    for (int j = 0; j < 4; ++j) o8[64 * j] = (unsigned long long)pk2(v[j].x, v[j].y) | ((unsigned long long)pk2(v[j].z, v[j].w) << 32);
    if (lane < 16) rss16[lane] = (lane == 0) ? s : 0.f;
}

struct Unit { int pm, pn; };
struct Sched {
    int nM, nN, nwg, G, c, K;
    const char* A; const char* B; const int* bexp; size_t estride;
    __device__ void init(const void* A_, const void* B_, int K_, int nM_, int nN_, int G_, int c_, const int* bexp_ = nullptr, size_t estride_ = 0) {
        A = (const char*)A_; B = (const char*)B_; K = K_; nM = nM_; nN = nN_; nwg = nM * nN; G = G_; c = c_; bexp = bexp_; estride = estride_; }
    __device__ bool next(int i, Unit& u) const {
        const long L = (long)i * G + c; if (L >= nwg) return false;
        int wgid = (int)L; { const int q = nwg / 8, r = nwg % 8, xcd = wgid % 8, off = wgid / 8; wgid = (xcd < r ? xcd * (q + 1) : r * (q + 1) + (xcd - r) * q) + off; }
        const int nig = 8 * nN, gid = wgid / nig, fm = gid * 8, gsz = (nM - fm) < 8 ? (nM - fm) : 8;
        u.pm = fm + ((wgid % nig) % gsz); u.pn = (wgid % nig) / gsz; return true;
    }
    __device__ const char* a_base(const Unit& u) const { return A + (size_t)u.pm * 512 * K; }
    __device__ const char* b_base(const Unit& u) const { return B + (bexp ? (size_t)bexp[u.pm] * estride : (size_t)0) + (size_t)u.pn * 512 * K; }
};

struct NoCtx {};
struct EpiRowScale {
    static constexpr bool NEED_SS = false; typedef NoCtx Ctx;
    bf16* O; int ldc; const float* rss;
    __device__ __forceinline__ void begin(Ctx&, int, int) const {}
    __device__ __forceinline__ float apply(const Ctx&, int row, int pn, int c128, const float (&a)[8], const float (&b)[8]) const {
        const float s = rstd_from(rss + (size_t)row * 16);
        bf16* p = O + (size_t)row * ldc + pn * 256 + c128;
        v4u w; w.x = pk2(a[0] * s, a[1] * s); w.y = pk2(a[2] * s, a[3] * s); w.z = pk2(a[4] * s, a[5] * s); w.w = pk2(a[6] * s, a[7] * s); *(v4u*)p = w;
        w.x = pk2(b[0] * s, b[1] * s); w.y = pk2(b[2] * s, b[3] * s); w.z = pk2(b[4] * s, b[5] * s); w.w = pk2(b[6] * s, b[7] * s); *(v4u*)(p + 128) = w;
        return 0.f;
    }
    __device__ __forceinline__ void row_done(int, int, int, float) const {}
};
struct ColCtx { float sa[8], sb[8]; };
struct EpiColScale {
    static constexpr bool NEED_SS = false; typedef ColCtx Ctx;
    bf16* O; int ldc; const float* rss;
    __device__ __forceinline__ void begin(Ctx& c, int pn, int c128) const {
        const float* pa = rss + (size_t)(pn * 256 + c128) * 16; const float* pb = pa + 128 * 16;
#pragma unroll
        for (int j = 0; j < 8; ++j) { c.sa[j] = rstd_from(pa + j * 16); c.sb[j] = rstd_from(pb + j * 16); }
    }
    __device__ __forceinline__ float apply(const Ctx& c, int row, int pn, int c128, const float (&a)[8], const float (&b)[8]) const {
        bf16* p = O + (size_t)row * ldc + pn * 256 + c128;
        v4u w; w.x = pk2(a[0] * c.sa[0], a[1] * c.sa[1]); w.y = pk2(a[2] * c.sa[2], a[3] * c.sa[3]); w.z = pk2(a[4] * c.sa[4], a[5] * c.sa[5]); w.w = pk2(a[6] * c.sa[6], a[7] * c.sa[7]); *(v4u*)p = w;
        w.x = pk2(b[0] * c.sb[0], b[1] * c.sb[1]); w.y = pk2(b[2] * c.sb[2], b[3] * c.sb[3]); w.z = pk2(b[4] * c.sb[4], b[5] * c.sb[5]); w.w = pk2(b[6] * c.sb[6], b[7] * c.sb[7]); *(v4u*)(p + 128) = w;
        return 0.f;
    }
    __device__ __forceinline__ void row_done(int, int, int, float) const {}
};
struct EpiResid {
    static constexpr bool NEED_SS = true; typedef NoCtx Ctx;
    __device__ __forceinline__ void begin(Ctx&, int, int) const {}
    const float* R; float* H; bf16* HB; float* rss;
    __device__ __forceinline__ float apply(const Ctx&, int row, int pn, int c128, const float (&a)[8], const float (&b)[8]) const {
        const size_t off = (size_t)row * DM + pn * 256 + c128; float ss = 0.f;
        {   const f32x4 r0 = *(const f32x4*)(R + off), r1 = *(const f32x4*)(R + off + 4);
            const f32x4 h0 = {r0.x + a[0], r0.y + a[1], r0.z + a[2], r0.w + a[3]}, h1 = {r1.x + a[4], r1.y + a[5], r1.z + a[6], r1.w + a[7]};
            *(f32x4*)(H + off) = h0; *(f32x4*)(H + off + 4) = h1;
            v4u w; w.x = pk2(h0.x, h0.y); w.y = pk2(h0.z, h0.w); w.z = pk2(h1.x, h1.y); w.w = pk2(h1.z, h1.w); *(v4u*)(HB + off) = w;
            ss += (h0.x * h0.x + h0.y * h0.y) + (h0.z * h0.z + h0.w * h0.w) + (h1.x * h1.x + h1.y * h1.y) + (h1.z * h1.z + h1.w * h1.w); }
        {   const size_t o2 = off + 128; const f32x4 r0 = *(const f32x4*)(R + o2), r1 = *(const f32x4*)(R + o2 + 4);
            const f32x4 h0 = {r0.x + b[0], r0.y + b[1], r0.z + b[2], r0.w + b[3]}, h1 = {r1.x + b[4], r1.y + b[5], r1.z + b[6], r1.w + b[7]};
            *(f32x4*)(H + o2) = h0; *(f32x4*)(H + o2 + 4) = h1;
            v4u w; w.x = pk2(h0.x, h0.y); w.y = pk2(h0.z, h0.w); w.z = pk2(h1.x, h1.y); w.w = pk2(h1.z, h1.w); *(v4u*)(HB + o2) = w;
            ss += (h0.x * h0.x + h0.y * h0.y) + (h0.z * h0.z + h0.w * h0.w) + (h1.x * h1.x + h1.y * h1.y) + (h1.z * h1.z + h1.w * h1.w); }
        return ss;
    }
    __device__ __forceinline__ void row_done(int row, int pn, int wc, float ss) const { rss[(size_t)row * 16 + pn * 4 + wc] = ss; }
};
__device__ __forceinline__ float silu_mul(float g, float u) { return g / (1.0f + __expf(-g)) * u; }
struct EpiSwiGLU {
    static constexpr bool NEED_SS = false; typedef NoCtx Ctx;
    __device__ __forceinline__ void begin(Ctx&, int, int) const {}
    bf16* Hm; int ldh; const float* rss; const int* tok;
    __device__ __forceinline__ float apply(const Ctx&, int row, int pn, int c128, const float (&a)[8], const float (&b)[8]) const {
        int t = row; if (tok) t = tok[row];
        float o[8];
        if (t >= 0) { const float s = rstd_from(rss + (size_t)t * 16);
#pragma unroll
            for (int j = 0; j < 8; ++j) o[j] = silu_mul(a[j] * s, b[j] * s);
        } else {
#pragma unroll
            for (int j = 0; j < 8; ++j) o[j] = 0.f; }
        v4u w; w.x = pk2(o[0], o[1]); w.y = pk2(o[2], o[3]); w.z = pk2(o[4], o[5]); w.w = pk2(o[6], o[7]);
        *(v4u*)(Hm + (size_t)row * ldh + pn * 128 + c128) = w;
        return 0.f;
    }
    __device__ __forceinline__ void row_done(int, int, int, float) const {}
};
struct EpiMoeDown {
    static constexpr bool NEED_SS = false; typedef NoCtx Ctx;
    __device__ __forceinline__ void begin(Ctx&, int, int) const {}
    float* H; const int* tok; const float* w;
    __device__ __forceinline__ float apply(const Ctx&, int row, int pn, int c128, const float (&a)[8], const float (&b)[8]) const {
        const int t = tok[row]; if (t < 0) return 0.f;
        const float s = w[row]; float* p = H + (size_t)t * DM + pn * 256 + c128;
        f32x4 h0 = *(f32x4*)p, h1 = *(f32x4*)(p + 4), h2 = *(f32x4*)(p + 128), h3 = *(f32x4*)(p + 132);
        h0.x += s * a[0]; h0.y += s * a[1]; h0.z += s * a[2]; h0.w += s * a[3]; h1.x += s * a[4]; h1.y += s * a[5]; h1.z += s * a[6]; h1.w += s * a[7];
        h2.x += s * b[0]; h2.y += s * b[1]; h2.z += s * b[2]; h2.w += s * b[3]; h3.x += s * b[4]; h3.y += s * b[5]; h3.z += s * b[6]; h3.w += s * b[7];
        *(f32x4*)p = h0; *(f32x4*)(p + 4) = h1; *(f32x4*)(p + 128) = h2; *(f32x4*)(p + 132) = h3;
        return 0.f;
    }
    __device__ __forceinline__ void row_done(int, int, int, float) const {}
};

template <class Epi, bool GATHER>
__device__ __forceinline__ void gemm_simple(LAS unsigned char* lds, const Sched& S, const Epi& E, const int* gtok) {
    LAS float* As = (LAS float*)lds;
    LAS float* Bs = (LAS float*)(lds + 16384);
    const int tid = threadIdx.x, wc = tid & 3, rr = tid >> 2, K = S.K;
    Unit u;
    for (int i = 0; S.next(i, u); ++i) {
        const char* bb = S.b_base(u);
        for (int h = 0; h < 2; ++h) {
            const int rowbase = u.pm * 256 + h * 128;
            const bf16* arow; { int r = rowbase + (tid >> 2); if (GATHER) { int t = gtok[r]; if (t < 0) t = 0; arow = (const bf16*)S.A + (size_t)t * K; } else arow = (const bf16*)S.A + (size_t)r * K; }
            const bf16* brow = (const bf16*)bb + (size_t)(tid >> 1) * K;
            float ca[32], cb[32];
#pragma unroll
            for (int j = 0; j < 32; ++j) { ca[j] = 0.f; cb[j] = 0.f; }
            for (int k0 = 0; k0 < K; k0 += 16) {
                const v2u av = *(const v2u*)(arow + k0 + (tid & 3) * 4);
                const v4u bv = *(const v4u*)(brow + k0 + (tid & 1) * 8);
                __syncthreads();
                { LAS float* d = As + (tid >> 2) * 17 + (tid & 3) * 4; d[0] = bflo(av.x); d[1] = bfhi(av.x); d[2] = bflo(av.y); d[3] = bfhi(av.y); }
                { const int kb = (tid & 1) * 8, n = tid >> 1; LAS float* d = Bs + n;
                  d[(kb + 0) * 260] = bflo(bv.x); d[(kb + 1) * 260] = bfhi(bv.x); d[(kb + 2) * 260] = bflo(bv.y); d[(kb + 3) * 260] = bfhi(bv.y);
                  d[(kb + 4) * 260] = bflo(bv.z); d[(kb + 5) * 260] = bfhi(bv.z); d[(kb + 6) * 260] = bflo(bv.w); d[(kb + 7) * 260] = bfhi(bv.w); }
                __syncthreads();
#pragma unroll 4
                for (int k = 0; k < 16; ++k) {
                    const float a = As[rr * 17 + k];
                    const LAS f32x4* b0 = (const LAS f32x4*)(Bs + k * 260 + 32 * wc);
                    const LAS f32x4* b1 = (const LAS f32x4*)(Bs + k * 260 + 128 + 32 * wc);
#pragma unroll
                    for (int j = 0; j < 8; ++j) { const f32x4 x = b0[j], y = b1[j];
                        ca[4 * j] += a * x.x; ca[4 * j + 1] += a * x.y; ca[4 * j + 2] += a * x.z; ca[4 * j + 3] += a * x.w;
                        cb[4 * j] += a * y.x; cb[4 * j + 1] += a * y.y; cb[4 * j + 2] += a * y.z; cb[4 * j + 3] += a * y.w; }
                }
            }
            const int row = rowbase + rr; float ss = 0.f;
#pragma unroll
            for (int g = 0; g < 4; ++g) { float a8[8], b8[8];
#pragma unroll
                for (int j = 0; j < 8; ++j) { a8[j] = ca[8 * g + j]; b8[j] = cb[8 * g + j]; }
                typename Epi::Ctx ctx; E.begin(ctx, u.pn, 32 * wc + 8 * g); ss += E.apply(ctx, row, u.pn, 32 * wc + 8 * g, a8, b8); asm volatile("" ::: "memory"); }
            if (Epi::NEED_SS) E.row_done(row, u.pn, wc, ss);
        }
    }
    __syncthreads();
}

namespace pg8 {
constexpr int HTB = 16384, TOK_OFF = 132096;
__device__ __forceinline__ int lds_byte(int r, int c) { const int st = (r >> 4) * 2 + (c >> 5), rr = r & 15, cc = c & 31, ob = rr * 64 + cc * 2; return st * 1024 + (ob ^ (((ob >> 9) & 1) << 5)); }
__device__ __forceinline__ void stage_rc(int b, int& R, int& C) { const int st = b / 1024, sb = b % 1024, swz = sb ^ (((sb >> 9) & 1) << 5); R = (st >> 1) * 16 + swz / 64; C = (st & 1) * 32 + (swz % 64) / 2; }
__device__ __forceinline__ int perm32(int rho) { const int n = rho >> 4, i = rho & 15; return 8 * (i >> 2) + 4 * n + (i & 3); }

template <class Epi>
__device__ __forceinline__ void run_epi(const Epi& E, const f32x4 (&acc)[2][2][4][2], const Unit& u, int wr, int wc, int fr, int fq) {
    typename Epi::Ctx ctx; E.begin(ctx, u.pn, 32 * wc + 8 * fq);
#pragma unroll
    for (int ai = 0; ai < 2; ++ai)
#pragma unroll
        for (int m = 0; m < 4; ++m) {
            const int row = u.pm * 256 + ai * 128 + wr * 64 + m * 16 + fr;
            float a[8], b[8];
#pragma unroll
            for (int j = 0; j < 8; ++j) { a[j] = acc[ai][0][m][j >> 2][j & 3]; b[j] = acc[ai][1][m][j >> 2][j & 3]; }
            float ss = E.apply(ctx, row, u.pn, 32 * wc + 8 * fq, a, b);
            if (Epi::NEED_SS) { ss += __shfl_xor(ss, 16); ss += __shfl_xor(ss, 32); if (fq == 0) E.row_done(row, u.pn, wc, ss); }
        }
}

template <class Epi, bool GATHER>
__device__ __forceinline__ void gemm_fast(LAS unsigned char* lds, const Sched& S, const Epi& E, const int* gtok) {
    const int tid = threadIdx.x, wid = __builtin_amdgcn_readfirstlane(tid >> 6), lane = tid & 63, wr = wid >> 2, wc = wid & 3, fr = lane & 15, fq = lane >> 4;
    const int K = S.K, nt = K / 64;
    unsigned voffB[2], vA0[2], vA1[2], nA0[2], nA1[2]; int RA[2], CA2[2];
#pragma unroll
    for (int i = 0; i < 2; ++i) { int R, C; stage_rc(tid * 16 + i * 8192, R, C); const int Rb = (R & ~31) + perm32(R & 31);
        voffB[i] = (unsigned)(Rb * K + C) * 2u; RA[i] = R; CA2[i] = C * 2; vA0[i] = (unsigned)(R * K + C) * 2u; vA1[i] = vA0[i] + (unsigned)(128 * K * 2); nA0[i] = vA0[i]; nA1[i] = vA1[i]; }
    const size_t kstep = 128;
    const size_t hstep = (size_t)128 * K * 2;
    const unsigned ldsw = (unsigned)wid * 1024u;
    const int aoff = lds_byte(wr * 64 + fr, fq * 8), boff = lds_byte(wc * 32 + fr, fq * 8);
    LAS int* tl = (LAS int*)(lds + TOK_OFF);
#define PG8_SA(b, h) (((b) * 2 + (h)) * HTB)
#define PG8_SB(b, h) ((4 + (b) * 2 + (h)) * HTB)
#define PG8_STAGE(bufoff, gbase, voff) do { _Pragma("unroll") for (int _i = 0; _i < 2; ++_i) \
        __builtin_amdgcn_global_load_lds((const unsigned*)((const char*)(gbase) + (voff)[_i]), (LAS unsigned*)(lds + (bufoff) + ldsw + _i * 8192), 16, 0, 0); } while (0)
#define PG8_LDA(dst, b, h) do { _Pragma("unroll") for (int m = 0; m < 4; ++m) _Pragma("unroll") for (int k = 0; k < 2; ++k) dst[m][k] = *(const LAS bf16x8*)(lds + PG8_SA(b, h) + aoff + m * 2048 + k * 1024); } while (0)
#define PG8_LDB(dst, b, h) do { _Pragma("unroll") for (int n = 0; n < 2; ++n) _Pragma("unroll") for (int k = 0; k < 2; ++k) dst[n][k] = *(const LAS bf16x8*)(lds + PG8_SB(b, h) + boff + n * 2048 + k * 1024); } while (0)
#define PG8_MMA(ai, bj, At, Bt) do { __builtin_amdgcn_s_setprio(1); _Pragma("unroll") for (int m = 0; m < 4; ++m) _Pragma("unroll") for (int n = 0; n < 2; ++n) _Pragma("unroll") for (int k = 0; k < 2; ++k) \
        acc[ai][bj][m][n] = __builtin_amdgcn_mfma_f32_16x16x32_bf16(Bt[n][k], At[m][k], acc[ai][bj][m][n], 0, 0, 0); __builtin_amdgcn_s_setprio(0); } while (0)
#define PG8_WAIT_V(n) asm volatile("s_waitcnt vmcnt(" #n ")" ::: "memory")
#define PG8_WAIT_L(n) asm volatile("s_waitcnt lgkmcnt(" #n ")" ::: "memory")
#define PG8_BAR __builtin_amdgcn_s_barrier()
#define PG8_SCHED __builtin_amdgcn_sched_barrier(0)
#define PG8_IDS_DMA(pm_, par_) do { if (wid < 4) __builtin_amdgcn_global_load_lds((const unsigned*)(gtok + (pm_) * 256 + wid * 64 + lane), (LAS unsigned*)(lds + TOK_OFF + (par_) * 1024 + wid * 256), 4, 0, 0); } while (0)
#define PG8_IDS_READ(d0, d1, par_) do { _Pragma("unroll") for (int _i = 0; _i < 2; ++_i) { int t0 = tl[(par_) * 256 + RA[_i]], t1 = tl[(par_) * 256 + 128 + RA[_i]]; t0 = t0 < 0 ? 0 : t0; t1 = t1 < 0 ? 0 : t1; \
        d0[_i] = (unsigned)t0 * (unsigned)(K * 2) + (unsigned)CA2[_i]; d1[_i] = (unsigned)t1 * (unsigned)(K * 2) + (unsigned)CA2[_i]; } } while (0)
    Unit cur, nxt; int ui = 0, par = 0;
    if (!S.next(0, cur)) return;
    f32x4 acc[2][2][4][2];
#pragma unroll
    for (int a = 0; a < 2; ++a)
#pragma unroll
        for (int b = 0; b < 2; ++b)
#pragma unroll
            for (int m = 0; m < 4; ++m)
#pragma unroll
                for (int n = 0; n < 2; ++n) acc[a][b][m][n] = (f32x4){0.f, 0.f, 0.f, 0.f};
    bf16x8 At[4][2], B0[2][2], B1[2][2];
    const char* cA = GATHER ? S.A : S.a_base(cur); const char* cB = S.b_base(cur);
    if constexpr (GATHER) { PG8_IDS_DMA(cur.pm, 0); PG8_WAIT_V(0); __syncthreads(); PG8_IDS_READ(vA0, vA1, 0); }
    PG8_STAGE(PG8_SB(0, 0), cB, voffB); PG8_STAGE(PG8_SB(0, 1), cB + hstep, voffB); PG8_STAGE(PG8_SA(0, 0), cA, vA0); PG8_STAGE(PG8_SA(0, 1), cA, vA1);
    if (wr == 1) PG8_BAR;
    PG8_WAIT_V(2); PG8_BAR;
    PG8_STAGE(PG8_SB(1, 0), cB + kstep, voffB); PG8_STAGE(PG8_SA(1, 0), cA + kstep, vA0); PG8_STAGE(PG8_SB(1, 1), cB + hstep + kstep, voffB);
    PG8_WAIT_V(6); PG8_BAR;
    for (;;) {
        const bool has_next = S.next(ui + 1, nxt);
        const char* nA = has_next ? (GATHER ? S.A : S.a_base(nxt)) : cA; const char* nB = has_next ? S.b_base(nxt) : cB;
        for (int t = 0; t < nt; t += 2) {
            const bool last = (t == nt - 2);
            if constexpr (GATHER) {
                if (t == nt - 4 && has_next) PG8_IDS_DMA(nxt.pm, par ^ 1);
                if (last) { if (has_next) PG8_IDS_READ(nA0, nA1, par ^ 1); else { nA0[0] = vA0[0]; nA0[1] = vA0[1]; nA1[0] = vA1[0]; nA1[1] = vA1[1]; } }
            }
            const char* a1 = cA + (size_t)(t + 1) * kstep;
            const char* a2 = last ? nA : cA + (size_t)(t + 2) * kstep; const char* b2 = last ? nB : cB + (size_t)(t + 2) * kstep;
            const char* a3 = a2 + kstep; const char* b3 = b2 + kstep;
            unsigned w0[2], w1[2];
            if (GATHER && last) { w0[0] = nA0[0]; w0[1] = nA0[1]; w1[0] = nA1[0]; w1[1] = nA1[1]; } else { w0[0] = vA0[0]; w0[1] = vA0[1]; w1[0] = vA1[0]; w1[1] = vA1[1]; }
            PG8_LDB(B0, 0, 0); PG8_LDB(B1, 0, 1); PG8_SCHED; PG8_LDA(At, 0, 0); PG8_STAGE(PG8_SA(1, 1), a1, vA1);
            PG8_WAIT_V(8); PG8_WAIT_L(0); PG8_BAR; PG8_MMA(0, 0, At, B0); PG8_MMA(0, 1, At, B1); PG8_BAR; PG8_SCHED;
            PG8_LDA(At, 0, 1); PG8_STAGE(PG8_SB(0, 0), b2, voffB); PG8_STAGE(PG8_SB(0, 1), b2 + hstep, voffB); PG8_STAGE(PG8_SA(0, 0), a2, w0);
            PG8_WAIT_V(8); PG8_WAIT_L(0); PG8_BAR; PG8_MMA(1, 0, At, B0); PG8_MMA(1, 1, At, B1); PG8_BAR; PG8_SCHED;
            PG8_LDB(B0, 1, 0); PG8_LDB(B1, 1, 1); PG8_SCHED; PG8_LDA(At, 1, 0); PG8_STAGE(PG8_SA(0, 1), a2, w1);
            PG8_WAIT_V(8); PG8_WAIT_L(0); PG8_BAR; PG8_MMA(0, 0, At, B0); PG8_MMA(0, 1, At, B1); PG8_BAR; PG8_SCHED;
            PG8_LDA(At, 1, 1); PG8_STAGE(PG8_SB(1, 0), b3, voffB); PG8_STAGE(PG8_SB(1, 1), b3 + hstep, voffB); PG8_STAGE(PG8_SA(1, 0), a3, w0);
            PG8_WAIT_V(8); PG8_WAIT_L(0); PG8_BAR; PG8_MMA(1, 0, At, B0); PG8_MMA(1, 1, At, B1); PG8_BAR; PG8_SCHED;
        }
        if (wr == 0) PG8_BAR;
        run_epi(E, acc, cur, wr, wc, fr, fq);
        if (!has_next) break;
#pragma unroll
        for (int a = 0; a < 2; ++a)
#pragma unroll
            for (int b = 0; b < 2; ++b)
#pragma unroll
                for (int m = 0; m < 4; ++m)
#pragma unroll
                    for (int n = 0; n < 2; ++n) acc[a][b][m][n] = (f32x4){0.f, 0.f, 0.f, 0.f};
        cur = nxt; cA = nA; cB = nB; ++ui;
        if constexpr (GATHER) { vA0[0] = nA0[0]; vA0[1] = nA0[1]; vA1[0] = nA1[0]; vA1[1] = nA1[1]; par ^= 1; }
        if (wr == 1) PG8_BAR;
    }
    PG8_WAIT_V(0);
    PG8_BAR;
#undef PG8_SA
#undef PG8_SB
#undef PG8_STAGE
#undef PG8_LDA
#undef PG8_LDB
#undef PG8_MMA
#undef PG8_WAIT_V
#undef PG8_WAIT_L
#undef PG8_BAR
#undef PG8_SCHED
#undef PG8_IDS_DMA
#undef PG8_IDS_READ
}
}

template <class Epi, bool GATHER>
__device__ __forceinline__ void gemm_run(LAS unsigned char* lds, const Sched& S, const Epi& E, const int* gtok) {
#if FAST_GEMM
    pg8::gemm_fast<Epi, GATHER>(lds, S, E, gtok);
#else
    gemm_simple<Epi, GATHER>(lds, S, E, gtok);
#endif
}

__device__ __forceinline__ void na_simple(const Frame& F, const bf16* act0, const bf16* v0t, const float* rpb, bf16* mix) {
    for (int it = F.gw; it < NT * 12; it += F.NGW) {
        const int token = it / 12, h = it % 12, lane = F.lane;
        const int b = token >> 12, p = token & 4095, r = p >> 6, c = p & 63;
        const int r0 = min(max(r - 4, 0), 56), cs = min(max(c - 8, 0), 48);
        const float q = bf2f(act0[(size_t)token * A0_LD + h * 64 + lane]);
        float m = -INFINITY, l = 0.f, o = 0.f;
        for (int a = 0; a < 8; ++a)
            for (int u = 0; u < 16; ++u) {
                const int kt = b * SEQ + (r0 + a) * 64 + cs + u;
                const float kv = bf2f(act0[(size_t)kt * A0_LD + 768 + h * 64 + lane]);
                const float sc = wave_sum(q * kv) + rpb[h * 465 + (r0 + a - r + 7) * 31 + (cs + u - c + 15)];
                const float mn = fmaxf(m, sc), corr = __expf(m - mn), pe = __expf(sc - mn);
                const float vv = bf2f(v0t[(size_t)(h * 64 + lane) * NT + kt]);
                l = l * corr + pe; o = o * corr + pe * vv; m = mn;
            }
        mix[(size_t)token * DM + h * 64 + lane] = (bf16)f2bf(o / l);
    }
}
__device__ __forceinline__ void memattn_simple(const Frame& F, int first, int stride, const bf16* act, int ld, int qoff, const bf16* memk, const bf16* memvt, bf16* mix) {
    for (int it = first; it < NT * 4; it += stride) {
        const int token = it >> 2, h = it & 3, lane = F.lane, b = token >> 12;
        const float q = bf2f(act[(size_t)token * ld + qoff + h * 64 + lane]);
        float m = -INFINITY, l = 0.f, o = 0.f;
        for (int j = 0; j < 256; ++j) {
            const float kv = bf2f(memk[(size_t)(b * 256 + j) * 256 + h * 64 + lane]);
            const float sc = wave_sum(q * kv);
            const float mn = fmaxf(m, sc), corr = __expf(m - mn), pe = __expf(sc - mn);
            const float vv = bf2f(memvt[(size_t)(h * 64 + lane) * MEM_ROWS + b * 256 + j]);
            l = l * corr + pe; o = o * corr + pe * vv; m = mn;
        }
        mix[(size_t)token * DM + 768 + h * 64 + lane] = (bf16)f2bf(o / l);
    }
}

__device__ __forceinline__ float logsigmoid(float x) { return fminf(x, 0.f) - log1pf(__expf(-fabsf(x))); }
__device__ __forceinline__ void gla_simple(const Frame& F, int item, const bf16* act1, const bf16* v1t, const float* wgk, const float* bgk, bf16* O) {
    const int b = item >> 3, h = (item >> 1) & 3, dir = item & 1, tid = F.tid;
    LAS float* sh = (LAS float*)F.lds;
    float S[96];
#pragma unroll
    for (int d = 0; d < 96; ++d) S[d] = 0.f;
    float wcol[16], bias = 0.f;
    if (tid < 96) {
#pragma unroll
        for (int r = 0; r < 16; ++r) wcol[r] = wgk[r * 384 + h * 96 + tid];
        bias = bgk[h * 96 + tid];
    }
    for (int tau = 0; tau < SEQ; ++tau) {
        const int token = b * SEQ + (dir ? (SEQ - 1 - tau) : tau);
        LAS float* cur = sh + (tau & 1) * 288;
        if (tid < 96) {
            const bf16* row = act1 + (size_t)token * A1_LD;
            float z = bias;
#pragma unroll
            for (int r = 0; r < 16; ++r) z += bf2f(row[1792 + dir * 16 + r]) * wcol[r];
            cur[tid] = __expf(logsigmoid(z) * (1.0f / 16.0f));
            cur[96 + tid] = bf2f(row[h * 96 + tid]) * 0.10206207261596575f;
            cur[192 + tid] = bf2f(row[384 + h * 96 + tid]);
        }
        __syncthreads();
        if (tid < 192) {
            const float v = bf2f(v1t[(size_t)(h * 192 + tid) * NT + token]);
            float o = 0.f;
            if (dir == 0) {
#pragma unroll
                for (int d = 0; d < 96; ++d) { S[d] = cur[d] * S[d] + cur[192 + d] * v; o += cur[96 + d] * S[d]; }
            } else {
#pragma unroll
                for (int d = 0; d < 96; ++d) { S[d] = cur[d] * S[d]; o += cur[96 + d] * S[d]; S[d] += cur[192 + d] * v; }
            }
            O[(size_t)token * 768 + h * 192 + tid] = (bf16)f2bf(o);
        }
    }
    __syncthreads();
}

__device__ __forceinline__ void gla_combine(const Frame& F, const bf16* OF, const bf16* OB, const bf16* act1, const float* gnorm, bf16* mix) {
    for (int token = F.gw; token < NT; token += F.NGW) {
        const int lane = F.lane;
#pragma unroll
        for (int h = 0; h < 4; ++h) {
            float o[3]; float ss = 0.f;
#pragma unroll
            for (int j = 0; j < 3; ++j) { const size_t idx = (size_t)token * 768 + h * 192 + j * 64 + lane; o[j] = bf2f(OF[idx]) + bf2f(OB[idx]); ss += o[j] * o[j]; }
            ss = wave_sum(ss);
            const float rs = 1.0f / sqrtf(ss * (1.0f / 192.0f) + EPS);
#pragma unroll
            for (int j = 0; j < 3; ++j) { const int dv = j * 64 + lane; const float g = bf2f(act1[(size_t)token * A1_LD + 768 + h * 192 + dv]);
                const float val = o[j] * rs * gnorm[dv] * (g / (1.0f + __expf(-g)));
                mix[(size_t)token * DM + h * 192 + dv] = (bf16)f2bf(val); }
        }
    }
}
__device__ __forceinline__ void route1(const Frame& F, const float* H, const float* gain, const float* wr, int* topi, float* topw, int* cnt) {
    LAS int* lc = (LAS int*)F.lds;
    if (F.tid < 16) lc[F.tid] = 0;
    __syncthreads();
    for (int j = 0; j < 16; ++j) {
        const int token = F.bid * 128 + F.wave * 16 + j, lane = F.lane;
        const float* hr = H + (size_t)token * DM;
        float acc[8], ss = 0.f;
#pragma unroll
        for (int e = 0; e < 8; ++e) acc[e] = 0.f;
#pragma unroll 4
        for (int i = 0; i < 16; ++i) { const int k = i * 64 + lane; const float x = hr[k]; ss += x * x; const float xg = x * gain[k];
            const f32x4 w0 = *(const f32x4*)(wr + k * 8), w1 = *(const f32x4*)(wr + k * 8 + 4);
            acc[0] += xg * w0.x; acc[1] += xg * w0.y; acc[2] += xg * w0.z; acc[3] += xg * w0.w; acc[4] += xg * w1.x; acc[5] += xg * w1.y; acc[6] += xg * w1.z; acc[7] += xg * w1.w; }
        ss = wave_sum(ss); const float rs = 1.0f / sqrtf(ss * (1.0f / DM) + EPS);
#pragma unroll
        for (int e = 0; e < 8; ++e) acc[e] = wave_sum(acc[e]) * rs;
        if (lane == 0) {
            int e0 = 0; float l0 = acc[0];
#pragma unroll
            for (int e = 1; e < 8; ++e) if (acc[e] > l0) { l0 = acc[e]; e0 = e; }
            int e1 = -1; float l1 = -INFINITY;
#pragma unroll
            for (int e = 0; e < 8; ++e) if (e != e0 && acc[e] > l1) { l1 = acc[e]; e1 = e; }
            const float w0 = 1.0f / (1.0f + __expf(l1 - l0));
            topi[token] = e0 | (e1 << 8); topw[2 * token] = w0; topw[2 * token + 1] = 1.0f - w0;
            atomicAdd((int*)&lc[e0], 1); atomicAdd((int*)&lc[8 + e1], 1);
        }
    }
    __syncthreads();
    if (F.tid < 16) cnt[F.bid * 16 + F.tid] = lc[F.tid];
    __syncthreads();
}
__device__ __forceinline__ void route2(const Frame& F, const int* topi, const float* topw, const int* cnt, int* stok, float* sw, int* blk) {
    LAS int* part = (LAS int*)F.lds;
    LAS int* base = part + 1024;
    LAS int* tk = base + 64;
    const int tid = F.tid, pe = tid & 15, jg = tid >> 4;
    int below = 0, tot = 0;
    for (int w = jg; w < F.G; w += 32) { const int v = cnt[w * 16 + pe]; tot += v; if (w < F.bid) below += v; }
    part[jg * 16 + pe] = below; part[512 + jg * 16 + pe] = tot;
    if (tid < 128) tk[tid] = topi[F.bid * 128 + tid];
    __syncthreads();
    if (tid < 16) { int b = 0, t = 0; for (int j = 0; j < 32; ++j) { b += part[j * 16 + tid]; t += part[512 + j * 16 + tid]; } base[tid] = b; base[16 + tid] = t; }
    __syncthreads();
    if (tid < 2) { int ps = 0; for (int e = 0; e < 8; ++e) { base[32 + tid * 8 + e] = ps; ps += (base[16 + tid * 8 + e] + 255) / 256 * 256; } base[48 + tid] = ps / 256; }
    __syncthreads();
    if (tid < 256) {
        const int p = tid >> 7, i = tid & 127; const int e = (tk[i] >> (8 * p)) & 0xff;
        int rank = 0; for (int j = 0; j < i; ++j) rank += (((tk[j] >> (8 * p)) & 0xff) == e) ? 1 : 0;
        const int slot = base[32 + p * 8 + e] + base[p * 8 + e] + rank; const int token = F.bid * 128 + i;
        stok[p * SLOT_CAP + slot] = token; sw[p * SLOT_CAP + slot] = topw[2 * token + p];
    }
    if (F.bid < 16) {
        const int p = F.bid >> 3, e = F.bid & 7, ps = base[32 + F.bid], t = base[16 + F.bid], pend = ps + (t + 255) / 256 * 256;
        for (int s = ps + t + tid; s < pend; s += NTHR) { stok[p * SLOT_CAP + s] = -1; sw[p * SLOT_CAP + s] = 0.f; }
        for (int bk = ps / 256 + tid; bk < pend / 256; bk += NTHR) blk[16 + p * 256 + bk] = e;
        if (e == 0 && tid == 0) blk[p] = base[48 + p];
    }
    __syncthreads();
}
__device__ __forceinline__ void final_norm(const Frame& F, float* H, const float* gain) {
    for (int row = F.gw; row < NT; row += F.NGW) {
        GAS f32x4* xr = (GAS f32x4*)(H + (size_t)row * DM) + F.lane; const f32x4* gr = (const f32x4*)gain + F.lane;
        f32x4 v[4]; float s = 0.f;
#pragma unroll
        for (int j = 0; j < 4; ++j) { v[j] = xr[64 * j]; s += (v[j].x * v[j].x + v[j].y * v[j].y) + (v[j].z * v[j].z + v[j].w * v[j].w); }
        s = wave_sum(s); const float rs = 1.0f / sqrtf(s * (1.0f / DM) + EPS);
#pragma unroll
        for (int j = 0; j < 4; ++j) { const f32x4 g = gr[64 * j]; f32x4 o = {v[j].x * rs * g.x, v[j].y * rs * g.y, v[j].z * rs * g.z, v[j].w * rs * g.w}; xr[64 * j] = o; }
    }
}

constexpr int N_PHASES = 17;
__global__ void __launch_bounds__(NTHR, 2) mega(Args args) {
    extern __shared__ __attribute__((aligned(16))) unsigned char lds_raw[];
    Frame F;
    F.lds = (LAS unsigned char*)lds_raw;
    F.tid = threadIdx.x; F.lane = F.tid & 63; F.wave = __builtin_amdgcn_readfirstlane(F.tid >> 6);
    F.G = gridDim.x; F.bid = blockIdx.x; F.gw = F.bid * NWAVES + F.wave; F.NGW = F.G * NWAVES; F.ws = args.ws;
    unsigned char* ws = args.ws;
    gu32* ctl = (gu32*)(ws + WS_CTL);
    volatile LAS unsigned* MISC = (volatile LAS unsigned*)(F.lds + MISC_OFF);
    for (int u = F.tid; u < (LDS_BYTES - LDSCTL_OFF) / 4; u += NTHR) ((LAS unsigned*)(F.lds + LDSCTL_OFF))[u] = 0u;
    __syncthreads();
    XcdBarrier bar = xcd_barrier_post((unsigned*)(ctl + CW_BAR), MISC + 8);
    const int lo = args.ph_lo, hi = args.ph_hi;
#ifndef PH_MASK
#define PH_MASK 0x1ffff
#endif
#define IN(k) (((PH_MASK >> (k)) & 1) && lo <= (k) && (k) < hi)
#define SEAM(k) do { if (IN(k) && IN((k) + 1)) xcd_barrier(bar); } while (0)

    float* H = args.out;
    float* rss = (float*)(ws + WS_RSS); float* mrss = (float*)(ws + WS_MRSS);
    bf16* hbf = (bf16*)(ws + WS_HBF); bf16* membf = (bf16*)(ws + WS_MEMBF); bf16* memk = (bf16*)(ws + WS_MEMK); bf16* memvt = (bf16*)(ws + WS_MEMVT);
    bf16* act0 = (bf16*)(ws + WS_ACT0); bf16* v0t = (bf16*)(ws + WS_V0T); bf16* mix = (bf16*)(ws + WS_MIX); bf16* hmid0 = (bf16*)(ws + WS_HMID0);
    bf16* act1 = (bf16*)(ws + WS_ACT1); bf16* v1t = (bf16*)(ws + WS_V1T); bf16* OF = (bf16*)(ws + WS_OF); bf16* OB = (bf16*)(ws + WS_OB);
    bf16* hmid1 = (bf16*)(ws + WS_HMID1); bf16* wgu = (bf16*)(ws + WS_WGU); bf16* wdn = (bf16*)(ws + WS_WDN);
    int* cnt = (int*)(ws + WS_CNT); int* topi = (int*)(ws + WS_TOPI); float* topw = (float*)(ws + WS_TOPW);
    int* stok = (int*)(ws + WS_STOK); float* sw = (float*)(ws + WS_SW); int* blk = (int*)(ws + WS_BLK);
    LAS float* scr = (LAS float*)(F.lds + F.wave * 16384);

    if (IN(0)) {
        int it = F.gw;
#define CVT(Wp, Kd, Nd, WTp, gainp, kind) do { const CvtJob J{Wp, Kd, Nd, (bf16*)(WTp), gainp, kind}; const int n_ = ((Kd) / 64) * ((Nd) / 32); \
            for (; it < n_; it += F.NGW) cvt_job_item(J, it, scr, F.lane); it -= n_; } while (0)
        CVT(args.in[I_EWIN], 1024, 2560, ws + WS_W0IN, args.in[I_EN1], 1);
        CVT(args.in[I_EWIN], 1024, 2560, ws + WS_WV0, args.in[I_EN1], 2);
        CVT(args.in[I_EWOUT], 1024, 1024, ws + WS_W0OUT, nullptr, 0);
        CVT(args.in[I_EWG], 1024, 2816, ws + WS_W0GU, args.in[I_EN2], 3);
        CVT(args.in[I_EWU], 1024, 2816, ws + WS_W0GU, args.in[I_EN2], 4);
        CVT(args.in[I_EWD], 2816, 1024, ws + WS_W0DN, nullptr, 0);
        CVT(args.in[I_WMKV], 1024, 512, ws + WS_WMEM, args.in[I_MNORM], 0);
        CVT(args.in[I_OWIN], 1024, 2592, ws + WS_W1IN, args.in[I_ON1], 5);
        CVT(args.in[I_OWIN], 1024, 2592, ws + WS_WV1, args.in[I_ON1], 6);
        CVT(args.in[I_OWOUT], 1024, 1024, ws + WS_W1OUT, nullptr, 0);
#undef CVT
        { v4u z = {0u, 0u, 0u, 0u}; v4u* p = (v4u*)(ws + WS_W1IN + (size_t)1824 * 2048); const int n16 = 224 * 2048 / 16;
          for (int i = F.bid * NTHR + F.tid; i < n16; i += F.G * NTHR) p[i] = z; }
        for (int m = F.gw; m < NT; m += F.NGW) row_to_bf16(args.in[I_X] + (size_t)m * DM, hbf + (size_t)m * DM, rss + (size_t)m * 16, F.lane);
        for (int m = F.gw; m < MEM_ROWS; m += F.NGW) row_to_bf16(args.in[I_MEM] + (size_t)m * DM, membf + (size_t)m * DM, mrss + (size_t)m * 16, F.lane);
    }
    SEAM(0);
    if (IN(1)) {
        { Sched S; S.init(hbf, ws + WS_W0IN, 1024, 128, 7, F.G, F.bid); EpiRowScale E{act0, A0_LD, rss}; gemm_run<EpiRowScale, false>(F.lds, S, E, nullptr); }
        { Sched S; S.init(ws + WS_WV0, hbf, 1024, 3, 128, F.G, (F.bid + 128) % F.G); EpiColScale E{v0t, NT, rss}; gemm_run<EpiColScale, false>(F.lds, S, E, nullptr); }
        { Sched S; S.init(membf, ws + WS_WMEM, 1024, 8, 1, F.G, F.bid); EpiRowScale E{memk, 256, mrss}; gemm_run<EpiRowScale, false>(F.lds, S, E, nullptr); }
        { Sched S; S.init(ws + WS_WMEM + 256 * 2048, membf, 1024, 1, 8, F.G, (F.bid + 248) % F.G); EpiColScale E{memvt, MEM_ROWS, mrss}; gemm_run<EpiColScale, false>(F.lds, S, E, nullptr); }
    }
    SEAM(1);
    if (IN(2)) {
        na_simple(F, act0, v0t, args.in[I_RPB], mix);
        memattn_simple(F, F.gw, F.NGW, act0, A0_LD, 1536, memk, memvt, mix);
    }
    SEAM(2);
    if (IN(3)) { Sched S; S.init(mix, ws + WS_W0OUT, 1024, 128, 4, F.G, F.bid); EpiResid E{args.in[I_X], H, hbf, rss}; gemm_run<EpiResid, false>(F.lds, S, E, nullptr); }
    SEAM(3);
    if (IN(4)) { Sched S; S.init(hbf, ws + WS_W0GU, 1024, 128, 22, F.G, F.bid); EpiSwiGLU E{hmid0, FF0, rss, nullptr}; gemm_run<EpiSwiGLU, false>(F.lds, S, E, nullptr); }
    SEAM(4);
    if (IN(5)) { Sched S; S.init(hmid0, ws + WS_W0DN, FF0, 128, 4, F.G, F.bid); EpiResid E{H, H, hbf, rss}; gemm_run<EpiResid, false>(F.lds, S, E, nullptr); }
    SEAM(5);
    if (IN(6)) {
        { Sched S; S.init(hbf, ws + WS_W1IN, 1024, 128, 8, F.G, F.bid); EpiRowScale E{act1, A1_LD, rss}; gemm_run<EpiRowScale, false>(F.lds, S, E, nullptr); }
        { Sched S; S.init(ws + WS_WV1, hbf, 1024, 3, 128, F.G, F.bid); EpiColScale E{v1t, NT, rss}; gemm_run<EpiColScale, false>(F.lds, S, E, nullptr); }
    }
    SEAM(6);
    if (IN(7)) {
        if (F.bid < 64) {
            const int dir = F.bid & 1;
            gla_simple(F, F.bid, act1, v1t, dir ? args.in[I_WGKB] : args.in[I_WGKF], dir ? args.in[I_BGKB] : args.in[I_BGKF], dir ? OB : OF);
        } else {
            memattn_simple(F, (F.bid - 64) * NWAVES + F.wave, (F.G - 64) * NWAVES, act1, A1_LD, 1536, memk, memvt, mix);
        }
    }
    SEAM(7);
    if (IN(8)) gla_combine(F, OF, OB, act1, args.in[I_GNORM], mix);
    SEAM(8);
    if (IN(9)) { Sched S; S.init(mix, ws + WS_W1OUT, 1024, 128, 4, F.G, F.bid); EpiResid E{H, H, hbf, rss}; gemm_run<EpiResid, false>(F.lds, S, E, nullptr); }
    SEAM(9);
    if (IN(10)) {
        route1(F, H, args.in[I_ON2], args.in[I_WR], topi, topw, cnt);
        for (int it = F.gw; it < 8 * 3 * 1792; it += F.NGW) {
            const int e = it / 5376, r = it % 5376, which = r / 1792, item = r % 1792;
            if (which == 0) { CvtJob J{args.in[I_OWG] + (size_t)e * 1024 * FFE, 1024, FFE, wgu + (size_t)e * 7168 * 1024, args.in[I_ON2], 3}; cvt_job_item(J, item, scr, F.lane); }
            else if (which == 1) { CvtJob J{args.in[I_OWU] + (size_t)e * 1024 * FFE, 1024, FFE, wgu + (size_t)e * 7168 * 1024, args.in[I_ON2], 4}; cvt_job_item(J, item, scr, F.lane); }
            else { CvtJob J{args.in[I_OWD] + (size_t)e * FFE * 1024, FFE, 1024, wdn + (size_t)e * 1024 * FFE, nullptr, 0}; cvt_job_item(J, item, scr, F.lane); }
        }
    }
    SEAM(10);
    if (IN(11)) route2(F, topi, topw, cnt, stok, sw, blk);
    SEAM(11);
    if (IN(12)) { const int nb = blk[0]; Sched S; S.init(hbf, wgu, 1024, nb, 28, F.G, F.bid, blk + 16, (size_t)7168 * 1024 * 2);
        EpiSwiGLU E{hmid1, FFE, rss, stok}; gemm_run<EpiSwiGLU, true>(F.lds, S, E, stok); }
    SEAM(12);
    if (IN(13)) { const int nb = blk[0]; Sched S; S.init(hmid1, wdn, FFE, nb, 4, F.G, F.bid, blk + 16, (size_t)1024 * FFE * 2);
        EpiMoeDown E{H, stok, sw}; gemm_run<EpiMoeDown, false>(F.lds, S, E, nullptr); }
    SEAM(13);
    if (IN(14)) { const int nb = blk[1]; Sched S; S.init(hbf, wgu, 1024, nb, 28, F.G, F.bid, blk + 16 + 256, (size_t)7168 * 1024 * 2);
        EpiSwiGLU E{hmid1, FFE, rss, stok + SLOT_CAP}; gemm_run<EpiSwiGLU, true>(F.lds, S, E, stok + SLOT_CAP); }
    SEAM(14);
    if (IN(15)) { const int nb = blk[1]; Sched S; S.init(hmid1, wdn, FFE, nb, 4, F.G, F.bid, blk + 16 + 256, (size_t)1024 * FFE * 2);
        EpiMoeDown E{H, stok + SLOT_CAP, sw + SLOT_CAP}; gemm_run<EpiMoeDown, false>(F.lds, S, E, nullptr); }
    SEAM(15);
    if (IN(16)) final_norm(F, H, args.in[I_FNORM]);
#undef IN
#undef SEAM
}

extern "C" void kernel_launch(void* const* d_in, const int* in_sizes, int n_in, void* d_out, int out_size, void* d_ws, size_t ws_size, hipStream_t stream) {
    static int grid = 0;
    if (grid == 0) {
        if (n_in != 26 || out_size != NT * DM || ws_size < WS_END) { fprintf(stderr, "kernel_launch: unexpected problem (n_in %d out %d ws %zu need %zu)\n", n_in, out_size, ws_size, (size_t)WS_END); grid = -1; return; }
        int dev = 0, cus = 0, per_cu = 0;
        if (hipGetDevice(&dev) != hipSuccess || hipDeviceGetAttribute(&cus, hipDeviceAttributeMultiprocessorCount, dev) != hipSuccess) { grid = -1; return; }
        if (hipFuncSetAttribute((const void*)mega, hipFuncAttributeMaxDynamicSharedMemorySize, LDS_BYTES) != hipSuccess) { fprintf(stderr, "kernel_launch: hipFuncSetAttribute failed\n"); grid = -1; return; }
        if (hipOccupancyMaxActiveBlocksPerMultiprocessor(&per_cu, (const void*)mega, NTHR, LDS_BYTES) != hipSuccess || per_cu < 1) fprintf(stderr, "kernel_launch: occupancy query reports %d\n", per_cu);
        (void)hipGetLastError();
        grid = cus;
        if (grid != 256) fprintf(stderr, "kernel_launch: note: %d CUs\n", grid);
    }
    if (grid < 0) return;
    if (hipMemsetAsync((char*)d_ws + WS_CTL, 0, CTL_ZERO_BYTES, stream) != hipSuccess) return;
    Args a{};
    for (int i = 0; i < 26; ++i) a.in[i] = (const float*)d_in[i];
    a.out = (float*)d_out; a.ws = (unsigned char*)d_ws;
#if MK_FUSED
    a.ph_lo = 0; a.ph_hi = N_PHASES;
    hipLaunchKernelGGL(mega, dim3(grid), dim3(NTHR), LDS_BYTES, stream, a);
#else
    for (int p = 0; p < N_PHASES; ++p) { a.ph_lo = p; a.ph_hi = p + 1; hipLaunchKernelGGL(mega, dim3(grid), dim3(NTHR), LDS_BYTES, stream, a); }
#endif
}
```

```cpp
#include <hip/hip_runtime.h>
#include <cstdio>
#include <cstdint>

#ifndef MK_FUSED
#define MK_FUSED 1
#endif
#ifndef FAST_GEMM
#define FAST_GEMM 1
#endif
#ifndef FAST_ATT
#define FAST_ATT 1
#endif
#ifndef FAST_GLA
#define FAST_GLA 1
#endif

#define GAS __attribute__((address_space(1)))
#define LAS __attribute__((address_space(3)))
typedef unsigned short bf16;
typedef unsigned v4u __attribute__((ext_vector_type(4)));
typedef unsigned v2u __attribute__((ext_vector_type(2)));
typedef float f32x4 __attribute__((ext_vector_type(4)));
typedef short bf16x8 __attribute__((ext_vector_type(8)));
typedef GAS unsigned gu32;
#define RLX_AGENT __ATOMIC_RELAXED, __HIP_MEMORY_SCOPE_AGENT
#define LDS_WAIT() asm volatile("s_waitcnt lgkmcnt(0)" ::: "memory")
#define VM_WAIT() asm volatile("s_waitcnt vmcnt(0)" ::: "memory")

constexpr int NT = 32768, DM = 1024, SEQ = 4096, NB = 8;
constexpr int MEM_ROWS = 2048;
constexpr int A0_LD = 1792;
constexpr int A1_LD = 2048;
constexpr int FF0 = 2816, FFE = 3584, NEXP = 8;
constexpr int SLOT_CAP = 34816;
constexpr float EPS = 1e-6f;
constexpr int NWAVES = 8, NTHR = 512;

constexpr size_t MiB = 1u << 20;
constexpr size_t WS_CTL = 0, CTL_ZERO_BYTES = 1 * MiB;
constexpr size_t WS_RSS = 1 * MiB;
constexpr size_t WS_MRSS = 3 * MiB;
constexpr size_t WS_CNT = 3 * MiB + 256 * 1024;
constexpr size_t WS_TOPI = 3 * MiB + 512 * 1024;
constexpr size_t WS_TOPW = 3 * MiB + 768 * 1024;
constexpr size_t WS_STOK = 4 * MiB;
constexpr size_t WS_SW = 4 * MiB + 512 * 1024;
constexpr size_t WS_BLK = 5 * MiB;
constexpr size_t WS_W0IN = 6 * MiB;
constexpr size_t WS_WV0 = WS_W0IN + 1792 * 2048;
constexpr size_t WS_W0OUT = 11 * MiB;
constexpr size_t WS_W0GU = 13 * MiB;
constexpr size_t WS_W0DN = 24 * MiB;
constexpr size_t WS_WMEM = WS_W0DN + 1024 * 2816 * 2;
constexpr size_t WS_W1IN = 31 * MiB;
constexpr size_t WS_WV1 = 35 * MiB;
constexpr size_t WS_W1OUT = 37 * MiB - 512 * 1024;
constexpr size_t WS_HBF = 39 * MiB;
constexpr size_t WS_MEMBF = 103 * MiB;
constexpr size_t WS_MEMK = 107 * MiB;
constexpr size_t WS_MEMVT = 108 * MiB;
constexpr size_t WS_ACT = 109 * MiB;
constexpr size_t WS_ACT0 = WS_ACT;
constexpr size_t WS_V0T = WS_ACT + 112 * MiB;
constexpr size_t WS_MIX = WS_ACT + 176 * MiB;
constexpr size_t WS_HMID0 = WS_ACT;
constexpr size_t WS_ACT1 = WS_ACT;
constexpr size_t WS_V1T = WS_ACT + 128 * MiB;
constexpr size_t WS_OF = WS_ACT + 240 * MiB;
constexpr size_t WS_OB = WS_ACT + 288 * MiB;
constexpr size_t WS_E = WS_ACT + 336 * MiB;
constexpr size_t WS_HMID1 = WS_ACT;
constexpr size_t WS_WGU = WS_ACT + 240 * MiB;
constexpr size_t WS_WDN = WS_ACT + 352 * MiB;
constexpr size_t WS_END = WS_ACT + 408 * MiB;
static_assert(WS_W1OUT + 2 * MiB <= WS_HBF && WS_WV1 + 768 * 2048 <= WS_W1OUT && WS_W1IN + 4 * MiB <= WS_WV1 && WS_WMEM + MiB <= WS_W1IN, "weight map");
static_assert(WS_W0GU + 11 * MiB <= WS_W0DN && WS_WV0 + 768 * 2048 <= WS_W0OUT, "weight map 2");
static_assert((size_t)SLOT_CAP * 3584 * 2 <= 240 * MiB, "hmid1");

constexpr int CW_TMO = 0, CW_CODE = 1, CW_BAR = 4096;

constexpr int RING_BYTES = 131072;
constexpr int LDSCTL_OFF = RING_BYTES, MISC_OFF = LDSCTL_OFF + 320;
constexpr int LDS_BYTES = 147456;

__device__ __forceinline__ unsigned f2bf(float f) { unsigned u = __builtin_bit_cast(unsigned, f); return (u + 0x7fffu + ((u >> 16) & 1u)) >> 16; }
__device__ __forceinline__ unsigned pk2(float lo, float hi) { return f2bf(lo) | (f2bf(hi) << 16); }
__device__ __forceinline__ float bf2f(bf16 b) { return __builtin_bit_cast(float, (unsigned)b << 16); }
__device__ __forceinline__ float bflo(unsigned u) { return __builtin_bit_cast(float, u << 16); }
__device__ __forceinline__ float bfhi(unsigned u) { return __builtin_bit_cast(float, u & 0xffff0000u); }
__device__ __forceinline__ float wave_sum(float v) {
#pragma unroll
    for (int o = 1; o < 64; o <<= 1) v += __shfl_xor(v, o);
    return v;
}
__device__ __forceinline__ float wave_max(float v) {
#pragma unroll
    for (int o = 1; o < 64; o <<= 1) v = fmaxf(v, __shfl_xor(v, o));
    return v;
}
__device__ __forceinline__ float rstd_from(const float* rss16) {
    const f32x4* p = (const f32x4*)rss16; f32x4 a = p[0], b = p[1], c = p[2], d = p[3];
    const float s = ((a.x + a.y) + (a.z + a.w)) + ((b.x + b.y) + (b.z + b.w)) + ((c.x + c.y) + (c.z + c.w)) + ((d.x + d.y) + (d.z + d.w));
    return 1.0f / sqrtf(s * (1.0f / DM) + EPS);
}

#define XB_TMO      128
#define XB_XCNT(j)  (256  + 64 * (j))
#define XB_XSUB(j)  (1280 + 64 * (j))
#define XB_XGEN(j)  (2304 + 64 * (j))
#define XB_TOP      3328
#define XB_TOPGEN   3392
#define XCD_BAR_WORDS 3456
#define XB_SPIN_CAP (1u << 22)

__device__ __forceinline__ unsigned xb_ld(unsigned* p)              { return __hip_atomic_load(p, __ATOMIC_RELAXED, __HIP_MEMORY_SCOPE_AGENT); }
__device__ __forceinline__ unsigned xb_add(unsigned* p, unsigned v) { return __hip_atomic_fetch_add(p, v, __ATOMIC_RELAXED, __HIP_MEMORY_SCOPE_AGENT); }
__device__ __forceinline__ unsigned xb_xcc_id() { return (unsigned)__builtin_amdgcn_s_getreg((3 << 11) | 20) & 0xFu; }
#define XB_SPIN(cond, bar) do { unsigned _sp = 0; while (cond) { __builtin_amdgcn_s_sleep(1); \
    if ((++_sp & 255u) == 0u) { if (xb_ld(&(bar)[XB_TMO])) break; if (_sp > XB_SPIN_CAP) { atomicAdd(&(bar)[XB_TMO], 1u); break; } } } } while (0)

struct XcdBarrier { unsigned* bar; unsigned x; volatile LAS unsigned* st; };

__device__ __forceinline__ XcdBarrier xcd_barrier_post(unsigned* bar, volatile LAS unsigned* st) {
    XcdBarrier b; b.bar = bar; b.x = xb_xcc_id(); b.st = st;
    if (threadIdx.x == 0) (void)xb_add(&bar[XB_XCNT(b.x)], 1u);
    return b;
}
__device__ __forceinline__ void xcd_barrier_complete(unsigned* bar, unsigned x, unsigned& nloc, unsigned& nx) {
    const unsigned G = gridDim.x * gridDim.y * gridDim.z;
    unsigned sum, cnt, mine, sp = 0u;
    for (;;) {
        sum = 0u; cnt = 0u; mine = 0u;
#pragma unroll
        for (unsigned j = 0; j < 16; ++j) { const unsigned c = xb_ld(&bar[XB_XCNT(j)]); sum += c; cnt += (c > 0u) ? 1u : 0u; mine = (j == x) ? c : mine; }
        if (sum == G) break;
        __builtin_amdgcn_s_sleep(1);
        if ((++sp & 255u) == 0u) { if (xb_ld(&bar[XB_TMO])) break; if (sp > XB_SPIN_CAP) { atomicAdd(&bar[XB_TMO], 1u); break; } }
    }
    nloc = mine > 0u ? mine : 1u; nx = cnt > 0u ? cnt : 1u;
}
__device__ __forceinline__ void xcd_barrier(const XcdBarrier& b) {
    asm volatile("s_waitcnt vmcnt(0)" ::: "memory");
    __syncthreads();
    if (threadIdx.x == 0) {
        unsigned* bar = b.bar;
        __builtin_amdgcn_s_waitcnt(0);
        unsigned nloc = b.st[0], nx = b.st[1];
        if (nloc == 0u) { xcd_barrier_complete(bar, b.x, nloc, nx); b.st[0] = nloc; b.st[1] = nx; }
        const unsigned old = xb_add(&bar[XB_XSUB(b.x)], 1u);
        const unsigned gen = old / nloc;
        if (old + 1u == (gen + 1u) * nloc) {
            __builtin_amdgcn_fence(__ATOMIC_RELEASE, "agent");
            asm volatile("s_waitcnt vmcnt(0)" ::: "memory");
            const unsigned og = xb_add(&bar[XB_TOP], 1u);
            const unsigned tg = og / nx;
            if (og + 1u == (tg + 1u) * nx) xb_add(&bar[XB_TOPGEN], 1u);
            else XB_SPIN(xb_ld(&bar[XB_TOPGEN]) == tg, bar);
            __builtin_amdgcn_fence(__ATOMIC_ACQUIRE, "agent");
            xb_add(&bar[XB_XGEN(b.x)], 1u);
            asm volatile("s_waitcnt vmcnt(0)" ::: "memory");
        } else {
            XB_SPIN(xb_ld(&bar[XB_XGEN(b.x)]) == gen, bar);
            __builtin_amdgcn_fence(__ATOMIC_ACQUIRE, "agent");
            asm volatile("s_waitcnt vmcnt(0)" ::: "memory");
        }
    }
    __syncthreads();
}

struct Args { const float* in[26]; float* out; unsigned char* ws; int ph_lo, ph_hi; };
enum { I_X = 0, I_MEM, I_EN1, I_EWIN, I_RPB, I_EWOUT, I_EN2, I_EWG, I_EWU, I_EWD, I_ON1, I_OWIN, I_WGKF, I_BGKF, I_WGKB, I_BGKB, I_GNORM, I_OWOUT, I_ON2, I_WR, I_OWG, I_OWU, I_OWD, I_MNORM, I_WMKV, I_FNORM };

struct Frame {
    LAS unsigned char* lds;
    int tid, lane, wave, G, bid;
    int gw, NGW;
    unsigned char* ws;
};

__device__ __forceinline__ void cvt_item(const float* W, int ldn, int k0, int n0, bf16* WT, int ldk, int drow0, const float* gain, float scale, LAS float* scr, int lane) {
#pragma unroll 8
    for (int i = 0; i < 32; ++i) { const int kk = 2 * i + (lane >> 5); float v = W[(size_t)(k0 + kk) * ldn + n0 + (lane & 31)];
        const float gg = gain ? gain[k0 + kk] : 1.0f; scr[kk * 33 + (lane & 31)] = v * gg * scale; }
    LDS_WAIT(); asm volatile("" ::: "memory");
    const int c = lane & 7;
#pragma unroll
    for (int j = 0; j < 4; ++j) { const int n = (lane >> 3) + 8 * j; const LAS float* s = scr + (8 * c) * 33 + n;
        v4u o; o.x = pk2(s[0 * 33], s[1 * 33]); o.y = pk2(s[2 * 33], s[3 * 33]); o.z = pk2(s[4 * 33], s[5 * 33]); o.w = pk2(s[6 * 33], s[7 * 33]);
        *(GAS v4u*)(WT + (size_t)(drow0 + n) * ldk + k0 + 8 * c) = o; }
    LDS_WAIT(); asm volatile("" ::: "memory");
}
struct CvtJob { const float* W; int K, N; bf16* WT; const float* gain; int kind; };
__device__ __forceinline__ bool cvt_map(int kind, int n0, int& drow, float& scale) {
    scale = 1.0f;
    switch (kind) {
    case 0: drow = n0; return true;
    case 1: if (n0 < 768) { drow = n0; scale = 0.125f; return true; } if (n0 < 1536) { drow = n0; return true; } if (n0 >= 2304) { drow = n0 - 768; scale = 0.125f; return true; } return false;
    case 2: if (n0 >= 1536 && n0 < 2304) { drow = n0 - 1536; return true; } return false;
    case 3: drow = (n0 >> 7) * 256 + (n0 & 127); return true;
    case 4: drow = (n0 >> 7) * 256 + 128 + (n0 & 127); return true;
    case 5: if (n0 < 768) { drow = n0; return true; } if (n0 < 1536) return false; if (n0 < 2304) { drow = n0 - 768; return true; }
            if (n0 < 2336) { drow = n0 - 512; return true; } drow = n0 - 800; scale = 0.125f; return true;
    case 6: if (n0 >= 768 && n0 < 1536) { drow = n0 - 768; return true; } return false;
    default: drow = n0; return true;
    }
}
__device__ __forceinline__ void cvt_job_item(const CvtJob& J, int item, LAS float* scr, int lane) {
    const int nblk = J.N / 32, kb = item / nblk, nb = item % nblk; int drow; float scale;
    if (!cvt_map(J.kind, nb * 32, drow, scale)) return;
    cvt_item(J.W, J.N, kb * 64, nb * 32, J.WT, J.K, drow, J.gain, scale, scr, lane);
}

__device__ __forceinline__ void row_to_bf16(const float* xrow, bf16* orow, float* rss16, int lane) {
    const GAS f32x4* xr = (const GAS f32x4*)xrow + lane;
    f32x4 v[4]; float s = 0.f;
#pragma unroll
    for (int j = 0; j < 4; ++j) { v[j] = xr[64 * j]; s += (v[j].x * v[j].x + v[j].y * v[j].y) + (v[j].z * v[j].z + v[j].w * v[j].w); }
    s = wave_sum(s);
    GAS unsigned long long* o8 = (GAS unsigned long long*)orow + lane;
#pragma unroll
    for (int j = 0; j < 4; ++j) o8[64 * j] = (unsigned long long)pk2(v[j].x, v[j].y) | ((unsigned long long)pk2(v[j].z, v[j].w) << 32);
    if (lane < 16) rss16[lane] = (lane == 0) ? s : 0.f;
}

struct Unit { int pm, pn; };
struct Sched {
    int nM, nN, nwg, G, c, K;
    const char* A; const char* B; const int* bexp; size_t estride;
    __device__ void init(const void* A_, const void* B_, int K_, int nM_, int nN_, int G_, int c_, const int* bexp_ = nullptr, size_t estride_ = 0) {
        A = (const char*)A_; B = (const char*)B_; K = K_; nM = nM_; nN = nN_; nwg = nM * nN; G = G_; c = c_; bexp = bexp_; estride = estride_; }
    __device__ bool next(int i, Unit& u) const {
        const long L = (long)i * G + c; if (L >= nwg) return false;
        int wgid = (int)L; { const int q = nwg / 8, r = nwg % 8, xcd = wgid % 8, off = wgid / 8; wgid = (xcd < r ? xcd * (q + 1) : r * (q + 1) + (xcd - r) * q) + off; }
        const int nig = 8 * nN, gid = wgid / nig, fm = gid * 8, gsz = (nM - fm) < 8 ? (nM - fm) : 8;
        u.pm = fm + ((wgid % nig) % gsz); u.pn = (wgid % nig) / gsz; return true;
    }
    __device__ const char* a_base(const Unit& u) const { return A + (size_t)u.pm * 512 * K; }
    __device__ const char* b_base(const Unit& u) const { return B + (bexp ? (size_t)bexp[u.pm] * estride : (size_t)0) + (size_t)u.pn * 512 * K; }
};

struct NoCtx {};
struct EpiRowScale {
    static constexpr bool NEED_SS = false; typedef NoCtx Ctx;
    bf16* O; int ldc; const float* rss;
    __device__ __forceinline__ void begin(Ctx&, int, int) const {}
    __device__ __forceinline__ float apply(const Ctx&, int row, int pn, int c128, const float (&a)[8], const float (&b)[8]) const {
        const float s = rstd_from(rss + (size_t)row * 16);
        bf16* p = O + (size_t)row * ldc + pn * 256 + c128;
        v4u w; w.x = pk2(a[0] * s, a[1] * s); w.y = pk2(a[2] * s, a[3] * s); w.z = pk2(a[4] * s, a[5] * s); w.w = pk2(a[6] * s, a[7] * s); *(v4u*)p = w;
        w.x = pk2(b[0] * s, b[1] * s); w.y = pk2(b[2] * s, b[3] * s); w.z = pk2(b[4] * s, b[5] * s); w.w = pk2(b[6] * s, b[7] * s); *(v4u*)(p + 128) = w;
        return 0.f;
    }
    __device__ __forceinline__ void row_done(int, int, int, float) const {}
};
struct ColCtx { float sa[8], sb[8]; };
struct EpiColScale {
    static constexpr bool NEED_SS = false; typedef ColCtx Ctx;
    bf16* O; int ldc; const float* rss;
    __device__ __forceinline__ void begin(Ctx& c, int pn, int c128) const {
        const float* pa = rss + (size_t)(pn * 256 + c128) * 16; const float* pb = pa + 128 * 16;
#pragma unroll
        for (int j = 0; j < 8; ++j) { c.sa[j] = rstd_from(pa + j * 16); c.sb[j] = rstd_from(pb + j * 16); }
    }
    __device__ __forceinline__ float apply(const Ctx& c, int row, int pn, int c128, const float (&a)[8], const float (&b)[8]) const {
        bf16* p = O + (size_t)row * ldc + pn * 256 + c128;
        v4u w; w.x = pk2(a[0] * c.sa[0], a[1] * c.sa[1]); w.y = pk2(a[2] * c.sa[2], a[3] * c.sa[3]); w.z = pk2(a[4] * c.sa[4], a[5] * c.sa[5]); w.w = pk2(a[6] * c.sa[6], a[7] * c.sa[7]); *(v4u*)p = w;
        w.x = pk2(b[0] * c.sb[0], b[1] * c.sb[1]); w.y = pk2(b[2] * c.sb[2], b[3] * c.sb[3]); w.z = pk2(b[4] * c.sb[4], b[5] * c.sb[5]); w.w = pk2(b[6] * c.sb[6], b[7] * c.sb[7]); *(v4u*)(p + 128) = w;
        return 0.f;
    }
    __device__ __forceinline__ void row_done(int, int, int, float) const {}
};
struct EpiResid {
    static constexpr bool NEED_SS = true; typedef NoCtx Ctx;
    __device__ __forceinline__ void begin(Ctx&, int, int) const {}
    const float* R; float* H; bf16* HB; float* rss;
    __device__ __forceinline__ float apply(const Ctx&, int row, int pn, int c128, const float (&a)[8], const float (&b)[8]) const {
        const size_t off = (size_t)row * DM + pn * 256 + c128; float ss = 0.f;
        {   const f32x4 r0 = *(const f32x4*)(R + off), r1 = *(const f32x4*)(R + off + 4);
            const f32x4 h0 = {r0.x + a[0], r0.y + a[1], r0.z + a[2], r0.w + a[3]}, h1 = {r1.x + a[4], r1.y + a[5], r1.z + a[6], r1.w + a[7]};
            *(f32x4*)(H + off) = h0; *(f32x4*)(H + off + 4) = h1;
            v4u w; w.x = pk2(h0.x, h0.y); w.y = pk2(h0.z, h0.w); w.z = pk2(h1.x, h1.y); w.w = pk2(h1.z, h1.w); *(v4u*)(HB + off) = w;
            ss += (h0.x * h0.x + h0.y * h0.y) + (h0.z * h0.z + h0.w * h0.w) + (h1.x * h1.x + h1.y * h1.y) + (h1.z * h1.z + h1.w * h1.w); }
        {   const size_t o2 = off + 128; const f32x4 r0 = *(const f32x4*)(R + o2), r1 = *(const f32x4*)(R + o2 + 4);
            const f32x4 h0 = {r0.x + b[0], r0.y + b[1], r0.z + b[2], r0.w + b[3]}, h1 = {r1.x + b[4], r1.y + b[5], r1.z + b[6], r1.w + b[7]};
            *(f32x4*)(H + o2) = h0; *(f32x4*)(H + o2 + 4) = h1;
            v4u w; w.x = pk2(h0.x, h0.y); w.y = pk2(h0.z, h0.w); w.z = pk2(h1.x, h1.y); w.w = pk2(h1.z, h1.w); *(v4u*)(HB + o2) = w;
            ss += (h0.x * h0.x + h0.y * h0.y) + (h0.z * h0.z + h0.w * h0.w) + (h1.x * h1.x + h1.y * h1.y) + (h1.z * h1.z + h1.w * h1.w); }
        return ss;
    }
    __device__ __forceinline__ void row_done(int row, int pn, int wc, float ss) const { rss[(size_t)row * 16 + pn * 4 + wc] = ss; }
};
__device__ __forceinline__ float silu_mul(float g, float u) { return g / (1.0f + __expf(-g)) * u; }
struct EpiSwiGLU {
    static constexpr bool NEED_SS = false; typedef NoCtx Ctx;
    __device__ __forceinline__ void begin(Ctx&, int, int) const {}
    bf16* Hm; int ldh; const float* rss; const int* tok;
    __device__ __forceinline__ float apply(const Ctx&, int row, int pn, int c128, const float (&a)[8], const float (&b)[8]) const {
        int t = row; if (tok) t = tok[row];
        float o[8];
        if (t >= 0) { const float s = rstd_from(rss + (size_t)t * 16);
#pragma unroll
            for (int j = 0; j < 8; ++j) o[j] = silu_mul(a[j] * s, b[j] * s);
        } else {
#pragma unroll
            for (int j = 0; j < 8; ++j) o[j] = 0.f; }
        v4u w; w.x = pk2(o[0], o[1]); w.y = pk2(o[2], o[3]); w.z = pk2(o[4], o[5]); w.w = pk2(o[6], o[7]);
        *(v4u*)(Hm + (size_t)row * ldh + pn * 128 + c128) = w;
        return 0.f;
    }
    __device__ __forceinline__ void row_done(int, int, int, float) const {}
};
struct EpiMoeDown {
    static constexpr bool NEED_SS = false; typedef NoCtx Ctx;
    __device__ __forceinline__ void begin(Ctx&, int, int) const {}
    float* H; const int* tok; const float* w;
    __device__ __forceinline__ float apply(const Ctx&, int row, int pn, int c128, const float (&a)[8], const float (&b)[8]) const {
        const int t = tok[row]; if (t < 0) return 0.f;
        const float s = w[row]; float* p = H + (size_t)t * DM + pn * 256 + c128;
        f32x4 h0 = *(f32x4*)p, h1 = *(f32x4*)(p + 4), h2 = *(f32x4*)(p + 128), h3 = *(f32x4*)(p + 132);
        h0.x += s * a[0]; h0.y += s * a[1]; h0.z += s * a[2]; h0.w += s * a[3]; h1.x += s * a[4]; h1.y += s * a[5]; h1.z += s * a[6]; h1.w += s * a[7];
        h2.x += s * b[0]; h2.y += s * b[1]; h2.z += s * b[2]; h2.w += s * b[3]; h3.x += s * b[4]; h3.y += s * b[5]; h3.z += s * b[6]; h3.w += s * b[7];
        *(f32x4*)p = h0; *(f32x4*)(p + 4) = h1; *(f32x4*)(p + 128) = h2; *(f32x4*)(p + 132) = h3;
        return 0.f;
    }
    __device__ __forceinline__ void row_done(int, int, int, float) const {}
};

template <class Epi, bool GATHER>
__device__ __forceinline__ void gemm_simple(LAS unsigned char* lds, const Sched& S, const Epi& E, const int* gtok) {
    LAS float* As = (LAS float*)lds;
    LAS float* Bs = (LAS float*)(lds + 16384);
    const int tid = threadIdx.x, wc = tid & 3, rr = tid >> 2, K = S.K;
    Unit u;
    for (int i = 0; S.next(i, u); ++i) {
        const char* bb = S.b_base(u);
        for (int h = 0; h < 2; ++h) {
            const int rowbase = u.pm * 256 + h * 128;
            const bf16* arow; { int r = rowbase + (tid >> 2); if (GATHER) { int t = gtok[r]; if (t < 0) t = 0; arow = (const bf16*)S.A + (size_t)t * K; } else arow = (const bf16*)S.A + (size_t)r * K; }
            const bf16* brow = (const bf16*)bb + (size_t)(tid >> 1) * K;
            float ca[32], cb[32];
#pragma unroll
            for (int j = 0; j < 32; ++j) { ca[j] = 0.f; cb[j] = 0.f; }
            for (int k0 = 0; k0 < K; k0 += 16) {
                const v2u av = *(const v2u*)(arow + k0 + (tid & 3) * 4);
                const v4u bv = *(const v4u*)(brow + k0 + (tid & 1) * 8);
                __syncthreads();
                { LAS float* d = As + (tid >> 2) * 17 + (tid & 3) * 4; d[0] = bflo(av.x); d[1] = bfhi(av.x); d[2] = bflo(av.y); d[3] = bfhi(av.y); }
                { const int kb = (tid & 1) * 8, n = tid >> 1; LAS float* d = Bs + n;
                  d[(kb + 0) * 260] = bflo(bv.x); d[(kb + 1) * 260] = bfhi(bv.x); d[(kb + 2) * 260] = bflo(bv.y); d[(kb + 3) * 260] = bfhi(bv.y);
                  d[(kb + 4) * 260] = bflo(bv.z); d[(kb + 5) * 260] = bfhi(bv.z); d[(kb + 6) * 260] = bflo(bv.w); d[(kb + 7) * 260] = bfhi(bv.w); }
                __syncthreads();
#pragma unroll 4
                for (int k = 0; k < 16; ++k) {
                    const float a = As[rr * 17 + k];
                    const LAS f32x4* b0 = (const LAS f32x4*)(Bs + k * 260 + 32 * wc);
                    const LAS f32x4* b1 = (const LAS f32x4*)(Bs + k * 260 + 128 + 32 * wc);
#pragma unroll
                    for (int j = 0; j < 8; ++j) { const f32x4 x = b0[j], y = b1[j];
                        ca[4 * j] += a * x.x; ca[4 * j + 1] += a * x.y; ca[4 * j + 2] += a * x.z; ca[4 * j + 3] += a * x.w;
                        cb[4 * j] += a * y.x; cb[4 * j + 1] += a * y.y; cb[4 * j + 2] += a * y.z; cb[4 * j + 3] += a * y.w; }
                }
            }
            const int row = rowbase + rr; float ss = 0.f;
#pragma unroll
            for (int g = 0; g < 4; ++g) { float a8[8], b8[8];
#pragma unroll
                for (int j = 0; j < 8; ++j) { a8[j] = ca[8 * g + j]; b8[j] = cb[8 * g + j]; }
                typename Epi::Ctx ctx; E.begin(ctx, u.pn, 32 * wc + 8 * g); ss += E.apply(ctx, row, u.pn, 32 * wc + 8 * g, a8, b8); asm volatile("" ::: "memory"); }
            if (Epi::NEED_SS) E.row_done(row, u.pn, wc, ss);
        }
    }
    __syncthreads();
}

namespace pg8 {
constexpr int HTB = 16384, TOK_OFF = 132096;
__device__ __forceinline__ int lds_byte(int r, int c) { const int st = (r >> 4) * 2 + (c >> 5), rr = r & 15, cc = c & 31, ob = rr * 64 + cc * 2; return st * 1024 + (ob ^ (((ob >> 9) & 1) << 5)); }
__device__ __forceinline__ void stage_rc(int b, int& R, int& C) { const int st = b / 1024, sb = b % 1024, swz = sb ^ (((sb >> 9) & 1) << 5); R = (st >> 1) * 16 + swz / 64; C = (st & 1) * 32 + (swz % 64) / 2; }
__device__ __forceinline__ int perm32(int rho) { const int n = rho >> 4, i = rho & 15; return 8 * (i >> 2) + 4 * n + (i & 3); }

template <class Epi>
__device__ __forceinline__ void run_epi(const Epi& E, const f32x4 (&acc)[2][2][4][2], const Unit& u, int wr, int wc, int fr, int fq) {
    typename Epi::Ctx ctx; E.begin(ctx, u.pn, 32 * wc + 8 * fq);
#pragma unroll
    for (int ai = 0; ai < 2; ++ai)
#pragma unroll
        for (int m = 0; m < 4; ++m) {
            const int row = u.pm * 256 + ai * 128 + wr * 64 + m * 16 + fr;
            float a[8], b[8];
#pragma unroll
            for (int j = 0; j < 8; ++j) { a[j] = acc[ai][0][m][j >> 2][j & 3]; b[j] = acc[ai][1][m][j >> 2][j & 3]; }
            float ss = E.apply(ctx, row, u.pn, 32 * wc + 8 * fq, a, b);
            if (Epi::NEED_SS) { ss += __shfl_xor(ss, 16); ss += __shfl_xor(ss, 32); if (fq == 0) E.row_done(row, u.pn, wc, ss); }
        }
}

template <class Epi, bool GATHER>
__device__ __forceinline__ void gemm_fast(LAS unsigned char* lds, const Sched& S, const Epi& E, const int* gtok) {
    const int tid = threadIdx.x, wid = __builtin_amdgcn_readfirstlane(tid >> 6), lane = tid & 63, wr = wid >> 2, wc = wid & 3, fr = lane & 15, fq = lane >> 4;
    const int K = S.K, nt = K / 64;
    unsigned voffB[2], vA0[2], vA1[2], nA0[2], nA1[2]; int RA[2], CA2[2];
#pragma unroll
    for (int i = 0; i < 2; ++i) { int R, C; stage_rc(tid * 16 + i * 8192, R, C); const int Rb = (R & ~31) + perm32(R & 31);
        voffB[i] = (unsigned)(Rb * K + C) * 2u; RA[i] = R; CA2[i] = C * 2; vA0[i] = (unsigned)(R * K + C) * 2u; vA1[i] = vA0[i] + (unsigned)(128 * K * 2); nA0[i] = vA0[i]; nA1[i] = vA1[i]; }
    const size_t kstep = 128;
    const size_t hstep = (size_t)128 * K * 2;
    const unsigned ldsw = (unsigned)wid * 1024u;
    const int aoff = lds_byte(wr * 64 + fr, fq * 8), boff = lds_byte(wc * 32 + fr, fq * 8);
    LAS int* tl = (LAS int*)(lds + TOK_OFF);
#define PG8_SA(b, h) (((b) * 2 + (h)) * HTB)
#define PG8_SB(b, h) ((4 + (b) * 2 + (h)) * HTB)
#define PG8_STAGE(bufoff, gbase, voff) do { _Pragma("unroll") for (int _i = 0; _i < 2; ++_i) \
        __builtin_amdgcn_global_load_lds((const unsigned*)((const char*)(gbase) + (voff)[_i]), (LAS unsigned*)(lds + (bufoff) + ldsw + _i * 8192), 16, 0, 0); } while (0)
#define PG8_LDA(dst, b, h) do { _Pragma("unroll") for (int m = 0; m < 4; ++m) _Pragma("unroll") for (int k = 0; k < 2; ++k) dst[m][k] = *(const LAS bf16x8*)(lds + PG8_SA(b, h) + aoff + m * 2048 + k * 1024); } while (0)
#define PG8_LDB(dst, b, h) do { _Pragma("unroll") for (int n = 0; n < 2; ++n) _Pragma("unroll") for (int k = 0; k < 2; ++k) dst[n][k] = *(const LAS bf16x8*)(lds + PG8_SB(b, h) + boff + n * 2048 + k * 1024); } while (0)
#define PG8_MMA(ai, bj, At, Bt) do { __builtin_amdgcn_s_setprio(1); _Pragma("unroll") for (int m = 0; m < 4; ++m) _Pragma("unroll") for (int n = 0; n < 2; ++n) _Pragma("unroll") for (int k = 0; k < 2; ++k) \
        acc[ai][bj][m][n] = __builtin_amdgcn_mfma_f32_16x16x32_bf16(Bt[n][k], At[m][k], acc[ai][bj][m][n], 0, 0, 0); __builtin_amdgcn_s_setprio(0); } while (0)
#define PG8_WAIT_V(n) asm volatile("s_waitcnt vmcnt(" #n ")" ::: "memory")
#define PG8_WAIT_L(n) asm volatile("s_waitcnt lgkmcnt(" #n ")" ::: "memory")
#define PG8_BAR __builtin_amdgcn_s_barrier()
#define PG8_SCHED __builtin_amdgcn_sched_barrier(0)
#define PG8_IDS_DMA(pm_, par_) do { if (wid < 4) __builtin_amdgcn_global_load_lds((const unsigned*)(gtok + (pm_) * 256 + wid * 64 + lane), (LAS unsigned*)(lds + TOK_OFF + (par_) * 1024 + wid * 256), 4, 0, 0); } while (0)
#define PG8_IDS_READ(d0, d1, par_) do { _Pragma("unroll") for (int _i = 0; _i < 2; ++_i) { int t0 = tl[(par_) * 256 + RA[_i]], t1 = tl[(par_) * 256 + 128 + RA[_i]]; t0 = t0 < 0 ? 0 : t0; t1 = t1 < 0 ? 0 : t1; \
        d0[_i] = (unsigned)t0 * (unsigned)(K * 2) + (unsigned)CA2[_i]; d1[_i] = (unsigned)t1 * (unsigned)(K * 2) + (unsigned)CA2[_i]; } } while (0)
    Unit cur, nxt; int ui = 0, par = 0;
    if (!S.next(0, cur)) return;
    f32x4 acc[2][2][4][2];
#pragma unroll
    for (int a = 0; a < 2; ++a)
#pragma unroll
        for (int b = 0; b < 2; ++b)
#pragma unroll
            for (int m = 0; m < 4; ++m)
#pragma unroll
                for (int n = 0; n < 2; ++n) acc[a][b][m][n] = (f32x4){0.f, 0.f, 0.f, 0.f};
    bf16x8 At[4][2], B0[2][2], B1[2][2];
    const char* cA = GATHER ? S.A : S.a_base(cur); const char* cB = S.b_base(cur);
    if constexpr (GATHER) { PG8_IDS_DMA(cur.pm, 0); PG8_WAIT_V(0); __syncthreads(); PG8_IDS_READ(vA0, vA1, 0); }
    PG8_STAGE(PG8_SB(0, 0), cB, voffB); PG8_STAGE(PG8_SB(0, 1), cB + hstep, voffB); PG8_STAGE(PG8_SA(0, 0), cA, vA0); PG8_STAGE(PG8_SA(0, 1), cA, vA1);
    if (wr == 1) PG8_BAR;
    PG8_WAIT_V(2); PG8_BAR;
    PG8_STAGE(PG8_SB(1, 0), cB + kstep, voffB); PG8_STAGE(PG8_SA(1, 0), cA + kstep, vA0); PG8_STAGE(PG8_SB(1, 1), cB + hstep + kstep, voffB);
    PG8_WAIT_V(6); PG8_BAR;
    for (;;) {
        const bool has_next = S.next(ui + 1, nxt);
        const char* nA = has_next ? (GATHER ? S.A : S.a_base(nxt)) : cA; const char* nB = has_next ? S.b_base(nxt) : cB;
        for (int t = 0; t < nt; t += 2) {
            const bool last = (t == nt - 2);
            if constexpr (GATHER) {
                if (t == nt - 4 && has_next) PG8_IDS_DMA(nxt.pm, par ^ 1);
                if (last) { if (has_next) PG8_IDS_READ(nA0, nA1, par ^ 1); else { nA0[0] = vA0[0]; nA0[1] = vA0[1]; nA1[0] = vA1[0]; nA1[1] = vA1[1]; } }
            }
            const char* a1 = cA + (size_t)(t + 1) * kstep;
            const char* a2 = last ? nA : cA + (size_t)(t + 2) * kstep; const char* b2 = last ? nB : cB + (size_t)(t + 2) * kstep;
            const char* a3 = a2 + kstep; const char* b3 = b2 + kstep;
            unsigned w0[2], w1[2];
            if (GATHER && last) { w0[0] = nA0[0]; w0[1] = nA0[1]; w1[0] = nA1[0]; w1[1] = nA1[1]; } else { w0[0] = vA0[0]; w0[1] = vA0[1]; w1[0] = vA1[0]; w1[1] = vA1[1]; }
            PG8_LDB(B0, 0, 0); PG8_LDB(B1, 0, 1); PG8_SCHED; PG8_LDA(At, 0, 0); PG8_STAGE(PG8_SA(1, 1), a1, vA1);
            PG8_WAIT_V(8); PG8_WAIT_L(0); PG8_BAR; PG8_MMA(0, 0, At, B0); PG8_MMA(0, 1, At, B1); PG8_BAR; PG8_SCHED;
            PG8_LDA(At, 0, 1); PG8_STAGE(PG8_SB(0, 0), b2, voffB); PG8_STAGE(PG8_SB(0, 1), b2 + hstep, voffB); PG8_STAGE(PG8_SA(0, 0), a2, w0);
            PG8_WAIT_V(8); PG8_WAIT_L(0); PG8_BAR; PG8_MMA(1, 0, At, B0); PG8_MMA(1, 1, At, B1); PG8_BAR; PG8_SCHED;
            PG8_LDB(B0, 1, 0); PG8_LDB(B1, 1, 1); PG8_SCHED; PG8_LDA(At, 1, 0); PG8_STAGE(PG8_SA(0, 1), a2, w1);
            PG8_WAIT_V(8); PG8_WAIT_L(0); PG8_BAR; PG8_MMA(0, 0, At, B0); PG8_MMA(0, 1, At, B1); PG8_BAR; PG8_SCHED;
            PG8_LDA(At, 1, 1); PG8_STAGE(PG8_SB(1, 0), b3, voffB); PG8_STAGE(PG8_SB(1, 1), b3 + hstep, voffB); PG8_STAGE(PG8_SA(1, 0), a3, w0);
            PG8_WAIT_V(8); PG8_WAIT_L(0); PG8_BAR; PG8_MMA(1, 0, At, B0); PG8_MMA(1, 1, At, B1); PG8_BAR; PG8_SCHED;
        }
        if (wr == 0) PG8_BAR;
        run_epi(E, acc, cur, wr, wc, fr, fq);
        if (!has_next) break;
#pragma unroll
        for (int a = 0; a < 2; ++a)
#pragma unroll
            for (int b = 0; b < 2; ++b)
#pragma unroll
                for (int m = 0; m < 4; ++m)
#pragma unroll
                    for (int n = 0; n < 2; ++n) acc[a][b][m][n] = (f32x4){0.f, 0.f, 0.f, 0.f};
        cur = nxt; cA = nA; cB = nB; ++ui;
        if constexpr (GATHER) { vA0[0] = nA0[0]; vA0[1] = nA0[1]; vA1[0] = nA1[0]; vA1[1] = nA1[1]; par ^= 1; }
        if (wr == 1) PG8_BAR;
    }
    PG8_WAIT_V(0);
    PG8_BAR;
#undef PG8_SA
#undef PG8_SB
#undef PG8_STAGE
#undef PG8_LDA
#undef PG8_LDB
#undef PG8_MMA
#undef PG8_WAIT_V
#undef PG8_WAIT_L
#undef PG8_BAR
#undef PG8_SCHED
#undef PG8_IDS_DMA
#undef PG8_IDS_READ
}
}

template <class Epi, bool GATHER>
__device__ __forceinline__ void gemm_run(LAS unsigned char* lds, const Sched& S, const Epi& E, const int* gtok) {
#if FAST_GEMM
    pg8::gemm_fast<Epi, GATHER>(lds, S, E, gtok);
#else
    gemm_simple<Epi, GATHER>(lds, S, E, gtok);
#endif
}

__device__ __forceinline__ void na_simple(const Frame& F, const bf16* act0, const bf16* v0t, const float* rpb, bf16* mix) {
    for (int it = F.gw; it < NT * 12; it += F.NGW) {
        const int token = it / 12, h = it % 12, lane = F.lane;
        const int b = token >> 12, p = token & 4095, r = p >> 6, c = p & 63;
        const int r0 = min(max(r - 4, 0), 56), cs = min(max(c - 8, 0), 48);
        const float q = bf2f(act0[(size_t)token * A0_LD + h * 64 + lane]);
        float m = -INFINITY, l = 0.f, o = 0.f;
        for (int a = 0; a < 8; ++a)
            for (int u = 0; u < 16; ++u) {
                const int kt = b * SEQ + (r0 + a) * 64 + cs + u;
                const float kv = bf2f(act0[(size_t)kt * A0_LD + 768 + h * 64 + lane]);
                const float sc = wave_sum(q * kv) + rpb[h * 465 + (r0 + a - r + 7) * 31 + (cs + u - c + 15)];
                const float mn = fmaxf(m, sc), corr = __expf(m - mn), pe = __expf(sc - mn);
                const float vv = bf2f(v0t[(size_t)(h * 64 + lane) * NT + kt]);
                l = l * corr + pe; o = o * corr + pe * vv; m = mn;
            }
        mix[(size_t)token * DM + h * 64 + lane] = (bf16)f2bf(o / l);
    }
}
__device__ __forceinline__ void memattn_simple(const Frame& F, int first, int stride, const bf16* act, int ld, int qoff, const bf16* memk, const bf16* memvt, bf16* mix) {
    for (int it = first; it < NT * 4; it += stride) {
        const int token = it >> 2, h = it & 3, lane = F.lane, b = token >> 12;
        const float q = bf2f(act[(size_t)token * ld + qoff + h * 64 + lane]);
        float m = -INFINITY, l = 0.f, o = 0.f;
        for (int j = 0; j < 256; ++j) {
            const float kv = bf2f(memk[(size_t)(b * 256 + j) * 256 + h * 64 + lane]);
            const float sc = wave_sum(q * kv);
            const float mn = fmaxf(m, sc), corr = __expf(m - mn), pe = __expf(sc - mn);
            const float vv = bf2f(memvt[(size_t)(h * 64 + lane) * MEM_ROWS + b * 256 + j]);
            l = l * corr + pe; o = o * corr + pe * vv; m = mn;
        }
        mix[(size_t)token * DM + 768 + h * 64 + lane] = (bf16)f2bf(o / l);
    }
}

typedef short s16x4 __attribute__((ext_vector_type(4)));
template <bool NA>
__device__ __forceinline__ void attn16(int lane, const bf16* Q, int ldq, const bf16* Kb, int ldk, const bf16* Vt, int ldv, int ktok0, int trs, bf16* O, int ldo,
                                       const LAS float* rpb_h, int r, int r0, int jb, int band0) {
    const int qi = lane & 15, g = lane >> 4;
    bf16x8 qf[2];
#pragma unroll
    for (int ks = 0; ks < 2; ++ks) qf[ks] = *(const bf16x8*)(Q + (size_t)qi * ldq + ks * 32 + 8 * g);
    f32x4 s[16];
#pragma unroll
    for (int t = 0; t < 16; ++t) {
        const bf16* kp = Kb + (size_t)(ktok0 + (t >> 1) * trs + (t & 1) * 16 + qi) * ldk + 8 * g;
        const bf16x8 k0 = *(const bf16x8*)kp, k1 = *(const bf16x8*)(kp + 32);
        f32x4 z = {0.f, 0.f, 0.f, 0.f};
        z = __builtin_amdgcn_mfma_f32_16x16x32_bf16(k0, qf[0], z, 0, 0, 0);
        z = __builtin_amdgcn_mfma_f32_16x16x32_bf16(k1, qf[1], z, 0, 0, 0);
        s[t] = z;
    }
    constexpr float L2E = 1.4426950408889634f;
    float m = -INFINITY;
    if constexpr (NA) {
        const int qc = 16 * jb + qi, cs = min(max(qc - 8, 0), 48);
#pragma unroll
        for (int t = 0; t < 16; ++t)
#pragma unroll
            for (int i = 0; i < 4; ++i) {
                const int kc = band0 + 16 * (t & 1) + 4 * g + i; const bool ok = (kc >= cs) && (kc < cs + 16);
                float v = -INFINITY;
                if (ok) v = s[t][i] + rpb_h[(r0 + (t >> 1) - r + 7) * 31 + (kc - qc + 15)];
                s[t][i] = v; m = fmaxf(m, v);
            }
    } else {
#pragma unroll
        for (int t = 0; t < 16; ++t)
#pragma unroll
            for (int i = 0; i < 4; ++i) m = fmaxf(m, s[t][i]);
    }
    m = fmaxf(m, __shfl_xor(m, 16)); m = fmaxf(m, __shfl_xor(m, 32));
    const float mb = m * L2E; float l = 0.f;
    bf16x8 pf[8];
#pragma unroll
    for (int kk = 0; kk < 8; ++kk) {
        float p[8];
#pragma unroll
        for (int i = 0; i < 4; ++i) { p[i] = __builtin_amdgcn_exp2f(s[2 * kk][i] * L2E - mb); p[4 + i] = __builtin_amdgcn_exp2f(s[2 * kk + 1][i] * L2E - mb); }
#pragma unroll
        for (int i = 0; i < 8; ++i) l += p[i];
        v4u w; w.x = pk2(p[0], p[1]); w.y = pk2(p[2], p[3]); w.z = pk2(p[4], p[5]); w.w = pk2(p[6], p[7]);
        pf[kk] = __builtin_bit_cast(bf16x8, w);
    }
    l += __shfl_xor(l, 16); l += __shfl_xor(l, 32);
    const float inv = 1.0f / l;
#pragma unroll
    for (int mt = 0; mt < 4; ++mt) {
        f32x4 acc = {0.f, 0.f, 0.f, 0.f};
#pragma unroll
        for (int kk = 0; kk < 8; ++kk) {
            const bf16* vp = Vt + (size_t)(16 * mt + qi) * ldv + ktok0 + kk * trs + 4 * g;
            const s16x4 v0 = *(const s16x4*)vp, v1 = *(const s16x4*)(vp + 16);
            const bf16x8 vf = __builtin_shufflevector(v0, v1, 0, 1, 2, 3, 4, 5, 6, 7);
            acc = __builtin_amdgcn_mfma_f32_16x16x32_bf16(vf, pf[kk], acc, 0, 0, 0);
        }
        v2u w; w.x = pk2(acc[0] * inv, acc[1] * inv); w.y = pk2(acc[2] * inv, acc[3] * inv);
        *(v2u*)(O + (size_t)qi * ldo + 16 * mt + 4 * g) = w;
    }
}
__device__ __forceinline__ void memattn_item(int it, int lane, const bf16* act, int ld, int qoff, const bf16* memk, const bf16* memvt, bf16* mix) {
    const int tb = it >> 2, h = it & 3, tok0 = tb * 16, b = tok0 >> 12;
    attn16<false>(lane, act + (size_t)tok0 * ld + qoff + h * 64, ld, memk + h * 64, 256, memvt + (size_t)(h * 64) * MEM_ROWS, MEM_ROWS, b * 256, 32,
                  mix + (size_t)tok0 * DM + 768 + h * 64, DM, nullptr, 0, 0, 0, 0);
}
__device__ __forceinline__ void na_item(int it, int lane, const bf16* act0, const bf16* v0t, const LAS float* rpb, bf16* mix) {
    const int jb = it & 3, h = (it >> 2) % 12, br = (it >> 2) / 12, r = br & 63, b = br >> 6;
    const int r0 = min(max(r - 4, 0), 56), band0 = min(max(jb * 16 - 8, 0), 32);
    const int tok0 = b * SEQ + r * 64 + jb * 16;
    attn16<true>(lane, act0 + (size_t)tok0 * A0_LD + h * 64, A0_LD, act0 + 768 + h * 64, A0_LD, v0t + (size_t)(h * 64) * NT, NT, b * SEQ + r0 * 64 + band0, 64,
                 mix + (size_t)tok0 * DM + h * 64, DM, rpb + h * 465, r, r0, jb, band0);
}

__device__ __forceinline__ float logsigmoid(float x) { return fminf(x, 0.f) - log1pf(__expf(-fabsf(x))); }
__device__ __forceinline__ void gla_simple(const Frame& F, int item, const bf16* act1, const bf16* v1t, const float* wgk, const float* bgk, bf16* O) {
    const int b = item >> 3, h = (item >> 1) & 3, dir = item & 1, tid = F.tid;
    LAS float* sh = (LAS float*)F.lds;
    float S[96];
#pragma unroll
    for (int d = 0; d < 96; ++d) S[d] = 0.f;
    float wcol[16], bias = 0.f;
    if (tid < 96) {
#pragma unroll
        for (int r = 0; r < 16; ++r) wcol[r] = wgk[r * 384 + h * 96 + tid];
        bias = bgk[h * 96 + tid];
    }
    for (int tau = 0; tau < SEQ; ++tau) {
        const int token = b * SEQ + (dir ? (SEQ - 1 - tau) : tau);
        LAS float* cur = sh + (tau & 1) * 288;
        if (tid < 96) {
            const bf16* row = act1 + (size_t)token * A1_LD;
            float z = bias;
#pragma unroll
            for (int r = 0; r < 16; ++r) z += bf2f(row[1792 + dir * 16 + r]) * wcol[r];
            cur[tid] = __expf(logsigmoid(z) * (1.0f / 16.0f));
            cur[96 + tid] = bf2f(row[h * 96 + tid]) * 0.10206207261596575f;
            cur[192 + tid] = bf2f(row[384 + h * 96 + tid]);
        }
        __syncthreads();
        if (tid < 192) {
            const float v = bf2f(v1t[(size_t)(h * 192 + tid) * NT + token]);
            float o = 0.f;
            if (dir == 0) {
#pragma unroll
                for (int d = 0; d < 96; ++d) { S[d] = cur[d] * S[d] + cur[192 + d] * v; o += cur[96 + d] * S[d]; }
            } else {
#pragma unroll
                for (int d = 0; d < 96; ++d) { S[d] = cur[d] * S[d]; o += cur[96 + d] * S[d]; S[d] += cur[192 + d] * v; }
            }
            O[(size_t)token * 768 + h * 192 + tid] = (bf16)f2bf(o);
        }
    }
    __syncthreads();
}

__device__ __forceinline__ void gla_pre_item(int item, int wave, int lane, const bf16* act1, const float* W, const float* Bi, bf16* E) {
    const int n = item & 63, dir = (item >> 6) & 1, b = item >> 7, base = b * SEQ + n * 64;
    const int qi = lane & 15, g = lane >> 4;
    bf16x8 zf[4];
#pragma unroll
    for (int ct = 0; ct < 4; ++ct) { const int c = 16 * ct + qi, tok = dir ? base + 63 - c : base + c;
        bf16x8 z = {0, 0, 0, 0, 0, 0, 0, 0}; if (g < 2) z = *(const bf16x8*)(act1 + (size_t)tok * A1_LD + 1792 + dir * 16 + 8 * g); zf[ct] = z; }
#pragma unroll 1
    for (int jj = 0; jj < 3; ++jj) {
        const int j = 16 * (wave + 8 * jj) + qi;
        v4u wu = {0u, 0u, 0u, 0u};
        if (g < 2) { const float* wp = W + (size_t)(8 * g) * 384 + j;
            wu.x = pk2(wp[0], wp[384]); wu.y = pk2(wp[768], wp[1152]); wu.z = pk2(wp[1536], wp[1920]); wu.w = pk2(wp[2304], wp[2688]); }
        const bf16x8 wfr = __builtin_bit_cast(bf16x8, wu);
        const float bias = Bi[j]; float carry = 0.f;
#pragma unroll
        for (int ct = 0; ct < 4; ++ct) {
            f32x4 d = {0.f, 0.f, 0.f, 0.f};
            d = __builtin_amdgcn_mfma_f32_16x16x32_bf16(zf[ct], wfr, d, 0, 0, 0);
            float p[4];
#pragma unroll
            for (int i = 0; i < 4; ++i) { const float x = d[i] + bias; p[i] = (fminf(x, 0.f) - __logf(1.0f + __expf(-fabsf(x)))) * 0.0625f; }
            p[1] += p[0]; p[2] += p[1]; p[3] += p[2];
            float a = p[3]; float t = __shfl_up(a, 16); if (g >= 1) a += t; t = __shfl_up(a, 32); if (g >= 2) a += t;
            const float excl = a - p[3] + carry;
            carry += __shfl(a, 48 + qi);
#pragma unroll
            for (int i = 0; i < 4; ++i) { const int c = 16 * ct + 4 * g + i, tok = dir ? base + 63 - c : base + c;
                E[(size_t)tok * 384 + j] = (bf16)f2bf(__expf(excl + p[i])); }
        }
    }
}
constexpr int GL_QT = 0, GL_KT = 13312, GL_KDT = 26624, GL_VT = 40448, GL_DEC = 47360, GL_BUF = 49152;
__device__ __forceinline__ unsigned rev16(unsigned u) { return (u >> 16) | (u << 16); }
__device__ __forceinline__ void gla_main_item(const Frame& F, int item, const bf16* act1, const bf16* v1t, const bf16* Eall, bf16* OFp, bf16* OBp) {
    const int vs = item & 3, dir = (item >> 2) & 1, h = (item >> 3) & 3, b = item >> 5;
    const int tid = F.tid, lane = F.lane, wave = F.wave, qi = lane & 15, g = lane >> 4, ct = wave & 3, vh = wave >> 2;
    const bf16* E = Eall + (size_t)dir * NT * 384; bf16* O = dir ? OBp : OFp;
    LAS unsigned char* L = F.lds;
    const int pc = tid >> 3, pdg = tid & 7;
    f32x4 S[2][6];
#pragma unroll
    for (int vi = 0; vi < 2; ++vi)
#pragma unroll
        for (int dt = 0; dt < 6; ++dt) S[vi][dt] = (f32x4){0.f, 0.f, 0.f, 0.f};
    v2u rq[3], rk[3], re[3], rel[3]; v4u rv = {0u, 0u, 0u, 0u};
#define GL_LOAD(n_) do { const int nn_ = dir ? 63 - (n_) : (n_), base_ = b * SEQ + nn_ * 64, tokc_ = dir ? base_ + 63 - pc : base_ + pc, tokl_ = dir ? base_ : base_ + 63; \
        const bf16* ar_ = act1 + (size_t)tokc_ * A1_LD + h * 96 + 12 * pdg; const bf16* er_ = E + (size_t)tokc_ * 384 + h * 96 + 12 * pdg; const bf16* el_ = E + (size_t)tokl_ * 384 + h * 96 + 12 * pdg; \
        _Pragma("unroll") for (int j_ = 0; j_ < 3; ++j_) { rq[j_] = *(const v2u*)(ar_ + 4 * j_); rk[j_] = *(const v2u*)(ar_ + 384 + 4 * j_); re[j_] = *(const v2u*)(er_ + 4 * j_); rel[j_] = *(const v2u*)(el_ + 4 * j_); } \
        if (pc < 48) rv = *(const v4u*)(v1t + (size_t)(h * 192 + vs * 48 + pc) * NT + base_ + 8 * pdg); } while (0)
#define GL_PREP(bufo_) do { LAS unsigned char* B_ = L + (bufo_); \
        _Pragma("unroll") for (int j_ = 0; j_ < 3; ++j_) { float q_[4], k_[4], e_[4], l_[4], qt_[4], kt_[4], kd_[4]; \
            q_[0] = bflo(rq[j_].x); q_[1] = bfhi(rq[j_].x); q_[2] = bflo(rq[j_].y); q_[3] = bfhi(rq[j_].y); k_[0] = bflo(rk[j_].x); k_[1] = bfhi(rk[j_].x); k_[2] = bflo(rk[j_].y); k_[3] = bfhi(rk[j_].y); \
            e_[0] = bflo(re[j_].x); e_[1] = bfhi(re[j_].x); e_[2] = bflo(re[j_].y); e_[3] = bfhi(re[j_].y); l_[0] = bflo(rel[j_].x); l_[1] = bfhi(rel[j_].x); l_[2] = bflo(rel[j_].y); l_[3] = bfhi(rel[j_].y); \
            _Pragma("unroll") for (int i_ = 0; i_ < 4; ++i_) { const float inv_ = 1.0f / e_[i_]; qt_[i_] = q_[i_] * 0.10206207261596575f * e_[i_]; kt_[i_] = k_[i_] * inv_; kd_[i_] = kt_[i_] * l_[i_]; } \
            v2u w_; w_.x = pk2(qt_[0], qt_[1]); w_.y = pk2(qt_[2], qt_[3]); *(LAS v2u*)(B_ + GL_QT + pc * 208 + (12 * pdg + 4 * j_) * 2) = w_; \
            w_.x = pk2(kt_[0], kt_[1]); w_.y = pk2(kt_[2], kt_[3]); *(LAS v2u*)(B_ + GL_KT + pc * 208 + (12 * pdg + 4 * j_) * 2) = w_; \
            _Pragma("unroll") for (int i_ = 0; i_ < 4; ++i_) *(LAS bf16*)(B_ + GL_KDT + (12 * pdg + 4 * j_ + i_) * 144 + pc * 2) = (bf16)f2bf(kd_[i_]); \
            if (pc == 0) { f32x4 d_ = {l_[0], l_[1], l_[2], l_[3]}; *(LAS f32x4*)(B_ + GL_DEC + (12 * pdg + 4 * j_) * 4) = d_; } } \
        if (pc < 48) { v4u o_ = rv; int c0_ = 8 * pdg; if (dir) { o_.x = rev16(rv.w); o_.y = rev16(rv.z); o_.z = rev16(rv.y); o_.w = rev16(rv.x); c0_ = 56 - 8 * pdg; } \
            *(LAS v4u*)(B_ + GL_VT + pc * 144 + c0_ * 2) = o_; } } while (0)
    GL_LOAD(0);
    GL_PREP(0);
    GL_LOAD(1);
    __syncthreads();
#pragma unroll 1
    for (int n = 0; n < 64; ++n) {
        const int bo = (n & 1) * GL_BUF;
        if (n + 1 < 64) { GL_PREP(GL_BUF - bo); if (n + 2 < 64) GL_LOAD(n + 2); }
        LAS unsigned char* Bf = L + bo;
        bf16x8 qf[3];
#pragma unroll
        for (int ks = 0; ks < 3; ++ks) qf[ks] = *(const LAS bf16x8*)(Bf + GL_QT + (16 * ct + qi) * 208 + (32 * ks + 8 * g) * 2);
        f32x4 am[4];
#pragma unroll
        for (int tp = 0; tp < 4; ++tp) {
            f32x4 z = {0.f, 0.f, 0.f, 0.f};
            if (tp <= ct) {
#pragma unroll
                for (int ks = 0; ks < 3; ++ks) { const bf16x8 kf = *(const LAS bf16x8*)(Bf + GL_KT + (16 * tp + qi) * 208 + (32 * ks + 8 * g) * 2);
                    z = __builtin_amdgcn_mfma_f32_16x16x32_bf16(kf, qf[ks], z, 0, 0, 0); }
                const int c = 16 * ct + qi;
#pragma unroll
                for (int i = 0; i < 4; ++i) { const int cp = 16 * tp + 4 * g + i; const bool keep = (cp < c) || (dir == 0 && cp == c); z[i] = keep ? z[i] : 0.f; }
            }
            am[tp] = z;
        }
        bf16x8 pf[2];
#pragma unroll
        for (int kk = 0; kk < 2; ++kk) { v4u w; w.x = pk2(am[2 * kk][0], am[2 * kk][1]); w.y = pk2(am[2 * kk][2], am[2 * kk][3]); w.z = pk2(am[2 * kk + 1][0], am[2 * kk + 1][1]); w.w = pk2(am[2 * kk + 1][2], am[2 * kk + 1][3]);
            pf[kk] = __builtin_bit_cast(bf16x8, w); }
        bf16x8 qp[3];
#pragma unroll
        for (int kk = 0; kk < 3; ++kk) { const LAS unsigned char* qr = Bf + GL_QT + (16 * ct + qi) * 208 + (32 * kk + 4 * g) * 2;
            const s16x4 a0 = *(const LAS s16x4*)qr, a1 = *(const LAS s16x4*)(qr + 32); qp[kk] = __builtin_shufflevector(a0, a1, 0, 1, 2, 3, 4, 5, 6, 7); }
        const int nn = dir ? 63 - n : n, base = b * SEQ + nn * 64, c = 16 * ct + qi, tok = dir ? base + 63 - c : base + c;
#pragma unroll
        for (int vi = 0; vi < 2; ++vi) {
            if (vi == 1 && vh == 1) break;
            const int vt = 2 * vh + vi;
            f32x4 acc = {0.f, 0.f, 0.f, 0.f};
#pragma unroll
            for (int kk = 0; kk < 2; ++kk) { const LAS unsigned char* vr = Bf + GL_VT + (16 * vt + qi) * 144 + (32 * kk + 4 * g) * 2;
                const s16x4 a0 = *(const LAS s16x4*)vr, a1 = *(const LAS s16x4*)(vr + 32); const bf16x8 vf = __builtin_shufflevector(a0, a1, 0, 1, 2, 3, 4, 5, 6, 7);
                acc = __builtin_amdgcn_mfma_f32_16x16x32_bf16(vf, pf[kk], acc, 0, 0, 0); }
#pragma unroll
            for (int kk = 0; kk < 3; ++kk) { v4u w; w.x = pk2(S[vi][2 * kk][0], S[vi][2 * kk][1]); w.y = pk2(S[vi][2 * kk][2], S[vi][2 * kk][3]); w.z = pk2(S[vi][2 * kk + 1][0], S[vi][2 * kk + 1][1]); w.w = pk2(S[vi][2 * kk + 1][2], S[vi][2 * kk + 1][3]);
                acc = __builtin_amdgcn_mfma_f32_16x16x32_bf16(__builtin_bit_cast(bf16x8, w), qp[kk], acc, 0, 0, 0); }
            v2u w; w.x = pk2(acc[0], acc[1]); w.y = pk2(acc[2], acc[3]);
            *(v2u*)(O + (size_t)tok * 768 + h * 192 + vs * 48 + 16 * vt + 4 * g) = w;
            bf16x8 vfr[2];
#pragma unroll
            for (int ks = 0; ks < 2; ++ks) vfr[ks] = *(const LAS bf16x8*)(Bf + GL_VT + (16 * vt + qi) * 144 + (32 * ks + 8 * g) * 2);
#pragma unroll
            for (int dt = 0; dt < 6; ++dt) {
                const f32x4 dec = *(const LAS f32x4*)(Bf + GL_DEC + (16 * dt + 4 * g) * 4);
                f32x4 sv = S[vi][dt]; sv[0] *= dec[0]; sv[1] *= dec[1]; sv[2] *= dec[2]; sv[3] *= dec[3];
#pragma unroll
                for (int ks = 0; ks < 2; ++ks) { const bf16x8 kdf = *(const LAS bf16x8*)(Bf + GL_KDT + (16 * dt + qi) * 144 + (32 * ks + 8 * g) * 2);
                    sv = __builtin_amdgcn_mfma_f32_16x16x32_bf16(kdf, vfr[ks], sv, 0, 0, 0); }
                S[vi][dt] = sv;
            }
        }
        __syncthreads();
    }
#undef GL_LOAD
#undef GL_PREP
}

__device__ __forceinline__ void gla_combine(const Frame& F, const bf16* OF, const bf16* OB, const bf16* act1, const float* gnorm, bf16* mix) {
    for (int token = F.gw; token < NT; token += F.NGW) {
        const int lane = F.lane;
#pragma unroll
        for (int h = 0; h < 4; ++h) {
            float o[3]; float ss = 0.f;
#pragma unroll
            for (int j = 0; j < 3; ++j) { const size_t idx = (size_t)token * 768 + h * 192 + j * 64 + lane; o[j] = bf2f(OF[idx]) + bf2f(OB[idx]); ss += o[j] * o[j]; }
            ss = wave_sum(ss);
            const float rs = 1.0f / sqrtf(ss * (1.0f / 192.0f) + EPS);
#pragma unroll
            for (int j = 0; j < 3; ++j) { const int dv = j * 64 + lane; const float g = bf2f(act1[(size_t)token * A1_LD + 768 + h * 192 + dv]);
                const float val = o[j] * rs * gnorm[dv] * (g / (1.0f + __expf(-g)));
                mix[(size_t)token * DM + h * 192 + dv] = (bf16)f2bf(val); }
        }
    }
}
__device__ __forceinline__ void route1(const Frame& F, const float* H, const float* gain, const float* wr, int* topi, float* topw, int* cnt) {
    LAS int* lc = (LAS int*)F.lds;
    if (F.tid < 16) lc[F.tid] = 0;
    __syncthreads();
    for (int j = 0; j < 16; ++j) {
        const int token = F.bid * 128 + F.wave * 16 + j, lane = F.lane;
        const float* hr = H + (size_t)token * DM;
        float acc[8], ss = 0.f;
#pragma unroll
        for (int e = 0; e < 8; ++e) acc[e] = 0.f;
#pragma unroll 4
        for (int i = 0; i < 16; ++i) { const int k = i * 64 + lane; const float x = hr[k]; ss += x * x; const float xg = x * gain[k];
            const f32x4 w0 = *(const f32x4*)(wr + k * 8), w1 = *(const f32x4*)(wr + k * 8 + 4);
            acc[0] += xg * w0.x; acc[1] += xg * w0.y; acc[2] += xg * w0.z; acc[3] += xg * w0.w; acc[4] += xg * w1.x; acc[5] += xg * w1.y; acc[6] += xg * w1.z; acc[7] += xg * w1.w; }
        ss = wave_sum(ss); const float rs = 1.0f / sqrtf(ss * (1.0f / DM) + EPS);
#pragma unroll
        for (int e = 0; e < 8; ++e) acc[e] = wave_sum(acc[e]) * rs;
        if (lane == 0) {
            int e0 = 0; float l0 = acc[0];
#pragma unroll
            for (int e = 1; e < 8; ++e) if (acc[e] > l0) { l0 = acc[e]; e0 = e; }
            int e1 = -1; float l1 = -INFINITY;
#pragma unroll
            for (int e = 0; e < 8; ++e) if (e != e0 && acc[e] > l1) { l1 = acc[e]; e1 = e; }
            const float w0 = 1.0f / (1.0f + __expf(l1 - l0));
            topi[token] = e0 | (e1 << 8); topw[2 * token] = w0; topw[2 * token + 1] = 1.0f - w0;
            atomicAdd((int*)&lc[e0], 1); atomicAdd((int*)&lc[8 + e1], 1);
        }
    }
    __syncthreads();
    if (F.tid < 16) cnt[F.bid * 16 + F.tid] = lc[F.tid];
    __syncthreads();
}
__device__ __forceinline__ void route2(const Frame& F, const int* topi, const float* topw, const int* cnt, int* stok, float* sw, int* blk) {
    LAS int* part = (LAS int*)F.lds;
    LAS int* base = part + 1024;
    LAS int* tk = base + 64;
    const int tid = F.tid, pe = tid & 15, jg = tid >> 4;
    int below = 0, tot = 0;
    for (int w = jg; w < F.G; w += 32) { const int v = cnt[w * 16 + pe]; tot += v; if (w < F.bid) below += v; }
    part[jg * 16 + pe] = below; part[512 + jg * 16 + pe] = tot;
    if (tid < 128) tk[tid] = topi[F.bid * 128 + tid];
    __syncthreads();
    if (tid < 16) { int b = 0, t = 0; for (int j = 0; j < 32; ++j) { b += part[j * 16 + tid]; t += part[512 + j * 16 + tid]; } base[tid] = b; base[16 + tid] = t; }
    __syncthreads();
    if (tid < 2) { int ps = 0; for (int e = 0; e < 8; ++e) { base[32 + tid * 8 + e] = ps; ps += (base[16 + tid * 8 + e] + 255) / 256 * 256; } base[48 + tid] = ps / 256; }
    __syncthreads();
    if (tid < 256) {
        const int p = tid >> 7, i = tid & 127; const int e = (tk[i] >> (8 * p)) & 0xff;
        int rank = 0; for (int j = 0; j < i; ++j) rank += (((tk[j] >> (8 * p)) & 0xff) == e) ? 1 : 0;
        const int slot = base[32 + p * 8 + e] + base[p * 8 + e] + rank; const int token = F.bid * 128 + i;
        stok[p * SLOT_CAP + slot] = token; sw[p * SLOT_CAP + slot] = topw[2 * token + p];
    }
    if (F.bid < 16) {
        const int p = F.bid >> 3, e = F.bid & 7, ps = base[32 + F.bid], t = base[16 + F.bid], pend = ps + (t + 255) / 256 * 256;
        for (int s = ps + t + tid; s < pend; s += NTHR) { stok[p * SLOT_CAP + s] = -1; sw[p * SLOT_CAP + s] = 0.f; }
        for (int bk = ps / 256 + tid; bk < pend / 256; bk += NTHR) blk[16 + p * 256 + bk] = e;
        if (e == 0 && tid == 0) blk[p] = base[48 + p];
    }
    __syncthreads();
}
__device__ __forceinline__ void final_norm(const Frame& F, float* H, const float* gain) {
    for (int row = F.gw; row < NT; row += F.NGW) {
        GAS f32x4* xr = (GAS f32x4*)(H + (size_t)row * DM) + F.lane; const f32x4* gr = (const f32x4*)gain + F.lane;
        f32x4 v[4]; float s = 0.f;
#pragma unroll
        for (int j = 0; j < 4; ++j) { v[j] = xr[64 * j]; s += (v[j].x * v[j].x + v[j].y * v[j].y) + (v[j].z * v[j].z + v[j].w * v[j].w); }
        s = wave_sum(s); const float rs = 1.0f / sqrtf(s * (1.0f / DM) + EPS);
#pragma unroll
        for (int j = 0; j < 4; ++j) { const f32x4 g = gr[64 * j]; f32x4 o = {v[j].x * rs * g.x, v[j].y * rs * g.y, v[j].z * rs * g.z, v[j].w * rs * g.w}; xr[64 * j] = o; }
    }
}

constexpr int N_PHASES = 17;
__global__ void __launch_bounds__(NTHR, 2) mega(Args args) {
    extern __shared__ __attribute__((aligned(16))) unsigned char lds_raw[];
    Frame F;
    F.lds = (LAS unsigned char*)lds_raw;
    F.tid = threadIdx.x; F.lane = F.tid & 63; F.wave = __builtin_amdgcn_readfirstlane(F.tid >> 6);
    F.G = gridDim.x; F.bid = blockIdx.x; F.gw = F.bid * NWAVES + F.wave; F.NGW = F.G * NWAVES; F.ws = args.ws;
    unsigned char* ws = args.ws;
    gu32* ctl = (gu32*)(ws + WS_CTL);
    volatile LAS unsigned* MISC = (volatile LAS unsigned*)(F.lds + MISC_OFF);
    for (int u = F.tid; u < (LDS_BYTES - LDSCTL_OFF) / 4; u += NTHR) ((LAS unsigned*)(F.lds + LDSCTL_OFF))[u] = 0u;
    __syncthreads();
    XcdBarrier bar = xcd_barrier_post((unsigned*)(ctl + CW_BAR), MISC + 8);
    const int lo = args.ph_lo, hi = args.ph_hi;
#ifndef PH_MASK
#define PH_MASK 0x1ffff
#endif
#define IN(k) (((PH_MASK >> (k)) & 1) && lo <= (k) && (k) < hi)
#define SEAM(k) do { if (IN(k) && IN((k) + 1)) xcd_barrier(bar); } while (0)

    float* H = args.out;
    float* rss = (float*)(ws + WS_RSS); float* mrss = (float*)(ws + WS_MRSS);
    bf16* hbf = (bf16*)(ws + WS_HBF); bf16* membf = (bf16*)(ws + WS_MEMBF); bf16* memk = (bf16*)(ws + WS_MEMK); bf16* memvt = (bf16*)(ws + WS_MEMVT);
    bf16* act0 = (bf16*)(ws + WS_ACT0); bf16* v0t = (bf16*)(ws + WS_V0T); bf16* mix = (bf16*)(ws + WS_MIX); bf16* hmid0 = (bf16*)(ws + WS_HMID0);
    bf16* act1 = (bf16*)(ws + WS_ACT1); bf16* v1t = (bf16*)(ws + WS_V1T); bf16* OF = (bf16*)(ws + WS_OF); bf16* OB = (bf16*)(ws + WS_OB);
    bf16* hmid1 = (bf16*)(ws + WS_HMID1); bf16* wgu = (bf16*)(ws + WS_WGU); bf16* wdn = (bf16*)(ws + WS_WDN);
    int* cnt = (int*)(ws + WS_CNT); int* topi = (int*)(ws + WS_TOPI); float* topw = (float*)(ws + WS_TOPW);
    int* stok = (int*)(ws + WS_STOK); float* sw = (float*)(ws + WS_SW); int* blk = (int*)(ws + WS_BLK);
    LAS float* scr = (LAS float*)(F.lds + F.wave * 16384);

    if (IN(0)) {
        int it = F.gw;
#define CVT(Wp, Kd, Nd, WTp, gainp, kind) do { const CvtJob J{Wp, Kd, Nd, (bf16*)(WTp), gainp, kind}; const int n_ = ((Kd) / 64) * ((Nd) / 32); \
            for (; it < n_; it += F.NGW) cvt_job_item(J, it, scr, F.lane); it -= n_; } while (0)
        CVT(args.in[I_EWIN], 1024, 2560, ws + WS_W0IN, args.in[I_EN1], 1);
        CVT(args.in[I_EWIN], 1024, 2560, ws + WS_WV0, args.in[I_EN1], 2);
        CVT(args.in[I_EWOUT], 1024, 1024, ws + WS_W0OUT, nullptr, 0);
        CVT(args.in[I_EWG], 1024, 2816, ws + WS_W0GU, args.in[I_EN2], 3);
        CVT(args.in[I_EWU], 1024, 2816, ws + WS_W0GU, args.in[I_EN2], 4);
        CVT(args.in[I_EWD], 2816, 1024, ws + WS_W0DN, nullptr, 0);
        CVT(args.in[I_WMKV], 1024, 512, ws + WS_WMEM, args.in[I_MNORM], 0);
        CVT(args.in[I_OWIN], 1024, 2592, ws + WS_W1IN, args.in[I_ON1], 5);
        CVT(args.in[I_OWIN], 1024, 2592, ws + WS_WV1, args.in[I_ON1], 6);
        CVT(args.in[I_OWOUT], 1024, 1024, ws + WS_W1OUT, nullptr, 0);
#undef CVT
        { v4u z = {0u, 0u, 0u, 0u}; v4u* p = (v4u*)(ws + WS_W1IN + (size_t)1824 * 2048); const int n16 = 224 * 2048 / 16;
          for (int i = F.bid * NTHR + F.tid; i < n16; i += F.G * NTHR) p[i] = z; }
        for (int m = F.gw; m < NT; m += F.NGW) row_to_bf16(args.in[I_X] + (size_t)m * DM, hbf + (size_t)m * DM, rss + (size_t)m * 16, F.lane);
        for (int m = F.gw; m < MEM_ROWS; m += F.NGW) row_to_bf16(args.in[I_MEM] + (size_t)m * DM, membf + (size_t)m * DM, mrss + (size_t)m * 16, F.lane);
    }
    SEAM(0);
    if (IN(1)) {
        { Sched S; S.init(hbf, ws + WS_W0IN, 1024, 128, 7, F.G, F.bid); EpiRowScale E{act0, A0_LD, rss}; gemm_run<EpiRowScale, false>(F.lds, S, E, nullptr); }
        { Sched S; S.init(ws + WS_WV0, hbf, 1024, 3, 128, F.G, (F.bid + 128) % F.G); EpiColScale E{v0t, NT, rss}; gemm_run<EpiColScale, false>(F.lds, S, E, nullptr); }
        { Sched S; S.init(membf, ws + WS_WMEM, 1024, 8, 1, F.G, F.bid); EpiRowScale E{memk, 256, mrss}; gemm_run<EpiRowScale, false>(F.lds, S, E, nullptr); }
        { Sched S; S.init(ws + WS_WMEM + 256 * 2048, membf, 1024, 1, 8, F.G, (F.bid + 248) % F.G); EpiColScale E{memvt, MEM_ROWS, mrss}; gemm_run<EpiColScale, false>(F.lds, S, E, nullptr); }
    }
    SEAM(1);
    if (IN(2)) {
#if FAST_ATT
        { LAS float* rl = (LAS float*)F.lds; for (int i = F.tid; i < 5580; i += NTHR) rl[i] = args.in[I_RPB][i]; __syncthreads();
          for (int it = F.gw; it < 32768; it += F.NGW) { if (it < 24576) na_item(it, F.lane, act0, v0t, rl, mix); else memattn_item(it - 24576, F.lane, act0, A0_LD, 1536, memk, memvt, mix); }
          __syncthreads(); }
#else
        na_simple(F, act0, v0t, args.in[I_RPB], mix);
        memattn_simple(F, F.gw, F.NGW, act0, A0_LD, 1536, memk, memvt, mix);
#endif
    }
    SEAM(2);
    if (IN(3)) { Sched S; S.init(mix, ws + WS_W0OUT, 1024, 128, 4, F.G, F.bid); EpiResid E{args.in[I_X], H, hbf, rss}; gemm_run<EpiResid, false>(F.lds, S, E, nullptr); }
    SEAM(3);
    if (IN(4)) { Sched S; S.init(hbf, ws + WS_W0GU, 1024, 128, 22, F.G, F.bid); EpiSwiGLU E{hmid0, FF0, rss, nullptr}; gemm_run<EpiSwiGLU, false>(F.lds, S, E, nullptr); }
    SEAM(4);
    if (IN(5)) { Sched S; S.init(hmid0, ws + WS_W0DN, FF0, 128, 4, F.G, F.bid); EpiResid E{H, H, hbf, rss}; gemm_run<EpiResid, false>(F.lds, S, E, nullptr); }
    SEAM(5);
    if (IN(6)) {
        { Sched S; S.init(hbf, ws + WS_W1IN, 1024, 128, 8, F.G, F.bid); EpiRowScale E{act1, A1_LD, rss}; gemm_run<EpiRowScale, false>(F.lds, S, E, nullptr); }
        { Sched S; S.init(ws + WS_WV1, hbf, 1024, 3, 128, F.G, F.bid); EpiColScale E{v1t, NT, rss}; gemm_run<EpiColScale, false>(F.lds, S, E, nullptr); }
    }
    SEAM(6);
    if (IN(7)) {
#if FAST_GLA
        for (int it = F.bid; it < 1024; it += F.G) { const int dir = (it >> 6) & 1;
            gla_pre_item(it, F.wave, F.lane, act1, dir ? args.in[I_WGKB] : args.in[I_WGKF], dir ? args.in[I_BGKB] : args.in[I_BGKF], (bf16*)(ws + WS_E) + (size_t)dir * NT * 384); }
        for (int it = F.gw; it < 8192; it += F.NGW) memattn_item(it, F.lane, act1, A1_LD, 1536, memk, memvt, mix);
        xcd_barrier(bar);
        for (int it = F.bid; it < 256; it += F.G) gla_main_item(F, it, act1, v1t, (const bf16*)(ws + WS_E), OF, OB);
#else
        if (F.bid < 64) {
            const int dir = F.bid & 1;
            gla_simple(F, F.bid, act1, v1t, dir ? args.in[I_WGKB] : args.in[I_WGKF], dir ? args.in[I_BGKB] : args.in[I_BGKF], dir ? OB : OF);
        } else {
#if FAST_ATT
            for (int it = (F.bid - 64) * NWAVES + F.wave; it < 8192; it += (F.G - 64) * NWAVES) memattn_item(it, F.lane, act1, A1_LD, 1536, memk, memvt, mix);
#else
            memattn_simple(F, (F.bid - 64) * NWAVES + F.wave, (F.G - 64) * NWAVES, act1, A1_LD, 1536, memk, memvt, mix);
#endif
        }
#endif
    }
    SEAM(7);
    if (IN(8)) gla_combine(F, OF, OB, act1, args.in[I_GNORM], mix);
    SEAM(8);
    if (IN(9)) { Sched S; S.init(mix, ws + WS_W1OUT, 1024, 128, 4, F.G, F.bid); EpiResid E{H, H, hbf, rss}; gemm_run<EpiResid, false>(F.lds, S, E, nullptr); }
    SEAM(9);
    if (IN(10)) {
        route1(F, H, args.in[I_ON2], args.in[I_WR], topi, topw, cnt);
        for (int it = F.gw; it < 8 * 3 * 1792; it += F.NGW) {
            const int e = it / 5376, r = it % 5376, which = r / 1792, item = r % 1792;
            if (which == 0) { CvtJob J{args.in[I_OWG] + (size_t)e * 1024 * FFE, 1024, FFE, wgu + (size_t)e * 7168 * 1024, args.in[I_ON2], 3}; cvt_job_item(J, item, scr, F.lane); }
            else if (which == 1) { CvtJob J{args.in[I_OWU] + (size_t)e * 1024 * FFE, 1024, FFE, wgu + (size_t)e * 7168 * 1024, args.in[I_ON2], 4}; cvt_job_item(J, item, scr, F.lane); }
            else { CvtJob J{args.in[I_OWD] + (size_t)e * FFE * 1024, FFE, 1024, wdn + (size_t)e * 1024 * FFE, nullptr, 0}; cvt_job_item(J, item, scr, F.lane); }
        }
    }
    SEAM(10);
    if (IN(11)) route2(F, topi, topw, cnt, stok, sw, blk);
    SEAM(11);
    if (IN(12)) { const int nb = blk[0]; Sched S; S.init(hbf, wgu, 1024, nb, 28, F.G, F.bid, blk + 16, (size_t)7168 * 1024 * 2);
        EpiSwiGLU E{hmid1, FFE, rss, stok}; gemm_run<EpiSwiGLU, true>(F.lds, S, E, stok); }
    SEAM(12);
    if (IN(13)) { const int nb = blk[0]; Sched S; S.init(hmid1, wdn, FFE, nb, 4, F.G, F.bid, blk + 16, (size_t)1024 * FFE * 2);
        EpiMoeDown E{H, stok, sw}; gemm_run<EpiMoeDown, false>(F.lds, S, E, nullptr); }
    SEAM(13);
    if (IN(14)) { const int nb = blk[1]; Sched S; S.init(hbf, wgu, 1024, nb, 28, F.G, F.bid, blk + 16 + 256, (size_t)7168 * 1024 * 2);
        EpiSwiGLU E{hmid1, FFE, rss, stok + SLOT_CAP}; gemm_run<EpiSwiGLU, true>(F.lds, S, E, stok + SLOT_CAP); }
    SEAM(14);
    if (IN(15)) { const int nb = blk[1]; Sched S; S.init(hmid1, wdn, FFE, nb, 4, F.G, F.bid, blk + 16 + 256, (size_t)1024 * FFE * 2);
        EpiMoeDown E{H, stok + SLOT_CAP, sw + SLOT_CAP}; gemm_run<EpiMoeDown, false>(F.lds, S, E, nullptr); }
    SEAM(15);
    if (IN(16)) final_norm(F, H, args.in[I_FNORM]);
#undef IN
#undef SEAM
}

extern "C" void kernel_launch(void* const* d_in, const int* in_sizes, int n_in, void* d_out, int out_size, void* d_ws, size_t ws_size, hipStream_t stream) {
    static int grid = 0;
    if (grid == 0) {
        if (n_in != 26 || out_size != NT * DM || ws_size < WS_END) { fprintf(stderr, "kernel_launch: unexpected problem (n_in %d out %d ws %zu need %zu)\n", n_in, out_size, ws_size, (size_t)WS_END); grid = -1; return; }
        int dev = 0, cus = 0, per_cu = 0;
        if (hipGetDevice(&dev) != hipSuccess || hipDeviceGetAttribute(&cus, hipDeviceAttributeMultiprocessorCount, dev) != hipSuccess) { grid = -1; return; }
        if (hipFuncSetAttribute((const void*)mega, hipFuncAttributeMaxDynamicSharedMemorySize, LDS_BYTES) != hipSuccess) { fprintf(stderr, "kernel_launch: hipFuncSetAttribute failed\n"); grid = -1; return; }
        if (hipOccupancyMaxActiveBlocksPerMultiprocessor(&per_cu, (const void*)mega, NTHR, LDS_BYTES) != hipSuccess || per_cu < 1) fprintf(stderr, "kernel_launch: occupancy query reports %d\n", per_cu);
        (void)hipGetLastError();
        grid = cus;
        if (grid != 256) fprintf(stderr, "kernel_launch: note: %d CUs\n", grid);
    }
    if (grid < 0) return;
    if (hipMemsetAsync((char*)d_ws + WS_CTL, 0, CTL_ZERO_BYTES, stream) != hipSuccess) return;
    Args a{};
    for (int i = 0; i < 26; ++i) a.in[i] = (const float*)d_in[i];
    a.out = (float*)d_out; a.ws = (unsigned char*)d_ws;
#if MK_FUSED
    a.ph_lo = 0; a.ph_hi = N_PHASES;
    hipLaunchKernelGGL(mega, dim3(grid), dim3(NTHR), LDS_BYTES, stream, a);
#else
    for (int p = 0; p < N_PHASES; ++p) { a.ph_lo = p; a.ph_hi = p + 1; hipLaunchKernelGGL(mega, dim3(grid), dim3(NTHR), LDS_BYTES, stream, a); }
#endif
}
```

```cpp
#include <hip/hip_runtime.h>
#include <cstdio>
#include <cstdint>

#ifndef MK_FUSED
#define MK_FUSED 1
#endif
#ifndef FAST_GEMM
#define FAST_GEMM 1
#endif
#ifndef FAST_ATT
#define FAST_ATT 1
#endif
#ifndef FAST_GLA
#define FAST_GLA 1
#endif

#define GAS __attribute__((address_space(1)))
#define LAS __attribute__((address_space(3)))
typedef unsigned short bf16;
typedef unsigned v4u __attribute__((ext_vector_type(4)));
typedef unsigned v2u __attribute__((ext_vector_type(2)));
typedef float f32x4 __attribute__((ext_vector_type(4)));
typedef short bf16x8 __attribute__((ext_vector_type(8)));
typedef GAS unsigned gu32;
#define RLX_AGENT __ATOMIC_RELAXED, __HIP_MEMORY_SCOPE_AGENT
#define LDS_WAIT() asm volatile("s_waitcnt lgkmcnt(0)" ::: "memory")
#define VM_WAIT() asm volatile("s_waitcnt vmcnt(0)" ::: "memory")

constexpr int NT = 32768, DM = 1024, SEQ = 4096, NB = 8;
constexpr int MEM_ROWS = 2048;
constexpr int A0_LD = 1792;
constexpr int A1_LD = 2048;
constexpr int FF0 = 2816, FFE = 3584, NEXP = 8;
constexpr int SLOT_CAP = 34816;
constexpr float EPS = 1e-6f;
constexpr int NWAVES = 8, NTHR = 512;

constexpr size_t MiB = 1u << 20;
constexpr size_t WS_CTL = 0, CTL_ZERO_BYTES = 1 * MiB;
constexpr size_t WS_RSS = 1 * MiB;
constexpr size_t WS_MRSS = 3 * MiB;
constexpr size_t WS_CNT = 3 * MiB + 256 * 1024;
constexpr size_t WS_TOPI = 3 * MiB + 512 * 1024;
constexpr size_t WS_TOPW = 3 * MiB + 768 * 1024;
constexpr size_t WS_STOK = 4 * MiB;
constexpr size_t WS_SW = 4 * MiB + 512 * 1024;
constexpr size_t WS_BLK = 5 * MiB;
constexpr size_t WS_W0IN = 6 * MiB;
constexpr size_t WS_WV0 = WS_W0IN + 1792 * 2048;
constexpr size_t WS_W0OUT = 11 * MiB;
constexpr size_t WS_W0GU = 13 * MiB;
constexpr size_t WS_W0DN = 24 * MiB;
constexpr size_t WS_WMEM = WS_W0DN + 1024 * 2816 * 2;
constexpr size_t WS_W1IN = 31 * MiB;
constexpr size_t WS_WV1 = 35 * MiB;
constexpr size_t WS_W1OUT = 37 * MiB - 512 * 1024;
constexpr size_t WS_HBF = 39 * MiB;
constexpr size_t WS_MEMBF = 103 * MiB;
constexpr size_t WS_MEMK = 107 * MiB;
constexpr size_t WS_MEMVT = 108 * MiB;
constexpr size_t WS_ACT = 109 * MiB;
constexpr size_t WS_ACT0 = WS_ACT;
constexpr size_t WS_V0T = WS_ACT + 112 * MiB;
constexpr size_t WS_MIX = WS_ACT + 176 * MiB;
constexpr size_t WS_HMID0 = WS_ACT;
constexpr size_t WS_ACT1 = WS_ACT;
constexpr size_t WS_V1T = WS_ACT + 128 * MiB;
constexpr size_t WS_OF = WS_ACT + 240 * MiB;
constexpr size_t WS_OB = WS_ACT + 288 * MiB;
constexpr size_t WS_E = WS_ACT + 336 * MiB;
constexpr size_t WS_HMID1 = WS_ACT;
constexpr size_t WS_WGU = WS_ACT + 240 * MiB;
constexpr size_t WS_WDN = WS_ACT + 352 * MiB;
constexpr size_t WS_END = WS_ACT + 408 * MiB;
static_assert(WS_W1OUT + 2 * MiB <= WS_HBF && WS_WV1 + 768 * 2048 <= WS_W1OUT && WS_W1IN + 4 * MiB <= WS_WV1 && WS_WMEM + MiB <= WS_W1IN, "weight map");
static_assert(WS_W0GU + 11 * MiB <= WS_W0DN && WS_WV0 + 768 * 2048 <= WS_W0OUT, "weight map 2");
static_assert((size_t)SLOT_CAP * 3584 * 2 <= 240 * MiB, "hmid1");

constexpr int CW_TMO = 0, CW_CODE = 1, CW_BAR = 4096;

constexpr int RING_BYTES = 131072;
constexpr int LDSCTL_OFF = RING_BYTES, MISC_OFF = LDSCTL_OFF + 320;
constexpr int LDS_BYTES = 147456;

__device__ __forceinline__ unsigned f2bf(float f) { unsigned u = __builtin_bit_cast(unsigned, f); return (u + 0x7fffu + ((u >> 16) & 1u)) >> 16; }
__device__ __forceinline__ unsigned pk2(float lo, float hi) { return f2bf(lo) | (f2bf(hi) << 16); }
__device__ __forceinline__ float bf2f(bf16 b) { return __builtin_bit_cast(float, (unsigned)b << 16); }
__device__ __forceinline__ float bflo(unsigned u) { return __builtin_bit_cast(float, u << 16); }
__device__ __forceinline__ float bfhi(unsigned u) { return __builtin_bit_cast(float, u & 0xffff0000u); }
__device__ __forceinline__ float wave_sum(float v) {
#pragma unroll
    for (int o = 1; o < 64; o <<= 1) v += __shfl_xor(v, o);
    return v;
}
__device__ __forceinline__ float wave_max(float v) {
#pragma unroll
    for (int o = 1; o < 64; o <<= 1) v = fmaxf(v, __shfl_xor(v, o));
    return v;
}

#define XB_TMO      128
#define XB_XCNT(j)  (256  + 64 * (j))
#define XB_XSUB(j)  (1280 + 64 * (j))
#define XB_XGEN(j)  (2304 + 64 * (j))
#define XB_TOP      3328
#define XB_TOPGEN   3392
#define XCD_BAR_WORDS 3456
#define XB_SPIN_CAP (1u << 22)

__device__ __forceinline__ unsigned xb_ld(unsigned* p)              { return __hip_atomic_load(p, __ATOMIC_RELAXED, __HIP_MEMORY_SCOPE_AGENT); }
__device__ __forceinline__ unsigned xb_add(unsigned* p, unsigned v) { return __hip_atomic_fetch_add(p, v, __ATOMIC_RELAXED, __HIP_MEMORY_SCOPE_AGENT); }
__device__ __forceinline__ unsigned xb_xcc_id() { return (unsigned)__builtin_amdgcn_s_getreg((3 << 11) | 20) & 0xFu; }
#define XB_SPIN(cond, bar) do { unsigned _sp = 0; while (cond) { __builtin_amdgcn_s_sleep(1); \
    if ((++_sp & 255u) == 0u) { if (xb_ld(&(bar)[XB_TMO])) break; if (_sp > XB_SPIN_CAP) { atomicAdd(&(bar)[XB_TMO], 1u); break; } } } } while (0)

struct XcdBarrier { unsigned* bar; unsigned x; volatile LAS unsigned* st; };

__device__ __forceinline__ XcdBarrier xcd_barrier_post(unsigned* bar, volatile LAS unsigned* st) {
    XcdBarrier b; b.bar = bar; b.x = xb_xcc_id(); b.st = st;
    if (threadIdx.x == 0) (void)xb_add(&bar[XB_XCNT(b.x)], 1u);
    return b;
}
__device__ __forceinline__ void xcd_barrier_complete(unsigned* bar, unsigned x, unsigned& nloc, unsigned& nx) {
    const unsigned G = gridDim.x * gridDim.y * gridDim.z;
    unsigned sum, cnt, mine, sp = 0u;
    for (;;) {
        sum = 0u; cnt = 0u; mine = 0u;
#pragma unroll
        for (unsigned j = 0; j < 16; ++j) { const unsigned c = xb_ld(&bar[XB_XCNT(j)]); sum += c; cnt += (c > 0u) ? 1u : 0u; mine = (j == x) ? c : mine; }
        if (sum == G) break;
        __builtin_amdgcn_s_sleep(1);
        if ((++sp & 255u) == 0u) { if (xb_ld(&bar[XB_TMO])) break; if (sp > XB_SPIN_CAP) { atomicAdd(&bar[XB_TMO], 1u); break; } }
    }
    nloc = mine > 0u ? mine : 1u; nx = cnt > 0u ? cnt : 1u;
}
__device__ __forceinline__ void xcd_barrier(const XcdBarrier& b) {
    asm volatile("s_waitcnt vmcnt(0)" ::: "memory");
    __syncthreads();
    if (threadIdx.x == 0) {
        unsigned* bar = b.bar;
        __builtin_amdgcn_s_waitcnt(0);
        unsigned nloc = b.st[0], nx = b.st[1];
        if (nloc == 0u) { xcd_barrier_complete(bar, b.x, nloc, nx); b.st[0] = nloc; b.st[1] = nx; }
        const unsigned old = xb_add(&bar[XB_XSUB(b.x)], 1u);
        const unsigned gen = old / nloc;
        if (old + 1u == (gen + 1u) * nloc) {
            __builtin_amdgcn_fence(__ATOMIC_RELEASE, "agent");
            asm volatile("s_waitcnt vmcnt(0)" ::: "memory");
            const unsigned og = xb_add(&bar[XB_TOP], 1u);
            const unsigned tg = og / nx;
            if (og + 1u == (tg + 1u) * nx) xb_add(&bar[XB_TOPGEN], 1u);
            else XB_SPIN(xb_ld(&bar[XB_TOPGEN]) == tg, bar);
            __builtin_amdgcn_fence(__ATOMIC_ACQUIRE, "agent");
            xb_add(&bar[XB_XGEN(b.x)], 1u);
            asm volatile("s_waitcnt vmcnt(0)" ::: "memory");
        } else {
            XB_SPIN(xb_ld(&bar[XB_XGEN(b.x)]) == gen, bar);
            __builtin_amdgcn_fence(__ATOMIC_ACQUIRE, "agent");
            asm volatile("s_waitcnt vmcnt(0)" ::: "memory");
        }
    }
    __syncthreads();
}

struct Args { const float* in[26]; float* out; unsigned char* ws; int ph_lo, ph_hi; };
enum { I_X = 0, I_MEM, I_EN1, I_EWIN, I_RPB, I_EWOUT, I_EN2, I_EWG, I_EWU, I_EWD, I_ON1, I_OWIN, I_WGKF, I_BGKF, I_WGKB, I_BGKB, I_GNORM, I_OWOUT, I_ON2, I_WR, I_OWG, I_OWU, I_OWD, I_MNORM, I_WMKV, I_FNORM };

struct Frame {
    LAS unsigned char* lds;
    int tid, lane, wave, G, bid;
    int gw, NGW;
    unsigned char* ws;
};

__device__ __forceinline__ void cvt_item(const float* W, int ldn, int k0, int n0, bf16* WT, int ldk, int drow0, const float* gain, float scale, LAS float* scr, int lane) {
#pragma unroll 8
    for (int i = 0; i < 32; ++i) { const int kk = 2 * i + (lane >> 5); float v = W[(size_t)(k0 + kk) * ldn + n0 + (lane & 31)];
        const float gg = gain ? gain[k0 + kk] : 1.0f; scr[kk * 33 + (lane & 31)] = v * gg * scale; }
    LDS_WAIT(); asm volatile("" ::: "memory");
    const int c = lane & 7;
#pragma unroll
    for (int j = 0; j < 4; ++j) { const int n = (lane >> 3) + 8 * j; const LAS float* s = scr + (8 * c) * 33 + n;
        v4u o; o.x = pk2(s[0 * 33], s[1 * 33]); o.y = pk2(s[2 * 33], s[3 * 33]); o.z = pk2(s[4 * 33], s[5 * 33]); o.w = pk2(s[6 * 33], s[7 * 33]);
        *(GAS v4u*)(WT + (size_t)(drow0 + n) * ldk + k0 + 8 * c) = o; }
    LDS_WAIT(); asm volatile("" ::: "memory");
}
struct CvtJob { const float* W; int K, N; bf16* WT; const float* gain; int kind; };
__device__ __forceinline__ bool cvt_map(int kind, int n0, int& drow, float& scale) {
    scale = 1.0f;
    switch (kind) {
    case 0: drow = n0; return true;
    case 1: if (n0 < 768) { drow = n0; scale = 0.125f; return true; } if (n0 < 1536) { drow = n0; return true; } if (n0 >= 2304) { drow = n0 - 768; scale = 0.125f; return true; } return false;
    case 2: if (n0 >= 1536 && n0 < 2304) { drow = n0 - 1536; return true; } return false;
    case 3: drow = (n0 >> 7) * 256 + (n0 & 127); return true;
    case 4: drow = (n0 >> 7) * 256 + 128 + (n0 & 127); return true;
    case 5: if (n0 < 768) { drow = n0; return true; } if (n0 < 1536) return false; if (n0 < 2304) { drow = n0 - 768; return true; }
            if (n0 < 2336) { drow = n0 - 512; return true; } drow = n0 - 800; scale = 0.125f; return true;
    case 6: if (n0 >= 768 && n0 < 1536) { drow = n0 - 768; return true; } return false;
    default: drow = n0; return true;
    }
}
__device__ __forceinline__ void cvt_job_item(const CvtJob& J, int item, LAS float* scr, int lane) {
    const int nblk = J.N / 32, kb = item / nblk, nb = item % nblk; int drow; float scale;
    if (!cvt_map(J.kind, nb * 32, drow, scale)) return;
    cvt_item(J.W, J.N, kb * 64, nb * 32, J.WT, J.K, drow, J.gain, scale, scr, lane);
}

__device__ __forceinline__ void row_to_bf16(const float* xrow, bf16* orow, float* rss16, int lane) {
    const GAS f32x4* xr = (const GAS f32x4*)xrow + lane;
    f32x4 v[4]; float s = 0.f;
#pragma unroll
    for (int j = 0; j < 4; ++j) { v[j] = xr[64 * j]; s += (v[j].x * v[j].x + v[j].y * v[j].y) + (v[j].z * v[j].z + v[j].w * v[j].w); }
    s = wave_sum(s);
    GAS unsigned long long* o8 = (GAS unsigned long long*)orow + lane;
#pragma unroll
    for (int j = 0; j < 4; ++j) o8[64 * j] = (unsigned long long)pk2(v[j].x, v[j].y) | ((unsigned long long)pk2(v[j].z, v[j].w) << 32);
    if (lane < 16) rss16[lane] = (lane == 0) ? s : 0.f;
}

struct Unit { int pm, pn; };
struct Sched {
    int nM, nN, nwg, G, c, K;
    const char* A; const char* B; const int* bexp; size_t estride;
    __device__ void init(const void* A_, const void* B_, int K_, int nM_, int nN_, int G_, int c_, const int* bexp_ = nullptr, size_t estride_ = 0) {
        A = (const char*)A_; B = (const char*)B_; K = K_; nM = nM_; nN = nN_; nwg = nM * nN; G = G_; c = c_; bexp = bexp_; estride = estride_; }
    __device__ bool next(int i, Unit& u) const {
        const long L = (long)i * G + c; if (L >= nwg) return false;
        int wgid = (int)L; { const int q = nwg / 8, r = nwg % 8, xcd = wgid % 8, off = wgid / 8; wgid = (xcd < r ? xcd * (q + 1) : r * (q + 1) + (xcd - r) * q) + off; }
        const int nig = 8 * nN, gid = wgid / nig, fm = gid * 8, gsz = (nM - fm) < 8 ? (nM - fm) : 8;
        u.pm = fm + ((wgid % nig) % gsz); u.pn = (wgid % nig) / gsz; return true;
    }
    __device__ const char* a_base(const Unit& u) const { return A + (size_t)u.pm * 512 * K; }
    __device__ const char* b_base(const Unit& u) const { return B + (bexp ? (size_t)bexp[u.pm] * estride : (size_t)0) + (size_t)u.pn * 512 * K; }
};

struct NoAux {};
__device__ __forceinline__ float rstd_from(const float* rss16) {
    const f32x4* p = (const f32x4*)rss16; f32x4 a = p[0], b = p[1], c = p[2], d = p[3];
    const float s = ((a.x + a.y) + (a.z + a.w)) + ((b.x + b.y) + (b.z + b.w)) + ((c.x + c.y) + (c.z + c.w)) + ((d.x + d.y) + (d.z + d.w));
    return __builtin_amdgcn_rsqf(s * (1.0f / DM) + EPS);
}
struct RowCtx { float rs[2][4]; };
__device__ __forceinline__ void row_scales(RowCtx& c, const float* rss, const int (&t)[2][4], int fq) {
    f32x4 p[2][4];
#pragma unroll
    for (int ai = 0; ai < 2; ++ai)
#pragma unroll
        for (int m = 0; m < 4; ++m) p[ai][m] = *(const f32x4*)(rss + (size_t)(t[ai][m] < 0 ? 0 : t[ai][m]) * 16 + 4 * fq);
#pragma unroll
    for (int ai = 0; ai < 2; ++ai)
#pragma unroll
        for (int m = 0; m < 4; ++m) { float s = (p[ai][m].x + p[ai][m].y) + (p[ai][m].z + p[ai][m].w); s += __shfl_xor(s, 16); s += __shfl_xor(s, 32);
            c.rs[ai][m] = t[ai][m] < 0 ? 0.f : __builtin_amdgcn_rsqf(s * (1.0f / DM) + EPS); }
}
struct EpiRowScale {
    static constexpr bool NEED_SS = false; typedef RowCtx Ctx; typedef NoAux Aux;
    bf16* O; int ldc; const float* rss;
    __device__ __forceinline__ void begin(Ctx& c, int row0, int, int c128) const {
        int t[2][4];
#pragma unroll
        for (int ai = 0; ai < 2; ++ai)
#pragma unroll
            for (int m = 0; m < 4; ++m) t[ai][m] = row0 + ai * 128 + m * 16;
        row_scales(c, rss, t, (c128 >> 3) & 3);
    }
    __device__ __forceinline__ void load_aux(Aux&, const Ctx&, int, int, int, int, int) const {}
    __device__ __forceinline__ float apply(const Ctx& c, const Aux&, int ai, int m, int row, int pn, int c128, const float (&a)[8], const float (&b)[8]) const {
        const float s = c.rs[ai][m];
        bf16* p = O + (size_t)row * ldc + pn * 256 + c128;
        v4u w; w.x = pk2(a[0] * s, a[1] * s); w.y = pk2(a[2] * s, a[3] * s); w.z = pk2(a[4] * s, a[5] * s); w.w = pk2(a[6] * s, a[7] * s); *(v4u*)p = w;
        w.x = pk2(b[0] * s, b[1] * s); w.y = pk2(b[2] * s, b[3] * s); w.z = pk2(b[4] * s, b[5] * s); w.w = pk2(b[6] * s, b[7] * s); *(v4u*)(p + 128) = w;
        return 0.f;
    }
    __device__ __forceinline__ void row_done(int, int, int, float) const {}
};
struct ColCtx { float sa[8], sb[8]; };
struct EpiColScale {
    static constexpr bool NEED_SS = false; typedef ColCtx Ctx; typedef NoAux Aux;
    bf16* O; int ldc; const float* rss;
    __device__ __forceinline__ void begin(Ctx& c, int row0, int pn, int c128) const {
        const int fr = row0 & 15, lane = threadIdx.x & 63;
        const float mine = rstd_from(rss + (size_t)(pn * 256 + c128 + (fr & 7) + (fr >> 3) * 128) * 16);
#pragma unroll
        for (int j = 0; j < 8; ++j) { c.sa[j] = __shfl(mine, (lane & 48) + j); c.sb[j] = __shfl(mine, (lane & 48) + 8 + j); }
    }
    __device__ __forceinline__ void load_aux(Aux&, const Ctx&, int, int, int, int, int) const {}
    __device__ __forceinline__ float apply(const Ctx& c, const Aux&, int, int, int row, int pn, int c128, const float (&a)[8], const float (&b)[8]) const {
        bf16* p = O + (size_t)row * ldc + pn * 256 + c128;
        v4u w; w.x = pk2(a[0] * c.sa[0], a[1] * c.sa[1]); w.y = pk2(a[2] * c.sa[2], a[3] * c.sa[3]); w.z = pk2(a[4] * c.sa[4], a[5] * c.sa[5]); w.w = pk2(a[6] * c.sa[6], a[7] * c.sa[7]); *(v4u*)p = w;
        w.x = pk2(b[0] * c.sb[0], b[1] * c.sb[1]); w.y = pk2(b[2] * c.sb[2], b[3] * c.sb[3]); w.z = pk2(b[4] * c.sb[4], b[5] * c.sb[5]); w.w = pk2(b[6] * c.sb[6], b[7] * c.sb[7]); *(v4u*)(p + 128) = w;
        return 0.f;
    }
    __device__ __forceinline__ void row_done(int, int, int, float) const {}
};
struct Aux4 { f32x4 v[4]; };
struct NoCtx {};
struct EpiResid {
    static constexpr bool NEED_SS = true; typedef NoCtx Ctx; typedef Aux4 Aux;
    const float* R; float* H; bf16* HB; float* rss;
    __device__ __forceinline__ void begin(Ctx&, int, int, int) const {}
    __device__ __forceinline__ void load_aux(Aux& x, const Ctx&, int, int, int row, int pn, int c128) const {
        const float* p = R + (size_t)row * DM + pn * 256 + c128;
        x.v[0] = *(const f32x4*)p; x.v[1] = *(const f32x4*)(p + 4); x.v[2] = *(const f32x4*)(p + 128); x.v[3] = *(const f32x4*)(p + 132);
    }
    __device__ __forceinline__ float apply(const Ctx&, const Aux& x, int, int, int row, int pn, int c128, const float (&a)[8], const float (&b)[8]) const {
        const size_t off = (size_t)row * DM + pn * 256 + c128;
        const f32x4 h0 = {x.v[0].x + a[0], x.v[0].y + a[1], x.v[0].z + a[2], x.v[0].w + a[3]}, h1 = {x.v[1].x + a[4], x.v[1].y + a[5], x.v[1].z + a[6], x.v[1].w + a[7]};
        const f32x4 h2 = {x.v[2].x + b[0], x.v[2].y + b[1], x.v[2].z + b[2], x.v[2].w + b[3]}, h3 = {x.v[3].x + b[4], x.v[3].y + b[5], x.v[3].z + b[6], x.v[3].w + b[7]};
        *(f32x4*)(H + off) = h0; *(f32x4*)(H + off + 4) = h1; *(f32x4*)(H + off + 128) = h2; *(f32x4*)(H + off + 132) = h3;
        v4u w; w.x = pk2(h0.x, h0.y); w.y = pk2(h0.z, h0.w); w.z = pk2(h1.x, h1.y); w.w = pk2(h1.z, h1.w); *(v4u*)(HB + off) = w;
        w.x = pk2(h2.x, h2.y); w.y = pk2(h2.z, h2.w); w.z = pk2(h3.x, h3.y); w.w = pk2(h3.z, h3.w); *(v4u*)(HB + off + 128) = w;
        return ((h0.x * h0.x + h0.y * h0.y) + (h0.z * h0.z + h0.w * h0.w) + (h1.x * h1.x + h1.y * h1.y) + (h1.z * h1.z + h1.w * h1.w))
             + ((h2.x * h2.x + h2.y * h2.y) + (h2.z * h2.z + h2.w * h2.w) + (h3.x * h3.x + h3.y * h3.y) + (h3.z * h3.z + h3.w * h3.w));
    }
    __device__ __forceinline__ void row_done(int row, int pn, int wc, float ss) const { rss[(size_t)row * 16 + pn * 4 + wc] = ss; }
};
__device__ __forceinline__ float silu_mul(float g, float u) { return g * __builtin_amdgcn_rcpf(1.0f + __builtin_amdgcn_exp2f(g * -1.4426950408889634f)) * u; }
struct EpiSwiGLU {
    static constexpr bool NEED_SS = false; typedef RowCtx Ctx; typedef NoAux Aux;
    bf16* Hm; int ldh; const float* rss; const int* tok;
    __device__ __forceinline__ void begin(Ctx& c, int row0, int, int c128) const {
        int t[2][4];
#pragma unroll
        for (int ai = 0; ai < 2; ++ai)
#pragma unroll
            for (int m = 0; m < 4; ++m) { const int row = row0 + ai * 128 + m * 16; t[ai][m] = tok ? tok[row] : row; }
        row_scales(c, rss, t, (c128 >> 3) & 3);
    }
    __device__ __forceinline__ void load_aux(Aux&, const Ctx&, int, int, int, int, int) const {}
    __device__ __forceinline__ float apply(const Ctx& c, const Aux&, int ai, int m, int row, int pn, int c128, const float (&a)[8], const float (&b)[8]) const {
        const float s = c.rs[ai][m]; float o[8];
#pragma unroll
        for (int j = 0; j < 8; ++j) o[j] = silu_mul(a[j] * s, b[j] * s);
        v4u w; w.x = pk2(o[0], o[1]); w.y = pk2(o[2], o[3]); w.z = pk2(o[4], o[5]); w.w = pk2(o[6], o[7]);
        *(v4u*)(Hm + (size_t)row * ldh + pn * 128 + c128) = w;
        return 0.f;
    }
    __device__ __forceinline__ void row_done(int, int, int, float) const {}
};
struct MoeCtx { int t[2][4]; float w[2][4]; };
struct EpiMoeDown {
    static constexpr bool NEED_SS = false; typedef MoeCtx Ctx; typedef Aux4 Aux;
    float* H; const int* tok; const float* w;
    __device__ __forceinline__ void begin(Ctx& c, int row0, int, int) const {
#pragma unroll
        for (int ai = 0; ai < 2; ++ai)
#pragma unroll
            for (int m = 0; m < 4; ++m) { const int row = row0 + ai * 128 + m * 16; c.t[ai][m] = tok[row]; c.w[ai][m] = w[row]; }
    }
    __device__ __forceinline__ void load_aux(Aux& x, const Ctx& c, int ai, int m, int, int pn, int c128) const {
        const int t = c.t[ai][m]; const float* p = H + (size_t)(t < 0 ? 0 : t) * DM + pn * 256 + c128;
        x.v[0] = *(const f32x4*)p; x.v[1] = *(const f32x4*)(p + 4); x.v[2] = *(const f32x4*)(p + 128); x.v[3] = *(const f32x4*)(p + 132);
    }
    __device__ __forceinline__ float apply(const Ctx& c, const Aux& x, int ai, int m, int, int pn, int c128, const float (&a)[8], const float (&b)[8]) const {
        const int t = c.t[ai][m]; if (t < 0) return 0.f;
        const float s = c.w[ai][m]; float* p = H + (size_t)t * DM + pn * 256 + c128;
        f32x4 h0 = x.v[0], h1 = x.v[1], h2 = x.v[2], h3 = x.v[3];
        h0.x += s * a[0]; h0.y += s * a[1]; h0.z += s * a[2]; h0.w += s * a[3]; h1.x += s * a[4]; h1.y += s * a[5]; h1.z += s * a[6]; h1.w += s * a[7];
        h2.x += s * b[0]; h2.y += s * b[1]; h2.z += s * b[2]; h2.w += s * b[3]; h3.x += s * b[4]; h3.y += s * b[5]; h3.z += s * b[6]; h3.w += s * b[7];
        *(f32x4*)p = h0; *(f32x4*)(p + 4) = h1; *(f32x4*)(p + 128) = h2; *(f32x4*)(p + 132) = h3;
        return 0.f;
    }
    __device__ __forceinline__ void row_done(int, int, int, float) const {}
};

namespace pg8 {
constexpr int HTB = 16384, TOK_OFF = 132096;
__device__ __forceinline__ int lds_byte(int r, int c) { const int st = (r >> 4) * 2 + (c >> 5), rr = r & 15, cc = c & 31, ob = rr * 64 + cc * 2; return st * 1024 + (ob ^ (((ob >> 9) & 1) << 5)); }
__device__ __forceinline__ void stage_rc(int b, int& R, int& C) { const int st = b / 1024, sb = b % 1024, swz = sb ^ (((sb >> 9) & 1) << 5); R = (st >> 1) * 16 + swz / 64; C = (st & 1) * 32 + (swz % 64) / 2; }
__device__ __forceinline__ int perm32(int rho) { const int n = rho >> 4, i = rho & 15; return 8 * (i >> 2) + 4 * n + (i & 3); }

template <class Epi>
__device__ __forceinline__ void run_epi(const Epi& E, const f32x4 (&acc)[2][2][4][2], const Unit& u, int wr, int wc, int fr, int fq) {
    int row0 = u.pm * 256 + wr * 64 + fr, c128 = 32 * wc + 8 * fq;
    asm volatile("" : "+v"(row0), "+v"(c128));
    typename Epi::Ctx ctx; E.begin(ctx, row0, u.pn, c128);
#pragma unroll
    for (int ai = 0; ai < 2; ++ai) {
        typename Epi::Aux aux[4];
#pragma unroll
        for (int m = 0; m < 4; ++m) E.load_aux(aux[m], ctx, ai, m, row0 + ai * 128 + m * 16, u.pn, c128);
#pragma unroll
        for (int m = 0; m < 4; ++m) {
            const int row = row0 + ai * 128 + m * 16;
            float a[8], b[8];
#pragma unroll
            for (int j = 0; j < 8; ++j) { a[j] = acc[ai][0][m][j >> 2][j & 3]; b[j] = acc[ai][1][m][j >> 2][j & 3]; }
            float ss = E.apply(ctx, aux[m], ai, m, row, u.pn, c128, a, b);
            if (Epi::NEED_SS) { ss += __shfl_xor(ss, 16); ss += __shfl_xor(ss, 32); if (fq == 0) E.row_done(row, u.pn, wc, ss); }
        }
    }
}

template <class Epi, bool GATHER>
__device__ __forceinline__ void gemm_fast(LAS unsigned char* lds, const Sched& S, const Epi& E, const int* gtok) {
    int tid = threadIdx.x; asm volatile("" : "+v"(tid));
    const int wid = __builtin_amdgcn_readfirstlane(tid >> 6), lane = tid & 63, wr = wid >> 2, wc = wid & 3, fr = lane & 15, fq = lane >> 4;
    const int K = S.K, nt = K / 64;
    unsigned voffB[2], vA0[2], vA1[2], nA0[2], nA1[2]; int RA[2], CA2[2];
#pragma unroll
    for (int i = 0; i < 2; ++i) { int R, C; stage_rc(tid * 16 + i * 8192, R, C); const int Rb = (R & ~31) + perm32(R & 31);
        voffB[i] = (unsigned)(Rb * K + C) * 2u; RA[i] = R; CA2[i] = C * 2; vA0[i] = (unsigned)(R * K + C) * 2u; vA1[i] = vA0[i] + (unsigned)(128 * K * 2); nA0[i] = vA0[i]; nA1[i] = vA1[i]; }
    const size_t kstep = 128;
    const size_t hstep = (size_t)128 * K * 2;
    const unsigned ldsw = (unsigned)wid * 1024u;
    const int aoff = lds_byte(wr * 64 + fr, fq * 8), boff = lds_byte(wc * 32 + fr, fq * 8);
    LAS int* tl = (LAS int*)(lds + TOK_OFF);
#define PG8_SA(b, h) (((b) * 2 + (h)) * HTB)
#define PG8_SB(b, h) ((4 + (b) * 2 + (h)) * HTB)
#define PG8_STAGE(bufoff, gbase, voff) do { _Pragma("unroll") for (int _i = 0; _i < 2; ++_i) \
        __builtin_amdgcn_global_load_lds((const unsigned*)((const char*)(gbase) + (voff)[_i]), (LAS unsigned*)(lds + (bufoff) + ldsw + _i * 8192), 16, 0, 0); } while (0)
#define PG8_LDA(dst, b, h) do { _Pragma("unroll") for (int m = 0; m < 4; ++m) _Pragma("unroll") for (int k = 0; k < 2; ++k) dst[m][k] = *(const LAS bf16x8*)(lds + PG8_SA(b, h) + aoff + m * 2048 + k * 1024); } while (0)
#define PG8_LDB(dst, b, h) do { _Pragma("unroll") for (int n = 0; n < 2; ++n) _Pragma("unroll") for (int k = 0; k < 2; ++k) dst[n][k] = *(const LAS bf16x8*)(lds + PG8_SB(b, h) + boff + n * 2048 + k * 1024); } while (0)
#define PG8_MMA(ai, bj, At, Bt) do { __builtin_amdgcn_s_setprio(1); _Pragma("unroll") for (int m = 0; m < 4; ++m) _Pragma("unroll") for (int n = 0; n < 2; ++n) _Pragma("unroll") for (int k = 0; k < 2; ++k) \
        acc[ai][bj][m][n] = __builtin_amdgcn_mfma_f32_16x16x32_bf16(Bt[n][k], At[m][k], acc[ai][bj][m][n], 0, 0, 0); __builtin_amdgcn_s_setprio(0); } while (0)
#define PG8_WAIT_V(n) asm volatile("s_waitcnt vmcnt(" #n ")" ::: "memory")
#define PG8_WAIT_L(n) asm volatile("s_waitcnt lgkmcnt(" #n ")" ::: "memory")
#define PG8_BAR __builtin_amdgcn_s_barrier()
#define PG8_SCHED __builtin_amdgcn_sched_barrier(0)
#define PG8_IDS_DMA(pm_, par_) do { if (wid < 4) __builtin_amdgcn_global_load_lds((const unsigned*)(gtok + (pm_) * 256 + wid * 64 + lane), (LAS unsigned*)(lds + TOK_OFF + (par_) * 1024 + wid * 256), 4, 0, 0); } while (0)
#define PG8_IDS_READ(d0, d1, par_) do { _Pragma("unroll") for (int _i = 0; _i < 2; ++_i) { int t0 = tl[(par_) * 256 + RA[_i]], t1 = tl[(par_) * 256 + 128 + RA[_i]]; t0 = t0 < 0 ? 0 : t0; t1 = t1 < 0 ? 0 : t1; \
        d0[_i] = (unsigned)t0 * (unsigned)(K * 2) + (unsigned)CA2[_i]; d1[_i] = (unsigned)t1 * (unsigned)(K * 2) + (unsigned)CA2[_i]; } } while (0)
    Unit cur, nxt; int ui = 0, par = 0;
    if (!S.next(0, cur)) return;
    f32x4 acc[2][2][4][2];
#pragma unroll
    for (int a = 0; a < 2; ++a)
#pragma unroll
        for (int b = 0; b < 2; ++b)
#pragma unroll
            for (int m = 0; m < 4; ++m)
#pragma unroll
                for (int n = 0; n < 2; ++n) acc[a][b][m][n] = (f32x4){0.f, 0.f, 0.f, 0.f};
    bf16x8 At[4][2], B0[2][2], B1[2][2];
    const char* cA = GATHER ? S.A : S.a_base(cur); const char* cB = S.b_base(cur);
    if constexpr (GATHER) { PG8_IDS_DMA(cur.pm, 0); PG8_WAIT_V(0); __syncthreads(); PG8_IDS_READ(vA0, vA1, 0); }
    PG8_STAGE(PG8_SB(0, 0), cB, voffB); PG8_STAGE(PG8_SB(0, 1), cB + hstep, voffB); PG8_STAGE(PG8_SA(0, 0), cA, vA0); PG8_STAGE(PG8_SA(0, 1), cA, vA1);
    if (wr == 1) PG8_BAR;
    PG8_WAIT_V(2); PG8_BAR;
    PG8_STAGE(PG8_SB(1, 0), cB + kstep, voffB); PG8_STAGE(PG8_SA(1, 0), cA + kstep, vA0); PG8_STAGE(PG8_SB(1, 1), cB + hstep + kstep, voffB);
    PG8_WAIT_V(6); PG8_BAR;
    for (;;) {
        const bool has_next = S.next(ui + 1, nxt);
        const char* nA = has_next ? (GATHER ? S.A : S.a_base(nxt)) : cA; const char* nB = has_next ? S.b_base(nxt) : cB;
        for (int t = 0; t < nt; t += 2) {
            const bool last = (t == nt - 2);
            if constexpr (GATHER) {
                if (t == nt - 4 && has_next) PG8_IDS_DMA(nxt.pm, par ^ 1);
                if (last) { if (has_next) PG8_IDS_READ(nA0, nA1, par ^ 1); else { nA0[0] = vA0[0]; nA0[1] = vA0[1]; nA1[0] = vA1[0]; nA1[1] = vA1[1]; } }
            }
            const char* a1 = cA + (size_t)(t + 1) * kstep;
            const char* a2 = last ? nA : cA + (size_t)(t + 2) * kstep; const char* b2 = last ? nB : cB + (size_t)(t + 2) * kstep;
            const char* a3 = a2 + kstep; const char* b3 = b2 + kstep;
            unsigned w0[2], w1[2];
            if (GATHER && last) { w0[0] = nA0[0]; w0[1] = nA0[1]; w1[0] = nA1[0]; w1[1] = nA1[1]; } else { w0[0] = vA0[0]; w0[1] = vA0[1]; w1[0] = vA1[0]; w1[1] = vA1[1]; }
            PG8_LDB(B0, 0, 0); PG8_LDB(B1, 0, 1); PG8_SCHED; PG8_LDA(At, 0, 0); PG8_STAGE(PG8_SA(1, 1), a1, vA1);
            PG8_WAIT_V(8); PG8_WAIT_L(0); PG8_BAR; PG8_MMA(0, 0, At, B0); PG8_MMA(0, 1, At, B1); PG8_BAR; PG8_SCHED;
            PG8_LDA(At, 0, 1); PG8_STAGE(PG8_SB(0, 0), b2, voffB); PG8_STAGE(PG8_SB(0, 1), b2 + hstep, voffB); PG8_STAGE(PG8_SA(0, 0), a2, w0);
            PG8_WAIT_V(8); PG8_WAIT_L(0); PG8_BAR; PG8_MMA(1, 0, At, B0); PG8_MMA(1, 1, At, B1); PG8_BAR; PG8_SCHED;
            PG8_LDB(B0, 1, 0); PG8_LDB(B1, 1, 1); PG8_SCHED; PG8_LDA(At, 1, 0); PG8_STAGE(PG8_SA(0, 1), a2, w1);
            PG8_WAIT_V(8); PG8_WAIT_L(0); PG8_BAR; PG8_MMA(0, 0, At, B0); PG8_MMA(0, 1, At, B1); PG8_BAR; PG8_SCHED;
            PG8_LDA(At, 1, 1); PG8_STAGE(PG8_SB(1, 0), b3, voffB); PG8_STAGE(PG8_SB(1, 1), b3 + hstep, voffB); PG8_STAGE(PG8_SA(1, 0), a3, w0);
            PG8_WAIT_V(8); PG8_WAIT_L(0); PG8_BAR; PG8_MMA(1, 0, At, B0); PG8_MMA(1, 1, At, B1); PG8_BAR; PG8_SCHED;
        }
        if (wr == 0) PG8_BAR;
        run_epi(E, acc, cur, wr, wc, fr, fq);
        if (!has_next) break;
#pragma unroll
        for (int a = 0; a < 2; ++a)
#pragma unroll
            for (int b = 0; b < 2; ++b)
#pragma unroll
                for (int m = 0; m < 4; ++m)
#pragma unroll
                    for (int n = 0; n < 2; ++n) acc[a][b][m][n] = (f32x4){0.f, 0.f, 0.f, 0.f};
        cur = nxt; cA = nA; cB = nB; ++ui;
        if constexpr (GATHER) { vA0[0] = nA0[0]; vA0[1] = nA0[1]; vA1[0] = nA1[0]; vA1[1] = nA1[1]; par ^= 1; }
        if (wr == 1) PG8_BAR;
    }
    PG8_WAIT_V(0);
    PG8_BAR;
#undef PG8_SA
#undef PG8_SB
#undef PG8_STAGE
#undef PG8_LDA
#undef PG8_LDB
#undef PG8_MMA
#undef PG8_WAIT_V
#undef PG8_WAIT_L
#undef PG8_BAR
#undef PG8_SCHED
#undef PG8_IDS_DMA
#undef PG8_IDS_READ
}
}

template <class Epi, bool GATHER>
__device__ __forceinline__ void gemm_run(LAS unsigned char* lds, const Sched& S, const Epi& E, const int* gtok) { pg8::gemm_fast<Epi, GATHER>(lds, S, E, gtok); }

__device__ __forceinline__ void na_simple(const Frame& F, const bf16* act0, const bf16* v0t, const float* rpb, bf16* mix) {
    for (int it = F.gw; it < NT * 12; it += F.NGW) {
        const int token = it / 12, h = it % 12, lane = F.lane;
        const int b = token >> 12, p = token & 4095, r = p >> 6, c = p & 63;
        const int r0 = min(max(r - 4, 0), 56), cs = min(max(c - 8, 0), 48);
        const float q = bf2f(act0[(size_t)token * A0_LD + h * 64 + lane]);
        float m = -INFINITY, l = 0.f, o = 0.f;
        for (int a = 0; a < 8; ++a)
            for (int u = 0; u < 16; ++u) {
                const int kt = b * SEQ + (r0 + a) * 64 + cs + u;
                const float kv = bf2f(act0[(size_t)kt * A0_LD + 768 + h * 64 + lane]);
                const float sc = wave_sum(q * kv) + rpb[h * 465 + (r0 + a - r + 7) * 31 + (cs + u - c + 15)];
                const float mn = fmaxf(m, sc), corr = __expf(m - mn), pe = __expf(sc - mn);
                const float vv = bf2f(v0t[(size_t)(h * 64 + lane) * NT + kt]);
                l = l * corr + pe; o = o * corr + pe * vv; m = mn;
            }
        mix[(size_t)token * DM + h * 64 + lane] = (bf16)f2bf(o / l);
    }
}
__device__ __forceinline__ void memattn_simple(const Frame& F, int first, int stride, const bf16* act, int ld, int qoff, const bf16* memk, const bf16* memvt, bf16* mix) {
    for (int it = first; it < NT * 4; it += stride) {
        const int token = it >> 2, h = it & 3, lane = F.lane, b = token >> 12;
        const float q = bf2f(act[(size_t)token * ld + qoff + h * 64 + lane]);
        float m = -INFINITY, l = 0.f, o = 0.f;
        for (int j = 0; j < 256; ++j) {
            const float kv = bf2f(memk[(size_t)(b * 256 + j) * 256 + h * 64 + lane]);
            const float sc = wave_sum(q * kv);
            const float mn = fmaxf(m, sc), corr = __expf(m - mn), pe = __expf(sc - mn);
            const float vv = bf2f(memvt[(size_t)(h * 64 + lane) * MEM_ROWS + b * 256 + j]);
            l = l * corr + pe; o = o * corr + pe * vv; m = mn;
        }
        mix[(size_t)token * DM + 768 + h * 64 + lane] = (bf16)f2bf(o / l);
    }
}

typedef short s16x4 __attribute__((ext_vector_type(4)));
template <bool NA>
__device__ __forceinline__ void attn16(int lane, const bf16* Q, int ldq, const bf16* Kb, int ldk, const bf16* Vt, int ldv, int ktok0, int trs, bf16* O, int ldo,
                                       const LAS float* rpb_h, int r, int r0, int jb, int band0) {
    const int qi = lane & 15, g = lane >> 4;
    bf16x8 qf[2];
#pragma unroll
    for (int ks = 0; ks < 2; ++ks) qf[ks] = *(const bf16x8*)(Q + (size_t)qi * ldq + ks * 32 + 8 * g);
    f32x4 s[16];
#pragma unroll
    for (int t = 0; t < 16; ++t) {
        const bf16* kp = Kb + (size_t)(ktok0 + (t >> 1) * trs + (t & 1) * 16 + qi) * ldk + 8 * g;
        const bf16x8 k0 = *(const bf16x8*)kp, k1 = *(const bf16x8*)(kp + 32);
        f32x4 z = {0.f, 0.f, 0.f, 0.f};
        z = __builtin_amdgcn_mfma_f32_16x16x32_bf16(k0, qf[0], z, 0, 0, 0);
        z = __builtin_amdgcn_mfma_f32_16x16x32_bf16(k1, qf[1], z, 0, 0, 0);
        s[t] = z;
    }
    constexpr float L2E = 1.4426950408889634f;
    float m = -INFINITY;
    if constexpr (NA) {
        const int qc = 16 * jb + qi, cs = min(max(qc - 8, 0), 48);
#pragma unroll
        for (int t = 0; t < 16; ++t)
#pragma unroll
            for (int i = 0; i < 4; ++i) {
                const int kc = band0 + 16 * (t & 1) + 4 * g + i; const bool ok = (kc >= cs) && (kc < cs + 16);
                float v = -INFINITY;
                if (ok) v = s[t][i] + rpb_h[(r0 + (t >> 1) - r + 7) * 31 + (kc - qc + 15)];
                s[t][i] = v; m = fmaxf(m, v);
            }
    } else {
#pragma unroll
        for (int t = 0; t < 16; ++t)
#pragma unroll
            for (int i = 0; i < 4; ++i) m = fmaxf(m, s[t][i]);
    }
    m = fmaxf(m, __shfl_xor(m, 16)); m = fmaxf(m, __shfl_xor(m, 32));
    const float mb = m * L2E; float l = 0.f;
    bf16x8 pf[8];
#pragma unroll
    for (int kk = 0; kk < 8; ++kk) {
        float p[8];
#pragma unroll
        for (int i = 0; i < 4; ++i) { p[i] = __builtin_amdgcn_exp2f(s[2 * kk][i] * L2E - mb); p[4 + i] = __builtin_amdgcn_exp2f(s[2 * kk + 1][i] * L2E - mb); }
#pragma unroll
        for (int i = 0; i < 8; ++i) l += p[i];
        v4u w; w.x = pk2(p[0], p[1]); w.y = pk2(p[2], p[3]); w.z = pk2(p[4], p[5]); w.w = pk2(p[6], p[7]);
        pf[kk] = __builtin_bit_cast(bf16x8, w);
    }
    l += __shfl_xor(l, 16); l += __shfl_xor(l, 32);
    const float inv = 1.0f / l;
#pragma unroll
    for (int mt = 0; mt < 4; ++mt) {
        f32x4 acc = {0.f, 0.f, 0.f, 0.f};
#pragma unroll
        for (int kk = 0; kk < 8; ++kk) {
            const bf16* vp = Vt + (size_t)(16 * mt + qi) * ldv + ktok0 + kk * trs + 4 * g;
            const s16x4 v0 = *(const s16x4*)vp, v1 = *(const s16x4*)(vp + 16);
            const bf16x8 vf = __builtin_shufflevector(v0, v1, 0, 1, 2, 3, 4, 5, 6, 7);
            acc = __builtin_amdgcn_mfma_f32_16x16x32_bf16(vf, pf[kk], acc, 0, 0, 0);
        }
        v2u w; w.x = pk2(acc[0] * inv, acc[1] * inv); w.y = pk2(acc[2] * inv, acc[3] * inv);
        *(v2u*)(O + (size_t)qi * ldo + 16 * mt + 4 * g) = w;
    }
}
__device__ __forceinline__ void memattn_item(int it, int lane, const bf16* act, int ld, int qoff, const bf16* memk, const bf16* memvt, bf16* mix) {
    const int tb = it >> 2, h = it & 3, tok0 = tb * 16, b = tok0 >> 12;
    attn16<false>(lane, act + (size_t)tok0 * ld + qoff + h * 64, ld, memk + h * 64, 256, memvt + (size_t)(h * 64) * MEM_ROWS, MEM_ROWS, b * 256, 32,
                  mix + (size_t)tok0 * DM + 768 + h * 64, DM, nullptr, 0, 0, 0, 0);
}
__device__ __forceinline__ void na_item(int it, int lane, const bf16* act0, const bf16* v0t, const LAS float* rpb, bf16* mix) {
    const int jb = it & 3, h = (it >> 2) % 12, br = (it >> 2) / 12, r = br & 63, b = br >> 6;
    const int r0 = min(max(r - 4, 0), 56), band0 = min(max(jb * 16 - 8, 0), 32);
    const int tok0 = b * SEQ + r * 64 + jb * 16;
    attn16<true>(lane, act0 + (size_t)tok0 * A0_LD + h * 64, A0_LD, act0 + 768 + h * 64, A0_LD, v0t + (size_t)(h * 64) * NT, NT, b * SEQ + r0 * 64 + band0, 64,
                 mix + (size_t)tok0 * DM + h * 64, DM, rpb + h * 465, r, r0, jb, band0);
}

__device__ __forceinline__ float logsigmoid(float x) { return fminf(x, 0.f) - log1pf(__expf(-fabsf(x))); }
__device__ __forceinline__ void gla_simple(const Frame& F, int item, const bf16* act1, const bf16* v1t, const float* wgk, const float* bgk, bf16* O) {
    const int b = item >> 3, h = (item >> 1) & 3, dir = item & 1, tid = F.tid;
    LAS float* sh = (LAS float*)F.lds;
    float S[96];
#pragma unroll
    for (int d = 0; d < 96; ++d) S[d] = 0.f;
    float wcol[16], bias = 0.f;
    if (tid < 96) {
#pragma unroll
        for (int r = 0; r < 16; ++r) wcol[r] = wgk[r * 384 + h * 96 + tid];
        bias = bgk[h * 96 + tid];
    }
    for (int tau = 0; tau < SEQ; ++tau) {
        const int token = b * SEQ + (dir ? (SEQ - 1 - tau) : tau);
        LAS float* cur = sh + (tau & 1) * 288;
        if (tid < 96) {
            const bf16* row = act1 + (size_t)token * A1_LD;
            float z = bias;
#pragma unroll
            for (int r = 0; r < 16; ++r) z += bf2f(row[1792 + dir * 16 + r]) * wcol[r];
            cur[tid] = __expf(logsigmoid(z) * (1.0f / 16.0f));
            cur[96 + tid] = bf2f(row[h * 96 + tid]) * 0.10206207261596575f;
            cur[192 + tid] = bf2f(row[384 + h * 96 + tid]);
        }
        __syncthreads();
        if (tid < 192) {
            const float v = bf2f(v1t[(size_t)(h * 192 + tid) * NT + token]);
            float o = 0.f;
            if (dir == 0) {
#pragma unroll
                for (int d = 0; d < 96; ++d) { S[d] = cur[d] * S[d] + cur[192 + d] * v; o += cur[96 + d] * S[d]; }
            } else {
#pragma unroll
                for (int d = 0; d < 96; ++d) { S[d] = cur[d] * S[d]; o += cur[96 + d] * S[d]; S[d] += cur[192 + d] * v; }
            }
            O[(size_t)token * 768 + h * 192 + tid] = (bf16)f2bf(o);
        }
    }
    __syncthreads();
}

__device__ __forceinline__ void gla_pre_item(int item, int wave, int lane, const bf16* act1, const float* W, const float* Bi, bf16* E) {
    const int n = item & 63, dir = (item >> 6) & 1, b = item >> 7, base = b * SEQ + n * 64;
    const int qi = lane & 15, g = lane >> 4;
    bf16x8 zf[4];
#pragma unroll
    for (int ct = 0; ct < 4; ++ct) { const int c = 16 * ct + qi, tok = dir ? base + 63 - c : base + c;
        bf16x8 z = {0, 0, 0, 0, 0, 0, 0, 0}; if (g < 2) z = *(const bf16x8*)(act1 + (size_t)tok * A1_LD + 1792 + dir * 16 + 8 * g); zf[ct] = z; }
#pragma unroll 1
    for (int jj = 0; jj < 3; ++jj) {
        const int j = 16 * (wave + 8 * jj) + qi;
        v4u wu = {0u, 0u, 0u, 0u};
        if (g < 2) { const float* wp = W + (size_t)(8 * g) * 384 + j;
            wu.x = pk2(wp[0], wp[384]); wu.y = pk2(wp[768], wp[1152]); wu.z = pk2(wp[1536], wp[1920]); wu.w = pk2(wp[2304], wp[2688]); }
        const bf16x8 wfr = __builtin_bit_cast(bf16x8, wu);
        const float bias = Bi[j]; float carry = 0.f;
#pragma unroll
        for (int ct = 0; ct < 4; ++ct) {
            f32x4 d = {0.f, 0.f, 0.f, 0.f};
            d = __builtin_amdgcn_mfma_f32_16x16x32_bf16(zf[ct], wfr, d, 0, 0, 0);
            float p[4];
#pragma unroll
            for (int i = 0; i < 4; ++i) { const float x = d[i] + bias; p[i] = (fminf(x, 0.f) - __logf(1.0f + __expf(-fabsf(x)))) * 0.0625f; }
            p[1] += p[0]; p[2] += p[1]; p[3] += p[2];
            float a = p[3]; float t = __shfl_up(a, 16); if (g >= 1) a += t; t = __shfl_up(a, 32); if (g >= 2) a += t;
            const float excl = a - p[3] + carry;
            carry += __shfl(a, 48 + qi);
#pragma unroll
            for (int i = 0; i < 4; ++i) { const int c = 16 * ct + 4 * g + i, tok = dir ? base + 63 - c : base + c;
                E[(size_t)tok * 384 + j] = (bf16)f2bf(__expf(excl + p[i])); }
        }
    }
}
constexpr int GL_QT = 0, GL_KT = 13312, GL_KDT = 26624, GL_VT = 40448, GL_DEC = 47360, GL_BUF = 49152;
__device__ __forceinline__ unsigned rev16(unsigned u) { return (u >> 16) | (u << 16); }
__device__ __forceinline__ void gla_main_item(const Frame& F, int item, const bf16* act1, const bf16* v1t, const bf16* Eall, bf16* OFp, bf16* OBp) {
    const int vs = item & 3, dir = (item >> 2) & 1, h = (item >> 3) & 3, b = item >> 5;
    const int tid = F.tid, lane = F.lane, wave = F.wave, qi = lane & 15, g = lane >> 4, ct = wave & 3, vh = wave >> 2;
    const bf16* E = Eall + (size_t)dir * NT * 384; bf16* O = dir ? OBp : OFp;
    LAS unsigned char* L = F.lds;
    const int pc = tid >> 3, pdg = tid & 7;
    f32x4 S[2][6];
#pragma unroll
    for (int vi = 0; vi < 2; ++vi)
#pragma unroll
        for (int dt = 0; dt < 6; ++dt) S[vi][dt] = (f32x4){0.f, 0.f, 0.f, 0.f};
    v2u rq[3], rk[3], re[3], rel[3]; v4u rv = {0u, 0u, 0u, 0u};
#define GL_LOAD(n_) do { const int nn_ = dir ? 63 - (n_) : (n_), base_ = b * SEQ + nn_ * 64, tokc_ = dir ? base_ + 63 - pc : base_ + pc, tokl_ = dir ? base_ : base_ + 63; \
        const bf16* ar_ = act1 + (size_t)tokc_ * A1_LD + h * 96 + 12 * pdg; const bf16* er_ = E + (size_t)tokc_ * 384 + h * 96 + 12 * pdg; const bf16* el_ = E + (size_t)tokl_ * 384 + h * 96 + 12 * pdg; \
        _Pragma("unroll") for (int j_ = 0; j_ < 3; ++j_) { rq[j_] = *(const v2u*)(ar_ + 4 * j_); rk[j_] = *(const v2u*)(ar_ + 384 + 4 * j_); re[j_] = *(const v2u*)(er_ + 4 * j_); rel[j_] = *(const v2u*)(el_ + 4 * j_); } \
        if (pc < 48) rv = *(const v4u*)(v1t + (size_t)(h * 192 + vs * 48 + pc) * NT + base_ + 8 * pdg); } while (0)
#define GL_PREP(bufo_) do { LAS unsigned char* B_ = L + (bufo_); \
        _Pragma("unroll") for (int j_ = 0; j_ < 3; ++j_) { float q_[4], k_[4], e_[4], l_[4], qt_[4], kt_[4], kd_[4]; \
            q_[0] = bflo(rq[j_].x); q_[1] = bfhi(rq[j_].x); q_[2] = bflo(rq[j_].y); q_[3] = bfhi(rq[j_].y); k_[0] = bflo(rk[j_].x); k_[1] = bfhi(rk[j_].x); k_[2] = bflo(rk[j_].y); k_[3] = bfhi(rk[j_].y); \
            e_[0] = bflo(re[j_].x); e_[1] = bfhi(re[j_].x); e_[2] = bflo(re[j_].y); e_[3] = bfhi(re[j_].y); l_[0] = bflo(rel[j_].x); l_[1] = bfhi(rel[j_].x); l_[2] = bflo(rel[j_].y); l_[3] = bfhi(rel[j_].y); \
            _Pragma("unroll") for (int i_ = 0; i_ < 4; ++i_) { const float inv_ = 1.0f / e_[i_]; qt_[i_] = q_[i_] * 0.10206207261596575f * e_[i_]; kt_[i_] = k_[i_] * inv_; kd_[i_] = kt_[i_] * l_[i_]; } \
            v2u w_; w_.x = pk2(qt_[0], qt_[1]); w_.y = pk2(qt_[2], qt_[3]); *(LAS v2u*)(B_ + GL_QT + pc * 208 + (12 * pdg + 4 * j_) * 2) = w_; \
            w_.x = pk2(kt_[0], kt_[1]); w_.y = pk2(kt_[2], kt_[3]); *(LAS v2u*)(B_ + GL_KT + pc * 208 + (12 * pdg + 4 * j_) * 2) = w_; \
            _Pragma("unroll") for (int i_ = 0; i_ < 4; ++i_) *(LAS bf16*)(B_ + GL_KDT + (12 * pdg + 4 * j_ + i_) * 144 + pc * 2) = (bf16)f2bf(kd_[i_]); \
            if (pc == 0) { f32x4 d_ = {l_[0], l_[1], l_[2], l_[3]}; *(LAS f32x4*)(B_ + GL_DEC + (12 * pdg + 4 * j_) * 4) = d_; } } \
        if (pc < 48) { v4u o_ = rv; int c0_ = 8 * pdg; if (dir) { o_.x = rev16(rv.w); o_.y = rev16(rv.z); o_.z = rev16(rv.y); o_.w = rev16(rv.x); c0_ = 56 - 8 * pdg; } \
            *(LAS v4u*)(B_ + GL_VT + pc * 144 + c0_ * 2) = o_; } } while (0)
    GL_LOAD(0);
    GL_PREP(0);
    GL_LOAD(1);
    __syncthreads();
#pragma unroll 1
    for (int n = 0; n < 64; ++n) {
        const int bo = (n & 1) * GL_BUF;
        if (n + 1 < 64) { GL_PREP(GL_BUF - bo); if (n + 2 < 64) GL_LOAD(n + 2); }
        LAS unsigned char* Bf = L + bo;
        bf16x8 qf[3];
#pragma unroll
        for (int ks = 0; ks < 3; ++ks) qf[ks] = *(const LAS bf16x8*)(Bf + GL_QT + (16 * ct + qi) * 208 + (32 * ks + 8 * g) * 2);
        f32x4 am[4];
#pragma unroll
        for (int tp = 0; tp < 4; ++tp) {
            f32x4 z = {0.f, 0.f, 0.f, 0.f};
            if (tp <= ct) {
#pragma unroll
                for (int ks = 0; ks < 3; ++ks) { const bf16x8 kf = *(const LAS bf16x8*)(Bf + GL_KT + (16 * tp + qi) * 208 + (32 * ks + 8 * g) * 2);
                    z = __builtin_amdgcn_mfma_f32_16x16x32_bf16(kf, qf[ks], z, 0, 0, 0); }
                const int c = 16 * ct + qi;
#pragma unroll
                for (int i = 0; i < 4; ++i) { const int cp = 16 * tp + 4 * g + i; const bool keep = (cp < c) || (dir == 0 && cp == c); z[i] = keep ? z[i] : 0.f; }
            }
            am[tp] = z;
        }
        bf16x8 pf[2];
#pragma unroll
        for (int kk = 0; kk < 2; ++kk) { v4u w; w.x = pk2(am[2 * kk][0], am[2 * kk][1]); w.y = pk2(am[2 * kk][2], am[2 * kk][3]); w.z = pk2(am[2 * kk + 1][0], am[2 * kk + 1][1]); w.w = pk2(am[2 * kk + 1][2], am[2 * kk + 1][3]);
            pf[kk] = __builtin_bit_cast(bf16x8, w); }
        bf16x8 qp[3];
#pragma unroll
        for (int kk = 0; kk < 3; ++kk) { const LAS unsigned char* qr = Bf + GL_QT + (16 * ct + qi) * 208 + (32 * kk + 4 * g) * 2;
            const s16x4 a0 = *(const LAS s16x4*)qr, a1 = *(const LAS s16x4*)(qr + 32); qp[kk] = __builtin_shufflevector(a0, a1, 0, 1, 2, 3, 4, 5, 6, 7); }
        const int nn = dir ? 63 - n : n, base = b * SEQ + nn * 64, c = 16 * ct + qi, tok = dir ? base + 63 - c : base + c;
#pragma unroll
        for (int vi = 0; vi < 2; ++vi) {
            if (vi == 1 && vh == 1) break;
            const int vt = 2 * vh + vi;
            f32x4 acc = {0.f, 0.f, 0.f, 0.f};
#pragma unroll
            for (int kk = 0; kk < 2; ++kk) { const LAS unsigned char* vr = Bf + GL_VT + (16 * vt + qi) * 144 + (32 * kk + 4 * g) * 2;
                const s16x4 a0 = *(const LAS s16x4*)vr, a1 = *(const LAS s16x4*)(vr + 32); const bf16x8 vf = __builtin_shufflevector(a0, a1, 0, 1, 2, 3, 4, 5, 6, 7);
                acc = __builtin_amdgcn_mfma_f32_16x16x32_bf16(vf, pf[kk], acc, 0, 0, 0); }
#pragma unroll
            for (int kk = 0; kk < 3; ++kk) { v4u w; w.x = pk2(S[vi][2 * kk][0], S[vi][2 * kk][1]); w.y = pk2(S[vi][2 * kk][2], S[vi][2 * kk][3]); w.z = pk2(S[vi][2 * kk + 1][0], S[vi][2 * kk + 1][1]); w.w = pk2(S[vi][2 * kk + 1][2], S[vi][2 * kk + 1][3]);
                acc = __builtin_amdgcn_mfma_f32_16x16x32_bf16(__builtin_bit_cast(bf16x8, w), qp[kk], acc, 0, 0, 0); }
            v2u w; w.x = pk2(acc[0], acc[1]); w.y = pk2(acc[2], acc[3]);
            *(v2u*)(O + (size_t)tok * 768 + h * 192 + vs * 48 + 16 * vt + 4 * g) = w;
            bf16x8 vfr[2];
#pragma unroll
            for (int ks = 0; ks < 2; ++ks) vfr[ks] = *(const LAS bf16x8*)(Bf + GL_VT + (16 * vt + qi) * 144 + (32 * ks + 8 * g) * 2);
#pragma unroll
            for (int dt = 0; dt < 6; ++dt) {
                const f32x4 dec = *(const LAS f32x4*)(Bf + GL_DEC + (16 * dt + 4 * g) * 4);
                f32x4 sv = S[vi][dt]; sv[0] *= dec[0]; sv[1] *= dec[1]; sv[2] *= dec[2]; sv[3] *= dec[3];
#pragma unroll
                for (int ks = 0; ks < 2; ++ks) { const bf16x8 kdf = *(const LAS bf16x8*)(Bf + GL_KDT + (16 * dt + qi) * 144 + (32 * ks + 8 * g) * 2);
                    sv = __builtin_amdgcn_mfma_f32_16x16x32_bf16(kdf, vfr[ks], sv, 0, 0, 0); }
                S[vi][dt] = sv;
            }
        }
        __syncthreads();
    }
#undef GL_LOAD
#undef GL_PREP
}

__device__ __forceinline__ void gla_combine(const Frame& F, const bf16* OF, const bf16* OB, const bf16* act1, const float* gnorm, bf16* mix) {
    for (int token = F.gw; token < NT; token += F.NGW) {
        const int lane = F.lane;
#pragma unroll
        for (int h = 0; h < 4; ++h) {
            float o[3]; float ss = 0.f;
#pragma unroll
            for (int j = 0; j < 3; ++j) { const size_t idx = (size_t)token * 768 + h * 192 + j * 64 + lane; o[j] = bf2f(OF[idx]) + bf2f(OB[idx]); ss += o[j] * o[j]; }
            ss = wave_sum(ss);
            const float rs = 1.0f / sqrtf(ss * (1.0f / 192.0f) + EPS);
#pragma unroll
            for (int j = 0; j < 3; ++j) { const int dv = j * 64 + lane; const float g = bf2f(act1[(size_t)token * A1_LD + 768 + h * 192 + dv]);
                const float val = o[j] * rs * gnorm[dv] * (g / (1.0f + __expf(-g)));
                mix[(size_t)token * DM + h * 192 + dv] = (bf16)f2bf(val); }
        }
    }
}
__device__ __forceinline__ void route1(const Frame& F, const float* H, const float* gain, const float* wr, int* topi, float* topw, int* cnt) {
    LAS int* lc = (LAS int*)F.lds;
    if (F.tid < 16) lc[F.tid] = 0;
    __syncthreads();
    for (int j = 0; j < 16; ++j) {
        const int token = F.bid * 128 + F.wave * 16 + j, lane = F.lane;
        const float* hr = H + (size_t)token * DM;
        float acc[8], ss = 0.f;
#pragma unroll
        for (int e = 0; e < 8; ++e) acc[e] = 0.f;
#pragma unroll 4
        for (int i = 0; i < 16; ++i) { const int k = i * 64 + lane; const float x = hr[k]; ss += x * x; const float xg = x * gain[k];
            const f32x4 w0 = *(const f32x4*)(wr + k * 8), w1 = *(const f32x4*)(wr + k * 8 + 4);
            acc[0] += xg * w0.x; acc[1] += xg * w0.y; acc[2] += xg * w0.z; acc[3] += xg * w0.w; acc[4] += xg * w1.x; acc[5] += xg * w1.y; acc[6] += xg * w1.z; acc[7] += xg * w1.w; }
        ss = wave_sum(ss); const float rs = 1.0f / sqrtf(ss * (1.0f / DM) + EPS);
#pragma unroll
        for (int e = 0; e < 8; ++e) acc[e] = wave_sum(acc[e]) * rs;
        if (lane == 0) {
            int e0 = 0; float l0 = acc[0];
#pragma unroll
            for (int e = 1; e < 8; ++e) if (acc[e] > l0) { l0 = acc[e]; e0 = e; }
            int e1 = -1; float l1 = -INFINITY;
#pragma unroll
            for (int e = 0; e < 8; ++e) if (e != e0 && acc[e] > l1) { l1 = acc[e]; e1 = e; }
            const float w0 = 1.0f / (1.0f + __expf(l1 - l0));
            topi[token] = e0 | (e1 << 8); topw[2 * token] = w0; topw[2 * token + 1] = 1.0f - w0;
            atomicAdd((int*)&lc[e0], 1); atomicAdd((int*)&lc[8 + e1], 1);
        }
    }
    __syncthreads();
    if (F.tid < 16) cnt[F.bid * 16 + F.tid] = lc[F.tid];
    __syncthreads();
}
__device__ __forceinline__ void route2(const Frame& F, const int* topi, const float* topw, const int* cnt, int* stok, float* sw, int* blk) {
    LAS int* part = (LAS int*)F.lds;
    LAS int* base = part + 1024;
    LAS int* tk = base + 64;
    const int tid = F.tid, pe = tid & 15, jg = tid >> 4;
    int below = 0, tot = 0;
    for (int w = jg; w < F.G; w += 32) { const int v = cnt[w * 16 + pe]; tot += v; if (w < F.bid) below += v; }
    part[jg * 16 + pe] = below; part[512 + jg * 16 + pe] = tot;
    if (tid < 128) tk[tid] = topi[F.bid * 128 + tid];
    __syncthreads();
    if (tid < 16) { int b = 0, t = 0; for (int j = 0; j < 32; ++j) { b += part[j * 16 + tid]; t += part[512 + j * 16 + tid]; } base[tid] = b; base[16 + tid] = t; }
    __syncthreads();
    if (tid < 2) { int ps = 0; for (int e = 0; e < 8; ++e) { base[32 + tid * 8 + e] = ps; ps += (base[16 + tid * 8 + e] + 255) / 256 * 256; } base[48 + tid] = ps / 256; }
    __syncthreads();
    if (tid < 256) {
        const int p = tid >> 7, i = tid & 127; const int e = (tk[i] >> (8 * p)) & 0xff;
        int rank = 0; for (int j = 0; j < i; ++j) rank += (((tk[j] >> (8 * p)) & 0xff) == e) ? 1 : 0;
        const int slot = base[32 + p * 8 + e] + base[p * 8 + e] + rank; const int token = F.bid * 128 + i;
        stok[p * SLOT_CAP + slot] = token; sw[p * SLOT_CAP + slot] = topw[2 * token + p];
    }
    if (F.bid < 16) {
        const int p = F.bid >> 3, e = F.bid & 7, ps = base[32 + F.bid], t = base[16 + F.bid], pend = ps + (t + 255) / 256 * 256;
        for (int s = ps + t + tid; s < pend; s += NTHR) { stok[p * SLOT_CAP + s] = -1; sw[p * SLOT_CAP + s] = 0.f; }
        for (int bk = ps / 256 + tid; bk < pend / 256; bk += NTHR) blk[16 + p * 256 + bk] = e;
        if (e == 0 && tid == 0) blk[p] = base[48 + p];
    }
    __syncthreads();
}
__device__ __forceinline__ void final_norm(const Frame& F, float* H, const float* gain) {
    for (int row = F.gw; row < NT; row += F.NGW) {
        GAS f32x4* xr = (GAS f32x4*)(H + (size_t)row * DM) + F.lane; const f32x4* gr = (const f32x4*)gain + F.lane;
        f32x4 v[4]; float s = 0.f;
#pragma unroll
        for (int j = 0; j < 4; ++j) { v[j] = xr[64 * j]; s += (v[j].x * v[j].x + v[j].y * v[j].y) + (v[j].z * v[j].z + v[j].w * v[j].w); }
        s = wave_sum(s); const float rs = 1.0f / sqrtf(s * (1.0f / DM) + EPS);
#pragma unroll
        for (int j = 0; j < 4; ++j) { const f32x4 g = gr[64 * j]; f32x4 o = {v[j].x * rs * g.x, v[j].y * rs * g.y, v[j].z * rs * g.z, v[j].w * rs * g.w}; xr[64 * j] = o; }
    }
}

constexpr int N_PHASES = 17;
__global__ void __launch_bounds__(NTHR, 2) mega(Args args) {
    extern __shared__ __attribute__((aligned(16))) unsigned char lds_raw[];
    Frame F;
    F.lds = (LAS unsigned char*)lds_raw;
    F.tid = threadIdx.x; F.lane = F.tid & 63; F.wave = __builtin_amdgcn_readfirstlane(F.tid >> 6);
    F.G = gridDim.x; F.bid = blockIdx.x; F.gw = F.bid * NWAVES + F.wave; F.NGW = F.G * NWAVES; F.ws = args.ws;
    unsigned char* ws = args.ws;
    gu32* ctl = (gu32*)(ws + WS_CTL);
    volatile LAS unsigned* MISC = (volatile LAS unsigned*)(F.lds + MISC_OFF);
    for (int u = F.tid; u < (LDS_BYTES - LDSCTL_OFF) / 4; u += NTHR) ((LAS unsigned*)(F.lds + LDSCTL_OFF))[u] = 0u;
    __syncthreads();
    XcdBarrier bar = xcd_barrier_post((unsigned*)(ctl + CW_BAR), MISC + 8);
    const int lo = args.ph_lo, hi = args.ph_hi;
#ifndef PH_MASK
#define PH_MASK 0x1ffff
#endif
#define IN(k) (((PH_MASK >> (k)) & 1) && lo <= (k) && (k) < hi)
#ifndef REPEAT_MASK
#define REPEAT_MASK 0
#endif
#define REPS(k) (1 + ((REPEAT_MASK >> (k)) & 1))
#define SEAM(k) do { if (IN(k) && IN((k) + 1)) xcd_barrier(bar); } while (0)

    float* H = args.out;
    float* rss = (float*)(ws + WS_RSS); float* mrss = (float*)(ws + WS_MRSS);
    bf16* hbf = (bf16*)(ws + WS_HBF); bf16* membf = (bf16*)(ws + WS_MEMBF); bf16* memk = (bf16*)(ws + WS_MEMK); bf16* memvt = (bf16*)(ws + WS_MEMVT);
    bf16* act0 = (bf16*)(ws + WS_ACT0); bf16* v0t = (bf16*)(ws + WS_V0T); bf16* mix = (bf16*)(ws + WS_MIX); bf16* hmid0 = (bf16*)(ws + WS_HMID0);
    bf16* act1 = (bf16*)(ws + WS_ACT1); bf16* v1t = (bf16*)(ws + WS_V1T); bf16* OF = (bf16*)(ws + WS_OF); bf16* OB = (bf16*)(ws + WS_OB);
    bf16* hmid1 = (bf16*)(ws + WS_HMID1); bf16* wgu = (bf16*)(ws + WS_WGU); bf16* wdn = (bf16*)(ws + WS_WDN);
    int* cnt = (int*)(ws + WS_CNT); int* topi = (int*)(ws + WS_TOPI); float* topw = (float*)(ws + WS_TOPW);
    int* stok = (int*)(ws + WS_STOK); float* sw = (float*)(ws + WS_SW); int* blk = (int*)(ws + WS_BLK);
    LAS float* scr = (LAS float*)(F.lds + F.wave * 16384);

    if (IN(0)) for (int rep_ = 0; rep_ < REPS(0); ++rep_) {
        int it = F.gw;
#define CVT(Wp, Kd, Nd, WTp, gainp, kind) do { const CvtJob J{Wp, Kd, Nd, (bf16*)(WTp), gainp, kind}; const int n_ = ((Kd) / 64) * ((Nd) / 32); \
            for (; it < n_; it += F.NGW) cvt_job_item(J, it, scr, F.lane); it -= n_; } while (0)
        CVT(args.in[I_EWIN], 1024, 2560, ws + WS_W0IN, args.in[I_EN1], 1);
        CVT(args.in[I_EWIN], 1024, 2560, ws + WS_WV0, args.in[I_EN1], 2);
        CVT(args.in[I_EWOUT], 1024, 1024, ws + WS_W0OUT, nullptr, 0);
        CVT(args.in[I_EWG], 1024, 2816, ws + WS_W0GU, args.in[I_EN2], 3);
        CVT(args.in[I_EWU], 1024, 2816, ws + WS_W0GU, args.in[I_EN2], 4);
        CVT(args.in[I_EWD], 2816, 1024, ws + WS_W0DN, nullptr, 0);
        CVT(args.in[I_WMKV], 1024, 512, ws + WS_WMEM, args.in[I_MNORM], 0);
        CVT(args.in[I_OWIN], 1024, 2592, ws + WS_W1IN, args.in[I_ON1], 5);
        CVT(args.in[I_OWIN], 1024, 2592, ws + WS_WV1, args.in[I_ON1], 6);
        CVT(args.in[I_OWOUT], 1024, 1024, ws + WS_W1OUT, nullptr, 0);
#undef CVT
        { v4u z = {0u, 0u, 0u, 0u}; v4u* p = (v4u*)(ws + WS_W1IN + (size_t)1824 * 2048); const int n16 = 224 * 2048 / 16;
          for (int i = F.bid * NTHR + F.tid; i < n16; i += F.G * NTHR) p[i] = z; }
        for (int m = F.gw; m < NT; m += F.NGW) row_to_bf16(args.in[I_X] + (size_t)m * DM, hbf + (size_t)m * DM, rss + (size_t)m * 16, F.lane);
        for (int m = F.gw; m < MEM_ROWS; m += F.NGW) row_to_bf16(args.in[I_MEM] + (size_t)m * DM, membf + (size_t)m * DM, mrss + (size_t)m * 16, F.lane);
    }
    SEAM(0);
    if (IN(1)) for (int rep_ = 0; rep_ < REPS(1); ++rep_) {
        { Sched S; S.init(hbf, ws + WS_W0IN, 1024, 128, 7, F.G, F.bid); EpiRowScale E{act0, A0_LD, rss}; gemm_run<EpiRowScale, false>(F.lds, S, E, nullptr); }
        { Sched S; S.init(ws + WS_WV0, hbf, 1024, 3, 128, F.G, (F.bid + 128) % F.G); EpiColScale E{v0t, NT, rss}; gemm_run<EpiColScale, false>(F.lds, S, E, nullptr); }
        { Sched S; S.init(membf, ws + WS_WMEM, 1024, 8, 1, F.G, F.bid); EpiRowScale E{memk, 256, mrss}; gemm_run<EpiRowScale, false>(F.lds, S, E, nullptr); }
        { Sched S; S.init(ws + WS_WMEM + 256 * 2048, membf, 1024, 1, 8, F.G, (F.bid + 248) % F.G); EpiColScale E{memvt, MEM_ROWS, mrss}; gemm_run<EpiColScale, false>(F.lds, S, E, nullptr); }
    }
    SEAM(1);
    if (IN(2)) for (int rep_ = 0; rep_ < REPS(2); ++rep_) {
#if FAST_ATT
        { LAS float* rl = (LAS float*)F.lds; for (int i = F.tid; i < 5580; i += NTHR) rl[i] = args.in[I_RPB][i]; __syncthreads();
          for (int it = F.gw; it < 32768; it += F.NGW) { if (it < 24576) na_item(it, F.lane, act0, v0t, rl, mix); else memattn_item(it - 24576, F.lane, act0, A0_LD, 1536, memk, memvt, mix); }
          __syncthreads(); }
#else
        na_simple(F, act0, v0t, args.in[I_RPB], mix);
        memattn_simple(F, F.gw, F.NGW, act0, A0_LD, 1536, memk, memvt, mix);
#endif
    }
    SEAM(2);
    if (IN(3)) for (int rep_ = 0; rep_ < REPS(3); ++rep_) {
        Sched S; S.init(mix, ws + WS_W0OUT, 1024, 128, 4, F.G, F.bid); EpiResid E{args.in[I_X], H, hbf, rss}; gemm_run<EpiResid, false>(F.lds, S, E, nullptr);
    }
    SEAM(3);
    if (IN(4)) for (int rep_ = 0; rep_ < REPS(4); ++rep_) {
        Sched S; S.init(hbf, ws + WS_W0GU, 1024, 128, 22, F.G, F.bid); EpiSwiGLU E{hmid0, FF0, rss, nullptr}; gemm_run<EpiSwiGLU, false>(F.lds, S, E, nullptr);
    }
    SEAM(4);
    if (IN(5)) for (int rep_ = 0; rep_ < REPS(5); ++rep_) {
        Sched S; S.init(hmid0, ws + WS_W0DN, FF0, 128, 4, F.G, F.bid); EpiResid E{H, H, hbf, rss}; gemm_run<EpiResid, false>(F.lds, S, E, nullptr);
    }
    SEAM(5);
    if (IN(6)) for (int rep_ = 0; rep_ < REPS(6); ++rep_) {
        { Sched S; S.init(hbf, ws + WS_W1IN, 1024, 128, 8, F.G, F.bid); EpiRowScale E{act1, A1_LD, rss}; gemm_run<EpiRowScale, false>(F.lds, S, E, nullptr); }
        { Sched S; S.init(ws + WS_WV1, hbf, 1024, 3, 128, F.G, F.bid); EpiColScale E{v1t, NT, rss}; gemm_run<EpiColScale, false>(F.lds, S, E, nullptr); }
    }
    SEAM(6);
    if (IN(7)) for (int rep_ = 0; rep_ < REPS(7); ++rep_) {
#if FAST_GLA
        for (int it = F.bid; it < 1024; it += F.G) { const int dir = (it >> 6) & 1;
            gla_pre_item(it, F.wave, F.lane, act1, dir ? args.in[I_WGKB] : args.in[I_WGKF], dir ? args.in[I_BGKB] : args.in[I_BGKF], (bf16*)(ws + WS_E) + (size_t)dir * NT * 384); }
        for (int it = F.gw; it < 8192; it += F.NGW) memattn_item(it, F.lane, act1, A1_LD, 1536, memk, memvt, mix);
        xcd_barrier(bar);
        for (int it = F.bid; it < 256; it += F.G) gla_main_item(F, it, act1, v1t, (const bf16*)(ws + WS_E), OF, OB);
#else
        if (F.bid < 64) {
            const int dir = F.bid & 1;
            gla_simple(F, F.bid, act1, v1t, dir ? args.in[I_WGKB] : args.in[I_WGKF], dir ? args.in[I_BGKB] : args.in[I_BGKF], dir ? OB : OF);
        } else {
#if FAST_ATT
            for (int it = (F.bid - 64) * NWAVES + F.wave; it < 8192; it += (F.G - 64) * NWAVES) memattn_item(it, F.lane, act1, A1_LD, 1536, memk, memvt, mix);
#else
            memattn_simple(F, (F.bid - 64) * NWAVES + F.wave, (F.G - 64) * NWAVES, act1, A1_LD, 1536, memk, memvt, mix);
#endif
        }
#endif
    }
    SEAM(7);
    if (IN(8)) for (int rep_ = 0; rep_ < REPS(8); ++rep_) gla_combine(F, OF, OB, act1, args.in[I_GNORM], mix);
    SEAM(8);
    if (IN(9)) for (int rep_ = 0; rep_ < REPS(9); ++rep_) {
        Sched S; S.init(mix, ws + WS_W1OUT, 1024, 128, 4, F.G, F.bid); EpiResid E{H, H, hbf, rss}; gemm_run<EpiResid, false>(F.lds, S, E, nullptr);
    }
    SEAM(9);
    if (IN(10)) for (int rep_ = 0; rep_ < REPS(10); ++rep_) {
        route1(F, H, args.in[I_ON2], args.in[I_WR], topi, topw, cnt);
        for (int it = F.gw; it < 8 * 3 * 1792; it += F.NGW) {
            const int e = it / 5376, r = it % 5376, which = r / 1792, item = r % 1792;
            if (which == 0) { CvtJob J{args.in[I_OWG] + (size_t)e * 1024 * FFE, 1024, FFE, wgu + (size_t)e * 7168 * 1024, args.in[I_ON2], 3}; cvt_job_item(J, item, scr, F.lane); }
            else if (which == 1) { CvtJob J{args.in[I_OWU] + (size_t)e * 1024 * FFE, 1024, FFE, wgu + (size_t)e * 7168 * 1024, args.in[I_ON2], 4}; cvt_job_item(J, item, scr, F.lane); }
            else { CvtJob J{args.in[I_OWD] + (size_t)e * FFE * 1024, FFE, 1024, wdn + (size_t)e * 1024 * FFE, nullptr, 0}; cvt_job_item(J, item, scr, F.lane); }
        }
    }
    SEAM(10);
    if (IN(11)) for (int rep_ = 0; rep_ < REPS(11); ++rep_) route2(F, topi, topw, cnt, stok, sw, blk);
    SEAM(11);
    if (IN(12)) for (int rep_ = 0; rep_ < REPS(12); ++rep_) {
        const int nb = blk[0]; Sched S; S.init(hbf, wgu, 1024, nb, 28, F.G, F.bid, blk + 16, (size_t)7168 * 1024 * 2); EpiSwiGLU E{hmid1, FFE, rss, stok}; gemm_run<EpiSwiGLU, true>(F.lds, S, E, stok);
    }
    SEAM(12);
    if (IN(13)) for (int rep_ = 0; rep_ < REPS(13); ++rep_) {
        const int nb = blk[0]; Sched S; S.init(hmid1, wdn, FFE, nb, 4, F.G, F.bid, blk + 16, (size_t)1024 * FFE * 2); EpiMoeDown E{H, stok, sw}; gemm_run<EpiMoeDown, false>(F.lds, S, E, nullptr);
    }
    SEAM(13);
    if (IN(14)) for (int rep_ = 0; rep_ < REPS(14); ++rep_) {
        const int nb = blk[1]; Sched S; S.init(hbf, wgu, 1024, nb, 28, F.G, F.bid, blk + 16 + 256, (size_t)7168 * 1024 * 2); EpiSwiGLU E{hmid1, FFE, rss, stok + SLOT_CAP}; gemm_run<EpiSwiGLU, true>(F.lds, S, E, stok + SLOT_CAP);
    }
    SEAM(14);
    if (IN(15)) for (int rep_ = 0; rep_ < REPS(15); ++rep_) {
        const int nb = blk[1]; Sched S; S.init(hmid1, wdn, FFE, nb, 4, F.G, F.bid, blk + 16 + 256, (size_t)1024 * FFE * 2); EpiMoeDown E{H, stok + SLOT_CAP, sw + SLOT_CAP}; gemm_run<EpiMoeDown, false>(F.lds, S, E, nullptr);
    }
    SEAM(15);
    if (IN(16)) final_norm(F, H, args.in[I_FNORM]);
#undef IN
#undef SEAM
}

extern "C" void kernel_launch(void* const* d_in, const int* in_sizes, int n_in, void* d_out, int out_size, void* d_ws, size_t ws_size, hipStream_t stream) {
    static int grid = 0;
    if (grid == 0) {
        if (n_in != 26 || out_size != NT * DM || ws_size < WS_END) { fprintf(stderr, "kernel_launch: unexpected problem (n_in %d out %d ws %zu need %zu)\n", n_in, out_size, ws_size, (size_t)WS_END); grid = -1; return; }
        int dev = 0, cus = 0, per_cu = 0;
        if (hipGetDevice(&dev) != hipSuccess || hipDeviceGetAttribute(&cus, hipDeviceAttributeMultiprocessorCount, dev) != hipSuccess) { grid = -1; return; }
        if (hipFuncSetAttribute((const void*)mega, hipFuncAttributeMaxDynamicSharedMemorySize, LDS_BYTES) != hipSuccess) { fprintf(stderr, "kernel_launch: hipFuncSetAttribute failed\n"); grid = -1; return; }
        if (hipOccupancyMaxActiveBlocksPerMultiprocessor(&per_cu, (const void*)mega, NTHR, LDS_BYTES) != hipSuccess || per_cu < 1) fprintf(stderr, "kernel_launch: occupancy query reports %d\n", per_cu);
        (void)hipGetLastError();
        grid = cus;
        if (grid != 256) fprintf(stderr, "kernel_launch: note: %d CUs\n", grid);
    }
    if (grid < 0) return;
    if (hipMemsetAsync((char*)d_ws + WS_CTL, 0, CTL_ZERO_BYTES, stream) != hipSuccess) return;
    Args a{};
    for (int i = 0; i < 26; ++i) a.in[i] = (const float*)d_in[i];
    a.out = (float*)d_out; a.ws = (unsigned char*)d_ws;
#if MK_FUSED
    a.ph_lo = 0; a.ph_hi = N_PHASES;
    hipLaunchKernelGGL(mega, dim3(grid), dim3(NTHR), LDS_BYTES, stream, a);
#else
    for (int p = 0; p < N_PHASES; ++p) { a.ph_lo = p; a.ph_hi = p + 1; hipLaunchKernelGGL(mega, dim3(grid), dim3(NTHR), LDS_BYTES, stream, a); }
#endif
}
```

```cpp
#include <hip/hip_runtime.h>
#include <cstdio>
#include <cstdint>

#ifndef MK_FUSED
#define MK_FUSED 1
#endif
#ifndef FAST_GEMM
#define FAST_GEMM 1
#endif
#ifndef FAST_ATT
#define FAST_ATT 1
#endif
#ifndef FAST_GLA
#define FAST_GLA 1
#endif

#define GAS __attribute__((address_space(1)))
#define LAS __attribute__((address_space(3)))
typedef unsigned short bf16;
typedef unsigned v4u __attribute__((ext_vector_type(4)));
typedef unsigned v2u __attribute__((ext_vector_type(2)));
typedef float f32x4 __attribute__((ext_vector_type(4)));
typedef short bf16x8 __attribute__((ext_vector_type(8)));
typedef GAS unsigned gu32;
#define RLX_AGENT __ATOMIC_RELAXED, __HIP_MEMORY_SCOPE_AGENT
#define LDS_WAIT() asm volatile("s_waitcnt lgkmcnt(0)" ::: "memory")
#define VM_WAIT() asm volatile("s_waitcnt vmcnt(0)" ::: "memory")

constexpr int NT = 32768, DM = 1024, SEQ = 4096, NB = 8;
constexpr int MEM_ROWS = 2048;
constexpr int A0_LD = 1792;
constexpr int A1_LD = 2048;
constexpr int FF0 = 2816, FFE = 3584, NEXP = 8;
constexpr int SLOT_CAP = 34816;
constexpr float EPS = 1e-6f;
constexpr int NWAVES = 8, NTHR = 512;

constexpr size_t MiB = 1u << 20;
constexpr size_t WS_CTL = 0, CTL_ZERO_BYTES = 1 * MiB;
constexpr size_t WS_RSS = 1 * MiB;
constexpr size_t WS_MRSS = 3 * MiB;
constexpr size_t WS_CNT = 3 * MiB + 256 * 1024;
constexpr size_t WS_TOPI = 3 * MiB + 512 * 1024;
constexpr size_t WS_TOPW = 3 * MiB + 768 * 1024;
constexpr size_t WS_STOK = 4 * MiB;
constexpr size_t WS_SW = 4 * MiB + 512 * 1024;
constexpr size_t WS_BLK = 5 * MiB;
constexpr size_t WS_W0IN = 6 * MiB;
constexpr size_t WS_WV0 = WS_W0IN + 1792 * 2048;
constexpr size_t WS_W0OUT = 11 * MiB;
constexpr size_t WS_W0GU = 13 * MiB;
constexpr size_t WS_W0DN = 24 * MiB;
constexpr size_t WS_WMEM = WS_W0DN + 1024 * 2816 * 2;
constexpr size_t WS_W1IN = 31 * MiB;
constexpr size_t WS_WV1 = 35 * MiB;
constexpr size_t WS_W1OUT = 37 * MiB - 512 * 1024;
constexpr size_t WS_HBF = 39 * MiB;
constexpr size_t WS_MEMBF = 103 * MiB;
constexpr size_t WS_MEMK = 107 * MiB;
constexpr size_t WS_MEMVT = 108 * MiB;
constexpr size_t WS_ACT = 109 * MiB;
constexpr size_t WS_ACT0 = WS_ACT;
constexpr size_t WS_V0T = WS_ACT + 112 * MiB;
constexpr size_t WS_MIX = WS_ACT + 176 * MiB;
constexpr size_t WS_HMID0 = WS_ACT;
constexpr size_t WS_ACT1 = WS_ACT;
constexpr size_t WS_V1T = WS_ACT + 128 * MiB;
constexpr size_t WS_OF = WS_ACT + 240 * MiB;
constexpr size_t WS_OB = WS_ACT + 288 * MiB;
constexpr size_t WS_E = WS_ACT + 336 * MiB;
constexpr size_t WS_HMID1 = WS_ACT;
constexpr size_t WS_WGU = WS_ACT + 240 * MiB;
constexpr size_t WS_WDN = WS_ACT + 352 * MiB;
constexpr size_t WS_END = WS_ACT + 408 * MiB;
static_assert(WS_W1OUT + 2 * MiB <= WS_HBF && WS_WV1 + 768 * 2048 <= WS_W1OUT && WS_W1IN + 4 * MiB <= WS_WV1 && WS_WMEM + MiB <= WS_W1IN, "weight map");
static_assert(WS_W0GU + 11 * MiB <= WS_W0DN && WS_WV0 + 768 * 2048 <= WS_W0OUT, "weight map 2");
static_assert((size_t)SLOT_CAP * 3584 * 2 <= 240 * MiB, "hmid1");

constexpr int CW_TMO = 0, CW_CODE = 1, CW_BAR = 4096;

constexpr int RING_BYTES = 131072;
constexpr int LDSCTL_OFF = RING_BYTES, MISC_OFF = LDSCTL_OFF + 320;
constexpr int LDS_BYTES = 147456;

__device__ __forceinline__ unsigned f2bf(float f) { unsigned u = __builtin_bit_cast(unsigned, f); return (u + 0x7fffu + ((u >> 16) & 1u)) >> 16; }
__device__ __forceinline__ unsigned pk2(float lo, float hi) { return f2bf(lo) | (f2bf(hi) << 16); }
__device__ __forceinline__ float bf2f(bf16 b) { return __builtin_bit_cast(float, (unsigned)b << 16); }
__device__ __forceinline__ float bflo(unsigned u) { return __builtin_bit_cast(float, u << 16); }
__device__ __forceinline__ float bfhi(unsigned u) { return __builtin_bit_cast(float, u & 0xffff0000u); }
__device__ __forceinline__ float wave_sum(float v) {
#pragma unroll
    for (int o = 1; o < 64; o <<= 1) v += __shfl_xor(v, o);
    return v;
}
__device__ __forceinline__ float wave_max(float v) {
#pragma unroll
    for (int o = 1; o < 64; o <<= 1) v = fmaxf(v, __shfl_xor(v, o));
    return v;
}

#define XB_TMO      128
#define XB_XCNT(j)  (256  + 64 * (j))
#define XB_XSUB(j)  (1280 + 64 * (j))
#define XB_XGEN(j)  (2304 + 64 * (j))
#define XB_TOP      3328
#define XB_TOPGEN   3392
#define XCD_BAR_WORDS 3456
#define XB_SPIN_CAP (1u << 22)

__device__ __forceinline__ unsigned xb_ld(unsigned* p)              { return __hip_atomic_load(p, __ATOMIC_RELAXED, __HIP_MEMORY_SCOPE_AGENT); }
__device__ __forceinline__ unsigned xb_add(unsigned* p, unsigned v) { return __hip_atomic_fetch_add(p, v, __ATOMIC_RELAXED, __HIP_MEMORY_SCOPE_AGENT); }
__device__ __forceinline__ unsigned xb_xcc_id() { return (unsigned)__builtin_amdgcn_s_getreg((3 << 11) | 20) & 0xFu; }
#define XB_SPIN(cond, bar) do { unsigned _sp = 0; while (cond) { __builtin_amdgcn_s_sleep(1); \
    if ((++_sp & 255u) == 0u) { if (xb_ld(&(bar)[XB_TMO])) break; if (_sp > XB_SPIN_CAP) { atomicAdd(&(bar)[XB_TMO], 1u); break; } } } } while (0)

struct XcdBarrier { unsigned* bar; unsigned x; volatile LAS unsigned* st; };

__device__ __forceinline__ XcdBarrier xcd_barrier_post(unsigned* bar, volatile LAS unsigned* st) {
    XcdBarrier b; b.bar = bar; b.x = xb_xcc_id(); b.st = st;
    if (threadIdx.x == 0) (void)xb_add(&bar[XB_XCNT(b.x)], 1u);
    return b;
}
__device__ __forceinline__ void xcd_barrier_complete(unsigned* bar, unsigned x, unsigned& nloc, unsigned& nx) {
    const unsigned G = gridDim.x * gridDim.y * gridDim.z;
    unsigned sum, cnt, mine, sp = 0u;
    for (;;) {
        sum = 0u; cnt = 0u; mine = 0u;
#pragma unroll
        for (unsigned j = 0; j < 16; ++j) { const unsigned c = xb_ld(&bar[XB_XCNT(j)]); sum += c; cnt += (c > 0u) ? 1u : 0u; mine = (j == x) ? c : mine; }
        if (sum == G) break;
        __builtin_amdgcn_s_sleep(1);
        if ((++sp & 255u) == 0u) { if (xb_ld(&bar[XB_TMO])) break; if (sp > XB_SPIN_CAP) { atomicAdd(&bar[XB_TMO], 1u); break; } }
    }
    nloc = mine > 0u ? mine : 1u; nx = cnt > 0u ? cnt : 1u;
}
__device__ __forceinline__ void xcd_barrier(const XcdBarrier& b) {
    asm volatile("s_waitcnt vmcnt(0)" ::: "memory");
    __syncthreads();
    if (threadIdx.x == 0) {
        unsigned* bar = b.bar;
        __builtin_amdgcn_s_waitcnt(0);
        unsigned nloc = b.st[0], nx = b.st[1];
        if (nloc == 0u) { xcd_barrier_complete(bar, b.x, nloc, nx); b.st[0] = nloc; b.st[1] = nx; }
        const unsigned old = xb_add(&bar[XB_XSUB(b.x)], 1u);
        const unsigned gen = old / nloc;
        if (old + 1u == (gen + 1u) * nloc) {
            __builtin_amdgcn_fence(__ATOMIC_RELEASE, "agent");
            asm volatile("s_waitcnt vmcnt(0)" ::: "memory");
            const unsigned og = xb_add(&bar[XB_TOP], 1u);
            const unsigned tg = og / nx;
            if (og + 1u == (tg + 1u) * nx) xb_add(&bar[XB_TOPGEN], 1u);
            else XB_SPIN(xb_ld(&bar[XB_TOPGEN]) == tg, bar);
            __builtin_amdgcn_fence(__ATOMIC_ACQUIRE, "agent");
            xb_add(&bar[XB_XGEN(b.x)], 1u);
            asm volatile("s_waitcnt vmcnt(0)" ::: "memory");
        } else {
            XB_SPIN(xb_ld(&bar[XB_XGEN(b.x)]) == gen, bar);
            __builtin_amdgcn_fence(__ATOMIC_ACQUIRE, "agent");
            asm volatile("s_waitcnt vmcnt(0)" ::: "memory");
        }
    }
    __syncthreads();
}

struct Args { const float* in[26]; float* out; unsigned char* ws; int ph_lo, ph_hi; };
enum { I_X = 0, I_MEM, I_EN1, I_EWIN, I_RPB, I_EWOUT, I_EN2, I_EWG, I_EWU, I_EWD, I_ON1, I_OWIN, I_WGKF, I_BGKF, I_WGKB, I_BGKB, I_GNORM, I_OWOUT, I_ON2, I_WR, I_OWG, I_OWU, I_OWD, I_MNORM, I_WMKV, I_FNORM };

struct Frame {
    LAS unsigned char* lds;
    int tid, lane, wave, G, bid;
    int gw, NGW;
    unsigned char* ws;
};

struct CvtJob { const float* W; int K, N; bf16* WT; const float* gain; int kind; };
__device__ __forceinline__ bool cvt_map(int kind, int n0, int& drow, float& scale) {
    scale = 1.0f;
    switch (kind) {
    case 0: drow = n0; return true;
    case 1: if (n0 < 768) { drow = n0; scale = 0.125f; return true; } if (n0 < 1536) { drow = n0; return true; } if (n0 >= 2304) { drow = n0 - 768; scale = 0.125f; return true; } return false;
    case 2: if (n0 >= 1536 && n0 < 2304) { drow = n0 - 1536; return true; } return false;
    case 3: drow = (n0 >> 7) * 256 + (n0 & 127); return true;
    case 4: drow = (n0 >> 7) * 256 + 128 + (n0 & 127); return true;
    case 5: if (n0 < 768) { drow = n0; return true; } if (n0 < 1536) return false; if (n0 < 2304) { drow = n0 - 768; return true; }
            if (n0 < 2336) { drow = n0 - 512; return true; } drow = n0 - 800; scale = 0.125f; return true;
    case 6: if (n0 >= 768 && n0 < 1536) { drow = n0 - 768; return true; } return false;
    default: drow = n0; return true;
    }
}
struct CvtRegs { f32x4 v[8]; const float* gain; bf16* WT; int K, k0, drow, valid; float scale; };
__device__ __forceinline__ void cvt_load(CvtRegs& R, const CvtJob& J, int item, int lane) {
    const int nblk = J.N / 32, kb = item / nblk, nb = item % nblk, n0 = nb * 32;
    R.k0 = kb * 64; R.gain = J.gain; R.WT = J.WT; R.K = J.K;
    R.valid = cvt_map(J.kind, n0, R.drow, R.scale) ? 1 : 0;
    if (R.valid) { const float* p = J.W + (size_t)(R.k0 + 2 * (lane >> 3)) * J.N + n0 + 4 * (lane & 7);
#pragma unroll
        for (int j = 0; j < 8; ++j) R.v[j] = *(const f32x4*)(p + (size_t)(16 * (j >> 1) + (j & 1)) * J.N); }
}
__device__ __forceinline__ void cvt_finish(const CvtRegs& R, LAS unsigned* T, int lane) {
    if (!R.valid) return;
    const int nq = lane & 7, kr = lane >> 3;
#pragma unroll
    for (int p = 0; p < 4; ++p) { const int k = R.k0 + 16 * p + 2 * kr; float g0 = R.scale, g1 = R.scale; if (R.gain) { g0 *= R.gain[k]; g1 *= R.gain[k + 1]; }
        const f32x4 a = R.v[2 * p], b = R.v[2 * p + 1]; LAS unsigned* t = T + (4 * nq) * 33 + 8 * p + kr;
        t[0] = pk2(a.x * g0, b.x * g1); t[33] = pk2(a.y * g0, b.y * g1); t[66] = pk2(a.z * g0, b.z * g1); t[99] = pk2(a.w * g0, b.w * g1); }
    LDS_WAIT(); asm volatile("" ::: "memory");
#pragma unroll
    for (int r = 0; r < 4; ++r) { const int n = (lane >> 3) + 8 * r, c = lane & 7; const LAS unsigned* sp = T + n * 33 + 4 * c;
        v4u o; o.x = sp[0]; o.y = sp[1]; o.z = sp[2]; o.w = sp[3];
        *(GAS v4u*)(R.WT + (size_t)(R.drow + n) * R.K + R.k0 + 8 * c) = o; }
    LDS_WAIT(); asm volatile("" ::: "memory");
}
__device__ __forceinline__ void rows_to_bf16(const float* X, bf16* Ob, float* rss, int first, int nrows, int stride, int lane) {
    for (int m = first; m < nrows; m += 2 * stride) {
        const int m2 = m + stride; const bool h2 = m2 < nrows;
        const GAS f32x4* xa = (const GAS f32x4*)(X + (size_t)m * DM) + lane; const GAS f32x4* xb = (const GAS f32x4*)(X + (size_t)(h2 ? m2 : m) * DM) + lane;
        f32x4 va[4], vb[4];
#pragma unroll
        for (int j = 0; j < 4; ++j) va[j] = xa[64 * j];
#pragma unroll
        for (int j = 0; j < 4; ++j) vb[j] = xb[64 * j];
        float sa = 0.f, sb = 0.f;
#pragma unroll
        for (int j = 0; j < 4; ++j) { sa += (va[j].x * va[j].x + va[j].y * va[j].y) + (va[j].z * va[j].z + va[j].w * va[j].w); sb += (vb[j].x * vb[j].x + vb[j].y * vb[j].y) + (vb[j].z * vb[j].z + vb[j].w * vb[j].w); }
        sa = wave_sum(sa); sb = wave_sum(sb);
        GAS unsigned long long* oa = (GAS unsigned long long*)(Ob + (size_t)m * DM) + lane;
#pragma unroll
        for (int j = 0; j < 4; ++j) oa[64 * j] = (unsigned long long)pk2(va[j].x, va[j].y) | ((unsigned long long)pk2(va[j].z, va[j].w) << 32);
        if (lane < 16) rss[(size_t)m * 16 + lane] = (lane == 0) ? sa : 0.f;
        if (h2) { GAS unsigned long long* ob = (GAS unsigned long long*)(Ob + (size_t)m2 * DM) + lane;
#pragma unroll
            for (int j = 0; j < 4; ++j) ob[64 * j] = (unsigned long long)pk2(vb[j].x, vb[j].y) | ((unsigned long long)pk2(vb[j].z, vb[j].w) << 32);
            if (lane < 16) rss[(size_t)m2 * 16 + lane] = (lane == 0) ? sb : 0.f; }
    }
}

struct Unit { int pm, pn; };
struct Sched {
    int nM, nN, nwg, G, c, K;
    const char* A; const char* B; const int* bexp; size_t estride;
    __device__ void init(const void* A_, const void* B_, int K_, int nM_, int nN_, int G_, int c_, const int* bexp_ = nullptr, size_t estride_ = 0) {
        A = (const char*)A_; B = (const char*)B_; K = K_; nM = nM_; nN = nN_; nwg = nM * nN; G = G_; c = c_; bexp = bexp_; estride = estride_; }
    __device__ bool next(int i, Unit& u) const {
        const long L = (long)i * G + c; if (L >= nwg) return false;
        int wgid = (int)L; { const int q = nwg / 8, r = nwg % 8, xcd = wgid % 8, off = wgid / 8; wgid = (xcd < r ? xcd * (q + 1) : r * (q + 1) + (xcd - r) * q) + off; }
        const int nig = 8 * nN, gid = wgid / nig, fm = gid * 8, gsz = (nM - fm) < 8 ? (nM - fm) : 8;
        u.pm = fm + ((wgid % nig) % gsz); u.pn = (wgid % nig) / gsz; return true;
    }
    __device__ const char* a_base(const Unit& u) const { return A + (size_t)u.pm * 512 * K; }
    __device__ const char* b_base(const Unit& u) const { return B + (bexp ? (size_t)bexp[u.pm] * estride : (size_t)0) + (size_t)u.pn * 512 * K; }
};

struct NoAux {};
__device__ __forceinline__ float rstd_from(const float* rss16) {
    const f32x4* p = (const f32x4*)rss16; f32x4 a = p[0], b = p[1], c = p[2], d = p[3];
    const float s = ((a.x + a.y) + (a.z + a.w)) + ((b.x + b.y) + (b.z + b.w)) + ((c.x + c.y) + (c.z + c.w)) + ((d.x + d.y) + (d.z + d.w));
    return __builtin_amdgcn_rsqf(s * (1.0f / DM) + EPS);
}
struct RowCtx { float rs[2][4]; };
__device__ __forceinline__ void row_scales(RowCtx& c, const float* rss, const int (&t)[2][4], int fq) {
    f32x4 p[2][4];
#pragma unroll
    for (int ai = 0; ai < 2; ++ai)
#pragma unroll
        for (int m = 0; m < 4; ++m) p[ai][m] = *(const f32x4*)(rss + (size_t)(t[ai][m] < 0 ? 0 : t[ai][m]) * 16 + 4 * fq);
#pragma unroll
    for (int ai = 0; ai < 2; ++ai)
#pragma unroll
        for (int m = 0; m < 4; ++m) { float s = (p[ai][m].x + p[ai][m].y) + (p[ai][m].z + p[ai][m].w); s += __shfl_xor(s, 16); s += __shfl_xor(s, 32);
            c.rs[ai][m] = t[ai][m] < 0 ? 0.f : __builtin_amdgcn_rsqf(s * (1.0f / DM) + EPS); }
}
struct EpiRowScale {
    static constexpr bool NEED_SS = false; typedef RowCtx Ctx; typedef NoAux Aux;
    bf16* O; int ldc; const float* rss;
    __device__ __forceinline__ void begin(Ctx& c, int row0, int, int c128) const {
        int t[2][4];
#pragma unroll
        for (int ai = 0; ai < 2; ++ai)
#pragma unroll
            for (int m = 0; m < 4; ++m) t[ai][m] = row0 + ai * 128 + m * 16;
        row_scales(c, rss, t, (c128 >> 3) & 3);
    }
    __device__ __forceinline__ void load_aux(Aux&, const Ctx&, int, int, int, int, int) const {}
    __device__ __forceinline__ float apply(const Ctx& c, const Aux&, int ai, int m, int row, int pn, int c128, const float (&a)[8], const float (&b)[8]) const {
        const float s = c.rs[ai][m];
        bf16* p = O + (size_t)row * ldc + pn * 256 + c128;
        v4u w; w.x = pk2(a[0] * s, a[1] * s); w.y = pk2(a[2] * s, a[3] * s); w.z = pk2(a[4] * s, a[5] * s); w.w = pk2(a[6] * s, a[7] * s); *(v4u*)p = w;
        w.x = pk2(b[0] * s, b[1] * s); w.y = pk2(b[2] * s, b[3] * s); w.z = pk2(b[4] * s, b[5] * s); w.w = pk2(b[6] * s, b[7] * s); *(v4u*)(p + 128) = w;
        return 0.f;
    }
    __device__ __forceinline__ void row_done(int, int, int, float) const {}
};
struct ColCtx { float sa[8], sb[8]; };
struct EpiColScale {
    static constexpr bool NEED_SS = false; typedef ColCtx Ctx; typedef NoAux Aux;
    bf16* O; int ldc; const float* rss;
    __device__ __forceinline__ void begin(Ctx& c, int row0, int pn, int c128) const {
        const int fr = row0 & 15, lane = threadIdx.x & 63;
        const float mine = rstd_from(rss + (size_t)(pn * 256 + c128 + (fr & 7) + (fr >> 3) * 128) * 16);
#pragma unroll
        for (int j = 0; j < 8; ++j) { c.sa[j] = __shfl(mine, (lane & 48) + j); c.sb[j] = __shfl(mine, (lane & 48) + 8 + j); }
    }
    __device__ __forceinline__ void load_aux(Aux&, const Ctx&, int, int, int, int, int) const {}
    __device__ __forceinline__ float apply(const Ctx& c, const Aux&, int, int, int row, int pn, int c128, const float (&a)[8], const float (&b)[8]) const {
        bf16* p = O + (size_t)row * ldc + pn * 256 + c128;
        v4u w; w.x = pk2(a[0] * c.sa[0], a[1] * c.sa[1]); w.y = pk2(a[2] * c.sa[2], a[3] * c.sa[3]); w.z = pk2(a[4] * c.sa[4], a[5] * c.sa[5]); w.w = pk2(a[6] * c.sa[6], a[7] * c.sa[7]); *(v4u*)p = w;
        w.x = pk2(b[0] * c.sb[0], b[1] * c.sb[1]); w.y = pk2(b[2] * c.sb[2], b[3] * c.sb[3]); w.z = pk2(b[4] * c.sb[4], b[5] * c.sb[5]); w.w = pk2(b[6] * c.sb[6], b[7] * c.sb[7]); *(v4u*)(p + 128) = w;
        return 0.f;
    }
    __device__ __forceinline__ void row_done(int, int, int, float) const {}
};
struct Aux4 { f32x4 v[4]; };
struct NoCtx {};
struct EpiResid {
    static constexpr bool NEED_SS = true; typedef NoCtx Ctx; typedef Aux4 Aux;
    const float* R; float* H; bf16* HB; float* rss;
    __device__ __forceinline__ void begin(Ctx&, int, int, int) const {}
    __device__ __forceinline__ void load_aux(Aux& x, const Ctx&, int, int, int row, int pn, int c128) const {
        const float* p = R + (size_t)row * DM + pn * 256 + c128;
        x.v[0] = *(const f32x4*)p; x.v[1] = *(const f32x4*)(p + 4); x.v[2] = *(const f32x4*)(p + 128); x.v[3] = *(const f32x4*)(p + 132);
    }
    __device__ __forceinline__ float apply(const Ctx&, const Aux& x, int, int, int row, int pn, int c128, const float (&a)[8], const float (&b)[8]) const {
        const size_t off = (size_t)row * DM + pn * 256 + c128;
        const f32x4 h0 = {x.v[0].x + a[0], x.v[0].y + a[1], x.v[0].z + a[2], x.v[0].w + a[3]}, h1 = {x.v[1].x + a[4], x.v[1].y + a[5], x.v[1].z + a[6], x.v[1].w + a[7]};
        const f32x4 h2 = {x.v[2].x + b[0], x.v[2].y + b[1], x.v[2].z + b[2], x.v[2].w + b[3]}, h3 = {x.v[3].x + b[4], x.v[3].y + b[5], x.v[3].z + b[6], x.v[3].w + b[7]};
        *(f32x4*)(H + off) = h0; *(f32x4*)(H + off + 4) = h1; *(f32x4*)(H + off + 128) = h2; *(f32x4*)(H + off + 132) = h3;
        v4u w; w.x = pk2(h0.x, h0.y); w.y = pk2(h0.z, h0.w); w.z = pk2(h1.x, h1.y); w.w = pk2(h1.z, h1.w); *(v4u*)(HB + off) = w;
        w.x = pk2(h2.x, h2.y); w.y = pk2(h2.z, h2.w); w.z = pk2(h3.x, h3.y); w.w = pk2(h3.z, h3.w); *(v4u*)(HB + off + 128) = w;
        return ((h0.x * h0.x + h0.y * h0.y) + (h0.z * h0.z + h0.w * h0.w) + (h1.x * h1.x + h1.y * h1.y) + (h1.z * h1.z + h1.w * h1.w))
             + ((h2.x * h2.x + h2.y * h2.y) + (h2.z * h2.z + h2.w * h2.w) + (h3.x * h3.x + h3.y * h3.y) + (h3.z * h3.z + h3.w * h3.w));
    }
    __device__ __forceinline__ void row_done(int row, int pn, int wc, float ss) const { rss[(size_t)row * 16 + pn * 4 + wc] = ss; }
};
__device__ __forceinline__ float silu_mul(float g, float u) { return g * __builtin_amdgcn_rcpf(1.0f + __builtin_amdgcn_exp2f(g * -1.4426950408889634f)) * u; }
struct EpiSwiGLU {
    static constexpr bool NEED_SS = false; typedef RowCtx Ctx; typedef NoAux Aux;
    bf16* Hm; int ldh; const float* rss; const int* tok;
    __device__ __forceinline__ void begin(Ctx& c, int row0, int, int c128) const {
        int t[2][4];
#pragma unroll
        for (int ai = 0; ai < 2; ++ai)
#pragma unroll
            for (int m = 0; m < 4; ++m) { const int row = row0 + ai * 128 + m * 16; t[ai][m] = tok ? tok[row] : row; }
        row_scales(c, rss, t, (c128 >> 3) & 3);
    }
    __device__ __forceinline__ void load_aux(Aux&, const Ctx&, int, int, int, int, int) const {}
    __device__ __forceinline__ float apply(const Ctx& c, const Aux&, int ai, int m, int row, int pn, int c128, const float (&a)[8], const float (&b)[8]) const {
        const float s = c.rs[ai][m]; float o[8];
#pragma unroll
        for (int j = 0; j < 8; ++j) o[j] = silu_mul(a[j] * s, b[j] * s);
        v4u w; w.x = pk2(o[0], o[1]); w.y = pk2(o[2], o[3]); w.z = pk2(o[4], o[5]); w.w = pk2(o[6], o[7]);
        *(v4u*)(Hm + (size_t)row * ldh + pn * 128 + c128) = w;
        return 0.f;
    }
    __device__ __forceinline__ void row_done(int, int, int, float) const {}
};
struct MoeCtx { int t[2][4]; float w[2][4]; };
struct EpiMoeDown {
    static constexpr bool NEED_SS = false; typedef MoeCtx Ctx; typedef Aux4 Aux;
    float* H; const int* tok; const float* w;
    __device__ __forceinline__ void begin(Ctx& c, int row0, int, int) const {
#pragma unroll
        for (int ai = 0; ai < 2; ++ai)
#pragma unroll
            for (int m = 0; m < 4; ++m) { const int row = row0 + ai * 128 + m * 16; c.t[ai][m] = tok[row]; c.w[ai][m] = w[row]; }
    }
    __device__ __forceinline__ void load_aux(Aux& x, const Ctx& c, int ai, int m, int, int pn, int c128) const {
        const int t = c.t[ai][m]; const float* p = H + (size_t)(t < 0 ? 0 : t) * DM + pn * 256 + c128;
        x.v[0] = *(const f32x4*)p; x.v[1] = *(const f32x4*)(p + 4); x.v[2] = *(const f32x4*)(p + 128); x.v[3] = *(const f32x4*)(p + 132);
    }
    __device__ __forceinline__ float apply(const Ctx& c, const Aux& x, int ai, int m, int, int pn, int c128, const float (&a)[8], const float (&b)[8]) const {
        const int t = c.t[ai][m]; if (t < 0) return 0.f;
        const float s = c.w[ai][m]; float* p = H + (size_t)t * DM + pn * 256 + c128;
        f32x4 h0 = x.v[0], h1 = x.v[1], h2 = x.v[2], h3 = x.v[3];
        h0.x += s * a[0]; h0.y += s * a[1]; h0.z += s * a[2]; h0.w += s * a[3]; h1.x += s * a[4]; h1.y += s * a[5]; h1.z += s * a[6]; h1.w += s * a[7];
        h2.x += s * b[0]; h2.y += s * b[1]; h2.z += s * b[2]; h2.w += s * b[3]; h3.x += s * b[4]; h3.y += s * b[5]; h3.z += s * b[6]; h3.w += s * b[7];
        *(f32x4*)p = h0; *(f32x4*)(p + 4) = h1; *(f32x4*)(p + 128) = h2; *(f32x4*)(p + 132) = h3;
        return 0.f;
    }
    __device__ __forceinline__ void row_done(int, int, int, float) const {}
};

namespace pg8 {
constexpr int HTB = 16384, TOK_OFF = 132096;
__device__ __forceinline__ int lds_byte(int r, int c) { const int st = (r >> 4) * 2 + (c >> 5), rr = r & 15, cc = c & 31, ob = rr * 64 + cc * 2; return st * 1024 + (ob ^ (((ob >> 9) & 1) << 5)); }
__device__ __forceinline__ void stage_rc(int b, int& R, int& C) { const int st = b / 1024, sb = b % 1024, swz = sb ^ (((sb >> 9) & 1) << 5); R = (st >> 1) * 16 + swz / 64; C = (st & 1) * 32 + (swz % 64) / 2; }
__device__ __forceinline__ int perm32(int rho) { const int n = rho >> 4, i = rho & 15; return 8 * (i >> 2) + 4 * n + (i & 3); }

template <class Epi>
__device__ __forceinline__ void run_epi(const Epi& E, const f32x4 (&acc)[2][2][4][2], const Unit& u, int wr, int wc, int fr, int fq) {
    int row0 = u.pm * 256 + wr * 64 + fr, c128 = 32 * wc + 8 * fq;
    asm volatile("" : "+v"(row0), "+v"(c128));
    typename Epi::Ctx ctx; E.begin(ctx, row0, u.pn, c128);
#pragma unroll
    for (int ai = 0; ai < 2; ++ai) {
        typename Epi::Aux aux[4];
#pragma unroll
        for (int m = 0; m < 4; ++m) E.load_aux(aux[m], ctx, ai, m, row0 + ai * 128 + m * 16, u.pn, c128);
#pragma unroll
        for (int m = 0; m < 4; ++m) {
            const int row = row0 + ai * 128 + m * 16;
            float a[8], b[8];
#pragma unroll
            for (int j = 0; j < 8; ++j) { a[j] = acc[ai][0][m][j >> 2][j & 3]; b[j] = acc[ai][1][m][j >> 2][j & 3]; }
            float ss = E.apply(ctx, aux[m], ai, m, row, u.pn, c128, a, b);
            if (Epi::NEED_SS) { ss += __shfl_xor(ss, 16); ss += __shfl_xor(ss, 32); if (fq == 0) E.row_done(row, u.pn, wc, ss); }
        }
    }
}

template <class Epi, bool GATHER>
__device__ __forceinline__ void gemm_fast(LAS unsigned char* lds, const Sched& S, const Epi& E, const int* gtok) {
    int tid = threadIdx.x; asm volatile("" : "+v"(tid));
    const int wid = __builtin_amdgcn_readfirstlane(tid >> 6), lane = tid & 63, wr = wid >> 2, wc = wid & 3, fr = lane & 15, fq = lane >> 4;
    const int K = S.K, nt = K / 64;
    unsigned voffB[2], vA0[2], vA1[2], nA0[2], nA1[2]; int RA[2], CA2[2];
#pragma unroll
    for (int i = 0; i < 2; ++i) { int R, C; stage_rc(tid * 16 + i * 8192, R, C); const int Rb = (R & ~31) + perm32(R & 31);
        voffB[i] = (unsigned)(Rb * K + C) * 2u; RA[i] = R; CA2[i] = C * 2; vA0[i] = (unsigned)(R * K + C) * 2u; vA1[i] = vA0[i] + (unsigned)(128 * K * 2); nA0[i] = vA0[i]; nA1[i] = vA1[i]; }
    const size_t kstep = 128;
    const size_t hstep = (size_t)128 * K * 2;
    const unsigned ldsw = (unsigned)wid * 1024u;
    const int aoff = lds_byte(wr * 64 + fr, fq * 8), boff = lds_byte(wc * 32 + fr, fq * 8);
    LAS int* tl = (LAS int*)(lds + TOK_OFF);
#define PG8_SA(b, h) (((b) * 2 + (h)) * HTB)
#define PG8_SB(b, h) ((4 + (b) * 2 + (h)) * HTB)
#define PG8_STAGE(bufoff, gbase, voff) do { _Pragma("unroll") for (int _i = 0; _i < 2; ++_i) \
        __builtin_amdgcn_global_load_lds((const unsigned*)((const char*)(gbase) + (voff)[_i]), (LAS unsigned*)(lds + (bufoff) + ldsw + _i * 8192), 16, 0, 0); } while (0)
#define PG8_LDA(dst, b, h) do { _Pragma("unroll") for (int m = 0; m < 4; ++m) _Pragma("unroll") for (int k = 0; k < 2; ++k) dst[m][k] = *(const LAS bf16x8*)(lds + PG8_SA(b, h) + aoff + m * 2048 + k * 1024); } while (0)
#define PG8_LDB(dst, b, h) do { _Pragma("unroll") for (int n = 0; n < 2; ++n) _Pragma("unroll") for (int k = 0; k < 2; ++k) dst[n][k] = *(const LAS bf16x8*)(lds + PG8_SB(b, h) + boff + n * 2048 + k * 1024); } while (0)
#define PG8_MMA(ai, bj, At, Bt) do { __builtin_amdgcn_s_setprio(1); _Pragma("unroll") for (int m = 0; m < 4; ++m) _Pragma("unroll") for (int n = 0; n < 2; ++n) _Pragma("unroll") for (int k = 0; k < 2; ++k) \
        acc[ai][bj][m][n] = __builtin_amdgcn_mfma_f32_16x16x32_bf16(Bt[n][k], At[m][k], acc[ai][bj][m][n], 0, 0, 0); __builtin_amdgcn_s_setprio(0); } while (0)
#define PG8_WAIT_V(n) asm volatile("s_waitcnt vmcnt(" #n ")" ::: "memory")
#define PG8_WAIT_L(n) asm volatile("s_waitcnt lgkmcnt(" #n ")" ::: "memory")
#define PG8_BAR __builtin_amdgcn_s_barrier()
#define PG8_SCHED __builtin_amdgcn_sched_barrier(0)
#define PG8_IDS_DMA(pm_, par_) do { if (wid < 4) __builtin_amdgcn_global_load_lds((const unsigned*)(gtok + (pm_) * 256 + wid * 64 + lane), (LAS unsigned*)(lds + TOK_OFF + (par_) * 1024 + wid * 256), 4, 0, 0); } while (0)
#define PG8_IDS_READ(d0, d1, par_) do { _Pragma("unroll") for (int _i = 0; _i < 2; ++_i) { int t0 = tl[(par_) * 256 + RA[_i]], t1 = tl[(par_) * 256 + 128 + RA[_i]]; t0 = t0 < 0 ? 0 : t0; t1 = t1 < 0 ? 0 : t1; \
        d0[_i] = (unsigned)t0 * (unsigned)(K * 2) + (unsigned)CA2[_i]; d1[_i] = (unsigned)t1 * (unsigned)(K * 2) + (unsigned)CA2[_i]; } } while (0)
    Unit cur, nxt; int ui = 0, par = 0;
    if (!S.next(0, cur)) return;
    f32x4 acc[2][2][4][2];
#pragma unroll
    for (int a = 0; a < 2; ++a)
#pragma unroll
        for (int b = 0; b < 2; ++b)
#pragma unroll
            for (int m = 0; m < 4; ++m)
#pragma unroll
                for (int n = 0; n < 2; ++n) acc[a][b][m][n] = (f32x4){0.f, 0.f, 0.f, 0.f};
    bf16x8 At[4][2], B0[2][2], B1[2][2];
    const char* cA = GATHER ? S.A : S.a_base(cur); const char* cB = S.b_base(cur);
    if constexpr (GATHER) { PG8_IDS_DMA(cur.pm, 0); PG8_WAIT_V(0); __syncthreads(); PG8_IDS_READ(vA0, vA1, 0); }
    PG8_STAGE(PG8_SB(0, 0), cB, voffB); PG8_STAGE(PG8_SB(0, 1), cB + hstep, voffB); PG8_STAGE(PG8_SA(0, 0), cA, vA0); PG8_STAGE(PG8_SA(0, 1), cA, vA1);
    if (wr == 1) PG8_BAR;
    PG8_WAIT_V(2); PG8_BAR;
    PG8_STAGE(PG8_SB(1, 0), cB + kstep, voffB); PG8_STAGE(PG8_SA(1, 0), cA + kstep, vA0); PG8_STAGE(PG8_SB(1, 1), cB + hstep + kstep, voffB);
    PG8_WAIT_V(6); PG8_BAR;
    for (;;) {
        const bool has_next = S.next(ui + 1, nxt);
        const char* nA = has_next ? (GATHER ? S.A : S.a_base(nxt)) : cA; const char* nB = has_next ? S.b_base(nxt) : cB;
        for (int t = 0; t < nt; t += 2) {
            const bool last = (t == nt - 2);
            if constexpr (GATHER) {
                if (t == nt - 4 && has_next) PG8_IDS_DMA(nxt.pm, par ^ 1);
                if (last) { if (has_next) PG8_IDS_READ(nA0, nA1, par ^ 1); else { nA0[0] = vA0[0]; nA0[1] = vA0[1]; nA1[0] = vA1[0]; nA1[1] = vA1[1]; } }
            }
            const char* a1 = cA + (size_t)(t + 1) * kstep;
            const char* a2 = last ? nA : cA + (size_t)(t + 2) * kstep; const char* b2 = last ? nB : cB + (size_t)(t + 2) * kstep;
            const char* a3 = a2 + kstep; const char* b3 = b2 + kstep;
            unsigned w0[2], w1[2];
            if (GATHER && last) { w0[0] = nA0[0]; w0[1] = nA0[1]; w1[0] = nA1[0]; w1[1] = nA1[1]; } else { w0[0] = vA0[0]; w0[1] = vA0[1]; w1[0] = vA1[0]; w1[1] = vA1[1]; }
            PG8_LDB(B0, 0, 0); PG8_LDB(B1, 0, 1); PG8_SCHED; PG8_LDA(At, 0, 0); PG8_STAGE(PG8_SA(1, 1), a1, vA1);
            PG8_WAIT_V(8); PG8_WAIT_L(0); PG8_BAR; PG8_MMA(0, 0, At, B0); PG8_MMA(0, 1, At, B1); PG8_BAR; PG8_SCHED;
            PG8_LDA(At, 0, 1); PG8_STAGE(PG8_SB(0, 0), b2, voffB); PG8_STAGE(PG8_SB(0, 1), b2 + hstep, voffB); PG8_STAGE(PG8_SA(0, 0), a2, w0);
            PG8_WAIT_V(8); PG8_WAIT_L(0); PG8_BAR; PG8_MMA(1, 0, At, B0); PG8_MMA(1, 1, At, B1); PG8_BAR; PG8_SCHED;
            PG8_LDB(B0, 1, 0); PG8_LDB(B1, 1, 1); PG8_SCHED; PG8_LDA(At, 1, 0); PG8_STAGE(PG8_SA(0, 1), a2, w1);
            PG8_WAIT_V(8); PG8_WAIT_L(0); PG8_BAR; PG8_MMA(0, 0, At, B0); PG8_MMA(0, 1, At, B1); PG8_BAR; PG8_SCHED;
            PG8_LDA(At, 1, 1); PG8_STAGE(PG8_SB(1, 0), b3, voffB); PG8_STAGE(PG8_SB(1, 1), b3 + hstep, voffB); PG8_STAGE(PG8_SA(1, 0), a3, w0);
            PG8_WAIT_V(8); PG8_WAIT_L(0); PG8_BAR; PG8_MMA(1, 0, At, B0); PG8_MMA(1, 1, At, B1); PG8_BAR; PG8_SCHED;
        }
        if (wr == 0) PG8_BAR;
        run_epi(E, acc, cur, wr, wc, fr, fq);
        if (!has_next) break;
#pragma unroll
        for (int a = 0; a < 2; ++a)
#pragma unroll
            for (int b = 0; b < 2; ++b)
#pragma unroll
                for (int m = 0; m < 4; ++m)
#pragma unroll
                    for (int n = 0; n < 2; ++n) acc[a][b][m][n] = (f32x4){0.f, 0.f, 0.f, 0.f};
        cur = nxt; cA = nA; cB = nB; ++ui;
        if constexpr (GATHER) { vA0[0] = nA0[0]; vA0[1] = nA0[1]; vA1[0] = nA1[0]; vA1[1] = nA1[1]; par ^= 1; }
        if (wr == 1) PG8_BAR;
    }
    PG8_WAIT_V(0);
    PG8_BAR;
#undef PG8_SA
#undef PG8_SB
#undef PG8_STAGE
#undef PG8_LDA
#undef PG8_LDB
#undef PG8_MMA
#undef PG8_WAIT_V
#undef PG8_WAIT_L
#undef PG8_BAR
#undef PG8_SCHED
#undef PG8_IDS_DMA
#undef PG8_IDS_READ
}
}

template <class Epi, bool GATHER>
__device__ __forceinline__ void gemm_run(LAS unsigned char* lds, const Sched& S, const Epi& E, const int* gtok) { pg8::gemm_fast<Epi, GATHER>(lds, S, E, gtok); }

__device__ __forceinline__ void na_simple(const Frame& F, const bf16* act0, const bf16* v0t, const float* rpb, bf16* mix) {
    for (int it = F.gw; it < NT * 12; it += F.NGW) {
        const int token = it / 12, h = it % 12, lane = F.lane;
        const int b = token >> 12, p = token & 4095, r = p >> 6, c = p & 63;
        const int r0 = min(max(r - 4, 0), 56), cs = min(max(c - 8, 0), 48);
        const float q = bf2f(act0[(size_t)token * A0_LD + h * 64 + lane]);
        float m = -INFINITY, l = 0.f, o = 0.f;
        for (int a = 0; a < 8; ++a)
            for (int u = 0; u < 16; ++u) {
                const int kt = b * SEQ + (r0 + a) * 64 + cs + u;
                const float kv = bf2f(act0[(size_t)kt * A0_LD + 768 + h * 64 + lane]);
                const float sc = wave_sum(q * kv) + rpb[h * 465 + (r0 + a - r + 7) * 31 + (cs + u - c + 15)];
                const float mn = fmaxf(m, sc), corr = __expf(m - mn), pe = __expf(sc - mn);
                const float vv = bf2f(v0t[(size_t)(h * 64 + lane) * NT + kt]);
                l = l * corr + pe; o = o * corr + pe * vv; m = mn;
            }
        mix[(size_t)token * DM + h * 64 + lane] = (bf16)f2bf(o / l);
    }
}
__device__ __forceinline__ void memattn_simple(const Frame& F, int first, int stride, const bf16* act, int ld, int qoff, const bf16* memk, const bf16* memvt, bf16* mix) {
    for (int it = first; it < NT * 4; it += stride) {
        const int token = it >> 2, h = it & 3, lane = F.lane, b = token >> 12;
        const float q = bf2f(act[(size_t)token * ld + qoff + h * 64 + lane]);
        float m = -INFINITY, l = 0.f, o = 0.f;
        for (int j = 0; j < 256; ++j) {
            const float kv = bf2f(memk[(size_t)(b * 256 + j) * 256 + h * 64 + lane]);
            const float sc = wave_sum(q * kv);
            const float mn = fmaxf(m, sc), corr = __expf(m - mn), pe = __expf(sc - mn);
            const float vv = bf2f(memvt[(size_t)(h * 64 + lane) * MEM_ROWS + b * 256 + j]);
            l = l * corr + pe; o = o * corr + pe * vv; m = mn;
        }
        mix[(size_t)token * DM + 768 + h * 64 + lane] = (bf16)f2bf(o / l);
    }
}

typedef short s16x4 __attribute__((ext_vector_type(4)));
template <bool NA>
__device__ __forceinline__ void attn16(int lane, const bf16* Q, int ldq, const bf16* Kb, int ldk, const bf16* Vt, int ldv, int ktok0, int trs, bf16* O, int ldo,
                                       const LAS float* rpb_h, int r, int r0, int jb, int band0) {
    const int qi = lane & 15, g = lane >> 4;
    bf16x8 qf[2];
#pragma unroll
    for (int ks = 0; ks < 2; ++ks) qf[ks] = *(const bf16x8*)(Q + (size_t)qi * ldq + ks * 32 + 8 * g);
    f32x4 s[16];
#pragma unroll
    for (int t = 0; t < 16; ++t) {
        const bf16* kp = Kb + (size_t)(ktok0 + (t >> 1) * trs + (t & 1) * 16 + qi) * ldk + 8 * g;
        const bf16x8 k0 = *(const bf16x8*)kp, k1 = *(const bf16x8*)(kp + 32);
        f32x4 z = {0.f, 0.f, 0.f, 0.f};
        z = __builtin_amdgcn_mfma_f32_16x16x32_bf16(k0, qf[0], z, 0, 0, 0);
        z = __builtin_amdgcn_mfma_f32_16x16x32_bf16(k1, qf[1], z, 0, 0, 0);
        s[t] = z;
    }
    constexpr float L2E = 1.4426950408889634f;
    float m = -INFINITY;
    if constexpr (NA) {
        const int qc = 16 * jb + qi, cs = min(max(qc - 8, 0), 48);
#pragma unroll
        for (int t = 0; t < 16; ++t)
#pragma unroll
            for (int i = 0; i < 4; ++i) {
                const int kc = band0 + 16 * (t & 1) + 4 * g + i; const bool ok = (kc >= cs) && (kc < cs + 16);
                float v = -INFINITY;
                if (ok) v = s[t][i] + rpb_h[(r0 + (t >> 1) - r + 7) * 31 + (kc - qc + 15)];
                s[t][i] = v; m = fmaxf(m, v);
            }
    } else {
#pragma unroll
        for (int t = 0; t < 16; ++t)
#pragma unroll
            for (int i = 0; i < 4; ++i) m = fmaxf(m, s[t][i]);
    }
    m = fmaxf(m, __shfl_xor(m, 16)); m = fmaxf(m, __shfl_xor(m, 32));
    const float mb = m * L2E; float l = 0.f;
    bf16x8 pf[8];
#pragma unroll
    for (int kk = 0; kk < 8; ++kk) {
        float p[8];
#pragma unroll
        for (int i = 0; i < 4; ++i) { p[i] = __builtin_amdgcn_exp2f(s[2 * kk][i] * L2E - mb); p[4 + i] = __builtin_amdgcn_exp2f(s[2 * kk + 1][i] * L2E - mb); }
#pragma unroll
        for (int i = 0; i < 8; ++i) l += p[i];
        v4u w; w.x = pk2(p[0], p[1]); w.y = pk2(p[2], p[3]); w.z = pk2(p[4], p[5]); w.w = pk2(p[6], p[7]);
        pf[kk] = __builtin_bit_cast(bf16x8, w);
    }
    l += __shfl_xor(l, 16); l += __shfl_xor(l, 32);
    const float inv = 1.0f / l;
#pragma unroll
    for (int mt = 0; mt < 4; ++mt) {
        f32x4 acc = {0.f, 0.f, 0.f, 0.f};
#pragma unroll
        for (int kk = 0; kk < 8; ++kk) {
            const bf16* vp = Vt + (size_t)(16 * mt + qi) * ldv + ktok0 + kk * trs + 4 * g;
            const s16x4 v0 = *(const s16x4*)vp, v1 = *(const s16x4*)(vp + 16);
            const bf16x8 vf = __builtin_shufflevector(v0, v1, 0, 1, 2, 3, 4, 5, 6, 7);
            acc = __builtin_amdgcn_mfma_f32_16x16x32_bf16(vf, pf[kk], acc, 0, 0, 0);
        }
        v2u w; w.x = pk2(acc[0] * inv, acc[1] * inv); w.y = pk2(acc[2] * inv, acc[3] * inv);
        *(v2u*)(O + (size_t)qi * ldo + 16 * mt + 4 * g) = w;
    }
}
__device__ __forceinline__ void memattn_item(int it, int lane, const bf16* act, int ld, int qoff, const bf16* memk, const bf16* memvt, bf16* mix) {
    const int tb = it >> 2, h = it & 3, tok0 = tb * 16, b = tok0 >> 12;
    attn16<false>(lane, act + (size_t)tok0 * ld + qoff + h * 64, ld, memk + h * 64, 256, memvt + (size_t)(h * 64) * MEM_ROWS, MEM_ROWS, b * 256, 32,
                  mix + (size_t)tok0 * DM + 768 + h * 64, DM, nullptr, 0, 0, 0, 0);
}
__device__ __forceinline__ void na_item(int it, int lane, const bf16* act0, const bf16* v0t, const LAS float* rpb, bf16* mix) {
    const int jb = it & 3, h = (it >> 2) % 12, br = (it >> 2) / 12, r = br & 63, b = br >> 6;
    const int r0 = min(max(r - 4, 0), 56), band0 = min(max(jb * 16 - 8, 0), 32);
    const int tok0 = b * SEQ + r * 64 + jb * 16;
    attn16<true>(lane, act0 + (size_t)tok0 * A0_LD + h * 64, A0_LD, act0 + 768 + h * 64, A0_LD, v0t + (size_t)(h * 64) * NT, NT, b * SEQ + r0 * 64 + band0, 64,
                 mix + (size_t)tok0 * DM + h * 64, DM, rpb + h * 465, r, r0, jb, band0);
}

__device__ __forceinline__ float logsigmoid(float x) { return fminf(x, 0.f) - log1pf(__expf(-fabsf(x))); }
__device__ __forceinline__ void gla_simple(const Frame& F, int item, const bf16* act1, const bf16* v1t, const float* wgk, const float* bgk, bf16* O) {
    const int b = item >> 3, h = (item >> 1) & 3, dir = item & 1, tid = F.tid;
    LAS float* sh = (LAS float*)F.lds;
    float S[96];
#pragma unroll
    for (int d = 0; d < 96; ++d) S[d] = 0.f;
    float wcol[16], bias = 0.f;
    if (tid < 96) {
#pragma unroll
        for (int r = 0; r < 16; ++r) wcol[r] = wgk[r * 384 + h * 96 + tid];
        bias = bgk[h * 96 + tid];
    }
    for (int tau = 0; tau < SEQ; ++tau) {
        const int token = b * SEQ + (dir ? (SEQ - 1 - tau) : tau);
        LAS float* cur = sh + (tau & 1) * 288;
        if (tid < 96) {
            const bf16* row = act1 + (size_t)token * A1_LD;
            float z = bias;
#pragma unroll
            for (int r = 0; r < 16; ++r) z += bf2f(row[1792 + dir * 16 + r]) * wcol[r];
            cur[tid] = __expf(logsigmoid(z) * (1.0f / 16.0f));
            cur[96 + tid] = bf2f(row[h * 96 + tid]) * 0.10206207261596575f;
            cur[192 + tid] = bf2f(row[384 + h * 96 + tid]);
        }
        __syncthreads();
        if (tid < 192) {
            const float v = bf2f(v1t[(size_t)(h * 192 + tid) * NT + token]);
            float o = 0.f;
            if (dir == 0) {
#pragma unroll
                for (int d = 0; d < 96; ++d) { S[d] = cur[d] * S[d] + cur[192 + d] * v; o += cur[96 + d] * S[d]; }
            } else {
#pragma unroll
                for (int d = 0; d < 96; ++d) { S[d] = cur[d] * S[d]; o += cur[96 + d] * S[d]; S[d] += cur[192 + d] * v; }
            }
            O[(size_t)token * 768 + h * 192 + tid] = (bf16)f2bf(o);
        }
    }
    __syncthreads();
}

__device__ __forceinline__ void gla_pre_item(int item, int wave, int lane, const bf16* act1, const float* W, const float* Bi, bf16* E) {
    const int n = item & 63, dir = (item >> 6) & 1, b = item >> 7, base = b * SEQ + n * 64;
    const int qi = lane & 15, g = lane >> 4;
    bf16x8 zf[4];
#pragma unroll
    for (int ct = 0; ct < 4; ++ct) { const int c = 16 * ct + qi, tok = dir ? base + 63 - c : base + c;
        bf16x8 z = {0, 0, 0, 0, 0, 0, 0, 0}; if (g < 2) z = *(const bf16x8*)(act1 + (size_t)tok * A1_LD + 1792 + dir * 16 + 8 * g); zf[ct] = z; }
#pragma unroll 1
    for (int jj = 0; jj < 3; ++jj) {
        const int j = 16 * (wave + 8 * jj) + qi;
        v4u wu = {0u, 0u, 0u, 0u};
        if (g < 2) { const float* wp = W + (size_t)(8 * g) * 384 + j;
            wu.x = pk2(wp[0], wp[384]); wu.y = pk2(wp[768], wp[1152]); wu.z = pk2(wp[1536], wp[1920]); wu.w = pk2(wp[2304], wp[2688]); }
        const bf16x8 wfr = __builtin_bit_cast(bf16x8, wu);
        const float bias = Bi[j]; float carry = 0.f;
#pragma unroll
        for (int ct = 0; ct < 4; ++ct) {
            f32x4 d = {0.f, 0.f, 0.f, 0.f};
            d = __builtin_amdgcn_mfma_f32_16x16x32_bf16(zf[ct], wfr, d, 0, 0, 0);
            float p[4];
#pragma unroll
            for (int i = 0; i < 4; ++i) { const float x = d[i] + bias; p[i] = (fminf(x, 0.f) - __logf(1.0f + __expf(-fabsf(x)))) * 0.0625f; }
            p[1] += p[0]; p[2] += p[1]; p[3] += p[2];
            float a = p[3]; float t = __shfl_up(a, 16); if (g >= 1) a += t; t = __shfl_up(a, 32); if (g >= 2) a += t;
            const float excl = a - p[3] + carry;
            carry += __shfl(a, 48 + qi);
#pragma unroll
            for (int i = 0; i < 4; ++i) { const int c = 16 * ct + 4 * g + i, tok = dir ? base + 63 - c : base + c;
                E[(size_t)tok * 384 + j] = (bf16)f2bf(__expf(excl + p[i])); }
        }
    }
}
constexpr int GL_QT = 0, GL_KT = 13312, GL_KDT = 26624, GL_VT = 40448, GL_DEC = 47360, GL_BUF = 49152;
__device__ __forceinline__ unsigned rev16(unsigned u) { return (u >> 16) | (u << 16); }
__device__ __forceinline__ void gla_main_item(const Frame& F, int item, const bf16* act1, const bf16* v1t, const bf16* Eall, bf16* OFp, bf16* OBp) {
    const int vs = item & 3, dir = (item >> 2) & 1, h = (item >> 3) & 3, b = item >> 5;
    const int tid = F.tid, lane = F.lane, wave = F.wave, qi = lane & 15, g = lane >> 4, ct = wave & 3, vh = wave >> 2;
    const bf16* E = Eall + (size_t)dir * NT * 384; bf16* O = dir ? OBp : OFp;
    LAS unsigned char* L = F.lds;
    const int pc = tid >> 3, pdg = tid & 7;
    f32x4 S[2][6];
#pragma unroll
    for (int vi = 0; vi < 2; ++vi)
#pragma unroll
        for (int dt = 0; dt < 6; ++dt) S[vi][dt] = (f32x4){0.f, 0.f, 0.f, 0.f};
    v2u rq[3], rk[3], re[3], rel[3]; v4u rv = {0u, 0u, 0u, 0u};
#define GL_LOAD(n_) do { const int nn_ = dir ? 63 - (n_) : (n_), base_ = b * SEQ + nn_ * 64, tokc_ = dir ? base_ + 63 - pc : base_ + pc, tokl_ = dir ? base_ : base_ + 63; \
        const bf16* ar_ = act1 + (size_t)tokc_ * A1_LD + h * 96 + 12 * pdg; const bf16* er_ = E + (size_t)tokc_ * 384 + h * 96 + 12 * pdg; const bf16* el_ = E + (size_t)tokl_ * 384 + h * 96 + 12 * pdg; \
        _Pragma("unroll") for (int j_ = 0; j_ < 3; ++j_) { rq[j_] = *(const v2u*)(ar_ + 4 * j_); rk[j_] = *(const v2u*)(ar_ + 384 + 4 * j_); re[j_] = *(const v2u*)(er_ + 4 * j_); rel[j_] = *(const v2u*)(el_ + 4 * j_); } \
        if (pc < 48) rv = *(const v4u*)(v1t + (size_t)(h * 192 + vs * 48 + pc) * NT + base_ + 8 * pdg); } while (0)
#define GL_PREP(bufo_) do { LAS unsigned char* B_ = L + (bufo_); \
        _Pragma("unroll") for (int j_ = 0; j_ < 3; ++j_) { float q_[4], k_[4], e_[4], l_[4], qt_[4], kt_[4], kd_[4]; \
            q_[0] = bflo(rq[j_].x); q_[1] = bfhi(rq[j_].x); q_[2] = bflo(rq[j_].y); q_[3] = bfhi(rq[j_].y); k_[0] = bflo(rk[j_].x); k_[1] = bfhi(rk[j_].x); k_[2] = bflo(rk[j_].y); k_[3] = bfhi(rk[j_].y); \
            e_[0] = bflo(re[j_].x); e_[1] = bfhi(re[j_].x); e_[2] = bflo(re[j_].y); e_[3] = bfhi(re[j_].y); l_[0] = bflo(rel[j_].x); l_[1] = bfhi(rel[j_].x); l_[2] = bflo(rel[j_].y); l_[3] = bfhi(rel[j_].y); \
            _Pragma("unroll") for (int i_ = 0; i_ < 4; ++i_) { const float inv_ = 1.0f / e_[i_]; qt_[i_] = q_[i_] * 0.10206207261596575f * e_[i_]; kt_[i_] = k_[i_] * inv_; kd_[i_] = kt_[i_] * l_[i_]; } \
            v2u w_; w_.x = pk2(qt_[0], qt_[1]); w_.y = pk2(qt_[2], qt_[3]); *(LAS v2u*)(B_ + GL_QT + pc * 208 + (12 * pdg + 4 * j_) * 2) = w_; \
            w_.x = pk2(kt_[0], kt_[1]); w_.y = pk2(kt_[2], kt_[3]); *(LAS v2u*)(B_ + GL_KT + pc * 208 + (12 * pdg + 4 * j_) * 2) = w_; \
            _Pragma("unroll") for (int i_ = 0; i_ < 4; ++i_) *(LAS bf16*)(B_ + GL_KDT + (12 * pdg + 4 * j_ + i_) * 144 + pc * 2) = (bf16)f2bf(kd_[i_]); \
            if (pc == 0) { f32x4 d_ = {l_[0], l_[1], l_[2], l_[3]}; *(LAS f32x4*)(B_ + GL_DEC + (12 * pdg + 4 * j_) * 4) = d_; } } \
        if (pc < 48) { v4u o_ = rv; int c0_ = 8 * pdg; if (dir) { o_.x = rev16(rv.w); o_.y = rev16(rv.z); o_.z = rev16(rv.y); o_.w = rev16(rv.x); c0_ = 56 - 8 * pdg; } \
            *(LAS v4u*)(B_ + GL_VT + pc * 144 + c0_ * 2) = o_; } } while (0)
    GL_LOAD(0);
    GL_PREP(0);
    GL_LOAD(1);
    __syncthreads();
#pragma unroll 1
    for (int n = 0; n < 64; ++n) {
        const int bo = (n & 1) * GL_BUF;
        if (n + 1 < 64) { GL_PREP(GL_BUF - bo); if (n + 2 < 64) GL_LOAD(n + 2); }
        LAS unsigned char* Bf = L + bo;
        bf16x8 qf[3];
#pragma unroll
        for (int ks = 0; ks < 3; ++ks) qf[ks] = *(const LAS bf16x8*)(Bf + GL_QT + (16 * ct + qi) * 208 + (32 * ks + 8 * g) * 2);
        f32x4 am[4];
#pragma unroll
        for (int tp = 0; tp < 4; ++tp) {
            f32x4 z = {0.f, 0.f, 0.f, 0.f};
            if (tp <= ct) {
#pragma unroll
                for (int ks = 0; ks < 3; ++ks) { const bf16x8 kf = *(const LAS bf16x8*)(Bf + GL_KT + (16 * tp + qi) * 208 + (32 * ks + 8 * g) * 2);
                    z = __builtin_amdgcn_mfma_f32_16x16x32_bf16(kf, qf[ks], z, 0, 0, 0); }
                const int c = 16 * ct + qi;
#pragma unroll
                for (int i = 0; i < 4; ++i) { const int cp = 16 * tp + 4 * g + i; const bool keep = (cp < c) || (dir == 0 && cp == c); z[i] = keep ? z[i] : 0.f; }
            }
            am[tp] = z;
        }
        bf16x8 pf[2];
#pragma unroll
        for (int kk = 0; kk < 2; ++kk) { v4u w; w.x = pk2(am[2 * kk][0], am[2 * kk][1]); w.y = pk2(am[2 * kk][2], am[2 * kk][3]); w.z = pk2(am[2 * kk + 1][0], am[2 * kk + 1][1]); w.w = pk2(am[2 * kk + 1][2], am[2 * kk + 1][3]);
            pf[kk] = __builtin_bit_cast(bf16x8, w); }
        bf16x8 qp[3];
#pragma unroll
        for (int kk = 0; kk < 3; ++kk) { const LAS unsigned char* qr = Bf + GL_QT + (16 * ct + qi) * 208 + (32 * kk + 4 * g) * 2;
            const s16x4 a0 = *(const LAS s16x4*)qr, a1 = *(const LAS s16x4*)(qr + 32); qp[kk] = __builtin_shufflevector(a0, a1, 0, 1, 2, 3, 4, 5, 6, 7); }
        const int nn = dir ? 63 - n : n, base = b * SEQ + nn * 64, c = 16 * ct + qi, tok = dir ? base + 63 - c : base + c;
#pragma unroll
        for (int vi = 0; vi < 2; ++vi) {
            if (vi == 1 && vh == 1) break;
            const int vt = 2 * vh + vi;
            f32x4 acc = {0.f, 0.f, 0.f, 0.f};
#pragma unroll
            for (int kk = 0; kk < 2; ++kk) { const LAS unsigned char* vr = Bf + GL_VT + (16 * vt + qi) * 144 + (32 * kk + 4 * g) * 2;
                const s16x4 a0 = *(const LAS s16x4*)vr, a1 = *(const LAS s16x4*)(vr + 32); const bf16x8 vf = __builtin_shufflevector(a0, a1, 0, 1, 2, 3, 4, 5, 6, 7);
                acc = __builtin_amdgcn_mfma_f32_16x16x32_bf16(vf, pf[kk], acc, 0, 0, 0); }
#pragma unroll
            for (int kk = 0; kk < 3; ++kk) { v4u w; w.x = pk2(S[vi][2 * kk][0], S[vi][2 * kk][1]); w.y = pk2(S[vi][2 * kk][2], S[vi][2 * kk][3]); w.z = pk2(S[vi][2 * kk + 1][0], S[vi][2 * kk + 1][1]); w.w = pk2(S[vi][2 * kk + 1][2], S[vi][2 * kk + 1][3]);
                acc = __builtin_amdgcn_mfma_f32_16x16x32_bf16(__builtin_bit_cast(bf16x8, w), qp[kk], acc, 0, 0, 0); }
            v2u w; w.x = pk2(acc[0], acc[1]); w.y = pk2(acc[2], acc[3]);
            *(v2u*)(O + (size_t)tok * 768 + h * 192 + vs * 48 + 16 * vt + 4 * g) = w;
            bf16x8 vfr[2];
#pragma unroll
            for (int ks = 0; ks < 2; ++ks) vfr[ks] = *(const LAS bf16x8*)(Bf + GL_VT + (16 * vt + qi) * 144 + (32 * ks + 8 * g) * 2);
#pragma unroll
            for (int dt = 0; dt < 6; ++dt) {
                const f32x4 dec = *(const LAS f32x4*)(Bf + GL_DEC + (16 * dt + 4 * g) * 4);
                f32x4 sv = S[vi][dt]; sv[0] *= dec[0]; sv[1] *= dec[1]; sv[2] *= dec[2]; sv[3] *= dec[3];
#pragma unroll
                for (int ks = 0; ks < 2; ++ks) { const bf16x8 kdf = *(const LAS bf16x8*)(Bf + GL_KDT + (16 * dt + qi) * 144 + (32 * ks + 8 * g) * 2);
                    sv = __builtin_amdgcn_mfma_f32_16x16x32_bf16(kdf, vfr[ks], sv, 0, 0, 0); }
                S[vi][dt] = sv;
            }
        }
        __syncthreads();
    }
#undef GL_LOAD
#undef GL_PREP
}

__device__ __forceinline__ void gla_combine(const Frame& F, const bf16* OF, const bf16* OB, const bf16* act1, const float* gnorm, bf16* mix) {
    for (int token = F.gw; token < NT; token += F.NGW) {
        const int lane = F.lane;
#pragma unroll
        for (int h = 0; h < 4; ++h) {
            float o[3]; float ss = 0.f;
#pragma unroll
            for (int j = 0; j < 3; ++j) { const size_t idx = (size_t)token * 768 + h * 192 + j * 64 + lane; o[j] = bf2f(OF[idx]) + bf2f(OB[idx]); ss += o[j] * o[j]; }
            ss = wave_sum(ss);
            const float rs = 1.0f / sqrtf(ss * (1.0f / 192.0f) + EPS);
#pragma unroll
            for (int j = 0; j < 3; ++j) { const int dv = j * 64 + lane; const float g = bf2f(act1[(size_t)token * A1_LD + 768 + h * 192 + dv]);
                const float val = o[j] * rs * gnorm[dv] * (g / (1.0f + __expf(-g)));
                mix[(size_t)token * DM + h * 192 + dv] = (bf16)f2bf(val); }
        }
    }
}
__device__ __forceinline__ void route_pick(const float (&acc)[8], int token, int* topi, float* topw, LAS int* lc) {
    int e0 = 0; float l0 = acc[0];
#pragma unroll
    for (int e = 1; e < 8; ++e) if (acc[e] > l0) { l0 = acc[e]; e0 = e; }
    int e1 = -1; float l1 = -INFINITY;
#pragma unroll
    for (int e = 0; e < 8; ++e) if (e != e0 && acc[e] > l1) { l1 = acc[e]; e1 = e; }
    const float w0 = 1.0f / (1.0f + __expf(l1 - l0));
    topi[token] = e0 | (e1 << 8); topw[2 * token] = w0; topw[2 * token + 1] = 1.0f - w0;
    atomicAdd((int*)&lc[e0], 1); atomicAdd((int*)&lc[8 + e1], 1);
}
__device__ __forceinline__ void route1(const Frame& F, const float* H, const float* gain, const float* wr, int* topi, float* topw, int* cnt) {
    LAS int* lc = (LAS int*)F.lds;
    if (F.tid < 16) lc[F.tid] = 0;
    __syncthreads();
    const int lane = F.lane;
    float w[4][4][8];
#pragma unroll
    for (int j = 0; j < 4; ++j) { const f32x4 g = *(const f32x4*)(gain + 256 * j + 4 * lane);
#pragma unroll
        for (int i = 0; i < 4; ++i) { const float* p = wr + (size_t)(256 * j + 4 * lane + i) * 8; const f32x4 a = *(const f32x4*)p, b = *(const f32x4*)(p + 4); const float gi = g[i];
            w[j][i][0] = a.x * gi; w[j][i][1] = a.y * gi; w[j][i][2] = a.z * gi; w[j][i][3] = a.w * gi; w[j][i][4] = b.x * gi; w[j][i][5] = b.y * gi; w[j][i][6] = b.z * gi; w[j][i][7] = b.w * gi; } }
    for (int t2 = 0; t2 < 16; t2 += 2) {
        const int token = F.bid * 128 + F.wave * 16 + t2;
        const f32x4* h0 = (const f32x4*)(H + (size_t)token * DM) + lane; const f32x4* h1 = h0 + DM / 4;
        f32x4 x0[4], x1[4];
#pragma unroll
        for (int j = 0; j < 4; ++j) x0[j] = h0[64 * j];
#pragma unroll
        for (int j = 0; j < 4; ++j) x1[j] = h1[64 * j];
        float a0[8], a1[8], s0 = 0.f, s1 = 0.f;
#pragma unroll
        for (int e = 0; e < 8; ++e) { a0[e] = 0.f; a1[e] = 0.f; }
#pragma unroll
        for (int j = 0; j < 4; ++j)
#pragma unroll
            for (int i = 0; i < 4; ++i) { const float u = x0[j][i], v = x1[j][i]; s0 += u * u; s1 += v * v;
#pragma unroll
                for (int e = 0; e < 8; ++e) { a0[e] += u * w[j][i][e]; a1[e] += v * w[j][i][e]; } }
        s0 = wave_sum(s0); s1 = wave_sum(s1);
        const float r0 = 1.0f / sqrtf(s0 * (1.0f / DM) + EPS), r1 = 1.0f / sqrtf(s1 * (1.0f / DM) + EPS);
#pragma unroll
        for (int e = 0; e < 8; ++e) { a0[e] = wave_sum(a0[e]) * r0; a1[e] = wave_sum(a1[e]) * r1; }
        if (lane == 0) { route_pick(a0, token, topi, topw, lc); route_pick(a1, token + 1, topi, topw, lc); }
    }
    __syncthreads();
    if (F.tid < 16) cnt[F.bid * 16 + F.tid] = lc[F.tid];
    __syncthreads();
}
__device__ __forceinline__ void route2(const Frame& F, const int* topi, const float* topw, const int* cnt, int* stok, float* sw, int* blk) {
    LAS int* part = (LAS int*)F.lds;
    LAS int* base = part + 1024;
    LAS int* tk = base + 64;
    const int tid = F.tid, pe = tid & 15, jg = tid >> 4;
    int below = 0, tot = 0;
    for (int w = jg; w < F.G; w += 32) { const int v = cnt[w * 16 + pe]; tot += v; if (w < F.bid) below += v; }
    part[jg * 16 + pe] = below; part[512 + jg * 16 + pe] = tot;
    if (tid < 128) tk[tid] = topi[F.bid * 128 + tid];
    __syncthreads();
    if (tid < 16) { int b = 0, t = 0; for (int j = 0; j < 32; ++j) { b += part[j * 16 + tid]; t += part[512 + j * 16 + tid]; } base[tid] = b; base[16 + tid] = t; }
    __syncthreads();
    if (tid < 2) { int ps = 0; for (int e = 0; e < 8; ++e) { base[32 + tid * 8 + e] = ps; ps += (base[16 + tid * 8 + e] + 255) / 256 * 256; } base[48 + tid] = ps / 256; }
    __syncthreads();
    if (tid < 256) {
        const int p = tid >> 7, i = tid & 127; const int e = (tk[i] >> (8 * p)) & 0xff;
        int rank = 0; for (int j = 0; j < i; ++j) rank += (((tk[j] >> (8 * p)) & 0xff) == e) ? 1 : 0;
        const int slot = base[32 + p * 8 + e] + base[p * 8 + e] + rank; const int token = F.bid * 128 + i;
        stok[p * SLOT_CAP + slot] = token; sw[p * SLOT_CAP + slot] = topw[2 * token + p];
    }
    if (F.bid < 16) {
        const int p = F.bid >> 3, e = F.bid & 7, ps = base[32 + F.bid], t = base[16 + F.bid], pend = ps + (t + 255) / 256 * 256;
        for (int s = ps + t + tid; s < pend; s += NTHR) { stok[p * SLOT_CAP + s] = -1; sw[p * SLOT_CAP + s] = 0.f; }
        for (int bk = ps / 256 + tid; bk < pend / 256; bk += NTHR) blk[16 + p * 256 + bk] = e;
        if (e == 0 && tid == 0) blk[p] = base[48 + p];
    }
    __syncthreads();
}
__device__ __forceinline__ void final_norm(const Frame& F, float* H, const float* gain) {
    for (int row = F.gw; row < NT; row += F.NGW) {
        GAS f32x4* xr = (GAS f32x4*)(H + (size_t)row * DM) + F.lane; const f32x4* gr = (const f32x4*)gain + F.lane;
        f32x4 v[4]; float s = 0.f;
#pragma unroll
        for (int j = 0; j < 4; ++j) { v[j] = xr[64 * j]; s += (v[j].x * v[j].x + v[j].y * v[j].y) + (v[j].z * v[j].z + v[j].w * v[j].w); }
        s = wave_sum(s); const float rs = 1.0f / sqrtf(s * (1.0f / DM) + EPS);
#pragma unroll
        for (int j = 0; j < 4; ++j) { const f32x4 g = gr[64 * j]; f32x4 o = {v[j].x * rs * g.x, v[j].y * rs * g.y, v[j].z * rs * g.z, v[j].w * rs * g.w}; xr[64 * j] = o; }
    }
}

constexpr int N_PHASES = 17;
__global__ void __launch_bounds__(NTHR, 2) mega(Args args) {
    extern __shared__ __attribute__((aligned(16))) unsigned char lds_raw[];
    Frame F;
    F.lds = (LAS unsigned char*)lds_raw;
    F.tid = threadIdx.x; F.lane = F.tid & 63; F.wave = __builtin_amdgcn_readfirstlane(F.tid >> 6);
    F.G = gridDim.x; F.bid = blockIdx.x; F.gw = F.bid * NWAVES + F.wave; F.NGW = F.G * NWAVES; F.ws = args.ws;
    unsigned char* ws = args.ws;
    gu32* ctl = (gu32*)(ws + WS_CTL);
    volatile LAS unsigned* MISC = (volatile LAS unsigned*)(F.lds + MISC_OFF);
    for (int u = F.tid; u < (LDS_BYTES - LDSCTL_OFF) / 4; u += NTHR) ((LAS unsigned*)(F.lds + LDSCTL_OFF))[u] = 0u;
    __syncthreads();
    XcdBarrier bar = xcd_barrier_post((unsigned*)(ctl + CW_BAR), MISC + 8);
    const int lo = args.ph_lo, hi = args.ph_hi;
#ifndef PH_MASK
#define PH_MASK 0x1ffff
#endif
#define IN(k) (((PH_MASK >> (k)) & 1) && lo <= (k) && (k) < hi)
#ifndef REPEAT_MASK
#define REPEAT_MASK 0
#endif
#define REPS(k) (1 + ((REPEAT_MASK >> (k)) & 1))
#define SEAM(k) do { if (IN(k) && IN((k) + 1)) xcd_barrier(bar); } while (0)

    float* H = args.out;
    float* rss = (float*)(ws + WS_RSS); float* mrss = (float*)(ws + WS_MRSS);
    bf16* hbf = (bf16*)(ws + WS_HBF); bf16* membf = (bf16*)(ws + WS_MEMBF); bf16* memk = (bf16*)(ws + WS_MEMK); bf16* memvt = (bf16*)(ws + WS_MEMVT);
    bf16* act0 = (bf16*)(ws + WS_ACT0); bf16* v0t = (bf16*)(ws + WS_V0T); bf16* mix = (bf16*)(ws + WS_MIX); bf16* hmid0 = (bf16*)(ws + WS_HMID0);
    bf16* act1 = (bf16*)(ws + WS_ACT1); bf16* v1t = (bf16*)(ws + WS_V1T); bf16* OF = (bf16*)(ws + WS_OF); bf16* OB = (bf16*)(ws + WS_OB);
    bf16* hmid1 = (bf16*)(ws + WS_HMID1); bf16* wgu = (bf16*)(ws + WS_WGU); bf16* wdn = (bf16*)(ws + WS_WDN);
    int* cnt = (int*)(ws + WS_CNT); int* topi = (int*)(ws + WS_TOPI); float* topw = (float*)(ws + WS_TOPW);
    int* stok = (int*)(ws + WS_STOK); float* sw = (float*)(ws + WS_SW); int* blk = (int*)(ws + WS_BLK);
    LAS float* scr = (LAS float*)(F.lds + F.wave * 16384);

    if (IN(0)) for (int rep_ = 0; rep_ < REPS(0); ++rep_) {
        int it = F.gw; LAS unsigned* T0 = (LAS unsigned*)scr; LAS unsigned* T1 = T0 + 1088;
#define CVT(Wp, Kd, Nd, WTp, gainp, kind) do { const CvtJob J{Wp, Kd, Nd, (bf16*)(WTp), gainp, kind}; const int n_ = ((Kd) / 64) * ((Nd) / 32); \
            while (it < n_) { CvtRegs A_, B_; B_.valid = 0; cvt_load(A_, J, it, F.lane); it += F.NGW; if (it < n_) { cvt_load(B_, J, it, F.lane); it += F.NGW; } cvt_finish(A_, T0, F.lane); cvt_finish(B_, T1, F.lane); } \
            it -= n_; } while (0)
        CVT(args.in[I_EWIN], 1024, 2560, ws + WS_W0IN, args.in[I_EN1], 1);
        CVT(args.in[I_EWIN], 1024, 2560, ws + WS_WV0, args.in[I_EN1], 2);
        CVT(args.in[I_EWOUT], 1024, 1024, ws + WS_W0OUT, nullptr, 0);
        CVT(args.in[I_EWG], 1024, 2816, ws + WS_W0GU, args.in[I_EN2], 3);
        CVT(args.in[I_EWU], 1024, 2816, ws + WS_W0GU, args.in[I_EN2], 4);
        CVT(args.in[I_EWD], 2816, 1024, ws + WS_W0DN, nullptr, 0);
        CVT(args.in[I_WMKV], 1024, 512, ws + WS_WMEM, args.in[I_MNORM], 0);
        CVT(args.in[I_OWIN], 1024, 2592, ws + WS_W1IN, args.in[I_ON1], 5);
        CVT(args.in[I_OWIN], 1024, 2592, ws + WS_WV1, args.in[I_ON1], 6);
        CVT(args.in[I_OWOUT], 1024, 1024, ws + WS_W1OUT, nullptr, 0);
#undef CVT
        { v4u z = {0u, 0u, 0u, 0u}; v4u* p = (v4u*)(ws + WS_W1IN + (size_t)1824 * 2048); const int n16 = 224 * 2048 / 16;
          for (int i = F.bid * NTHR + F.tid; i < n16; i += F.G * NTHR) p[i] = z; }
        rows_to_bf16(args.in[I_X], hbf, rss, F.gw, NT, F.NGW, F.lane);
        rows_to_bf16(args.in[I_MEM], membf, mrss, F.gw, MEM_ROWS, F.NGW, F.lane);
    }
    SEAM(0);
    if (IN(1)) for (int rep_ = 0; rep_ < REPS(1); ++rep_) {
        { Sched S; S.init(hbf, ws + WS_W0IN, 1024, 128, 7, F.G, F.bid); EpiRowScale E{act0, A0_LD, rss}; gemm_run<EpiRowScale, false>(F.lds, S, E, nullptr); }
        { Sched S; S.init(ws + WS_WV0, hbf, 1024, 3, 128, F.G, (F.bid + 128) % F.G); EpiColScale E{v0t, NT, rss}; gemm_run<EpiColScale, false>(F.lds, S, E, nullptr); }
        { Sched S; S.init(membf, ws + WS_WMEM, 1024, 8, 1, F.G, F.bid); EpiRowScale E{memk, 256, mrss}; gemm_run<EpiRowScale, false>(F.lds, S, E, nullptr); }
        { Sched S; S.init(ws + WS_WMEM + 256 * 2048, membf, 1024, 1, 8, F.G, (F.bid + 248) % F.G); EpiColScale E{memvt, MEM_ROWS, mrss}; gemm_run<EpiColScale, false>(F.lds, S, E, nullptr); }
    }
    SEAM(1);
    if (IN(2)) for (int rep_ = 0; rep_ < REPS(2); ++rep_) {
#if FAST_ATT
        { LAS float* rl = (LAS float*)F.lds; for (int i = F.tid; i < 5580; i += NTHR) rl[i] = args.in[I_RPB][i]; __syncthreads();
          for (int it = F.gw; it < 32768; it += F.NGW) { if (it < 24576) na_item(it, F.lane, act0, v0t, rl, mix); else memattn_item(it - 24576, F.lane, act0, A0_LD, 1536, memk, memvt, mix); }
          __syncthreads(); }
#else
        na_simple(F, act0, v0t, args.in[I_RPB], mix);
        memattn_simple(F, F.gw, F.NGW, act0, A0_LD, 1536, memk, memvt, mix);
#endif
    }
    SEAM(2);
    if (IN(3)) for (int rep_ = 0; rep_ < REPS(3); ++rep_) {
        Sched S; S.init(mix, ws + WS_W0OUT, 1024, 128, 4, F.G, F.bid); EpiResid E{args.in[I_X], H, hbf, rss}; gemm_run<EpiResid, false>(F.lds, S, E, nullptr);
    }
    SEAM(3);
    if (IN(4)) for (int rep_ = 0; rep_ < REPS(4); ++rep_) {
        Sched S; S.init(hbf, ws + WS_W0GU, 1024, 128, 22, F.G, F.bid); EpiSwiGLU E{hmid0, FF0, rss, nullptr}; gemm_run<EpiSwiGLU, false>(F.lds, S, E, nullptr);
    }
    SEAM(4);
    if (IN(5)) for (int rep_ = 0; rep_ < REPS(5); ++rep_) {
        Sched S; S.init(hmid0, ws + WS_W0DN, FF0, 128, 4, F.G, F.bid); EpiResid E{H, H, hbf, rss}; gemm_run<EpiResid, false>(F.lds, S, E, nullptr);
    }
    SEAM(5);
    if (IN(6)) for (int rep_ = 0; rep_ < REPS(6); ++rep_) {
        { Sched S; S.init(hbf, ws + WS_W1IN, 1024, 128, 8, F.G, F.bid); EpiRowScale E{act1, A1_LD, rss}; gemm_run<EpiRowScale, false>(F.lds, S, E, nullptr); }
        { Sched S; S.init(ws + WS_WV1, hbf, 1024, 3, 128, F.G, F.bid); EpiColScale E{v1t, NT, rss}; gemm_run<EpiColScale, false>(F.lds, S, E, nullptr); }
    }
    SEAM(6);
    if (IN(7)) for (int rep_ = 0; rep_ < REPS(7); ++rep_) {
#if FAST_GLA
        for (int it = F.bid; it < 1024; it += F.G) { const int dir = (it >> 6) & 1;
            gla_pre_item(it, F.wave, F.lane, act1, dir ? args.in[I_WGKB] : args.in[I_WGKF], dir ? args.in[I_BGKB] : args.in[I_BGKF], (bf16*)(ws + WS_E) + (size_t)dir * NT * 384); }
        for (int it = F.gw; it < 8192; it += F.NGW) memattn_item(it, F.lane, act1, A1_LD, 1536, memk, memvt, mix);
        xcd_barrier(bar);
        for (int it = F.bid; it < 256; it += F.G) gla_main_item(F, it, act1, v1t, (const bf16*)(ws + WS_E), OF, OB);
#else
        if (F.bid < 64) {
            const int dir = F.bid & 1;
            gla_simple(F, F.bid, act1, v1t, dir ? args.in[I_WGKB] : args.in[I_WGKF], dir ? args.in[I_BGKB] : args.in[I_BGKF], dir ? OB : OF);
        } else {
#if FAST_ATT
            for (int it = (F.bid - 64) * NWAVES + F.wave; it < 8192; it += (F.G - 64) * NWAVES) memattn_item(it, F.lane, act1, A1_LD, 1536, memk, memvt, mix);
#else
            memattn_simple(F, (F.bid - 64) * NWAVES + F.wave, (F.G - 64) * NWAVES, act1, A1_LD, 1536, memk, memvt, mix);
#endif
        }
#endif
    }
    SEAM(7);
    if (IN(8)) for (int rep_ = 0; rep_ < REPS(8); ++rep_) gla_combine(F, OF, OB, act1, args.in[I_GNORM], mix);
    SEAM(8);
    if (IN(9)) for (int rep_ = 0; rep_ < REPS(9); ++rep_) {
        Sched S; S.init(mix, ws + WS_W1OUT, 1024, 128, 4, F.G, F.bid); EpiResid E{H, H, hbf, rss}; gemm_run<EpiResid, false>(F.lds, S, E, nullptr);
    }
    SEAM(9);
    if (IN(10)) for (int rep_ = 0; rep_ < REPS(10); ++rep_) {
        route1(F, H, args.in[I_ON2], args.in[I_WR], topi, topw, cnt);
        { LAS unsigned* T0 = (LAS unsigned*)scr; LAS unsigned* T1 = T0 + 1088;
#define MOE_JOB(J_, it_) const int e_##J_ = (it_) / 5376, r_##J_ = (it_) % 5376, wh_##J_ = r_##J_ / 1792; \
            const CvtJob J_{wh_##J_ == 0 ? args.in[I_OWG] + (size_t)e_##J_ * 1024 * FFE : (wh_##J_ == 1 ? args.in[I_OWU] + (size_t)e_##J_ * 1024 * FFE : args.in[I_OWD] + (size_t)e_##J_ * FFE * 1024), \
                wh_##J_ == 2 ? FFE : 1024, wh_##J_ == 2 ? 1024 : FFE, wh_##J_ == 2 ? wdn + (size_t)e_##J_ * 1024 * FFE : wgu + (size_t)e_##J_ * 7168 * 1024, wh_##J_ == 2 ? nullptr : args.in[I_ON2], wh_##J_ == 2 ? 0 : 3 + wh_##J_}
          for (int it = F.gw; it < 8 * 3 * 1792; it += 2 * F.NGW) {
            CvtRegs A_, B_; B_.valid = 0;
            { MOE_JOB(Ja, it); cvt_load(A_, Ja, it % 1792, F.lane); }
            if (it + F.NGW < 8 * 3 * 1792) { MOE_JOB(Jb, it + F.NGW); cvt_load(B_, Jb, (it + F.NGW) % 1792, F.lane); }
            cvt_finish(A_, T0, F.lane); cvt_finish(B_, T1, F.lane);
          }
#undef MOE_JOB
        }
    }
    SEAM(10);
    if (IN(11)) for (int rep_ = 0; rep_ < REPS(11); ++rep_) route2(F, topi, topw, cnt, stok, sw, blk);
    SEAM(11);
    if (IN(12)) for (int rep_ = 0; rep_ < REPS(12); ++rep_) {
        const int nb = blk[0]; Sched S; S.init(hbf, wgu, 1024, nb, 28, F.G, F.bid, blk + 16, (size_t)7168 * 1024 * 2); EpiSwiGLU E{hmid1, FFE, rss, stok}; gemm_run<EpiSwiGLU, true>(F.lds, S, E, stok);
    }
    SEAM(12);
    if (IN(13)) for (int rep_ = 0; rep_ < REPS(13); ++rep_) {
        const int nb = blk[0]; Sched S; S.init(hmid1, wdn, FFE, nb, 4, F.G, F.bid, blk + 16, (size_t)1024 * FFE * 2); EpiMoeDown E{H, stok, sw}; gemm_run<EpiMoeDown, false>(F.lds, S, E, nullptr);
    }
    SEAM(13);
    if (IN(14)) for (int rep_ = 0; rep_ < REPS(14); ++rep_) {
        const int nb = blk[1]; Sched S; S.init(hbf, wgu, 1024, nb, 28, F.G, F.bid, blk + 16 + 256, (size_t)7168 * 1024 * 2); EpiSwiGLU E{hmid1, FFE, rss, stok + SLOT_CAP}; gemm_run<EpiSwiGLU, true>(F.lds, S, E, stok + SLOT_CAP);
    }
    SEAM(14);
    if (IN(15)) for (int rep_ = 0; rep_ < REPS(15); ++rep_) {
        const int nb = blk[1]; Sched S; S.init(hmid1, wdn, FFE, nb, 4, F.G, F.bid, blk + 16 + 256, (size_t)1024 * FFE * 2); EpiMoeDown E{H, stok + SLOT_CAP, sw + SLOT_CAP}; gemm_run<EpiMoeDown, false>(F.lds, S, E, nullptr);
    }
    SEAM(15);
    if (IN(16)) final_norm(F, H, args.in[I_FNORM]);
#undef IN
#undef SEAM
}

extern "C" void kernel_launch(void* const* d_in, const int* in_sizes, int n_in, void* d_out, int out_size, void* d_ws, size_t ws_size, hipStream_t stream) {
    static int grid = 0;
    if (grid == 0) {
        if (n_in != 26 || out_size != NT * DM || ws_size < WS_END) { fprintf(stderr, "kernel_launch: unexpected problem (n_in %d out %d ws %zu need %zu)\n", n_in, out_size, ws_size, (size_t)WS_END); grid = -1; return; }
        int dev = 0, cus = 0, per_cu = 0;
        if (hipGetDevice(&dev) != hipSuccess || hipDeviceGetAttribute(&cus, hipDeviceAttributeMultiprocessorCount, dev) != hipSuccess) { grid = -1; return; }
        if (hipFuncSetAttribute((const void*)mega, hipFuncAttributeMaxDynamicSharedMemorySize, LDS_BYTES) != hipSuccess) { fprintf(stderr, "kernel_launch: hipFuncSetAttribute failed\n"); grid = -1; return; }
        if (hipOccupancyMaxActiveBlocksPerMultiprocessor(&per_cu, (const void*)mega, NTHR, LDS_BYTES) != hipSuccess || per_cu < 1) fprintf(stderr, "kernel_launch: occupancy query reports %d\n", per_cu);
        (void)hipGetLastError();
        grid = cus;
        if (grid != 256) fprintf(stderr, "kernel_launch: note: %d CUs\n", grid);
    }
    if (grid < 0) return;
    if (hipMemsetAsync((char*)d_ws + WS_CTL, 0, CTL_ZERO_BYTES, stream) != hipSuccess) return;
    Args a{};
    for (int i = 0; i < 26; ++i) a.in[i] = (const float*)d_in[i];
    a.out = (float*)d_out; a.ws = (unsigned char*)d_ws;
#if MK_FUSED
    a.ph_lo = 0; a.ph_hi = N_PHASES;
    hipLaunchKernelGGL(mega, dim3(grid), dim3(NTHR), LDS_BYTES, stream, a);
#else
    for (int p = 0; p < N_PHASES; ++p) { a.ph_lo = p; a.ph_hi = p + 1; hipLaunchKernelGGL(mega, dim3(grid), dim3(NTHR), LDS_BYTES, stream, a); }
#endif
}
```

```cpp
#include <hip/hip_runtime.h>
#include <cstdio>
#include <cstdint>

#ifndef MK_FUSED
#define MK_FUSED 1
#endif
#ifndef FAST_GEMM
#define FAST_GEMM 1
#endif
#ifndef FAST_ATT
#define FAST_ATT 1
#endif
#ifndef FAST_GLA
#define FAST_GLA 1
#endif

#define GAS __attribute__((address_space(1)))
#define LAS __attribute__((address_space(3)))
typedef unsigned short bf16;
typedef unsigned v4u __attribute__((ext_vector_type(4)));
typedef unsigned v2u __attribute__((ext_vector_type(2)));
typedef float f32x4 __attribute__((ext_vector_type(4)));
typedef short bf16x8 __attribute__((ext_vector_type(8)));
typedef GAS unsigned gu32;
#define RLX_AGENT __ATOMIC_RELAXED, __HIP_MEMORY_SCOPE_AGENT
#define LDS_WAIT() asm volatile("s_waitcnt lgkmcnt(0)" ::: "memory")
#define VM_WAIT() asm volatile("s_waitcnt vmcnt(0)" ::: "memory")

constexpr int NT = 32768, DM = 1024, SEQ = 4096, NB = 8;
constexpr int MEM_ROWS = 2048;
constexpr int A0_LD = 1792;
constexpr int A1_LD = 2048;
constexpr int FF0 = 2816, FFE = 3584, NEXP = 8;
constexpr int SLOT_CAP = 34816;
constexpr float EPS = 1e-6f;
constexpr int NWAVES = 8, NTHR = 512;

constexpr size_t MiB = 1u << 20;
constexpr size_t WS_CTL = 0, CTL_ZERO_BYTES = 1 * MiB;
constexpr size_t WS_RSS = 1 * MiB;
constexpr size_t WS_MRSS = 3 * MiB;
constexpr size_t WS_CNT = 3 * MiB + 256 * 1024;
constexpr size_t WS_TOPI = 3 * MiB + 512 * 1024;
constexpr size_t WS_TOPW = 3 * MiB + 768 * 1024;
constexpr size_t WS_STOK = 4 * MiB;
constexpr size_t WS_SW = 4 * MiB + 512 * 1024;
constexpr size_t WS_BLK = 5 * MiB;
constexpr size_t WS_W0IN = 6 * MiB;
constexpr size_t WS_WV0 = WS_W0IN + 1792 * 2048;
constexpr size_t WS_W0OUT = 11 * MiB;
constexpr size_t WS_W0GU = 13 * MiB;
constexpr size_t WS_W0DN = 24 * MiB;
constexpr size_t WS_WMEM = WS_W0DN + 1024 * 2816 * 2;
constexpr size_t WS_W1IN = 31 * MiB;
constexpr size_t WS_WV1 = 35 * MiB;
constexpr size_t WS_W1OUT = 37 * MiB - 512 * 1024;
constexpr size_t WS_HBF = 39 * MiB;
constexpr size_t WS_MEMBF = 103 * MiB;
constexpr size_t WS_MEMK = 107 * MiB;
constexpr size_t WS_MEMVT = 108 * MiB;
constexpr size_t WS_ACT = 109 * MiB;
constexpr size_t WS_ACT0 = WS_ACT;
constexpr size_t WS_V0T = WS_ACT + 112 * MiB;
constexpr size_t WS_MIX = WS_ACT + 176 * MiB;
constexpr size_t WS_HMID0 = WS_ACT;
constexpr size_t WS_ACT1 = WS_ACT;
constexpr size_t WS_V1T = WS_ACT + 128 * MiB;
constexpr size_t WS_OF = WS_ACT + 240 * MiB;
constexpr size_t WS_OB = WS_ACT + 288 * MiB;
constexpr size_t WS_E = WS_ACT + 336 * MiB;
constexpr size_t WS_HMID1 = WS_ACT;
constexpr size_t WS_WGU = WS_ACT + 240 * MiB;
constexpr size_t WS_WDN = WS_ACT + 352 * MiB;
constexpr size_t WS_END = WS_ACT + 408 * MiB;
static_assert(WS_W1OUT + 2 * MiB <= WS_HBF && WS_WV1 + 768 * 2048 <= WS_W1OUT && WS_W1IN + 4 * MiB <= WS_WV1 && WS_WMEM + MiB <= WS_W1IN, "weight map");
static_assert(WS_W0GU + 11 * MiB <= WS_W0DN && WS_WV0 + 768 * 2048 <= WS_W0OUT, "weight map 2");
static_assert((size_t)SLOT_CAP * 3584 * 2 <= 240 * MiB, "hmid1");

constexpr int CW_TMO = 0, CW_CODE = 1, CW_BAR = 4096;

constexpr int RING_BYTES = 131072;
constexpr int LDSCTL_OFF = RING_BYTES, MISC_OFF = LDSCTL_OFF + 320;
constexpr int LDS_BYTES = 147456;

typedef float f32x2_t __attribute__((ext_vector_type(2)));
typedef __bf16 bf16x2_t __attribute__((ext_vector_type(2)));
__device__ __forceinline__ unsigned pk2(float lo, float hi) { const f32x2_t v = {lo, hi}; const bf16x2_t b = __builtin_convertvector(v, bf16x2_t); return __builtin_bit_cast(unsigned, b); }
__device__ __forceinline__ unsigned f2bf(float f) { return pk2(f, 0.f) & 0xffffu; }
__device__ __forceinline__ float bf2f(bf16 b) { return __builtin_bit_cast(float, (unsigned)b << 16); }
__device__ __forceinline__ float bflo(unsigned u) { return __builtin_bit_cast(float, u << 16); }
__device__ __forceinline__ float bfhi(unsigned u) { return __builtin_bit_cast(float, u & 0xffff0000u); }
__device__ __forceinline__ float wave_sum(float v) {
#pragma unroll
    for (int o = 1; o < 64; o <<= 1) v += __shfl_xor(v, o);
    return v;
}
__device__ __forceinline__ float wave_max(float v) {
#pragma unroll
    for (int o = 1; o < 64; o <<= 1) v = fmaxf(v, __shfl_xor(v, o));
    return v;
}

#define XB_TMO      128
#define XB_XCNT(j)  (256  + 64 * (j))
#define XB_XSUB(j)  (1280 + 64 * (j))
#define XB_XGEN(j)  (2304 + 64 * (j))
#define XB_TOP      3328
#define XB_TOPGEN   3392
#define XCD_BAR_WORDS 3456
#define XB_SPIN_CAP (1u << 22)

__device__ __forceinline__ unsigned xb_ld(unsigned* p)              { return __hip_atomic_load(p, __ATOMIC_RELAXED, __HIP_MEMORY_SCOPE_AGENT); }
__device__ __forceinline__ unsigned xb_add(unsigned* p, unsigned v) { return __hip_atomic_fetch_add(p, v, __ATOMIC_RELAXED, __HIP_MEMORY_SCOPE_AGENT); }
__device__ __forceinline__ unsigned xb_xcc_id() { return (unsigned)__builtin_amdgcn_s_getreg((3 << 11) | 20) & 0xFu; }
#define XB_SPIN(cond, bar) do { unsigned _sp = 0; while (cond) { __builtin_amdgcn_s_sleep(1); \
    if ((++_sp & 255u) == 0u) { if (xb_ld(&(bar)[XB_TMO])) break; if (_sp > XB_SPIN_CAP) { atomicAdd(&(bar)[XB_TMO], 1u); break; } } } } while (0)

struct XcdBarrier { unsigned* bar; unsigned x; volatile LAS unsigned* st; };

__device__ __forceinline__ XcdBarrier xcd_barrier_post(unsigned* bar, volatile LAS unsigned* st) {
    XcdBarrier b; b.bar = bar; b.x = xb_xcc_id(); b.st = st;
    if (threadIdx.x == 0) (void)xb_add(&bar[XB_XCNT(b.x)], 1u);
    return b;
}
__device__ __forceinline__ void xcd_barrier_complete(unsigned* bar, unsigned x, unsigned& nloc, unsigned& nx) {
    const unsigned G = gridDim.x * gridDim.y * gridDim.z;
    unsigned sum, cnt, mine, sp = 0u;
    for (;;) {
        sum = 0u; cnt = 0u; mine = 0u;
#pragma unroll
        for (unsigned j = 0; j < 16; ++j) { const unsigned c = xb_ld(&bar[XB_XCNT(j)]); sum += c; cnt += (c > 0u) ? 1u : 0u; mine = (j == x) ? c : mine; }
        if (sum == G) break;
        __builtin_amdgcn_s_sleep(1);
        if ((++sp & 255u) == 0u) { if (xb_ld(&bar[XB_TMO])) break; if (sp > XB_SPIN_CAP) { atomicAdd(&bar[XB_TMO], 1u); break; } }
    }
    nloc = mine > 0u ? mine : 1u; nx = cnt > 0u ? cnt : 1u;
}
__device__ __forceinline__ void xcd_barrier(const XcdBarrier& b) {
    asm volatile("s_waitcnt vmcnt(0)" ::: "memory");
    __syncthreads();
    if (threadIdx.x == 0) {
        unsigned* bar = b.bar;
        __builtin_amdgcn_s_waitcnt(0);
        unsigned nloc = b.st[0], nx = b.st[1];
        if (nloc == 0u) { xcd_barrier_complete(bar, b.x, nloc, nx); b.st[0] = nloc; b.st[1] = nx; }
        const unsigned old = xb_add(&bar[XB_XSUB(b.x)], 1u);
        const unsigned gen = old / nloc;
        if (old + 1u == (gen + 1u) * nloc) {
            __builtin_amdgcn_fence(__ATOMIC_RELEASE, "agent");
            asm volatile("s_waitcnt vmcnt(0)" ::: "memory");
            const unsigned og = xb_add(&bar[XB_TOP], 1u);
            const unsigned tg = og / nx;
            if (og + 1u == (tg + 1u) * nx) xb_add(&bar[XB_TOPGEN], 1u);
            else XB_SPIN(xb_ld(&bar[XB_TOPGEN]) == tg, bar);
            __builtin_amdgcn_fence(__ATOMIC_ACQUIRE, "agent");
            xb_add(&bar[XB_XGEN(b.x)], 1u);
            asm volatile("s_waitcnt vmcnt(0)" ::: "memory");
        } else {
            XB_SPIN(xb_ld(&bar[XB_XGEN(b.x)]) == gen, bar);
            __builtin_amdgcn_fence(__ATOMIC_ACQUIRE, "agent");
            asm volatile("s_waitcnt vmcnt(0)" ::: "memory");
        }
    }
    __syncthreads();
}

struct Args { const float* in[26]; float* out; unsigned char* ws; int ph_lo, ph_hi; };
enum { I_X = 0, I_MEM, I_EN1, I_EWIN, I_RPB, I_EWOUT, I_EN2, I_EWG, I_EWU, I_EWD, I_ON1, I_OWIN, I_WGKF, I_BGKF, I_WGKB, I_BGKB, I_GNORM, I_OWOUT, I_ON2, I_WR, I_OWG, I_OWU, I_OWD, I_MNORM, I_WMKV, I_FNORM };

struct Frame {
    LAS unsigned char* lds;
    int tid, lane, wave, G, bid;
    int gw, NGW;
    unsigned char* ws;
};

struct CvtJob { const float* W; int K, N; bf16* WT; const float* gain; int kind; };
__device__ __forceinline__ bool cvt_map(int kind, int n0, int& drow, float& scale) {
    scale = 1.0f;
    switch (kind) {
    case 0: drow = n0; return true;
    case 1: if (n0 < 768) { drow = n0; scale = 0.125f; return true; } if (n0 < 1536) { drow = n0; return true; } if (n0 >= 2304) { drow = n0 - 768; scale = 0.125f; return true; } return false;
    case 2: if (n0 >= 1536 && n0 < 2304) { drow = n0 - 1536; return true; } return false;
    case 3: drow = (n0 >> 7) * 256 + (n0 & 127); return true;
    case 4: drow = (n0 >> 7) * 256 + 128 + (n0 & 127); return true;
    case 5: if (n0 < 768) { drow = n0; return true; } if (n0 < 1536) return false; if (n0 < 2304) { drow = n0 - 768; return true; }
            if (n0 < 2336) { drow = n0 - 512; return true; } drow = n0 - 800; scale = 0.125f; return true;
    case 6: if (n0 >= 768 && n0 < 1536) { drow = n0 - 768; return true; } return false;
    default: drow = n0; return true;
    }
}
struct CvtRegs { f32x4 v[8]; const float* gain; bf16* WT; int K, k0, drow, valid; float scale; };
__device__ __forceinline__ void cvt_load(CvtRegs& R, const CvtJob& J, int item, int lane) {
    const int nblk = J.N / 32, kb = item / nblk, nb = item % nblk, n0 = nb * 32;
    R.k0 = kb * 64; R.gain = J.gain; R.WT = J.WT; R.K = J.K;
    R.valid = cvt_map(J.kind, n0, R.drow, R.scale) ? 1 : 0;
    if (R.valid) { const float* p = J.W + (size_t)(R.k0 + 2 * (lane >> 3)) * J.N + n0 + 4 * (lane & 7);
#pragma unroll
        for (int j = 0; j < 8; ++j) R.v[j] = *(const f32x4*)(p + (size_t)(16 * (j >> 1) + (j & 1)) * J.N); }
}
__device__ __forceinline__ void cvt_finish(const CvtRegs& R, LAS unsigned* T, int lane) {
    if (!R.valid) return;
    const int nq = lane & 7, kr = lane >> 3;
#pragma unroll
    for (int p = 0; p < 4; ++p) { const int k = R.k0 + 16 * p + 2 * kr; float g0 = R.scale, g1 = R.scale; if (R.gain) { g0 *= R.gain[k]; g1 *= R.gain[k + 1]; }
        const f32x4 a = R.v[2 * p], b = R.v[2 * p + 1]; LAS unsigned* t = T + (4 * nq) * 33 + 8 * p + kr;
        t[0] = pk2(a.x * g0, b.x * g1); t[33] = pk2(a.y * g0, b.y * g1); t[66] = pk2(a.z * g0, b.z * g1); t[99] = pk2(a.w * g0, b.w * g1); }
    LDS_WAIT(); asm volatile("" ::: "memory");
#pragma unroll
    for (int r = 0; r < 4; ++r) { const int n = (lane >> 3) + 8 * r, c = lane & 7; const LAS unsigned* sp = T + n * 33 + 4 * c;
        v4u o; o.x = sp[0]; o.y = sp[1]; o.z = sp[2]; o.w = sp[3];
        *(GAS v4u*)(R.WT + (size_t)(R.drow + n) * R.K + R.k0 + 8 * c) = o; }
    LDS_WAIT(); asm volatile("" ::: "memory");
}
__device__ __forceinline__ void rows_to_bf16(const float* X, bf16* Ob, float* rss, int first, int nrows, int stride, int lane) {
    for (int m = first; m < nrows; m += 2 * stride) {
        const int m2 = m + stride; const bool h2 = m2 < nrows;
        const GAS f32x4* xa = (const GAS f32x4*)(X + (size_t)m * DM) + lane; const GAS f32x4* xb = (const GAS f32x4*)(X + (size_t)(h2 ? m2 : m) * DM) + lane;
        f32x4 va[4], vb[4];
#pragma unroll
        for (int j = 0; j < 4; ++j) va[j] = xa[64 * j];
#pragma unroll
        for (int j = 0; j < 4; ++j) vb[j] = xb[64 * j];
        float sa = 0.f, sb = 0.f;
#pragma unroll
        for (int j = 0; j < 4; ++j) { sa += (va[j].x * va[j].x + va[j].y * va[j].y) + (va[j].z * va[j].z + va[j].w * va[j].w); sb += (vb[j].x * vb[j].x + vb[j].y * vb[j].y) + (vb[j].z * vb[j].z + vb[j].w * vb[j].w); }
        sa = wave_sum(sa); sb = wave_sum(sb);
        GAS unsigned long long* oa = (GAS unsigned long long*)(Ob + (size_t)m * DM) + lane;
#pragma unroll
        for (int j = 0; j < 4; ++j) oa[64 * j] = (unsigned long long)pk2(va[j].x, va[j].y) | ((unsigned long long)pk2(va[j].z, va[j].w) << 32);
        if (lane < 16) rss[(size_t)m * 16 + lane] = (lane == 0) ? sa : 0.f;
        if (h2) { GAS unsigned long long* ob = (GAS unsigned long long*)(Ob + (size_t)m2 * DM) + lane;
#pragma unroll
            for (int j = 0; j < 4; ++j) ob[64 * j] = (unsigned long long)pk2(vb[j].x, vb[j].y) | ((unsigned long long)pk2(vb[j].z, vb[j].w) << 32);
            if (lane < 16) rss[(size_t)m2 * 16 + lane] = (lane == 0) ? sb : 0.f; }
    }
}

struct Unit { int pm, pn; };
struct Sched {
    int nM, nN, nwg, G, c, K;
    const char* A; const char* B; const int* bexp; size_t estride;
    __device__ void init(const void* A_, const void* B_, int K_, int nM_, int nN_, int G_, int c_, const int* bexp_ = nullptr, size_t estride_ = 0) {
        A = (const char*)A_; B = (const char*)B_; K = K_; nM = nM_; nN = nN_; nwg = nM * nN; G = G_; c = c_; bexp = bexp_; estride = estride_; }
    __device__ bool next(int i, Unit& u) const {
        const long L = (long)i * G + c; if (L >= nwg) return false;
        int wgid = (int)L; { const int q = nwg / 8, r = nwg % 8, xcd = wgid % 8, off = wgid / 8; wgid = (xcd < r ? xcd * (q + 1) : r * (q + 1) + (xcd - r) * q) + off; }
        const int nig = 8 * nN, gid = wgid / nig, fm = gid * 8, gsz = (nM - fm) < 8 ? (nM - fm) : 8;
        u.pm = fm + ((wgid % nig) % gsz); u.pn = (wgid % nig) / gsz; return true;
    }
    __device__ const char* a_base(const Unit& u) const { return A + (size_t)u.pm * 512 * K; }
    __device__ const char* b_base(const Unit& u) const { return B + (bexp ? (size_t)bexp[u.pm] * estride : (size_t)0) + (size_t)u.pn * 512 * K; }
};

struct NoAux {};
__device__ __forceinline__ float rstd_from(const float* rss16) {
    const f32x4* p = (const f32x4*)rss16; f32x4 a = p[0], b = p[1], c = p[2], d = p[3];
    const float s = ((a.x + a.y) + (a.z + a.w)) + ((b.x + b.y) + (b.z + b.w)) + ((c.x + c.y) + (c.z + c.w)) + ((d.x + d.y) + (d.z + d.w));
    return __builtin_amdgcn_rsqf(s * (1.0f / DM) + EPS);
}
struct RowCtx { float rs[2][4]; };
__device__ __forceinline__ void row_scales(RowCtx& c, const float* rss, const int (&t)[2][4], int fq) {
    f32x4 p[2][4];
#pragma unroll
    for (int ai = 0; ai < 2; ++ai)
#pragma unroll
        for (int m = 0; m < 4; ++m) p[ai][m] = *(const f32x4*)(rss + (size_t)(t[ai][m] < 0 ? 0 : t[ai][m]) * 16 + 4 * fq);
#pragma unroll
    for (int ai = 0; ai < 2; ++ai)
#pragma unroll
        for (int m = 0; m < 4; ++m) { float s = (p[ai][m].x + p[ai][m].y) + (p[ai][m].z + p[ai][m].w); s += __shfl_xor(s, 16); s += __shfl_xor(s, 32);
            c.rs[ai][m] = t[ai][m] < 0 ? 0.f : __builtin_amdgcn_rsqf(s * (1.0f / DM) + EPS); }
}
struct EpiRowScale {
    static constexpr bool NEED_SS = false; typedef RowCtx Ctx; typedef NoAux Aux;
    bf16* O; int ldc; const float* rss;
    __device__ __forceinline__ void begin(Ctx& c, int row0, int, int c128) const {
        int t[2][4];
#pragma unroll
        for (int ai = 0; ai < 2; ++ai)
#pragma unroll
            for (int m = 0; m < 4; ++m) t[ai][m] = row0 + ai * 128 + m * 16;
        row_scales(c, rss, t, (c128 >> 3) & 3);
    }
    __device__ __forceinline__ void load_aux(Aux&, const Ctx&, int, int, int, int, int) const {}
    __device__ __forceinline__ float apply(const Ctx& c, const Aux&, int ai, int m, int row, int pn, int c128, const float (&a)[8], const float (&b)[8]) const {
        const float s = c.rs[ai][m];
        bf16* p = O + (size_t)row * ldc + pn * 256 + c128;
        v4u w; w.x = pk2(a[0] * s, a[1] * s); w.y = pk2(a[2] * s, a[3] * s); w.z = pk2(a[4] * s, a[5] * s); w.w = pk2(a[6] * s, a[7] * s); *(v4u*)p = w;
        w.x = pk2(b[0] * s, b[1] * s); w.y = pk2(b[2] * s, b[3] * s); w.z = pk2(b[4] * s, b[5] * s); w.w = pk2(b[6] * s, b[7] * s); *(v4u*)(p + 128) = w;
        return 0.f;
    }
    __device__ __forceinline__ void row_done(int, int, int, float) const {}
};
struct ColCtx { float sa[8], sb[8]; };
struct EpiColScale {
    static constexpr bool NEED_SS = false; typedef ColCtx Ctx; typedef NoAux Aux;
    bf16* O; int ldc; const float* rss;
    __device__ __forceinline__ void begin(Ctx& c, int row0, int pn, int c128) const {
        const int fr = row0 & 15, lane = threadIdx.x & 63;
        const float mine = rstd_from(rss + (size_t)(pn * 256 + c128 + (fr & 7) + (fr >> 3) * 128) * 16);
#pragma unroll
        for (int j = 0; j < 8; ++j) { c.sa[j] = __shfl(mine, (lane & 48) + j); c.sb[j] = __shfl(mine, (lane & 48) + 8 + j); }
    }
    __device__ __forceinline__ void load_aux(Aux&, const Ctx&, int, int, int, int, int) const {}
    __device__ __forceinline__ float apply(const Ctx& c, const Aux&, int, int, int row, int pn, int c128, const float (&a)[8], const float (&b)[8]) const {
        bf16* p = O + (size_t)row * ldc + pn * 256 + c128;
        v4u w; w.x = pk2(a[0] * c.sa[0], a[1] * c.sa[1]); w.y = pk2(a[2] * c.sa[2], a[3] * c.sa[3]); w.z = pk2(a[4] * c.sa[4], a[5] * c.sa[5]); w.w = pk2(a[6] * c.sa[6], a[7] * c.sa[7]); *(v4u*)p = w;
        w.x = pk2(b[0] * c.sb[0], b[1] * c.sb[1]); w.y = pk2(b[2] * c.sb[2], b[3] * c.sb[3]); w.z = pk2(b[4] * c.sb[4], b[5] * c.sb[5]); w.w = pk2(b[6] * c.sb[6], b[7] * c.sb[7]); *(v4u*)(p + 128) = w;
        return 0.f;
    }
    __device__ __forceinline__ void row_done(int, int, int, float) const {}
};
struct Aux4 { f32x4 v[4]; };
struct NoCtx {};
struct EpiResid {
    static constexpr bool NEED_SS = true; typedef NoCtx Ctx; typedef Aux4 Aux;
    const float* R; float* H; bf16* HB; float* rss;
    __device__ __forceinline__ void begin(Ctx&, int, int, int) const {}
    __device__ __forceinline__ void load_aux(Aux& x, const Ctx&, int, int, int row, int pn, int c128) const {
        const float* p = R + (size_t)row * DM + pn * 256 + c128;
        x.v[0] = *(const f32x4*)p; x.v[1] = *(const f32x4*)(p + 4); x.v[2] = *(const f32x4*)(p + 128); x.v[3] = *(const f32x4*)(p + 132);
    }
    __device__ __forceinline__ float apply(const Ctx&, const Aux& x, int, int, int row, int pn, int c128, const float (&a)[8], const float (&b)[8]) const {
        const size_t off = (size_t)row * DM + pn * 256 + c128;
        const f32x4 h0 = {x.v[0].x + a[0], x.v[0].y + a[1], x.v[0].z + a[2], x.v[0].w + a[3]}, h1 = {x.v[1].x + a[4], x.v[1].y + a[5], x.v[1].z + a[6], x.v[1].w + a[7]};
        const f32x4 h2 = {x.v[2].x + b[0], x.v[2].y + b[1], x.v[2].z + b[2], x.v[2].w + b[3]}, h3 = {x.v[3].x + b[4], x.v[3].y + b[5], x.v[3].z + b[6], x.v[3].w + b[7]};
        *(f32x4*)(H + off) = h0; *(f32x4*)(H + off + 4) = h1; *(f32x4*)(H + off + 128) = h2; *(f32x4*)(H + off + 132) = h3;
        v4u w; w.x = pk2(h0.x, h0.y); w.y = pk2(h0.z, h0.w); w.z = pk2(h1.x, h1.y); w.w = pk2(h1.z, h1.w); *(v4u*)(HB + off) = w;
        w.x = pk2(h2.x, h2.y); w.y = pk2(h2.z, h2.w); w.z = pk2(h3.x, h3.y); w.w = pk2(h3.z, h3.w); *(v4u*)(HB + off + 128) = w;
        return ((h0.x * h0.x + h0.y * h0.y) + (h0.z * h0.z + h0.w * h0.w) + (h1.x * h1.x + h1.y * h1.y) + (h1.z * h1.z + h1.w * h1.w))
             + ((h2.x * h2.x + h2.y * h2.y) + (h2.z * h2.z + h2.w * h2.w) + (h3.x * h3.x + h3.y * h3.y) + (h3.z * h3.z + h3.w * h3.w));
    }
    __device__ __forceinline__ void row_done(int row, int pn, int wc, float ss) const { rss[(size_t)row * 16 + pn * 4 + wc] = ss; }
};
__device__ __forceinline__ float silu_mul(float g, float u) { return g * __builtin_amdgcn_rcpf(1.0f + __builtin_amdgcn_exp2f(g * -1.4426950408889634f)) * u; }
struct EpiSwiGLU {
    static constexpr bool NEED_SS = false; typedef RowCtx Ctx; typedef NoAux Aux;
    bf16* Hm; int ldh; const float* rss; const int* tok;
    __device__ __forceinline__ void begin(Ctx& c, int row0, int, int c128) const {
        int t[2][4];
#pragma unroll
        for (int ai = 0; ai < 2; ++ai)
#pragma unroll
            for (int m = 0; m < 4; ++m) { const int row = row0 + ai * 128 + m * 16; t[ai][m] = tok ? tok[row] : row; }
        row_scales(c, rss, t, (c128 >> 3) & 3);
    }
    __device__ __forceinline__ void load_aux(Aux&, const Ctx&, int, int, int, int, int) const {}
    __device__ __forceinline__ float apply(const Ctx& c, const Aux&, int ai, int m, int row, int pn, int c128, const float (&a)[8], const float (&b)[8]) const {
        const float s = c.rs[ai][m]; float o[8];
#pragma unroll
        for (int j = 0; j < 8; ++j) o[j] = silu_mul(a[j] * s, b[j] * s);
        v4u w; w.x = pk2(o[0], o[1]); w.y = pk2(o[2], o[3]); w.z = pk2(o[4], o[5]); w.w = pk2(o[6], o[7]);
        *(v4u*)(Hm + (size_t)row * ldh + pn * 128 + c128) = w;
        return 0.f;
    }
    __device__ __forceinline__ void row_done(int, int, int, float) const {}
};
struct MoeCtx { int t[2][4]; float w[2][4]; };
struct EpiMoeDown {
    static constexpr bool NEED_SS = false; typedef MoeCtx Ctx; typedef Aux4 Aux;
    float* H; const int* tok; const float* w;
    __device__ __forceinline__ void begin(Ctx& c, int row0, int, int) const {
#pragma unroll
        for (int ai = 0; ai < 2; ++ai)
#pragma unroll
            for (int m = 0; m < 4; ++m) { const int row = row0 + ai * 128 + m * 16; c.t[ai][m] = tok[row]; c.w[ai][m] = w[row]; }
    }
    __device__ __forceinline__ void load_aux(Aux& x, const Ctx& c, int ai, int m, int, int pn, int c128) const {
        const int t = c.t[ai][m]; const float* p = H + (size_t)(t < 0 ? 0 : t) * DM + pn * 256 + c128;
        x.v[0] = *(const f32x4*)p; x.v[1] = *(const f32x4*)(p + 4); x.v[2] = *(const f32x4*)(p + 128); x.v[3] = *(const f32x4*)(p + 132);
    }
    __device__ __forceinline__ float apply(const Ctx& c, const Aux& x, int ai, int m, int, int pn, int c128, const float (&a)[8], const float (&b)[8]) const {
        const int t = c.t[ai][m]; if (t < 0) return 0.f;
        const float s = c.w[ai][m]; float* p = H + (size_t)t * DM + pn * 256 + c128;
        f32x4 h0 = x.v[0], h1 = x.v[1], h2 = x.v[2], h3 = x.v[3];
        h0.x += s * a[0]; h0.y += s * a[1]; h0.z += s * a[2]; h0.w += s * a[3]; h1.x += s * a[4]; h1.y += s * a[5]; h1.z += s * a[6]; h1.w += s * a[7];
        h2.x += s * b[0]; h2.y += s * b[1]; h2.z += s * b[2]; h2.w += s * b[3]; h3.x += s * b[4]; h3.y += s * b[5]; h3.z += s * b[6]; h3.w += s * b[7];
        *(f32x4*)p = h0; *(f32x4*)(p + 4) = h1; *(f32x4*)(p + 128) = h2; *(f32x4*)(p + 132) = h3;
        return 0.f;
    }
    __device__ __forceinline__ void row_done(int, int, int, float) const {}
};

namespace pg8 {
constexpr int HTB = 16384, TOK_OFF = 132096;
__device__ __forceinline__ int lds_byte(int r, int c) { const int st = (r >> 4) * 2 + (c >> 5), rr = r & 15, cc = c & 31, ob = rr * 64 + cc * 2; return st * 1024 + (ob ^ (((ob >> 9) & 1) << 5)); }
__device__ __forceinline__ void stage_rc(int b, int& R, int& C) { const int st = b / 1024, sb = b % 1024, swz = sb ^ (((sb >> 9) & 1) << 5); R = (st >> 1) * 16 + swz / 64; C = (st & 1) * 32 + (swz % 64) / 2; }
__device__ __forceinline__ int perm32(int rho) { const int n = rho >> 4, i = rho & 15; return 8 * (i >> 2) + 4 * n + (i & 3); }

template <class Epi>
__device__ __forceinline__ void run_epi(const Epi& E, const f32x4 (&acc)[2][2][4][2], const Unit& u, int wr, int wc, int fr, int fq) {
    int row0 = u.pm * 256 + wr * 64 + fr, c128 = 32 * wc + 8 * fq;
    asm volatile("" : "+v"(row0), "+v"(c128));
    typename Epi::Ctx ctx; E.begin(ctx, row0, u.pn, c128);
#pragma unroll
    for (int ai = 0; ai < 2; ++ai) {
        typename Epi::Aux aux[4];
#pragma unroll
        for (int m = 0; m < 4; ++m) E.load_aux(aux[m], ctx, ai, m, row0 + ai * 128 + m * 16, u.pn, c128);
#pragma unroll
        for (int m = 0; m < 4; ++m) {
            const int row = row0 + ai * 128 + m * 16;
            float a[8], b[8];
#pragma unroll
            for (int j = 0; j < 8; ++j) { a[j] = acc[ai][0][m][j >> 2][j & 3]; b[j] = acc[ai][1][m][j >> 2][j & 3]; }
            float ss = E.apply(ctx, aux[m], ai, m, row, u.pn, c128, a, b);
            if (Epi::NEED_SS) { ss += __shfl_xor(ss, 16); ss += __shfl_xor(ss, 32); if (fq == 0) E.row_done(row, u.pn, wc, ss); }
        }
    }
}

template <class Epi, bool GATHER>
__device__ __forceinline__ void gemm_fast(LAS unsigned char* lds, const Sched& S, const Epi& E, const int* gtok) {
    int tid = threadIdx.x; asm volatile("" : "+v"(tid));
    const int wid = __builtin_amdgcn_readfirstlane(tid >> 6), lane = tid & 63, wr = wid >> 2, wc = wid & 3, fr = lane & 15, fq = lane >> 4;
    const int K = S.K, nt = K / 64;
    unsigned voffB[2], vA0[2], vA1[2], nA0[2], nA1[2]; int RA[2], CA2[2];
#pragma unroll
    for (int i = 0; i < 2; ++i) { int R, C; stage_rc(tid * 16 + i * 8192, R, C); const int Rb = (R & ~31) + perm32(R & 31);
        voffB[i] = (unsigned)(Rb * K + C) * 2u; RA[i] = R; CA2[i] = C * 2; vA0[i] = (unsigned)(R * K + C) * 2u; vA1[i] = vA0[i] + (unsigned)(128 * K * 2); nA0[i] = vA0[i]; nA1[i] = vA1[i]; }
    const size_t kstep = 128;
    const size_t hstep = (size_t)128 * K * 2;
    const unsigned ldsw = (unsigned)wid * 1024u;
    const int aoff = lds_byte(wr * 64 + fr, fq * 8), boff = lds_byte(wc * 32 + fr, fq * 8);
    LAS int* tl = (LAS int*)(lds + TOK_OFF);
#define PG8_SA(b, h) (((b) * 2 + (h)) * HTB)
#define PG8_SB(b, h) ((4 + (b) * 2 + (h)) * HTB)
#define PG8_STAGE(bufoff, gbase, voff) do { _Pragma("unroll") for (int _i = 0; _i < 2; ++_i) \
        __builtin_amdgcn_global_load_lds((const unsigned*)((const char*)(gbase) + (voff)[_i]), (LAS unsigned*)(lds + (bufoff) + ldsw + _i * 8192), 16, 0, 0); } while (0)
#define PG8_LDA(dst, b, h) do { _Pragma("unroll") for (int m = 0; m < 4; ++m) _Pragma("unroll") for (int k = 0; k < 2; ++k) dst[m][k] = *(const LAS bf16x8*)(lds + PG8_SA(b, h) + aoff + m * 2048 + k * 1024); } while (0)
#define PG8_LDB(dst, b, h) do { _Pragma("unroll") for (int n = 0; n < 2; ++n) _Pragma("unroll") for (int k = 0; k < 2; ++k) dst[n][k] = *(const LAS bf16x8*)(lds + PG8_SB(b, h) + boff + n * 2048 + k * 1024); } while (0)
#define PG8_MMA(ai, bj, At, Bt) do { __builtin_amdgcn_s_setprio(1); _Pragma("unroll") for (int m = 0; m < 4; ++m) _Pragma("unroll") for (int n = 0; n < 2; ++n) _Pragma("unroll") for (int k = 0; k < 2; ++k) \
        acc[ai][bj][m][n] = __builtin_amdgcn_mfma_f32_16x16x32_bf16(Bt[n][k], At[m][k], acc[ai][bj][m][n], 0, 0, 0); __builtin_amdgcn_s_setprio(0); } while (0)
#define PG8_WAIT_V(n) asm volatile("s_waitcnt vmcnt(" #n ")" ::: "memory")
#define PG8_WAIT_L(n) asm volatile("s_waitcnt lgkmcnt(" #n ")" ::: "memory")
#define PG8_BAR __builtin_amdgcn_s_barrier()
#define PG8_SCHED __builtin_amdgcn_sched_barrier(0)
#define PG8_IDS_DMA(pm_, par_) do { if (wid < 4) __builtin_amdgcn_global_load_lds((const unsigned*)(gtok + (pm_) * 256 + wid * 64 + lane), (LAS unsigned*)(lds + TOK_OFF + (par_) * 1024 + wid * 256), 4, 0, 0); } while (0)
#define PG8_IDS_READ(d0, d1, par_) do { _Pragma("unroll") for (int _i = 0; _i < 2; ++_i) { int t0 = tl[(par_) * 256 + RA[_i]], t1 = tl[(par_) * 256 + 128 + RA[_i]]; t0 = t0 < 0 ? 0 : t0; t1 = t1 < 0 ? 0 : t1; \
        d0[_i] = (unsigned)t0 * (unsigned)(K * 2) + (unsigned)CA2[_i]; d1[_i] = (unsigned)t1 * (unsigned)(K * 2) + (unsigned)CA2[_i]; } } while (0)
    Unit cur, nxt; int ui = 0, par = 0;
    if (!S.next(0, cur)) return;
    f32x4 acc[2][2][4][2];
#pragma unroll
    for (int a = 0; a < 2; ++a)
#pragma unroll
        for (int b = 0; b < 2; ++b)
#pragma unroll
            for (int m = 0; m < 4; ++m)
#pragma unroll
                for (int n = 0; n < 2; ++n) acc[a][b][m][n] = (f32x4){0.f, 0.f, 0.f, 0.f};
    bf16x8 At[4][2], B0[2][2], B1[2][2];
    const char* cA = GATHER ? S.A : S.a_base(cur); const char* cB = S.b_base(cur);
    if constexpr (GATHER) { PG8_IDS_DMA(cur.pm, 0); PG8_WAIT_V(0); __syncthreads(); PG8_IDS_READ(vA0, vA1, 0); }
    PG8_STAGE(PG8_SB(0, 0), cB, voffB); PG8_STAGE(PG8_SB(0, 1), cB + hstep, voffB); PG8_STAGE(PG8_SA(0, 0), cA, vA0); PG8_STAGE(PG8_SA(0, 1), cA, vA1);
    if (wr == 1) PG8_BAR;
    PG8_WAIT_V(2); PG8_BAR;
    PG8_STAGE(PG8_SB(1, 0), cB + kstep, voffB); PG8_STAGE(PG8_SA(1, 0), cA + kstep, vA0); PG8_STAGE(PG8_SB(1, 1), cB + hstep + kstep, voffB);
    PG8_WAIT_V(6); PG8_BAR;
    for (;;) {
        const bool has_next = S.next(ui + 1, nxt);
        const char* nA = has_next ? (GATHER ? S.A : S.a_base(nxt)) : cA; const char* nB = has_next ? S.b_base(nxt) : cB;
        for (int t = 0; t < nt; t += 2) {
            const bool last = (t == nt - 2);
            if constexpr (GATHER) {
                if (t == nt - 4 && has_next) PG8_IDS_DMA(nxt.pm, par ^ 1);
                if (last) { if (has_next) PG8_IDS_READ(nA0, nA1, par ^ 1); else { nA0[0] = vA0[0]; nA0[1] = vA0[1]; nA1[0] = vA1[0]; nA1[1] = vA1[1]; } }
            }
            const char* a1 = cA + (size_t)(t + 1) * kstep;
            const char* a2 = last ? nA : cA + (size_t)(t + 2) * kstep; const char* b2 = last ? nB : cB + (size_t)(t + 2) * kstep;
            const char* a3 = a2 + kstep; const char* b3 = b2 + kstep;
            unsigned w0[2], w1[2];
            if (GATHER && last) { w0[0] = nA0[0]; w0[1] = nA0[1]; w1[0] = nA1[0]; w1[1] = nA1[1]; } else { w0[0] = vA0[0]; w0[1] = vA0[1]; w1[0] = vA1[0]; w1[1] = vA1[1]; }
            PG8_LDB(B0, 0, 0); PG8_LDB(B1, 0, 1); PG8_SCHED; PG8_LDA(At, 0, 0); PG8_STAGE(PG8_SA(1, 1), a1, vA1);
            PG8_WAIT_V(8); PG8_WAIT_L(0); PG8_BAR; PG8_MMA(0, 0, At, B0); PG8_MMA(0, 1, At, B1); PG8_BAR; PG8_SCHED;
            PG8_LDA(At, 0, 1); PG8_STAGE(PG8_SB(0, 0), b2, voffB); PG8_STAGE(PG8_SB(0, 1), b2 + hstep, voffB); PG8_STAGE(PG8_SA(0, 0), a2, w0);
            PG8_WAIT_V(8); PG8_WAIT_L(0); PG8_BAR; PG8_MMA(1, 0, At, B0); PG8_MMA(1, 1, At, B1); PG8_BAR; PG8_SCHED;
            PG8_LDB(B0, 1, 0); PG8_LDB(B1, 1, 1); PG8_SCHED; PG8_LDA(At, 1, 0); PG8_STAGE(PG8_SA(0, 1), a2, w1);
            PG8_WAIT_V(8); PG8_WAIT_L(0); PG8_BAR; PG8_MMA(0, 0, At, B0); PG8_MMA(0, 1, At, B1); PG8_BAR; PG8_SCHED;
            PG8_LDA(At, 1, 1); PG8_STAGE(PG8_SB(1, 0), b3, voffB); PG8_STAGE(PG8_SB(1, 1), b3 + hstep, voffB); PG8_STAGE(PG8_SA(1, 0), a3, w0);
            PG8_WAIT_V(8); PG8_WAIT_L(0); PG8_BAR; PG8_MMA(1, 0, At, B0); PG8_MMA(1, 1, At, B1); PG8_BAR; PG8_SCHED;
        }
        if (wr == 0) PG8_BAR;
        run_epi(E, acc, cur, wr, wc, fr, fq);
        if (!has_next) break;
#pragma unroll
        for (int a = 0; a < 2; ++a)
#pragma unroll
            for (int b = 0; b < 2; ++b)
#pragma unroll
                for (int m = 0; m < 4; ++m)
#pragma unroll
                    for (int n = 0; n < 2; ++n) acc[a][b][m][n] = (f32x4){0.f, 0.f, 0.f, 0.f};
        cur = nxt; cA = nA; cB = nB; ++ui;
        if constexpr (GATHER) { vA0[0] = nA0[0]; vA0[1] = nA0[1]; vA1[0] = nA1[0]; vA1[1] = nA1[1]; par ^= 1; }
        if (wr == 1) PG8_BAR;
    }
    PG8_WAIT_V(0);
    PG8_BAR;
#undef PG8_SA
#undef PG8_SB
#undef PG8_STAGE
#undef PG8_LDA
#undef PG8_LDB
#undef PG8_MMA
#undef PG8_WAIT_V
#undef PG8_WAIT_L
#undef PG8_BAR
#undef PG8_SCHED
#undef PG8_IDS_DMA
#undef PG8_IDS_READ
}
}

template <class Epi, bool GATHER>
__device__ __forceinline__ void gemm_run(LAS unsigned char* lds, const Sched& S, const Epi& E, const int* gtok) { pg8::gemm_fast<Epi, GATHER>(lds, S, E, gtok); }

__device__ __forceinline__ void na_simple(const Frame& F, const bf16* act0, const bf16* v0t, const float* rpb, bf16* mix) {
    for (int it = F.gw; it < NT * 12; it += F.NGW) {
        const int token = it / 12, h = it % 12, lane = F.lane;
        const int b = token >> 12, p = token & 4095, r = p >> 6, c = p & 63;
        const int r0 = min(max(r - 4, 0), 56), cs = min(max(c - 8, 0), 48);
        const float q = bf2f(act0[(size_t)token * A0_LD + h * 64 + lane]);
        float m = -INFINITY, l = 0.f, o = 0.f;
        for (int a = 0; a < 8; ++a)
            for (int u = 0; u < 16; ++u) {
                const int kt = b * SEQ + (r0 + a) * 64 + cs + u;
                const float kv = bf2f(act0[(size_t)kt * A0_LD + 768 + h * 64 + lane]);
                const float sc = wave_sum(q * kv) + rpb[h * 465 + (r0 + a - r + 7) * 31 + (cs + u - c + 15)];
                const float mn = fmaxf(m, sc), corr = __expf(m - mn), pe = __expf(sc - mn);
                const float vv = bf2f(v0t[(size_t)(h * 64 + lane) * NT + kt]);
                l = l * corr + pe; o = o * corr + pe * vv; m = mn;
            }
        mix[(size_t)token * DM + h * 64 + lane] = (bf16)f2bf(o / l);
    }
}
__device__ __forceinline__ void memattn_simple(const Frame& F, int first, int stride, const bf16* act, int ld, int qoff, const bf16* memk, const bf16* memvt, bf16* mix) {
    for (int it = first; it < NT * 4; it += stride) {
        const int token = it >> 2, h = it & 3, lane = F.lane, b = token >> 12;
        const float q = bf2f(act[(size_t)token * ld + qoff + h * 64 + lane]);
        float m = -INFINITY, l = 0.f, o = 0.f;
        for (int j = 0; j < 256; ++j) {
            const float kv = bf2f(memk[(size_t)(b * 256 + j) * 256 + h * 64 + lane]);
            const float sc = wave_sum(q * kv);
            const float mn = fmaxf(m, sc), corr = __expf(m - mn), pe = __expf(sc - mn);
            const float vv = bf2f(memvt[(size_t)(h * 64 + lane) * MEM_ROWS + b * 256 + j]);
            l = l * corr + pe; o = o * corr + pe * vv; m = mn;
        }
        mix[(size_t)token * DM + 768 + h * 64 + lane] = (bf16)f2bf(o / l);
    }
}

typedef short s16x4 __attribute__((ext_vector_type(4)));
template <bool NA>
__device__ __forceinline__ void attn16(int lane, const bf16* Q, int ldq, const bf16* Kb, int ldk, const bf16* Vt, int ldv, int ktok0, int trs, bf16* O, int ldo,
                                       const LAS float* rpb_h, int r, int r0, int jb, int band0) {
    const int qi = lane & 15, g = lane >> 4;
    bf16x8 qf[2];
#pragma unroll
    for (int ks = 0; ks < 2; ++ks) qf[ks] = *(const bf16x8*)(Q + (size_t)qi * ldq + ks * 32 + 8 * g);
    f32x4 s[16];
#pragma unroll
    for (int t = 0; t < 16; ++t) {
        const bf16* kp = Kb + (size_t)(ktok0 + (t >> 1) * trs + (t & 1) * 16 + qi) * ldk + 8 * g;
        const bf16x8 k0 = *(const bf16x8*)kp, k1 = *(const bf16x8*)(kp + 32);
        f32x4 z = {0.f, 0.f, 0.f, 0.f};
        z = __builtin_amdgcn_mfma_f32_16x16x32_bf16(k0, qf[0], z, 0, 0, 0);
        z = __builtin_amdgcn_mfma_f32_16x16x32_bf16(k1, qf[1], z, 0, 0, 0);
        s[t] = z;
    }
    constexpr float L2E = 1.4426950408889634f;
    float m = -INFINITY;
    if constexpr (NA) {
        const int qc = 16 * jb + qi, cs = min(max(qc - 8, 0), 48);
#pragma unroll
        for (int t = 0; t < 16; ++t)
#pragma unroll
            for (int i = 0; i < 4; ++i) {
                const int kc = band0 + 16 * (t & 1) + 4 * g + i; const bool ok = (kc >= cs) && (kc < cs + 16);
                float v = -INFINITY;
                if (ok) v = s[t][i] + rpb_h[(r0 + (t >> 1) - r + 7) * 31 + (kc - qc + 15)];
                s[t][i] = v; m = fmaxf(m, v);
            }
    } else {
#pragma unroll
        for (int t = 0; t < 16; ++t)
#pragma unroll
            for (int i = 0; i < 4; ++i) m = fmaxf(m, s[t][i]);
    }
    m = fmaxf(m, __shfl_xor(m, 16)); m = fmaxf(m, __shfl_xor(m, 32));
    const float mb = m * L2E; float l = 0.f;
    bf16x8 pf[8];
#pragma unroll
    for (int kk = 0; kk < 8; ++kk) {
        float p[8];
#pragma unroll
        for (int i = 0; i < 4; ++i) { p[i] = __builtin_amdgcn_exp2f(s[2 * kk][i] * L2E - mb); p[4 + i] = __builtin_amdgcn_exp2f(s[2 * kk + 1][i] * L2E - mb); }
#pragma unroll
        for (int i = 0; i < 8; ++i) l += p[i];
        v4u w; w.x = pk2(p[0], p[1]); w.y = pk2(p[2], p[3]); w.z = pk2(p[4], p[5]); w.w = pk2(p[6], p[7]);
        pf[kk] = __builtin_bit_cast(bf16x8, w);
    }
    l += __shfl_xor(l, 16); l += __shfl_xor(l, 32);
    const float inv = 1.0f / l;
#pragma unroll
    for (int mt = 0; mt < 4; ++mt) {
        f32x4 acc = {0.f, 0.f, 0.f, 0.f};
#pragma unroll
        for (int kk = 0; kk < 8; ++kk) {
            const bf16* vp = Vt + (size_t)(16 * mt + qi) * ldv + ktok0 + kk * trs + 4 * g;
            const s16x4 v0 = *(const s16x4*)vp, v1 = *(const s16x4*)(vp + 16);
            const bf16x8 vf = __builtin_shufflevector(v0, v1, 0, 1, 2, 3, 4, 5, 6, 7);
            acc = __builtin_amdgcn_mfma_f32_16x16x32_bf16(vf, pf[kk], acc, 0, 0, 0);
        }
        v2u w; w.x = pk2(acc[0] * inv, acc[1] * inv); w.y = pk2(acc[2] * inv, acc[3] * inv);
        *(v2u*)(O + (size_t)qi * ldo + 16 * mt + 4 * g) = w;
    }
}
__device__ __forceinline__ void memattn_item(int it, int lane, const bf16* act, int ld, int qoff, const bf16* memk, const bf16* memvt, bf16* mix) {
    const int tb = it >> 2, h = it & 3, tok0 = tb * 16, b = tok0 >> 12;
    attn16<false>(lane, act + (size_t)tok0 * ld + qoff + h * 64, ld, memk + h * 64, 256, memvt + (size_t)(h * 64) * MEM_ROWS, MEM_ROWS, b * 256, 32,
                  mix + (size_t)tok0 * DM + 768 + h * 64, DM, nullptr, 0, 0, 0, 0);
}
__device__ __forceinline__ void na_item(int it, int lane, const bf16* act0, const bf16* v0t, const LAS float* rpb, bf16* mix) {
    const int jb = it & 3, h = (it >> 2) % 12, br = (it >> 2) / 12, r = br & 63, b = br >> 6;
    const int r0 = min(max(r - 4, 0), 56), band0 = min(max(jb * 16 - 8, 0), 32);
    const int tok0 = b * SEQ + r * 64 + jb * 16;
    attn16<true>(lane, act0 + (size_t)tok0 * A0_LD + h * 64, A0_LD, act0 + 768 + h * 64, A0_LD, v0t + (size_t)(h * 64) * NT, NT, b * SEQ + r0 * 64 + band0, 64,
                 mix + (size_t)tok0 * DM + h * 64, DM, rpb + h * 465, r, r0, jb, band0);
}

__device__ __forceinline__ float logsigmoid(float x) { return fminf(x, 0.f) - log1pf(__expf(-fabsf(x))); }
__device__ __forceinline__ void gla_simple(const Frame& F, int item, const bf16* act1, const bf16* v1t, const float* wgk, const float* bgk, bf16* O) {
    const int b = item >> 3, h = (item >> 1) & 3, dir = item & 1, tid = F.tid;
    LAS float* sh = (LAS float*)F.lds;
    float S[96];
#pragma unroll
    for (int d = 0; d < 96; ++d) S[d] = 0.f;
    float wcol[16], bias = 0.f;
    if (tid < 96) {
#pragma unroll
        for (int r = 0; r < 16; ++r) wcol[r] = wgk[r * 384 + h * 96 + tid];
        bias = bgk[h * 96 + tid];
    }
    for (int tau = 0; tau < SEQ; ++tau) {
        const int token = b * SEQ + (dir ? (SEQ - 1 - tau) : tau);
        LAS float* cur = sh + (tau & 1) * 288;
        if (tid < 96) {
            const bf16* row = act1 + (size_t)token * A1_LD;
            float z = bias;
#pragma unroll
            for (int r = 0; r < 16; ++r) z += bf2f(row[1792 + dir * 16 + r]) * wcol[r];
            cur[tid] = __expf(logsigmoid(z) * (1.0f / 16.0f));
            cur[96 + tid] = bf2f(row[h * 96 + tid]) * 0.10206207261596575f;
            cur[192 + tid] = bf2f(row[384 + h * 96 + tid]);
        }
        __syncthreads();
        if (tid < 192) {
            const float v = bf2f(v1t[(size_t)(h * 192 + tid) * NT + token]);
            float o = 0.f;
            if (dir == 0) {
#pragma unroll
                for (int d = 0; d < 96; ++d) { S[d] = cur[d] * S[d] + cur[192 + d] * v; o += cur[96 + d] * S[d]; }
            } else {
#pragma unroll
                for (int d = 0; d < 96; ++d) { S[d] = cur[d] * S[d]; o += cur[96 + d] * S[d]; S[d] += cur[192 + d] * v; }
            }
            O[(size_t)token * 768 + h * 192 + tid] = (bf16)f2bf(o);
        }
    }
    __syncthreads();
}

__device__ __forceinline__ void gla_pre_item(int item, int wave, int lane, const bf16* act1, const float* W, const float* Bi, bf16* E) {
    const int n = item & 63, dir = (item >> 6) & 1, b = item >> 7, base = b * SEQ + n * 64;
    const int qi = lane & 15, g = lane >> 4;
    bf16x8 zf[4];
#pragma unroll
    for (int ct = 0; ct < 4; ++ct) { const int c = 16 * ct + qi, tok = dir ? base + 63 - c : base + c;
        bf16x8 z = {0, 0, 0, 0, 0, 0, 0, 0}; if (g < 2) z = *(const bf16x8*)(act1 + (size_t)tok * A1_LD + 1792 + dir * 16 + 8 * g); zf[ct] = z; }
#pragma unroll 1
    for (int jj = 0; jj < 3; ++jj) {
        const int j = 16 * (wave + 8 * jj) + qi;
        v4u wu = {0u, 0u, 0u, 0u};
        if (g < 2) { const float* wp = W + (size_t)(8 * g) * 384 + j;
            wu.x = pk2(wp[0], wp[384]); wu.y = pk2(wp[768], wp[1152]); wu.z = pk2(wp[1536], wp[1920]); wu.w = pk2(wp[2304], wp[2688]); }
        const bf16x8 wfr = __builtin_bit_cast(bf16x8, wu);
        const float bias = Bi[j]; float carry = 0.f;
#pragma unroll
        for (int ct = 0; ct < 4; ++ct) {
            f32x4 d = {0.f, 0.f, 0.f, 0.f};
            d = __builtin_amdgcn_mfma_f32_16x16x32_bf16(zf[ct], wfr, d, 0, 0, 0);
            float p[4];
#pragma unroll
            for (int i = 0; i < 4; ++i) { const float x = d[i] + bias; p[i] = (fminf(x, 0.f) - __logf(1.0f + __expf(-fabsf(x)))) * 0.0625f; }
            p[1] += p[0]; p[2] += p[1]; p[3] += p[2];
            float a = p[3]; float t = __shfl_up(a, 16); if (g >= 1) a += t; t = __shfl_up(a, 32); if (g >= 2) a += t;
            const float excl = a - p[3] + carry;
            carry += __shfl(a, 48 + qi);
#pragma unroll
            for (int i = 0; i < 4; ++i) { const int c = 16 * ct + 4 * g + i, tok = dir ? base + 63 - c : base + c;
                E[(size_t)tok * 384 + j] = (bf16)f2bf(__expf(excl + p[i])); }
        }
    }
}
constexpr int GL_QT = 0, GL_KT = 13312, GL_KDT = 26624, GL_VT = 40448, GL_DEC = 47360, GL_BUF = 49152;
__device__ __forceinline__ unsigned rev16(unsigned u) { return (u >> 16) | (u << 16); }
__device__ __forceinline__ void gla_main_item(const Frame& F, int item, const bf16* act1, const bf16* v1t, const bf16* Eall, bf16* OFp, bf16* OBp) {
    const int vs = item & 3, dir = (item >> 2) & 1, h = (item >> 3) & 3, b = item >> 5;
    const int tid = F.tid, lane = F.lane, wave = F.wave, qi = lane & 15, g = lane >> 4, ct = wave & 3, vh = wave >> 2;
    const bf16* E = Eall + (size_t)dir * NT * 384; bf16* O = dir ? OBp : OFp;
    LAS unsigned char* L = F.lds;
    const int pc = tid >> 3, pdg = tid & 7;
    f32x4 S[2][6];
#pragma unroll
    for (int vi = 0; vi < 2; ++vi)
#pragma unroll
        for (int dt = 0; dt < 6; ++dt) S[vi][dt] = (f32x4){0.f, 0.f, 0.f, 0.f};
    v2u rq[3], rk[3], re[3], rel[3]; v4u rv = {0u, 0u, 0u, 0u};
#define GL_LOAD(n_) do { const int nn_ = dir ? 63 - (n_) : (n_), base_ = b * SEQ + nn_ * 64, tokc_ = dir ? base_ + 63 - pc : base_ + pc, tokl_ = dir ? base_ : base_ + 63; \
        const bf16* ar_ = act1 + (size_t)tokc_ * A1_LD + h * 96 + 12 * pdg; const bf16* er_ = E + (size_t)tokc_ * 384 + h * 96 + 12 * pdg; const bf16* el_ = E + (size_t)tokl_ * 384 + h * 96 + 12 * pdg; \
        _Pragma("unroll") for (int j_ = 0; j_ < 3; ++j_) { rq[j_] = *(const v2u*)(ar_ + 4 * j_); rk[j_] = *(const v2u*)(ar_ + 384 + 4 * j_); re[j_] = *(const v2u*)(er_ + 4 * j_); rel[j_] = *(const v2u*)(el_ + 4 * j_); } \
        if (pc < 48) rv = *(const v4u*)(v1t + (size_t)(h * 192 + vs * 48 + pc) * NT + base_ + 8 * pdg); } while (0)
#define GL_PREP(bufo_) do { LAS unsigned char* B_ = L + (bufo_); \
        _Pragma("unroll") for (int j_ = 0; j_ < 3; ++j_) { float q_[4], k_[4], e_[4], l_[4], qt_[4], kt_[4], kd_[4]; \
            q_[0] = bflo(rq[j_].x); q_[1] = bfhi(rq[j_].x); q_[2] = bflo(rq[j_].y); q_[3] = bfhi(rq[j_].y); k_[0] = bflo(rk[j_].x); k_[1] = bfhi(rk[j_].x); k_[2] = bflo(rk[j_].y); k_[3] = bfhi(rk[j_].y); \
            e_[0] = bflo(re[j_].x); e_[1] = bfhi(re[j_].x); e_[2] = bflo(re[j_].y); e_[3] = bfhi(re[j_].y); l_[0] = bflo(rel[j_].x); l_[1] = bfhi(rel[j_].x); l_[2] = bflo(rel[j_].y); l_[3] = bfhi(rel[j_].y); \
            _Pragma("unroll") for (int i_ = 0; i_ < 4; ++i_) { const float inv_ = __builtin_amdgcn_rcpf(e_[i_]); qt_[i_] = q_[i_] * 0.10206207261596575f * e_[i_]; kt_[i_] = k_[i_] * inv_; kd_[i_] = kt_[i_] * l_[i_]; } \
            v2u w_; w_.x = pk2(qt_[0], qt_[1]); w_.y = pk2(qt_[2], qt_[3]); *(LAS v2u*)(B_ + GL_QT + pc * 208 + (12 * pdg + 4 * j_) * 2) = w_; \
            w_.x = pk2(kt_[0], kt_[1]); w_.y = pk2(kt_[2], kt_[3]); *(LAS v2u*)(B_ + GL_KT + pc * 208 + (12 * pdg + 4 * j_) * 2) = w_; \
            _Pragma("unroll") for (int i_ = 0; i_ < 4; ++i_) *(LAS bf16*)(B_ + GL_KDT + (12 * pdg + 4 * j_ + i_) * 144 + pc * 2) = (bf16)f2bf(kd_[i_]); \
            if (pc == 0) { f32x4 d_ = {l_[0], l_[1], l_[2], l_[3]}; *(LAS f32x4*)(B_ + GL_DEC + (12 * pdg + 4 * j_) * 4) = d_; } } \
        if (pc < 48) { v4u o_ = rv; int c0_ = 8 * pdg; if (dir) { o_.x = rev16(rv.w); o_.y = rev16(rv.z); o_.z = rev16(rv.y); o_.w = rev16(rv.x); c0_ = 56 - 8 * pdg; } \
            *(LAS v4u*)(B_ + GL_VT + pc * 144 + c0_ * 2) = o_; } } while (0)
    GL_LOAD(0);
    GL_PREP(0);
    GL_LOAD(1);
    asm volatile("s_waitcnt lgkmcnt(0)\n\ts_barrier" ::: "memory");
#pragma unroll 1
    for (int n = 0; n < 64; ++n) {
        const int bo = (n & 1) * GL_BUF;
        if (n + 1 < 64) { GL_PREP(GL_BUF - bo); if (n + 2 < 64) GL_LOAD(n + 2); }
        LAS unsigned char* Bf = L + bo;
        bf16x8 qf[3];
#pragma unroll
        for (int ks = 0; ks < 3; ++ks) qf[ks] = *(const LAS bf16x8*)(Bf + GL_QT + (16 * ct + qi) * 208 + (32 * ks + 8 * g) * 2);
        f32x4 am[4];
#pragma unroll
        for (int tp = 0; tp < 4; ++tp) {
            f32x4 z = {0.f, 0.f, 0.f, 0.f};
            if (tp <= ct) {
#pragma unroll
                for (int ks = 0; ks < 3; ++ks) { const bf16x8 kf = *(const LAS bf16x8*)(Bf + GL_KT + (16 * tp + qi) * 208 + (32 * ks + 8 * g) * 2);
                    z = __builtin_amdgcn_mfma_f32_16x16x32_bf16(kf, qf[ks], z, 0, 0, 0); }
                const int c = 16 * ct + qi;
#pragma unroll
                for (int i = 0; i < 4; ++i) { const int cp = 16 * tp + 4 * g + i; const bool keep = (cp < c) || (dir == 0 && cp == c); z[i] = keep ? z[i] : 0.f; }
            }
            am[tp] = z;
        }
        bf16x8 pf[2];
#pragma unroll
        for (int kk = 0; kk < 2; ++kk) { v4u w; w.x = pk2(am[2 * kk][0], am[2 * kk][1]); w.y = pk2(am[2 * kk][2], am[2 * kk][3]); w.z = pk2(am[2 * kk + 1][0], am[2 * kk + 1][1]); w.w = pk2(am[2 * kk + 1][2], am[2 * kk + 1][3]);
            pf[kk] = __builtin_bit_cast(bf16x8, w); }
        bf16x8 qp[3];
#pragma unroll
        for (int kk = 0; kk < 3; ++kk) { const LAS unsigned char* qr = Bf + GL_QT + (16 * ct + qi) * 208 + (32 * kk + 4 * g) * 2;
            const s16x4 a0 = *(const LAS s16x4*)qr, a1 = *(const LAS s16x4*)(qr + 32); qp[kk] = __builtin_shufflevector(a0, a1, 0, 1, 2, 3, 4, 5, 6, 7); }
        const int nn = dir ? 63 - n : n, base = b * SEQ + nn * 64, c = 16 * ct + qi, tok = dir ? base + 63 - c : base + c;
#pragma unroll
        for (int vi = 0; vi < 2; ++vi) {
            if (vi == 1 && vh == 1) break;
            const int vt = 2 * vh + vi;
            f32x4 acc = {0.f, 0.f, 0.f, 0.f};
#pragma unroll
            for (int kk = 0; kk < 2; ++kk) { const LAS unsigned char* vr = Bf + GL_VT + (16 * vt + qi) * 144 + (32 * kk + 4 * g) * 2;
                const s16x4 a0 = *(const LAS s16x4*)vr, a1 = *(const LAS s16x4*)(vr + 32); const bf16x8 vf = __builtin_shufflevector(a0, a1, 0, 1, 2, 3, 4, 5, 6, 7);
                acc = __builtin_amdgcn_mfma_f32_16x16x32_bf16(vf, pf[kk], acc, 0, 0, 0); }
#pragma unroll
            for (int kk = 0; kk < 3; ++kk) { v4u w; w.x = pk2(S[vi][2 * kk][0], S[vi][2 * kk][1]); w.y = pk2(S[vi][2 * kk][2], S[vi][2 * kk][3]); w.z = pk2(S[vi][2 * kk + 1][0], S[vi][2 * kk + 1][1]); w.w = pk2(S[vi][2 * kk + 1][2], S[vi][2 * kk + 1][3]);
                acc = __builtin_amdgcn_mfma_f32_16x16x32_bf16(__builtin_bit_cast(bf16x8, w), qp[kk], acc, 0, 0, 0); }
            v2u w; w.x = pk2(acc[0], acc[1]); w.y = pk2(acc[2], acc[3]);
            *(v2u*)(O + (size_t)tok * 768 + h * 192 + vs * 48 + 16 * vt + 4 * g) = w;
            bf16x8 vfr[2];
#pragma unroll
            for (int ks = 0; ks < 2; ++ks) vfr[ks] = *(const LAS bf16x8*)(Bf + GL_VT + (16 * vt + qi) * 144 + (32 * ks + 8 * g) * 2);
#pragma unroll
            for (int dt = 0; dt < 6; ++dt) {
                const f32x4 dec = *(const LAS f32x4*)(Bf + GL_DEC + (16 * dt + 4 * g) * 4);
                f32x4 sv = S[vi][dt]; sv[0] *= dec[0]; sv[1] *= dec[1]; sv[2] *= dec[2]; sv[3] *= dec[3];
#pragma unroll
                for (int ks = 0; ks < 2; ++ks) { const bf16x8 kdf = *(const LAS bf16x8*)(Bf + GL_KDT + (16 * dt + qi) * 144 + (32 * ks + 8 * g) * 2);
                    sv = __builtin_amdgcn_mfma_f32_16x16x32_bf16(kdf, vfr[ks], sv, 0, 0, 0); }
                S[vi][dt] = sv;
            }
        }
        asm volatile("s_waitcnt lgkmcnt(0)\n\ts_barrier" ::: "memory");
    }
    __syncthreads();
#undef GL_LOAD
#undef GL_PREP
}

__device__ __forceinline__ void gla_combine(const Frame& F, const bf16* OF, const bf16* OB, const bf16* act1, const float* gnorm, bf16* mix) {
    for (int token = F.gw; token < NT; token += F.NGW) {
        const int lane = F.lane;
#pragma unroll
        for (int h = 0; h < 4; ++h) {
            float o[3]; float ss = 0.f;
#pragma unroll
            for (int j = 0; j < 3; ++j) { const size_t idx = (size_t)token * 768 + h * 192 + j * 64 + lane; o[j] = bf2f(OF[idx]) + bf2f(OB[idx]); ss += o[j] * o[j]; }
            ss = wave_sum(ss);
            const float rs = 1.0f / sqrtf(ss * (1.0f / 192.0f) + EPS);
#pragma unroll
            for (int j = 0; j < 3; ++j) { const int dv = j * 64 + lane; const float g = bf2f(act1[(size_t)token * A1_LD + 768 + h * 192 + dv]);
                const float val = o[j] * rs * gnorm[dv] * (g / (1.0f + __expf(-g)));
                mix[(size_t)token * DM + h * 192 + dv] = (bf16)f2bf(val); }
        }
    }
}
__device__ __forceinline__ void route_pick(const float (&acc)[8], int token, int* topi, float* topw, LAS int* lc) {
    int e0 = 0; float l0 = acc[0];
#pragma unroll
    for (int e = 1; e < 8; ++e) if (acc[e] > l0) { l0 = acc[e]; e0 = e; }
    int e1 = -1; float l1 = -INFINITY;
#pragma unroll
    for (int e = 0; e < 8; ++e) if (e != e0 && acc[e] > l1) { l1 = acc[e]; e1 = e; }
    if (e1 < 0) { e1 = (e0 + 1) & 7; l1 = l0; }
    const float w0 = 1.0f / (1.0f + __expf(l1 - l0));
    topi[token] = e0 | (e1 << 8); topw[2 * token] = w0; topw[2 * token + 1] = 1.0f - w0;
    atomicAdd((int*)&lc[e0], 1); atomicAdd((int*)&lc[8 + e1], 1);
}
__device__ __forceinline__ void route1(const Frame& F, const float* H, const float* gain, const float* wr, int* topi, float* topw, int* cnt) {
    LAS int* lc = (LAS int*)F.lds;
    if (F.tid < 16) lc[F.tid] = 0;
    __syncthreads();
    const int lane = F.lane;
    float w[4][4][8];
#pragma unroll
    for (int j = 0; j < 4; ++j) { const f32x4 g = *(const f32x4*)(gain + 256 * j + 4 * lane);
#pragma unroll
        for (int i = 0; i < 4; ++i) { const float* p = wr + (size_t)(256 * j + 4 * lane + i) * 8; const f32x4 a = *(const f32x4*)p, b = *(const f32x4*)(p + 4); const float gi = g[i];
            w[j][i][0] = a.x * gi; w[j][i][1] = a.y * gi; w[j][i][2] = a.z * gi; w[j][i][3] = a.w * gi; w[j][i][4] = b.x * gi; w[j][i][5] = b.y * gi; w[j][i][6] = b.z * gi; w[j][i][7] = b.w * gi; } }
    for (int t2 = 0; t2 < 16; t2 += 2) {
        const int token = F.bid * 128 + F.wave * 16 + t2;
        const f32x4* h0 = (const f32x4*)(H + (size_t)token * DM) + lane; const f32x4* h1 = h0 + DM / 4;
        f32x4 x0[4], x1[4];
#pragma unroll
        for (int j = 0; j < 4; ++j) x0[j] = h0[64 * j];
#pragma unroll
        for (int j = 0; j < 4; ++j) x1[j] = h1[64 * j];
        float a0[8], a1[8], s0 = 0.f, s1 = 0.f;
#pragma unroll
        for (int e = 0; e < 8; ++e) { a0[e] = 0.f; a1[e] = 0.f; }
#pragma unroll
        for (int j = 0; j < 4; ++j)
#pragma unroll
            for (int i = 0; i < 4; ++i) { const float u = x0[j][i], v = x1[j][i]; s0 += u * u; s1 += v * v;
#pragma unroll
                for (int e = 0; e < 8; ++e) { a0[e] += u * w[j][i][e]; a1[e] += v * w[j][i][e]; } }
        s0 = wave_sum(s0); s1 = wave_sum(s1);
        const float r0 = 1.0f / sqrtf(s0 * (1.0f / DM) + EPS), r1 = 1.0f / sqrtf(s1 * (1.0f / DM) + EPS);
#pragma unroll
        for (int e = 0; e < 8; ++e) { a0[e] = wave_sum(a0[e]) * r0; a1[e] = wave_sum(a1[e]) * r1; }
        if (lane == 0) { route_pick(a0, token, topi, topw, lc); route_pick(a1, token + 1, topi, topw, lc); }
    }
    __syncthreads();
    if (F.tid < 16) cnt[F.bid * 16 + F.tid] = lc[F.tid];
    __syncthreads();
}
__device__ __forceinline__ void route2(const Frame& F, const int* topi, const float* topw, const int* cnt, int* stok, float* sw, int* blk) {
    LAS int* part = (LAS int*)F.lds;
    LAS int* base = part + 1024;
    LAS int* tk = base + 64;
    const int tid = F.tid, pe = tid & 15, jg = tid >> 4;
    int below = 0, tot = 0;
    for (int w = jg; w < F.G; w += 32) { const int v = cnt[w * 16 + pe]; tot += v; if (w < F.bid) below += v; }
    part[jg * 16 + pe] = below; part[512 + jg * 16 + pe] = tot;
    if (tid < 128) tk[tid] = topi[F.bid * 128 + tid];
    __syncthreads();
    if (tid < 16) { int b = 0, t = 0; for (int j = 0; j < 32; ++j) { b += part[j * 16 + tid]; t += part[512 + j * 16 + tid]; } base[tid] = b; base[16 + tid] = t; }
    __syncthreads();
    if (tid < 2) { int ps = 0; for (int e = 0; e < 8; ++e) { base[32 + tid * 8 + e] = ps; ps += (base[16 + tid * 8 + e] + 255) / 256 * 256; } base[48 + tid] = ps / 256; }
    __syncthreads();
    if (tid < 256) {
        const int p = tid >> 7, i = tid & 127; const int e = (tk[i] >> (8 * p)) & 0xff;
        int rank = 0; for (int j = 0; j < i; ++j) rank += (((tk[j] >> (8 * p)) & 0xff) == e) ? 1 : 0;
        const int slot = base[32 + p * 8 + e] + base[p * 8 + e] + rank; const int token = F.bid * 128 + i;
        stok[p * SLOT_CAP + slot] = token; sw[p * SLOT_CAP + slot] = topw[2 * token + p];
    }
    if (F.bid < 16) {
        const int p = F.bid >> 3, e = F.bid & 7, ps = base[32 + F.bid], t = base[16 + F.bid], pend = ps + (t + 255) / 256 * 256;
        for (int s = ps + t + tid; s < pend; s += NTHR) { stok[p * SLOT_CAP + s] = -1; sw[p * SLOT_CAP + s] = 0.f; }
        for (int bk = ps / 256 + tid; bk < pend / 256; bk += NTHR) blk[16 + p * 256 + bk] = e;
        if (e == 0 && tid == 0) blk[p] = base[48 + p];
    }
    __syncthreads();
}
__device__ __forceinline__ void final_norm(const Frame& F, float* H, const float* gain) {
    for (int row = F.gw; row < NT; row += F.NGW) {
        GAS f32x4* xr = (GAS f32x4*)(H + (size_t)row * DM) + F.lane; const f32x4* gr = (const f32x4*)gain + F.lane;
        f32x4 v[4]; float s = 0.f;
#pragma unroll
        for (int j = 0; j < 4; ++j) { v[j] = xr[64 * j]; s += (v[j].x * v[j].x + v[j].y * v[j].y) + (v[j].z * v[j].z + v[j].w * v[j].w); }
        s = wave_sum(s); const float rs = 1.0f / sqrtf(s * (1.0f / DM) + EPS);
#pragma unroll
        for (int j = 0; j < 4; ++j) { const f32x4 g = gr[64 * j]; f32x4 o = {v[j].x * rs * g.x, v[j].y * rs * g.y, v[j].z * rs * g.z, v[j].w * rs * g.w}; xr[64 * j] = o; }
    }
}

constexpr int N_PHASES = 17;
__global__ void __launch_bounds__(NTHR, 2) mega(Args args) {
    extern __shared__ __attribute__((aligned(16))) unsigned char lds_raw[];
    Frame F;
    F.lds = (LAS unsigned char*)lds_raw;
    F.tid = threadIdx.x; F.lane = F.tid & 63; F.wave = __builtin_amdgcn_readfirstlane(F.tid >> 6);
    F.G = gridDim.x; F.bid = blockIdx.x; F.gw = F.bid * NWAVES + F.wave; F.NGW = F.G * NWAVES; F.ws = args.ws;
    unsigned char* ws = args.ws;
    gu32* ctl = (gu32*)(ws + WS_CTL);
    volatile LAS unsigned* MISC = (volatile LAS unsigned*)(F.lds + MISC_OFF);
    for (int u = F.tid; u < (LDS_BYTES - LDSCTL_OFF) / 4; u += NTHR) ((LAS unsigned*)(F.lds + LDSCTL_OFF))[u] = 0u;
    __syncthreads();
    XcdBarrier bar = xcd_barrier_post((unsigned*)(ctl + CW_BAR), MISC + 8);
    const int lo = args.ph_lo, hi = args.ph_hi;
#ifndef PH_MASK
#define PH_MASK 0x1ffff
#endif
#define IN(k) (((PH_MASK >> (k)) & 1) && lo <= (k) && (k) < hi)
#ifndef REPEAT_MASK
#define REPEAT_MASK 0
#endif
#define REPS(k) (1 + ((REPEAT_MASK >> (k)) & 1))
#define SEAM(k) do { if (IN(k) && IN((k) + 1)) xcd_barrier(bar); } while (0)

    float* H = args.out;
    float* rss = (float*)(ws + WS_RSS); float* mrss = (float*)(ws + WS_MRSS);
    bf16* hbf = (bf16*)(ws + WS_HBF); bf16* membf = (bf16*)(ws + WS_MEMBF); bf16* memk = (bf16*)(ws + WS_MEMK); bf16* memvt = (bf16*)(ws + WS_MEMVT);
    bf16* act0 = (bf16*)(ws + WS_ACT0); bf16* v0t = (bf16*)(ws + WS_V0T); bf16* mix = (bf16*)(ws + WS_MIX); bf16* hmid0 = (bf16*)(ws + WS_HMID0);
    bf16* act1 = (bf16*)(ws + WS_ACT1); bf16* v1t = (bf16*)(ws + WS_V1T); bf16* OF = (bf16*)(ws + WS_OF); bf16* OB = (bf16*)(ws + WS_OB);
    bf16* hmid1 = (bf16*)(ws + WS_HMID1); bf16* wgu = (bf16*)(ws + WS_WGU); bf16* wdn = (bf16*)(ws + WS_WDN);
    int* cnt = (int*)(ws + WS_CNT); int* topi = (int*)(ws + WS_TOPI); float* topw = (float*)(ws + WS_TOPW);
    int* stok = (int*)(ws + WS_STOK); float* sw = (float*)(ws + WS_SW); int* blk = (int*)(ws + WS_BLK);
    LAS float* scr = (LAS float*)(F.lds + F.wave * 16384);

    if (IN(0)) for (int rep_ = 0; rep_ < REPS(0); ++rep_) {
        int it = F.gw; LAS unsigned* T0 = (LAS unsigned*)scr; LAS unsigned* T1 = T0 + 1088;
#define CVT(Wp, Kd, Nd, WTp, gainp, kind) do { const CvtJob J{Wp, Kd, Nd, (bf16*)(WTp), gainp, kind}; const int n_ = ((Kd) / 64) * ((Nd) / 32); \
            while (it < n_) { CvtRegs A_, B_; B_.valid = 0; cvt_load(A_, J, it, F.lane); it += F.NGW; if (it < n_) { cvt_load(B_, J, it, F.lane); it += F.NGW; } cvt_finish(A_, T0, F.lane); cvt_finish(B_, T1, F.lane); } \
            it -= n_; } while (0)
        CVT(args.in[I_EWIN], 1024, 2560, ws + WS_W0IN, args.in[I_EN1], 1);
        CVT(args.in[I_EWIN], 1024, 2560, ws + WS_WV0, args.in[I_EN1], 2);
        CVT(args.in[I_EWOUT], 1024, 1024, ws + WS_W0OUT, nullptr, 0);
        CVT(args.in[I_EWG], 1024, 2816, ws + WS_W0GU, args.in[I_EN2], 3);
        CVT(args.in[I_EWU], 1024, 2816, ws + WS_W0GU, args.in[I_EN2], 4);
        CVT(args.in[I_EWD], 2816, 1024, ws + WS_W0DN, nullptr, 0);
        CVT(args.in[I_WMKV], 1024, 512, ws + WS_WMEM, args.in[I_MNORM], 0);
        CVT(args.in[I_OWIN], 1024, 2592, ws + WS_W1IN, args.in[I_ON1], 5);
        CVT(args.in[I_OWIN], 1024, 2592, ws + WS_WV1, args.in[I_ON1], 6);
        CVT(args.in[I_OWOUT], 1024, 1024, ws + WS_W1OUT, nullptr, 0);
#undef CVT
        { v4u z = {0u, 0u, 0u, 0u}; v4u* p = (v4u*)(ws + WS_W1IN + (size_t)1824 * 2048); const int n16 = 224 * 2048 / 16;
          for (int i = F.bid * NTHR + F.tid; i < n16; i += F.G * NTHR) p[i] = z; }
        rows_to_bf16(args.in[I_X], hbf, rss, F.gw, NT, F.NGW, F.lane);
        rows_to_bf16(args.in[I_MEM], membf, mrss, F.gw, MEM_ROWS, F.NGW, F.lane);
    }
    SEAM(0);
    if (IN(1)) for (int rep_ = 0; rep_ < REPS(1); ++rep_) {
        { Sched S; S.init(hbf, ws + WS_W0IN, 1024, 128, 7, F.G, F.bid); EpiRowScale E{act0, A0_LD, rss}; gemm_run<EpiRowScale, false>(F.lds, S, E, nullptr); }
        { Sched S; S.init(ws + WS_WV0, hbf, 1024, 3, 128, F.G, (F.bid + 128) % F.G); EpiColScale E{v0t, NT, rss}; gemm_run<EpiColScale, false>(F.lds, S, E, nullptr); }
        { Sched S; S.init(membf, ws + WS_WMEM, 1024, 8, 1, F.G, F.bid); EpiRowScale E{memk, 256, mrss}; gemm_run<EpiRowScale, false>(F.lds, S, E, nullptr); }
        { Sched S; S.init(ws + WS_WMEM + 256 * 2048, membf, 1024, 1, 8, F.G, (F.bid + 248) % F.G); EpiColScale E{memvt, MEM_ROWS, mrss}; gemm_run<EpiColScale, false>(F.lds, S, E, nullptr); }
    }
    SEAM(1);
    if (IN(2)) for (int rep_ = 0; rep_ < REPS(2); ++rep_) {
#if FAST_ATT
        { LAS float* rl = (LAS float*)F.lds; for (int i = F.tid; i < 5580; i += NTHR) rl[i] = args.in[I_RPB][i]; __syncthreads();
          for (int it = F.gw; it < 32768; it += F.NGW) { if (it < 24576) na_item(it, F.lane, act0, v0t, rl, mix); else memattn_item(it - 24576, F.lane, act0, A0_LD, 1536, memk, memvt, mix); }
          __syncthreads(); }
#else
        na_simple(F, act0, v0t, args.in[I_RPB], mix);
        memattn_simple(F, F.gw, F.NGW, act0, A0_LD, 1536, memk, memvt, mix);
#endif
    }
    SEAM(2);
    if (IN(3)) for (int rep_ = 0; rep_ < REPS(3); ++rep_) {
        Sched S; S.init(mix, ws + WS_W0OUT, 1024, 128, 4, F.G, F.bid); EpiResid E{args.in[I_X], H, hbf, rss}; gemm_run<EpiResid, false>(F.lds, S, E, nullptr);
    }
    SEAM(3);
    if (IN(4)) for (int rep_ = 0; rep_ < REPS(4); ++rep_) {
        Sched S; S.init(hbf, ws + WS_W0GU, 1024, 128, 22, F.G, F.bid); EpiSwiGLU E{hmid0, FF0, rss, nullptr}; gemm_run<EpiSwiGLU, false>(F.lds, S, E, nullptr);
    }
    SEAM(4);
    if (IN(5)) for (int rep_ = 0; rep_ < REPS(5); ++rep_) {
        Sched S; S.init(hmid0, ws + WS_W0DN, FF0, 128, 4, F.G, F.bid); EpiResid E{H, H, hbf, rss}; gemm_run<EpiResid, false>(F.lds, S, E, nullptr);
    }
    SEAM(5);
    if (IN(6)) for (int rep_ = 0; rep_ < REPS(6); ++rep_) {
        { Sched S; S.init(hbf, ws + WS_W1IN, 1024, 128, 8, F.G, F.bid); EpiRowScale E{act1, A1_LD, rss}; gemm_run<EpiRowScale, false>(F.lds, S, E, nullptr); }
        { Sched S; S.init(ws + WS_WV1, hbf, 1024, 3, 128, F.G, F.bid); EpiColScale E{v1t, NT, rss}; gemm_run<EpiColScale, false>(F.lds, S, E, nullptr); }
    }
    SEAM(6);
    if (IN(7)) for (int rep_ = 0; rep_ < REPS(7); ++rep_) {
#if FAST_GLA
        for (int it = F.bid; it < 1024; it += F.G) { const int dir = (it >> 6) & 1;
            gla_pre_item(it, F.wave, F.lane, act1, dir ? args.in[I_WGKB] : args.in[I_WGKF], dir ? args.in[I_BGKB] : args.in[I_BGKF], (bf16*)(ws + WS_E) + (size_t)dir * NT * 384); }
        for (int it = F.gw; it < 8192; it += F.NGW) memattn_item(it, F.lane, act1, A1_LD, 1536, memk, memvt, mix);
        xcd_barrier(bar);
        for (int it = F.bid; it < 256; it += F.G) gla_main_item(F, it, act1, v1t, (const bf16*)(ws + WS_E), OF, OB);
#else
        if (F.bid < 64) {
            const int dir = F.bid & 1;
            gla_simple(F, F.bid, act1, v1t, dir ? args.in[I_WGKB] : args.in[I_WGKF], dir ? args.in[I_BGKB] : args.in[I_BGKF], dir ? OB : OF);
        } else {
#if FAST_ATT
            for (int it = (F.bid - 64) * NWAVES + F.wave; it < 8192; it += (F.G - 64) * NWAVES) memattn_item(it, F.lane, act1, A1_LD, 1536, memk, memvt, mix);
#else
            memattn_simple(F, (F.bid - 64) * NWAVES + F.wave, (F.G - 64) * NWAVES, act1, A1_LD, 1536, memk, memvt, mix);
#endif
        }
#endif
    }
    SEAM(7);
    if (IN(8)) for (int rep_ = 0; rep_ < REPS(8); ++rep_) gla_combine(F, OF, OB, act1, args.in[I_GNORM], mix);
    SEAM(8);
    if (IN(9)) for (int rep_ = 0; rep_ < REPS(9); ++rep_) {
        Sched S; S.init(mix, ws + WS_W1OUT, 1024, 128, 4, F.G, F.bid); EpiResid E{H, H, hbf, rss}; gemm_run<EpiResid, false>(F.lds, S, E, nullptr);
    }
    SEAM(9);
    if (IN(10)) for (int rep_ = 0; rep_ < REPS(10); ++rep_) {
        route1(F, H, args.in[I_ON2], args.in[I_WR], topi, topw, cnt);
        { LAS unsigned* T0 = (LAS unsigned*)scr; LAS unsigned* T1 = T0 + 1088;
#define MOE_JOB(J_, it_) const int e_##J_ = (it_) / 5376, r_##J_ = (it_) % 5376, wh_##J_ = r_##J_ / 1792; \
            const CvtJob J_{wh_##J_ == 0 ? args.in[I_OWG] + (size_t)e_##J_ * 1024 * FFE : (wh_##J_ == 1 ? args.in[I_OWU] + (size_t)e_##J_ * 1024 * FFE : args.in[I_OWD] + (size_t)e_##J_ * FFE * 1024), \
                wh_##J_ == 2 ? FFE : 1024, wh_##J_ == 2 ? 1024 : FFE, wh_##J_ == 2 ? wdn + (size_t)e_##J_ * 1024 * FFE : wgu + (size_t)e_##J_ * 7168 * 1024, wh_##J_ == 2 ? nullptr : args.in[I_ON2], wh_##J_ == 2 ? 0 : 3 + wh_##J_}
          for (int it = F.gw; it < 8 * 3 * 1792; it += 2 * F.NGW) {
            CvtRegs A_, B_; B_.valid = 0;
            { MOE_JOB(Ja, it); cvt_load(A_, Ja, it % 1792, F.lane); }
            if (it + F.NGW < 8 * 3 * 1792) { MOE_JOB(Jb, it + F.NGW); cvt_load(B_, Jb, (it + F.NGW) % 1792, F.lane); }
            cvt_finish(A_, T0, F.lane); cvt_finish(B_, T1, F.lane);
          }
#undef MOE_JOB
        }
    }
    SEAM(10);
    if (IN(11)) for (int rep_ = 0; rep_ < REPS(11); ++rep_) route2(F, topi, topw, cnt, stok, sw, blk);
    SEAM(11);
    if (IN(12)) for (int rep_ = 0; rep_ < REPS(12); ++rep_) {
        const int nb = blk[0]; Sched S; S.init(hbf, wgu, 1024, nb, 28, F.G, F.bid, blk + 16, (size_t)7168 * 1024 * 2); EpiSwiGLU E{hmid1, FFE, rss, stok}; gemm_run<EpiSwiGLU, true>(F.lds, S, E, stok);
    }
    SEAM(12);
    if (IN(13)) for (int rep_ = 0; rep_ < REPS(13); ++rep_) {
        const int nb = blk[0]; Sched S; S.init(hmid1, wdn, FFE, nb, 4, F.G, F.bid, blk + 16, (size_t)1024 * FFE * 2); EpiMoeDown E{H, stok, sw}; gemm_run<EpiMoeDown, false>(F.lds, S, E, nullptr);
    }
    SEAM(13);
    if (IN(14)) for (int rep_ = 0; rep_ < REPS(14); ++rep_) {
        const int nb = blk[1]; Sched S; S.init(hbf, wgu, 1024, nb, 28, F.G, F.bid, blk + 16 + 256, (size_t)7168 * 1024 * 2); EpiSwiGLU E{hmid1, FFE, rss, stok + SLOT_CAP}; gemm_run<EpiSwiGLU, true>(F.lds, S, E, stok + SLOT_CAP);
    }
    SEAM(14);
    if (IN(15)) for (int rep_ = 0; rep_ < REPS(15); ++rep_) {
        const int nb = blk[1]; Sched S; S.init(hmid1, wdn, FFE, nb, 4, F.G, F.bid, blk + 16 + 256, (size_t)1024 * FFE * 2); EpiMoeDown E{H, stok + SLOT_CAP, sw + SLOT_CAP}; gemm_run<EpiMoeDown, false>(F.lds, S, E, nullptr);
    }
    SEAM(15);
    if (IN(16)) final_norm(F, H, args.in[I_FNORM]);
#undef IN
#undef SEAM
}

extern "C" void kernel_launch(void* const* d_in, const int* in_sizes, int n_in, void* d_out, int out_size, void* d_ws, size_t ws_size, hipStream_t stream) {
    static int grid = 0;
    if (grid == 0) {
        if (n_in != 26 || out_size != NT * DM || ws_size < WS_END) { fprintf(stderr, "kernel_launch: unexpected problem (n_in %d out %d ws %zu need %zu)\n", n_in, out_size, ws_size, (size_t)WS_END); grid = -1; return; }
        int dev = 0, cus = 0, per_cu = 0;
        if (hipGetDevice(&dev) != hipSuccess || hipDeviceGetAttribute(&cus, hipDeviceAttributeMultiprocessorCount, dev) != hipSuccess) { grid = -1; return; }
        if (hipFuncSetAttribute((const void*)mega, hipFuncAttributeMaxDynamicSharedMemorySize, LDS_BYTES) != hipSuccess) { fprintf(stderr, "kernel_launch: hipFuncSetAttribute failed\n"); grid = -1; return; }
        if (hipOccupancyMaxActiveBlocksPerMultiprocessor(&per_cu, (const void*)mega, NTHR, LDS_BYTES) != hipSuccess || per_cu < 1) fprintf(stderr, "kernel_launch: occupancy query reports %d\n", per_cu);
        (void)hipGetLastError();
        grid = cus;
        if (grid != 256) fprintf(stderr, "kernel_launch: note: %d CUs\n", grid);
    }
    if (grid < 0) return;
    if (hipMemsetAsync((char*)d_ws + WS_CTL, 0, CTL_ZERO_BYTES, stream) != hipSuccess) return;
    Args a{};
    for (int i = 0; i < 26; ++i) a.in[i] = (const float*)d_in[i];
    a.out = (float*)d_out; a.ws = (unsigned char*)d_ws;
#if MK_FUSED
    a.ph_lo = 0; a.ph_hi = N_PHASES;
    hipLaunchKernelGGL(mega, dim3(grid), dim3(NTHR), LDS_BYTES, stream, a);
#else
    for (int p = 0; p < N_PHASES; ++p) { a.ph_lo = p; a.ph_hi = p + 1; hipLaunchKernelGGL(mega, dim3(grid), dim3(NTHR), LDS_BYTES, stream, a); }
#endif
}
```

```cpp
#include <hip/hip_runtime.h>
#include <cstdio>
#include <cstdint>

#ifndef MK_FUSED
#define MK_FUSED 1
#endif
#ifndef FAST_GEMM
#define FAST_GEMM 1
#endif
#ifndef FAST_ATT
#define FAST_ATT 1
#endif
#ifndef FAST_GLA
#define FAST_GLA 1
#endif

#define GAS __attribute__((address_space(1)))
#define LAS __attribute__((address_space(3)))
typedef unsigned short bf16;
typedef unsigned v4u __attribute__((ext_vector_type(4)));
typedef unsigned v2u __attribute__((ext_vector_type(2)));
typedef float f32x4 __attribute__((ext_vector_type(4)));
typedef short bf16x8 __attribute__((ext_vector_type(8)));
typedef GAS unsigned gu32;
#define RLX_AGENT __ATOMIC_RELAXED, __HIP_MEMORY_SCOPE_AGENT
#define LDS_WAIT() asm volatile("s_waitcnt lgkmcnt(0)" ::: "memory")
#define VM_WAIT() asm volatile("s_waitcnt vmcnt(0)" ::: "memory")

constexpr int NT = 32768, DM = 1024, SEQ = 4096, NB = 8;
constexpr int MEM_ROWS = 2048;
constexpr int A0_LD = 1792;
constexpr int A1_LD = 2048;
constexpr int FF0 = 2816, FFE = 3584, NEXP = 8;
constexpr int SLOT_CAP = 34816;
constexpr float EPS = 1e-6f;
constexpr int NWAVES = 8, NTHR = 512;

constexpr size_t MiB = 1u << 20;
constexpr size_t WS_CTL = 0, CTL_ZERO_BYTES = 1 * MiB;
constexpr size_t WS_RSS = 1 * MiB;
constexpr size_t WS_MRSS = 3 * MiB;
constexpr size_t WS_CNT = 3 * MiB + 256 * 1024;
constexpr size_t WS_TOPI = 3 * MiB + 512 * 1024;
constexpr size_t WS_TOPW = 3 * MiB + 768 * 1024;
constexpr size_t WS_STOK = 4 * MiB;
constexpr size_t WS_SW = 4 * MiB + 512 * 1024;
constexpr size_t WS_BLK = 5 * MiB;
constexpr size_t WS_RSTD = 5 * MiB + 64 * 1024;
constexpr size_t WS_W0IN = 6 * MiB;
constexpr size_t WS_WV0 = WS_W0IN + 1792 * 2048;
constexpr size_t WS_W0OUT = 11 * MiB;
constexpr size_t WS_W0GU = 13 * MiB;
constexpr size_t WS_W0DN = 24 * MiB;
constexpr size_t WS_WMEM = WS_W0DN + 1024 * 2816 * 2;
constexpr size_t WS_W1IN = 31 * MiB;
constexpr size_t WS_WV1 = 35 * MiB;
constexpr size_t WS_W1OUT = 37 * MiB - 512 * 1024;
constexpr size_t WS_HBF = 39 * MiB;
constexpr size_t WS_MEMBF = 103 * MiB;
constexpr size_t WS_MEMK = 107 * MiB;
constexpr size_t WS_MEMVT = 108 * MiB;
constexpr size_t WS_ACT = 109 * MiB;
constexpr size_t WS_ACT0 = WS_ACT;
constexpr size_t WS_V0T = WS_ACT + 112 * MiB;
constexpr size_t WS_MIX = WS_ACT + 176 * MiB;
constexpr size_t WS_HMID0 = WS_ACT;
constexpr size_t WS_ACT1 = WS_ACT;
constexpr size_t WS_V1T = WS_ACT + 128 * MiB;
constexpr size_t WS_OF = WS_ACT + 240 * MiB;
constexpr size_t WS_OB = WS_ACT + 288 * MiB;
constexpr size_t WS_E = WS_ACT + 336 * MiB;
constexpr size_t WS_HMID1 = WS_ACT;
constexpr size_t WS_WGU = WS_ACT + 240 * MiB;
constexpr size_t WS_WDN = WS_ACT + 352 * MiB;
constexpr size_t WS_END = WS_ACT + 408 * MiB;
static_assert(WS_W1OUT + 2 * MiB <= WS_HBF && WS_WV1 + 768 * 2048 <= WS_W1OUT && WS_W1IN + 4 * MiB <= WS_WV1 && WS_WMEM + MiB <= WS_W1IN, "weight map");
static_assert(WS_W0GU + 11 * MiB <= WS_W0DN && WS_WV0 + 768 * 2048 <= WS_W0OUT, "weight map 2");
static_assert((size_t)SLOT_CAP * 3584 * 2 <= 240 * MiB, "hmid1");

constexpr int CW_TMO = 0, CW_CODE = 1, CW_BAR = 4096;

constexpr int RING_BYTES = 131072;
constexpr int LDSCTL_OFF = RING_BYTES, MISC_OFF = LDSCTL_OFF + 320;
constexpr int LDS_BYTES = 147456;

typedef float f32x2_t __attribute__((ext_vector_type(2)));
typedef __bf16 bf16x2_t __attribute__((ext_vector_type(2)));
__device__ __forceinline__ unsigned pk2(float lo, float hi) { const f32x2_t v = {lo, hi}; const bf16x2_t b = __builtin_convertvector(v, bf16x2_t); return __builtin_bit_cast(unsigned, b); }
__device__ __forceinline__ unsigned f2bf(float f) { return pk2(f, 0.f) & 0xffffu; }
__device__ __forceinline__ float bf2f(bf16 b) { return __builtin_bit_cast(float, (unsigned)b << 16); }
__device__ __forceinline__ float bflo(unsigned u) { return __builtin_bit_cast(float, u << 16); }
__device__ __forceinline__ float bfhi(unsigned u) { return __builtin_bit_cast(float, u & 0xffff0000u); }
__device__ __forceinline__ float wave_sum(float v) {
#pragma unroll
    for (int o = 1; o < 64; o <<= 1) v += __shfl_xor(v, o);
    return v;
}
__device__ __forceinline__ float wave_max(float v) {
#pragma unroll
    for (int o = 1; o < 64; o <<= 1) v = fmaxf(v, __shfl_xor(v, o));
    return v;
}

#define XB_TMO      128
#define XB_XCNT(j)  (256  + 64 * (j))
#define XB_XSUB(j)  (1280 + 64 * (j))
#define XB_XGEN(j)  (2304 + 64 * (j))
#define XB_TOP      3328
#define XB_TOPGEN   3392
#define XCD_BAR_WORDS 3456
#define XB_SPIN_CAP (1u << 22)

__device__ __forceinline__ unsigned xb_ld(unsigned* p)              { return __hip_atomic_load(p, __ATOMIC_RELAXED, __HIP_MEMORY_SCOPE_AGENT); }
__device__ __forceinline__ unsigned xb_add(unsigned* p, unsigned v) { return __hip_atomic_fetch_add(p, v, __ATOMIC_RELAXED, __HIP_MEMORY_SCOPE_AGENT); }
__device__ __forceinline__ unsigned xb_xcc_id() { return (unsigned)__builtin_amdgcn_s_getreg((3 << 11) | 20) & 0xFu; }
#define XB_SPIN(cond, bar) do { unsigned _sp = 0; while (cond) { __builtin_amdgcn_s_sleep(1); \
    if ((++_sp & 255u) == 0u) { if (xb_ld(&(bar)[XB_TMO])) break; if (_sp > XB_SPIN_CAP) { atomicAdd(&(bar)[XB_TMO], 1u); break; } } } } while (0)

struct XcdBarrier { unsigned* bar; unsigned x; volatile LAS unsigned* st; };

__device__ __forceinline__ XcdBarrier xcd_barrier_post(unsigned* bar, volatile LAS unsigned* st) {
    XcdBarrier b; b.bar = bar; b.x = xb_xcc_id(); b.st = st;
    if (threadIdx.x == 0) (void)xb_add(&bar[XB_XCNT(b.x)], 1u);
    return b;
}
__device__ __forceinline__ void xcd_barrier_complete(unsigned* bar, unsigned x, unsigned& nloc, unsigned& nx) {
    const unsigned G = gridDim.x * gridDim.y * gridDim.z;
    unsigned sum, cnt, mine, sp = 0u;
    for (;;) {
        sum = 0u; cnt = 0u; mine = 0u;
#pragma unroll
        for (unsigned j = 0; j < 16; ++j) { const unsigned c = xb_ld(&bar[XB_XCNT(j)]); sum += c; cnt += (c > 0u) ? 1u : 0u; mine = (j == x) ? c : mine; }
        if (sum == G) break;
        __builtin_amdgcn_s_sleep(1);
        if ((++sp & 255u) == 0u) { if (xb_ld(&bar[XB_TMO])) break; if (sp > XB_SPIN_CAP) { atomicAdd(&bar[XB_TMO], 1u); break; } }
    }
    nloc = mine > 0u ? mine : 1u; nx = cnt > 0u ? cnt : 1u;
}
__device__ __forceinline__ void xcd_barrier(const XcdBarrier& b) {
    asm volatile("s_waitcnt vmcnt(0)" ::: "memory");
    __syncthreads();
    if (threadIdx.x == 0) {
        unsigned* bar = b.bar;
        __builtin_amdgcn_s_waitcnt(0);
        unsigned nloc = b.st[0], nx = b.st[1];
        if (nloc == 0u) { xcd_barrier_complete(bar, b.x, nloc, nx); b.st[0] = nloc; b.st[1] = nx; }
        const unsigned old = xb_add(&bar[XB_XSUB(b.x)], 1u);
        const unsigned gen = old / nloc;
        if (old + 1u == (gen + 1u) * nloc) {
            __builtin_amdgcn_fence(__ATOMIC_RELEASE, "agent");
            asm volatile("s_waitcnt vmcnt(0)" ::: "memory");
            const unsigned og = xb_add(&bar[XB_TOP], 1u);
            const unsigned tg = og / nx;
            if (og + 1u == (tg + 1u) * nx) xb_add(&bar[XB_TOPGEN], 1u);
            else XB_SPIN(xb_ld(&bar[XB_TOPGEN]) == tg, bar);
            __builtin_amdgcn_fence(__ATOMIC_ACQUIRE, "agent");
            xb_add(&bar[XB_XGEN(b.x)], 1u);
            asm volatile("s_waitcnt vmcnt(0)" ::: "memory");
        } else {
            XB_SPIN(xb_ld(&bar[XB_XGEN(b.x)]) == gen, bar);
            __builtin_amdgcn_fence(__ATOMIC_ACQUIRE, "agent");
            asm volatile("s_waitcnt vmcnt(0)" ::: "memory");
        }
    }
    __syncthreads();
}

struct Args { const float* in[26]; float* out; unsigned char* ws; int ph_lo, ph_hi; };
enum { I_X = 0, I_MEM, I_EN1, I_EWIN, I_RPB, I_EWOUT, I_EN2, I_EWG, I_EWU, I_EWD, I_ON1, I_OWIN, I_WGKF, I_BGKF, I_WGKB, I_BGKB, I_GNORM, I_OWOUT, I_ON2, I_WR, I_OWG, I_OWU, I_OWD, I_MNORM, I_WMKV, I_FNORM };

struct Frame {
    LAS unsigned char* lds;
    int tid, lane, wave, G, bid;
    int gw, NGW;
    unsigned char* ws;
};

constexpr float QSCALE = 0.125f * 1.4426950408889634f;
struct CvtJob { const float* W; int K, N; bf16* WT; const float* gain; int kind; };
__device__ __forceinline__ bool cvt_map(int kind, int n0, int& drow, float& scale) {
    scale = 1.0f;
    switch (kind) {
    case 0: drow = n0; return true;
    case 1: if (n0 < 768) { drow = n0; scale = QSCALE; return true; } if (n0 < 1536) { drow = n0; return true; } if (n0 >= 2304) { drow = n0 - 768; scale = QSCALE; return true; } return false;
    case 2: if (n0 >= 1536 && n0 < 2304) { drow = n0 - 1536; return true; } return false;
    case 3: drow = (n0 >> 7) * 256 + (n0 & 127); return true;
    case 4: drow = (n0 >> 7) * 256 + 128 + (n0 & 127); return true;
    case 5: if (n0 < 768) { drow = n0; return true; } if (n0 < 1536) return false; if (n0 < 2304) { drow = n0 - 768; return true; }
            if (n0 < 2336) { drow = n0 - 512; return true; } drow = n0 - 800; scale = QSCALE; return true;
    case 6: if (n0 >= 768 && n0 < 1536) { drow = n0 - 768; return true; } return false;
    default: drow = n0; return true;
    }
}
struct CvtRegs { f32x4 v[8]; const float* gain; bf16* WT; int K, k0, drow, valid; float scale; };
__device__ __forceinline__ void cvt_load(CvtRegs& R, const CvtJob& J, int item, int lane) {
    const int nblk = J.N / 32, kb = item / nblk, nb = item % nblk, n0 = nb * 32;
    R.k0 = kb * 64; R.gain = J.gain; R.WT = J.WT; R.K = J.K;
    R.valid = cvt_map(J.kind, n0, R.drow, R.scale) ? 1 : 0;
    if (R.valid) { const float* p = J.W + (size_t)(R.k0 + 2 * (lane >> 3)) * J.N + n0 + 4 * (lane & 7);
#pragma unroll
        for (int j = 0; j < 8; ++j) R.v[j] = *(const f32x4*)(p + (size_t)(16 * (j >> 1) + (j & 1)) * J.N); }
}
__device__ __forceinline__ void cvt_finish(const CvtRegs& R, LAS unsigned* T, int lane) {
    if (!R.valid) return;
    const int nq = lane & 7, kr = lane >> 3;
#pragma unroll
    for (int p = 0; p < 4; ++p) { const int k = R.k0 + 16 * p + 2 * kr; float g0 = R.scale, g1 = R.scale; if (R.gain) { g0 *= R.gain[k]; g1 *= R.gain[k + 1]; }
        const f32x4 a = R.v[2 * p], b = R.v[2 * p + 1]; LAS unsigned* t = T + (4 * nq) * 33 + 8 * p + kr;
        t[0] = pk2(a.x * g0, b.x * g1); t[33] = pk2(a.y * g0, b.y * g1); t[66] = pk2(a.z * g0, b.z * g1); t[99] = pk2(a.w * g0, b.w * g1); }
    LDS_WAIT(); asm volatile("" ::: "memory");
#pragma unroll
    for (int r = 0; r < 4; ++r) { const int n = (lane >> 3) + 8 * r, c = lane & 7; const LAS unsigned* sp = T + n * 33 + 4 * c;
        v4u o; o.x = sp[0]; o.y = sp[1]; o.z = sp[2]; o.w = sp[3];
        *(GAS v4u*)(R.WT + (size_t)(R.drow + n) * R.K + R.k0 + 8 * c) = o; }
    LDS_WAIT(); asm volatile("" ::: "memory");
}
__device__ __forceinline__ void rows_to_bf16(const float* X, bf16* Ob, float* rstd, int first, int nrows, int stride, int lane) {
    for (int m = first; m < nrows; m += 2 * stride) {
        const int m2 = m + stride; const bool h2 = m2 < nrows;
        const GAS f32x4* xa = (const GAS f32x4*)(X + (size_t)m * DM) + lane; const GAS f32x4* xb = (const GAS f32x4*)(X + (size_t)(h2 ? m2 : m) * DM) + lane;
        f32x4 va[4], vb[4];
#pragma unroll
        for (int j = 0; j < 4; ++j) va[j] = xa[64 * j];
#pragma unroll
        for (int j = 0; j < 4; ++j) vb[j] = xb[64 * j];
        float sa = 0.f, sb = 0.f;
#pragma unroll
        for (int j = 0; j < 4; ++j) { sa += (va[j].x * va[j].x + va[j].y * va[j].y) + (va[j].z * va[j].z + va[j].w * va[j].w); sb += (vb[j].x * vb[j].x + vb[j].y * vb[j].y) + (vb[j].z * vb[j].z + vb[j].w * vb[j].w); }
        sa = wave_sum(sa); sb = wave_sum(sb);
        GAS unsigned long long* oa = (GAS unsigned long long*)(Ob + (size_t)m * DM) + lane;
#pragma unroll
        for (int j = 0; j < 4; ++j) oa[64 * j] = (unsigned long long)pk2(va[j].x, va[j].y) | ((unsigned long long)pk2(va[j].z, va[j].w) << 32);
        if (lane == 0) rstd[m] = __builtin_amdgcn_rsqf(sa * (1.0f / DM) + EPS);
        if (h2) { GAS unsigned long long* ob = (GAS unsigned long long*)(Ob + (size_t)m2 * DM) + lane;
#pragma unroll
            for (int j = 0; j < 4; ++j) ob[64 * j] = (unsigned long long)pk2(vb[j].x, vb[j].y) | ((unsigned long long)pk2(vb[j].z, vb[j].w) << 32);
            if (lane == 0) rstd[m2] = __builtin_amdgcn_rsqf(sb * (1.0f / DM) + EPS); }
    }
}

struct Unit { int pm, pn; };
struct Sched {
    int nM, nN, nwg, G, c, K;
    const char* A; const char* B; const int* bexp; size_t estride;
    __device__ void init(const void* A_, const void* B_, int K_, int nM_, int nN_, int G_, int c_, const int* bexp_ = nullptr, size_t estride_ = 0) {
        A = (const char*)A_; B = (const char*)B_; K = K_; nM = nM_; nN = nN_; nwg = nM * nN; G = G_; c = c_; bexp = bexp_; estride = estride_; }
    __device__ bool next(int i, Unit& u) const {
        const long L = (long)i * G + c; if (L >= nwg) return false;
        int wgid = (int)L; { const int q = nwg / 8, r = nwg % 8, xcd = wgid % 8, off = wgid / 8; wgid = (xcd < r ? xcd * (q + 1) : r * (q + 1) + (xcd - r) * q) + off; }
        const int nig = 8 * nN, gid = wgid / nig, fm = gid * 8, gsz = (nM - fm) < 8 ? (nM - fm) : 8;
        u.pm = fm + ((wgid % nig) % gsz); u.pn = (wgid % nig) / gsz; return true;
    }
    __device__ const char* a_base(const Unit& u) const { return A + (size_t)u.pm * 512 * K; }
    __device__ const char* b_base(const Unit& u) const { return B + (bexp ? (size_t)bexp[u.pm] * estride : (size_t)0) + (size_t)u.pn * 512 * K; }
};

struct NoAux {};
__device__ __forceinline__ float rstd_from(const float* rss16) {
    const f32x4* p = (const f32x4*)rss16; f32x4 a = p[0], b = p[1], c = p[2], d = p[3];
    const float s = ((a.x + a.y) + (a.z + a.w)) + ((b.x + b.y) + (b.z + b.w)) + ((c.x + c.y) + (c.z + c.w)) + ((d.x + d.y) + (d.z + d.w));
    return __builtin_amdgcn_rsqf(s * (1.0f / DM) + EPS);
}
struct RowCtx { float rs[2][4]; };
struct EpiRowScale {
    static constexpr bool NEED_SS = false; static constexpr int SC_MODE = 1; typedef RowCtx Ctx; typedef NoAux Aux;
    bf16* O; int ldc; const float* sc_src;
    __device__ __forceinline__ void begin(Ctx& c, const LAS float* sc, const LAS int*, int lr0, int, int, int) const {
#pragma unroll
        for (int ai = 0; ai < 2; ++ai)
#pragma unroll
            for (int m = 0; m < 4; ++m) c.rs[ai][m] = sc[ai * 128 + lr0 + m * 16];
    }
    __device__ __forceinline__ void load_aux(Aux&, const Ctx&, int, int, int, int, int) const {}
    __device__ __forceinline__ float apply(const Ctx& c, const Aux&, int ai, int m, int row, int pn, int c128, const float (&a)[8], const float (&b)[8]) const {
        const float s = c.rs[ai][m];
        bf16* p = O + (size_t)row * ldc + pn * 256 + c128;
        v4u w; w.x = pk2(a[0] * s, a[1] * s); w.y = pk2(a[2] * s, a[3] * s); w.z = pk2(a[4] * s, a[5] * s); w.w = pk2(a[6] * s, a[7] * s); *(v4u*)p = w;
        w.x = pk2(b[0] * s, b[1] * s); w.y = pk2(b[2] * s, b[3] * s); w.z = pk2(b[4] * s, b[5] * s); w.w = pk2(b[6] * s, b[7] * s); *(v4u*)(p + 128) = w;
        return 0.f;
    }
    __device__ __forceinline__ void row_done(int, int, int, float) const {}
};
struct ColCtx { float sa[8], sb[8]; };
struct EpiColScale {
    static constexpr bool NEED_SS = false; static constexpr int SC_MODE = 2; typedef ColCtx Ctx; typedef NoAux Aux;
    bf16* O; int ldc; const float* sc_src;
    __device__ __forceinline__ void begin(Ctx& c, const LAS float* sc, const LAS int*, int, int, int, int c128) const {
#pragma unroll
        for (int j = 0; j < 8; ++j) { c.sa[j] = sc[c128 + j]; c.sb[j] = sc[128 + c128 + j]; }
    }
    __device__ __forceinline__ void load_aux(Aux&, const Ctx&, int, int, int, int, int) const {}
    __device__ __forceinline__ float apply(const Ctx& c, const Aux&, int, int, int row, int pn, int c128, const float (&a)[8], const float (&b)[8]) const {
        bf16* p = O + (size_t)row * ldc + pn * 256 + c128;
        v4u w; w.x = pk2(a[0] * c.sa[0], a[1] * c.sa[1]); w.y = pk2(a[2] * c.sa[2], a[3] * c.sa[3]); w.z = pk2(a[4] * c.sa[4], a[5] * c.sa[5]); w.w = pk2(a[6] * c.sa[6], a[7] * c.sa[7]); *(v4u*)p = w;
        w.x = pk2(b[0] * c.sb[0], b[1] * c.sb[1]); w.y = pk2(b[2] * c.sb[2], b[3] * c.sb[3]); w.z = pk2(b[4] * c.sb[4], b[5] * c.sb[5]); w.w = pk2(b[6] * c.sb[6], b[7] * c.sb[7]); *(v4u*)(p + 128) = w;
        return 0.f;
    }
    __device__ __forceinline__ void row_done(int, int, int, float) const {}
};
struct Aux4 { f32x4 v[4]; };
struct NoCtx {};
struct EpiResid {
    static constexpr bool NEED_SS = true; static constexpr int SC_MODE = 0; typedef NoCtx Ctx; typedef Aux4 Aux;
    const float* R; float* H; bf16* HB; float* rss;
    __device__ __forceinline__ void begin(Ctx&, const LAS float*, const LAS int*, int, int, int, int) const {}
    __device__ __forceinline__ void load_aux(Aux& x, const Ctx&, int, int, int row, int pn, int c128) const {
        const float* p = R + (size_t)row * DM + pn * 256 + c128;
        x.v[0] = *(const f32x4*)p; x.v[1] = *(const f32x4*)(p + 4); x.v[2] = *(const f32x4*)(p + 128); x.v[3] = *(const f32x4*)(p + 132);
    }
    __device__ __forceinline__ float apply(const Ctx&, const Aux& x, int, int, int row, int pn, int c128, const float (&a)[8], const float (&b)[8]) const {
        const size_t off = (size_t)row * DM + pn * 256 + c128;
        const f32x4 h0 = {x.v[0].x + a[0], x.v[0].y + a[1], x.v[0].z + a[2], x.v[0].w + a[3]}, h1 = {x.v[1].x + a[4], x.v[1].y + a[5], x.v[1].z + a[6], x.v[1].w + a[7]};
        const f32x4 h2 = {x.v[2].x + b[0], x.v[2].y + b[1], x.v[2].z + b[2], x.v[2].w + b[3]}, h3 = {x.v[3].x + b[4], x.v[3].y + b[5], x.v[3].z + b[6], x.v[3].w + b[7]};
        *(f32x4*)(H + off) = h0; *(f32x4*)(H + off + 4) = h1; *(f32x4*)(H + off + 128) = h2; *(f32x4*)(H + off + 132) = h3;
        v4u w; w.x = pk2(h0.x, h0.y); w.y = pk2(h0.z, h0.w); w.z = pk2(h1.x, h1.y); w.w = pk2(h1.z, h1.w); *(v4u*)(HB + off) = w;
        w.x = pk2(h2.x, h2.y); w.y = pk2(h2.z, h2.w); w.z = pk2(h3.x, h3.y); w.w = pk2(h3.z, h3.w); *(v4u*)(HB + off + 128) = w;
        return ((h0.x * h0.x + h0.y * h0.y) + (h0.z * h0.z + h0.w * h0.w) + (h1.x * h1.x + h1.y * h1.y) + (h1.z * h1.z + h1.w * h1.w))
             + ((h2.x * h2.x + h2.y * h2.y) + (h2.z * h2.z + h2.w * h2.w) + (h3.x * h3.x + h3.y * h3.y) + (h3.z * h3.z + h3.w * h3.w));
    }
    __device__ __forceinline__ void row_done(int row, int pn, int wc, float ss) const { rss[(size_t)row * 16 + pn * 4 + wc] = ss; }
};
__device__ __forceinline__ float silu_mul(float g, float u) { return g * __builtin_amdgcn_rcpf(1.0f + __builtin_amdgcn_exp2f(g * -1.4426950408889634f)) * u; }
template <bool MOE> struct EpiSwiGLU {
    static constexpr bool NEED_SS = false; static constexpr int SC_MODE = MOE ? 3 : 1; typedef RowCtx Ctx; typedef NoAux Aux;
    bf16* Hm; int ldh; const float* sc_src;
    __device__ __forceinline__ void begin(Ctx& c, const LAS float* sc, const LAS int* tl, int lr0, int, int, int) const {
#pragma unroll
        for (int ai = 0; ai < 2; ++ai)
#pragma unroll
            for (int m = 0; m < 4; ++m) { const int i = ai * 128 + lr0 + m * 16; float r = sc[i]; if (MOE) { if (tl[i] < 0) r = 0.f; } c.rs[ai][m] = r; }
    }
    __device__ __forceinline__ void load_aux(Aux&, const Ctx&, int, int, int, int, int) const {}
    __device__ __forceinline__ float apply(const Ctx& c, const Aux&, int ai, int m, int row, int pn, int c128, const float (&a)[8], const float (&b)[8]) const {
        const float s = c.rs[ai][m]; float o[8];
#pragma unroll
        for (int j = 0; j < 8; ++j) o[j] = silu_mul(a[j] * s, b[j] * s);
        v4u w; w.x = pk2(o[0], o[1]); w.y = pk2(o[2], o[3]); w.z = pk2(o[4], o[5]); w.w = pk2(o[6], o[7]);
        *(v4u*)(Hm + (size_t)row * ldh + pn * 128 + c128) = w;
        return 0.f;
    }
    __device__ __forceinline__ void row_done(int, int, int, float) const {}
};
struct MoeCtx { int t[2][4]; float w[2][4]; };
struct EpiMoeDown {
    static constexpr bool NEED_SS = false; static constexpr int SC_MODE = 4; typedef MoeCtx Ctx; typedef Aux4 Aux;
    float* H; const int* tok; const float* w;
    __device__ __forceinline__ void begin(Ctx& c, const LAS float* sc, const LAS int*, int lr0, int, int, int) const {
#pragma unroll
        for (int ai = 0; ai < 2; ++ai)
#pragma unroll
            for (int m = 0; m < 4; ++m) { const int i = ai * 128 + lr0 + m * 16; c.t[ai][m] = ((const LAS int*)sc)[i]; c.w[ai][m] = sc[256 + i]; }
    }
    __device__ __forceinline__ void load_aux(Aux& x, const Ctx& c, int ai, int m, int, int pn, int c128) const {
        const int t = c.t[ai][m]; const float* p = H + (size_t)(t < 0 ? 0 : t) * DM + pn * 256 + c128;
        x.v[0] = *(const f32x4*)p; x.v[1] = *(const f32x4*)(p + 4); x.v[2] = *(const f32x4*)(p + 128); x.v[3] = *(const f32x4*)(p + 132);
    }
    __device__ __forceinline__ float apply(const Ctx& c, const Aux& x, int ai, int m, int, int pn, int c128, const float (&a)[8], const float (&b)[8]) const {
        const int t = c.t[ai][m]; if (t < 0) return 0.f;
        const float s = c.w[ai][m]; float* p = H + (size_t)t * DM + pn * 256 + c128;
        f32x4 h0 = x.v[0], h1 = x.v[1], h2 = x.v[2], h3 = x.v[3];
        h0.x += s * a[0]; h0.y += s * a[1]; h0.z += s * a[2]; h0.w += s * a[3]; h1.x += s * a[4]; h1.y += s * a[5]; h1.z += s * a[6]; h1.w += s * a[7];
        h2.x += s * b[0]; h2.y += s * b[1]; h2.z += s * b[2]; h2.w += s * b[3]; h3.x += s * b[4]; h3.y += s * b[5]; h3.z += s * b[6]; h3.w += s * b[7];
        *(f32x4*)p = h0; *(f32x4*)(p + 4) = h1; *(f32x4*)(p + 128) = h2; *(f32x4*)(p + 132) = h3;
        return 0.f;
    }
    __device__ __forceinline__ void row_done(int, int, int, float) const {}
};

namespace pg8 {
constexpr int HTB = 16384, TOK_OFF = 132096, SC_OFF = 134144;
__device__ __forceinline__ int lds_byte(int r, int c) { const int st = (r >> 4) * 2 + (c >> 5), rr = r & 15, cc = c & 31, ob = rr * 64 + cc * 2; return st * 1024 + (ob ^ (((ob >> 9) & 1) << 5)); }
__device__ __forceinline__ void stage_rc(int b, int& R, int& C) { const int st = b / 1024, sb = b % 1024, swz = sb ^ (((sb >> 9) & 1) << 5); R = (st >> 1) * 16 + swz / 64; C = (st & 1) * 32 + (swz % 64) / 2; }
__device__ __forceinline__ int perm32(int rho) { const int n = rho >> 4, i = rho & 15; return 8 * (i >> 2) + 4 * n + (i & 3); }

template <class Epi>
__device__ __forceinline__ void run_epi(const Epi& E, const f32x4 (&acc)[2][2][4][2], const Unit& u, int wr, int wc, int fr, int fq, const LAS float* sc, const LAS int* tlp) {
    int row0 = u.pm * 256 + wr * 64 + fr, c128 = 32 * wc + 8 * fq;
    asm volatile("" : "+v"(row0), "+v"(c128));
    typename Epi::Ctx ctx; E.begin(ctx, sc, tlp, wr * 64 + fr, row0, u.pn, c128);
#pragma unroll
    for (int ai = 0; ai < 2; ++ai) {
        typename Epi::Aux aux[4];
#pragma unroll
        for (int m = 0; m < 4; ++m) E.load_aux(aux[m], ctx, ai, m, row0 + ai * 128 + m * 16, u.pn, c128);
#pragma unroll
        for (int m = 0; m < 4; ++m) {
            const int row = row0 + ai * 128 + m * 16;
            float a[8], b[8];
#pragma unroll
            for (int j = 0; j < 8; ++j) { a[j] = acc[ai][0][m][j >> 2][j & 3]; b[j] = acc[ai][1][m][j >> 2][j & 3]; }
            float ss = E.apply(ctx, aux[m], ai, m, row, u.pn, c128, a, b);
            if (Epi::NEED_SS) { ss += __shfl_xor(ss, 16); ss += __shfl_xor(ss, 32); if (fq == 0) E.row_done(row, u.pn, wc, ss); }
        }
    }
}

template <class Epi, bool GATHER>
__device__ __forceinline__ void gemm_fast(LAS unsigned char* lds, const Sched& S, const Epi& E, const int* gtok) {
    int tid = threadIdx.x; asm volatile("" : "+v"(tid));
    const int wid = __builtin_amdgcn_readfirstlane(tid >> 6), lane = tid & 63, wr = wid >> 2, wc = wid & 3, fr = lane & 15, fq = lane >> 4;
    const int K = S.K, nt = K / 64;
    unsigned voffB[2], vA0[2], vA1[2], nA0[2], nA1[2]; int RA[2], CA2[2];
#pragma unroll
    for (int i = 0; i < 2; ++i) { int R, C; stage_rc(tid * 16 + i * 8192, R, C); const int Rb = (R & ~31) + perm32(R & 31);
        voffB[i] = (unsigned)(Rb * K + C) * 2u; RA[i] = R; CA2[i] = C * 2; vA0[i] = (unsigned)(R * K + C) * 2u; vA1[i] = vA0[i] + (unsigned)(128 * K * 2); nA0[i] = vA0[i]; nA1[i] = vA1[i]; }
    const size_t kstep = 128;
    const size_t hstep = (size_t)128 * K * 2;
    const unsigned ldsw = (unsigned)wid * 1024u;
    const int aoff = lds_byte(wr * 64 + fr, fq * 8), boff = lds_byte(wc * 32 + fr, fq * 8);
    LAS int* tl = (LAS int*)(lds + TOK_OFF);
#define PG8_SA(b, h) (((b) * 2 + (h)) * HTB)
#define PG8_SB(b, h) ((4 + (b) * 2 + (h)) * HTB)
#define PG8_STAGE(bufoff, gbase, voff) do { _Pragma("unroll") for (int _i = 0; _i < 2; ++_i) \
        __builtin_amdgcn_global_load_lds((const unsigned*)((const char*)(gbase) + (voff)[_i]), (LAS unsigned*)(lds + (bufoff) + ldsw + _i * 8192), 16, 0, 0); } while (0)
#define PG8_LDA(dst, b, h) do { _Pragma("unroll") for (int m = 0; m < 4; ++m) _Pragma("unroll") for (int k = 0; k < 2; ++k) dst[m][k] = *(const LAS bf16x8*)(lds + PG8_SA(b, h) + aoff + m * 2048 + k * 1024); } while (0)
#define PG8_LDB(dst, b, h) do { _Pragma("unroll") for (int n = 0; n < 2; ++n) _Pragma("unroll") for (int k = 0; k < 2; ++k) dst[n][k] = *(const LAS bf16x8*)(lds + PG8_SB(b, h) + boff + n * 2048 + k * 1024); } while (0)
#define PG8_MMA(ai, bj, At, Bt) do { __builtin_amdgcn_s_setprio(1); _Pragma("unroll") for (int m = 0; m < 4; ++m) _Pragma("unroll") for (int n = 0; n < 2; ++n) _Pragma("unroll") for (int k = 0; k < 2; ++k) \
        acc[ai][bj][m][n] = __builtin_amdgcn_mfma_f32_16x16x32_bf16(Bt[n][k], At[m][k], acc[ai][bj][m][n], 0, 0, 0); __builtin_amdgcn_s_setprio(0); } while (0)
#define PG8_WAIT_V(n) asm volatile("s_waitcnt vmcnt(" #n ")" ::: "memory")
#define PG8_WAIT_L(n) asm volatile("s_waitcnt lgkmcnt(" #n ")" ::: "memory")
#define PG8_BAR __builtin_amdgcn_s_barrier()
#define PG8_SCHED __builtin_amdgcn_sched_barrier(0)
#define PG8_IDS_DMA(pm_, par_) do { if (wid < 4) __builtin_amdgcn_global_load_lds((const unsigned*)(gtok + (pm_) * 256 + wid * 64 + lane), (LAS unsigned*)(lds + TOK_OFF + (par_) * 1024 + wid * 256), 4, 0, 0); } while (0)
#define PG8_IDS_READ(d0, d1, par_) do { _Pragma("unroll") for (int _i = 0; _i < 2; ++_i) { int t0 = tl[(par_) * 256 + RA[_i]], t1 = tl[(par_) * 256 + 128 + RA[_i]]; t0 = t0 < 0 ? 0 : t0; t1 = t1 < 0 ? 0 : t1; \
        d0[_i] = (unsigned)t0 * (unsigned)(K * 2) + (unsigned)CA2[_i]; d1[_i] = (unsigned)t1 * (unsigned)(K * 2) + (unsigned)CA2[_i]; } } while (0)
    Unit cur, nxt; int ui = 0, par = 0;
    if (!S.next(0, cur)) return;
    f32x4 acc[2][2][4][2];
#pragma unroll
    for (int a = 0; a < 2; ++a)
#pragma unroll
        for (int b = 0; b < 2; ++b)
#pragma unroll
            for (int m = 0; m < 4; ++m)
#pragma unroll
                for (int n = 0; n < 2; ++n) acc[a][b][m][n] = (f32x4){0.f, 0.f, 0.f, 0.f};
    bf16x8 At[4][2], B0[2][2], B1[2][2];
    const char* cA = GATHER ? S.A : S.a_base(cur); const char* cB = S.b_base(cur);
    if constexpr (GATHER) { PG8_IDS_DMA(cur.pm, 0); PG8_WAIT_V(0); __syncthreads(); PG8_IDS_READ(vA0, vA1, 0); }
    PG8_STAGE(PG8_SB(0, 0), cB, voffB); PG8_STAGE(PG8_SB(0, 1), cB + hstep, voffB); PG8_STAGE(PG8_SA(0, 0), cA, vA0); PG8_STAGE(PG8_SA(0, 1), cA, vA1);
    if (wr == 1) PG8_BAR;
    PG8_WAIT_V(2); PG8_BAR;
    PG8_STAGE(PG8_SB(1, 0), cB + kstep, voffB); PG8_STAGE(PG8_SA(1, 0), cA + kstep, vA0); PG8_STAGE(PG8_SB(1, 1), cB + hstep + kstep, voffB);
    PG8_WAIT_V(6); PG8_BAR;
    for (;;) {
        const bool has_next = S.next(ui + 1, nxt);
        const char* nA = has_next ? (GATHER ? S.A : S.a_base(nxt)) : cA; const char* nB = has_next ? S.b_base(nxt) : cB;
        for (int t = 0; t < nt; t += 2) {
            const bool last = (t == nt - 2);
            if constexpr (GATHER) {
                if (t == nt - 4 && has_next) PG8_IDS_DMA(nxt.pm, par ^ 1);
                if (last) { if (has_next) PG8_IDS_READ(nA0, nA1, par ^ 1); else { nA0[0] = vA0[0]; nA0[1] = vA0[1]; nA1[0] = vA1[0]; nA1[1] = vA1[1]; } }
            }
            if constexpr (Epi::SC_MODE != 0) {
                if (last && wid < 4) { const int i_ = wid * 64 + lane; LAS unsigned* d_ = (LAS unsigned*)(lds + SC_OFF + wid * 256);
                    if constexpr (Epi::SC_MODE == 1) __builtin_amdgcn_global_load_lds((const unsigned*)(E.sc_src + cur.pm * 256 + i_), d_, 4, 0, 0);
                    if constexpr (Epi::SC_MODE == 2) __builtin_amdgcn_global_load_lds((const unsigned*)(E.sc_src + cur.pn * 256 + i_), d_, 4, 0, 0);
                    if constexpr (Epi::SC_MODE == 3) { int t_ = tl[par * 256 + i_]; t_ = t_ < 0 ? 0 : t_; __builtin_amdgcn_global_load_lds((const unsigned*)(E.sc_src + t_), d_, 4, 0, 0); }
                    if constexpr (Epi::SC_MODE == 4) { __builtin_amdgcn_global_load_lds((const unsigned*)(E.tok + cur.pm * 256 + i_), d_, 4, 0, 0);
                        __builtin_amdgcn_global_load_lds((const unsigned*)(E.w + cur.pm * 256 + i_), (LAS unsigned*)(lds + SC_OFF + 1024 + wid * 256), 4, 0, 0); } }
            }
            const char* a1 = cA + (size_t)(t + 1) * kstep;
            const char* a2 = last ? nA : cA + (size_t)(t + 2) * kstep; const char* b2 = last ? nB : cB + (size_t)(t + 2) * kstep;
            const char* a3 = a2 + kstep; const char* b3 = b2 + kstep;
            unsigned w0[2], w1[2];
            if (GATHER && last) { w0[0] = nA0[0]; w0[1] = nA0[1]; w1[0] = nA1[0]; w1[1] = nA1[1]; } else { w0[0] = vA0[0]; w0[1] = vA0[1]; w1[0] = vA1[0]; w1[1] = vA1[1]; }
            PG8_LDB(B0, 0, 0); PG8_LDB(B1, 0, 1); PG8_SCHED; PG8_LDA(At, 0, 0); PG8_STAGE(PG8_SA(1, 1), a1, vA1);
            PG8_WAIT_V(8); PG8_WAIT_L(0); PG8_BAR; PG8_MMA(0, 0, At, B0); PG8_MMA(0, 1, At, B1); PG8_BAR; PG8_SCHED;
            PG8_LDA(At, 0, 1); PG8_STAGE(PG8_SB(0, 0), b2, voffB); PG8_STAGE(PG8_SB(0, 1), b2 + hstep, voffB); PG8_STAGE(PG8_SA(0, 0), a2, w0);
            PG8_WAIT_V(8); PG8_WAIT_L(0); PG8_BAR; PG8_MMA(1, 0, At, B0); PG8_MMA(1, 1, At, B1); PG8_BAR; PG8_SCHED;
            PG8_LDB(B0, 1, 0); PG8_LDB(B1, 1, 1); PG8_SCHED; PG8_LDA(At, 1, 0); PG8_STAGE(PG8_SA(0, 1), a2, w1);
            PG8_WAIT_V(8); PG8_WAIT_L(0); PG8_BAR; PG8_MMA(0, 0, At, B0); PG8_MMA(0, 1, At, B1); PG8_BAR; PG8_SCHED;
            PG8_LDA(At, 1, 1); PG8_STAGE(PG8_SB(1, 0), b3, voffB); PG8_STAGE(PG8_SB(1, 1), b3 + hstep, voffB); PG8_STAGE(PG8_SA(1, 0), a3, w0);
            PG8_WAIT_V(8); PG8_WAIT_L(0); PG8_BAR; PG8_MMA(1, 0, At, B0); PG8_MMA(1, 1, At, B1); PG8_BAR; PG8_SCHED;
        }
        if (wr == 0) PG8_BAR;
        run_epi(E, acc, cur, wr, wc, fr, fq, (const LAS float*)(lds + SC_OFF), (const LAS int*)(lds + TOK_OFF + par * 1024));
        if (!has_next) break;
#pragma unroll
        for (int a = 0; a < 2; ++a)
#pragma unroll
            for (int b = 0; b < 2; ++b)
#pragma unroll
                for (int m = 0; m < 4; ++m)
#pragma unroll
                    for (int n = 0; n < 2; ++n) acc[a][b][m][n] = (f32x4){0.f, 0.f, 0.f, 0.f};
        cur = nxt; cA = nA; cB = nB; ++ui;
        if constexpr (GATHER) { vA0[0] = nA0[0]; vA0[1] = nA0[1]; vA1[0] = nA1[0]; vA1[1] = nA1[1]; par ^= 1; }
        if (wr == 1) PG8_BAR;
    }
    PG8_WAIT_V(0);
    PG8_BAR;
#undef PG8_SA
#undef PG8_SB
#undef PG8_STAGE
#undef PG8_LDA
#undef PG8_LDB
#undef PG8_MMA
#undef PG8_WAIT_V
#undef PG8_WAIT_L
#undef PG8_BAR
#undef PG8_SCHED
#undef PG8_IDS_DMA
#undef PG8_IDS_READ
}
}

template <class Epi, bool GATHER>
__device__ __forceinline__ void gemm_run(LAS unsigned char* lds, const Sched& S, const Epi& E, const int* gtok) { pg8::gemm_fast<Epi, GATHER>(lds, S, E, gtok); }

__device__ __forceinline__ void na_simple(const Frame& F, const bf16* act0, const bf16* v0t, const float* rpb, bf16* mix) {
    for (int it = F.gw; it < NT * 12; it += F.NGW) {
        const int token = it / 12, h = it % 12, lane = F.lane;
        const int b = token >> 12, p = token & 4095, r = p >> 6, c = p & 63;
        const int r0 = min(max(r - 4, 0), 56), cs = min(max(c - 8, 0), 48);
        const float q = bf2f(act0[(size_t)token * A0_LD + h * 64 + lane]);
        float m = -INFINITY, l = 0.f, o = 0.f;
        for (int a = 0; a < 8; ++a)
            for (int u = 0; u < 16; ++u) {
                const int kt = b * SEQ + (r0 + a) * 64 + cs + u;
                const float kv = bf2f(act0[(size_t)kt * A0_LD + 768 + h * 64 + lane]);
                const float sc = wave_sum(q * kv) + rpb[h * 465 + (r0 + a - r + 7) * 31 + (cs + u - c + 15)];
                const float mn = fmaxf(m, sc), corr = __expf(m - mn), pe = __expf(sc - mn);
                const float vv = bf2f(v0t[(size_t)(h * 64 + lane) * NT + kt]);
                l = l * corr + pe; o = o * corr + pe * vv; m = mn;
            }
        mix[(size_t)token * DM + h * 64 + lane] = (bf16)f2bf(o / l);
    }
}
__device__ __forceinline__ void memattn_simple(const Frame& F, int first, int stride, const bf16* act, int ld, int qoff, const bf16* memk, const bf16* memvt, bf16* mix) {
    for (int it = first; it < NT * 4; it += stride) {
        const int token = it >> 2, h = it & 3, lane = F.lane, b = token >> 12;
        const float q = bf2f(act[(size_t)token * ld + qoff + h * 64 + lane]);
        float m = -INFINITY, l = 0.f, o = 0.f;
        for (int j = 0; j < 256; ++j) {
            const float kv = bf2f(memk[(size_t)(b * 256 + j) * 256 + h * 64 + lane]);
            const float sc = wave_sum(q * kv);
            const float mn = fmaxf(m, sc), corr = __expf(m - mn), pe = __expf(sc - mn);
            const float vv = bf2f(memvt[(size_t)(h * 64 + lane) * MEM_ROWS + b * 256 + j]);
            l = l * corr + pe; o = o * corr + pe * vv; m = mn;
        }
        mix[(size_t)token * DM + 768 + h * 64 + lane] = (bf16)f2bf(o / l);
    }
}

typedef short s16x4 __attribute__((ext_vector_type(4)));
template <bool NA>
__device__ __forceinline__ void attn16(int lane, const bf16* Q, int ldq, const bf16* Kb, int ldk, const bf16* Vt, int ldv, int ktok0, int trs, bf16* O, int ldo,
                                       const LAS float* rpb_h, int r, int r0, int jb, int band0) {
    const int qi = lane & 15, g = lane >> 4;
    bf16x8 qf[2];
#pragma unroll
    for (int ks = 0; ks < 2; ++ks) qf[ks] = *(const bf16x8*)(Q + (size_t)qi * ldq + ks * 32 + 8 * g);
    f32x4 s[16];
    const int krow = 8 * (qi >> 2) + (qi & 3);
#pragma unroll
    for (int t = 0; t < 16; ++t) {
        const bf16* kp = Kb + (size_t)(ktok0 + (t >> 1) * trs + krow + 4 * (t & 1)) * ldk + 8 * g;
        const bf16x8 k0 = *(const bf16x8*)kp, k1 = *(const bf16x8*)(kp + 32);
        f32x4 z = {0.f, 0.f, 0.f, 0.f};
        z = __builtin_amdgcn_mfma_f32_16x16x32_bf16(k0, qf[0], z, 0, 0, 0);
        z = __builtin_amdgcn_mfma_f32_16x16x32_bf16(k1, qf[1], z, 0, 0, 0);
        s[t] = z;
    }
    bf16x8 vfa[4][8];
#pragma unroll
    for (int mt = 0; mt < 4; ++mt)
#pragma unroll
        for (int kk = 0; kk < 8; ++kk) vfa[mt][kk] = *(const bf16x8*)(Vt + (size_t)(16 * mt + qi) * ldv + ktok0 + kk * trs + 8 * g);
    __builtin_amdgcn_sched_barrier(0);
    float m = -INFINITY;
    if constexpr (NA) {
        const int qc = 16 * jb + qi, cs = min(max(qc - 8, 0), 48);
        const LAS float* bp = rpb_h + (r0 - r + 7) * 31 + (band0 + 8 * g - qc + 15);
        bool ok[2][4];
#pragma unroll
        for (int hh = 0; hh < 2; ++hh)
#pragma unroll
            for (int i = 0; i < 4; ++i) { const int kc = band0 + 8 * g + 4 * hh + i; ok[hh][i] = (kc >= cs) && (kc < cs + 16); }
#pragma unroll
        for (int t = 0; t < 16; ++t)
#pragma unroll
            for (int i = 0; i < 4; ++i) {
                const float bv = bp[(t >> 1) * 31 + 4 * (t & 1) + i];
                const float v = ok[t & 1][i] ? s[t][i] + bv : -INFINITY;
                s[t][i] = v; m = fmaxf(m, v);
            }
    } else {
#pragma unroll
        for (int t = 0; t < 16; ++t)
#pragma unroll
            for (int i = 0; i < 4; ++i) m = fmaxf(m, s[t][i]);
    }
    m = fmaxf(m, __shfl_xor(m, 16)); m = fmaxf(m, __shfl_xor(m, 32));
    float l = 0.f;
    bf16x8 pf[8];
#pragma unroll
    for (int kk = 0; kk < 8; ++kk) {
        float p[8];
#pragma unroll
        for (int i = 0; i < 4; ++i) { p[i] = __builtin_amdgcn_exp2f(s[2 * kk][i] - m); p[4 + i] = __builtin_amdgcn_exp2f(s[2 * kk + 1][i] - m); }
#pragma unroll
        for (int i = 0; i < 8; ++i) l += p[i];
        v4u w; w.x = pk2(p[0], p[1]); w.y = pk2(p[2], p[3]); w.z = pk2(p[4], p[5]); w.w = pk2(p[6], p[7]);
        pf[kk] = __builtin_bit_cast(bf16x8, w);
    }
    l += __shfl_xor(l, 16); l += __shfl_xor(l, 32);
    const float inv = __builtin_amdgcn_rcpf(l);
#pragma unroll
    for (int mt = 0; mt < 4; ++mt) {
        f32x4 acc = {0.f, 0.f, 0.f, 0.f};
#pragma unroll
        for (int kk = 0; kk < 8; ++kk) {
            acc = __builtin_amdgcn_mfma_f32_16x16x32_bf16(vfa[mt][kk], pf[kk], acc, 0, 0, 0);
        }
        v2u w; w.x = pk2(acc[0] * inv, acc[1] * inv); w.y = pk2(acc[2] * inv, acc[3] * inv);
        *(v2u*)(O + (size_t)qi * ldo + 16 * mt + 4 * g) = w;
    }
}
__device__ __forceinline__ void memattn_item(int it, int lane, const bf16* act, int ld, int qoff, const bf16* memk, const bf16* memvt, bf16* mix) {
    const int tb = it >> 2, h = it & 3, tok0 = tb * 16, b = tok0 >> 12;
    attn16<false>(lane, act + (size_t)tok0 * ld + qoff + h * 64, ld, memk + h * 64, 256, memvt + (size_t)(h * 64) * MEM_ROWS, MEM_ROWS, b * 256, 32,
                  mix + (size_t)tok0 * DM + 768 + h * 64, DM, nullptr, 0, 0, 0, 0);
}
__device__ __forceinline__ void na_item(int it, int lane, const bf16* act0, const bf16* v0t, const LAS float* rpb, bf16* mix) {
    const int jb = it & 3, h = (it >> 2) % 12, br = (it >> 2) / 12, r = br & 63, b = br >> 6;
    const int r0 = min(max(r - 4, 0), 56), band0 = min(max(jb * 16 - 8, 0), 32);
    const int tok0 = b * SEQ + r * 64 + jb * 16;
    attn16<true>(lane, act0 + (size_t)tok0 * A0_LD + h * 64, A0_LD, act0 + 768 + h * 64, A0_LD, v0t + (size_t)(h * 64) * NT, NT, b * SEQ + r0 * 64 + band0, 64,
                 mix + (size_t)tok0 * DM + h * 64, DM, rpb + h * 465, r, r0, jb, band0);
}

__device__ __forceinline__ float logsigmoid(float x) { return fminf(x, 0.f) - log1pf(__expf(-fabsf(x))); }
__device__ __forceinline__ void gla_simple(const Frame& F, int item, const bf16* act1, const bf16* v1t, const float* wgk, const float* bgk, bf16* O) {
    const int b = item >> 3, h = (item >> 1) & 3, dir = item & 1, tid = F.tid;
    LAS float* sh = (LAS float*)F.lds;
    float S[96];
#pragma unroll
    for (int d = 0; d < 96; ++d) S[d] = 0.f;
    float wcol[16], bias = 0.f;
    if (tid < 96) {
#pragma unroll
        for (int r = 0; r < 16; ++r) wcol[r] = wgk[r * 384 + h * 96 + tid];
        bias = bgk[h * 96 + tid];
    }
    for (int tau = 0; tau < SEQ; ++tau) {
        const int token = b * SEQ + (dir ? (SEQ - 1 - tau) : tau);
        LAS float* cur = sh + (tau & 1) * 288;
        if (tid < 96) {
            const bf16* row = act1 + (size_t)token * A1_LD;
            float z = bias;
#pragma unroll
            for (int r = 0; r < 16; ++r) z += bf2f(row[1792 + dir * 16 + r]) * wcol[r];
            cur[tid] = __expf(logsigmoid(z) * (1.0f / 16.0f));
            cur[96 + tid] = bf2f(row[h * 96 + tid]) * 0.10206207261596575f;
            cur[192 + tid] = bf2f(row[384 + h * 96 + tid]);
        }
        __syncthreads();
        if (tid < 192) {
            const float v = bf2f(v1t[(size_t)(h * 192 + tid) * NT + token]);
            float o = 0.f;
            if (dir == 0) {
#pragma unroll
                for (int d = 0; d < 96; ++d) { S[d] = cur[d] * S[d] + cur[192 + d] * v; o += cur[96 + d] * S[d]; }
            } else {
#pragma unroll
                for (int d = 0; d < 96; ++d) { S[d] = cur[d] * S[d]; o += cur[96 + d] * S[d]; S[d] += cur[192 + d] * v; }
            }
            O[(size_t)token * 768 + h * 192 + tid] = (bf16)f2bf(o);
        }
    }
    __syncthreads();
}

__device__ __forceinline__ void gla_pre_item(int item, int wave, int lane, const bf16* act1, const float* W, const float* Bi, bf16* E) {
    const int n = item & 63, dir = (item >> 6) & 1, b = item >> 7, base = b * SEQ + n * 64;
    const int qi = lane & 15, g = lane >> 4;
    bf16x8 zf[4];
#pragma unroll
    for (int ct = 0; ct < 4; ++ct) { const int c = 16 * ct + qi, tok = dir ? base + 63 - c : base + c;
        bf16x8 z = {0, 0, 0, 0, 0, 0, 0, 0}; if (g < 2) z = *(const bf16x8*)(act1 + (size_t)tok * A1_LD + 1792 + dir * 16 + 8 * g); zf[ct] = z; }
#pragma unroll 1
    for (int jj = 0; jj < 3; ++jj) {
        const int j = 16 * (wave + 8 * jj) + qi;
        v4u wu = {0u, 0u, 0u, 0u};
        if (g < 2) { const float* wp = W + (size_t)(8 * g) * 384 + j;
            wu.x = pk2(wp[0], wp[384]); wu.y = pk2(wp[768], wp[1152]); wu.z = pk2(wp[1536], wp[1920]); wu.w = pk2(wp[2304], wp[2688]); }
        const bf16x8 wfr = __builtin_bit_cast(bf16x8, wu);
        const float bias = Bi[j]; float carry = 0.f;
#pragma unroll
        for (int ct = 0; ct < 4; ++ct) {
            f32x4 d = {0.f, 0.f, 0.f, 0.f};
            d = __builtin_amdgcn_mfma_f32_16x16x32_bf16(zf[ct], wfr, d, 0, 0, 0);
            float p[4];
#pragma unroll
            for (int i = 0; i < 4; ++i) { const float x = d[i] + bias; p[i] = (fminf(x, 0.f) - __logf(1.0f + __expf(-fabsf(x)))) * 0.0625f; }
            p[1] += p[0]; p[2] += p[1]; p[3] += p[2];
            float a = p[3]; float t = __shfl_up(a, 16); if (g >= 1) a += t; t = __shfl_up(a, 32); if (g >= 2) a += t;
            const float excl = a - p[3] + carry;
            carry += __shfl(a, 48 + qi);
#pragma unroll
            for (int i = 0; i < 4; ++i) { const int c = 16 * ct + 4 * g + i, tok = dir ? base + 63 - c : base + c;
                E[(size_t)tok * 384 + j] = (bf16)f2bf(__expf(excl + p[i])); }
        }
    }
}
constexpr int GL_QT = 0, GL_KT = 13312, GL_KDT = 26624, GL_VT = 40448, GL_DEC = 47360, GL_BUF = 49152;
__device__ __forceinline__ unsigned rev16(unsigned u) { return (u >> 16) | (u << 16); }
__device__ __forceinline__ void gla_main_item(const Frame& F, int item, const bf16* act1, const bf16* v1t, const bf16* Eall, bf16* OFp, bf16* OBp) {
    const int vs = item & 3, dir = (item >> 2) & 1, h = (item >> 3) & 3, b = item >> 5;
    const int tid = F.tid, lane = F.lane, wave = F.wave, qi = lane & 15, g = lane >> 4, ct = wave & 3, vh = wave >> 2;
    const bf16* E = Eall + (size_t)dir * NT * 384; bf16* O = dir ? OBp : OFp;
    LAS unsigned char* L = F.lds;
    const int pc = tid >> 3, pdg = tid & 7;
    f32x4 S[2][6];
#pragma unroll
    for (int vi = 0; vi < 2; ++vi)
#pragma unroll
        for (int dt = 0; dt < 6; ++dt) S[vi][dt] = (f32x4){0.f, 0.f, 0.f, 0.f};
    v2u rq[3], rk[3], re[3], rel[3]; v4u rv = {0u, 0u, 0u, 0u};
#define GL_LOAD(n_) do { const int nn_ = dir ? 63 - (n_) : (n_), base_ = b * SEQ + nn_ * 64, tokc_ = dir ? base_ + 63 - pc : base_ + pc, tokl_ = dir ? base_ : base_ + 63; \
        const bf16* ar_ = act1 + (size_t)tokc_ * A1_LD + h * 96 + 12 * pdg; const bf16* er_ = E + (size_t)tokc_ * 384 + h * 96 + 12 * pdg; const bf16* el_ = E + (size_t)tokl_ * 384 + h * 96 + 12 * pdg; \
        _Pragma("unroll") for (int j_ = 0; j_ < 3; ++j_) { rq[j_] = *(const v2u*)(ar_ + 4 * j_); rk[j_] = *(const v2u*)(ar_ + 384 + 4 * j_); re[j_] = *(const v2u*)(er_ + 4 * j_); rel[j_] = *(const v2u*)(el_ + 4 * j_); } \
        if (pc < 48) rv = *(const v4u*)(v1t + (size_t)(h * 192 + vs * 48 + pc) * NT + base_ + 8 * pdg); } while (0)
#define GL_PREP(bufo_) do { LAS unsigned char* B_ = L + (bufo_); \
        _Pragma("unroll") for (int j_ = 0; j_ < 3; ++j_) { float q_[4], k_[4], e_[4], l_[4], qt_[4], kt_[4], kd_[4]; \
            q_[0] = bflo(rq[j_].x); q_[1] = bfhi(rq[j_].x); q_[2] = bflo(rq[j_].y); q_[3] = bfhi(rq[j_].y); k_[0] = bflo(rk[j_].x); k_[1] = bfhi(rk[j_].x); k_[2] = bflo(rk[j_].y); k_[3] = bfhi(rk[j_].y); \
            e_[0] = bflo(re[j_].x); e_[1] = bfhi(re[j_].x); e_[2] = bflo(re[j_].y); e_[3] = bfhi(re[j_].y); l_[0] = bflo(rel[j_].x); l_[1] = bfhi(rel[j_].x); l_[2] = bflo(rel[j_].y); l_[3] = bfhi(rel[j_].y); \
            _Pragma("unroll") for (int i_ = 0; i_ < 4; ++i_) { const float inv_ = __builtin_amdgcn_rcpf(e_[i_]); qt_[i_] = q_[i_] * 0.10206207261596575f * e_[i_]; kt_[i_] = k_[i_] * inv_; kd_[i_] = kt_[i_] * l_[i_]; } \
            v2u w_; w_.x = pk2(qt_[0], qt_[1]); w_.y = pk2(qt_[2], qt_[3]); *(LAS v2u*)(B_ + GL_QT + pc * 208 + (12 * pdg + 4 * j_) * 2) = w_; \
            w_.x = pk2(kt_[0], kt_[1]); w_.y = pk2(kt_[2], kt_[3]); *(LAS v2u*)(B_ + GL_KT + pc * 208 + (12 * pdg + 4 * j_) * 2) = w_; \
            _Pragma("unroll") for (int i_ = 0; i_ < 4; ++i_) *(LAS bf16*)(B_ + GL_KDT + (12 * pdg + 4 * j_ + i_) * 144 + pc * 2) = (bf16)f2bf(kd_[i_]); \
            if (pc == 0) { f32x4 d_ = {l_[0], l_[1], l_[2], l_[3]}; *(LAS f32x4*)(B_ + GL_DEC + (12 * pdg + 4 * j_) * 4) = d_; } } \
        if (pc < 48) { v4u o_ = rv; int c0_ = 8 * pdg; if (dir) { o_.x = rev16(rv.w); o_.y = rev16(rv.z); o_.z = rev16(rv.y); o_.w = rev16(rv.x); c0_ = 56 - 8 * pdg; } \
            *(LAS v4u*)(B_ + GL_VT + pc * 144 + c0_ * 2) = o_; } } while (0)
    GL_LOAD(0);
    GL_PREP(0);
    GL_LOAD(1);
    asm volatile("s_waitcnt lgkmcnt(0)\n\ts_barrier" ::: "memory");
#pragma unroll 1
    for (int n = 0; n < 64; ++n) {
        const int bo = (n & 1) * GL_BUF;
        if (n + 1 < 64) { GL_PREP(GL_BUF - bo); if (n + 2 < 64) GL_LOAD(n + 2); }
        LAS unsigned char* Bf = L + bo;
        bf16x8 qf[3];
#pragma unroll
        for (int ks = 0; ks < 3; ++ks) qf[ks] = *(const LAS bf16x8*)(Bf + GL_QT + (16 * ct + qi) * 208 + (32 * ks + 8 * g) * 2);
        f32x4 am[4];
#pragma unroll
        for (int tp = 0; tp < 4; ++tp) {
            f32x4 z = {0.f, 0.f, 0.f, 0.f};
            if (tp <= ct) {
#pragma unroll
                for (int ks = 0; ks < 3; ++ks) { const bf16x8 kf = *(const LAS bf16x8*)(Bf + GL_KT + (16 * tp + qi) * 208 + (32 * ks + 8 * g) * 2);
                    z = __builtin_amdgcn_mfma_f32_16x16x32_bf16(kf, qf[ks], z, 0, 0, 0); }
                const int c = 16 * ct + qi;
#pragma unroll
                for (int i = 0; i < 4; ++i) { const int cp = 16 * tp + 4 * g + i; const bool keep = (cp < c) || (dir == 0 && cp == c); z[i] = keep ? z[i] : 0.f; }
            }
            am[tp] = z;
        }
        bf16x8 pf[2];
#pragma unroll
        for (int kk = 0; kk < 2; ++kk) { v4u w; w.x = pk2(am[2 * kk][0], am[2 * kk][1]); w.y = pk2(am[2 * kk][2], am[2 * kk][3]); w.z = pk2(am[2 * kk + 1][0], am[2 * kk + 1][1]); w.w = pk2(am[2 * kk + 1][2], am[2 * kk + 1][3]);
            pf[kk] = __builtin_bit_cast(bf16x8, w); }
        bf16x8 qp[3];
#pragma unroll
        for (int kk = 0; kk < 3; ++kk) { const LAS unsigned char* qr = Bf + GL_QT + (16 * ct + qi) * 208 + (32 * kk + 4 * g) * 2;
            const s16x4 a0 = *(const LAS s16x4*)qr, a1 = *(const LAS s16x4*)(qr + 32); qp[kk] = __builtin_shufflevector(a0, a1, 0, 1, 2, 3, 4, 5, 6, 7); }
        const int nn = dir ? 63 - n : n, base = b * SEQ + nn * 64, c = 16 * ct + qi, tok = dir ? base + 63 - c : base + c;
#pragma unroll
        for (int vi = 0; vi < 2; ++vi) {
            if (vi == 1 && vh == 1) break;
            const int vt = 2 * vh + vi;
            f32x4 acc = {0.f, 0.f, 0.f, 0.f};
#pragma unroll
            for (int kk = 0; kk < 2; ++kk) { const LAS unsigned char* vr = Bf + GL_VT + (16 * vt + qi) * 144 + (32 * kk + 4 * g) * 2;
                const s16x4 a0 = *(const LAS s16x4*)vr, a1 = *(const LAS s16x4*)(vr + 32); const bf16x8 vf = __builtin_shufflevector(a0, a1, 0, 1, 2, 3, 4, 5, 6, 7);
                acc = __builtin_amdgcn_mfma_f32_16x16x32_bf16(vf, pf[kk], acc, 0, 0, 0); }
#pragma unroll
            for (int kk = 0; kk < 3; ++kk) { v4u w; w.x = pk2(S[vi][2 * kk][0], S[vi][2 * kk][1]); w.y = pk2(S[vi][2 * kk][2], S[vi][2 * kk][3]); w.z = pk2(S[vi][2 * kk + 1][0], S[vi][2 * kk + 1][1]); w.w = pk2(S[vi][2 * kk + 1][2], S[vi][2 * kk + 1][3]);
                acc = __builtin_amdgcn_mfma_f32_16x16x32_bf16(__builtin_bit_cast(bf16x8, w), qp[kk], acc, 0, 0, 0); }
            v2u w; w.x = pk2(acc[0], acc[1]); w.y = pk2(acc[2], acc[3]);
            *(v2u*)(O + (size_t)tok * 768 + h * 192 + vs * 48 + 16 * vt + 4 * g) = w;
            bf16x8 vfr[2];
#pragma unroll
            for (int ks = 0; ks < 2; ++ks) vfr[ks] = *(const LAS bf16x8*)(Bf + GL_VT + (16 * vt + qi) * 144 + (32 * ks + 8 * g) * 2);
#pragma unroll
            for (int dt = 0; dt < 6; ++dt) {
                const f32x4 dec = *(const LAS f32x4*)(Bf + GL_DEC + (16 * dt + 4 * g) * 4);
                f32x4 sv = S[vi][dt]; sv[0] *= dec[0]; sv[1] *= dec[1]; sv[2] *= dec[2]; sv[3] *= dec[3];
#pragma unroll
                for (int ks = 0; ks < 2; ++ks) { const bf16x8 kdf = *(const LAS bf16x8*)(Bf + GL_KDT + (16 * dt + qi) * 144 + (32 * ks + 8 * g) * 2);
                    sv = __builtin_amdgcn_mfma_f32_16x16x32_bf16(kdf, vfr[ks], sv, 0, 0, 0); }
                S[vi][dt] = sv;
            }
        }
        asm volatile("s_waitcnt lgkmcnt(0)\n\ts_barrier" ::: "memory");
    }
    __syncthreads();
#undef GL_LOAD
#undef GL_PREP
}

__device__ __forceinline__ void finalize_rstd(const Frame& F, const float* rss, float* rstd) {
    for (int row = F.bid * NTHR + F.tid; row < NT; row += F.G * NTHR) rstd[row] = rstd_from(rss + (size_t)row * 16);
}
__device__ __forceinline__ void gla_combine(const Frame& F, const bf16* OF, const bf16* OB, const bf16* act1, const float* gnorm, bf16* mix) {
    for (int token = F.gw; token < NT; token += F.NGW) {
        const int lane = F.lane;
#pragma unroll
        for (int h = 0; h < 4; ++h) {
            float o[3]; float ss = 0.f;
#pragma unroll
            for (int j = 0; j < 3; ++j) { const size_t idx = (size_t)token * 768 + h * 192 + j * 64 + lane; o[j] = bf2f(OF[idx]) + bf2f(OB[idx]); ss += o[j] * o[j]; }
            ss = wave_sum(ss);
            const float rs = 1.0f / sqrtf(ss * (1.0f / 192.0f) + EPS);
#pragma unroll
            for (int j = 0; j < 3; ++j) { const int dv = j * 64 + lane; const float g = bf2f(act1[(size_t)token * A1_LD + 768 + h * 192 + dv]);
                const float val = o[j] * rs * gnorm[dv] * (g / (1.0f + __expf(-g)));
                mix[(size_t)token * DM + h * 192 + dv] = (bf16)f2bf(val); }
        }
    }
}
__device__ __forceinline__ void route_pick(const float (&acc)[8], int token, int* topi, float* topw, LAS int* lc) {
    int e0 = 0; float l0 = acc[0];
#pragma unroll
    for (int e = 1; e < 8; ++e) if (acc[e] > l0) { l0 = acc[e]; e0 = e; }
    int e1 = -1; float l1 = -INFINITY;
#pragma unroll
    for (int e = 0; e < 8; ++e) if (e != e0 && acc[e] > l1) { l1 = acc[e]; e1 = e; }
    if (e1 < 0) { e1 = (e0 + 1) & 7; l1 = l0; }
    const float w0 = 1.0f / (1.0f + __expf(l1 - l0));
    topi[token] = e0 | (e1 << 8); topw[2 * token] = w0; topw[2 * token + 1] = 1.0f - w0;
    atomicAdd((int*)&lc[e0], 1); atomicAdd((int*)&lc[8 + e1], 1);
}
__device__ __forceinline__ void route1(const Frame& F, const float* H, const float* gain, const float* wr, int* topi, float* topw, int* cnt, float* rstd) {
    LAS int* lc = (LAS int*)F.lds;
    if (F.tid < 16) lc[F.tid] = 0;
    __syncthreads();
    const int lane = F.lane;
    float w[4][4][8];
#pragma unroll
    for (int j = 0; j < 4; ++j) { const f32x4 g = *(const f32x4*)(gain + 256 * j + 4 * lane);
#pragma unroll
        for (int i = 0; i < 4; ++i) { const float* p = wr + (size_t)(256 * j + 4 * lane + i) * 8; const f32x4 a = *(const f32x4*)p, b = *(const f32x4*)(p + 4); const float gi = g[i];
            w[j][i][0] = a.x * gi; w[j][i][1] = a.y * gi; w[j][i][2] = a.z * gi; w[j][i][3] = a.w * gi; w[j][i][4] = b.x * gi; w[j][i][5] = b.y * gi; w[j][i][6] = b.z * gi; w[j][i][7] = b.w * gi; } }
    for (int t2 = 0; t2 < 16; t2 += 2) {
        const int token = F.bid * 128 + F.wave * 16 + t2;
        const f32x4* h0 = (const f32x4*)(H + (size_t)token * DM) + lane; const f32x4* h1 = h0 + DM / 4;
        f32x4 x0[4], x1[4];
#pragma unroll
        for (int j = 0; j < 4; ++j) x0[j] = h0[64 * j];
#pragma unroll
        for (int j = 0; j < 4; ++j) x1[j] = h1[64 * j];
        float a0[8], a1[8], s0 = 0.f, s1 = 0.f;
#pragma unroll
        for (int e = 0; e < 8; ++e) { a0[e] = 0.f; a1[e] = 0.f; }
#pragma unroll
        for (int j = 0; j < 4; ++j)
#pragma unroll
            for (int i = 0; i < 4; ++i) { const float u = x0[j][i], v = x1[j][i]; s0 += u * u; s1 += v * v;
#pragma unroll
                for (int e = 0; e < 8; ++e) { a0[e] += u * w[j][i][e]; a1[e] += v * w[j][i][e]; } }
        s0 = wave_sum(s0); s1 = wave_sum(s1);
        const float r0 = 1.0f / sqrtf(s0 * (1.0f / DM) + EPS), r1 = 1.0f / sqrtf(s1 * (1.0f / DM) + EPS);
#pragma unroll
        for (int e = 0; e < 8; ++e) { a0[e] = wave_sum(a0[e]) * r0; a1[e] = wave_sum(a1[e]) * r1; }
        if (lane == 0) { route_pick(a0, token, topi, topw, lc); route_pick(a1, token + 1, topi, topw, lc); rstd[token] = r0; rstd[token + 1] = r1; }
    }
    __syncthreads();
    if (F.tid < 16) cnt[F.bid * 16 + F.tid] = lc[F.tid];
    __syncthreads();
}
__device__ __forceinline__ void route2(const Frame& F, const int* topi, const float* topw, const int* cnt, int* stok, float* sw, int* blk) {
    LAS int* part = (LAS int*)F.lds;
    LAS int* base = part + 1024;
    LAS int* tk = base + 64;
    const int tid = F.tid, pe = tid & 15, jg = tid >> 4;
    int below = 0, tot = 0;
    for (int w = jg; w < F.G; w += 32) { const int v = cnt[w * 16 + pe]; tot += v; if (w < F.bid) below += v; }
    part[jg * 16 + pe] = below; part[512 + jg * 16 + pe] = tot;
    if (tid < 128) tk[tid] = topi[F.bid * 128 + tid];
    __syncthreads();
    if (tid < 16) { int b = 0, t = 0; for (int j = 0; j < 32; ++j) { b += part[j * 16 + tid]; t += part[512 + j * 16 + tid]; } base[tid] = b; base[16 + tid] = t; }
    __syncthreads();
    if (tid < 2) { int ps = 0; for (int e = 0; e < 8; ++e) { base[32 + tid * 8 + e] = ps; ps += (base[16 + tid * 8 + e] + 255) / 256 * 256; } base[48 + tid] = ps / 256; }
    __syncthreads();
    if (tid < 256) {
        const int p = tid >> 7, i = tid & 127; const int e = (tk[i] >> (8 * p)) & 0xff;
        int rank = 0; for (int j = 0; j < i; ++j) rank += (((tk[j] >> (8 * p)) & 0xff) == e) ? 1 : 0;
        const int slot = base[32 + p * 8 + e] + base[p * 8 + e] + rank; const int token = F.bid * 128 + i;
        stok[p * SLOT_CAP + slot] = token; sw[p * SLOT_CAP + slot] = topw[2 * token + p];
    }
    if (F.bid < 16) {
        const int p = F.bid >> 3, e = F.bid & 7, ps = base[32 + F.bid], t = base[16 + F.bid], pend = ps + (t + 255) / 256 * 256;
        for (int s = ps + t + tid; s < pend; s += NTHR) { stok[p * SLOT_CAP + s] = -1; sw[p * SLOT_CAP + s] = 0.f; }
        for (int bk = ps / 256 + tid; bk < pend / 256; bk += NTHR) blk[16 + p * 256 + bk] = e;
        if (e == 0 && tid == 0) blk[p] = base[48 + p];
    }
    __syncthreads();
}
__device__ __forceinline__ void final_norm(const Frame& F, float* H, const float* gain) {
    for (int row = F.gw; row < NT; row += F.NGW) {
        GAS f32x4* xr = (GAS f32x4*)(H + (size_t)row * DM) + F.lane; const f32x4* gr = (const f32x4*)gain + F.lane;
        f32x4 v[4]; float s = 0.f;
#pragma unroll
        for (int j = 0; j < 4; ++j) { v[j] = xr[64 * j]; s += (v[j].x * v[j].x + v[j].y * v[j].y) + (v[j].z * v[j].z + v[j].w * v[j].w); }
        s = wave_sum(s); const float rs = 1.0f / sqrtf(s * (1.0f / DM) + EPS);
#pragma unroll
        for (int j = 0; j < 4; ++j) { const f32x4 g = gr[64 * j]; f32x4 o = {v[j].x * rs * g.x, v[j].y * rs * g.y, v[j].z * rs * g.z, v[j].w * rs * g.w}; xr[64 * j] = o; }
    }
}

constexpr int N_PHASES = 17;
__global__ void __launch_bounds__(NTHR, 2) mega(Args args) {
    extern __shared__ __attribute__((aligned(16))) unsigned char lds_raw[];
    Frame F;
    F.lds = (LAS unsigned char*)lds_raw;
    F.tid = threadIdx.x; F.lane = F.tid & 63; F.wave = __builtin_amdgcn_readfirstlane(F.tid >> 6);
    F.G = gridDim.x; F.bid = blockIdx.x; F.gw = F.bid * NWAVES + F.wave; F.NGW = F.G * NWAVES; F.ws = args.ws;
    unsigned char* ws = args.ws;
    gu32* ctl = (gu32*)(ws + WS_CTL);
    volatile LAS unsigned* MISC = (volatile LAS unsigned*)(F.lds + MISC_OFF);
    for (int u = F.tid; u < (LDS_BYTES - LDSCTL_OFF) / 4; u += NTHR) ((LAS unsigned*)(F.lds + LDSCTL_OFF))[u] = 0u;
    __syncthreads();
    XcdBarrier bar = xcd_barrier_post((unsigned*)(ctl + CW_BAR), MISC + 8);
    const int lo = args.ph_lo, hi = args.ph_hi;
#ifndef PH_MASK
#define PH_MASK 0x1ffff
#endif
#define IN(k) (((PH_MASK >> (k)) & 1) && lo <= (k) && (k) < hi)
#ifndef REPEAT_MASK
#define REPEAT_MASK 0
#endif
#define REPS(k) (1 + ((REPEAT_MASK >> (k)) & 1))
#define SEAM(k) do { if (IN(k) && IN((k) + 1)) xcd_barrier(bar); } while (0)

    float* H = args.out;
    float* rss = (float*)(ws + WS_RSS); float* rstd = (float*)(ws + WS_RSTD);
    bf16* hbf = (bf16*)(ws + WS_HBF); bf16* membf = (bf16*)(ws + WS_MEMBF); bf16* memk = (bf16*)(ws + WS_MEMK); bf16* memvt = (bf16*)(ws + WS_MEMVT);
    bf16* act0 = (bf16*)(ws + WS_ACT0); bf16* v0t = (bf16*)(ws + WS_V0T); bf16* mix = (bf16*)(ws + WS_MIX); bf16* hmid0 = (bf16*)(ws + WS_HMID0);
    bf16* act1 = (bf16*)(ws + WS_ACT1); bf16* v1t = (bf16*)(ws + WS_V1T); bf16* OF = (bf16*)(ws + WS_OF); bf16* OB = (bf16*)(ws + WS_OB);
    bf16* hmid1 = (bf16*)(ws + WS_HMID1); bf16* wgu = (bf16*)(ws + WS_WGU); bf16* wdn = (bf16*)(ws + WS_WDN);
    int* cnt = (int*)(ws + WS_CNT); int* topi = (int*)(ws + WS_TOPI); float* topw = (float*)(ws + WS_TOPW);
    int* stok = (int*)(ws + WS_STOK); float* sw = (float*)(ws + WS_SW); int* blk = (int*)(ws + WS_BLK);
    LAS float* scr = (LAS float*)(F.lds + F.wave * 16384);

    if (IN(0)) for (int rep_ = 0; rep_ < REPS(0); ++rep_) {
        int it = F.gw; LAS unsigned* T0 = (LAS unsigned*)scr; LAS unsigned* T1 = T0 + 1088;
#define CVT(Wp, Kd, Nd, WTp, gainp, kind) do { const CvtJob J{Wp, Kd, Nd, (bf16*)(WTp), gainp, kind}; const int n_ = ((Kd) / 64) * ((Nd) / 32); \
            while (it < n_) { CvtRegs A_, B_; B_.valid = 0; cvt_load(A_, J, it, F.lane); it += F.NGW; if (it < n_) { cvt_load(B_, J, it, F.lane); it += F.NGW; } cvt_finish(A_, T0, F.lane); cvt_finish(B_, T1, F.lane); } \
            it -= n_; } while (0)
        CVT(args.in[I_EWIN], 1024, 2560, ws + WS_W0IN, args.in[I_EN1], 1);
        CVT(args.in[I_EWIN], 1024, 2560, ws + WS_WV0, args.in[I_EN1], 2);
        CVT(args.in[I_EWOUT], 1024, 1024, ws + WS_W0OUT, nullptr, 0);
        CVT(args.in[I_EWG], 1024, 2816, ws + WS_W0GU, args.in[I_EN2], 3);
        CVT(args.in[I_EWU], 1024, 2816, ws + WS_W0GU, args.in[I_EN2], 4);
        CVT(args.in[I_EWD], 2816, 1024, ws + WS_W0DN, nullptr, 0);
        CVT(args.in[I_WMKV], 1024, 512, ws + WS_WMEM, args.in[I_MNORM], 0);
        CVT(args.in[I_OWIN], 1024, 2592, ws + WS_W1IN, args.in[I_ON1], 5);
        CVT(args.in[I_OWIN], 1024, 2592, ws + WS_WV1, args.in[I_ON1], 6);
        CVT(args.in[I_OWOUT], 1024, 1024, ws + WS_W1OUT, nullptr, 0);
#undef CVT
        { v4u z = {0u, 0u, 0u, 0u}; v4u* p = (v4u*)(ws + WS_W1IN + (size_t)1824 * 2048); const int n16 = 224 * 2048 / 16;
          for (int i = F.bid * NTHR + F.tid; i < n16; i += F.G * NTHR) p[i] = z; }
        rows_to_bf16(args.in[I_X], hbf, rstd, F.gw, NT, F.NGW, F.lane);
        rows_to_bf16(args.in[I_MEM], membf, rstd + NT, F.gw, MEM_ROWS, F.NGW, F.lane);
    }
    SEAM(0);
    if (IN(1)) for (int rep_ = 0; rep_ < REPS(1); ++rep_) {
        { Sched S; S.init(hbf, ws + WS_W0IN, 1024, 128, 7, F.G, F.bid); EpiRowScale E{act0, A0_LD, rstd}; gemm_run<EpiRowScale, false>(F.lds, S, E, nullptr); }
        { Sched S; S.init(ws + WS_WV0, hbf, 1024, 3, 128, F.G, (F.bid + 128) % F.G); EpiColScale E{v0t, NT, rstd}; gemm_run<EpiColScale, false>(F.lds, S, E, nullptr); }
        { Sched S; S.init(membf, ws + WS_WMEM, 1024, 8, 1, F.G, F.bid); EpiRowScale E{memk, 256, rstd + NT}; gemm_run<EpiRowScale, false>(F.lds, S, E, nullptr); }
        { Sched S; S.init(ws + WS_WMEM + 256 * 2048, membf, 1024, 1, 8, F.G, (F.bid + 248) % F.G); EpiColScale E{memvt, MEM_ROWS, rstd + NT}; gemm_run<EpiColScale, false>(F.lds, S, E, nullptr); }
    }
    SEAM(1);
    if (IN(2)) for (int rep_ = 0; rep_ < REPS(2); ++rep_) {
#if FAST_ATT
        { LAS float* rl = (LAS float*)(F.lds + 256); for (int i = F.tid; i < 5580; i += NTHR) rl[i] = args.in[I_RPB][i] * 1.4426950408889634f; __syncthreads();
          for (int it = F.gw; it < 32768; it += F.NGW) { if (it < 24576) na_item(it, F.lane, act0, v0t, rl, mix); else memattn_item(it - 24576, F.lane, act0, A0_LD, 1536, memk, memvt, mix); }
          __syncthreads(); }
#else
        na_simple(F, act0, v0t, args.in[I_RPB], mix);
        memattn_simple(F, F.gw, F.NGW, act0, A0_LD, 1536, memk, memvt, mix);
#endif
    }
    SEAM(2);
    if (IN(3)) for (int rep_ = 0; rep_ < REPS(3); ++rep_) {
        Sched S; S.init(mix, ws + WS_W0OUT, 1024, 128, 4, F.G, F.bid); EpiResid E{args.in[I_X], H, hbf, rss}; gemm_run<EpiResid, false>(F.lds, S, E, nullptr);
    }
    SEAM(3);
    if (IN(4)) for (int rep_ = 0; rep_ < REPS(4); ++rep_) {
        finalize_rstd(F, rss, rstd); xcd_barrier(bar);
        Sched S; S.init(hbf, ws + WS_W0GU, 1024, 128, 22, F.G, F.bid); EpiSwiGLU<false> E{hmid0, FF0, rstd}; gemm_run<EpiSwiGLU<false>, false>(F.lds, S, E, nullptr);
    }
    SEAM(4);
    if (IN(5)) for (int rep_ = 0; rep_ < REPS(5); ++rep_) {
        Sched S; S.init(hmid0, ws + WS_W0DN, FF0, 128, 4, F.G, F.bid); EpiResid E{H, H, hbf, rss}; gemm_run<EpiResid, false>(F.lds, S, E, nullptr);
    }
    SEAM(5);
    if (IN(6)) for (int rep_ = 0; rep_ < REPS(6); ++rep_) {
        finalize_rstd(F, rss, rstd); xcd_barrier(bar);
        { Sched S; S.init(hbf, ws + WS_W1IN, 1024, 128, 8, F.G, F.bid); EpiRowScale E{act1, A1_LD, rstd}; gemm_run<EpiRowScale, false>(F.lds, S, E, nullptr); }
        { Sched S; S.init(ws + WS_WV1, hbf, 1024, 3, 128, F.G, F.bid); EpiColScale E{v1t, NT, rstd}; gemm_run<EpiColScale, false>(F.lds, S, E, nullptr); }
    }
    SEAM(6);
    if (IN(7)) for (int rep_ = 0; rep_ < REPS(7); ++rep_) {
#if FAST_GLA
        for (int it = F.bid; it < 1024; it += F.G) { const int dir = (it >> 6) & 1;
            gla_pre_item(it, F.wave, F.lane, act1, dir ? args.in[I_WGKB] : args.in[I_WGKF], dir ? args.in[I_BGKB] : args.in[I_BGKF], (bf16*)(ws + WS_E) + (size_t)dir * NT * 384); }
        for (int it = F.gw; it < 8192; it += F.NGW) memattn_item(it, F.lane, act1, A1_LD, 1536, memk, memvt, mix);
        xcd_barrier(bar);
        for (int it = F.bid; it < 256; it += F.G) gla_main_item(F, it, act1, v1t, (const bf16*)(ws + WS_E), OF, OB);
#else
        if (F.bid < 64) {
            const int dir = F.bid & 1;
            gla_simple(F, F.bid, act1, v1t, dir ? args.in[I_WGKB] : args.in[I_WGKF], dir ? args.in[I_BGKB] : args.in[I_BGKF], dir ? OB : OF);
        } else {
#if FAST_ATT
            for (int it = (F.bid - 64) * NWAVES + F.wave; it < 8192; it += (F.G - 64) * NWAVES) memattn_item(it, F.lane, act1, A1_LD, 1536, memk, memvt, mix);
#else
            memattn_simple(F, (F.bid - 64) * NWAVES + F.wave, (F.G - 64) * NWAVES, act1, A1_LD, 1536, memk, memvt, mix);
#endif
        }
#endif
    }
    SEAM(7);
    if (IN(8)) for (int rep_ = 0; rep_ < REPS(8); ++rep_) gla_combine(F, OF, OB, act1, args.in[I_GNORM], mix);
    SEAM(8);
    if (IN(9)) for (int rep_ = 0; rep_ < REPS(9); ++rep_) {
        Sched S; S.init(mix, ws + WS_W1OUT, 1024, 128, 4, F.G, F.bid); EpiResid E{H, H, hbf, rss}; gemm_run<EpiResid, false>(F.lds, S, E, nullptr);
    }
    SEAM(9);
    if (IN(10)) for (int rep_ = 0; rep_ < REPS(10); ++rep_) {
        route1(F, H, args.in[I_ON2], args.in[I_WR], topi, topw, cnt, rstd);
        { LAS unsigned* T0 = (LAS unsigned*)scr; LAS unsigned* T1 = T0 + 1088;
#define MOE_JOB(J_, it_) const int e_##J_ = (it_) / 5376, r_##J_ = (it_) % 5376, wh_##J_ = r_##J_ / 1792; \
            const CvtJob J_{wh_##J_ == 0 ? args.in[I_OWG] + (size_t)e_##J_ * 1024 * FFE : (wh_##J_ == 1 ? args.in[I_OWU] + (size_t)e_##J_ * 1024 * FFE : args.in[I_OWD] + (size_t)e_##J_ * FFE * 1024), \
                wh_##J_ == 2 ? FFE : 1024, wh_##J_ == 2 ? 1024 : FFE, wh_##J_ == 2 ? wdn + (size_t)e_##J_ * 1024 * FFE : wgu + (size_t)e_##J_ * 7168 * 1024, wh_##J_ == 2 ? nullptr : args.in[I_ON2], wh_##J_ == 2 ? 0 : 3 + wh_##J_}
          for (int it = F.gw; it < 8 * 3 * 1792; it += 2 * F.NGW) {
            CvtRegs A_, B_; B_.valid = 0;
            { MOE_JOB(Ja, it); cvt_load(A_, Ja, it % 1792, F.lane); }
            if (it + F.NGW < 8 * 3 * 1792) { MOE_JOB(Jb, it + F.NGW); cvt_load(B_, Jb, (it + F.NGW) % 1792, F.lane); }
            cvt_finish(A_, T0, F.lane); cvt_finish(B_, T1, F.lane);
          }
#undef MOE_JOB
        }
    }
    SEAM(10);
    if (IN(11)) for (int rep_ = 0; rep_ < REPS(11); ++rep_) route2(F, topi, topw, cnt, stok, sw, blk);
    SEAM(11);
    if (IN(12)) for (int rep_ = 0; rep_ < REPS(12); ++rep_) {
        const int nb = blk[0]; Sched S; S.init(hbf, wgu, 1024, nb, 28, F.G, F.bid, blk + 16, (size_t)7168 * 1024 * 2); EpiSwiGLU<true> E{hmid1, FFE, rstd}; gemm_run<EpiSwiGLU<true>, true>(F.lds, S, E, stok);
    }
    SEAM(12);
    if (IN(13)) for (int rep_ = 0; rep_ < REPS(13); ++rep_) {
        const int nb = blk[0]; Sched S; S.init(hmid1, wdn, FFE, nb, 4, F.G, F.bid, blk + 16, (size_t)1024 * FFE * 2); EpiMoeDown E{H, stok, sw}; gemm_run<EpiMoeDown, false>(F.lds, S, E, nullptr);
    }
    SEAM(13);
    if (IN(14)) for (int rep_ = 0; rep_ < REPS(14); ++rep_) {
        const int nb = blk[1]; Sched S; S.init(hbf, wgu, 1024, nb, 28, F.G, F.bid, blk + 16 + 256, (size_t)7168 * 1024 * 2); EpiSwiGLU<true> E{hmid1, FFE, rstd}; gemm_run<EpiSwiGLU<true>, true>(F.lds, S, E, stok + SLOT_CAP);
    }
    SEAM(14);
    if (IN(15)) for (int rep_ = 0; rep_ < REPS(15); ++rep_) {
        const int nb = blk[1]; Sched S; S.init(hmid1, wdn, FFE, nb, 4, F.G, F.bid, blk + 16 + 256, (size_t)1024 * FFE * 2); EpiMoeDown E{H, stok + SLOT_CAP, sw + SLOT_CAP}; gemm_run<EpiMoeDown, false>(F.lds, S, E, nullptr);
    }
    SEAM(15);
    if (IN(16)) final_norm(F, H, args.in[I_FNORM]);
#undef IN
#undef SEAM
}

extern "C" void kernel_launch(void* const* d_in, const int* in_sizes, int n_in, void* d_out, int out_size, void* d_ws, size_t ws_size, hipStream_t stream) {
    static int grid = 0;
    if (grid == 0) {
        if (n_in != 26 || out_size != NT * DM || ws_size < WS_END) { fprintf(stderr, "kernel_launch: unexpected problem (n_in %d out %d ws %zu need %zu)\n", n_in, out_size, ws_size, (size_t)WS_END); grid = -1; return; }
        int dev = 0, cus = 0, per_cu = 0;
        if (hipGetDevice(&dev) != hipSuccess || hipDeviceGetAttribute(&cus, hipDeviceAttributeMultiprocessorCount, dev) != hipSuccess) { grid = -1; return; }
        if (hipFuncSetAttribute((const void*)mega, hipFuncAttributeMaxDynamicSharedMemorySize, LDS_BYTES) != hipSuccess) { fprintf(stderr, "kernel_launch: hipFuncSetAttribute failed\n"); grid = -1; return; }
        if (hipOccupancyMaxActiveBlocksPerMultiprocessor(&per_cu, (const void*)mega, NTHR, LDS_BYTES) != hipSuccess || per_cu < 1) fprintf(stderr, "kernel_launch: occupancy query reports %d\n", per_cu);
        (void)hipGetLastError();
        grid = cus;
        if (grid != 256) fprintf(stderr, "kernel_launch: note: %d CUs\n", grid);
    }
    if (grid < 0) return;
    if (hipMemsetAsync((char*)d_ws + WS_CTL, 0, CTL_ZERO_BYTES, stream) != hipSuccess) return;
    Args a{};
    for (int i = 0; i < 26; ++i) a.in[i] = (const float*)d_in[i];
    a.out = (float*)d_out; a.ws = (unsigned char*)d_ws;
#if MK_FUSED
    a.ph_lo = 0; a.ph_hi = N_PHASES;
    hipLaunchKernelGGL(mega, dim3(grid), dim3(NTHR), LDS_BYTES, stream, a);
#else
    for (int p = 0; p < N_PHASES; ++p) { a.ph_lo = p; a.ph_hi = p + 1; hipLaunchKernelGGL(mega, dim3(grid), dim3(NTHR), LDS_BYTES, stream, a); }
#endif
}
```

```cpp
#include <hip/hip_runtime.h>
#include <cstdio>
#include <cstdint>

#ifndef MK_FUSED
#define MK_FUSED 1
#endif
#ifndef FAST_GEMM
#define FAST_GEMM 1
#endif
#ifndef FAST_ATT
#define FAST_ATT 1
#endif
#ifndef FAST_GLA
#define FAST_GLA 1
#endif

#define GAS __attribute__((address_space(1)))
#define LAS __attribute__((address_space(3)))
typedef unsigned short bf16;
typedef unsigned v4u __attribute__((ext_vector_type(4)));
typedef unsigned v2u __attribute__((ext_vector_type(2)));
typedef float f32x4 __attribute__((ext_vector_type(4)));
typedef short bf16x8 __attribute__((ext_vector_type(8)));
typedef GAS unsigned gu32;
#define RLX_AGENT __ATOMIC_RELAXED, __HIP_MEMORY_SCOPE_AGENT
#define LDS_WAIT() asm volatile("s_waitcnt lgkmcnt(0)" ::: "memory")
#define VM_WAIT() asm volatile("s_waitcnt vmcnt(0)" ::: "memory")

constexpr int NT = 32768, DM = 1024, SEQ = 4096, NB = 8;
constexpr int MEM_ROWS = 2048;
constexpr int A0_LD = 1792;
constexpr int A1_LD = 2048;
constexpr int FF0 = 2816, FFE = 3584, NEXP = 8;
constexpr int SLOT_CAP = 34816;
constexpr float EPS = 1e-6f;
constexpr int NWAVES = 8, NTHR = 512;

constexpr size_t MiB = 1u << 20;
constexpr size_t WS_CTL = 0, CTL_ZERO_BYTES = 1 * MiB;
constexpr size_t WS_RSS = 1 * MiB;
constexpr size_t WS_MRSS = 3 * MiB;
constexpr size_t WS_CNT = 3 * MiB + 256 * 1024;
constexpr size_t WS_TOPI = 3 * MiB + 512 * 1024;
constexpr size_t WS_TOPW = 3 * MiB + 768 * 1024;
constexpr size_t WS_STOK = 4 * MiB;
constexpr size_t WS_SW = 4 * MiB + 512 * 1024;
constexpr size_t WS_BLK = 5 * MiB;
constexpr size_t WS_RSTD = 5 * MiB + 64 * 1024;
constexpr size_t WS_W0IN = 6 * MiB;
constexpr size_t WS_WV0 = WS_W0IN + 1792 * 2048;
constexpr size_t WS_W0OUT = 11 * MiB;
constexpr size_t WS_W0GU = 13 * MiB;
constexpr size_t WS_W0DN = 24 * MiB;
constexpr size_t WS_WMEM = WS_W0DN + 1024 * 2816 * 2;
constexpr size_t WS_W1IN = 31 * MiB;
constexpr size_t WS_WV1 = 35 * MiB;
constexpr size_t WS_W1OUT = 37 * MiB - 512 * 1024;
constexpr size_t WS_HBF = 39 * MiB;
constexpr size_t WS_MEMBF = 103 * MiB;
constexpr size_t WS_MEMK = 107 * MiB;
constexpr size_t WS_MEMVT = 108 * MiB;
constexpr size_t WS_ACT = 109 * MiB;
constexpr size_t WS_ACT0 = WS_ACT;
constexpr size_t WS_V0T = WS_ACT + 112 * MiB;
constexpr size_t WS_MIX = WS_ACT + 176 * MiB;
constexpr size_t WS_HMID0 = WS_ACT;
constexpr size_t WS_ACT1 = WS_ACT;
constexpr size_t WS_V1T = WS_ACT + 128 * MiB;
constexpr size_t WS_OF = WS_ACT + 240 * MiB;
constexpr size_t WS_OB = WS_ACT + 288 * MiB;
constexpr size_t WS_GQT = WS_ACT + 336 * MiB;
constexpr size_t WS_GKDT0 = WS_ACT + 384 * MiB;
constexpr size_t WS_GKDT1 = 6 * MiB;
constexpr size_t WS_GKT = WS_HBF;
constexpr size_t WS_GDEC = WS_HBF + 48 * MiB;
constexpr size_t WS_E = WS_ACT + 336 * MiB;
constexpr size_t WS_HT1 = 6 * MiB;
constexpr size_t WS_HMID1 = WS_ACT;
constexpr size_t WS_WGU = WS_ACT + 240 * MiB;
constexpr size_t WS_WDN = WS_ACT + 352 * MiB;
constexpr size_t WS_END = WS_ACT + 408 * MiB;
static_assert(WS_W1OUT + 2 * MiB <= WS_HBF && WS_WV1 + 768 * 2048 <= WS_W1OUT && WS_W1IN + 4 * MiB <= WS_WV1 && WS_WMEM + MiB <= WS_W1IN, "weight map");
static_assert(WS_W0GU + 11 * MiB <= WS_W0DN && WS_WV0 + 768 * 2048 <= WS_W0OUT, "weight map 2");
static_assert((size_t)SLOT_CAP * 3584 * 2 <= 240 * MiB, "hmid1");

constexpr int CW_TMO = 0, CW_CODE = 1, CW_BAR = 4096;

constexpr int RING_BYTES = 131072;
constexpr int LDSCTL_OFF = RING_BYTES, MISC_OFF = LDSCTL_OFF + 320;
constexpr int LDS_BYTES = 147456;

typedef float f32x2_t __attribute__((ext_vector_type(2)));
typedef __bf16 bf16x2_t __attribute__((ext_vector_type(2)));
__device__ __forceinline__ unsigned pk2(float lo, float hi) { const f32x2_t v = {lo, hi}; const bf16x2_t b = __builtin_convertvector(v, bf16x2_t); return __builtin_bit_cast(unsigned, b); }
__device__ __forceinline__ unsigned f2bf(float f) { return pk2(f, 0.f) & 0xffffu; }
__device__ __forceinline__ float bf2f(bf16 b) { return __builtin_bit_cast(float, (unsigned)b << 16); }
__device__ __forceinline__ float bflo(unsigned u) { return __builtin_bit_cast(float, u << 16); }
__device__ __forceinline__ float bfhi(unsigned u) { return __builtin_bit_cast(float, u & 0xffff0000u); }
__device__ __forceinline__ float wave_sum(float v) {
#pragma unroll
    for (int o = 1; o < 64; o <<= 1) v += __shfl_xor(v, o);
    return v;
}
__device__ __forceinline__ float wave_max(float v) {
#pragma unroll
    for (int o = 1; o < 64; o <<= 1) v = fmaxf(v, __shfl_xor(v, o));
    return v;
}

#define XB_TMO      128
#define XB_XCNT(j)  (256  + 64 * (j))
#define XB_XSUB(j)  (1280 + 64 * (j))
#define XB_XGEN(j)  (2304 + 64 * (j))
#define XB_TOP      3328
#define XB_TOPGEN   3392
#define XCD_BAR_WORDS 3456
#define XB_SPIN_CAP (1u << 22)

__device__ __forceinline__ unsigned xb_ld(unsigned* p)              { return __hip_atomic_load(p, __ATOMIC_RELAXED, __HIP_MEMORY_SCOPE_AGENT); }
__device__ __forceinline__ unsigned xb_add(unsigned* p, unsigned v) { return __hip_atomic_fetch_add(p, v, __ATOMIC_RELAXED, __HIP_MEMORY_SCOPE_AGENT); }
__device__ __forceinline__ unsigned xb_xcc_id() { return (unsigned)__builtin_amdgcn_s_getreg((3 << 11) | 20) & 0xFu; }
#define XB_SPIN(cond, bar) do { unsigned _sp = 0; while (cond) { __builtin_amdgcn_s_sleep(1); \
    if ((++_sp & 255u) == 0u) { if (xb_ld(&(bar)[XB_TMO])) break; if (_sp > XB_SPIN_CAP) { atomicAdd(&(bar)[XB_TMO], 1u); break; } } } } while (0)

struct XcdBarrier { unsigned* bar; unsigned x; volatile LAS unsigned* st; };

__device__ __forceinline__ XcdBarrier xcd_barrier_post(unsigned* bar, volatile LAS unsigned* st) {
    XcdBarrier b; b.bar = bar; b.x = xb_xcc_id(); b.st = st;
    if (threadIdx.x == 0) (void)xb_add(&bar[XB_XCNT(b.x)], 1u);
    return b;
}
__device__ __forceinline__ void xcd_barrier_complete(unsigned* bar, unsigned x, unsigned& nloc, unsigned& nx) {
    const unsigned G = gridDim.x * gridDim.y * gridDim.z;
    unsigned sum, cnt, mine, sp = 0u;
    for (;;) {
        sum = 0u; cnt = 0u; mine = 0u;
#pragma unroll
        for (unsigned j = 0; j < 16; ++j) { const unsigned c = xb_ld(&bar[XB_XCNT(j)]); sum += c; cnt += (c > 0u) ? 1u : 0u; mine = (j == x) ? c : mine; }
        if (sum == G) break;
        __builtin_amdgcn_s_sleep(1);
        if ((++sp & 255u) == 0u) { if (xb_ld(&bar[XB_TMO])) break; if (sp > XB_SPIN_CAP) { atomicAdd(&bar[XB_TMO], 1u); break; } }
    }
    nloc = mine > 0u ? mine : 1u; nx = cnt > 0u ? cnt : 1u;
}
__device__ __forceinline__ void xcd_barrier(const XcdBarrier& b) {
    asm volatile("s_waitcnt vmcnt(0)" ::: "memory");
    __syncthreads();
    if (threadIdx.x == 0) {
        unsigned* bar = b.bar;
        __builtin_amdgcn_s_waitcnt(0);
        unsigned nloc = b.st[0], nx = b.st[1];
        if (nloc == 0u) { xcd_barrier_complete(bar, b.x, nloc, nx); b.st[0] = nloc; b.st[1] = nx; }
        const unsigned old = xb_add(&bar[XB_XSUB(b.x)], 1u);
        const unsigned gen = old / nloc;
        if (old + 1u == (gen + 1u) * nloc) {
            __builtin_amdgcn_fence(__ATOMIC_RELEASE, "agent");
            asm volatile("s_waitcnt vmcnt(0)" ::: "memory");
            const unsigned og = xb_add(&bar[XB_TOP], 1u);
            const unsigned tg = og / nx;
            if (og + 1u == (tg + 1u) * nx) xb_add(&bar[XB_TOPGEN], 1u);
            else XB_SPIN(xb_ld(&bar[XB_TOPGEN]) == tg, bar);
            __builtin_amdgcn_fence(__ATOMIC_ACQUIRE, "agent");
            xb_add(&bar[XB_XGEN(b.x)], 1u);
            asm volatile("s_waitcnt vmcnt(0)" ::: "memory");
        } else {
            XB_SPIN(xb_ld(&bar[XB_XGEN(b.x)]) == gen, bar);
            __builtin_amdgcn_fence(__ATOMIC_ACQUIRE, "agent");
            asm volatile("s_waitcnt vmcnt(0)" ::: "memory");
        }
    }
    __syncthreads();
}

struct Args { const float* in[26]; float* out; unsigned char* ws; int ph_lo, ph_hi; };
enum { I_X = 0, I_MEM, I_EN1, I_EWIN, I_RPB, I_EWOUT, I_EN2, I_EWG, I_EWU, I_EWD, I_ON1, I_OWIN, I_WGKF, I_BGKF, I_WGKB, I_BGKB, I_GNORM, I_OWOUT, I_ON2, I_WR, I_OWG, I_OWU, I_OWD, I_MNORM, I_WMKV, I_FNORM };

struct Frame {
    LAS unsigned char* lds;
    int tid, lane, wave, G, bid;
    int gw, NGW;
    unsigned char* ws;
};

constexpr float QSCALE = 0.125f * 1.4426950408889634f;
struct CvtJob { const float* W; int K, N; bf16* WT; const float* gain; int kind; };
__device__ __forceinline__ bool cvt_map(int kind, int n0, int& drow, float& scale) {
    scale = 1.0f;
    switch (kind) {
    case 0: drow = n0; return true;
    case 1: if (n0 < 768) { drow = n0; scale = QSCALE; return true; } if (n0 < 1536) { drow = n0; return true; } if (n0 >= 2304) { drow = n0 - 768; scale = QSCALE; return true; } return false;
    case 2: if (n0 >= 1536 && n0 < 2304) { drow = n0 - 1536; return true; } return false;
    case 3: drow = (n0 >> 7) * 256 + (n0 & 127); return true;
    case 4: drow = (n0 >> 7) * 256 + 128 + (n0 & 127); return true;
    case 5: if (n0 < 768) { drow = n0; return true; } if (n0 < 1536) return false; if (n0 < 2304) { drow = n0 - 768; return true; }
            if (n0 < 2336) { drow = n0 - 512; return true; } drow = n0 - 800; scale = QSCALE; return true;
    case 6: if (n0 >= 768 && n0 < 1536) { drow = n0 - 768; return true; } return false;
    default: drow = n0; return true;
    }
}
struct CvtRegs { f32x4 v[8]; const float* gain; bf16* WT; int K, k0, drow, valid; float scale; };
__device__ __forceinline__ void cvt_load(CvtRegs& R, const CvtJob& J, int item, int lane) {
    const int nblk = J.N / 32, kb = item / nblk, nb = item % nblk, n0 = nb * 32;
    R.k0 = kb * 64; R.gain = J.gain; R.WT = J.WT; R.K = J.K;
    R.valid = cvt_map(J.kind, n0, R.drow, R.scale) ? 1 : 0;
    if (R.valid) { const float* p = J.W + (size_t)(R.k0 + 2 * (lane >> 3)) * J.N + n0 + 4 * (lane & 7);
#pragma unroll
        for (int j = 0; j < 8; ++j) R.v[j] = *(const f32x4*)(p + (size_t)(16 * (j >> 1) + (j & 1)) * J.N); }
}
__device__ __forceinline__ void cvt_finish(const CvtRegs& R, LAS unsigned* T, int lane) {
    if (!R.valid) return;
    const int nq = lane & 7, kr = lane >> 3;
#pragma unroll
    for (int p = 0; p < 4; ++p) { const int k = R.k0 + 16 * p + 2 * kr; float g0 = R.scale, g1 = R.scale; if (R.gain) { g0 *= R.gain[k]; g1 *= R.gain[k + 1]; }
        const f32x4 a = R.v[2 * p], b = R.v[2 * p + 1]; LAS unsigned* t = T + (4 * nq) * 33 + 8 * p + kr;
        t[0] = pk2(a.x * g0, b.x * g1); t[33] = pk2(a.y * g0, b.y * g1); t[66] = pk2(a.z * g0, b.z * g1); t[99] = pk2(a.w * g0, b.w * g1); }
    LDS_WAIT(); asm volatile("" ::: "memory");
#pragma unroll
    for (int r = 0; r < 4; ++r) { const int n = (lane >> 3) + 8 * r, c = lane & 7; const LAS unsigned* sp = T + n * 33 + 4 * c;
        v4u o; o.x = sp[0]; o.y = sp[1]; o.z = sp[2]; o.w = sp[3];
        *(GAS v4u*)(R.WT + (size_t)(R.drow + n) * R.K + R.k0 + 8 * c) = o; }
    LDS_WAIT(); asm volatile("" ::: "memory");
}
__device__ __forceinline__ void rows_to_bf16(const float* X, bf16* Ob, float* rstd, int first, int nrows, int stride, int lane) {
    for (int m = first; m < nrows; m += 2 * stride) {
        const int m2 = m + stride; const bool h2 = m2 < nrows;
        const GAS f32x4* xa = (const GAS f32x4*)(X + (size_t)m * DM) + lane; const GAS f32x4* xb = (const GAS f32x4*)(X + (size_t)(h2 ? m2 : m) * DM) + lane;
        f32x4 va[4], vb[4];
#pragma unroll
        for (int j = 0; j < 4; ++j) va[j] = xa[64 * j];
#pragma unroll
        for (int j = 0; j < 4; ++j) vb[j] = xb[64 * j];
        float sa = 0.f, sb = 0.f;
#pragma unroll
        for (int j = 0; j < 4; ++j) { sa += (va[j].x * va[j].x + va[j].y * va[j].y) + (va[j].z * va[j].z + va[j].w * va[j].w); sb += (vb[j].x * vb[j].x + vb[j].y * vb[j].y) + (vb[j].z * vb[j].z + vb[j].w * vb[j].w); }
        sa = wave_sum(sa); sb = wave_sum(sb);
        GAS unsigned long long* oa = (GAS unsigned long long*)(Ob + (size_t)m * DM) + lane;
#pragma unroll
        for (int j = 0; j < 4; ++j) oa[64 * j] = (unsigned long long)pk2(va[j].x, va[j].y) | ((unsigned long long)pk2(va[j].z, va[j].w) << 32);
        if (lane == 0) rstd[m] = __builtin_amdgcn_rsqf(sa * (1.0f / DM) + EPS);
        if (h2) { GAS unsigned long long* ob = (GAS unsigned long long*)(Ob + (size_t)m2 * DM) + lane;
#pragma unroll
            for (int j = 0; j < 4; ++j) ob[64 * j] = (unsigned long long)pk2(vb[j].x, vb[j].y) | ((unsigned long long)pk2(vb[j].z, vb[j].w) << 32);
            if (lane == 0) rstd[m2] = __builtin_amdgcn_rsqf(sb * (1.0f / DM) + EPS); }
    }
}

struct Unit { int pm, pn; };
struct Sched {
    int nM, nN, nwg, G, c, K, off0, off1, per;
    const char* A; const char* B; const int* bexp; size_t estride;
    __device__ void init(const void* A_, const void* B_, int K_, int nM_, int nN_, int G_, int c_, const int* bexp_ = nullptr, size_t estride_ = 0) {
        A = (const char*)A_; B = (const char*)B_; K = K_; nM = nM_; nN = nN_; nwg = nM * nN; G = G_; c = c_; bexp = bexp_; estride = estride_; off0 = 0; off1 = 0x7fffffff; per = G_ / 8; }
    __device__ void range(int off0_, int off1_, int per_) { off0 = off0_; off1 = off1_; per = per_; }
    __device__ bool next(int i, Unit& u) const {
        const int q = nwg / 8, r = nwg % 8, xcd = c % 8, slot = c / 8, qx = q + (xcd < r ? 1 : 0);
        if (slot >= per) return false;
        const int off = off0 + i * per + slot, lim = off1 < qx ? off1 : qx;
        if (off >= lim) return false;
        const int wgid = (xcd < r ? xcd * (q + 1) : r * (q + 1) + (xcd - r) * q) + off;
        const int nig = 8 * nN, gid = wgid / nig, fm = gid * 8, gsz = (nM - fm) < 8 ? (nM - fm) : 8;
        u.pm = fm + ((wgid % nig) % gsz); u.pn = (wgid % nig) / gsz; return true;
    }
    __device__ const char* a_base(const Unit& u) const { return A + (size_t)u.pm * 512 * K; }
    __device__ const char* b_base(const Unit& u) const { return B + (bexp ? (size_t)bexp[u.pm] * estride : (size_t)0) + (size_t)u.pn * 512 * K; }
};

struct NoAux {};
__device__ __forceinline__ float rstd_from(const float* rss16) {
    const f32x4* p = (const f32x4*)rss16; f32x4 a = p[0], b = p[1], c = p[2], d = p[3];
    const float s = ((a.x + a.y) + (a.z + a.w)) + ((b.x + b.y) + (b.z + b.w)) + ((c.x + c.y) + (c.z + c.w)) + ((d.x + d.y) + (d.z + d.w));
    return __builtin_amdgcn_rsqf(s * (1.0f / DM) + EPS);
}
struct RowCtx { float rs[2][4]; };
struct EpiRowScale {
    static constexpr bool NEED_SS = false; static constexpr int SC_MODE = 1; typedef RowCtx Ctx; typedef NoAux Aux;
    bf16* O; int ldc; const float* sc_src;
    __device__ __forceinline__ void begin(Ctx& c, const LAS float* sc, const LAS int*, int lr0, int, int, int) const {
#pragma unroll
        for (int ai = 0; ai < 2; ++ai)
#pragma unroll
            for (int m = 0; m < 4; ++m) c.rs[ai][m] = sc[ai * 128 + lr0 + m * 16];
    }
    __device__ __forceinline__ void load_aux(Aux&, const Ctx&, int, int, int, int, int) const {}
    __device__ __forceinline__ float apply(const Ctx& c, const Aux&, int ai, int m, int row, int pn, int c128, const float (&a)[8], const float (&b)[8]) const {
        const float s = c.rs[ai][m];
        bf16* p = O + (size_t)row * ldc + pn * 256 + c128;
        v4u w; w.x = pk2(a[0] * s, a[1] * s); w.y = pk2(a[2] * s, a[3] * s); w.z = pk2(a[4] * s, a[5] * s); w.w = pk2(a[6] * s, a[7] * s); *(v4u*)p = w;
        w.x = pk2(b[0] * s, b[1] * s); w.y = pk2(b[2] * s, b[3] * s); w.z = pk2(b[4] * s, b[5] * s); w.w = pk2(b[6] * s, b[7] * s); *(v4u*)(p + 128) = w;
        return 0.f;
    }
    __device__ __forceinline__ void row_done(int, int, int, float) const {}
};
struct ColCtx { float sa[8], sb[8]; };
struct EpiColScale {
    static constexpr bool NEED_SS = false; static constexpr int SC_MODE = 2; typedef ColCtx Ctx; typedef NoAux Aux;
    bf16* O; int ldc; const float* sc_src;
    __device__ __forceinline__ void begin(Ctx& c, const LAS float* sc, const LAS int*, int, int, int, int c128) const {
#pragma unroll
        for (int j = 0; j < 8; ++j) { c.sa[j] = sc[c128 + j]; c.sb[j] = sc[128 + c128 + j]; }
    }
    __device__ __forceinline__ void load_aux(Aux&, const Ctx&, int, int, int, int, int) const {}
    __device__ __forceinline__ float apply(const Ctx& c, const Aux&, int, int, int row, int pn, int c128, const float (&a)[8], const float (&b)[8]) const {
        bf16* p = O + (size_t)row * ldc + pn * 256 + c128;
        v4u w; w.x = pk2(a[0] * c.sa[0], a[1] * c.sa[1]); w.y = pk2(a[2] * c.sa[2], a[3] * c.sa[3]); w.z = pk2(a[4] * c.sa[4], a[5] * c.sa[5]); w.w = pk2(a[6] * c.sa[6], a[7] * c.sa[7]); *(v4u*)p = w;
        w.x = pk2(b[0] * c.sb[0], b[1] * c.sb[1]); w.y = pk2(b[2] * c.sb[2], b[3] * c.sb[3]); w.z = pk2(b[4] * c.sb[4], b[5] * c.sb[5]); w.w = pk2(b[6] * c.sb[6], b[7] * c.sb[7]); *(v4u*)(p + 128) = w;
        return 0.f;
    }
    __device__ __forceinline__ void row_done(int, int, int, float) const {}
};
struct Aux4 { f32x4 v[4]; };
struct NoCtx {};
struct EpiResid {
    static constexpr bool NEED_SS = true; static constexpr int SC_MODE = 0; typedef NoCtx Ctx; typedef Aux4 Aux;
    const float* R; float* H; bf16* HB; float* rss;
    __device__ __forceinline__ void begin(Ctx&, const LAS float*, const LAS int*, int, int, int, int) const {}
    __device__ __forceinline__ void load_aux(Aux& x, const Ctx&, int, int, int row, int pn, int c128) const {
        const float* p = R + (size_t)row * DM + pn * 256 + c128;
        x.v[0] = *(const f32x4*)p; x.v[1] = *(const f32x4*)(p + 4); x.v[2] = *(const f32x4*)(p + 128); x.v[3] = *(const f32x4*)(p + 132);
    }
    __device__ __forceinline__ float apply(const Ctx&, const Aux& x, int, int, int row, int pn, int c128, const float (&a)[8], const float (&b)[8]) const {
        const size_t off = (size_t)row * DM + pn * 256 + c128;
        const f32x4 h0 = {x.v[0].x + a[0], x.v[0].y + a[1], x.v[0].z + a[2], x.v[0].w + a[3]}, h1 = {x.v[1].x + a[4], x.v[1].y + a[5], x.v[1].z + a[6], x.v[1].w + a[7]};
        const f32x4 h2 = {x.v[2].x + b[0], x.v[2].y + b[1], x.v[2].z + b[2], x.v[2].w + b[3]}, h3 = {x.v[3].x + b[4], x.v[3].y + b[5], x.v[3].z + b[6], x.v[3].w + b[7]};
        *(f32x4*)(H + off) = h0; *(f32x4*)(H + off + 4) = h1; *(f32x4*)(H + off + 128) = h2; *(f32x4*)(H + off + 132) = h3;
        v4u w; w.x = pk2(h0.x, h0.y); w.y = pk2(h0.z, h0.w); w.z = pk2(h1.x, h1.y); w.w = pk2(h1.z, h1.w); *(v4u*)(HB + off) = w;
        w.x = pk2(h2.x, h2.y); w.y = pk2(h2.z, h2.w); w.z = pk2(h3.x, h3.y); w.w = pk2(h3.z, h3.w); *(v4u*)(HB + off + 128) = w;
        return ((h0.x * h0.x + h0.y * h0.y) + (h0.z * h0.z + h0.w * h0.w) + (h1.x * h1.x + h1.y * h1.y) + (h1.z * h1.z + h1.w * h1.w))
             + ((h2.x * h2.x + h2.y * h2.y) + (h2.z * h2.z + h2.w * h2.w) + (h3.x * h3.x + h3.y * h3.y) + (h3.z * h3.z + h3.w * h3.w));
    }
    __device__ __forceinline__ void row_done(int row, int pn, int wc, float ss) const { rss[(size_t)row * 16 + pn * 4 + wc] = ss; }
};
__device__ __forceinline__ float silu_mul(float g, float u) { return g * __builtin_amdgcn_rcpf(1.0f + __builtin_amdgcn_exp2f(g * -1.4426950408889634f)) * u; }
template <bool MOE> struct EpiSwiGLU {
    static constexpr bool NEED_SS = false; static constexpr int SC_MODE = MOE ? 3 : 1; typedef RowCtx Ctx; typedef NoAux Aux;
    bf16* Hm; int ldh; const float* sc_src; bf16* Hmt;
    __device__ __forceinline__ void begin(Ctx& c, const LAS float* sc, const LAS int* tl, int lr0, int, int, int) const {
#pragma unroll
        for (int ai = 0; ai < 2; ++ai)
#pragma unroll
            for (int m = 0; m < 4; ++m) { const int i = ai * 128 + lr0 + m * 16; float r = sc[i]; if (MOE) { if (tl[i] < 0) r = 0.f; } c.rs[ai][m] = r; }
    }
    __device__ __forceinline__ void load_aux(Aux&, const Ctx&, int, int, int, int, int) const {}
    __device__ __forceinline__ float apply(const Ctx& c, const Aux&, int ai, int m, int row, int pn, int c128, const float (&a)[8], const float (&b)[8]) const {
        const float s = c.rs[ai][m]; float o[8];
#pragma unroll
        for (int j = 0; j < 8; ++j) o[j] = silu_mul(a[j] * s, b[j] * s);
        v4u w; w.x = pk2(o[0], o[1]); w.y = pk2(o[2], o[3]); w.z = pk2(o[4], o[5]); w.w = pk2(o[6], o[7]);
        bf16* rp = (MOE && row >= NT) ? Hmt + (size_t)(row - NT) * ldh : Hm + (size_t)row * ldh;
        *(v4u*)(rp + pn * 128 + c128) = w;
        return 0.f;
    }
    __device__ __forceinline__ void row_done(int, int, int, float) const {}
};
struct MoeCtx { int t[2][4]; float w[2][4]; };
struct EpiMoeDown {
    static constexpr bool NEED_SS = false; static constexpr int SC_MODE = 4; typedef MoeCtx Ctx; typedef Aux4 Aux;
    float* H; const int* tok; const float* w;
    __device__ __forceinline__ void begin(Ctx& c, const LAS float* sc, const LAS int*, int lr0, int, int, int) const {
#pragma unroll
        for (int ai = 0; ai < 2; ++ai)
#pragma unroll
            for (int m = 0; m < 4; ++m) { const int i = ai * 128 + lr0 + m * 16; c.t[ai][m] = ((const LAS int*)sc)[i]; c.w[ai][m] = sc[256 + i]; }
    }
    __device__ __forceinline__ void load_aux(Aux& x, const Ctx& c, int ai, int m, int, int pn, int c128) const {
        const int t = c.t[ai][m]; const float* p = H + (size_t)(t < 0 ? 0 : t) * DM + pn * 256 + c128;
        x.v[0] = *(const f32x4*)p; x.v[1] = *(const f32x4*)(p + 4); x.v[2] = *(const f32x4*)(p + 128); x.v[3] = *(const f32x4*)(p + 132);
    }
    __device__ __forceinline__ float apply(const Ctx& c, const Aux& x, int ai, int m, int, int pn, int c128, const float (&a)[8], const float (&b)[8]) const {
        const int t = c.t[ai][m]; if (t < 0) return 0.f;
        const float s = c.w[ai][m]; float* p = H + (size_t)t * DM + pn * 256 + c128;
        f32x4 h0 = x.v[0], h1 = x.v[1], h2 = x.v[2], h3 = x.v[3];
        h0.x += s * a[0]; h0.y += s * a[1]; h0.z += s * a[2]; h0.w += s * a[3]; h1.x += s * a[4]; h1.y += s * a[5]; h1.z += s * a[6]; h1.w += s * a[7];
        h2.x += s * b[0]; h2.y += s * b[1]; h2.z += s * b[2]; h2.w += s * b[3]; h3.x += s * b[4]; h3.y += s * b[5]; h3.z += s * b[6]; h3.w += s * b[7];
        *(f32x4*)p = h0; *(f32x4*)(p + 4) = h1; *(f32x4*)(p + 128) = h2; *(f32x4*)(p + 132) = h3;
        return 0.f;
    }
    __device__ __forceinline__ void row_done(int, int, int, float) const {}
};

namespace pg8 {
constexpr int HTB = 16384, TOK_OFF = 132096, SC_OFF = 134144;
__device__ __forceinline__ int lds_byte(int r, int c) { const int st = (r >> 4) * 2 + (c >> 5), rr = r & 15, cc = c & 31, ob = rr * 64 + cc * 2; return st * 1024 + (ob ^ (((ob >> 9) & 1) << 5)); }
__device__ __forceinline__ void stage_rc(int b, int& R, int& C) { const int st = b / 1024, sb = b % 1024, swz = sb ^ (((sb >> 9) & 1) << 5); R = (st >> 1) * 16 + swz / 64; C = (st & 1) * 32 + (swz % 64) / 2; }
__device__ __forceinline__ int perm32(int rho) { const int n = rho >> 4, i = rho & 15; return 8 * (i >> 2) + 4 * n + (i & 3); }

template <class Epi>
__device__ __forceinline__ void run_epi(const Epi& E, const f32x4 (&acc)[2][2][4][2], const Unit& u, int wr, int wc, int fr, int fq, const LAS float* sc, const LAS int* tlp) {
    int row0 = u.pm * 256 + wr * 64 + fr, c128 = 32 * wc + 8 * fq;
    asm volatile("" : "+v"(row0), "+v"(c128));
    typename Epi::Ctx ctx; E.begin(ctx, sc, tlp, wr * 64 + fr, row0, u.pn, c128);
#pragma unroll
    for (int ai = 0; ai < 2; ++ai) {
        typename Epi::Aux aux[4];
#pragma unroll
        for (int m = 0; m < 4; ++m) E.load_aux(aux[m], ctx, ai, m, row0 + ai * 128 + m * 16, u.pn, c128);
#pragma unroll
        for (int m = 0; m < 4; ++m) {
            const int row = row0 + ai * 128 + m * 16;
            float a[8], b[8];
#pragma unroll
            for (int j = 0; j < 8; ++j) { a[j] = acc[ai][0][m][j >> 2][j & 3]; b[j] = acc[ai][1][m][j >> 2][j & 3]; }
            float ss = E.apply(ctx, aux[m], ai, m, row, u.pn, c128, a, b);
            if (Epi::NEED_SS) { ss += __shfl_xor(ss, 16); ss += __shfl_xor(ss, 32); if (fq == 0) E.row_done(row, u.pn, wc, ss); }
        }
    }
}

template <class Epi, bool GATHER>
__device__ __forceinline__ void gemm_fast(LAS unsigned char* lds, const Sched& S, const Epi& E, const int* gtok) {
    int tid = threadIdx.x; asm volatile("" : "+v"(tid));
    const int wid = __builtin_amdgcn_readfirstlane(tid >> 6), lane = tid & 63, wr = wid >> 2, wc = wid & 3, fr = lane & 15, fq = lane >> 4;
    const int K = S.K, nt = K / 64;
    unsigned voffB[2], vA0[2], vA1[2], nA0[2], nA1[2]; int RA[2], CA2[2];
#pragma unroll
    for (int i = 0; i < 2; ++i) { int R, C; stage_rc(tid * 16 + i * 8192, R, C); const int Rb = (R & ~31) + perm32(R & 31);
        voffB[i] = (unsigned)(Rb * K + C) * 2u; RA[i] = R; CA2[i] = C * 2; vA0[i] = (unsigned)(R * K + C) * 2u; vA1[i] = vA0[i] + (unsigned)(128 * K * 2); nA0[i] = vA0[i]; nA1[i] = vA1[i]; }
    const size_t kstep = 128;
    const size_t hstep = (size_t)128 * K * 2;
    const unsigned ldsw = (unsigned)wid * 1024u;
    const int aoff = lds_byte(wr * 64 + fr, fq * 8), boff = lds_byte(wc * 32 + fr, fq * 8);
    LAS int* tl = (LAS int*)(lds + TOK_OFF);
#define PG8_SA(b, h) (((b) * 2 + (h)) * HTB)
#define PG8_SB(b, h) ((4 + (b) * 2 + (h)) * HTB)
#define PG8_STAGE(bufoff, gbase, voff) do { _Pragma("unroll") for (int _i = 0; _i < 2; ++_i) \
        __builtin_amdgcn_global_load_lds((const unsigned*)((const char*)(gbase) + (voff)[_i]), (LAS unsigned*)(lds + (bufoff) + ldsw + _i * 8192), 16, 0, 0); } while (0)
#define PG8_LDA(dst, b, h) do { _Pragma("unroll") for (int m = 0; m < 4; ++m) _Pragma("unroll") for (int k = 0; k < 2; ++k) dst[m][k] = *(const LAS bf16x8*)(lds + PG8_SA(b, h) + aoff + m * 2048 + k * 1024); } while (0)
#define PG8_LDB(dst, b, h) do { _Pragma("unroll") for (int n = 0; n < 2; ++n) _Pragma("unroll") for (int k = 0; k < 2; ++k) dst[n][k] = *(const LAS bf16x8*)(lds + PG8_SB(b, h) + boff + n * 2048 + k * 1024); } while (0)
#define PG8_MMA(ai, bj, At, Bt) do { __builtin_amdgcn_s_setprio(1); _Pragma("unroll") for (int m = 0; m < 4; ++m) _Pragma("unroll") for (int n = 0; n < 2; ++n) _Pragma("unroll") for (int k = 0; k < 2; ++k) \
        acc[ai][bj][m][n] = __builtin_amdgcn_mfma_f32_16x16x32_bf16(Bt[n][k], At[m][k], acc[ai][bj][m][n], 0, 0, 0); __builtin_amdgcn_s_setprio(0); } while (0)
#define PG8_WAIT_V(n) asm volatile("s_waitcnt vmcnt(" #n ")" ::: "memory")
#define PG8_WAIT_L(n) asm volatile("s_waitcnt lgkmcnt(" #n ")" ::: "memory")
#define PG8_BAR __builtin_amdgcn_s_barrier()
#define PG8_SCHED __builtin_amdgcn_sched_barrier(0)
#define PG8_IDS_DMA(pm_, par_) do { if (wid < 4) __builtin_amdgcn_global_load_lds((const unsigned*)(gtok + (pm_) * 256 + wid * 64 + lane), (LAS unsigned*)(lds + TOK_OFF + (par_) * 1024 + wid * 256), 4, 0, 0); } while (0)
#define PG8_IDS_READ(d0, d1, par_) do { _Pragma("unroll") for (int _i = 0; _i < 2; ++_i) { int t0 = tl[(par_) * 256 + RA[_i]], t1 = tl[(par_) * 256 + 128 + RA[_i]]; t0 = t0 < 0 ? 0 : t0; t1 = t1 < 0 ? 0 : t1; \
        d0[_i] = (unsigned)t0 * (unsigned)(K * 2) + (unsigned)CA2[_i]; d1[_i] = (unsigned)t1 * (unsigned)(K * 2) + (unsigned)CA2[_i]; } } while (0)
    Unit cur, nxt; int ui = 0, par = 0;
    if (!S.next(0, cur)) return;
    f32x4 acc[2][2][4][2];
#pragma unroll
    for (int a = 0; a < 2; ++a)
#pragma unroll
        for (int b = 0; b < 2; ++b)
#pragma unroll
            for (int m = 0; m < 4; ++m)
#pragma unroll
                for (int n = 0; n < 2; ++n) acc[a][b][m][n] = (f32x4){0.f, 0.f, 0.f, 0.f};
    bf16x8 At[4][2], B0[2][2], B1[2][2];
    const char* cA = GATHER ? S.A : S.a_base(cur); const char* cB = S.b_base(cur);
    if constexpr (GATHER) { PG8_IDS_DMA(cur.pm, 0); PG8_WAIT_V(0); __syncthreads(); PG8_IDS_READ(vA0, vA1, 0); }
    PG8_STAGE(PG8_SB(0, 0), cB, voffB); PG8_STAGE(PG8_SB(0, 1), cB + hstep, voffB); PG8_STAGE(PG8_SA(0, 0), cA, vA0); PG8_STAGE(PG8_SA(0, 1), cA, vA1);
    if (wr == 1) PG8_BAR;
    PG8_WAIT_V(2); PG8_BAR;
    PG8_STAGE(PG8_SB(1, 0), cB + kstep, voffB); PG8_STAGE(PG8_SA(1, 0), cA + kstep, vA0); PG8_STAGE(PG8_SB(1, 1), cB + hstep + kstep, voffB);
    PG8_WAIT_V(6); PG8_BAR;
    for (;;) {
        const bool has_next = S.next(ui + 1, nxt);
        const char* nA = has_next ? (GATHER ? S.A : S.a_base(nxt)) : cA; const char* nB = has_next ? S.b_base(nxt) : cB;
        for (int t = 0; t < nt; t += 2) {
            const bool last = (t == nt - 2);
            if constexpr (GATHER) {
                if (t == nt - 4 && has_next) PG8_IDS_DMA(nxt.pm, par ^ 1);
                if (last) { if (has_next) PG8_IDS_READ(nA0, nA1, par ^ 1); else { nA0[0] = vA0[0]; nA0[1] = vA0[1]; nA1[0] = vA1[0]; nA1[1] = vA1[1]; } }
            }
            if constexpr (Epi::SC_MODE != 0) {
                if (last && wid < 4) { const int i_ = wid * 64 + lane; LAS unsigned* d_ = (LAS unsigned*)(lds + SC_OFF + wid * 256);
                    if constexpr (Epi::SC_MODE == 1) __builtin_amdgcn_global_load_lds((const unsigned*)(E.sc_src + cur.pm * 256 + i_), d_, 4, 0, 0);
                    if constexpr (Epi::SC_MODE == 2) __builtin_amdgcn_global_load_lds((const unsigned*)(E.sc_src + cur.pn * 256 + i_), d_, 4, 0, 0);
                    if constexpr (Epi::SC_MODE == 3) { int t_ = tl[par * 256 + i_]; t_ = t_ < 0 ? 0 : t_; __builtin_amdgcn_global_load_lds((const unsigned*)(E.sc_src + t_), d_, 4, 0, 0); }
                    if constexpr (Epi::SC_MODE == 4) { __builtin_amdgcn_global_load_lds((const unsigned*)(E.tok + cur.pm * 256 + i_), d_, 4, 0, 0);
                        __builtin_amdgcn_global_load_lds((const unsigned*)(E.w + cur.pm * 256 + i_), (LAS unsigned*)(lds + SC_OFF + 1024 + wid * 256), 4, 0, 0); } }
            }
            const char* a1 = cA + (size_t)(t + 1) * kstep;
            const char* a2 = last ? nA : cA + (size_t)(t + 2) * kstep; const char* b2 = last ? nB : cB + (size_t)(t + 2) * kstep;
            const char* a3 = a2 + kstep; const char* b3 = b2 + kstep;
            unsigned w0[2], w1[2];
            if (GATHER && last) { w0[0] = nA0[0]; w0[1] = nA0[1]; w1[0] = nA1[0]; w1[1] = nA1[1]; } else { w0[0] = vA0[0]; w0[1] = vA0[1]; w1[0] = vA1[0]; w1[1] = vA1[1]; }
            PG8_LDB(B0, 0, 0); PG8_LDB(B1, 0, 1); PG8_SCHED; PG8_LDA(At, 0, 0); PG8_STAGE(PG8_SA(1, 1), a1, vA1);
            PG8_WAIT_V(8); PG8_WAIT_L(0); PG8_BAR; PG8_MMA(0, 0, At, B0); PG8_MMA(0, 1, At, B1); PG8_BAR; PG8_SCHED;
            PG8_LDA(At, 0, 1); PG8_STAGE(PG8_SB(0, 0), b2, voffB); PG8_STAGE(PG8_SB(0, 1), b2 + hstep, voffB); PG8_STAGE(PG8_SA(0, 0), a2, w0);
            PG8_WAIT_V(8); PG8_WAIT_L(0); PG8_BAR; PG8_MMA(1, 0, At, B0); PG8_MMA(1, 1, At, B1); PG8_BAR; PG8_SCHED;
            PG8_LDB(B0, 1, 0); PG8_LDB(B1, 1, 1); PG8_SCHED; PG8_LDA(At, 1, 0); PG8_STAGE(PG8_SA(0, 1), a2, w1);
            PG8_WAIT_V(8); PG8_WAIT_L(0); PG8_BAR; PG8_MMA(0, 0, At, B0); PG8_MMA(0, 1, At, B1); PG8_BAR; PG8_SCHED;
            PG8_LDA(At, 1, 1); PG8_STAGE(PG8_SB(1, 0), b3, voffB); PG8_STAGE(PG8_SB(1, 1), b3 + hstep, voffB); PG8_STAGE(PG8_SA(1, 0), a3, w0);
            PG8_WAIT_V(8); PG8_WAIT_L(0); PG8_BAR; PG8_MMA(1, 0, At, B0); PG8_MMA(1, 1, At, B1); PG8_BAR; PG8_SCHED;
        }
        if (wr == 0) PG8_BAR;
        run_epi(E, acc, cur, wr, wc, fr, fq, (const LAS float*)(lds + SC_OFF), (const LAS int*)(lds + TOK_OFF + par * 1024));
        if (!has_next) break;
#pragma unroll
        for (int a = 0; a < 2; ++a)
#pragma unroll
            for (int b = 0; b < 2; ++b)
#pragma unroll
                for (int m = 0; m < 4; ++m)
#pragma unroll
                    for (int n = 0; n < 2; ++n) acc[a][b][m][n] = (f32x4){0.f, 0.f, 0.f, 0.f};
        cur = nxt; cA = nA; cB = nB; ++ui;
        if constexpr (GATHER) { vA0[0] = nA0[0]; vA0[1] = nA0[1]; vA1[0] = nA1[0]; vA1[1] = nA1[1]; par ^= 1; }
        if (wr == 1) PG8_BAR;
    }
    PG8_WAIT_V(0);
    PG8_BAR;
#undef PG8_SA
#undef PG8_SB
#undef PG8_STAGE
#undef PG8_LDA
#undef PG8_LDB
#undef PG8_MMA
#undef PG8_WAIT_V
#undef PG8_WAIT_L
#undef PG8_BAR
#undef PG8_SCHED
#undef PG8_IDS_DMA
#undef PG8_IDS_READ
}
}

template <class Epi, bool GATHER>
__device__ __forceinline__ void gemm_run(LAS unsigned char* lds, const Sched& S, const Epi& E, const int* gtok) { pg8::gemm_fast<Epi, GATHER>(lds, S, E, gtok); }

__device__ __forceinline__ void na_simple(const Frame& F, const bf16* act0, const bf16* v0t, const float* rpb, bf16* mix) {
    for (int it = F.gw; it < NT * 12; it += F.NGW) {
        const int token = it / 12, h = it % 12, lane = F.lane;
        const int b = token >> 12, p = token & 4095, r = p >> 6, c = p & 63;
        const int r0 = min(max(r - 4, 0), 56), cs = min(max(c - 8, 0), 48);
        const float q = bf2f(act0[(size_t)token * A0_LD + h * 64 + lane]);
        float m = -INFINITY, l = 0.f, o = 0.f;
        for (int a = 0; a < 8; ++a)
            for (int u = 0; u < 16; ++u) {
                const int kt = b * SEQ + (r0 + a) * 64 + cs + u;
                const float kv = bf2f(act0[(size_t)kt * A0_LD + 768 + h * 64 + lane]);
                const float sc = wave_sum(q * kv) + rpb[h * 465 + (r0 + a - r + 7) * 31 + (cs + u - c + 15)];
                const float mn = fmaxf(m, sc), corr = __expf(m - mn), pe = __expf(sc - mn);
                const float vv = bf2f(v0t[(size_t)(h * 64 + lane) * NT + kt]);
                l = l * corr + pe; o = o * corr + pe * vv; m = mn;
            }
        mix[(size_t)token * DM + h * 64 + lane] = (bf16)f2bf(o / l);
    }
}
__device__ __forceinline__ void memattn_simple(const Frame& F, int first, int stride, const bf16* act, int ld, int qoff, const bf16* memk, const bf16* memvt, bf16* mix) {
    for (int it = first; it < NT * 4; it += stride) {
        const int token = it >> 2, h = it & 3, lane = F.lane, b = token >> 12;
        const float q = bf2f(act[(size_t)token * ld + qoff + h * 64 + lane]);
        float m = -INFINITY, l = 0.f, o = 0.f;
        for (int j = 0; j < 256; ++j) {
            const float kv = bf2f(memk[(size_t)(b * 256 + j) * 256 + h * 64 + lane]);
            const float sc = wave_sum(q * kv);
            const float mn = fmaxf(m, sc), corr = __expf(m - mn), pe = __expf(sc - mn);
            const float vv = bf2f(memvt[(size_t)(h * 64 + lane) * MEM_ROWS + b * 256 + j]);
            l = l * corr + pe; o = o * corr + pe * vv; m = mn;
        }
        mix[(size_t)token * DM + 768 + h * 64 + lane] = (bf16)f2bf(o / l);
    }
}

typedef short s16x4 __attribute__((ext_vector_type(4)));
template <bool NA>
__device__ __forceinline__ void attn16(int lane, const bf16* Q, int ldq, const bf16* Kb, int ldk, const bf16* Vt, int ldv, int ktok0, int trs, bf16* O, int ldo,
                                       const LAS float* rpb_h, int r, int r0, int jb, int band0) {
    const int qi = lane & 15, g = lane >> 4;
    bf16x8 qf[2];
#pragma unroll
    for (int ks = 0; ks < 2; ++ks) qf[ks] = *(const bf16x8*)(Q + (size_t)qi * ldq + ks * 32 + 8 * g);
    f32x4 s[16];
    const int krow = 8 * (qi >> 2) + (qi & 3);
#pragma unroll
    for (int t = 0; t < 16; ++t) {
        const bf16* kp = Kb + (size_t)(ktok0 + (t >> 1) * trs + krow + 4 * (t & 1)) * ldk + 8 * g;
        const bf16x8 k0 = *(const bf16x8*)kp, k1 = *(const bf16x8*)(kp + 32);
        f32x4 z = {0.f, 0.f, 0.f, 0.f};
        z = __builtin_amdgcn_mfma_f32_16x16x32_bf16(k0, qf[0], z, 0, 0, 0);
        z = __builtin_amdgcn_mfma_f32_16x16x32_bf16(k1, qf[1], z, 0, 0, 0);
        s[t] = z;
    }
    bf16x8 vfa[4][8];
#pragma unroll
    for (int mt = 0; mt < 4; ++mt)
#pragma unroll
        for (int kk = 0; kk < 8; ++kk) vfa[mt][kk] = *(const bf16x8*)(Vt + (size_t)(16 * mt + qi) * ldv + ktok0 + kk * trs + 8 * g);
    __builtin_amdgcn_sched_barrier(0);
    float m = -INFINITY;
    if constexpr (NA) {
        const int qc = 16 * jb + qi, cs = min(max(qc - 8, 0), 48);
        const LAS float* bp = rpb_h + (r0 - r + 7) * 31 + (band0 + 8 * g - qc + 15);
        bool ok[2][4];
#pragma unroll
        for (int hh = 0; hh < 2; ++hh)
#pragma unroll
            for (int i = 0; i < 4; ++i) { const int kc = band0 + 8 * g + 4 * hh + i; ok[hh][i] = (kc >= cs) && (kc < cs + 16); }
#pragma unroll
        for (int t = 0; t < 16; ++t)
#pragma unroll
            for (int i = 0; i < 4; ++i) {
                const float bv = bp[(t >> 1) * 31 + 4 * (t & 1) + i];
                const float v = ok[t & 1][i] ? s[t][i] + bv : -INFINITY;
                s[t][i] = v; m = fmaxf(m, v);
            }
    } else {
#pragma unroll
        for (int t = 0; t < 16; ++t)
#pragma unroll
            for (int i = 0; i < 4; ++i) m = fmaxf(m, s[t][i]);
    }
    m = fmaxf(m, __shfl_xor(m, 16)); m = fmaxf(m, __shfl_xor(m, 32));
    float l = 0.f;
    bf16x8 pf[8];
#pragma unroll
    for (int kk = 0; kk < 8; ++kk) {
        float p[8];
#pragma unroll
        for (int i = 0; i < 4; ++i) { p[i] = __builtin_amdgcn_exp2f(s[2 * kk][i] - m); p[4 + i] = __builtin_amdgcn_exp2f(s[2 * kk + 1][i] - m); }
#pragma unroll
        for (int i = 0; i < 8; ++i) l += p[i];
        v4u w; w.x = pk2(p[0], p[1]); w.y = pk2(p[2], p[3]); w.z = pk2(p[4], p[5]); w.w = pk2(p[6], p[7]);
        pf[kk] = __builtin_bit_cast(bf16x8, w);
    }
    l += __shfl_xor(l, 16); l += __shfl_xor(l, 32);
    const float inv = __builtin_amdgcn_rcpf(l);
#pragma unroll
    for (int mt = 0; mt < 4; ++mt) {
        f32x4 acc = {0.f, 0.f, 0.f, 0.f};
#pragma unroll
        for (int kk = 0; kk < 8; ++kk) {
            acc = __builtin_amdgcn_mfma_f32_16x16x32_bf16(vfa[mt][kk], pf[kk], acc, 0, 0, 0);
        }
        v2u w; w.x = pk2(acc[0] * inv, acc[1] * inv); w.y = pk2(acc[2] * inv, acc[3] * inv);
        *(v2u*)(O + (size_t)qi * ldo + 16 * mt + 4 * g) = w;
    }
}
__device__ __forceinline__ void memattn_item(int it, int lane, const bf16* act, int ld, int qoff, const bf16* memk, const bf16* memvt, bf16* mix) {
    const int tb = it >> 2, h = it & 3, tok0 = tb * 16, b = tok0 >> 12;
    attn16<false>(lane, act + (size_t)tok0 * ld + qoff + h * 64, ld, memk + h * 64, 256, memvt + (size_t)(h * 64) * MEM_ROWS, MEM_ROWS, b * 256, 32,
                  mix + (size_t)tok0 * DM + 768 + h * 64, DM, nullptr, 0, 0, 0, 0);
}
__device__ __forceinline__ void na_item(int it, int lane, const bf16* act0, const bf16* v0t, const LAS float* rpb, bf16* mix) {
    const int jb = it & 3, h = (it >> 2) % 12, br = (it >> 2) / 12, r = br & 63, b = br >> 6;
    const int r0 = min(max(r - 4, 0), 56), band0 = min(max(jb * 16 - 8, 0), 32);
    const int tok0 = b * SEQ + r * 64 + jb * 16;
    attn16<true>(lane, act0 + (size_t)tok0 * A0_LD + h * 64, A0_LD, act0 + 768 + h * 64, A0_LD, v0t + (size_t)(h * 64) * NT, NT, b * SEQ + r0 * 64 + band0, 64,
                 mix + (size_t)tok0 * DM + h * 64, DM, rpb + h * 465, r, r0, jb, band0);
}

__device__ __forceinline__ float logsigmoid(float x) { return fminf(x, 0.f) - log1pf(__expf(-fabsf(x))); }
__device__ __forceinline__ void gla_simple(const Frame& F, int item, const bf16* act1, const bf16* v1t, const float* wgk, const float* bgk, bf16* O) {
    const int b = item >> 3, h = (item >> 1) & 3, dir = item & 1, tid = F.tid;
    LAS float* sh = (LAS float*)F.lds;
    float S[96];
#pragma unroll
    for (int d = 0; d < 96; ++d) S[d] = 0.f;
    float wcol[16], bias = 0.f;
    if (tid < 96) {
#pragma unroll
        for (int r = 0; r < 16; ++r) wcol[r] = wgk[r * 384 + h * 96 + tid];
        bias = bgk[h * 96 + tid];
    }
    for (int tau = 0; tau < SEQ; ++tau) {
        const int token = b * SEQ + (dir ? (SEQ - 1 - tau) : tau);
        LAS float* cur = sh + (tau & 1) * 288;
        if (tid < 96) {
            const bf16* row = act1 + (size_t)token * A1_LD;
            float z = bias;
#pragma unroll
            for (int r = 0; r < 16; ++r) z += bf2f(row[1792 + dir * 16 + r]) * wcol[r];
            cur[tid] = __expf(logsigmoid(z) * (1.0f / 16.0f));
            cur[96 + tid] = bf2f(row[h * 96 + tid]) * 0.10206207261596575f;
            cur[192 + tid] = bf2f(row[384 + h * 96 + tid]);
        }
        __syncthreads();
        if (tid < 192) {
            const float v = bf2f(v1t[(size_t)(h * 192 + tid) * NT + token]);
            float o = 0.f;
            if (dir == 0) {
#pragma unroll
                for (int d = 0; d < 96; ++d) { S[d] = cur[d] * S[d] + cur[192 + d] * v; o += cur[96 + d] * S[d]; }
            } else {
#pragma unroll
                for (int d = 0; d < 96; ++d) { S[d] = cur[d] * S[d]; o += cur[96 + d] * S[d]; S[d] += cur[192 + d] * v; }
            }
            O[(size_t)token * 768 + h * 192 + tid] = (bf16)f2bf(o);
        }
    }
    __syncthreads();
}

constexpr int GP_LD = 392;
__device__ __forceinline__ void gla_pre_item(const Frame& F, int item, const bf16* act1, const float* W, const float* Bi, bf16* QT, bf16* KT, bf16* KDT, float* DEC) {
    const int n = item & 63, dir = (item >> 6) & 1, b = item >> 7, base = b * SEQ + n * 64;
    const int tid = F.tid, lane = F.lane, wave = F.wave, qi = lane & 15, g = lane >> 4;
    LAS bf16* EL = (LAS bf16*)F.lds; LAS bf16* KDL = EL + 64 * GP_LD;
    {   bf16x8 zf[4];
#pragma unroll
        for (int ct = 0; ct < 4; ++ct) { const int c = 16 * ct + qi, tok = dir ? base + 63 - c : base + c;
            bf16x8 z = {0, 0, 0, 0, 0, 0, 0, 0}; if (g < 2) z = *(const bf16x8*)(act1 + (size_t)tok * A1_LD + 1792 + dir * 16 + 8 * g); zf[ct] = z; }
#pragma unroll 1
        for (int jj = 0; jj < 3; ++jj) {
            const int j = 16 * (wave + 8 * jj) + qi;
            v4u wu = {0u, 0u, 0u, 0u};
            if (g < 2) { const float* wp = W + (size_t)(8 * g) * 384 + j;
                wu.x = pk2(wp[0], wp[384]); wu.y = pk2(wp[768], wp[1152]); wu.z = pk2(wp[1536], wp[1920]); wu.w = pk2(wp[2304], wp[2688]); }
            const bf16x8 wfr = __builtin_bit_cast(bf16x8, wu);
            const float bias = Bi[j]; float carry = 0.f;
#pragma unroll
            for (int ct = 0; ct < 4; ++ct) {
                f32x4 d = {0.f, 0.f, 0.f, 0.f};
                d = __builtin_amdgcn_mfma_f32_16x16x32_bf16(zf[ct], wfr, d, 0, 0, 0);
                float p[4];
#pragma unroll
                for (int i = 0; i < 4; ++i) { const float x = d[i] + bias; p[i] = (fminf(x, 0.f) - __logf(1.0f + __expf(-fabsf(x)))) * 0.0625f; }
                p[1] += p[0]; p[2] += p[1]; p[3] += p[2];
                float a = p[3]; float t = __shfl_up(a, 16); if (g >= 1) a += t; t = __shfl_up(a, 32); if (g >= 2) a += t;
                const float excl = a - p[3] + carry;
                carry += __shfl(a, 48 + qi);
#pragma unroll
                for (int i = 0; i < 4; ++i) { const int c = 16 * ct + 4 * g + i, ctok = dir ? 63 - c : c; EL[ctok * GP_LD + j] = (bf16)f2bf(__expf(excl + p[i])); }
            }
        }
    }
    __syncthreads();
    const int clast = dir ? 0 : 63;
#pragma unroll 2
    for (int k = 0; k < 6; ++k) {
        const int idx = tid + 512 * k, c = idx / 48, jg = idx % 48;
        const bf16* arow = act1 + (size_t)(base + c) * A1_LD + 8 * jg;
        const v4u q8 = *(const v4u*)arow, k8 = *(const v4u*)(arow + 384);
        const v4u e8 = *(const LAS v4u*)(EL + c * GP_LD + 8 * jg), l8 = *(const LAS v4u*)(EL + clast * GP_LD + 8 * jg);
        const unsigned qa[4] = {q8.x, q8.y, q8.z, q8.w}, ka[4] = {k8.x, k8.y, k8.z, k8.w}, ea[4] = {e8.x, e8.y, e8.z, e8.w}, la[4] = {l8.x, l8.y, l8.z, l8.w};
        unsigned qo[4], ko[4], dq[4];
        float lf[8];
#pragma unroll
        for (int i = 0; i < 4; ++i) {
            const float e0 = bflo(ea[i]), e1 = bfhi(ea[i]), i0 = __builtin_amdgcn_rcpf(e0), i1 = __builtin_amdgcn_rcpf(e1);
            const float kt0 = bflo(ka[i]) * i0, kt1 = bfhi(ka[i]) * i1; lf[2 * i] = bflo(la[i]); lf[2 * i + 1] = bfhi(la[i]);
            qo[i] = pk2(bflo(qa[i]) * 0.10206207261596575f * e0, bfhi(qa[i]) * 0.10206207261596575f * e1);
            ko[i] = pk2(kt0, kt1); dq[i] = pk2(kt0 * lf[2 * i], kt1 * lf[2 * i + 1]);
        }
        v4u w; w.x = qo[0]; w.y = qo[1]; w.z = qo[2]; w.w = qo[3]; *(v4u*)(QT + (size_t)(base + c) * 384 + 8 * jg) = w;
        w.x = ko[0]; w.y = ko[1]; w.z = ko[2]; w.w = ko[3]; *(v4u*)(KT + (size_t)(base + c) * 384 + 8 * jg) = w;
        w.x = dq[0]; w.y = dq[1]; w.z = dq[2]; w.w = dq[3]; *(LAS v4u*)(KDL + c * GP_LD + 8 * jg) = w;
        if (c == clast) { float* dp = DEC + (size_t)((b * 4 + jg / 12) * 64 + n) * 96 + (jg % 12) * 8;
            *(f32x4*)dp = (f32x4){lf[0], lf[1], lf[2], lf[3]}; *(f32x4*)(dp + 4) = (f32x4){lf[4], lf[5], lf[6], lf[7]}; }
    }
    __syncthreads();
#pragma unroll 2
    for (int k = 0; k < 6; ++k) {
        const int idx = tid + 512 * k, j = idx % 384, cg = idx / 384, h = j / 96, d = j % 96;
        const LAS bf16* sp = KDL + (8 * cg) * GP_LD + j;
        v4u w; w.x = (unsigned)sp[0] | ((unsigned)sp[GP_LD] << 16); w.y = (unsigned)sp[2 * GP_LD] | ((unsigned)sp[3 * GP_LD] << 16);
        w.z = (unsigned)sp[4 * GP_LD] | ((unsigned)sp[5 * GP_LD] << 16); w.w = (unsigned)sp[6 * GP_LD] | ((unsigned)sp[7 * GP_LD] << 16);
        *(v4u*)(KDT + ((size_t)((b * 4 + h) * 64 + n) * 96 + d) * 64 + 8 * cg) = w;
    }
    __syncthreads();
}
constexpr int GL_QT = 0, GL_KT = 13312, GL_KDT = 26624, GL_VT = 40960, GL_DEC = 48128, GL_BUF = 49152;
__device__ __forceinline__ void gla_main_item(const Frame& F, int item, const bf16* QTa, const bf16* KTa, const bf16* KDT0, const bf16* KDT1, const float* DECa, const bf16* v1t, bf16* OFp, bf16* OBp) {
    const int vs = item & 3, dir = (item >> 2) & 1, h = (item >> 3) & 3, b = item >> 5;
    const int lane = F.lane, wave = F.wave, qi = lane & 15, g = lane >> 4, ct = wave & 3, vh = wave >> 2;
    bf16* O = dir ? OBp : OFp;
    LAS unsigned char* L = F.lds;
    unsigned off[6];
#pragma unroll
    for (int jj = 0; jj < 6; ++jj) { const int k = wave + 8 * jj; unsigned o;
        if (k < 26) { const int gi = (k < 13 ? k : k - 13) * 64 + lane, row = gi / 13, col = gi % 13; o = (unsigned)(row * 768 + (col < 12 ? col * 16 : 0)); }
        else if (k < 40) { const int gi = (k - 26) * 64 + lane, row = gi / 9, col = gi % 9; o = (gi < 864) ? (unsigned)(row * 128 + (col < 8 ? col * 16 : 0)) : 0u; }
        else if (k < 47) { const int gi = (k - 40) * 64 + lane, row = gi / 9, col = gi % 9; o = (gi < 432) ? (unsigned)(row * NT * 2 + (col < 8 ? col * 16 : 0)) : 0u; }
        else o = (lane < 24) ? (unsigned)(lane * 16) : 0u;
        off[jj] = o; }
    const char* qtb = (const char*)(QTa + (size_t)dir * NT * 384 + h * 96); const char* ktb = (const char*)(KTa + (size_t)dir * NT * 384 + h * 96);
    const char* kdb = (const char*)(dir ? KDT1 : KDT0) + (size_t)((b * 4 + h) * 64) * 12288; const char* deb = (const char*)(DECa + (size_t)dir * 8 * 4 * 64 * 96 + (size_t)((b * 4 + h) * 64) * 96);
    const char* vtb = (const char*)(v1t + (size_t)(h * 192 + vs * 48) * NT);
#define GL_DMA(n_, bufo_) do { const int nn_ = dir ? 63 - (n_) : (n_); const size_t tb_ = (size_t)(b * SEQ + nn_ * 64); \
        _Pragma("unroll") for (int jj_ = 0; jj_ < 6; ++jj_) { const int k_ = wave + 8 * jj_; \
            const char* src_ = k_ < 13 ? qtb + tb_ * 768 : (k_ < 26 ? ktb + tb_ * 768 : (k_ < 40 ? kdb + (size_t)nn_ * 12288 : (k_ < 47 ? vtb + tb_ * 2 : deb + (size_t)nn_ * 384))); \
            __builtin_amdgcn_global_load_lds((const unsigned*)(src_ + off[jj_]), (LAS unsigned*)(L + (bufo_) + k_ * 1024), 16, 0, 0); } } while (0)
    f32x4 S[2][6];
#pragma unroll
    for (int vi = 0; vi < 2; ++vi)
#pragma unroll
        for (int dt = 0; dt < 6; ++dt) S[vi][dt] = (f32x4){0.f, 0.f, 0.f, 0.f};
    GL_DMA(0, 0);
    asm volatile("s_waitcnt vmcnt(0)\n\ts_barrier" ::: "memory");
#pragma unroll 1
    for (int n = 0; n < 64; ++n) {
        const int bo = (n & 1) * GL_BUF;
        if (n + 1 < 64) GL_DMA(n + 1, GL_BUF - bo);
        LAS unsigned char* Bf = L + bo;
        bf16x8 qf[3];
#pragma unroll
        for (int ks = 0; ks < 3; ++ks) qf[ks] = *(const LAS bf16x8*)(Bf + GL_QT + (16 * ct + qi) * 208 + (32 * ks + 8 * g) * 2);
        f32x4 am[4];
#pragma unroll
        for (int tp = 0; tp < 4; ++tp) {
            f32x4 z = {0.f, 0.f, 0.f, 0.f};
            if (dir ? (tp >= ct) : (tp <= ct)) {
#pragma unroll
                for (int ks = 0; ks < 3; ++ks) { const bf16x8 kf = *(const LAS bf16x8*)(Bf + GL_KT + (16 * tp + qi) * 208 + (32 * ks + 8 * g) * 2);
                    z = __builtin_amdgcn_mfma_f32_16x16x32_bf16(kf, qf[ks], z, 0, 0, 0); }
                const int c = 16 * ct + qi;
#pragma unroll
                for (int i = 0; i < 4; ++i) { const int cp = 16 * tp + 4 * g + i; const bool keep = dir ? (cp > c) : (cp <= c); z[i] = keep ? z[i] : 0.f; }
            }
            am[tp] = z;
        }
        bf16x8 pf[2];
#pragma unroll
        for (int kk = 0; kk < 2; ++kk) { v4u w; w.x = pk2(am[2 * kk][0], am[2 * kk][1]); w.y = pk2(am[2 * kk][2], am[2 * kk][3]); w.z = pk2(am[2 * kk + 1][0], am[2 * kk + 1][1]); w.w = pk2(am[2 * kk + 1][2], am[2 * kk + 1][3]);
            pf[kk] = __builtin_bit_cast(bf16x8, w); }
        bf16x8 qp[3];
#pragma unroll
        for (int kk = 0; kk < 3; ++kk) { const LAS unsigned char* qr = Bf + GL_QT + (16 * ct + qi) * 208 + (32 * kk + 4 * g) * 2;
            const s16x4 a0 = *(const LAS s16x4*)qr, a1 = *(const LAS s16x4*)(qr + 32); qp[kk] = __builtin_shufflevector(a0, a1, 0, 1, 2, 3, 4, 5, 6, 7); }
        const int nn = dir ? 63 - n : n, tok = b * SEQ + nn * 64 + 16 * ct + qi;
#pragma unroll
        for (int vi = 0; vi < 2; ++vi) {
            if (vi == 1 && vh == 1) break;
            const int vt = 2 * vh + vi;
            f32x4 acc = {0.f, 0.f, 0.f, 0.f};
#pragma unroll
            for (int kk = 0; kk < 2; ++kk) { const LAS unsigned char* vr = Bf + GL_VT + (16 * vt + qi) * 144 + (32 * kk + 4 * g) * 2;
                const s16x4 a0 = *(const LAS s16x4*)vr, a1 = *(const LAS s16x4*)(vr + 32); const bf16x8 vf = __builtin_shufflevector(a0, a1, 0, 1, 2, 3, 4, 5, 6, 7);
                acc = __builtin_amdgcn_mfma_f32_16x16x32_bf16(vf, pf[kk], acc, 0, 0, 0); }
#pragma unroll
            for (int kk = 0; kk < 3; ++kk) { v4u w; w.x = pk2(S[vi][2 * kk][0], S[vi][2 * kk][1]); w.y = pk2(S[vi][2 * kk][2], S[vi][2 * kk][3]); w.z = pk2(S[vi][2 * kk + 1][0], S[vi][2 * kk + 1][1]); w.w = pk2(S[vi][2 * kk + 1][2], S[vi][2 * kk + 1][3]);
                acc = __builtin_amdgcn_mfma_f32_16x16x32_bf16(__builtin_bit_cast(bf16x8, w), qp[kk], acc, 0, 0, 0); }
            v2u w; w.x = pk2(acc[0], acc[1]); w.y = pk2(acc[2], acc[3]);
            *(v2u*)(O + (size_t)tok * 768 + h * 192 + vs * 48 + 16 * vt + 4 * g) = w;
            bf16x8 vfr[2];
#pragma unroll
            for (int ks = 0; ks < 2; ++ks) vfr[ks] = *(const LAS bf16x8*)(Bf + GL_VT + (16 * vt + qi) * 144 + (32 * ks + 8 * g) * 2);
#pragma unroll
            for (int dt = 0; dt < 6; ++dt) {
                const f32x4 dec = *(const LAS f32x4*)(Bf + GL_DEC + (16 * dt + 4 * g) * 4);
                f32x4 sv = S[vi][dt]; sv[0] *= dec[0]; sv[1] *= dec[1]; sv[2] *= dec[2]; sv[3] *= dec[3];
#pragma unroll
                for (int ks = 0; ks < 2; ++ks) { const bf16x8 kdf = *(const LAS bf16x8*)(Bf + GL_KDT + (16 * dt + qi) * 144 + (32 * ks + 8 * g) * 2);
                    sv = __builtin_amdgcn_mfma_f32_16x16x32_bf16(kdf, vfr[ks], sv, 0, 0, 0); }
                S[vi][dt] = sv;
            }
        }
        if (vh) asm volatile("s_waitcnt vmcnt(1) lgkmcnt(0)\n\ts_barrier" ::: "memory"); else asm volatile("s_waitcnt vmcnt(2) lgkmcnt(0)\n\ts_barrier" ::: "memory");
    }
    __syncthreads();
#undef GL_DMA
}

__device__ __forceinline__ void finalize_rstd(const Frame& F, const float* rss, float* rstd) {
    for (int row = F.bid * NTHR + F.tid; row < NT; row += F.G * NTHR) rstd[row] = rstd_from(rss + (size_t)row * 16);
}
__device__ __forceinline__ void gla_combine(const Frame& F, const bf16* OF, const bf16* OB, const bf16* act1, const float* gnorm, bf16* mix) {
    for (int token = F.gw; token < NT; token += F.NGW) {
        const int lane = F.lane;
#pragma unroll
        for (int h = 0; h < 4; ++h) {
            float o[3]; float ss = 0.f;
#pragma unroll
            for (int j = 0; j < 3; ++j) { const size_t idx = (size_t)token * 768 + h * 192 + j * 64 + lane; o[j] = bf2f(OF[idx]) + bf2f(OB[idx]); ss += o[j] * o[j]; }
            ss = wave_sum(ss);
            const float rs = 1.0f / sqrtf(ss * (1.0f / 192.0f) + EPS);
#pragma unroll
            for (int j = 0; j < 3; ++j) { const int dv = j * 64 + lane; const float g = bf2f(act1[(size_t)token * A1_LD + 768 + h * 192 + dv]);
                const float val = o[j] * rs * gnorm[dv] * (g / (1.0f + __expf(-g)));
                mix[(size_t)token * DM + h * 192 + dv] = (bf16)f2bf(val); }
        }
    }
}
__device__ __forceinline__ void route_pick(const float (&acc)[8], int token, int* topi, float* topw, LAS int* lc) {
    int e0 = 0; float l0 = acc[0];
#pragma unroll
    for (int e = 1; e < 8; ++e) if (acc[e] > l0) { l0 = acc[e]; e0 = e; }
    int e1 = -1; float l1 = -INFINITY;
#pragma unroll
    for (int e = 0; e < 8; ++e) if (e != e0 && acc[e] > l1) { l1 = acc[e]; e1 = e; }
    if (e1 < 0) { e1 = (e0 + 1) & 7; l1 = l0; }
    const float w0 = 1.0f / (1.0f + __expf(l1 - l0));
    topi[token] = e0 | (e1 << 8); topw[2 * token] = w0; topw[2 * token + 1] = 1.0f - w0;
    atomicAdd((int*)&lc[e0], 1); atomicAdd((int*)&lc[8 + e1], 1);
}
__device__ __forceinline__ void route1(const Frame& F, const float* H, const float* gain, const float* wr, int* topi, float* topw, int* cnt, float* rstd) {
    LAS int* lc = (LAS int*)F.lds;
    if (F.tid < 16) lc[F.tid] = 0;
    __syncthreads();
    const int lane = F.lane;
    float w[4][4][8];
#pragma unroll
    for (int j = 0; j < 4; ++j) { const f32x4 g = *(const f32x4*)(gain + 256 * j + 4 * lane);
#pragma unroll
        for (int i = 0; i < 4; ++i) { const float* p = wr + (size_t)(256 * j + 4 * lane + i) * 8; const f32x4 a = *(const f32x4*)p, b = *(const f32x4*)(p + 4); const float gi = g[i];
            w[j][i][0] = a.x * gi; w[j][i][1] = a.y * gi; w[j][i][2] = a.z * gi; w[j][i][3] = a.w * gi; w[j][i][4] = b.x * gi; w[j][i][5] = b.y * gi; w[j][i][6] = b.z * gi; w[j][i][7] = b.w * gi; } }
    for (int t2 = 0; t2 < 16; t2 += 2) {
        const int token = F.bid * 128 + F.wave * 16 + t2;
        const f32x4* h0 = (const f32x4*)(H + (size_t)token * DM) + lane; const f32x4* h1 = h0 + DM / 4;
        f32x4 x0[4], x1[4];
#pragma unroll
        for (int j = 0; j < 4; ++j) x0[j] = h0[64 * j];
#pragma unroll
        for (int j = 0; j < 4; ++j) x1[j] = h1[64 * j];
        float a0[8], a1[8], s0 = 0.f, s1 = 0.f;
#pragma unroll
        for (int e = 0; e < 8; ++e) { a0[e] = 0.f; a1[e] = 0.f; }
#pragma unroll
        for (int j = 0; j < 4; ++j)
#pragma unroll
            for (int i = 0; i < 4; ++i) { const float u = x0[j][i], v = x1[j][i]; s0 += u * u; s1 += v * v;
#pragma unroll
                for (int e = 0; e < 8; ++e) { a0[e] += u * w[j][i][e]; a1[e] += v * w[j][i][e]; } }
        s0 = wave_sum(s0); s1 = wave_sum(s1);
        const float r0 = 1.0f / sqrtf(s0 * (1.0f / DM) + EPS), r1 = 1.0f / sqrtf(s1 * (1.0f / DM) + EPS);
#pragma unroll
        for (int e = 0; e < 8; ++e) { a0[e] = wave_sum(a0[e]) * r0; a1[e] = wave_sum(a1[e]) * r1; }
        if (lane == 0) { route_pick(a0, token, topi, topw, lc); route_pick(a1, token + 1, topi, topw, lc); rstd[token] = r0; rstd[token + 1] = r1; }
    }
    __syncthreads();
    if (F.tid < 16) cnt[F.bid * 16 + F.tid] = lc[F.tid];
    __syncthreads();
}
__device__ __forceinline__ void route2(const Frame& F, const int* topi, const float* topw, const int* cnt, int* stok, float* sw, int* blk) {
    LAS int* part = (LAS int*)F.lds;
    LAS int* base = part + 1024;
    LAS int* tk = base + 64;
    const int tid = F.tid, pe = tid & 15, jg = tid >> 4;
    int below = 0, tot = 0;
    for (int w = jg; w < F.G; w += 32) { const int v = cnt[w * 16 + pe]; tot += v; if (w < F.bid) below += v; }
    part[jg * 16 + pe] = below; part[512 + jg * 16 + pe] = tot;
    if (tid < 128) tk[tid] = topi[F.bid * 128 + tid];
    __syncthreads();
    if (tid < 16) { int b = 0, t = 0; for (int j = 0; j < 32; ++j) { b += part[j * 16 + tid]; t += part[512 + j * 16 + tid]; } base[tid] = b; base[16 + tid] = t; }
    __syncthreads();
    if (tid < 2) { int ps = 0; for (int e = 0; e < 8; ++e) { base[32 + tid * 8 + e] = ps; ps += (base[16 + tid * 8 + e] + 255) / 256 * 256; } base[48 + tid] = ps / 256; }
    __syncthreads();
    if (tid < 256) {
        const int p = tid >> 7, i = tid & 127; const int e = (tk[i] >> (8 * p)) & 0xff;
        int rank = 0; for (int j = 0; j < i; ++j) rank += (((tk[j] >> (8 * p)) & 0xff) == e) ? 1 : 0;
        const int slot = base[32 + p * 8 + e] + base[p * 8 + e] + rank; const int token = F.bid * 128 + i;
        stok[p * SLOT_CAP + slot] = token; sw[p * SLOT_CAP + slot] = topw[2 * token + p];
    }
    if (F.bid < 16) {
        const int p = F.bid >> 3, e = F.bid & 7, ps = base[32 + F.bid], t = base[16 + F.bid], pend = ps + (t + 255) / 256 * 256;
        for (int s = ps + t + tid; s < pend; s += NTHR) { stok[p * SLOT_CAP + s] = -1; sw[p * SLOT_CAP + s] = 0.f; }
        for (int bk = ps / 256 + tid; bk < pend / 256; bk += NTHR) blk[16 + p * 256 + bk] = e;
        if (e == 0 && tid == 0) blk[p] = base[48 + p];
    }
    __syncthreads();
}
__device__ __forceinline__ void final_norm_slots(int lane, float* H, const float* gain, const int* tok, int s0, int s1, int first, int stride) {
    for (int sl = s0 + first; sl < s1; sl += stride) {
        const int row = tok[sl]; if (row < 0) continue;
        GAS f32x4* xr = (GAS f32x4*)(H + (size_t)row * DM) + lane; const f32x4* gr = (const f32x4*)gain + lane;
        f32x4 v[4]; float s = 0.f;
#pragma unroll
        for (int j = 0; j < 4; ++j) { v[j] = xr[64 * j]; s += (v[j].x * v[j].x + v[j].y * v[j].y) + (v[j].z * v[j].z + v[j].w * v[j].w); }
        s = wave_sum(s); const float rs = 1.0f / sqrtf(s * (1.0f / DM) + EPS);
#pragma unroll
        for (int j = 0; j < 4; ++j) { const f32x4 g = gr[64 * j]; f32x4 o = {v[j].x * rs * g.x, v[j].y * rs * g.y, v[j].z * rs * g.z, v[j].w * rs * g.w}; xr[64 * j] = o; }
    }
}
__device__ __forceinline__ void final_norm(const Frame& F, float* H, const float* gain) {
    for (int row = F.gw; row < NT; row += F.NGW) {
        GAS f32x4* xr = (GAS f32x4*)(H + (size_t)row * DM) + F.lane; const f32x4* gr = (const f32x4*)gain + F.lane;
        f32x4 v[4]; float s = 0.f;
#pragma unroll
        for (int j = 0; j < 4; ++j) { v[j] = xr[64 * j]; s += (v[j].x * v[j].x + v[j].y * v[j].y) + (v[j].z * v[j].z + v[j].w * v[j].w); }
        s = wave_sum(s); const float rs = 1.0f / sqrtf(s * (1.0f / DM) + EPS);
#pragma unroll
        for (int j = 0; j < 4; ++j) { const f32x4 g = gr[64 * j]; f32x4 o = {v[j].x * rs * g.x, v[j].y * rs * g.y, v[j].z * rs * g.z, v[j].w * rs * g.w}; xr[64 * j] = o; }
    }
}

constexpr int N_PHASES = 17;
__global__ void __launch_bounds__(NTHR, 2) mega(Args args) {
    extern __shared__ __attribute__((aligned(16))) unsigned char lds_raw[];
    Frame F;
    F.lds = (LAS unsigned char*)lds_raw;
    F.tid = threadIdx.x; F.lane = F.tid & 63; F.wave = __builtin_amdgcn_readfirstlane(F.tid >> 6);
    F.G = gridDim.x; F.bid = blockIdx.x; F.gw = F.bid * NWAVES + F.wave; F.NGW = F.G * NWAVES; F.ws = args.ws;
    unsigned char* ws = args.ws;
    gu32* ctl = (gu32*)(ws + WS_CTL);
    volatile LAS unsigned* MISC = (volatile LAS unsigned*)(F.lds + MISC_OFF);
    for (int u = F.tid; u < (LDS_BYTES - LDSCTL_OFF) / 4; u += NTHR) ((LAS unsigned*)(F.lds + LDSCTL_OFF))[u] = 0u;
    __syncthreads();
    XcdBarrier bar = xcd_barrier_post((unsigned*)(ctl + CW_BAR), MISC + 8);
    const int lo = args.ph_lo, hi = args.ph_hi;
#ifndef PH_MASK
#define PH_MASK 0x1ffff
#endif
#define IN(k) (((PH_MASK >> (k)) & 1) && lo <= (k) && (k) < hi)
#ifndef REPEAT_MASK
#define REPEAT_MASK 0
#endif
#define REPS(k) (1 + ((REPEAT_MASK >> (k)) & 1))
#define SEAM(k) do { if (IN(k) && IN((k) + 1)) xcd_barrier(bar); } while (0)

    float* H = args.out;
    float* rss = (float*)(ws + WS_RSS); float* rstd = (float*)(ws + WS_RSTD);
    bf16* hbf = (bf16*)(ws + WS_HBF); bf16* membf = (bf16*)(ws + WS_MEMBF); bf16* memk = (bf16*)(ws + WS_MEMK); bf16* memvt = (bf16*)(ws + WS_MEMVT);
    bf16* act0 = (bf16*)(ws + WS_ACT0); bf16* v0t = (bf16*)(ws + WS_V0T); bf16* mix = (bf16*)(ws + WS_MIX); bf16* hmid0 = (bf16*)(ws + WS_HMID0);
    bf16* act1 = (bf16*)(ws + WS_ACT1); bf16* v1t = (bf16*)(ws + WS_V1T); bf16* OF = (bf16*)(ws + WS_OF); bf16* OB = (bf16*)(ws + WS_OB);
    bf16* hmid1 = (bf16*)(ws + WS_HMID1); bf16* wgu = (bf16*)(ws + WS_WGU); bf16* wdn = (bf16*)(ws + WS_WDN);
    int* cnt = (int*)(ws + WS_CNT); int* topi = (int*)(ws + WS_TOPI); float* topw = (float*)(ws + WS_TOPW);
    int* stok = (int*)(ws + WS_STOK); float* sw = (float*)(ws + WS_SW); int* blk = (int*)(ws + WS_BLK);
    LAS float* scr = (LAS float*)(F.lds + F.wave * 16384);

    if (IN(0)) {
        int it = F.gw; LAS unsigned* T0 = (LAS unsigned*)scr; LAS unsigned* T1 = T0 + 1088;
#define CVT(Wp, Kd, Nd, WTp, gainp, kind) do { const CvtJob J{Wp, Kd, Nd, (bf16*)(WTp), gainp, kind}; const int n_ = ((Kd) / 64) * ((Nd) / 32); \
            while (it < n_) { CvtRegs A_, B_; B_.valid = 0; cvt_load(A_, J, it, F.lane); it += F.NGW; if (it < n_) { cvt_load(B_, J, it, F.lane); it += F.NGW; } cvt_finish(A_, T0, F.lane); cvt_finish(B_, T1, F.lane); } \
            it -= n_; } while (0)
        CVT(args.in[I_EWIN], 1024, 2560, ws + WS_W0IN, args.in[I_EN1], 1);
        CVT(args.in[I_EWIN], 1024, 2560, ws + WS_WV0, args.in[I_EN1], 2);
        CVT(args.in[I_EWOUT], 1024, 1024, ws + WS_W0OUT, nullptr, 0);
        CVT(args.in[I_EWG], 1024, 2816, ws + WS_W0GU, args.in[I_EN2], 3);
        CVT(args.in[I_EWU], 1024, 2816, ws + WS_W0GU, args.in[I_EN2], 4);
        CVT(args.in[I_EWD], 2816, 1024, ws + WS_W0DN, nullptr, 0);
        CVT(args.in[I_WMKV], 1024, 512, ws + WS_WMEM, args.in[I_MNORM], 0);
        CVT(args.in[I_OWIN], 1024, 2592, ws + WS_W1IN, args.in[I_ON1], 5);
        CVT(args.in[I_OWIN], 1024, 2592, ws + WS_WV1, args.in[I_ON1], 6);
        CVT(args.in[I_OWOUT], 1024, 1024, ws + WS_W1OUT, nullptr, 0);
#undef CVT
        { v4u z = {0u, 0u, 0u, 0u}; v4u* p = (v4u*)(ws + WS_W1IN + (size_t)1824 * 2048); const int n16 = 224 * 2048 / 16;
          for (int i = F.bid * NTHR + F.tid; i < n16; i += F.G * NTHR) p[i] = z; }
        rows_to_bf16(args.in[I_X], hbf, rstd, F.gw, NT, F.NGW, F.lane);
        rows_to_bf16(args.in[I_MEM], membf, rstd + NT, F.gw, MEM_ROWS, F.NGW, F.lane);
    }
    SEAM(0);
    if (IN(1)) {
        { Sched S; S.init(hbf, ws + WS_W0IN, 1024, 128, 7, F.G, F.bid); EpiRowScale E{act0, A0_LD, rstd}; gemm_run<EpiRowScale, false>(F.lds, S, E, nullptr); }
        { Sched S; S.init(ws + WS_WV0, hbf, 1024, 3, 128, F.G, (F.bid + 128) % F.G); EpiColScale E{v0t, NT, rstd}; gemm_run<EpiColScale, false>(F.lds, S, E, nullptr); }
        { Sched S; S.init(membf, ws + WS_WMEM, 1024, 8, 1, F.G, F.bid); EpiRowScale E{memk, 256, rstd + NT}; gemm_run<EpiRowScale, false>(F.lds, S, E, nullptr); }
        { Sched S; S.init(ws + WS_WMEM + 256 * 2048, membf, 1024, 1, 8, F.G, (F.bid + 248) % F.G); EpiColScale E{memvt, MEM_ROWS, rstd + NT}; gemm_run<EpiColScale, false>(F.lds, S, E, nullptr); }
    }
    SEAM(1);
    if (IN(2)) {
#if FAST_ATT
        { LAS float* rl = (LAS float*)(F.lds + 256); for (int i = F.tid; i < 5580; i += NTHR) rl[i] = args.in[I_RPB][i] * 1.4426950408889634f; __syncthreads();
          for (int it = F.gw; it < 32768; it += F.NGW) { if (it < 24576) na_item(it, F.lane, act0, v0t, rl, mix); else memattn_item(it - 24576, F.lane, act0, A0_LD, 1536, memk, memvt, mix); }
          __syncthreads(); }
#else
        na_simple(F, act0, v0t, args.in[I_RPB], mix);
        memattn_simple(F, F.gw, F.NGW, act0, A0_LD, 1536, memk, memvt, mix);
#endif
    }
    SEAM(2);
    if (IN(3)) {
        Sched S; S.init(mix, ws + WS_W0OUT, 1024, 128, 4, F.G, F.bid); EpiResid E{args.in[I_X], H, hbf, rss}; gemm_run<EpiResid, false>(F.lds, S, E, nullptr);
    }
    SEAM(3);
    if (IN(4)) {
        finalize_rstd(F, rss, rstd); xcd_barrier(bar);
        Sched S; S.init(hbf, ws + WS_W0GU, 1024, 128, 22, F.G, F.bid); EpiSwiGLU<false> E{hmid0, FF0, rstd, nullptr}; gemm_run<EpiSwiGLU<false>, false>(F.lds, S, E, nullptr);
    }
    SEAM(4);
    if (IN(5)) {
        Sched S; S.init(hmid0, ws + WS_W0DN, FF0, 128, 4, F.G, F.bid); EpiResid E{H, H, hbf, rss}; gemm_run<EpiResid, false>(F.lds, S, E, nullptr);
    }
    SEAM(5);
    if (IN(6)) {
        finalize_rstd(F, rss, rstd); xcd_barrier(bar);
        { Sched S; S.init(hbf, ws + WS_W1IN, 1024, 128, 8, F.G, F.bid); EpiRowScale E{act1, A1_LD, rstd}; gemm_run<EpiRowScale, false>(F.lds, S, E, nullptr); }
        { Sched S; S.init(ws + WS_WV1, hbf, 1024, 3, 128, F.G, F.bid); EpiColScale E{v1t, NT, rstd}; gemm_run<EpiColScale, false>(F.lds, S, E, nullptr); }
    }
    SEAM(6);
    if (IN(7)) {
#if FAST_GLA
        for (int it = F.bid; it < 1024; it += F.G) { const int dir = (it >> 6) & 1;
            gla_pre_item(F, it, act1, dir ? args.in[I_WGKB] : args.in[I_WGKF], dir ? args.in[I_BGKB] : args.in[I_BGKF], (bf16*)(ws + WS_GQT) + (size_t)dir * NT * 384, (bf16*)(ws + WS_GKT) + (size_t)dir * NT * 384,
                         (bf16*)(ws + (dir ? WS_GKDT1 : WS_GKDT0)), (float*)(ws + WS_GDEC) + (size_t)dir * 8 * 4 * 64 * 96); }
        for (int it = F.gw; it < 8192; it += F.NGW) memattn_item(it, F.lane, act1, A1_LD, 1536, memk, memvt, mix);
        xcd_barrier(bar);
        for (int it0 = F.bid; it0 < 256; it0 += F.G) { const int it = (F.G == 256) ? ((it0 & 7) * 8 + (it0 >> 5)) * 4 + ((it0 >> 3) & 3) : it0;
            gla_main_item(F, it, (const bf16*)(ws + WS_GQT), (const bf16*)(ws + WS_GKT), (const bf16*)(ws + WS_GKDT0), (const bf16*)(ws + WS_GKDT1), (const float*)(ws + WS_GDEC), v1t, OF, OB); }
#else
        if (F.bid < 64) {
            const int dir = F.bid & 1;
            gla_simple(F, F.bid, act1, v1t, dir ? args.in[I_WGKB] : args.in[I_WGKF], dir ? args.in[I_BGKB] : args.in[I_BGKF], dir ? OB : OF);
        } else {
#if FAST_ATT
            for (int it = (F.bid - 64) * NWAVES + F.wave; it < 8192; it += (F.G - 64) * NWAVES) memattn_item(it, F.lane, act1, A1_LD, 1536, memk, memvt, mix);
#else
            memattn_simple(F, (F.bid - 64) * NWAVES + F.wave, (F.G - 64) * NWAVES, act1, A1_LD, 1536, memk, memvt, mix);
#endif
        }
#endif
    }
    SEAM(7);
    if (IN(8)) gla_combine(F, OF, OB, act1, args.in[I_GNORM], mix);
    SEAM(8);
    if (IN(9)) {
        Sched S; S.init(mix, ws + WS_W1OUT, 1024, 128, 4, F.G, F.bid); EpiResid E{H, H, hbf, rss}; gemm_run<EpiResid, false>(F.lds, S, E, nullptr);
    }
    SEAM(9);
    if (IN(10)) {
        route1(F, H, args.in[I_ON2], args.in[I_WR], topi, topw, cnt, rstd);
        { LAS unsigned* T0 = (LAS unsigned*)scr; LAS unsigned* T1 = T0 + 1088;
#define MOE_JOB(J_, it_) const int e_##J_ = (it_) / 5376, r_##J_ = (it_) % 5376, wh_##J_ = r_##J_ / 1792; \
            const CvtJob J_{wh_##J_ == 0 ? args.in[I_OWG] + (size_t)e_##J_ * 1024 * FFE : (wh_##J_ == 1 ? args.in[I_OWU] + (size_t)e_##J_ * 1024 * FFE : args.in[I_OWD] + (size_t)e_##J_ * FFE * 1024), \
                wh_##J_ == 2 ? FFE : 1024, wh_##J_ == 2 ? 1024 : FFE, wh_##J_ == 2 ? wdn + (size_t)e_##J_ * 1024 * FFE : wgu + (size_t)e_##J_ * 7168 * 1024, wh_##J_ == 2 ? nullptr : args.in[I_ON2], wh_##J_ == 2 ? 0 : 3 + wh_##J_}
          for (int it = F.gw; it < 8 * 3 * 1792; it += 2 * F.NGW) {
            CvtRegs A_, B_; B_.valid = 0;
            { MOE_JOB(Ja, it); cvt_load(A_, Ja, it % 1792, F.lane); }
            if (it + F.NGW < 8 * 3 * 1792) { MOE_JOB(Jb, it + F.NGW); cvt_load(B_, Jb, (it + F.NGW) % 1792, F.lane); }
            cvt_finish(A_, T0, F.lane); cvt_finish(B_, T1, F.lane);
          }
#undef MOE_JOB
        }
    }
    SEAM(10);
    if (IN(11)) route2(F, topi, topw, cnt, stok, sw, blk);
    SEAM(11);
    bf16* ht0 = hmid1 + (size_t)NT * FFE; bf16* ht1 = (bf16*)(ws + WS_HT1);
    if (IN(12)) {
        const int nb = blk[0]; Sched S; S.init(hbf, wgu, 1024, nb, 28, F.G, F.bid, blk + 16, (size_t)7168 * 1024 * 2); EpiSwiGLU<true> E{hmid1, FFE, rstd, ht0}; gemm_run<EpiSwiGLU<true>, true>(F.lds, S, E, stok);
    }
    SEAM(12);
    if (IN(13)) {
        const int nb = blk[0], nbm = nb < 128 ? nb : 128; Sched S; S.init(hmid1, wdn, FFE, nbm, 4, F.G, F.bid, blk + 16, (size_t)1024 * FFE * 2); EpiMoeDown E{H, stok, sw}; gemm_run<EpiMoeDown, false>(F.lds, S, E, nullptr);
    }
    SEAM(13);
    if (IN(14)) {
        const int nb = blk[1], nb0 = blk[0], rfull = (nb * 28 / F.G > 3) ? nb * 28 / F.G - 3 : 0, per = F.G / 8;
        { Sched S; S.init(hbf, wgu, 1024, nb, 28, F.G, F.bid, blk + 16 + 256, (size_t)7168 * 1024 * 2); S.range(0, rfull * per, per);
          EpiSwiGLU<true> E{hmid1, FFE, rstd, ht1}; gemm_run<EpiSwiGLU<true>, true>(F.lds, S, E, stok + SLOT_CAP); }
        { Sched S; S.init(hbf, wgu, 1024, nb, 28, F.G, F.bid, blk + 16 + 256, (size_t)7168 * 1024 * 2); S.range(rfull * per, 0x7fffffff, per - 4);
          EpiSwiGLU<true> E{hmid1, FFE, rstd, ht1}; gemm_run<EpiSwiGLU<true>, true>(F.lds, S, E, stok + SLOT_CAP); }
        if (F.bid / 8 >= per - 4 && nb0 > 128) {
            Sched S; S.init(ht0, wdn, FFE, nb0 - 128, 4, 32, (F.bid / 8 - (per - 4)) * 8 + F.bid % 8, blk + 16 + 128, (size_t)1024 * FFE * 2);
            EpiMoeDown E{H, stok + NT, sw + NT}; gemm_run<EpiMoeDown, false>(F.lds, S, E, nullptr); }
    }
    SEAM(14);
    if (IN(15)) {
        const int nb = blk[1], nbm = nb < 128 ? nb : 128; Sched S; S.init(hmid1, wdn, FFE, nbm, 4, F.G, F.bid, blk + 16 + 256, (size_t)1024 * FFE * 2); EpiMoeDown E{H, stok + SLOT_CAP, sw + SLOT_CAP}; gemm_run<EpiMoeDown, false>(F.lds, S, E, nullptr);
    }
    SEAM(15);
    if (IN(16)) {
        const int nb = blk[1], per = F.G / 8, nmain = (nb < 128 ? nb : 128) * 256;
        if (F.bid / 8 >= per - 4) {
            if (nb > 128) { Sched S; S.init(ht1, wdn, FFE, nb - 128, 4, 32, (F.bid / 8 - (per - 4)) * 8 + F.bid % 8, blk + 16 + 256 + 128, (size_t)1024 * FFE * 2);
                EpiMoeDown E{H, stok + SLOT_CAP + NT, sw + SLOT_CAP + NT}; gemm_run<EpiMoeDown, false>(F.lds, S, E, nullptr); }
        } else {
            const int wv = (int)(blockIdx.x * NWAVES + (threadIdx.x >> 6));
            final_norm_slots((int)(threadIdx.x & 63u), H, args.in[I_FNORM], stok + SLOT_CAP, 0, nmain, wv, (per - 4) * 8 * NWAVES);
        }
        xcd_barrier(bar);
        if (nb > 128) final_norm_slots((int)(threadIdx.x & 63u), H, args.in[I_FNORM], stok + SLOT_CAP, NT, nb * 256, (int)(blockIdx.x * NWAVES + (threadIdx.x >> 6)), F.NGW);
    }
#undef IN
#undef SEAM
}

extern "C" void kernel_launch(void* const* d_in, const int* in_sizes, int n_in, void* d_out, int out_size, void* d_ws, size_t ws_size, hipStream_t stream) {
    static int grid = 0;
    if (grid == 0) {
        if (n_in != 26 || out_size != NT * DM || ws_size < WS_END) { fprintf(stderr, "kernel_launch: unexpected problem (n_in %d out %d ws %zu need %zu)\n", n_in, out_size, ws_size, (size_t)WS_END); grid = -1; return; }
        int dev = 0, cus = 0, per_cu = 0;
        if (hipGetDevice(&dev) != hipSuccess || hipDeviceGetAttribute(&cus, hipDeviceAttributeMultiprocessorCount, dev) != hipSuccess) { grid = -1; return; }
        if (hipFuncSetAttribute((const void*)mega, hipFuncAttributeMaxDynamicSharedMemorySize, LDS_BYTES) != hipSuccess) { fprintf(stderr, "kernel_launch: hipFuncSetAttribute failed\n"); grid = -1; return; }
        if (hipOccupancyMaxActiveBlocksPerMultiprocessor(&per_cu, (const void*)mega, NTHR, LDS_BYTES) != hipSuccess || per_cu < 1) fprintf(stderr, "kernel_launch: occupancy query reports %d\n", per_cu);
        (void)hipGetLastError();
        grid = cus;
        if (grid != 256) fprintf(stderr, "kernel_launch: note: %d CUs\n", grid);
    }
    if (grid < 0) return;
    if (hipMemsetAsync((char*)d_ws + WS_CTL, 0, CTL_ZERO_BYTES, stream) != hipSuccess) return;
    Args a{};
    for (int i = 0; i < 26; ++i) a.in[i] = (const float*)d_in[i];
    a.out = (float*)d_out; a.ws = (unsigned char*)d_ws;
#if MK_FUSED
    a.ph_lo = 0; a.ph_hi = N_PHASES;
    hipLaunchKernelGGL(mega, dim3(grid), dim3(NTHR), LDS_BYTES, stream, a);
#else
    for (int p = 0; p < N_PHASES; ++p) { a.ph_lo = p; a.ph_hi = p + 1; hipLaunchKernelGGL(mega, dim3(grid), dim3(NTHR), LDS_BYTES, stream, a); }
#endif
}
```

```cpp
#include <hip/hip_runtime.h>
#include <cstdio>
#include <cstdint>

#ifndef MK_FUSED
#define MK_FUSED 1
#endif
#ifndef FAST_GEMM
#define FAST_GEMM 1
#endif
#ifndef FAST_ATT
#define FAST_ATT 1
#endif
#ifndef FAST_GLA
#define FAST_GLA 1
#endif

#define GAS __attribute__((address_space(1)))
#define LAS __attribute__((address_space(3)))
typedef unsigned short bf16;
typedef unsigned v4u __attribute__((ext_vector_type(4)));
typedef unsigned v2u __attribute__((ext_vector_type(2)));
typedef float f32x4 __attribute__((ext_vector_type(4)));
typedef short bf16x8 __attribute__((ext_vector_type(8)));
typedef GAS unsigned gu32;
#define RLX_AGENT __ATOMIC_RELAXED, __HIP_MEMORY_SCOPE_AGENT
#define LDS_WAIT() asm volatile("s_waitcnt lgkmcnt(0)" ::: "memory")
#define VM_WAIT() asm volatile("s_waitcnt vmcnt(0)" ::: "memory")

constexpr int NT = 32768, DM = 1024, SEQ = 4096, NB = 8;
constexpr int MEM_ROWS = 2048;
constexpr int A0_LD = 1792;
constexpr int A1_LD = 2048;
constexpr int FF0 = 2816, FFE = 3584, NEXP = 8;
constexpr int SLOT_CAP = 34816;
constexpr float EPS = 1e-6f;
constexpr int NWAVES = 8, NTHR = 512;

constexpr size_t MiB = 1u << 20;
constexpr size_t WS_CTL = 0, CTL_ZERO_BYTES = 1 * MiB;
constexpr size_t WS_RSS = 1 * MiB;
constexpr size_t WS_MRSS = 3 * MiB;
constexpr size_t WS_CNT = 3 * MiB + 256 * 1024;
constexpr size_t WS_TOPI = 3 * MiB + 512 * 1024;
constexpr size_t WS_TOPW = 3 * MiB + 768 * 1024;
constexpr size_t WS_STOK = 4 * MiB;
constexpr size_t WS_SW = 4 * MiB + 512 * 1024;
constexpr size_t WS_BLK = 5 * MiB;
constexpr size_t WS_RSTD = 5 * MiB + 64 * 1024;
constexpr size_t WS_W0IN = 6 * MiB;
constexpr size_t WS_WV0 = WS_W0IN + 1792 * 2048;
constexpr size_t WS_W0OUT = 11 * MiB;
constexpr size_t WS_W0GU = 13 * MiB;
constexpr size_t WS_W0DN = 24 * MiB;
constexpr size_t WS_WMEM = WS_W0DN + 1024 * 2816 * 2;
constexpr size_t WS_W1IN = 31 * MiB;
constexpr size_t WS_WV1 = 35 * MiB;
constexpr size_t WS_W1OUT = 37 * MiB - 512 * 1024;
constexpr size_t WS_HBF = 39 * MiB;
constexpr size_t WS_MEMBF = 103 * MiB;
constexpr size_t WS_MEMK = 107 * MiB;
constexpr size_t WS_MEMVT = 108 * MiB;
constexpr size_t WS_ACT = 109 * MiB;
constexpr size_t WS_ACT0 = WS_ACT;
constexpr size_t WS_V0T = WS_ACT + 112 * MiB;
constexpr size_t WS_MIX = WS_ACT + 176 * MiB;
constexpr size_t WS_HMID0 = WS_ACT;
constexpr size_t WS_ACT1 = WS_ACT;
constexpr size_t WS_V1T = WS_ACT + 128 * MiB;
constexpr size_t WS_OF = WS_ACT + 240 * MiB;
constexpr size_t WS_OB = WS_ACT + 288 * MiB;
constexpr size_t WS_GQT = WS_ACT + 336 * MiB;
constexpr size_t WS_GKDT0 = WS_ACT + 384 * MiB;
constexpr size_t WS_GKDT1 = 6 * MiB;
constexpr size_t WS_GKT = WS_HBF;
constexpr size_t WS_GDEC = WS_HBF + 48 * MiB;
constexpr size_t WS_E = WS_ACT + 336 * MiB;
constexpr size_t WS_HT1 = 6 * MiB;
constexpr size_t WS_YB = WS_ACT + 240 * MiB;
constexpr size_t WS_HMID1 = WS_ACT;
constexpr size_t WS_WGU = WS_ACT + 240 * MiB;
constexpr size_t WS_WDN = WS_ACT + 352 * MiB;
constexpr size_t WS_END = WS_ACT + 408 * MiB;
static_assert(WS_W1OUT + 2 * MiB <= WS_HBF && WS_WV1 + 768 * 2048 <= WS_W1OUT && WS_W1IN + 4 * MiB <= WS_WV1 && WS_WMEM + MiB <= WS_W1IN, "weight map");
static_assert(WS_W0GU + 11 * MiB <= WS_W0DN && WS_WV0 + 768 * 2048 <= WS_W0OUT, "weight map 2");
static_assert((size_t)SLOT_CAP * 3584 * 2 <= 240 * MiB, "hmid1");

constexpr int CW_TMO = 0, CW_CODE = 1, CW_BAR = 4096;

constexpr int RING_BYTES = 131072;
constexpr int LDSCTL_OFF = 147456, MISC_OFF = LDSCTL_OFF + 320;
constexpr int LDS_BYTES = 148480;

typedef float f32x2_t __attribute__((ext_vector_type(2)));
typedef __bf16 bf16x2_t __attribute__((ext_vector_type(2)));
__device__ __forceinline__ unsigned pk2(float lo, float hi) { const f32x2_t v = {lo, hi}; const bf16x2_t b = __builtin_convertvector(v, bf16x2_t); return __builtin_bit_cast(unsigned, b); }
__device__ __forceinline__ unsigned f2bf(float f) { return pk2(f, 0.f) & 0xffffu; }
__device__ __forceinline__ float bf2f(bf16 b) { return __builtin_bit_cast(float, (unsigned)b << 16); }
__device__ __forceinline__ float bflo(unsigned u) { return __builtin_bit_cast(float, u << 16); }
__device__ __forceinline__ float bfhi(unsigned u) { return __builtin_bit_cast(float, u & 0xffff0000u); }
__device__ __forceinline__ float wave_sum(float v) {
#pragma unroll
    for (int o = 1; o < 64; o <<= 1) v += __shfl_xor(v, o);
    return v;
}
__device__ __forceinline__ float wave_max(float v) {
#pragma unroll
    for (int o = 1; o < 64; o <<= 1) v = fmaxf(v, __shfl_xor(v, o));
    return v;
}

#define XB_TMO      128
#define XB_XCNT(j)  (256  + 64 * (j))
#define XB_XSUB(j)  (1280 + 64 * (j))
#define XB_XGEN(j)  (2304 + 64 * (j))
#define XB_TOP      3328
#define XB_TOPGEN   3392
#define XCD_BAR_WORDS 3456
#define XB_SPIN_CAP (1u << 22)

__device__ __forceinline__ unsigned xb_ld(unsigned* p)              { return __hip_atomic_load(p, __ATOMIC_RELAXED, __HIP_MEMORY_SCOPE_AGENT); }
__device__ __forceinline__ unsigned xb_add(unsigned* p, unsigned v) { return __hip_atomic_fetch_add(p, v, __ATOMIC_RELAXED, __HIP_MEMORY_SCOPE_AGENT); }
__device__ __forceinline__ unsigned xb_xcc_id() { return (unsigned)__builtin_amdgcn_s_getreg((3 << 11) | 20) & 0xFu; }
#define XB_SPIN(cond, bar) do { unsigned _sp = 0; while (cond) { __builtin_amdgcn_s_sleep(1); \
    if ((++_sp & 255u) == 0u) { if (xb_ld(&(bar)[XB_TMO])) break; if (_sp > XB_SPIN_CAP) { atomicAdd(&(bar)[XB_TMO], 1u); break; } } } } while (0)

struct XcdBarrier { unsigned* bar; unsigned x; volatile LAS unsigned* st; };

__device__ __forceinline__ XcdBarrier xcd_barrier_post(unsigned* bar, volatile LAS unsigned* st) {
    XcdBarrier b; b.bar = bar; b.x = xb_xcc_id(); b.st = st;
    if (threadIdx.x == 0) (void)xb_add(&bar[XB_XCNT(b.x)], 1u);
    return b;
}
__device__ __forceinline__ void xcd_barrier_complete(unsigned* bar, unsigned x, unsigned& nloc, unsigned& nx) {
    const unsigned G = gridDim.x * gridDim.y * gridDim.z;
    unsigned sum, cnt, mine, sp = 0u;
    for (;;) {
        sum = 0u; cnt = 0u; mine = 0u;
#pragma unroll
        for (unsigned j = 0; j < 16; ++j) { const unsigned c = xb_ld(&bar[XB_XCNT(j)]); sum += c; cnt += (c > 0u) ? 1u : 0u; mine = (j == x) ? c : mine; }
        if (sum == G) break;
        __builtin_amdgcn_s_sleep(1);
        if ((++sp & 255u) == 0u) { if (xb_ld(&bar[XB_TMO])) break; if (sp > XB_SPIN_CAP) { atomicAdd(&bar[XB_TMO], 1u); break; } }
    }
    nloc = mine > 0u ? mine : 1u; nx = cnt > 0u ? cnt : 1u;
}
__device__ __forceinline__ void xcd_barrier(const XcdBarrier& b) {
    asm volatile("s_waitcnt vmcnt(0)" ::: "memory");
    __syncthreads();
    if (threadIdx.x == 0) {
        unsigned* bar = b.bar;
        __builtin_amdgcn_s_waitcnt(0);
        unsigned nloc = b.st[0], nx = b.st[1];
        if (nloc == 0u) { xcd_barrier_complete(bar, b.x, nloc, nx); b.st[0] = nloc; b.st[1] = nx; }
        const unsigned old = xb_add(&bar[XB_XSUB(b.x)], 1u);
        const unsigned gen = old / nloc;
        if (old + 1u == (gen + 1u) * nloc) {
            __builtin_amdgcn_fence(__ATOMIC_RELEASE, "agent");
            asm volatile("s_waitcnt vmcnt(0)" ::: "memory");
            const unsigned og = xb_add(&bar[XB_TOP], 1u);
            const unsigned tg = og / nx;
            if (og + 1u == (tg + 1u) * nx) xb_add(&bar[XB_TOPGEN], 1u);
            else XB_SPIN(xb_ld(&bar[XB_TOPGEN]) == tg, bar);
            __builtin_amdgcn_fence(__ATOMIC_ACQUIRE, "agent");
            xb_add(&bar[XB_XGEN(b.x)], 1u);
            asm volatile("s_waitcnt vmcnt(0)" ::: "memory");
        } else {
            XB_SPIN(xb_ld(&bar[XB_XGEN(b.x)]) == gen, bar);
            __builtin_amdgcn_fence(__ATOMIC_ACQUIRE, "agent");
            asm volatile("s_waitcnt vmcnt(0)" ::: "memory");
        }
    }
    __syncthreads();
}

struct Args { const float* in[26]; float* out; unsigned char* ws; int ph_lo, ph_hi; };
enum { I_X = 0, I_MEM, I_EN1, I_EWIN, I_RPB, I_EWOUT, I_EN2, I_EWG, I_EWU, I_EWD, I_ON1, I_OWIN, I_WGKF, I_BGKF, I_WGKB, I_BGKB, I_GNORM, I_OWOUT, I_ON2, I_WR, I_OWG, I_OWU, I_OWD, I_MNORM, I_WMKV, I_FNORM };

struct Frame {
    LAS unsigned char* lds;
    int tid, lane, wave, G, bid;
    int gw, NGW;
    unsigned char* ws;
};

constexpr float QSCALE = 0.125f * 1.4426950408889634f;
struct CvtJob { const float* W; int K, N; bf16* WT; const float* gain; int kind; };
__device__ __forceinline__ bool cvt_map(int kind, int n0, int& drow, float& scale) {
    scale = 1.0f;
    switch (kind) {
    case 0: drow = n0; return true;
    case 1: if (n0 < 768) { drow = n0; scale = QSCALE; return true; } if (n0 < 1536) { drow = n0; return true; } if (n0 >= 2304) { drow = n0 - 768; scale = QSCALE; return true; } return false;
    case 2: if (n0 >= 1536 && n0 < 2304) { drow = n0 - 1536; return true; } return false;
    case 3: drow = (n0 >> 7) * 256 + (n0 & 127); return true;
    case 4: drow = (n0 >> 7) * 256 + 128 + (n0 & 127); return true;
    case 5: if (n0 < 768) { drow = n0; return true; } if (n0 < 1536) return false; if (n0 < 2304) { drow = n0 - 768; return true; }
            if (n0 < 2336) { drow = n0 - 512; return true; } drow = n0 - 800; scale = QSCALE; return true;
    case 6: if (n0 >= 768 && n0 < 1536) { drow = n0 - 768; return true; } return false;
    default: drow = n0; return true;
    }
}
struct CvtRegs { f32x4 v[8]; const float* gain; bf16* WT; int K, k0, drow, valid; float scale; };
__device__ __forceinline__ void cvt_load(CvtRegs& R, const CvtJob& J, int item, int lane) {
    const int nblk = J.N / 32, kb = item / nblk, nb = item % nblk, n0 = nb * 32;
    R.k0 = kb * 64; R.gain = J.gain; R.WT = J.WT; R.K = J.K;
    R.valid = cvt_map(J.kind, n0, R.drow, R.scale) ? 1 : 0;
    if (R.valid) { const float* p = J.W + (size_t)(R.k0 + 2 * (lane >> 3)) * J.N + n0 + 4 * (lane & 7);
#pragma unroll
        for (int j = 0; j < 8; ++j) R.v[j] = *(const f32x4*)(p + (size_t)(16 * (j >> 1) + (j & 1)) * J.N); }
}
__device__ __forceinline__ void cvt_finish(const CvtRegs& R, LAS unsigned* T, int lane) {
    if (!R.valid) return;
    const int nq = lane & 7, kr = lane >> 3;
#pragma unroll
    for (int p = 0; p < 4; ++p) { const int k = R.k0 + 16 * p + 2 * kr; float g0 = R.scale, g1 = R.scale; if (R.gain) { g0 *= R.gain[k]; g1 *= R.gain[k + 1]; }
        const f32x4 a = R.v[2 * p], b = R.v[2 * p + 1]; LAS unsigned* t = T + (4 * nq) * 33 + 8 * p + kr;
        t[0] = pk2(a.x * g0, b.x * g1); t[33] = pk2(a.y * g0, b.y * g1); t[66] = pk2(a.z * g0, b.z * g1); t[99] = pk2(a.w * g0, b.w * g1); }
    LDS_WAIT(); asm volatile("" ::: "memory");
#pragma unroll
    for (int r = 0; r < 4; ++r) { const int n = (lane >> 3) + 8 * r, c = lane & 7; const LAS unsigned* sp = T + n * 33 + 4 * c;
        v4u o; o.x = sp[0]; o.y = sp[1]; o.z = sp[2]; o.w = sp[3];
        *(GAS v4u*)(R.WT + (size_t)(R.drow + n) * R.K + R.k0 + 8 * c) = o; }
    LDS_WAIT(); asm volatile("" ::: "memory");
}
__device__ __forceinline__ void rows_to_bf16(const float* X, bf16* Ob, float* rstd, int first, int nrows, int stride, int lane) {
    for (int m = first; m < nrows; m += 2 * stride) {
        const int m2 = m + stride; const bool h2 = m2 < nrows;
        const GAS f32x4* xa = (const GAS f32x4*)(X + (size_t)m * DM) + lane; const GAS f32x4* xb = (const GAS f32x4*)(X + (size_t)(h2 ? m2 : m) * DM) + lane;
        f32x4 va[4], vb[4];
#pragma unroll
        for (int j = 0; j < 4; ++j) va[j] = xa[64 * j];
#pragma unroll
        for (int j = 0; j < 4; ++j) vb[j] = xb[64 * j];
        float sa = 0.f, sb = 0.f;
#pragma unroll
        for (int j = 0; j < 4; ++j) { sa += (va[j].x * va[j].x + va[j].y * va[j].y) + (va[j].z * va[j].z + va[j].w * va[j].w); sb += (vb[j].x * vb[j].x + vb[j].y * vb[j].y) + (vb[j].z * vb[j].z + vb[j].w * vb[j].w); }
        sa = wave_sum(sa); sb = wave_sum(sb);
        GAS unsigned long long* oa = (GAS unsigned long long*)(Ob + (size_t)m * DM) + lane;
#pragma unroll
        for (int j = 0; j < 4; ++j) oa[64 * j] = (unsigned long long)pk2(va[j].x, va[j].y) | ((unsigned long long)pk2(va[j].z, va[j].w) << 32);
        if (lane == 0) rstd[m] = __builtin_amdgcn_rsqf(sa * (1.0f / DM) + EPS);
        if (h2) { GAS unsigned long long* ob = (GAS unsigned long long*)(Ob + (size_t)m2 * DM) + lane;
#pragma unroll
            for (int j = 0; j < 4; ++j) ob[64 * j] = (unsigned long long)pk2(vb[j].x, vb[j].y) | ((unsigned long long)pk2(vb[j].z, vb[j].w) << 32);
            if (lane == 0) rstd[m2] = __builtin_amdgcn_rsqf(sb * (1.0f / DM) + EPS); }
    }
}

struct Unit { int pm, pn; };
struct Sched {
    int nM, nN, nwg, G, c, K, off0, off1, per;
    const char* A; const char* B; const int* bexp; size_t estride;
    __device__ void init(const void* A_, const void* B_, int K_, int nM_, int nN_, int G_, int c_, const int* bexp_ = nullptr, size_t estride_ = 0) {
        A = (const char*)A_; B = (const char*)B_; K = K_; nM = nM_; nN = nN_; nwg = nM * nN; G = G_; c = c_; bexp = bexp_; estride = estride_; off0 = 0; off1 = 0x7fffffff; per = G_ / 8; }
    __device__ void range(int off0_, int off1_, int per_) { off0 = off0_; off1 = off1_; per = per_; }
    __device__ bool next(int i, Unit& u) const {
        const int q = nwg / 8, r = nwg % 8, xcd = c % 8, slot = c / 8, qx = q + (xcd < r ? 1 : 0);
        if (slot >= per) return false;
        const int off = off0 + i * per + slot, lim = off1 < qx ? off1 : qx;
        if (off >= lim) return false;
        const int wgid = (xcd < r ? xcd * (q + 1) : r * (q + 1) + (xcd - r) * q) + off;
        const int nig = 8 * nN, gid = wgid / nig, fm = gid * 8, gsz = (nM - fm) < 8 ? (nM - fm) : 8;
        u.pm = fm + ((wgid % nig) % gsz); u.pn = (wgid % nig) / gsz; return true;
    }
    __device__ const char* a_base(const Unit& u) const { return A + (size_t)u.pm * 512 * K; }
    __device__ const char* b_base(const Unit& u) const { return B + (bexp ? (size_t)bexp[u.pm] * estride : (size_t)0) + (size_t)u.pn * 512 * K; }
};

struct NoAux {};
__device__ __forceinline__ float rstd_from(const float* rss16) {
    const f32x4* p = (const f32x4*)rss16; f32x4 a = p[0], b = p[1], c = p[2], d = p[3];
    const float s = ((a.x + a.y) + (a.z + a.w)) + ((b.x + b.y) + (b.z + b.w)) + ((c.x + c.y) + (c.z + c.w)) + ((d.x + d.y) + (d.z + d.w));
    return __builtin_amdgcn_rsqf(s * (1.0f / DM) + EPS);
}
struct RowCtx { float rs[2][4]; };
struct EpiRowScale {
    static constexpr bool NEED_SS = false; static constexpr int SC_MODE = 1; typedef RowCtx Ctx; typedef NoAux Aux;
    bf16* O; int ldc; const float* sc_src;
    __device__ __forceinline__ void begin(Ctx& c, const LAS float* sc, const LAS int*, int lr0, int, int, int) const {
#pragma unroll
        for (int ai = 0; ai < 2; ++ai)
#pragma unroll
            for (int m = 0; m < 4; ++m) c.rs[ai][m] = sc[ai * 128 + lr0 + m * 16];
    }
    __device__ __forceinline__ void load_aux(Aux&, const Ctx&, int, int, int, int, int) const {}
    __device__ __forceinline__ float apply(const Ctx& c, const Aux&, int ai, int m, int row, int pn, int c128, const float (&a)[8], const float (&b)[8]) const {
        const float s = c.rs[ai][m];
        bf16* p = O + (size_t)row * ldc + pn * 256 + c128;
        v4u w; w.x = pk2(a[0] * s, a[1] * s); w.y = pk2(a[2] * s, a[3] * s); w.z = pk2(a[4] * s, a[5] * s); w.w = pk2(a[6] * s, a[7] * s); *(v4u*)p = w;
        w.x = pk2(b[0] * s, b[1] * s); w.y = pk2(b[2] * s, b[3] * s); w.z = pk2(b[4] * s, b[5] * s); w.w = pk2(b[6] * s, b[7] * s); *(v4u*)(p + 128) = w;
        return 0.f;
    }
    __device__ __forceinline__ void row_done(int, int, int, float) const {}
};
struct ColCtx { float sa[8], sb[8]; };
struct EpiColScale {
    static constexpr bool NEED_SS = false; static constexpr int SC_MODE = 2; typedef ColCtx Ctx; typedef NoAux Aux;
    bf16* O; int ldc; const float* sc_src;
    __device__ __forceinline__ void begin(Ctx& c, const LAS float* sc, const LAS int*, int, int, int, int c128) const {
#pragma unroll
        for (int j = 0; j < 8; ++j) { c.sa[j] = sc[c128 + j]; c.sb[j] = sc[128 + c128 + j]; }
    }
    __device__ __forceinline__ void load_aux(Aux&, const Ctx&, int, int, int, int, int) const {}
    __device__ __forceinline__ float apply(const Ctx& c, const Aux&, int, int, int row, int pn, int c128, const float (&a)[8], const float (&b)[8]) const {
        bf16* p = O + (size_t)row * ldc + pn * 256 + c128;
        v4u w; w.x = pk2(a[0] * c.sa[0], a[1] * c.sa[1]); w.y = pk2(a[2] * c.sa[2], a[3] * c.sa[3]); w.z = pk2(a[4] * c.sa[4], a[5] * c.sa[5]); w.w = pk2(a[6] * c.sa[6], a[7] * c.sa[7]); *(v4u*)p = w;
        w.x = pk2(b[0] * c.sb[0], b[1] * c.sb[1]); w.y = pk2(b[2] * c.sb[2], b[3] * c.sb[3]); w.z = pk2(b[4] * c.sb[4], b[5] * c.sb[5]); w.w = pk2(b[6] * c.sb[6], b[7] * c.sb[7]); *(v4u*)(p + 128) = w;
        return 0.f;
    }
    __device__ __forceinline__ void row_done(int, int, int, float) const {}
};
struct Aux4 { f32x4 v[4]; };
struct NoCtx {};
struct EpiResid {
    static constexpr bool NEED_SS = true; static constexpr int SC_MODE = 0; typedef NoCtx Ctx; typedef Aux4 Aux;
    const float* R; float* H; bf16* HB; float* rss;
    __device__ __forceinline__ void begin(Ctx&, const LAS float*, const LAS int*, int, int, int, int) const {}
    __device__ __forceinline__ void load_aux(Aux& x, const Ctx&, int, int, int row, int pn, int c128) const {
        const float* p = R + (size_t)row * DM + pn * 256 + c128;
        x.v[0] = *(const f32x4*)p; x.v[1] = *(const f32x4*)(p + 4); x.v[2] = *(const f32x4*)(p + 128); x.v[3] = *(const f32x4*)(p + 132);
    }
    __device__ __forceinline__ float apply(const Ctx&, const Aux& x, int, int, int row, int pn, int c128, const float (&a)[8], const float (&b)[8]) const {
        const size_t off = (size_t)row * DM + pn * 256 + c128;
        const f32x4 h0 = {x.v[0].x + a[0], x.v[0].y + a[1], x.v[0].z + a[2], x.v[0].w + a[3]}, h1 = {x.v[1].x + a[4], x.v[1].y + a[5], x.v[1].z + a[6], x.v[1].w + a[7]};
        const f32x4 h2 = {x.v[2].x + b[0], x.v[2].y + b[1], x.v[2].z + b[2], x.v[2].w + b[3]}, h3 = {x.v[3].x + b[4], x.v[3].y + b[5], x.v[3].z + b[6], x.v[3].w + b[7]};
        *(f32x4*)(H + off) = h0; *(f32x4*)(H + off + 4) = h1; *(f32x4*)(H + off + 128) = h2; *(f32x4*)(H + off + 132) = h3;
        v4u w; w.x = pk2(h0.x, h0.y); w.y = pk2(h0.z, h0.w); w.z = pk2(h1.x, h1.y); w.w = pk2(h1.z, h1.w); *(v4u*)(HB + off) = w;
        w.x = pk2(h2.x, h2.y); w.y = pk2(h2.z, h2.w); w.z = pk2(h3.x, h3.y); w.w = pk2(h3.z, h3.w); *(v4u*)(HB + off + 128) = w;
        return ((h0.x * h0.x + h0.y * h0.y) + (h0.z * h0.z + h0.w * h0.w) + (h1.x * h1.x + h1.y * h1.y) + (h1.z * h1.z + h1.w * h1.w))
             + ((h2.x * h2.x + h2.y * h2.y) + (h2.z * h2.z + h2.w * h2.w) + (h3.x * h3.x + h3.y * h3.y) + (h3.z * h3.z + h3.w * h3.w));
    }
    __device__ __forceinline__ void row_done(int row, int pn, int wc, float ss) const { rss[(size_t)row * 16 + pn * 4 + wc] = ss; }
};
__device__ __forceinline__ float silu_mul(float g, float u) { return g * __builtin_amdgcn_rcpf(1.0f + __builtin_amdgcn_exp2f(g * -1.4426950408889634f)) * u; }
template <bool MOE> struct EpiSwiGLU {
    static constexpr bool NEED_SS = false; static constexpr int SC_MODE = MOE ? 3 : 1; typedef RowCtx Ctx; typedef NoAux Aux;
    bf16* Hm; int ldh; const float* sc_src; bf16* Hmt;
    __device__ __forceinline__ void begin(Ctx& c, const LAS float* sc, const LAS int* tl, int lr0, int, int, int) const {
#pragma unroll
        for (int ai = 0; ai < 2; ++ai)
#pragma unroll
            for (int m = 0; m < 4; ++m) { const int i = ai * 128 + lr0 + m * 16; float r = sc[i]; if (MOE) { if (tl[i] < 0) r = 0.f; } c.rs[ai][m] = r; }
    }
    __device__ __forceinline__ void load_aux(Aux&, const Ctx&, int, int, int, int, int) const {}
    __device__ __forceinline__ float apply(const Ctx& c, const Aux&, int ai, int m, int row, int pn, int c128, const float (&a)[8], const float (&b)[8]) const {
        const float s = c.rs[ai][m]; float o[8];
#pragma unroll
        for (int j = 0; j < 8; ++j) o[j] = silu_mul(a[j] * s, b[j] * s);
        v4u w; w.x = pk2(o[0], o[1]); w.y = pk2(o[2], o[3]); w.z = pk2(o[4], o[5]); w.w = pk2(o[6], o[7]);
        bf16* rp = (MOE && row >= NT) ? Hmt + (size_t)(row - NT) * ldh : Hm + (size_t)row * ldh;
        *(v4u*)(rp + pn * 128 + c128) = w;
        return 0.f;
    }
    __device__ __forceinline__ void row_done(int, int, int, float) const {}
};
struct MoeCtx { int t[2][4]; float w[2][4]; };
struct EpiMoeDown {
    static constexpr bool NEED_SS = false; static constexpr int SC_MODE = 4; typedef MoeCtx Ctx; typedef Aux4 Aux;
    float* H; const int* tok; const float* w;
    __device__ __forceinline__ void begin(Ctx& c, const LAS float* sc, const LAS int*, int lr0, int, int, int) const {
#pragma unroll
        for (int ai = 0; ai < 2; ++ai)
#pragma unroll
            for (int m = 0; m < 4; ++m) { const int i = ai * 128 + lr0 + m * 16; c.t[ai][m] = ((const LAS int*)sc)[i]; c.w[ai][m] = sc[256 + i]; }
    }
    __device__ __forceinline__ void load_aux(Aux& x, const Ctx& c, int ai, int m, int, int pn, int c128) const {
        const int t = c.t[ai][m]; const float* p = H + (size_t)(t < 0 ? 0 : t) * DM + pn * 256 + c128;
        x.v[0] = *(const f32x4*)p; x.v[1] = *(const f32x4*)(p + 4); x.v[2] = *(const f32x4*)(p + 128); x.v[3] = *(const f32x4*)(p + 132);
    }
    __device__ __forceinline__ float apply(const Ctx& c, const Aux& x, int ai, int m, int, int pn, int c128, const float (&a)[8], const float (&b)[8]) const {
        const int t = c.t[ai][m]; if (t < 0) return 0.f;
        const float s = c.w[ai][m]; float* p = H + (size_t)t * DM + pn * 256 + c128;
        f32x4 h0 = x.v[0], h1 = x.v[1], h2 = x.v[2], h3 = x.v[3];
        h0.x += s * a[0]; h0.y += s * a[1]; h0.z += s * a[2]; h0.w += s * a[3]; h1.x += s * a[4]; h1.y += s * a[5]; h1.z += s * a[6]; h1.w += s * a[7];
        h2.x += s * b[0]; h2.y += s * b[1]; h2.z += s * b[2]; h2.w += s * b[3]; h3.x += s * b[4]; h3.y += s * b[5]; h3.z += s * b[6]; h3.w += s * b[7];
        *(f32x4*)p = h0; *(f32x4*)(p + 4) = h1; *(f32x4*)(p + 128) = h2; *(f32x4*)(p + 132) = h3;
        return 0.f;
    }
    __device__ __forceinline__ void row_done(int, int, int, float) const {}
};

namespace pg8 {
constexpr int HTB = 16384, TOK_OFF = 132096, SC_OFF = 134144;
__device__ __forceinline__ int lds_byte(int r, int c) { const int st = (r >> 4) * 2 + (c >> 5), rr = r & 15, cc = c & 31, ob = rr * 64 + cc * 2; return st * 1024 + (ob ^ (((ob >> 9) & 1) << 5)); }
__device__ __forceinline__ void stage_rc(int b, int& R, int& C) { const int st = b / 1024, sb = b % 1024, swz = sb ^ (((sb >> 9) & 1) << 5); R = (st >> 1) * 16 + swz / 64; C = (st & 1) * 32 + (swz % 64) / 2; }
__device__ __forceinline__ int perm32(int rho) { const int n = rho >> 4, i = rho & 15; return 8 * (i >> 2) + 4 * n + (i & 3); }

template <class Epi>
__device__ __forceinline__ void run_epi(const Epi& E, const f32x4 (&acc)[2][2][4][2], const Unit& u, int wr, int wc, int fr, int fq, const LAS float* sc, const LAS int* tlp) {
    int row0 = u.pm * 256 + wr * 64 + fr, c128 = 32 * wc + 8 * fq;
    asm volatile("" : "+v"(row0), "+v"(c128));
    typename Epi::Ctx ctx; E.begin(ctx, sc, tlp, wr * 64 + fr, row0, u.pn, c128);
#pragma unroll
    for (int ai = 0; ai < 2; ++ai) {
        typename Epi::Aux aux[4];
#pragma unroll
        for (int m = 0; m < 4; ++m) E.load_aux(aux[m], ctx, ai, m, row0 + ai * 128 + m * 16, u.pn, c128);
#pragma unroll
        for (int m = 0; m < 4; ++m) {
            const int row = row0 + ai * 128 + m * 16;
            float a[8], b[8];
#pragma unroll
            for (int j = 0; j < 8; ++j) { a[j] = acc[ai][0][m][j >> 2][j & 3]; b[j] = acc[ai][1][m][j >> 2][j & 3]; }
            float ss = E.apply(ctx, aux[m], ai, m, row, u.pn, c128, a, b);
            if (Epi::NEED_SS) { ss += __shfl_xor(ss, 16); ss += __shfl_xor(ss, 32); if (fq == 0) E.row_done(row, u.pn, wc, ss); }
        }
    }
}

template <class Epi, bool GATHER>
__device__ __forceinline__ void gemm_fast(LAS unsigned char* lds, const Sched& S, const Epi& E, const int* gtok) {
    int tid = threadIdx.x; asm volatile("" : "+v"(tid));
    const int wid = __builtin_amdgcn_readfirstlane(tid >> 6), lane = tid & 63, wr = wid >> 2, wc = wid & 3, fr = lane & 15, fq = lane >> 4;
    const int K = S.K, nt = K / 64;
    unsigned voffB[2], vA0[2], vA1[2], nA0[2], nA1[2]; int RA[2], CA2[2];
#pragma unroll
    for (int i = 0; i < 2; ++i) { int R, C; stage_rc(tid * 16 + i * 8192, R, C); const int Rb = (R & ~31) + perm32(R & 31);
        voffB[i] = (unsigned)(Rb * K + C) * 2u; RA[i] = R; CA2[i] = C * 2; vA0[i] = (unsigned)(R * K + C) * 2u; vA1[i] = vA0[i] + (unsigned)(128 * K * 2); nA0[i] = vA0[i]; nA1[i] = vA1[i]; }
    const size_t kstep = 128;
    const size_t hstep = (size_t)128 * K * 2;
    const unsigned ldsw = (unsigned)wid * 1024u;
    const int aoff = lds_byte(wr * 64 + fr, fq * 8), boff = lds_byte(wc * 32 + fr, fq * 8);
    LAS int* tl = (LAS int*)(lds + TOK_OFF);
#define PG8_SA(b, h) (((b) * 2 + (h)) * HTB)
#define PG8_SB(b, h) ((4 + (b) * 2 + (h)) * HTB)
#define PG8_STAGE(bufoff, gbase, voff) do { _Pragma("unroll") for (int _i = 0; _i < 2; ++_i) \
        __builtin_amdgcn_global_load_lds((const unsigned*)((const char*)(gbase) + (voff)[_i]), (LAS unsigned*)(lds + (bufoff) + ldsw + _i * 8192), 16, 0, 0); } while (0)
#define PG8_LDA(dst, b, h) do { _Pragma("unroll") for (int m = 0; m < 4; ++m) _Pragma("unroll") for (int k = 0; k < 2; ++k) dst[m][k] = *(const LAS bf16x8*)(lds + PG8_SA(b, h) + aoff + m * 2048 + k * 1024); } while (0)
#define PG8_LDB(dst, b, h) do { _Pragma("unroll") for (int n = 0; n < 2; ++n) _Pragma("unroll") for (int k = 0; k < 2; ++k) dst[n][k] = *(const LAS bf16x8*)(lds + PG8_SB(b, h) + boff + n * 2048 + k * 1024); } while (0)
#define PG8_MMA(ai, bj, At, Bt) do { __builtin_amdgcn_s_setprio(1); _Pragma("unroll") for (int m = 0; m < 4; ++m) _Pragma("unroll") for (int n = 0; n < 2; ++n) _Pragma("unroll") for (int k = 0; k < 2; ++k) \
        acc[ai][bj][m][n] = __builtin_amdgcn_mfma_f32_16x16x32_bf16(Bt[n][k], At[m][k], acc[ai][bj][m][n], 0, 0, 0); __builtin_amdgcn_s_setprio(0); } while (0)
#define PG8_WAIT_V(n) asm volatile("s_waitcnt vmcnt(" #n ")" ::: "memory")
#define PG8_WAIT_L(n) asm volatile("s_waitcnt lgkmcnt(" #n ")" ::: "memory")
#define PG8_BAR __builtin_amdgcn_s_barrier()
#define PG8_SCHED __builtin_amdgcn_sched_barrier(0)
#define PG8_IDS_DMA(pm_, par_) do { if (wid < 4) __builtin_amdgcn_global_load_lds((const unsigned*)(gtok + (pm_) * 256 + wid * 64 + lane), (LAS unsigned*)(lds + TOK_OFF + (par_) * 1024 + wid * 256), 4, 0, 0); } while (0)
#define PG8_IDS_READ(d0, d1, par_) do { _Pragma("unroll") for (int _i = 0; _i < 2; ++_i) { int t0 = tl[(par_) * 256 + RA[_i]], t1 = tl[(par_) * 256 + 128 + RA[_i]]; t0 = t0 < 0 ? 0 : t0; t1 = t1 < 0 ? 0 : t1; \
        d0[_i] = (unsigned)t0 * (unsigned)(K * 2) + (unsigned)CA2[_i]; d1[_i] = (unsigned)t1 * (unsigned)(K * 2) + (unsigned)CA2[_i]; } } while (0)
    Unit cur, nxt; int ui = 0, par = 0;
    if (!S.next(0, cur)) return;
    f32x4 acc[2][2][4][2];
#pragma unroll
    for (int a = 0; a < 2; ++a)
#pragma unroll
        for (int b = 0; b < 2; ++b)
#pragma unroll
            for (int m = 0; m < 4; ++m)
#pragma unroll
                for (int n = 0; n < 2; ++n) acc[a][b][m][n] = (f32x4){0.f, 0.f, 0.f, 0.f};
    bf16x8 At[4][2], B0[2][2], B1[2][2];
    const char* cA = GATHER ? S.A : S.a_base(cur); const char* cB = S.b_base(cur);
    if constexpr (GATHER) { PG8_IDS_DMA(cur.pm, 0); PG8_WAIT_V(0); __syncthreads(); PG8_IDS_READ(vA0, vA1, 0); }
    PG8_STAGE(PG8_SB(0, 0), cB, voffB); PG8_STAGE(PG8_SB(0, 1), cB + hstep, voffB); PG8_STAGE(PG8_SA(0, 0), cA, vA0); PG8_STAGE(PG8_SA(0, 1), cA, vA1);
    if (wr == 1) PG8_BAR;
    PG8_WAIT_V(2); PG8_BAR;
    PG8_STAGE(PG8_SB(1, 0), cB + kstep, voffB); PG8_STAGE(PG8_SA(1, 0), cA + kstep, vA0); PG8_STAGE(PG8_SB(1, 1), cB + hstep + kstep, voffB);
    PG8_WAIT_V(6); PG8_BAR;
    for (;;) {
        const bool has_next = S.next(ui + 1, nxt);
        const char* nA = has_next ? (GATHER ? S.A : S.a_base(nxt)) : cA; const char* nB = has_next ? S.b_base(nxt) : cB;
        for (int t = 0; t < nt; t += 2) {
            const bool last = (t == nt - 2);
            if constexpr (GATHER) {
                if (t == nt - 4 && has_next) PG8_IDS_DMA(nxt.pm, par ^ 1);
                if (last) { if (has_next) PG8_IDS_READ(nA0, nA1, par ^ 1); else { nA0[0] = vA0[0]; nA0[1] = vA0[1]; nA1[0] = vA1[0]; nA1[1] = vA1[1]; } }
            }
            if constexpr (Epi::SC_MODE != 0) {
                if (last && wid < 4) { const int i_ = wid * 64 + lane; LAS unsigned* d_ = (LAS unsigned*)(lds + SC_OFF + wid * 256);
                    if constexpr (Epi::SC_MODE == 1) __builtin_amdgcn_global_load_lds((const unsigned*)(E.sc_src + cur.pm * 256 + i_), d_, 4, 0, 0);
                    if constexpr (Epi::SC_MODE == 2) __builtin_amdgcn_global_load_lds((const unsigned*)(E.sc_src + cur.pn * 256 + i_), d_, 4, 0, 0);
                    if constexpr (Epi::SC_MODE == 3) { int t_ = tl[par * 256 + i_]; t_ = t_ < 0 ? 0 : t_; __builtin_amdgcn_global_load_lds((const unsigned*)(E.sc_src + t_), d_, 4, 0, 0); }
                    if constexpr (Epi::SC_MODE == 4) { __builtin_amdgcn_global_load_lds((const unsigned*)(E.tok + cur.pm * 256 + i_), d_, 4, 0, 0);
                        __builtin_amdgcn_global_load_lds((const unsigned*)(E.w + cur.pm * 256 + i_), (LAS unsigned*)(lds + SC_OFF + 1024 + wid * 256), 4, 0, 0); } }
            }
            const char* a1 = cA + (size_t)(t + 1) * kstep;
            const char* a2 = last ? nA : cA + (size_t)(t + 2) * kstep; const char* b2 = last ? nB : cB + (size_t)(t + 2) * kstep;
            const char* a3 = a2 + kstep; const char* b3 = b2 + kstep;
            unsigned w0[2], w1[2];
            if (GATHER && last) { w0[0] = nA0[0]; w0[1] = nA0[1]; w1[0] = nA1[0]; w1[1] = nA1[1]; } else { w0[0] = vA0[0]; w0[1] = vA0[1]; w1[0] = vA1[0]; w1[1] = vA1[1]; }
            PG8_LDB(B0, 0, 0); PG8_LDB(B1, 0, 1); PG8_SCHED; PG8_LDA(At, 0, 0); PG8_STAGE(PG8_SA(1, 1), a1, vA1);
            PG8_WAIT_V(8); PG8_WAIT_L(0); PG8_BAR; PG8_MMA(0, 0, At, B0); PG8_MMA(0, 1, At, B1); PG8_BAR; PG8_SCHED;
            PG8_LDA(At, 0, 1); PG8_STAGE(PG8_SB(0, 0), b2, voffB); PG8_STAGE(PG8_SB(0, 1), b2 + hstep, voffB); PG8_STAGE(PG8_SA(0, 0), a2, w0);
            PG8_WAIT_V(8); PG8_WAIT_L(0); PG8_BAR; PG8_MMA(1, 0, At, B0); PG8_MMA(1, 1, At, B1); PG8_BAR; PG8_SCHED;
            PG8_LDB(B0, 1, 0); PG8_LDB(B1, 1, 1); PG8_SCHED; PG8_LDA(At, 1, 0); PG8_STAGE(PG8_SA(0, 1), a2, w1);
            PG8_WAIT_V(8); PG8_WAIT_L(0); PG8_BAR; PG8_MMA(0, 0, At, B0); PG8_MMA(0, 1, At, B1); PG8_BAR; PG8_SCHED;
            PG8_LDA(At, 1, 1); PG8_STAGE(PG8_SB(1, 0), b3, voffB); PG8_STAGE(PG8_SB(1, 1), b3 + hstep, voffB); PG8_STAGE(PG8_SA(1, 0), a3, w0);
            PG8_WAIT_V(8); PG8_WAIT_L(0); PG8_BAR; PG8_MMA(1, 0, At, B0); PG8_MMA(1, 1, At, B1); PG8_BAR; PG8_SCHED;
        }
        if (wr == 0) PG8_BAR;
        run_epi(E, acc, cur, wr, wc, fr, fq, (const LAS float*)(lds + SC_OFF), (const LAS int*)(lds + TOK_OFF + par * 1024));
        if (!has_next) break;
#pragma unroll
        for (int a = 0; a < 2; ++a)
#pragma unroll
            for (int b = 0; b < 2; ++b)
#pragma unroll
                for (int m = 0; m < 4; ++m)
#pragma unroll
                    for (int n = 0; n < 2; ++n) acc[a][b][m][n] = (f32x4){0.f, 0.f, 0.f, 0.f};
        cur = nxt; cA = nA; cB = nB; ++ui;
        if constexpr (GATHER) { vA0[0] = nA0[0]; vA0[1] = nA0[1]; vA1[0] = nA1[0]; vA1[1] = nA1[1]; par ^= 1; }
        if (wr == 1) PG8_BAR;
    }
    PG8_WAIT_V(0);
    PG8_BAR;
#undef PG8_SA
#undef PG8_SB
#undef PG8_STAGE
#undef PG8_LDA
#undef PG8_LDB
#undef PG8_MMA
#undef PG8_WAIT_V
#undef PG8_WAIT_L
#undef PG8_BAR
#undef PG8_SCHED
#undef PG8_IDS_DMA
#undef PG8_IDS_READ
}
}

template <class Epi, bool GATHER>
__device__ __forceinline__ void gemm_run(LAS unsigned char* lds, const Sched& S, const Epi& E, const int* gtok) { pg8::gemm_fast<Epi, GATHER>(lds, S, E, gtok); }

__device__ __forceinline__ void na_simple(const Frame& F, const bf16* act0, const bf16* v0t, const float* rpb, bf16* mix) {
    for (int it = F.gw; it < NT * 12; it += F.NGW) {
        const int token = it / 12, h = it % 12, lane = F.lane;
        const int b = token >> 12, p = token & 4095, r = p >> 6, c = p & 63;
        const int r0 = min(max(r - 4, 0), 56), cs = min(max(c - 8, 0), 48);
        const float q = bf2f(act0[(size_t)token * A0_LD + h * 64 + lane]);
        float m = -INFINITY, l = 0.f, o = 0.f;
        for (int a = 0; a < 8; ++a)
            for (int u = 0; u < 16; ++u) {
                const int kt = b * SEQ + (r0 + a) * 64 + cs + u;
                const float kv = bf2f(act0[(size_t)kt * A0_LD + 768 + h * 64 + lane]);
                const float sc = wave_sum(q * kv) + rpb[h * 465 + (r0 + a - r + 7) * 31 + (cs + u - c + 15)];
                const float mn = fmaxf(m, sc), corr = __expf(m - mn), pe = __expf(sc - mn);
                const float vv = bf2f(v0t[(size_t)(h * 64 + lane) * NT + kt]);
                l = l * corr + pe; o = o * corr + pe * vv; m = mn;
            }
        mix[(size_t)token * DM + h * 64 + lane] = (bf16)f2bf(o / l);
    }
}
__device__ __forceinline__ void memattn_simple(const Frame& F, int first, int stride, const bf16* act, int ld, int qoff, const bf16* memk, const bf16* memvt, bf16* mix) {
    for (int it = first; it < NT * 4; it += stride) {
        const int token = it >> 2, h = it & 3, lane = F.lane, b = token >> 12;
        const float q = bf2f(act[(size_t)token * ld + qoff + h * 64 + lane]);
        float m = -INFINITY, l = 0.f, o = 0.f;
        for (int j = 0; j < 256; ++j) {
            const float kv = bf2f(memk[(size_t)(b * 256 + j) * 256 + h * 64 + lane]);
            const float sc = wave_sum(q * kv);
            const float mn = fmaxf(m, sc), corr = __expf(m - mn), pe = __expf(sc - mn);
            const float vv = bf2f(memvt[(size_t)(h * 64 + lane) * MEM_ROWS + b * 256 + j]);
            l = l * corr + pe; o = o * corr + pe * vv; m = mn;
        }
        mix[(size_t)token * DM + 768 + h * 64 + lane] = (bf16)f2bf(o / l);
    }
}

typedef short s16x4 __attribute__((ext_vector_type(4)));
template <bool NA, bool KLDS = false, bool VLDS = false, int KRS = 64>
__device__ __forceinline__ void attn16(int lane, const bf16* Q, int ldq, const bf16* Kb, int ldk, const bf16* Vt, int ldv, int ktok0, int trs, bf16* O, int ldo,
                                       const LAS float* rpb_h, int r, int r0, int jb, int band0, const LAS unsigned char* Kl = nullptr, int arow0 = 0, const LAS unsigned char* Vl = nullptr) {
    const int qi = lane & 15, g = lane >> 4;
    bf16x8 qf[2];
#pragma unroll
    for (int ks = 0; ks < 2; ++ks) qf[ks] = *(const bf16x8*)(Q + (size_t)qi * ldq + ks * 32 + 8 * g);
    f32x4 s[16];
    const int krow = 8 * (qi >> 2) + (qi & 3);
#pragma unroll
    for (int t = 0; t < 16; ++t) {
        bf16x8 k0, k1;
        if constexpr (KLDS) {
            const int kcol = band0 + krow + 4 * (t & 1), swz = (((kcol >> 3) & 3) << 1) | ((kcol >> 1) & 1);
            const LAS unsigned char* kb = Kl + ((arow0 + (t >> 1)) * KRS + kcol) * 128;
            k0 = *(const LAS bf16x8*)(kb + ((g ^ swz) << 4)); k1 = *(const LAS bf16x8*)(kb + (((4 + g) ^ swz) << 4));
        } else {
            const bf16* kp = Kb + (size_t)(ktok0 + (t >> 1) * trs + krow + 4 * (t & 1)) * ldk + 8 * g;
            k0 = *(const bf16x8*)kp; k1 = *(const bf16x8*)(kp + 32);
        }
        f32x4 z = {0.f, 0.f, 0.f, 0.f};
        z = __builtin_amdgcn_mfma_f32_16x16x32_bf16(k0, qf[0], z, 0, 0, 0);
        z = __builtin_amdgcn_mfma_f32_16x16x32_bf16(k1, qf[1], z, 0, 0, 0);
        s[t] = z;
        if constexpr (KLDS) { if ((t & 3) == 3) __builtin_amdgcn_sched_barrier(0); }
    }
    bf16x8 vfa[VLDS ? 1 : 4][VLDS ? 1 : 8];
    if constexpr (!VLDS) {
#pragma unroll
        for (int mt = 0; mt < 4; ++mt)
#pragma unroll
            for (int kk = 0; kk < 8; ++kk) vfa[mt][kk] = *(const bf16x8*)(Vt + (size_t)(16 * mt + qi) * ldv + ktok0 + kk * trs + 8 * g);
        __builtin_amdgcn_sched_barrier(0);
    }
    float m = -INFINITY;
    if constexpr (NA) {
        const int qc = 16 * jb + qi, cs = min(max(qc - 8, 0), 48);
        const LAS float* bp = rpb_h + (r0 - r + 7) * 31 + (band0 + 8 * g - qc + 15);
        bool ok[2][4];
#pragma unroll
        for (int hh = 0; hh < 2; ++hh)
#pragma unroll
            for (int i = 0; i < 4; ++i) { const int kc = band0 + 8 * g + 4 * hh + i; ok[hh][i] = (kc >= cs) && (kc < cs + 16); }
#pragma unroll
        for (int t = 0; t < 16; ++t)
#pragma unroll
            for (int i = 0; i < 4; ++i) {
                const float bv = bp[(t >> 1) * 31 + 4 * (t & 1) + i];
                const float v = ok[t & 1][i] ? s[t][i] + bv : -INFINITY;
                s[t][i] = v; m = fmaxf(m, v);
            }
    } else {
#pragma unroll
        for (int t = 0; t < 16; ++t)
#pragma unroll
            for (int i = 0; i < 4; ++i) m = fmaxf(m, s[t][i]);
    }
    m = fmaxf(m, __shfl_xor(m, 16)); m = fmaxf(m, __shfl_xor(m, 32));
    float l = 0.f;
    bf16x8 pf[8];
#pragma unroll
    for (int kk = 0; kk < 8; ++kk) {
        float p[8];
#pragma unroll
        for (int i = 0; i < 4; ++i) { p[i] = __builtin_amdgcn_exp2f(s[2 * kk][i] - m); p[4 + i] = __builtin_amdgcn_exp2f(s[2 * kk + 1][i] - m); }
#pragma unroll
        for (int i = 0; i < 8; ++i) l += p[i];
        v4u w; w.x = pk2(p[0], p[1]); w.y = pk2(p[2], p[3]); w.z = pk2(p[4], p[5]); w.w = pk2(p[6], p[7]);
        pf[kk] = __builtin_bit_cast(bf16x8, w);
    }
    l += __shfl_xor(l, 16); l += __shfl_xor(l, 32);
    const float inv = __builtin_amdgcn_rcpf(l);
#pragma unroll
    for (int mt = 0; mt < 4; ++mt) {
        f32x4 acc = {0.f, 0.f, 0.f, 0.f};
#pragma unroll
        for (int kk = 0; kk < 8; ++kk) {
            bf16x8 vf; if constexpr (VLDS) vf = *(const LAS bf16x8*)(Vl + (16 * mt + qi) * 512 + (((4 * kk + g) ^ qi) << 4));
            else vf = vfa[mt][kk];
            acc = __builtin_amdgcn_mfma_f32_16x16x32_bf16(vf, pf[kk], acc, 0, 0, 0);
        }
        v2u w; w.x = pk2(acc[0] * inv, acc[1] * inv); w.y = pk2(acc[2] * inv, acc[3] * inv);
        *(v2u*)(O + (size_t)qi * ldo + 16 * mt + 4 * g) = w;
        if constexpr (VLDS) __builtin_amdgcn_sched_barrier(0);
    }
}
__device__ __forceinline__ void memattn_strip(const Frame& F, int item, const bf16* act, int ld, int qoff, const bf16* memk, const bf16* memvt, bf16* mix) {
    const int tg = item & 15, h = (item >> 4) & 3, b = item >> 6, lane = F.lane, wave = F.wave;
    LAS unsigned char* Kl = F.lds; LAS unsigned char* Vl = F.lds + 32768;
#pragma unroll
    for (int j = 0; j < 4; ++j) {
        const int p = (wave * 4 + j) * 64 + lane, key = p >> 3, kpos = p & 7, kc = key & 31, swz = (((kc >> 3) & 3) << 1) | ((kc >> 1) & 1);
        __builtin_amdgcn_global_load_lds((const unsigned*)(memk + (size_t)(b * 256 + key) * 256 + h * 64 + ((kpos ^ swz) << 3)), (LAS unsigned*)(Kl + (wave * 4 + j) * 1024), 16, 0, 0);
        const int d = p >> 5, vpos = p & 31;
        __builtin_amdgcn_global_load_lds((const unsigned*)(memvt + (size_t)(h * 64 + d) * MEM_ROWS + b * 256 + ((vpos ^ (d & 15)) << 3)), (LAS unsigned*)(Vl + (wave * 4 + j) * 1024), 16, 0, 0);
    }
    asm volatile("s_waitcnt vmcnt(0)\n\ts_barrier" ::: "memory");
#pragma unroll 1
    for (int u = 0; u < 2; ++u) {
        const int tok0 = b * SEQ + tg * 256 + (wave * 2 + u) * 16;
        attn16<false, true, true, 32>(lane, act + (size_t)tok0 * ld + qoff + h * 64, ld, nullptr, 0, nullptr, 0, 0, 32, mix + (size_t)tok0 * DM + 768 + h * 64, DM, nullptr, 0, 0, 0, 0, Kl, 0, Vl);
    }
    asm volatile("s_waitcnt lgkmcnt(0)\n\ts_barrier" ::: "memory");
}
__device__ __forceinline__ void memattn_item(int it, int lane, const bf16* act, int ld, int qoff, const bf16* memk, const bf16* memvt, bf16* mix) {
    const int tb = it >> 2, h = it & 3, tok0 = tb * 16, b = tok0 >> 12;
    attn16<false>(lane, act + (size_t)tok0 * ld + qoff + h * 64, ld, memk + h * 64, 256, memvt + (size_t)(h * 64) * MEM_ROWS, MEM_ROWS, b * 256, 32,
                  mix + (size_t)tok0 * DM + 768 + h * 64, DM, nullptr, 0, 0, 0, 0);
}
constexpr int NA_RPB_OFF = 122880;
__device__ __forceinline__ void na_strip(const Frame& F, int item, const bf16* act0, const bf16* v0t, bf16* mix) {
    const int s8 = item & 7, h = (item >> 3) % 12, b = (item >> 3) / 12, lane = F.lane, wave = F.wave;
    const int R0 = 8 * s8, rowbase = min(max(R0 - 4, 0), 56), rowend = min(max(R0 + 7 - 4, 0), 56) + 8, nrows = rowend - rowbase;
    LAS unsigned char* Kl = F.lds;
    {
        const int col = wave * 8 + (lane >> 3), pos = lane & 7, swz = (((col >> 3) & 3) << 1) | ((col >> 1) & 1);
        const bf16* src = act0 + (size_t)(b * SEQ + rowbase * 64 + col) * A0_LD + 768 + h * 64 + ((pos ^ swz) << 3);
        for (int j = 0; j < nrows; ++j)
            __builtin_amdgcn_global_load_lds((const unsigned*)(src + (size_t)j * 64 * A0_LD), (LAS unsigned*)(Kl + j * 8192 + wave * 1024), 16, 0, 0);
    }
    asm volatile("s_waitcnt vmcnt(0)\n\ts_barrier" ::: "memory");
    const int r = R0 + wave, r0 = min(max(r - 4, 0), 56);
    const LAS float* rpb = (const LAS float*)(F.lds + NA_RPB_OFF) + h * 465;
#pragma unroll 1
    for (int jb = 0; jb < 4; ++jb) {
        const int band0 = min(max(jb * 16 - 8, 0), 32), tok0 = b * SEQ + r * 64 + jb * 16;
        attn16<true, true>(lane, act0 + (size_t)tok0 * A0_LD + h * 64, A0_LD, nullptr, 0, v0t + (size_t)(h * 64) * NT, NT, b * SEQ + r0 * 64 + band0, 64,
                           mix + (size_t)tok0 * DM + h * 64, DM, rpb, r, r0, jb, band0, Kl, r0 - rowbase);
    }
    asm volatile("s_waitcnt lgkmcnt(0)\n\ts_barrier" ::: "memory");
}
__device__ __forceinline__ void na_item(int it, int lane, const bf16* act0, const bf16* v0t, const LAS float* rpb, bf16* mix) {
    const int jb = it & 3, h = (it >> 2) % 12, br = (it >> 2) / 12, r = br & 63, b = br >> 6;
    const int r0 = min(max(r - 4, 0), 56), band0 = min(max(jb * 16 - 8, 0), 32);
    const int tok0 = b * SEQ + r * 64 + jb * 16;
    attn16<true>(lane, act0 + (size_t)tok0 * A0_LD + h * 64, A0_LD, act0 + 768 + h * 64, A0_LD, v0t + (size_t)(h * 64) * NT, NT, b * SEQ + r0 * 64 + band0, 64,
                 mix + (size_t)tok0 * DM + h * 64, DM, rpb + h * 465, r, r0, jb, band0);
}

__device__ __forceinline__ float logsigmoid(float x) { return fminf(x, 0.f) - log1pf(__expf(-fabsf(x))); }
__device__ __forceinline__ void gla_simple(const Frame& F, int item, const bf16* act1, const bf16* v1t, const float* wgk, const float* bgk, bf16* O) {
    const int b = item >> 3, h = (item >> 1) & 3, dir = item & 1, tid = F.tid;
    LAS float* sh = (LAS float*)F.lds;
    float S[96];
#pragma unroll
    for (int d = 0; d < 96; ++d) S[d] = 0.f;
    float wcol[16], bias = 0.f;
    if (tid < 96) {
#pragma unroll
        for (int r = 0; r < 16; ++r) wcol[r] = wgk[r * 384 + h * 96 + tid];
        bias = bgk[h * 96 + tid];
    }
    for (int tau = 0; tau < SEQ; ++tau) {
        const int token = b * SEQ + (dir ? (SEQ - 1 - tau) : tau);
        LAS float* cur = sh + (tau & 1) * 288;
        if (tid < 96) {
            const bf16* row = act1 + (size_t)token * A1_LD;
            float z = bias;
#pragma unroll
            for (int r = 0; r < 16; ++r) z += bf2f(row[1792 + dir * 16 + r]) * wcol[r];
            cur[tid] = __expf(logsigmoid(z) * (1.0f / 16.0f));
            cur[96 + tid] = bf2f(row[h * 96 + tid]) * 0.10206207261596575f;
            cur[192 + tid] = bf2f(row[384 + h * 96 + tid]);
        }
        __syncthreads();
        if (tid < 192) {
            const float v = bf2f(v1t[(size_t)(h * 192 + tid) * NT + token]);
            float o = 0.f;
            if (dir == 0) {
#pragma unroll
                for (int d = 0; d < 96; ++d) { S[d] = cur[d] * S[d] + cur[192 + d] * v; o += cur[96 + d] * S[d]; }
            } else {
#pragma unroll
                for (int d = 0; d < 96; ++d) { S[d] = cur[d] * S[d]; o += cur[96 + d] * S[d]; S[d] += cur[192 + d] * v; }
            }
            O[(size_t)token * 768 + h * 192 + tid] = (bf16)f2bf(o);
        }
    }
    __syncthreads();
}

constexpr int GP_LD = 392;
__device__ __forceinline__ void gla_pre_item(const Frame& F, int item, const bf16* act1, const float* W, const float* Bi, bf16* QT, bf16* KT, bf16* KDT, float* DEC) {
    const int n = item & 63, dir = (item >> 6) & 1, b = item >> 7, base = b * SEQ + n * 64;
    const int tid = F.tid, lane = F.lane, wave = F.wave, qi = lane & 15, g = lane >> 4;
    LAS bf16* EL = (LAS bf16*)F.lds; LAS bf16* KDL = EL + 64 * GP_LD;
    {   bf16x8 zf[4];
#pragma unroll
        for (int ct = 0; ct < 4; ++ct) { const int c = 16 * ct + qi, tok = dir ? base + 63 - c : base + c;
            bf16x8 z = {0, 0, 0, 0, 0, 0, 0, 0}; if (g < 2) z = *(const bf16x8*)(act1 + (size_t)tok * A1_LD + 1792 + dir * 16 + 8 * g); zf[ct] = z; }
#pragma unroll 1
        for (int jj = 0; jj < 3; ++jj) {
            const int j = 16 * (wave + 8 * jj) + qi;
            v4u wu = {0u, 0u, 0u, 0u};
            if (g < 2) { const float* wp = W + (size_t)(8 * g) * 384 + j;
                wu.x = pk2(wp[0], wp[384]); wu.y = pk2(wp[768], wp[1152]); wu.z = pk2(wp[1536], wp[1920]); wu.w = pk2(wp[2304], wp[2688]); }
            const bf16x8 wfr = __builtin_bit_cast(bf16x8, wu);
            const float bias = Bi[j]; float carry = 0.f;
#pragma unroll
            for (int ct = 0; ct < 4; ++ct) {
                f32x4 d = {0.f, 0.f, 0.f, 0.f};
                d = __builtin_amdgcn_mfma_f32_16x16x32_bf16(zf[ct], wfr, d, 0, 0, 0);
                float p[4];
#pragma unroll
                for (int i = 0; i < 4; ++i) { const float x = d[i] + bias; p[i] = (fminf(x, 0.f) - __logf(1.0f + __expf(-fabsf(x)))) * 0.0625f; }
                p[1] += p[0]; p[2] += p[1]; p[3] += p[2];
                float a = p[3]; float t = __shfl_up(a, 16); if (g >= 1) a += t; t = __shfl_up(a, 32); if (g >= 2) a += t;
                const float excl = a - p[3] + carry;
                carry += __shfl(a, 48 + qi);
#pragma unroll
                for (int i = 0; i < 4; ++i) { const int c = 16 * ct + 4 * g + i, ctok = dir ? 63 - c : c; EL[ctok * GP_LD + j] = (bf16)f2bf(__expf(excl + p[i])); }
            }
        }
    }
    __syncthreads();
    const int clast = dir ? 0 : 63;
#pragma unroll 2
    for (int k = 0; k < 6; ++k) {
        const int idx = tid + 512 * k, c = idx / 48, jg = idx % 48;
        const bf16* arow = act1 + (size_t)(base + c) * A1_LD + 8 * jg;
        const v4u q8 = *(const v4u*)arow, k8 = *(const v4u*)(arow + 384);
        const v4u e8 = *(const LAS v4u*)(EL + c * GP_LD + 8 * jg), l8 = *(const LAS v4u*)(EL + clast * GP_LD + 8 * jg);
        const unsigned qa[4] = {q8.x, q8.y, q8.z, q8.w}, ka[4] = {k8.x, k8.y, k8.z, k8.w}, ea[4] = {e8.x, e8.y, e8.z, e8.w}, la[4] = {l8.x, l8.y, l8.z, l8.w};
        unsigned qo[4], ko[4], dq[4];
        float lf[8];
#pragma unroll
        for (int i = 0; i < 4; ++i) {
            const float e0 = bflo(ea[i]), e1 = bfhi(ea[i]), i0 = __builtin_amdgcn_rcpf(e0), i1 = __builtin_amdgcn_rcpf(e1);
            const float kt0 = bflo(ka[i]) * i0, kt1 = bfhi(ka[i]) * i1; lf[2 * i] = bflo(la[i]); lf[2 * i + 1] = bfhi(la[i]);
            qo[i] = pk2(bflo(qa[i]) * 0.10206207261596575f * e0, bfhi(qa[i]) * 0.10206207261596575f * e1);
            ko[i] = pk2(kt0, kt1); dq[i] = pk2(kt0 * lf[2 * i], kt1 * lf[2 * i + 1]);
        }
        v4u w; w.x = qo[0]; w.y = qo[1]; w.z = qo[2]; w.w = qo[3]; *(v4u*)(QT + (size_t)(base + c) * 384 + 8 * jg) = w;
        w.x = ko[0]; w.y = ko[1]; w.z = ko[2]; w.w = ko[3]; *(v4u*)(KT + (size_t)(base + c) * 384 + 8 * jg) = w;
        w.x = dq[0]; w.y = dq[1]; w.z = dq[2]; w.w = dq[3]; *(LAS v4u*)(KDL + c * GP_LD + 8 * jg) = w;
        if (c == clast) { float* dp = DEC + (size_t)((b * 4 + jg / 12) * 64 + n) * 96 + (jg % 12) * 8;
            *(f32x4*)dp = (f32x4){lf[0], lf[1], lf[2], lf[3]}; *(f32x4*)(dp + 4) = (f32x4){lf[4], lf[5], lf[6], lf[7]}; }
    }
    __syncthreads();
#pragma unroll 2
    for (int k = 0; k < 6; ++k) {
        const int idx = tid + 512 * k, j = idx % 384, cg = idx / 384, h = j / 96, d = j % 96;
        const LAS bf16* sp = KDL + (8 * cg) * GP_LD + j;
        v4u w; w.x = (unsigned)sp[0] | ((unsigned)sp[GP_LD] << 16); w.y = (unsigned)sp[2 * GP_LD] | ((unsigned)sp[3 * GP_LD] << 16);
        w.z = (unsigned)sp[4 * GP_LD] | ((unsigned)sp[5 * GP_LD] << 16); w.w = (unsigned)sp[6 * GP_LD] | ((unsigned)sp[7 * GP_LD] << 16);
        *(v4u*)(KDT + ((size_t)((b * 4 + h) * 64 + n) * 96 + d) * 64 + 8 * cg) = w;
    }
    __syncthreads();
}
constexpr int GL_QT = 0, GL_KT = 13312, GL_KDT = 26624, GL_VT = 40960, GL_DEC = 48128, GL_BUF = 49152;
__device__ __forceinline__ void gla_main_item(const Frame& F, int item, const bf16* QTa, const bf16* KTa, const bf16* KDT0, const bf16* KDT1, const float* DECa, const bf16* v1t, bf16* OFp, bf16* OBp) {
    const int vs = item & 3, dir = (item >> 2) & 1, h = (item >> 3) & 3, b = item >> 5;
    const int lane = F.lane, wave = F.wave, qi = lane & 15, g = lane >> 4, ct = wave & 3, vh = wave >> 2;
    bf16* O = dir ? OBp : OFp;
    LAS unsigned char* L = F.lds;
    unsigned off[6];
#pragma unroll
    for (int jj = 0; jj < 6; ++jj) { const int k = wave + 8 * jj; unsigned o;
        if (k < 26) { const int gi = (k < 13 ? k : k - 13) * 64 + lane, row = gi / 13, col = gi % 13; o = (unsigned)(row * 768 + (col < 12 ? col * 16 : 0)); }
        else if (k < 40) { const int gi = (k - 26) * 64 + lane, row = gi / 9, col = gi % 9; o = (gi < 864) ? (unsigned)(row * 128 + (col < 8 ? col * 16 : 0)) : 0u; }
        else if (k < 47) { const int gi = (k - 40) * 64 + lane, row = gi / 9, col = gi % 9; o = (gi < 432) ? (unsigned)(row * NT * 2 + (col < 8 ? col * 16 : 0)) : 0u; }
        else o = (lane < 24) ? (unsigned)(lane * 16) : 0u;
        off[jj] = o; }
    const char* qtb = (const char*)(QTa + (size_t)dir * NT * 384 + h * 96); const char* ktb = (const char*)(KTa + (size_t)dir * NT * 384 + h * 96);
    const char* kdb = (const char*)(dir ? KDT1 : KDT0) + (size_t)((b * 4 + h) * 64) * 12288; const char* deb = (const char*)(DECa + (size_t)dir * 8 * 4 * 64 * 96 + (size_t)((b * 4 + h) * 64) * 96);
    const char* vtb = (const char*)(v1t + (size_t)(h * 192 + vs * 48) * NT);
#define GL_DMA(n_, bufo_) do { const int nn_ = dir ? 63 - (n_) : (n_); const size_t tb_ = (size_t)(b * SEQ + nn_ * 64); \
        _Pragma("unroll") for (int jj_ = 0; jj_ < 6; ++jj_) { const int k_ = wave + 8 * jj_; \
            const char* src_ = k_ < 13 ? qtb + tb_ * 768 : (k_ < 26 ? ktb + tb_ * 768 : (k_ < 40 ? kdb + (size_t)nn_ * 12288 : (k_ < 47 ? vtb + tb_ * 2 : deb + (size_t)nn_ * 384))); \
            __builtin_amdgcn_global_load_lds((const unsigned*)(src_ + off[jj_]), (LAS unsigned*)(L + (bufo_) + k_ * 1024), 16, 0, 0); } } while (0)
    f32x4 S[2][6];
#pragma unroll
    for (int vi = 0; vi < 2; ++vi)
#pragma unroll
        for (int dt = 0; dt < 6; ++dt) S[vi][dt] = (f32x4){0.f, 0.f, 0.f, 0.f};
    GL_DMA(0, 0);
    asm volatile("s_waitcnt vmcnt(0)\n\ts_barrier" ::: "memory");
#pragma unroll 1
    for (int n = 0; n < 64; ++n) {
        const int bo = (n & 1) * GL_BUF;
        if (n + 1 < 64) GL_DMA(n + 1, GL_BUF - bo);
        LAS unsigned char* Bf = L + bo;
        bf16x8 qf[3];
#pragma unroll
        for (int ks = 0; ks < 3; ++ks) qf[ks] = *(const LAS bf16x8*)(Bf + GL_QT + (16 * ct + qi) * 208 + (32 * ks + 8 * g) * 2);
        f32x4 am[4];
#pragma unroll
        for (int tp = 0; tp < 4; ++tp) {
            f32x4 z = {0.f, 0.f, 0.f, 0.f};
            if (dir ? (tp >= ct) : (tp <= ct)) {
#pragma unroll
                for (int ks = 0; ks < 3; ++ks) { const bf16x8 kf = *(const LAS bf16x8*)(Bf + GL_KT + (16 * tp + qi) * 208 + (32 * ks + 8 * g) * 2);
                    z = __builtin_amdgcn_mfma_f32_16x16x32_bf16(kf, qf[ks], z, 0, 0, 0); }
                const int c = 16 * ct + qi;
#pragma unroll
                for (int i = 0; i < 4; ++i) { const int cp = 16 * tp + 4 * g + i; const bool keep = dir ? (cp > c) : (cp <= c); z[i] = keep ? z[i] : 0.f; }
            }
            am[tp] = z;
        }
        bf16x8 pf[2];
#pragma unroll
        for (int kk = 0; kk < 2; ++kk) { v4u w; w.x = pk2(am[2 * kk][0], am[2 * kk][1]); w.y = pk2(am[2 * kk][2], am[2 * kk][3]); w.z = pk2(am[2 * kk + 1][0], am[2 * kk + 1][1]); w.w = pk2(am[2 * kk + 1][2], am[2 * kk + 1][3]);
            pf[kk] = __builtin_bit_cast(bf16x8, w); }
        bf16x8 qp[3];
#pragma unroll
        for (int kk = 0; kk < 3; ++kk) { const LAS unsigned char* qr = Bf + GL_QT + (16 * ct + qi) * 208 + (32 * kk + 4 * g) * 2;
            const s16x4 a0 = *(const LAS s16x4*)qr, a1 = *(const LAS s16x4*)(qr + 32); qp[kk] = __builtin_shufflevector(a0, a1, 0, 1, 2, 3, 4, 5, 6, 7); }
        const int nn = dir ? 63 - n : n, tok = b * SEQ + nn * 64 + 16 * ct + qi;
#pragma unroll
        for (int vi = 0; vi < 2; ++vi) {
            if (vi == 1 && vh == 1) break;
            const int vt = 2 * vh + vi;
            f32x4 acc = {0.f, 0.f, 0.f, 0.f};
#pragma unroll
            for (int kk = 0; kk < 2; ++kk) { const LAS unsigned char* vr = Bf + GL_VT + (16 * vt + qi) * 144 + (32 * kk + 4 * g) * 2;
                const s16x4 a0 = *(const LAS s16x4*)vr, a1 = *(const LAS s16x4*)(vr + 32); const bf16x8 vf = __builtin_shufflevector(a0, a1, 0, 1, 2, 3, 4, 5, 6, 7);
                acc = __builtin_amdgcn_mfma_f32_16x16x32_bf16(vf, pf[kk], acc, 0, 0, 0); }
#pragma unroll
            for (int kk = 0; kk < 3; ++kk) { v4u w; w.x = pk2(S[vi][2 * kk][0], S[vi][2 * kk][1]); w.y = pk2(S[vi][2 * kk][2], S[vi][2 * kk][3]); w.z = pk2(S[vi][2 * kk + 1][0], S[vi][2 * kk + 1][1]); w.w = pk2(S[vi][2 * kk + 1][2], S[vi][2 * kk + 1][3]);
                acc = __builtin_amdgcn_mfma_f32_16x16x32_bf16(__builtin_bit_cast(bf16x8, w), qp[kk], acc, 0, 0, 0); }
            v2u w; w.x = pk2(acc[0], acc[1]); w.y = pk2(acc[2], acc[3]);
            *(v2u*)(O + (size_t)tok * 768 + h * 192 + vs * 48 + 16 * vt + 4 * g) = w;
            bf16x8 vfr[2];
#pragma unroll
            for (int ks = 0; ks < 2; ++ks) vfr[ks] = *(const LAS bf16x8*)(Bf + GL_VT + (16 * vt + qi) * 144 + (32 * ks + 8 * g) * 2);
#pragma unroll
            for (int dt = 0; dt < 6; ++dt) {
                const f32x4 dec = *(const LAS f32x4*)(Bf + GL_DEC + (16 * dt + 4 * g) * 4);
                f32x4 sv = S[vi][dt]; sv[0] *= dec[0]; sv[1] *= dec[1]; sv[2] *= dec[2]; sv[3] *= dec[3];
#pragma unroll
                for (int ks = 0; ks < 2; ++ks) { const bf16x8 kdf = *(const LAS bf16x8*)(Bf + GL_KDT + (16 * dt + qi) * 144 + (32 * ks + 8 * g) * 2);
                    sv = __builtin_amdgcn_mfma_f32_16x16x32_bf16(kdf, vfr[ks], sv, 0, 0, 0); }
                S[vi][dt] = sv;
            }
        }
        if (vh) asm volatile("s_waitcnt vmcnt(1) lgkmcnt(0)\n\ts_barrier" ::: "memory"); else asm volatile("s_waitcnt vmcnt(2) lgkmcnt(0)\n\ts_barrier" ::: "memory");
    }
    __syncthreads();
#undef GL_DMA
}

__device__ __forceinline__ void finalize_rstd(const Frame& F, const float* rss, float* rstd) {
    for (int row = F.bid * NTHR + F.tid; row < NT; row += F.G * NTHR) rstd[row] = rstd_from(rss + (size_t)row * 16);
}
__device__ __forceinline__ void gla_combine(const Frame& F, const bf16* OF, const bf16* OB, const bf16* act1, const float* gnorm, bf16* mix) {
    for (int token = F.gw; token < NT; token += F.NGW) {
        const int lane = F.lane;
#pragma unroll
        for (int h = 0; h < 4; ++h) {
            float o[3]; float ss = 0.f;
#pragma unroll
            for (int j = 0; j < 3; ++j) { const size_t idx = (size_t)token * 768 + h * 192 + j * 64 + lane; o[j] = bf2f(OF[idx]) + bf2f(OB[idx]); ss += o[j] * o[j]; }
            ss = wave_sum(ss);
            const float rs = 1.0f / sqrtf(ss * (1.0f / 192.0f) + EPS);
#pragma unroll
            for (int j = 0; j < 3; ++j) { const int dv = j * 64 + lane; const float g = bf2f(act1[(size_t)token * A1_LD + 768 + h * 192 + dv]);
                const float val = o[j] * rs * gnorm[dv] * (g / (1.0f + __expf(-g)));
                mix[(size_t)token * DM + h * 192 + dv] = (bf16)f2bf(val); }
        }
    }
}
__device__ __forceinline__ void route_pick(const float (&acc)[8], int token, int* topi, float* topw, LAS int* lc) {
    int e0 = 0; float l0 = acc[0];
#pragma unroll
    for (int e = 1; e < 8; ++e) if (acc[e] > l0) { l0 = acc[e]; e0 = e; }
    int e1 = -1; float l1 = -INFINITY;
#pragma unroll
    for (int e = 0; e < 8; ++e) if (e != e0 && acc[e] > l1) { l1 = acc[e]; e1 = e; }
    if (e1 < 0) { e1 = (e0 + 1) & 7; l1 = l0; }
    const float w0 = 1.0f / (1.0f + __expf(l1 - l0));
    topi[token] = e0 | (e1 << 8); topw[2 * token] = w0; topw[2 * token + 1] = 1.0f - w0;
    atomicAdd((int*)&lc[e0], 1); atomicAdd((int*)&lc[8 + e1], 1);
}
__device__ __forceinline__ void route1(const Frame& F, const float* H, const float* gain, const float* wr, int* topi, float* topw, int* cnt, float* rstd) {
    LAS int* lc = (LAS int*)F.lds;
    if (F.tid < 16) lc[F.tid] = 0;
    __syncthreads();
    const int lane = F.lane;
    float w[4][4][8];
#pragma unroll
    for (int j = 0; j < 4; ++j) { const f32x4 g = *(const f32x4*)(gain + 256 * j + 4 * lane);
#pragma unroll
        for (int i = 0; i < 4; ++i) { const float* p = wr + (size_t)(256 * j + 4 * lane + i) * 8; const f32x4 a = *(const f32x4*)p, b = *(const f32x4*)(p + 4); const float gi = g[i];
            w[j][i][0] = a.x * gi; w[j][i][1] = a.y * gi; w[j][i][2] = a.z * gi; w[j][i][3] = a.w * gi; w[j][i][4] = b.x * gi; w[j][i][5] = b.y * gi; w[j][i][6] = b.z * gi; w[j][i][7] = b.w * gi; } }
    for (int t2 = 0; t2 < 16; t2 += 2) {
        const int token = F.bid * 128 + F.wave * 16 + t2;
        const f32x4* h0 = (const f32x4*)(H + (size_t)token * DM) + lane; const f32x4* h1 = h0 + DM / 4;
        f32x4 x0[4], x1[4];
#pragma unroll
        for (int j = 0; j < 4; ++j) x0[j] = h0[64 * j];
#pragma unroll
        for (int j = 0; j < 4; ++j) x1[j] = h1[64 * j];
        float a0[8], a1[8], s0 = 0.f, s1 = 0.f;
#pragma unroll
        for (int e = 0; e < 8; ++e) { a0[e] = 0.f; a1[e] = 0.f; }
#pragma unroll
        for (int j = 0; j < 4; ++j)
#pragma unroll
            for (int i = 0; i < 4; ++i) { const float u = x0[j][i], v = x1[j][i]; s0 += u * u; s1 += v * v;
#pragma unroll
                for (int e = 0; e < 8; ++e) { a0[e] += u * w[j][i][e]; a1[e] += v * w[j][i][e]; } }
        s0 = wave_sum(s0); s1 = wave_sum(s1);
        const float r0 = 1.0f / sqrtf(s0 * (1.0f / DM) + EPS), r1 = 1.0f / sqrtf(s1 * (1.0f / DM) + EPS);
#pragma unroll
        for (int e = 0; e < 8; ++e) { a0[e] = wave_sum(a0[e]) * r0; a1[e] = wave_sum(a1[e]) * r1; }
        if (lane == 0) { route_pick(a0, token, topi, topw, lc); route_pick(a1, token + 1, topi, topw, lc); rstd[token] = r0; rstd[token + 1] = r1; }
    }
    __syncthreads();
    if (F.tid < 16) cnt[F.bid * 16 + F.tid] = lc[F.tid];
    __syncthreads();
}
__device__ __forceinline__ void route2(const Frame& F, const int* topi, const float* topw, const int* cnt, int* stok, float* sw, int* blk) {
    LAS int* part = (LAS int*)F.lds;
    LAS int* base = part + 1024;
    LAS int* tk = base + 64;
    const int tid = F.tid, pe = tid & 15, jg = tid >> 4;
    int below = 0, tot = 0;
    for (int w = jg; w < F.G; w += 32) { const int v = cnt[w * 16 + pe]; tot += v; if (w < F.bid) below += v; }
    part[jg * 16 + pe] = below; part[512 + jg * 16 + pe] = tot;
    if (tid < 128) tk[tid] = topi[F.bid * 128 + tid];
    __syncthreads();
    if (tid < 16) { int b = 0, t = 0; for (int j = 0; j < 32; ++j) { b += part[j * 16 + tid]; t += part[512 + j * 16 + tid]; } base[tid] = b; base[16 + tid] = t; }
    __syncthreads();
    if (tid < 2) { int ps = 0; for (int e = 0; e < 8; ++e) { base[32 + tid * 8 + e] = ps; ps += (base[16 + tid * 8 + e] + 255) / 256 * 256; } base[48 + tid] = ps / 256; }
    __syncthreads();
    if (tid < 256) {
        const int p = tid >> 7, i = tid & 127; const int e = (tk[i] >> (8 * p)) & 0xff;
        int rank = 0; for (int j = 0; j < i; ++j) rank += (((tk[j] >> (8 * p)) & 0xff) == e) ? 1 : 0;
        const int slot = base[32 + p * 8 + e] + base[p * 8 + e] + rank; const int token = F.bid * 128 + i;
        stok[p * SLOT_CAP + slot] = token; sw[p * SLOT_CAP + slot] = topw[2 * token + p];
    }
    if (F.bid < 16) {
        const int p = F.bid >> 3, e = F.bid & 7, ps = base[32 + F.bid], t = base[16 + F.bid], pend = ps + (t + 255) / 256 * 256;
        for (int s = ps + t + tid; s < pend; s += NTHR) { stok[p * SLOT_CAP + s] = -1; sw[p * SLOT_CAP + s] = 0.f; }
        for (int bk = ps / 256 + tid; bk < pend / 256; bk += NTHR) blk[16 + p * 256 + bk] = e;
        if (e == 0 && tid == 0) blk[p] = base[48 + p];
    }
    __syncthreads();
}
__device__ __forceinline__ void final_norm_slots(int lane, float* H, const bf16* Y, const float* gain, const int* tok, int s0, int s1, int first, int stride) {
    for (int sl = s0 + first; sl < s1; sl += stride) {
        const int row = tok[sl]; if (row < 0) continue;
        GAS f32x4* xr = (GAS f32x4*)(H + (size_t)row * DM) + lane; const f32x4* gr = (const f32x4*)gain + lane; const v2u* yr = (const v2u*)(Y + (size_t)sl * DM) + lane;
        f32x4 v[4]; float s = 0.f;
#pragma unroll
        for (int j = 0; j < 4; ++j) { const v2u y = yr[64 * j]; v[j] = xr[64 * j]; v[j].x += bflo(y.x); v[j].y += bfhi(y.x); v[j].z += bflo(y.y); v[j].w += bfhi(y.y); s += (v[j].x * v[j].x + v[j].y * v[j].y) + (v[j].z * v[j].z + v[j].w * v[j].w); }
        s = wave_sum(s); const float rs = 1.0f / sqrtf(s * (1.0f / DM) + EPS);
#pragma unroll
        for (int j = 0; j < 4; ++j) { const f32x4 g = gr[64 * j]; f32x4 o = {v[j].x * rs * g.x, v[j].y * rs * g.y, v[j].z * rs * g.z, v[j].w * rs * g.w}; xr[64 * j] = o; }
    }
}
__device__ __forceinline__ void final_norm(const Frame& F, float* H, const float* gain) {
    for (int row = F.gw; row < NT; row += F.NGW) {
        GAS f32x4* xr = (GAS f32x4*)(H + (size_t)row * DM) + F.lane; const f32x4* gr = (const f32x4*)gain + F.lane;
        f32x4 v[4]; float s = 0.f;
#pragma unroll
        for (int j = 0; j < 4; ++j) { v[j] = xr[64 * j]; s += (v[j].x * v[j].x + v[j].y * v[j].y) + (v[j].z * v[j].z + v[j].w * v[j].w); }
        s = wave_sum(s); const float rs = 1.0f / sqrtf(s * (1.0f / DM) + EPS);
#pragma unroll
        for (int j = 0; j < 4; ++j) { const f32x4 g = gr[64 * j]; f32x4 o = {v[j].x * rs * g.x, v[j].y * rs * g.y, v[j].z * rs * g.z, v[j].w * rs * g.w}; xr[64 * j] = o; }
    }
}

constexpr int N_PHASES = 17;
__global__ void __launch_bounds__(NTHR, 2) mega(Args args) {
    extern __shared__ __attribute__((aligned(16))) unsigned char lds_raw[];
    Frame F;
    F.lds = (LAS unsigned char*)lds_raw;
    F.tid = threadIdx.x; F.lane = F.tid & 63; F.wave = __builtin_amdgcn_readfirstlane(F.tid >> 6);
    F.G = gridDim.x; F.bid = blockIdx.x; F.gw = F.bid * NWAVES + F.wave; F.NGW = F.G * NWAVES; F.ws = args.ws;
    unsigned char* ws = args.ws;
    gu32* ctl = (gu32*)(ws + WS_CTL);
    volatile LAS unsigned* MISC = (volatile LAS unsigned*)(F.lds + MISC_OFF);
    for (int u = F.tid; u < (LDS_BYTES - LDSCTL_OFF) / 4; u += NTHR) ((LAS unsigned*)(F.lds + LDSCTL_OFF))[u] = 0u;
    __syncthreads();
    XcdBarrier bar = xcd_barrier_post((unsigned*)(ctl + CW_BAR), MISC + 8);
    const int lo = args.ph_lo, hi = args.ph_hi;
#ifndef PH_MASK
#define PH_MASK 0x1ffff
#endif
#define IN(k) (((PH_MASK >> (k)) & 1) && lo <= (k) && (k) < hi)
#ifndef REPEAT_MASK
#define REPEAT_MASK 0
#endif
#define REPS(k) (1 + ((REPEAT_MASK >> (k)) & 1))
#define SEAM(k) do { if (IN(k) && IN((k) + 1)) xcd_barrier(bar); } while (0)

    float* H = args.out;
    float* rss = (float*)(ws + WS_RSS); float* rstd = (float*)(ws + WS_RSTD);
    bf16* hbf = (bf16*)(ws + WS_HBF); bf16* membf = (bf16*)(ws + WS_MEMBF); bf16* memk = (bf16*)(ws + WS_MEMK); bf16* memvt = (bf16*)(ws + WS_MEMVT);
    bf16* act0 = (bf16*)(ws + WS_ACT0); bf16* v0t = (bf16*)(ws + WS_V0T); bf16* mix = (bf16*)(ws + WS_MIX); bf16* hmid0 = (bf16*)(ws + WS_HMID0);
    bf16* act1 = (bf16*)(ws + WS_ACT1); bf16* v1t = (bf16*)(ws + WS_V1T); bf16* OF = (bf16*)(ws + WS_OF); bf16* OB = (bf16*)(ws + WS_OB);
    bf16* hmid1 = (bf16*)(ws + WS_HMID1); bf16* wgu = (bf16*)(ws + WS_WGU); bf16* wdn = (bf16*)(ws + WS_WDN);
    int* cnt = (int*)(ws + WS_CNT); int* topi = (int*)(ws + WS_TOPI); float* topw = (float*)(ws + WS_TOPW);
    int* stok = (int*)(ws + WS_STOK); float* sw = (float*)(ws + WS_SW); int* blk = (int*)(ws + WS_BLK);
    LAS float* scr = (LAS float*)(F.lds + F.wave * 16384);

    if (IN(0)) {
        int it = F.gw; LAS unsigned* T0 = (LAS unsigned*)scr; LAS unsigned* T1 = T0 + 1088;
#define CVT(Wp, Kd, Nd, WTp, gainp, kind) do { const CvtJob J{Wp, Kd, Nd, (bf16*)(WTp), gainp, kind}; const int n_ = ((Kd) / 64) * ((Nd) / 32); \
            while (it < n_) { CvtRegs A_, B_; B_.valid = 0; cvt_load(A_, J, it, F.lane); it += F.NGW; if (it < n_) { cvt_load(B_, J, it, F.lane); it += F.NGW; } cvt_finish(A_, T0, F.lane); cvt_finish(B_, T1, F.lane); } \
            it -= n_; } while (0)
        CVT(args.in[I_EWIN], 1024, 2560, ws + WS_W0IN, args.in[I_EN1], 1);
        CVT(args.in[I_EWIN], 1024, 2560, ws + WS_WV0, args.in[I_EN1], 2);
        CVT(args.in[I_EWOUT], 1024, 1024, ws + WS_W0OUT, nullptr, 0);
        CVT(args.in[I_EWG], 1024, 2816, ws + WS_W0GU, args.in[I_EN2], 3);
        CVT(args.in[I_EWU], 1024, 2816, ws + WS_W0GU, args.in[I_EN2], 4);
        CVT(args.in[I_EWD], 2816, 1024, ws + WS_W0DN, nullptr, 0);
        CVT(args.in[I_WMKV], 1024, 512, ws + WS_WMEM, args.in[I_MNORM], 0);
        CVT(args.in[I_OWIN], 1024, 2592, ws + WS_W1IN, args.in[I_ON1], 5);
        CVT(args.in[I_OWIN], 1024, 2592, ws + WS_WV1, args.in[I_ON1], 6);
        CVT(args.in[I_OWOUT], 1024, 1024, ws + WS_W1OUT, nullptr, 0);
#undef CVT
        { v4u z = {0u, 0u, 0u, 0u}; v4u* p = (v4u*)(ws + WS_W1IN + (size_t)1824 * 2048); const int n16 = 224 * 2048 / 16;
          for (int i = F.bid * NTHR + F.tid; i < n16; i += F.G * NTHR) p[i] = z; }
        rows_to_bf16(args.in[I_X], hbf, rstd, F.gw, NT, F.NGW, F.lane);
        rows_to_bf16(args.in[I_MEM], membf, rstd + NT, F.gw, MEM_ROWS, F.NGW, F.lane);
    }
    SEAM(0);
    if (IN(1)) {
        { Sched S; S.init(hbf, ws + WS_W0IN, 1024, 128, 7, F.G, F.bid); EpiRowScale E{act0, A0_LD, rstd}; gemm_run<EpiRowScale, false>(F.lds, S, E, nullptr); }
        { Sched S; S.init(ws + WS_WV0, hbf, 1024, 3, 128, F.G, (F.bid + 128) % F.G); EpiColScale E{v0t, NT, rstd}; gemm_run<EpiColScale, false>(F.lds, S, E, nullptr); }
        { Sched S; S.init(membf, ws + WS_WMEM, 1024, 8, 1, F.G, F.bid); EpiRowScale E{memk, 256, rstd + NT}; gemm_run<EpiRowScale, false>(F.lds, S, E, nullptr); }
        { Sched S; S.init(ws + WS_WMEM + 256 * 2048, membf, 1024, 1, 8, F.G, (F.bid + 248) % F.G); EpiColScale E{memvt, MEM_ROWS, rstd + NT}; gemm_run<EpiColScale, false>(F.lds, S, E, nullptr); }
    }
    SEAM(1);
    if (IN(2)) {
#if FAST_ATT
        { LAS float* rl = (LAS float*)(F.lds + NA_RPB_OFF); for (int i = F.tid; i < 5580; i += NTHR) rl[i] = args.in[I_RPB][i] * 1.4426950408889634f; __syncthreads();
          for (int it = F.bid; it < 768; it += F.G) na_strip(F, it, act0, v0t, mix);
          for (int it = F.bid; it < 512; it += F.G) memattn_strip(F, it, act0, A0_LD, 1536, memk, memvt, mix);
          __syncthreads(); }
#else
        na_simple(F, act0, v0t, args.in[I_RPB], mix);
        memattn_simple(F, F.gw, F.NGW, act0, A0_LD, 1536, memk, memvt, mix);
#endif
    }
    SEAM(2);
    if (IN(3)) {
        Sched S; S.init(mix, ws + WS_W0OUT, 1024, 128, 4, F.G, F.bid); EpiResid E{args.in[I_X], H, hbf, rss}; gemm_run<EpiResid, false>(F.lds, S, E, nullptr);
    }
    SEAM(3);
    if (IN(4)) {
        finalize_rstd(F, rss, rstd); xcd_barrier(bar);
        Sched S; S.init(hbf, ws + WS_W0GU, 1024, 128, 22, F.G, F.bid); EpiSwiGLU<false> E{hmid0, FF0, rstd, nullptr}; gemm_run<EpiSwiGLU<false>, false>(F.lds, S, E, nullptr);
    }
    SEAM(4);
    if (IN(5)) {
        Sched S; S.init(hmid0, ws + WS_W0DN, FF0, 128, 4, F.G, F.bid); EpiResid E{H, H, hbf, rss}; gemm_run<EpiResid, false>(F.lds, S, E, nullptr);
    }
    SEAM(5);
    if (IN(6)) {
        finalize_rstd(F, rss, rstd); xcd_barrier(bar);
        { Sched S; S.init(hbf, ws + WS_W1IN, 1024, 128, 8, F.G, F.bid); EpiRowScale E{act1, A1_LD, rstd}; gemm_run<EpiRowScale, false>(F.lds, S, E, nullptr); }
        { Sched S; S.init(ws + WS_WV1, hbf, 1024, 3, 128, F.G, F.bid); EpiColScale E{v1t, NT, rstd}; gemm_run<EpiColScale, false>(F.lds, S, E, nullptr); }
    }
    SEAM(6);
    if (IN(7)) {
#if FAST_GLA
        for (int it = F.bid; it < 1024; it += F.G) { const int dir = (it >> 6) & 1;
            gla_pre_item(F, it, act1, dir ? args.in[I_WGKB] : args.in[I_WGKF], dir ? args.in[I_BGKB] : args.in[I_BGKF], (bf16*)(ws + WS_GQT) + (size_t)dir * NT * 384, (bf16*)(ws + WS_GKT) + (size_t)dir * NT * 384,
                         (bf16*)(ws + (dir ? WS_GKDT1 : WS_GKDT0)), (float*)(ws + WS_GDEC) + (size_t)dir * 8 * 4 * 64 * 96); }
        for (int it = F.bid; it < 512; it += F.G) memattn_strip(F, it, act1, A1_LD, 1536, memk, memvt, mix);
        xcd_barrier(bar);
        for (int it0 = F.bid; it0 < 256; it0 += F.G) { const int it = (F.G == 256) ? ((it0 & 7) * 8 + (it0 >> 5)) * 4 + ((it0 >> 3) & 3) : it0;
            gla_main_item(F, it, (const bf16*)(ws + WS_GQT), (const bf16*)(ws + WS_GKT), (const bf16*)(ws + WS_GKDT0), (const bf16*)(ws + WS_GKDT1), (const float*)(ws + WS_GDEC), v1t, OF, OB); }
#else
        if (F.bid < 64) {
            const int dir = F.bid & 1;
            gla_simple(F, F.bid, act1, v1t, dir ? args.in[I_WGKB] : args.in[I_WGKF], dir ? args.in[I_BGKB] : args.in[I_BGKF], dir ? OB : OF);
        } else {
#if FAST_ATT
            for (int it = (F.bid - 64) * NWAVES + F.wave; it < 8192; it += (F.G - 64) * NWAVES) memattn_item(it, F.lane, act1, A1_LD, 1536, memk, memvt, mix);
#else
            memattn_simple(F, (F.bid - 64) * NWAVES + F.wave, (F.G - 64) * NWAVES, act1, A1_LD, 1536, memk, memvt, mix);
#endif
        }
#endif
    }
    SEAM(7);
    if (IN(8)) gla_combine(F, OF, OB, act1, args.in[I_GNORM], mix);
    SEAM(8);
    if (IN(9)) {
        Sched S; S.init(mix, ws + WS_W1OUT, 1024, 128, 4, F.G, F.bid); EpiResid E{H, H, hbf, rss}; gemm_run<EpiResid, false>(F.lds, S, E, nullptr);
    }
    SEAM(9);
    if (IN(10)) {
        route1(F, H, args.in[I_ON2], args.in[I_WR], topi, topw, cnt, rstd);
        { LAS unsigned* T0 = (LAS unsigned*)scr; LAS unsigned* T1 = T0 + 1088;
#define MOE_JOB(J_, it_) const int e_##J_ = (it_) / 5376, r_##J_ = (it_) % 5376, wh_##J_ = r_##J_ / 1792; \
            const CvtJob J_{wh_##J_ == 0 ? args.in[I_OWG] + (size_t)e_##J_ * 1024 * FFE : (wh_##J_ == 1 ? args.in[I_OWU] + (size_t)e_##J_ * 1024 * FFE : args.in[I_OWD] + (size_t)e_##J_ * FFE * 1024), \
                wh_##J_ == 2 ? FFE : 1024, wh_##J_ == 2 ? 1024 : FFE, wh_##J_ == 2 ? wdn + (size_t)e_##J_ * 1024 * FFE : wgu + (size_t)e_##J_ * 7168 * 1024, wh_##J_ == 2 ? nullptr : args.in[I_ON2], wh_##J_ == 2 ? 0 : 3 + wh_##J_}
          for (int it = F.gw; it < 8 * 3 * 1792; it += 2 * F.NGW) {
            CvtRegs A_, B_; B_.valid = 0;
            { MOE_JOB(Ja, it); cvt_load(A_, Ja, it % 1792, F.lane); }
            if (it + F.NGW < 8 * 3 * 1792) { MOE_JOB(Jb, it + F.NGW); cvt_load(B_, Jb, (it + F.NGW) % 1792, F.lane); }
            cvt_finish(A_, T0, F.lane); cvt_finish(B_, T1, F.lane);
          }
#undef MOE_JOB
        }
    }
    SEAM(10);
    if (IN(11)) route2(F, topi, topw, cnt, stok, sw, blk);
    SEAM(11);
    bf16* ht0 = hmid1 + (size_t)NT * FFE; bf16* ht1 = (bf16*)(ws + WS_HT1);
    if (IN(12)) {
        const int nb = blk[0]; Sched S; S.init(hbf, wgu, 1024, nb, 28, F.G, F.bid, blk + 16, (size_t)7168 * 1024 * 2); EpiSwiGLU<true> E{hmid1, FFE, rstd, ht0}; gemm_run<EpiSwiGLU<true>, true>(F.lds, S, E, stok);
    }
    SEAM(12);
    if (IN(13)) {
        const int nb = blk[0], nbm = nb < 128 ? nb : 128; Sched S; S.init(hmid1, wdn, FFE, nbm, 4, F.G, F.bid, blk + 16, (size_t)1024 * FFE * 2); EpiMoeDown E{H, stok, sw}; gemm_run<EpiMoeDown, false>(F.lds, S, E, nullptr);
    }
    SEAM(13);
    if (IN(14)) {
        const int nb = blk[1], nb0 = blk[0], rfull = (nb * 28 / F.G > 3) ? nb * 28 / F.G - 3 : 0, per = F.G / 8;
        { Sched S; S.init(hbf, wgu, 1024, nb, 28, F.G, F.bid, blk + 16 + 256, (size_t)7168 * 1024 * 2); S.range(0, rfull * per, per);
          EpiSwiGLU<true> E{hmid1, FFE, rstd, ht1}; gemm_run<EpiSwiGLU<true>, true>(F.lds, S, E, stok + SLOT_CAP); }
        { Sched S; S.init(hbf, wgu, 1024, nb, 28, F.G, F.bid, blk + 16 + 256, (size_t)7168 * 1024 * 2); S.range(rfull * per, 0x7fffffff, per - 4);
          EpiSwiGLU<true> E{hmid1, FFE, rstd, ht1}; gemm_run<EpiSwiGLU<true>, true>(F.lds, S, E, stok + SLOT_CAP); }
        if (F.bid / 8 >= per - 4 && nb0 > 128) {
            Sched S; S.init(ht0, wdn, FFE, nb0 - 128, 4, 32, (F.bid / 8 - (per - 4)) * 8 + F.bid % 8, blk + 16 + 128, (size_t)1024 * FFE * 2);
            EpiMoeDown E{H, stok + NT, sw + NT}; gemm_run<EpiMoeDown, false>(F.lds, S, E, nullptr); }
    }
    SEAM(14);
    if (IN(15)) {
        const int nb = blk[1], nbm = nb < 128 ? nb : 128; Sched S; S.init(hmid1, wdn, FFE, nbm, 4, F.G, F.bid, blk + 16 + 256, (size_t)1024 * FFE * 2); EpiRowScale E{(bf16*)(ws + WS_YB), DM, sw + SLOT_CAP}; gemm_run<EpiRowScale, false>(F.lds, S, E, nullptr);
    }
    SEAM(15);
    if (IN(16)) {
        const int nb = blk[1], per = F.G / 8, nmain = (nb < 128 ? nb : 128) * 256;
        if (F.bid / 8 >= per - 4) {
            if (nb > 128) { Sched S; S.init(ht1, wdn, FFE, nb - 128, 4, 32, (F.bid / 8 - (per - 4)) * 8 + F.bid % 8, blk + 16 + 256 + 128, (size_t)1024 * FFE * 2);
                EpiRowScale E{(bf16*)(ws + WS_YB) + (size_t)NT * DM, DM, sw + SLOT_CAP + NT}; gemm_run<EpiRowScale, false>(F.lds, S, E, nullptr); }
        } else {
            const int wv = (int)(blockIdx.x * NWAVES + (threadIdx.x >> 6));
            final_norm_slots((int)(threadIdx.x & 63u), H, (const bf16*)(ws + WS_YB), args.in[I_FNORM], stok + SLOT_CAP, 0, nmain, wv, (per - 4) * 8 * NWAVES);
        }
        xcd_barrier(bar);
        if (nb > 128) final_norm_slots((int)(threadIdx.x & 63u), H, (const bf16*)(ws + WS_YB), args.in[I_FNORM], stok + SLOT_CAP, NT, nb * 256, (int)(blockIdx.x * NWAVES + (threadIdx.x >> 6)), F.NGW);
    }
#undef IN
#undef SEAM
}

extern "C" void kernel_launch(void* const* d_in, const int* in_sizes, int n_in, void* d_out, int out_size, void* d_ws, size_t ws_size, hipStream_t stream) {
    static int grid = 0;
    if (grid == 0) {
        if (n_in != 26 || out_size != NT * DM || ws_size < WS_END) { fprintf(stderr, "kernel_launch: unexpected problem (n_in %d out %d ws %zu need %zu)\n", n_in, out_size, ws_size, (size_t)WS_END); grid = -1; return; }
        int dev = 0, cus = 0, per_cu = 0;
        if (hipGetDevice(&dev) != hipSuccess || hipDeviceGetAttribute(&cus, hipDeviceAttributeMultiprocessorCount, dev) != hipSuccess) { grid = -1; return; }
        if (hipFuncSetAttribute((const void*)mega, hipFuncAttributeMaxDynamicSharedMemorySize, LDS_BYTES) != hipSuccess) { fprintf(stderr, "kernel_launch: hipFuncSetAttribute failed\n"); grid = -1; return; }
        if (hipOccupancyMaxActiveBlocksPerMultiprocessor(&per_cu, (const void*)mega, NTHR, LDS_BYTES) != hipSuccess || per_cu < 1) fprintf(stderr, "kernel_launch: occupancy query reports %d\n", per_cu);
        (void)hipGetLastError();
        grid = cus;
        if (grid != 256) fprintf(stderr, "kernel_launch: note: %d CUs\n", grid);
    }
    if (grid < 0) return;
    if (hipMemsetAsync((char*)d_ws + WS_CTL, 0, CTL_ZERO_BYTES, stream) != hipSuccess) return;
    Args a{};
    for (int i = 0; i < 26; ++i) a.in[i] = (const float*)d_in[i];
    a.out = (float*)d_out; a.ws = (unsigned char*)d_ws;
#if MK_FUSED
    a.ph_lo = 0; a.ph_hi = N_PHASES;
    hipLaunchKernelGGL(mega, dim3(grid), dim3(NTHR), LDS_BYTES, stream, a);
#else
    for (int p = 0; p < N_PHASES; ++p) { a.ph_lo = p; a.ph_hi = p + 1; hipLaunchKernelGGL(mega, dim3(grid), dim3(NTHR), LDS_BYTES, stream, a); }
#endif
}
```

```cpp
#include <hip/hip_runtime.h>
#include <cstdio>
#include <cstdint>

#ifndef MK_FUSED
#define MK_FUSED 1
#endif
#ifndef FAST_GEMM
#define FAST_GEMM 1
#endif
#ifndef FAST_ATT
#define FAST_ATT 1
#endif
#ifndef FAST_GLA
#define FAST_GLA 1
#endif

#define GAS __attribute__((address_space(1)))
#define LAS __attribute__((address_space(3)))
typedef unsigned short bf16;
typedef unsigned v4u __attribute__((ext_vector_type(4)));
typedef unsigned v2u __attribute__((ext_vector_type(2)));
typedef float f32x4 __attribute__((ext_vector_type(4)));
typedef short bf16x8 __attribute__((ext_vector_type(8)));
typedef GAS unsigned gu32;
#define RLX_AGENT __ATOMIC_RELAXED, __HIP_MEMORY_SCOPE_AGENT
#define LDS_WAIT() asm volatile("s_waitcnt lgkmcnt(0)" ::: "memory")
#define VM_WAIT() asm volatile("s_waitcnt vmcnt(0)" ::: "memory")

constexpr int NT = 32768, DM = 1024, SEQ = 4096, NB = 8;
constexpr int MEM_ROWS = 2048;
constexpr int A0_LD = 1792;
constexpr int A1_LD = 2048;
constexpr int FF0 = 2816, FFE = 3584, NEXP = 8;
constexpr int SLOT_CAP = 34816;
constexpr float EPS = 1e-6f;
constexpr int NWAVES = 8, NTHR = 512;

constexpr size_t MiB = 1u << 20;
constexpr size_t WS_CTL = 0, CTL_ZERO_BYTES = 1 * MiB;
constexpr size_t WS_RSS = 1 * MiB;
constexpr size_t WS_MRSS = 3 * MiB;
constexpr size_t WS_CNT = 3 * MiB + 256 * 1024;
constexpr size_t WS_TOPI = 3 * MiB + 512 * 1024;
constexpr size_t WS_TOPW = 3 * MiB + 768 * 1024;
constexpr size_t WS_STOK = 4 * MiB;
constexpr size_t WS_SW = 4 * MiB + 512 * 1024;
constexpr size_t WS_BLK = 5 * MiB;
constexpr size_t WS_RSTD = 5 * MiB + 64 * 1024;
constexpr size_t WS_W0IN = 6 * MiB;
constexpr size_t WS_WV0 = WS_W0IN + 1792 * 2048;
constexpr size_t WS_W0OUT = 11 * MiB;
constexpr size_t WS_W0GU = 13 * MiB;
constexpr size_t WS_W0DN = 24 * MiB;
constexpr size_t WS_WMEM = WS_W0DN + 1024 * 2816 * 2;
constexpr size_t WS_W1IN = 31 * MiB;
constexpr size_t WS_WV1 = 35 * MiB;
constexpr size_t WS_W1OUT = 37 * MiB - 512 * 1024;
constexpr size_t WS_HBF = 39 * MiB;
constexpr size_t WS_MEMBF = 103 * MiB;
constexpr size_t WS_MEMK = 107 * MiB;
constexpr size_t WS_MEMVT = 108 * MiB;
constexpr size_t WS_ACT = 109 * MiB;
constexpr size_t WS_ACT0 = WS_ACT;
constexpr size_t WS_V0T = WS_ACT + 112 * MiB;
constexpr size_t WS_MIX = WS_ACT + 176 * MiB;
constexpr size_t WS_HMID0 = WS_ACT;
constexpr size_t WS_ACT1 = WS_ACT;
constexpr size_t WS_V1T = WS_ACT + 128 * MiB;
constexpr size_t WS_OF = WS_ACT + 240 * MiB;
constexpr size_t WS_OB = WS_ACT + 288 * MiB;
constexpr size_t WS_GQT = WS_ACT + 336 * MiB;
constexpr size_t WS_GKDT0 = WS_ACT + 384 * MiB;
constexpr size_t WS_GKDT1 = 6 * MiB;
constexpr size_t OUT_GKT = 0, OUT_GDEC = 48 * MiB;
constexpr size_t WS_E = WS_ACT + 336 * MiB;
constexpr size_t WS_HT1 = 6 * MiB;
constexpr size_t WS_YB = WS_ACT + 240 * MiB;
constexpr size_t WS_HMID1 = WS_ACT;
constexpr size_t WS_WGU = WS_ACT + 240 * MiB;
constexpr size_t WS_WDN = WS_ACT + 352 * MiB;
constexpr size_t WS_END = WS_ACT + 408 * MiB;
static_assert(WS_W1OUT + 2 * MiB <= WS_HBF && WS_WV1 + 768 * 2048 <= WS_W1OUT && WS_W1IN + 4 * MiB <= WS_WV1 && WS_WMEM + MiB <= WS_W1IN, "weight map");
static_assert(WS_W0GU + 11 * MiB <= WS_W0DN && WS_WV0 + 768 * 2048 <= WS_W0OUT, "weight map 2");
static_assert((size_t)SLOT_CAP * 3584 * 2 <= 240 * MiB, "hmid1");

constexpr int CW_TMO = 0, CW_CODE = 1, CW_BAR = 4096;

constexpr int RING_BYTES = 131072;
constexpr int LDSCTL_OFF = 147456, MISC_OFF = LDSCTL_OFF + 320;
constexpr int LDS_BYTES = 148480;

typedef float f32x2_t __attribute__((ext_vector_type(2)));
typedef __bf16 bf16x2_t __attribute__((ext_vector_type(2)));
__device__ __forceinline__ unsigned pk2(float lo, float hi) { const f32x2_t v = {lo, hi}; const bf16x2_t b = __builtin_convertvector(v, bf16x2_t); return __builtin_bit_cast(unsigned, b); }
__device__ __forceinline__ unsigned f2bf(float f) { return pk2(f, 0.f) & 0xffffu; }
__device__ __forceinline__ float bf2f(bf16 b) { return __builtin_bit_cast(float, (unsigned)b << 16); }
__device__ __forceinline__ float bflo(unsigned u) { return __builtin_bit_cast(float, u << 16); }
__device__ __forceinline__ float bfhi(unsigned u) { return __builtin_bit_cast(float, u & 0xffff0000u); }
__device__ __forceinline__ float wave_sum(float v) {
#pragma unroll
    for (int o = 1; o < 64; o <<= 1) v += __shfl_xor(v, o);
    return v;
}
__device__ __forceinline__ float wave_max(float v) {
#pragma unroll
    for (int o = 1; o < 64; o <<= 1) v = fmaxf(v, __shfl_xor(v, o));
    return v;
}

#define XB_TMO      128
#define XB_XCNT(j)  (256  + 64 * (j))
#define XB_XSUB(j)  (1280 + 64 * (j))
#define XB_XGEN(j)  (2304 + 64 * (j))
#define XB_TOP      3328
#define XB_TOPGEN   3392
#define XCD_BAR_WORDS 3456
#define XB_SPIN_CAP (1u << 22)

__device__ __forceinline__ unsigned xb_ld(unsigned* p)              { return __hip_atomic_load(p, __ATOMIC_RELAXED, __HIP_MEMORY_SCOPE_AGENT); }
__device__ __forceinline__ unsigned xb_add(unsigned* p, unsigned v) { return __hip_atomic_fetch_add(p, v, __ATOMIC_RELAXED, __HIP_MEMORY_SCOPE_AGENT); }
__device__ __forceinline__ unsigned xb_xcc_id() { return (unsigned)__builtin_amdgcn_s_getreg((3 << 11) | 20) & 0xFu; }
#define XB_SPIN(cond, bar) do { unsigned _sp = 0; while (cond) { __builtin_amdgcn_s_sleep(1); \
    if ((++_sp & 255u) == 0u) { if (xb_ld(&(bar)[XB_TMO])) break; if (_sp > XB_SPIN_CAP) { atomicAdd(&(bar)[XB_TMO], 1u); break; } } } } while (0)

struct XcdBarrier { unsigned* bar; unsigned x; volatile LAS unsigned* st; };

__device__ __forceinline__ XcdBarrier xcd_barrier_post(unsigned* bar, volatile LAS unsigned* st) {
    XcdBarrier b; b.bar = bar; b.x = xb_xcc_id(); b.st = st;
    if (threadIdx.x == 0) (void)xb_add(&bar[XB_XCNT(b.x)], 1u);
    return b;
}
__device__ __forceinline__ void xcd_barrier_complete(unsigned* bar, unsigned x, unsigned& nloc, unsigned& nx) {
    const unsigned G = gridDim.x * gridDim.y * gridDim.z;
    unsigned sum, cnt, mine, sp = 0u;
    for (;;) {
        sum = 0u; cnt = 0u; mine = 0u;
#pragma unroll
        for (unsigned j = 0; j < 16; ++j) { const unsigned c = xb_ld(&bar[XB_XCNT(j)]); sum += c; cnt += (c > 0u) ? 1u : 0u; mine = (j == x) ? c : mine; }
        if (sum == G) break;
        __builtin_amdgcn_s_sleep(1);
        if ((++sp & 255u) == 0u) { if (xb_ld(&bar[XB_TMO])) break; if (sp > XB_SPIN_CAP) { atomicAdd(&bar[XB_TMO], 1u); break; } }
    }
    nloc = mine > 0u ? mine : 1u; nx = cnt > 0u ? cnt : 1u;
}
__device__ __forceinline__ void xcd_barrier(const XcdBarrier& b) {
    asm volatile("s_waitcnt vmcnt(0)" ::: "memory");
    __syncthreads();
    if (threadIdx.x == 0) {
        unsigned* bar = b.bar;
        __builtin_amdgcn_s_waitcnt(0);
        unsigned nloc = b.st[0], nx = b.st[1];
        if (nloc == 0u) { xcd_barrier_complete(bar, b.x, nloc, nx); b.st[0] = nloc; b.st[1] = nx; }
        const unsigned old = xb_add(&bar[XB_XSUB(b.x)], 1u);
        const unsigned gen = old / nloc;
        if (old + 1u == (gen + 1u) * nloc) {
            __builtin_amdgcn_fence(__ATOMIC_RELEASE, "agent");
            asm volatile("s_waitcnt vmcnt(0)" ::: "memory");
            const unsigned og = xb_add(&bar[XB_TOP], 1u);
            const unsigned tg = og / nx;
            if (og + 1u == (tg + 1u) * nx) xb_add(&bar[XB_TOPGEN], 1u);
            else XB_SPIN(xb_ld(&bar[XB_TOPGEN]) == tg, bar);
            __builtin_amdgcn_fence(__ATOMIC_ACQUIRE, "agent");
            xb_add(&bar[XB_XGEN(b.x)], 1u);
            asm volatile("s_waitcnt vmcnt(0)" ::: "memory");
        } else {
            XB_SPIN(xb_ld(&bar[XB_XGEN(b.x)]) == gen, bar);
            __builtin_amdgcn_fence(__ATOMIC_ACQUIRE, "agent");
            asm volatile("s_waitcnt vmcnt(0)" ::: "memory");
        }
    }
    __syncthreads();
}

struct Args { const float* in[26]; float* out; unsigned char* ws; int ph_lo, ph_hi; };
enum { I_X = 0, I_MEM, I_EN1, I_EWIN, I_RPB, I_EWOUT, I_EN2, I_EWG, I_EWU, I_EWD, I_ON1, I_OWIN, I_WGKF, I_BGKF, I_WGKB, I_BGKB, I_GNORM, I_OWOUT, I_ON2, I_WR, I_OWG, I_OWU, I_OWD, I_MNORM, I_WMKV, I_FNORM };

#define LANE() ((int)(threadIdx.x & 63u))
#define TID() ((int)threadIdx.x)
struct Frame {
    LAS unsigned char* lds;
    int wave, G, bid;
    int gw, NGW;
    unsigned char* ws;
};

constexpr float QSCALE = 0.125f * 1.4426950408889634f;
struct CvtJob { const float* W; int K, N; bf16* WT; const float* gain; int kind; };
__device__ __forceinline__ bool cvt_map(int kind, int n0, int& drow, float& scale) {
    scale = 1.0f;
    switch (kind) {
    case 0: drow = n0; return true;
    case 1: if (n0 < 768) { drow = n0; scale = QSCALE; return true; } if (n0 < 1536) { drow = n0; return true; } if (n0 >= 2304) { drow = n0 - 768; scale = QSCALE; return true; } return false;
    case 2: if (n0 >= 1536 && n0 < 2304) { drow = n0 - 1536; return true; } return false;
    case 3: drow = (n0 >> 7) * 256 + (n0 & 127); return true;
    case 4: drow = (n0 >> 7) * 256 + 128 + (n0 & 127); return true;
    case 5: if (n0 < 768) { drow = n0; return true; } if (n0 < 1536) return false; if (n0 < 2304) { drow = n0 - 768; return true; }
            if (n0 < 2336) { drow = n0 - 512; return true; } drow = n0 - 800; scale = QSCALE; return true;
    case 6: if (n0 >= 768 && n0 < 1536) { drow = n0 - 768; return true; } return false;
    default: drow = n0; return true;
    }
}
struct CvtRegs { f32x4 v[8]; const float* gain; bf16* WT; int K, k0, drow, valid; float scale; };
__device__ __forceinline__ void cvt_load(CvtRegs& R, const CvtJob& J, int item, int lane) {
    const int nblk = J.N / 32, kb = item / nblk, nb = item % nblk, n0 = nb * 32;
    R.k0 = kb * 64; R.gain = J.gain; R.WT = J.WT; R.K = J.K;
    R.valid = cvt_map(J.kind, n0, R.drow, R.scale) ? 1 : 0;
    if (R.valid) { const float* p = J.W + (size_t)(R.k0 + 2 * (lane >> 3)) * J.N + n0 + 4 * (lane & 7);
#pragma unroll
        for (int j = 0; j < 8; ++j) R.v[j] = *(const f32x4*)(p + (size_t)(16 * (j >> 1) + (j & 1)) * J.N); }
}
__device__ __forceinline__ void cvt_finish(const CvtRegs& R, LAS unsigned* T, int lane) {
    if (!R.valid) return;
    const int nq = lane & 7, kr = lane >> 3;
#pragma unroll
    for (int p = 0; p < 4; ++p) { const int k = R.k0 + 16 * p + 2 * kr; float g0 = R.scale, g1 = R.scale; if (R.gain) { g0 *= R.gain[k]; g1 *= R.gain[k + 1]; }
        const f32x4 a = R.v[2 * p], b = R.v[2 * p + 1]; LAS unsigned* t = T + (4 * nq) * 33 + 8 * p + kr;
        t[0] = pk2(a.x * g0, b.x * g1); t[33] = pk2(a.y * g0, b.y * g1); t[66] = pk2(a.z * g0, b.z * g1); t[99] = pk2(a.w * g0, b.w * g1); }
    LDS_WAIT(); asm volatile("" ::: "memory");
#pragma unroll
    for (int r = 0; r < 4; ++r) { const int n = (lane >> 3) + 8 * r, c = lane & 7; const LAS unsigned* sp = T + n * 33 + 4 * c;
        v4u o; o.x = sp[0]; o.y = sp[1]; o.z = sp[2]; o.w = sp[3];
        *(GAS v4u*)(R.WT + (size_t)(R.drow + n) * R.K + R.k0 + 8 * c) = o; }
    LDS_WAIT(); asm volatile("" ::: "memory");
}
__device__ __forceinline__ void rows_to_bf16(const float* X, bf16* Ob, float* rstd, int first, int nrows, int stride, int lane) {
    for (int m = first; m < nrows; m += 2 * stride) {
        const int m2 = m + stride; const bool h2 = m2 < nrows;
        const GAS f32x4* xa = (const GAS f32x4*)(X + (size_t)m * DM) + lane; const GAS f32x4* xb = (const GAS f32x4*)(X + (size_t)(h2 ? m2 : m) * DM) + lane;
        f32x4 va[4], vb[4];
#pragma unroll
        for (int j = 0; j < 4; ++j) va[j] = xa[64 * j];
#pragma unroll
        for (int j = 0; j < 4; ++j) vb[j] = xb[64 * j];
        float sa = 0.f, sb = 0.f;
#pragma unroll
        for (int j = 0; j < 4; ++j) { sa += (va[j].x * va[j].x + va[j].y * va[j].y) + (va[j].z * va[j].z + va[j].w * va[j].w); sb += (vb[j].x * vb[j].x + vb[j].y * vb[j].y) + (vb[j].z * vb[j].z + vb[j].w * vb[j].w); }
        sa = wave_sum(sa); sb = wave_sum(sb);
        GAS unsigned long long* oa = (GAS unsigned long long*)(Ob + (size_t)m * DM) + lane;
#pragma unroll
        for (int j = 0; j < 4; ++j) oa[64 * j] = (unsigned long long)pk2(va[j].x, va[j].y) | ((unsigned long long)pk2(va[j].z, va[j].w) << 32);
        if (lane == 0) rstd[m] = __builtin_amdgcn_rsqf(sa * (1.0f / DM) + EPS);
        if (h2) { GAS unsigned long long* ob = (GAS unsigned long long*)(Ob + (size_t)m2 * DM) + lane;
#pragma unroll
            for (int j = 0; j < 4; ++j) ob[64 * j] = (unsigned long long)pk2(vb[j].x, vb[j].y) | ((unsigned long long)pk2(vb[j].z, vb[j].w) << 32);
            if (lane == 0) rstd[m2] = __builtin_amdgcn_rsqf(sb * (1.0f / DM) + EPS); }
    }
}

struct Unit { int pm, pn; };
struct Sched {
    int nM, nN, nwg, G, c, K, ld, off0, off1, per;
    const char* A; const char* B; const int* bexp; size_t estride;
    __device__ void init(const void* A_, const void* B_, int K_, int nM_, int nN_, int G_, int c_, const int* bexp_ = nullptr, size_t estride_ = 0) {
        A = (const char*)A_; B = (const char*)B_; K = K_; ld = K_; nM = nM_; nN = nN_; nwg = nM * nN; G = G_; c = c_; bexp = bexp_; estride = estride_; off0 = 0; off1 = 0x7fffffff; per = G_ / 8; }
    __device__ void range(int off0_, int off1_, int per_) { off0 = off0_; off1 = off1_; per = per_; }
    __device__ bool next(int i, Unit& u) const {
        const int q = nwg / 8, r = nwg % 8, xcd = c % 8, slot = c / 8, lt = (int)((unsigned)(xcd - r) >> 31), qx = q + lt;
        if (slot >= per) return false;
        const int off = off0 + i * per + slot, lim = off1 < qx ? off1 : qx;
        if (off >= lim) return false;
        const int wgid = xcd * q + (lt ? xcd : r) + off;
        const int nig = 8 * nN, gid = wgid / nig, fm = gid * 8, gsz = (nM - fm) < 8 ? (nM - fm) : 8;
        u.pm = fm + ((wgid % nig) % gsz); u.pn = (wgid % nig) / gsz; return true;
    }
    __device__ const char* a_base(const Unit& u) const { return A + (size_t)u.pm * 512 * ld; }
    __device__ const char* b_base(const Unit& u) const { return B + (bexp ? (size_t)bexp[u.pm] * estride : (size_t)0) + (size_t)u.pn * 512 * ld; }
};

struct NoAux {};
__device__ __forceinline__ float rstd_from(const float* rss16) {
    const f32x4* p = (const f32x4*)rss16; f32x4 a = p[0], b = p[1], c = p[2], d = p[3];
    const float s = ((a.x + a.y) + (a.z + a.w)) + ((b.x + b.y) + (b.z + b.w)) + ((c.x + c.y) + (c.z + c.w)) + ((d.x + d.y) + (d.z + d.w));
    return __builtin_amdgcn_rsqf(s * (1.0f / DM) + EPS);
}
struct RowCtx { float rs[2][4]; };
struct EpiRowScale {
    static constexpr bool NEED_SS = false; static constexpr int SC_MODE = 1; typedef RowCtx Ctx; typedef NoAux Aux;
    bf16* O; int ldc; const float* sc_src;
    __device__ __forceinline__ void begin(Ctx& c, const LAS float* sc, const LAS int*, int lr0, int, int, int) const {
#pragma unroll
        for (int ai = 0; ai < 2; ++ai)
#pragma unroll
            for (int m = 0; m < 4; ++m) c.rs[ai][m] = sc[ai * 128 + lr0 + m * 16];
    }
    __device__ __forceinline__ void load_aux(Aux&, const Ctx&, int, int, int, int, int) const {}
    __device__ __forceinline__ float apply(const Ctx& c, const Aux&, int ai, int m, int row, int pn, int c128, const float (&a)[8], const float (&b)[8]) const {
        const float s = c.rs[ai][m];
        bf16* p = O + (size_t)row * ldc + pn * 256 + c128;
        v4u w; w.x = pk2(a[0] * s, a[1] * s); w.y = pk2(a[2] * s, a[3] * s); w.z = pk2(a[4] * s, a[5] * s); w.w = pk2(a[6] * s, a[7] * s); *(v4u*)p = w;
        w.x = pk2(b[0] * s, b[1] * s); w.y = pk2(b[2] * s, b[3] * s); w.z = pk2(b[4] * s, b[5] * s); w.w = pk2(b[6] * s, b[7] * s); *(v4u*)(p + 128) = w;
        return 0.f;
    }
    __device__ __forceinline__ void row_done(int, int, int, float) const {}
};
struct ColCtx { float sa[8], sb[8]; };
struct EpiColScale {
    static constexpr bool NEED_SS = false; static constexpr int SC_MODE = 2; typedef ColCtx Ctx; typedef NoAux Aux;
    bf16* O; int ldc; const float* sc_src;
    __device__ __forceinline__ void begin(Ctx& c, const LAS float* sc, const LAS int*, int, int, int, int c128) const {
#pragma unroll
        for (int j = 0; j < 8; ++j) { c.sa[j] = sc[c128 + j]; c.sb[j] = sc[128 + c128 + j]; }
    }
    __device__ __forceinline__ void load_aux(Aux&, const Ctx&, int, int, int, int, int) const {}
    __device__ __forceinline__ float apply(const Ctx& c, const Aux&, int, int, int row, int pn, int c128, const float (&a)[8], const float (&b)[8]) const {
        bf16* p = O + (size_t)row * ldc + pn * 256 + c128;
        v4u w; w.x = pk2(a[0] * c.sa[0], a[1] * c.sa[1]); w.y = pk2(a[2] * c.sa[2], a[3] * c.sa[3]); w.z = pk2(a[4] * c.sa[4], a[5] * c.sa[5]); w.w = pk2(a[6] * c.sa[6], a[7] * c.sa[7]); *(v4u*)p = w;
        w.x = pk2(b[0] * c.sb[0], b[1] * c.sb[1]); w.y = pk2(b[2] * c.sb[2], b[3] * c.sb[3]); w.z = pk2(b[4] * c.sb[4], b[5] * c.sb[5]); w.w = pk2(b[6] * c.sb[6], b[7] * c.sb[7]); *(v4u*)(p + 128) = w;
        return 0.f;
    }
    __device__ __forceinline__ void row_done(int, int, int, float) const {}
};
struct Aux4 { f32x4 v[4]; };
struct NoCtx {};
struct AuxR { f32x4 v[4]; };
struct AuxB { v4u a, b; };
__device__ __forceinline__ void unpack16(const AuxB& x, f32x4 (&v)[4]) {
    v[0] = (f32x4){bflo(x.a.x), bfhi(x.a.x), bflo(x.a.y), bfhi(x.a.y)}; v[1] = (f32x4){bflo(x.a.z), bfhi(x.a.z), bflo(x.a.w), bfhi(x.a.w)};
    v[2] = (f32x4){bflo(x.b.x), bfhi(x.b.x), bflo(x.b.y), bfhi(x.b.y)}; v[3] = (f32x4){bflo(x.b.z), bfhi(x.b.z), bflo(x.b.w), bfhi(x.b.w)}; }
template <bool F32> struct AuxSel { typedef AuxR T; };
template <> struct AuxSel<false> { typedef AuxB T; };
template <bool RF32> struct EpiResid {
    static constexpr bool NEED_SS = true; static constexpr int SC_MODE = 0; typedef NoCtx Ctx; typedef typename AuxSel<RF32>::T Aux;
    const float* R; bf16* HB; float* rss; bf16* HB2;
    __device__ __forceinline__ void begin(Ctx&, const LAS float*, const LAS int*, int, int, int, int) const {}
    __device__ __forceinline__ void load_aux(Aux& x, const Ctx&, int, int, int row, int pn, int c128) const {
        const size_t off = (size_t)row * DM + pn * 256 + c128;
        if constexpr (RF32) { const float* p = R + off; x.v[0] = *(const f32x4*)p; x.v[1] = *(const f32x4*)(p + 4); x.v[2] = *(const f32x4*)(p + 128); x.v[3] = *(const f32x4*)(p + 132); }
        else { x.a = *(const v4u*)(HB + off); x.b = *(const v4u*)(HB + off + 128); }
    }
    __device__ __forceinline__ float apply(const Ctx&, const Aux& xr, int, int, int row, int pn, int c128, const float (&a)[8], const float (&b)[8]) const {
        const size_t off = (size_t)row * DM + pn * 256 + c128;
        struct { f32x4 v[4]; } x; if constexpr (RF32) { x.v[0] = xr.v[0]; x.v[1] = xr.v[1]; x.v[2] = xr.v[2]; x.v[3] = xr.v[3]; } else unpack16(xr, x.v);
        const f32x4 h0 = {x.v[0].x + a[0], x.v[0].y + a[1], x.v[0].z + a[2], x.v[0].w + a[3]}, h1 = {x.v[1].x + a[4], x.v[1].y + a[5], x.v[1].z + a[6], x.v[1].w + a[7]};
        const f32x4 h2 = {x.v[2].x + b[0], x.v[2].y + b[1], x.v[2].z + b[2], x.v[2].w + b[3]}, h3 = {x.v[3].x + b[4], x.v[3].y + b[5], x.v[3].z + b[6], x.v[3].w + b[7]};
        v4u w; w.x = pk2(h0.x, h0.y); w.y = pk2(h0.z, h0.w); w.z = pk2(h1.x, h1.y); w.w = pk2(h1.z, h1.w); *(v4u*)(HB + off) = w; if (HB2) *(v4u*)(HB2 + off) = w;
        w.x = pk2(h2.x, h2.y); w.y = pk2(h2.z, h2.w); w.z = pk2(h3.x, h3.y); w.w = pk2(h3.z, h3.w); *(v4u*)(HB + off + 128) = w; if (HB2) *(v4u*)(HB2 + off + 128) = w;
        return ((h0.x * h0.x + h0.y * h0.y) + (h0.z * h0.z + h0.w * h0.w) + (h1.x * h1.x + h1.y * h1.y) + (h1.z * h1.z + h1.w * h1.w))
             + ((h2.x * h2.x + h2.y * h2.y) + (h2.z * h2.z + h2.w * h2.w) + (h3.x * h3.x + h3.y * h3.y) + (h3.z * h3.z + h3.w * h3.w));
    }
    __device__ __forceinline__ void row_done(int row, int pn, int wc, float ss) const { rss[(size_t)row * 16 + pn * 4 + wc] = ss; }
};
__device__ __forceinline__ float silu_mul(float g, float u) { return g * __builtin_amdgcn_rcpf(1.0f + __builtin_amdgcn_exp2f(g * -1.4426950408889634f)) * u; }
template <bool MOE> struct EpiSwiGLU {
    static constexpr bool NEED_SS = false; static constexpr int SC_MODE = MOE ? 3 : 1; typedef RowCtx Ctx; typedef NoAux Aux;
    bf16* Hm; int ldh; const float* sc_src; bf16* Hmt;
    __device__ __forceinline__ void begin(Ctx& c, const LAS float* sc, const LAS int* tl, int lr0, int, int, int) const {
#pragma unroll
        for (int ai = 0; ai < 2; ++ai)
#pragma unroll
            for (int m = 0; m < 4; ++m) { const int i = ai * 128 + lr0 + m * 16; float r = sc[i]; if (MOE) { if (tl[i] < 0) r = 0.f; } c.rs[ai][m] = r; }
    }
    __device__ __forceinline__ void load_aux(Aux&, const Ctx&, int, int, int, int, int) const {}
    __device__ __forceinline__ float apply(const Ctx& c, const Aux&, int ai, int m, int row, int pn, int c128, const float (&a)[8], const float (&b)[8]) const {
        const float s = c.rs[ai][m]; float o[8];
#pragma unroll
        for (int j = 0; j < 8; ++j) o[j] = silu_mul(a[j] * s, b[j] * s);
        v4u w; w.x = pk2(o[0], o[1]); w.y = pk2(o[2], o[3]); w.z = pk2(o[4], o[5]); w.w = pk2(o[6], o[7]);
        bf16* rp = (MOE && row >= NT) ? Hmt + (size_t)(row - NT) * ldh : Hm + (size_t)row * ldh;
        *(v4u*)(rp + pn * 128 + c128) = w;
        return 0.f;
    }
    __device__ __forceinline__ void row_done(int, int, int, float) const {}
};
struct MoeCtx { int t[2][4]; float w[2][4]; };
struct EpiMoeDown {
    static constexpr bool NEED_SS = false; static constexpr int SC_MODE = 4; typedef MoeCtx Ctx; typedef AuxB Aux;
    bf16* HB; const int* tok; const float* w;
    __device__ __forceinline__ void begin(Ctx& c, const LAS float* sc, const LAS int*, int lr0, int, int, int) const {
#pragma unroll
        for (int ai = 0; ai < 2; ++ai)
#pragma unroll
            for (int m = 0; m < 4; ++m) { const int i = ai * 128 + lr0 + m * 16; c.t[ai][m] = ((const LAS int*)sc)[i]; c.w[ai][m] = sc[256 + i]; }
    }
    __device__ __forceinline__ void load_aux(Aux& x, const Ctx& c, int ai, int m, int, int pn, int c128) const {
        const int t = c.t[ai][m]; const bf16* p = HB + (size_t)(t < 0 ? 0 : t) * DM + pn * 256 + c128;
        x.a = *(const v4u*)p; x.b = *(const v4u*)(p + 128);
    }
    __device__ __forceinline__ float apply(const Ctx& c, const Aux& xr, int ai, int m, int, int pn, int c128, const float (&a)[8], const float (&b)[8]) const {
        const int t = c.t[ai][m]; if (t < 0) return 0.f;
        struct { f32x4 v[4]; } x; unpack16(xr, x.v);
        const float s = c.w[ai][m]; bf16* p = HB + (size_t)t * DM + pn * 256 + c128;
        v4u w; w.x = pk2(x.v[0].x + s * a[0], x.v[0].y + s * a[1]); w.y = pk2(x.v[0].z + s * a[2], x.v[0].w + s * a[3]); w.z = pk2(x.v[1].x + s * a[4], x.v[1].y + s * a[5]); w.w = pk2(x.v[1].z + s * a[6], x.v[1].w + s * a[7]); *(v4u*)p = w;
        w.x = pk2(x.v[2].x + s * b[0], x.v[2].y + s * b[1]); w.y = pk2(x.v[2].z + s * b[2], x.v[2].w + s * b[3]); w.z = pk2(x.v[3].x + s * b[4], x.v[3].y + s * b[5]); w.w = pk2(x.v[3].z + s * b[6], x.v[3].w + s * b[7]); *(v4u*)(p + 128) = w;
        return 0.f;
    }
    __device__ __forceinline__ void row_done(int, int, int, float) const {}
};

namespace pg8 {
constexpr int HTB = 16384, TOK_OFF = 132096, SC_OFF = 134144;
__device__ __forceinline__ int lds_byte(int r, int c) { const int st = (r >> 4) * 2 + (c >> 5), rr = r & 15, cc = c & 31, ob = rr * 64 + cc * 2; return st * 1024 + (ob ^ (((ob >> 9) & 1) << 5)); }
__device__ __forceinline__ void stage_rc(int b, int& R, int& C) { const int st = b / 1024, sb = b % 1024, swz = sb ^ (((sb >> 9) & 1) << 5); R = (st >> 1) * 16 + swz / 64; C = (st & 1) * 32 + (swz % 64) / 2; }
__device__ __forceinline__ int perm32(int rho) { const int n = rho >> 4, i = rho & 15; return 8 * (i >> 2) + 4 * n + (i & 3); }

template <class Epi>
__device__ __forceinline__ void run_epi(const Epi& E, const f32x4 (&acc)[2][2][4][2], const Unit& u, int wr, int wc, int fr, int fq, const LAS float* sc, const LAS int* tlp) {
    int row0 = u.pm * 256 + wr * 64 + fr, c128 = 32 * wc + 8 * fq;
    asm volatile("" : "+v"(row0), "+v"(c128));
    typename Epi::Ctx ctx; E.begin(ctx, sc, tlp, wr * 64 + fr, row0, u.pn, c128);
#pragma unroll
    for (int ai = 0; ai < 2; ++ai) {
        typename Epi::Aux aux[4];
#pragma unroll
        for (int m = 0; m < 4; ++m) E.load_aux(aux[m], ctx, ai, m, row0 + ai * 128 + m * 16, u.pn, c128);
#pragma unroll
        for (int m = 0; m < 4; ++m) {
            const int row = row0 + ai * 128 + m * 16;
            float a[8], b[8];
#pragma unroll
            for (int j = 0; j < 8; ++j) { a[j] = acc[ai][0][m][j >> 2][j & 3]; b[j] = acc[ai][1][m][j >> 2][j & 3]; }
            float ss = E.apply(ctx, aux[m], ai, m, row, u.pn, c128, a, b);
            if (Epi::NEED_SS) { ss += __shfl_xor(ss, 16); ss += __shfl_xor(ss, 32); if (fq == 0) E.row_done(row, u.pn, wc, ss); }
        }
    }
}

template <class Epi, bool GATHER>
__device__ __forceinline__ void gemm_fast(LAS unsigned char* lds, const Sched& S, const Epi& E, const int* gtok) {
    int tid = threadIdx.x; asm volatile("" : "+v"(tid));
    const int wid = __builtin_amdgcn_readfirstlane(tid >> 6), lane = tid & 63, wr = wid >> 2, wc = wid & 3, fr = lane & 15, fq = lane >> 4;
    const int K = S.ld, nt = S.K / 64;
    unsigned voffB[2], vA0[2], vA1[2], nA0[2], nA1[2]; int RA[2], CA2[2];
#pragma unroll
    for (int i = 0; i < 2; ++i) { int R, C; stage_rc(tid * 16 + i * 8192, R, C); const int Rb = (R & ~31) + perm32(R & 31);
        voffB[i] = (unsigned)(Rb * K + C) * 2u; RA[i] = R; CA2[i] = C * 2; vA0[i] = (unsigned)(R * K + C) * 2u; vA1[i] = vA0[i] + (unsigned)(128 * K * 2); nA0[i] = vA0[i]; nA1[i] = vA1[i]; }
    const size_t kstep = 128;
    const size_t hstep = (size_t)128 * K * 2;
    const unsigned ldsw = (unsigned)wid * 1024u;
    const int aoff = lds_byte(wr * 64 + fr, fq * 8), boff = lds_byte(wc * 32 + fr, fq * 8);
    LAS int* tl = (LAS int*)(lds + TOK_OFF);
#define PG8_SA(b, h) (((b) * 2 + (h)) * HTB)
#define PG8_SB(b, h) ((4 + (b) * 2 + (h)) * HTB)
#define PG8_STAGE(bufoff, gbase, voff) do { _Pragma("unroll") for (int _i = 0; _i < 2; ++_i) \
        __builtin_amdgcn_global_load_lds((const unsigned*)((const char*)(gbase) + (voff)[_i]), (LAS unsigned*)(lds + (bufoff) + ldsw + _i * 8192), 16, 0, 0); } while (0)
#define PG8_LDA(dst, b, h) do { _Pragma("unroll") for (int m = 0; m < 4; ++m) _Pragma("unroll") for (int k = 0; k < 2; ++k) dst[m][k] = *(const LAS bf16x8*)(lds + PG8_SA(b, h) + aoff + m * 2048 + k * 1024); } while (0)
#define PG8_LDB(dst, b, h) do { _Pragma("unroll") for (int n = 0; n < 2; ++n) _Pragma("unroll") for (int k = 0; k < 2; ++k) dst[n][k] = *(const LAS bf16x8*)(lds + PG8_SB(b, h) + boff + n * 2048 + k * 1024); } while (0)
#define PG8_MMA(ai, bj, At, Bt) do { __builtin_amdgcn_s_setprio(1); _Pragma("unroll") for (int m = 0; m < 4; ++m) _Pragma("unroll") for (int n = 0; n < 2; ++n) _Pragma("unroll") for (int k = 0; k < 2; ++k) \
        acc[ai][bj][m][n] = __builtin_amdgcn_mfma_f32_16x16x32_bf16(Bt[n][k], At[m][k], acc[ai][bj][m][n], 0, 0, 0); __builtin_amdgcn_s_setprio(0); } while (0)
#define PG8_WAIT_V(n) asm volatile("s_waitcnt vmcnt(" #n ")" ::: "memory")
#define PG8_WAIT_L(n) asm volatile("s_waitcnt lgkmcnt(" #n ")" ::: "memory")
#define PG8_BAR __builtin_amdgcn_s_barrier()
#define PG8_SCHED __builtin_amdgcn_sched_barrier(0)
#define PG8_IDS_DMA(pm_, par_) do { if (wid < 4) __builtin_amdgcn_global_load_lds((const unsigned*)(gtok + (pm_) * 256 + wid * 64 + lane), (LAS unsigned*)(lds + TOK_OFF + (par_) * 1024 + wid * 256), 4, 0, 0); } while (0)
#define PG8_IDS_READ(d0, d1, par_) do { _Pragma("unroll") for (int _i = 0; _i < 2; ++_i) { int t0 = tl[(par_) * 256 + RA[_i]], t1 = tl[(par_) * 256 + 128 + RA[_i]]; t0 = t0 < 0 ? 0 : t0; t1 = t1 < 0 ? 0 : t1; \
        d0[_i] = (unsigned)t0 * (unsigned)(K * 2) + (unsigned)CA2[_i]; d1[_i] = (unsigned)t1 * (unsigned)(K * 2) + (unsigned)CA2[_i]; } } while (0)
    Unit cur, nxt; int ui = 0, par = 0;
    if (!S.next(0, cur)) return;
    f32x4 acc[2][2][4][2];
#pragma unroll
    for (int a = 0; a < 2; ++a)
#pragma unroll
        for (int b = 0; b < 2; ++b)
#pragma unroll
            for (int m = 0; m < 4; ++m)
#pragma unroll
                for (int n = 0; n < 2; ++n) acc[a][b][m][n] = (f32x4){0.f, 0.f, 0.f, 0.f};
    bf16x8 At[4][2], B0[2][2], B1[2][2];
    const char* cA = GATHER ? S.A : S.a_base(cur); const char* cB = S.b_base(cur);
    if constexpr (GATHER) { PG8_IDS_DMA(cur.pm, 0); PG8_WAIT_V(0); __syncthreads(); PG8_IDS_READ(vA0, vA1, 0); }
    PG8_STAGE(PG8_SB(0, 0), cB, voffB); PG8_STAGE(PG8_SB(0, 1), cB + hstep, voffB); PG8_STAGE(PG8_SA(0, 0), cA, vA0); PG8_STAGE(PG8_SA(0, 1), cA, vA1);
    if (wr == 1) PG8_BAR;
    PG8_WAIT_V(2); PG8_BAR;
    PG8_STAGE(PG8_SB(1, 0), cB + kstep, voffB); PG8_STAGE(PG8_SA(1, 0), cA + kstep, vA0); PG8_STAGE(PG8_SB(1, 1), cB + hstep + kstep, voffB);
    PG8_WAIT_V(6); PG8_BAR;
    for (;;) {
        const bool has_next = S.next(ui + 1, nxt);
        const char* nA = has_next ? (GATHER ? S.A : S.a_base(nxt)) : cA; const char* nB = has_next ? S.b_base(nxt) : cB;
        for (int t = 0; t < nt; t += 2) {
            const bool last = (t == nt - 2);
            if constexpr (GATHER) {
                if (t == nt - 4 && has_next) PG8_IDS_DMA(nxt.pm, par ^ 1);
                if (last) { if (has_next) PG8_IDS_READ(nA0, nA1, par ^ 1); else { nA0[0] = vA0[0]; nA0[1] = vA0[1]; nA1[0] = vA1[0]; nA1[1] = vA1[1]; } }
            }
            if constexpr (Epi::SC_MODE != 0) {
                if (last && wid < 4) { const int i_ = wid * 64 + lane; LAS unsigned* d_ = (LAS unsigned*)(lds + SC_OFF + wid * 256);
                    if constexpr (Epi::SC_MODE == 1) __builtin_amdgcn_global_load_lds((const unsigned*)(E.sc_src + cur.pm * 256 + i_), d_, 4, 0, 0);
                    if constexpr (Epi::SC_MODE == 2) __builtin_amdgcn_global_load_lds((const unsigned*)(E.sc_src + cur.pn * 256 + i_), d_, 4, 0, 0);
                    if constexpr (Epi::SC_MODE == 3) { int t_ = tl[par * 256 + i_]; t_ = t_ < 0 ? 0 : t_; __builtin_amdgcn_global_load_lds((const unsigned*)(E.sc_src + t_), d_, 4, 0, 0); }
                    if constexpr (Epi::SC_MODE == 4) { __builtin_amdgcn_global_load_lds((const unsigned*)(E.tok + cur.pm * 256 + i_), d_, 4, 0, 0);
                        __builtin_amdgcn_global_load_lds((const unsigned*)(E.w + cur.pm * 256 + i_), (LAS unsigned*)(lds + SC_OFF + 1024 + wid * 256), 4, 0, 0); } }
            }
            const char* a1 = cA + (size_t)(t + 1) * kstep;
            const char* a2 = last ? nA : cA + (size_t)(t + 2) * kstep; const char* b2 = last ? nB : cB + (size_t)(t + 2) * kstep;
            const char* a3 = a2 + kstep; const char* b3 = b2 + kstep;
            unsigned w0[2], w1[2];
            if (GATHER && last) { w0[0] = nA0[0]; w0[1] = nA0[1]; w1[0] = nA1[0]; w1[1] = nA1[1]; } else { w0[0] = vA0[0]; w0[1] = vA0[1]; w1[0] = vA1[0]; w1[1] = vA1[1]; }
            PG8_LDB(B0, 0, 0); PG8_LDB(B1, 0, 1); PG8_SCHED; PG8_LDA(At, 0, 0); PG8_STAGE(PG8_SA(1, 1), a1, vA1);
            PG8_WAIT_V(8); PG8_WAIT_L(0); PG8_BAR; PG8_MMA(0, 0, At, B0); PG8_MMA(0, 1, At, B1); PG8_BAR; PG8_SCHED;
            PG8_LDA(At, 0, 1); PG8_STAGE(PG8_SB(0, 0), b2, voffB); PG8_STAGE(PG8_SB(0, 1), b2 + hstep, voffB); PG8_STAGE(PG8_SA(0, 0), a2, w0);
            PG8_WAIT_V(8); PG8_WAIT_L(0); PG8_BAR; PG8_MMA(1, 0, At, B0); PG8_MMA(1, 1, At, B1); PG8_BAR; PG8_SCHED;
            PG8_LDB(B0, 1, 0); PG8_LDB(B1, 1, 1); PG8_SCHED; PG8_LDA(At, 1, 0); PG8_STAGE(PG8_SA(0, 1), a2, w1);
            PG8_WAIT_V(8); PG8_WAIT_L(0); PG8_BAR; PG8_MMA(0, 0, At, B0); PG8_MMA(0, 1, At, B1); PG8_BAR; PG8_SCHED;
            PG8_LDA(At, 1, 1); PG8_STAGE(PG8_SB(1, 0), b3, voffB); PG8_STAGE(PG8_SB(1, 1), b3 + hstep, voffB); PG8_STAGE(PG8_SA(1, 0), a3, w0);
            PG8_WAIT_V(8); PG8_WAIT_L(0); PG8_BAR; PG8_MMA(1, 0, At, B0); PG8_MMA(1, 1, At, B1); PG8_BAR; PG8_SCHED;
        }
        if (wr == 0) PG8_BAR;
        run_epi(E, acc, cur, wr, wc, fr, fq, (const LAS float*)(lds + SC_OFF), (const LAS int*)(lds + TOK_OFF + par * 1024));
        if (!has_next) break;
#pragma unroll
        for (int a = 0; a < 2; ++a)
#pragma unroll
            for (int b = 0; b < 2; ++b)
#pragma unroll
                for (int m = 0; m < 4; ++m)
#pragma unroll
                    for (int n = 0; n < 2; ++n) acc[a][b][m][n] = (f32x4){0.f, 0.f, 0.f, 0.f};
        cur = nxt; cA = nA; cB = nB; ++ui;
        if constexpr (GATHER) { vA0[0] = nA0[0]; vA0[1] = nA0[1]; vA1[0] = nA1[0]; vA1[1] = nA1[1]; par ^= 1; }
        if (wr == 1) PG8_BAR;
    }
    PG8_WAIT_V(0);
    PG8_BAR;
#undef PG8_SA
#undef PG8_SB
#undef PG8_STAGE
#undef PG8_LDA
#undef PG8_LDB
#undef PG8_MMA
#undef PG8_WAIT_V
#undef PG8_WAIT_L
#undef PG8_BAR
#undef PG8_SCHED
#undef PG8_IDS_DMA
#undef PG8_IDS_READ
}
}

template <class Epi, bool GATHER>
__device__ __forceinline__ void gemm_run(LAS unsigned char* lds, const Sched& S, const Epi& E, const int* gtok) { pg8::gemm_fast<Epi, GATHER>(lds, S, E, gtok); }

__device__ __forceinline__ void na_simple(const Frame& F, const bf16* act0, const bf16* v0t, const float* rpb, bf16* mix) {
    for (int it = F.gw; it < NT * 12; it += F.NGW) {
        const int token = it / 12, h = it % 12, lane = LANE();
        const int b = token >> 12, p = token & 4095, r = p >> 6, c = p & 63;
        const int r0 = min(max(r - 4, 0), 56), cs = min(max(c - 8, 0), 48);
        const float q = bf2f(act0[(size_t)token * A0_LD + h * 64 + lane]);
        float m = -INFINITY, l = 0.f, o = 0.f;
        for (int a = 0; a < 8; ++a)
            for (int u = 0; u < 16; ++u) {
                const int kt = b * SEQ + (r0 + a) * 64 + cs + u;
                const float kv = bf2f(act0[(size_t)kt * A0_LD + 768 + h * 64 + lane]);
                const float sc = wave_sum(q * kv) + rpb[h * 465 + (r0 + a - r + 7) * 31 + (cs + u - c + 15)];
                const float mn = fmaxf(m, sc), corr = __expf(m - mn), pe = __expf(sc - mn);
                const float vv = bf2f(v0t[(size_t)(h * 64 + lane) * NT + kt]);
                l = l * corr + pe; o = o * corr + pe * vv; m = mn;
            }
        mix[(size_t)token * DM + h * 64 + lane] = (bf16)f2bf(o / l);
    }
}
__device__ __forceinline__ void memattn_simple(const Frame& F, int first, int stride, const bf16* act, int ld, int qoff, const bf16* memk, const bf16* memvt, bf16* mix) {
    for (int it = first; it < NT * 4; it += stride) {
        const int token = it >> 2, h = it & 3, lane = LANE(), b = token >> 12;
        const float q = bf2f(act[(size_t)token * ld + qoff + h * 64 + lane]);
        float m = -INFINITY, l = 0.f, o = 0.f;
        for (int j = 0; j < 256; ++j) {
            const float kv = bf2f(memk[(size_t)(b * 256 + j) * 256 + h * 64 + lane]);
            const float sc = wave_sum(q * kv);
            const float mn = fmaxf(m, sc), corr = __expf(m - mn), pe = __expf(sc - mn);
            const float vv = bf2f(memvt[(size_t)(h * 64 + lane) * MEM_ROWS + b * 256 + j]);
            l = l * corr + pe; o = o * corr + pe * vv; m = mn;
        }
        mix[(size_t)token * DM + 768 + h * 64 + lane] = (bf16)f2bf(o / l);
    }
}

typedef short s16x4 __attribute__((ext_vector_type(4)));
template <bool NA, bool KLDS = false, bool VLDS = false, int KRS = 64>
__device__ __forceinline__ void attn16(int lane, const bf16* Q, int ldq, const bf16* Kb, int ldk, const bf16* Vt, int ldv, int ktok0, int trs, bf16* O, int ldo,
                                       const LAS float* rpb_h, int r, int r0, int jb, int band0, const LAS unsigned char* Kl = nullptr, int arow0 = 0, const LAS unsigned char* Vl = nullptr) {
    const int qi = lane & 15, g = lane >> 4;
    bf16x8 qf[2];
#pragma unroll
    for (int ks = 0; ks < 2; ++ks) qf[ks] = *(const bf16x8*)(Q + (size_t)qi * ldq + ks * 32 + 8 * g);
    f32x4 s[16];
    const int krow = 8 * (qi >> 2) + (qi & 3);
#pragma unroll
    for (int t = 0; t < 16; ++t) {
        bf16x8 k0, k1;
        if constexpr (KLDS) {
            const int kcol = band0 + krow + 4 * (t & 1), swz = (((kcol >> 3) & 3) << 1) | ((kcol >> 1) & 1);
            const LAS unsigned char* kb = Kl + ((arow0 + (t >> 1)) * KRS + kcol) * 128;
            k0 = *(const LAS bf16x8*)(kb + ((g ^ swz) << 4)); k1 = *(const LAS bf16x8*)(kb + (((4 + g) ^ swz) << 4));
        } else {
            const bf16* kp = Kb + (size_t)(ktok0 + (t >> 1) * trs + krow + 4 * (t & 1)) * ldk + 8 * g;
            k0 = *(const bf16x8*)kp; k1 = *(const bf16x8*)(kp + 32);
        }
        f32x4 z = {0.f, 0.f, 0.f, 0.f};
        z = __builtin_amdgcn_mfma_f32_16x16x32_bf16(k0, qf[0], z, 0, 0, 0);
        z = __builtin_amdgcn_mfma_f32_16x16x32_bf16(k1, qf[1], z, 0, 0, 0);
        s[t] = z;
        if constexpr (KLDS) { if ((t & 3) == 3) __builtin_amdgcn_sched_barrier(0); }
    }
    bf16x8 vfa[VLDS ? 1 : 4][VLDS ? 1 : 8];
    if constexpr (!VLDS) {
#pragma unroll
        for (int mt = 0; mt < 4; ++mt)
#pragma unroll
            for (int kk = 0; kk < 8; ++kk) vfa[mt][kk] = *(const bf16x8*)(Vt + (size_t)(16 * mt + qi) * ldv + ktok0 + kk * trs + 8 * g);
        __builtin_amdgcn_sched_barrier(0);
    }
    float m = -INFINITY;
    if constexpr (NA) {
        const int qc = 16 * jb + qi, cs = min(max(qc - 8, 0), 48);
        const LAS float* bp = rpb_h + (r0 - r + 7) * 31 + (band0 + 8 * g - qc + 15);
        bool ok[2][4];
#pragma unroll
        for (int hh = 0; hh < 2; ++hh)
#pragma unroll
            for (int i = 0; i < 4; ++i) { const int kc = band0 + 8 * g + 4 * hh + i; ok[hh][i] = (kc >= cs) && (kc < cs + 16); }
#pragma unroll
        for (int t = 0; t < 16; ++t)
#pragma unroll
            for (int i = 0; i < 4; ++i) {
                const float bv = bp[(t >> 1) * 31 + 4 * (t & 1) + i];
                const float v = ok[t & 1][i] ? s[t][i] + bv : -INFINITY;
                s[t][i] = v; m = fmaxf(m, v);
            }
    } else {
#pragma unroll
        for (int t = 0; t < 16; ++t)
#pragma unroll
            for (int i = 0; i < 4; ++i) m = fmaxf(m, s[t][i]);
    }
    m = fmaxf(m, __shfl_xor(m, 16)); m = fmaxf(m, __shfl_xor(m, 32));
    float l = 0.f;
    bf16x8 pf[8];
#pragma unroll
    for (int kk = 0; kk < 8; ++kk) {
        float p[8];
#pragma unroll
        for (int i = 0; i < 4; ++i) { p[i] = __builtin_amdgcn_exp2f(s[2 * kk][i] - m); p[4 + i] = __builtin_amdgcn_exp2f(s[2 * kk + 1][i] - m); }
#pragma unroll
        for (int i = 0; i < 8; ++i) l += p[i];
        v4u w; w.x = pk2(p[0], p[1]); w.y = pk2(p[2], p[3]); w.z = pk2(p[4], p[5]); w.w = pk2(p[6], p[7]);
        pf[kk] = __builtin_bit_cast(bf16x8, w);
    }
    l += __shfl_xor(l, 16); l += __shfl_xor(l, 32);
    const float inv = __builtin_amdgcn_rcpf(l);
#pragma unroll
    for (int mt = 0; mt < 4; ++mt) {
        f32x4 acc = {0.f, 0.f, 0.f, 0.f};
#pragma unroll
        for (int kk = 0; kk < 8; ++kk) {
            bf16x8 vf; if constexpr (VLDS) vf = *(const LAS bf16x8*)(Vl + (16 * mt + qi) * 512 + (((4 * kk + g) ^ qi) << 4));
            else vf = vfa[mt][kk];
            acc = __builtin_amdgcn_mfma_f32_16x16x32_bf16(vf, pf[kk], acc, 0, 0, 0);
        }
        v2u w; w.x = pk2(acc[0] * inv, acc[1] * inv); w.y = pk2(acc[2] * inv, acc[3] * inv);
        *(v2u*)(O + (size_t)qi * ldo + 16 * mt + 4 * g) = w;
        if constexpr (VLDS) __builtin_amdgcn_sched_barrier(0);
    }
}
__device__ __forceinline__ void memattn_strip(const Frame& F, int item, const bf16* act, int ld, int qoff, const bf16* memk, const bf16* memvt, bf16* mix) {
    const int tg = item & 15, h = (item >> 4) & 3, b = item >> 6, lane = LANE(), wave = F.wave;
    LAS unsigned char* Kl = F.lds; LAS unsigned char* Vl = F.lds + 32768;
#pragma unroll
    for (int j = 0; j < 4; ++j) {
        const int p = (wave * 4 + j) * 64 + lane, key = p >> 3, kpos = p & 7, kc = key & 31, swz = (((kc >> 3) & 3) << 1) | ((kc >> 1) & 1);
        __builtin_amdgcn_global_load_lds((const unsigned*)(memk + (size_t)(b * 256 + key) * 256 + h * 64 + ((kpos ^ swz) << 3)), (LAS unsigned*)(Kl + (wave * 4 + j) * 1024), 16, 0, 0);
        const int d = p >> 5, vpos = p & 31;
        __builtin_amdgcn_global_load_lds((const unsigned*)(memvt + (size_t)(h * 64 + d) * MEM_ROWS + b * 256 + ((vpos ^ (d & 15)) << 3)), (LAS unsigned*)(Vl + (wave * 4 + j) * 1024), 16, 0, 0);
    }
    asm volatile("s_waitcnt vmcnt(0)\n\ts_barrier" ::: "memory");
#pragma unroll 1
    for (int u = 0; u < 2; ++u) {
        const int tok0 = b * SEQ + tg * 256 + (wave * 2 + u) * 16;
        attn16<false, true, true, 32>(lane, act + (size_t)tok0 * ld + qoff + h * 64, ld, nullptr, 0, nullptr, 0, 0, 32, mix + (size_t)tok0 * DM + 768 + h * 64, DM, nullptr, 0, 0, 0, 0, Kl, 0, Vl);
    }
    asm volatile("s_waitcnt lgkmcnt(0)\n\ts_barrier" ::: "memory");
}
__device__ __forceinline__ void memattn_item(int it, int lane, const bf16* act, int ld, int qoff, const bf16* memk, const bf16* memvt, bf16* mix) {
    const int tb = it >> 2, h = it & 3, tok0 = tb * 16, b = tok0 >> 12;
    attn16<false>(lane, act + (size_t)tok0 * ld + qoff + h * 64, ld, memk + h * 64, 256, memvt + (size_t)(h * 64) * MEM_ROWS, MEM_ROWS, b * 256, 32,
                  mix + (size_t)tok0 * DM + 768 + h * 64, DM, nullptr, 0, 0, 0, 0);
}
constexpr int NA_RPB_OFF = 122880;
__device__ __forceinline__ void na_strip(const Frame& F, int item, const bf16* act0, const bf16* v0t, bf16* mix) {
    const int s8 = item & 7, h = (item >> 3) % 12, b = (item >> 3) / 12, lane = LANE(), wave = F.wave;
    const int R0 = 8 * s8, rowbase = min(max(R0 - 4, 0), 56), rowend = min(max(R0 + 7 - 4, 0), 56) + 8, nrows = rowend - rowbase;
    LAS unsigned char* Kl = F.lds;
    {
        const int col = wave * 8 + (lane >> 3), pos = lane & 7, swz = (((col >> 3) & 3) << 1) | ((col >> 1) & 1);
        const bf16* src = act0 + (size_t)(b * SEQ + rowbase * 64 + col) * A0_LD + 768 + h * 64 + ((pos ^ swz) << 3);
        for (int j = 0; j < nrows; ++j)
            __builtin_amdgcn_global_load_lds((const unsigned*)(src + (size_t)j * 64 * A0_LD), (LAS unsigned*)(Kl + j * 8192 + wave * 1024), 16, 0, 0);
    }
    asm volatile("s_waitcnt vmcnt(0)\n\ts_barrier" ::: "memory");
    const int r = R0 + wave, r0 = min(max(r - 4, 0), 56);
    const LAS float* rpb = (const LAS float*)(F.lds + NA_RPB_OFF) + h * 465;
#pragma unroll 1
    for (int jb = 0; jb < 4; ++jb) {
        const int band0 = min(max(jb * 16 - 8, 0), 32), tok0 = b * SEQ + r * 64 + jb * 16;
        attn16<true, true>(lane, act0 + (size_t)tok0 * A0_LD + h * 64, A0_LD, nullptr, 0, v0t + (size_t)(h * 64) * NT, NT, b * SEQ + r0 * 64 + band0, 64,
                           mix + (size_t)tok0 * DM + h * 64, DM, rpb, r, r0, jb, band0, Kl, r0 - rowbase);
    }
    asm volatile("s_waitcnt lgkmcnt(0)\n\ts_barrier" ::: "memory");
}
__device__ __forceinline__ void na_item(int it, int lane, const bf16* act0, const bf16* v0t, const LAS float* rpb, bf16* mix) {
    const int jb = it & 3, h = (it >> 2) % 12, br = (it >> 2) / 12, r = br & 63, b = br >> 6;
    const int r0 = min(max(r - 4, 0), 56), band0 = min(max(jb * 16 - 8, 0), 32);
    const int tok0 = b * SEQ + r * 64 + jb * 16;
    attn16<true>(lane, act0 + (size_t)tok0 * A0_LD + h * 64, A0_LD, act0 + 768 + h * 64, A0_LD, v0t + (size_t)(h * 64) * NT, NT, b * SEQ + r0 * 64 + band0, 64,
                 mix + (size_t)tok0 * DM + h * 64, DM, rpb + h * 465, r, r0, jb, band0);
}

__device__ __forceinline__ float logsigmoid(float x) { return fminf(x, 0.f) - log1pf(__expf(-fabsf(x))); }
__device__ __forceinline__ void gla_simple(const Frame& F, int item, const bf16* act1, const bf16* v1t, const float* wgk, const float* bgk, bf16* O) {
    const int b = item >> 3, h = (item >> 1) & 3, dir = item & 1, tid = TID();
    LAS float* sh = (LAS float*)F.lds;
    float S[96];
#pragma unroll
    for (int d = 0; d < 96; ++d) S[d] = 0.f;
    float wcol[16], bias = 0.f;
    if (tid < 96) {
#pragma unroll
        for (int r = 0; r < 16; ++r) wcol[r] = wgk[r * 384 + h * 96 + tid];
        bias = bgk[h * 96 + tid];
    }
    for (int tau = 0; tau < SEQ; ++tau) {
        const int token = b * SEQ + (dir ? (SEQ - 1 - tau) : tau);
        LAS float* cur = sh + (tau & 1) * 288;
        if (tid < 96) {
            const bf16* row = act1 + (size_t)token * A1_LD;
            float z = bias;
#pragma unroll
            for (int r = 0; r < 16; ++r) z += bf2f(row[1792 + dir * 16 + r]) * wcol[r];
            cur[tid] = __expf(logsigmoid(z) * (1.0f / 16.0f));
            cur[96 + tid] = bf2f(row[h * 96 + tid]) * 0.10206207261596575f;
            cur[192 + tid] = bf2f(row[384 + h * 96 + tid]);
        }
        __syncthreads();
        if (tid < 192) {
            const float v = bf2f(v1t[(size_t)(h * 192 + tid) * NT + token]);
            float o = 0.f;
            if (dir == 0) {
#pragma unroll
                for (int d = 0; d < 96; ++d) { S[d] = cur[d] * S[d] + cur[192 + d] * v; o += cur[96 + d] * S[d]; }
            } else {
#pragma unroll
                for (int d = 0; d < 96; ++d) { S[d] = cur[d] * S[d]; o += cur[96 + d] * S[d]; S[d] += cur[192 + d] * v; }
            }
            O[(size_t)token * 768 + h * 192 + tid] = (bf16)f2bf(o);
        }
    }
    __syncthreads();
}

constexpr int GP_LD = 392;
__device__ __forceinline__ void gla_pre_item(const Frame& F, int item, const bf16* act1, const float* W, const float* Bi, bf16* QT, bf16* KT, bf16* KDT, float* DEC) {
    const int n = item & 63, dir = (item >> 6) & 1, b = item >> 7, base = b * SEQ + n * 64;
    const int tid = TID(), lane = LANE(), wave = F.wave, qi = lane & 15, g = lane >> 4;
    LAS bf16* EL = (LAS bf16*)F.lds; LAS bf16* KDL = EL + 64 * GP_LD;
    {   bf16x8 zf[4];
#pragma unroll
        for (int ct = 0; ct < 4; ++ct) { const int c = 16 * ct + qi, tok = dir ? base + 63 - c : base + c;
            bf16x8 z = {0, 0, 0, 0, 0, 0, 0, 0}; if (g < 2) z = *(const bf16x8*)(act1 + (size_t)tok * A1_LD + 1792 + dir * 16 + 8 * g); zf[ct] = z; }
#pragma unroll 1
        for (int jj = 0; jj < 3; ++jj) {
            const int j = 16 * (wave + 8 * jj) + qi;
            v4u wu = {0u, 0u, 0u, 0u};
            if (g < 2) { const float* wp = W + (size_t)(8 * g) * 384 + j;
                wu.x = pk2(wp[0], wp[384]); wu.y = pk2(wp[768], wp[1152]); wu.z = pk2(wp[1536], wp[1920]); wu.w = pk2(wp[2304], wp[2688]); }
            const bf16x8 wfr = __builtin_bit_cast(bf16x8, wu);
            const float bias = Bi[j]; float carry = 0.f;
#pragma unroll
            for (int ct = 0; ct < 4; ++ct) {
                f32x4 d = {0.f, 0.f, 0.f, 0.f};
                d = __builtin_amdgcn_mfma_f32_16x16x32_bf16(zf[ct], wfr, d, 0, 0, 0);
                float p[4];
#pragma unroll
                for (int i = 0; i < 4; ++i) { const float x = d[i] + bias; p[i] = (fminf(x, 0.f) - __logf(1.0f + __expf(-fabsf(x)))) * 0.0625f; }
                p[1] += p[0]; p[2] += p[1]; p[3] += p[2];
                float a = p[3]; float t = __shfl_up(a, 16); if (g >= 1) a += t; t = __shfl_up(a, 32); if (g >= 2) a += t;
                const float excl = a - p[3] + carry;
                carry += __shfl(a, 48 + qi);
#pragma unroll
                for (int i = 0; i < 4; ++i) { const int c = 16 * ct + 4 * g + i, ctok = dir ? 63 - c : c; EL[ctok * GP_LD + j] = (bf16)f2bf(__expf(excl + p[i])); }
            }
        }
    }
    __syncthreads();
    const int clast = dir ? 0 : 63;
#pragma unroll 2
    for (int k = 0; k < 6; ++k) {
        const int idx = tid + 512 * k, c = idx / 48, jg = idx % 48;
        const bf16* arow = act1 + (size_t)(base + c) * A1_LD + 8 * jg;
        const v4u q8 = *(const v4u*)arow, k8 = *(const v4u*)(arow + 384);
        const v4u e8 = *(const LAS v4u*)(EL + c * GP_LD + 8 * jg), l8 = *(const LAS v4u*)(EL + clast * GP_LD + 8 * jg);
        const unsigned qa[4] = {q8.x, q8.y, q8.z, q8.w}, ka[4] = {k8.x, k8.y, k8.z, k8.w}, ea[4] = {e8.x, e8.y, e8.z, e8.w}, la[4] = {l8.x, l8.y, l8.z, l8.w};
        unsigned qo[4], ko[4], dq[4];
        float lf[8];
#pragma unroll
        for (int i = 0; i < 4; ++i) {
            const float e0 = bflo(ea[i]), e1 = bfhi(ea[i]), i0 = __builtin_amdgcn_rcpf(e0), i1 = __builtin_amdgcn_rcpf(e1);
            const float kt0 = bflo(ka[i]) * i0, kt1 = bfhi(ka[i]) * i1; lf[2 * i] = bflo(la[i]); lf[2 * i + 1] = bfhi(la[i]);
            qo[i] = pk2(bflo(qa[i]) * 0.10206207261596575f * e0, bfhi(qa[i]) * 0.10206207261596575f * e1);
            ko[i] = pk2(kt0, kt1); dq[i] = pk2(kt0 * lf[2 * i], kt1 * lf[2 * i + 1]);
        }
        v4u w; w.x = qo[0]; w.y = qo[1]; w.z = qo[2]; w.w = qo[3]; *(v4u*)(QT + (size_t)(base + c) * 384 + 8 * jg) = w;
        w.x = ko[0]; w.y = ko[1]; w.z = ko[2]; w.w = ko[3]; *(v4u*)(KT + (size_t)(base + c) * 384 + 8 * jg) = w;
        w.x = dq[0]; w.y = dq[1]; w.z = dq[2]; w.w = dq[3]; *(LAS v4u*)(KDL + c * GP_LD + 8 * jg) = w;
        if (c == clast) { float* dp = DEC + (size_t)((b * 4 + jg / 12) * 64 + n) * 96 + (jg % 12) * 8;
            *(f32x4*)dp = (f32x4){lf[0], lf[1], lf[2], lf[3]}; *(f32x4*)(dp + 4) = (f32x4){lf[4], lf[5], lf[6], lf[7]}; }
    }
    __syncthreads();
#pragma unroll 2
    for (int k = 0; k < 6; ++k) {
        const int idx = tid + 512 * k, j = idx % 384, cg = idx / 384, h = j / 96, d = j % 96;
        const LAS bf16* sp = KDL + (8 * cg) * GP_LD + j;
        v4u w; w.x = (unsigned)sp[0] | ((unsigned)sp[GP_LD] << 16); w.y = (unsigned)sp[2 * GP_LD] | ((unsigned)sp[3 * GP_LD] << 16);
        w.z = (unsigned)sp[4 * GP_LD] | ((unsigned)sp[5 * GP_LD] << 16); w.w = (unsigned)sp[6 * GP_LD] | ((unsigned)sp[7 * GP_LD] << 16);
        *(v4u*)(KDT + ((size_t)((b * 4 + h) * 64 + n) * 96 + d) * 64 + 8 * cg) = w;
    }
    __syncthreads();
}
constexpr int GL_QT = 0, GL_KT = 13312, GL_KDT = 26624, GL_VT = 40960, GL_DEC = 48128, GL_BUF = 49152;
__device__ __forceinline__ void gla_main_item(const Frame& F, int item, const bf16* QTa, const bf16* KTa, const bf16* KDT0, const bf16* KDT1, const float* DECa, const bf16* v1t, bf16* OFp, bf16* OBp) {
    const int vs = item & 3, dir = (item >> 2) & 1, h = (item >> 3) & 3, b = item >> 5;
    const int lane = LANE(), wave = F.wave, qi = lane & 15, g = lane >> 4, ct = wave & 3, vh = wave >> 2;
    bf16* O = dir ? OBp : OFp;
    LAS unsigned char* L = F.lds;
    unsigned off[6];
#pragma unroll
    for (int jj = 0; jj < 6; ++jj) { const int k = wave + 8 * jj; unsigned o;
        if (k < 26) { const int gi = (k < 13 ? k : k - 13) * 64 + lane, row = gi / 13, col = gi % 13; o = (unsigned)(row * 768 + (col < 12 ? col * 16 : 0)); }
        else if (k < 40) { const int gi = (k - 26) * 64 + lane, row = gi / 9, col = gi % 9; o = (gi < 864) ? (unsigned)(row * 128 + (col < 8 ? col * 16 : 0)) : 0u; }
        else if (k < 47) { const int gi = (k - 40) * 64 + lane, row = gi / 9, col = gi % 9; o = (gi < 432) ? (unsigned)(row * NT * 2 + (col < 8 ? col * 16 : 0)) : 0u; }
        else o = (lane < 24) ? (unsigned)(lane * 16) : 0u;
        off[jj] = o; }
    const char* qtb = (const char*)(QTa + (size_t)dir * NT * 384 + h * 96); const char* ktb = (const char*)(KTa + (size_t)dir * NT * 384 + h * 96);
    const char* kdb = (const char*)(dir ? KDT1 : KDT0) + (size_t)((b * 4 + h) * 64) * 12288; const char* deb = (const char*)(DECa + (size_t)dir * 8 * 4 * 64 * 96 + (size_t)((b * 4 + h) * 64) * 96);
    const char* vtb = (const char*)(v1t + (size_t)(h * 192 + vs * 48) * NT);
#define GL_DMA(n_, bufo_) do { const int nn_ = dir ? 63 - (n_) : (n_); const size_t tb_ = (size_t)(b * SEQ + nn_ * 64); \
        _Pragma("unroll") for (int jj_ = 0; jj_ < 6; ++jj_) { const int k_ = wave + 8 * jj_; \
            const char* src_ = k_ < 13 ? qtb + tb_ * 768 : (k_ < 26 ? ktb + tb_ * 768 : (k_ < 40 ? kdb + (size_t)nn_ * 12288 : (k_ < 47 ? vtb + tb_ * 2 : deb + (size_t)nn_ * 384))); \
            __builtin_amdgcn_global_load_lds((const unsigned*)(src_ + off[jj_]), (LAS unsigned*)(L + (bufo_) + k_ * 1024), 16, 0, 0); } } while (0)
    constexpr int GL_SB = 2 * GL_BUF;
    int oT[3]; bool oV[3];
#pragma unroll
    for (int j = 0; j < 3; ++j) { if (wave >= 4) { oT[j] = (wave - 4) + 4 * j; oV[j] = true; } else { oT[j] = (j == 0) ? 12 + wave : 16 + wave; oV[j] = (j == 0) || (j == 1 && wave < 2); } }
    f32x4 So[3];
#pragma unroll
    for (int j = 0; j < 3; ++j) So[j] = (f32x4){0.f, 0.f, 0.f, 0.f};
    for (int i = TID(); i < 18 * 512 / 8; i += NTHR) *(LAS v2u*)(L + GL_SB + i * 8) = (v2u){0u, 0u};
    GL_DMA(0, 0);
    asm volatile("s_waitcnt vmcnt(0) lgkmcnt(0)\n\ts_barrier" ::: "memory");
#pragma unroll 1
    for (int n = 0; n < 64; ++n) {
        const int bo = (n & 1) * GL_BUF;
        if (n + 1 < 64) GL_DMA(n + 1, GL_BUF - bo);
        LAS unsigned char* Bf = L + bo;
        const LAS unsigned char* SBr = L + GL_SB + (n & 1) * 9216; LAS unsigned char* SBw = L + GL_SB + ((n + 1) & 1) * 9216;
        bf16x8 qf[3];
#pragma unroll
        for (int ks = 0; ks < 3; ++ks) qf[ks] = *(const LAS bf16x8*)(Bf + GL_QT + (16 * ct + qi) * 208 + (32 * ks + 8 * g) * 2);
        f32x4 am[4];
#pragma unroll
        for (int tp = 0; tp < 4; ++tp) {
            f32x4 z = {0.f, 0.f, 0.f, 0.f};
            if (dir ? (tp >= ct) : (tp <= ct)) {
#pragma unroll
                for (int ks = 0; ks < 3; ++ks) { const bf16x8 kf = *(const LAS bf16x8*)(Bf + GL_KT + (16 * tp + qi) * 208 + (32 * ks + 8 * g) * 2);
                    z = __builtin_amdgcn_mfma_f32_16x16x32_bf16(kf, qf[ks], z, 0, 0, 0); }
                const int c = 16 * ct + qi;
#pragma unroll
                for (int i = 0; i < 4; ++i) { const int cp = 16 * tp + 4 * g + i; const bool keep = dir ? (cp > c) : (cp <= c); z[i] = keep ? z[i] : 0.f; }
            }
            am[tp] = z;
        }
        bf16x8 pf[2];
#pragma unroll
        for (int kk = 0; kk < 2; ++kk) { v4u w; w.x = pk2(am[2 * kk][0], am[2 * kk][1]); w.y = pk2(am[2 * kk][2], am[2 * kk][3]); w.z = pk2(am[2 * kk + 1][0], am[2 * kk + 1][1]); w.w = pk2(am[2 * kk + 1][2], am[2 * kk + 1][3]);
            pf[kk] = __builtin_bit_cast(bf16x8, w); }
        bf16x8 qp[3];
#pragma unroll
        for (int kk = 0; kk < 3; ++kk) { const LAS unsigned char* qr = Bf + GL_QT + (16 * ct + qi) * 208 + (32 * kk + 4 * g) * 2;
            const s16x4 a0 = *(const LAS s16x4*)qr, a1 = *(const LAS s16x4*)(qr + 32); qp[kk] = __builtin_shufflevector(a0, a1, 0, 1, 2, 3, 4, 5, 6, 7); }
        const int nn = dir ? 63 - n : n, tok = b * SEQ + nn * 64 + 16 * ct + qi;
#pragma unroll
        for (int vi = 0; vi < 2; ++vi) {
            if (vi == 1 && vh == 1) break;
            const int vt = 2 * vh + vi;
            f32x4 acc = {0.f, 0.f, 0.f, 0.f};
#pragma unroll
            for (int kk = 0; kk < 2; ++kk) { const LAS unsigned char* vr = Bf + GL_VT + (16 * vt + qi) * 144 + (32 * kk + 4 * g) * 2;
                const s16x4 a0 = *(const LAS s16x4*)vr, a1 = *(const LAS s16x4*)(vr + 32); const bf16x8 vf = __builtin_shufflevector(a0, a1, 0, 1, 2, 3, 4, 5, 6, 7);
                acc = __builtin_amdgcn_mfma_f32_16x16x32_bf16(vf, pf[kk], acc, 0, 0, 0); }
#pragma unroll
            for (int kk = 0; kk < 3; ++kk) { const LAS unsigned char* sr = SBr + (vt * 6 + 2 * kk) * 512 + lane * 8;
                const s16x4 a0 = *(const LAS s16x4*)sr, a1 = *(const LAS s16x4*)(sr + 512); const bf16x8 sf = __builtin_shufflevector(a0, a1, 0, 1, 2, 3, 4, 5, 6, 7);
                acc = __builtin_amdgcn_mfma_f32_16x16x32_bf16(sf, qp[kk], acc, 0, 0, 0); }
            v2u w; w.x = pk2(acc[0], acc[1]); w.y = pk2(acc[2], acc[3]);
            *(v2u*)(O + (size_t)tok * 768 + h * 192 + vs * 48 + 16 * vt + 4 * g) = w;
        }
#pragma unroll
        for (int j = 0; j < 3; ++j) {
            if (oV[j]) {
                const int T = oT[j], vt = T / 6, dt = T - 6 * vt;
                const f32x4 dec = *(const LAS f32x4*)(Bf + GL_DEC + (16 * dt + 4 * g) * 4);
                f32x4 sv = So[j]; sv[0] *= dec[0]; sv[1] *= dec[1]; sv[2] *= dec[2]; sv[3] *= dec[3];
#pragma unroll
                for (int ks = 0; ks < 2; ++ks) { const bf16x8 kdf = *(const LAS bf16x8*)(Bf + GL_KDT + (16 * dt + qi) * 144 + (32 * ks + 8 * g) * 2);
                    const bf16x8 vfr = *(const LAS bf16x8*)(Bf + GL_VT + (16 * vt + qi) * 144 + (32 * ks + 8 * g) * 2);
                    sv = __builtin_amdgcn_mfma_f32_16x16x32_bf16(kdf, vfr, sv, 0, 0, 0); }
                So[j] = sv;
                v2u w; w.x = pk2(sv[0], sv[1]); w.y = pk2(sv[2], sv[3]); *(LAS v2u*)(SBw + T * 512 + lane * 8) = w;
            }
        }
        if (vh) asm volatile("s_waitcnt vmcnt(1) lgkmcnt(0)\n\ts_barrier" ::: "memory"); else asm volatile("s_waitcnt vmcnt(2) lgkmcnt(0)\n\ts_barrier" ::: "memory");
    }
    __syncthreads();
#undef GL_DMA
}

__device__ __forceinline__ void finalize_rstd(const Frame& F, const float* rss, float* rstd) {
    for (int row = F.bid * NTHR + TID(); row < NT; row += F.G * NTHR) rstd[row] = rstd_from(rss + (size_t)row * 16);
}
__device__ __forceinline__ void gla_combine(const Frame& F, const bf16* OF, const bf16* OB, const bf16* act1, const float* gnorm, bf16* mix) {
    for (int token = F.gw; token < NT; token += F.NGW) {
        const int lane = LANE();
#pragma unroll
        for (int h = 0; h < 4; ++h) {
            float o[3]; float ss = 0.f;
#pragma unroll
            for (int j = 0; j < 3; ++j) { const size_t idx = (size_t)token * 768 + h * 192 + j * 64 + lane; o[j] = bf2f(OF[idx]) + bf2f(OB[idx]); ss += o[j] * o[j]; }
            ss = wave_sum(ss);
            const float rs = 1.0f / sqrtf(ss * (1.0f / 192.0f) + EPS);
#pragma unroll
            for (int j = 0; j < 3; ++j) { const int dv = j * 64 + lane; const float g = bf2f(act1[(size_t)token * A1_LD + 768 + h * 192 + dv]);
                const float val = o[j] * rs * gnorm[dv] * (g / (1.0f + __expf(-g)));
                mix[(size_t)token * DM + h * 192 + dv] = (bf16)f2bf(val); }
        }
    }
}
__device__ __forceinline__ void route_pick(const float (&acc)[8], int token, int* topi, float* topw, LAS int* lc) {
    int e0 = 0; float l0 = acc[0];
#pragma unroll
    for (int e = 1; e < 8; ++e) if (acc[e] > l0) { l0 = acc[e]; e0 = e; }
    int e1 = -1; float l1 = -INFINITY;
#pragma unroll
    for (int e = 0; e < 8; ++e) if (e != e0 && acc[e] > l1) { l1 = acc[e]; e1 = e; }
    if (e1 < 0) { e1 = (e0 + 1) & 7; l1 = l0; }
    const float w0 = 1.0f / (1.0f + __expf(l1 - l0));
    topi[token] = e0 | (e1 << 8); topw[2 * token] = w0; topw[2 * token + 1] = 1.0f - w0;
    atomicAdd((int*)&lc[e0], 1); atomicAdd((int*)&lc[8 + e1], 1);
}
__device__ __forceinline__ void route1(const Frame& F, const bf16* H, const float* gain, const float* wr, int* topi, float* topw, int* cnt, float* rstd) {
    LAS int* lc = (LAS int*)F.lds;
    if (TID() < 16) lc[TID()] = 0;
    __syncthreads();
    const int lane = LANE();
    float w[4][4][8];
#pragma unroll
    for (int j = 0; j < 4; ++j) { const f32x4 g = *(const f32x4*)(gain + 256 * j + 4 * lane);
#pragma unroll
        for (int i = 0; i < 4; ++i) { const float* p = wr + (size_t)(256 * j + 4 * lane + i) * 8; const f32x4 a = *(const f32x4*)p, b = *(const f32x4*)(p + 4); const float gi = g[i];
            w[j][i][0] = a.x * gi; w[j][i][1] = a.y * gi; w[j][i][2] = a.z * gi; w[j][i][3] = a.w * gi; w[j][i][4] = b.x * gi; w[j][i][5] = b.y * gi; w[j][i][6] = b.z * gi; w[j][i][7] = b.w * gi; } }
    for (int t2 = 0; t2 < 16; t2 += 2) {
        const int token = F.bid * 128 + F.wave * 16 + t2;
        const v2u* h0 = (const v2u*)(H + (size_t)token * DM) + lane; const v2u* h1 = h0 + DM / 4;
        f32x4 x0[4], x1[4];
#pragma unroll
        for (int j = 0; j < 4; ++j) { const v2u p = h0[64 * j], q = h1[64 * j]; x0[j] = (f32x4){bflo(p.x), bfhi(p.x), bflo(p.y), bfhi(p.y)}; x1[j] = (f32x4){bflo(q.x), bfhi(q.x), bflo(q.y), bfhi(q.y)}; }
        float a0[8], a1[8], s0 = 0.f, s1 = 0.f;
#pragma unroll
        for (int e = 0; e < 8; ++e) { a0[e] = 0.f; a1[e] = 0.f; }
#pragma unroll
        for (int j = 0; j < 4; ++j)
#pragma unroll
            for (int i = 0; i < 4; ++i) { const float u = x0[j][i], v = x1[j][i]; s0 += u * u; s1 += v * v;
#pragma unroll
                for (int e = 0; e < 8; ++e) { a0[e] += u * w[j][i][e]; a1[e] += v * w[j][i][e]; } }
        s0 = wave_sum(s0); s1 = wave_sum(s1);
        const float r0 = 1.0f / sqrtf(s0 * (1.0f / DM) + EPS), r1 = 1.0f / sqrtf(s1 * (1.0f / DM) + EPS);
#pragma unroll
        for (int e = 0; e < 8; ++e) { a0[e] = wave_sum(a0[e]) * r0; a1[e] = wave_sum(a1[e]) * r1; }
        if (lane == 0) { route_pick(a0, token, topi, topw, lc); route_pick(a1, token + 1, topi, topw, lc); rstd[token] = r0; rstd[token + 1] = r1; }
    }
    __syncthreads();
    if (TID() < 16) cnt[F.bid * 16 + TID()] = lc[TID()];
    __syncthreads();
}
__device__ __forceinline__ void route2(const Frame& F, const int* topi, const float* topw, const int* cnt, int* stok, float* sw, int* blk) {
    LAS int* part = (LAS int*)F.lds;
    LAS int* base = part + 1024;
    LAS int* tk = base + 64;
    const int tid = TID(), pe = tid & 15, jg = tid >> 4;
    int below = 0, tot = 0;
    for (int w = jg; w < F.G; w += 32) { const int v = cnt[w * 16 + pe]; tot += v; if (w < F.bid) below += v; }
    part[jg * 16 + pe] = below; part[512 + jg * 16 + pe] = tot;
    if (tid < 128) tk[tid] = topi[F.bid * 128 + tid];
    __syncthreads();
    if (tid < 16) { int b = 0, t = 0; for (int j = 0; j < 32; ++j) { b += part[j * 16 + tid]; t += part[512 + j * 16 + tid]; } base[tid] = b; base[16 + tid] = t; }
    __syncthreads();
    if (tid < 2) { int ps = 0; for (int e = 0; e < 8; ++e) { base[32 + tid * 8 + e] = ps; ps += (base[16 + tid * 8 + e] + 255) / 256 * 256; } base[48 + tid] = ps / 256; }
    __syncthreads();
    if (tid < 256) {
        const int p = tid >> 7, i = tid & 127; const int e = (tk[i] >> (8 * p)) & 0xff;
        int rank = 0; for (int j = 0; j < i; ++j) rank += (((tk[j] >> (8 * p)) & 0xff) == e) ? 1 : 0;
        const int slot = base[32 + p * 8 + e] + base[p * 8 + e] + rank; const int token = F.bid * 128 + i;
        stok[p * SLOT_CAP + slot] = token; sw[p * SLOT_CAP + slot] = topw[2 * token + p];
    }
    if (F.bid < 16) {
        const int p = F.bid >> 3, e = F.bid & 7, ps = base[32 + F.bid], t = base[16 + F.bid], pend = ps + (t + 255) / 256 * 256;
        for (int s = ps + t + tid; s < pend; s += NTHR) { stok[p * SLOT_CAP + s] = -1; sw[p * SLOT_CAP + s] = 0.f; }
        for (int bk = ps / 256 + tid; bk < pend / 256; bk += NTHR) blk[16 + p * 256 + bk] = e;
        if (e == 0 && tid == 0) blk[p] = base[48 + p];
    }
    __syncthreads();
}
__device__ __forceinline__ void final_norm_slots(int lane, const bf16* HB, float* OUT, const bf16* Y, const bf16* Y2, const float* gain, const int* tok, int s0, int s1, int first, int stride) {
    const f32x4* gr = (const f32x4*)gain + lane;
    for (int sl = s0 + first; sl < s1; sl += 2 * stride) {
        const int slb = sl + stride; const bool hb = slb < s1;
        const int ra = tok[sl], rb = hb ? tok[slb] : -1;
        const int rowa = ra < 0 ? 0 : ra, rowb = rb < 0 ? 0 : rb;
        const v2u* xa = (const v2u*)(HB + (size_t)rowa * DM) + lane; const v2u* xb = (const v2u*)(HB + (size_t)rowb * DM) + lane;
        const v2u* ya = (const v2u*)(Y + (size_t)sl * DM) + lane; const v2u* yb = (const v2u*)(Y + (size_t)(hb ? slb : sl) * DM) + lane;
        f32x4 va[4], vb[4]; v2u wa[4], wb[4], ua[4], ub[4];
#pragma unroll
        for (int j = 0; j < 4; ++j) { ua[j] = xa[64 * j]; wa[j] = ya[64 * j]; }
#pragma unroll
        for (int j = 0; j < 4; ++j) { ub[j] = xb[64 * j]; wb[j] = yb[64 * j]; }
#pragma unroll
        for (int j = 0; j < 4; ++j) { va[j] = (f32x4){bflo(ua[j].x), bfhi(ua[j].x), bflo(ua[j].y), bfhi(ua[j].y)}; vb[j] = (f32x4){bflo(ub[j].x), bfhi(ub[j].x), bflo(ub[j].y), bfhi(ub[j].y)}; }
        if (Y2) {
            const v2u* za = (const v2u*)(Y2 + (size_t)(sl - s0) * DM) + lane; const v2u* zb = (const v2u*)(Y2 + (size_t)((hb ? slb : sl) - s0) * DM) + lane;
#pragma unroll
            for (int j = 0; j < 4; ++j) { const v2u p = za[64 * j], q = zb[64 * j];
                va[j].x += bflo(p.x); va[j].y += bfhi(p.x); va[j].z += bflo(p.y); va[j].w += bfhi(p.y); vb[j].x += bflo(q.x); vb[j].y += bfhi(q.x); vb[j].z += bflo(q.y); vb[j].w += bfhi(q.y); }
        }
        float sa = 0.f, sb = 0.f;
#pragma unroll
        for (int j = 0; j < 4; ++j) {
            va[j].x += bflo(wa[j].x); va[j].y += bfhi(wa[j].x); va[j].z += bflo(wa[j].y); va[j].w += bfhi(wa[j].y);
            vb[j].x += bflo(wb[j].x); vb[j].y += bfhi(wb[j].x); vb[j].z += bflo(wb[j].y); vb[j].w += bfhi(wb[j].y);
            sa += (va[j].x * va[j].x + va[j].y * va[j].y) + (va[j].z * va[j].z + va[j].w * va[j].w); sb += (vb[j].x * vb[j].x + vb[j].y * vb[j].y) + (vb[j].z * vb[j].z + vb[j].w * vb[j].w); }
        sa = wave_sum(sa); sb = wave_sum(sb);
        const float rsa = 1.0f / sqrtf(sa * (1.0f / DM) + EPS), rsb = 1.0f / sqrtf(sb * (1.0f / DM) + EPS);
        if (ra >= 0) { GAS f32x4* oa = (GAS f32x4*)(OUT + (size_t)rowa * DM) + lane;
#pragma unroll
            for (int j = 0; j < 4; ++j) { const f32x4 g = gr[64 * j]; oa[64 * j] = (f32x4){va[j].x * rsa * g.x, va[j].y * rsa * g.y, va[j].z * rsa * g.z, va[j].w * rsa * g.w}; } }
        if (rb >= 0) { GAS f32x4* ob = (GAS f32x4*)(OUT + (size_t)rowb * DM) + lane;
#pragma unroll
            for (int j = 0; j < 4; ++j) { const f32x4 g = gr[64 * j]; ob[64 * j] = (f32x4){vb[j].x * rsb * g.x, vb[j].y * rsb * g.y, vb[j].z * rsb * g.z, vb[j].w * rsb * g.w}; } }
    }
}
__device__ __forceinline__ void final_norm(const Frame& F, float* H, const float* gain) {
    for (int row = F.gw; row < NT; row += F.NGW) {
        GAS f32x4* xr = (GAS f32x4*)(H + (size_t)row * DM) + LANE(); const f32x4* gr = (const f32x4*)gain + LANE();
        f32x4 v[4]; float s = 0.f;
#pragma unroll
        for (int j = 0; j < 4; ++j) { v[j] = xr[64 * j]; s += (v[j].x * v[j].x + v[j].y * v[j].y) + (v[j].z * v[j].z + v[j].w * v[j].w); }
        s = wave_sum(s); const float rs = 1.0f / sqrtf(s * (1.0f / DM) + EPS);
#pragma unroll
        for (int j = 0; j < 4; ++j) { const f32x4 g = gr[64 * j]; f32x4 o = {v[j].x * rs * g.x, v[j].y * rs * g.y, v[j].z * rs * g.z, v[j].w * rs * g.w}; xr[64 * j] = o; }
    }
}

constexpr int N_PHASES = 17;
__global__ void __launch_bounds__(NTHR, 2) mega(Args args) {
    extern __shared__ __attribute__((aligned(16))) unsigned char lds_raw[];
    Frame F;
    F.lds = (LAS unsigned char*)lds_raw;
    F.wave = __builtin_amdgcn_readfirstlane((int)(threadIdx.x >> 6));
    F.G = gridDim.x; F.bid = blockIdx.x; F.gw = F.bid * NWAVES + F.wave; F.NGW = F.G * NWAVES; F.ws = args.ws;
    unsigned char* ws = args.ws;
    gu32* ctl = (gu32*)(ws + WS_CTL);
    volatile LAS unsigned* MISC = (volatile LAS unsigned*)(F.lds + MISC_OFF);
    for (int u = TID(); u < (LDS_BYTES - LDSCTL_OFF) / 4; u += NTHR) ((LAS unsigned*)(F.lds + LDSCTL_OFF))[u] = 0u;
    __syncthreads();
    XcdBarrier bar = xcd_barrier_post((unsigned*)(ctl + CW_BAR), MISC + 8);
    const int lo = args.ph_lo, hi = args.ph_hi;
#ifndef PH_MASK
#define PH_MASK 0x1ffff
#endif
#define IN(k) (((PH_MASK >> (k)) & 1) && lo <= (k) && (k) < hi)
#ifndef REPEAT_MASK
#define REPEAT_MASK 0
#endif
#define REPS(k) (1 + ((REPEAT_MASK >> (k)) & 1))
#define SEAM(k) do { if (IN(k) && IN((k) + 1)) xcd_barrier(bar); } while (0)

    float* H = args.out;
    bf16* x3 = (bf16*)args.out;
    float* rss = (float*)(ws + WS_RSS); float* rstd = (float*)(ws + WS_RSTD);
    bf16* hbf = (bf16*)(ws + WS_HBF); bf16* membf = (bf16*)(ws + WS_MEMBF); bf16* memk = (bf16*)(ws + WS_MEMK); bf16* memvt = (bf16*)(ws + WS_MEMVT);
    bf16* act0 = (bf16*)(ws + WS_ACT0); bf16* v0t = (bf16*)(ws + WS_V0T); bf16* mix = (bf16*)(ws + WS_MIX); bf16* hmid0 = (bf16*)(ws + WS_HMID0);
    bf16* act1 = (bf16*)(ws + WS_ACT1); bf16* v1t = (bf16*)(ws + WS_V1T); bf16* OF = (bf16*)(ws + WS_OF); bf16* OB = (bf16*)(ws + WS_OB);
    bf16* hmid1 = (bf16*)(ws + WS_HMID1); bf16* wgu = (bf16*)(ws + WS_WGU); bf16* wdn = (bf16*)(ws + WS_WDN);
    int* cnt = (int*)(ws + WS_CNT); int* topi = (int*)(ws + WS_TOPI); float* topw = (float*)(ws + WS_TOPW);
    int* stok = (int*)(ws + WS_STOK); float* sw = (float*)(ws + WS_SW); int* blk = (int*)(ws + WS_BLK);
    LAS float* scr = (LAS float*)(F.lds + F.wave * 16384);

    if (IN(0)) {
        int it = F.gw; LAS unsigned* T0 = (LAS unsigned*)scr; LAS unsigned* T1 = T0 + 1088;
#define CVT(Wp, Kd, Nd, WTp, gainp, kind) do { const CvtJob J{Wp, Kd, Nd, (bf16*)(WTp), gainp, kind}; const int n_ = ((Kd) / 64) * ((Nd) / 32); \
            while (it < n_) { CvtRegs A_, B_; B_.valid = 0; cvt_load(A_, J, it, LANE()); it += F.NGW; if (it < n_) { cvt_load(B_, J, it, LANE()); it += F.NGW; } cvt_finish(A_, T0, LANE()); cvt_finish(B_, T1, LANE()); } \
            it -= n_; } while (0)
        CVT(args.in[I_EWIN], 1024, 2560, ws + WS_W0IN, args.in[I_EN1], 1);
        CVT(args.in[I_EWIN], 1024, 2560, ws + WS_WV0, args.in[I_EN1], 2);
        CVT(args.in[I_EWOUT], 1024, 1024, ws + WS_W0OUT, nullptr, 0);
        CVT(args.in[I_EWG], 1024, 2816, ws + WS_W0GU, args.in[I_EN2], 3);
        CVT(args.in[I_EWU], 1024, 2816, ws + WS_W0GU, args.in[I_EN2], 4);
        CVT(args.in[I_EWD], 2816, 1024, ws + WS_W0DN, nullptr, 0);
        CVT(args.in[I_WMKV], 1024, 512, ws + WS_WMEM, args.in[I_MNORM], 0);
        CVT(args.in[I_OWIN], 1024, 2592, ws + WS_W1IN, args.in[I_ON1], 5);
        CVT(args.in[I_OWIN], 1024, 2592, ws + WS_WV1, args.in[I_ON1], 6);
        CVT(args.in[I_OWOUT], 1024, 1024, ws + WS_W1OUT, nullptr, 0);
#undef CVT
        { v4u z = {0u, 0u, 0u, 0u}; v4u* p = (v4u*)(ws + WS_W1IN + (size_t)1824 * 2048); const int n16 = 224 * 2048 / 16;
          for (int i = F.bid * NTHR + TID(); i < n16; i += F.G * NTHR) p[i] = z; }
        rows_to_bf16(args.in[I_X], hbf, rstd, F.gw, NT, F.NGW, LANE());
        rows_to_bf16(args.in[I_MEM], membf, rstd + NT, F.gw, MEM_ROWS, F.NGW, LANE());
    }
    SEAM(0);
    if (IN(1)) {
        { Sched S; S.init(hbf, ws + WS_W0IN, 1024, 128, 7, F.G, F.bid); EpiRowScale E{act0, A0_LD, rstd}; gemm_run<EpiRowScale, false>(F.lds, S, E, nullptr); }
        { Sched S; S.init(ws + WS_WV0, hbf, 1024, 3, 128, F.G, (F.bid + 128) % F.G); EpiColScale E{v0t, NT, rstd}; gemm_run<EpiColScale, false>(F.lds, S, E, nullptr); }
        { Sched S; S.init(membf, ws + WS_WMEM, 1024, 8, 1, F.G, F.bid); EpiRowScale E{memk, 256, rstd + NT}; gemm_run<EpiRowScale, false>(F.lds, S, E, nullptr); }
        { Sched S; S.init(ws + WS_WMEM + 256 * 2048, membf, 1024, 1, 8, F.G, (F.bid + 248) % F.G); EpiColScale E{memvt, MEM_ROWS, rstd + NT}; gemm_run<EpiColScale, false>(F.lds, S, E, nullptr); }
    }
    SEAM(1);
    if (IN(2)) {
#if FAST_ATT
        { LAS float* rl = (LAS float*)(F.lds + NA_RPB_OFF); for (int i = TID(); i < 5580; i += NTHR) rl[i] = args.in[I_RPB][i] * 1.4426950408889634f; __syncthreads();
          for (int it = F.bid; it < 768; it += F.G) na_strip(F, it, act0, v0t, mix);
          for (int it = F.bid; it < 512; it += F.G) memattn_strip(F, it, act0, A0_LD, 1536, memk, memvt, mix);
          __syncthreads(); }
#else
        na_simple(F, act0, v0t, args.in[I_RPB], mix);
        memattn_simple(F, F.gw, F.NGW, act0, A0_LD, 1536, memk, memvt, mix);
#endif
    }
    SEAM(2);
    if (IN(3)) {
        Sched S; S.init(mix, ws + WS_W0OUT, 1024, 128, 4, F.G, F.bid); EpiResid<true> E{args.in[I_X], hbf, rss, nullptr}; gemm_run<EpiResid<true>, false>(F.lds, S, E, nullptr);
    }
    SEAM(3);
    if (IN(4)) {
        finalize_rstd(F, rss, rstd); xcd_barrier(bar);
        Sched S; S.init(hbf, ws + WS_W0GU, 1024, 128, 22, F.G, F.bid); EpiSwiGLU<false> E{hmid0, FF0, rstd, nullptr}; gemm_run<EpiSwiGLU<false>, false>(F.lds, S, E, nullptr);
    }
    SEAM(4);
    if (IN(5)) {
        Sched S; S.init(hmid0, ws + WS_W0DN, FF0, 128, 4, F.G, F.bid); EpiResid<false> E{nullptr, hbf, rss, nullptr}; gemm_run<EpiResid<false>, false>(F.lds, S, E, nullptr);
    }
    SEAM(5);
    if (IN(6)) {
        finalize_rstd(F, rss, rstd); xcd_barrier(bar);
        { Sched S; S.init(hbf, ws + WS_W1IN, 1024, 128, 8, F.G, F.bid); EpiRowScale E{act1, A1_LD, rstd}; gemm_run<EpiRowScale, false>(F.lds, S, E, nullptr); }
        { Sched S; S.init(ws + WS_WV1, hbf, 1024, 3, 128, F.G, F.bid); EpiColScale E{v1t, NT, rstd}; gemm_run<EpiColScale, false>(F.lds, S, E, nullptr); }
    }
    SEAM(6);
    if (IN(7)) {
#if FAST_GLA
        for (int it = F.bid; it < 1024; it += F.G) { const int dir = (it >> 6) & 1;
            gla_pre_item(F, it, act1, dir ? args.in[I_WGKB] : args.in[I_WGKF], dir ? args.in[I_BGKB] : args.in[I_BGKF], (bf16*)(ws + WS_GQT) + (size_t)dir * NT * 384, (bf16*)((unsigned char*)args.out + OUT_GKT) + (size_t)dir * NT * 384,
                         (bf16*)(ws + (dir ? WS_GKDT1 : WS_GKDT0)), (float*)((unsigned char*)args.out + OUT_GDEC) + (size_t)dir * 8 * 4 * 64 * 96); }
        for (int it = F.bid; it < 512; it += F.G) memattn_strip(F, it, act1, A1_LD, 1536, memk, memvt, mix);
        xcd_barrier(bar);
        for (int it0 = F.bid; it0 < 256; it0 += F.G) { const int it = (F.G == 256) ? ((it0 & 7) * 8 + (it0 >> 5)) * 4 + ((it0 >> 3) & 3) : it0;
            gla_main_item(F, it, (const bf16*)(ws + WS_GQT), (const bf16*)((unsigned char*)args.out + OUT_GKT), (const bf16*)(ws + WS_GKDT0), (const bf16*)(ws + WS_GKDT1), (const float*)((unsigned char*)args.out + OUT_GDEC), v1t, OF, OB); }
#else
        if (F.bid < 64) {
            const int dir = F.bid & 1;
            gla_simple(F, F.bid, act1, v1t, dir ? args.in[I_WGKB] : args.in[I_WGKF], dir ? args.in[I_BGKB] : args.in[I_BGKF], dir ? OB : OF);
        } else {
#if FAST_ATT
            for (int it = (F.bid - 64) * NWAVES + F.wave; it < 8192; it += (F.G - 64) * NWAVES) memattn_item(it, LANE(), act1, A1_LD, 1536, memk, memvt, mix);
#else
            memattn_simple(F, (F.bid - 64) * NWAVES + F.wave, (F.G - 64) * NWAVES, act1, A1_LD, 1536, memk, memvt, mix);
#endif
        }
#endif
    }
    SEAM(7);
    if (IN(8)) gla_combine(F, OF, OB, act1, args.in[I_GNORM], mix);
    SEAM(8);
    if (IN(9)) {
        Sched S; S.init(mix, ws + WS_W1OUT, 1024, 128, 4, F.G, F.bid); EpiResid<false> E{nullptr, hbf, rss, x3}; gemm_run<EpiResid<false>, false>(F.lds, S, E, nullptr);
    }
    SEAM(9);
    if (IN(10)) {
        route1(F, hbf, args.in[I_ON2], args.in[I_WR], topi, topw, cnt, rstd);
        { LAS unsigned* T0 = (LAS unsigned*)scr; LAS unsigned* T1 = T0 + 1088;
#define MOE_JOB(J_, it_) const int e_##J_ = (it_) / 5376, r_##J_ = (it_) % 5376, wh_##J_ = r_##J_ / 1792; \
            const CvtJob J_{wh_##J_ == 0 ? args.in[I_OWG] + (size_t)e_##J_ * 1024 * FFE : (wh_##J_ == 1 ? args.in[I_OWU] + (size_t)e_##J_ * 1024 * FFE : args.in[I_OWD] + (size_t)e_##J_ * FFE * 1024), \
                wh_##J_ == 2 ? FFE : 1024, wh_##J_ == 2 ? 1024 : FFE, wh_##J_ == 2 ? wdn + (size_t)e_##J_ * 1024 * FFE : wgu + (size_t)e_##J_ * 7168 * 1024, wh_##J_ == 2 ? nullptr : args.in[I_ON2], wh_##J_ == 2 ? 0 : 3 + wh_##J_}
          for (int it = F.gw; it < 8 * 3 * 1792; it += 2 * F.NGW) {
            CvtRegs A_, B_; B_.valid = 0;
            { MOE_JOB(Ja, it); cvt_load(A_, Ja, it % 1792, LANE()); }
            if (it + F.NGW < 8 * 3 * 1792) { MOE_JOB(Jb, it + F.NGW); cvt_load(B_, Jb, (it + F.NGW) % 1792, LANE()); }
            cvt_finish(A_, T0, LANE()); cvt_finish(B_, T1, LANE());
          }
#undef MOE_JOB
        }
    }
    SEAM(10);
    if (IN(11)) route2(F, topi, topw, cnt, stok, sw, blk);
    SEAM(11);
    bf16* ht0 = hmid1 + (size_t)NT * FFE; bf16* ht1 = (bf16*)(ws + WS_HT1);
    if (IN(12)) {
        const int nb = blk[0]; Sched S; S.init(x3, wgu, 1024, nb, 28, F.G, F.bid, blk + 16, (size_t)7168 * 1024 * 2); EpiSwiGLU<true> E{hmid1, FFE, rstd, ht0}; gemm_run<EpiSwiGLU<true>, true>(F.lds, S, E, stok);
    }
    SEAM(12);
    if (IN(13)) {
        const int nb = blk[0], nbm = nb < 128 ? nb : 128; Sched S; S.init(hmid1, wdn, FFE, nbm, 4, F.G, F.bid, blk + 16, (size_t)1024 * FFE * 2); EpiMoeDown E{hbf, stok, sw}; gemm_run<EpiMoeDown, false>(F.lds, S, E, nullptr);
    }
    SEAM(13);
    if (IN(14)) {
        const int nb = blk[1], nb0 = blk[0], rfull = (nb * 28 / F.G > 3) ? nb * 28 / F.G - 3 : 0, per = F.G / 8;
        { Sched S; S.init(x3, wgu, 1024, nb, 28, F.G, F.bid, blk + 16 + 256, (size_t)7168 * 1024 * 2); S.range(0, rfull * per, per);
          EpiSwiGLU<true> E{hmid1, FFE, rstd, ht1}; gemm_run<EpiSwiGLU<true>, true>(F.lds, S, E, stok + SLOT_CAP); }
        { Sched S; S.init(x3, wgu, 1024, nb, 28, F.G, F.bid, blk + 16 + 256, (size_t)7168 * 1024 * 2); S.range(rfull * per, 0x7fffffff, per - 4);
          EpiSwiGLU<true> E{hmid1, FFE, rstd, ht1}; gemm_run<EpiSwiGLU<true>, true>(F.lds, S, E, stok + SLOT_CAP); }
        if (F.bid / 8 >= per - 4 && nb0 > 128) {
            Sched S; S.init(ht0, wdn, FFE, nb0 - 128, 4, 32, (F.bid / 8 - (per - 4)) * 8 + F.bid % 8, blk + 16 + 128, (size_t)1024 * FFE * 2);
            EpiMoeDown E{hbf, stok + NT, sw + NT}; gemm_run<EpiMoeDown, false>(F.lds, S, E, nullptr); }
    }
    SEAM(14);
    if (IN(15)) {
        const int nb = blk[1], nbm = nb < 128 ? nb : 128; Sched S; S.init(hmid1, wdn, FFE, nbm, 4, F.G, F.bid, blk + 16 + 256, (size_t)1024 * FFE * 2); EpiRowScale E{(bf16*)(ws + WS_YB), DM, sw + SLOT_CAP}; gemm_run<EpiRowScale, false>(F.lds, S, E, nullptr);
    }
    SEAM(15);
    if (IN(16)) {
        const int nb = blk[1], per = F.G / 8, nmain = (nb < 128 ? nb : 128) * 256;
        bf16* yb = (bf16*)(ws + WS_YB); bf16* yb2 = yb + (size_t)SLOT_CAP * DM;
        if (F.bid / 8 >= per - 4) {
            if (nb > 128) {
                const int sl = F.bid / 8 - (per - 4), kh = sl >> 1;
                Sched S; S.init((const bf16*)ht1 + kh * (FFE / 2), (const bf16*)wdn + kh * (FFE / 2), FFE / 2, nb - 128, 4, 16, (sl & 1) * 8 + F.bid % 8, blk + 16 + 256 + 128, (size_t)1024 * FFE * 2); S.ld = FFE;
                EpiRowScale E{kh ? yb2 : yb + (size_t)NT * DM, DM, sw + SLOT_CAP + NT}; gemm_run<EpiRowScale, false>(F.lds, S, E, nullptr); }
        } else {
            const int wv = (int)(blockIdx.x * NWAVES + (threadIdx.x >> 6));
            final_norm_slots((int)(threadIdx.x & 63u), hbf, H, yb, nullptr, args.in[I_FNORM], stok + SLOT_CAP, 0, nmain, wv, (per - 4) * 8 * NWAVES);
        }
        xcd_barrier(bar);
        if (nb > 128) final_norm_slots((int)(threadIdx.x & 63u), hbf, H, yb, yb2, args.in[I_FNORM], stok + SLOT_CAP, NT, nb * 256, (int)(blockIdx.x * NWAVES + (threadIdx.x >> 6)), F.NGW);
    }
#undef IN
#undef SEAM
}

extern "C" void kernel_launch(void* const* d_in, const int* in_sizes, int n_in, void* d_out, int out_size, void* d_ws, size_t ws_size, hipStream_t stream) {
    static int grid = 0;
    if (grid == 0) {
        if (n_in != 26 || out_size != NT * DM || ws_size < WS_END) { fprintf(stderr, "kernel_launch: unexpected problem (n_in %d out %d ws %zu need %zu)\n", n_in, out_size, ws_size, (size_t)WS_END); grid = -1; return; }
        int dev = 0, cus = 0, per_cu = 0;
        if (hipGetDevice(&dev) != hipSuccess || hipDeviceGetAttribute(&cus, hipDeviceAttributeMultiprocessorCount, dev) != hipSuccess) { grid = -1; return; }
        if (hipFuncSetAttribute((const void*)mega, hipFuncAttributeMaxDynamicSharedMemorySize, LDS_BYTES) != hipSuccess) { fprintf(stderr, "kernel_launch: hipFuncSetAttribute failed\n"); grid = -1; return; }
        if (hipOccupancyMaxActiveBlocksPerMultiprocessor(&per_cu, (const void*)mega, NTHR, LDS_BYTES) != hipSuccess || per_cu < 1) fprintf(stderr, "kernel_launch: occupancy query reports %d\n", per_cu);
        (void)hipGetLastError();
        grid = cus;
        if (grid != 256) fprintf(stderr, "kernel_launch: note: %d CUs\n", grid);
    }
    if (grid < 0) return;
    if (hipMemsetAsync((char*)d_ws + WS_CTL, 0, CTL_ZERO_BYTES, stream) != hipSuccess) return;
    Args a{};
    for (int i = 0; i < 26; ++i) a.in[i] = (const float*)d_in[i];
    a.out = (float*)d_out; a.ws = (unsigned char*)d_ws;
#if MK_FUSED
    a.ph_lo = 0; a.ph_hi = N_PHASES;
    hipLaunchKernelGGL(mega, dim3(grid), dim3(NTHR), LDS_BYTES, stream, a);
#else
    for (int p = 0; p < N_PHASES; ++p) { a.ph_lo = p; a.ph_hi = p + 1; hipLaunchKernelGGL(mega, dim3(grid), dim3(NTHR), LDS_BYTES, stream, a); }
#endif
}
```

```cpp
#include <hip/hip_runtime.h>
#include <cstdio>
#include <cstdint>


#define GAS __attribute__((address_space(1)))
#define LAS __attribute__((address_space(3)))
typedef unsigned short bf16;
typedef unsigned v4u __attribute__((ext_vector_type(4)));
typedef unsigned v2u __attribute__((ext_vector_type(2)));
typedef float f32x4 __attribute__((ext_vector_type(4)));
typedef short bf16x8 __attribute__((ext_vector_type(8)));
typedef GAS unsigned gu32;
#define RLX_AGENT __ATOMIC_RELAXED, __HIP_MEMORY_SCOPE_AGENT
#define LDS_WAIT() asm volatile("s_waitcnt lgkmcnt(0)" ::: "memory")
#define VM_WAIT() asm volatile("s_waitcnt vmcnt(0)" ::: "memory")

constexpr int NT = 32768, DM = 1024, SEQ = 4096, NB = 8;
constexpr int MEM_ROWS = 2048;
constexpr int A0_LD = 1792;
constexpr int A1_LD = 2048;
constexpr int FF0 = 2816, FFE = 3584, NEXP = 8;
constexpr int SLOT_CAP = 34816;
constexpr float EPS = 1e-6f;
constexpr int NWAVES = 8, NTHR = 512;

constexpr size_t MiB = 1u << 20;
constexpr size_t WS_CTL = 0, CTL_ZERO_BYTES = 1 * MiB;
constexpr size_t WS_RSS = 1 * MiB;
constexpr size_t WS_MRSS = 3 * MiB;
constexpr size_t WS_CNT = 3 * MiB + 256 * 1024;
constexpr size_t WS_TOPI = 3 * MiB + 512 * 1024;
constexpr size_t WS_TOPW = 3 * MiB + 768 * 1024;
constexpr size_t WS_STOK = 4 * MiB;
constexpr size_t WS_SW = 4 * MiB + 512 * 1024;
constexpr size_t WS_BLK = 5 * MiB;
constexpr size_t WS_RSTD = 5 * MiB + 64 * 1024;
constexpr size_t WS_W0IN = 6 * MiB;
constexpr size_t WS_WV0 = WS_W0IN + 1792 * 2048;
constexpr size_t WS_W0OUT = 11 * MiB;
constexpr size_t WS_W0GU = 13 * MiB;
constexpr size_t WS_W0DN = 24 * MiB;
constexpr size_t WS_WMEM = WS_W0DN + 1024 * 2816 * 2;
constexpr size_t WS_W1IN = 31 * MiB;
constexpr size_t WS_WV1 = 35 * MiB;
constexpr size_t WS_W1OUT = 37 * MiB - 512 * 1024;
constexpr size_t WS_HBF = 39 * MiB;
constexpr size_t WS_MEMBF = 103 * MiB;
constexpr size_t WS_MEMK = 107 * MiB;
constexpr size_t WS_MEMVT = 108 * MiB;
constexpr size_t WS_ACT = 109 * MiB;
constexpr size_t WS_ACT0 = WS_ACT;
constexpr size_t WS_V0T = WS_ACT + 112 * MiB;
constexpr size_t WS_MIX = WS_ACT + 176 * MiB;
constexpr size_t WS_HMID0 = WS_ACT;
constexpr size_t WS_ACT1 = WS_ACT;
constexpr size_t WS_V1T = WS_ACT + 128 * MiB;
constexpr size_t WS_OF = WS_ACT + 240 * MiB;
constexpr size_t WS_OB = WS_ACT + 288 * MiB;
constexpr size_t WS_GQT = WS_ACT + 336 * MiB;
constexpr size_t WS_GKDT0 = WS_ACT + 384 * MiB;
constexpr size_t WS_GKDT1 = 6 * MiB;
constexpr size_t OUT_GKT = 0, OUT_GDEC = 48 * MiB;
constexpr size_t WS_E = WS_ACT + 336 * MiB;
constexpr size_t WS_HT1 = 6 * MiB;
constexpr size_t WS_YB = WS_ACT + 240 * MiB;
constexpr size_t WS_HMID1 = WS_ACT;
constexpr size_t WS_WGU = WS_ACT + 240 * MiB;
constexpr size_t WS_WDN = WS_ACT + 352 * MiB;
constexpr size_t WS_END = WS_ACT + 408 * MiB;
static_assert(WS_W1OUT + 2 * MiB <= WS_HBF && WS_WV1 + 768 * 2048 <= WS_W1OUT && WS_W1IN + 4 * MiB <= WS_WV1 && WS_WMEM + MiB <= WS_W1IN, "weight map");
static_assert(WS_W0GU + 11 * MiB <= WS_W0DN && WS_WV0 + 768 * 2048 <= WS_W0OUT, "weight map 2");
static_assert((size_t)SLOT_CAP * 3584 * 2 <= 240 * MiB, "hmid1");

constexpr int CW_TMO = 0, CW_CODE = 1, CW_BAR = 4096;

constexpr int RING_BYTES = 131072;
constexpr int LDSCTL_OFF = 147456, MISC_OFF = LDSCTL_OFF + 320;
constexpr int LDS_BYTES = 148480;

typedef float f32x2_t __attribute__((ext_vector_type(2)));
typedef __bf16 bf16x2_t __attribute__((ext_vector_type(2)));
__device__ __forceinline__ unsigned pk2(float lo, float hi) { const f32x2_t v = {lo, hi}; const bf16x2_t b = __builtin_convertvector(v, bf16x2_t); return __builtin_bit_cast(unsigned, b); }
__device__ __forceinline__ unsigned f2bf(float f) { return pk2(f, 0.f) & 0xffffu; }
__device__ __forceinline__ float bf2f(bf16 b) { return __builtin_bit_cast(float, (unsigned)b << 16); }
__device__ __forceinline__ float bflo(unsigned u) { return __builtin_bit_cast(float, u << 16); }
__device__ __forceinline__ float bfhi(unsigned u) { return __builtin_bit_cast(float, u & 0xffff0000u); }
__device__ __forceinline__ float wave_sum(float v) {
#pragma unroll
    for (int o = 1; o < 64; o <<= 1) v += __shfl_xor(v, o);
    return v;
}
__device__ __forceinline__ float wave_max(float v) {
#pragma unroll
    for (int o = 1; o < 64; o <<= 1) v = fmaxf(v, __shfl_xor(v, o));
    return v;
}

#define XB_TMO      128
#define XB_XCNT(j)  (256  + 64 * (j))
#define XB_XSUB(j)  (1280 + 64 * (j))
#define XB_XGEN(j)  (2304 + 64 * (j))
#define XB_TOP      3328
#define XB_TOPGEN   3392
#define XCD_BAR_WORDS 3456
#define XB_SPIN_CAP (1u << 22)

__device__ __forceinline__ unsigned xb_ld(unsigned* p)              { return __hip_atomic_load(p, __ATOMIC_RELAXED, __HIP_MEMORY_SCOPE_AGENT); }
__device__ __forceinline__ unsigned xb_add(unsigned* p, unsigned v) { return __hip_atomic_fetch_add(p, v, __ATOMIC_RELAXED, __HIP_MEMORY_SCOPE_AGENT); }
__device__ __forceinline__ unsigned xb_xcc_id() { return (unsigned)__builtin_amdgcn_s_getreg((3 << 11) | 20) & 0xFu; }
#define XB_SPIN(cond, bar) do { unsigned _sp = 0; while (cond) { __builtin_amdgcn_s_sleep(1); \
    if ((++_sp & 255u) == 0u) { if (xb_ld(&(bar)[XB_TMO])) break; if (_sp > XB_SPIN_CAP) { atomicAdd(&(bar)[XB_TMO], 1u); break; } } } } while (0)

struct XcdBarrier { unsigned* bar; unsigned x; volatile LAS unsigned* st; };

__device__ __forceinline__ XcdBarrier xcd_barrier_post(unsigned* bar, volatile LAS unsigned* st) {
    XcdBarrier b; b.bar = bar; b.x = xb_xcc_id(); b.st = st;
    if (threadIdx.x == 0) (void)xb_add(&bar[XB_XCNT(b.x)], 1u);
    return b;
}
__device__ __forceinline__ void xcd_barrier_complete(unsigned* bar, unsigned x, unsigned& nloc, unsigned& nx) {
    const unsigned G = gridDim.x * gridDim.y * gridDim.z;
    unsigned sum, cnt, mine, sp = 0u;
    for (;;) {
        sum = 0u; cnt = 0u; mine = 0u;
#pragma unroll
        for (unsigned j = 0; j < 16; ++j) { const unsigned c = xb_ld(&bar[XB_XCNT(j)]); sum += c; cnt += (c > 0u) ? 1u : 0u; mine = (j == x) ? c : mine; }
        if (sum == G) break;
        __builtin_amdgcn_s_sleep(1);
        if ((++sp & 255u) == 0u) { if (xb_ld(&bar[XB_TMO])) break; if (sp > XB_SPIN_CAP) { atomicAdd(&bar[XB_TMO], 1u); break; } }
    }
    nloc = mine > 0u ? mine : 1u; nx = cnt > 0u ? cnt : 1u;
}
__device__ __forceinline__ void xcd_barrier(const XcdBarrier& b) {
    asm volatile("s_waitcnt vmcnt(0)" ::: "memory");
    __syncthreads();
    if (threadIdx.x == 0) {
        unsigned* bar = b.bar;
        __builtin_amdgcn_s_waitcnt(0);
        unsigned nloc = b.st[0], nx = b.st[1];
        if (nloc == 0u) { xcd_barrier_complete(bar, b.x, nloc, nx); b.st[0] = nloc; b.st[1] = nx; }
        const unsigned old = xb_add(&bar[XB_XSUB(b.x)], 1u);
        const unsigned gen = old / nloc;
        if (old + 1u == (gen + 1u) * nloc) {
            __builtin_amdgcn_fence(__ATOMIC_RELEASE, "agent");
            asm volatile("s_waitcnt vmcnt(0)" ::: "memory");
            const unsigned og = xb_add(&bar[XB_TOP], 1u);
            const unsigned tg = og / nx;
            if (og + 1u == (tg + 1u) * nx) xb_add(&bar[XB_TOPGEN], 1u);
            else XB_SPIN(xb_ld(&bar[XB_TOPGEN]) == tg, bar);
            __builtin_amdgcn_fence(__ATOMIC_ACQUIRE, "agent");
            xb_add(&bar[XB_XGEN(b.x)], 1u);
            asm volatile("s_waitcnt vmcnt(0)" ::: "memory");
        } else {
            XB_SPIN(xb_ld(&bar[XB_XGEN(b.x)]) == gen, bar);
            __builtin_amdgcn_fence(__ATOMIC_ACQUIRE, "agent");
            asm volatile("s_waitcnt vmcnt(0)" ::: "memory");
        }
    }
    __syncthreads();
}

struct Args { const float* in[26]; float* out; unsigned char* ws; int ph_lo, ph_hi; };
enum { I_X = 0, I_MEM, I_EN1, I_EWIN, I_RPB, I_EWOUT, I_EN2, I_EWG, I_EWU, I_EWD, I_ON1, I_OWIN, I_WGKF, I_BGKF, I_WGKB, I_BGKB, I_GNORM, I_OWOUT, I_ON2, I_WR, I_OWG, I_OWU, I_OWD, I_MNORM, I_WMKV, I_FNORM };

#define LANE() ((int)(threadIdx.x & 63u))
#define TID() ((int)threadIdx.x)
struct Frame {
    LAS unsigned char* lds;
    int wave, G, bid;
    int gw, NGW;
    unsigned char* ws;
};

constexpr float QSCALE = 0.125f * 1.4426950408889634f;
struct CvtJob { const float* W; int K, N; bf16* WT; const float* gain; int kind; };
__device__ __forceinline__ bool cvt_map(int kind, int n0, int& drow, float& scale) {
    scale = 1.0f;
    switch (kind) {
    case 0: drow = n0; return true;
    case 1: if (n0 < 768) { drow = n0; scale = QSCALE; return true; } if (n0 < 1536) { drow = n0; return true; } if (n0 >= 2304) { drow = n0 - 768; scale = QSCALE; return true; } return false;
    case 2: if (n0 >= 1536 && n0 < 2304) { drow = n0 - 1536; return true; } return false;
    case 3: drow = (n0 >> 7) * 256 + (n0 & 127); return true;
    case 4: drow = (n0 >> 7) * 256 + 128 + (n0 & 127); return true;
    case 5: if (n0 < 768) { drow = n0; return true; } if (n0 < 1536) return false; if (n0 < 2304) { drow = n0 - 768; return true; }
            if (n0 < 2336) { drow = n0 - 512; return true; } drow = n0 - 800; scale = QSCALE; return true;
    case 6: if (n0 >= 768 && n0 < 1536) { drow = n0 - 768; return true; } return false;
    default: drow = n0; return true;
    }
}
struct CvtRegs { f32x4 v[8]; const float* gain; bf16* WT; int K, k0, drow, valid; float scale; };
__device__ __forceinline__ void cvt_load(CvtRegs& R, const CvtJob& J, int item, int lane) {
    const int nblk = J.N / 32, kb = item / nblk, nb = item % nblk, n0 = nb * 32;
    R.k0 = kb * 64; R.gain = J.gain; R.WT = J.WT; R.K = J.K;
    R.valid = cvt_map(J.kind, n0, R.drow, R.scale) ? 1 : 0;
    if (R.valid) { const float* p = J.W + (size_t)(R.k0 + 2 * (lane >> 3)) * J.N + n0 + 4 * (lane & 7);
#pragma unroll
        for (int j = 0; j < 8; ++j) R.v[j] = *(const f32x4*)(p + (size_t)(16 * (j >> 1) + (j & 1)) * J.N); }
}
__device__ __forceinline__ void cvt_finish(const CvtRegs& R, LAS unsigned* T, int lane) {
    if (!R.valid) return;
    const int nq = lane & 7, kr = lane >> 3;
#pragma unroll
    for (int p = 0; p < 4; ++p) { const int k = R.k0 + 16 * p + 2 * kr; float g0 = R.scale, g1 = R.scale; if (R.gain) { g0 *= R.gain[k]; g1 *= R.gain[k + 1]; }
        const f32x4 a = R.v[2 * p], b = R.v[2 * p + 1]; LAS unsigned* t = T + (4 * nq) * 33 + 8 * p + kr;
        t[0] = pk2(a.x * g0, b.x * g1); t[33] = pk2(a.y * g0, b.y * g1); t[66] = pk2(a.z * g0, b.z * g1); t[99] = pk2(a.w * g0, b.w * g1); }
    LDS_WAIT(); asm volatile("" ::: "memory");
#pragma unroll
    for (int r = 0; r < 4; ++r) { const int n = (lane >> 3) + 8 * r, c = lane & 7; const LAS unsigned* sp = T + n * 33 + 4 * c;
        v4u o; o.x = sp[0]; o.y = sp[1]; o.z = sp[2]; o.w = sp[3];
        *(GAS v4u*)(R.WT + (size_t)(R.drow + n) * R.K + R.k0 + 8 * c) = o; }
    LDS_WAIT(); asm volatile("" ::: "memory");
}
__device__ __forceinline__ void rows_to_bf16(const float* X, bf16* Ob, float* rstd, int first, int nrows, int stride, int lane) {
    for (int m = first; m < nrows; m += 2 * stride) {
        const int m2 = m + stride; const bool h2 = m2 < nrows;
        const GAS f32x4* xa = (const GAS f32x4*)(X + (size_t)m * DM) + lane; const GAS f32x4* xb = (const GAS f32x4*)(X + (size_t)(h2 ? m2 : m) * DM) + lane;
        f32x4 va[4], vb[4];
#pragma unroll
        for (int j = 0; j < 4; ++j) va[j] = xa[64 * j];
#pragma unroll
        for (int j = 0; j < 4; ++j) vb[j] = xb[64 * j];
        float sa = 0.f, sb = 0.f;
#pragma unroll
        for (int j = 0; j < 4; ++j) { sa += (va[j].x * va[j].x + va[j].y * va[j].y) + (va[j].z * va[j].z + va[j].w * va[j].w); sb += (vb[j].x * vb[j].x + vb[j].y * vb[j].y) + (vb[j].z * vb[j].z + vb[j].w * vb[j].w); }
        sa = wave_sum(sa); sb = wave_sum(sb);
        GAS unsigned long long* oa = (GAS unsigned long long*)(Ob + (size_t)m * DM) + lane;
#pragma unroll
        for (int j = 0; j < 4; ++j) oa[64 * j] = (unsigned long long)pk2(va[j].x, va[j].y) | ((unsigned long long)pk2(va[j].z, va[j].w) << 32);
        if (lane == 0) rstd[m] = __builtin_amdgcn_rsqf(sa * (1.0f / DM) + EPS);
        if (h2) { GAS unsigned long long* ob = (GAS unsigned long long*)(Ob + (size_t)m2 * DM) + lane;
#pragma unroll
            for (int j = 0; j < 4; ++j) ob[64 * j] = (unsigned long long)pk2(vb[j].x, vb[j].y) | ((unsigned long long)pk2(vb[j].z, vb[j].w) << 32);
            if (lane == 0) rstd[m2] = __builtin_amdgcn_rsqf(sb * (1.0f / DM) + EPS); }
    }
}

struct Unit { int pm, pn; };
struct Sched {
    int nM, nN, nwg, G, c, K, ld, off0, off1, per;
    const char* A; const char* B; const int* bexp; size_t estride;
    __device__ void init(const void* A_, const void* B_, int K_, int nM_, int nN_, int G_, int c_, const int* bexp_ = nullptr, size_t estride_ = 0) {
        A = (const char*)A_; B = (const char*)B_; K = K_; ld = K_; nM = nM_; nN = nN_; nwg = nM * nN; G = G_; c = c_; bexp = bexp_; estride = estride_; off0 = 0; off1 = 0x7fffffff; per = G_ / 8; }
    __device__ void range(int off0_, int off1_, int per_) { off0 = off0_; off1 = off1_; per = per_; }
    __device__ bool next(int i, Unit& u) const {
        const int q = nwg / 8, r = nwg % 8, xcd = c % 8, slot = c / 8, lt = (int)((unsigned)(xcd - r) >> 31), qx = q + lt;
        if (slot >= per) return false;
        const int off = off0 + i * per + slot, lim = off1 < qx ? off1 : qx;
        if (off >= lim) return false;
        const int wgid = xcd * q + (lt ? xcd : r) + off;
        const int nig = 8 * nN, gid = wgid / nig, fm = gid * 8, gsz = (nM - fm) < 8 ? (nM - fm) : 8;
        u.pm = fm + ((wgid % nig) % gsz); u.pn = (wgid % nig) / gsz; return true;
    }
    __device__ const char* a_base(const Unit& u) const { return A + (size_t)u.pm * 512 * ld; }
    __device__ const char* b_base(const Unit& u) const { return B + (bexp ? (size_t)bexp[u.pm] * estride : (size_t)0) + (size_t)u.pn * 512 * ld; }
};

struct NoAux {};
__device__ __forceinline__ float rstd_from(const float* rss16) {
    const f32x4* p = (const f32x4*)rss16; f32x4 a = p[0], b = p[1], c = p[2], d = p[3];
    const float s = ((a.x + a.y) + (a.z + a.w)) + ((b.x + b.y) + (b.z + b.w)) + ((c.x + c.y) + (c.z + c.w)) + ((d.x + d.y) + (d.z + d.w));
    return __builtin_amdgcn_rsqf(s * (1.0f / DM) + EPS);
}
struct RowCtx { float rs[2][4]; };
struct EpiRowScale {
    static constexpr bool NEED_SS = false; static constexpr int SC_MODE = 1; typedef RowCtx Ctx; typedef NoAux Aux;
    bf16* O; int ldc; const float* sc_src;
    __device__ __forceinline__ void begin(Ctx& c, const LAS float* sc, const LAS int*, int lr0, int, int, int) const {
#pragma unroll
        for (int ai = 0; ai < 2; ++ai)
#pragma unroll
            for (int m = 0; m < 4; ++m) c.rs[ai][m] = sc[ai * 128 + lr0 + m * 16];
    }
    __device__ __forceinline__ void load_aux(Aux&, const Ctx&, int, int, int, int, int) const {}
    __device__ __forceinline__ float apply(const Ctx& c, const Aux&, int ai, int m, int row, int pn, int c128, const float (&a)[8], const float (&b)[8]) const {
        const float s = c.rs[ai][m];
        bf16* p = O + (size_t)row * ldc + pn * 256 + c128;
        v4u w; w.x = pk2(a[0] * s, a[1] * s); w.y = pk2(a[2] * s, a[3] * s); w.z = pk2(a[4] * s, a[5] * s); w.w = pk2(a[6] * s, a[7] * s); *(v4u*)p = w;
        w.x = pk2(b[0] * s, b[1] * s); w.y = pk2(b[2] * s, b[3] * s); w.z = pk2(b[4] * s, b[5] * s); w.w = pk2(b[6] * s, b[7] * s); *(v4u*)(p + 128) = w;
        return 0.f;
    }
    __device__ __forceinline__ void row_done(int, int, int, float) const {}
};
struct ColCtx { float sa[8], sb[8]; };
struct EpiColScale {
    static constexpr bool NEED_SS = false; static constexpr int SC_MODE = 2; typedef ColCtx Ctx; typedef NoAux Aux;
    bf16* O; int ldc; const float* sc_src;
    __device__ __forceinline__ void begin(Ctx& c, const LAS float* sc, const LAS int*, int, int, int, int c128) const {
#pragma unroll
        for (int j = 0; j < 8; ++j) { c.sa[j] = sc[c128 + j]; c.sb[j] = sc[128 + c128 + j]; }
    }
    __device__ __forceinline__ void load_aux(Aux&, const Ctx&, int, int, int, int, int) const {}
    __device__ __forceinline__ float apply(const Ctx& c, const Aux&, int, int, int row, int pn, int c128, const float (&a)[8], const float (&b)[8]) const {
        bf16* p = O + (size_t)row * ldc + pn * 256 + c128;
        v4u w; w.x = pk2(a[0] * c.sa[0], a[1] * c.sa[1]); w.y = pk2(a[2] * c.sa[2], a[3] * c.sa[3]); w.z = pk2(a[4] * c.sa[4], a[5] * c.sa[5]); w.w = pk2(a[6] * c.sa[6], a[7] * c.sa[7]); *(v4u*)p = w;
        w.x = pk2(b[0] * c.sb[0], b[1] * c.sb[1]); w.y = pk2(b[2] * c.sb[2], b[3] * c.sb[3]); w.z = pk2(b[4] * c.sb[4], b[5] * c.sb[5]); w.w = pk2(b[6] * c.sb[6], b[7] * c.sb[7]); *(v4u*)(p + 128) = w;
        return 0.f;
    }
    __device__ __forceinline__ void row_done(int, int, int, float) const {}
};
struct Aux4 { f32x4 v[4]; };
struct NoCtx {};
struct AuxR { f32x4 v[4]; };
struct AuxB { v4u a, b; };
__device__ __forceinline__ void unpack16(const AuxB& x, f32x4 (&v)[4]) {
    v[0] = (f32x4){bflo(x.a.x), bfhi(x.a.x), bflo(x.a.y), bfhi(x.a.y)}; v[1] = (f32x4){bflo(x.a.z), bfhi(x.a.z), bflo(x.a.w), bfhi(x.a.w)};
    v[2] = (f32x4){bflo(x.b.x), bfhi(x.b.x), bflo(x.b.y), bfhi(x.b.y)}; v[3] = (f32x4){bflo(x.b.z), bfhi(x.b.z), bflo(x.b.w), bfhi(x.b.w)}; }
template <bool F32> struct AuxSel { typedef AuxR T; };
template <> struct AuxSel<false> { typedef AuxB T; };
template <bool RF32> struct EpiResid {
    static constexpr bool NEED_SS = true; static constexpr int SC_MODE = 0; typedef NoCtx Ctx; typedef typename AuxSel<RF32>::T Aux;
    const float* R; bf16* HB; float* rss; bf16* HB2;
    __device__ __forceinline__ void begin(Ctx&, const LAS float*, const LAS int*, int, int, int, int) const {}
    __device__ __forceinline__ void load_aux(Aux& x, const Ctx&, int, int, int row, int pn, int c128) const {
        const size_t off = (size_t)row * DM + pn * 256 + c128;
        if constexpr (RF32) { const float* p = R + off; x.v[0] = *(const f32x4*)p; x.v[1] = *(const f32x4*)(p + 4); x.v[2] = *(const f32x4*)(p + 128); x.v[3] = *(const f32x4*)(p + 132); }
        else { x.a = *(const v4u*)(HB + off); x.b = *(const v4u*)(HB + off + 128); }
    }
    __device__ __forceinline__ float apply(const Ctx&, const Aux& xr, int, int, int row, int pn, int c128, const float (&a)[8], const float (&b)[8]) const {
        const size_t off = (size_t)row * DM + pn * 256 + c128;
        struct { f32x4 v[4]; } x; if constexpr (RF32) { x.v[0] = xr.v[0]; x.v[1] = xr.v[1]; x.v[2] = xr.v[2]; x.v[3] = xr.v[3]; } else unpack16(xr, x.v);
        const f32x4 h0 = {x.v[0].x + a[0], x.v[0].y + a[1], x.v[0].z + a[2], x.v[0].w + a[3]}, h1 = {x.v[1].x + a[4], x.v[1].y + a[5], x.v[1].z + a[6], x.v[1].w + a[7]};
        const f32x4 h2 = {x.v[2].x + b[0], x.v[2].y + b[1], x.v[2].z + b[2], x.v[2].w + b[3]}, h3 = {x.v[3].x + b[4], x.v[3].y + b[5], x.v[3].z + b[6], x.v[3].w + b[7]};
        v4u w; w.x = pk2(h0.x, h0.y); w.y = pk2(h0.z, h0.w); w.z = pk2(h1.x, h1.y); w.w = pk2(h1.z, h1.w); *(v4u*)(HB + off) = w; if (HB2) *(v4u*)(HB2 + off) = w;
        w.x = pk2(h2.x, h2.y); w.y = pk2(h2.z, h2.w); w.z = pk2(h3.x, h3.y); w.w = pk2(h3.z, h3.w); *(v4u*)(HB + off + 128) = w; if (HB2) *(v4u*)(HB2 + off + 128) = w;
        return ((h0.x * h0.x + h0.y * h0.y) + (h0.z * h0.z + h0.w * h0.w) + (h1.x * h1.x + h1.y * h1.y) + (h1.z * h1.z + h1.w * h1.w))
             + ((h2.x * h2.x + h2.y * h2.y) + (h2.z * h2.z + h2.w * h2.w) + (h3.x * h3.x + h3.y * h3.y) + (h3.z * h3.z + h3.w * h3.w));
    }
    __device__ __forceinline__ void row_done(int row, int pn, int wc, float ss) const { rss[(size_t)row * 16 + pn * 4 + wc] = ss; }
};
__device__ __forceinline__ float silu_mul(float g, float u) { return g * __builtin_amdgcn_rcpf(1.0f + __builtin_amdgcn_exp2f(g * -1.4426950408889634f)) * u; }
template <bool MOE> struct EpiSwiGLU {
    static constexpr bool NEED_SS = false; static constexpr int SC_MODE = MOE ? 3 : 1; typedef RowCtx Ctx; typedef NoAux Aux;
    bf16* Hm; int ldh; const float* sc_src; bf16* Hmt;
    __device__ __forceinline__ void begin(Ctx& c, const LAS float* sc, const LAS int* tl, int lr0, int, int, int) const {
#pragma unroll
        for (int ai = 0; ai < 2; ++ai)
#pragma unroll
            for (int m = 0; m < 4; ++m) { const int i = ai * 128 + lr0 + m * 16; float r = sc[i]; if (MOE) { if (tl[i] < 0) r = 0.f; } c.rs[ai][m] = r; }
    }
    __device__ __forceinline__ void load_aux(Aux&, const Ctx&, int, int, int, int, int) const {}
    __device__ __forceinline__ float apply(const Ctx& c, const Aux&, int ai, int m, int row, int pn, int c128, const float (&a)[8], const float (&b)[8]) const {
        const float s = c.rs[ai][m]; float o[8];
#pragma unroll
        for (int j = 0; j < 8; ++j) o[j] = silu_mul(a[j] * s, b[j] * s);
        v4u w; w.x = pk2(o[0], o[1]); w.y = pk2(o[2], o[3]); w.z = pk2(o[4], o[5]); w.w = pk2(o[6], o[7]);
        bf16* rp = (MOE && row >= NT) ? Hmt + (size_t)(row - NT) * ldh : Hm + (size_t)row * ldh;
        *(v4u*)(rp + pn * 128 + c128) = w;
        return 0.f;
    }
    __device__ __forceinline__ void row_done(int, int, int, float) const {}
};
struct MoeCtx { int t[2][4]; float w[2][4]; };
struct EpiMoeDown {
    static constexpr bool NEED_SS = false; static constexpr int SC_MODE = 4; typedef MoeCtx Ctx; typedef AuxB Aux;
    bf16* HB; const int* tok; const float* w;
    __device__ __forceinline__ void begin(Ctx& c, const LAS float* sc, const LAS int*, int lr0, int, int, int) const {
#pragma unroll
        for (int ai = 0; ai < 2; ++ai)
#pragma unroll
            for (int m = 0; m < 4; ++m) { const int i = ai * 128 + lr0 + m * 16; c.t[ai][m] = ((const LAS int*)sc)[i]; c.w[ai][m] = sc[256 + i]; }
    }
    __device__ __forceinline__ void load_aux(Aux& x, const Ctx& c, int ai, int m, int, int pn, int c128) const {
        const int t = c.t[ai][m]; const bf16* p = HB + (size_t)(t < 0 ? 0 : t) * DM + pn * 256 + c128;
        x.a = *(const v4u*)p; x.b = *(const v4u*)(p + 128);
    }
    __device__ __forceinline__ float apply(const Ctx& c, const Aux& xr, int ai, int m, int, int pn, int c128, const float (&a)[8], const float (&b)[8]) const {
        const int t = c.t[ai][m]; if (t < 0) return 0.f;
        struct { f32x4 v[4]; } x; unpack16(xr, x.v);
        const float s = c.w[ai][m]; bf16* p = HB + (size_t)t * DM + pn * 256 + c128;
        v4u w; w.x = pk2(x.v[0].x + s * a[0], x.v[0].y + s * a[1]); w.y = pk2(x.v[0].z + s * a[2], x.v[0].w + s * a[3]); w.z = pk2(x.v[1].x + s * a[4], x.v[1].y + s * a[5]); w.w = pk2(x.v[1].z + s * a[6], x.v[1].w + s * a[7]); *(v4u*)p = w;
        w.x = pk2(x.v[2].x + s * b[0], x.v[2].y + s * b[1]); w.y = pk2(x.v[2].z + s * b[2], x.v[2].w + s * b[3]); w.z = pk2(x.v[3].x + s * b[4], x.v[3].y + s * b[5]); w.w = pk2(x.v[3].z + s * b[6], x.v[3].w + s * b[7]); *(v4u*)(p + 128) = w;
        return 0.f;
    }
    __device__ __forceinline__ void row_done(int, int, int, float) const {}
};

namespace pg8 {
constexpr int HTB = 16384, TOK_OFF = 132096, SC_OFF = 134144;
__device__ __forceinline__ int lds_byte(int r, int c) { const int st = (r >> 4) * 2 + (c >> 5), rr = r & 15, cc = c & 31, ob = rr * 64 + cc * 2; return st * 1024 + (ob ^ (((ob >> 9) & 1) << 5)); }
__device__ __forceinline__ void stage_rc(int b, int& R, int& C) { const int st = b / 1024, sb = b % 1024, swz = sb ^ (((sb >> 9) & 1) << 5); R = (st >> 1) * 16 + swz / 64; C = (st & 1) * 32 + (swz % 64) / 2; }
__device__ __forceinline__ int perm32(int rho) { const int n = rho >> 4, i = rho & 15; return 8 * (i >> 2) + 4 * n + (i & 3); }

template <class Epi>
__device__ __forceinline__ void run_epi(const Epi& E, const f32x4 (&acc)[2][2][4][2], const Unit& u, int wr, int wc, int fr, int fq, const LAS float* sc, const LAS int* tlp) {
    int row0 = u.pm * 256 + wr * 64 + fr, c128 = 32 * wc + 8 * fq;
    asm volatile("" : "+v"(row0), "+v"(c128));
    typename Epi::Ctx ctx; E.begin(ctx, sc, tlp, wr * 64 + fr, row0, u.pn, c128);
#pragma unroll
    for (int ai = 0; ai < 2; ++ai) {
        typename Epi::Aux aux[4];
#pragma unroll
        for (int m = 0; m < 4; ++m) E.load_aux(aux[m], ctx, ai, m, row0 + ai * 128 + m * 16, u.pn, c128);
#pragma unroll
        for (int m = 0; m < 4; ++m) {
            const int row = row0 + ai * 128 + m * 16;
            float a[8], b[8];
#pragma unroll
            for (int j = 0; j < 8; ++j) { a[j] = acc[ai][0][m][j >> 2][j & 3]; b[j] = acc[ai][1][m][j >> 2][j & 3]; }
            float ss = E.apply(ctx, aux[m], ai, m, row, u.pn, c128, a, b);
            if (Epi::NEED_SS) { ss += __shfl_xor(ss, 16); ss += __shfl_xor(ss, 32); if (fq == 0) E.row_done(row, u.pn, wc, ss); }
        }
    }
}

template <class Epi, bool GATHER>
__device__ __forceinline__ void gemm_fast(LAS unsigned char* lds, const Sched& S, const Epi& E, const int* gtok) {
    int tid = threadIdx.x; asm volatile("" : "+v"(tid));
    const int wid = __builtin_amdgcn_readfirstlane(tid >> 6), lane = tid & 63, wr = wid >> 2, wc = wid & 3, fr = lane & 15, fq = lane >> 4;
    const int K = S.ld, nt = S.K / 64;
    unsigned voffB[2], vA0[2], vA1[2], nA0[2], nA1[2]; int RA[2], CA2[2];
#pragma unroll
    for (int i = 0; i < 2; ++i) { int R, C; stage_rc(tid * 16 + i * 8192, R, C); const int Rb = (R & ~31) + perm32(R & 31);
        voffB[i] = (unsigned)(Rb * K + C) * 2u; RA[i] = R; CA2[i] = C * 2; vA0[i] = (unsigned)(R * K + C) * 2u; vA1[i] = vA0[i] + (unsigned)(128 * K * 2); nA0[i] = vA0[i]; nA1[i] = vA1[i]; }
    const size_t kstep = 128;
    const size_t hstep = (size_t)128 * K * 2;
    const unsigned ldsw = (unsigned)wid * 1024u;
    const int aoff = lds_byte(wr * 64 + fr, fq * 8), boff = lds_byte(wc * 32 + fr, fq * 8);
    LAS int* tl = (LAS int*)(lds + TOK_OFF);
#define PG8_SA(b, h) (((b) * 2 + (h)) * HTB)
#define PG8_SB(b, h) ((4 + (b) * 2 + (h)) * HTB)
#define PG8_STAGE(bufoff, gbase, voff) do { _Pragma("unroll") for (int _i = 0; _i < 2; ++_i) \
        __builtin_amdgcn_global_load_lds((const unsigned*)((const char*)(gbase) + (voff)[_i]), (LAS unsigned*)(lds + (bufoff) + ldsw + _i * 8192), 16, 0, 0); } while (0)
#define PG8_LDA(dst, b, h) do { _Pragma("unroll") for (int m = 0; m < 4; ++m) _Pragma("unroll") for (int k = 0; k < 2; ++k) dst[m][k] = *(const LAS bf16x8*)(lds + PG8_SA(b, h) + aoff + m * 2048 + k * 1024); } while (0)
#define PG8_LDB(dst, b, h) do { _Pragma("unroll") for (int n = 0; n < 2; ++n) _Pragma("unroll") for (int k = 0; k < 2; ++k) dst[n][k] = *(const LAS bf16x8*)(lds + PG8_SB(b, h) + boff + n * 2048 + k * 1024); } while (0)
#define PG8_MMA(ai, bj, At, Bt) do { __builtin_amdgcn_s_setprio(1); _Pragma("unroll") for (int m = 0; m < 4; ++m) _Pragma("unroll") for (int n = 0; n < 2; ++n) _Pragma("unroll") for (int k = 0; k < 2; ++k) \
        acc[ai][bj][m][n] = __builtin_amdgcn_mfma_f32_16x16x32_bf16(Bt[n][k], At[m][k], acc[ai][bj][m][n], 0, 0, 0); __builtin_amdgcn_s_setprio(0); } while (0)
#define PG8_WAIT_V(n) asm volatile("s_waitcnt vmcnt(" #n ")" ::: "memory")
#define PG8_WAIT_L(n) asm volatile("s_waitcnt lgkmcnt(" #n ")" ::: "memory")
#define PG8_BAR __builtin_amdgcn_s_barrier()
#define PG8_SCHED __builtin_amdgcn_sched_barrier(0)
#define PG8_IDS_DMA(pm_, par_) do { if (wid < 4) __builtin_amdgcn_global_load_lds((const unsigned*)(gtok + (pm_) * 256 + wid * 64 + lane), (LAS unsigned*)(lds + TOK_OFF + (par_) * 1024 + wid * 256), 4, 0, 0); } while (0)
#define PG8_IDS_READ(d0, d1, par_) do { _Pragma("unroll") for (int _i = 0; _i < 2; ++_i) { int t0 = tl[(par_) * 256 + RA[_i]], t1 = tl[(par_) * 256 + 128 + RA[_i]]; t0 = t0 < 0 ? 0 : t0; t1 = t1 < 0 ? 0 : t1; \
        d0[_i] = (unsigned)t0 * (unsigned)(K * 2) + (unsigned)CA2[_i]; d1[_i] = (unsigned)t1 * (unsigned)(K * 2) + (unsigned)CA2[_i]; } } while (0)
    Unit cur, nxt; int ui = 0, par = 0;
    if (!S.next(0, cur)) return;
    f32x4 acc[2][2][4][2];
#pragma unroll
    for (int a = 0; a < 2; ++a)
#pragma unroll
        for (int b = 0; b < 2; ++b)
#pragma unroll
            for (int m = 0; m < 4; ++m)
#pragma unroll
                for (int n = 0; n < 2; ++n) acc[a][b][m][n] = (f32x4){0.f, 0.f, 0.f, 0.f};
    bf16x8 At[4][2], B0[2][2], B1[2][2];
    const char* cA = GATHER ? S.A : S.a_base(cur); const char* cB = S.b_base(cur);
    if constexpr (GATHER) { PG8_IDS_DMA(cur.pm, 0); PG8_WAIT_V(0); __syncthreads(); PG8_IDS_READ(vA0, vA1, 0); }
    PG8_STAGE(PG8_SB(0, 0), cB, voffB); PG8_STAGE(PG8_SB(0, 1), cB + hstep, voffB); PG8_STAGE(PG8_SA(0, 0), cA, vA0); PG8_STAGE(PG8_SA(0, 1), cA, vA1);
    if (wr == 1) PG8_BAR;
    PG8_WAIT_V(2); PG8_BAR;
    PG8_STAGE(PG8_SB(1, 0), cB + kstep, voffB); PG8_STAGE(PG8_SA(1, 0), cA + kstep, vA0); PG8_STAGE(PG8_SB(1, 1), cB + hstep + kstep, voffB);
    PG8_WAIT_V(6); PG8_BAR;
    for (;;) {
        const bool has_next = S.next(ui + 1, nxt);
        const char* nA = has_next ? (GATHER ? S.A : S.a_base(nxt)) : cA; const char* nB = has_next ? S.b_base(nxt) : cB;
        for (int t = 0; t < nt; t += 2) {
            const bool last = (t == nt - 2);
            if constexpr (GATHER) {
                if (t == nt - 4 && has_next) PG8_IDS_DMA(nxt.pm, par ^ 1);
                if (last) { if (has_next) PG8_IDS_READ(nA0, nA1, par ^ 1); else { nA0[0] = vA0[0]; nA0[1] = vA0[1]; nA1[0] = vA1[0]; nA1[1] = vA1[1]; } }
            }
            if constexpr (Epi::SC_MODE != 0) {
                if (last && wid < 4) { const int i_ = wid * 64 + lane; LAS unsigned* d_ = (LAS unsigned*)(lds + SC_OFF + wid * 256);
                    if constexpr (Epi::SC_MODE == 1) __builtin_amdgcn_global_load_lds((const unsigned*)(E.sc_src + cur.pm * 256 + i_), d_, 4, 0, 0);
                    if constexpr (Epi::SC_MODE == 2) __builtin_amdgcn_global_load_lds((const unsigned*)(E.sc_src + cur.pn * 256 + i_), d_, 4, 0, 0);
                    if constexpr (Epi::SC_MODE == 3) { int t_ = tl[par * 256 + i_]; t_ = t_ < 0 ? 0 : t_; __builtin_amdgcn_global_load_lds((const unsigned*)(E.sc_src + t_), d_, 4, 0, 0); }
                    if constexpr (Epi::SC_MODE == 4) { __builtin_amdgcn_global_load_lds((const unsigned*)(E.tok + cur.pm * 256 + i_), d_, 4, 0, 0);
                        __builtin_amdgcn_global_load_lds((const unsigned*)(E.w + cur.pm * 256 + i_), (LAS unsigned*)(lds + SC_OFF + 1024 + wid * 256), 4, 0, 0); } }
            }
            const char* a1 = cA + (size_t)(t + 1) * kstep;
            const char* a2 = last ? nA : cA + (size_t)(t + 2) * kstep; const char* b2 = last ? nB : cB + (size_t)(t + 2) * kstep;
            const char* a3 = a2 + kstep; const char* b3 = b2 + kstep;
            unsigned w0[2], w1[2];
            if (GATHER && last) { w0[0] = nA0[0]; w0[1] = nA0[1]; w1[0] = nA1[0]; w1[1] = nA1[1]; } else { w0[0] = vA0[0]; w0[1] = vA0[1]; w1[0] = vA1[0]; w1[1] = vA1[1]; }
            PG8_LDB(B0, 0, 0); PG8_LDB(B1, 0, 1); PG8_SCHED; PG8_LDA(At, 0, 0); PG8_STAGE(PG8_SA(1, 1), a1, vA1);
            PG8_WAIT_V(8); PG8_WAIT_L(0); PG8_BAR; PG8_MMA(0, 0, At, B0); PG8_MMA(0, 1, At, B1); PG8_BAR; PG8_SCHED;
            PG8_LDA(At, 0, 1); PG8_STAGE(PG8_SB(0, 0), b2, voffB); PG8_STAGE(PG8_SB(0, 1), b2 + hstep, voffB); PG8_STAGE(PG8_SA(0, 0), a2, w0);
            PG8_WAIT_V(8); PG8_WAIT_L(0); PG8_BAR; PG8_MMA(1, 0, At, B0); PG8_MMA(1, 1, At, B1); PG8_BAR; PG8_SCHED;
            PG8_LDB(B0, 1, 0); PG8_LDB(B1, 1, 1); PG8_SCHED; PG8_LDA(At, 1, 0); PG8_STAGE(PG8_SA(0, 1), a2, w1);
            PG8_WAIT_V(8); PG8_WAIT_L(0); PG8_BAR; PG8_MMA(0, 0, At, B0); PG8_MMA(0, 1, At, B1); PG8_BAR; PG8_SCHED;
            PG8_LDA(At, 1, 1); PG8_STAGE(PG8_SB(1, 0), b3, voffB); PG8_STAGE(PG8_SB(1, 1), b3 + hstep, voffB); PG8_STAGE(PG8_SA(1, 0), a3, w0);
            PG8_WAIT_V(8); PG8_WAIT_L(0); PG8_BAR; PG8_MMA(1, 0, At, B0); PG8_MMA(1, 1, At, B1); PG8_BAR; PG8_SCHED;
        }
        if (wr == 0) PG8_BAR;
        run_epi(E, acc, cur, wr, wc, fr, fq, (const LAS float*)(lds + SC_OFF), (const LAS int*)(lds + TOK_OFF + par * 1024));
        if (!has_next) break;
#pragma unroll
        for (int a = 0; a < 2; ++a)
#pragma unroll
            for (int b = 0; b < 2; ++b)
#pragma unroll
                for (int m = 0; m < 4; ++m)
#pragma unroll
                    for (int n = 0; n < 2; ++n) acc[a][b][m][n] = (f32x4){0.f, 0.f, 0.f, 0.f};
        cur = nxt; cA = nA; cB = nB; ++ui;
        if constexpr (GATHER) { vA0[0] = nA0[0]; vA0[1] = nA0[1]; vA1[0] = nA1[0]; vA1[1] = nA1[1]; par ^= 1; }
        if (wr == 1) PG8_BAR;
    }
    PG8_WAIT_V(0);
    PG8_BAR;
#undef PG8_SA
#undef PG8_SB
#undef PG8_STAGE
#undef PG8_LDA
#undef PG8_LDB
#undef PG8_MMA
#undef PG8_WAIT_V
#undef PG8_WAIT_L
#undef PG8_BAR
#undef PG8_SCHED
#undef PG8_IDS_DMA
#undef PG8_IDS_READ
}
}

template <class Epi, bool GATHER>
__device__ __forceinline__ void gemm_run(LAS unsigned char* lds, const Sched& S, const Epi& E, const int* gtok) { pg8::gemm_fast<Epi, GATHER>(lds, S, E, gtok); }

typedef short s16x4 __attribute__((ext_vector_type(4)));
template <bool NA, bool KLDS = false, bool VLDS = false, int KRS = 64>
__device__ __forceinline__ void attn16(int lane, const bf16* Q, int ldq, const bf16* Kb, int ldk, const bf16* Vt, int ldv, int ktok0, int trs, bf16* O, int ldo,
                                       const LAS float* rpb_h, int r, int r0, int jb, int band0, const LAS unsigned char* Kl = nullptr, int arow0 = 0, const LAS unsigned char* Vl = nullptr) {
    const int qi = lane & 15, g = lane >> 4;
    bf16x8 qf[2];
#pragma unroll
    for (int ks = 0; ks < 2; ++ks) qf[ks] = *(const bf16x8*)(Q + (size_t)qi * ldq + ks * 32 + 8 * g);
    f32x4 s[16];
    const int krow = 8 * (qi >> 2) + (qi & 3);
#pragma unroll
    for (int t = 0; t < 16; ++t) {
        bf16x8 k0, k1;
        if constexpr (KLDS) {
            const int kcol = band0 + krow + 4 * (t & 1), swz = (((kcol >> 3) & 3) << 1) | ((kcol >> 1) & 1);
            const LAS unsigned char* kb = Kl + ((arow0 + (t >> 1)) * KRS + kcol) * 128;
            k0 = *(const LAS bf16x8*)(kb + ((g ^ swz) << 4)); k1 = *(const LAS bf16x8*)(kb + (((4 + g) ^ swz) << 4));
        } else {
            const bf16* kp = Kb + (size_t)(ktok0 + (t >> 1) * trs + krow + 4 * (t & 1)) * ldk + 8 * g;
            k0 = *(const bf16x8*)kp; k1 = *(const bf16x8*)(kp + 32);
        }
        f32x4 z = {0.f, 0.f, 0.f, 0.f};
        z = __builtin_amdgcn_mfma_f32_16x16x32_bf16(k0, qf[0], z, 0, 0, 0);
        z = __builtin_amdgcn_mfma_f32_16x16x32_bf16(k1, qf[1], z, 0, 0, 0);
        s[t] = z;
        if constexpr (KLDS) { if ((t & 3) == 3) __builtin_amdgcn_sched_barrier(0); }
    }
    bf16x8 vfa[VLDS ? 1 : 4][VLDS ? 1 : 8];
    if constexpr (!VLDS) {
#pragma unroll
        for (int mt = 0; mt < 4; ++mt)
#pragma unroll
            for (int kk = 0; kk < 8; ++kk) vfa[mt][kk] = *(const bf16x8*)(Vt + (size_t)(16 * mt + qi) * ldv + ktok0 + kk * trs + 8 * g);
        __builtin_amdgcn_sched_barrier(0);
    }
    float m = -INFINITY;
    if constexpr (NA) {
        const int qc = 16 * jb + qi, cs = min(max(qc - 8, 0), 48);
        const LAS float* bp = rpb_h + (r0 - r + 7) * 31 + (band0 + 8 * g - qc + 15);
        bool ok[2][4];
#pragma unroll
        for (int hh = 0; hh < 2; ++hh)
#pragma unroll
            for (int i = 0; i < 4; ++i) { const int kc = band0 + 8 * g + 4 * hh + i; ok[hh][i] = (kc >= cs) && (kc < cs + 16); }
#pragma unroll
        for (int t = 0; t < 16; ++t)
#pragma unroll
            for (int i = 0; i < 4; ++i) {
                const float bv = bp[(t >> 1) * 31 + 4 * (t & 1) + i];
                const float v = ok[t & 1][i] ? s[t][i] + bv : -INFINITY;
                s[t][i] = v; m = fmaxf(m, v);
            }
    } else {
#pragma unroll
        for (int t = 0; t < 16; ++t)
#pragma unroll
            for (int i = 0; i < 4; ++i) m = fmaxf(m, s[t][i]);
    }
    m = fmaxf(m, __shfl_xor(m, 16)); m = fmaxf(m, __shfl_xor(m, 32));
    float l = 0.f;
    bf16x8 pf[8];
#pragma unroll
    for (int kk = 0; kk < 8; ++kk) {
        float p[8];
#pragma unroll
        for (int i = 0; i < 4; ++i) { p[i] = __builtin_amdgcn_exp2f(s[2 * kk][i] - m); p[4 + i] = __builtin_amdgcn_exp2f(s[2 * kk + 1][i] - m); }
#pragma unroll
        for (int i = 0; i < 8; ++i) l += p[i];
        v4u w; w.x = pk2(p[0], p[1]); w.y = pk2(p[2], p[3]); w.z = pk2(p[4], p[5]); w.w = pk2(p[6], p[7]);
        pf[kk] = __builtin_bit_cast(bf16x8, w);
    }
    l += __shfl_xor(l, 16); l += __shfl_xor(l, 32);
    const float inv = __builtin_amdgcn_rcpf(l);
#pragma unroll
    for (int mt = 0; mt < 4; ++mt) {
        f32x4 acc = {0.f, 0.f, 0.f, 0.f};
#pragma unroll
        for (int kk = 0; kk < 8; ++kk) {
            bf16x8 vf; if constexpr (VLDS) vf = *(const LAS bf16x8*)(Vl + (16 * mt + qi) * 512 + (((4 * kk + g) ^ qi) << 4));
            else vf = vfa[mt][kk];
            acc = __builtin_amdgcn_mfma_f32_16x16x32_bf16(vf, pf[kk], acc, 0, 0, 0);
        }
        v2u w; w.x = pk2(acc[0] * inv, acc[1] * inv); w.y = pk2(acc[2] * inv, acc[3] * inv);
        *(v2u*)(O + (size_t)qi * ldo + 16 * mt + 4 * g) = w;
        if constexpr (VLDS) __builtin_amdgcn_sched_barrier(0);
    }
}
__device__ __forceinline__ void memkv_item(int it, int lane, const bf16* membf, const bf16* wt, const float* mrstd, bf16* memk, bf16* memvt) {
    const int rt = it >> 4, ctile = it & 15, qi = lane & 15, g = lane >> 4, row0 = rt * 16, col0 = ctile * 32;
    const bf16* ap = membf + (size_t)(row0 + qi) * DM + 8 * g; const bf16* bp = wt + (size_t)(col0 + qi) * DM + 8 * g;
    f32x4 acc0 = {0.f, 0.f, 0.f, 0.f}, acc1 = {0.f, 0.f, 0.f, 0.f};
    const bool isk = col0 < 256;
#pragma unroll 8
    for (int ks = 0; ks < 32; ++ks) {
        const bf16x8 a = *(const bf16x8*)(ap + 32 * ks), b0 = *(const bf16x8*)(bp + 32 * ks), b1 = *(const bf16x8*)(bp + 16 * DM + 32 * ks);
        if (isk) { acc0 = __builtin_amdgcn_mfma_f32_16x16x32_bf16(b0, a, acc0, 0, 0, 0); acc1 = __builtin_amdgcn_mfma_f32_16x16x32_bf16(b1, a, acc1, 0, 0, 0); }
        else { acc0 = __builtin_amdgcn_mfma_f32_16x16x32_bf16(a, b0, acc0, 0, 0, 0); acc1 = __builtin_amdgcn_mfma_f32_16x16x32_bf16(a, b1, acc1, 0, 0, 0); }
    }
    if (isk) {
        const float s = mrstd[row0 + qi]; bf16* p = memk + (size_t)(row0 + qi) * 256 + col0 + 4 * g;
        v2u w; w.x = pk2(acc0[0] * s, acc0[1] * s); w.y = pk2(acc0[2] * s, acc0[3] * s); *(v2u*)p = w;
        w.x = pk2(acc1[0] * s, acc1[1] * s); w.y = pk2(acc1[2] * s, acc1[3] * s); *(v2u*)(p + 16) = w;
    } else {
        const f32x4 s = *(const f32x4*)(mrstd + row0 + 4 * g); bf16* p = memvt + (size_t)(col0 - 256 + qi) * MEM_ROWS + row0 + 4 * g;
        v2u w; w.x = pk2(acc0[0] * s[0], acc0[1] * s[1]); w.y = pk2(acc0[2] * s[2], acc0[3] * s[3]); *(v2u*)p = w;
        w.x = pk2(acc1[0] * s[0], acc1[1] * s[1]); w.y = pk2(acc1[2] * s[2], acc1[3] * s[3]); *(v2u*)(p + (size_t)16 * MEM_ROWS) = w;
    }
}
__device__ __forceinline__ void memattn_strip(const Frame& F, int item, const bf16* act, int ld, int qoff, const bf16* memk, const bf16* memvt, bf16* mix) {
    const int tg = item & 15, h = (item >> 4) & 3, b = item >> 6, lane = LANE(), wave = F.wave;
    LAS unsigned char* Kl = F.lds; LAS unsigned char* Vl = F.lds + 32768;
#pragma unroll
    for (int j = 0; j < 4; ++j) {
        const int p = (wave * 4 + j) * 64 + lane, key = p >> 3, kpos = p & 7, kc = key & 31, swz = (((kc >> 3) & 3) << 1) | ((kc >> 1) & 1);
        __builtin_amdgcn_global_load_lds((const unsigned*)(memk + (size_t)(b * 256 + key) * 256 + h * 64 + ((kpos ^ swz) << 3)), (LAS unsigned*)(Kl + (wave * 4 + j) * 1024), 16, 0, 0);
        const int d = p >> 5, vpos = p & 31;
        __builtin_amdgcn_global_load_lds((const unsigned*)(memvt + (size_t)(h * 64 + d) * MEM_ROWS + b * 256 + ((vpos ^ (d & 15)) << 3)), (LAS unsigned*)(Vl + (wave * 4 + j) * 1024), 16, 0, 0);
    }
    asm volatile("s_waitcnt vmcnt(0)\n\ts_barrier" ::: "memory");
#pragma unroll 1
    for (int u = 0; u < 2; ++u) {
        const int tok0 = b * SEQ + tg * 256 + (wave * 2 + u) * 16;
        attn16<false, true, true, 32>(lane, act + (size_t)tok0 * ld + qoff + h * 64, ld, nullptr, 0, nullptr, 0, 0, 32, mix + (size_t)tok0 * DM + 768 + h * 64, DM, nullptr, 0, 0, 0, 0, Kl, 0, Vl);
    }
    asm volatile("s_waitcnt lgkmcnt(0)\n\ts_barrier" ::: "memory");
}
__device__ __forceinline__ void memattn_item(int it, int lane, const bf16* act, int ld, int qoff, const bf16* memk, const bf16* memvt, bf16* mix) {
    const int tb = it >> 2, h = it & 3, tok0 = tb * 16, b = tok0 >> 12;
    attn16<false>(lane, act + (size_t)tok0 * ld + qoff + h * 64, ld, memk + h * 64, 256, memvt + (size_t)(h * 64) * MEM_ROWS, MEM_ROWS, b * 256, 32,
                  mix + (size_t)tok0 * DM + 768 + h * 64, DM, nullptr, 0, 0, 0, 0);
}
constexpr int NA_RPB_OFF = 122880;
__device__ __forceinline__ void na_strip(const Frame& F, int item, const bf16* act0, const bf16* v0t, bf16* mix) {
    const int s8 = item & 7, h = (item >> 3) % 12, b = (item >> 3) / 12, lane = LANE(), wave = F.wave;
    const int R0 = 8 * s8, rowbase = min(max(R0 - 4, 0), 56), rowend = min(max(R0 + 7 - 4, 0), 56) + 8, nrows = rowend - rowbase;
    LAS unsigned char* Kl = F.lds;
    {
        const int col = wave * 8 + (lane >> 3), pos = lane & 7, swz = (((col >> 3) & 3) << 1) | ((col >> 1) & 1);
        const bf16* src = act0 + (size_t)(b * SEQ + rowbase * 64 + col) * A0_LD + 768 + h * 64 + ((pos ^ swz) << 3);
        for (int j = 0; j < nrows; ++j)
            __builtin_amdgcn_global_load_lds((const unsigned*)(src + (size_t)j * 64 * A0_LD), (LAS unsigned*)(Kl + j * 8192 + wave * 1024), 16, 0, 0);
    }
    asm volatile("s_waitcnt vmcnt(0)\n\ts_barrier" ::: "memory");
    const int r = R0 + wave, r0 = min(max(r - 4, 0), 56);
    const LAS float* rpb = (const LAS float*)(F.lds + NA_RPB_OFF) + h * 465;
#pragma unroll 1
    for (int jb = 0; jb < 4; ++jb) {
        const int band0 = min(max(jb * 16 - 8, 0), 32), tok0 = b * SEQ + r * 64 + jb * 16;
        attn16<true, true>(lane, act0 + (size_t)tok0 * A0_LD + h * 64, A0_LD, nullptr, 0, v0t + (size_t)(h * 64) * NT, NT, b * SEQ + r0 * 64 + band0, 64,
                           mix + (size_t)tok0 * DM + h * 64, DM, rpb, r, r0, jb, band0, Kl, r0 - rowbase);
    }
    asm volatile("s_waitcnt lgkmcnt(0)\n\ts_barrier" ::: "memory");
}
__device__ __forceinline__ void na_item(int it, int lane, const bf16* act0, const bf16* v0t, const LAS float* rpb, bf16* mix) {
    const int jb = it & 3, h = (it >> 2) % 12, br = (it >> 2) / 12, r = br & 63, b = br >> 6;
    const int r0 = min(max(r - 4, 0), 56), band0 = min(max(jb * 16 - 8, 0), 32);
    const int tok0 = b * SEQ + r * 64 + jb * 16;
    attn16<true>(lane, act0 + (size_t)tok0 * A0_LD + h * 64, A0_LD, act0 + 768 + h * 64, A0_LD, v0t + (size_t)(h * 64) * NT, NT, b * SEQ + r0 * 64 + band0, 64,
                 mix + (size_t)tok0 * DM + h * 64, DM, rpb + h * 465, r, r0, jb, band0);
}

constexpr int GP_LD = 392;
__device__ __forceinline__ void gla_pre_item(const Frame& F, int item, const bf16* act1, const float* W, const float* Bi, bf16* QT, bf16* KT, bf16* KDT, float* DEC) {
    const int n = item & 63, dir = (item >> 6) & 1, b = item >> 7, base = b * SEQ + n * 64;
    const int tid = TID(), lane = LANE(), wave = F.wave, qi = lane & 15, g = lane >> 4;
    LAS bf16* EL = (LAS bf16*)F.lds; LAS bf16* KDL = EL + 64 * GP_LD;
    v4u q8a[6], k8a[6];
#pragma unroll
    for (int k = 0; k < 6; ++k) { const int idx = tid + 512 * k, c = idx / 48, jg = idx % 48; const bf16* arow = act1 + (size_t)(base + c) * A1_LD + 8 * jg; q8a[k] = *(const v4u*)arow; k8a[k] = *(const v4u*)(arow + 384); }
    {   bf16x8 zf[4];
#pragma unroll
        for (int ct = 0; ct < 4; ++ct) { const int c = 16 * ct + qi, tok = dir ? base + 63 - c : base + c;
            bf16x8 z = {0, 0, 0, 0, 0, 0, 0, 0}; if (g < 2) z = *(const bf16x8*)(act1 + (size_t)tok * A1_LD + 1792 + dir * 16 + 8 * g); zf[ct] = z; }
#pragma unroll 1
        for (int jj = 0; jj < 3; ++jj) {
            const int j = 16 * (wave + 8 * jj) + qi;
            v4u wu = {0u, 0u, 0u, 0u};
            if (g < 2) { const float* wp = W + (size_t)(8 * g) * 384 + j;
                wu.x = pk2(wp[0], wp[384]); wu.y = pk2(wp[768], wp[1152]); wu.z = pk2(wp[1536], wp[1920]); wu.w = pk2(wp[2304], wp[2688]); }
            const bf16x8 wfr = __builtin_bit_cast(bf16x8, wu);
            const float bias = Bi[j]; float carry = 0.f;
#pragma unroll
            for (int ct = 0; ct < 4; ++ct) {
                f32x4 d = {0.f, 0.f, 0.f, 0.f};
                d = __builtin_amdgcn_mfma_f32_16x16x32_bf16(zf[ct], wfr, d, 0, 0, 0);
                float p[4];
#pragma unroll
                for (int i = 0; i < 4; ++i) { const float x = d[i] + bias;
                    p[i] = (fminf(x, 0.f) * 1.4426950408889634f - __builtin_amdgcn_logf(1.0f + __builtin_amdgcn_exp2f(fabsf(x) * -1.4426950408889634f))) * 0.0625f; }
                p[1] += p[0]; p[2] += p[1]; p[3] += p[2];
                float a = p[3]; float t = __shfl_up(a, 16); if (g >= 1) a += t; t = __shfl_up(a, 32); if (g >= 2) a += t;
                const float excl = a - p[3] + carry;
                carry += __shfl(a, 48 + qi);
#pragma unroll
                for (int i = 0; i < 4; ++i) { const int c = 16 * ct + 4 * g + i, ctok = dir ? 63 - c : c; EL[ctok * GP_LD + j] = (bf16)f2bf(__builtin_amdgcn_exp2f(excl + p[i])); }
            }
        }
    }
    __syncthreads();
    const int clast = dir ? 0 : 63;
#pragma unroll
    for (int k = 0; k < 6; ++k) {
        const int idx = tid + 512 * k, c = idx / 48, jg = idx % 48;
        const v4u q8 = q8a[k], k8 = k8a[k];
        const v4u e8 = *(const LAS v4u*)(EL + c * GP_LD + 8 * jg), l8 = *(const LAS v4u*)(EL + clast * GP_LD + 8 * jg);
        const unsigned qa[4] = {q8.x, q8.y, q8.z, q8.w}, ka[4] = {k8.x, k8.y, k8.z, k8.w}, ea[4] = {e8.x, e8.y, e8.z, e8.w}, la[4] = {l8.x, l8.y, l8.z, l8.w};
        unsigned qo[4], ko[4], dq[4];
        float lf[8];
#pragma unroll
        for (int i = 0; i < 4; ++i) {
            const float e0 = bflo(ea[i]), e1 = bfhi(ea[i]), i0 = __builtin_amdgcn_rcpf(e0), i1 = __builtin_amdgcn_rcpf(e1);
            const float kt0 = bflo(ka[i]) * i0, kt1 = bfhi(ka[i]) * i1; lf[2 * i] = bflo(la[i]); lf[2 * i + 1] = bfhi(la[i]);
            qo[i] = pk2(bflo(qa[i]) * 0.10206207261596575f * e0, bfhi(qa[i]) * 0.10206207261596575f * e1);
            ko[i] = pk2(kt0, kt1); dq[i] = pk2(kt0 * lf[2 * i], kt1 * lf[2 * i + 1]);
        }
        v4u w; w.x = qo[0]; w.y = qo[1]; w.z = qo[2]; w.w = qo[3]; *(v4u*)(QT + (size_t)(base + c) * 384 + 8 * jg) = w;
        w.x = ko[0]; w.y = ko[1]; w.z = ko[2]; w.w = ko[3]; *(v4u*)(KT + (size_t)(base + c) * 384 + 8 * jg) = w;
        w.x = dq[0]; w.y = dq[1]; w.z = dq[2]; w.w = dq[3]; *(LAS v4u*)(KDL + c * GP_LD + 8 * jg) = w;
        if (c == clast) { float* dp = DEC + (size_t)((b * 4 + jg / 12) * 64 + n) * 96 + (jg % 12) * 8;
            *(f32x4*)dp = (f32x4){lf[0], lf[1], lf[2], lf[3]}; *(f32x4*)(dp + 4) = (f32x4){lf[4], lf[5], lf[6], lf[7]}; }
    }
    __syncthreads();
#pragma unroll 2
    for (int k = 0; k < 6; ++k) {
        const int idx = tid + 512 * k, j = idx % 384, cg = idx / 384, h = j / 96, d = j % 96;
        const LAS bf16* sp = KDL + (8 * cg) * GP_LD + j;
        v4u w; w.x = (unsigned)sp[0] | ((unsigned)sp[GP_LD] << 16); w.y = (unsigned)sp[2 * GP_LD] | ((unsigned)sp[3 * GP_LD] << 16);
        w.z = (unsigned)sp[4 * GP_LD] | ((unsigned)sp[5 * GP_LD] << 16); w.w = (unsigned)sp[6 * GP_LD] | ((unsigned)sp[7 * GP_LD] << 16);
        *(v4u*)(KDT + ((size_t)((b * 4 + h) * 64 + n) * 96 + d) * 64 + 8 * cg) = w;
    }
    __syncthreads();
}
constexpr int GL_QT = 0, GL_KT = 13312, GL_KDT = 26624, GL_VT = 40960, GL_DEC = 48128, GL_BUF = 49152;
__device__ __forceinline__ void gla_main_item(const Frame& F, int item, const bf16* QTa, const bf16* KTa, const bf16* KDT0, const bf16* KDT1, const float* DECa, const bf16* v1t, bf16* OFp, bf16* OBp) {
    const int vs = item & 3, dir = (item >> 2) & 1, h = (item >> 3) & 3, b = item >> 5;
    const int lane = LANE(), wave = F.wave, qi = lane & 15, g = lane >> 4, ct = wave & 3, vh = wave >> 2;
    bf16* O = dir ? OBp : OFp;
    LAS unsigned char* L = F.lds;
    unsigned off[6];
#pragma unroll
    for (int jj = 0; jj < 6; ++jj) { const int k = wave + 8 * jj; unsigned o;
        if (k < 26) { const int gi = (k < 13 ? k : k - 13) * 64 + lane, row = gi / 13, col = gi % 13; o = (unsigned)(row * 768 + (col < 12 ? col * 16 : 0)); }
        else if (k < 40) { const int gi = (k - 26) * 64 + lane, row = gi / 9, col = gi % 9; o = (gi < 864) ? (unsigned)(row * 128 + (col < 8 ? col * 16 : 0)) : 0u; }
        else if (k < 47) { const int gi = (k - 40) * 64 + lane, row = gi / 9, col = gi % 9; o = (gi < 432) ? (unsigned)(row * NT * 2 + (col < 8 ? col * 16 : 0)) : 0u; }
        else o = (lane < 24) ? (unsigned)(lane * 16) : 0u;
        off[jj] = o; }
    const char* qtb = (const char*)(QTa + (size_t)dir * NT * 384 + h * 96); const char* ktb = (const char*)(KTa + (size_t)dir * NT * 384 + h * 96);
    const char* kdb = (const char*)(dir ? KDT1 : KDT0) + (size_t)((b * 4 + h) * 64) * 12288; const char* deb = (const char*)(DECa + (size_t)dir * 8 * 4 * 64 * 96 + (size_t)((b * 4 + h) * 64) * 96);
    const char* vtb = (const char*)(v1t + (size_t)(h * 192 + vs * 48) * NT);
#define GL_DMA(n_, bufo_) do { const int nn_ = dir ? 63 - (n_) : (n_); const size_t tb_ = (size_t)(b * SEQ + nn_ * 64); \
        _Pragma("unroll") for (int jj_ = 0; jj_ < 6; ++jj_) { const int k_ = wave + 8 * jj_; \
            const char* src_ = k_ < 13 ? qtb + tb_ * 768 : (k_ < 26 ? ktb + tb_ * 768 : (k_ < 40 ? kdb + (size_t)nn_ * 12288 : (k_ < 47 ? vtb + tb_ * 2 : deb + (size_t)nn_ * 384))); \
            __builtin_amdgcn_global_load_lds((const unsigned*)(src_ + off[jj_]), (LAS unsigned*)(L + (bufo_) + k_ * 1024), 16, 0, 0); } } while (0)
    constexpr int GL_SB = 2 * GL_BUF;
    int oT[3]; bool oV[3];
#pragma unroll
    for (int j = 0; j < 3; ++j) { if (wave >= 4) { oT[j] = (wave - 4) + 4 * j; oV[j] = true; } else { oT[j] = (j == 0) ? 12 + wave : 16 + wave; oV[j] = (j == 0) || (j == 1 && wave < 2); } }
    f32x4 So[3];
#pragma unroll
    for (int j = 0; j < 3; ++j) So[j] = (f32x4){0.f, 0.f, 0.f, 0.f};
    for (int i = TID(); i < 18 * 512 / 8; i += NTHR) *(LAS v2u*)(L + GL_SB + i * 8) = (v2u){0u, 0u};
    GL_DMA(0, 0);
    asm volatile("s_waitcnt vmcnt(0) lgkmcnt(0)\n\ts_barrier" ::: "memory");
#pragma unroll 1
    for (int n = 0; n < 64; ++n) {
        const int bo = (n & 1) * GL_BUF;
        if (n + 1 < 64) GL_DMA(n + 1, GL_BUF - bo);
        LAS unsigned char* Bf = L + bo;
        const LAS unsigned char* SBr = L + GL_SB + (n & 1) * 9216; LAS unsigned char* SBw = L + GL_SB + ((n + 1) & 1) * 9216;
        bf16x8 qf[3];
#pragma unroll
        for (int ks = 0; ks < 3; ++ks) qf[ks] = *(const LAS bf16x8*)(Bf + GL_QT + (16 * ct + qi) * 208 + (32 * ks + 8 * g) * 2);
        f32x4 am[4];
#pragma unroll
        for (int tp = 0; tp < 4; ++tp) {
            f32x4 z = {0.f, 0.f, 0.f, 0.f};
            if (dir ? (tp >= ct) : (tp <= ct)) {
#pragma unroll
                for (int ks = 0; ks < 3; ++ks) { const bf16x8 kf = *(const LAS bf16x8*)(Bf + GL_KT + (16 * tp + qi) * 208 + (32 * ks + 8 * g) * 2);
                    z = __builtin_amdgcn_mfma_f32_16x16x32_bf16(kf, qf[ks], z, 0, 0, 0); }
                const int c = 16 * ct + qi;
#pragma unroll
                for (int i = 0; i < 4; ++i) { const int cp = 16 * tp + 4 * g + i; const bool keep = dir ? (cp > c) : (cp <= c); z[i] = keep ? z[i] : 0.f; }
            }
            am[tp] = z;
        }
        bf16x8 pf[2];
#pragma unroll
        for (int kk = 0; kk < 2; ++kk) { v4u w; w.x = pk2(am[2 * kk][0], am[2 * kk][1]); w.y = pk2(am[2 * kk][2], am[2 * kk][3]); w.z = pk2(am[2 * kk + 1][0], am[2 * kk + 1][1]); w.w = pk2(am[2 * kk + 1][2], am[2 * kk + 1][3]);
            pf[kk] = __builtin_bit_cast(bf16x8, w); }
        bf16x8 qp[3];
#pragma unroll
        for (int kk = 0; kk < 3; ++kk) { const LAS unsigned char* qr = Bf + GL_QT + (16 * ct + qi) * 208 + (32 * kk + 4 * g) * 2;
            const s16x4 a0 = *(const LAS s16x4*)qr, a1 = *(const LAS s16x4*)(qr + 32); qp[kk] = __builtin_shufflevector(a0, a1, 0, 1, 2, 3, 4, 5, 6, 7); }
        const int nn = dir ? 63 - n : n, tok = b * SEQ + nn * 64 + 16 * ct + qi;
#pragma unroll
        for (int vi = 0; vi < 2; ++vi) {
            if (vi == 1 && vh == 1) break;
            const int vt = 2 * vh + vi;
            f32x4 acc = {0.f, 0.f, 0.f, 0.f};
#pragma unroll
            for (int kk = 0; kk < 2; ++kk) { const LAS unsigned char* vr = Bf + GL_VT + (16 * vt + qi) * 144 + (32 * kk + 4 * g) * 2;
                const s16x4 a0 = *(const LAS s16x4*)vr, a1 = *(const LAS s16x4*)(vr + 32); const bf16x8 vf = __builtin_shufflevector(a0, a1, 0, 1, 2, 3, 4, 5, 6, 7);
                acc = __builtin_amdgcn_mfma_f32_16x16x32_bf16(vf, pf[kk], acc, 0, 0, 0); }
#pragma unroll
            for (int kk = 0; kk < 3; ++kk) { const LAS unsigned char* sr = SBr + (vt * 6 + 2 * kk) * 512 + lane * 8;
                const s16x4 a0 = *(const LAS s16x4*)sr, a1 = *(const LAS s16x4*)(sr + 512); const bf16x8 sf = __builtin_shufflevector(a0, a1, 0, 1, 2, 3, 4, 5, 6, 7);
                acc = __builtin_amdgcn_mfma_f32_16x16x32_bf16(sf, qp[kk], acc, 0, 0, 0); }
            v2u w; w.x = pk2(acc[0], acc[1]); w.y = pk2(acc[2], acc[3]);
            *(v2u*)(O + (size_t)tok * 768 + h * 192 + vs * 48 + 16 * vt + 4 * g) = w;
        }
#pragma unroll
        for (int j = 0; j < 3; ++j) {
            if (oV[j]) {
                const int T = oT[j], vt = T / 6, dt = T - 6 * vt;
                const f32x4 dec = *(const LAS f32x4*)(Bf + GL_DEC + (16 * dt + 4 * g) * 4);
                f32x4 sv = So[j]; sv[0] *= dec[0]; sv[1] *= dec[1]; sv[2] *= dec[2]; sv[3] *= dec[3];
#pragma unroll
                for (int ks = 0; ks < 2; ++ks) { const bf16x8 kdf = *(const LAS bf16x8*)(Bf + GL_KDT + (16 * dt + qi) * 144 + (32 * ks + 8 * g) * 2);
                    const bf16x8 vfr = *(const LAS bf16x8*)(Bf + GL_VT + (16 * vt + qi) * 144 + (32 * ks + 8 * g) * 2);
                    sv = __builtin_amdgcn_mfma_f32_16x16x32_bf16(kdf, vfr, sv, 0, 0, 0); }
                So[j] = sv;
                v2u w; w.x = pk2(sv[0], sv[1]); w.y = pk2(sv[2], sv[3]); *(LAS v2u*)(SBw + T * 512 + lane * 8) = w;
            }
        }
        if (vh) asm volatile("s_waitcnt vmcnt(1) lgkmcnt(0)\n\ts_barrier" ::: "memory"); else asm volatile("s_waitcnt vmcnt(2) lgkmcnt(0)\n\ts_barrier" ::: "memory");
    }
    __syncthreads();
#undef GL_DMA
}

__device__ __forceinline__ void finalize_rstd(const Frame& F, const float* rss, float* rstd) {
    for (int row = F.bid * NTHR + TID(); row < NT; row += F.G * NTHR) rstd[row] = rstd_from(rss + (size_t)row * 16);
}
__device__ __forceinline__ void gla_combine(const Frame& F, const bf16* OF, const bf16* OB, const bf16* act1, const float* gnorm, bf16* mix) {
    for (int token = F.gw; token < NT; token += F.NGW) {
        const int lane = LANE();
#pragma unroll
        for (int h = 0; h < 4; ++h) {
            float o[3]; float ss = 0.f;
#pragma unroll
            for (int j = 0; j < 3; ++j) { const size_t idx = (size_t)token * 768 + h * 192 + j * 64 + lane; o[j] = bf2f(OF[idx]) + bf2f(OB[idx]); ss += o[j] * o[j]; }
            ss = wave_sum(ss);
            const float rs = 1.0f / sqrtf(ss * (1.0f / 192.0f) + EPS);
#pragma unroll
            for (int j = 0; j < 3; ++j) { const int dv = j * 64 + lane; const float g = bf2f(act1[(size_t)token * A1_LD + 768 + h * 192 + dv]);
                const float val = o[j] * rs * gnorm[dv] * (g / (1.0f + __expf(-g)));
                mix[(size_t)token * DM + h * 192 + dv] = (bf16)f2bf(val); }
        }
    }
}
__device__ __forceinline__ void route_pick(const float (&acc)[8], int token, int* topi, float* topw, LAS int* lc) {
    int e0 = 0; float l0 = acc[0];
#pragma unroll
    for (int e = 1; e < 8; ++e) if (acc[e] > l0) { l0 = acc[e]; e0 = e; }
    int e1 = -1; float l1 = -INFINITY;
#pragma unroll
    for (int e = 0; e < 8; ++e) if (e != e0 && acc[e] > l1) { l1 = acc[e]; e1 = e; }
    if (e1 < 0) { e1 = (e0 + 1) & 7; l1 = l0; }
    const float w0 = 1.0f / (1.0f + __expf(l1 - l0));
    topi[token] = e0 | (e1 << 8); topw[2 * token] = w0; topw[2 * token + 1] = 1.0f - w0;
    atomicAdd((int*)&lc[e0], 1); atomicAdd((int*)&lc[8 + e1], 1);
}
__device__ __forceinline__ void route1(const Frame& F, const bf16* H, const float* gain, const float* wr, int* topi, float* topw, int* cnt, float* rstd) {
    LAS int* lc = (LAS int*)F.lds;
    if (TID() < 16) lc[TID()] = 0;
    __syncthreads();
    const int lane = LANE();
    float w[4][4][8];
#pragma unroll
    for (int j = 0; j < 4; ++j) { const f32x4 g = *(const f32x4*)(gain + 256 * j + 4 * lane);
#pragma unroll
        for (int i = 0; i < 4; ++i) { const float* p = wr + (size_t)(256 * j + 4 * lane + i) * 8; const f32x4 a = *(const f32x4*)p, b = *(const f32x4*)(p + 4); const float gi = g[i];
            w[j][i][0] = a.x * gi; w[j][i][1] = a.y * gi; w[j][i][2] = a.z * gi; w[j][i][3] = a.w * gi; w[j][i][4] = b.x * gi; w[j][i][5] = b.y * gi; w[j][i][6] = b.z * gi; w[j][i][7] = b.w * gi; } }
    for (int t2 = 0; t2 < 16; t2 += 2) {
        const int token = F.bid * 128 + F.wave * 16 + t2;
        const v2u* h0 = (const v2u*)(H + (size_t)token * DM) + lane; const v2u* h1 = h0 + DM / 4;
        f32x4 x0[4], x1[4];
#pragma unroll
        for (int j = 0; j < 4; ++j) { const v2u p = h0[64 * j], q = h1[64 * j]; x0[j] = (f32x4){bflo(p.x), bfhi(p.x), bflo(p.y), bfhi(p.y)}; x1[j] = (f32x4){bflo(q.x), bfhi(q.x), bflo(q.y), bfhi(q.y)}; }
        float a0[8], a1[8], s0 = 0.f, s1 = 0.f;
#pragma unroll
        for (int e = 0; e < 8; ++e) { a0[e] = 0.f; a1[e] = 0.f; }
#pragma unroll
        for (int j = 0; j < 4; ++j)
#pragma unroll
            for (int i = 0; i < 4; ++i) { const float u = x0[j][i], v = x1[j][i]; s0 += u * u; s1 += v * v;
#pragma unroll
                for (int e = 0; e < 8; ++e) { a0[e] += u * w[j][i][e]; a1[e] += v * w[j][i][e]; } }
        s0 = wave_sum(s0); s1 = wave_sum(s1);
        const float r0 = 1.0f / sqrtf(s0 * (1.0f / DM) + EPS), r1 = 1.0f / sqrtf(s1 * (1.0f / DM) + EPS);
#pragma unroll
        for (int e = 0; e < 8; ++e) { a0[e] = wave_sum(a0[e]) * r0; a1[e] = wave_sum(a1[e]) * r1; }
        if (lane == 0) { route_pick(a0, token, topi, topw, lc); route_pick(a1, token + 1, topi, topw, lc); rstd[token] = r0; rstd[token + 1] = r1; }
    }
    __syncthreads();
    if (TID() < 16) cnt[F.bid * 16 + TID()] = lc[TID()];
    __syncthreads();
}
__device__ __forceinline__ void route2(const Frame& F, const int* topi, const float* topw, const int* cnt, int* stok, float* sw, int* blk) {
    LAS int* part = (LAS int*)F.lds;
    LAS int* base = part + 1024;
    LAS int* tk = base + 64;
    const int tid = TID(), pe = tid & 15, jg = tid >> 4;
    int below = 0, tot = 0;
    for (int w = jg; w < F.G; w += 32) { const int v = cnt[w * 16 + pe]; tot += v; if (w < F.bid) below += v; }
    part[jg * 16 + pe] = below; part[512 + jg * 16 + pe] = tot;
    if (tid < 128) tk[tid] = topi[F.bid * 128 + tid];
    __syncthreads();
    if (tid < 16) { int b = 0, t = 0; for (int j = 0; j < 32; ++j) { b += part[j * 16 + tid]; t += part[512 + j * 16 + tid]; } base[tid] = b; base[16 + tid] = t; }
    __syncthreads();
    if (tid < 2) { int ps = 0; for (int e = 0; e < 8; ++e) { base[32 + tid * 8 + e] = ps; ps += (base[16 + tid * 8 + e] + 255) / 256 * 256; } base[48 + tid] = ps / 256; }
    __syncthreads();
    if (tid < 256) {
        const int p = tid >> 7, i = tid & 127; const int e = (tk[i] >> (8 * p)) & 0xff;
        int rank = 0; for (int j = 0; j < i; ++j) rank += (((tk[j] >> (8 * p)) & 0xff) == e) ? 1 : 0;
        const int slot = base[32 + p * 8 + e] + base[p * 8 + e] + rank; const int token = F.bid * 128 + i;
        stok[p * SLOT_CAP + slot] = token; sw[p * SLOT_CAP + slot] = topw[2 * token + p];
    }
    if (F.bid < 16) {
        const int p = F.bid >> 3, e = F.bid & 7, ps = base[32 + F.bid], t = base[16 + F.bid], pend = ps + (t + 255) / 256 * 256;
        for (int s = ps + t + tid; s < pend; s += NTHR) { stok[p * SLOT_CAP + s] = -1; sw[p * SLOT_CAP + s] = 0.f; }
        for (int bk = ps / 256 + tid; bk < pend / 256; bk += NTHR) blk[16 + p * 256 + bk] = e;
        if (e == 0 && tid == 0) blk[p] = base[48 + p];
    }
    __syncthreads();
}
__device__ __forceinline__ void final_norm_slots(int lane, const bf16* HB, float* OUT, const bf16* Y, const bf16* Y2, const float* gain, const int* tok, int s0, int s1, int first, int stride) {
    const f32x4* gr = (const f32x4*)gain + lane;
    for (int sl = s0 + first; sl < s1; sl += 2 * stride) {
        const int slb = sl + stride; const bool hb = slb < s1;
        const int ra = tok[sl], rb = hb ? tok[slb] : -1;
        const int rowa = ra < 0 ? 0 : ra, rowb = rb < 0 ? 0 : rb;
        const v2u* xa = (const v2u*)(HB + (size_t)rowa * DM) + lane; const v2u* xb = (const v2u*)(HB + (size_t)rowb * DM) + lane;
        const v2u* ya = (const v2u*)(Y + (size_t)sl * DM) + lane; const v2u* yb = (const v2u*)(Y + (size_t)(hb ? slb : sl) * DM) + lane;
        f32x4 va[4], vb[4]; v2u wa[4], wb[4], ua[4], ub[4];
#pragma unroll
        for (int j = 0; j < 4; ++j) { ua[j] = xa[64 * j]; wa[j] = ya[64 * j]; }
#pragma unroll
        for (int j = 0; j < 4; ++j) { ub[j] = xb[64 * j]; wb[j] = yb[64 * j]; }
#pragma unroll
        for (int j = 0; j < 4; ++j) { va[j] = (f32x4){bflo(ua[j].x), bfhi(ua[j].x), bflo(ua[j].y), bfhi(ua[j].y)}; vb[j] = (f32x4){bflo(ub[j].x), bfhi(ub[j].x), bflo(ub[j].y), bfhi(ub[j].y)}; }
        if (Y2) {
            const v2u* za = (const v2u*)(Y2 + (size_t)(sl - s0) * DM) + lane; const v2u* zb = (const v2u*)(Y2 + (size_t)((hb ? slb : sl) - s0) * DM) + lane;
#pragma unroll
            for (int j = 0; j < 4; ++j) { const v2u p = za[64 * j], q = zb[64 * j];
                va[j].x += bflo(p.x); va[j].y += bfhi(p.x); va[j].z += bflo(p.y); va[j].w += bfhi(p.y); vb[j].x += bflo(q.x); vb[j].y += bfhi(q.x); vb[j].z += bflo(q.y); vb[j].w += bfhi(q.y); }
        }
        float sa = 0.f, sb = 0.f;
#pragma unroll
        for (int j = 0; j < 4; ++j) {
            va[j].x += bflo(wa[j].x); va[j].y += bfhi(wa[j].x); va[j].z += bflo(wa[j].y); va[j].w += bfhi(wa[j].y);
            vb[j].x += bflo(wb[j].x); vb[j].y += bfhi(wb[j].x); vb[j].z += bflo(wb[j].y); vb[j].w += bfhi(wb[j].y);
            sa += (va[j].x * va[j].x + va[j].y * va[j].y) + (va[j].z * va[j].z + va[j].w * va[j].w); sb += (vb[j].x * vb[j].x + vb[j].y * vb[j].y) + (vb[j].z * vb[j].z + vb[j].w * vb[j].w); }
        sa = wave_sum(sa); sb = wave_sum(sb);
        const float rsa = 1.0f / sqrtf(sa * (1.0f / DM) + EPS), rsb = 1.0f / sqrtf(sb * (1.0f / DM) + EPS);
        if (ra >= 0) { GAS f32x4* oa = (GAS f32x4*)(OUT + (size_t)rowa * DM) + lane;
#pragma unroll
            for (int j = 0; j < 4; ++j) { const f32x4 g = gr[64 * j]; oa[64 * j] = (f32x4){va[j].x * rsa * g.x, va[j].y * rsa * g.y, va[j].z * rsa * g.z, va[j].w * rsa * g.w}; } }
        if (rb >= 0) { GAS f32x4* ob = (GAS f32x4*)(OUT + (size_t)rowb * DM) + lane;
#pragma unroll
            for (int j = 0; j < 4; ++j) { const f32x4 g = gr[64 * j]; ob[64 * j] = (f32x4){vb[j].x * rsb * g.x, vb[j].y * rsb * g.y, vb[j].z * rsb * g.z, vb[j].w * rsb * g.w}; } }
    }
}
__device__ __forceinline__ void final_norm(const Frame& F, float* H, const float* gain) {
    for (int row = F.gw; row < NT; row += F.NGW) {
        GAS f32x4* xr = (GAS f32x4*)(H + (size_t)row * DM) + LANE(); const f32x4* gr = (const f32x4*)gain + LANE();
        f32x4 v[4]; float s = 0.f;
#pragma unroll
        for (int j = 0; j < 4; ++j) { v[j] = xr[64 * j]; s += (v[j].x * v[j].x + v[j].y * v[j].y) + (v[j].z * v[j].z + v[j].w * v[j].w); }
        s = wave_sum(s); const float rs = 1.0f / sqrtf(s * (1.0f / DM) + EPS);
#pragma unroll
        for (int j = 0; j < 4; ++j) { const f32x4 g = gr[64 * j]; f32x4 o = {v[j].x * rs * g.x, v[j].y * rs * g.y, v[j].z * rs * g.z, v[j].w * rs * g.w}; xr[64 * j] = o; }
    }
}

constexpr int N_PHASES = 17;
__global__ void __launch_bounds__(NTHR, 2) mega(Args args) {
    extern __shared__ __attribute__((aligned(16))) unsigned char lds_raw[];
    Frame F;
    F.lds = (LAS unsigned char*)lds_raw;
    F.wave = __builtin_amdgcn_readfirstlane((int)(threadIdx.x >> 6));
    F.G = gridDim.x; F.bid = blockIdx.x; F.gw = F.bid * NWAVES + F.wave; F.NGW = F.G * NWAVES; F.ws = args.ws;
    unsigned char* ws = args.ws;
    gu32* ctl = (gu32*)(ws + WS_CTL);
    volatile LAS unsigned* MISC = (volatile LAS unsigned*)(F.lds + MISC_OFF);
    for (int u = TID(); u < (LDS_BYTES - LDSCTL_OFF) / 4; u += NTHR) ((LAS unsigned*)(F.lds + LDSCTL_OFF))[u] = 0u;
    __syncthreads();
    XcdBarrier bar = xcd_barrier_post((unsigned*)(ctl + CW_BAR), MISC + 8);
    const int lo = args.ph_lo, hi = args.ph_hi;
#ifndef PH_MASK
#define PH_MASK 0x1ffff
#endif
#define IN(k) (((PH_MASK >> (k)) & 1) && lo <= (k) && (k) < hi)
#ifndef REPEAT_MASK
#define REPEAT_MASK 0
#endif
#define REPS(k) (1 + ((REPEAT_MASK >> (k)) & 1))
#define SEAM(k) do { if (IN(k) && IN((k) + 1)) xcd_barrier(bar); } while (0)

    float* H = args.out;
    bf16* x3 = (bf16*)args.out;
    float* rss = (float*)(ws + WS_RSS); float* rstd = (float*)(ws + WS_RSTD);
    bf16* hbf = (bf16*)(ws + WS_HBF); bf16* membf = (bf16*)(ws + WS_MEMBF); bf16* memk = (bf16*)(ws + WS_MEMK); bf16* memvt = (bf16*)(ws + WS_MEMVT);
    bf16* act0 = (bf16*)(ws + WS_ACT0); bf16* v0t = (bf16*)(ws + WS_V0T); bf16* mix = (bf16*)(ws + WS_MIX); bf16* hmid0 = (bf16*)(ws + WS_HMID0);
    bf16* act1 = (bf16*)(ws + WS_ACT1); bf16* v1t = (bf16*)(ws + WS_V1T); bf16* OF = (bf16*)(ws + WS_OF); bf16* OB = (bf16*)(ws + WS_OB);
    bf16* hmid1 = (bf16*)(ws + WS_HMID1); bf16* wgu = (bf16*)(ws + WS_WGU); bf16* wdn = (bf16*)(ws + WS_WDN);
    int* cnt = (int*)(ws + WS_CNT); int* topi = (int*)(ws + WS_TOPI); float* topw = (float*)(ws + WS_TOPW);
    int* stok = (int*)(ws + WS_STOK); float* sw = (float*)(ws + WS_SW); int* blk = (int*)(ws + WS_BLK);
    LAS float* scr = (LAS float*)(F.lds + F.wave * 16384);

    if (IN(0)) {
        int it = F.gw; LAS unsigned* T0 = (LAS unsigned*)scr; LAS unsigned* T1 = T0 + 1088;
#define CVT(Wp, Kd, Nd, WTp, gainp, kind) do { const CvtJob J{Wp, Kd, Nd, (bf16*)(WTp), gainp, kind}; const int n_ = ((Kd) / 64) * ((Nd) / 32); \
            while (it < n_) { CvtRegs A_, B_; B_.valid = 0; cvt_load(A_, J, it, LANE()); it += F.NGW; if (it < n_) { cvt_load(B_, J, it, LANE()); it += F.NGW; } cvt_finish(A_, T0, LANE()); cvt_finish(B_, T1, LANE()); } \
            it -= n_; } while (0)
        CVT(args.in[I_EWIN], 1024, 2560, ws + WS_W0IN, args.in[I_EN1], 1);
        CVT(args.in[I_EWIN], 1024, 2560, ws + WS_WV0, args.in[I_EN1], 2);
        CVT(args.in[I_EWOUT], 1024, 1024, ws + WS_W0OUT, nullptr, 0);
        CVT(args.in[I_EWG], 1024, 2816, ws + WS_W0GU, args.in[I_EN2], 3);
        CVT(args.in[I_EWU], 1024, 2816, ws + WS_W0GU, args.in[I_EN2], 4);
        CVT(args.in[I_EWD], 2816, 1024, ws + WS_W0DN, nullptr, 0);
        CVT(args.in[I_WMKV], 1024, 512, ws + WS_WMEM, args.in[I_MNORM], 0);
        CVT(args.in[I_OWIN], 1024, 2592, ws + WS_W1IN, args.in[I_ON1], 5);
        CVT(args.in[I_OWIN], 1024, 2592, ws + WS_WV1, args.in[I_ON1], 6);
        CVT(args.in[I_OWOUT], 1024, 1024, ws + WS_W1OUT, nullptr, 0);
#undef CVT
        { v4u z = {0u, 0u, 0u, 0u}; v4u* p = (v4u*)(ws + WS_W1IN + (size_t)1824 * 2048); const int n16 = 224 * 2048 / 16;
          for (int i = F.bid * NTHR + TID(); i < n16; i += F.G * NTHR) p[i] = z; }
        rows_to_bf16(args.in[I_X], hbf, rstd, F.gw, NT, F.NGW, LANE());
        rows_to_bf16(args.in[I_MEM], membf, rstd + NT, F.gw, MEM_ROWS, F.NGW, LANE());
    }
    SEAM(0);
    if (IN(1)) {
        { Sched S; S.init(hbf, ws + WS_W0IN, 1024, 128, 7, F.G, F.bid); EpiRowScale E{act0, A0_LD, rstd}; gemm_run<EpiRowScale, false>(F.lds, S, E, nullptr); }
        { Sched S; S.init(ws + WS_WV0, hbf, 1024, 3, 128, F.G, (F.bid + 128) % F.G); EpiColScale E{v0t, NT, rstd}; gemm_run<EpiColScale, false>(F.lds, S, E, nullptr); }
        for (int it = F.gw; it < 2048; it += F.NGW) memkv_item(it, LANE(), membf, (const bf16*)(ws + WS_WMEM), rstd + NT, memk, memvt);
    }
    SEAM(1);
    if (IN(2)) {
        { LAS float* rl = (LAS float*)(F.lds + NA_RPB_OFF); for (int i = TID(); i < 5580; i += NTHR) rl[i] = args.in[I_RPB][i] * 1.4426950408889634f; __syncthreads();
          for (int it = F.bid; it < 768; it += F.G) na_strip(F, it, act0, v0t, mix);
          for (int it = F.bid; it < 512; it += F.G) memattn_strip(F, it, act0, A0_LD, 1536, memk, memvt, mix);
          __syncthreads(); }
    }
    SEAM(2);
    if (IN(3)) {
        Sched S; S.init(mix, ws + WS_W0OUT, 1024, 128, 4, F.G, F.bid); EpiResid<true> E{args.in[I_X], hbf, rss, nullptr}; gemm_run<EpiResid<true>, false>(F.lds, S, E, nullptr);
    }
    SEAM(3);
    if (IN(4)) {
        finalize_rstd(F, rss, rstd); xcd_barrier(bar);
        Sched S; S.init(hbf, ws + WS_W0GU, 1024, 128, 22, F.G, F.bid); EpiSwiGLU<false> E{hmid0, FF0, rstd, nullptr}; gemm_run<EpiSwiGLU<false>, false>(F.lds, S, E, nullptr);
    }
    SEAM(4);
    if (IN(5)) {
        Sched S; S.init(hmid0, ws + WS_W0DN, FF0, 128, 4, F.G, F.bid); EpiResid<false> E{nullptr, hbf, rss, nullptr}; gemm_run<EpiResid<false>, false>(F.lds, S, E, nullptr);
    }
    SEAM(5);
    if (IN(6)) {
        finalize_rstd(F, rss, rstd); xcd_barrier(bar);
        { Sched S; S.init(hbf, ws + WS_W1IN, 1024, 128, 8, F.G, F.bid); EpiRowScale E{act1, A1_LD, rstd}; gemm_run<EpiRowScale, false>(F.lds, S, E, nullptr); }
        { Sched S; S.init(ws + WS_WV1, hbf, 1024, 3, 128, F.G, F.bid); EpiColScale E{v1t, NT, rstd}; gemm_run<EpiColScale, false>(F.lds, S, E, nullptr); }
    }
    SEAM(6);
    if (IN(7)) {
        for (int it = F.bid; it < 1024; it += F.G) { const int dir = (it >> 6) & 1;
            gla_pre_item(F, it, act1, dir ? args.in[I_WGKB] : args.in[I_WGKF], dir ? args.in[I_BGKB] : args.in[I_BGKF], (bf16*)(ws + WS_GQT) + (size_t)dir * NT * 384, (bf16*)((unsigned char*)args.out + OUT_GKT) + (size_t)dir * NT * 384,
                         (bf16*)(ws + (dir ? WS_GKDT1 : WS_GKDT0)), (float*)((unsigned char*)args.out + OUT_GDEC) + (size_t)dir * 8 * 4 * 64 * 96); }
        for (int it = F.bid; it < 512; it += F.G) memattn_strip(F, it, act1, A1_LD, 1536, memk, memvt, mix);
        xcd_barrier(bar);
        for (int it0 = F.bid; it0 < 256; it0 += F.G) { const int it = (F.G == 256) ? ((it0 & 7) * 8 + (it0 >> 5)) * 4 + ((it0 >> 3) & 3) : it0;
            gla_main_item(F, it, (const bf16*)(ws + WS_GQT), (const bf16*)((unsigned char*)args.out + OUT_GKT), (const bf16*)(ws + WS_GKDT0), (const bf16*)(ws + WS_GKDT1), (const float*)((unsigned char*)args.out + OUT_GDEC), v1t, OF, OB); }
    }
    SEAM(7);
    if (IN(8)) gla_combine(F, OF, OB, act1, args.in[I_GNORM], mix);
    SEAM(8);
    if (IN(9)) {
        Sched S; S.init(mix, ws + WS_W1OUT, 1024, 128, 4, F.G, F.bid); EpiResid<false> E{nullptr, hbf, rss, x3}; gemm_run<EpiResid<false>, false>(F.lds, S, E, nullptr);
    }
    SEAM(9);
    if (IN(10)) {
        route1(F, hbf, args.in[I_ON2], args.in[I_WR], topi, topw, cnt, rstd);
        { LAS unsigned* T0 = (LAS unsigned*)scr; LAS unsigned* T1 = T0 + 1088;
#define MOE_JOB(J_, it_) const int e_##J_ = (it_) / 5376, r_##J_ = (it_) % 5376, wh_##J_ = r_##J_ / 1792; \
            const CvtJob J_{wh_##J_ == 0 ? args.in[I_OWG] + (size_t)e_##J_ * 1024 * FFE : (wh_##J_ == 1 ? args.in[I_OWU] + (size_t)e_##J_ * 1024 * FFE : args.in[I_OWD] + (size_t)e_##J_ * FFE * 1024), \
                wh_##J_ == 2 ? FFE : 1024, wh_##J_ == 2 ? 1024 : FFE, wh_##J_ == 2 ? wdn + (size_t)e_##J_ * 1024 * FFE : wgu + (size_t)e_##J_ * 7168 * 1024, wh_##J_ == 2 ? nullptr : args.in[I_ON2], wh_##J_ == 2 ? 0 : 3 + wh_##J_}
          for (int it = F.gw; it < 8 * 3 * 1792; it += 2 * F.NGW) {
            CvtRegs A_, B_; B_.valid = 0;
            { MOE_JOB(Ja, it); cvt_load(A_, Ja, it % 1792, LANE()); }
            if (it + F.NGW < 8 * 3 * 1792) { MOE_JOB(Jb, it + F.NGW); cvt_load(B_, Jb, (it + F.NGW) % 1792, LANE()); }
            cvt_finish(A_, T0, LANE()); cvt_finish(B_, T1, LANE());
          }
#undef MOE_JOB
        }
    }
    SEAM(10);
    if (IN(11)) route2(F, topi, topw, cnt, stok, sw, blk);
    SEAM(11);
    bf16* ht0 = hmid1 + (size_t)NT * FFE; bf16* ht1 = (bf16*)(ws + WS_HT1);
    if (IN(12)) {
        const int nb = blk[0]; Sched S; S.init(x3, wgu, 1024, nb, 28, F.G, F.bid, blk + 16, (size_t)7168 * 1024 * 2); EpiSwiGLU<true> E{hmid1, FFE, rstd, ht0}; gemm_run<EpiSwiGLU<true>, true>(F.lds, S, E, stok);
    }
    SEAM(12);
    if (IN(13)) {
        const int nb = blk[0], nbm = nb < 128 ? nb : 128; Sched S; S.init(hmid1, wdn, FFE, nbm, 4, F.G, F.bid, blk + 16, (size_t)1024 * FFE * 2); EpiMoeDown E{hbf, stok, sw}; gemm_run<EpiMoeDown, false>(F.lds, S, E, nullptr);
    }
    SEAM(13);
    if (IN(14)) {
        const int nb = blk[1], nb0 = blk[0], rfull = (nb * 28 / F.G > 3) ? nb * 28 / F.G - 3 : 0, per = F.G / 8;
        { Sched S; S.init(x3, wgu, 1024, nb, 28, F.G, F.bid, blk + 16 + 256, (size_t)7168 * 1024 * 2); S.range(0, rfull * per, per);
          EpiSwiGLU<true> E{hmid1, FFE, rstd, ht1}; gemm_run<EpiSwiGLU<true>, true>(F.lds, S, E, stok + SLOT_CAP); }
        { Sched S; S.init(x3, wgu, 1024, nb, 28, F.G, F.bid, blk + 16 + 256, (size_t)7168 * 1024 * 2); S.range(rfull * per, 0x7fffffff, per - 4);
          EpiSwiGLU<true> E{hmid1, FFE, rstd, ht1}; gemm_run<EpiSwiGLU<true>, true>(F.lds, S, E, stok + SLOT_CAP); }
        if (F.bid / 8 >= per - 4 && nb0 > 128) {
            Sched S; S.init(ht0, wdn, FFE, nb0 - 128, 4, 32, (F.bid / 8 - (per - 4)) * 8 + F.bid % 8, blk + 16 + 128, (size_t)1024 * FFE * 2);
            EpiMoeDown E{hbf, stok + NT, sw + NT}; gemm_run<EpiMoeDown, false>(F.lds, S, E, nullptr); }
    }
    SEAM(14);
    if (IN(15)) {
        const int nb = blk[1], nbm = nb < 128 ? nb : 128; Sched S; S.init(hmid1, wdn, FFE, nbm, 4, F.G, F.bid, blk + 16 + 256, (size_t)1024 * FFE * 2); EpiRowScale E{(bf16*)(ws + WS_YB), DM, sw + SLOT_CAP}; gemm_run<EpiRowScale, false>(F.lds, S, E, nullptr);
    }
    SEAM(15);
    if (IN(16)) {
        const int nb = blk[1], per = F.G / 8, nmain = (nb < 128 ? nb : 128) * 256;
        bf16* yb = (bf16*)(ws + WS_YB); bf16* yb2 = yb + (size_t)SLOT_CAP * DM;
        if (F.bid / 8 >= per - 4) {
            if (nb > 128) {
                const int sl = F.bid / 8 - (per - 4), kh = sl >> 1;
                Sched S; S.init((const bf16*)ht1 + kh * (FFE / 2), (const bf16*)wdn + kh * (FFE / 2), FFE / 2, nb - 128, 4, 16, (sl & 1) * 8 + F.bid % 8, blk + 16 + 256 + 128, (size_t)1024 * FFE * 2); S.ld = FFE;
                EpiRowScale E{kh ? yb2 : yb + (size_t)NT * DM, DM, sw + SLOT_CAP + NT}; gemm_run<EpiRowScale, false>(F.lds, S, E, nullptr); }
        } else {
            const int wv = (int)(blockIdx.x * NWAVES + (threadIdx.x >> 6));
            final_norm_slots((int)(threadIdx.x & 63u), hbf, H, yb, nullptr, args.in[I_FNORM], stok + SLOT_CAP, 0, nmain, wv, (per - 4) * 8 * NWAVES);
        }
        xcd_barrier(bar);
        if (nb > 128) final_norm_slots((int)(threadIdx.x & 63u), hbf, H, yb, yb2, args.in[I_FNORM], stok + SLOT_CAP, NT, nb * 256, (int)(blockIdx.x * NWAVES + (threadIdx.x >> 6)), F.NGW);
    }
#undef IN
#undef SEAM
}

extern "C" void kernel_launch(void* const* d_in, const int* in_sizes, int n_in, void* d_out, int out_size, void* d_ws, size_t ws_size, hipStream_t stream) {
    static int grid = 0;
    if (grid == 0) {
        if (n_in != 26 || out_size != NT * DM || ws_size < WS_END) { fprintf(stderr, "kernel_launch: unexpected problem (n_in %d out %d ws %zu need %zu)\n", n_in, out_size, ws_size, (size_t)WS_END); grid = -1; return; }
        int dev = 0, cus = 0, per_cu = 0;
        if (hipGetDevice(&dev) != hipSuccess || hipDeviceGetAttribute(&cus, hipDeviceAttributeMultiprocessorCount, dev) != hipSuccess) { grid = -1; return; }
        if (hipFuncSetAttribute((const void*)mega, hipFuncAttributeMaxDynamicSharedMemorySize, LDS_BYTES) != hipSuccess) { fprintf(stderr, "kernel_launch: hipFuncSetAttribute failed\n"); grid = -1; return; }
        if (hipOccupancyMaxActiveBlocksPerMultiprocessor(&per_cu, (const void*)mega, NTHR, LDS_BYTES) != hipSuccess || per_cu < 1) fprintf(stderr, "kernel_launch: occupancy query reports %d\n", per_cu);
        (void)hipGetLastError();
        grid = cus;
        if (grid != 256) fprintf(stderr, "kernel_launch: note: %d CUs\n", grid);
    }
    if (grid < 0) return;
    if (hipMemsetAsync((char*)d_ws + WS_CTL, 0, CTL_ZERO_BYTES, stream) != hipSuccess) return;
    Args a{};
    for (int i = 0; i < 26; ++i) a.in[i] = (const float*)d_in[i];
    a.out = (float*)d_out; a.ws = (unsigned char*)d_ws;
    a.ph_lo = 0; a.ph_hi = N_PHASES;
    hipLaunchKernelGGL(mega, dim3(grid), dim3(NTHR), LDS_BYTES, stream, a);
}
```

```cpp
#include <hip/hip_runtime.h>
#include <cstdio>
#include <cstdint>


#define GAS __attribute__((address_space(1)))
#define LAS __attribute__((address_space(3)))
typedef unsigned short bf16;
typedef unsigned v4u __attribute__((ext_vector_type(4)));
typedef unsigned v2u __attribute__((ext_vector_type(2)));
typedef float f32x4 __attribute__((ext_vector_type(4)));
typedef short bf16x8 __attribute__((ext_vector_type(8)));
typedef GAS unsigned gu32;
#define RLX_AGENT __ATOMIC_RELAXED, __HIP_MEMORY_SCOPE_AGENT
#define LDS_WAIT() asm volatile("s_waitcnt lgkmcnt(0)" ::: "memory")
#define VM_WAIT() asm volatile("s_waitcnt vmcnt(0)" ::: "memory")

constexpr int NT = 32768, DM = 1024, SEQ = 4096, NB = 8;
constexpr int MEM_ROWS = 2048;
constexpr int A0_LD = 1792;
constexpr int A1_LD = 2048;
constexpr int FF0 = 2816, FFE = 3584, NEXP = 8;
constexpr int SLOT_CAP = 34816;
constexpr float EPS = 1e-6f;
constexpr int NWAVES = 8, NTHR = 512;

constexpr size_t MiB = 1u << 20;
constexpr size_t WS_CTL = 0, CTL_ZERO_BYTES = 1 * MiB;
constexpr size_t WS_RSS = 1 * MiB;
constexpr size_t WS_MRSS = 3 * MiB;
constexpr size_t WS_CNT = 3 * MiB + 256 * 1024;
constexpr size_t WS_TOPI = 3 * MiB + 512 * 1024;
constexpr size_t WS_TOPW = 3 * MiB + 768 * 1024;
constexpr size_t WS_STOK = 4 * MiB;
constexpr size_t WS_SW = 4 * MiB + 512 * 1024;
constexpr size_t WS_BLK = 5 * MiB;
constexpr size_t WS_RSTD = 5 * MiB + 64 * 1024;
constexpr size_t WS_S0TAB = 5 * MiB + 512 * 1024;
constexpr size_t WS_W0IN = 6 * MiB;
constexpr size_t WS_WV0 = WS_W0IN + 1792 * 2048;
constexpr size_t WS_W0OUT = 11 * MiB;
constexpr size_t WS_W0GU = 13 * MiB;
constexpr size_t WS_W0DN = 24 * MiB;
constexpr size_t WS_WMEM = WS_W0DN + 1024 * 2816 * 2;
constexpr size_t WS_W1IN = 31 * MiB;
constexpr size_t WS_WV1 = 35 * MiB;
constexpr size_t WS_W1OUT = 37 * MiB - 512 * 1024;
constexpr size_t WS_HBF = 39 * MiB;
constexpr size_t WS_MEMBF = 103 * MiB;
constexpr size_t WS_MEMK = 107 * MiB;
constexpr size_t WS_MEMVT = 108 * MiB;
constexpr size_t WS_ACT = 109 * MiB;
constexpr size_t WS_ACT0 = WS_ACT;
constexpr size_t WS_V0T = WS_ACT + 112 * MiB;
constexpr size_t WS_MIX = WS_ACT + 176 * MiB;
constexpr size_t WS_HMID0 = WS_ACT;
constexpr size_t WS_ACT1 = WS_ACT;
constexpr size_t WS_V1T = WS_ACT + 128 * MiB;
constexpr size_t WS_OF = WS_ACT + 240 * MiB;
constexpr size_t WS_OB = WS_ACT + 288 * MiB;
constexpr size_t WS_GQT = WS_ACT + 336 * MiB;
constexpr size_t WS_GKDT0 = WS_ACT + 384 * MiB;
constexpr size_t WS_GKDT1 = 6 * MiB;
constexpr size_t OUT_GKT = 0, OUT_GDEC = 48 * MiB, OUT_WGU = 52 * MiB;
constexpr size_t WS_E = WS_ACT + 336 * MiB;
constexpr size_t WS_HT1 = 6 * MiB;
constexpr size_t WS_YB = WS_ACT + 240 * MiB;
constexpr size_t WS_YA = WS_ACT + 128 * MiB;
constexpr size_t WS_HMID1 = WS_ACT;
constexpr size_t WS_WGU = WS_ACT + 240 * MiB;
constexpr size_t WS_WDN = WS_ACT + 352 * MiB;
constexpr size_t WS_END = WS_ACT + 408 * MiB;
static_assert(WS_W1OUT + 2 * MiB <= WS_HBF && WS_WV1 + 768 * 2048 <= WS_W1OUT && WS_W1IN + 4 * MiB <= WS_WV1 && WS_WMEM + MiB <= WS_W1IN, "weight map");
static_assert(WS_W0GU + 11 * MiB <= WS_W0DN && WS_WV0 + 768 * 2048 <= WS_W0OUT, "weight map 2");
static_assert((size_t)SLOT_CAP * 3584 * 2 <= 240 * MiB, "hmid1");

constexpr int CW_TMO = 0, CW_CODE = 1, CW_BAR = 4096;

constexpr int RING_BYTES = 131072;
constexpr int LDSCTL_OFF = 155648, MISC_OFF = LDSCTL_OFF + 320;
constexpr int LDS_BYTES = 156672;

typedef float f32x2_t __attribute__((ext_vector_type(2)));
typedef __bf16 bf16x2_t __attribute__((ext_vector_type(2)));
__device__ __forceinline__ unsigned pk2(float lo, float hi) { const f32x2_t v = {lo, hi}; const bf16x2_t b = __builtin_convertvector(v, bf16x2_t); return __builtin_bit_cast(unsigned, b); }
__device__ __forceinline__ unsigned f2bf(float f) { return pk2(f, 0.f) & 0xffffu; }
__device__ __forceinline__ float bf2f(bf16 b) { return __builtin_bit_cast(float, (unsigned)b << 16); }
__device__ __forceinline__ float bflo(unsigned u) { return __builtin_bit_cast(float, u << 16); }
__device__ __forceinline__ float bfhi(unsigned u) { return __builtin_bit_cast(float, u & 0xffff0000u); }
__device__ __forceinline__ float wave_sum(float v) {
#pragma unroll
    for (int o = 1; o < 64; o <<= 1) v += __shfl_xor(v, o);
    return v;
}
__device__ __forceinline__ float wave_max(float v) {
#pragma unroll
    for (int o = 1; o < 64; o <<= 1) v = fmaxf(v, __shfl_xor(v, o));
    return v;
}

#define XB_TMO      128
#define XB_XCNT(j)  (256  + 64 * (j))
#define XB_XSUB(j)  (1280 + 64 * (j))
#define XB_XGEN(j)  (2304 + 64 * (j))
#define XB_TOP      3328
#define XB_TOPGEN   3392
#define XCD_BAR_WORDS 3456
#define XB_SPIN_CAP (1u << 22)

__device__ __forceinline__ unsigned xb_ld(unsigned* p)              { return __hip_atomic_load(p, __ATOMIC_RELAXED, __HIP_MEMORY_SCOPE_AGENT); }
__device__ __forceinline__ unsigned xb_add(unsigned* p, unsigned v) { return __hip_atomic_fetch_add(p, v, __ATOMIC_RELAXED, __HIP_MEMORY_SCOPE_AGENT); }
__device__ __forceinline__ unsigned xb_xcc_id() { return (unsigned)__builtin_amdgcn_s_getreg((3 << 11) | 20) & 0xFu; }
#define XB_SPIN(cond, bar) do { unsigned _sp = 0; while (cond) { __builtin_amdgcn_s_sleep(1); \
    if ((++_sp & 255u) == 0u) { if (xb_ld(&(bar)[XB_TMO])) break; if (_sp > XB_SPIN_CAP) { atomicAdd(&(bar)[XB_TMO], 1u); break; } } } } while (0)

struct XcdBarrier { unsigned* bar; unsigned x; volatile LAS unsigned* st; };

__device__ __forceinline__ XcdBarrier xcd_barrier_post(unsigned* bar, volatile LAS unsigned* st) {
    XcdBarrier b; b.bar = bar; b.x = xb_xcc_id(); b.st = st;
    if (threadIdx.x == 0) (void)xb_add(&bar[XB_XCNT(b.x)], 1u);
    return b;
}
__device__ __forceinline__ void xcd_barrier_complete(unsigned* bar, unsigned x, unsigned& nloc, unsigned& nx) {
    const unsigned G = gridDim.x * gridDim.y * gridDim.z;
    unsigned sum, cnt, mine, sp = 0u;
    for (;;) {
        sum = 0u; cnt = 0u; mine = 0u;
#pragma unroll
        for (unsigned j = 0; j < 16; ++j) { const unsigned c = xb_ld(&bar[XB_XCNT(j)]); sum += c; cnt += (c > 0u) ? 1u : 0u; mine = (j == x) ? c : mine; }
        if (sum == G) break;
        __builtin_amdgcn_s_sleep(1);
        if ((++sp & 255u) == 0u) { if (xb_ld(&bar[XB_TMO])) break; if (sp > XB_SPIN_CAP) { atomicAdd(&bar[XB_TMO], 1u); break; } }
    }
    nloc = mine > 0u ? mine : 1u; nx = cnt > 0u ? cnt : 1u;
}
__device__ __forceinline__ void xcd_barrier(const XcdBarrier& b) {
    asm volatile("s_waitcnt vmcnt(0)" ::: "memory");
    __syncthreads();
    if (threadIdx.x == 0) {
        unsigned* bar = b.bar;
        __builtin_amdgcn_s_waitcnt(0);
        unsigned nloc = b.st[0], nx = b.st[1];
        if (nloc == 0u) { xcd_barrier_complete(bar, b.x, nloc, nx); b.st[0] = nloc; b.st[1] = nx; }
        const unsigned old = xb_add(&bar[XB_XSUB(b.x)], 1u);
        const unsigned gen = old / nloc;
        if (old + 1u == (gen + 1u) * nloc) {
            __builtin_amdgcn_fence(__ATOMIC_RELEASE, "agent");
            asm volatile("s_waitcnt vmcnt(0)" ::: "memory");
            const unsigned og = xb_add(&bar[XB_TOP], 1u);
            const unsigned tg = og / nx;
            if (og + 1u == (tg + 1u) * nx) xb_add(&bar[XB_TOPGEN], 1u);
            else XB_SPIN(xb_ld(&bar[XB_TOPGEN]) == tg, bar);
            __builtin_amdgcn_fence(__ATOMIC_ACQUIRE, "agent");
            xb_add(&bar[XB_XGEN(b.x)], 1u);
            asm volatile("s_waitcnt vmcnt(0)" ::: "memory");
        } else {
            XB_SPIN(xb_ld(&bar[XB_XGEN(b.x)]) == gen, bar);
            __builtin_amdgcn_fence(__ATOMIC_ACQUIRE, "agent");
            asm volatile("s_waitcnt vmcnt(0)" ::: "memory");
        }
    }
    __syncthreads();
}

struct Args { const float* in[26]; float* out; unsigned char* ws; int ph_lo, ph_hi; };
enum { I_X = 0, I_MEM, I_EN1, I_EWIN, I_RPB, I_EWOUT, I_EN2, I_EWG, I_EWU, I_EWD, I_ON1, I_OWIN, I_WGKF, I_BGKF, I_WGKB, I_BGKB, I_GNORM, I_OWOUT, I_ON2, I_WR, I_OWG, I_OWU, I_OWD, I_MNORM, I_WMKV, I_FNORM };

#define LANE() ((int)(threadIdx.x & 63u))
#define TID() ((int)threadIdx.x)
struct Frame {
    LAS unsigned char* lds;
    int wave, G, bid;
    int gw, NGW;
    unsigned char* ws;
};

constexpr float QSCALE = 0.125f * 1.4426950408889634f;
struct CvtJob { const float* W; int K, N; bf16* WT; const float* gain; int kind; };
__device__ __forceinline__ bool cvt_map(int kind, int n0, int& drow, float& scale) {
    scale = 1.0f;
    switch (kind) {
    case 0: drow = n0; return true;
    case 1: if (n0 < 768) { drow = n0; scale = QSCALE; return true; } if (n0 < 1536) { drow = n0; return true; } if (n0 >= 2304) { drow = n0 - 768; scale = QSCALE; return true; } return false;
    case 2: if (n0 >= 1536 && n0 < 2304) { drow = n0 - 1536; return true; } return false;
    case 3: drow = (n0 >> 7) * 256 + (n0 & 127); return true;
    case 4: drow = (n0 >> 7) * 256 + 128 + (n0 & 127); return true;
    case 5: if (n0 < 768) { drow = n0; return true; } if (n0 < 1536) return false; if (n0 < 2304) { drow = n0 - 768; return true; }
            if (n0 < 2336) { drow = n0 - 512; return true; } drow = n0 - 800; scale = QSCALE; return true;
    case 6: if (n0 >= 768 && n0 < 1536) { drow = n0 - 768; return true; } return false;
    default: drow = n0; return true;
    }
}
__device__ __forceinline__ unsigned pk4_fp8(float a, float b, float c, float d) { a = __builtin_amdgcn_fmed3f(a, -448.f, 448.f); b = __builtin_amdgcn_fmed3f(b, -448.f, 448.f); c = __builtin_amdgcn_fmed3f(c, -448.f, 448.f); d = __builtin_amdgcn_fmed3f(d, -448.f, 448.f);
    unsigned w = 0u; w = (unsigned)__builtin_amdgcn_cvt_pk_fp8_f32(a, b, (int)w, false); w = (unsigned)__builtin_amdgcn_cvt_pk_fp8_f32(c, d, (int)w, true); return w; }
struct CvtRegs { f32x4 v[8]; const float* gain; bf16* WT; int K, k0, drow, valid; float scale; };
__device__ __forceinline__ void cvt_load(CvtRegs& R, const CvtJob& J, int item, int lane) {
    const int nblk = J.N / 32, kb = item / nblk, nb = item % nblk, n0 = nb * 32;
    R.k0 = kb * 64; R.gain = J.gain; R.WT = J.WT; R.K = J.K;
    R.valid = cvt_map(J.kind, n0, R.drow, R.scale) ? 1 : 0;
    if (R.valid) { const float* p = J.W + (size_t)(R.k0 + 2 * (lane >> 3)) * J.N + n0 + 4 * (lane & 7);
#pragma unroll
        for (int j = 0; j < 8; ++j) R.v[j] = *(const f32x4*)(p + (size_t)(16 * (j >> 1) + (j & 1)) * J.N); }
}
__device__ __forceinline__ void cvt_load8(CvtRegs& R, const CvtJob& J, int item, int lane) {
    const int nblk = J.N / 32, kb = item / nblk, nb = item % nblk, n0 = nb * 32;
    R.k0 = kb * 64; R.gain = J.gain; R.WT = J.WT; R.K = J.K;
    R.valid = cvt_map(J.kind, n0, R.drow, R.scale) ? 1 : 0;
    if (R.valid) { const float* p = J.W + (size_t)(R.k0 + 4 * (lane >> 3)) * J.N + n0 + 4 * (lane & 7);
#pragma unroll
        for (int j = 0; j < 8; ++j) R.v[j] = *(const f32x4*)(p + (size_t)(32 * (j >> 2) + (j & 3)) * J.N); }
}
__device__ __forceinline__ void cvt_finish8(const CvtRegs& R, LAS unsigned* T, int lane, float mul) {
    if (!R.valid) return;
    const int nq = lane & 7, kr = lane >> 3;
#pragma unroll
    for (int p = 0; p < 2; ++p) { const int k = R.k0 + 32 * p + 4 * kr; float g[4];
#pragma unroll
        for (int q = 0; q < 4; ++q) g[q] = R.scale * mul * (R.gain ? R.gain[k + q] : 1.0f);
        const f32x4 a = R.v[4 * p], b = R.v[4 * p + 1], c = R.v[4 * p + 2], d = R.v[4 * p + 3]; LAS unsigned* t = T + (4 * nq) * 17 + 8 * p + kr;
        t[0] = pk4_fp8(a.x * g[0], b.x * g[1], c.x * g[2], d.x * g[3]); t[17] = pk4_fp8(a.y * g[0], b.y * g[1], c.y * g[2], d.y * g[3]);
        t[34] = pk4_fp8(a.z * g[0], b.z * g[1], c.z * g[2], d.z * g[3]); t[51] = pk4_fp8(a.w * g[0], b.w * g[1], c.w * g[2], d.w * g[3]); }
    LDS_WAIT(); asm volatile("" ::: "memory");
#pragma unroll
    for (int r = 0; r < 2; ++r) { const int n = (lane >> 2) + 16 * r, c = lane & 3; const LAS unsigned* sp = T + n * 17 + 4 * c;
        v4u o; o.x = sp[0]; o.y = sp[1]; o.z = sp[2]; o.w = sp[3];
        *(GAS v4u*)((unsigned char*)R.WT + (size_t)(R.drow + n) * R.K + R.k0 + 16 * c) = o; }
    LDS_WAIT(); asm volatile("" ::: "memory");
}
__device__ __forceinline__ void cvt_finish(const CvtRegs& R, LAS unsigned* T, int lane) {
    if (!R.valid) return;
    const int nq = lane & 7, kr = lane >> 3;
#pragma unroll
    for (int p = 0; p < 4; ++p) { const int k = R.k0 + 16 * p + 2 * kr; float g0 = R.scale, g1 = R.scale; if (R.gain) { g0 *= R.gain[k]; g1 *= R.gain[k + 1]; }
        const f32x4 a = R.v[2 * p], b = R.v[2 * p + 1]; LAS unsigned* t = T + (4 * nq) * 33 + 8 * p + kr;
        t[0] = pk2(a.x * g0, b.x * g1); t[33] = pk2(a.y * g0, b.y * g1); t[66] = pk2(a.z * g0, b.z * g1); t[99] = pk2(a.w * g0, b.w * g1); }
    LDS_WAIT(); asm volatile("" ::: "memory");
#pragma unroll
    for (int r = 0; r < 4; ++r) { const int n = (lane >> 3) + 8 * r, c = lane & 7; const LAS unsigned* sp = T + n * 33 + 4 * c;
        v4u o; o.x = sp[0]; o.y = sp[1]; o.z = sp[2]; o.w = sp[3];
        *(GAS v4u*)(R.WT + (size_t)(R.drow + n) * R.K + R.k0 + 8 * c) = o; }
    LDS_WAIT(); asm volatile("" ::: "memory");
}
__device__ __forceinline__ void rows_to_bf16(const float* X, bf16* Ob, float* rstd, int first, int nrows, int stride, int lane) {
    for (int m = first; m < nrows; m += 2 * stride) {
        const int m2 = m + stride; const bool h2 = m2 < nrows;
        const GAS f32x4* xa = (const GAS f32x4*)(X + (size_t)m * DM) + lane; const GAS f32x4* xb = (const GAS f32x4*)(X + (size_t)(h2 ? m2 : m) * DM) + lane;
        f32x4 va[4], vb[4];
#pragma unroll
        for (int j = 0; j < 4; ++j) va[j] = xa[64 * j];
#pragma unroll
        for (int j = 0; j < 4; ++j) vb[j] = xb[64 * j];
        float sa = 0.f, sb = 0.f;
#pragma unroll
        for (int j = 0; j < 4; ++j) { sa += (va[j].x * va[j].x + va[j].y * va[j].y) + (va[j].z * va[j].z + va[j].w * va[j].w); sb += (vb[j].x * vb[j].x + vb[j].y * vb[j].y) + (vb[j].z * vb[j].z + vb[j].w * vb[j].w); }
        sa = wave_sum(sa); sb = wave_sum(sb);
        GAS unsigned long long* oa = (GAS unsigned long long*)(Ob + (size_t)m * DM) + lane;
#pragma unroll
        for (int j = 0; j < 4; ++j) oa[64 * j] = (unsigned long long)pk2(va[j].x, va[j].y) | ((unsigned long long)pk2(va[j].z, va[j].w) << 32);
        if (lane == 0) rstd[m] = __builtin_amdgcn_rsqf(sa * (1.0f / DM) + EPS);
        if (h2) { GAS unsigned long long* ob = (GAS unsigned long long*)(Ob + (size_t)m2 * DM) + lane;
#pragma unroll
            for (int j = 0; j < 4; ++j) ob[64 * j] = (unsigned long long)pk2(vb[j].x, vb[j].y) | ((unsigned long long)pk2(vb[j].z, vb[j].w) << 32);
            if (lane == 0) rstd[m2] = __builtin_amdgcn_rsqf(sb * (1.0f / DM) + EPS); }
    }
}

struct Unit { int pm, pn; };
struct Sched {
    int nM, nN, nwg, G, c, K, ld, off0, off1, per;
    const char* A; const char* B; const int* bexp; size_t estride;
    __device__ void init(const void* A_, const void* B_, int K_, int nM_, int nN_, int G_, int c_, const int* bexp_ = nullptr, size_t estride_ = 0) {
        A = (const char*)A_; B = (const char*)B_; K = K_; ld = K_; nM = nM_; nN = nN_; nwg = nM * nN; G = G_; c = c_; bexp = bexp_; estride = estride_; off0 = 0; off1 = 0x7fffffff; per = G_ / 8; }
    __device__ void range(int off0_, int off1_, int per_) { off0 = off0_; off1 = off1_; per = per_; }
    __device__ bool next(int i, Unit& u) const {
        const int q = nwg / 8, r = nwg % 8, xcd = c % 8, slot = c / 8, lt = (int)((unsigned)(xcd - r) >> 31), qx = q + lt;
        if (slot >= per) return false;
        const int off = off0 + i * per + slot, lim = off1 < qx ? off1 : qx;
        if (off >= lim) return false;
        const int wgid = xcd * q + (lt ? xcd : r) + off;
        const int nig = 8 * nN, gid = wgid / nig, fm = gid * 8, gsz = (nM - fm) < 8 ? (nM - fm) : 8;
        u.pm = fm + ((wgid % nig) % gsz); u.pn = (wgid % nig) / gsz; return true;
    }
    __device__ const char* a_base(const Unit& u) const { return A + (size_t)u.pm * 512 * ld; }
    __device__ const char* b_base(const Unit& u) const { return B + (bexp ? (size_t)bexp[u.pm] * estride : (size_t)0) + (size_t)u.pn * 512 * ld; }
};

struct NoAux {};
__device__ __forceinline__ float rstd_from(const float* rss16) {
    const f32x4* p = (const f32x4*)rss16; f32x4 a = p[0], b = p[1], c = p[2], d = p[3];
    const float s = ((a.x + a.y) + (a.z + a.w)) + ((b.x + b.y) + (b.z + b.w)) + ((c.x + c.y) + (c.z + c.w)) + ((d.x + d.y) + (d.z + d.w));
    return __builtin_amdgcn_rsqf(s * (1.0f / DM) + EPS);
}
__device__ __forceinline__ float rstd_from_lds(const LAS float* rss16) {
    const LAS f32x4* p = (const LAS f32x4*)rss16; f32x4 a = p[0], b = p[1], c = p[2], d = p[3];
    const float s = ((a.x + a.y) + (a.z + a.w)) + ((b.x + b.y) + (b.z + b.w)) + ((c.x + c.y) + (c.z + c.w)) + ((d.x + d.y) + (d.z + d.w));
    return __builtin_amdgcn_rsqf(s * (1.0f / DM) + EPS);
}
constexpr int RSS_LDS_REL = 2048;
struct RowCtx { float rs[2][4]; };
template <bool RSS = false> struct EpiRowScaleT {
    static constexpr bool NEED_SS = false; static constexpr int SC_MODE = RSS ? 5 : 1; typedef RowCtx Ctx; typedef NoAux Aux;
    bf16* O; int ldc; const float* sc_src; float mul;
    __device__ __forceinline__ void begin(Ctx& c, const LAS float* sc, const LAS int*, int lr0, int, int, int) const {
#pragma unroll
        for (int ai = 0; ai < 2; ++ai)
#pragma unroll
            for (int m = 0; m < 4; ++m) c.rs[ai][m] = sc[ai * 128 + lr0 + m * 16] * mul;
    }
    __device__ __forceinline__ void load_aux(Aux&, const Ctx&, int, int, int, int, int) const {}
    __device__ __forceinline__ float apply(const Ctx& c, const Aux&, int ai, int m, int row, int pn, int c128, const float (&a)[8], const float (&b)[8]) const {
        const float s = c.rs[ai][m];
        bf16* p = O + (size_t)row * ldc + pn * 256 + c128;
        v4u w; w.x = pk2(a[0] * s, a[1] * s); w.y = pk2(a[2] * s, a[3] * s); w.z = pk2(a[4] * s, a[5] * s); w.w = pk2(a[6] * s, a[7] * s); *(v4u*)p = w;
        w.x = pk2(b[0] * s, b[1] * s); w.y = pk2(b[2] * s, b[3] * s); w.z = pk2(b[4] * s, b[5] * s); w.w = pk2(b[6] * s, b[7] * s); *(v4u*)(p + 128) = w;
        return 0.f;
    }
    __device__ __forceinline__ void row_done(int, int, int, float) const {}
};
typedef EpiRowScaleT<false> EpiRowScale;
struct ColCtx { float sa[8], sb[8]; };
template <bool RSS = false> struct EpiColScaleT {
    static constexpr bool NEED_SS = false; static constexpr int SC_MODE = RSS ? 6 : 2; typedef ColCtx Ctx; typedef NoAux Aux;
    bf16* O; int ldc; const float* sc_src;
    __device__ __forceinline__ void begin(Ctx& c, const LAS float* sc, const LAS int*, int, int, int, int c128) const {
#pragma unroll
        for (int j = 0; j < 8; ++j) { c.sa[j] = sc[c128 + j]; c.sb[j] = sc[128 + c128 + j]; }
    }
    __device__ __forceinline__ void load_aux(Aux&, const Ctx&, int, int, int, int, int) const {}
    __device__ __forceinline__ float apply(const Ctx& c, const Aux&, int, int, int row, int pn, int c128, const float (&a)[8], const float (&b)[8]) const {
        bf16* p = O + (size_t)row * ldc + pn * 256 + c128;
        v4u w; w.x = pk2(a[0] * c.sa[0], a[1] * c.sa[1]); w.y = pk2(a[2] * c.sa[2], a[3] * c.sa[3]); w.z = pk2(a[4] * c.sa[4], a[5] * c.sa[5]); w.w = pk2(a[6] * c.sa[6], a[7] * c.sa[7]); *(v4u*)p = w;
        w.x = pk2(b[0] * c.sb[0], b[1] * c.sb[1]); w.y = pk2(b[2] * c.sb[2], b[3] * c.sb[3]); w.z = pk2(b[4] * c.sb[4], b[5] * c.sb[5]); w.w = pk2(b[6] * c.sb[6], b[7] * c.sb[7]); *(v4u*)(p + 128) = w;
        return 0.f;
    }
    __device__ __forceinline__ void row_done(int, int, int, float) const {}
};
typedef EpiColScaleT<false> EpiColScale;
struct Aux4 { f32x4 v[4]; };
struct NoCtx {};
struct AuxR { f32x4 v[4]; };
struct AuxB { v4u a, b; };
__device__ __forceinline__ void unpack16(const AuxB& x, f32x4 (&v)[4]) {
    v[0] = (f32x4){bflo(x.a.x), bfhi(x.a.x), bflo(x.a.y), bfhi(x.a.y)}; v[1] = (f32x4){bflo(x.a.z), bfhi(x.a.z), bflo(x.a.w), bfhi(x.a.w)};
    v[2] = (f32x4){bflo(x.b.x), bfhi(x.b.x), bflo(x.b.y), bfhi(x.b.y)}; v[3] = (f32x4){bflo(x.b.z), bfhi(x.b.z), bflo(x.b.w), bfhi(x.b.w)}; }
template <bool F32> struct AuxSel { typedef AuxR T; };
template <> struct AuxSel<false> { typedef AuxB T; };
template <bool RF32> struct EpiResid {
    static constexpr bool NEED_SS = true; static constexpr int SC_MODE = 0; typedef NoCtx Ctx; typedef typename AuxSel<RF32>::T Aux;
    const float* R; bf16* HB; float* rss; bf16* HB2;
    __device__ __forceinline__ void begin(Ctx&, const LAS float*, const LAS int*, int, int, int, int) const {}
    __device__ __forceinline__ void load_aux(Aux& x, const Ctx&, int, int, int row, int pn, int c128) const {
        const size_t off = (size_t)row * DM + pn * 256 + c128;
        if constexpr (RF32) { const float* p = R + off; x.v[0] = *(const f32x4*)p; x.v[1] = *(const f32x4*)(p + 4); x.v[2] = *(const f32x4*)(p + 128); x.v[3] = *(const f32x4*)(p + 132); }
        else { x.a = *(const v4u*)(HB + off); x.b = *(const v4u*)(HB + off + 128); }
    }
    __device__ __forceinline__ float apply(const Ctx&, const Aux& xr, int, int, int row, int pn, int c128, const float (&a)[8], const float (&b)[8]) const {
        const size_t off = (size_t)row * DM + pn * 256 + c128;
        struct { f32x4 v[4]; } x; if constexpr (RF32) { x.v[0] = xr.v[0]; x.v[1] = xr.v[1]; x.v[2] = xr.v[2]; x.v[3] = xr.v[3]; } else unpack16(xr, x.v);
        const f32x4 h0 = {x.v[0].x + a[0], x.v[0].y + a[1], x.v[0].z + a[2], x.v[0].w + a[3]}, h1 = {x.v[1].x + a[4], x.v[1].y + a[5], x.v[1].z + a[6], x.v[1].w + a[7]};
        const f32x4 h2 = {x.v[2].x + b[0], x.v[2].y + b[1], x.v[2].z + b[2], x.v[2].w + b[3]}, h3 = {x.v[3].x + b[4], x.v[3].y + b[5], x.v[3].z + b[6], x.v[3].w + b[7]};
        v4u w; w.x = pk2(h0.x, h0.y); w.y = pk2(h0.z, h0.w); w.z = pk2(h1.x, h1.y); w.w = pk2(h1.z, h1.w); *(v4u*)(HB + off) = w; if (HB2) { v2u f; f.x = pk4_fp8(h0.x, h0.y, h0.z, h0.w); f.y = pk4_fp8(h1.x, h1.y, h1.z, h1.w); *(v2u*)((unsigned char*)HB2 + off) = f; }
        w.x = pk2(h2.x, h2.y); w.y = pk2(h2.z, h2.w); w.z = pk2(h3.x, h3.y); w.w = pk2(h3.z, h3.w); *(v4u*)(HB + off + 128) = w; if (HB2) { v2u f; f.x = pk4_fp8(h2.x, h2.y, h2.z, h2.w); f.y = pk4_fp8(h3.x, h3.y, h3.z, h3.w); *(v2u*)((unsigned char*)HB2 + off + 128) = f; }
        return ((h0.x * h0.x + h0.y * h0.y) + (h0.z * h0.z + h0.w * h0.w) + (h1.x * h1.x + h1.y * h1.y) + (h1.z * h1.z + h1.w * h1.w))
             + ((h2.x * h2.x + h2.y * h2.y) + (h2.z * h2.z + h2.w * h2.w) + (h3.x * h3.x + h3.y * h3.y) + (h3.z * h3.z + h3.w * h3.w));
    }
    __device__ __forceinline__ void row_done(int row, int pn, int wc, float ss) const { rss[(size_t)row * 16 + pn * 4 + wc] = ss; }
};
__device__ __forceinline__ float silu_mul(float g, float u) { return g * __builtin_amdgcn_rcpf(1.0f + __builtin_amdgcn_exp2f(g * -1.4426950408889634f)) * u; }
template <bool MOE, bool RSS = false> struct EpiSwiGLU {
    static constexpr bool NEED_SS = false; static constexpr int SC_MODE = MOE ? 3 : (RSS ? 5 : 1); typedef RowCtx Ctx; typedef NoAux Aux;
    bf16* Hm; int ldh; const float* sc_src; bf16* Hmt;
    __device__ __forceinline__ void begin(Ctx& c, const LAS float* sc, const LAS int* tl, int lr0, int, int, int) const {
#pragma unroll
        for (int ai = 0; ai < 2; ++ai)
#pragma unroll
            for (int m = 0; m < 4; ++m) { const int i = ai * 128 + lr0 + m * 16; float r = sc[i];
                if (MOE) { r *= 0.03125f; if (tl[i] < 0) r = 0.f; } c.rs[ai][m] = r; }
    }
    __device__ __forceinline__ void load_aux(Aux&, const Ctx&, int, int, int, int, int) const {}
    __device__ __forceinline__ float apply(const Ctx& c, const Aux&, int ai, int m, int row, int pn, int c128, const float (&a)[8], const float (&b)[8]) const {
        const float s = c.rs[ai][m]; float o[8];
#pragma unroll
        for (int j = 0; j < 8; ++j) o[j] = silu_mul(a[j] * s, b[j] * s);
        v4u w; w.x = pk2(o[0], o[1]); w.y = pk2(o[2], o[3]); w.z = pk2(o[4], o[5]); w.w = pk2(o[6], o[7]);
        if constexpr (MOE) {
            unsigned char* rp = (row >= NT) ? (unsigned char*)Hmt + (size_t)(row - NT) * ldh : (unsigned char*)Hm + (size_t)row * ldh;
            v2u f; f.x = pk4_fp8(o[0], o[1], o[2], o[3]); f.y = pk4_fp8(o[4], o[5], o[6], o[7]); *(v2u*)(rp + pn * 128 + c128) = f;
        } else *(v4u*)(Hm + (size_t)row * ldh + pn * 128 + c128) = w;
        return 0.f;
    }
    __device__ __forceinline__ void row_done(int, int, int, float) const {}
};

namespace pg8 {
constexpr int HTB = 16384, TOK_OFF = 132096, SC_OFF = 134144;
__device__ __forceinline__ int lds_byte(int r, int c) { const int st = (r >> 4) * 2 + (c >> 5), rr = r & 15, cc = c & 31, ob = rr * 64 + cc * 2; return st * 1024 + (ob ^ (((ob >> 9) & 1) << 5)); }
__device__ __forceinline__ void stage_rc(int b, int& R, int& C) { const int st = b / 1024, sb = b % 1024, swz = sb ^ (((sb >> 9) & 1) << 5); R = (st >> 1) * 16 + swz / 64; C = (st & 1) * 32 + (swz % 64) / 2; }
__device__ __forceinline__ int perm32(int rho) { const int n = rho >> 4, i = rho & 15; return 8 * (i >> 2) + 4 * n + (i & 3); }

template <class Epi>
__device__ __forceinline__ void run_epi(const Epi& E, const f32x4 (&acc)[2][2][4][2], const Unit& u, int wr, int wc, int fr, int fq, const LAS float* sc, const LAS int* tlp) {
    int row0 = u.pm * 256 + wr * 64 + fr, c128 = 32 * wc + 8 * fq;
    asm volatile("" : "+v"(row0), "+v"(c128));
    typename Epi::Ctx ctx; E.begin(ctx, sc, tlp, wr * 64 + fr, row0, u.pn, c128);
#pragma unroll
    for (int ai = 0; ai < 2; ++ai) {
        typename Epi::Aux aux[4];
#pragma unroll
        for (int m = 0; m < 4; ++m) E.load_aux(aux[m], ctx, ai, m, row0 + ai * 128 + m * 16, u.pn, c128);
#pragma unroll
        for (int m = 0; m < 4; ++m) {
            const int row = row0 + ai * 128 + m * 16;
            float a[8], b[8];
#pragma unroll
            for (int j = 0; j < 8; ++j) { a[j] = acc[ai][0][m][j >> 2][j & 3]; b[j] = acc[ai][1][m][j >> 2][j & 3]; }
            float ss = E.apply(ctx, aux[m], ai, m, row, u.pn, c128, a, b);
            if (Epi::NEED_SS) { ss += __shfl_xor(ss, 16); ss += __shfl_xor(ss, 32); if (fq == 0) E.row_done(row, u.pn, wc, ss); }
        }
    }
}

typedef int v8i __attribute__((ext_vector_type(8)));
template <class Epi, bool GATHER, bool FP8 = false>
__device__ __forceinline__ void gemm_fast(LAS unsigned char* lds, const Sched& S, const Epi& E, const int* gtok) {
    int tid = threadIdx.x; asm volatile("" : "+v"(tid));
    const int wid = __builtin_amdgcn_readfirstlane(tid >> 6), lane = tid & 63, wr = wid >> 2, wc = wid & 3, fr = lane & 15, fq = lane >> 4;
    const int K = S.ld, nt = S.K / 64;
    unsigned voffB[2], vA0[2], vA1[2], nA0[2], nA1[2]; int RA[2], CA2[2];
#pragma unroll
    for (int i = 0; i < 2; ++i) { int R, C; stage_rc(tid * 16 + i * 8192, R, C); const int Rb = (R & ~31) + perm32(R & 31);
        voffB[i] = (unsigned)(Rb * K + C) * 2u; RA[i] = R; CA2[i] = C * 2; vA0[i] = (unsigned)(R * K + C) * 2u; vA1[i] = vA0[i] + (unsigned)(128 * K * 2); nA0[i] = vA0[i]; nA1[i] = vA1[i]; }
    const size_t kstep = 128;
    const size_t hstep = (size_t)128 * K * 2;
    const unsigned ldsw = (unsigned)wid * 1024u;
    const int aoff = lds_byte(wr * 64 + fr, fq * 8), boff = lds_byte(wc * 32 + fr, fq * 8);
    LAS int* tl = (LAS int*)(lds + TOK_OFF);
#define PG8_SA(b, h) (((b) * 2 + (h)) * HTB)
#define PG8_SB(b, h) ((4 + (b) * 2 + (h)) * HTB)
#define PG8_STAGE(bufoff, gbase, voff) do { _Pragma("unroll") for (int _i = 0; _i < 2; ++_i) \
        __builtin_amdgcn_global_load_lds((const unsigned*)((const char*)(gbase) + (voff)[_i]), (LAS unsigned*)(lds + (bufoff) + ldsw + _i * 8192), 16, 0, 0); } while (0)
#define PG8_LDA(dst, b, h) do { _Pragma("unroll") for (int m = 0; m < 4; ++m) _Pragma("unroll") for (int k = 0; k < 2; ++k) dst[m][k] = *(const LAS bf16x8*)(lds + PG8_SA(b, h) + aoff + m * 2048 + k * 1024); } while (0)
#define PG8_LDB(dst, b, h) do { _Pragma("unroll") for (int n = 0; n < 2; ++n) _Pragma("unroll") for (int k = 0; k < 2; ++k) dst[n][k] = *(const LAS bf16x8*)(lds + PG8_SB(b, h) + boff + n * 2048 + k * 1024); } while (0)
#define PG8_MMA(ai, bj, At, Bt) do { __builtin_amdgcn_s_setprio(1); _Pragma("unroll") for (int m = 0; m < 4; ++m) _Pragma("unroll") for (int n = 0; n < 2; ++n) { \
        if constexpr (FP8) { const v8i b8_ = __builtin_bit_cast(v8i, __builtin_shufflevector(Bt[n][0], Bt[n][1], 0, 1, 2, 3, 4, 5, 6, 7, 8, 9, 10, 11, 12, 13, 14, 15)), a8_ = __builtin_bit_cast(v8i, __builtin_shufflevector(At[m][0], At[m][1], 0, 1, 2, 3, 4, 5, 6, 7, 8, 9, 10, 11, 12, 13, 14, 15)); \
            asm volatile("v_mfma_f32_16x16x128_f8f6f4 %0, %1, %2, %0" : "+v"(acc[ai][bj][m][n]) : "v"(b8_), "v"(a8_)); }     \
        else { _Pragma("unroll") for (int k = 0; k < 2; ++k) acc[ai][bj][m][n] = __builtin_amdgcn_mfma_f32_16x16x32_bf16(Bt[n][k], At[m][k], acc[ai][bj][m][n], 0, 0, 0); } } \
        __builtin_amdgcn_s_setprio(0); } while (0)
#define PG8_WAIT_V(n) asm volatile("s_waitcnt vmcnt(" #n ")" ::: "memory")
#define PG8_WAIT_L(n) asm volatile("s_waitcnt lgkmcnt(" #n ")" ::: "memory")
#define PG8_BAR __builtin_amdgcn_s_barrier()
#define PG8_SCHED __builtin_amdgcn_sched_barrier(0)
#define PG8_IDS_DMA(pm_, par_) do { if (wid < 4) __builtin_amdgcn_global_load_lds((const unsigned*)(gtok + (pm_) * 256 + wid * 64 + lane), (LAS unsigned*)(lds + TOK_OFF + (par_) * 1024 + wid * 256), 4, 0, 0); } while (0)
#define PG8_IDS_READ(d0, d1, par_) do { _Pragma("unroll") for (int _i = 0; _i < 2; ++_i) { int t0 = tl[(par_) * 256 + RA[_i]], t1 = tl[(par_) * 256 + 128 + RA[_i]]; t0 = t0 < 0 ? 0 : t0; t1 = t1 < 0 ? 0 : t1; \
        d0[_i] = (unsigned)t0 * (unsigned)(K * 2) + (unsigned)CA2[_i]; d1[_i] = (unsigned)t1 * (unsigned)(K * 2) + (unsigned)CA2[_i]; } } while (0)
    Unit cur, nxt; int ui = 0, par = 0;
    if (!S.next(0, cur)) return;
    f32x4 acc[2][2][4][2];
#pragma unroll
    for (int a = 0; a < 2; ++a)
#pragma unroll
        for (int b = 0; b < 2; ++b)
#pragma unroll
            for (int m = 0; m < 4; ++m)
#pragma unroll
                for (int n = 0; n < 2; ++n) acc[a][b][m][n] = (f32x4){0.f, 0.f, 0.f, 0.f};
    bf16x8 At[4][2], B0[2][2], B1[2][2];
    const char* cA = GATHER ? S.A : S.a_base(cur); const char* cB = S.b_base(cur);
    if constexpr (GATHER) { PG8_IDS_DMA(cur.pm, 0); PG8_WAIT_V(0); __syncthreads(); PG8_IDS_READ(vA0, vA1, 0); }
    PG8_STAGE(PG8_SB(0, 0), cB, voffB); PG8_STAGE(PG8_SB(0, 1), cB + hstep, voffB); PG8_STAGE(PG8_SA(0, 0), cA, vA0); PG8_STAGE(PG8_SA(0, 1), cA, vA1);
    if (wr == 1) PG8_BAR;
    PG8_WAIT_V(2); PG8_BAR;
    PG8_STAGE(PG8_SB(1, 0), cB + kstep, voffB); PG8_STAGE(PG8_SA(1, 0), cA + kstep, vA0); PG8_STAGE(PG8_SB(1, 1), cB + hstep + kstep, voffB);
    PG8_WAIT_V(6); PG8_BAR;
    for (;;) {
        const bool has_next = S.next(ui + 1, nxt);
        const char* nA = has_next ? (GATHER ? S.A : S.a_base(nxt)) : cA; const char* nB = has_next ? S.b_base(nxt) : cB;
        for (int t = 0; t < nt; t += 2) {
            const bool last = (t == nt - 2);
            if constexpr (GATHER) {
                if (t == nt - 4 && has_next) PG8_IDS_DMA(nxt.pm, par ^ 1);
                if (last) { if (has_next) PG8_IDS_READ(nA0, nA1, par ^ 1); else { nA0[0] = vA0[0]; nA0[1] = vA0[1]; nA1[0] = vA1[0]; nA1[1] = vA1[1]; } }
            }
            if constexpr (Epi::SC_MODE == 5 || Epi::SC_MODE == 6) {
                if (last) { const float* src_ = E.sc_src + (size_t)(Epi::SC_MODE == 5 ? cur.pm : cur.pn) * 4096 + wid * 512 + lane * 4;
                    __builtin_amdgcn_global_load_lds((const unsigned*)src_, (LAS unsigned*)(lds + SC_OFF + RSS_LDS_REL + wid * 2048), 16, 0, 0);
                    __builtin_amdgcn_global_load_lds((const unsigned*)(src_ + 256), (LAS unsigned*)(lds + SC_OFF + RSS_LDS_REL + wid * 2048 + 1024), 16, 0, 0); }
            } else if constexpr (Epi::SC_MODE != 0) {
                if (last && wid < 4) { const int i_ = wid * 64 + lane; LAS unsigned* d_ = (LAS unsigned*)(lds + SC_OFF + wid * 256);
                    if constexpr (Epi::SC_MODE == 1) __builtin_amdgcn_global_load_lds((const unsigned*)(E.sc_src + cur.pm * 256 + i_), d_, 4, 0, 0);
                    if constexpr (Epi::SC_MODE == 2) __builtin_amdgcn_global_load_lds((const unsigned*)(E.sc_src + cur.pn * 256 + i_), d_, 4, 0, 0);
                    if constexpr (Epi::SC_MODE == 3) { int t_ = tl[par * 256 + i_]; t_ = t_ < 0 ? 0 : t_; __builtin_amdgcn_global_load_lds((const unsigned*)(E.sc_src + t_), d_, 4, 0, 0); }
                    if constexpr (Epi::SC_MODE == 4) { __builtin_amdgcn_global_load_lds((const unsigned*)(E.tok + cur.pm * 256 + i_), d_, 4, 0, 0);
                        __builtin_amdgcn_global_load_lds((const unsigned*)(E.w + cur.pm * 256 + i_), (LAS unsigned*)(lds + SC_OFF + 1024 + wid * 256), 4, 0, 0); } }
            }
            const char* a1 = cA + (size_t)(t + 1) * kstep;
            const char* a2 = last ? nA : cA + (size_t)(t + 2) * kstep; const char* b2 = last ? nB : cB + (size_t)(t + 2) * kstep;
            const char* a3 = a2 + kstep; const char* b3 = b2 + kstep;
            unsigned w0[2], w1[2];
            if (GATHER && last) { w0[0] = nA0[0]; w0[1] = nA0[1]; w1[0] = nA1[0]; w1[1] = nA1[1]; } else { w0[0] = vA0[0]; w0[1] = vA0[1]; w1[0] = vA1[0]; w1[1] = vA1[1]; }
            PG8_LDB(B0, 0, 0); PG8_LDB(B1, 0, 1); PG8_SCHED; PG8_LDA(At, 0, 0); PG8_STAGE(PG8_SA(1, 1), a1, vA1);
            PG8_WAIT_V(8); PG8_WAIT_L(0); PG8_BAR; PG8_MMA(0, 0, At, B0); PG8_MMA(0, 1, At, B1); PG8_BAR; PG8_SCHED;
            PG8_LDA(At, 0, 1); PG8_STAGE(PG8_SB(0, 0), b2, voffB); PG8_STAGE(PG8_SB(0, 1), b2 + hstep, voffB); PG8_STAGE(PG8_SA(0, 0), a2, w0);
            PG8_WAIT_V(8); PG8_WAIT_L(0); PG8_BAR; PG8_MMA(1, 0, At, B0); PG8_MMA(1, 1, At, B1); PG8_BAR; PG8_SCHED;
            PG8_LDB(B0, 1, 0); PG8_LDB(B1, 1, 1); PG8_SCHED; PG8_LDA(At, 1, 0); PG8_STAGE(PG8_SA(0, 1), a2, w1);
            PG8_WAIT_V(8); PG8_WAIT_L(0); PG8_BAR; PG8_MMA(0, 0, At, B0); PG8_MMA(0, 1, At, B1); PG8_BAR; PG8_SCHED;
            PG8_LDA(At, 1, 1); PG8_STAGE(PG8_SB(1, 0), b3, voffB); PG8_STAGE(PG8_SB(1, 1), b3 + hstep, voffB); PG8_STAGE(PG8_SA(1, 0), a3, w0);
            PG8_WAIT_V(8); PG8_WAIT_L(0); PG8_BAR; PG8_MMA(1, 0, At, B0); PG8_MMA(1, 1, At, B1); PG8_BAR; PG8_SCHED;
        }
        if constexpr (FP8) asm volatile("s_nop 15\n\ts_nop 15" ::: "memory");
        if (wr == 0) PG8_BAR;
        if constexpr (Epi::SC_MODE == 5 || Epi::SC_MODE == 6) {
            if (wid < 4) ((LAS float*)(lds + SC_OFF))[tid] = rstd_from_lds((const LAS float*)(lds + SC_OFF + RSS_LDS_REL) + tid * 16);
            PG8_WAIT_L(0); PG8_BAR;
        }
        run_epi(E, acc, cur, wr, wc, fr, fq, (const LAS float*)(lds + SC_OFF), (const LAS int*)(lds + TOK_OFF + par * 1024));
        if (!has_next) break;
#pragma unroll
        for (int a = 0; a < 2; ++a)
#pragma unroll
            for (int b = 0; b < 2; ++b)
#pragma unroll
                for (int m = 0; m < 4; ++m)
#pragma unroll
                    for (int n = 0; n < 2; ++n) acc[a][b][m][n] = (f32x4){0.f, 0.f, 0.f, 0.f};
        cur = nxt; cA = nA; cB = nB; ++ui;
        if constexpr (GATHER) { vA0[0] = nA0[0]; vA0[1] = nA0[1]; vA1[0] = nA1[0]; vA1[1] = nA1[1]; par ^= 1; }
        if (wr == 1) PG8_BAR;
    }
    PG8_WAIT_V(0);
    PG8_BAR;
#undef PG8_SA
#undef PG8_SB
#undef PG8_STAGE
#undef PG8_LDA
#undef PG8_LDB
#undef PG8_MMA
#undef PG8_WAIT_V
#undef PG8_WAIT_L
#undef PG8_BAR
#undef PG8_SCHED
#undef PG8_IDS_DMA
#undef PG8_IDS_READ
}
}

template <class Epi, bool GATHER, bool FP8 = false>
__device__ __forceinline__ void gemm_run(LAS unsigned char* lds, const Sched& S, const Epi& E, const int* gtok) { pg8::gemm_fast<Epi, GATHER, FP8>(lds, S, E, gtok); }

typedef short s16x4 __attribute__((ext_vector_type(4)));
template <bool NA, bool KLDS = false, int VLDS = 0, int KRS = 64>
__device__ __forceinline__ void attn16(int lane, const bf16* Q, int ldq, const bf16* Kb, int ldk, const bf16* Vt, int ldv, int ktok0, int trs, bf16* O, int ldo,
                                       const LAS float* rpb_h, int r, int r0, int jb, int band0, const LAS unsigned char* Kl = nullptr, int arow0 = 0, const LAS unsigned char* Vl = nullptr, int kb0 = 0) {
    const int qi = lane & 15, g = lane >> 4;
    bf16x8 qf[2];
#pragma unroll
    for (int ks = 0; ks < 2; ++ks) qf[ks] = *(const bf16x8*)(Q + (size_t)qi * ldq + ks * 32 + 8 * g);
    f32x4 s[16];
    const int krow = 8 * (qi >> 2) + (qi & 3);
#pragma unroll
    for (int t = 0; t < 16; ++t) {
        bf16x8 k0, k1;
        if constexpr (KLDS) {
            const int kcol = kb0 + krow + 4 * (t & 1), swz = (((kcol >> 3) & 3) << 1) | ((kcol >> 1) & 1);
            const LAS unsigned char* kb = Kl + ((arow0 + (t >> 1)) * KRS + kcol) * 128;
            k0 = *(const LAS bf16x8*)(kb + ((g ^ swz) << 4)); k1 = *(const LAS bf16x8*)(kb + (((4 + g) ^ swz) << 4));
        } else {
            const bf16* kp = Kb + (size_t)(ktok0 + (t >> 1) * trs + krow + 4 * (t & 1)) * ldk + 8 * g;
            k0 = *(const bf16x8*)kp; k1 = *(const bf16x8*)(kp + 32);
        }
        f32x4 z = {0.f, 0.f, 0.f, 0.f};
        z = __builtin_amdgcn_mfma_f32_16x16x32_bf16(k0, qf[0], z, 0, 0, 0);
        z = __builtin_amdgcn_mfma_f32_16x16x32_bf16(k1, qf[1], z, 0, 0, 0);
        s[t] = z;
        if constexpr (KLDS) { if ((t & 3) == 3) __builtin_amdgcn_sched_barrier(0); }
    }
    bf16x8 vfa[VLDS ? 1 : 4][VLDS ? 1 : 8];
    if constexpr (!VLDS) {
#pragma unroll
        for (int mt = 0; mt < 4; ++mt)
#pragma unroll
            for (int kk = 0; kk < 8; ++kk) vfa[mt][kk] = *(const bf16x8*)(Vt + (size_t)(16 * mt + qi) * ldv + ktok0 + kk * trs + 8 * g);
        __builtin_amdgcn_sched_barrier(0);
    }
    float m = -INFINITY;
    if constexpr (NA) {
        const int qc = 16 * jb + qi, cs = min(max(qc - 8, 0), 48);
        const LAS float* bp = rpb_h + (r0 - r + 7) * 31 + (band0 + 8 * g - qc + 15);
        bool ok[2][4];
#pragma unroll
        for (int hh = 0; hh < 2; ++hh)
#pragma unroll
            for (int i = 0; i < 4; ++i) { const int kc = band0 + 8 * g + 4 * hh + i; ok[hh][i] = (kc >= cs) && (kc < cs + 16); }
#pragma unroll
        for (int tq = 0; tq < 4; ++tq) {
            float bv[4][4];
#pragma unroll
            for (int tt = 0; tt < 4; ++tt)
#pragma unroll
                for (int i = 0; i < 4; ++i) { const int t = 4 * tq + tt; bv[tt][i] = bp[(t >> 1) * 31 + 4 * (t & 1) + i]; }
#pragma unroll
            for (int tt = 0; tt < 4; ++tt)
#pragma unroll
                for (int i = 0; i < 4; ++i) asm volatile("" : "+v"(bv[tt][i]));
#pragma unroll
            for (int tt = 0; tt < 4; ++tt)
#pragma unroll
                for (int i = 0; i < 4; ++i) { const int t = 4 * tq + tt;
                    const float v = ok[t & 1][i] ? s[t][i] + bv[tt][i] : -INFINITY;
                    s[t][i] = v; m = fmaxf(m, v); }
        }
    } else {
#pragma unroll
        for (int t = 0; t < 16; ++t)
#pragma unroll
            for (int i = 0; i < 4; ++i) m = fmaxf(m, s[t][i]);
    }
    m = fmaxf(m, __shfl_xor(m, 16)); m = fmaxf(m, __shfl_xor(m, 32));
    float l = 0.f;
    bf16x8 pf[8];
#pragma unroll
    for (int kk = 0; kk < 8; ++kk) {
        float p[8];
#pragma unroll
        for (int i = 0; i < 4; ++i) { p[i] = __builtin_amdgcn_exp2f(s[2 * kk][i] - m); p[4 + i] = __builtin_amdgcn_exp2f(s[2 * kk + 1][i] - m); }
#pragma unroll
        for (int i = 0; i < 8; ++i) l += p[i];
        v4u w; w.x = pk2(p[0], p[1]); w.y = pk2(p[2], p[3]); w.z = pk2(p[4], p[5]); w.w = pk2(p[6], p[7]);
        pf[kk] = __builtin_bit_cast(bf16x8, w);
    }
    l += __shfl_xor(l, 16); l += __shfl_xor(l, 32);
    const float inv = __builtin_amdgcn_rcpf(l);
#pragma unroll
    for (int mt = 0; mt < 4; ++mt) {
        f32x4 acc = {0.f, 0.f, 0.f, 0.f};
#pragma unroll
        for (int kk = 0; kk < 8; ++kk) {
            bf16x8 vf; if constexpr (VLDS == 1) vf = *(const LAS bf16x8*)(Vl + (16 * mt + qi) * 512 + (((4 * kk + g) ^ qi) << 4));
            else if constexpr (VLDS == 2) vf = *(const LAS bf16x8*)(Vl + (16 * mt + qi) * 1200 + ((arow0 + kk) * 40 + kb0 + 8 * g) * 2);
            else vf = vfa[mt][kk];
            acc = __builtin_amdgcn_mfma_f32_16x16x32_bf16(vf, pf[kk], acc, 0, 0, 0);
        }
        v2u w; w.x = pk2(acc[0] * inv, acc[1] * inv); w.y = pk2(acc[2] * inv, acc[3] * inv);
        *(v2u*)(O + (size_t)qi * ldo + 16 * mt + 4 * g) = w;
        if constexpr (VLDS) __builtin_amdgcn_sched_barrier(0);
    }
}
template <bool NA, int VMODE, int KRS>
__device__ __forceinline__ void attn16_lds(int lane, const bf16* Q, int ldq, bf16* O, int ldo, const LAS float* rpb_h, int r, int r0, int jb, int band0,
                                           const LAS unsigned char* Kl, int arow0, const LAS unsigned char* Vl, int kb0) {
    const int qi = lane & 15, g = lane >> 4;
    bf16x8 qf[2];
#pragma unroll
    for (int ks = 0; ks < 2; ++ks) qf[ks] = *(const bf16x8*)(Q + (size_t)qi * ldq + ks * 32 + 8 * g);
    const int krow = 8 * (qi >> 2) + (qi & 3);
    const LAS unsigned char* kbase[2][2];
#pragma unroll
    for (int e = 0; e < 2; ++e) { const int kcol = kb0 + krow + 4 * e, swz = (((kcol >> 3) & 3) << 1) | ((kcol >> 1) & 1); const LAS unsigned char* rb = Kl + (arow0 * KRS + kcol) * 128;
        kbase[e][0] = rb + ((g ^ swz) << 4); kbase[e][1] = rb + (((4 + g) ^ swz) << 4); }
#define A16_KFR(t, hh) (*(const LAS bf16x8*)(kbase[(t) & 1][hh] + ((t) >> 1) * (KRS * 128)))
    const LAS unsigned char* vbase[VMODE == 1 ? 8 : 1];
    if constexpr (VMODE == 1) {
#pragma unroll
        for (int kk = 0; kk < 8; ++kk) vbase[kk] = Vl + qi * 512 + (((4 * kk + g) ^ qi) << 4);
    } else vbase[0] = Vl + qi * 1200 + (arow0 * 40 + kb0 + 8 * g) * 2;
#define A16_VFR(mt, kk) (VMODE == 1 ? *(const LAS bf16x8*)(vbase[VMODE == 1 ? (kk) : 0] + (mt) * 8192) : *(const LAS bf16x8*)(vbase[0] + (mt) * 19200 + (kk) * 80))
    f32x4 s[16];
    bf16x8 kb[2][4][2];
    float bv[NA ? 16 : 1][4];
    const LAS float* bp = nullptr;
    if constexpr (NA) { const int qc = 16 * jb + qi; bp = rpb_h + (r0 - r + 7) * 31 + (band0 + 8 * g - qc + 15); }
#pragma unroll
    for (int tt = 0; tt < 4; ++tt) { kb[0][tt][0] = A16_KFR(tt, 0); kb[0][tt][1] = A16_KFR(tt, 1); }
#pragma unroll
    for (int gi = 0; gi < 4; ++gi) {
        if (gi < 3) {
#pragma unroll
            for (int tt = 0; tt < 4; ++tt) { kb[(gi + 1) & 1][tt][0] = A16_KFR(4 * (gi + 1) + tt, 0); kb[(gi + 1) & 1][tt][1] = A16_KFR(4 * (gi + 1) + tt, 1); }
        } else if constexpr (NA) {
#pragma unroll
            for (int t = 0; t < 16; ++t)
#pragma unroll
                for (int i = 0; i < 4; ++i) bv[t][i] = bp[(t >> 1) * 31 + 4 * (t & 1) + i];
        }
        __builtin_amdgcn_sched_barrier(0);
#pragma unroll
        for (int tt = 0; tt < 4; ++tt) { const f32x4 z = {0.f, 0.f, 0.f, 0.f}; s[4 * gi + tt] = __builtin_amdgcn_mfma_f32_16x16x32_bf16(kb[gi & 1][tt][0], qf[0], z, 0, 0, 0); }
#pragma unroll
        for (int tt = 0; tt < 4; ++tt) s[4 * gi + tt] = __builtin_amdgcn_mfma_f32_16x16x32_bf16(kb[gi & 1][tt][1], qf[1], s[4 * gi + tt], 0, 0, 0);
        __builtin_amdgcn_sched_barrier(0);
    }
    bf16x8 vb[2][8];
#pragma unroll
    for (int kk = 0; kk < 8; ++kk) vb[0][kk] = A16_VFR(0, kk);
    __builtin_amdgcn_sched_barrier(0);
    float m = -INFINITY;
    if constexpr (NA) {
        const int qc = 16 * jb + qi, cs = min(max(qc - 8, 0), 48);
        bool ok[2][4];
#pragma unroll
        for (int hh = 0; hh < 2; ++hh)
#pragma unroll
            for (int i = 0; i < 4; ++i) { const int kc = band0 + 8 * g + 4 * hh + i; ok[hh][i] = (kc >= cs) && (kc < cs + 16); }
#pragma unroll
        for (int t = 0; t < 16; ++t)
#pragma unroll
            for (int i = 0; i < 4; ++i) asm volatile("" : "+v"(bv[t][i]));
#pragma unroll
        for (int t = 0; t < 16; ++t)
#pragma unroll
            for (int i = 0; i < 4; ++i) { const float v = ok[t & 1][i] ? s[t][i] + bv[t][i] : -INFINITY; s[t][i] = v; m = fmaxf(m, v); }
    } else {
#pragma unroll
        for (int t = 0; t < 16; ++t)
#pragma unroll
            for (int i = 0; i < 4; ++i) m = fmaxf(m, s[t][i]);
    }
    m = fmaxf(m, __shfl_xor(m, 16)); m = fmaxf(m, __shfl_xor(m, 32));
    float l = 0.f;
    bf16x8 pf[8];
#pragma unroll
    for (int kk = 0; kk < 8; ++kk) {
        float p[8];
#pragma unroll
        for (int i = 0; i < 4; ++i) { p[i] = __builtin_amdgcn_exp2f(s[2 * kk][i] - m); p[4 + i] = __builtin_amdgcn_exp2f(s[2 * kk + 1][i] - m); }
#pragma unroll
        for (int i = 0; i < 8; ++i) l += p[i];
        v4u w; w.x = pk2(p[0], p[1]); w.y = pk2(p[2], p[3]); w.z = pk2(p[4], p[5]); w.w = pk2(p[6], p[7]);
        pf[kk] = __builtin_bit_cast(bf16x8, w);
    }
    l += __shfl_xor(l, 16); l += __shfl_xor(l, 32);
    const float inv = __builtin_amdgcn_rcpf(l);
    __builtin_amdgcn_sched_barrier(0);
#pragma unroll
    for (int mt = 0; mt < 4; ++mt) {
        if (mt < 3) {
#pragma unroll
            for (int kk = 0; kk < 8; ++kk) vb[(mt + 1) & 1][kk] = A16_VFR(mt + 1, kk);
        }
        __builtin_amdgcn_sched_barrier(0);
        f32x4 a0 = {0.f, 0.f, 0.f, 0.f}, a1 = {0.f, 0.f, 0.f, 0.f};
#pragma unroll
        for (int kk = 0; kk < 8; kk += 2) { a0 = __builtin_amdgcn_mfma_f32_16x16x32_bf16(vb[mt & 1][kk], pf[kk], a0, 0, 0, 0); a1 = __builtin_amdgcn_mfma_f32_16x16x32_bf16(vb[mt & 1][kk + 1], pf[kk + 1], a1, 0, 0, 0); }
        v2u w; w.x = pk2((a0[0] + a1[0]) * inv, (a0[1] + a1[1]) * inv); w.y = pk2((a0[2] + a1[2]) * inv, (a0[3] + a1[3]) * inv);
        *(v2u*)(O + (size_t)qi * ldo + 16 * mt + 4 * g) = w;
        __builtin_amdgcn_sched_barrier(0);
    }
#undef A16_KFR
#undef A16_VFR
}
__device__ __forceinline__ void memkv_item(int it, int lane, const bf16* membf, const bf16* wt, const float* mrstd, bf16* memk, bf16* memvt) {
    const int rt = it >> 4, ctile = it & 15, qi = lane & 15, g = lane >> 4, row0 = rt * 16, col0 = ctile * 32;
    const bf16* ap = membf + (size_t)(row0 + qi) * DM + 8 * g; const bf16* bp = wt + (size_t)(col0 + qi) * DM + 8 * g;
    f32x4 acc0 = {0.f, 0.f, 0.f, 0.f}, acc1 = {0.f, 0.f, 0.f, 0.f};
    const bool isk = col0 < 256;
#pragma unroll 8
    for (int ks = 0; ks < 32; ++ks) {
        const bf16x8 a = *(const bf16x8*)(ap + 32 * ks), b0 = *(const bf16x8*)(bp + 32 * ks), b1 = *(const bf16x8*)(bp + 16 * DM + 32 * ks);
        if (isk) { acc0 = __builtin_amdgcn_mfma_f32_16x16x32_bf16(b0, a, acc0, 0, 0, 0); acc1 = __builtin_amdgcn_mfma_f32_16x16x32_bf16(b1, a, acc1, 0, 0, 0); }
        else { acc0 = __builtin_amdgcn_mfma_f32_16x16x32_bf16(a, b0, acc0, 0, 0, 0); acc1 = __builtin_amdgcn_mfma_f32_16x16x32_bf16(a, b1, acc1, 0, 0, 0); }
    }
    if (isk) {
        const float s = mrstd[row0 + qi]; bf16* p = memk + (size_t)(row0 + qi) * 256 + col0 + 4 * g;
        v2u w; w.x = pk2(acc0[0] * s, acc0[1] * s); w.y = pk2(acc0[2] * s, acc0[3] * s); *(v2u*)p = w;
        w.x = pk2(acc1[0] * s, acc1[1] * s); w.y = pk2(acc1[2] * s, acc1[3] * s); *(v2u*)(p + 16) = w;
    } else {
        const f32x4 s = *(const f32x4*)(mrstd + row0 + 4 * g); bf16* p = memvt + (size_t)(col0 - 256 + qi) * MEM_ROWS + row0 + 4 * g;
        v2u w; w.x = pk2(acc0[0] * s[0], acc0[1] * s[1]); w.y = pk2(acc0[2] * s[2], acc0[3] * s[3]); *(v2u*)p = w;
        w.x = pk2(acc1[0] * s[0], acc1[1] * s[1]); w.y = pk2(acc1[2] * s[2], acc1[3] * s[3]); *(v2u*)(p + (size_t)16 * MEM_ROWS) = w;
    }
}
__device__ __forceinline__ void memattn_strip(const Frame& F, int item, const bf16* act, int ld, int qoff, const bf16* memk, const bf16* memvt, bf16* mix) {
    const int tg = item & 15, h = (item >> 4) & 3, b = item >> 6, lane = LANE(), wave = F.wave;
    LAS unsigned char* Kl = F.lds; LAS unsigned char* Vl = F.lds + 32768;
#pragma unroll
    for (int j = 0; j < 4; ++j) {
        const int p = (wave * 4 + j) * 64 + lane, key = p >> 3, kpos = p & 7, kc = key & 31, swz = (((kc >> 3) & 3) << 1) | ((kc >> 1) & 1);
        __builtin_amdgcn_global_load_lds((const unsigned*)(memk + (size_t)(b * 256 + key) * 256 + h * 64 + ((kpos ^ swz) << 3)), (LAS unsigned*)(Kl + (wave * 4 + j) * 1024), 16, 0, 0);
        const int d = p >> 5, vpos = p & 31;
        __builtin_amdgcn_global_load_lds((const unsigned*)(memvt + (size_t)(h * 64 + d) * MEM_ROWS + b * 256 + ((vpos ^ (d & 15)) << 3)), (LAS unsigned*)(Vl + (wave * 4 + j) * 1024), 16, 0, 0);
    }
    asm volatile("s_waitcnt vmcnt(0)\n\ts_barrier" ::: "memory");
#pragma unroll 1
    for (int u = 0; u < 2; ++u) {
        const int tok0 = b * SEQ + tg * 256 + (wave * 2 + u) * 16;
        attn16_lds<false, 1, 32>(lane, act + (size_t)tok0 * ld + qoff + h * 64, ld, mix + (size_t)tok0 * DM + 768 + h * 64, DM, nullptr, 0, 0, 0, 0, Kl, 0, Vl, 0);
    }
    asm volatile("s_waitcnt lgkmcnt(0)\n\ts_barrier" ::: "memory");
}
__device__ __forceinline__ void memattn_item(int it, int lane, const bf16* act, int ld, int qoff, const bf16* memk, const bf16* memvt, bf16* mix) {
    const int tb = it >> 2, h = it & 3, tok0 = tb * 16, b = tok0 >> 12;
    attn16<false>(lane, act + (size_t)tok0 * ld + qoff + h * 64, ld, memk + h * 64, 256, memvt + (size_t)(h * 64) * MEM_ROWS, MEM_ROWS, b * 256, 32,
                  mix + (size_t)tok0 * DM + 768 + h * 64, DM, nullptr, 0, 0, 0, 0);
}
constexpr int NA_RPB_OFF = 122880;
__device__ __forceinline__ void na_strip(const Frame& F, int item, const bf16* act0, const bf16* v0t, bf16* mix) {
    const int s8 = item & 7, h = (item >> 3) % 12, b = (item >> 3) / 12, lane = LANE(), wave = F.wave;
    const int R0 = 8 * s8, rowbase = min(max(R0 - 4, 0), 56), rowend = min(max(R0 + 7 - 4, 0), 56) + 8, nrows = rowend - rowbase;
    LAS unsigned char* Kl = F.lds;
    {
        const int col = wave * 8 + (lane >> 3), pos = lane & 7, swz = (((col >> 3) & 3) << 1) | ((col >> 1) & 1);
        const bf16* src = act0 + (size_t)(b * SEQ + rowbase * 64 + col) * A0_LD + 768 + h * 64 + ((pos ^ swz) << 3);
        for (int j = 0; j < nrows; ++j)
            __builtin_amdgcn_global_load_lds((const unsigned*)(src + (size_t)j * 64 * A0_LD), (LAS unsigned*)(Kl + j * 8192 + wave * 1024), 16, 0, 0);
    }
    asm volatile("s_waitcnt vmcnt(0)\n\ts_barrier" ::: "memory");
    const int r = R0 + wave, r0 = min(max(r - 4, 0), 56);
    const LAS float* rpb = (const LAS float*)(F.lds + NA_RPB_OFF) + h * 465;
#pragma unroll 1
    for (int jb = 0; jb < 4; ++jb) {
        const int band0 = min(max(jb * 16 - 8, 0), 32), tok0 = b * SEQ + r * 64 + jb * 16;
        attn16<true, true>(lane, act0 + (size_t)tok0 * A0_LD + h * 64, A0_LD, nullptr, 0, v0t + (size_t)(h * 64) * NT, NT, b * SEQ + r0 * 64 + band0, 64,
                           mix + (size_t)tok0 * DM + h * 64, DM, rpb, r, r0, jb, band0, Kl, r0 - rowbase, nullptr, band0);
    }
    asm volatile("s_waitcnt lgkmcnt(0)\n\ts_barrier" ::: "memory");
}
constexpr int NAH_V = 76800, NAH_RPB = 153600;
__device__ __forceinline__ void na_hstrip(const Frame& F, int item, const bf16* act0, const bf16* v0t, const float* rpb_g, bf16* mix) {
    const int half = item & 1, s8 = (item >> 1) & 7, h = (item >> 4) % 12, b = (item >> 4) / 12, lane = LANE(), wave = F.wave;
    const int R0 = 8 * s8, rowbase = min(max(R0 - 4, 0), 56), rowend = min(max(R0 + 7 - 4, 0), 56) + 8, nrows = rowend - rowbase, cb0 = half ? 24 : 0;
    LAS unsigned char* Kl = F.lds; LAS unsigned char* Vl = F.lds + NAH_V; LAS float* rl = (LAS float*)(F.lds + NAH_RPB);
    {
        const int pos = lane & 7, nk = nrows * 5 - 1;
#pragma unroll
        for (int i = 0; i < 10; ++i) { const int k = min(wave + NWAVES * i, 74), idx = min(k, nk);
            { const int j = idx / 5, q = idx - 5 * j, lc = q * 8 + (lane >> 3), swz = (((lc >> 3) & 3) << 1) | ((lc >> 1) & 1);
              __builtin_amdgcn_global_load_lds((const unsigned*)(act0 + (size_t)(b * SEQ + (rowbase + j) * 64 + cb0 + lc) * A0_LD + 768 + h * 64 + ((pos ^ swz) << 3)), (LAS unsigned*)(Kl + idx * 1024), 16, 0, 0); }
            { const int G = k * 64 + lane, d = G / 75, rem = G - 75 * d, j0 = rem / 5, gc = rem - 5 * j0, j = min(j0, nrows - 1);
              __builtin_amdgcn_global_load_lds((const unsigned*)(v0t + (size_t)(h * 64 + d) * NT + b * SEQ + (rowbase + j) * 64 + cb0 + gc * 8), (LAS unsigned*)(Vl + k * 1024), 16, 0, 0); } }
    }
    float bias = 0.f; if (TID() < 465) bias = rpb_g[h * 465 + TID()];
    asm volatile("" : "+v"(bias));
    bias *= 1.4426950408889634f;
    if (TID() < 465) rl[TID()] = bias;
    asm volatile("s_waitcnt vmcnt(0) lgkmcnt(0)\n\ts_barrier" ::: "memory");
    const int r = R0 + wave, r0 = min(max(r - 4, 0), 56);
#pragma unroll 1
    for (int u = 0; u < 2; ++u) {
        const int jb = 2 * half + u, band0 = min(max(jb * 16 - 8, 0), 32), tok0 = b * SEQ + r * 64 + jb * 16;
        attn16_lds<true, 2, 40>(lane, act0 + (size_t)tok0 * A0_LD + h * 64, A0_LD, mix + (size_t)tok0 * DM + h * 64, DM, rl, r, r0, jb, band0, Kl, r0 - rowbase, Vl, band0 - cb0);
    }
    asm volatile("s_waitcnt lgkmcnt(0)\n\ts_barrier" ::: "memory");
}
__device__ __forceinline__ void na_item(int it, int lane, const bf16* act0, const bf16* v0t, const LAS float* rpb, bf16* mix) {
    const int jb = it & 3, h = (it >> 2) % 12, br = (it >> 2) / 12, r = br & 63, b = br >> 6;
    const int r0 = min(max(r - 4, 0), 56), band0 = min(max(jb * 16 - 8, 0), 32);
    const int tok0 = b * SEQ + r * 64 + jb * 16;
    attn16<true>(lane, act0 + (size_t)tok0 * A0_LD + h * 64, A0_LD, act0 + 768 + h * 64, A0_LD, v0t + (size_t)(h * 64) * NT, NT, b * SEQ + r0 * 64 + band0, 64,
                 mix + (size_t)tok0 * DM + h * 64, DM, rpb + h * 465, r, r0, jb, band0);
}

constexpr int GP_LD = 392;
__device__ __forceinline__ void gla_pre_w(int wave, int lane, const float* W, const float* Bi, bf16x8 (&wfr)[3], float (&bias)[3]) {
    const int qi = lane & 15, g = lane >> 4;
#pragma unroll
    for (int jj = 0; jj < 3; ++jj) {
        const int j = 16 * (wave + 8 * jj) + qi;
        v4u wu = {0u, 0u, 0u, 0u};
        if (g < 2) { const float* wp = W + (size_t)(8 * g) * 384 + j;
            wu.x = pk2(wp[0], wp[384]); wu.y = pk2(wp[768], wp[1152]); wu.z = pk2(wp[1536], wp[1920]); wu.w = pk2(wp[2304], wp[2688]); }
        wfr[jj] = __builtin_bit_cast(bf16x8, wu); bias[jj] = Bi[j];
    }
}
__device__ __forceinline__ void gla_pre_item(const Frame& F, int item, const bf16* act1, const bf16x8 (&wfr)[3], const float (&bias)[3], bf16* QT, bf16* KT, bf16* KDT, float* DEC) {
    const int n = item & 63, dir = (item >> 6) & 1, b = item >> 7, base = b * SEQ + n * 64;
    const int tid = TID(), lane = LANE(), wave = F.wave, qi = lane & 15, g = lane >> 4;
    LAS bf16* EL = (LAS bf16*)F.lds; LAS bf16* KDL = EL + 64 * GP_LD;
    bf16x8 zf[4];
#pragma unroll
    for (int ct = 0; ct < 4; ++ct) { const int c = 16 * ct + qi, tok = dir ? base + 63 - c : base + c;
        bf16x8 z = {0, 0, 0, 0, 0, 0, 0, 0}; if (g < 2) z = *(const bf16x8*)(act1 + (size_t)tok * A1_LD + 1792 + dir * 16 + 8 * g); zf[ct] = z; }
    v4u q8a[6], k8a[6];
#pragma unroll
    for (int k = 0; k < 6; ++k) { const int idx = tid + 512 * k, c = idx / 48, jg = idx % 48; const bf16* arow = act1 + (size_t)(base + c) * A1_LD + 8 * jg; q8a[k] = *(const v4u*)arow; k8a[k] = *(const v4u*)(arow + 384); }
#pragma unroll
    for (int jj = 0; jj < 3; ++jj) {
        const int j = 16 * (wave + 8 * jj) + qi;
        float p[4][4], a[4], t1[4], t2[4], tot[4];
#pragma unroll
        for (int ct = 0; ct < 4; ++ct) {
            f32x4 d = {0.f, 0.f, 0.f, 0.f};
            d = __builtin_amdgcn_mfma_f32_16x16x32_bf16(zf[ct], wfr[jj], d, 0, 0, 0);
#pragma unroll
            for (int i = 0; i < 4; ++i) { const float x = d[i] + bias[jj];
                p[ct][i] = (fminf(x, 0.f) * 1.4426950408889634f - __builtin_amdgcn_logf(1.0f + __builtin_amdgcn_exp2f(fabsf(x) * -1.4426950408889634f))) * 0.0625f; }
            p[ct][1] += p[ct][0]; p[ct][2] += p[ct][1]; p[ct][3] += p[ct][2]; a[ct] = p[ct][3];
        }
#pragma unroll
        for (int ct = 0; ct < 4; ++ct) t1[ct] = __shfl_up(a[ct], 16);
#pragma unroll
        for (int ct = 0; ct < 4; ++ct) if (g >= 1) a[ct] += t1[ct];
#pragma unroll
        for (int ct = 0; ct < 4; ++ct) t2[ct] = __shfl_up(a[ct], 32);
#pragma unroll
        for (int ct = 0; ct < 4; ++ct) if (g >= 2) a[ct] += t2[ct];
#pragma unroll
        for (int ct = 0; ct < 4; ++ct) tot[ct] = __shfl(a[ct], 48 + qi);
        float carry = 0.f;
#pragma unroll
        for (int ct = 0; ct < 4; ++ct) {
            const float excl = a[ct] - p[ct][3] + carry;
            carry += tot[ct];
#pragma unroll
            for (int i = 0; i < 4; ++i) { const int c = 16 * ct + 4 * g + i, ctok = dir ? 63 - c : c; EL[ctok * GP_LD + j] = (bf16)f2bf(__builtin_amdgcn_exp2f(excl + p[ct][i])); }
        }
    }
    __syncthreads();
    const int clast = dir ? 0 : 63;
#pragma unroll
    for (int k = 0; k < 6; ++k) {
        const int idx = tid + 512 * k, c = idx / 48, jg = idx % 48;
        const v4u q8 = q8a[k], k8 = k8a[k];
        const v4u e8 = *(const LAS v4u*)(EL + c * GP_LD + 8 * jg), l8 = *(const LAS v4u*)(EL + clast * GP_LD + 8 * jg);
        const unsigned qa[4] = {q8.x, q8.y, q8.z, q8.w}, ka[4] = {k8.x, k8.y, k8.z, k8.w}, ea[4] = {e8.x, e8.y, e8.z, e8.w}, la[4] = {l8.x, l8.y, l8.z, l8.w};
        unsigned qo[4], ko[4], dq[4];
        float lf[8];
#pragma unroll
        for (int i = 0; i < 4; ++i) {
            const float e0 = bflo(ea[i]), e1 = bfhi(ea[i]), i0 = __builtin_amdgcn_rcpf(e0), i1 = __builtin_amdgcn_rcpf(e1);
            const float kt0 = bflo(ka[i]) * i0, kt1 = bfhi(ka[i]) * i1; lf[2 * i] = bflo(la[i]); lf[2 * i + 1] = bfhi(la[i]);
            qo[i] = pk2(bflo(qa[i]) * 0.10206207261596575f * e0, bfhi(qa[i]) * 0.10206207261596575f * e1);
            ko[i] = pk2(kt0, kt1); dq[i] = pk2(kt0 * lf[2 * i], kt1 * lf[2 * i + 1]);
        }
        v4u w; w.x = qo[0]; w.y = qo[1]; w.z = qo[2]; w.w = qo[3]; *(v4u*)(QT + (size_t)(base + c) * 384 + 8 * jg) = w;
        w.x = ko[0]; w.y = ko[1]; w.z = ko[2]; w.w = ko[3]; *(v4u*)(KT + (size_t)(base + c) * 384 + 8 * jg) = w;
        w.x = dq[0]; w.y = dq[1]; w.z = dq[2]; w.w = dq[3]; *(LAS v4u*)(KDL + c * GP_LD + 8 * jg) = w;
        if (c == clast) { float* dp = DEC + (size_t)((b * 4 + jg / 12) * 64 + n) * 96 + (jg % 12) * 8;
            *(f32x4*)dp = (f32x4){lf[0], lf[1], lf[2], lf[3]}; *(f32x4*)(dp + 4) = (f32x4){lf[4], lf[5], lf[6], lf[7]}; }
    }
    __syncthreads();
#pragma unroll 2
    for (int k = 0; k < 6; ++k) {
        const int idx = tid + 512 * k, j = idx % 384, cg = idx / 384, h = j / 96, d = j % 96;
        const LAS bf16* sp = KDL + (8 * cg) * GP_LD + j;
        v4u w; w.x = (unsigned)sp[0] | ((unsigned)sp[GP_LD] << 16); w.y = (unsigned)sp[2 * GP_LD] | ((unsigned)sp[3 * GP_LD] << 16);
        w.z = (unsigned)sp[4 * GP_LD] | ((unsigned)sp[5 * GP_LD] << 16); w.w = (unsigned)sp[6 * GP_LD] | ((unsigned)sp[7 * GP_LD] << 16);
        *(v4u*)(KDT + ((size_t)((b * 4 + h) * 64 + n) * 96 + d) * 64 + 8 * cg) = w;
    }
    __syncthreads();
}
constexpr int GL_QT = 0, GL_KT = 13312, GL_KDT = 26624, GL_VT = 40960, GL_DEC = 48128, GL_BUF = 49152;
__device__ __forceinline__ void gla_main_item(const Frame& F, int item, const bf16* QTa, const bf16* KTa, const bf16* KDT0, const bf16* KDT1, const float* DECa, const bf16* v1t, bf16* OFp, bf16* OBp,
                                              const float* cwg, const float* cwu, const float* cgain, unsigned char* c8) {
    const int vs = item & 3, dir = (item >> 2) & 1, h = (item >> 3) & 3, b = item >> 5;
    const int lane = LANE(), wave = F.wave, qi = lane & 15, g = lane >> 4, ct = wave & 3, vh = wave >> 2;
    bf16* O = dir ? OBp : OFp;
    LAS unsigned char* L = F.lds;
    unsigned off[6];
#pragma unroll
    for (int jj = 0; jj < 6; ++jj) { const int k = wave + 8 * jj; unsigned o;
        if (k < 26) { const int gi = (k < 13 ? k : k - 13) * 64 + lane, row = gi / 13, col = gi % 13; o = (unsigned)(row * 768 + (col < 12 ? col * 16 : 0)); }
        else if (k < 40) { const int gi = (k - 26) * 64 + lane, row = gi / 9, col = gi % 9; o = (gi < 864) ? (unsigned)(row * 128 + (col < 8 ? col * 16 : 0)) : 0u; }
        else if (k < 47) { const int gi = (k - 40) * 64 + lane, row = gi / 9, col = gi % 9; o = (gi < 432) ? (unsigned)(row * NT * 2 + (col < 8 ? col * 16 : 0)) : 0u; }
        else o = (lane < 24) ? (unsigned)(lane * 16) : 0u;
        off[jj] = o; }
    const char* qtb = (const char*)(QTa + (size_t)dir * NT * 384 + h * 96); const char* ktb = (const char*)(KTa + (size_t)dir * NT * 384 + h * 96);
    const char* kdb = (const char*)(dir ? KDT1 : KDT0) + (size_t)((b * 4 + h) * 64) * 12288; const char* deb = (const char*)(DECa + (size_t)dir * 8 * 4 * 64 * 96 + (size_t)((b * 4 + h) * 64) * 96);
    const char* vtb = (const char*)(v1t + (size_t)(h * 192 + vs * 48) * NT);
#define GL_DMA(n_, bufo_) do { const int nn_ = dir ? 63 - (n_) : (n_); const size_t tb_ = (size_t)(b * SEQ + nn_ * 64); \
        _Pragma("unroll") for (int jj_ = 0; jj_ < 6; ++jj_) { const int k_ = wave + 8 * jj_; \
            const char* src_ = k_ < 13 ? qtb + tb_ * 768 : (k_ < 26 ? ktb + tb_ * 768 : (k_ < 40 ? kdb + (size_t)nn_ * 12288 : (k_ < 47 ? vtb + tb_ * 2 : deb + (size_t)nn_ * 384))); \
            __builtin_amdgcn_global_load_lds((const unsigned*)(src_ + off[jj_]), (LAS unsigned*)(L + (bufo_) + k_ * 1024), 16, 0, 0); } } while (0)
    constexpr int GL_SB = 2 * GL_BUF;
    int oT[3]; bool oV[3];
#pragma unroll
    for (int j = 0; j < 3; ++j) { if (wave >= 4) { oT[j] = (wave - 4) + 4 * j; oV[j] = true; } else { oV[j] = (j == 0) || (j == 1 && wave < 2); oT[j] = (j == 1 && wave < 2) ? 16 + wave : 12 + wave; } }
    f32x4 So[3];
#pragma unroll
    for (int j = 0; j < 3; ++j) So[j] = (f32x4){0.f, 0.f, 0.f, 0.f};
    unsigned km = 0u;
#pragma unroll
    for (int tp = 0; tp < 4; ++tp)
#pragma unroll
        for (int i = 0; i < 4; ++i) { const int c = 16 * ct + qi, cp = 16 * tp + 4 * g + i; if (dir ? (cp > c) : (cp <= c)) km |= 1u << (4 * tp + i); }
    for (int i = TID(); i < 18 * 512 / 8; i += NTHR) *(LAS v2u*)(L + GL_SB + i * 8) = (v2u){0u, 0u};
    GL_DMA(0, 0);
    asm volatile("s_waitcnt vmcnt(0) lgkmcnt(0)\n\ts_barrier" ::: "memory");
    f32x4 cv[8], cg[2];
#pragma unroll
    for (int j = 0; j < 8; ++j) cv[j] = (f32x4){0.f, 0.f, 0.f, 0.f};
    cg[0] = cv[0]; cg[1] = cv[0];
    LAS unsigned* CT = (LAS unsigned*)(L + GL_SB + 18432 + wave * 2304);
#pragma unroll 1
    for (int n = 0; n < 64; ++n) {
        const int bo = (n & 1) * GL_BUF;
        if (n + 1 < 64) GL_DMA(n + 1, GL_BUF - bo);
        const bool cld = ((n & 3) == 0) && (n < 56);
        if (cld) {
            const int id = F.gw + 2048 * (n >> 2), e = id / 3584, r2 = id - e * 3584, wh = r2 / 1792, it2 = r2 - wh * 1792, kb = it2 / 112, nb = it2 - kb * 112;
            const float* p = (wh ? cwu : cwg) + (size_t)e * 1024 * FFE + (size_t)(kb * 64 + 4 * (lane >> 3)) * FFE + nb * 32 + 4 * (lane & 7);
#pragma unroll
            for (int j = 0; j < 8; ++j) cv[j] = *(const f32x4*)(p + (size_t)(32 * (j >> 2) + (j & 3)) * FFE);
            cg[0] = *(const f32x4*)(cgain + kb * 64 + 4 * (lane >> 3)); cg[1] = *(const f32x4*)(cgain + kb * 64 + 32 + 4 * (lane >> 3));
        }
        LAS unsigned char* Bf = L + bo;
        const LAS unsigned char* SBr = L + GL_SB + (n & 1) * 9216; LAS unsigned char* SBw = L + GL_SB + ((n + 1) & 1) * 9216;
        bf16x8 qf[3], kf[4][3], qp[3], vf[2][2], sf[2][3];
#pragma unroll
        for (int ks = 0; ks < 3; ++ks) qf[ks] = *(const LAS bf16x8*)(Bf + GL_QT + (16 * ct + qi) * 208 + (32 * ks + 8 * g) * 2);
#pragma unroll
        for (int tp = 0; tp < 4; ++tp)
#pragma unroll
            for (int ks = 0; ks < 3; ++ks) kf[tp][ks] = *(const LAS bf16x8*)(Bf + GL_KT + (16 * tp + qi) * 208 + (32 * ks + 8 * g) * 2);
#pragma unroll
        for (int kk = 0; kk < 3; ++kk) { const LAS unsigned char* qr = Bf + GL_QT + (16 * ct + qi) * 208 + (32 * kk + 4 * g) * 2;
            const s16x4 a0 = *(const LAS s16x4*)qr, a1 = *(const LAS s16x4*)(qr + 32); qp[kk] = __builtin_shufflevector(a0, a1, 0, 1, 2, 3, 4, 5, 6, 7); }
#pragma unroll
        for (int vi = 0; vi < 2; ++vi) { const int vt = vh ? 2 : vi;
#pragma unroll
            for (int kk = 0; kk < 2; ++kk) { const LAS unsigned char* vr = Bf + GL_VT + (16 * vt + qi) * 144 + (32 * kk + 4 * g) * 2;
                const s16x4 a0 = *(const LAS s16x4*)vr, a1 = *(const LAS s16x4*)(vr + 32); vf[vi][kk] = __builtin_shufflevector(a0, a1, 0, 1, 2, 3, 4, 5, 6, 7); }
#pragma unroll
            for (int kk = 0; kk < 3; ++kk) { const LAS unsigned char* sr = SBr + (vt * 6 + 2 * kk) * 512 + lane * 8;
                const s16x4 a0 = *(const LAS s16x4*)sr, a1 = *(const LAS s16x4*)(sr + 512); sf[vi][kk] = __builtin_shufflevector(a0, a1, 0, 1, 2, 3, 4, 5, 6, 7); } }
        __builtin_amdgcn_sched_barrier(0);
        f32x4 am[4];
#pragma unroll
        for (int tp = 0; tp < 4; ++tp) {
            f32x4 z = {0.f, 0.f, 0.f, 0.f};
#pragma unroll
            for (int ks = 0; ks < 3; ++ks) z = __builtin_amdgcn_mfma_f32_16x16x32_bf16(kf[tp][ks], qf[ks], z, 0, 0, 0);
            am[tp] = z;
        }
        f32x4 dec[3]; bf16x8 kdf[3][2], vfr[3][2];
#pragma unroll
        for (int j = 0; j < 3; ++j) { const int T = oT[j], vt = T / 6, dt = T - 6 * vt;
            dec[j] = *(const LAS f32x4*)(Bf + GL_DEC + (16 * dt + 4 * g) * 4);
#pragma unroll
            for (int ks = 0; ks < 2; ++ks) { kdf[j][ks] = *(const LAS bf16x8*)(Bf + GL_KDT + (16 * dt + qi) * 144 + (32 * ks + 8 * g) * 2);
                vfr[j][ks] = *(const LAS bf16x8*)(Bf + GL_VT + (16 * vt + qi) * 144 + (32 * ks + 8 * g) * 2); } }
        __builtin_amdgcn_sched_barrier(0);
#pragma unroll
        for (int tp = 0; tp < 4; ++tp)
#pragma unroll
            for (int i = 0; i < 4; ++i) am[tp][i] = ((km >> (4 * tp + i)) & 1u) ? am[tp][i] : 0.f;
        bf16x8 pf[2];
#pragma unroll
        for (int kk = 0; kk < 2; ++kk) { v4u w; w.x = pk2(am[2 * kk][0], am[2 * kk][1]); w.y = pk2(am[2 * kk][2], am[2 * kk][3]); w.z = pk2(am[2 * kk + 1][0], am[2 * kk + 1][1]); w.w = pk2(am[2 * kk + 1][2], am[2 * kk + 1][3]);
            pf[kk] = __builtin_bit_cast(bf16x8, w); }
        const int nn = dir ? 63 - n : n, tok = b * SEQ + nn * 64 + 16 * ct + qi;
        f32x4 oacc[2];
#pragma unroll
        for (int vi = 0; vi < 2; ++vi) {
            f32x4 acc = {0.f, 0.f, 0.f, 0.f};
#pragma unroll
            for (int kk = 0; kk < 3; ++kk) acc = __builtin_amdgcn_mfma_f32_16x16x32_bf16(sf[vi][kk], qp[kk], acc, 0, 0, 0);
#pragma unroll
            for (int kk = 0; kk < 2; ++kk) acc = __builtin_amdgcn_mfma_f32_16x16x32_bf16(vf[vi][kk], pf[kk], acc, 0, 0, 0);
            oacc[vi] = acc;
        }
#pragma unroll
        for (int j = 0; j < 3; ++j) {
            f32x4 sv = So[j]; sv[0] *= dec[j][0]; sv[1] *= dec[j][1]; sv[2] *= dec[j][2]; sv[3] *= dec[j][3];
#pragma unroll
            for (int ks = 0; ks < 2; ++ks) sv = __builtin_amdgcn_mfma_f32_16x16x32_bf16(kdf[j][ks], vfr[j][ks], sv, 0, 0, 0);
            So[j] = sv;
        }
        { v2u w; w.x = pk2(oacc[0][0], oacc[0][1]); w.y = pk2(oacc[0][2], oacc[0][3]);
          *(v2u*)(O + (size_t)tok * 768 + h * 192 + vs * 48 + 16 * (vh ? 2 : 0) + 4 * g) = w; }
        if (vh == 0) { v2u w; w.x = pk2(oacc[1][0], oacc[1][1]); w.y = pk2(oacc[1][2], oacc[1][3]);
          *(v2u*)(O + (size_t)tok * 768 + h * 192 + vs * 48 + 16 + 4 * g) = w; }
#pragma unroll
        for (int j = 0; j < 3; ++j) if (oV[j]) { v2u w; w.x = pk2(So[j][0], So[j][1]); w.y = pk2(So[j][2], So[j][3]); *(LAS v2u*)(SBw + oT[j] * 512 + lane * 8) = w; }
        if (((n & 3) == 1) && (n < 57)) {
            const int id = F.gw + 2048 * (n >> 2), e = id / 3584, r2 = id - e * 3584, wh = r2 / 1792, it2 = r2 - wh * 1792, kb = it2 / 112, nb = it2 - kb * 112, n0 = nb * 32;
            unsigned char* dst = c8 + (size_t)e * 7168 * 1024 + (size_t)((n0 >> 7) * 256 + wh * 128 + (n0 & 127)) * 1024 + kb * 64;
            const int nq = lane & 7, kr = lane >> 3;
#pragma unroll
            for (int p = 0; p < 2; ++p) { const f32x4 gq = cg[p] * 32.0f;
                const f32x4 a = cv[4 * p], b2 = cv[4 * p + 1], c2 = cv[4 * p + 2], d2 = cv[4 * p + 3]; LAS unsigned* t = CT + (4 * nq) * 17 + 8 * p + kr;
                t[0] = pk4_fp8(a.x * gq[0], b2.x * gq[1], c2.x * gq[2], d2.x * gq[3]); t[17] = pk4_fp8(a.y * gq[0], b2.y * gq[1], c2.y * gq[2], d2.y * gq[3]);
                t[34] = pk4_fp8(a.z * gq[0], b2.z * gq[1], c2.z * gq[2], d2.z * gq[3]); t[51] = pk4_fp8(a.w * gq[0], b2.w * gq[1], c2.w * gq[2], d2.w * gq[3]); }
            LDS_WAIT(); asm volatile("" ::: "memory");
#pragma unroll
            for (int r = 0; r < 2; ++r) { const int nn2 = (lane >> 2) + 16 * r, c4 = lane & 3; const LAS unsigned* sp = CT + nn2 * 17 + 4 * c4;
                v4u o; o.x = sp[0]; o.y = sp[1]; o.z = sp[2]; o.w = sp[3];
                *(GAS v4u*)(dst + (size_t)nn2 * 1024 + 16 * c4) = o; }
        }
        if (cld) { if (vh) asm volatile("s_waitcnt vmcnt(11) lgkmcnt(0)\n\ts_barrier" ::: "memory"); else asm volatile("s_waitcnt vmcnt(12) lgkmcnt(0)\n\ts_barrier" ::: "memory"); }
        else { if (vh) asm volatile("s_waitcnt vmcnt(1) lgkmcnt(0)\n\ts_barrier" ::: "memory"); else asm volatile("s_waitcnt vmcnt(2) lgkmcnt(0)\n\ts_barrier" ::: "memory"); }
    }
    __syncthreads();
#undef GL_DMA
}

__device__ __forceinline__ void finalize_rstd(const Frame& F, const float* rss, float* rstd) {
    for (int row = F.bid * NTHR + TID(); row < NT; row += F.G * NTHR) rstd[row] = rstd_from(rss + (size_t)row * 16);
}
__device__ __forceinline__ void gla_combine(const Frame& F, const bf16* OF, const bf16* OB, const bf16* act1, const float* gnorm, bf16* mix) {
    const int lane = LANE(), h = lane >> 4, c0 = h * 192 + 12 * (lane & 15);
    float gn[12];
#pragma unroll
    for (int j = 0; j < 12; ++j) gn[j] = gnorm[12 * (lane & 15) + j];
    for (int token = F.gw; token < NT; token += 2 * F.NGW) {
        const int tb = token + F.NGW; const bool hb = tb < NT; const int t2 = hb ? tb : token;
        v2u fa[3], ba[3], ga[3], fb[3], bb[3], gb[3];
#pragma unroll
        for (int j = 0; j < 3; ++j) { fa[j] = *(const v2u*)(OF + (size_t)token * 768 + c0 + 4 * j); ba[j] = *(const v2u*)(OB + (size_t)token * 768 + c0 + 4 * j); ga[j] = *(const v2u*)(act1 + (size_t)token * A1_LD + 768 + c0 + 4 * j); }
#pragma unroll
        for (int j = 0; j < 3; ++j) { fb[j] = *(const v2u*)(OF + (size_t)t2 * 768 + c0 + 4 * j); bb[j] = *(const v2u*)(OB + (size_t)t2 * 768 + c0 + 4 * j); gb[j] = *(const v2u*)(act1 + (size_t)t2 * A1_LD + 768 + c0 + 4 * j); }
        float oa[12], ob[12], sa = 0.f, sb = 0.f;
#pragma unroll
        for (int j = 0; j < 3; ++j) {
            oa[4 * j] = bflo(fa[j].x) + bflo(ba[j].x); oa[4 * j + 1] = bfhi(fa[j].x) + bfhi(ba[j].x); oa[4 * j + 2] = bflo(fa[j].y) + bflo(ba[j].y); oa[4 * j + 3] = bfhi(fa[j].y) + bfhi(ba[j].y);
            ob[4 * j] = bflo(fb[j].x) + bflo(bb[j].x); ob[4 * j + 1] = bfhi(fb[j].x) + bfhi(bb[j].x); ob[4 * j + 2] = bflo(fb[j].y) + bflo(bb[j].y); ob[4 * j + 3] = bfhi(fb[j].y) + bfhi(bb[j].y); }
#pragma unroll
        for (int j = 0; j < 12; ++j) { sa += oa[j] * oa[j]; sb += ob[j] * ob[j]; }
#pragma unroll
        for (int o = 1; o < 16; o <<= 1) { sa += __shfl_xor(sa, o); sb += __shfl_xor(sb, o); }
        const float ra = __builtin_amdgcn_rsqf(sa * (1.0f / 192.0f) + EPS), rb = __builtin_amdgcn_rsqf(sb * (1.0f / 192.0f) + EPS);
#pragma unroll
        for (int j = 0; j < 3; ++j) {
            const float g0 = bflo(ga[j].x), g1 = bfhi(ga[j].x), g2 = bflo(ga[j].y), g3 = bfhi(ga[j].y);
            v2u w; w.x = pk2(oa[4 * j] * ra * gn[4 * j] * g0 * __builtin_amdgcn_rcpf(1.0f + __expf(-g0)), oa[4 * j + 1] * ra * gn[4 * j + 1] * g1 * __builtin_amdgcn_rcpf(1.0f + __expf(-g1)));
            w.y = pk2(oa[4 * j + 2] * ra * gn[4 * j + 2] * g2 * __builtin_amdgcn_rcpf(1.0f + __expf(-g2)), oa[4 * j + 3] * ra * gn[4 * j + 3] * g3 * __builtin_amdgcn_rcpf(1.0f + __expf(-g3)));
            *(v2u*)(mix + (size_t)token * DM + c0 + 4 * j) = w; }
        if (hb) {
#pragma unroll
            for (int j = 0; j < 3; ++j) {
                const float g0 = bflo(gb[j].x), g1 = bfhi(gb[j].x), g2 = bflo(gb[j].y), g3 = bfhi(gb[j].y);
                v2u w; w.x = pk2(ob[4 * j] * rb * gn[4 * j] * g0 * __builtin_amdgcn_rcpf(1.0f + __expf(-g0)), ob[4 * j + 1] * rb * gn[4 * j + 1] * g1 * __builtin_amdgcn_rcpf(1.0f + __expf(-g1)));
                w.y = pk2(ob[4 * j + 2] * rb * gn[4 * j + 2] * g2 * __builtin_amdgcn_rcpf(1.0f + __expf(-g2)), ob[4 * j + 3] * rb * gn[4 * j + 3] * g3 * __builtin_amdgcn_rcpf(1.0f + __expf(-g3)));
                *(v2u*)(mix + (size_t)tb * DM + c0 + 4 * j) = w; } }
    }
}
__device__ __forceinline__ void route_pick(const float (&acc)[8], int token, int* topi, float* topw, LAS int* lc) {
    int e0 = 0; float l0 = acc[0];
#pragma unroll
    for (int e = 1; e < 8; ++e) if (acc[e] > l0) { l0 = acc[e]; e0 = e; }
    int e1 = -1; float l1 = -INFINITY;
#pragma unroll
    for (int e = 0; e < 8; ++e) if (e != e0 && acc[e] > l1) { l1 = acc[e]; e1 = e; }
    if (e1 < 0) { e1 = (e0 + 1) & 7; l1 = l0; }
    const float w0 = 1.0f / (1.0f + __expf(l1 - l0));
    topi[token] = e0 | (e1 << 8); topw[2 * token] = w0; topw[2 * token + 1] = 1.0f - w0;
    atomicAdd((int*)&lc[e0], 1); atomicAdd((int*)&lc[8 + e1], 1);
}
__device__ __forceinline__ void route1(const Frame& F, const bf16* H, const float* gain, const float* wr, int* topi, float* topw, int* cnt, float* rstd) {
    LAS int* lc = (LAS int*)F.lds;
    if (TID() < 16) lc[TID()] = 0;
    __syncthreads();
    const int lane = LANE();
    float w[4][4][8];
#pragma unroll
    for (int j = 0; j < 4; ++j) { const f32x4 g = *(const f32x4*)(gain + 256 * j + 4 * lane);
#pragma unroll
        for (int i = 0; i < 4; ++i) { const float* p = wr + (size_t)(256 * j + 4 * lane + i) * 8; const f32x4 a = *(const f32x4*)p, b = *(const f32x4*)(p + 4); const float gi = g[i];
            w[j][i][0] = a.x * gi; w[j][i][1] = a.y * gi; w[j][i][2] = a.z * gi; w[j][i][3] = a.w * gi; w[j][i][4] = b.x * gi; w[j][i][5] = b.y * gi; w[j][i][6] = b.z * gi; w[j][i][7] = b.w * gi; } }
    for (int t2 = 0; t2 < 16; t2 += 2) {
        const int token = F.bid * 128 + F.wave * 16 + t2;
        const v2u* h0 = (const v2u*)(H + (size_t)token * DM) + lane; const v2u* h1 = h0 + DM / 4;
        f32x4 x0[4], x1[4];
#pragma unroll
        for (int j = 0; j < 4; ++j) { const v2u p = h0[64 * j], q = h1[64 * j]; x0[j] = (f32x4){bflo(p.x), bfhi(p.x), bflo(p.y), bfhi(p.y)}; x1[j] = (f32x4){bflo(q.x), bfhi(q.x), bflo(q.y), bfhi(q.y)}; }
        float a0[8], a1[8], s0 = 0.f, s1 = 0.f;
#pragma unroll
        for (int e = 0; e < 8; ++e) { a0[e] = 0.f; a1[e] = 0.f; }
#pragma unroll
        for (int j = 0; j < 4; ++j)
#pragma unroll
            for (int i = 0; i < 4; ++i) { const float u = x0[j][i], v = x1[j][i]; s0 += u * u; s1 += v * v;
#pragma unroll
                for (int e = 0; e < 8; ++e) { a0[e] += u * w[j][i][e]; a1[e] += v * w[j][i][e]; } }
        s0 = wave_sum(s0); s1 = wave_sum(s1);
        const float r0 = 1.0f / sqrtf(s0 * (1.0f / DM) + EPS), r1 = 1.0f / sqrtf(s1 * (1.0f / DM) + EPS);
#pragma unroll
        for (int e = 0; e < 8; ++e) { a0[e] = wave_sum(a0[e]) * r0; a1[e] = wave_sum(a1[e]) * r1; }
        if (lane == 0) { route_pick(a0, token, topi, topw, lc); route_pick(a1, token + 1, topi, topw, lc); rstd[token] = r0; rstd[token + 1] = r1; }
    }
    __syncthreads();
    if (TID() < 16) cnt[F.bid * 16 + TID()] = lc[TID()];
    __syncthreads();
}
__device__ __forceinline__ void route2(const Frame& F, const int* topi, const float* topw, const int* cnt, int* stok, float* sw, int* blk, int* s0tab) {
    LAS int* part = (LAS int*)F.lds;
    LAS int* base = part + 1024;
    LAS int* tk = base + 64;
    const int tid = TID(), pe = tid & 15, jg = tid >> 4;
    int below = 0, tot = 0;
    for (int w = jg; w < F.G; w += 32) { const int v = cnt[w * 16 + pe]; tot += v; if (w < F.bid) below += v; }
    part[jg * 16 + pe] = below; part[512 + jg * 16 + pe] = tot;
    if (tid < 128) tk[tid] = topi[F.bid * 128 + tid];
    __syncthreads();
    if (tid < 16) { int b = 0, t = 0; for (int j = 0; j < 32; ++j) { b += part[j * 16 + tid]; t += part[512 + j * 16 + tid]; } base[tid] = b; base[16 + tid] = t; }
    __syncthreads();
    if (tid < 2) { int ps = 0; for (int e = 0; e < 8; ++e) { base[32 + tid * 8 + e] = ps; ps += (base[16 + tid * 8 + e] + 255) / 256 * 256; } base[48 + tid] = ps / 256; }
    __syncthreads();
    if (tid < 256) {
        const int p = tid >> 7, i = tid & 127; const int e = (tk[i] >> (8 * p)) & 0xff;
        int rank = 0; for (int j = 0; j < i; ++j) rank += (((tk[j] >> (8 * p)) & 0xff) == e) ? 1 : 0;
        const int slot = base[32 + p * 8 + e] + base[p * 8 + e] + rank; const int token = F.bid * 128 + i;
        stok[p * SLOT_CAP + slot] = token; sw[p * SLOT_CAP + slot] = topw[2 * token + p]; if (p == 0) s0tab[token] = slot;
    }
    if (F.bid < 16) {
        const int p = F.bid >> 3, e = F.bid & 7, ps = base[32 + F.bid], t = base[16 + F.bid], pend = ps + (t + 255) / 256 * 256;
        for (int s = ps + t + tid; s < pend; s += NTHR) { stok[p * SLOT_CAP + s] = -1; sw[p * SLOT_CAP + s] = 0.f; }
        for (int bk = ps / 256 + tid; bk < pend / 256; bk += NTHR) blk[16 + p * 256 + bk] = e;
        if (e == 0 && tid == 0) blk[p] = base[48 + p];
    }
    __syncthreads();
}
__device__ __forceinline__ void final_norm_slots(int lane, const bf16* HB, float* OUT, const bf16* YA, const int* s0tab, const bf16* Y, const bf16* Y2, const float* gain, const int* tok, int s0, int s1, int first, int stride) {
    const f32x4* gr = (const f32x4*)gain + lane;
    for (int base = s0 + first; base < s1; base += 64 * stride) {
      const int sll = base + lane * stride; int mytok = -1; if (sll < s1) mytok = tok[sll];
      const int mys0 = s0tab[mytok < 0 ? 0 : mytok];
      const int cnt = min(64, (s1 - base + stride - 1) / stride);
      for (int i = 0; i < cnt; i += 2) {
        const int sl = base + i * stride, slb = sl + stride; const bool hb = i + 1 < cnt; const int i1 = hb ? i + 1 : i;
        const int ra = __builtin_amdgcn_readlane(mytok, i), rb = hb ? __builtin_amdgcn_readlane(mytok, i1) : -1;
        const int rowa = ra < 0 ? 0 : ra, rowb = rb < 0 ? 0 : rb;
        const v2u* xa = (const v2u*)(HB + (size_t)rowa * DM) + lane; const v2u* xb = (const v2u*)(HB + (size_t)rowb * DM) + lane;
        const v2u* ya = (const v2u*)(Y + (size_t)sl * DM) + lane; const v2u* yb = (const v2u*)(Y + (size_t)(hb ? slb : sl) * DM) + lane;
        const v2u* pa = (const v2u*)(YA + (size_t)__builtin_amdgcn_readlane(mys0, i) * DM) + lane; const v2u* pb = (const v2u*)(YA + (size_t)__builtin_amdgcn_readlane(mys0, i1) * DM) + lane;
        f32x4 va[4], vb[4]; v2u wa[4], wb[4], ua[4], ub[4], ta[4], tb[4];
#pragma unroll
        for (int j = 0; j < 4; ++j) { ua[j] = xa[64 * j]; wa[j] = ya[64 * j]; ta[j] = pa[64 * j]; }
#pragma unroll
        for (int j = 0; j < 4; ++j) { ub[j] = xb[64 * j]; wb[j] = yb[64 * j]; tb[j] = pb[64 * j]; }
#pragma unroll
        for (int j = 0; j < 4; ++j) { va[j] = (f32x4){bflo(ua[j].x) + bflo(ta[j].x), bfhi(ua[j].x) + bfhi(ta[j].x), bflo(ua[j].y) + bflo(ta[j].y), bfhi(ua[j].y) + bfhi(ta[j].y)};
            vb[j] = (f32x4){bflo(ub[j].x) + bflo(tb[j].x), bfhi(ub[j].x) + bfhi(tb[j].x), bflo(ub[j].y) + bflo(tb[j].y), bfhi(ub[j].y) + bfhi(tb[j].y)}; }
        if (Y2) {
            const v2u* za = (const v2u*)(Y2 + (size_t)(sl - s0) * DM) + lane; const v2u* zb = (const v2u*)(Y2 + (size_t)((hb ? slb : sl) - s0) * DM) + lane;
#pragma unroll
            for (int j = 0; j < 4; ++j) { const v2u p = za[64 * j], q = zb[64 * j];
                va[j].x += bflo(p.x); va[j].y += bfhi(p.x); va[j].z += bflo(p.y); va[j].w += bfhi(p.y); vb[j].x += bflo(q.x); vb[j].y += bfhi(q.x); vb[j].z += bflo(q.y); vb[j].w += bfhi(q.y); }
        }
        float sa = 0.f, sb = 0.f;
#pragma unroll
        for (int j = 0; j < 4; ++j) {
            va[j].x += bflo(wa[j].x); va[j].y += bfhi(wa[j].x); va[j].z += bflo(wa[j].y); va[j].w += bfhi(wa[j].y);
            vb[j].x += bflo(wb[j].x); vb[j].y += bfhi(wb[j].x); vb[j].z += bflo(wb[j].y); vb[j].w += bfhi(wb[j].y);
            sa += (va[j].x * va[j].x + va[j].y * va[j].y) + (va[j].z * va[j].z + va[j].w * va[j].w); sb += (vb[j].x * vb[j].x + vb[j].y * vb[j].y) + (vb[j].z * vb[j].z + vb[j].w * vb[j].w); }
        sa = wave_sum(sa); sb = wave_sum(sb);
        const float rsa = 1.0f / sqrtf(sa * (1.0f / DM) + EPS), rsb = 1.0f / sqrtf(sb * (1.0f / DM) + EPS);
        if (ra >= 0) { GAS f32x4* oa = (GAS f32x4*)(OUT + (size_t)rowa * DM) + lane;
#pragma unroll
            for (int j = 0; j < 4; ++j) { const f32x4 g = gr[64 * j]; oa[64 * j] = (f32x4){va[j].x * rsa * g.x, va[j].y * rsa * g.y, va[j].z * rsa * g.z, va[j].w * rsa * g.w}; } }
        if (rb >= 0) { GAS f32x4* ob = (GAS f32x4*)(OUT + (size_t)rowb * DM) + lane;
#pragma unroll
            for (int j = 0; j < 4; ++j) { const f32x4 g = gr[64 * j]; ob[64 * j] = (f32x4){vb[j].x * rsb * g.x, vb[j].y * rsb * g.y, vb[j].z * rsb * g.z, vb[j].w * rsb * g.w}; } }
      }
    }
}
__device__ __forceinline__ void final_norm(const Frame& F, float* H, const float* gain) {
    for (int row = F.gw; row < NT; row += F.NGW) {
        GAS f32x4* xr = (GAS f32x4*)(H + (size_t)row * DM) + LANE(); const f32x4* gr = (const f32x4*)gain + LANE();
        f32x4 v[4]; float s = 0.f;
#pragma unroll
        for (int j = 0; j < 4; ++j) { v[j] = xr[64 * j]; s += (v[j].x * v[j].x + v[j].y * v[j].y) + (v[j].z * v[j].z + v[j].w * v[j].w); }
        s = wave_sum(s); const float rs = 1.0f / sqrtf(s * (1.0f / DM) + EPS);
#pragma unroll
        for (int j = 0; j < 4; ++j) { const f32x4 g = gr[64 * j]; f32x4 o = {v[j].x * rs * g.x, v[j].y * rs * g.y, v[j].z * rs * g.z, v[j].w * rs * g.w}; xr[64 * j] = o; }
    }
}

constexpr int N_PHASES = 17;
__global__ void __launch_bounds__(NTHR, 2) mega(Args args) {
    extern __shared__ __attribute__((aligned(16))) unsigned char lds_raw[];
    Frame F;
    F.lds = (LAS unsigned char*)lds_raw;
    F.wave = __builtin_amdgcn_readfirstlane((int)(threadIdx.x >> 6));
    F.G = gridDim.x; F.bid = blockIdx.x; F.gw = F.bid * NWAVES + F.wave; F.NGW = F.G * NWAVES; F.ws = args.ws;
    unsigned char* ws = args.ws;
    gu32* ctl = (gu32*)(ws + WS_CTL);
    volatile LAS unsigned* MISC = (volatile LAS unsigned*)(F.lds + MISC_OFF);
    for (int u = TID(); u < (LDS_BYTES - LDSCTL_OFF) / 4; u += NTHR) ((LAS unsigned*)(F.lds + LDSCTL_OFF))[u] = 0u;
    __syncthreads();
    XcdBarrier bar = xcd_barrier_post((unsigned*)(ctl + CW_BAR), MISC + 8);
    const int lo = args.ph_lo, hi = args.ph_hi;
#ifndef PH_MASK
#define PH_MASK 0x1ffff
#endif
#define IN(k) (((PH_MASK >> (k)) & 1) && lo <= (k) && (k) < hi)
#ifndef REPEAT_MASK
#define REPEAT_MASK 0
#endif
#define REPS(k) (1 + ((REPEAT_MASK >> (k)) & 1))
#define SEAM(k) do { if (IN(k) && IN((k) + 1)) xcd_barrier(bar); } while (0)

    float* H = args.out;
    bf16* x3 = (bf16*)args.out;
    float* rss = (float*)(ws + WS_RSS); float* rstd = (float*)(ws + WS_RSTD);
    bf16* hbf = (bf16*)(ws + WS_HBF); bf16* membf = (bf16*)(ws + WS_MEMBF); bf16* memk = (bf16*)(ws + WS_MEMK); bf16* memvt = (bf16*)(ws + WS_MEMVT);
    bf16* act0 = (bf16*)(ws + WS_ACT0); bf16* v0t = (bf16*)(ws + WS_V0T); bf16* mix = (bf16*)(ws + WS_MIX); bf16* hmid0 = (bf16*)(ws + WS_HMID0);
    bf16* act1 = (bf16*)(ws + WS_ACT1); bf16* v1t = (bf16*)(ws + WS_V1T); bf16* OF = (bf16*)(ws + WS_OF); bf16* OB = (bf16*)(ws + WS_OB);
    bf16* hmid1 = (bf16*)(ws + WS_HMID1); bf16* wgu = (bf16*)((unsigned char*)args.out + OUT_WGU); bf16* wdn = (bf16*)(ws + WS_WDN);
    int* cnt = (int*)(ws + WS_CNT); int* topi = (int*)(ws + WS_TOPI); float* topw = (float*)(ws + WS_TOPW);
    int* stok = (int*)(ws + WS_STOK); float* sw = (float*)(ws + WS_SW); int* blk = (int*)(ws + WS_BLK);
    LAS float* scr = (LAS float*)(F.lds + F.wave * 16384);

    if (IN(0)) {
        int it = F.gw; LAS unsigned* T0 = (LAS unsigned*)scr; LAS unsigned* T1 = T0 + 1088;
#define CVT(Wp, Kd, Nd, WTp, gainp, kind) do { const CvtJob J{Wp, Kd, Nd, (bf16*)(WTp), gainp, kind}; const int n_ = ((Kd) / 64) * ((Nd) / 32); \
            while (it < n_) { CvtRegs A_, B_; B_.valid = 0; cvt_load(A_, J, it, LANE()); it += F.NGW; if (it < n_) { cvt_load(B_, J, it, LANE()); it += F.NGW; } cvt_finish(A_, T0, LANE()); cvt_finish(B_, T1, LANE()); } \
            it -= n_; } while (0)
        CVT(args.in[I_EWIN], 1024, 2560, ws + WS_W0IN, args.in[I_EN1], 1);
        CVT(args.in[I_EWIN], 1024, 2560, ws + WS_WV0, args.in[I_EN1], 2);
        CVT(args.in[I_EWOUT], 1024, 1024, ws + WS_W0OUT, nullptr, 0);
        CVT(args.in[I_EWG], 1024, 2816, ws + WS_W0GU, args.in[I_EN2], 3);
        CVT(args.in[I_EWU], 1024, 2816, ws + WS_W0GU, args.in[I_EN2], 4);
        CVT(args.in[I_EWD], 2816, 1024, ws + WS_W0DN, nullptr, 0);
        CVT(args.in[I_WMKV], 1024, 512, ws + WS_WMEM, args.in[I_MNORM], 0);
        CVT(args.in[I_OWIN], 1024, 2592, ws + WS_W1IN, args.in[I_ON1], 5);
        CVT(args.in[I_OWIN], 1024, 2592, ws + WS_WV1, args.in[I_ON1], 6);
        CVT(args.in[I_OWOUT], 1024, 1024, ws + WS_W1OUT, nullptr, 0);
#undef CVT
        { v4u z = {0u, 0u, 0u, 0u}; v4u* p = (v4u*)(ws + WS_W1IN + (size_t)1824 * 2048); const int n16 = 224 * 2048 / 16;
          for (int i = F.bid * NTHR + TID(); i < n16; i += F.G * NTHR) p[i] = z; }
        rows_to_bf16(args.in[I_X], hbf, rstd, F.gw, NT, F.NGW, LANE());
        rows_to_bf16(args.in[I_MEM], membf, rstd + NT, F.gw, MEM_ROWS, F.NGW, LANE());
    }
    SEAM(0);
    if (IN(1)) {
        { Sched S; S.init(hbf, ws + WS_W0IN, 1024, 128, 7, F.G, F.bid); EpiRowScale E{act0, A0_LD, rstd, 1.0f}; gemm_run<EpiRowScale, false>(F.lds, S, E, nullptr); }
        { Sched S; S.init(ws + WS_WV0, hbf, 1024, 3, 128, F.G, (F.bid + 128) % F.G); EpiColScale E{v0t, NT, rstd}; gemm_run<EpiColScale, false>(F.lds, S, E, nullptr); }
        for (int it = F.gw; it < 2048; it += F.NGW) memkv_item(it, LANE(), membf, (const bf16*)(ws + WS_WMEM), rstd + NT, memk, memvt);
    }
    SEAM(1);
    if (IN(2)) {
        { for (int i = 0; i < 1536 / 256; ++i) na_hstrip(F, (F.G == 256) ? (F.bid & 7) * 192 + i * 32 + (F.bid >> 3) : F.bid + i * F.G, act0, v0t, args.in[I_RPB], mix);
          for (int it = F.bid; it < 512; it += F.G) memattn_strip(F, it, act0, A0_LD, 1536, memk, memvt, mix);
          __syncthreads(); }
    }
    SEAM(2);
    if (IN(3)) {
        Sched S; S.init(mix, ws + WS_W0OUT, 1024, 128, 4, F.G, F.bid); EpiResid<true> E{args.in[I_X], hbf, rss, nullptr}; gemm_run<EpiResid<true>, false>(F.lds, S, E, nullptr);
    }
    SEAM(3);
    if (IN(4)) {
        Sched S; S.init(hbf, ws + WS_W0GU, 1024, 128, 22, F.G, F.bid); EpiSwiGLU<false, true> E{hmid0, FF0, rss, nullptr}; gemm_run<EpiSwiGLU<false, true>, false>(F.lds, S, E, nullptr);
    }
    SEAM(4);
    if (IN(5)) {
        Sched S; S.init(hmid0, ws + WS_W0DN, FF0, 128, 4, F.G, F.bid); EpiResid<false> E{nullptr, hbf, rss, nullptr}; gemm_run<EpiResid<false>, false>(F.lds, S, E, nullptr);
    }
    SEAM(5);
    if (IN(6)) {
        { Sched S; S.init(hbf, ws + WS_W1IN, 1024, 128, 8, F.G, F.bid); EpiRowScaleT<true> E{act1, A1_LD, rss, 1.0f}; gemm_run<EpiRowScaleT<true>, false>(F.lds, S, E, nullptr); }
        { Sched S; S.init(ws + WS_WV1, hbf, 1024, 3, 128, F.G, F.bid); EpiColScaleT<true> E{v1t, NT, rss}; gemm_run<EpiColScaleT<true>, false>(F.lds, S, E, nullptr); }
    }
    SEAM(6);
    if (IN(7)) {
        bf16x8 gwf[3]; float gbi[3]; int gdir = -1;
        for (int it = F.bid; it < 1024; it += F.G) { const int dir = (it >> 6) & 1;
            if (dir != gdir) { gla_pre_w(F.wave, LANE(), dir ? args.in[I_WGKB] : args.in[I_WGKF], dir ? args.in[I_BGKB] : args.in[I_BGKF], gwf, gbi); gdir = dir; }
            gla_pre_item(F, it, act1, gwf, gbi, (bf16*)(ws + WS_GQT) + (size_t)dir * NT * 384, (bf16*)((unsigned char*)args.out + OUT_GKT) + (size_t)dir * NT * 384,
                         (bf16*)(ws + (dir ? WS_GKDT1 : WS_GKDT0)), (float*)((unsigned char*)args.out + OUT_GDEC) + (size_t)dir * 8 * 4 * 64 * 96); }
        for (int it = F.bid; it < 512; it += F.G) memattn_strip(F, it, act1, A1_LD, 1536, memk, memvt, mix);
        xcd_barrier(bar);
        for (int it0 = F.bid; it0 < 256; it0 += F.G) { const int it = (F.G == 256) ? ((it0 & 7) * 8 + (it0 >> 5)) * 4 + ((it0 >> 3) & 3) : it0;
            gla_main_item(F, it, (const bf16*)(ws + WS_GQT), (const bf16*)((unsigned char*)args.out + OUT_GKT), (const bf16*)(ws + WS_GKDT0), (const bf16*)(ws + WS_GKDT1), (const float*)((unsigned char*)args.out + OUT_GDEC), v1t, OF, OB, args.in[I_OWG], args.in[I_OWU], args.in[I_ON2], (unsigned char*)wgu); }
    }
    SEAM(7);
    if (IN(8)) gla_combine(F, OF, OB, act1, args.in[I_GNORM], mix);
    SEAM(8);
    if (IN(9)) {
        Sched S; S.init(mix, ws + WS_W1OUT, 1024, 128, 4, F.G, F.bid); EpiResid<false> E{nullptr, hbf, rss, x3}; gemm_run<EpiResid<false>, false>(F.lds, S, E, nullptr);
    }
    SEAM(9);
    if (IN(10)) {
        route1(F, hbf, args.in[I_ON2], args.in[I_WR], topi, topw, cnt, rstd);
    }
    SEAM(10);
    if (IN(11)) {
        route2(F, topi, topw, cnt, stok, sw, blk, (int*)(ws + WS_S0TAB));
        { LAS unsigned* T0 = (LAS unsigned*)scr; LAS unsigned* T1 = T0 + 1088;
#define MOE_JOB(J_, it_) const int e_##J_ = (it_) / 1792; \
            const CvtJob J_{args.in[I_OWD] + (size_t)e_##J_ * FFE * 1024, FFE, 1024, (bf16*)((unsigned char*)wdn + (size_t)e_##J_ * 1024 * FFE), nullptr, 0}
          for (int it = F.gw; it < 8 * 1792; it += 2 * F.NGW) {
            CvtRegs A_, B_; B_.valid = 0;
            { MOE_JOB(Ja, it); cvt_load8(A_, Ja, it % 1792, LANE()); }
            if (it + F.NGW < 8 * 1792) { MOE_JOB(Jb, it + F.NGW); cvt_load8(B_, Jb, (it + F.NGW) % 1792, LANE()); }
            cvt_finish8(A_, T0, LANE(), 32.0f); cvt_finish8(B_, T1, LANE(), 32.0f);
          }
#undef MOE_JOB
        }
    }
    SEAM(11);
    bf16* ht0 = (bf16*)((unsigned char*)hmid1 + (size_t)NT * FFE); bf16* ht1 = (bf16*)(ws + WS_HT1);
    constexpr int KG = 512, KD = FFE / 2; constexpr size_t ESG = (size_t)7168 * 1024, ESD = (size_t)1024 * FFE;
    if (IN(12)) {
        const int nb = blk[0]; Sched S; S.init(x3, wgu, KG, nb, 28, F.G, F.bid, blk + 16, ESG); EpiSwiGLU<true> E{hmid1, FFE, rstd, ht0}; gemm_run<EpiSwiGLU<true>, true, true>(F.lds, S, E, stok);
    }
    SEAM(12);
    if (IN(13)) {
        const int nb = blk[0], nbm = nb < 128 ? nb : 128; Sched S; S.init(hmid1, wdn, KD, nbm, 4, F.G, F.bid, blk + 16, ESD); EpiRowScale E{(bf16*)(ws + WS_YA), DM, sw, 0.03125f}; gemm_run<EpiRowScale, false, true>(F.lds, S, E, nullptr);
    }
    SEAM(13);
    if (IN(14)) {
        const int nb = blk[1], nb0 = blk[0], rfull = (nb * 28 / F.G > 3) ? nb * 28 / F.G - 3 : 0, per = F.G / 8;
        { Sched S; S.init(x3, wgu, KG, nb, 28, F.G, F.bid, blk + 16 + 256, ESG); S.range(0, rfull * per, per);
          EpiSwiGLU<true> E{hmid1, FFE, rstd, ht1}; gemm_run<EpiSwiGLU<true>, true, true>(F.lds, S, E, stok + SLOT_CAP); }
        { Sched S; S.init(x3, wgu, KG, nb, 28, F.G, F.bid, blk + 16 + 256, ESG); S.range(rfull * per, 0x7fffffff, per - 4);
          EpiSwiGLU<true> E{hmid1, FFE, rstd, ht1}; gemm_run<EpiSwiGLU<true>, true, true>(F.lds, S, E, stok + SLOT_CAP); }
        if (F.bid / 8 >= per - 4 && nb0 > 128) {
            Sched S; S.init(ht0, wdn, KD, nb0 - 128, 4, 32, (F.bid / 8 - (per - 4)) * 8 + F.bid % 8, blk + 16 + 128, ESD);
            EpiRowScale E{(bf16*)(ws + WS_YA) + (size_t)NT * DM, DM, sw + NT, 0.03125f}; gemm_run<EpiRowScale, false, true>(F.lds, S, E, nullptr); }
    }
    SEAM(14);
    if (IN(15)) {
        const int nb = blk[1], nbm = nb < 128 ? nb : 128; Sched S; S.init(hmid1, wdn, KD, nbm, 4, F.G, F.bid, blk + 16 + 256, ESD); EpiRowScale E{(bf16*)(ws + WS_YB), DM, sw + SLOT_CAP, 0.03125f}; gemm_run<EpiRowScale, false, true>(F.lds, S, E, nullptr);
    }
    SEAM(15);
    if (IN(16)) {
        const int nb = blk[1], per = F.G / 8, nmain = (nb < 128 ? nb : 128) * 256;
        bf16* yb = (bf16*)(ws + WS_YB); bf16* yb2 = yb + (size_t)SLOT_CAP * DM;
        if (F.bid / 8 >= per - 4) {
            if (nb > 128) {
                const int sl = F.bid / 8 - (per - 4), kh = sl >> 1;
                Sched S; S.init((const bf16*)ht1 + kh * (KD / 2), (const bf16*)wdn + kh * (KD / 2), KD / 2, nb - 128, 4, 16, (sl & 1) * 8 + F.bid % 8, blk + 16 + 256 + 128, ESD); S.ld = KD;
                EpiRowScale E{kh ? yb2 : yb + (size_t)NT * DM, DM, sw + SLOT_CAP + NT, 0.03125f}; gemm_run<EpiRowScale, false, true>(F.lds, S, E, nullptr); }
        } else {
            const int wv = (int)(blockIdx.x * NWAVES + (threadIdx.x >> 6));
            final_norm_slots((int)(threadIdx.x & 63u), hbf, H, (const bf16*)(ws + WS_YA), (const int*)(ws + WS_S0TAB), yb, nullptr, args.in[I_FNORM], stok + SLOT_CAP, 0, nmain, wv, (per - 4) * 8 * NWAVES);
        }
        xcd_barrier(bar);
        if (nb > 128) final_norm_slots((int)(threadIdx.x & 63u), hbf, H, (const bf16*)(ws + WS_YA), (const int*)(ws + WS_S0TAB), yb, yb2, args.in[I_FNORM], stok + SLOT_CAP, NT, nb * 256, (int)(blockIdx.x * NWAVES + (threadIdx.x >> 6)), F.NGW);
    }
#undef IN
#undef SEAM
}

extern "C" void kernel_launch(void* const* d_in, const int* in_sizes, int n_in, void* d_out, int out_size, void* d_ws, size_t ws_size, hipStream_t stream) {
    static int grid = 0;
    if (grid == 0) {
        if (n_in != 26 || out_size != NT * DM || ws_size < WS_END) { fprintf(stderr, "kernel_launch: unexpected problem (n_in %d out %d ws %zu need %zu)\n", n_in, out_size, ws_size, (size_t)WS_END); grid = -1; return; }
        int dev = 0, cus = 0, per_cu = 0;
        if (hipGetDevice(&dev) != hipSuccess || hipDeviceGetAttribute(&cus, hipDeviceAttributeMultiprocessorCount, dev) != hipSuccess) { grid = -1; return; }
        if (hipFuncSetAttribute((const void*)mega, hipFuncAttributeMaxDynamicSharedMemorySize, LDS_BYTES) != hipSuccess) { fprintf(stderr, "kernel_launch: hipFuncSetAttribute failed\n"); grid = -1; return; }
        if (hipOccupancyMaxActiveBlocksPerMultiprocessor(&per_cu, (const void*)mega, NTHR, LDS_BYTES) != hipSuccess || per_cu < 1) fprintf(stderr, "kernel_launch: occupancy query reports %d\n", per_cu);
        (void)hipGetLastError();
        if (cus < 256) { fprintf(stderr, "kernel_launch: this kernel is built for a 256-CU device (one resident workgroup per CU), found %d CUs; nothing launched\n", cus); grid = -1; return; }
        grid = 256;
    }
    if (grid < 0) return;
    if (hipMemsetAsync((char*)d_ws + WS_CTL, 0, CTL_ZERO_BYTES, stream) != hipSuccess) return;
    Args a{};
    for (int i = 0; i < 26; ++i) a.in[i] = (const float*)d_in[i];
    a.out = (float*)d_out; a.ws = (unsigned char*)d_ws;
    a.ph_lo = 0; a.ph_hi = N_PHASES;
    hipLaunchKernelGGL(mega, dim3(grid), dim3(NTHR), LDS_BYTES, stream, a);
}
```

```cpp
#include <hip/hip_runtime.h>
#include <cstdio>
#include <cstdint>


#define GAS __attribute__((address_space(1)))
#define LAS __attribute__((address_space(3)))
typedef unsigned short bf16;
typedef unsigned v4u __attribute__((ext_vector_type(4)));
typedef unsigned v2u __attribute__((ext_vector_type(2)));
typedef float f32x4 __attribute__((ext_vector_type(4)));
typedef short bf16x8 __attribute__((ext_vector_type(8)));
typedef GAS unsigned gu32;
#define RLX_AGENT __ATOMIC_RELAXED, __HIP_MEMORY_SCOPE_AGENT
#define LDS_WAIT() asm volatile("s_waitcnt lgkmcnt(0)" ::: "memory")
#define VM_WAIT() asm volatile("s_waitcnt vmcnt(0)" ::: "memory")

constexpr int NT = 32768, DM = 1024, SEQ = 4096, NB = 8;
constexpr int MEM_ROWS = 2048;
constexpr int A0_LD = 1792;
constexpr int A1_LD = 2048;
constexpr int FF0 = 2816, FFE = 3584, NEXP = 8;
constexpr int SLOT_CAP = 34816;
constexpr float EPS = 1e-6f;
constexpr int NWAVES = 8, NTHR = 512;

constexpr size_t MiB = 1u << 20;
constexpr size_t WS_CTL = 0, CTL_ZERO_BYTES = 1 * MiB;
constexpr size_t WS_RSS = 1 * MiB;
constexpr size_t WS_MRSS = 3 * MiB;
constexpr size_t WS_CNT = 3 * MiB + 256 * 1024;
constexpr size_t WS_TOPI = 3 * MiB + 512 * 1024;
constexpr size_t WS_TOPW = 3 * MiB + 768 * 1024;
constexpr size_t WS_STOK = 4 * MiB;
constexpr size_t WS_SW = 4 * MiB + 512 * 1024;
constexpr size_t WS_BLK = 5 * MiB;
constexpr size_t WS_RSTD = 5 * MiB + 64 * 1024;
constexpr size_t WS_S0TAB = 5 * MiB + 512 * 1024;
constexpr size_t WS_W0IN = 6 * MiB;
constexpr size_t WS_WV0 = WS_W0IN + 1792 * 2048;
constexpr size_t WS_W0OUT = 11 * MiB;
constexpr size_t WS_W0GU = 13 * MiB;
constexpr size_t WS_W0DN = 24 * MiB;
constexpr size_t WS_WMEM = WS_W0DN + 1024 * 2816 * 2;
constexpr size_t WS_W1IN = 31 * MiB;
constexpr size_t WS_WV1 = 35 * MiB;
constexpr size_t WS_W1OUT = 37 * MiB - 512 * 1024;
constexpr size_t WS_HBF = 39 * MiB;
constexpr size_t WS_MEMBF = 103 * MiB;
constexpr size_t WS_MEMK = 107 * MiB;
constexpr size_t WS_MEMVT = 108 * MiB;
constexpr size_t WS_ACT = 109 * MiB;
constexpr size_t WS_ACT0 = WS_ACT;
constexpr size_t WS_V0T = WS_ACT + 112 * MiB;
constexpr size_t WS_MIX = WS_ACT + 176 * MiB;
constexpr size_t WS_HMID0 = WS_ACT;
constexpr size_t WS_ACT1 = WS_ACT;
constexpr size_t WS_V1T = WS_ACT + 128 * MiB;
constexpr size_t WS_OF = WS_ACT + 240 * MiB;
constexpr size_t WS_OB = WS_ACT + 288 * MiB;
constexpr size_t WS_GQT = WS_ACT + 336 * MiB;
constexpr size_t WS_GKDT0 = WS_ACT + 384 * MiB;
constexpr size_t WS_GKDT1 = 6 * MiB;
constexpr size_t OUT_GKT = 0, OUT_GDEC = 48 * MiB, OUT_WGU = 52 * MiB;
constexpr size_t WS_E = WS_ACT + 336 * MiB;
constexpr size_t WS_HT1 = 6 * MiB;
constexpr size_t WS_YB = WS_ACT + 240 * MiB;
constexpr size_t WS_YA = WS_ACT + 128 * MiB;
constexpr size_t WS_HMID1 = WS_ACT;
constexpr size_t WS_WGU = WS_ACT + 240 * MiB;
constexpr size_t WS_WDN = WS_ACT + 352 * MiB;
constexpr size_t WS_END = WS_ACT + 408 * MiB;
static_assert(WS_W1OUT + 2 * MiB <= WS_HBF && WS_WV1 + 768 * 2048 <= WS_W1OUT && WS_W1IN + 4 * MiB <= WS_WV1 && WS_WMEM + MiB <= WS_W1IN, "weight map");
static_assert(WS_W0GU + 11 * MiB <= WS_W0DN && WS_WV0 + 768 * 2048 <= WS_W0OUT, "weight map 2");
static_assert((size_t)SLOT_CAP * 3584 * 2 <= 240 * MiB, "hmid1");

constexpr int CW_TMO = 0, CW_CODE = 1, CW_BAR = 4096;

constexpr int RING_BYTES = 131072;
constexpr int LDSCTL_OFF = 155648, MISC_OFF = LDSCTL_OFF + 320;
constexpr int LDS_BYTES = 156672;

typedef float f32x2_t __attribute__((ext_vector_type(2)));
typedef __bf16 bf16x2_t __attribute__((ext_vector_type(2)));
__device__ __forceinline__ unsigned pk2(float lo, float hi) { const f32x2_t v = {lo, hi}; const bf16x2_t b = __builtin_convertvector(v, bf16x2_t); return __builtin_bit_cast(unsigned, b); }
__device__ __forceinline__ unsigned f2bf(float f) { return pk2(f, 0.f) & 0xffffu; }
__device__ __forceinline__ float bf2f(bf16 b) { return __builtin_bit_cast(float, (unsigned)b << 16); }
__device__ __forceinline__ float bflo(unsigned u) { return __builtin_bit_cast(float, u << 16); }
__device__ __forceinline__ float bfhi(unsigned u) { return __builtin_bit_cast(float, u & 0xffff0000u); }
__device__ __forceinline__ float wave_sum(float v) {
#pragma unroll
    for (int o = 1; o < 64; o <<= 1) v += __shfl_xor(v, o);
    return v;
}
__device__ __forceinline__ float wave_max(float v) {
#pragma unroll
    for (int o = 1; o < 64; o <<= 1) v = fmaxf(v, __shfl_xor(v, o));
    return v;
}

__device__ __forceinline__ int lane_id() { unsigned z = 0u; asm volatile("" : "+v"(z)); return (int)__builtin_amdgcn_mbcnt_hi(0xffffffffu, __builtin_amdgcn_mbcnt_lo(0xffffffffu, z)); }
#define XB_TMO      128
#define XB_XCNT(j)  (256  + 64 * (j))
#define XB_XSUB(j)  (1280 + 64 * (j))
#define XB_XGEN(j)  (2304 + 64 * (j))
#define XB_TOP      3328
#define XB_TOPGEN   3392
#define XCD_BAR_WORDS 3456
#define XB_SPIN_CAP (1u << 22)

__device__ __forceinline__ unsigned xb_ld(unsigned* p)              { return __hip_atomic_load(p, __ATOMIC_RELAXED, __HIP_MEMORY_SCOPE_AGENT); }
__device__ __forceinline__ unsigned xb_add(unsigned* p, unsigned v) { return __hip_atomic_fetch_add(p, v, __ATOMIC_RELAXED, __HIP_MEMORY_SCOPE_AGENT); }
__device__ __forceinline__ unsigned xb_xcc_id() { return (unsigned)__builtin_amdgcn_s_getreg((3 << 11) | 20) & 0xFu; }
#define XB_SPIN(cond, bar) do { unsigned _sp = 0; while (cond) { __builtin_amdgcn_s_sleep(1); \
    if ((++_sp & 255u) == 0u) { if (xb_ld(&(bar)[XB_TMO])) break; if (_sp > XB_SPIN_CAP) { atomicAdd(&(bar)[XB_TMO], 1u); break; } } } } while (0)

struct XcdBarrier { unsigned* bar; unsigned x; volatile LAS unsigned* st; int w0; };

__device__ __forceinline__ XcdBarrier xcd_barrier_post(unsigned* bar, volatile LAS unsigned* st, int wave) {
    XcdBarrier b; b.bar = bar; b.x = xb_xcc_id(); b.st = st; b.w0 = (wave == 0) ? 1 : 0;
    if (b.w0 && lane_id() == 0) (void)xb_add(&bar[XB_XCNT(b.x)], 1u);
    return b;
}
__device__ __forceinline__ void xcd_barrier_complete(unsigned* bar, unsigned x, unsigned& nloc, unsigned& nx) {
    const unsigned G = gridDim.x * gridDim.y * gridDim.z;
    unsigned sum, cnt, mine, sp = 0u;
    for (;;) {
        sum = 0u; cnt = 0u; mine = 0u;
#pragma unroll
        for (unsigned j = 0; j < 16; ++j) { const unsigned c = xb_ld(&bar[XB_XCNT(j)]); sum += c; cnt += (c > 0u) ? 1u : 0u; mine = (j == x) ? c : mine; }
        if (sum == G) break;
        __builtin_amdgcn_s_sleep(1);
        if ((++sp & 255u) == 0u) { if (xb_ld(&bar[XB_TMO])) break; if (sp > XB_SPIN_CAP) { atomicAdd(&bar[XB_TMO], 1u); break; } }
    }
    nloc = mine > 0u ? mine : 1u; nx = cnt > 0u ? cnt : 1u;
}
__device__ __forceinline__ void xcd_barrier(const XcdBarrier& b) {
    asm volatile("s_waitcnt vmcnt(0)" ::: "memory");
    __syncthreads();
    if (b.w0 && lane_id() == 0) {
        unsigned* bar = b.bar;
        __builtin_amdgcn_s_waitcnt(0);
        unsigned nloc = b.st[0], nx = b.st[1];
        if (nloc == 0u) { xcd_barrier_complete(bar, b.x, nloc, nx); b.st[0] = nloc; b.st[1] = nx; }
        const unsigned old = xb_add(&bar[XB_XSUB(b.x)], 1u);
        const unsigned gen = old / nloc;
        if (old + 1u == (gen + 1u) * nloc) {
            __builtin_amdgcn_fence(__ATOMIC_RELEASE, "agent");
            asm volatile("s_waitcnt vmcnt(0)" ::: "memory");
            const unsigned og = xb_add(&bar[XB_TOP], 1u);
            const unsigned tg = og / nx;
            if (og + 1u == (tg + 1u) * nx) xb_add(&bar[XB_TOPGEN], 1u);
            else XB_SPIN(xb_ld(&bar[XB_TOPGEN]) == tg, bar);
            __builtin_amdgcn_fence(__ATOMIC_ACQUIRE, "agent");
            xb_add(&bar[XB_XGEN(b.x)], 1u);
            asm volatile("s_waitcnt vmcnt(0)" ::: "memory");
        } else {
            XB_SPIN(xb_ld(&bar[XB_XGEN(b.x)]) == gen, bar);
            __builtin_amdgcn_fence(__ATOMIC_ACQUIRE, "agent");
            asm volatile("s_waitcnt vmcnt(0)" ::: "memory");
        }
    }
    __syncthreads();
}

struct Args { const float* in[26]; float* out; unsigned char* ws; int ph_lo, ph_hi; };
enum { I_X = 0, I_MEM, I_EN1, I_EWIN, I_RPB, I_EWOUT, I_EN2, I_EWG, I_EWU, I_EWD, I_ON1, I_OWIN, I_WGKF, I_BGKF, I_WGKB, I_BGKB, I_GNORM, I_OWOUT, I_ON2, I_WR, I_OWG, I_OWU, I_OWD, I_MNORM, I_WMKV, I_FNORM };

#define LANE() lane_id()
#define TID() ((F.wave << 6) | lane_id())
struct Frame {
    LAS unsigned char* lds;
    int wave, G, bid;
    int gw, NGW;
    unsigned char* ws;
};

constexpr float QSCALE = 0.125f * 1.4426950408889634f;
struct CvtJob { const float* W; int K, N; bf16* WT; const float* gain; int kind; };
__device__ __forceinline__ bool cvt_map(int kind, int n0, int& drow, float& scale) {
    scale = 1.0f;
    switch (kind) {
    case 0: drow = n0; return true;
    case 1: if (n0 < 768) { drow = n0; scale = QSCALE; return true; } if (n0 < 1536) { drow = n0; return true; } if (n0 >= 2304) { drow = n0 - 768; scale = QSCALE; return true; } return false;
    case 2: if (n0 >= 1536 && n0 < 2304) { drow = n0 - 1536; return true; } return false;
    case 3: drow = (n0 >> 7) * 256 + (n0 & 127); return true;
    case 4: drow = (n0 >> 7) * 256 + 128 + (n0 & 127); return true;
    case 5: if (n0 < 768) { drow = n0; return true; } if (n0 < 1536) return false; if (n0 < 2304) { drow = n0 - 768; return true; }
            if (n0 < 2336) { drow = n0 - 512; return true; } drow = n0 - 800; scale = QSCALE; return true;
    case 6: if (n0 >= 768 && n0 < 1536) { drow = n0 - 768; return true; } return false;
    default: drow = n0; return true;
    }
}
__device__ __forceinline__ unsigned pk4_fp8(float a, float b, float c, float d) { a = __builtin_amdgcn_fmed3f(a, -448.f, 448.f); b = __builtin_amdgcn_fmed3f(b, -448.f, 448.f); c = __builtin_amdgcn_fmed3f(c, -448.f, 448.f); d = __builtin_amdgcn_fmed3f(d, -448.f, 448.f);
    unsigned w = 0u; w = (unsigned)__builtin_amdgcn_cvt_pk_fp8_f32(a, b, (int)w, false); w = (unsigned)__builtin_amdgcn_cvt_pk_fp8_f32(c, d, (int)w, true); return w; }
struct CvtRegs { f32x4 v[8]; const float* gain; bf16* WT; int K, k0, drow, valid; float scale; };
__device__ __forceinline__ void cvt_load(CvtRegs& R, const CvtJob& J, int item, int lane) {
    const int nblk = J.N / 32, kb = item / nblk, nb = item % nblk, n0 = nb * 32;
    R.k0 = kb * 64; R.gain = J.gain; R.WT = J.WT; R.K = J.K;
    R.valid = cvt_map(J.kind, n0, R.drow, R.scale) ? 1 : 0;
    if (R.valid) { const float* p = J.W + (size_t)(R.k0 + 2 * (lane >> 3)) * J.N + n0 + 4 * (lane & 7);
#pragma unroll
        for (int j = 0; j < 8; ++j) R.v[j] = *(const f32x4*)(p + (size_t)(16 * (j >> 1) + (j & 1)) * J.N); }
}
__device__ __forceinline__ void cvt_load8(CvtRegs& R, const CvtJob& J, int item, int lane) {
    const int nblk = J.N / 32, kb = item / nblk, nb = item % nblk, n0 = nb * 32;
    R.k0 = kb * 64; R.gain = J.gain; R.WT = J.WT; R.K = J.K;
    R.valid = cvt_map(J.kind, n0, R.drow, R.scale) ? 1 : 0;
    if (R.valid) { const float* p = J.W + (size_t)(R.k0 + 4 * (lane >> 3)) * J.N + n0 + 4 * (lane & 7);
#pragma unroll
        for (int j = 0; j < 8; ++j) R.v[j] = *(const f32x4*)(p + (size_t)(32 * (j >> 2) + (j & 3)) * J.N); }
}
__device__ __forceinline__ void cvt_finish8(const CvtRegs& R, LAS unsigned* T, int lane, float mul) {
    if (!R.valid) return;
    const int nq = lane & 7, kr = lane >> 3;
#pragma unroll
    for (int p = 0; p < 2; ++p) { const int k = R.k0 + 32 * p + 4 * kr; float g[4];
#pragma unroll
        for (int q = 0; q < 4; ++q) g[q] = R.scale * mul * (R.gain ? R.gain[k + q] : 1.0f);
        const f32x4 a = R.v[4 * p], b = R.v[4 * p + 1], c = R.v[4 * p + 2], d = R.v[4 * p + 3]; LAS unsigned* t = T + (4 * nq) * 17 + 8 * p + kr;
        t[0] = pk4_fp8(a.x * g[0], b.x * g[1], c.x * g[2], d.x * g[3]); t[17] = pk4_fp8(a.y * g[0], b.y * g[1], c.y * g[2], d.y * g[3]);
        t[34] = pk4_fp8(a.z * g[0], b.z * g[1], c.z * g[2], d.z * g[3]); t[51] = pk4_fp8(a.w * g[0], b.w * g[1], c.w * g[2], d.w * g[3]); }
    LDS_WAIT(); asm volatile("" ::: "memory");
#pragma unroll
    for (int r = 0; r < 2; ++r) { const int n = (lane >> 2) + 16 * r, c = lane & 3; const LAS unsigned* sp = T + n * 17 + 4 * c;
        v4u o; o.x = sp[0]; o.y = sp[1]; o.z = sp[2]; o.w = sp[3];
        *(GAS v4u*)((unsigned char*)R.WT + (size_t)(R.drow + n) * R.K + R.k0 + 16 * c) = o; }
    LDS_WAIT(); asm volatile("" ::: "memory");
}
__device__ __forceinline__ void cvt_finish(const CvtRegs& R, LAS unsigned* T, int lane) {
    if (!R.valid) return;
    const int nq = lane & 7, kr = lane >> 3;
#pragma unroll
    for (int p = 0; p < 4; ++p) { const int k = R.k0 + 16 * p + 2 * kr; float g0 = R.scale, g1 = R.scale; if (R.gain) { g0 *= R.gain[k]; g1 *= R.gain[k + 1]; }
        const f32x4 a = R.v[2 * p], b = R.v[2 * p + 1]; LAS unsigned* t = T + (4 * nq) * 33 + 8 * p + kr;
        t[0] = pk2(a.x * g0, b.x * g1); t[33] = pk2(a.y * g0, b.y * g1); t[66] = pk2(a.z * g0, b.z * g1); t[99] = pk2(a.w * g0, b.w * g1); }
    LDS_WAIT(); asm volatile("" ::: "memory");
#pragma unroll
    for (int r = 0; r < 4; ++r) { const int n = (lane >> 3) + 8 * r, c = lane & 7; const LAS unsigned* sp = T + n * 33 + 4 * c;
        v4u o; o.x = sp[0]; o.y = sp[1]; o.z = sp[2]; o.w = sp[3];
        *(GAS v4u*)(R.WT + (size_t)(R.drow + n) * R.K + R.k0 + 8 * c) = o; }
    LDS_WAIT(); asm volatile("" ::: "memory");
}
__device__ __forceinline__ void rows_to_bf16(const float* X, bf16* Ob, float* rstd, int first, int nrows, int stride, int lane) {
    for (int m = first; m < nrows; m += 2 * stride) {
        const int m2 = m + stride; const bool h2 = m2 < nrows;
        const GAS f32x4* xa = (const GAS f32x4*)(X + (size_t)m * DM) + lane; const GAS f32x4* xb = (const GAS f32x4*)(X + (size_t)(h2 ? m2 : m) * DM) + lane;
        f32x4 va[4], vb[4];
#pragma unroll
        for (int j = 0; j < 4; ++j) va[j] = xa[64 * j];
#pragma unroll
        for (int j = 0; j < 4; ++j) vb[j] = xb[64 * j];
        float sa = 0.f, sb = 0.f;
#pragma unroll
        for (int j = 0; j < 4; ++j) { sa += (va[j].x * va[j].x + va[j].y * va[j].y) + (va[j].z * va[j].z + va[j].w * va[j].w); sb += (vb[j].x * vb[j].x + vb[j].y * vb[j].y) + (vb[j].z * vb[j].z + vb[j].w * vb[j].w); }
        sa = wave_sum(sa); sb = wave_sum(sb);
        GAS unsigned long long* oa = (GAS unsigned long long*)(Ob + (size_t)m * DM) + lane;
#pragma unroll
        for (int j = 0; j < 4; ++j) oa[64 * j] = (unsigned long long)pk2(va[j].x, va[j].y) | ((unsigned long long)pk2(va[j].z, va[j].w) << 32);
        if (lane == 0) rstd[m] = __builtin_amdgcn_rsqf(sa * (1.0f / DM) + EPS);
        if (h2) { GAS unsigned long long* ob = (GAS unsigned long long*)(Ob + (size_t)m2 * DM) + lane;
#pragma unroll
            for (int j = 0; j < 4; ++j) ob[64 * j] = (unsigned long long)pk2(vb[j].x, vb[j].y) | ((unsigned long long)pk2(vb[j].z, vb[j].w) << 32);
            if (lane == 0) rstd[m2] = __builtin_amdgcn_rsqf(sb * (1.0f / DM) + EPS); }
    }
}

struct Unit { int pm, pn; };
struct Sched {
    int nM, nN, nwg, G, c, K, ld, off0, off1, per;
    const char* A; const char* B; const int* bexp; size_t estride;
    __device__ void init(const void* A_, const void* B_, int K_, int nM_, int nN_, int G_, int c_, const int* bexp_ = nullptr, size_t estride_ = 0) {
        A = (const char*)A_; B = (const char*)B_; K = K_; ld = K_; nM = nM_; nN = nN_; nwg = nM * nN; G = G_; c = c_; bexp = bexp_; estride = estride_; off0 = 0; off1 = 0x7fffffff; per = G_ / 8; }
    __device__ void range(int off0_, int off1_, int per_) { off0 = off0_; off1 = off1_; per = per_; }
    __device__ bool next(int i, Unit& u) const {
        const int q = nwg / 8, r = nwg % 8, xcd = c % 8, slot = c / 8, lt = (int)((unsigned)(xcd - r) >> 31), qx = q + lt;
        if (slot >= per) return false;
        const int off = off0 + i * per + slot, lim = off1 < qx ? off1 : qx;
        if (off >= lim) return false;
        const int wgid = xcd * q + (lt ? xcd : r) + off;
        const int nig = 8 * nN, gid = wgid / nig, fm = gid * 8, gsz = (nM - fm) < 8 ? (nM - fm) : 8;
        u.pm = fm + ((wgid % nig) % gsz); u.pn = (wgid % nig) / gsz; return true;
    }
    __device__ const char* a_base(const Unit& u) const { return A + (size_t)u.pm * 512 * ld; }
    __device__ const char* b_base(const Unit& u) const { return B + (bexp ? (size_t)bexp[u.pm] * estride : (size_t)0) + (size_t)u.pn * 512 * ld; }
};

struct NoAux {};
__device__ __forceinline__ float rstd_from(const float* rss16) {
    const f32x4* p = (const f32x4*)rss16; f32x4 a = p[0], b = p[1], c = p[2], d = p[3];
    const float s = ((a.x + a.y) + (a.z + a.w)) + ((b.x + b.y) + (b.z + b.w)) + ((c.x + c.y) + (c.z + c.w)) + ((d.x + d.y) + (d.z + d.w));
    return __builtin_amdgcn_rsqf(s * (1.0f / DM) + EPS);
}
__device__ __forceinline__ float rstd_from_lds(const LAS float* rss16) {
    const LAS f32x4* p = (const LAS f32x4*)rss16; f32x4 a = p[0], b = p[1], c = p[2], d = p[3];
    const float s = ((a.x + a.y) + (a.z + a.w)) + ((b.x + b.y) + (b.z + b.w)) + ((c.x + c.y) + (c.z + c.w)) + ((d.x + d.y) + (d.z + d.w));
    return __builtin_amdgcn_rsqf(s * (1.0f / DM) + EPS);
}
constexpr int RSS_LDS_REL = 2048;
struct RowCtx { float rs[2][4]; };
template <bool RSS = false> struct EpiRowScaleT {
    static constexpr bool NEED_SS = false; static constexpr int SC_MODE = RSS ? 5 : 1; typedef RowCtx Ctx; typedef NoAux Aux;
    bf16* O; int ldc; const float* sc_src; float mul;
    __device__ __forceinline__ void begin(Ctx& c, const LAS float* sc, const LAS int*, int lr0, int, int, int) const {
#pragma unroll
        for (int ai = 0; ai < 2; ++ai)
#pragma unroll
            for (int m = 0; m < 4; ++m) c.rs[ai][m] = sc[ai * 128 + lr0 + m * 16] * mul;
    }
    __device__ __forceinline__ void load_aux(Aux&, const Ctx&, int, int, int, int, int) const {}
    __device__ __forceinline__ float apply(const Ctx& c, const Aux&, int ai, int m, int row, int pn, int c128, const float (&a)[8], const float (&b)[8]) const {
        const float s = c.rs[ai][m];
        bf16* p = O + (size_t)row * ldc + pn * 256 + c128;
        v4u w; w.x = pk2(a[0] * s, a[1] * s); w.y = pk2(a[2] * s, a[3] * s); w.z = pk2(a[4] * s, a[5] * s); w.w = pk2(a[6] * s, a[7] * s); *(v4u*)p = w;
        w.x = pk2(b[0] * s, b[1] * s); w.y = pk2(b[2] * s, b[3] * s); w.z = pk2(b[4] * s, b[5] * s); w.w = pk2(b[6] * s, b[7] * s); *(v4u*)(p + 128) = w;
        return 0.f;
    }
    __device__ __forceinline__ void row_done(int, int, int, float) const {}
};
typedef EpiRowScaleT<false> EpiRowScale;
struct ColCtx { float sa[8], sb[8]; };
template <bool RSS = false> struct EpiColScaleT {
    static constexpr bool NEED_SS = false; static constexpr int SC_MODE = RSS ? 6 : 2; typedef ColCtx Ctx; typedef NoAux Aux;
    bf16* O; int ldc; const float* sc_src;
    __device__ __forceinline__ void begin(Ctx& c, const LAS float* sc, const LAS int*, int, int, int, int c128) const {
#pragma unroll
        for (int j = 0; j < 8; ++j) { c.sa[j] = sc[c128 + j]; c.sb[j] = sc[128 + c128 + j]; }
    }
    __device__ __forceinline__ void load_aux(Aux&, const Ctx&, int, int, int, int, int) const {}
    __device__ __forceinline__ float apply(const Ctx& c, const Aux&, int, int, int row, int pn, int c128, const float (&a)[8], const float (&b)[8]) const {
        bf16* p = O + (size_t)row * ldc + pn * 256 + c128;
        v4u w; w.x = pk2(a[0] * c.sa[0], a[1] * c.sa[1]); w.y = pk2(a[2] * c.sa[2], a[3] * c.sa[3]); w.z = pk2(a[4] * c.sa[4], a[5] * c.sa[5]); w.w = pk2(a[6] * c.sa[6], a[7] * c.sa[7]); *(v4u*)p = w;
        w.x = pk2(b[0] * c.sb[0], b[1] * c.sb[1]); w.y = pk2(b[2] * c.sb[2], b[3] * c.sb[3]); w.z = pk2(b[4] * c.sb[4], b[5] * c.sb[5]); w.w = pk2(b[6] * c.sb[6], b[7] * c.sb[7]); *(v4u*)(p + 128) = w;
        return 0.f;
    }
    __device__ __forceinline__ void row_done(int, int, int, float) const {}
};
typedef EpiColScaleT<false> EpiColScale;
struct Aux4 { f32x4 v[4]; };
struct NoCtx {};
struct AuxR { f32x4 v[4]; };
struct AuxB { v4u a, b; };
__device__ __forceinline__ void unpack16(const AuxB& x, f32x4 (&v)[4]) {
    v[0] = (f32x4){bflo(x.a.x), bfhi(x.a.x), bflo(x.a.y), bfhi(x.a.y)}; v[1] = (f32x4){bflo(x.a.z), bfhi(x.a.z), bflo(x.a.w), bfhi(x.a.w)};
    v[2] = (f32x4){bflo(x.b.x), bfhi(x.b.x), bflo(x.b.y), bfhi(x.b.y)}; v[3] = (f32x4){bflo(x.b.z), bfhi(x.b.z), bflo(x.b.w), bfhi(x.b.w)}; }
template <bool F32> struct AuxSel { typedef AuxR T; };
template <> struct AuxSel<false> { typedef AuxB T; };
template <bool RF32> struct EpiResid {
    static constexpr bool NEED_SS = true; static constexpr int SC_MODE = 0; typedef NoCtx Ctx; typedef typename AuxSel<RF32>::T Aux;
    const float* R; bf16* HB; float* rss; bf16* HB2;
    __device__ __forceinline__ void begin(Ctx&, const LAS float*, const LAS int*, int, int, int, int) const {}
    __device__ __forceinline__ void load_aux(Aux& x, const Ctx&, int, int, int row, int pn, int c128) const {
        const size_t off = (size_t)row * DM + pn * 256 + c128;
        if constexpr (RF32) { const float* p = R + off; x.v[0] = *(const f32x4*)p; x.v[1] = *(const f32x4*)(p + 4); x.v[2] = *(const f32x4*)(p + 128); x.v[3] = *(const f32x4*)(p + 132); }
        else { x.a = *(const v4u*)(HB + off); x.b = *(const v4u*)(HB + off + 128); }
    }
    __device__ __forceinline__ float apply(const Ctx&, const Aux& xr, int, int, int row, int pn, int c128, const float (&a)[8], const float (&b)[8]) const {
        const size_t off = (size_t)row * DM + pn * 256 + c128;
        struct { f32x4 v[4]; } x; if constexpr (RF32) { x.v[0] = xr.v[0]; x.v[1] = xr.v[1]; x.v[2] = xr.v[2]; x.v[3] = xr.v[3]; } else unpack16(xr, x.v);
        const f32x4 h0 = {x.v[0].x + a[0], x.v[0].y + a[1], x.v[0].z + a[2], x.v[0].w + a[3]}, h1 = {x.v[1].x + a[4], x.v[1].y + a[5], x.v[1].z + a[6], x.v[1].w + a[7]};
        const f32x4 h2 = {x.v[2].x + b[0], x.v[2].y + b[1], x.v[2].z + b[2], x.v[2].w + b[3]}, h3 = {x.v[3].x + b[4], x.v[3].y + b[5], x.v[3].z + b[6], x.v[3].w + b[7]};
        v4u w; w.x = pk2(h0.x, h0.y); w.y = pk2(h0.z, h0.w); w.z = pk2(h1.x, h1.y); w.w = pk2(h1.z, h1.w); *(v4u*)(HB + off) = w; if (HB2) { v2u f; f.x = pk4_fp8(h0.x, h0.y, h0.z, h0.w); f.y = pk4_fp8(h1.x, h1.y, h1.z, h1.w); *(v2u*)((unsigned char*)HB2 + off) = f; }
        w.x = pk2(h2.x, h2.y); w.y = pk2(h2.z, h2.w); w.z = pk2(h3.x, h3.y); w.w = pk2(h3.z, h3.w); *(v4u*)(HB + off + 128) = w; if (HB2) { v2u f; f.x = pk4_fp8(h2.x, h2.y, h2.z, h2.w); f.y = pk4_fp8(h3.x, h3.y, h3.z, h3.w); *(v2u*)((unsigned char*)HB2 + off + 128) = f; }
        return ((h0.x * h0.x + h0.y * h0.y) + (h0.z * h0.z + h0.w * h0.w) + (h1.x * h1.x + h1.y * h1.y) + (h1.z * h1.z + h1.w * h1.w))
             + ((h2.x * h2.x + h2.y * h2.y) + (h2.z * h2.z + h2.w * h2.w) + (h3.x * h3.x + h3.y * h3.y) + (h3.z * h3.z + h3.w * h3.w));
    }
    __device__ __forceinline__ void row_done(int row, int pn, int wc, float ss) const { rss[(size_t)row * 16 + pn * 4 + wc] = ss; }
};
__device__ __forceinline__ float silu_mul(float g, float u) { return g * __builtin_amdgcn_rcpf(1.0f + __builtin_amdgcn_exp2f(g * -1.4426950408889634f)) * u; }
template <bool MOE, bool RSS = false> struct EpiSwiGLU {
    static constexpr bool NEED_SS = false; static constexpr int SC_MODE = MOE ? 3 : (RSS ? 5 : 1); typedef RowCtx Ctx; typedef NoAux Aux;
    bf16* Hm; int ldh; const float* sc_src; bf16* Hmt;
    __device__ __forceinline__ void begin(Ctx& c, const LAS float* sc, const LAS int* tl, int lr0, int, int, int) const {
#pragma unroll
        for (int ai = 0; ai < 2; ++ai)
#pragma unroll
            for (int m = 0; m < 4; ++m) { const int i = ai * 128 + lr0 + m * 16; float r = sc[i];
                if (MOE) { r *= 0.03125f; if (tl[i] < 0) r = 0.f; } c.rs[ai][m] = r; }
    }
    __device__ __forceinline__ void load_aux(Aux&, const Ctx&, int, int, int, int, int) const {}
    __device__ __forceinline__ float apply(const Ctx& c, const Aux&, int ai, int m, int row, int pn, int c128, const float (&a)[8], const float (&b)[8]) const {
        const float s = c.rs[ai][m]; float o[8];
#pragma unroll
        for (int j = 0; j < 8; ++j) o[j] = silu_mul(a[j] * s, b[j] * s);
        v4u w; w.x = pk2(o[0], o[1]); w.y = pk2(o[2], o[3]); w.z = pk2(o[4], o[5]); w.w = pk2(o[6], o[7]);
        if constexpr (MOE) {
            unsigned char* rp = (row >= NT) ? (unsigned char*)Hmt + (size_t)(row - NT) * ldh : (unsigned char*)Hm + (size_t)row * ldh;
            v2u f; f.x = pk4_fp8(o[0], o[1], o[2], o[3]); f.y = pk4_fp8(o[4], o[5], o[6], o[7]); *(v2u*)(rp + pn * 128 + c128) = f;
        } else *(v4u*)(Hm + (size_t)row * ldh + pn * 128 + c128) = w;
        return 0.f;
    }
    __device__ __forceinline__ void row_done(int, int, int, float) const {}
};

namespace pg8 {
constexpr int HTB = 16384, TOK_OFF = 132096, SC_OFF = 134144;
__device__ __forceinline__ int lds_byte(int r, int c) { const int st = (r >> 4) * 2 + (c >> 5), rr = r & 15, cc = c & 31, ob = rr * 64 + cc * 2; return st * 1024 + (ob ^ (((ob >> 9) & 1) << 5)); }
__device__ __forceinline__ void stage_rc(int b, int& R, int& C) { const int st = b / 1024, sb = b % 1024, swz = sb ^ (((sb >> 9) & 1) << 5); R = (st >> 1) * 16 + swz / 64; C = (st & 1) * 32 + (swz % 64) / 2; }
__device__ __forceinline__ int perm32(int rho) { const int n = rho >> 4, i = rho & 15; return 8 * (i >> 2) + 4 * n + (i & 3); }

template <class Epi>
__device__ __forceinline__ void run_epi(const Epi& E, const f32x4 (&acc)[2][2][4][2], const Unit& u, int wr, int wc, int fr, int fq, const LAS float* sc, const LAS int* tlp) {
    int row0 = u.pm * 256 + wr * 64 + fr, c128 = 32 * wc + 8 * fq;
    asm volatile("" : "+v"(row0), "+v"(c128));
    typename Epi::Ctx ctx; E.begin(ctx, sc, tlp, wr * 64 + fr, row0, u.pn, c128);
#pragma unroll
    for (int ai = 0; ai < 2; ++ai) {
        typename Epi::Aux aux[4];
#pragma unroll
        for (int m = 0; m < 4; ++m) E.load_aux(aux[m], ctx, ai, m, row0 + ai * 128 + m * 16, u.pn, c128);
#pragma unroll
        for (int m = 0; m < 4; ++m) {
            const int row = row0 + ai * 128 + m * 16;
            float a[8], b[8];
#pragma unroll
            for (int j = 0; j < 8; ++j) { a[j] = acc[ai][0][m][j >> 2][j & 3]; b[j] = acc[ai][1][m][j >> 2][j & 3]; }
            float ss = E.apply(ctx, aux[m], ai, m, row, u.pn, c128, a, b);
            if (Epi::NEED_SS) { ss += __shfl_xor(ss, 16); ss += __shfl_xor(ss, 32); if (fq == 0) E.row_done(row, u.pn, wc, ss); }
        }
    }
}

typedef int v8i __attribute__((ext_vector_type(8)));
template <class Epi, bool GATHER, bool FP8 = false>
__device__ __forceinline__ void gemm_fast(LAS unsigned char* lds, const Sched& S, const Epi& E, const int* gtok, int wave_) {
    int tid = (wave_ << 6) | lane_id(); asm volatile("" : "+v"(tid));
    const int wid = __builtin_amdgcn_readfirstlane(tid >> 6), lane = tid & 63, wr = wid >> 2, wc = wid & 3, fr = lane & 15, fq = lane >> 4;
    const int K = S.ld, nt = S.K / 64;
    unsigned voffB[2], vA0[2], vA1[2], nA0[2], nA1[2]; int RA[2], CA2[2];
#pragma unroll
    for (int i = 0; i < 2; ++i) { int R, C; stage_rc(tid * 16 + i * 8192, R, C); const int Rb = (R & ~31) + perm32(R & 31);
        voffB[i] = (unsigned)(Rb * K + C) * 2u; RA[i] = R; CA2[i] = C * 2; vA0[i] = (unsigned)(R * K + C) * 2u; vA1[i] = vA0[i] + (unsigned)(128 * K * 2); nA0[i] = vA0[i]; nA1[i] = vA1[i]; }
    const size_t kstep = 128;
    const size_t hstep = (size_t)128 * K * 2;
    const unsigned ldsw = (unsigned)wid * 1024u;
    const int aoff = lds_byte(wr * 64 + fr, fq * 8), boff = lds_byte(wc * 32 + fr, fq * 8);
    LAS int* tl = (LAS int*)(lds + TOK_OFF);
#define PG8_SA(b, h) (((b) * 2 + (h)) * HTB)
#define PG8_SB(b, h) ((4 + (b) * 2 + (h)) * HTB)
#define PG8_STAGE(bufoff, gbase, voff) do { _Pragma("unroll") for (int _i = 0; _i < 2; ++_i) \
        __builtin_amdgcn_global_load_lds((const unsigned*)((const char*)(gbase) + (voff)[_i]), (LAS unsigned*)(lds + (bufoff) + ldsw + _i * 8192), 16, 0, 0); } while (0)
#define PG8_LDA(dst, b, h) do { _Pragma("unroll") for (int m = 0; m < 4; ++m) _Pragma("unroll") for (int k = 0; k < 2; ++k) dst[m][k] = *(const LAS bf16x8*)(lds + PG8_SA(b, h) + aoff + m * 2048 + k * 1024); } while (0)
#define PG8_LDB(dst, b, h) do { _Pragma("unroll") for (int n = 0; n < 2; ++n) _Pragma("unroll") for (int k = 0; k < 2; ++k) dst[n][k] = *(const LAS bf16x8*)(lds + PG8_SB(b, h) + boff + n * 2048 + k * 1024); } while (0)
#define PG8_MMA(ai, bj, At, Bt) do { __builtin_amdgcn_s_setprio(1); _Pragma("unroll") for (int m = 0; m < 4; ++m) _Pragma("unroll") for (int n = 0; n < 2; ++n) { \
        if constexpr (FP8) { const v8i b8_ = __builtin_bit_cast(v8i, __builtin_shufflevector(Bt[n][0], Bt[n][1], 0, 1, 2, 3, 4, 5, 6, 7, 8, 9, 10, 11, 12, 13, 14, 15)), a8_ = __builtin_bit_cast(v8i, __builtin_shufflevector(At[m][0], At[m][1], 0, 1, 2, 3, 4, 5, 6, 7, 8, 9, 10, 11, 12, 13, 14, 15)); \
            asm volatile("v_mfma_f32_16x16x128_f8f6f4 %0, %1, %2, %0" : "+v"(acc[ai][bj][m][n]) : "v"(b8_), "v"(a8_)); }     \
        else { _Pragma("unroll") for (int k = 0; k < 2; ++k) acc[ai][bj][m][n] = __builtin_amdgcn_mfma_f32_16x16x32_bf16(Bt[n][k], At[m][k], acc[ai][bj][m][n], 0, 0, 0); } } \
        __builtin_amdgcn_s_setprio(0); } while (0)
#define PG8_WAIT_V(n) asm volatile("s_waitcnt vmcnt(" #n ")" ::: "memory")
#define PG8_WAIT_L(n) asm volatile("s_waitcnt lgkmcnt(" #n ")" ::: "memory")
#define PG8_BAR __builtin_amdgcn_s_barrier()
#define PG8_SCHED __builtin_amdgcn_sched_barrier(0)
#define PG8_IDS_DMA(pm_, par_) do { if (wid < 4) __builtin_amdgcn_global_load_lds((const unsigned*)(gtok + (pm_) * 256 + wid * 64 + lane), (LAS unsigned*)(lds + TOK_OFF + (par_) * 1024 + wid * 256), 4, 0, 0); } while (0)
#define PG8_IDS_READ(d0, d1, par_) do { _Pragma("unroll") for (int _i = 0; _i < 2; ++_i) { int t0 = tl[(par_) * 256 + RA[_i]], t1 = tl[(par_) * 256 + 128 + RA[_i]]; t0 = t0 < 0 ? 0 : t0; t1 = t1 < 0 ? 0 : t1; \
        d0[_i] = (unsigned)t0 * (unsigned)(K * 2) + (unsigned)CA2[_i]; d1[_i] = (unsigned)t1 * (unsigned)(K * 2) + (unsigned)CA2[_i]; } } while (0)
    Unit cur, nxt; int ui = 0, par = 0;
    if (!S.next(0, cur)) return;
    f32x4 acc[2][2][4][2];
#pragma unroll
    for (int a = 0; a < 2; ++a)
#pragma unroll
        for (int b = 0; b < 2; ++b)
#pragma unroll
            for (int m = 0; m < 4; ++m)
#pragma unroll
                for (int n = 0; n < 2; ++n) acc[a][b][m][n] = (f32x4){0.f, 0.f, 0.f, 0.f};
    bf16x8 At[4][2], B0[2][2], B1[2][2];
    const char* cA = GATHER ? S.A : S.a_base(cur); const char* cB = S.b_base(cur);
    if constexpr (GATHER) { PG8_IDS_DMA(cur.pm, 0); PG8_WAIT_V(0); __syncthreads(); PG8_IDS_READ(vA0, vA1, 0); }
    PG8_STAGE(PG8_SB(0, 0), cB, voffB); PG8_STAGE(PG8_SB(0, 1), cB + hstep, voffB); PG8_STAGE(PG8_SA(0, 0), cA, vA0); PG8_STAGE(PG8_SA(0, 1), cA, vA1);
    if (wr == 1) PG8_BAR;
    PG8_WAIT_V(2); PG8_BAR;
    PG8_STAGE(PG8_SB(1, 0), cB + kstep, voffB); PG8_STAGE(PG8_SA(1, 0), cA + kstep, vA0); PG8_STAGE(PG8_SB(1, 1), cB + hstep + kstep, voffB);
    PG8_WAIT_V(6); PG8_BAR;
    for (;;) {
        const bool has_next = S.next(ui + 1, nxt);
        const char* nA = has_next ? (GATHER ? S.A : S.a_base(nxt)) : cA; const char* nB = has_next ? S.b_base(nxt) : cB;
        for (int t = 0; t < nt; t += 2) {
            const bool last = (t == nt - 2);
            if constexpr (GATHER) {
                if (t == nt - 4 && has_next) PG8_IDS_DMA(nxt.pm, par ^ 1);
                if (last) { if (has_next) PG8_IDS_READ(nA0, nA1, par ^ 1); else { nA0[0] = vA0[0]; nA0[1] = vA0[1]; nA1[0] = vA1[0]; nA1[1] = vA1[1]; } }
            }
            if constexpr (Epi::SC_MODE == 5 || Epi::SC_MODE == 6) {
                if (last) { const float* src_ = E.sc_src + (size_t)(Epi::SC_MODE == 5 ? cur.pm : cur.pn) * 4096 + wid * 512 + lane * 4;
                    __builtin_amdgcn_global_load_lds((const unsigned*)src_, (LAS unsigned*)(lds + SC_OFF + RSS_LDS_REL + wid * 2048), 16, 0, 0);
                    __builtin_amdgcn_global_load_lds((const unsigned*)(src_ + 256), (LAS unsigned*)(lds + SC_OFF + RSS_LDS_REL + wid * 2048 + 1024), 16, 0, 0); }
            } else if constexpr (Epi::SC_MODE != 0) {
                if (last && wid < 4) { const int i_ = wid * 64 + lane; LAS unsigned* d_ = (LAS unsigned*)(lds + SC_OFF + wid * 256);
                    if constexpr (Epi::SC_MODE == 1) __builtin_amdgcn_global_load_lds((const unsigned*)(E.sc_src + cur.pm * 256 + i_), d_, 4, 0, 0);
                    if constexpr (Epi::SC_MODE == 2) __builtin_amdgcn_global_load_lds((const unsigned*)(E.sc_src + cur.pn * 256 + i_), d_, 4, 0, 0);
                    if constexpr (Epi::SC_MODE == 3) { int t_ = tl[par * 256 + i_]; t_ = t_ < 0 ? 0 : t_; __builtin_amdgcn_global_load_lds((const unsigned*)(E.sc_src + t_), d_, 4, 0, 0); }
                    if constexpr (Epi::SC_MODE == 4) { __builtin_amdgcn_global_load_lds((const unsigned*)(E.tok + cur.pm * 256 + i_), d_, 4, 0, 0);
                        __builtin_amdgcn_global_load_lds((const unsigned*)(E.w + cur.pm * 256 + i_), (LAS unsigned*)(lds + SC_OFF + 1024 + wid * 256), 4, 0, 0); } }
            }
            const char* a1 = cA + (size_t)(t + 1) * kstep;
            const char* a2 = last ? nA : cA + (size_t)(t + 2) * kstep; const char* b2 = last ? nB : cB + (size_t)(t + 2) * kstep;
            const char* a3 = a2 + kstep; const char* b3 = b2 + kstep;
            unsigned w0[2], w1[2];
            if (GATHER && last) { w0[0] = nA0[0]; w0[1] = nA0[1]; w1[0] = nA1[0]; w1[1] = nA1[1]; } else { w0[0] = vA0[0]; w0[1] = vA0[1]; w1[0] = vA1[0]; w1[1] = vA1[1]; }
            PG8_LDB(B0, 0, 0); PG8_LDB(B1, 0, 1); PG8_SCHED; PG8_LDA(At, 0, 0); PG8_STAGE(PG8_SA(1, 1), a1, vA1);
            PG8_WAIT_V(8); PG8_WAIT_L(0); PG8_BAR; PG8_MMA(0, 0, At, B0); PG8_MMA(0, 1, At, B1); PG8_BAR; PG8_SCHED;
            PG8_LDA(At, 0, 1); PG8_STAGE(PG8_SB(0, 0), b2, voffB); PG8_STAGE(PG8_SB(0, 1), b2 + hstep, voffB); PG8_STAGE(PG8_SA(0, 0), a2, w0);
            PG8_WAIT_V(8); PG8_WAIT_L(0); PG8_BAR; PG8_MMA(1, 0, At, B0); PG8_MMA(1, 1, At, B1); PG8_BAR; PG8_SCHED;
            PG8_LDB(B0, 1, 0); PG8_LDB(B1, 1, 1); PG8_SCHED; PG8_LDA(At, 1, 0); PG8_STAGE(PG8_SA(0, 1), a2, w1);
            PG8_WAIT_V(8); PG8_WAIT_L(0); PG8_BAR; PG8_MMA(0, 0, At, B0); PG8_MMA(0, 1, At, B1); PG8_BAR; PG8_SCHED;
            PG8_LDA(At, 1, 1); PG8_STAGE(PG8_SB(1, 0), b3, voffB); PG8_STAGE(PG8_SB(1, 1), b3 + hstep, voffB); PG8_STAGE(PG8_SA(1, 0), a3, w0);
            PG8_WAIT_V(8); PG8_WAIT_L(0); PG8_BAR; PG8_MMA(1, 0, At, B0); PG8_MMA(1, 1, At, B1); PG8_BAR; PG8_SCHED;
        }
        if constexpr (FP8) asm volatile("s_nop 15\n\ts_nop 15" ::: "memory");
        if (wr == 0) PG8_BAR;
        if constexpr (Epi::SC_MODE == 5 || Epi::SC_MODE == 6) {
            if (wid < 4) ((LAS float*)(lds + SC_OFF))[tid] = rstd_from_lds((const LAS float*)(lds + SC_OFF + RSS_LDS_REL) + tid * 16);
            PG8_WAIT_L(0); PG8_BAR;
        }
        run_epi(E, acc, cur, wr, wc, fr, fq, (const LAS float*)(lds + SC_OFF), (const LAS int*)(lds + TOK_OFF + par * 1024));
        if (!has_next) break;
#pragma unroll
        for (int a = 0; a < 2; ++a)
#pragma unroll
            for (int b = 0; b < 2; ++b)
#pragma unroll
                for (int m = 0; m < 4; ++m)
#pragma unroll
                    for (int n = 0; n < 2; ++n) acc[a][b][m][n] = (f32x4){0.f, 0.f, 0.f, 0.f};
        cur = nxt; cA = nA; cB = nB; ++ui;
        if constexpr (GATHER) { vA0[0] = nA0[0]; vA0[1] = nA0[1]; vA1[0] = nA1[0]; vA1[1] = nA1[1]; par ^= 1; }
        if (wr == 1) PG8_BAR;
    }
    PG8_WAIT_V(0);
    PG8_BAR;
#undef PG8_SA
#undef PG8_SB
#undef PG8_STAGE
#undef PG8_LDA
#undef PG8_LDB
#undef PG8_MMA
#undef PG8_WAIT_V
#undef PG8_WAIT_L
#undef PG8_BAR
#undef PG8_SCHED
#undef PG8_IDS_DMA
#undef PG8_IDS_READ
}
}

template <class Epi, bool GATHER, bool FP8 = false>
__device__ __forceinline__ void gemm_run(LAS unsigned char* lds, const Sched& S, const Epi& E, const int* gtok, int wave_) { pg8::gemm_fast<Epi, GATHER, FP8>(lds, S, E, gtok, wave_); }

typedef short s16x4 __attribute__((ext_vector_type(4)));
template <bool NA, bool KLDS = false, int VLDS = 0, int KRS = 64>
__device__ __forceinline__ void attn16(int lane, const bf16* Q, int ldq, const bf16* Kb, int ldk, const bf16* Vt, int ldv, int ktok0, int trs, bf16* O, int ldo,
                                       const LAS float* rpb_h, int r, int r0, int jb, int band0, const LAS unsigned char* Kl = nullptr, int arow0 = 0, const LAS unsigned char* Vl = nullptr, int kb0 = 0) {
    const int qi = lane & 15, g = lane >> 4;
    bf16x8 qf[2];
#pragma unroll
    for (int ks = 0; ks < 2; ++ks) qf[ks] = *(const bf16x8*)(Q + (size_t)qi * ldq + ks * 32 + 8 * g);
    f32x4 s[16];
    const int krow = 8 * (qi >> 2) + (qi & 3);
#pragma unroll
    for (int t = 0; t < 16; ++t) {
        bf16x8 k0, k1;
        if constexpr (KLDS) {
            const int kcol = kb0 + krow + 4 * (t & 1), swz = (((kcol >> 3) & 3) << 1) | ((kcol >> 1) & 1);
            const LAS unsigned char* kb = Kl + ((arow0 + (t >> 1)) * KRS + kcol) * 128;
            k0 = *(const LAS bf16x8*)(kb + ((g ^ swz) << 4)); k1 = *(const LAS bf16x8*)(kb + (((4 + g) ^ swz) << 4));
        } else {
            const bf16* kp = Kb + (size_t)(ktok0 + (t >> 1) * trs + krow + 4 * (t & 1)) * ldk + 8 * g;
            k0 = *(const bf16x8*)kp; k1 = *(const bf16x8*)(kp + 32);
        }
        f32x4 z = {0.f, 0.f, 0.f, 0.f};
        z = __builtin_amdgcn_mfma_f32_16x16x32_bf16(k0, qf[0], z, 0, 0, 0);
        z = __builtin_amdgcn_mfma_f32_16x16x32_bf16(k1, qf[1], z, 0, 0, 0);
        s[t] = z;
        if constexpr (KLDS) { if ((t & 3) == 3) __builtin_amdgcn_sched_barrier(0); }
    }
    bf16x8 vfa[VLDS ? 1 : 4][VLDS ? 1 : 8];
    if constexpr (!VLDS) {
#pragma unroll
        for (int mt = 0; mt < 4; ++mt)
#pragma unroll
            for (int kk = 0; kk < 8; ++kk) vfa[mt][kk] = *(const bf16x8*)(Vt + (size_t)(16 * mt + qi) * ldv + ktok0 + kk * trs + 8 * g);
        __builtin_amdgcn_sched_barrier(0);
    }
    float m = -INFINITY;
    if constexpr (NA) {
        const int qc = 16 * jb + qi, cs = min(max(qc - 8, 0), 48);
        const LAS float* bp = rpb_h + (r0 - r + 7) * 31 + (band0 + 8 * g - qc + 15);
        bool ok[2][4];
#pragma unroll
        for (int hh = 0; hh < 2; ++hh)
#pragma unroll
            for (int i = 0; i < 4; ++i) { const int kc = band0 + 8 * g + 4 * hh + i; ok[hh][i] = (kc >= cs) && (kc < cs + 16); }
#pragma unroll
        for (int tq = 0; tq < 4; ++tq) {
            float bv[4][4];
#pragma unroll
            for (int tt = 0; tt < 4; ++tt)
#pragma unroll
                for (int i = 0; i < 4; ++i) { const int t = 4 * tq + tt; bv[tt][i] = bp[(t >> 1) * 31 + 4 * (t & 1) + i]; }
#pragma unroll
            for (int tt = 0; tt < 4; ++tt)
#pragma unroll
                for (int i = 0; i < 4; ++i) asm volatile("" : "+v"(bv[tt][i]));
#pragma unroll
            for (int tt = 0; tt < 4; ++tt)
#pragma unroll
                for (int i = 0; i < 4; ++i) { const int t = 4 * tq + tt;
                    const float v = ok[t & 1][i] ? s[t][i] + bv[tt][i] : -INFINITY;
                    s[t][i] = v; m = fmaxf(m, v); }
        }
    } else {
#pragma unroll
        for (int t = 0; t < 16; ++t)
#pragma unroll
            for (int i = 0; i < 4; ++i) m = fmaxf(m, s[t][i]);
    }
    m = fmaxf(m, __shfl_xor(m, 16)); m = fmaxf(m, __shfl_xor(m, 32));
    float l = 0.f;
    bf16x8 pf[8];
#pragma unroll
    for (int kk = 0; kk < 8; ++kk) {
        float p[8];
#pragma unroll
        for (int i = 0; i < 4; ++i) { p[i] = __builtin_amdgcn_exp2f(s[2 * kk][i] - m); p[4 + i] = __builtin_amdgcn_exp2f(s[2 * kk + 1][i] - m); }
#pragma unroll
        for (int i = 0; i < 8; ++i) l += p[i];
        v4u w; w.x = pk2(p[0], p[1]); w.y = pk2(p[2], p[3]); w.z = pk2(p[4], p[5]); w.w = pk2(p[6], p[7]);
        pf[kk] = __builtin_bit_cast(bf16x8, w);
    }
    l += __shfl_xor(l, 16); l += __shfl_xor(l, 32);
    const float inv = __builtin_amdgcn_rcpf(l);
#pragma unroll
    for (int mt = 0; mt < 4; ++mt) {
        f32x4 acc = {0.f, 0.f, 0.f, 0.f};
#pragma unroll
        for (int kk = 0; kk < 8; ++kk) {
            bf16x8 vf; if constexpr (VLDS == 1) vf = *(const LAS bf16x8*)(Vl + (16 * mt + qi) * 512 + (((4 * kk + g) ^ qi) << 4));
            else if constexpr (VLDS == 2) vf = *(const LAS bf16x8*)(Vl + (16 * mt + qi) * 1200 + ((arow0 + kk) * 40 + kb0 + 8 * g) * 2);
            else vf = vfa[mt][kk];
            acc = __builtin_amdgcn_mfma_f32_16x16x32_bf16(vf, pf[kk], acc, 0, 0, 0);
        }
        v2u w; w.x = pk2(acc[0] * inv, acc[1] * inv); w.y = pk2(acc[2] * inv, acc[3] * inv);
        *(v2u*)(O + (size_t)qi * ldo + 16 * mt + 4 * g) = w;
        if constexpr (VLDS) __builtin_amdgcn_sched_barrier(0);
    }
}
template <bool NA, int VMODE, int KRS>
__device__ __forceinline__ void attn16_lds(int lane, const bf16* Q, int ldq, bf16* O, int ldo, const LAS float* rpb_h, int r, int r0, int jb, int band0,
                                           const LAS unsigned char* Kl, int arow0, const LAS unsigned char* Vl, int kb0) {
    const int qi = lane & 15, g = lane >> 4;
    bf16x8 qf[2];
#pragma unroll
    for (int ks = 0; ks < 2; ++ks) qf[ks] = *(const bf16x8*)(Q + (size_t)qi * ldq + ks * 32 + 8 * g);
    const int krow = 8 * (qi >> 2) + (qi & 3);
    const LAS unsigned char* kbase[2][2];
#pragma unroll
    for (int e = 0; e < 2; ++e) { const int kcol = kb0 + krow + 4 * e, swz = (((kcol >> 3) & 3) << 1) | ((kcol >> 1) & 1); const LAS unsigned char* rb = Kl + (arow0 * KRS + kcol) * 128;
        kbase[e][0] = rb + ((g ^ swz) << 4); kbase[e][1] = rb + (((4 + g) ^ swz) << 4); }
#define A16_KFR(t, hh) (*(const LAS bf16x8*)(kbase[(t) & 1][hh] + ((t) >> 1) * (KRS * 128)))
    const LAS unsigned char* vbase[VMODE == 1 ? 8 : 1];
    if constexpr (VMODE == 1) {
#pragma unroll
        for (int kk = 0; kk < 8; ++kk) vbase[kk] = Vl + qi * 512 + (((4 * kk + g) ^ qi) << 4);
    } else vbase[0] = Vl + qi * 1200 + (arow0 * 40 + kb0 + 8 * g) * 2;
#define A16_VFR(mt, kk) (VMODE == 1 ? *(const LAS bf16x8*)(vbase[VMODE == 1 ? (kk) : 0] + (mt) * 8192) : *(const LAS bf16x8*)(vbase[0] + (mt) * 19200 + (kk) * 80))
    f32x4 s[16];
    bf16x8 kb[2][4][2];
    float bv[NA ? 16 : 1][4];
    const LAS float* bp = nullptr;
    if constexpr (NA) { const int qc = 16 * jb + qi; bp = rpb_h + (r0 - r + 7) * 31 + (band0 + 8 * g - qc + 15); }
#pragma unroll
    for (int tt = 0; tt < 4; ++tt) { kb[0][tt][0] = A16_KFR(tt, 0); kb[0][tt][1] = A16_KFR(tt, 1); }
#pragma unroll
    for (int gi = 0; gi < 4; ++gi) {
        if (gi < 3) {
#pragma unroll
            for (int tt = 0; tt < 4; ++tt) { kb[(gi + 1) & 1][tt][0] = A16_KFR(4 * (gi + 1) + tt, 0); kb[(gi + 1) & 1][tt][1] = A16_KFR(4 * (gi + 1) + tt, 1); }
        } else if constexpr (NA) {
#pragma unroll
            for (int t = 0; t < 16; ++t)
#pragma unroll
                for (int i = 0; i < 4; ++i) bv[t][i] = bp[(t >> 1) * 31 + 4 * (t & 1) + i];
        }
        __builtin_amdgcn_sched_barrier(0);
#pragma unroll
        for (int tt = 0; tt < 4; ++tt) { const f32x4 z = {0.f, 0.f, 0.f, 0.f}; s[4 * gi + tt] = __builtin_amdgcn_mfma_f32_16x16x32_bf16(kb[gi & 1][tt][0], qf[0], z, 0, 0, 0); }
#pragma unroll
        for (int tt = 0; tt < 4; ++tt) s[4 * gi + tt] = __builtin_amdgcn_mfma_f32_16x16x32_bf16(kb[gi & 1][tt][1], qf[1], s[4 * gi + tt], 0, 0, 0);
        __builtin_amdgcn_sched_barrier(0);
    }
    bf16x8 vb[2][8];
#pragma unroll
    for (int kk = 0; kk < 8; ++kk) vb[0][kk] = A16_VFR(0, kk);
    __builtin_amdgcn_sched_barrier(0);
    float m = -INFINITY;
    if constexpr (NA) {
        const int qc = 16 * jb + qi, cs = min(max(qc - 8, 0), 48);
        bool ok[2][4];
#pragma unroll
        for (int hh = 0; hh < 2; ++hh)
#pragma unroll
            for (int i = 0; i < 4; ++i) { const int kc = band0 + 8 * g + 4 * hh + i; ok[hh][i] = (kc >= cs) && (kc < cs + 16); }
#pragma unroll
        for (int t = 0; t < 16; ++t)
#pragma unroll
            for (int i = 0; i < 4; ++i) asm volatile("" : "+v"(bv[t][i]));
#pragma unroll
        for (int t = 0; t < 16; ++t)
#pragma unroll
            for (int i = 0; i < 4; ++i) { const float v = ok[t & 1][i] ? s[t][i] + bv[t][i] : -INFINITY; s[t][i] = v; m = fmaxf(m, v); }
    } else {
#pragma unroll
        for (int t = 0; t < 16; ++t)
#pragma unroll
            for (int i = 0; i < 4; ++i) m = fmaxf(m, s[t][i]);
    }
    m = fmaxf(m, __shfl_xor(m, 16)); m = fmaxf(m, __shfl_xor(m, 32));
    float l = 0.f;
    bf16x8 pf[8];
#pragma unroll
    for (int kk = 0; kk < 8; ++kk) {
        float p[8];
#pragma unroll
        for (int i = 0; i < 4; ++i) { p[i] = __builtin_amdgcn_exp2f(s[2 * kk][i] - m); p[4 + i] = __builtin_amdgcn_exp2f(s[2 * kk + 1][i] - m); }
#pragma unroll
        for (int i = 0; i < 8; ++i) l += p[i];
        v4u w; w.x = pk2(p[0], p[1]); w.y = pk2(p[2], p[3]); w.z = pk2(p[4], p[5]); w.w = pk2(p[6], p[7]);
        pf[kk] = __builtin_bit_cast(bf16x8, w);
    }
    l += __shfl_xor(l, 16); l += __shfl_xor(l, 32);
    const float inv = __builtin_amdgcn_rcpf(l);
    __builtin_amdgcn_sched_barrier(0);
#pragma unroll
    for (int mt = 0; mt < 4; ++mt) {
        if (mt < 3) {
#pragma unroll
            for (int kk = 0; kk < 8; ++kk) vb[(mt + 1) & 1][kk] = A16_VFR(mt + 1, kk);
        }
        __builtin_amdgcn_sched_barrier(0);
        f32x4 a0 = {0.f, 0.f, 0.f, 0.f}, a1 = {0.f, 0.f, 0.f, 0.f};
#pragma unroll
        for (int kk = 0; kk < 8; kk += 2) { a0 = __builtin_amdgcn_mfma_f32_16x16x32_bf16(vb[mt & 1][kk], pf[kk], a0, 0, 0, 0); a1 = __builtin_amdgcn_mfma_f32_16x16x32_bf16(vb[mt & 1][kk + 1], pf[kk + 1], a1, 0, 0, 0); }
        v2u w; w.x = pk2((a0[0] + a1[0]) * inv, (a0[1] + a1[1]) * inv); w.y = pk2((a0[2] + a1[2]) * inv, (a0[3] + a1[3]) * inv);
        *(v2u*)(O + (size_t)qi * ldo + 16 * mt + 4 * g) = w;
        __builtin_amdgcn_sched_barrier(0);
    }
#undef A16_KFR
#undef A16_VFR
}
__device__ __forceinline__ void memkv_item(int it, int lane, const bf16* membf, const bf16* wt, const float* mrstd, bf16* memk, bf16* memvt) {
    const int rt = it >> 4, ctile = it & 15, qi = lane & 15, g = lane >> 4, row0 = rt * 16, col0 = ctile * 32;
    const bf16* ap = membf + (size_t)(row0 + qi) * DM + 8 * g; const bf16* bp = wt + (size_t)(col0 + qi) * DM + 8 * g;
    f32x4 acc0 = {0.f, 0.f, 0.f, 0.f}, acc1 = {0.f, 0.f, 0.f, 0.f};
    const bool isk = col0 < 256;
#pragma unroll 8
    for (int ks = 0; ks < 32; ++ks) {
        const bf16x8 a = *(const bf16x8*)(ap + 32 * ks), b0 = *(const bf16x8*)(bp + 32 * ks), b1 = *(const bf16x8*)(bp + 16 * DM + 32 * ks);
        if (isk) { acc0 = __builtin_amdgcn_mfma_f32_16x16x32_bf16(b0, a, acc0, 0, 0, 0); acc1 = __builtin_amdgcn_mfma_f32_16x16x32_bf16(b1, a, acc1, 0, 0, 0); }
        else { acc0 = __builtin_amdgcn_mfma_f32_16x16x32_bf16(a, b0, acc0, 0, 0, 0); acc1 = __builtin_amdgcn_mfma_f32_16x16x32_bf16(a, b1, acc1, 0, 0, 0); }
    }
    if (isk) {
        const float s = mrstd[row0 + qi]; bf16* p = memk + (size_t)(row0 + qi) * 256 + col0 + 4 * g;
        v2u w; w.x = pk2(acc0[0] * s, acc0[1] * s); w.y = pk2(acc0[2] * s, acc0[3] * s); *(v2u*)p = w;
        w.x = pk2(acc1[0] * s, acc1[1] * s); w.y = pk2(acc1[2] * s, acc1[3] * s); *(v2u*)(p + 16) = w;
    } else {
        const f32x4 s = *(const f32x4*)(mrstd + row0 + 4 * g); bf16* p = memvt + (size_t)(col0 - 256 + qi) * MEM_ROWS + row0 + 4 * g;
        v2u w; w.x = pk2(acc0[0] * s[0], acc0[1] * s[1]); w.y = pk2(acc0[2] * s[2], acc0[3] * s[3]); *(v2u*)p = w;
        w.x = pk2(acc1[0] * s[0], acc1[1] * s[1]); w.y = pk2(acc1[2] * s[2], acc1[3] * s[3]); *(v2u*)(p + (size_t)16 * MEM_ROWS) = w;
    }
}
__device__ __forceinline__ void memattn_strip(const Frame& F, int item, const bf16* act, int ld, int qoff, const bf16* memk, const bf16* memvt, bf16* mix) {
    const int tg = item & 15, h = (item >> 4) & 3, b = item >> 6, lane = LANE(), wave = F.wave;
    LAS unsigned char* Kl = F.lds; LAS unsigned char* Vl = F.lds + 32768;
#pragma unroll
    for (int j = 0; j < 4; ++j) {
        const int p = (wave * 4 + j) * 64 + lane, key = p >> 3, kpos = p & 7, kc = key & 31, swz = (((kc >> 3) & 3) << 1) | ((kc >> 1) & 1);
        __builtin_amdgcn_global_load_lds((const unsigned*)(memk + (size_t)(b * 256 + key) * 256 + h * 64 + ((kpos ^ swz) << 3)), (LAS unsigned*)(Kl + (wave * 4 + j) * 1024), 16, 0, 0);
        const int d = p >> 5, vpos = p & 31;
        __builtin_amdgcn_global_load_lds((const unsigned*)(memvt + (size_t)(h * 64 + d) * MEM_ROWS + b * 256 + ((vpos ^ (d & 15)) << 3)), (LAS unsigned*)(Vl + (wave * 4 + j) * 1024), 16, 0, 0);
    }
    asm volatile("s_waitcnt vmcnt(0)\n\ts_barrier" ::: "memory");
#pragma unroll 1
    for (int u = 0; u < 2; ++u) {
        const int tok0 = b * SEQ + tg * 256 + (wave * 2 + u) * 16;
        attn16_lds<false, 1, 32>(lane, act + (size_t)tok0 * ld + qoff + h * 64, ld, mix + (size_t)tok0 * DM + 768 + h * 64, DM, nullptr, 0, 0, 0, 0, Kl, 0, Vl, 0);
    }
    asm volatile("s_waitcnt lgkmcnt(0)\n\ts_barrier" ::: "memory");
}
__device__ __forceinline__ void memattn_item(int it, int lane, const bf16* act, int ld, int qoff, const bf16* memk, const bf16* memvt, bf16* mix) {
    const int tb = it >> 2, h = it & 3, tok0 = tb * 16, b = tok0 >> 12;
    attn16<false>(lane, act + (size_t)tok0 * ld + qoff + h * 64, ld, memk + h * 64, 256, memvt + (size_t)(h * 64) * MEM_ROWS, MEM_ROWS, b * 256, 32,
                  mix + (size_t)tok0 * DM + 768 + h * 64, DM, nullptr, 0, 0, 0, 0);
}
constexpr int NA_RPB_OFF = 122880;
__device__ __forceinline__ void na_strip(const Frame& F, int item, const bf16* act0, const bf16* v0t, bf16* mix) {
    const int s8 = item & 7, h = (item >> 3) % 12, b = (item >> 3) / 12, lane = LANE(), wave = F.wave;
    const int R0 = 8 * s8, rowbase = min(max(R0 - 4, 0), 56), rowend = min(max(R0 + 7 - 4, 0), 56) + 8, nrows = rowend - rowbase;
    LAS unsigned char* Kl = F.lds;
    {
        const int col = wave * 8 + (lane >> 3), pos = lane & 7, swz = (((col >> 3) & 3) << 1) | ((col >> 1) & 1);
        const bf16* src = act0 + (size_t)(b * SEQ + rowbase * 64 + col) * A0_LD + 768 + h * 64 + ((pos ^ swz) << 3);
        for (int j = 0; j < nrows; ++j)
            __builtin_amdgcn_global_load_lds((const unsigned*)(src + (size_t)j * 64 * A0_LD), (LAS unsigned*)(Kl + j * 8192 + wave * 1024), 16, 0, 0);
    }
    asm volatile("s_waitcnt vmcnt(0)\n\ts_barrier" ::: "memory");
    const int r = R0 + wave, r0 = min(max(r - 4, 0), 56);
    const LAS float* rpb = (const LAS float*)(F.lds + NA_RPB_OFF) + h * 465;
#pragma unroll 1
    for (int jb = 0; jb < 4; ++jb) {
        const int band0 = min(max(jb * 16 - 8, 0), 32), tok0 = b * SEQ + r * 64 + jb * 16;
        attn16<true, true>(lane, act0 + (size_t)tok0 * A0_LD + h * 64, A0_LD, nullptr, 0, v0t + (size_t)(h * 64) * NT, NT, b * SEQ + r0 * 64 + band0, 64,
                           mix + (size_t)tok0 * DM + h * 64, DM, rpb, r, r0, jb, band0, Kl, r0 - rowbase, nullptr, band0);
    }
    asm volatile("s_waitcnt lgkmcnt(0)\n\ts_barrier" ::: "memory");
}
constexpr int NAH_V = 76800, NAH_RPB = 153600;
__device__ __forceinline__ void na_hstrip(const Frame& F, int item, const bf16* act0, const bf16* v0t, const float* rpb_g, bf16* mix) {
    const int half = item & 1, s8 = (item >> 1) & 7, h = (item >> 4) % 12, b = (item >> 4) / 12, lane = LANE(), wave = F.wave;
    const int R0 = 8 * s8, rowbase = min(max(R0 - 4, 0), 56), rowend = min(max(R0 + 7 - 4, 0), 56) + 8, nrows = rowend - rowbase, cb0 = half ? 24 : 0;
    LAS unsigned char* Kl = F.lds; LAS unsigned char* Vl = F.lds + NAH_V; LAS float* rl = (LAS float*)(F.lds + NAH_RPB);
    {
        const int pos = lane & 7, nk = nrows * 5 - 1;
#pragma unroll
        for (int i = 0; i < 10; ++i) { const int k = min(wave + NWAVES * i, 74), idx = min(k, nk);
            { const int j = idx / 5, q = idx - 5 * j, lc = q * 8 + (lane >> 3), swz = (((lc >> 3) & 3) << 1) | ((lc >> 1) & 1);
              __builtin_amdgcn_global_load_lds((const unsigned*)(act0 + (size_t)(b * SEQ + (rowbase + j) * 64 + cb0 + lc) * A0_LD + 768 + h * 64 + ((pos ^ swz) << 3)), (LAS unsigned*)(Kl + idx * 1024), 16, 0, 0); }
            { const int G = k * 64 + lane, d = G / 75, rem = G - 75 * d, j0 = rem / 5, gc = rem - 5 * j0, j = min(j0, nrows - 1);
              __builtin_amdgcn_global_load_lds((const unsigned*)(v0t + (size_t)(h * 64 + d) * NT + b * SEQ + (rowbase + j) * 64 + cb0 + gc * 8), (LAS unsigned*)(Vl + k * 1024), 16, 0, 0); } }
    }
    float bias = 0.f; if (TID() < 465) bias = rpb_g[h * 465 + TID()];
    asm volatile("" : "+v"(bias));
    bias *= 1.4426950408889634f;
    if (TID() < 465) rl[TID()] = bias;
    asm volatile("s_waitcnt vmcnt(0) lgkmcnt(0)\n\ts_barrier" ::: "memory");
    const int r = R0 + wave, r0 = min(max(r - 4, 0), 56);
#pragma unroll 1
    for (int u = 0; u < 2; ++u) {
        const int jb = 2 * half + u, band0 = min(max(jb * 16 - 8, 0), 32), tok0 = b * SEQ + r * 64 + jb * 16;
        attn16_lds<true, 2, 40>(lane, act0 + (size_t)tok0 * A0_LD + h * 64, A0_LD, mix + (size_t)tok0 * DM + h * 64, DM, rl, r, r0, jb, band0, Kl, r0 - rowbase, Vl, band0 - cb0);
    }
    asm volatile("s_waitcnt lgkmcnt(0)\n\ts_barrier" ::: "memory");
}
__device__ __forceinline__ void na_item(int it, int lane, const bf16* act0, const bf16* v0t, const LAS float* rpb, bf16* mix) {
    const int jb = it & 3, h = (it >> 2) % 12, br = (it >> 2) / 12, r = br & 63, b = br >> 6;
    const int r0 = min(max(r - 4, 0), 56), band0 = min(max(jb * 16 - 8, 0), 32);
    const int tok0 = b * SEQ + r * 64 + jb * 16;
    attn16<true>(lane, act0 + (size_t)tok0 * A0_LD + h * 64, A0_LD, act0 + 768 + h * 64, A0_LD, v0t + (size_t)(h * 64) * NT, NT, b * SEQ + r0 * 64 + band0, 64,
                 mix + (size_t)tok0 * DM + h * 64, DM, rpb + h * 465, r, r0, jb, band0);
}

constexpr int GP_LD = 392;
__device__ __forceinline__ void gla_pre_w(int wave, int lane, const float* W, const float* Bi, bf16x8 (&wfr)[3], float (&bias)[3]) {
    const int qi = lane & 15, g = lane >> 4;
#pragma unroll
    for (int jj = 0; jj < 3; ++jj) {
        const int j = 16 * (wave + 8 * jj) + qi;
        v4u wu = {0u, 0u, 0u, 0u};
        if (g < 2) { const float* wp = W + (size_t)(8 * g) * 384 + j;
            wu.x = pk2(wp[0], wp[384]); wu.y = pk2(wp[768], wp[1152]); wu.z = pk2(wp[1536], wp[1920]); wu.w = pk2(wp[2304], wp[2688]); }
        wfr[jj] = __builtin_bit_cast(bf16x8, wu); bias[jj] = Bi[j];
    }
}
__device__ __forceinline__ void gla_pre_item(const Frame& F, int item, const bf16* act1, const bf16x8 (&wfr)[3], const float (&bias)[3], bf16* QT, bf16* KT, float* DEC) {
    const int n = item & 63, dir = (item >> 6) & 1, b = item >> 7, base = b * SEQ + n * 64;
    const int tid = TID(), lane = LANE(), wave = F.wave, qi = lane & 15, g = lane >> 4;
    LAS bf16* EL = (LAS bf16*)F.lds;
    bf16x8 zf[4];
#pragma unroll
    for (int ct = 0; ct < 4; ++ct) { const int c = 16 * ct + qi, tok = dir ? base + 63 - c : base + c;
        bf16x8 z = {0, 0, 0, 0, 0, 0, 0, 0}; if (g < 2) z = *(const bf16x8*)(act1 + (size_t)tok * A1_LD + 1792 + dir * 16 + 8 * g); zf[ct] = z; }
    v4u q8a[6], k8a[6];
#pragma unroll
    for (int k = 0; k < 6; ++k) { const int idx = tid + 512 * k, c = idx / 48, jg = idx % 48; const bf16* arow = act1 + (size_t)(base + c) * A1_LD + 8 * jg; q8a[k] = *(const v4u*)arow; k8a[k] = *(const v4u*)(arow + 384); }
#pragma unroll
    for (int jj = 0; jj < 3; ++jj) {
        const int j = 16 * (wave + 8 * jj) + qi;
        float p[4][4], a[4], t1[4], t2[4], tot[4];
#pragma unroll
        for (int ct = 0; ct < 4; ++ct) {
            f32x4 d = {0.f, 0.f, 0.f, 0.f};
            d = __builtin_amdgcn_mfma_f32_16x16x32_bf16(zf[ct], wfr[jj], d, 0, 0, 0);
#pragma unroll
            for (int i = 0; i < 4; ++i) { const float x = d[i] + bias[jj];
                p[ct][i] = (fminf(x, 0.f) * 1.4426950408889634f - __builtin_amdgcn_logf(1.0f + __builtin_amdgcn_exp2f(fabsf(x) * -1.4426950408889634f))) * 0.0625f; }
            p[ct][1] += p[ct][0]; p[ct][2] += p[ct][1]; p[ct][3] += p[ct][2]; a[ct] = p[ct][3];
        }
#pragma unroll
        for (int ct = 0; ct < 4; ++ct) t1[ct] = __shfl_up(a[ct], 16);
#pragma unroll
        for (int ct = 0; ct < 4; ++ct) if (g >= 1) a[ct] += t1[ct];
#pragma unroll
        for (int ct = 0; ct < 4; ++ct) t2[ct] = __shfl_up(a[ct], 32);
#pragma unroll
        for (int ct = 0; ct < 4; ++ct) if (g >= 2) a[ct] += t2[ct];
#pragma unroll
        for (int ct = 0; ct < 4; ++ct) tot[ct] = __shfl(a[ct], 48 + qi);
        float carry = 0.f;
#pragma unroll
        for (int ct = 0; ct < 4; ++ct) {
            const float excl = a[ct] - p[ct][3] + carry;
            carry += tot[ct];
#pragma unroll
            for (int i = 0; i < 4; ++i) { const int c = 16 * ct + 4 * g + i, ctok = dir ? 63 - c : c; EL[ctok * GP_LD + j] = (bf16)f2bf(__builtin_amdgcn_exp2f(excl + p[ct][i])); }
        }
    }
    __syncthreads();
    const int clast = dir ? 0 : 63;
#pragma unroll
    for (int k = 0; k < 6; ++k) {
        const int idx = tid + 512 * k, c = idx / 48, jg = idx % 48;
        const v4u q8 = q8a[k], k8 = k8a[k];
        const v4u e8 = *(const LAS v4u*)(EL + c * GP_LD + 8 * jg), l8 = *(const LAS v4u*)(EL + clast * GP_LD + 8 * jg);
        const unsigned qa[4] = {q8.x, q8.y, q8.z, q8.w}, ka[4] = {k8.x, k8.y, k8.z, k8.w}, ea[4] = {e8.x, e8.y, e8.z, e8.w}, la[4] = {l8.x, l8.y, l8.z, l8.w};
        unsigned qo[4], ko[4];
        float lf[8];
#pragma unroll
        for (int i = 0; i < 4; ++i) {
            const float e0 = bflo(ea[i]), e1 = bfhi(ea[i]), i0 = __builtin_amdgcn_rcpf(e0), i1 = __builtin_amdgcn_rcpf(e1);
            const float kt0 = bflo(ka[i]) * i0, kt1 = bfhi(ka[i]) * i1; lf[2 * i] = bflo(la[i]); lf[2 * i + 1] = bfhi(la[i]);
            qo[i] = pk2(bflo(qa[i]) * 0.10206207261596575f * e0, bfhi(qa[i]) * 0.10206207261596575f * e1);
            ko[i] = pk2(kt0, kt1);
        }
        v4u w; w.x = qo[0]; w.y = qo[1]; w.z = qo[2]; w.w = qo[3]; *(v4u*)(QT + (size_t)(base + c) * 384 + 8 * jg) = w;
        w.x = ko[0]; w.y = ko[1]; w.z = ko[2]; w.w = ko[3]; *(v4u*)(KT + (size_t)(base + c) * 384 + 8 * jg) = w;
        if (c == clast) { float* dp = DEC + (size_t)((b * 4 + jg / 12) * 64 + n) * 96 + (jg % 12) * 8;
            *(f32x4*)dp = (f32x4){lf[0], lf[1], lf[2], lf[3]}; *(f32x4*)(dp + 4) = (f32x4){lf[4], lf[5], lf[6], lf[7]}; }
    }
    __syncthreads();
}
constexpr int GL_QT = 0, GL_KT = 13312, GL_VT = 26624, GL_DEC = 33792, GL_BUF = 34816;
__device__ __forceinline__ void gla_main_item(const Frame& F, int item, const bf16* QTa, const bf16* KTa, const float* DECa, const bf16* v1t, bf16* OFp, bf16* OBp,
                                              const float* cwg, const float* cwu, const float* cgain, unsigned char* c8) {
    const int vs = item & 3, dir = (item >> 2) & 1, h = (item >> 3) & 3, b = item >> 5;
    const int lane = LANE(), wave = F.wave, qi = lane & 15, g = lane >> 4, ct = wave & 3, vh = wave >> 2;
    bf16* O = dir ? OBp : OFp;
    LAS unsigned char* L = F.lds;
    unsigned off[5];
#pragma unroll
    for (int jj = 0; jj < 5; ++jj) { const int k = wave + 8 * jj; unsigned o;
        if (k < 26) { const int gi = (k < 13 ? k : k - 13) * 64 + lane, row = gi / 13, col = gi % 13; o = (unsigned)(row * 768 + (col < 12 ? col * 16 : 0)); }
        else if (k < 33) { const int gi = (k - 26) * 64 + lane, row = gi / 9, col = gi % 9; o = (gi < 432) ? (unsigned)(row * NT * 2 + (col < 8 ? col * 16 : 0)) : 0u; }
        else o = (lane < 24) ? (unsigned)(lane * 16) : 0u;
        off[jj] = o; }
    const char* qtb = (const char*)(QTa + (size_t)dir * NT * 384 + h * 96); const char* ktb = (const char*)(KTa + (size_t)dir * NT * 384 + h * 96);
    const char* deb = (const char*)(DECa + (size_t)dir * 8 * 4 * 64 * 96 + (size_t)((b * 4 + h) * 64) * 96);
    const char* vtb = (const char*)(v1t + (size_t)(h * 192 + vs * 48) * NT);
#define GL_DMA(n_, bufo_) do { const int nn_ = dir ? 63 - (n_) : (n_); const size_t tb_ = (size_t)(b * SEQ + nn_ * 64); \
        _Pragma("unroll") for (int jj_ = 0; jj_ < 5; ++jj_) { const int k_ = wave + 8 * jj_; if (k_ < 34) { \
            const char* src_ = k_ < 13 ? qtb + tb_ * 768 : (k_ < 26 ? ktb + tb_ * 768 : (k_ < 33 ? vtb + tb_ * 2 : deb + (size_t)nn_ * 384)); \
            __builtin_amdgcn_global_load_lds((const unsigned*)(src_ + off[jj_]), (LAS unsigned*)(L + (bufo_) + k_ * 1024), 16, 0, 0); } } } while (0)
    constexpr int GL_SB = 3 * GL_BUF;
    int oT[3]; bool oV[3];
#pragma unroll
    for (int j = 0; j < 3; ++j) { if (wave >= 4) { oT[j] = (wave - 4) + 4 * j; oV[j] = true; } else { oV[j] = (j == 0) || (j == 1 && wave < 2); oT[j] = (j == 1 && wave < 2) ? 16 + wave : 12 + wave; } }
    f32x4 So[3];
#pragma unroll
    for (int j = 0; j < 3; ++j) So[j] = (f32x4){0.f, 0.f, 0.f, 0.f};
    unsigned kmw[2][4];
#pragma unroll
    for (int kk = 0; kk < 2; ++kk)
#pragma unroll
        for (int w2 = 0; w2 < 4; ++w2) { const int tp = 2 * kk + (w2 >> 1), i0 = 2 * (w2 & 1), c = 16 * ct + qi, cp = 16 * tp + 4 * g + i0;
            const bool k0 = dir ? (cp > c) : (cp <= c), k1 = dir ? (cp + 1 > c) : (cp + 1 <= c); kmw[kk][w2] = (k0 ? 0x0000ffffu : 0u) | (k1 ? 0xffff0000u : 0u); }
    for (int i = TID(); i < 18 * 512 / 8; i += NTHR) *(LAS v2u*)(L + GL_SB + i * 8) = (v2u){0u, 0u};
    GL_DMA(0, 0); GL_DMA(1, GL_BUF);
    asm volatile("s_waitcnt vmcnt(0) lgkmcnt(0)\n\ts_barrier" ::: "memory");
    int bo = 0, bo2 = 2 * GL_BUF;
    f32x4 cv[8], cg[2];
#pragma unroll
    for (int j = 0; j < 8; ++j) cv[j] = (f32x4){0.f, 0.f, 0.f, 0.f};
    cg[0] = cv[0]; cg[1] = cv[0];
    LAS unsigned* CT = (LAS unsigned*)(L + GL_SB + 18432 + wave * 2304);
#pragma unroll 1
    for (int n = 0; n < 64; ++n) {
        LAS unsigned char* Bf = L + bo;
        const LAS unsigned char* SBr = L + GL_SB + (n & 1) * 9216; LAS unsigned char* SBw = L + GL_SB + ((n + 1) & 1) * 9216;
        bf16x8 qf[3], kf[4][3], qp[3], vf[2][2], sf[2][3];
#pragma unroll
        for (int ks = 0; ks < 3; ++ks) qf[ks] = *(const LAS bf16x8*)(Bf + GL_QT + (16 * ct + qi) * 208 + (32 * ks + 8 * g) * 2);
#pragma unroll
        for (int tp = 0; tp < 4; ++tp)
#pragma unroll
            for (int ks = 0; ks < 3; ++ks) kf[tp][ks] = *(const LAS bf16x8*)(Bf + GL_KT + (16 * tp + qi) * 208 + (32 * ks + 8 * g) * 2);
#pragma unroll
        for (int kk = 0; kk < 3; ++kk) { const LAS unsigned char* qr = Bf + GL_QT + (16 * ct + qi) * 208 + (32 * kk + 4 * g) * 2;
            const s16x4 a0 = *(const LAS s16x4*)qr, a1 = *(const LAS s16x4*)(qr + 32); qp[kk] = __builtin_shufflevector(a0, a1, 0, 1, 2, 3, 4, 5, 6, 7); }
#pragma unroll
        for (int vi = 0; vi < 2; ++vi) { const int vt = vh ? 2 : vi;
#pragma unroll
            for (int kk = 0; kk < 2; ++kk) { const LAS unsigned char* vr = Bf + GL_VT + (16 * vt + qi) * 144 + (32 * kk + 4 * g) * 2;
                const s16x4 a0 = *(const LAS s16x4*)vr, a1 = *(const LAS s16x4*)(vr + 32); vf[vi][kk] = __builtin_shufflevector(a0, a1, 0, 1, 2, 3, 4, 5, 6, 7); }
#pragma unroll
            for (int kk = 0; kk < 3; ++kk) { const LAS unsigned char* sr = SBr + (vt * 6 + 2 * kk) * 512 + lane * 8;
                const s16x4 a0 = *(const LAS s16x4*)sr, a1 = *(const LAS s16x4*)(sr + 512); sf[vi][kk] = __builtin_shufflevector(a0, a1, 0, 1, 2, 3, 4, 5, 6, 7); } }
        __builtin_amdgcn_sched_barrier(0);
        f32x4 am[4];
#pragma unroll
        for (int tp = 0; tp < 4; ++tp) {
            f32x4 z = {0.f, 0.f, 0.f, 0.f};
#pragma unroll
            for (int ks = 0; ks < 3; ++ks) z = __builtin_amdgcn_mfma_f32_16x16x32_bf16(kf[tp][ks], qf[ks], z, 0, 0, 0);
            am[tp] = z;
        }
        asm volatile("s_waitcnt vmcnt(0)" ::: "memory");
        f32x4 dec[3]; bf16x8 kdf[3][2], vfr[3][2];
#pragma unroll
        for (int j = 0; j < 3; ++j) { const int T = oT[j], vt = T / 6, dt = T - 6 * vt;
            dec[j] = *(const LAS f32x4*)(Bf + GL_DEC + (16 * dt + 4 * g) * 4);
#pragma unroll
            for (int ks = 0; ks < 2; ++ks) {
                const LAS unsigned char* kr = Bf + GL_KT + (32 * ks + 8 * g + (qi >> 2)) * 208 + (16 * dt + 4 * (qi & 3)) * 2;
                const s16x4 a0 = __builtin_amdgcn_ds_read_tr16_b64_v4i16((LAS s16x4*)kr), a1 = __builtin_amdgcn_ds_read_tr16_b64_v4i16((LAS s16x4*)(kr + 4 * 208));
                kdf[j][ks] = __builtin_shufflevector(a0, a1, 0, 1, 2, 3, 4, 5, 6, 7);
                vfr[j][ks] = *(const LAS bf16x8*)(Bf + GL_VT + (16 * vt + qi) * 144 + (32 * ks + 8 * g) * 2); } }
        __builtin_amdgcn_sched_barrier(0);
        if (((n & 3) == 1) && (n < 57)) {
            const int id = F.gw + 2048 * (n >> 2), e = id / 3584, r2 = id - e * 3584, wh = r2 / 1792, it2 = r2 - wh * 1792, kb = it2 / 112, nb = it2 - kb * 112, n0 = nb * 32;
            unsigned char* dst = c8 + (size_t)e * 7168 * 1024 + (size_t)((n0 >> 7) * 256 + wh * 128 + (n0 & 127)) * 1024 + kb * 64;
            const int nq = lane & 7, kr = lane >> 3;
#pragma unroll
            for (int p = 0; p < 2; ++p) { const f32x4 gq = cg[p] * 32.0f;
                const f32x4 a = cv[4 * p], b2 = cv[4 * p + 1], c2 = cv[4 * p + 2], d2 = cv[4 * p + 3]; LAS unsigned* t = CT + (4 * nq) * 17 + 8 * p + kr;
                t[0] = pk4_fp8(a.x * gq[0], b2.x * gq[1], c2.x * gq[2], d2.x * gq[3]); t[17] = pk4_fp8(a.y * gq[0], b2.y * gq[1], c2.y * gq[2], d2.y * gq[3]);
                t[34] = pk4_fp8(a.z * gq[0], b2.z * gq[1], c2.z * gq[2], d2.z * gq[3]); t[51] = pk4_fp8(a.w * gq[0], b2.w * gq[1], c2.w * gq[2], d2.w * gq[3]); }
            LDS_WAIT(); asm volatile("" ::: "memory");
#pragma unroll
            for (int r = 0; r < 2; ++r) { const int nn2 = (lane >> 2) + 16 * r, c4 = lane & 3; const LAS unsigned* sp = CT + nn2 * 17 + 4 * c4;
                v4u o; o.x = sp[0]; o.y = sp[1]; o.z = sp[2]; o.w = sp[3];
                *(GAS v4u*)(dst + (size_t)nn2 * 1024 + 16 * c4) = o; }
        }
        { const int n2 = n + 2 < 64 ? n + 2 : 63; GL_DMA(n2, bo2); }
        const bool cld = ((n & 3) == 0) && (n < 56);
        if (cld) {
            const int id = F.gw + 2048 * (n >> 2), e = id / 3584, r2 = id - e * 3584, wh = r2 / 1792, it2 = r2 - wh * 1792, kb = it2 / 112, nb = it2 - kb * 112;
            const float* p = (wh ? cwu : cwg) + (size_t)e * 1024 * FFE + (size_t)(kb * 64 + 4 * (lane >> 3)) * FFE + nb * 32 + 4 * (lane & 7);
#pragma unroll
            for (int j = 0; j < 8; ++j) cv[j] = *(const f32x4*)(p + (size_t)(32 * (j >> 2) + (j & 3)) * FFE);
            cg[0] = *(const f32x4*)(cgain + kb * 64 + 4 * (lane >> 3)); cg[1] = *(const f32x4*)(cgain + kb * 64 + 32 + 4 * (lane >> 3));
        }
        __builtin_amdgcn_sched_barrier(0);
        bf16x8 pf[2];
#pragma unroll
        for (int kk = 0; kk < 2; ++kk) { v4u w; w.x = pk2(am[2 * kk][0], am[2 * kk][1]) & kmw[kk][0]; w.y = pk2(am[2 * kk][2], am[2 * kk][3]) & kmw[kk][1]; w.z = pk2(am[2 * kk + 1][0], am[2 * kk + 1][1]) & kmw[kk][2]; w.w = pk2(am[2 * kk + 1][2], am[2 * kk + 1][3]) & kmw[kk][3];
            pf[kk] = __builtin_bit_cast(bf16x8, w); }
        const int nn = dir ? 63 - n : n, tok = b * SEQ + nn * 64 + 16 * ct + qi;
        f32x4 oacc[2];
#pragma unroll
        for (int vi = 0; vi < 2; ++vi) {
            f32x4 acc = {0.f, 0.f, 0.f, 0.f};
#pragma unroll
            for (int kk = 0; kk < 3; ++kk) acc = __builtin_amdgcn_mfma_f32_16x16x32_bf16(sf[vi][kk], qp[kk], acc, 0, 0, 0);
#pragma unroll
            for (int kk = 0; kk < 2; ++kk) acc = __builtin_amdgcn_mfma_f32_16x16x32_bf16(vf[vi][kk], pf[kk], acc, 0, 0, 0);
            oacc[vi] = acc;
        }
#pragma unroll
        for (int j = 0; j < 3; ++j) {
            f32x4 sv = So[j];
#pragma unroll
            for (int ks = 0; ks < 2; ++ks) sv = __builtin_amdgcn_mfma_f32_16x16x32_bf16(kdf[j][ks], vfr[j][ks], sv, 0, 0, 0);
            sv[0] *= dec[j][0]; sv[1] *= dec[j][1]; sv[2] *= dec[j][2]; sv[3] *= dec[j][3];
            So[j] = sv;
        }
        { v2u w; w.x = pk2(oacc[0][0], oacc[0][1]); w.y = pk2(oacc[0][2], oacc[0][3]);
          *(v2u*)(O + (size_t)tok * 768 + h * 192 + vs * 48 + 16 * (vh ? 2 : 0) + 4 * g) = w; }
        if (vh == 0) { v2u w; w.x = pk2(oacc[1][0], oacc[1][1]); w.y = pk2(oacc[1][2], oacc[1][3]);
          *(v2u*)(O + (size_t)tok * 768 + h * 192 + vs * 48 + 16 + 4 * g) = w; }
#pragma unroll
        for (int j = 0; j < 3; ++j) if (oV[j]) { v2u w; w.x = pk2(So[j][0], So[j][1]); w.y = pk2(So[j][2], So[j][3]); *(LAS v2u*)(SBw + oT[j] * 512 + lane * 8) = w; }
        asm volatile("s_waitcnt lgkmcnt(0)\n\ts_barrier" ::: "memory");
        { const int t_ = bo; bo = (bo == 2 * GL_BUF) ? 0 : bo + GL_BUF; bo2 = t_; }
    }
    __syncthreads();
#undef GL_DMA
}

__device__ __forceinline__ void finalize_rstd(const Frame& F, const float* rss, float* rstd) {
    for (int row = F.bid * NTHR + TID(); row < NT; row += F.G * NTHR) rstd[row] = rstd_from(rss + (size_t)row * 16);
}
__device__ __forceinline__ void gla_combine(const Frame& F, const bf16* OF, const bf16* OB, const bf16* act1, const float* gnorm, bf16* mix) {
    const int lane = LANE(), h = lane >> 4, c0 = h * 192 + 12 * (lane & 15);
    float gn[12];
#pragma unroll
    for (int j = 0; j < 12; ++j) gn[j] = gnorm[12 * (lane & 15) + j];
    for (int token = F.gw; token < NT; token += 2 * F.NGW) {
        const int tb = token + F.NGW; const bool hb = tb < NT; const int t2 = hb ? tb : token;
        v2u fa[3], ba[3], ga[3], fb[3], bb[3], gb[3];
#pragma unroll
        for (int j = 0; j < 3; ++j) { fa[j] = *(const v2u*)(OF + (size_t)token * 768 + c0 + 4 * j); ba[j] = *(const v2u*)(OB + (size_t)token * 768 + c0 + 4 * j); ga[j] = *(const v2u*)(act1 + (size_t)token * A1_LD + 768 + c0 + 4 * j); }
#pragma unroll
        for (int j = 0; j < 3; ++j) { fb[j] = *(const v2u*)(OF + (size_t)t2 * 768 + c0 + 4 * j); bb[j] = *(const v2u*)(OB + (size_t)t2 * 768 + c0 + 4 * j); gb[j] = *(const v2u*)(act1 + (size_t)t2 * A1_LD + 768 + c0 + 4 * j); }
        float oa[12], ob[12], sa = 0.f, sb = 0.f;
#pragma unroll
        for (int j = 0; j < 3; ++j) {
            oa[4 * j] = bflo(fa[j].x) + bflo(ba[j].x); oa[4 * j + 1] = bfhi(fa[j].x) + bfhi(ba[j].x); oa[4 * j + 2] = bflo(fa[j].y) + bflo(ba[j].y); oa[4 * j + 3] = bfhi(fa[j].y) + bfhi(ba[j].y);
            ob[4 * j] = bflo(fb[j].x) + bflo(bb[j].x); ob[4 * j + 1] = bfhi(fb[j].x) + bfhi(bb[j].x); ob[4 * j + 2] = bflo(fb[j].y) + bflo(bb[j].y); ob[4 * j + 3] = bfhi(fb[j].y) + bfhi(bb[j].y); }
#pragma unroll
        for (int j = 0; j < 12; ++j) { sa += oa[j] * oa[j]; sb += ob[j] * ob[j]; }
#pragma unroll
        for (int o = 1; o < 16; o <<= 1) { sa += __shfl_xor(sa, o); sb += __shfl_xor(sb, o); }
        const float ra = __builtin_amdgcn_rsqf(sa * (1.0f / 192.0f) + EPS), rb = __builtin_amdgcn_rsqf(sb * (1.0f / 192.0f) + EPS);
#pragma unroll
        for (int j = 0; j < 3; ++j) {
            const float g0 = bflo(ga[j].x), g1 = bfhi(ga[j].x), g2 = bflo(ga[j].y), g3 = bfhi(ga[j].y);
            v2u w; w.x = pk2(oa[4 * j] * ra * gn[4 * j] * g0 * __builtin_amdgcn_rcpf(1.0f + __expf(-g0)), oa[4 * j + 1] * ra * gn[4 * j + 1] * g1 * __builtin_amdgcn_rcpf(1.0f + __expf(-g1)));
            w.y = pk2(oa[4 * j + 2] * ra * gn[4 * j + 2] * g2 * __builtin_amdgcn_rcpf(1.0f + __expf(-g2)), oa[4 * j + 3] * ra * gn[4 * j + 3] * g3 * __builtin_amdgcn_rcpf(1.0f + __expf(-g3)));
            *(v2u*)(mix + (size_t)token * DM + c0 + 4 * j) = w; }
        if (hb) {
#pragma unroll
            for (int j = 0; j < 3; ++j) {
                const float g0 = bflo(gb[j].x), g1 = bfhi(gb[j].x), g2 = bflo(gb[j].y), g3 = bfhi(gb[j].y);
                v2u w; w.x = pk2(ob[4 * j] * rb * gn[4 * j] * g0 * __builtin_amdgcn_rcpf(1.0f + __expf(-g0)), ob[4 * j + 1] * rb * gn[4 * j + 1] * g1 * __builtin_amdgcn_rcpf(1.0f + __expf(-g1)));
                w.y = pk2(ob[4 * j + 2] * rb * gn[4 * j + 2] * g2 * __builtin_amdgcn_rcpf(1.0f + __expf(-g2)), ob[4 * j + 3] * rb * gn[4 * j + 3] * g3 * __builtin_amdgcn_rcpf(1.0f + __expf(-g3)));
                *(v2u*)(mix + (size_t)tb * DM + c0 + 4 * j) = w; } }
    }
}
__device__ __forceinline__ void route_pick(const float (&acc)[8], int token, int* topi, float* topw, LAS int* lc) {
    int e0 = 0; float l0 = acc[0];
#pragma unroll
    for (int e = 1; e < 8; ++e) if (acc[e] > l0) { l0 = acc[e]; e0 = e; }
    int e1 = -1; float l1 = -INFINITY;
#pragma unroll
    for (int e = 0; e < 8; ++e) if (e != e0 && acc[e] > l1) { l1 = acc[e]; e1 = e; }
    if (e1 < 0) { e1 = (e0 + 1) & 7; l1 = l0; }
    const float w0 = 1.0f / (1.0f + __expf(l1 - l0));
    topi[token] = e0 | (e1 << 8); topw[2 * token] = w0; topw[2 * token + 1] = 1.0f - w0;
    atomicAdd((int*)&lc[e0], 1); atomicAdd((int*)&lc[8 + e1], 1);
}
__device__ __forceinline__ void route1(const Frame& F, const bf16* H, const float* gain, const float* wr, int* topi, float* topw, int* cnt, float* rstd) {
    LAS int* lc = (LAS int*)F.lds;
    if (TID() < 16) lc[TID()] = 0;
    __syncthreads();
    const int lane = LANE();
    float w[4][4][8];
#pragma unroll
    for (int j = 0; j < 4; ++j) { const f32x4 g = *(const f32x4*)(gain + 256 * j + 4 * lane);
#pragma unroll
        for (int i = 0; i < 4; ++i) { const float* p = wr + (size_t)(256 * j + 4 * lane + i) * 8; const f32x4 a = *(const f32x4*)p, b = *(const f32x4*)(p + 4); const float gi = g[i];
            w[j][i][0] = a.x * gi; w[j][i][1] = a.y * gi; w[j][i][2] = a.z * gi; w[j][i][3] = a.w * gi; w[j][i][4] = b.x * gi; w[j][i][5] = b.y * gi; w[j][i][6] = b.z * gi; w[j][i][7] = b.w * gi; } }
    for (int t2 = 0; t2 < 16; t2 += 2) {
        const int token = F.bid * 128 + F.wave * 16 + t2;
        const v2u* h0 = (const v2u*)(H + (size_t)token * DM) + lane; const v2u* h1 = h0 + DM / 4;
        f32x4 x0[4], x1[4];
#pragma unroll
        for (int j = 0; j < 4; ++j) { const v2u p = h0[64 * j], q = h1[64 * j]; x0[j] = (f32x4){bflo(p.x), bfhi(p.x), bflo(p.y), bfhi(p.y)}; x1[j] = (f32x4){bflo(q.x), bfhi(q.x), bflo(q.y), bfhi(q.y)}; }
        float a0[8], a1[8], s0 = 0.f, s1 = 0.f;
#pragma unroll
        for (int e = 0; e < 8; ++e) { a0[e] = 0.f; a1[e] = 0.f; }
#pragma unroll
        for (int j = 0; j < 4; ++j)
#pragma unroll
            for (int i = 0; i < 4; ++i) { const float u = x0[j][i], v = x1[j][i]; s0 += u * u; s1 += v * v;
#pragma unroll
                for (int e = 0; e < 8; ++e) { a0[e] += u * w[j][i][e]; a1[e] += v * w[j][i][e]; } }
        s0 = wave_sum(s0); s1 = wave_sum(s1);
        const float r0 = 1.0f / sqrtf(s0 * (1.0f / DM) + EPS), r1 = 1.0f / sqrtf(s1 * (1.0f / DM) + EPS);
#pragma unroll
        for (int e = 0; e < 8; ++e) { a0[e] = wave_sum(a0[e]) * r0; a1[e] = wave_sum(a1[e]) * r1; }
        if (lane == 0) { route_pick(a0, token, topi, topw, lc); route_pick(a1, token + 1, topi, topw, lc); rstd[token] = r0; rstd[token + 1] = r1; }
    }
    __syncthreads();
    if (TID() < 16) cnt[F.bid * 16 + TID()] = lc[TID()];
    __syncthreads();
}
__device__ __forceinline__ void route2(const Frame& F, const int* topi, const float* topw, const int* cnt, int* stok, float* sw, int* blk, int* s0tab) {
    LAS int* part = (LAS int*)F.lds;
    LAS int* base = part + 1024;
    LAS int* tk = base + 64;
    const int tid = TID(), pe = tid & 15, jg = tid >> 4;
    int below = 0, tot = 0;
    for (int w = jg; w < F.G; w += 32) { const int v = cnt[w * 16 + pe]; tot += v; if (w < F.bid) below += v; }
    part[jg * 16 + pe] = below; part[512 + jg * 16 + pe] = tot;
    if (tid < 128) tk[tid] = topi[F.bid * 128 + tid];
    __syncthreads();
    if (tid < 16) { int b = 0, t = 0; for (int j = 0; j < 32; ++j) { b += part[j * 16 + tid]; t += part[512 + j * 16 + tid]; } base[tid] = b; base[16 + tid] = t; }
    __syncthreads();
    if (tid < 2) { int ps = 0; for (int e = 0; e < 8; ++e) { base[32 + tid * 8 + e] = ps; ps += (base[16 + tid * 8 + e] + 255) / 256 * 256; } base[48 + tid] = ps / 256; }
    __syncthreads();
    if (tid < 256) {
        const int p = tid >> 7, i = tid & 127; const int e = (tk[i] >> (8 * p)) & 0xff;
        int rank = 0; for (int j = 0; j < i; ++j) rank += (((tk[j] >> (8 * p)) & 0xff) == e) ? 1 : 0;
        const int slot = base[32 + p * 8 + e] + base[p * 8 + e] + rank; const int token = F.bid * 128 + i;
        stok[p * SLOT_CAP + slot] = token; sw[p * SLOT_CAP + slot] = topw[2 * token + p]; if (p == 0) s0tab[token] = slot;
    }
    if (F.bid < 16) {
        const int p = F.bid >> 3, e = F.bid & 7, ps = base[32 + F.bid], t = base[16 + F.bid], pend = ps + (t + 255) / 256 * 256;
        for (int s = ps + t + tid; s < pend; s += NTHR) { stok[p * SLOT_CAP + s] = -1; sw[p * SLOT_CAP + s] = 0.f; }
        for (int bk = ps / 256 + tid; bk < pend / 256; bk += NTHR) blk[16 + p * 256 + bk] = e;
        if (e == 0 && tid == 0) blk[p] = base[48 + p];
    }
    __syncthreads();
}
__device__ __forceinline__ void final_norm_slots(int lane, const bf16* HB, float* OUT, const bf16* YA, const int* s0tab, const bf16* Y, const bf16* Y2, const float* gain, const int* tok, int s0, int s1, int first, int stride) {
    const f32x4* gr = (const f32x4*)gain + lane;
    for (int base = s0 + first; base < s1; base += 64 * stride) {
      const int sll = base + lane * stride; int mytok = -1; if (sll < s1) mytok = tok[sll];
      const int mys0 = s0tab[mytok < 0 ? 0 : mytok];
      const int cnt = min(64, (s1 - base + stride - 1) / stride);
      for (int i = 0; i < cnt; i += 2) {
        const int sl = base + i * stride, slb = sl + stride; const bool hb = i + 1 < cnt; const int i1 = hb ? i + 1 : i;
        const int ra = __builtin_amdgcn_readlane(mytok, i), rb = hb ? __builtin_amdgcn_readlane(mytok, i1) : -1;
        const int rowa = ra < 0 ? 0 : ra, rowb = rb < 0 ? 0 : rb;
        const v2u* xa = (const v2u*)(HB + (size_t)rowa * DM) + lane; const v2u* xb = (const v2u*)(HB + (size_t)rowb * DM) + lane;
        const v2u* ya = (const v2u*)(Y + (size_t)sl * DM) + lane; const v2u* yb = (const v2u*)(Y + (size_t)(hb ? slb : sl) * DM) + lane;
        const v2u* pa = (const v2u*)(YA + (size_t)__builtin_amdgcn_readlane(mys0, i) * DM) + lane; const v2u* pb = (const v2u*)(YA + (size_t)__builtin_amdgcn_readlane(mys0, i1) * DM) + lane;
        f32x4 va[4], vb[4]; v2u wa[4], wb[4], ua[4], ub[4], ta[4], tb[4];
#pragma unroll
        for (int j = 0; j < 4; ++j) { ua[j] = xa[64 * j]; wa[j] = ya[64 * j]; ta[j] = pa[64 * j]; }
#pragma unroll
        for (int j = 0; j < 4; ++j) { ub[j] = xb[64 * j]; wb[j] = yb[64 * j]; tb[j] = pb[64 * j]; }
#pragma unroll
        for (int j = 0; j < 4; ++j) { va[j] = (f32x4){bflo(ua[j].x) + bflo(ta[j].x), bfhi(ua[j].x) + bfhi(ta[j].x), bflo(ua[j].y) + bflo(ta[j].y), bfhi(ua[j].y) + bfhi(ta[j].y)};
            vb[j] = (f32x4){bflo(ub[j].x) + bflo(tb[j].x), bfhi(ub[j].x) + bfhi(tb[j].x), bflo(ub[j].y) + bflo(tb[j].y), bfhi(ub[j].y) + bfhi(tb[j].y)}; }
        if (Y2) {
            const v2u* za = (const v2u*)(Y2 + (size_t)(sl - s0) * DM) + lane; const v2u* zb = (const v2u*)(Y2 + (size_t)((hb ? slb : sl) - s0) * DM) + lane;
#pragma unroll
            for (int j = 0; j < 4; ++j) { const v2u p = za[64 * j], q = zb[64 * j];
                va[j].x += bflo(p.x); va[j].y += bfhi(p.x); va[j].z += bflo(p.y); va[j].w += bfhi(p.y); vb[j].x += bflo(q.x); vb[j].y += bfhi(q.x); vb[j].z += bflo(q.y); vb[j].w += bfhi(q.y); }
        }
        float sa = 0.f, sb = 0.f;
#pragma unroll
        for (int j = 0; j < 4; ++j) {
            va[j].x += bflo(wa[j].x); va[j].y += bfhi(wa[j].x); va[j].z += bflo(wa[j].y); va[j].w += bfhi(wa[j].y);
            vb[j].x += bflo(wb[j].x); vb[j].y += bfhi(wb[j].x); vb[j].z += bflo(wb[j].y); vb[j].w += bfhi(wb[j].y);
            sa += (va[j].x * va[j].x + va[j].y * va[j].y) + (va[j].z * va[j].z + va[j].w * va[j].w); sb += (vb[j].x * vb[j].x + vb[j].y * vb[j].y) + (vb[j].z * vb[j].z + vb[j].w * vb[j].w); }
        sa = wave_sum(sa); sb = wave_sum(sb);
        const float rsa = 1.0f / sqrtf(sa * (1.0f / DM) + EPS), rsb = 1.0f / sqrtf(sb * (1.0f / DM) + EPS);
        if (ra >= 0) { GAS f32x4* oa = (GAS f32x4*)(OUT + (size_t)rowa * DM) + lane;
#pragma unroll
            for (int j = 0; j < 4; ++j) { const f32x4 g = gr[64 * j]; oa[64 * j] = (f32x4){va[j].x * rsa * g.x, va[j].y * rsa * g.y, va[j].z * rsa * g.z, va[j].w * rsa * g.w}; } }
        if (rb >= 0) { GAS f32x4* ob = (GAS f32x4*)(OUT + (size_t)rowb * DM) + lane;
#pragma unroll
            for (int j = 0; j < 4; ++j) { const f32x4 g = gr[64 * j]; ob[64 * j] = (f32x4){vb[j].x * rsb * g.x, vb[j].y * rsb * g.y, vb[j].z * rsb * g.z, vb[j].w * rsb * g.w}; } }
      }
    }
}
__device__ __forceinline__ void final_norm(const Frame& F, float* H, const float* gain) {
    for (int row = F.gw; row < NT; row += F.NGW) {
        GAS f32x4* xr = (GAS f32x4*)(H + (size_t)row * DM) + LANE(); const f32x4* gr = (const f32x4*)gain + LANE();
        f32x4 v[4]; float s = 0.f;
#pragma unroll
        for (int j = 0; j < 4; ++j) { v[j] = xr[64 * j]; s += (v[j].x * v[j].x + v[j].y * v[j].y) + (v[j].z * v[j].z + v[j].w * v[j].w); }
        s = wave_sum(s); const float rs = 1.0f / sqrtf(s * (1.0f / DM) + EPS);
#pragma unroll
        for (int j = 0; j < 4; ++j) { const f32x4 g = gr[64 * j]; f32x4 o = {v[j].x * rs * g.x, v[j].y * rs * g.y, v[j].z * rs * g.z, v[j].w * rs * g.w}; xr[64 * j] = o; }
    }
}

constexpr int N_PHASES = 17;
__global__ void __launch_bounds__(NTHR, 2) mega(Args args) {
    extern __shared__ __attribute__((aligned(16))) unsigned char lds_raw[];
    Frame F;
    F.lds = (LAS unsigned char*)lds_raw;
    F.wave = __builtin_amdgcn_readfirstlane((int)(threadIdx.x >> 6));
    F.G = gridDim.x; F.bid = blockIdx.x; F.gw = F.bid * NWAVES + F.wave; F.NGW = F.G * NWAVES; F.ws = args.ws;
    unsigned char* ws = args.ws;
    gu32* ctl = (gu32*)(ws + WS_CTL);
    volatile LAS unsigned* MISC = (volatile LAS unsigned*)(F.lds + MISC_OFF);
    for (int u = TID(); u < (LDS_BYTES - LDSCTL_OFF) / 4; u += NTHR) ((LAS unsigned*)(F.lds + LDSCTL_OFF))[u] = 0u;
    __syncthreads();
    XcdBarrier bar = xcd_barrier_post((unsigned*)(ctl + CW_BAR), MISC + 8, F.wave);
    const int lo = args.ph_lo, hi = args.ph_hi;
#ifndef PH_MASK
#define PH_MASK 0x1ffff
#endif
#define IN(k) (((PH_MASK >> (k)) & 1) && lo <= (k) && (k) < hi)
#ifndef REPEAT_MASK
#define REPEAT_MASK 0
#endif
#define REPS(k) (1 + ((REPEAT_MASK >> (k)) & 1))
#define SEAM(k) do { if (IN(k) && IN((k) + 1)) xcd_barrier(bar); } while (0)

    float* H = args.out;
    bf16* x3 = (bf16*)args.out;
    float* rss = (float*)(ws + WS_RSS); float* rstd = (float*)(ws + WS_RSTD);
    bf16* hbf = (bf16*)(ws + WS_HBF); bf16* membf = (bf16*)(ws + WS_MEMBF); bf16* memk = (bf16*)(ws + WS_MEMK); bf16* memvt = (bf16*)(ws + WS_MEMVT);
    bf16* act0 = (bf16*)(ws + WS_ACT0); bf16* v0t = (bf16*)(ws + WS_V0T); bf16* mix = (bf16*)(ws + WS_MIX); bf16* hmid0 = (bf16*)(ws + WS_HMID0);
    bf16* act1 = (bf16*)(ws + WS_ACT1); bf16* v1t = (bf16*)(ws + WS_V1T); bf16* OF = (bf16*)(ws + WS_OF); bf16* OB = (bf16*)(ws + WS_OB);
    bf16* hmid1 = (bf16*)(ws + WS_HMID1); bf16* wgu = (bf16*)((unsigned char*)args.out + OUT_WGU); bf16* wdn = (bf16*)(ws + WS_WDN);
    int* cnt = (int*)(ws + WS_CNT); int* topi = (int*)(ws + WS_TOPI); float* topw = (float*)(ws + WS_TOPW);
    int* stok = (int*)(ws + WS_STOK); float* sw = (float*)(ws + WS_SW); int* blk = (int*)(ws + WS_BLK);
    LAS float* scr = (LAS float*)(F.lds + F.wave * 16384);

    if (IN(0)) {
        int it = F.gw; LAS unsigned* T0 = (LAS unsigned*)scr; LAS unsigned* T1 = T0 + 1088;
#define CVT(Wp, Kd, Nd, WTp, gainp, kind) do { const CvtJob J{Wp, Kd, Nd, (bf16*)(WTp), gainp, kind}; const int n_ = ((Kd) / 64) * ((Nd) / 32); \
            while (it < n_) { CvtRegs A_, B_; B_.valid = 0; cvt_load(A_, J, it, LANE()); it += F.NGW; if (it < n_) { cvt_load(B_, J, it, LANE()); it += F.NGW; } cvt_finish(A_, T0, LANE()); cvt_finish(B_, T1, LANE()); } \
            it -= n_; } while (0)
        CVT(args.in[I_EWIN], 1024, 2560, ws + WS_W0IN, args.in[I_EN1], 1);
        CVT(args.in[I_EWIN], 1024, 2560, ws + WS_WV0, args.in[I_EN1], 2);
        CVT(args.in[I_EWOUT], 1024, 1024, ws + WS_W0OUT, nullptr, 0);
        CVT(args.in[I_EWG], 1024, 2816, ws + WS_W0GU, args.in[I_EN2], 3);
        CVT(args.in[I_EWU], 1024, 2816, ws + WS_W0GU, args.in[I_EN2], 4);
        CVT(args.in[I_EWD], 2816, 1024, ws + WS_W0DN, nullptr, 0);
        CVT(args.in[I_WMKV], 1024, 512, ws + WS_WMEM, args.in[I_MNORM], 0);
        CVT(args.in[I_OWIN], 1024, 2592, ws + WS_W1IN, args.in[I_ON1], 5);
        CVT(args.in[I_OWIN], 1024, 2592, ws + WS_WV1, args.in[I_ON1], 6);
        CVT(args.in[I_OWOUT], 1024, 1024, ws + WS_W1OUT, nullptr, 0);
#undef CVT
        { v4u z = {0u, 0u, 0u, 0u}; v4u* p = (v4u*)(ws + WS_W1IN + (size_t)1824 * 2048); const int n16 = 224 * 2048 / 16;
          for (int i = F.bid * NTHR + TID(); i < n16; i += F.G * NTHR) p[i] = z; }
        rows_to_bf16(args.in[I_X], hbf, rstd, F.gw, NT, F.NGW, LANE());
        rows_to_bf16(args.in[I_MEM], membf, rstd + NT, F.gw, MEM_ROWS, F.NGW, LANE());
    }
    SEAM(0);
    if (IN(1)) {
        { Sched S; S.init(hbf, ws + WS_W0IN, 1024, 128, 7, F.G, F.bid); EpiRowScale E{act0, A0_LD, rstd, 1.0f}; gemm_run<EpiRowScale, false>(F.lds, S, E, nullptr, F.wave); }
        { Sched S; S.init(ws + WS_WV0, hbf, 1024, 3, 128, F.G, (F.bid + 128) % F.G); EpiColScale E{v0t, NT, rstd}; gemm_run<EpiColScale, false>(F.lds, S, E, nullptr, F.wave); }
        for (int it = F.gw; it < 2048; it += F.NGW) memkv_item(it, LANE(), membf, (const bf16*)(ws + WS_WMEM), rstd + NT, memk, memvt);
    }
    SEAM(1);
    if (IN(2)) {
        { for (int i = 0; i < 1536 / 256; ++i) na_hstrip(F, (F.G == 256) ? (F.bid & 7) * 192 + i * 32 + (F.bid >> 3) : F.bid + i * F.G, act0, v0t, args.in[I_RPB], mix);
          for (int it = F.bid; it < 512; it += F.G) memattn_strip(F, it, act0, A0_LD, 1536, memk, memvt, mix);
          __syncthreads(); }
    }
    SEAM(2);
    if (IN(3)) {
        Sched S; S.init(mix, ws + WS_W0OUT, 1024, 128, 4, F.G, F.bid); EpiResid<true> E{args.in[I_X], hbf, rss, nullptr}; gemm_run<EpiResid<true>, false>(F.lds, S, E, nullptr, F.wave);
    }
    SEAM(3);
    if (IN(4)) {
        Sched S; S.init(hbf, ws + WS_W0GU, 1024, 128, 22, F.G, F.bid); EpiSwiGLU<false, true> E{hmid0, FF0, rss, nullptr}; gemm_run<EpiSwiGLU<false, true>, false>(F.lds, S, E, nullptr, F.wave);
    }
    SEAM(4);
    if (IN(5)) {
        Sched S; S.init(hmid0, ws + WS_W0DN, FF0, 128, 4, F.G, F.bid); EpiResid<false> E{nullptr, hbf, rss, nullptr}; gemm_run<EpiResid<false>, false>(F.lds, S, E, nullptr, F.wave);
    }
    SEAM(5);
    if (IN(6)) {
        { Sched S; S.init(hbf, ws + WS_W1IN, 1024, 128, 8, F.G, F.bid); EpiRowScaleT<true> E{act1, A1_LD, rss, 1.0f}; gemm_run<EpiRowScaleT<true>, false>(F.lds, S, E, nullptr, F.wave); }
        { Sched S; S.init(ws + WS_WV1, hbf, 1024, 3, 128, F.G, F.bid); EpiColScaleT<true> E{v1t, NT, rss}; gemm_run<EpiColScaleT<true>, false>(F.lds, S, E, nullptr, F.wave); }
    }
    SEAM(6);
    if (IN(7)) {
        bf16x8 gwf[3]; float gbi[3]; int gdir = -1;
        for (int it = F.bid; it < 1024; it += F.G) { const int dir = (it >> 6) & 1;
            if (dir != gdir) { gla_pre_w(F.wave, LANE(), dir ? args.in[I_WGKB] : args.in[I_WGKF], dir ? args.in[I_BGKB] : args.in[I_BGKF], gwf, gbi); gdir = dir; }
            gla_pre_item(F, it, act1, gwf, gbi, (bf16*)(ws + WS_GQT) + (size_t)dir * NT * 384, (bf16*)((unsigned char*)args.out + OUT_GKT) + (size_t)dir * NT * 384,
                         (float*)((unsigned char*)args.out + OUT_GDEC) + (size_t)dir * 8 * 4 * 64 * 96); }
        for (int it = F.bid; it < 512; it += F.G) memattn_strip(F, it, act1, A1_LD, 1536, memk, memvt, mix);
        xcd_barrier(bar);
        for (int it0 = F.bid; it0 < 256; it0 += F.G) { const int it = (F.G == 256) ? ((it0 & 7) * 8 + (it0 >> 5)) * 4 + ((it0 >> 3) & 3) : it0;
            gla_main_item(F, it, (const bf16*)(ws + WS_GQT), (const bf16*)((unsigned char*)args.out + OUT_GKT), (const float*)((unsigned char*)args.out + OUT_GDEC), v1t, OF, OB, args.in[I_OWG], args.in[I_OWU], args.in[I_ON2], (unsigned char*)wgu); }
    }
    SEAM(7);
    if (IN(8)) gla_combine(F, OF, OB, act1, args.in[I_GNORM], mix);
    SEAM(8);
    if (IN(9)) {
        Sched S; S.init(mix, ws + WS_W1OUT, 1024, 128, 4, F.G, F.bid); EpiResid<false> E{nullptr, hbf, rss, x3}; gemm_run<EpiResid<false>, false>(F.lds, S, E, nullptr, F.wave);
    }
    SEAM(9);
    if (IN(10)) {
        route1(F, hbf, args.in[I_ON2], args.in[I_WR], topi, topw, cnt, rstd);
    }
    SEAM(10);
    if (IN(11)) {
        route2(F, topi, topw, cnt, stok, sw, blk, (int*)(ws + WS_S0TAB));
        { LAS unsigned* T0 = (LAS unsigned*)scr; LAS unsigned* T1 = T0 + 1088;
#define MOE_JOB(J_, it_) const int e_##J_ = (it_) / 1792; \
            const CvtJob J_{args.in[I_OWD] + (size_t)e_##J_ * FFE * 1024, FFE, 1024, (bf16*)((unsigned char*)wdn + (size_t)e_##J_ * 1024 * FFE), nullptr, 0}
          for (int it = F.gw; it < 8 * 1792; it += 2 * F.NGW) {
            CvtRegs A_, B_; B_.valid = 0;
            { MOE_JOB(Ja, it); cvt_load8(A_, Ja, it % 1792, LANE()); }
            if (it + F.NGW < 8 * 1792) { MOE_JOB(Jb, it + F.NGW); cvt_load8(B_, Jb, (it + F.NGW) % 1792, LANE()); }
            cvt_finish8(A_, T0, LANE(), 32.0f); cvt_finish8(B_, T1, LANE(), 32.0f);
          }
#undef MOE_JOB
        }
    }
    SEAM(11);
    bf16* ht0 = (bf16*)((unsigned char*)hmid1 + (size_t)NT * FFE); bf16* ht1 = (bf16*)(ws + WS_HT1);
    constexpr int KG = 512, KD = FFE / 2; constexpr size_t ESG = (size_t)7168 * 1024, ESD = (size_t)1024 * FFE;
    if (IN(12)) {
        const int nb = blk[0]; Sched S; S.init(x3, wgu, KG, nb, 28, F.G, F.bid, blk + 16, ESG); EpiSwiGLU<true> E{hmid1, FFE, rstd, ht0}; gemm_run<EpiSwiGLU<true>, true, true>(F.lds, S, E, stok, F.wave);
    }
    SEAM(12);
    if (IN(13)) {
        const int nb = blk[0], nbm = nb < 128 ? nb : 128; Sched S; S.init(hmid1, wdn, KD, nbm, 4, F.G, F.bid, blk + 16, ESD); EpiRowScale E{(bf16*)(ws + WS_YA), DM, sw, 0.03125f}; gemm_run<EpiRowScale, false, true>(F.lds, S, E, nullptr, F.wave);
    }
    SEAM(13);
    if (IN(14)) {
        const int nb = blk[1], nb0 = blk[0], rfull = (nb * 28 / F.G > 3) ? nb * 28 / F.G - 3 : 0, per = F.G / 8;
        { Sched S; S.init(x3, wgu, KG, nb, 28, F.G, F.bid, blk + 16 + 256, ESG); S.range(0, rfull * per, per);
          EpiSwiGLU<true> E{hmid1, FFE, rstd, ht1}; gemm_run<EpiSwiGLU<true>, true, true>(F.lds, S, E, stok + SLOT_CAP, F.wave); }
        { Sched S; S.init(x3, wgu, KG, nb, 28, F.G, F.bid, blk + 16 + 256, ESG); S.range(rfull * per, 0x7fffffff, per - 4);
          EpiSwiGLU<true> E{hmid1, FFE, rstd, ht1}; gemm_run<EpiSwiGLU<true>, true, true>(F.lds, S, E, stok + SLOT_CAP, F.wave); }
        if (F.bid / 8 >= per - 4 && nb0 > 128) {
            Sched S; S.init(ht0, wdn, KD, nb0 - 128, 4, 32, (F.bid / 8 - (per - 4)) * 8 + F.bid % 8, blk + 16 + 128, ESD);
            EpiRowScale E{(bf16*)(ws + WS_YA) + (size_t)NT * DM, DM, sw + NT, 0.03125f}; gemm_run<EpiRowScale, false, true>(F.lds, S, E, nullptr, F.wave); }
    }
    SEAM(14);
    if (IN(15)) {
        const int nb = blk[1], nbm = nb < 128 ? nb : 128; Sched S; S.init(hmid1, wdn, KD, nbm, 4, F.G, F.bid, blk + 16 + 256, ESD); EpiRowScale E{(bf16*)(ws + WS_YB), DM, sw + SLOT_CAP, 0.03125f}; gemm_run<EpiRowScale, false, true>(F.lds, S, E, nullptr, F.wave);
    }
    SEAM(15);
    if (IN(16)) {
        const int nb = blk[1], per = F.G / 8, nmain = (nb < 128 ? nb : 128) * 256;
        bf16* yb = (bf16*)(ws + WS_YB); bf16* yb2 = yb + (size_t)SLOT_CAP * DM;
        if (F.bid / 8 >= per - 4) {
            if (nb > 128) {
                const int sl = F.bid / 8 - (per - 4), kh = sl >> 1;
                Sched S; S.init((const bf16*)ht1 + kh * (KD / 2), (const bf16*)wdn + kh * (KD / 2), KD / 2, nb - 128, 4, 16, (sl & 1) * 8 + F.bid % 8, blk + 16 + 256 + 128, ESD); S.ld = KD;
                EpiRowScale E{kh ? yb2 : yb + (size_t)NT * DM, DM, sw + SLOT_CAP + NT, 0.03125f}; gemm_run<EpiRowScale, false, true>(F.lds, S, E, nullptr, F.wave); }
        } else {
            const int wv = (int)(blockIdx.x * NWAVES) + F.wave;
            final_norm_slots(LANE(), hbf, H, (const bf16*)(ws + WS_YA), (const int*)(ws + WS_S0TAB), yb, nullptr, args.in[I_FNORM], stok + SLOT_CAP, 0, nmain, wv, (per - 4) * 8 * NWAVES);
        }
        xcd_barrier(bar);
        if (nb > 128) final_norm_slots(LANE(), hbf, H, (const bf16*)(ws + WS_YA), (const int*)(ws + WS_S0TAB), yb, yb2, args.in[I_FNORM], stok + SLOT_CAP, NT, nb * 256, (int)(blockIdx.x * NWAVES) + F.wave, F.NGW);
    }
#undef IN
#undef SEAM
}

extern "C" void kernel_launch(void* const* d_in, const int* in_sizes, int n_in, void* d_out, int out_size, void* d_ws, size_t ws_size, hipStream_t stream) {
    static int grid = 0;
    if (grid == 0) {
        if (n_in != 26 || out_size != NT * DM || ws_size < WS_END) { fprintf(stderr, "kernel_launch: unexpected problem (n_in %d out %d ws %zu need %zu)\n", n_in, out_size, ws_size, (size_t)WS_END); grid = -1; return; }
        int dev = 0, cus = 0, per_cu = 0;
        if (hipGetDevice(&dev) != hipSuccess || hipDeviceGetAttribute(&cus, hipDeviceAttributeMultiprocessorCount, dev) != hipSuccess) { grid = -1; return; }
        if (hipFuncSetAttribute((const void*)mega, hipFuncAttributeMaxDynamicSharedMemorySize, LDS_BYTES) != hipSuccess) { fprintf(stderr, "kernel_launch: hipFuncSetAttribute failed\n"); grid = -1; return; }
        if (hipOccupancyMaxActiveBlocksPerMultiprocessor(&per_cu, (const void*)mega, NTHR, LDS_BYTES) != hipSuccess || per_cu < 1) fprintf(stderr, "kernel_launch: occupancy query reports %d\n", per_cu);
        (void)hipGetLastError();
        if (cus < 256) { fprintf(stderr, "kernel_launch: this kernel is built for a 256-CU device (one resident workgroup per CU), found %d CUs; nothing launched\n", cus); grid = -1; return; }
        grid = 256;
    }
    if (grid < 0) return;
    if (hipMemsetAsync((char*)d_ws + WS_CTL, 0, CTL_ZERO_BYTES, stream) != hipSuccess) return;
    Args a{};
    for (int i = 0; i < 26; ++i) a.in[i] = (const float*)d_in[i];
    a.out = (float*)d_out; a.ws = (unsigned char*)d_ws;
    a.ph_lo = 0; a.ph_hi = N_PHASES;
    hipLaunchKernelGGL(mega, dim3(grid), dim3(NTHR), LDS_BYTES, stream, a);
}
```

```cpp
#include <hip/hip_runtime.h>
#include <cstdio>
#include <cstdint>


#define GAS __attribute__((address_space(1)))
#define LAS __attribute__((address_space(3)))
typedef unsigned short bf16;
typedef unsigned v4u __attribute__((ext_vector_type(4)));
typedef unsigned v2u __attribute__((ext_vector_type(2)));
typedef float f32x4 __attribute__((ext_vector_type(4)));
typedef short bf16x8 __attribute__((ext_vector_type(8)));
typedef GAS unsigned gu32;
#define RLX_AGENT __ATOMIC_RELAXED, __HIP_MEMORY_SCOPE_AGENT
#define LDS_WAIT() asm volatile("s_waitcnt lgkmcnt(0)" ::: "memory")
#define VM_WAIT() asm volatile("s_waitcnt vmcnt(0)" ::: "memory")

constexpr int NT = 32768, DM = 1024, SEQ = 4096, NB = 8;
constexpr int MEM_ROWS = 2048;
constexpr int A0_LD = 1792;
constexpr int A1_LD = 2048;
constexpr int FF0 = 2816, FFE = 3584, NEXP = 8;
constexpr int SLOT_CAP = 34816;
constexpr float EPS = 1e-6f;
constexpr int NWAVES = 8, NTHR = 512;

constexpr size_t MiB = 1u << 20;
constexpr size_t WS_CTL = 0, CTL_ZERO_BYTES = 1 * MiB;
constexpr size_t WS_RSS = 1 * MiB;
constexpr size_t WS_MRSS = 3 * MiB;
constexpr size_t WS_CNT = 3 * MiB + 256 * 1024;
constexpr size_t WS_TOPI = 3 * MiB + 512 * 1024;
constexpr size_t WS_TOPW = 3 * MiB + 768 * 1024;
constexpr size_t WS_STOK = 4 * MiB;
constexpr size_t WS_SW = 4 * MiB + 512 * 1024;
constexpr size_t WS_BLK = 5 * MiB;
constexpr size_t WS_RSTD = 5 * MiB + 64 * 1024;
constexpr size_t WS_S0TAB = 5 * MiB + 512 * 1024;
constexpr size_t WS_W0IN = 6 * MiB;
constexpr size_t WS_WV0 = WS_W0IN + 1792 * 2048;
constexpr size_t WS_W0OUT = 11 * MiB;
constexpr size_t WS_W0GU = 13 * MiB;
constexpr size_t WS_W0DN = 24 * MiB;
constexpr size_t WS_WMEM = WS_W0DN + 1024 * 2816 * 2;
constexpr size_t WS_W1IN = 31 * MiB;
constexpr size_t WS_WV1 = 35 * MiB;
constexpr size_t WS_W1OUT = 37 * MiB - 512 * 1024;
constexpr size_t WS_HBF = 39 * MiB;
constexpr size_t WS_MEMBF = 103 * MiB;
constexpr size_t WS_MEMK = 107 * MiB;
constexpr size_t WS_MEMVT = 108 * MiB;
constexpr size_t WS_ACT = 109 * MiB;
constexpr size_t WS_ACT0 = WS_ACT;
constexpr size_t WS_V0T = WS_ACT + 112 * MiB;
constexpr size_t WS_MIX = WS_ACT + 176 * MiB;
constexpr size_t WS_HMID0 = WS_ACT;
constexpr size_t WS_ACT1 = WS_ACT;
constexpr size_t WS_V1T = WS_ACT + 128 * MiB;
constexpr size_t WS_OF = WS_ACT + 240 * MiB;
constexpr size_t WS_OB = WS_ACT + 288 * MiB;
constexpr size_t WS_GQT = WS_ACT + 336 * MiB;
constexpr size_t WS_GKDT0 = WS_ACT + 384 * MiB;
constexpr size_t WS_GKDT1 = 6 * MiB;
constexpr size_t OUT_GKT = 0, OUT_GDEC = 48 * MiB, OUT_WGU = 52 * MiB;
constexpr size_t WS_E = WS_ACT + 336 * MiB;
constexpr size_t WS_HT1 = 6 * MiB;
constexpr size_t WS_YB = WS_ACT + 240 * MiB;
constexpr size_t WS_YA = WS_ACT + 128 * MiB;
constexpr size_t WS_HMID1 = WS_ACT;
constexpr size_t WS_WGU = WS_ACT + 240 * MiB;
constexpr size_t WS_WDN = WS_ACT + 352 * MiB;
constexpr size_t WS_END = WS_ACT + 408 * MiB;
static_assert(WS_W1OUT + 2 * MiB <= WS_HBF && WS_WV1 + 768 * 2048 <= WS_W1OUT && WS_W1IN + 4 * MiB <= WS_WV1 && WS_WMEM + MiB <= WS_W1IN, "weight map");
static_assert(WS_W0GU + 11 * MiB <= WS_W0DN && WS_WV0 + 768 * 2048 <= WS_W0OUT, "weight map 2");
static_assert((size_t)SLOT_CAP * 3584 * 2 <= 240 * MiB, "hmid1");

constexpr int CW_TMO = 0, CW_CODE = 1, CW_BAR = 4096;

constexpr int RING_BYTES = 131072;
constexpr int LDSCTL_OFF = 155648, MISC_OFF = LDSCTL_OFF + 320;
constexpr int LDS_BYTES = 156672;

typedef float f32x2_t __attribute__((ext_vector_type(2)));
typedef __bf16 bf16x2_t __attribute__((ext_vector_type(2)));
__device__ __forceinline__ unsigned pk2(float lo, float hi) { const f32x2_t v = {lo, hi}; const bf16x2_t b = __builtin_convertvector(v, bf16x2_t); return __builtin_bit_cast(unsigned, b); }
__device__ __forceinline__ unsigned f2bf(float f) { return pk2(f, 0.f) & 0xffffu; }
__device__ __forceinline__ float bf2f(bf16 b) { return __builtin_bit_cast(float, (unsigned)b << 16); }
__device__ __forceinline__ float bflo(unsigned u) { return __builtin_bit_cast(float, u << 16); }
__device__ __forceinline__ float bfhi(unsigned u) { return __builtin_bit_cast(float, u & 0xffff0000u); }
__device__ __forceinline__ float wave_sum(float v) {
#pragma unroll
    for (int o = 1; o < 64; o <<= 1) v += __shfl_xor(v, o);
    return v;
}
__device__ __forceinline__ float wave_max(float v) {
#pragma unroll
    for (int o = 1; o < 64; o <<= 1) v = fmaxf(v, __shfl_xor(v, o));
    return v;
}

__device__ __forceinline__ int lane_id() { unsigned z = 0u; asm volatile("" : "+v"(z)); return (int)__builtin_amdgcn_mbcnt_hi(0xffffffffu, __builtin_amdgcn_mbcnt_lo(0xffffffffu, z)); }
#define XB_TMO      128
#define XB_XCNT(j)  (256  + 64 * (j))
#define XB_XSUB(j)  (1280 + 64 * (j))
#define XB_XGEN(j)  (2304 + 64 * (j))
#define XB_TOP      3328
#define XB_TOPGEN   3392
#define XCD_BAR_WORDS 3456
#define XB_SPIN_CAP (1u << 22)

__device__ __forceinline__ unsigned xb_ld(unsigned* p)              { return __hip_atomic_load(p, __ATOMIC_RELAXED, __HIP_MEMORY_SCOPE_AGENT); }
__device__ __forceinline__ unsigned xb_add(unsigned* p, unsigned v) { return __hip_atomic_fetch_add(p, v, __ATOMIC_RELAXED, __HIP_MEMORY_SCOPE_AGENT); }
__device__ __forceinline__ unsigned xb_xcc_id() { return (unsigned)__builtin_amdgcn_s_getreg((3 << 11) | 20) & 0xFu; }
#define XB_SPIN(cond, bar) do { unsigned _sp = 0; while (cond) { __builtin_amdgcn_s_sleep(1); \
    if ((++_sp & 255u) == 0u) { if (xb_ld(&(bar)[XB_TMO])) break; if (_sp > XB_SPIN_CAP) { atomicAdd(&(bar)[XB_TMO], 1u); break; } } } } while (0)

struct XcdBarrier { unsigned* bar; unsigned x; volatile LAS unsigned* st; int w0; };

__device__ __forceinline__ XcdBarrier xcd_barrier_post(unsigned* bar, volatile LAS unsigned* st, int wave) {
    XcdBarrier b; b.bar = bar; b.x = xb_xcc_id(); b.st = st; b.w0 = (wave == 0) ? 1 : 0;
    if (b.w0 && lane_id() == 0) (void)xb_add(&bar[XB_XCNT(b.x)], 1u);
    return b;
}
__device__ __forceinline__ void xcd_barrier_complete(unsigned* bar, unsigned x, unsigned& nloc, unsigned& nx) {
    const unsigned G = gridDim.x * gridDim.y * gridDim.z;
    unsigned sum, cnt, mine, sp = 0u;
    for (;;) {
        sum = 0u; cnt = 0u; mine = 0u;
#pragma unroll
        for (unsigned j = 0; j < 16; ++j) { const unsigned c = xb_ld(&bar[XB_XCNT(j)]); sum += c; cnt += (c > 0u) ? 1u : 0u; mine = (j == x) ? c : mine; }
        if (sum == G) break;
        __builtin_amdgcn_s_sleep(1);
        if ((++sp & 255u) == 0u) { if (xb_ld(&bar[XB_TMO])) break; if (sp > XB_SPIN_CAP) { atomicAdd(&bar[XB_TMO], 1u); break; } }
    }
    nloc = mine > 0u ? mine : 1u; nx = cnt > 0u ? cnt : 1u;
}
__device__ __forceinline__ void xcd_barrier(const XcdBarrier& b) {
    asm volatile("s_waitcnt vmcnt(0)" ::: "memory");
    __syncthreads();
    if (b.w0 && lane_id() == 0) {
        unsigned* bar = b.bar;
        __builtin_amdgcn_s_waitcnt(0);
        unsigned nloc = b.st[0], nx = b.st[1];
        if (nloc == 0u) { xcd_barrier_complete(bar, b.x, nloc, nx); b.st[0] = nloc; b.st[1] = nx; }
        const unsigned old = xb_add(&bar[XB_XSUB(b.x)], 1u);
        const unsigned gen = old / nloc;
        if (old + 1u == (gen + 1u) * nloc) {
            __builtin_amdgcn_fence(__ATOMIC_RELEASE, "agent");
            asm volatile("s_waitcnt vmcnt(0)" ::: "memory");
            const unsigned og = xb_add(&bar[XB_TOP], 1u);
            const unsigned tg = og / nx;
            if (og + 1u == (tg + 1u) * nx) xb_add(&bar[XB_TOPGEN], 1u);
            else XB_SPIN(xb_ld(&bar[XB_TOPGEN]) == tg, bar);
            __builtin_amdgcn_fence(__ATOMIC_ACQUIRE, "agent");
            xb_add(&bar[XB_XGEN(b.x)], 1u);
            asm volatile("s_waitcnt vmcnt(0)" ::: "memory");
        } else {
            XB_SPIN(xb_ld(&bar[XB_XGEN(b.x)]) == gen, bar);
            __builtin_amdgcn_fence(__ATOMIC_ACQUIRE, "agent");
            asm volatile("s_waitcnt vmcnt(0)" ::: "memory");
        }
    }
    __syncthreads();
}

struct Args { const float* in[26]; float* out; unsigned char* ws; int ph_lo, ph_hi; };
enum { I_X = 0, I_MEM, I_EN1, I_EWIN, I_RPB, I_EWOUT, I_EN2, I_EWG, I_EWU, I_EWD, I_ON1, I_OWIN, I_WGKF, I_BGKF, I_WGKB, I_BGKB, I_GNORM, I_OWOUT, I_ON2, I_WR, I_OWG, I_OWU, I_OWD, I_MNORM, I_WMKV, I_FNORM };

#define LANE() lane_id()
#define TID() ((F.wave << 6) | lane_id())
struct Frame {
    LAS unsigned char* lds;
    int wave, G, bid;
    int gw, NGW;
    unsigned char* ws;
};

constexpr float QSCALE = 0.125f * 1.4426950408889634f;
struct CvtJob { const float* W; int K, N; bf16* WT; const float* gain; int kind; };
__device__ __forceinline__ bool cvt_map(int kind, int n0, int& drow, float& scale) {
    scale = 1.0f;
    switch (kind) {
    case 0: drow = n0; return true;
    case 1: if (n0 < 768) { drow = n0; scale = QSCALE; return true; } if (n0 < 1536) { drow = n0; return true; } if (n0 >= 2304) { drow = n0 - 768; scale = QSCALE; return true; } return false;
    case 2: if (n0 >= 1536 && n0 < 2304) { drow = n0 - 1536; return true; } return false;
    case 3: drow = (n0 >> 7) * 256 + (n0 & 127); return true;
    case 4: drow = (n0 >> 7) * 256 + 128 + (n0 & 127); return true;
    case 5: if (n0 < 768) { drow = n0; return true; } if (n0 < 1536) return false; if (n0 < 2304) { drow = n0 - 768; return true; }
            if (n0 < 2336) { drow = n0 - 512; return true; } drow = n0 - 800; scale = QSCALE; return true;
    case 6: if (n0 >= 768 && n0 < 1536) { drow = n0 - 768; return true; } return false;
    default: drow = n0; return true;
    }
}
__device__ __forceinline__ unsigned pk4_fp8(float a, float b, float c, float d) { a = __builtin_amdgcn_fmed3f(a, -448.f, 448.f); b = __builtin_amdgcn_fmed3f(b, -448.f, 448.f); c = __builtin_amdgcn_fmed3f(c, -448.f, 448.f); d = __builtin_amdgcn_fmed3f(d, -448.f, 448.f);
    unsigned w = 0u; w = (unsigned)__builtin_amdgcn_cvt_pk_fp8_f32(a, b, (int)w, false); w = (unsigned)__builtin_amdgcn_cvt_pk_fp8_f32(c, d, (int)w, true); return w; }
struct CvtRegs { f32x4 v[8]; const float* gain; bf16* WT; int K, k0, drow, valid; float scale; };
__device__ __forceinline__ void cvt_load(CvtRegs& R, const CvtJob& J, int item, int lane) {
    const int nblk = J.N / 32, kb = item / nblk, nb = item % nblk, n0 = nb * 32;
    R.k0 = kb * 64; R.gain = J.gain; R.WT = J.WT; R.K = J.K;
    R.valid = cvt_map(J.kind, n0, R.drow, R.scale) ? 1 : 0;
    if (R.valid) { const float* p = J.W + (size_t)(R.k0 + 2 * (lane >> 3)) * J.N + n0 + 4 * (lane & 7);
#pragma unroll
        for (int j = 0; j < 8; ++j) R.v[j] = *(const f32x4*)(p + (size_t)(16 * (j >> 1) + (j & 1)) * J.N); }
}
__device__ __forceinline__ void cvt_load8(CvtRegs& R, const CvtJob& J, int item, int lane) {
    const int nblk = J.N / 32, kb = item / nblk, nb = item % nblk, n0 = nb * 32;
    R.k0 = kb * 64; R.gain = J.gain; R.WT = J.WT; R.K = J.K;
    R.valid = cvt_map(J.kind, n0, R.drow, R.scale) ? 1 : 0;
    if (R.valid) { const float* p = J.W + (size_t)(R.k0 + 4 * (lane >> 3)) * J.N + n0 + 4 * (lane & 7);
#pragma unroll
        for (int j = 0; j < 8; ++j) R.v[j] = *(const f32x4*)(p + (size_t)(32 * (j >> 2) + (j & 3)) * J.N); }
}
__device__ __forceinline__ void cvt_finish8(const CvtRegs& R, LAS unsigned* T, int lane, float mul) {
    if (!R.valid) return;
    const int nq = lane & 7, kr = lane >> 3;
#pragma unroll
    for (int p = 0; p < 2; ++p) { const int k = R.k0 + 32 * p + 4 * kr; float g[4];
#pragma unroll
        for (int q = 0; q < 4; ++q) g[q] = R.scale * mul * (R.gain ? R.gain[k + q] : 1.0f);
        const f32x4 a = R.v[4 * p], b = R.v[4 * p + 1], c = R.v[4 * p + 2], d = R.v[4 * p + 3]; LAS unsigned* t = T + (4 * nq) * 17 + 8 * p + kr;
        t[0] = pk4_fp8(a.x * g[0], b.x * g[1], c.x * g[2], d.x * g[3]); t[17] = pk4_fp8(a.y * g[0], b.y * g[1], c.y * g[2], d.y * g[3]);
        t[34] = pk4_fp8(a.z * g[0], b.z * g[1], c.z * g[2], d.z * g[3]); t[51] = pk4_fp8(a.w * g[0], b.w * g[1], c.w * g[2], d.w * g[3]); }
    LDS_WAIT(); asm volatile("" ::: "memory");
#pragma unroll
    for (int r = 0; r < 2; ++r) { const int n = (lane >> 2) + 16 * r, c = lane & 3; const LAS unsigned* sp = T + n * 17 + 4 * c;
        v4u o; o.x = sp[0]; o.y = sp[1]; o.z = sp[2]; o.w = sp[3];
        *(GAS v4u*)((unsigned char*)R.WT + (size_t)(R.drow + n) * R.K + R.k0 + 16 * c) = o; }
    LDS_WAIT(); asm volatile("" ::: "memory");
}
__device__ __forceinline__ void cvt_finish(const CvtRegs& R, LAS unsigned* T, int lane) {
    if (!R.valid) return;
    const int nq = lane & 7, kr = lane >> 3;
#pragma unroll
    for (int p = 0; p < 4; ++p) { const int k = R.k0 + 16 * p + 2 * kr; float g0 = R.scale, g1 = R.scale; if (R.gain) { g0 *= R.gain[k]; g1 *= R.gain[k + 1]; }
        const f32x4 a = R.v[2 * p], b = R.v[2 * p + 1]; LAS unsigned* t = T + (4 * nq) * 33 + 8 * p + kr;
        t[0] = pk2(a.x * g0, b.x * g1); t[33] = pk2(a.y * g0, b.y * g1); t[66] = pk2(a.z * g0, b.z * g1); t[99] = pk2(a.w * g0, b.w * g1); }
    LDS_WAIT(); asm volatile("" ::: "memory");
#pragma unroll
    for (int r = 0; r < 4; ++r) { const int n = (lane >> 3) + 8 * r, c = lane & 7; const LAS unsigned* sp = T + n * 33 + 4 * c;
        v4u o; o.x = sp[0]; o.y = sp[1]; o.z = sp[2]; o.w = sp[3];
        *(GAS v4u*)(R.WT + (size_t)(R.drow + n) * R.K + R.k0 + 8 * c) = o; }
    LDS_WAIT(); asm volatile("" ::: "memory");
}
__device__ __forceinline__ void rows_to_bf16(const float* X, bf16* Ob, float* rstd, int first, int nrows, int stride, int lane) {
    for (int m = first; m < nrows; m += 2 * stride) {
        const int m2 = m + stride; const bool h2 = m2 < nrows;
        const GAS f32x4* xa = (const GAS f32x4*)(X + (size_t)m * DM) + lane; const GAS f32x4* xb = (const GAS f32x4*)(X + (size_t)(h2 ? m2 : m) * DM) + lane;
        f32x4 va[4], vb[4];
#pragma unroll
        for (int j = 0; j < 4; ++j) va[j] = xa[64 * j];
#pragma unroll
        for (int j = 0; j < 4; ++j) vb[j] = xb[64 * j];
        float sa = 0.f, sb = 0.f;
#pragma unroll
        for (int j = 0; j < 4; ++j) { sa += (va[j].x * va[j].x + va[j].y * va[j].y) + (va[j].z * va[j].z + va[j].w * va[j].w); sb += (vb[j].x * vb[j].x + vb[j].y * vb[j].y) + (vb[j].z * vb[j].z + vb[j].w * vb[j].w); }
        sa = wave_sum(sa); sb = wave_sum(sb);
        GAS unsigned long long* oa = (GAS unsigned long long*)(Ob + (size_t)m * DM) + lane;
#pragma unroll
        for (int j = 0; j < 4; ++j) oa[64 * j] = (unsigned long long)pk2(va[j].x, va[j].y) | ((unsigned long long)pk2(va[j].z, va[j].w) << 32);
        if (lane == 0) rstd[m] = __builtin_amdgcn_rsqf(sa * (1.0f / DM) + EPS);
        if (h2) { GAS unsigned long long* ob = (GAS unsigned long long*)(Ob + (size_t)m2 * DM) + lane;
#pragma unroll
            for (int j = 0; j < 4; ++j) ob[64 * j] = (unsigned long long)pk2(vb[j].x, vb[j].y) | ((unsigned long long)pk2(vb[j].z, vb[j].w) << 32);
            if (lane == 0) rstd[m2] = __builtin_amdgcn_rsqf(sb * (1.0f / DM) + EPS); }
    }
}

struct Unit { int pm, pn; };
struct Sched {
    int nM, nN, nwg, G, c, K, ld, off0, off1, per;
    const char* A; const char* B; const int* bexp; size_t estride;
    __device__ void init(const void* A_, const void* B_, int K_, int nM_, int nN_, int G_, int c_, const int* bexp_ = nullptr, size_t estride_ = 0) {
        A = (const char*)A_; B = (const char*)B_; K = K_; ld = K_; nM = nM_; nN = nN_; nwg = nM * nN; G = G_; c = c_; bexp = bexp_; estride = estride_; off0 = 0; off1 = 0x7fffffff; per = G_ / 8; }
    __device__ void range(int off0_, int off1_, int per_) { off0 = off0_; off1 = off1_; per = per_; }
    __device__ bool next(int i, Unit& u) const {
        const int q = nwg / 8, r = nwg % 8, xcd = c % 8, slot = c / 8, lt = (int)((unsigned)(xcd - r) >> 31), qx = q + lt;
        if (slot >= per) return false;
        const int off = off0 + i * per + slot, lim = off1 < qx ? off1 : qx;
        if (off >= lim) return false;
        const int wgid = xcd * q + (lt ? xcd : r) + off;
        const int nig = 8 * nN, gid = wgid / nig, fm = gid * 8, gsz = (nM - fm) < 8 ? (nM - fm) : 8;
        u.pm = fm + ((wgid % nig) % gsz); u.pn = (wgid % nig) / gsz; return true;
    }
    __device__ const char* a_base(const Unit& u) const { return A + (size_t)u.pm * 512 * ld; }
    __device__ const char* b_base(const Unit& u) const { return B + (bexp ? (size_t)bexp[u.pm] * estride : (size_t)0) + (size_t)u.pn * 512 * ld; }
};

struct NoAux {};
__device__ __forceinline__ float rstd_from(const float* rss16) {
    const f32x4* p = (const f32x4*)rss16; f32x4 a = p[0], b = p[1], c = p[2], d = p[3];
    const float s = ((a.x + a.y) + (a.z + a.w)) + ((b.x + b.y) + (b.z + b.w)) + ((c.x + c.y) + (c.z + c.w)) + ((d.x + d.y) + (d.z + d.w));
    return __builtin_amdgcn_rsqf(s * (1.0f / DM) + EPS);
}
__device__ __forceinline__ float rstd_from_lds(const LAS float* rss16) {
    const LAS f32x4* p = (const LAS f32x4*)rss16; f32x4 a = p[0], b = p[1], c = p[2], d = p[3];
    const float s = ((a.x + a.y) + (a.z + a.w)) + ((b.x + b.y) + (b.z + b.w)) + ((c.x + c.y) + (c.z + c.w)) + ((d.x + d.y) + (d.z + d.w));
    return __builtin_amdgcn_rsqf(s * (1.0f / DM) + EPS);
}
constexpr int RSS_LDS_REL = 2048;
struct RowCtx { float rs[2][4]; };
template <bool RSS = false> struct EpiRowScaleT {
    static constexpr bool NEED_SS = false; static constexpr int SC_MODE = RSS ? 5 : 1; typedef RowCtx Ctx; typedef NoAux Aux;
    bf16* O; int ldc; const float* sc_src; float mul;
    __device__ __forceinline__ void begin(Ctx& c, const LAS float* sc, const LAS int*, int lr0, int, int, int) const {
#pragma unroll
        for (int ai = 0; ai < 2; ++ai)
#pragma unroll
            for (int m = 0; m < 4; ++m) c.rs[ai][m] = sc[ai * 128 + lr0 + m * 16] * mul;
    }
    __device__ __forceinline__ void load_aux(Aux&, const Ctx&, int, int, int, int, int) const {}
    __device__ __forceinline__ float apply(const Ctx& c, const Aux&, int ai, int m, int row, int pn, int c128, const float (&a)[8], const float (&b)[8]) const {
        const float s = c.rs[ai][m];
        bf16* p = O + (size_t)row * ldc + pn * 256 + c128;
        v4u w; w.x = pk2(a[0] * s, a[1] * s); w.y = pk2(a[2] * s, a[3] * s); w.z = pk2(a[4] * s, a[5] * s); w.w = pk2(a[6] * s, a[7] * s); *(v4u*)p = w;
        w.x = pk2(b[0] * s, b[1] * s); w.y = pk2(b[2] * s, b[3] * s); w.z = pk2(b[4] * s, b[5] * s); w.w = pk2(b[6] * s, b[7] * s); *(v4u*)(p + 128) = w;
        return 0.f;
    }
    __device__ __forceinline__ void row_done(int, int, int, float) const {}
};
typedef EpiRowScaleT<false> EpiRowScale;
struct ColCtx { float sa[8], sb[8]; };
template <bool RSS = false> struct EpiColScaleT {
    static constexpr bool NEED_SS = false; static constexpr int SC_MODE = RSS ? 6 : 2; typedef ColCtx Ctx; typedef NoAux Aux;
    bf16* O; int ldc; const float* sc_src;
    __device__ __forceinline__ void begin(Ctx& c, const LAS float* sc, const LAS int*, int, int, int, int c128) const {
#pragma unroll
        for (int j = 0; j < 8; ++j) { c.sa[j] = sc[c128 + j]; c.sb[j] = sc[128 + c128 + j]; }
    }
    __device__ __forceinline__ void load_aux(Aux&, const Ctx&, int, int, int, int, int) const {}
    __device__ __forceinline__ float apply(const Ctx& c, const Aux&, int, int, int row, int pn, int c128, const float (&a)[8], const float (&b)[8]) const {
        bf16* p = O + (size_t)row * ldc + pn * 256 + c128;
        v4u w; w.x = pk2(a[0] * c.sa[0], a[1] * c.sa[1]); w.y = pk2(a[2] * c.sa[2], a[3] * c.sa[3]); w.z = pk2(a[4] * c.sa[4], a[5] * c.sa[5]); w.w = pk2(a[6] * c.sa[6], a[7] * c.sa[7]); *(v4u*)p = w;
        w.x = pk2(b[0] * c.sb[0], b[1] * c.sb[1]); w.y = pk2(b[2] * c.sb[2], b[3] * c.sb[3]); w.z = pk2(b[4] * c.sb[4], b[5] * c.sb[5]); w.w = pk2(b[6] * c.sb[6], b[7] * c.sb[7]); *(v4u*)(p + 128) = w;
        return 0.f;
    }
    __device__ __forceinline__ void row_done(int, int, int, float) const {}
};
typedef EpiColScaleT<false> EpiColScale;
struct Aux4 { f32x4 v[4]; };
struct NoCtx {};
struct AuxR { f32x4 v[4]; };
struct AuxB { v4u a, b; };
__device__ __forceinline__ void unpack16(const AuxB& x, f32x4 (&v)[4]) {
    v[0] = (f32x4){bflo(x.a.x), bfhi(x.a.x), bflo(x.a.y), bfhi(x.a.y)}; v[1] = (f32x4){bflo(x.a.z), bfhi(x.a.z), bflo(x.a.w), bfhi(x.a.w)};
    v[2] = (f32x4){bflo(x.b.x), bfhi(x.b.x), bflo(x.b.y), bfhi(x.b.y)}; v[3] = (f32x4){bflo(x.b.z), bfhi(x.b.z), bflo(x.b.w), bfhi(x.b.w)}; }
template <bool F32> struct AuxSel { typedef AuxR T; };
template <> struct AuxSel<false> { typedef AuxB T; };
template <bool RF32> struct EpiResid {
    static constexpr bool NEED_SS = true; static constexpr int SC_MODE = 0; typedef NoCtx Ctx; typedef typename AuxSel<RF32>::T Aux;
    const float* R; bf16* HB; float* rss; bf16* HB2;
    __device__ __forceinline__ void begin(Ctx&, const LAS float*, const LAS int*, int, int, int, int) const {}
    __device__ __forceinline__ void load_aux(Aux& x, const Ctx&, int, int, int row, int pn, int c128) const {
        const size_t off = (size_t)row * DM + pn * 256 + c128;
        if constexpr (RF32) { const float* p = R + off; x.v[0] = *(const f32x4*)p; x.v[1] = *(const f32x4*)(p + 4); x.v[2] = *(const f32x4*)(p + 128); x.v[3] = *(const f32x4*)(p + 132); }
        else { x.a = *(const v4u*)(HB + off); x.b = *(const v4u*)(HB + off + 128); }
    }
    __device__ __forceinline__ float apply(const Ctx&, const Aux& xr, int, int, int row, int pn, int c128, const float (&a)[8], const float (&b)[8]) const {
        const size_t off = (size_t)row * DM + pn * 256 + c128;
        struct { f32x4 v[4]; } x; if constexpr (RF32) { x.v[0] = xr.v[0]; x.v[1] = xr.v[1]; x.v[2] = xr.v[2]; x.v[3] = xr.v[3]; } else unpack16(xr, x.v);
        const f32x4 h0 = {x.v[0].x + a[0], x.v[0].y + a[1], x.v[0].z + a[2], x.v[0].w + a[3]}, h1 = {x.v[1].x + a[4], x.v[1].y + a[5], x.v[1].z + a[6], x.v[1].w + a[7]};
        const f32x4 h2 = {x.v[2].x + b[0], x.v[2].y + b[1], x.v[2].z + b[2], x.v[2].w + b[3]}, h3 = {x.v[3].x + b[4], x.v[3].y + b[5], x.v[3].z + b[6], x.v[3].w + b[7]};
        v4u w; w.x = pk2(h0.x, h0.y); w.y = pk2(h0.z, h0.w); w.z = pk2(h1.x, h1.y); w.w = pk2(h1.z, h1.w); *(v4u*)(HB + off) = w; if (HB2) { v2u f; f.x = pk4_fp8(h0.x, h0.y, h0.z, h0.w); f.y = pk4_fp8(h1.x, h1.y, h1.z, h1.w); *(v2u*)((unsigned char*)HB2 + off) = f; }
        w.x = pk2(h2.x, h2.y); w.y = pk2(h2.z, h2.w); w.z = pk2(h3.x, h3.y); w.w = pk2(h3.z, h3.w); *(v4u*)(HB + off + 128) = w; if (HB2) { v2u f; f.x = pk4_fp8(h2.x, h2.y, h2.z, h2.w); f.y = pk4_fp8(h3.x, h3.y, h3.z, h3.w); *(v2u*)((unsigned char*)HB2 + off + 128) = f; }
        return ((h0.x * h0.x + h0.y * h0.y) + (h0.z * h0.z + h0.w * h0.w) + (h1.x * h1.x + h1.y * h1.y) + (h1.z * h1.z + h1.w * h1.w))
             + ((h2.x * h2.x + h2.y * h2.y) + (h2.z * h2.z + h2.w * h2.w) + (h3.x * h3.x + h3.y * h3.y) + (h3.z * h3.z + h3.w * h3.w));
    }
    __device__ __forceinline__ void row_done(int row, int pn, int wc, float ss) const { rss[(size_t)row * 16 + pn * 4 + wc] = ss; }
};
__device__ __forceinline__ float silu_mul(float g, float u) { return g * __builtin_amdgcn_rcpf(1.0f + __builtin_amdgcn_exp2f(g * -1.4426950408889634f)) * u; }
template <bool MOE, bool RSS = false> struct EpiSwiGLU {
    static constexpr bool NEED_SS = false; static constexpr int SC_MODE = MOE ? 3 : (RSS ? 5 : 1); typedef RowCtx Ctx; typedef NoAux Aux;
    bf16* Hm; int ldh; const float* sc_src; bf16* Hmt;
    __device__ __forceinline__ void begin(Ctx& c, const LAS float* sc, const LAS int* tl, int lr0, int, int, int) const {
#pragma unroll
        for (int ai = 0; ai < 2; ++ai)
#pragma unroll
            for (int m = 0; m < 4; ++m) { const int i = ai * 128 + lr0 + m * 16; float r = sc[i];
                if (MOE) { r *= 0.03125f; if (tl[i] < 0) r = 0.f; } c.rs[ai][m] = r; }
    }
    __device__ __forceinline__ void load_aux(Aux&, const Ctx&, int, int, int, int, int) const {}
    __device__ __forceinline__ float apply(const Ctx& c, const Aux&, int ai, int m, int row, int pn, int c128, const float (&a)[8], const float (&b)[8]) const {
        const float s = c.rs[ai][m], s2 = s * -1.4426950408889634f, ss = s * s; float o[8];
#pragma unroll
        for (int j = 0; j < 8; ++j) o[j] = (a[j] * b[j]) * (ss * __builtin_amdgcn_rcpf(1.0f + __builtin_amdgcn_exp2f(a[j] * s2)));
        v4u w; w.x = pk2(o[0], o[1]); w.y = pk2(o[2], o[3]); w.z = pk2(o[4], o[5]); w.w = pk2(o[6], o[7]);
        if constexpr (MOE) {
            unsigned char* rp = (row >= NT) ? (unsigned char*)Hmt + (size_t)(row - NT) * ldh : (unsigned char*)Hm + (size_t)row * ldh;
            v2u f; f.x = pk4_fp8(o[0], o[1], o[2], o[3]); f.y = pk4_fp8(o[4], o[5], o[6], o[7]); *(v2u*)(rp + pn * 128 + c128) = f;
        } else *(v4u*)(Hm + (size_t)row * ldh + pn * 128 + c128) = w;
        return 0.f;
    }
    __device__ __forceinline__ void row_done(int, int, int, float) const {}
};

namespace pg8 {
constexpr int HTB = 16384, TOK_OFF = 132096, SC_OFF = 134144;
__device__ __forceinline__ int lds_byte(int r, int c) { const int st = (r >> 4) * 2 + (c >> 5), rr = r & 15, cc = c & 31, ob = rr * 64 + cc * 2; return st * 1024 + (ob ^ (((ob >> 9) & 1) << 5)); }
__device__ __forceinline__ void stage_rc(int b, int& R, int& C) { const int st = b / 1024, sb = b % 1024, swz = sb ^ (((sb >> 9) & 1) << 5); R = (st >> 1) * 16 + swz / 64; C = (st & 1) * 32 + (swz % 64) / 2; }
__device__ __forceinline__ int perm32(int rho) { const int n = rho >> 4, i = rho & 15; return 8 * (i >> 2) + 4 * n + (i & 3); }

template <class Epi>
__device__ __forceinline__ void run_epi(const Epi& E, const f32x4 (&acc)[2][2][4][2], const Unit& u, int wr, int wc, int fr, int fq, const LAS float* sc, const LAS int* tlp) {
    int row0 = u.pm * 256 + wr * 64 + fr, c128 = 32 * wc + 8 * fq;
    asm volatile("" : "+v"(row0), "+v"(c128));
    typename Epi::Ctx ctx; E.begin(ctx, sc, tlp, wr * 64 + fr, row0, u.pn, c128);
#pragma unroll
    for (int ai = 0; ai < 2; ++ai) {
        typename Epi::Aux aux[4];
#pragma unroll
        for (int m = 0; m < 4; ++m) E.load_aux(aux[m], ctx, ai, m, row0 + ai * 128 + m * 16, u.pn, c128);
#pragma unroll
        for (int m = 0; m < 4; ++m) {
            const int row = row0 + ai * 128 + m * 16;
            float a[8], b[8];
#pragma unroll
            for (int j = 0; j < 8; ++j) { a[j] = acc[ai][0][m][j >> 2][j & 3]; b[j] = acc[ai][1][m][j >> 2][j & 3]; }
            float ss = E.apply(ctx, aux[m], ai, m, row, u.pn, c128, a, b);
            if (Epi::NEED_SS) { ss += __shfl_xor(ss, 16); ss += __shfl_xor(ss, 32); if (fq == 0) E.row_done(row, u.pn, wc, ss); }
        }
    }
}

typedef int v8i __attribute__((ext_vector_type(8)));
template <class Epi, bool GATHER, bool FP8 = false>
__device__ __forceinline__ void gemm_fast(LAS unsigned char* lds, const Sched& S, const Epi& E, const int* gtok, int wave_) {
    int tid = (wave_ << 6) | lane_id(); asm volatile("" : "+v"(tid));
    const int wid = __builtin_amdgcn_readfirstlane(tid >> 6), lane = tid & 63, wr = wid >> 2, wc = wid & 3, fr = lane & 15, fq = lane >> 4;
    const int K = S.ld, nt = S.K / 64;
    unsigned voffB[2], vA0[2], vA1[2], nA0[2], nA1[2]; int RA[2], CA2[2];
#pragma unroll
    for (int i = 0; i < 2; ++i) { int R, C; stage_rc(tid * 16 + i * 8192, R, C); const int Rb = (R & ~31) + perm32(R & 31);
        voffB[i] = (unsigned)(Rb * K + C) * 2u; RA[i] = R; CA2[i] = C * 2; vA0[i] = (unsigned)(R * K + C) * 2u; vA1[i] = vA0[i] + (unsigned)(128 * K * 2); nA0[i] = vA0[i]; nA1[i] = vA1[i]; }
    const size_t kstep = 128;
    const size_t hstep = (size_t)128 * K * 2;
    const unsigned ldsw = (unsigned)wid * 1024u;
    const int aoff = lds_byte(wr * 64 + fr, fq * 8), boff = lds_byte(wc * 32 + fr, fq * 8);
    LAS int* tl = (LAS int*)(lds + TOK_OFF);
#define PG8_SA(b, h) (((b) * 2 + (h)) * HTB)
#define PG8_SB(b, h) ((4 + (b) * 2 + (h)) * HTB)
#define PG8_STAGE(bufoff, gbase, voff) do { _Pragma("unroll") for (int _i = 0; _i < 2; ++_i) \
        __builtin_amdgcn_global_load_lds((const unsigned*)((const char*)(gbase) + (voff)[_i]), (LAS unsigned*)(lds + (bufoff) + ldsw + _i * 8192), 16, 0, 0); } while (0)
#define PG8_LDA(dst, b, h) do { _Pragma("unroll") for (int m = 0; m < 4; ++m) _Pragma("unroll") for (int k = 0; k < 2; ++k) dst[m][k] = *(const LAS bf16x8*)(lds + PG8_SA(b, h) + aoff + m * 2048 + k * 1024); } while (0)
#define PG8_LDB(dst, b, h) do { _Pragma("unroll") for (int n = 0; n < 2; ++n) _Pragma("unroll") for (int k = 0; k < 2; ++k) dst[n][k] = *(const LAS bf16x8*)(lds + PG8_SB(b, h) + boff + n * 2048 + k * 1024); } while (0)
#define PG8_MMA(ai, bj, At, Bt) do { __builtin_amdgcn_s_setprio(1); _Pragma("unroll") for (int m = 0; m < 4; ++m) _Pragma("unroll") for (int n = 0; n < 2; ++n) { \
        if constexpr (FP8) { const v8i b8_ = __builtin_bit_cast(v8i, __builtin_shufflevector(Bt[n][0], Bt[n][1], 0, 1, 2, 3, 4, 5, 6, 7, 8, 9, 10, 11, 12, 13, 14, 15)), a8_ = __builtin_bit_cast(v8i, __builtin_shufflevector(At[m][0], At[m][1], 0, 1, 2, 3, 4, 5, 6, 7, 8, 9, 10, 11, 12, 13, 14, 15)); \
            asm volatile("v_mfma_f32_16x16x128_f8f6f4 %0, %1, %2, %0" : "+v"(acc[ai][bj][m][n]) : "v"(b8_), "v"(a8_)); }     \
        else { _Pragma("unroll") for (int k = 0; k < 2; ++k) acc[ai][bj][m][n] = __builtin_amdgcn_mfma_f32_16x16x32_bf16(Bt[n][k], At[m][k], acc[ai][bj][m][n], 0, 0, 0); } } \
        __builtin_amdgcn_s_setprio(0); } while (0)
#define PG8_WAIT_V(n) asm volatile("s_waitcnt vmcnt(" #n ")" ::: "memory")
#define PG8_WAIT_L(n) asm volatile("s_waitcnt lgkmcnt(" #n ")" ::: "memory")
#define PG8_BAR __builtin_amdgcn_s_barrier()
#define PG8_SCHED __builtin_amdgcn_sched_barrier(0)
#define PG8_IDS_DMA(pm_, par_) do { if (wid < 4) __builtin_amdgcn_global_load_lds((const unsigned*)(gtok + (pm_) * 256 + wid * 64 + lane), (LAS unsigned*)(lds + TOK_OFF + (par_) * 1024 + wid * 256), 4, 0, 0); } while (0)
#define PG8_IDS_READ(d0, d1, par_) do { _Pragma("unroll") for (int _i = 0; _i < 2; ++_i) { int t0 = tl[(par_) * 256 + RA[_i]], t1 = tl[(par_) * 256 + 128 + RA[_i]]; t0 = t0 < 0 ? 0 : t0; t1 = t1 < 0 ? 0 : t1; \
        d0[_i] = (unsigned)t0 * (unsigned)(K * 2) + (unsigned)CA2[_i]; d1[_i] = (unsigned)t1 * (unsigned)(K * 2) + (unsigned)CA2[_i]; } } while (0)
    Unit cur, nxt; int ui = 0, par = 0;
    if (!S.next(0, cur)) return;
    f32x4 acc[2][2][4][2];
#pragma unroll
    for (int a = 0; a < 2; ++a)
#pragma unroll
        for (int b = 0; b < 2; ++b)
#pragma unroll
            for (int m = 0; m < 4; ++m)
#pragma unroll
                for (int n = 0; n < 2; ++n) acc[a][b][m][n] = (f32x4){0.f, 0.f, 0.f, 0.f};
    bf16x8 At[4][2], B0[2][2], B1[2][2];
    const char* cA = GATHER ? S.A : S.a_base(cur); const char* cB = S.b_base(cur);
    if constexpr (GATHER) { PG8_IDS_DMA(cur.pm, 0); PG8_WAIT_V(0); __syncthreads(); PG8_IDS_READ(vA0, vA1, 0); }
    PG8_STAGE(PG8_SB(0, 0), cB, voffB); PG8_STAGE(PG8_SB(0, 1), cB + hstep, voffB); PG8_STAGE(PG8_SA(0, 0), cA, vA0); PG8_STAGE(PG8_SA(0, 1), cA, vA1);
    if (wr == 1) PG8_BAR;
    PG8_WAIT_V(2); PG8_BAR;
    PG8_STAGE(PG8_SB(1, 0), cB + kstep, voffB); PG8_STAGE(PG8_SA(1, 0), cA + kstep, vA0); PG8_STAGE(PG8_SB(1, 1), cB + hstep + kstep, voffB);
    PG8_WAIT_V(6); PG8_BAR;
    for (;;) {
        const bool has_next = S.next(ui + 1, nxt);
        const char* nA = has_next ? (GATHER ? S.A : S.a_base(nxt)) : cA; const char* nB = has_next ? S.b_base(nxt) : cB;
        for (int t = 0; t < nt; t += 2) {
            const bool last = (t == nt - 2);
            if constexpr (GATHER) {
                if (t == nt - 4 && has_next) PG8_IDS_DMA(nxt.pm, par ^ 1);
                if (last) { if (has_next) PG8_IDS_READ(nA0, nA1, par ^ 1); else { nA0[0] = vA0[0]; nA0[1] = vA0[1]; nA1[0] = vA1[0]; nA1[1] = vA1[1]; } }
            }
            if constexpr (Epi::SC_MODE == 5 || Epi::SC_MODE == 6) {
                if (last) { const float* src_ = E.sc_src + (size_t)(Epi::SC_MODE == 5 ? cur.pm : cur.pn) * 4096 + wid * 512 + lane * 4;
                    __builtin_amdgcn_global_load_lds((const unsigned*)src_, (LAS unsigned*)(lds + SC_OFF + RSS_LDS_REL + wid * 2048), 16, 0, 0);
                    __builtin_amdgcn_global_load_lds((const unsigned*)(src_ + 256), (LAS unsigned*)(lds + SC_OFF + RSS_LDS_REL + wid * 2048 + 1024), 16, 0, 0); }
            } else if constexpr (Epi::SC_MODE != 0) {
                if (last && wid < 4) { const int i_ = wid * 64 + lane; LAS unsigned* d_ = (LAS unsigned*)(lds + SC_OFF + wid * 256);
                    if constexpr (Epi::SC_MODE == 1) __builtin_amdgcn_global_load_lds((const unsigned*)(E.sc_src + cur.pm * 256 + i_), d_, 4, 0, 0);
                    if constexpr (Epi::SC_MODE == 2) __builtin_amdgcn_global_load_lds((const unsigned*)(E.sc_src + cur.pn * 256 + i_), d_, 4, 0, 0);
                    if constexpr (Epi::SC_MODE == 3) { int t_ = tl[par * 256 + i_]; t_ = t_ < 0 ? 0 : t_; __builtin_amdgcn_global_load_lds((const unsigned*)(E.sc_src + t_), d_, 4, 0, 0); }
                    if constexpr (Epi::SC_MODE == 4) { __builtin_amdgcn_global_load_lds((const unsigned*)(E.tok + cur.pm * 256 + i_), d_, 4, 0, 0);
                        __builtin_amdgcn_global_load_lds((const unsigned*)(E.w + cur.pm * 256 + i_), (LAS unsigned*)(lds + SC_OFF + 1024 + wid * 256), 4, 0, 0); } }
            }
            const char* a1 = cA + (size_t)(t + 1) * kstep;
            const char* a2 = last ? nA : cA + (size_t)(t + 2) * kstep; const char* b2 = last ? nB : cB + (size_t)(t + 2) * kstep;
            const char* a3 = a2 + kstep; const char* b3 = b2 + kstep;
            unsigned w0[2], w1[2];
            if (GATHER && last) { w0[0] = nA0[0]; w0[1] = nA0[1]; w1[0] = nA1[0]; w1[1] = nA1[1]; } else { w0[0] = vA0[0]; w0[1] = vA0[1]; w1[0] = vA1[0]; w1[1] = vA1[1]; }
            PG8_LDB(B0, 0, 0); PG8_LDB(B1, 0, 1); PG8_SCHED; PG8_LDA(At, 0, 0); PG8_STAGE(PG8_SA(1, 1), a1, vA1);
            PG8_WAIT_V(8); PG8_WAIT_L(0); PG8_BAR; PG8_MMA(0, 0, At, B0); PG8_MMA(0, 1, At, B1); PG8_BAR; PG8_SCHED;
            PG8_LDA(At, 0, 1); PG8_STAGE(PG8_SB(0, 0), b2, voffB); PG8_STAGE(PG8_SB(0, 1), b2 + hstep, voffB); PG8_STAGE(PG8_SA(0, 0), a2, w0);
            PG8_WAIT_V(8); PG8_WAIT_L(0); PG8_BAR; PG8_MMA(1, 0, At, B0); PG8_MMA(1, 1, At, B1); PG8_BAR; PG8_SCHED;
            PG8_LDB(B0, 1, 0); PG8_LDB(B1, 1, 1); PG8_SCHED; PG8_LDA(At, 1, 0); PG8_STAGE(PG8_SA(0, 1), a2, w1);
            PG8_WAIT_V(8); PG8_WAIT_L(0); PG8_BAR; PG8_MMA(0, 0, At, B0); PG8_MMA(0, 1, At, B1); PG8_BAR; PG8_SCHED;
            PG8_LDA(At, 1, 1); PG8_STAGE(PG8_SB(1, 0), b3, voffB); PG8_STAGE(PG8_SB(1, 1), b3 + hstep, voffB); PG8_STAGE(PG8_SA(1, 0), a3, w0);
            PG8_WAIT_V(8); PG8_WAIT_L(0); PG8_BAR; PG8_MMA(1, 0, At, B0); PG8_MMA(1, 1, At, B1); PG8_BAR; PG8_SCHED;
        }
        if constexpr (FP8) asm volatile("s_nop 15\n\ts_nop 15" ::: "memory");
        if (wr == 0) PG8_BAR;
        if constexpr (Epi::SC_MODE == 5 || Epi::SC_MODE == 6) {
            if (wid < 4) ((LAS float*)(lds + SC_OFF))[tid] = rstd_from_lds((const LAS float*)(lds + SC_OFF + RSS_LDS_REL) + tid * 16);
            PG8_WAIT_L(0); PG8_BAR;
        }
        run_epi(E, acc, cur, wr, wc, fr, fq, (const LAS float*)(lds + SC_OFF), (const LAS int*)(lds + TOK_OFF + par * 1024));
        if (!has_next) break;
#pragma unroll
        for (int a = 0; a < 2; ++a)
#pragma unroll
            for (int b = 0; b < 2; ++b)
#pragma unroll
                for (int m = 0; m < 4; ++m)
#pragma unroll
                    for (int n = 0; n < 2; ++n) acc[a][b][m][n] = (f32x4){0.f, 0.f, 0.f, 0.f};
        cur = nxt; cA = nA; cB = nB; ++ui;
        if constexpr (GATHER) { vA0[0] = nA0[0]; vA0[1] = nA0[1]; vA1[0] = nA1[0]; vA1[1] = nA1[1]; par ^= 1; }
        if (wr == 1) PG8_BAR;
    }
    PG8_WAIT_V(0);
    PG8_BAR;
#undef PG8_SA
#undef PG8_SB
#undef PG8_STAGE
#undef PG8_LDA
#undef PG8_LDB
#undef PG8_MMA
#undef PG8_WAIT_V
#undef PG8_WAIT_L
#undef PG8_BAR
#undef PG8_SCHED
#undef PG8_IDS_DMA
#undef PG8_IDS_READ
}
}

template <class Epi, bool GATHER, bool FP8 = false>
__device__ __forceinline__ void gemm_run(LAS unsigned char* lds, const Sched& S, const Epi& E, const int* gtok, int wave_) { pg8::gemm_fast<Epi, GATHER, FP8>(lds, S, E, gtok, wave_); }

typedef short s16x4 __attribute__((ext_vector_type(4)));
template <bool NA, bool KLDS = false, int VLDS = 0, int KRS = 64>
__device__ __forceinline__ void attn16(int lane, const bf16* Q, int ldq, const bf16* Kb, int ldk, const bf16* Vt, int ldv, int ktok0, int trs, bf16* O, int ldo,
                                       const LAS float* rpb_h, int r, int r0, int jb, int band0, const LAS unsigned char* Kl = nullptr, int arow0 = 0, const LAS unsigned char* Vl = nullptr, int kb0 = 0) {
    const int qi = lane & 15, g = lane >> 4;
    bf16x8 qf[2];
#pragma unroll
    for (int ks = 0; ks < 2; ++ks) qf[ks] = *(const bf16x8*)(Q + (size_t)qi * ldq + ks * 32 + 8 * g);
    f32x4 s[16];
    const int krow = 8 * (qi >> 2) + (qi & 3);
#pragma unroll
    for (int t = 0; t < 16; ++t) {
        bf16x8 k0, k1;
        if constexpr (KLDS) {
            const int kcol = kb0 + krow + 4 * (t & 1), swz = (((kcol >> 3) & 3) << 1) | ((kcol >> 1) & 1);
            const LAS unsigned char* kb = Kl + ((arow0 + (t >> 1)) * KRS + kcol) * 128;
            k0 = *(const LAS bf16x8*)(kb + ((g ^ swz) << 4)); k1 = *(const LAS bf16x8*)(kb + (((4 + g) ^ swz) << 4));
        } else {
            const bf16* kp = Kb + (size_t)(ktok0 + (t >> 1) * trs + krow + 4 * (t & 1)) * ldk + 8 * g;
            k0 = *(const bf16x8*)kp; k1 = *(const bf16x8*)(kp + 32);
        }
        f32x4 z = {0.f, 0.f, 0.f, 0.f};
        z = __builtin_amdgcn_mfma_f32_16x16x32_bf16(k0, qf[0], z, 0, 0, 0);
        z = __builtin_amdgcn_mfma_f32_16x16x32_bf16(k1, qf[1], z, 0, 0, 0);
        s[t] = z;
        if constexpr (KLDS) { if ((t & 3) == 3) __builtin_amdgcn_sched_barrier(0); }
    }
    bf16x8 vfa[VLDS ? 1 : 4][VLDS ? 1 : 8];
    if constexpr (!VLDS) {
#pragma unroll
        for (int mt = 0; mt < 4; ++mt)
#pragma unroll
            for (int kk = 0; kk < 8; ++kk) vfa[mt][kk] = *(const bf16x8*)(Vt + (size_t)(16 * mt + qi) * ldv + ktok0 + kk * trs + 8 * g);
        __builtin_amdgcn_sched_barrier(0);
    }
    float m = -INFINITY;
    if constexpr (NA) {
        const int qc = 16 * jb + qi, cs = min(max(qc - 8, 0), 48);
        const LAS float* bp = rpb_h + (r0 - r + 7) * 31 + (band0 + 8 * g - qc + 15);
        bool ok[2][4];
#pragma unroll
        for (int hh = 0; hh < 2; ++hh)
#pragma unroll
            for (int i = 0; i < 4; ++i) { const int kc = band0 + 8 * g + 4 * hh + i; ok[hh][i] = (kc >= cs) && (kc < cs + 16); }
#pragma unroll
        for (int tq = 0; tq < 4; ++tq) {
            float bv[4][4];
#pragma unroll
            for (int tt = 0; tt < 4; ++tt)
#pragma unroll
                for (int i = 0; i < 4; ++i) { const int t = 4 * tq + tt; bv[tt][i] = bp[(t >> 1) * 31 + 4 * (t & 1) + i]; }
#pragma unroll
            for (int tt = 0; tt < 4; ++tt)
#pragma unroll
                for (int i = 0; i < 4; ++i) asm volatile("" : "+v"(bv[tt][i]));
#pragma unroll
            for (int tt = 0; tt < 4; ++tt)
#pragma unroll
                for (int i = 0; i < 4; ++i) { const int t = 4 * tq + tt;
                    const float v = ok[t & 1][i] ? s[t][i] + bv[tt][i] : -INFINITY;
                    s[t][i] = v; m = fmaxf(m, v); }
        }
    } else {
#pragma unroll
        for (int t = 0; t < 16; ++t)
#pragma unroll
            for (int i = 0; i < 4; ++i) m = fmaxf(m, s[t][i]);
    }
    m = fmaxf(m, __shfl_xor(m, 16)); m = fmaxf(m, __shfl_xor(m, 32));
    float l = 0.f;
    bf16x8 pf[8];
#pragma unroll
    for (int kk = 0; kk < 8; ++kk) {
        float p[8];
#pragma unroll
        for (int i = 0; i < 4; ++i) { p[i] = __builtin_amdgcn_exp2f(s[2 * kk][i] - m); p[4 + i] = __builtin_amdgcn_exp2f(s[2 * kk + 1][i] - m); }
#pragma unroll
        for (int i = 0; i < 8; ++i) l += p[i];
        v4u w; w.x = pk2(p[0], p[1]); w.y = pk2(p[2], p[3]); w.z = pk2(p[4], p[5]); w.w = pk2(p[6], p[7]);
        pf[kk] = __builtin_bit_cast(bf16x8, w);
    }
    l += __shfl_xor(l, 16); l += __shfl_xor(l, 32);
    const float inv = __builtin_amdgcn_rcpf(l);
#pragma unroll
    for (int mt = 0; mt < 4; ++mt) {
        f32x4 acc = {0.f, 0.f, 0.f, 0.f};
#pragma unroll
        for (int kk = 0; kk < 8; ++kk) {
            bf16x8 vf; if constexpr (VLDS == 1) vf = *(const LAS bf16x8*)(Vl + (16 * mt + qi) * 512 + (((4 * kk + g) ^ qi) << 4));
            else if constexpr (VLDS == 2) vf = *(const LAS bf16x8*)(Vl + (16 * mt + qi) * 1200 + ((arow0 + kk) * 40 + kb0 + 8 * g) * 2);
            else vf = vfa[mt][kk];
            acc = __builtin_amdgcn_mfma_f32_16x16x32_bf16(vf, pf[kk], acc, 0, 0, 0);
        }
        v2u w; w.x = pk2(acc[0] * inv, acc[1] * inv); w.y = pk2(acc[2] * inv, acc[3] * inv);
        *(v2u*)(O + (size_t)qi * ldo + 16 * mt + 4 * g) = w;
        if constexpr (VLDS) __builtin_amdgcn_sched_barrier(0);
    }
}
template <bool NA, int VMODE, int KRS>
__device__ __forceinline__ void attn16_lds(int lane, const bf16* Q, int ldq, bf16* O, int ldo, const LAS float* rpb_h, int r, int r0, int jb, int band0,
                                           const LAS unsigned char* Kl, int arow0, const LAS unsigned char* Vl, int kb0) {
    const int qi = lane & 15, g = lane >> 4;
    bf16x8 qf[2];
#pragma unroll
    for (int ks = 0; ks < 2; ++ks) qf[ks] = *(const bf16x8*)(Q + (size_t)qi * ldq + ks * 32 + 8 * g);
    const int krow = 8 * (qi >> 2) + (qi & 3);
    const LAS unsigned char* kbase[2][2];
#pragma unroll
    for (int e = 0; e < 2; ++e) { const int kcol = kb0 + krow + 4 * e, swz = (((kcol >> 3) & 3) << 1) | ((kcol >> 1) & 1); const LAS unsigned char* rb = Kl + (arow0 * KRS + kcol) * 128;
        kbase[e][0] = rb + ((g ^ swz) << 4); kbase[e][1] = rb + (((4 + g) ^ swz) << 4); }
#define A16_KFR(t, hh) (*(const LAS bf16x8*)(kbase[(t) & 1][hh] + ((t) >> 1) * (KRS * 128)))
    const LAS unsigned char* vbase[VMODE == 1 ? 8 : 1];
    if constexpr (VMODE == 1) {
#pragma unroll
        for (int kk = 0; kk < 8; ++kk) vbase[kk] = Vl + qi * 512 + (((4 * kk + g) ^ qi) << 4);
    } else vbase[0] = Vl + qi * 1200 + (arow0 * 40 + kb0 + 8 * g) * 2;
#define A16_VFR(mt, kk) (VMODE == 1 ? *(const LAS bf16x8*)(vbase[VMODE == 1 ? (kk) : 0] + (mt) * 8192) : *(const LAS bf16x8*)(vbase[0] + (mt) * 19200 + (kk) * 80))
    f32x4 s[16];
    bf16x8 kb[2][4][2];
    float bv[NA ? 16 : 1][4];
    const LAS float* bp = nullptr;
    if constexpr (NA) { const int qc = 16 * jb + qi; bp = rpb_h + (r0 - r + 7) * 31 + (band0 + 8 * g - qc + 15); }
#pragma unroll
    for (int tt = 0; tt < 4; ++tt) { kb[0][tt][0] = A16_KFR(tt, 0); kb[0][tt][1] = A16_KFR(tt, 1); }
#pragma unroll
    for (int gi = 0; gi < 4; ++gi) {
        if (gi < 3) {
#pragma unroll
            for (int tt = 0; tt < 4; ++tt) { kb[(gi + 1) & 1][tt][0] = A16_KFR(4 * (gi + 1) + tt, 0); kb[(gi + 1) & 1][tt][1] = A16_KFR(4 * (gi + 1) + tt, 1); }
        } else if constexpr (NA) {
#pragma unroll
            for (int t = 0; t < 16; ++t)
#pragma unroll
                for (int i = 0; i < 4; ++i) bv[t][i] = bp[(t >> 1) * 31 + 4 * (t & 1) + i];
        }
        __builtin_amdgcn_sched_barrier(0);
#pragma unroll
        for (int tt = 0; tt < 4; ++tt) { const f32x4 z = {0.f, 0.f, 0.f, 0.f}; s[4 * gi + tt] = __builtin_amdgcn_mfma_f32_16x16x32_bf16(kb[gi & 1][tt][0], qf[0], z, 0, 0, 0); }
#pragma unroll
        for (int tt = 0; tt < 4; ++tt) s[4 * gi + tt] = __builtin_amdgcn_mfma_f32_16x16x32_bf16(kb[gi & 1][tt][1], qf[1], s[4 * gi + tt], 0, 0, 0);
        __builtin_amdgcn_sched_barrier(0);
    }
    bf16x8 vb[2][8];
#pragma unroll
    for (int kk = 0; kk < 8; ++kk) vb[0][kk] = A16_VFR(0, kk);
    __builtin_amdgcn_sched_barrier(0);
    float m = -INFINITY;
    if constexpr (NA) {
        const int qc = 16 * jb + qi, cs = min(max(qc - 8, 0), 48);
        bool ok[2][4];
#pragma unroll
        for (int hh = 0; hh < 2; ++hh)
#pragma unroll
            for (int i = 0; i < 4; ++i) { const int kc = band0 + 8 * g + 4 * hh + i; ok[hh][i] = (kc >= cs) && (kc < cs + 16); }
#pragma unroll
        for (int t = 0; t < 16; ++t)
#pragma unroll
            for (int i = 0; i < 4; ++i) asm volatile("" : "+v"(bv[t][i]));
#pragma unroll
        for (int t = 0; t < 16; ++t)
#pragma unroll
            for (int i = 0; i < 4; ++i) { const float v = ok[t & 1][i] ? s[t][i] + bv[t][i] : -INFINITY; s[t][i] = v; m = fmaxf(m, v); }
    } else {
#pragma unroll
        for (int t = 0; t < 16; ++t)
#pragma unroll
            for (int i = 0; i < 4; ++i) m = fmaxf(m, s[t][i]);
    }
    m = fmaxf(m, __shfl_xor(m, 16)); m = fmaxf(m, __shfl_xor(m, 32));
    float l = 0.f;
    bf16x8 pf[8];
#pragma unroll
    for (int kk = 0; kk < 8; ++kk) {
        float p[8];
#pragma unroll
        for (int i = 0; i < 4; ++i) { p[i] = __builtin_amdgcn_exp2f(s[2 * kk][i] - m); p[4 + i] = __builtin_amdgcn_exp2f(s[2 * kk + 1][i] - m); }
#pragma unroll
        for (int i = 0; i < 8; ++i) l += p[i];
        v4u w; w.x = pk2(p[0], p[1]); w.y = pk2(p[2], p[3]); w.z = pk2(p[4], p[5]); w.w = pk2(p[6], p[7]);
        pf[kk] = __builtin_bit_cast(bf16x8, w);
    }
    l += __shfl_xor(l, 16); l += __shfl_xor(l, 32);
    const float inv = __builtin_amdgcn_rcpf(l);
    __builtin_amdgcn_sched_barrier(0);
#pragma unroll
    for (int mt = 0; mt < 4; ++mt) {
        if (mt < 3) {
#pragma unroll
            for (int kk = 0; kk < 8; ++kk) vb[(mt + 1) & 1][kk] = A16_VFR(mt + 1, kk);
        }
        __builtin_amdgcn_sched_barrier(0);
        f32x4 a0 = {0.f, 0.f, 0.f, 0.f}, a1 = {0.f, 0.f, 0.f, 0.f};
#pragma unroll
        for (int kk = 0; kk < 8; kk += 2) { a0 = __builtin_amdgcn_mfma_f32_16x16x32_bf16(vb[mt & 1][kk], pf[kk], a0, 0, 0, 0); a1 = __builtin_amdgcn_mfma_f32_16x16x32_bf16(vb[mt & 1][kk + 1], pf[kk + 1], a1, 0, 0, 0); }
        v2u w; w.x = pk2((a0[0] + a1[0]) * inv, (a0[1] + a1[1]) * inv); w.y = pk2((a0[2] + a1[2]) * inv, (a0[3] + a1[3]) * inv);
        *(v2u*)(O + (size_t)qi * ldo + 16 * mt + 4 * g) = w;
        __builtin_amdgcn_sched_barrier(0);
    }
#undef A16_KFR
#undef A16_VFR
}
__device__ __forceinline__ void memkv_item(int it, int lane, const bf16* membf, const bf16* wt, const float* mrstd, bf16* memk, bf16* memvt) {
    const int rt = it >> 4, ctile = it & 15, qi = lane & 15, g = lane >> 4, row0 = rt * 16, col0 = ctile * 32;
    const bf16* ap = membf + (size_t)(row0 + qi) * DM + 8 * g; const bf16* bp = wt + (size_t)(col0 + qi) * DM + 8 * g;
    f32x4 acc0 = {0.f, 0.f, 0.f, 0.f}, acc1 = {0.f, 0.f, 0.f, 0.f};
    const bool isk = col0 < 256;
    if (isk) {
#pragma unroll 1
        for (int k8 = 0; k8 < 32; k8 += 8) { bf16x8 a[8], b0[8], b1[8];
#pragma unroll
            for (int j = 0; j < 8; ++j) { a[j] = *(const bf16x8*)(ap + 32 * (k8 + j)); b0[j] = *(const bf16x8*)(bp + 32 * (k8 + j)); b1[j] = *(const bf16x8*)(bp + 16 * DM + 32 * (k8 + j)); }
#pragma unroll
            for (int j = 0; j < 8; ++j) { acc0 = __builtin_amdgcn_mfma_f32_16x16x32_bf16(b0[j], a[j], acc0, 0, 0, 0); acc1 = __builtin_amdgcn_mfma_f32_16x16x32_bf16(b1[j], a[j], acc1, 0, 0, 0); } }
    } else {
#pragma unroll 1
        for (int k8 = 0; k8 < 32; k8 += 8) { bf16x8 a[8], b0[8], b1[8];
#pragma unroll
            for (int j = 0; j < 8; ++j) { a[j] = *(const bf16x8*)(ap + 32 * (k8 + j)); b0[j] = *(const bf16x8*)(bp + 32 * (k8 + j)); b1[j] = *(const bf16x8*)(bp + 16 * DM + 32 * (k8 + j)); }
#pragma unroll
            for (int j = 0; j < 8; ++j) { acc0 = __builtin_amdgcn_mfma_f32_16x16x32_bf16(a[j], b0[j], acc0, 0, 0, 0); acc1 = __builtin_amdgcn_mfma_f32_16x16x32_bf16(a[j], b1[j], acc1, 0, 0, 0); } }
    }
    if (isk) {
        const float s = mrstd[row0 + qi]; bf16* p = memk + (size_t)(row0 + qi) * 256 + col0 + 4 * g;
        v2u w; w.x = pk2(acc0[0] * s, acc0[1] * s); w.y = pk2(acc0[2] * s, acc0[3] * s); *(v2u*)p = w;
        w.x = pk2(acc1[0] * s, acc1[1] * s); w.y = pk2(acc1[2] * s, acc1[3] * s); *(v2u*)(p + 16) = w;
    } else {
        const f32x4 s = *(const f32x4*)(mrstd + row0 + 4 * g); bf16* p = memvt + (size_t)(col0 - 256 + qi) * MEM_ROWS + row0 + 4 * g;
        v2u w; w.x = pk2(acc0[0] * s[0], acc0[1] * s[1]); w.y = pk2(acc0[2] * s[2], acc0[3] * s[3]); *(v2u*)p = w;
        w.x = pk2(acc1[0] * s[0], acc1[1] * s[1]); w.y = pk2(acc1[2] * s[2], acc1[3] * s[3]); *(v2u*)(p + (size_t)16 * MEM_ROWS) = w;
    }
}
__device__ __forceinline__ void memattn_strip(const Frame& F, int item, const bf16* act, int ld, int qoff, const bf16* memk, const bf16* memvt, bf16* mix) {
    const int tg = item & 15, h = (item >> 4) & 3, b = item >> 6, lane = LANE(), wave = F.wave;
    LAS unsigned char* Kl = F.lds; LAS unsigned char* Vl = F.lds + 32768;
#pragma unroll
    for (int j = 0; j < 4; ++j) {
        const int p = (wave * 4 + j) * 64 + lane, key = p >> 3, kpos = p & 7, kc = key & 31, swz = (((kc >> 3) & 3) << 1) | ((kc >> 1) & 1);
        __builtin_amdgcn_global_load_lds((const unsigned*)(memk + (size_t)(b * 256 + key) * 256 + h * 64 + ((kpos ^ swz) << 3)), (LAS unsigned*)(Kl + (wave * 4 + j) * 1024), 16, 0, 0);
        const int d = p >> 5, vpos = p & 31;
        __builtin_amdgcn_global_load_lds((const unsigned*)(memvt + (size_t)(h * 64 + d) * MEM_ROWS + b * 256 + ((vpos ^ (d & 15)) << 3)), (LAS unsigned*)(Vl + (wave * 4 + j) * 1024), 16, 0, 0);
    }
    asm volatile("s_waitcnt vmcnt(0)\n\ts_barrier" ::: "memory");
#pragma unroll 1
    for (int u = 0; u < 2; ++u) {
        const int tok0 = b * SEQ + tg * 256 + (wave * 2 + u) * 16;
        attn16_lds<false, 1, 32>(lane, act + (size_t)tok0 * ld + qoff + h * 64, ld, mix + (size_t)tok0 * DM + 768 + h * 64, DM, nullptr, 0, 0, 0, 0, Kl, 0, Vl, 0);
    }
    asm volatile("s_waitcnt lgkmcnt(0)\n\ts_barrier" ::: "memory");
}
__device__ __forceinline__ void memattn_item(int it, int lane, const bf16* act, int ld, int qoff, const bf16* memk, const bf16* memvt, bf16* mix) {
    const int tb = it >> 2, h = it & 3, tok0 = tb * 16, b = tok0 >> 12;
    attn16<false>(lane, act + (size_t)tok0 * ld + qoff + h * 64, ld, memk + h * 64, 256, memvt + (size_t)(h * 64) * MEM_ROWS, MEM_ROWS, b * 256, 32,
                  mix + (size_t)tok0 * DM + 768 + h * 64, DM, nullptr, 0, 0, 0, 0);
}
constexpr int NA_RPB_OFF = 122880;
__device__ __forceinline__ void na_strip(const Frame& F, int item, const bf16* act0, const bf16* v0t, bf16* mix) {
    const int s8 = item & 7, h = (item >> 3) % 12, b = (item >> 3) / 12, lane = LANE(), wave = F.wave;
    const int R0 = 8 * s8, rowbase = min(max(R0 - 4, 0), 56), rowend = min(max(R0 + 7 - 4, 0), 56) + 8, nrows = rowend - rowbase;
    LAS unsigned char* Kl = F.lds;
    {
        const int col = wave * 8 + (lane >> 3), pos = lane & 7, swz = (((col >> 3) & 3) << 1) | ((col >> 1) & 1);
        const bf16* src = act0 + (size_t)(b * SEQ + rowbase * 64 + col) * A0_LD + 768 + h * 64 + ((pos ^ swz) << 3);
        for (int j = 0; j < nrows; ++j)
            __builtin_amdgcn_global_load_lds((const unsigned*)(src + (size_t)j * 64 * A0_LD), (LAS unsigned*)(Kl + j * 8192 + wave * 1024), 16, 0, 0);
    }
    asm volatile("s_waitcnt vmcnt(0)\n\ts_barrier" ::: "memory");
    const int r = R0 + wave, r0 = min(max(r - 4, 0), 56);
    const LAS float* rpb = (const LAS float*)(F.lds + NA_RPB_OFF) + h * 465;
#pragma unroll 1
    for (int jb = 0; jb < 4; ++jb) {
        const int band0 = min(max(jb * 16 - 8, 0), 32), tok0 = b * SEQ + r * 64 + jb * 16;
        attn16<true, true>(lane, act0 + (size_t)tok0 * A0_LD + h * 64, A0_LD, nullptr, 0, v0t + (size_t)(h * 64) * NT, NT, b * SEQ + r0 * 64 + band0, 64,
                           mix + (size_t)tok0 * DM + h * 64, DM, rpb, r, r0, jb, band0, Kl, r0 - rowbase, nullptr, band0);
    }
    asm volatile("s_waitcnt lgkmcnt(0)\n\ts_barrier" ::: "memory");
}
constexpr int NAH_V = 76800, NAH_RPB = 153600;
__device__ __forceinline__ void na_hstrip(const Frame& F, int item, const bf16* act0, const bf16* v0t, const float* rpb_g, bf16* mix) {
    const int half = item & 1, s8 = (item >> 1) & 7, h = (item >> 4) % 12, b = (item >> 4) / 12, lane = LANE(), wave = F.wave;
    const int R0 = 8 * s8, rowbase = min(max(R0 - 4, 0), 56), rowend = min(max(R0 + 7 - 4, 0), 56) + 8, nrows = rowend - rowbase, cb0 = half ? 24 : 0;
    LAS unsigned char* Kl = F.lds; LAS unsigned char* Vl = F.lds + NAH_V; LAS float* rl = (LAS float*)(F.lds + NAH_RPB);
    {
        const int pos = lane & 7, nk = nrows * 5 - 1;
#pragma unroll
        for (int i = 0; i < 10; ++i) { const int k = min(wave + NWAVES * i, 74), idx = min(k, nk);
            { const int j = idx / 5, q = idx - 5 * j, lc = q * 8 + (lane >> 3), swz = (((lc >> 3) & 3) << 1) | ((lc >> 1) & 1);
              __builtin_amdgcn_global_load_lds((const unsigned*)(act0 + (size_t)(b * SEQ + (rowbase + j) * 64 + cb0 + lc) * A0_LD + 768 + h * 64 + ((pos ^ swz) << 3)), (LAS unsigned*)(Kl + idx * 1024), 16, 0, 0); }
            { const int G = k * 64 + lane, d = G / 75, rem = G - 75 * d, j0 = rem / 5, gc = rem - 5 * j0, j = min(j0, nrows - 1);
              __builtin_amdgcn_global_load_lds((const unsigned*)(v0t + (size_t)(h * 64 + d) * NT + b * SEQ + (rowbase + j) * 64 + cb0 + gc * 8), (LAS unsigned*)(Vl + k * 1024), 16, 0, 0); } }
    }
    float bias = 0.f; if (TID() < 465) bias = rpb_g[h * 465 + TID()];
    asm volatile("" : "+v"(bias));
    bias *= 1.4426950408889634f;
    if (TID() < 465) rl[TID()] = bias;
    asm volatile("s_waitcnt vmcnt(0) lgkmcnt(0)\n\ts_barrier" ::: "memory");
    const int r = R0 + wave, r0 = min(max(r - 4, 0), 56);
#pragma unroll 1
    for (int u = 0; u < 2; ++u) {
        const int jb = 2 * half + u, band0 = min(max(jb * 16 - 8, 0), 32), tok0 = b * SEQ + r * 64 + jb * 16;
        attn16_lds<true, 2, 40>(lane, act0 + (size_t)tok0 * A0_LD + h * 64, A0_LD, mix + (size_t)tok0 * DM + h * 64, DM, rl, r, r0, jb, band0, Kl, r0 - rowbase, Vl, band0 - cb0);
    }
    asm volatile("s_waitcnt lgkmcnt(0)\n\ts_barrier" ::: "memory");
}
__device__ __forceinline__ void na_item(int it, int lane, const bf16* act0, const bf16* v0t, const LAS float* rpb, bf16* mix) {
    const int jb = it & 3, h = (it >> 2) % 12, br = (it >> 2) / 12, r = br & 63, b = br >> 6;
    const int r0 = min(max(r - 4, 0), 56), band0 = min(max(jb * 16 - 8, 0), 32);
    const int tok0 = b * SEQ + r * 64 + jb * 16;
    attn16<true>(lane, act0 + (size_t)tok0 * A0_LD + h * 64, A0_LD, act0 + 768 + h * 64, A0_LD, v0t + (size_t)(h * 64) * NT, NT, b * SEQ + r0 * 64 + band0, 64,
                 mix + (size_t)tok0 * DM + h * 64, DM, rpb + h * 465, r, r0, jb, band0);
}

constexpr int GP_LD = 392;
__device__ __forceinline__ void gla_pre_w(int wave, int lane, const float* W, const float* Bi, bf16x8 (&wfr)[3], float (&bias)[3]) {
    const int qi = lane & 15, g = lane >> 4;
#pragma unroll
    for (int jj = 0; jj < 3; ++jj) {
        const int j = 16 * (wave + 8 * jj) + qi;
        v4u wu = {0u, 0u, 0u, 0u};
        if (g < 2) { const float* wp = W + (size_t)(8 * g) * 384 + j;
            wu.x = pk2(wp[0], wp[384]); wu.y = pk2(wp[768], wp[1152]); wu.z = pk2(wp[1536], wp[1920]); wu.w = pk2(wp[2304], wp[2688]); }
        wfr[jj] = __builtin_bit_cast(bf16x8, wu); bias[jj] = Bi[j];
    }
}
__device__ __forceinline__ void gla_pre_item(const Frame& F, int item, const bf16* act1, const bf16x8 (&wfr)[3], const float (&bias)[3], bf16* QT, bf16* KT, float* DEC) {
    const int n = item & 63, dir = (item >> 6) & 1, b = item >> 7, base = b * SEQ + n * 64;
    const int tid = TID(), lane = LANE(), wave = F.wave, qi = lane & 15, g = lane >> 4;
    LAS bf16* EL = (LAS bf16*)F.lds;
    bf16x8 zf[4];
#pragma unroll
    for (int ct = 0; ct < 4; ++ct) { const int c = 16 * ct + qi, tok = dir ? base + 63 - c : base + c;
        bf16x8 z = {0, 0, 0, 0, 0, 0, 0, 0}; if (g < 2) z = *(const bf16x8*)(act1 + (size_t)tok * A1_LD + 1792 + dir * 16 + 8 * g); zf[ct] = z; }
    v4u q8a[6], k8a[6];
#pragma unroll
    for (int k = 0; k < 6; ++k) { const int idx = tid + 512 * k, c = idx / 48, jg = idx % 48; const bf16* arow = act1 + (size_t)(base + c) * A1_LD + 8 * jg; q8a[k] = *(const v4u*)arow; k8a[k] = *(const v4u*)(arow + 384); }
#pragma unroll
    for (int jj = 0; jj < 3; ++jj) {
        const int j = 16 * (wave + 8 * jj) + qi;
        float p[4][4], a[4], t1[4], t2[4], tot[4];
#pragma unroll
        for (int ct = 0; ct < 4; ++ct) {
            f32x4 d = {0.f, 0.f, 0.f, 0.f};
            d = __builtin_amdgcn_mfma_f32_16x16x32_bf16(zf[ct], wfr[jj], d, 0, 0, 0);
#pragma unroll
            for (int i = 0; i < 4; ++i) { const float x = d[i] + bias[jj];
                p[ct][i] = (fminf(x, 0.f) * 1.4426950408889634f - __builtin_amdgcn_logf(1.0f + __builtin_amdgcn_exp2f(fabsf(x) * -1.4426950408889634f))) * 0.0625f; }
            p[ct][1] += p[ct][0]; p[ct][2] += p[ct][1]; p[ct][3] += p[ct][2]; a[ct] = p[ct][3];
        }
#pragma unroll
        for (int ct = 0; ct < 4; ++ct) t1[ct] = __shfl_up(a[ct], 16);
#pragma unroll
        for (int ct = 0; ct < 4; ++ct) if (g >= 1) a[ct] += t1[ct];
#pragma unroll
        for (int ct = 0; ct < 4; ++ct) t2[ct] = __shfl_up(a[ct], 32);
#pragma unroll
        for (int ct = 0; ct < 4; ++ct) if (g >= 2) a[ct] += t2[ct];
#pragma unroll
        for (int ct = 0; ct < 4; ++ct) tot[ct] = __shfl(a[ct], 48 + qi);
        float carry = 0.f;
#pragma unroll
        for (int ct = 0; ct < 4; ++ct) {
            const float excl = a[ct] - p[ct][3] + carry;
            carry += tot[ct];
#pragma unroll
            for (int i = 0; i < 4; ++i) { const int c = 16 * ct + 4 * g + i, ctok = dir ? 63 - c : c; EL[ctok * GP_LD + j] = (bf16)f2bf(__builtin_amdgcn_exp2f(excl + p[ct][i])); }
        }
    }
    __syncthreads();
    const int clast = dir ? 0 : 63;
#pragma unroll
    for (int k = 0; k < 6; ++k) {
        const int idx = tid + 512 * k, c = idx / 48, jg = idx % 48;
        const v4u q8 = q8a[k], k8 = k8a[k];
        const v4u e8 = *(const LAS v4u*)(EL + c * GP_LD + 8 * jg), l8 = *(const LAS v4u*)(EL + clast * GP_LD + 8 * jg);
        const unsigned qa[4] = {q8.x, q8.y, q8.z, q8.w}, ka[4] = {k8.x, k8.y, k8.z, k8.w}, ea[4] = {e8.x, e8.y, e8.z, e8.w}, la[4] = {l8.x, l8.y, l8.z, l8.w};
        unsigned qo[4], ko[4];
        float lf[8];
#pragma unroll
        for (int i = 0; i < 4; ++i) {
            const float e0 = bflo(ea[i]), e1 = bfhi(ea[i]), i0 = __builtin_amdgcn_rcpf(e0), i1 = __builtin_amdgcn_rcpf(e1);
            const float kt0 = bflo(ka[i]) * i0, kt1 = bfhi(ka[i]) * i1; lf[2 * i] = bflo(la[i]); lf[2 * i + 1] = bfhi(la[i]);
            qo[i] = pk2(bflo(qa[i]) * 0.10206207261596575f * e0, bfhi(qa[i]) * 0.10206207261596575f * e1);
            ko[i] = pk2(kt0, kt1);
        }
        v4u w; w.x = qo[0]; w.y = qo[1]; w.z = qo[2]; w.w = qo[3]; *(v4u*)(QT + (size_t)(base + c) * 384 + 8 * jg) = w;
        w.x = ko[0]; w.y = ko[1]; w.z = ko[2]; w.w = ko[3]; *(v4u*)(KT + (size_t)(base + c) * 384 + 8 * jg) = w;
        if (c == clast) { float* dp = DEC + (size_t)((b * 4 + jg / 12) * 64 + n) * 96 + (jg % 12) * 8;
            *(f32x4*)dp = (f32x4){lf[0], lf[1], lf[2], lf[3]}; *(f32x4*)(dp + 4) = (f32x4){lf[4], lf[5], lf[6], lf[7]}; }
    }
    __syncthreads();
}
constexpr int GL_QT = 0, GL_KT = 13312, GL_VT = 26624, GL_DEC = 33792, GL_BUF = 34816;
__device__ __forceinline__ void gla_main_item(const Frame& F, int item, const bf16* QTa, const bf16* KTa, const float* DECa, const bf16* v1t, bf16* OFp, bf16* OBp,
                                              const float* cwg, const float* cwu, const float* cgain, unsigned char* c8) {
    const int vs = item & 3, dir = (item >> 2) & 1, h = (item >> 3) & 3, b = item >> 5;
    const int lane = LANE(), wave = F.wave, qi = lane & 15, g = lane >> 4, ct = wave & 3, vh = wave >> 2;
    bf16* O = dir ? OBp : OFp;
    LAS unsigned char* L = F.lds;
    unsigned off[5];
#pragma unroll
    for (int jj = 0; jj < 5; ++jj) { const int k = wave + 8 * jj; unsigned o;
        if (k < 26) { const int gi = (k < 13 ? k : k - 13) * 64 + lane, row = gi / 13, col = gi % 13; o = (unsigned)(row * 768 + (col < 12 ? col * 16 : 0)); }
        else if (k < 33) { const int gi = (k - 26) * 64 + lane, row = gi / 9, col = gi % 9; o = (gi < 432) ? (unsigned)(row * NT * 2 + (col < 8 ? col * 16 : 0)) : 0u; }
        else o = (lane < 24) ? (unsigned)(lane * 16) : 0u;
        off[jj] = o; }
    const char* qtb = (const char*)(QTa + (size_t)dir * NT * 384 + h * 96); const char* ktb = (const char*)(KTa + (size_t)dir * NT * 384 + h * 96);
    const char* deb = (const char*)(DECa + (size_t)dir * 8 * 4 * 64 * 96 + (size_t)((b * 4 + h) * 64) * 96);
    const char* vtb = (const char*)(v1t + (size_t)(h * 192 + vs * 48) * NT);
#define GL_DMA(n_, bufo_) do { const int nn_ = dir ? 63 - (n_) : (n_); const size_t tb_ = (size_t)(b * SEQ + nn_ * 64); \
        _Pragma("unroll") for (int jj_ = 0; jj_ < 5; ++jj_) { const int k_ = wave + 8 * jj_; if (k_ < 34) { \
            const char* src_ = k_ < 13 ? qtb + tb_ * 768 : (k_ < 26 ? ktb + tb_ * 768 : (k_ < 33 ? vtb + tb_ * 2 : deb + (size_t)nn_ * 384)); \
            __builtin_amdgcn_global_load_lds((const unsigned*)(src_ + off[jj_]), (LAS unsigned*)(L + (bufo_) + k_ * 1024), 16, 0, 0); } } } while (0)
    constexpr int GL_SB = 3 * GL_BUF;
    int oT[3]; bool oV[3];
#pragma unroll
    for (int j = 0; j < 3; ++j) { if (wave >= 4) { oT[j] = (wave - 4) + 4 * j; oV[j] = true; } else { oV[j] = (j == 0) || (j == 1 && wave < 2); oT[j] = (j == 1 && wave < 2) ? 16 + wave : 12 + wave; } }
    f32x4 So[3];
#pragma unroll
    for (int j = 0; j < 3; ++j) So[j] = (f32x4){0.f, 0.f, 0.f, 0.f};
    unsigned kmw[2][4];
#pragma unroll
    for (int kk = 0; kk < 2; ++kk)
#pragma unroll
        for (int w2 = 0; w2 < 4; ++w2) { const int tp = 2 * kk + (w2 >> 1), i0 = 2 * (w2 & 1), c = 16 * ct + qi, cp = 16 * tp + 4 * g + i0;
            const bool k0 = dir ? (cp > c) : (cp <= c), k1 = dir ? (cp + 1 > c) : (cp + 1 <= c); kmw[kk][w2] = (k0 ? 0x0000ffffu : 0u) | (k1 ? 0xffff0000u : 0u); }
    for (int i = TID(); i < 18 * 512 / 8; i += NTHR) *(LAS v2u*)(L + GL_SB + i * 8) = (v2u){0u, 0u};
    GL_DMA(0, 0); GL_DMA(1, GL_BUF);
    asm volatile("s_waitcnt vmcnt(0) lgkmcnt(0)\n\ts_barrier" ::: "memory");
    int bo = 0, bo2 = 2 * GL_BUF;
    f32x4 cv[8], cg[2];
#pragma unroll
    for (int j = 0; j < 8; ++j) cv[j] = (f32x4){0.f, 0.f, 0.f, 0.f};
    cg[0] = cv[0]; cg[1] = cv[0];
    LAS unsigned* CT = (LAS unsigned*)(L + GL_SB + 18432 + wave * 2304);
#pragma unroll 1
    for (int n = 0; n < 64; ++n) {
        LAS unsigned char* Bf = L + bo;
        const LAS unsigned char* SBr = L + GL_SB + (n & 1) * 9216; LAS unsigned char* SBw = L + GL_SB + ((n + 1) & 1) * 9216;
        bf16x8 qf[3], kf[4][3], qp[3], vf[2][2], sf[2][3];
#pragma unroll
        for (int ks = 0; ks < 3; ++ks) qf[ks] = *(const LAS bf16x8*)(Bf + GL_QT + (16 * ct + qi) * 208 + (32 * ks + 8 * g) * 2);
#pragma unroll
        for (int tp = 0; tp < 4; ++tp)
#pragma unroll
            for (int ks = 0; ks < 3; ++ks) kf[tp][ks] = *(const LAS bf16x8*)(Bf + GL_KT + (16 * tp + qi) * 208 + (32 * ks + 8 * g) * 2);
#pragma unroll
        for (int kk = 0; kk < 3; ++kk) { const LAS unsigned char* qr = Bf + GL_QT + (16 * ct + qi) * 208 + (32 * kk + 4 * g) * 2;
            const s16x4 a0 = *(const LAS s16x4*)qr, a1 = *(const LAS s16x4*)(qr + 32); qp[kk] = __builtin_shufflevector(a0, a1, 0, 1, 2, 3, 4, 5, 6, 7); }
#pragma unroll
        for (int vi = 0; vi < 2; ++vi) { const int vt = vh ? 2 : vi;
#pragma unroll
            for (int kk = 0; kk < 2; ++kk) { const LAS unsigned char* vr = Bf + GL_VT + (16 * vt + qi) * 144 + (32 * kk + 4 * g) * 2;
                const s16x4 a0 = *(const LAS s16x4*)vr, a1 = *(const LAS s16x4*)(vr + 32); vf[vi][kk] = __builtin_shufflevector(a0, a1, 0, 1, 2, 3, 4, 5, 6, 7); }
#pragma unroll
            for (int kk = 0; kk < 3; ++kk) { const LAS unsigned char* sr = SBr + (vt * 6 + 2 * kk) * 512 + lane * 8;
                const s16x4 a0 = *(const LAS s16x4*)sr, a1 = *(const LAS s16x4*)(sr + 512); sf[vi][kk] = __builtin_shufflevector(a0, a1, 0, 1, 2, 3, 4, 5, 6, 7); } }
        __builtin_amdgcn_sched_barrier(0);
        f32x4 am[4];
#pragma unroll
        for (int tp = 0; tp < 4; ++tp) {
            f32x4 z = {0.f, 0.f, 0.f, 0.f};
#pragma unroll
            for (int ks = 0; ks < 3; ++ks) z = __builtin_amdgcn_mfma_f32_16x16x32_bf16(kf[tp][ks], qf[ks], z, 0, 0, 0);
            am[tp] = z;
        }
        asm volatile("s_waitcnt vmcnt(0)" ::: "memory");
        f32x4 dec[3]; bf16x8 kdf[3][2], vfr[3][2];
#pragma unroll
        for (int j = 0; j < 3; ++j) { const int T = oT[j], vt = T / 6, dt = T - 6 * vt;
            dec[j] = *(const LAS f32x4*)(Bf + GL_DEC + (16 * dt + 4 * g) * 4);
#pragma unroll
            for (int ks = 0; ks < 2; ++ks) {
                const LAS unsigned char* kr = Bf + GL_KT + (32 * ks + 8 * g + (qi >> 2)) * 208 + (16 * dt + 4 * (qi & 3)) * 2;
                const s16x4 a0 = __builtin_amdgcn_ds_read_tr16_b64_v4i16((LAS s16x4*)kr), a1 = __builtin_amdgcn_ds_read_tr16_b64_v4i16((LAS s16x4*)(kr + 4 * 208));
                kdf[j][ks] = __builtin_shufflevector(a0, a1, 0, 1, 2, 3, 4, 5, 6, 7);
                vfr[j][ks] = *(const LAS bf16x8*)(Bf + GL_VT + (16 * vt + qi) * 144 + (32 * ks + 8 * g) * 2); } }
        __builtin_amdgcn_sched_barrier(0);
        if (((n & 3) == 1) && (n < 57)) {
            const int id = F.gw + 2048 * (n >> 2), e = id / 3584, r2 = id - e * 3584, wh = r2 / 1792, it2 = r2 - wh * 1792, kb = it2 / 112, nb = it2 - kb * 112, n0 = nb * 32;
            unsigned char* dst = c8 + (size_t)e * 7168 * 1024 + (size_t)((n0 >> 7) * 256 + wh * 128 + (n0 & 127)) * 1024 + kb * 64;
            const int nq = lane & 7, kr = lane >> 3;
#pragma unroll
            for (int p = 0; p < 2; ++p) { const f32x4 gq = cg[p] * 32.0f;
                const f32x4 a = cv[4 * p], b2 = cv[4 * p + 1], c2 = cv[4 * p + 2], d2 = cv[4 * p + 3]; LAS unsigned* t = CT + (4 * nq) * 17 + 8 * p + kr;
                t[0] = pk4_fp8(a.x * gq[0], b2.x * gq[1], c2.x * gq[2], d2.x * gq[3]); t[17] = pk4_fp8(a.y * gq[0], b2.y * gq[1], c2.y * gq[2], d2.y * gq[3]);
                t[34] = pk4_fp8(a.z * gq[0], b2.z * gq[1], c2.z * gq[2], d2.z * gq[3]); t[51] = pk4_fp8(a.w * gq[0], b2.w * gq[1], c2.w * gq[2], d2.w * gq[3]); }
            LDS_WAIT(); asm volatile("" ::: "memory");
#pragma unroll
            for (int r = 0; r < 2; ++r) { const int nn2 = (lane >> 2) + 16 * r, c4 = lane & 3; const LAS unsigned* sp = CT + nn2 * 17 + 4 * c4;
                v4u o; o.x = sp[0]; o.y = sp[1]; o.z = sp[2]; o.w = sp[3];
                *(GAS v4u*)(dst + (size_t)nn2 * 1024 + 16 * c4) = o; }
        }
        { const int n2 = n + 2 < 64 ? n + 2 : 63; GL_DMA(n2, bo2); }
        const bool cld = ((n & 3) == 0) && (n < 56);
        if (cld) {
            const int id = F.gw + 2048 * (n >> 2), e = id / 3584, r2 = id - e * 3584, wh = r2 / 1792, it2 = r2 - wh * 1792, kb = it2 / 112, nb = it2 - kb * 112;
            const float* p = (wh ? cwu : cwg) + (size_t)e * 1024 * FFE + (size_t)(kb * 64 + 4 * (lane >> 3)) * FFE + nb * 32 + 4 * (lane & 7);
#pragma unroll
            for (int j = 0; j < 8; ++j) cv[j] = *(const f32x4*)(p + (size_t)(32 * (j >> 2) + (j & 3)) * FFE);
            cg[0] = *(const f32x4*)(cgain + kb * 64 + 4 * (lane >> 3)); cg[1] = *(const f32x4*)(cgain + kb * 64 + 32 + 4 * (lane >> 3));
        }
        __builtin_amdgcn_sched_barrier(0);
        bf16x8 pf[2];
#pragma unroll
        for (int kk = 0; kk < 2; ++kk) { v4u w; w.x = pk2(am[2 * kk][0], am[2 * kk][1]) & kmw[kk][0]; w.y = pk2(am[2 * kk][2], am[2 * kk][3]) & kmw[kk][1]; w.z = pk2(am[2 * kk + 1][0], am[2 * kk + 1][1]) & kmw[kk][2]; w.w = pk2(am[2 * kk + 1][2], am[2 * kk + 1][3]) & kmw[kk][3];
            pf[kk] = __builtin_bit_cast(bf16x8, w); }
        const int nn = dir ? 63 - n : n, tok = b * SEQ + nn * 64 + 16 * ct + qi;
        f32x4 oacc[2];
#pragma unroll
        for (int vi = 0; vi < 2; ++vi) {
            f32x4 acc = {0.f, 0.f, 0.f, 0.f};
#pragma unroll
            for (int kk = 0; kk < 3; ++kk) acc = __builtin_amdgcn_mfma_f32_16x16x32_bf16(sf[vi][kk], qp[kk], acc, 0, 0, 0);
#pragma unroll
            for (int kk = 0; kk < 2; ++kk) acc = __builtin_amdgcn_mfma_f32_16x16x32_bf16(vf[vi][kk], pf[kk], acc, 0, 0, 0);
            oacc[vi] = acc;
        }
#pragma unroll
        for (int j = 0; j < 3; ++j) {
            f32x4 sv = So[j];
#pragma unroll
            for (int ks = 0; ks < 2; ++ks) sv = __builtin_amdgcn_mfma_f32_16x16x32_bf16(kdf[j][ks], vfr[j][ks], sv, 0, 0, 0);
            sv[0] *= dec[j][0]; sv[1] *= dec[j][1]; sv[2] *= dec[j][2]; sv[3] *= dec[j][3];
            So[j] = sv;
        }
        { v2u w; w.x = pk2(oacc[0][0], oacc[0][1]); w.y = pk2(oacc[0][2], oacc[0][3]);
          *(v2u*)(O + (size_t)tok * 768 + h * 192 + vs * 48 + 16 * (vh ? 2 : 0) + 4 * g) = w; }
        if (vh == 0) { v2u w; w.x = pk2(oacc[1][0], oacc[1][1]); w.y = pk2(oacc[1][2], oacc[1][3]);
          *(v2u*)(O + (size_t)tok * 768 + h * 192 + vs * 48 + 16 + 4 * g) = w; }
#pragma unroll
        for (int j = 0; j < 3; ++j) if (oV[j]) { v2u w; w.x = pk2(So[j][0], So[j][1]); w.y = pk2(So[j][2], So[j][3]); *(LAS v2u*)(SBw + oT[j] * 512 + lane * 8) = w; }
        asm volatile("s_waitcnt lgkmcnt(0)\n\ts_barrier" ::: "memory");
        { const int t_ = bo; bo = (bo == 2 * GL_BUF) ? 0 : bo + GL_BUF; bo2 = t_; }
    }
    __syncthreads();
#undef GL_DMA
}

__device__ __forceinline__ void finalize_rstd(const Frame& F, const float* rss, float* rstd) {
    for (int row = F.bid * NTHR + TID(); row < NT; row += F.G * NTHR) rstd[row] = rstd_from(rss + (size_t)row * 16);
}
__device__ __forceinline__ void gla_combine(const Frame& F, const bf16* OF, const bf16* OB, const bf16* act1, const float* gnorm, bf16* mix) {
    const int lane = LANE(), h = lane >> 4, c0 = h * 192 + 12 * (lane & 15);
    float gn[12];
#pragma unroll
    for (int j = 0; j < 12; ++j) gn[j] = gnorm[12 * (lane & 15) + j];
    for (int token = F.gw; token < NT; token += 2 * F.NGW) {
        const int tb = token + F.NGW; const bool hb = tb < NT; const int t2 = hb ? tb : token;
        v2u fa[3], ba[3], ga[3], fb[3], bb[3], gb[3];
#pragma unroll
        for (int j = 0; j < 3; ++j) { fa[j] = *(const v2u*)(OF + (size_t)token * 768 + c0 + 4 * j); ba[j] = *(const v2u*)(OB + (size_t)token * 768 + c0 + 4 * j); ga[j] = *(const v2u*)(act1 + (size_t)token * A1_LD + 768 + c0 + 4 * j); }
#pragma unroll
        for (int j = 0; j < 3; ++j) { fb[j] = *(const v2u*)(OF + (size_t)t2 * 768 + c0 + 4 * j); bb[j] = *(const v2u*)(OB + (size_t)t2 * 768 + c0 + 4 * j); gb[j] = *(const v2u*)(act1 + (size_t)t2 * A1_LD + 768 + c0 + 4 * j); }
        float oa[12], ob[12], sa = 0.f, sb = 0.f;
#pragma unroll
        for (int j = 0; j < 3; ++j) {
            oa[4 * j] = bflo(fa[j].x) + bflo(ba[j].x); oa[4 * j + 1] = bfhi(fa[j].x) + bfhi(ba[j].x); oa[4 * j + 2] = bflo(fa[j].y) + bflo(ba[j].y); oa[4 * j + 3] = bfhi(fa[j].y) + bfhi(ba[j].y);
            ob[4 * j] = bflo(fb[j].x) + bflo(bb[j].x); ob[4 * j + 1] = bfhi(fb[j].x) + bfhi(bb[j].x); ob[4 * j + 2] = bflo(fb[j].y) + bflo(bb[j].y); ob[4 * j + 3] = bfhi(fb[j].y) + bfhi(bb[j].y); }
#pragma unroll
        for (int j = 0; j < 12; ++j) { sa += oa[j] * oa[j]; sb += ob[j] * ob[j]; }
#pragma unroll
        for (int o = 1; o < 16; o <<= 1) { sa += __shfl_xor(sa, o); sb += __shfl_xor(sb, o); }
        const float ra = __builtin_amdgcn_rsqf(sa * (1.0f / 192.0f) + EPS), rb = __builtin_amdgcn_rsqf(sb * (1.0f / 192.0f) + EPS);
#pragma unroll
        for (int j = 0; j < 3; ++j) {
            const float g0 = bflo(ga[j].x), g1 = bfhi(ga[j].x), g2 = bflo(ga[j].y), g3 = bfhi(ga[j].y);
            v2u w; w.x = pk2(oa[4 * j] * ra * gn[4 * j] * g0 * __builtin_amdgcn_rcpf(1.0f + __expf(-g0)), oa[4 * j + 1] * ra * gn[4 * j + 1] * g1 * __builtin_amdgcn_rcpf(1.0f + __expf(-g1)));
            w.y = pk2(oa[4 * j + 2] * ra * gn[4 * j + 2] * g2 * __builtin_amdgcn_rcpf(1.0f + __expf(-g2)), oa[4 * j + 3] * ra * gn[4 * j + 3] * g3 * __builtin_amdgcn_rcpf(1.0f + __expf(-g3)));
            *(v2u*)(mix + (size_t)token * DM + c0 + 4 * j) = w; }
        if (hb) {
#pragma unroll
            for (int j = 0; j < 3; ++j) {
                const float g0 = bflo(gb[j].x), g1 = bfhi(gb[j].x), g2 = bflo(gb[j].y), g3 = bfhi(gb[j].y);
                v2u w; w.x = pk2(ob[4 * j] * rb * gn[4 * j] * g0 * __builtin_amdgcn_rcpf(1.0f + __expf(-g0)), ob[4 * j + 1] * rb * gn[4 * j + 1] * g1 * __builtin_amdgcn_rcpf(1.0f + __expf(-g1)));
                w.y = pk2(ob[4 * j + 2] * rb * gn[4 * j + 2] * g2 * __builtin_amdgcn_rcpf(1.0f + __expf(-g2)), ob[4 * j + 3] * rb * gn[4 * j + 3] * g3 * __builtin_amdgcn_rcpf(1.0f + __expf(-g3)));
                *(v2u*)(mix + (size_t)tb * DM + c0 + 4 * j) = w; } }
    }
}
__device__ __forceinline__ void route_pick(const float (&acc)[8], int token, int* topi, float* topw, LAS int* lc) {
    int e0 = 0; float l0 = acc[0];
#pragma unroll
    for (int e = 1; e < 8; ++e) if (acc[e] > l0) { l0 = acc[e]; e0 = e; }
    int e1 = -1; float l1 = -INFINITY;
#pragma unroll
    for (int e = 0; e < 8; ++e) if (e != e0 && acc[e] > l1) { l1 = acc[e]; e1 = e; }
    if (e1 < 0) { e1 = (e0 + 1) & 7; l1 = l0; }
    const float w0 = 1.0f / (1.0f + __expf(l1 - l0));
    topi[token] = e0 | (e1 << 8); topw[2 * token] = w0; topw[2 * token + 1] = 1.0f - w0;
    atomicAdd((int*)&lc[e0], 1); atomicAdd((int*)&lc[8 + e1], 1);
}
__device__ __forceinline__ void route1(const Frame& F, const bf16* H, const float* gain, const float* wr, int* topi, float* topw, int* cnt, float* rstd) {
    LAS int* lc = (LAS int*)F.lds;
    if (TID() < 16) lc[TID()] = 0;
    __syncthreads();
    const int lane = LANE();
    float w[4][4][8];
#pragma unroll
    for (int j = 0; j < 4; ++j) { const f32x4 g = *(const f32x4*)(gain + 256 * j + 4 * lane);
#pragma unroll
        for (int i = 0; i < 4; ++i) { const float* p = wr + (size_t)(256 * j + 4 * lane + i) * 8; const f32x4 a = *(const f32x4*)p, b = *(const f32x4*)(p + 4); const float gi = g[i];
            w[j][i][0] = a.x * gi; w[j][i][1] = a.y * gi; w[j][i][2] = a.z * gi; w[j][i][3] = a.w * gi; w[j][i][4] = b.x * gi; w[j][i][5] = b.y * gi; w[j][i][6] = b.z * gi; w[j][i][7] = b.w * gi; } }
    for (int t2 = 0; t2 < 16; t2 += 2) {
        const int token = F.bid * 128 + F.wave * 16 + t2;
        const v2u* h0 = (const v2u*)(H + (size_t)token * DM) + lane; const v2u* h1 = h0 + DM / 4;
        f32x4 x0[4], x1[4];
#pragma unroll
        for (int j = 0; j < 4; ++j) { const v2u p = h0[64 * j], q = h1[64 * j]; x0[j] = (f32x4){bflo(p.x), bfhi(p.x), bflo(p.y), bfhi(p.y)}; x1[j] = (f32x4){bflo(q.x), bfhi(q.x), bflo(q.y), bfhi(q.y)}; }
        float a0[8], a1[8], s0 = 0.f, s1 = 0.f;
#pragma unroll
        for (int e = 0; e < 8; ++e) { a0[e] = 0.f; a1[e] = 0.f; }
#pragma unroll
        for (int j = 0; j < 4; ++j)
#pragma unroll
            for (int i = 0; i < 4; ++i) { const float u = x0[j][i], v = x1[j][i]; s0 += u * u; s1 += v * v;
#pragma unroll
                for (int e = 0; e < 8; ++e) { a0[e] += u * w[j][i][e]; a1[e] += v * w[j][i][e]; } }
        s0 = wave_sum(s0); s1 = wave_sum(s1);
        const float r0 = 1.0f / sqrtf(s0 * (1.0f / DM) + EPS), r1 = 1.0f / sqrtf(s1 * (1.0f / DM) + EPS);
#pragma unroll
        for (int e = 0; e < 8; ++e) { a0[e] = wave_sum(a0[e]) * r0; a1[e] = wave_sum(a1[e]) * r1; }
        if (lane == 0) { route_pick(a0, token, topi, topw, lc); route_pick(a1, token + 1, topi, topw, lc); rstd[token] = r0; rstd[token + 1] = r1; }
    }
    __syncthreads();
    if (TID() < 16) cnt[F.bid * 16 + TID()] = lc[TID()];
    __syncthreads();
}
__device__ __forceinline__ void route2(const Frame& F, const int* topi, const float* topw, const int* cnt, int* stok, float* sw, int* blk, int* s0tab) {
    LAS int* part = (LAS int*)F.lds;
    LAS int* base = part + 1024;
    LAS int* tk = base + 64;
    const int tid = TID(), pe = tid & 15, jg = tid >> 4;
    int below = 0, tot = 0;
    for (int w = jg; w < F.G; w += 32) { const int v = cnt[w * 16 + pe]; tot += v; if (w < F.bid) below += v; }
    part[jg * 16 + pe] = below; part[512 + jg * 16 + pe] = tot;
    if (tid < 128) tk[tid] = topi[F.bid * 128 + tid];
    __syncthreads();
    if (tid < 16) { int b = 0, t = 0; for (int j = 0; j < 32; ++j) { b += part[j * 16 + tid]; t += part[512 + j * 16 + tid]; } base[tid] = b; base[16 + tid] = t; }
    __syncthreads();
    if (tid < 2) { int ps = 0; for (int e = 0; e < 8; ++e) { base[32 + tid * 8 + e] = ps; ps += (base[16 + tid * 8 + e] + 255) / 256 * 256; } base[48 + tid] = ps / 256; }
    __syncthreads();
    if (tid < 256) {
        const int p = tid >> 7, i = tid & 127; const int e = (tk[i] >> (8 * p)) & 0xff;
        int rank = 0; for (int j = 0; j < i; ++j) rank += (((tk[j] >> (8 * p)) & 0xff) == e) ? 1 : 0;
        const int slot = base[32 + p * 8 + e] + base[p * 8 + e] + rank; const int token = F.bid * 128 + i;
        stok[p * SLOT_CAP + slot] = token; sw[p * SLOT_CAP + slot] = topw[2 * token + p]; if (p == 0) s0tab[token] = slot;
    }
    if (F.bid < 16) {
        const int p = F.bid >> 3, e = F.bid & 7, ps = base[32 + F.bid], t = base[16 + F.bid], pend = ps + (t + 255) / 256 * 256;
        for (int s = ps + t + tid; s < pend; s += NTHR) { stok[p * SLOT_CAP + s] = -1; sw[p * SLOT_CAP + s] = 0.f; }
        for (int bk = ps / 256 + tid; bk < pend / 256; bk += NTHR) blk[16 + p * 256 + bk] = e;
        if (e == 0 && tid == 0) blk[p] = base[48 + p];
    }
    __syncthreads();
}
__device__ __forceinline__ void final_norm_slots(int lane, const bf16* HB, float* OUT, const bf16* YA, const int* s0tab, const bf16* Y, const bf16* Y2, const float* gain, const int* tok, int s0, int s1, int first, int stride) {
    f32x4 gv[4];
#pragma unroll
    for (int j = 0; j < 4; ++j) gv[j] = ((const f32x4*)gain + lane)[64 * j];
    for (int base = s0 + first; base < s1; base += 64 * stride) {
      const int sll = base + lane * stride; int mytok = -1; if (sll < s1) mytok = tok[sll];
      const int mys0 = s0tab[mytok < 0 ? 0 : mytok];
      const int cnt = min(64, (s1 - base + stride - 1) / stride);
      for (int i = 0; i < cnt; i += 2) {
        const int sl = base + i * stride, slb = sl + stride; const bool hb = i + 1 < cnt; const int i1 = hb ? i + 1 : i;
        const int ra = __builtin_amdgcn_readlane(mytok, i), rb = hb ? __builtin_amdgcn_readlane(mytok, i1) : -1;
        const int rowa = ra < 0 ? 0 : ra, rowb = rb < 0 ? 0 : rb;
        const v2u* xa = (const v2u*)(HB + (size_t)rowa * DM) + lane; const v2u* xb = (const v2u*)(HB + (size_t)rowb * DM) + lane;
        const v2u* ya = (const v2u*)(Y + (size_t)sl * DM) + lane; const v2u* yb = (const v2u*)(Y + (size_t)(hb ? slb : sl) * DM) + lane;
        const v2u* pa = (const v2u*)(YA + (size_t)__builtin_amdgcn_readlane(mys0, i) * DM) + lane; const v2u* pb = (const v2u*)(YA + (size_t)__builtin_amdgcn_readlane(mys0, i1) * DM) + lane;
        f32x4 va[4], vb[4]; v2u wa[4], wb[4], ua[4], ub[4], ta[4], tb[4];
#pragma unroll
        for (int j = 0; j < 4; ++j) { ua[j] = xa[64 * j]; wa[j] = ya[64 * j]; ta[j] = pa[64 * j]; }
#pragma unroll
        for (int j = 0; j < 4; ++j) { ub[j] = xb[64 * j]; wb[j] = yb[64 * j]; tb[j] = pb[64 * j]; }
#pragma unroll
        for (int j = 0; j < 4; ++j) { va[j] = (f32x4){bflo(ua[j].x) + bflo(ta[j].x), bfhi(ua[j].x) + bfhi(ta[j].x), bflo(ua[j].y) + bflo(ta[j].y), bfhi(ua[j].y) + bfhi(ta[j].y)};
            vb[j] = (f32x4){bflo(ub[j].x) + bflo(tb[j].x), bfhi(ub[j].x) + bfhi(tb[j].x), bflo(ub[j].y) + bflo(tb[j].y), bfhi(ub[j].y) + bfhi(tb[j].y)}; }
        if (Y2) {
            const v2u* za = (const v2u*)(Y2 + (size_t)(sl - s0) * DM) + lane; const v2u* zb = (const v2u*)(Y2 + (size_t)((hb ? slb : sl) - s0) * DM) + lane;
#pragma unroll
            for (int j = 0; j < 4; ++j) { const v2u p = za[64 * j], q = zb[64 * j];
                va[j].x += bflo(p.x); va[j].y += bfhi(p.x); va[j].z += bflo(p.y); va[j].w += bfhi(p.y); vb[j].x += bflo(q.x); vb[j].y += bfhi(q.x); vb[j].z += bflo(q.y); vb[j].w += bfhi(q.y); }
        }
        float sa = 0.f, sb = 0.f;
#pragma unroll
        for (int j = 0; j < 4; ++j) {
            va[j].x += bflo(wa[j].x); va[j].y += bfhi(wa[j].x); va[j].z += bflo(wa[j].y); va[j].w += bfhi(wa[j].y);
            vb[j].x += bflo(wb[j].x); vb[j].y += bfhi(wb[j].x); vb[j].z += bflo(wb[j].y); vb[j].w += bfhi(wb[j].y);
            sa += (va[j].x * va[j].x + va[j].y * va[j].y) + (va[j].z * va[j].z + va[j].w * va[j].w); sb += (vb[j].x * vb[j].x + vb[j].y * vb[j].y) + (vb[j].z * vb[j].z + vb[j].w * vb[j].w); }
        sa = wave_sum(sa); sb = wave_sum(sb);
        const float rsa = 1.0f / sqrtf(sa * (1.0f / DM) + EPS), rsb = 1.0f / sqrtf(sb * (1.0f / DM) + EPS);
        if (ra >= 0) { GAS f32x4* oa = (GAS f32x4*)(OUT + (size_t)rowa * DM) + lane;
#pragma unroll
            for (int j = 0; j < 4; ++j) { const f32x4 g = gv[j]; oa[64 * j] = (f32x4){va[j].x * rsa * g.x, va[j].y * rsa * g.y, va[j].z * rsa * g.z, va[j].w * rsa * g.w}; } }
        if (rb >= 0) { GAS f32x4* ob = (GAS f32x4*)(OUT + (size_t)rowb * DM) + lane;
#pragma unroll
            for (int j = 0; j < 4; ++j) { const f32x4 g = gv[j]; ob[64 * j] = (f32x4){vb[j].x * rsb * g.x, vb[j].y * rsb * g.y, vb[j].z * rsb * g.z, vb[j].w * rsb * g.w}; } }
      }
    }
}
__device__ __forceinline__ void final_norm(const Frame& F, float* H, const float* gain) {
    for (int row = F.gw; row < NT; row += F.NGW) {
        GAS f32x4* xr = (GAS f32x4*)(H + (size_t)row * DM) + LANE(); const f32x4* gr = (const f32x4*)gain + LANE();
        f32x4 v[4]; float s = 0.f;
#pragma unroll
        for (int j = 0; j < 4; ++j) { v[j] = xr[64 * j]; s += (v[j].x * v[j].x + v[j].y * v[j].y) + (v[j].z * v[j].z + v[j].w * v[j].w); }
        s = wave_sum(s); const float rs = 1.0f / sqrtf(s * (1.0f / DM) + EPS);
#pragma unroll
        for (int j = 0; j < 4; ++j) { const f32x4 g = gr[64 * j]; f32x4 o = {v[j].x * rs * g.x, v[j].y * rs * g.y, v[j].z * rs * g.z, v[j].w * rs * g.w}; xr[64 * j] = o; }
    }
}

constexpr int N_PHASES = 17;
__global__ void __launch_bounds__(NTHR, 2) mega(Args args) {
    extern __shared__ __attribute__((aligned(16))) unsigned char lds_raw[];
    Frame F;
    F.lds = (LAS unsigned char*)lds_raw;
    F.wave = __builtin_amdgcn_readfirstlane((int)(threadIdx.x >> 6));
    F.G = gridDim.x; F.bid = blockIdx.x; F.gw = F.bid * NWAVES + F.wave; F.NGW = F.G * NWAVES; F.ws = args.ws;
    unsigned char* ws = args.ws;
    gu32* ctl = (gu32*)(ws + WS_CTL);
    volatile LAS unsigned* MISC = (volatile LAS unsigned*)(F.lds + MISC_OFF);
    for (int u = TID(); u < (LDS_BYTES - LDSCTL_OFF) / 4; u += NTHR) ((LAS unsigned*)(F.lds + LDSCTL_OFF))[u] = 0u;
    __syncthreads();
    XcdBarrier bar = xcd_barrier_post((unsigned*)(ctl + CW_BAR), MISC + 8, F.wave);
    const int lo = args.ph_lo, hi = args.ph_hi;
#ifndef PH_MASK
#define PH_MASK 0x1ffff
#endif
#define IN(k) (((PH_MASK >> (k)) & 1) && lo <= (k) && (k) < hi)
#ifndef REPEAT_MASK
#define REPEAT_MASK 0
#endif
#define REPS(k) (1 + ((REPEAT_MASK >> (k)) & 1))
#define SEAM(k) do { if (IN(k) && IN((k) + 1)) xcd_barrier(bar); } while (0)

    float* H = args.out;
    bf16* x3 = (bf16*)args.out;
    float* rss = (float*)(ws + WS_RSS); float* rstd = (float*)(ws + WS_RSTD);
    bf16* hbf = (bf16*)(ws + WS_HBF); bf16* membf = (bf16*)(ws + WS_MEMBF); bf16* memk = (bf16*)(ws + WS_MEMK); bf16* memvt = (bf16*)(ws + WS_MEMVT);
    bf16* act0 = (bf16*)(ws + WS_ACT0); bf16* v0t = (bf16*)(ws + WS_V0T); bf16* mix = (bf16*)(ws + WS_MIX); bf16* hmid0 = (bf16*)(ws + WS_HMID0);
    bf16* act1 = (bf16*)(ws + WS_ACT1); bf16* v1t = (bf16*)(ws + WS_V1T); bf16* OF = (bf16*)(ws + WS_OF); bf16* OB = (bf16*)(ws + WS_OB);
    bf16* hmid1 = (bf16*)(ws + WS_HMID1); bf16* wgu = (bf16*)((unsigned char*)args.out + OUT_WGU); bf16* wdn = (bf16*)(ws + WS_WDN);
    int* cnt = (int*)(ws + WS_CNT); int* topi = (int*)(ws + WS_TOPI); float* topw = (float*)(ws + WS_TOPW);
    int* stok = (int*)(ws + WS_STOK); float* sw = (float*)(ws + WS_SW); int* blk = (int*)(ws + WS_BLK);
    LAS float* scr = (LAS float*)(F.lds + F.wave * 16384);

    if (IN(0)) {
        int it = F.gw; LAS unsigned* T0 = (LAS unsigned*)scr; LAS unsigned* T1 = T0 + 1088;
#define CVT(Wp, Kd, Nd, WTp, gainp, kind) do { const CvtJob J{Wp, Kd, Nd, (bf16*)(WTp), gainp, kind}; const int n_ = ((Kd) / 64) * ((Nd) / 32); \
            while (it < n_) { CvtRegs A_, B_; B_.valid = 0; cvt_load(A_, J, it, LANE()); it += F.NGW; if (it < n_) { cvt_load(B_, J, it, LANE()); it += F.NGW; } cvt_finish(A_, T0, LANE()); cvt_finish(B_, T1, LANE()); } \
            it -= n_; } while (0)
        CVT(args.in[I_EWIN], 1024, 2560, ws + WS_W0IN, args.in[I_EN1], 1);
        CVT(args.in[I_EWIN], 1024, 2560, ws + WS_WV0, args.in[I_EN1], 2);
        CVT(args.in[I_EWOUT], 1024, 1024, ws + WS_W0OUT, nullptr, 0);
        CVT(args.in[I_EWG], 1024, 2816, ws + WS_W0GU, args.in[I_EN2], 3);
        CVT(args.in[I_EWU], 1024, 2816, ws + WS_W0GU, args.in[I_EN2], 4);
        CVT(args.in[I_EWD], 2816, 1024, ws + WS_W0DN, nullptr, 0);
        CVT(args.in[I_WMKV], 1024, 512, ws + WS_WMEM, args.in[I_MNORM], 0);
        CVT(args.in[I_OWIN], 1024, 2592, ws + WS_W1IN, args.in[I_ON1], 5);
        CVT(args.in[I_OWIN], 1024, 2592, ws + WS_WV1, args.in[I_ON1], 6);
        CVT(args.in[I_OWOUT], 1024, 1024, ws + WS_W1OUT, nullptr, 0);
#undef CVT
        { v4u z = {0u, 0u, 0u, 0u}; v4u* p = (v4u*)(ws + WS_W1IN + (size_t)1824 * 2048); const int n16 = 224 * 2048 / 16;
          for (int i = F.bid * NTHR + TID(); i < n16; i += F.G * NTHR) p[i] = z; }
        rows_to_bf16(args.in[I_X], hbf, rstd, F.gw, NT, F.NGW, LANE());
        rows_to_bf16(args.in[I_MEM], membf, rstd + NT, F.gw, MEM_ROWS, F.NGW, LANE());
    }
    SEAM(0);
    if (IN(1)) {
        { Sched S; S.init(hbf, ws + WS_W0IN, 1024, 128, 7, F.G, F.bid); EpiRowScale E{act0, A0_LD, rstd, 1.0f}; gemm_run<EpiRowScale, false>(F.lds, S, E, nullptr, F.wave); }
        { Sched S; S.init(ws + WS_WV0, hbf, 1024, 3, 128, F.G, (F.bid + 128) % F.G); EpiColScale E{v0t, NT, rstd}; gemm_run<EpiColScale, false>(F.lds, S, E, nullptr, F.wave); }
        for (int it = F.gw; it < 2048; it += F.NGW) memkv_item(it, LANE(), membf, (const bf16*)(ws + WS_WMEM), rstd + NT, memk, memvt);
    }
    SEAM(1);
    if (IN(2)) {
        { for (int i = 0; i < 1536 / 256; ++i) na_hstrip(F, (F.G == 256) ? (F.bid & 7) * 192 + i * 32 + (F.bid >> 3) : F.bid + i * F.G, act0, v0t, args.in[I_RPB], mix);
          for (int it = F.bid; it < 512; it += F.G) memattn_strip(F, it, act0, A0_LD, 1536, memk, memvt, mix);
          __syncthreads(); }
    }
    SEAM(2);
    if (IN(3)) {
        Sched S; S.init(mix, ws + WS_W0OUT, 1024, 128, 4, F.G, F.bid); EpiResid<true> E{args.in[I_X], hbf, rss, nullptr}; gemm_run<EpiResid<true>, false>(F.lds, S, E, nullptr, F.wave);
    }
    SEAM(3);
    if (IN(4)) {
        Sched S; S.init(hbf, ws + WS_W0GU, 1024, 128, 22, F.G, F.bid); EpiSwiGLU<false, true> E{hmid0, FF0, rss, nullptr}; gemm_run<EpiSwiGLU<false, true>, false>(F.lds, S, E, nullptr, F.wave);
    }
    SEAM(4);
    if (IN(5)) {
        Sched S; S.init(hmid0, ws + WS_W0DN, FF0, 128, 4, F.G, F.bid); EpiResid<false> E{nullptr, hbf, rss, nullptr}; gemm_run<EpiResid<false>, false>(F.lds, S, E, nullptr, F.wave);
    }
    SEAM(5);
    if (IN(6)) {
        { Sched S; S.init(hbf, ws + WS_W1IN, 1024, 128, 8, F.G, F.bid); EpiRowScaleT<true> E{act1, A1_LD, rss, 1.0f}; gemm_run<EpiRowScaleT<true>, false>(F.lds, S, E, nullptr, F.wave); }
        { Sched S; S.init(ws + WS_WV1, hbf, 1024, 3, 128, F.G, F.bid); EpiColScaleT<true> E{v1t, NT, rss}; gemm_run<EpiColScaleT<true>, false>(F.lds, S, E, nullptr, F.wave); }
    }
    SEAM(6);
    if (IN(7)) {
        bf16x8 gwf[3]; float gbi[3]; int gdir = -1;
        for (int it = F.bid; it < 1024; it += F.G) { const int dir = (it >> 6) & 1;
            if (dir != gdir) { gla_pre_w(F.wave, LANE(), dir ? args.in[I_WGKB] : args.in[I_WGKF], dir ? args.in[I_BGKB] : args.in[I_BGKF], gwf, gbi); gdir = dir; }
            gla_pre_item(F, it, act1, gwf, gbi, (bf16*)(ws + WS_GQT) + (size_t)dir * NT * 384, (bf16*)((unsigned char*)args.out + OUT_GKT) + (size_t)dir * NT * 384,
                         (float*)((unsigned char*)args.out + OUT_GDEC) + (size_t)dir * 8 * 4 * 64 * 96); }
        for (int it = F.bid; it < 512; it += F.G) memattn_strip(F, it, act1, A1_LD, 1536, memk, memvt, mix);
        xcd_barrier(bar);
        for (int it0 = F.bid; it0 < 256; it0 += F.G) { const int it = (F.G == 256) ? ((it0 & 7) * 8 + (it0 >> 5)) * 4 + ((it0 >> 3) & 3) : it0;
            gla_main_item(F, it, (const bf16*)(ws + WS_GQT), (const bf16*)((unsigned char*)args.out + OUT_GKT), (const float*)((unsigned char*)args.out + OUT_GDEC), v1t, OF, OB, args.in[I_OWG], args.in[I_OWU], args.in[I_ON2], (unsigned char*)wgu); }
    }
    SEAM(7);
    if (IN(8)) gla_combine(F, OF, OB, act1, args.in[I_GNORM], mix);
    SEAM(8);
    if (IN(9)) {
        Sched S; S.init(mix, ws + WS_W1OUT, 1024, 128, 4, F.G, F.bid); EpiResid<false> E{nullptr, hbf, rss, x3}; gemm_run<EpiResid<false>, false>(F.lds, S, E, nullptr, F.wave);
    }
    SEAM(9);
    if (IN(10)) {
        route1(F, hbf, args.in[I_ON2], args.in[I_WR], topi, topw, cnt, rstd);
    }
    SEAM(10);
    if (IN(11)) {
        route2(F, topi, topw, cnt, stok, sw, blk, (int*)(ws + WS_S0TAB));
        { LAS unsigned* T0 = (LAS unsigned*)scr; LAS unsigned* T1 = T0 + 1088;
#define MOE_JOB(J_, it_) const int e_##J_ = (it_) / 1792; \
            const CvtJob J_{args.in[I_OWD] + (size_t)e_##J_ * FFE * 1024, FFE, 1024, (bf16*)((unsigned char*)wdn + (size_t)e_##J_ * 1024 * FFE), nullptr, 0}
          for (int it = F.gw; it < 8 * 1792; it += 2 * F.NGW) {
            CvtRegs A_, B_; B_.valid = 0;
            { MOE_JOB(Ja, it); cvt_load8(A_, Ja, it % 1792, LANE()); }
            if (it + F.NGW < 8 * 1792) { MOE_JOB(Jb, it + F.NGW); cvt_load8(B_, Jb, (it + F.NGW) % 1792, LANE()); }
            cvt_finish8(A_, T0, LANE(), 32.0f); cvt_finish8(B_, T1, LANE(), 32.0f);
          }
#undef MOE_JOB
        }
    }
    SEAM(11);
    bf16* ht0 = (bf16*)((unsigned char*)hmid1 + (size_t)NT * FFE); bf16* ht1 = (bf16*)(ws + WS_HT1);
    constexpr int KG = 512, KD = FFE / 2; constexpr size_t ESG = (size_t)7168 * 1024, ESD = (size_t)1024 * FFE;
    if (IN(12)) {
        const int nb = blk[0]; Sched S; S.init(x3, wgu, KG, nb, 28, F.G, F.bid, blk + 16, ESG); EpiSwiGLU<true> E{hmid1, FFE, rstd, ht0}; gemm_run<EpiSwiGLU<true>, true, true>(F.lds, S, E, stok, F.wave);
    }
    SEAM(12);
    if (IN(13)) {
        const int nb = blk[0], nbm = nb < 128 ? nb : 128; Sched S; S.init(hmid1, wdn, KD, nbm, 4, F.G, F.bid, blk + 16, ESD); EpiRowScale E{(bf16*)(ws + WS_YA), DM, sw, 0.03125f}; gemm_run<EpiRowScale, false, true>(F.lds, S, E, nullptr, F.wave);
    }
    SEAM(13);
    if (IN(14)) {
        const int nb = blk[1], nb0 = blk[0], rfull = (nb * 28 / F.G > 3) ? nb * 28 / F.G - 3 : 0, per = F.G / 8;
        { Sched S; S.init(x3, wgu, KG, nb, 28, F.G, F.bid, blk + 16 + 256, ESG); S.range(0, rfull * per, per);
          EpiSwiGLU<true> E{hmid1, FFE, rstd, ht1}; gemm_run<EpiSwiGLU<true>, true, true>(F.lds, S, E, stok + SLOT_CAP, F.wave); }
        { Sched S; S.init(x3, wgu, KG, nb, 28, F.G, F.bid, blk + 16 + 256, ESG); S.range(rfull * per, 0x7fffffff, per - 4);
          EpiSwiGLU<true> E{hmid1, FFE, rstd, ht1}; gemm_run<EpiSwiGLU<true>, true, true>(F.lds, S, E, stok + SLOT_CAP, F.wave); }
        if (F.bid / 8 >= per - 4 && nb0 > 128) {
            Sched S; S.init(ht0, wdn, KD, nb0 - 128, 4, 32, (F.bid / 8 - (per - 4)) * 8 + F.bid % 8, blk + 16 + 128, ESD);
            EpiRowScale E{(bf16*)(ws + WS_YA) + (size_t)NT * DM, DM, sw + NT, 0.03125f}; gemm_run<EpiRowScale, false, true>(F.lds, S, E, nullptr, F.wave); }
    }
    SEAM(14);
    if (IN(15)) {
        const int nb = blk[1], nbm = nb < 128 ? nb : 128; Sched S; S.init(hmid1, wdn, KD, nbm, 4, F.G, F.bid, blk + 16 + 256, ESD); EpiRowScale E{(bf16*)(ws + WS_YB), DM, sw + SLOT_CAP, 0.03125f}; gemm_run<EpiRowScale, false, true>(F.lds, S, E, nullptr, F.wave);
    }
    SEAM(15);
    if (IN(16)) {
        const int nb = blk[1], per = F.G / 8, nmain = (nb < 128 ? nb : 128) * 256;
        bf16* yb = (bf16*)(ws + WS_YB); bf16* yb2 = yb + (size_t)SLOT_CAP * DM;
        if (F.bid / 8 >= per - 4) {
            if (nb > 128) {
                const int sl = F.bid / 8 - (per - 4), kh = sl >> 1;
                Sched S; S.init((const bf16*)ht1 + kh * (KD / 2), (const bf16*)wdn + kh * (KD / 2), KD / 2, nb - 128, 4, 16, (sl & 1) * 8 + F.bid % 8, blk + 16 + 256 + 128, ESD); S.ld = KD;
                EpiRowScale E{kh ? yb2 : yb + (size_t)NT * DM, DM, sw + SLOT_CAP + NT, 0.03125f}; gemm_run<EpiRowScale, false, true>(F.lds, S, E, nullptr, F.wave); }
        } else {
            const int wv = (int)(blockIdx.x * NWAVES) + F.wave;
            final_norm_slots(LANE(), hbf, H, (const bf16*)(ws + WS_YA), (const int*)(ws + WS_S0TAB), yb, nullptr, args.in[I_FNORM], stok + SLOT_CAP, 0, nmain, wv, (per - 4) * 8 * NWAVES);
        }
        xcd_barrier(bar);
        if (nb > 128) final_norm_slots(LANE(), hbf, H, (const bf16*)(ws + WS_YA), (const int*)(ws + WS_S0TAB), yb, yb2, args.in[I_FNORM], stok + SLOT_CAP, NT, nb * 256, (int)(blockIdx.x * NWAVES) + F.wave, F.NGW);
    }
#undef IN
#undef SEAM
}

extern "C" void kernel_launch(void* const* d_in, const int* in_sizes, int n_in, void* d_out, int out_size, void* d_ws, size_t ws_size, hipStream_t stream) {
    static int grid = 0;
    if (grid == 0) {
        if (n_in != 26 || out_size != NT * DM || ws_size < WS_END) { fprintf(stderr, "kernel_launch: unexpected problem (n_in %d out %d ws %zu need %zu)\n", n_in, out_size, ws_size, (size_t)WS_END); grid = -1; return; }
        int dev = 0, cus = 0, per_cu = 0;
        if (hipGetDevice(&dev) != hipSuccess || hipDeviceGetAttribute(&cus, hipDeviceAttributeMultiprocessorCount, dev) != hipSuccess) { grid = -1; return; }
        if (hipFuncSetAttribute((const void*)mega, hipFuncAttributeMaxDynamicSharedMemorySize, LDS_BYTES) != hipSuccess) { fprintf(stderr, "kernel_launch: hipFuncSetAttribute failed\n"); grid = -1; return; }
        if (hipOccupancyMaxActiveBlocksPerMultiprocessor(&per_cu, (const void*)mega, NTHR, LDS_BYTES) != hipSuccess || per_cu < 1) fprintf(stderr, "kernel_launch: occupancy query reports %d\n", per_cu);
        (void)hipGetLastError();
        if (cus < 256) { fprintf(stderr, "kernel_launch: this kernel is built for a 256-CU device (one resident workgroup per CU), found %d CUs; nothing launched\n", cus); grid = -1; return; }
        grid = 256;
    }
    if (grid < 0) return;
    if (hipMemsetAsync((char*)d_ws + WS_CTL, 0, CTL_ZERO_BYTES, stream) != hipSuccess) return;
    Args a{};
    for (int i = 0; i < 26; ++i) a.in[i] = (const float*)d_in[i];
    a.out = (float*)d_out; a.ws = (unsigned char*)d_ws;
    a.ph_lo = 0; a.ph_hi = N_PHASES;
    hipLaunchKernelGGL(mega, dim3(grid), dim3(NTHR), LDS_BYTES, stream, a);
}
```

```cpp
#include <hip/hip_runtime.h>
#include <cstdio>
#include <cstdint>


#define GAS __attribute__((address_space(1)))
#define LAS __attribute__((address_space(3)))
typedef unsigned short bf16;
typedef unsigned v4u __attribute__((ext_vector_type(4)));
typedef unsigned v2u __attribute__((ext_vector_type(2)));
typedef float f32x4 __attribute__((ext_vector_type(4)));
typedef short bf16x8 __attribute__((ext_vector_type(8)));
typedef GAS unsigned gu32;
#define RLX_AGENT __ATOMIC_RELAXED, __HIP_MEMORY_SCOPE_AGENT
#define LDS_WAIT() asm volatile("s_waitcnt lgkmcnt(0)" ::: "memory")
#define VM_WAIT() asm volatile("s_waitcnt vmcnt(0)" ::: "memory")

constexpr int NT = 32768, DM = 1024, SEQ = 4096, NB = 8;
constexpr int MEM_ROWS = 2048;
constexpr int A0_LD = 1792;
constexpr int A1_LD = 2048;
constexpr int FF0 = 2816, FFE = 3584, NEXP = 8;
constexpr int SLOT_CAP = 34816;
constexpr float EPS = 1e-6f;
constexpr int NWAVES = 8, NTHR = 512;

constexpr size_t MiB = 1u << 20;
constexpr size_t WS_CTL = 0, CTL_ZERO_BYTES = 1 * MiB;
constexpr size_t WS_RSS = 1 * MiB;
constexpr size_t WS_MRSS = 3 * MiB;
constexpr size_t WS_CNT = 3 * MiB + 256 * 1024;
constexpr size_t WS_TOPI = 3 * MiB + 512 * 1024;
constexpr size_t WS_TOPW = 3 * MiB + 768 * 1024;
constexpr size_t WS_STOK = 4 * MiB;
constexpr size_t WS_SW = 4 * MiB + 512 * 1024;
constexpr size_t WS_BLK = 5 * MiB;
constexpr size_t WS_RSTD = 5 * MiB + 64 * 1024;
constexpr size_t WS_S0TAB = 5 * MiB + 512 * 1024;
constexpr size_t WS_RPB2 = 5 * MiB + 768 * 1024;
constexpr size_t WS_W0IN = 6 * MiB;
constexpr size_t WS_WV0 = WS_W0IN + 1792 * 2048;
constexpr size_t WS_W0OUT = 11 * MiB;
constexpr size_t WS_W0GU = 13 * MiB;
constexpr size_t WS_W0DN = 24 * MiB;
constexpr size_t WS_WMEM = WS_W0DN + 1024 * 2816 * 2;
constexpr size_t WS_W1IN = 31 * MiB;
constexpr size_t WS_WV1 = 35 * MiB;
constexpr size_t WS_W1OUT = 37 * MiB - 512 * 1024;
constexpr size_t WS_HBF = 39 * MiB;
constexpr size_t WS_MEMBF = 103 * MiB;
constexpr size_t WS_MEMK = 107 * MiB;
constexpr size_t WS_MEMVT = 108 * MiB;
constexpr size_t WS_ACT = 109 * MiB;
constexpr size_t WS_ACT0 = WS_ACT;
constexpr size_t WS_V0T = WS_ACT + 112 * MiB;
constexpr size_t WS_MIX = WS_ACT + 176 * MiB;
constexpr size_t WS_HMID0 = WS_ACT;
constexpr size_t WS_ACT1 = WS_ACT;
constexpr size_t WS_V1T = WS_ACT + 128 * MiB;
constexpr size_t WS_OF = WS_ACT + 240 * MiB;
constexpr size_t WS_OB = WS_ACT + 288 * MiB;
constexpr size_t WS_GQT = WS_ACT + 336 * MiB;
constexpr size_t WS_GKDT0 = WS_ACT + 384 * MiB;
constexpr size_t WS_GKDT1 = 6 * MiB;
constexpr size_t OUT_GKT = 0, OUT_GDEC = 48 * MiB, OUT_WGU = 52 * MiB;
constexpr size_t WS_E = WS_ACT + 336 * MiB;
constexpr size_t WS_HT1 = 6 * MiB;
constexpr size_t WS_YB = WS_ACT + 240 * MiB;
constexpr size_t WS_YA = WS_ACT + 128 * MiB;
constexpr size_t WS_HMID1 = WS_ACT;
constexpr size_t WS_WGU = WS_ACT + 240 * MiB;
constexpr size_t WS_WDN = WS_ACT + 352 * MiB;
constexpr size_t WS_END = WS_ACT + 408 * MiB;
static_assert(WS_W1OUT + 2 * MiB <= WS_HBF && WS_WV1 + 768 * 2048 <= WS_W1OUT && WS_W1IN + 4 * MiB <= WS_WV1 && WS_WMEM + MiB <= WS_W1IN, "weight map");
static_assert(WS_W0GU + 11 * MiB <= WS_W0DN && WS_WV0 + 768 * 2048 <= WS_W0OUT, "weight map 2");
static_assert((size_t)SLOT_CAP * 3584 * 2 <= 240 * MiB, "hmid1");

constexpr int CW_TMO = 0, CW_CODE = 1, CW_BAR = 4096;

constexpr int RING_BYTES = 131072;
constexpr int LDSCTL_OFF = 155648, MISC_OFF = LDSCTL_OFF + 320;
constexpr int LDS_BYTES = 156672;

typedef float f32x2_t __attribute__((ext_vector_type(2)));
typedef __bf16 bf16x2_t __attribute__((ext_vector_type(2)));
__device__ __forceinline__ unsigned pk2(float lo, float hi) { const f32x2_t v = {lo, hi}; const bf16x2_t b = __builtin_convertvector(v, bf16x2_t); return __builtin_bit_cast(unsigned, b); }
__device__ __forceinline__ unsigned f2bf(float f) { return pk2(f, 0.f) & 0xffffu; }
__device__ __forceinline__ float bf2f(bf16 b) { return __builtin_bit_cast(float, (unsigned)b << 16); }
__device__ __forceinline__ float bflo(unsigned u) { return __builtin_bit_cast(float, u << 16); }
__device__ __forceinline__ float bfhi(unsigned u) { return __builtin_bit_cast(float, u & 0xffff0000u); }
__device__ __forceinline__ float wave_sum(float v) {
#pragma unroll
    for (int o = 1; o < 64; o <<= 1) v += __shfl_xor(v, o);
    return v;
}
__device__ __forceinline__ float wave_max(float v) {
#pragma unroll
    for (int o = 1; o < 64; o <<= 1) v = fmaxf(v, __shfl_xor(v, o));
    return v;
}

__device__ __forceinline__ int lane_id() { unsigned z = 0u; asm volatile("" : "+v"(z)); return (int)__builtin_amdgcn_mbcnt_hi(0xffffffffu, __builtin_amdgcn_mbcnt_lo(0xffffffffu, z)); }
#define XB_TMO      128
#define XB_XCNT(j)  (256  + 64 * (j))
#define XB_XSUB(j)  (1280 + 64 * (j))
#define XB_XGEN(j)  (2304 + 64 * (j))
#define XB_TOP      3328
#define XB_TOPGEN   3392
#define XCD_BAR_WORDS 3456
#define XB_SPIN_CAP (1u << 22)

__device__ __forceinline__ unsigned xb_ld(unsigned* p)              { return __hip_atomic_load(p, __ATOMIC_RELAXED, __HIP_MEMORY_SCOPE_AGENT); }
__device__ __forceinline__ unsigned xb_add(unsigned* p, unsigned v) { return __hip_atomic_fetch_add(p, v, __ATOMIC_RELAXED, __HIP_MEMORY_SCOPE_AGENT); }
__device__ __forceinline__ unsigned xb_xcc_id() { return (unsigned)__builtin_amdgcn_s_getreg((3 << 11) | 20) & 0xFu; }
#define XB_SPIN(cond, bar) do { unsigned _sp = 0; while (cond) { __builtin_amdgcn_s_sleep(1); \
    if ((++_sp & 255u) == 0u) { if (xb_ld(&(bar)[XB_TMO])) break; if (_sp > XB_SPIN_CAP) { atomicAdd(&(bar)[XB_TMO], 1u); break; } } } } while (0)

struct XcdBarrier { unsigned* bar; unsigned x; volatile LAS unsigned* st; int w0; };

__device__ __forceinline__ XcdBarrier xcd_barrier_post(unsigned* bar, volatile LAS unsigned* st, int wave) {
    XcdBarrier b; b.bar = bar; b.x = xb_xcc_id(); b.st = st; b.w0 = (wave == 0) ? 1 : 0;
    if (b.w0 && lane_id() == 0) (void)xb_add(&bar[XB_XCNT(b.x)], 1u);
    return b;
}
__device__ __forceinline__ void xcd_barrier_complete(unsigned* bar, unsigned x, unsigned& nloc, unsigned& nx) {
    const unsigned G = gridDim.x * gridDim.y * gridDim.z;
    unsigned sum, cnt, mine, sp = 0u;
    for (;;) {
        sum = 0u; cnt = 0u; mine = 0u;
#pragma unroll
        for (unsigned j = 0; j < 16; ++j) { const unsigned c = xb_ld(&bar[XB_XCNT(j)]); sum += c; cnt += (c > 0u) ? 1u : 0u; mine = (j == x) ? c : mine; }
        if (sum == G) break;
        __builtin_amdgcn_s_sleep(1);
        if ((++sp & 255u) == 0u) { if (xb_ld(&bar[XB_TMO])) break; if (sp > XB_SPIN_CAP) { atomicAdd(&bar[XB_TMO], 1u); break; } }
    }
    nloc = mine > 0u ? mine : 1u; nx = cnt > 0u ? cnt : 1u;
}
__device__ __forceinline__ void xcd_barrier(const XcdBarrier& b) {
    asm volatile("s_waitcnt vmcnt(0)" ::: "memory");
    __syncthreads();
    if (b.w0 && lane_id() == 0) {
        unsigned* bar = b.bar;
        __builtin_amdgcn_s_waitcnt(0);
        unsigned nloc = b.st[0], nx = b.st[1];
        if (nloc == 0u) { xcd_barrier_complete(bar, b.x, nloc, nx); b.st[0] = nloc; b.st[1] = nx; }
        const unsigned old = xb_add(&bar[XB_XSUB(b.x)], 1u);
        const unsigned gen = old / nloc;
        if (old + 1u == (gen + 1u) * nloc) {
            __builtin_amdgcn_fence(__ATOMIC_RELEASE, "agent");
            asm volatile("s_waitcnt vmcnt(0)" ::: "memory");
            const unsigned og = xb_add(&bar[XB_TOP], 1u);
            const unsigned tg = og / nx;
            if (og + 1u == (tg + 1u) * nx) xb_add(&bar[XB_TOPGEN], 1u);
            else XB_SPIN(xb_ld(&bar[XB_TOPGEN]) == tg, bar);
            __builtin_amdgcn_fence(__ATOMIC_ACQUIRE, "agent");
            xb_add(&bar[XB_XGEN(b.x)], 1u);
            asm volatile("s_waitcnt vmcnt(0)" ::: "memory");
        } else {
            XB_SPIN(xb_ld(&bar[XB_XGEN(b.x)]) == gen, bar);
            __builtin_amdgcn_fence(__ATOMIC_ACQUIRE, "agent");
            asm volatile("s_waitcnt vmcnt(0)" ::: "memory");
        }
    }
    __syncthreads();
}

struct Args { const float* in[26]; float* out; unsigned char* ws; int ph_lo, ph_hi; };
enum { I_X = 0, I_MEM, I_EN1, I_EWIN, I_RPB, I_EWOUT, I_EN2, I_EWG, I_EWU, I_EWD, I_ON1, I_OWIN, I_WGKF, I_BGKF, I_WGKB, I_BGKB, I_GNORM, I_OWOUT, I_ON2, I_WR, I_OWG, I_OWU, I_OWD, I_MNORM, I_WMKV, I_FNORM };

#define LANE() lane_id()
#define TID() ((F.wave << 6) | lane_id())
struct Frame {
    LAS unsigned char* lds;
    int wave, G, bid;
    int gw, NGW;
    unsigned char* ws;
};

constexpr float QSCALE = 0.125f * 1.4426950408889634f;
struct CvtJob { const float* W; int K, N; bf16* WT; const float* gain; int kind; };
__device__ __forceinline__ bool cvt_map(int kind, int n0, int& drow, float& scale) {
    scale = 1.0f;
    switch (kind) {
    case 0: drow = n0; return true;
    case 1: if (n0 < 768) { drow = n0; scale = QSCALE; return true; } if (n0 < 1536) { drow = n0; return true; } if (n0 >= 2304) { drow = n0 - 768; scale = QSCALE; return true; } return false;
    case 2: if (n0 >= 1536 && n0 < 2304) { drow = n0 - 1536; return true; } return false;
    case 3: drow = (n0 >> 7) * 256 + (n0 & 127); return true;
    case 4: drow = (n0 >> 7) * 256 + 128 + (n0 & 127); return true;
    case 5: if (n0 < 768) { drow = n0; return true; } if (n0 < 1536) return false; if (n0 < 2304) { drow = n0 - 768; return true; }
            if (n0 < 2336) { drow = n0 - 512; return true; } drow = n0 - 800; scale = QSCALE; return true;
    case 6: if (n0 >= 768 && n0 < 1536) { drow = n0 - 768; return true; } return false;
    default: drow = n0; return true;
    }
}
__device__ __forceinline__ unsigned pk4_fp8(float a, float b, float c, float d) { a = __builtin_amdgcn_fmed3f(a, -448.f, 448.f); b = __builtin_amdgcn_fmed3f(b, -448.f, 448.f); c = __builtin_amdgcn_fmed3f(c, -448.f, 448.f); d = __builtin_amdgcn_fmed3f(d, -448.f, 448.f);
    unsigned w = 0u; w = (unsigned)__builtin_amdgcn_cvt_pk_fp8_f32(a, b, (int)w, false); w = (unsigned)__builtin_amdgcn_cvt_pk_fp8_f32(c, d, (int)w, true); return w; }
struct CvtRegs { f32x4 v[8]; const float* gain; bf16* WT; int K, k0, drow, valid; float scale; };
__device__ __forceinline__ void cvt_load(CvtRegs& R, const CvtJob& J, int item, int lane) {
    const int nblk = J.N / 32, kb = item / nblk, nb = item % nblk, n0 = nb * 32;
    R.k0 = kb * 64; R.gain = J.gain; R.WT = J.WT; R.K = J.K;
    R.valid = cvt_map(J.kind, n0, R.drow, R.scale) ? 1 : 0;
    if (R.valid) { const float* p = J.W + (size_t)(R.k0 + 2 * (lane >> 3)) * J.N + n0 + 4 * (lane & 7);
#pragma unroll
        for (int j = 0; j < 8; ++j) R.v[j] = *(const f32x4*)(p + (size_t)(16 * (j >> 1) + (j & 1)) * J.N); }
}
__device__ __forceinline__ void cvt_load8(CvtRegs& R, const CvtJob& J, int item, int lane) {
    const int nblk = J.N / 32, kb = item / nblk, nb = item % nblk, n0 = nb * 32;
    R.k0 = kb * 64; R.gain = J.gain; R.WT = J.WT; R.K = J.K;
    R.valid = cvt_map(J.kind, n0, R.drow, R.scale) ? 1 : 0;
    if (R.valid) { const float* p = J.W + (size_t)(R.k0 + 4 * (lane >> 3)) * J.N + n0 + 4 * (lane & 7);
#pragma unroll
        for (int j = 0; j < 8; ++j) R.v[j] = *(const f32x4*)(p + (size_t)(32 * (j >> 2) + (j & 3)) * J.N); }
}
__device__ __forceinline__ void cvt_finish8(const CvtRegs& R, LAS unsigned* T, int lane, float mul) {
    if (!R.valid) return;
    const int nq = lane & 7, kr = lane >> 3;
#pragma unroll
    for (int p = 0; p < 2; ++p) { const int k = R.k0 + 32 * p + 4 * kr; float g[4];
#pragma unroll
        for (int q = 0; q < 4; ++q) g[q] = R.scale * mul * (R.gain ? R.gain[k + q] : 1.0f);
        const f32x4 a = R.v[4 * p], b = R.v[4 * p + 1], c = R.v[4 * p + 2], d = R.v[4 * p + 3]; LAS unsigned* t = T + (4 * nq) * 17 + 8 * p + kr;
        t[0] = pk4_fp8(a.x * g[0], b.x * g[1], c.x * g[2], d.x * g[3]); t[17] = pk4_fp8(a.y * g[0], b.y * g[1], c.y * g[2], d.y * g[3]);
        t[34] = pk4_fp8(a.z * g[0], b.z * g[1], c.z * g[2], d.z * g[3]); t[51] = pk4_fp8(a.w * g[0], b.w * g[1], c.w * g[2], d.w * g[3]); }
    LDS_WAIT(); asm volatile("" ::: "memory");
#pragma unroll
    for (int r = 0; r < 2; ++r) { const int n = (lane >> 2) + 16 * r, c = lane & 3; const LAS unsigned* sp = T + n * 17 + 4 * c;
        v4u o; o.x = sp[0]; o.y = sp[1]; o.z = sp[2]; o.w = sp[3];
        *(GAS v4u*)((unsigned char*)R.WT + (size_t)(R.drow + n) * R.K + R.k0 + 16 * c) = o; }
    LDS_WAIT(); asm volatile("" ::: "memory");
}
__device__ __forceinline__ void cvt_finish(const CvtRegs& R, LAS unsigned* T, int lane) {
    if (!R.valid) return;
    const int nq = lane & 7, kr = lane >> 3;
#pragma unroll
    for (int p = 0; p < 4; ++p) { const int k = R.k0 + 16 * p + 2 * kr; float g0 = R.scale, g1 = R.scale; if (R.gain) { g0 *= R.gain[k]; g1 *= R.gain[k + 1]; }
        const f32x4 a = R.v[2 * p], b = R.v[2 * p + 1]; LAS unsigned* t = T + (4 * nq) * 33 + 8 * p + kr;
        t[0] = pk2(a.x * g0, b.x * g1); t[33] = pk2(a.y * g0, b.y * g1); t[66] = pk2(a.z * g0, b.z * g1); t[99] = pk2(a.w * g0, b.w * g1); }
    LDS_WAIT(); asm volatile("" ::: "memory");
#pragma unroll
    for (int r = 0; r < 4; ++r) { const int n = (lane >> 3) + 8 * r, c = lane & 7; const LAS unsigned* sp = T + n * 33 + 4 * c;
        v4u o; o.x = sp[0]; o.y = sp[1]; o.z = sp[2]; o.w = sp[3];
        *(GAS v4u*)(R.WT + (size_t)(R.drow + n) * R.K + R.k0 + 8 * c) = o; }
    LDS_WAIT(); asm volatile("" ::: "memory");
}
__device__ __forceinline__ void rows_to_bf16(const float* X, bf16* Ob, float* rstd, int first, int nrows, int stride, int lane) {
    for (int m = first; m < nrows; m += 2 * stride) {
        const int m2 = m + stride; const bool h2 = m2 < nrows;
        const GAS f32x4* xa = (const GAS f32x4*)(X + (size_t)m * DM) + lane; const GAS f32x4* xb = (const GAS f32x4*)(X + (size_t)(h2 ? m2 : m) * DM) + lane;
        f32x4 va[4], vb[4];
#pragma unroll
        for (int j = 0; j < 4; ++j) va[j] = xa[64 * j];
#pragma unroll
        for (int j = 0; j < 4; ++j) vb[j] = xb[64 * j];
        float sa = 0.f, sb = 0.f;
#pragma unroll
        for (int j = 0; j < 4; ++j) { sa += (va[j].x * va[j].x + va[j].y * va[j].y) + (va[j].z * va[j].z + va[j].w * va[j].w); sb += (vb[j].x * vb[j].x + vb[j].y * vb[j].y) + (vb[j].z * vb[j].z + vb[j].w * vb[j].w); }
        sa = wave_sum(sa); sb = wave_sum(sb);
        GAS unsigned long long* oa = (GAS unsigned long long*)(Ob + (size_t)m * DM) + lane;
#pragma unroll
        for (int j = 0; j < 4; ++j) oa[64 * j] = (unsigned long long)pk2(va[j].x, va[j].y) | ((unsigned long long)pk2(va[j].z, va[j].w) << 32);
        if (lane == 0) rstd[m] = __builtin_amdgcn_rsqf(sa * (1.0f / DM) + EPS);
        if (h2) { GAS unsigned long long* ob = (GAS unsigned long long*)(Ob + (size_t)m2 * DM) + lane;
#pragma unroll
            for (int j = 0; j < 4; ++j) ob[64 * j] = (unsigned long long)pk2(vb[j].x, vb[j].y) | ((unsigned long long)pk2(vb[j].z, vb[j].w) << 32);
            if (lane == 0) rstd[m2] = __builtin_amdgcn_rsqf(sb * (1.0f / DM) + EPS); }
    }
}

struct Unit { int pm, pn; };
struct Sched {
    int nM, nN, nwg, G, c, K, ld, off0, off1, per;
    const char* A; const char* B; const int* bexp; size_t estride;
    __device__ void init(const void* A_, const void* B_, int K_, int nM_, int nN_, int G_, int c_, const int* bexp_ = nullptr, size_t estride_ = 0) {
        A = (const char*)A_; B = (const char*)B_; K = K_; ld = K_; nM = nM_; nN = nN_; nwg = nM * nN; G = G_; c = c_; bexp = bexp_; estride = estride_; off0 = 0; off1 = 0x7fffffff; per = G_ / 8; }
    __device__ void range(int off0_, int off1_, int per_) { off0 = off0_; off1 = off1_; per = per_; }
    __device__ bool next(int i, Unit& u) const {
        const int q = nwg / 8, r = nwg % 8, xcd = c % 8, slot = c / 8, lt = (int)((unsigned)(xcd - r) >> 31), qx = q + lt;
        if (slot >= per) return false;
        const int off = off0 + i * per + slot, lim = off1 < qx ? off1 : qx;
        if (off >= lim) return false;
        const int wgid = xcd * q + (lt ? xcd : r) + off;
        const int nig = 8 * nN, gid = wgid / nig, fm = gid * 8, gsz = (nM - fm) < 8 ? (nM - fm) : 8;
        u.pm = fm + ((wgid % nig) % gsz); u.pn = (wgid % nig) / gsz; return true;
    }
    __device__ const char* a_base(const Unit& u) const { return A + (size_t)u.pm * 512 * ld; }
    __device__ const char* b_base(const Unit& u) const { return B + (bexp ? (size_t)bexp[u.pm] * estride : (size_t)0) + (size_t)u.pn * 512 * ld; }
};

struct NoAux {};
__device__ __forceinline__ float rstd_from(const float* rss16) {
    const f32x4* p = (const f32x4*)rss16; f32x4 a = p[0], b = p[1], c = p[2], d = p[3];
    const float s = ((a.x + a.y) + (a.z + a.w)) + ((b.x + b.y) + (b.z + b.w)) + ((c.x + c.y) + (c.z + c.w)) + ((d.x + d.y) + (d.z + d.w));
    return __builtin_amdgcn_rsqf(s * (1.0f / DM) + EPS);
}
__device__ __forceinline__ float rstd_from_lds(const LAS float* rss16) {
    const LAS f32x4* p = (const LAS f32x4*)rss16; f32x4 a = p[0], b = p[1], c = p[2], d = p[3];
    const float s = ((a.x + a.y) + (a.z + a.w)) + ((b.x + b.y) + (b.z + b.w)) + ((c.x + c.y) + (c.z + c.w)) + ((d.x + d.y) + (d.z + d.w));
    return __builtin_amdgcn_rsqf(s * (1.0f / DM) + EPS);
}
constexpr int RSS_LDS_REL = 2048;
struct RowCtx { float rs[2][4]; };
template <bool RSS = false> struct EpiRowScaleT {
    static constexpr bool NEED_SS = false; static constexpr int SC_MODE = RSS ? 5 : 1; typedef RowCtx Ctx; typedef NoAux Aux;
    bf16* O; int ldc; const float* sc_src; float mul;
    __device__ __forceinline__ void begin(Ctx& c, const LAS float* sc, const LAS int*, int lr0, int, int, int) const {
#pragma unroll
        for (int ai = 0; ai < 2; ++ai)
#pragma unroll
            for (int m = 0; m < 4; ++m) c.rs[ai][m] = sc[ai * 128 + lr0 + m * 16] * mul;
    }
    __device__ __forceinline__ void load_aux(Aux&, const Ctx&, int, int, int, int, int) const {}
    __device__ __forceinline__ float apply(const Ctx& c, const Aux&, int ai, int m, int row, int pn, int c128, const float (&a)[8], const float (&b)[8]) const {
        const float s = c.rs[ai][m];
        bf16* p = O + (size_t)row * ldc + pn * 256 + c128;
        v4u w; w.x = pk2(a[0] * s, a[1] * s); w.y = pk2(a[2] * s, a[3] * s); w.z = pk2(a[4] * s, a[5] * s); w.w = pk2(a[6] * s, a[7] * s); *(v4u*)p = w;
        w.x = pk2(b[0] * s, b[1] * s); w.y = pk2(b[2] * s, b[3] * s); w.z = pk2(b[4] * s, b[5] * s); w.w = pk2(b[6] * s, b[7] * s); *(v4u*)(p + 128) = w;
        return 0.f;
    }
    __device__ __forceinline__ void row_done(int, int, int, float) const {}
};
typedef EpiRowScaleT<false> EpiRowScale;
struct ColCtx { float sa[8], sb[8]; };
template <bool RSS = false> struct EpiColScaleT {
    static constexpr bool NEED_SS = false; static constexpr int SC_MODE = RSS ? 6 : 2; typedef ColCtx Ctx; typedef NoAux Aux;
    bf16* O; int ldc; const float* sc_src;
    __device__ __forceinline__ void begin(Ctx& c, const LAS float* sc, const LAS int*, int, int, int, int c128) const {
#pragma unroll
        for (int j = 0; j < 8; ++j) { c.sa[j] = sc[c128 + j]; c.sb[j] = sc[128 + c128 + j]; }
    }
    __device__ __forceinline__ void load_aux(Aux&, const Ctx&, int, int, int, int, int) const {}
    __device__ __forceinline__ float apply(const Ctx& c, const Aux&, int, int, int row, int pn, int c128, const float (&a)[8], const float (&b)[8]) const {
        bf16* p = O + (size_t)row * ldc + pn * 256 + c128;
        v4u w; w.x = pk2(a[0] * c.sa[0], a[1] * c.sa[1]); w.y = pk2(a[2] * c.sa[2], a[3] * c.sa[3]); w.z = pk2(a[4] * c.sa[4], a[5] * c.sa[5]); w.w = pk2(a[6] * c.sa[6], a[7] * c.sa[7]); *(v4u*)p = w;
        w.x = pk2(b[0] * c.sb[0], b[1] * c.sb[1]); w.y = pk2(b[2] * c.sb[2], b[3] * c.sb[3]); w.z = pk2(b[4] * c.sb[4], b[5] * c.sb[5]); w.w = pk2(b[6] * c.sb[6], b[7] * c.sb[7]); *(v4u*)(p + 128) = w;
        return 0.f;
    }
    __device__ __forceinline__ void row_done(int, int, int, float) const {}
};
typedef EpiColScaleT<false> EpiColScale;
struct Aux4 { f32x4 v[4]; };
struct NoCtx {};
struct AuxR { f32x4 v[4]; };
struct AuxB { v4u a, b; };
__device__ __forceinline__ void unpack16(const AuxB& x, f32x4 (&v)[4]) {
    v[0] = (f32x4){bflo(x.a.x), bfhi(x.a.x), bflo(x.a.y), bfhi(x.a.y)}; v[1] = (f32x4){bflo(x.a.z), bfhi(x.a.z), bflo(x.a.w), bfhi(x.a.w)};
    v[2] = (f32x4){bflo(x.b.x), bfhi(x.b.x), bflo(x.b.y), bfhi(x.b.y)}; v[3] = (f32x4){bflo(x.b.z), bfhi(x.b.z), bflo(x.b.w), bfhi(x.b.w)}; }
template <bool F32> struct AuxSel { typedef AuxR T; };
template <> struct AuxSel<false> { typedef AuxB T; };
template <bool RF32> struct EpiResid {
    static constexpr bool NEED_SS = true; static constexpr int SC_MODE = 0; typedef NoCtx Ctx; typedef typename AuxSel<RF32>::T Aux;
    const float* R; bf16* HB; float* rss; bf16* HB2;
    __device__ __forceinline__ void begin(Ctx&, const LAS float*, const LAS int*, int, int, int, int) const {}
    __device__ __forceinline__ void load_aux(Aux& x, const Ctx&, int, int, int row, int pn, int c128) const {
        const size_t off = (size_t)row * DM + pn * 256 + c128;
        if constexpr (RF32) { const float* p = R + off; x.v[0] = *(const f32x4*)p; x.v[1] = *(const f32x4*)(p + 4); x.v[2] = *(const f32x4*)(p + 128); x.v[3] = *(const f32x4*)(p + 132); }
        else { x.a = *(const v4u*)(HB + off); x.b = *(const v4u*)(HB + off + 128); }
    }
    __device__ __forceinline__ float apply(const Ctx&, const Aux& xr, int, int, int row, int pn, int c128, const float (&a)[8], const float (&b)[8]) const {
        const size_t off = (size_t)row * DM + pn * 256 + c128;
        struct { f32x4 v[4]; } x; if constexpr (RF32) { x.v[0] = xr.v[0]; x.v[1] = xr.v[1]; x.v[2] = xr.v[2]; x.v[3] = xr.v[3]; } else unpack16(xr, x.v);
        const f32x4 h0 = {x.v[0].x + a[0], x.v[0].y + a[1], x.v[0].z + a[2], x.v[0].w + a[3]}, h1 = {x.v[1].x + a[4], x.v[1].y + a[5], x.v[1].z + a[6], x.v[1].w + a[7]};
        const f32x4 h2 = {x.v[2].x + b[0], x.v[2].y + b[1], x.v[2].z + b[2], x.v[2].w + b[3]}, h3 = {x.v[3].x + b[4], x.v[3].y + b[5], x.v[3].z + b[6], x.v[3].w + b[7]};
        v4u w; w.x = pk2(h0.x, h0.y); w.y = pk2(h0.z, h0.w); w.z = pk2(h1.x, h1.y); w.w = pk2(h1.z, h1.w); *(v4u*)(HB + off) = w; if (HB2) { v2u f; f.x = pk4_fp8(h0.x, h0.y, h0.z, h0.w); f.y = pk4_fp8(h1.x, h1.y, h1.z, h1.w); *(v2u*)((unsigned char*)HB2 + off) = f; }
        w.x = pk2(h2.x, h2.y); w.y = pk2(h2.z, h2.w); w.z = pk2(h3.x, h3.y); w.w = pk2(h3.z, h3.w); *(v4u*)(HB + off + 128) = w; if (HB2) { v2u f; f.x = pk4_fp8(h2.x, h2.y, h2.z, h2.w); f.y = pk4_fp8(h3.x, h3.y, h3.z, h3.w); *(v2u*)((unsigned char*)HB2 + off + 128) = f; }
        return ((h0.x * h0.x + h0.y * h0.y) + (h0.z * h0.z + h0.w * h0.w) + (h1.x * h1.x + h1.y * h1.y) + (h1.z * h1.z + h1.w * h1.w))
             + ((h2.x * h2.x + h2.y * h2.y) + (h2.z * h2.z + h2.w * h2.w) + (h3.x * h3.x + h3.y * h3.y) + (h3.z * h3.z + h3.w * h3.w));
    }
    __device__ __forceinline__ void row_done(int row, int pn, int wc, float ss) const { rss[(size_t)row * 16 + pn * 4 + wc] = ss; }
};
__device__ __forceinline__ float silu_mul(float g, float u) { return g * __builtin_amdgcn_rcpf(1.0f + __builtin_amdgcn_exp2f(g * -1.4426950408889634f)) * u; }
template <bool MOE, bool RSS = false> struct EpiSwiGLU {
    static constexpr bool NEED_SS = false; static constexpr int SC_MODE = MOE ? 3 : (RSS ? 5 : 1); typedef RowCtx Ctx; typedef NoAux Aux;
    bf16* Hm; int ldh; const float* sc_src; bf16* Hmt;
    __device__ __forceinline__ void begin(Ctx& c, const LAS float* sc, const LAS int* tl, int lr0, int, int, int) const {
#pragma unroll
        for (int ai = 0; ai < 2; ++ai)
#pragma unroll
            for (int m = 0; m < 4; ++m) { const int i = ai * 128 + lr0 + m * 16; float r = sc[i];
                if (MOE) { r *= 0.03125f; if (tl[i] < 0) r = 0.f; } c.rs[ai][m] = r; }
    }
    __device__ __forceinline__ void load_aux(Aux&, const Ctx&, int, int, int, int, int) const {}
    __device__ __forceinline__ float apply(const Ctx& c, const Aux&, int ai, int m, int row, int pn, int c128, const float (&a)[8], const float (&b)[8]) const {
        const float s = c.rs[ai][m], s2 = s * -1.4426950408889634f, iss = __builtin_amdgcn_rcpf(s * s); float o[8];
#pragma unroll
        for (int j = 0; j < 8; ++j) o[j] = (a[j] * b[j]) * __builtin_amdgcn_rcpf(__builtin_fmaf(__builtin_amdgcn_exp2f(a[j] * s2), iss, iss));
        v4u w; w.x = pk2(o[0], o[1]); w.y = pk2(o[2], o[3]); w.z = pk2(o[4], o[5]); w.w = pk2(o[6], o[7]);
        if constexpr (MOE) {
            unsigned char* rp = (row >= NT) ? (unsigned char*)Hmt + (size_t)(row - NT) * ldh : (unsigned char*)Hm + (size_t)row * ldh;
            v2u f; f.x = pk4_fp8(o[0], o[1], o[2], o[3]); f.y = pk4_fp8(o[4], o[5], o[6], o[7]); *(v2u*)(rp + pn * 128 + c128) = f;
        } else *(v4u*)(Hm + (size_t)row * ldh + pn * 128 + c128) = w;
        return 0.f;
    }
    __device__ __forceinline__ void row_done(int, int, int, float) const {}
};

namespace pg8 {
constexpr int HTB = 16384, TOK_OFF = 132096, SC_OFF = 134144;
__device__ __forceinline__ int lds_byte(int r, int c) { const int st = (r >> 4) * 2 + (c >> 5), rr = r & 15, cc = c & 31, ob = rr * 64 + cc * 2; return st * 1024 + (ob ^ (((ob >> 9) & 1) << 5)); }
__device__ __forceinline__ void stage_rc(int b, int& R, int& C) { const int st = b / 1024, sb = b % 1024, swz = sb ^ (((sb >> 9) & 1) << 5); R = (st >> 1) * 16 + swz / 64; C = (st & 1) * 32 + (swz % 64) / 2; }
__device__ __forceinline__ int perm32(int rho) { const int n = rho >> 4, i = rho & 15; return 8 * (i >> 2) + 4 * n + (i & 3); }

template <class Epi>
__device__ __forceinline__ void run_epi(const Epi& E, const f32x4 (&acc)[2][2][4][2], const Unit& u, int wr, int wc, int fr, int fq, const LAS float* sc, const LAS int* tlp) {
    int row0 = u.pm * 256 + wr * 64 + fr, c128 = 32 * wc + 8 * fq;
    asm volatile("" : "+v"(row0), "+v"(c128));
    typename Epi::Ctx ctx; E.begin(ctx, sc, tlp, wr * 64 + fr, row0, u.pn, c128);
#pragma unroll
    for (int ai = 0; ai < 2; ++ai) {
        typename Epi::Aux aux[4];
#pragma unroll
        for (int m = 0; m < 4; ++m) E.load_aux(aux[m], ctx, ai, m, row0 + ai * 128 + m * 16, u.pn, c128);
#pragma unroll
        for (int m = 0; m < 4; ++m) {
            const int row = row0 + ai * 128 + m * 16;
            float a[8], b[8];
#pragma unroll
            for (int j = 0; j < 8; ++j) { a[j] = acc[ai][0][m][j >> 2][j & 3]; b[j] = acc[ai][1][m][j >> 2][j & 3]; }
            float ss = E.apply(ctx, aux[m], ai, m, row, u.pn, c128, a, b);
            if (Epi::NEED_SS) { ss += __shfl_xor(ss, 16); ss += __shfl_xor(ss, 32); if (fq == 0) E.row_done(row, u.pn, wc, ss); }
        }
    }
}

typedef int v8i __attribute__((ext_vector_type(8)));
template <class Epi, bool GATHER, bool FP8 = false>
__device__ __forceinline__ void gemm_fast(LAS unsigned char* lds, const Sched& S, const Epi& E, const int* gtok, int wave_) {
    int tid = (wave_ << 6) | lane_id(); asm volatile("" : "+v"(tid));
    const int wid = __builtin_amdgcn_readfirstlane(tid >> 6), lane = tid & 63, wr = wid >> 2, wc = wid & 3, fr = lane & 15, fq = lane >> 4;
    const int K = S.ld, nt = S.K / 64;
    unsigned voffB[2], vA0[2], vA1[2], nA0[2], nA1[2]; int RA[2], CA2[2];
#pragma unroll
    for (int i = 0; i < 2; ++i) { int R, C; stage_rc(tid * 16 + i * 8192, R, C); const int Rb = (R & ~31) + perm32(R & 31);
        voffB[i] = (unsigned)(Rb * K + C) * 2u; RA[i] = R; CA2[i] = C * 2; vA0[i] = (unsigned)(R * K + C) * 2u; vA1[i] = vA0[i] + (unsigned)(128 * K * 2); nA0[i] = vA0[i]; nA1[i] = vA1[i]; }
    const size_t kstep = 128;
    const size_t hstep = (size_t)128 * K * 2;
    const unsigned ldsw = (unsigned)wid * 1024u;
    const int aoff = lds_byte(wr * 64 + fr, fq * 8), boff = lds_byte(wc * 32 + fr, fq * 8);
    LAS int* tl = (LAS int*)(lds + TOK_OFF);
#define PG8_SA(b, h) (((b) * 2 + (h)) * HTB)
#define PG8_SB(b, h) ((4 + (b) * 2 + (h)) * HTB)
#define PG8_STAGE(bufoff, gbase, voff) do { _Pragma("unroll") for (int _i = 0; _i < 2; ++_i) \
        __builtin_amdgcn_global_load_lds((const unsigned*)((const char*)(gbase) + (voff)[_i]), (LAS unsigned*)(lds + (bufoff) + ldsw + _i * 8192), 16, 0, 0); } while (0)
#define PG8_LDA(dst, b, h) do { _Pragma("unroll") for (int m = 0; m < 4; ++m) _Pragma("unroll") for (int k = 0; k < 2; ++k) dst[m][k] = *(const LAS bf16x8*)(lds + PG8_SA(b, h) + aoff + m * 2048 + k * 1024); } while (0)
#define PG8_LDB(dst, b, h) do { _Pragma("unroll") for (int n = 0; n < 2; ++n) _Pragma("unroll") for (int k = 0; k < 2; ++k) dst[n][k] = *(const LAS bf16x8*)(lds + PG8_SB(b, h) + boff + n * 2048 + k * 1024); } while (0)
#define PG8_MMA(ai, bj, At, Bt) do { __builtin_amdgcn_s_setprio(1); _Pragma("unroll") for (int m = 0; m < 4; ++m) _Pragma("unroll") for (int n = 0; n < 2; ++n) { \
        if constexpr (FP8) { const v8i b8_ = __builtin_bit_cast(v8i, __builtin_shufflevector(Bt[n][0], Bt[n][1], 0, 1, 2, 3, 4, 5, 6, 7, 8, 9, 10, 11, 12, 13, 14, 15)), a8_ = __builtin_bit_cast(v8i, __builtin_shufflevector(At[m][0], At[m][1], 0, 1, 2, 3, 4, 5, 6, 7, 8, 9, 10, 11, 12, 13, 14, 15)); \
            asm volatile("v_mfma_f32_16x16x128_f8f6f4 %0, %1, %2, %0" : "+v"(acc[ai][bj][m][n]) : "v"(b8_), "v"(a8_)); }     \
        else { _Pragma("unroll") for (int k = 0; k < 2; ++k) acc[ai][bj][m][n] = __builtin_amdgcn_mfma_f32_16x16x32_bf16(Bt[n][k], At[m][k], acc[ai][bj][m][n], 0, 0, 0); } } \
        __builtin_amdgcn_s_setprio(0); } while (0)
#define PG8_WAIT_V(n) asm volatile("s_waitcnt vmcnt(" #n ")" ::: "memory")
#define PG8_WAIT_L(n) asm volatile("s_waitcnt lgkmcnt(" #n ")" ::: "memory")
#define PG8_BAR __builtin_amdgcn_s_barrier()
#define PG8_SCHED __builtin_amdgcn_sched_barrier(0)
#define PG8_IDS_DMA(pm_, par_) do { if (wid < 4) __builtin_amdgcn_global_load_lds((const unsigned*)(gtok + (pm_) * 256 + wid * 64 + lane), (LAS unsigned*)(lds + TOK_OFF + (par_) * 1024 + wid * 256), 4, 0, 0); } while (0)
#define PG8_IDS_READ(d0, d1, par_) do { _Pragma("unroll") for (int _i = 0; _i < 2; ++_i) { int t0 = tl[(par_) * 256 + RA[_i]], t1 = tl[(par_) * 256 + 128 + RA[_i]]; t0 = t0 < 0 ? 0 : t0; t1 = t1 < 0 ? 0 : t1; \
        d0[_i] = (unsigned)t0 * (unsigned)(K * 2) + (unsigned)CA2[_i]; d1[_i] = (unsigned)t1 * (unsigned)(K * 2) + (unsigned)CA2[_i]; } } while (0)
    Unit cur, nxt; int ui = 0, par = 0;
    if (!S.next(0, cur)) return;
    f32x4 acc[2][2][4][2];
#pragma unroll
    for (int a = 0; a < 2; ++a)
#pragma unroll
        for (int b = 0; b < 2; ++b)
#pragma unroll
            for (int m = 0; m < 4; ++m)
#pragma unroll
                for (int n = 0; n < 2; ++n) acc[a][b][m][n] = (f32x4){0.f, 0.f, 0.f, 0.f};
    bf16x8 At[4][2], B0[2][2], B1[2][2];
    const char* cA = GATHER ? S.A : S.a_base(cur); const char* cB = S.b_base(cur);
    if constexpr (GATHER) { PG8_IDS_DMA(cur.pm, 0); PG8_WAIT_V(0); __syncthreads(); PG8_IDS_READ(vA0, vA1, 0); }
    PG8_STAGE(PG8_SB(0, 0), cB, voffB); PG8_STAGE(PG8_SB(0, 1), cB + hstep, voffB); PG8_STAGE(PG8_SA(0, 0), cA, vA0); PG8_STAGE(PG8_SA(0, 1), cA, vA1);
    if (wr == 1) PG8_BAR;
    PG8_WAIT_V(2); PG8_BAR;
    PG8_STAGE(PG8_SB(1, 0), cB + kstep, voffB); PG8_STAGE(PG8_SA(1, 0), cA + kstep, vA0); PG8_STAGE(PG8_SB(1, 1), cB + hstep + kstep, voffB);
    PG8_WAIT_V(6); PG8_BAR;
    for (;;) {
        const bool has_next = S.next(ui + 1, nxt);
        const char* nA = has_next ? (GATHER ? S.A : S.a_base(nxt)) : cA; const char* nB = has_next ? S.b_base(nxt) : cB;
        for (int t = 0; t < nt; t += 2) {
            const bool last = (t == nt - 2);
            if constexpr (GATHER) {
                if (t == nt - 4 && has_next) PG8_IDS_DMA(nxt.pm, par ^ 1);
                if (last) { if (has_next) PG8_IDS_READ(nA0, nA1, par ^ 1); else { nA0[0] = vA0[0]; nA0[1] = vA0[1]; nA1[0] = vA1[0]; nA1[1] = vA1[1]; } }
            }
            if constexpr (Epi::SC_MODE == 5 || Epi::SC_MODE == 6) {
                if (last) { const float* src_ = E.sc_src + (size_t)(Epi::SC_MODE == 5 ? cur.pm : cur.pn) * 4096 + wid * 512 + lane * 4;
                    __builtin_amdgcn_global_load_lds((const unsigned*)src_, (LAS unsigned*)(lds + SC_OFF + RSS_LDS_REL + wid * 2048), 16, 0, 0);
                    __builtin_amdgcn_global_load_lds((const unsigned*)(src_ + 256), (LAS unsigned*)(lds + SC_OFF + RSS_LDS_REL + wid * 2048 + 1024), 16, 0, 0); }
            } else if constexpr (Epi::SC_MODE != 0) {
                if (last && wid < 4) { const int i_ = wid * 64 + lane; LAS unsigned* d_ = (LAS unsigned*)(lds + SC_OFF + wid * 256);
                    if constexpr (Epi::SC_MODE == 1) __builtin_amdgcn_global_load_lds((const unsigned*)(E.sc_src + cur.pm * 256 + i_), d_, 4, 0, 0);
                    if constexpr (Epi::SC_MODE == 2) __builtin_amdgcn_global_load_lds((const unsigned*)(E.sc_src + cur.pn * 256 + i_), d_, 4, 0, 0);
                    if constexpr (Epi::SC_MODE == 3) { int t_ = tl[par * 256 + i_]; t_ = t_ < 0 ? 0 : t_; __builtin_amdgcn_global_load_lds((const unsigned*)(E.sc_src + t_), d_, 4, 0, 0); }
                    if constexpr (Epi::SC_MODE == 4) { __builtin_amdgcn_global_load_lds((const unsigned*)(E.tok + cur.pm * 256 + i_), d_, 4, 0, 0);
                        __builtin_amdgcn_global_load_lds((const unsigned*)(E.w + cur.pm * 256 + i_), (LAS unsigned*)(lds + SC_OFF + 1024 + wid * 256), 4, 0, 0); } }
            }
            const char* a1 = cA + (size_t)(t + 1) * kstep;
            const char* a2 = last ? nA : cA + (size_t)(t + 2) * kstep; const char* b2 = last ? nB : cB + (size_t)(t + 2) * kstep;
            const char* a3 = a2 + kstep; const char* b3 = b2 + kstep;
            unsigned w0[2], w1[2];
            if (GATHER && last) { w0[0] = nA0[0]; w0[1] = nA0[1]; w1[0] = nA1[0]; w1[1] = nA1[1]; } else { w0[0] = vA0[0]; w0[1] = vA0[1]; w1[0] = vA1[0]; w1[1] = vA1[1]; }
            PG8_LDB(B0, 0, 0); PG8_LDB(B1, 0, 1); PG8_SCHED; PG8_LDA(At, 0, 0); PG8_STAGE(PG8_SA(1, 1), a1, vA1);
            PG8_WAIT_V(8); PG8_WAIT_L(0); PG8_BAR; PG8_MMA(0, 0, At, B0); PG8_MMA(0, 1, At, B1); PG8_BAR; PG8_SCHED;
            PG8_LDA(At, 0, 1); PG8_STAGE(PG8_SB(0, 0), b2, voffB); PG8_STAGE(PG8_SB(0, 1), b2 + hstep, voffB); PG8_STAGE(PG8_SA(0, 0), a2, w0);
            PG8_WAIT_V(8); PG8_WAIT_L(0); PG8_BAR; PG8_MMA(1, 0, At, B0); PG8_MMA(1, 1, At, B1); PG8_BAR; PG8_SCHED;
            PG8_LDB(B0, 1, 0); PG8_LDB(B1, 1, 1); PG8_SCHED; PG8_LDA(At, 1, 0); PG8_STAGE(PG8_SA(0, 1), a2, w1);
            PG8_WAIT_V(8); PG8_WAIT_L(0); PG8_BAR; PG8_MMA(0, 0, At, B0); PG8_MMA(0, 1, At, B1); PG8_BAR; PG8_SCHED;
            PG8_LDA(At, 1, 1); PG8_STAGE(PG8_SB(1, 0), b3, voffB); PG8_STAGE(PG8_SB(1, 1), b3 + hstep, voffB); PG8_STAGE(PG8_SA(1, 0), a3, w0);
            PG8_WAIT_V(8); PG8_WAIT_L(0); PG8_BAR; PG8_MMA(1, 0, At, B0); PG8_MMA(1, 1, At, B1); PG8_BAR; PG8_SCHED;
        }
        if constexpr (FP8) asm volatile("s_nop 15\n\ts_nop 15" ::: "memory");
        if (wr == 0) PG8_BAR;
        if constexpr (Epi::SC_MODE == 5 || Epi::SC_MODE == 6) {
            if (wid < 4) ((LAS float*)(lds + SC_OFF))[tid] = rstd_from_lds((const LAS float*)(lds + SC_OFF + RSS_LDS_REL) + tid * 16);
            PG8_WAIT_L(0); PG8_BAR;
        }
        run_epi(E, acc, cur, wr, wc, fr, fq, (const LAS float*)(lds + SC_OFF), (const LAS int*)(lds + TOK_OFF + par * 1024));
        if (!has_next) break;
#pragma unroll
        for (int a = 0; a < 2; ++a)
#pragma unroll
            for (int b = 0; b < 2; ++b)
#pragma unroll
                for (int m = 0; m < 4; ++m)
#pragma unroll
                    for (int n = 0; n < 2; ++n) acc[a][b][m][n] = (f32x4){0.f, 0.f, 0.f, 0.f};
        cur = nxt; cA = nA; cB = nB; ++ui;
        if constexpr (GATHER) { vA0[0] = nA0[0]; vA0[1] = nA0[1]; vA1[0] = nA1[0]; vA1[1] = nA1[1]; par ^= 1; }
        if (wr == 1) PG8_BAR;
    }
    PG8_WAIT_V(0);
    PG8_BAR;
#undef PG8_SA
#undef PG8_SB
#undef PG8_STAGE
#undef PG8_LDA
#undef PG8_LDB
#undef PG8_MMA
#undef PG8_WAIT_V
#undef PG8_WAIT_L
#undef PG8_BAR
#undef PG8_SCHED
#undef PG8_IDS_DMA
#undef PG8_IDS_READ
}
}

template <class Epi, bool GATHER, bool FP8 = false>
__device__ __forceinline__ void gemm_run(LAS unsigned char* lds, const Sched& S, const Epi& E, const int* gtok, int wave_) { pg8::gemm_fast<Epi, GATHER, FP8>(lds, S, E, gtok, wave_); }

typedef short s16x4 __attribute__((ext_vector_type(4)));
template <bool NA, bool KLDS = false, int VLDS = 0, int KRS = 64>
__device__ __forceinline__ void attn16(int lane, const bf16* Q, int ldq, const bf16* Kb, int ldk, const bf16* Vt, int ldv, int ktok0, int trs, bf16* O, int ldo,
                                       const LAS float* rpb_h, int r, int r0, int jb, int band0, const LAS unsigned char* Kl = nullptr, int arow0 = 0, const LAS unsigned char* Vl = nullptr, int kb0 = 0) {
    const int qi = lane & 15, g = lane >> 4;
    bf16x8 qf[2];
#pragma unroll
    for (int ks = 0; ks < 2; ++ks) qf[ks] = *(const bf16x8*)(Q + (size_t)qi * ldq + ks * 32 + 8 * g);
    f32x4 s[16];
    const int krow = 8 * (qi >> 2) + (qi & 3);
#pragma unroll
    for (int t = 0; t < 16; ++t) {
        bf16x8 k0, k1;
        if constexpr (KLDS) {
            const int kcol = kb0 + krow + 4 * (t & 1), swz = (((kcol >> 3) & 3) << 1) | ((kcol >> 1) & 1);
            const LAS unsigned char* kb = Kl + ((arow0 + (t >> 1)) * KRS + kcol) * 128;
            k0 = *(const LAS bf16x8*)(kb + ((g ^ swz) << 4)); k1 = *(const LAS bf16x8*)(kb + (((4 + g) ^ swz) << 4));
        } else {
            const bf16* kp = Kb + (size_t)(ktok0 + (t >> 1) * trs + krow + 4 * (t & 1)) * ldk + 8 * g;
            k0 = *(const bf16x8*)kp; k1 = *(const bf16x8*)(kp + 32);
        }
        f32x4 z = {0.f, 0.f, 0.f, 0.f};
        z = __builtin_amdgcn_mfma_f32_16x16x32_bf16(k0, qf[0], z, 0, 0, 0);
        z = __builtin_amdgcn_mfma_f32_16x16x32_bf16(k1, qf[1], z, 0, 0, 0);
        s[t] = z;
        if constexpr (KLDS) { if ((t & 3) == 3) __builtin_amdgcn_sched_barrier(0); }
    }
    bf16x8 vfa[VLDS ? 1 : 4][VLDS ? 1 : 8];
    if constexpr (!VLDS) {
#pragma unroll
        for (int mt = 0; mt < 4; ++mt)
#pragma unroll
            for (int kk = 0; kk < 8; ++kk) vfa[mt][kk] = *(const bf16x8*)(Vt + (size_t)(16 * mt + qi) * ldv + ktok0 + kk * trs + 8 * g);
        __builtin_amdgcn_sched_barrier(0);
    }
    float m = -INFINITY;
    if constexpr (NA) {
        const int qc = 16 * jb + qi, cs = min(max(qc - 8, 0), 48);
        const LAS float* bp = rpb_h + (r0 - r + 7) * 31 + (band0 + 8 * g - qc + 15);
        bool ok[2][4];
#pragma unroll
        for (int hh = 0; hh < 2; ++hh)
#pragma unroll
            for (int i = 0; i < 4; ++i) { const int kc = band0 + 8 * g + 4 * hh + i; ok[hh][i] = (kc >= cs) && (kc < cs + 16); }
#pragma unroll
        for (int tq = 0; tq < 4; ++tq) {
            float bv[4][4];
#pragma unroll
            for (int tt = 0; tt < 4; ++tt)
#pragma unroll
                for (int i = 0; i < 4; ++i) { const int t = 4 * tq + tt; bv[tt][i] = bp[(t >> 1) * 31 + 4 * (t & 1) + i]; }
#pragma unroll
            for (int tt = 0; tt < 4; ++tt)
#pragma unroll
                for (int i = 0; i < 4; ++i) asm volatile("" : "+v"(bv[tt][i]));
#pragma unroll
            for (int tt = 0; tt < 4; ++tt)
#pragma unroll
                for (int i = 0; i < 4; ++i) { const int t = 4 * tq + tt;
                    const float v = ok[t & 1][i] ? s[t][i] + bv[tt][i] : -INFINITY;
                    s[t][i] = v; m = fmaxf(m, v); }
        }
    } else {
#pragma unroll
        for (int t = 0; t < 16; ++t)
#pragma unroll
            for (int i = 0; i < 4; ++i) m = fmaxf(m, s[t][i]);
    }
    m = fmaxf(m, __shfl_xor(m, 16)); m = fmaxf(m, __shfl_xor(m, 32));
    float l = 0.f;
    bf16x8 pf[8];
#pragma unroll
    for (int kk = 0; kk < 8; ++kk) {
        float p[8];
#pragma unroll
        for (int i = 0; i < 4; ++i) { p[i] = __builtin_amdgcn_exp2f(s[2 * kk][i] - m); p[4 + i] = __builtin_amdgcn_exp2f(s[2 * kk + 1][i] - m); }
#pragma unroll
        for (int i = 0; i < 8; ++i) l += p[i];
        v4u w; w.x = pk2(p[0], p[1]); w.y = pk2(p[2], p[3]); w.z = pk2(p[4], p[5]); w.w = pk2(p[6], p[7]);
        pf[kk] = __builtin_bit_cast(bf16x8, w);
    }
    l += __shfl_xor(l, 16); l += __shfl_xor(l, 32);
    const float inv = __builtin_amdgcn_rcpf(l);
#pragma unroll
    for (int mt = 0; mt < 4; ++mt) {
        f32x4 acc = {0.f, 0.f, 0.f, 0.f};
#pragma unroll
        for (int kk = 0; kk < 8; ++kk) {
            bf16x8 vf; if constexpr (VLDS == 1) vf = *(const LAS bf16x8*)(Vl + (16 * mt + qi) * 512 + (((4 * kk + g) ^ qi) << 4));
            else if constexpr (VLDS == 2) vf = *(const LAS bf16x8*)(Vl + (16 * mt + qi) * 1200 + ((arow0 + kk) * 40 + kb0 + 8 * g) * 2);
            else vf = vfa[mt][kk];
            acc = __builtin_amdgcn_mfma_f32_16x16x32_bf16(vf, pf[kk], acc, 0, 0, 0);
        }
        v2u w; w.x = pk2(acc[0] * inv, acc[1] * inv); w.y = pk2(acc[2] * inv, acc[3] * inv);
        *(v2u*)(O + (size_t)qi * ldo + 16 * mt + 4 * g) = w;
        if constexpr (VLDS) __builtin_amdgcn_sched_barrier(0);
    }
}
template <bool NA, int VMODE, int KRS>
__device__ __forceinline__ void attn16_lds(int lane, const bf16* Q, int ldq, bf16* O, int ldo, const LAS float* rpb_h, int r, int r0, int jb, int band0,
                                           const LAS unsigned char* Kl, int arow0, const LAS unsigned char* Vl, int kb0) {
    const int qi = lane & 15, g = lane >> 4;
    bf16x8 qf[2];
#pragma unroll
    for (int ks = 0; ks < 2; ++ks) qf[ks] = *(const bf16x8*)(Q + (size_t)qi * ldq + ks * 32 + 8 * g);
    const int krow = 8 * (qi >> 2) + (qi & 3);
    const LAS unsigned char* kbase[2][2];
#pragma unroll
    for (int e = 0; e < 2; ++e) { const int kcol = kb0 + krow + 4 * e, swz = (((kcol >> 3) & 3) << 1) | ((kcol >> 1) & 1); const LAS unsigned char* rb = Kl + (arow0 * KRS + kcol) * 128;
        kbase[e][0] = rb + ((g ^ swz) << 4); kbase[e][1] = rb + (((4 + g) ^ swz) << 4); }
#define A16_KFR(t, hh) (*(const LAS bf16x8*)(kbase[(t) & 1][hh] + ((t) >> 1) * (KRS * 128)))
    const LAS unsigned char* vbase[VMODE == 1 ? 8 : 1];
    if constexpr (VMODE == 1) {
#pragma unroll
        for (int kk = 0; kk < 8; ++kk) vbase[kk] = Vl + qi * 512 + (((4 * kk + g) ^ qi) << 4);
    } else vbase[0] = Vl + qi * 1200 + (arow0 * 40 + kb0 + 8 * g) * 2;
#define A16_VFR(mt, kk) (VMODE == 1 ? *(const LAS bf16x8*)(vbase[VMODE == 1 ? (kk) : 0] + (mt) * 8192) : *(const LAS bf16x8*)(vbase[0] + (mt) * 19200 + (kk) * 80))
    f32x4 s[16];
    bf16x8 kb[2][4][2];
    float bv[NA ? 16 : 1][4];
    const LAS float* bp = nullptr;
    if constexpr (NA) { const int qc = 16 * jb + qi; bp = rpb_h + (r0 - r + 7) * 31 + (band0 + 8 * g - qc + 15); }
#pragma unroll
    for (int tt = 0; tt < 4; ++tt) { kb[0][tt][0] = A16_KFR(tt, 0); kb[0][tt][1] = A16_KFR(tt, 1); }
#pragma unroll
    for (int gi = 0; gi < 4; ++gi) {
        if (gi < 3) {
#pragma unroll
            for (int tt = 0; tt < 4; ++tt) { kb[(gi + 1) & 1][tt][0] = A16_KFR(4 * (gi + 1) + tt, 0); kb[(gi + 1) & 1][tt][1] = A16_KFR(4 * (gi + 1) + tt, 1); }
        } else if constexpr (NA) {
#pragma unroll
            for (int t = 0; t < 16; ++t)
#pragma unroll
                for (int i = 0; i < 4; ++i) bv[t][i] = bp[(t >> 1) * 31 + 4 * (t & 1) + i];
        }
        __builtin_amdgcn_sched_barrier(0);
#pragma unroll
        for (int tt = 0; tt < 4; ++tt) { const f32x4 z = {0.f, 0.f, 0.f, 0.f}; s[4 * gi + tt] = __builtin_amdgcn_mfma_f32_16x16x32_bf16(kb[gi & 1][tt][0], qf[0], z, 0, 0, 0); }
#pragma unroll
        for (int tt = 0; tt < 4; ++tt) s[4 * gi + tt] = __builtin_amdgcn_mfma_f32_16x16x32_bf16(kb[gi & 1][tt][1], qf[1], s[4 * gi + tt], 0, 0, 0);
        __builtin_amdgcn_sched_barrier(0);
    }
    bf16x8 vb[2][8];
#pragma unroll
    for (int kk = 0; kk < 8; ++kk) vb[0][kk] = A16_VFR(0, kk);
    __builtin_amdgcn_sched_barrier(0);
    float m = -INFINITY;
    if constexpr (NA) {
        const int qc = 16 * jb + qi, cs = min(max(qc - 8, 0), 48);
        bool ok[2][4];
#pragma unroll
        for (int hh = 0; hh < 2; ++hh)
#pragma unroll
            for (int i = 0; i < 4; ++i) { const int kc = band0 + 8 * g + 4 * hh + i; ok[hh][i] = (kc >= cs) && (kc < cs + 16); }
#pragma unroll
        for (int t = 0; t < 16; ++t)
#pragma unroll
            for (int i = 0; i < 4; ++i) asm volatile("" : "+v"(bv[t][i]));
#pragma unroll
        for (int t = 0; t < 16; ++t)
#pragma unroll
            for (int i = 0; i < 4; ++i) { const float v = ok[t & 1][i] ? s[t][i] + bv[t][i] : -INFINITY; s[t][i] = v; m = fmaxf(m, v); }
    } else {
#pragma unroll
        for (int t = 0; t < 16; ++t)
#pragma unroll
            for (int i = 0; i < 4; ++i) m = fmaxf(m, s[t][i]);
    }
    m = fmaxf(m, __shfl_xor(m, 16)); m = fmaxf(m, __shfl_xor(m, 32));
    float l = 0.f;
    bf16x8 pf[8];
#pragma unroll
    for (int kk = 0; kk < 8; ++kk) {
        float p[8];
#pragma unroll
        for (int i = 0; i < 4; ++i) { p[i] = __builtin_amdgcn_exp2f(s[2 * kk][i] - m); p[4 + i] = __builtin_amdgcn_exp2f(s[2 * kk + 1][i] - m); }
#pragma unroll
        for (int i = 0; i < 8; ++i) l += p[i];
        v4u w; w.x = pk2(p[0], p[1]); w.y = pk2(p[2], p[3]); w.z = pk2(p[4], p[5]); w.w = pk2(p[6], p[7]);
        pf[kk] = __builtin_bit_cast(bf16x8, w);
    }
    l += __shfl_xor(l, 16); l += __shfl_xor(l, 32);
    const float inv = __builtin_amdgcn_rcpf(l);
    __builtin_amdgcn_sched_barrier(0);
#pragma unroll
    for (int mt = 0; mt < 4; ++mt) {
        if (mt < 3) {
#pragma unroll
            for (int kk = 0; kk < 8; ++kk) vb[(mt + 1) & 1][kk] = A16_VFR(mt + 1, kk);
        }
        __builtin_amdgcn_sched_barrier(0);
        f32x4 a0 = {0.f, 0.f, 0.f, 0.f}, a1 = {0.f, 0.f, 0.f, 0.f};
#pragma unroll
        for (int kk = 0; kk < 8; kk += 2) { a0 = __builtin_amdgcn_mfma_f32_16x16x32_bf16(vb[mt & 1][kk], pf[kk], a0, 0, 0, 0); a1 = __builtin_amdgcn_mfma_f32_16x16x32_bf16(vb[mt & 1][kk + 1], pf[kk + 1], a1, 0, 0, 0); }
        v2u w; w.x = pk2((a0[0] + a1[0]) * inv, (a0[1] + a1[1]) * inv); w.y = pk2((a0[2] + a1[2]) * inv, (a0[3] + a1[3]) * inv);
        *(v2u*)(O + (size_t)qi * ldo + 16 * mt + 4 * g) = w;
        __builtin_amdgcn_sched_barrier(0);
    }
#undef A16_KFR
#undef A16_VFR
}
template <int KRS>
__device__ __forceinline__ void na_qk_sm(int lane, const bf16x8 (&qf)[2], const LAS float* rpb_h, int r, int r0, int jb, int band0, const LAS unsigned char* Kl, int arow0, int kb0, bf16x8 (&pf)[8], float& inv) {
    const int qi = lane & 15, g = lane >> 4;
    const int krow = 8 * (qi >> 2) + (qi & 3);
    const LAS unsigned char* kbase[2][2];
#pragma unroll
    for (int e = 0; e < 2; ++e) { const int kcol = kb0 + krow + 4 * e, swz = (((kcol >> 3) & 3) << 1) | ((kcol >> 1) & 1); const LAS unsigned char* rb = Kl + (arow0 * KRS + kcol) * 128;
        kbase[e][0] = rb + ((g ^ swz) << 4); kbase[e][1] = rb + (((4 + g) ^ swz) << 4); }
#define A16_KFR(t, hh) (*(const LAS bf16x8*)(kbase[(t) & 1][hh] + ((t) >> 1) * (KRS * 128)))
    f32x4 s[16];
    bf16x8 kb[2][4][2];
    float bv[16][4];
    const int qc = 16 * jb + qi;
    const LAS float* bp = rpb_h + (r0 - r + 7) * 31 + (band0 + 8 * g - qc + 15);
#pragma unroll
    for (int tt = 0; tt < 4; ++tt) { kb[0][tt][0] = A16_KFR(tt, 0); kb[0][tt][1] = A16_KFR(tt, 1); }
#pragma unroll
    for (int gi = 0; gi < 4; ++gi) {
        if (gi < 3) {
#pragma unroll
            for (int tt = 0; tt < 4; ++tt) { kb[(gi + 1) & 1][tt][0] = A16_KFR(4 * (gi + 1) + tt, 0); kb[(gi + 1) & 1][tt][1] = A16_KFR(4 * (gi + 1) + tt, 1); }
        } else {
#pragma unroll
            for (int t = 0; t < 16; ++t)
#pragma unroll
                for (int i = 0; i < 4; ++i) bv[t][i] = bp[(t >> 1) * 31 + 4 * (t & 1) + i];
        }
        __builtin_amdgcn_sched_barrier(0);
#pragma unroll
        for (int tt = 0; tt < 4; ++tt) { const f32x4 z = {0.f, 0.f, 0.f, 0.f}; s[4 * gi + tt] = __builtin_amdgcn_mfma_f32_16x16x32_bf16(kb[gi & 1][tt][0], qf[0], z, 0, 0, 0); }
#pragma unroll
        for (int tt = 0; tt < 4; ++tt) s[4 * gi + tt] = __builtin_amdgcn_mfma_f32_16x16x32_bf16(kb[gi & 1][tt][1], qf[1], s[4 * gi + tt], 0, 0, 0);
        __builtin_amdgcn_sched_barrier(0);
    }
#undef A16_KFR
    float m = -INFINITY;
    { const int cs = min(max(qc - 8, 0), 48);
      bool ok[2][4];
#pragma unroll
      for (int hh = 0; hh < 2; ++hh)
#pragma unroll
          for (int i = 0; i < 4; ++i) { const int kc = band0 + 8 * g + 4 * hh + i; ok[hh][i] = (kc >= cs) && (kc < cs + 16); }
#pragma unroll
      for (int t = 0; t < 16; ++t)
#pragma unroll
          for (int i = 0; i < 4; ++i) asm volatile("" : "+v"(bv[t][i]));
#pragma unroll
      for (int t = 0; t < 16; ++t)
#pragma unroll
          for (int i = 0; i < 4; ++i) { const float v = ok[t & 1][i] ? s[t][i] + bv[t][i] : -INFINITY; s[t][i] = v; m = fmaxf(m, v); } }
    m = fmaxf(m, __shfl_xor(m, 16)); m = fmaxf(m, __shfl_xor(m, 32));
    float l = 0.f;
#pragma unroll
    for (int kk = 0; kk < 8; ++kk) {
        float p[8];
#pragma unroll
        for (int i = 0; i < 4; ++i) { p[i] = __builtin_amdgcn_exp2f(s[2 * kk][i] - m); p[4 + i] = __builtin_amdgcn_exp2f(s[2 * kk + 1][i] - m); }
#pragma unroll
        for (int i = 0; i < 8; ++i) l += p[i];
        v4u w; w.x = pk2(p[0], p[1]); w.y = pk2(p[2], p[3]); w.z = pk2(p[4], p[5]); w.w = pk2(p[6], p[7]);
        pf[kk] = __builtin_bit_cast(bf16x8, w);
    }
    l += __shfl_xor(l, 16); l += __shfl_xor(l, 32);
    inv = __builtin_amdgcn_rcpf(l);
}
__device__ __forceinline__ void na_pv(int lane, const bf16x8 (&pf)[8], float inv, bf16* O, int ldo, const LAS unsigned char* Vl, int arow0, int kb0) {
    const int qi = lane & 15, g = lane >> 4;
    const LAS unsigned char* vbase = Vl + qi * 1200 + (arow0 * 40 + kb0 + 8 * g) * 2;
#define A16_VFR(mt, kk) (*(const LAS bf16x8*)(vbase + (mt) * 19200 + (kk) * 80))
    bf16x8 vb[2][8];
#pragma unroll
    for (int kk = 0; kk < 8; ++kk) vb[0][kk] = A16_VFR(0, kk);
#pragma unroll
    for (int mt = 0; mt < 4; ++mt) {
        if (mt < 3) {
#pragma unroll
            for (int kk = 0; kk < 8; ++kk) vb[(mt + 1) & 1][kk] = A16_VFR(mt + 1, kk);
        }
        __builtin_amdgcn_sched_barrier(0);
        f32x4 a0 = {0.f, 0.f, 0.f, 0.f}, a1 = {0.f, 0.f, 0.f, 0.f};
#pragma unroll
        for (int kk = 0; kk < 8; kk += 2) { a0 = __builtin_amdgcn_mfma_f32_16x16x32_bf16(vb[mt & 1][kk], pf[kk], a0, 0, 0, 0); a1 = __builtin_amdgcn_mfma_f32_16x16x32_bf16(vb[mt & 1][kk + 1], pf[kk + 1], a1, 0, 0, 0); }
        v2u w; w.x = pk2((a0[0] + a1[0]) * inv, (a0[1] + a1[1]) * inv); w.y = pk2((a0[2] + a1[2]) * inv, (a0[3] + a1[3]) * inv);
        *(v2u*)(O + (size_t)qi * ldo + 16 * mt + 4 * g) = w;
        __builtin_amdgcn_sched_barrier(0);
    }
#undef A16_VFR
}
__device__ __forceinline__ void memkv_item(int it, int lane, const bf16* membf, const bf16* wt, const float* mrstd, bf16* memk, bf16* memvt) {
    const int rt = it >> 4, ctile = it & 15, qi = lane & 15, g = lane >> 4, row0 = rt * 16, col0 = ctile * 32;
    const bf16* ap = membf + (size_t)(row0 + qi) * DM + 8 * g; const bf16* bp = wt + (size_t)(col0 + qi) * DM + 8 * g;
    f32x4 acc0 = {0.f, 0.f, 0.f, 0.f}, acc1 = {0.f, 0.f, 0.f, 0.f};
    const bool isk = col0 < 256;
    if (isk) {
#pragma unroll 1
        for (int k8 = 0; k8 < 32; k8 += 8) { bf16x8 a[8], b0[8], b1[8];
#pragma unroll
            for (int j = 0; j < 8; ++j) { a[j] = *(const bf16x8*)(ap + 32 * (k8 + j)); b0[j] = *(const bf16x8*)(bp + 32 * (k8 + j)); b1[j] = *(const bf16x8*)(bp + 16 * DM + 32 * (k8 + j)); }
#pragma unroll
            for (int j = 0; j < 8; ++j) { acc0 = __builtin_amdgcn_mfma_f32_16x16x32_bf16(b0[j], a[j], acc0, 0, 0, 0); acc1 = __builtin_amdgcn_mfma_f32_16x16x32_bf16(b1[j], a[j], acc1, 0, 0, 0); } }
    } else {
#pragma unroll 1
        for (int k8 = 0; k8 < 32; k8 += 8) { bf16x8 a[8], b0[8], b1[8];
#pragma unroll
            for (int j = 0; j < 8; ++j) { a[j] = *(const bf16x8*)(ap + 32 * (k8 + j)); b0[j] = *(const bf16x8*)(bp + 32 * (k8 + j)); b1[j] = *(const bf16x8*)(bp + 16 * DM + 32 * (k8 + j)); }
#pragma unroll
            for (int j = 0; j < 8; ++j) { acc0 = __builtin_amdgcn_mfma_f32_16x16x32_bf16(a[j], b0[j], acc0, 0, 0, 0); acc1 = __builtin_amdgcn_mfma_f32_16x16x32_bf16(a[j], b1[j], acc1, 0, 0, 0); } }
    }
    if (isk) {
        const float s = mrstd[row0 + qi]; bf16* p = memk + (size_t)(row0 + qi) * 256 + col0 + 4 * g;
        v2u w; w.x = pk2(acc0[0] * s, acc0[1] * s); w.y = pk2(acc0[2] * s, acc0[3] * s); *(v2u*)p = w;
        w.x = pk2(acc1[0] * s, acc1[1] * s); w.y = pk2(acc1[2] * s, acc1[3] * s); *(v2u*)(p + 16) = w;
    } else {
        const f32x4 s = *(const f32x4*)(mrstd + row0 + 4 * g); bf16* p = memvt + (size_t)(col0 - 256 + qi) * MEM_ROWS + row0 + 4 * g;
        v2u w; w.x = pk2(acc0[0] * s[0], acc0[1] * s[1]); w.y = pk2(acc0[2] * s[2], acc0[3] * s[3]); *(v2u*)p = w;
        w.x = pk2(acc1[0] * s[0], acc1[1] * s[1]); w.y = pk2(acc1[2] * s[2], acc1[3] * s[3]); *(v2u*)(p + (size_t)16 * MEM_ROWS) = w;
    }
}
__device__ __forceinline__ void memattn_strip(const Frame& F, int item, const bf16* act, int ld, int qoff, const bf16* memk, const bf16* memvt, bf16* mix) {
    const int tg = item & 15, h = (item >> 4) & 3, b = item >> 6, lane = LANE(), wave = F.wave;
    LAS unsigned char* Kl = F.lds; LAS unsigned char* Vl = F.lds + 32768;
#pragma unroll
    for (int j = 0; j < 4; ++j) {
        const int p = (wave * 4 + j) * 64 + lane, key = p >> 3, kpos = p & 7, kc = key & 31, swz = (((kc >> 3) & 3) << 1) | ((kc >> 1) & 1);
        __builtin_amdgcn_global_load_lds((const unsigned*)(memk + (size_t)(b * 256 + key) * 256 + h * 64 + ((kpos ^ swz) << 3)), (LAS unsigned*)(Kl + (wave * 4 + j) * 1024), 16, 0, 0);
        const int d = p >> 5, vpos = p & 31;
        __builtin_amdgcn_global_load_lds((const unsigned*)(memvt + (size_t)(h * 64 + d) * MEM_ROWS + b * 256 + ((vpos ^ (d & 15)) << 3)), (LAS unsigned*)(Vl + (wave * 4 + j) * 1024), 16, 0, 0);
    }
    asm volatile("s_waitcnt vmcnt(0)\n\ts_barrier" ::: "memory");
#pragma unroll 1
    for (int u = 0; u < 2; ++u) {
        const int tok0 = b * SEQ + tg * 256 + (wave * 2 + u) * 16;
        attn16_lds<false, 1, 32>(lane, act + (size_t)tok0 * ld + qoff + h * 64, ld, mix + (size_t)tok0 * DM + 768 + h * 64, DM, nullptr, 0, 0, 0, 0, Kl, 0, Vl, 0);
    }
    asm volatile("s_waitcnt lgkmcnt(0)\n\ts_barrier" ::: "memory");
}
__device__ __forceinline__ void memattn_item(int it, int lane, const bf16* act, int ld, int qoff, const bf16* memk, const bf16* memvt, bf16* mix) {
    const int tb = it >> 2, h = it & 3, tok0 = tb * 16, b = tok0 >> 12;
    attn16<false>(lane, act + (size_t)tok0 * ld + qoff + h * 64, ld, memk + h * 64, 256, memvt + (size_t)(h * 64) * MEM_ROWS, MEM_ROWS, b * 256, 32,
                  mix + (size_t)tok0 * DM + 768 + h * 64, DM, nullptr, 0, 0, 0, 0);
}
constexpr int NA_RPB_OFF = 122880;
__device__ __forceinline__ void na_strip(const Frame& F, int item, const bf16* act0, const bf16* v0t, bf16* mix) {
    const int s8 = item & 7, h = (item >> 3) % 12, b = (item >> 3) / 12, lane = LANE(), wave = F.wave;
    const int R0 = 8 * s8, rowbase = min(max(R0 - 4, 0), 56), rowend = min(max(R0 + 7 - 4, 0), 56) + 8, nrows = rowend - rowbase;
    LAS unsigned char* Kl = F.lds;
    {
        const int col = wave * 8 + (lane >> 3), pos = lane & 7, swz = (((col >> 3) & 3) << 1) | ((col >> 1) & 1);
        const bf16* src = act0 + (size_t)(b * SEQ + rowbase * 64 + col) * A0_LD + 768 + h * 64 + ((pos ^ swz) << 3);
        for (int j = 0; j < nrows; ++j)
            __builtin_amdgcn_global_load_lds((const unsigned*)(src + (size_t)j * 64 * A0_LD), (LAS unsigned*)(Kl + j * 8192 + wave * 1024), 16, 0, 0);
    }
    asm volatile("s_waitcnt vmcnt(0)\n\ts_barrier" ::: "memory");
    const int r = R0 + wave, r0 = min(max(r - 4, 0), 56);
    const LAS float* rpb = (const LAS float*)(F.lds + NA_RPB_OFF) + h * 465;
#pragma unroll 1
    for (int jb = 0; jb < 4; ++jb) {
        const int band0 = min(max(jb * 16 - 8, 0), 32), tok0 = b * SEQ + r * 64 + jb * 16;
        attn16<true, true>(lane, act0 + (size_t)tok0 * A0_LD + h * 64, A0_LD, nullptr, 0, v0t + (size_t)(h * 64) * NT, NT, b * SEQ + r0 * 64 + band0, 64,
                           mix + (size_t)tok0 * DM + h * 64, DM, rpb, r, r0, jb, band0, Kl, r0 - rowbase, nullptr, band0);
    }
    asm volatile("s_waitcnt lgkmcnt(0)\n\ts_barrier" ::: "memory");
}
constexpr int NAH_V = 76800, NAH_RPB = 153600;
__device__ __forceinline__ void na_hstrip(const Frame& F, int item, const bf16* act0, const bf16* v0t, const float* rpb_g, bf16* mix) {
    const int half = item & 1, s8 = (item >> 1) & 7, h = (item >> 4) % 12, b = (item >> 4) / 12, lane = LANE(), wave = F.wave;
    const int R0 = 8 * s8, rowbase = min(max(R0 - 4, 0), 56), rowend = min(max(R0 + 7 - 4, 0), 56) + 8, nrows = rowend - rowbase, cb0 = half ? 24 : 0;
    LAS unsigned char* Kl = F.lds; LAS unsigned char* Vl = F.lds + NAH_V; LAS float* rl = (LAS float*)(F.lds + NAH_RPB);
    {
        const int pos = lane & 7, nk = nrows * 5 - 1;
#pragma unroll
        for (int i = 0; i < 10; ++i) { const int k = min(wave + NWAVES * i, 74), idx = min(k, nk);
            { const int j = idx / 5, q = idx - 5 * j, lc = q * 8 + (lane >> 3), swz = (((lc >> 3) & 3) << 1) | ((lc >> 1) & 1);
              __builtin_amdgcn_global_load_lds((const unsigned*)(act0 + (size_t)(b * SEQ + (rowbase + j) * 64 + cb0 + lc) * A0_LD + 768 + h * 64 + ((pos ^ swz) << 3)), (LAS unsigned*)(Kl + idx * 1024), 16, 0, 0); }
            { const int G = k * 64 + lane, d = G / 75, rem = G - 75 * d, j0 = rem / 5, gc = rem - 5 * j0, j = min(j0, nrows - 1);
              __builtin_amdgcn_global_load_lds((const unsigned*)(v0t + (size_t)(h * 64 + d) * NT + b * SEQ + (rowbase + j) * 64 + cb0 + gc * 8), (LAS unsigned*)(Vl + k * 1024), 16, 0, 0); } }
    }
    float bias = 0.f; if (TID() < 465) bias = rpb_g[h * 465 + TID()];
    asm volatile("" : "+v"(bias));
    bias *= 1.4426950408889634f;
    if (TID() < 465) rl[TID()] = bias;
    asm volatile("s_waitcnt vmcnt(0) lgkmcnt(0)\n\ts_barrier" ::: "memory");
    const int r = R0 + wave, r0 = min(max(r - 4, 0), 56);
#pragma unroll 1
    for (int u = 0; u < 2; ++u) {
        const int jb = 2 * half + u, band0 = min(max(jb * 16 - 8, 0), 32), tok0 = b * SEQ + r * 64 + jb * 16;
        attn16_lds<true, 2, 40>(lane, act0 + (size_t)tok0 * A0_LD + h * 64, A0_LD, mix + (size_t)tok0 * DM + h * 64, DM, rl, r, r0, jb, band0, Kl, r0 - rowbase, Vl, band0 - cb0);
    }
    asm volatile("s_waitcnt lgkmcnt(0)\n\ts_barrier" ::: "memory");
}
struct NaItem { int half, h, b, R0, rowbase, nrows, cb0; };
__device__ __forceinline__ NaItem na_decode(int item) { NaItem t; t.half = item & 1; const int s8 = (item >> 1) & 7; t.h = (item >> 4) % 12; t.b = (item >> 4) / 12; t.R0 = 8 * s8;
    t.rowbase = min(max(t.R0 - 4, 0), 56); t.nrows = min(max(t.R0 + 7 - 4, 0), 56) + 8 - t.rowbase; t.cb0 = t.half ? 24 : 0; return t; }
__device__ __forceinline__ void na_issue_k(const NaItem& t, int wave, const bf16* act0, LAS unsigned char* Kl) {
    const int lane = lane_id(), pos = lane & 7, nk = t.nrows * 5 - 1;
#pragma unroll
    for (int i = 0; i < 10; ++i) { const int idx = min(wave + NWAVES * i, nk), j = idx / 5, q = idx - 5 * j, lc = q * 8 + (lane >> 3), swz = (((lc >> 3) & 3) << 1) | ((lc >> 1) & 1);
        __builtin_amdgcn_global_load_lds((const unsigned*)(act0 + (size_t)(t.b * SEQ + (t.rowbase + j) * 64 + t.cb0 + lc) * A0_LD + 768 + t.h * 64 + ((pos ^ swz) << 3)), (LAS unsigned*)(Kl + idx * 1024), 16, 0, 0); }
}
__device__ __forceinline__ void na_issue_v(const NaItem& t, int wave, const bf16* v0t, LAS unsigned char* Vl) {
    const int lane = lane_id();
#pragma unroll
    for (int i = 0; i < 10; ++i) { const int k = min(wave + NWAVES * i, 74), G = k * 64 + lane, d = G / 75, rem = G - 75 * d, j0 = rem / 5, gc = rem - 5 * j0, j = min(j0, t.nrows - 1);
        __builtin_amdgcn_global_load_lds((const unsigned*)(v0t + (size_t)(t.h * 64 + d) * NT + t.b * SEQ + (t.rowbase + j) * 64 + t.cb0 + gc * 8), (LAS unsigned*)(Vl + k * 1024), 16, 0, 0); }
}
__device__ __forceinline__ void na_phase(const Frame& F, const bf16* act0, const bf16* v0t, const float* rpb2, bf16* mix) {
    const int wave = F.wave;
    LAS unsigned char* Kl = F.lds; LAS unsigned char* Vl = F.lds + NAH_V; LAS float* rl = (LAS float*)(F.lds + NAH_RPB);
    const int item0 = (F.bid & 7) * 192 + (F.bid >> 3);
    { const NaItem t0 = na_decode(item0); na_issue_k(t0, wave, act0, Kl); }
#pragma unroll 1
    for (int i = 0; i < 6; ++i) {
        const NaItem t = na_decode(item0 + 32 * i);
        const int lane = lane_id(), qi = lane & 15, g = lane >> 4;
        const int r = t.R0 + wave, r0 = min(max(r - 4, 0), 56), arow0 = r0 - t.rowbase;
        const int tokA = t.b * SEQ + r * 64 + (2 * t.half) * 16, tokB = tokA + 16;
        v4u q0, q1;
        const bf16* qa = act0 + (size_t)(tokA + qi) * A0_LD + t.h * 64 + 8 * g;
        asm volatile("global_load_dwordx4 %0, %1, off" : "=v"(q0) : "v"(qa)); asm volatile("global_load_dwordx4 %0, %1, off offset:64" : "=v"(q1) : "v"(qa));
        if (wave < 2) __builtin_amdgcn_global_load_lds((const unsigned*)(rpb2 + t.h * 480 + 4 * min(wave * 64 + lane, 119)), (LAS unsigned*)((LAS unsigned char*)rl + wave * 1024), 16, 0, 0);
        na_issue_v(t, wave, v0t, Vl);
        asm volatile("s_waitcnt vmcnt(10)\n\ts_barrier" : "+v"(q0), "+v"(q1) :: "memory");
        bf16x8 pf[8]; float inv;
        { const bf16x8 qf[2] = {__builtin_bit_cast(bf16x8, q0), __builtin_bit_cast(bf16x8, q1)}; const int jb = 2 * t.half, band0 = min(max(jb * 16 - 8, 0), 32);
          na_qk_sm<40>(lane, qf, rl, r, r0, jb, band0, Kl, arow0, band0 - t.cb0, pf, inv); }
        asm volatile("s_waitcnt vmcnt(0)\n\ts_barrier" ::: "memory");
        { const bf16* qb = qa + (size_t)16 * A0_LD;
          asm volatile("global_load_dwordx4 %0, %1, off" : "=v"(q0) : "v"(qb)); asm volatile("global_load_dwordx4 %0, %1, off offset:64" : "=v"(q1) : "v"(qb)); }
        { const int band0 = min(max((2 * t.half) * 16 - 8, 0), 32); na_pv(lane, pf, inv, mix + (size_t)tokA * DM + t.h * 64, DM, Vl, arow0, band0 - t.cb0); }
        asm volatile("s_waitcnt vmcnt(4)" : "+v"(q0), "+v"(q1) :: "memory");
        { const bf16x8 qf[2] = {__builtin_bit_cast(bf16x8, q0), __builtin_bit_cast(bf16x8, q1)}; const int jb = 2 * t.half + 1, band0 = min(max(jb * 16 - 8, 0), 32);
          na_qk_sm<40>(lane, qf, rl, r, r0, jb, band0, Kl, arow0, band0 - t.cb0, pf, inv); }
        asm volatile("s_waitcnt lgkmcnt(0)\n\ts_barrier" ::: "memory");
        if (i + 1 < 6) { const NaItem tn = na_decode(item0 + 32 * (i + 1)); na_issue_k(tn, wave, act0, Kl); }
        { const int band0 = min(max((2 * t.half + 1) * 16 - 8, 0), 32); na_pv(lane, pf, inv, mix + (size_t)tokB * DM + t.h * 64, DM, Vl, arow0, band0 - t.cb0); }
        asm volatile("s_waitcnt lgkmcnt(0)\n\ts_barrier" ::: "memory");
    }
}
__device__ __forceinline__ void na_item(int it, int lane, const bf16* act0, const bf16* v0t, const LAS float* rpb, bf16* mix) {
    const int jb = it & 3, h = (it >> 2) % 12, br = (it >> 2) / 12, r = br & 63, b = br >> 6;
    const int r0 = min(max(r - 4, 0), 56), band0 = min(max(jb * 16 - 8, 0), 32);
    const int tok0 = b * SEQ + r * 64 + jb * 16;
    attn16<true>(lane, act0 + (size_t)tok0 * A0_LD + h * 64, A0_LD, act0 + 768 + h * 64, A0_LD, v0t + (size_t)(h * 64) * NT, NT, b * SEQ + r0 * 64 + band0, 64,
                 mix + (size_t)tok0 * DM + h * 64, DM, rpb + h * 465, r, r0, jb, band0);
}

constexpr int GP_LD = 392;
__device__ __forceinline__ void gla_pre_w(int wave, int lane, const float* W, const float* Bi, bf16x8 (&wfr)[3], float (&bias)[3]) {
    const int qi = lane & 15, g = lane >> 4;
#pragma unroll
    for (int jj = 0; jj < 3; ++jj) {
        const int j = 16 * (wave + 8 * jj) + qi;
        v4u wu = {0u, 0u, 0u, 0u};
        if (g < 2) { const float* wp = W + (size_t)(8 * g) * 384 + j;
            wu.x = pk2(wp[0], wp[384]); wu.y = pk2(wp[768], wp[1152]); wu.z = pk2(wp[1536], wp[1920]); wu.w = pk2(wp[2304], wp[2688]); }
        wfr[jj] = __builtin_bit_cast(bf16x8, wu); bias[jj] = Bi[j];
    }
}
__device__ __forceinline__ void gla_pre_item(const Frame& F, int item, const bf16* act1, const bf16x8 (&wfr)[3], const float (&bias)[3], bf16* QT, bf16* KT, float* DEC) {
    const int n = item & 63, dir = (item >> 6) & 1, b = item >> 7, base = b * SEQ + n * 64;
    const int tid = TID(), lane = LANE(), wave = F.wave, qi = lane & 15, g = lane >> 4;
    LAS bf16* EL = (LAS bf16*)F.lds;
    bf16x8 zf[4];
#pragma unroll
    for (int ct = 0; ct < 4; ++ct) { const int c = 16 * ct + qi, tok = dir ? base + 63 - c : base + c;
        bf16x8 z = {0, 0, 0, 0, 0, 0, 0, 0}; if (g < 2) z = *(const bf16x8*)(act1 + (size_t)tok * A1_LD + 1792 + dir * 16 + 8 * g); zf[ct] = z; }
    v4u q8a[6], k8a[6];
#pragma unroll
    for (int k = 0; k < 6; ++k) { const int idx = tid + 512 * k, c = idx / 48, jg = idx % 48; const bf16* arow = act1 + (size_t)(base + c) * A1_LD + 8 * jg; q8a[k] = *(const v4u*)arow; k8a[k] = *(const v4u*)(arow + 384); }
#pragma unroll
    for (int jj = 0; jj < 3; ++jj) {
        const int j = 16 * (wave + 8 * jj) + qi;
        float p[4][4], a[4], t1[4], t2[4], tot[4];
#pragma unroll
        for (int ct = 0; ct < 4; ++ct) {
            f32x4 d = {0.f, 0.f, 0.f, 0.f};
            d = __builtin_amdgcn_mfma_f32_16x16x32_bf16(zf[ct], wfr[jj], d, 0, 0, 0);
#pragma unroll
            for (int i = 0; i < 4; ++i) { const float x = d[i] + bias[jj];
                p[ct][i] = (fminf(x, 0.f) * 1.4426950408889634f - __builtin_amdgcn_logf(1.0f + __builtin_amdgcn_exp2f(fabsf(x) * -1.4426950408889634f))) * 0.0625f; }
            p[ct][1] += p[ct][0]; p[ct][2] += p[ct][1]; p[ct][3] += p[ct][2]; a[ct] = p[ct][3];
        }
#pragma unroll
        for (int ct = 0; ct < 4; ++ct) t1[ct] = __shfl_up(a[ct], 16);
#pragma unroll
        for (int ct = 0; ct < 4; ++ct) if (g >= 1) a[ct] += t1[ct];
#pragma unroll
        for (int ct = 0; ct < 4; ++ct) t2[ct] = __shfl_up(a[ct], 32);
#pragma unroll
        for (int ct = 0; ct < 4; ++ct) if (g >= 2) a[ct] += t2[ct];
#pragma unroll
        for (int ct = 0; ct < 4; ++ct) tot[ct] = __shfl(a[ct], 48 + qi);
        float carry = 0.f;
#pragma unroll
        for (int ct = 0; ct < 4; ++ct) {
            const float excl = a[ct] - p[ct][3] + carry;
            carry += tot[ct];
#pragma unroll
            for (int i = 0; i < 4; ++i) { const int c = 16 * ct + 4 * g + i, ctok = dir ? 63 - c : c; EL[ctok * GP_LD + j] = (bf16)f2bf(__builtin_amdgcn_exp2f(excl + p[ct][i])); }
        }
    }
    __syncthreads();
    const int clast = dir ? 0 : 63;
#pragma unroll
    for (int k = 0; k < 6; ++k) {
        const int idx = tid + 512 * k, c = idx / 48, jg = idx % 48;
        const v4u q8 = q8a[k], k8 = k8a[k];
        const v4u e8 = *(const LAS v4u*)(EL + c * GP_LD + 8 * jg), l8 = *(const LAS v4u*)(EL + clast * GP_LD + 8 * jg);
        const unsigned qa[4] = {q8.x, q8.y, q8.z, q8.w}, ka[4] = {k8.x, k8.y, k8.z, k8.w}, ea[4] = {e8.x, e8.y, e8.z, e8.w}, la[4] = {l8.x, l8.y, l8.z, l8.w};
        unsigned qo[4], ko[4];
        float lf[8];
#pragma unroll
        for (int i = 0; i < 4; ++i) {
            const float e0 = bflo(ea[i]), e1 = bfhi(ea[i]), i0 = __builtin_amdgcn_rcpf(e0), i1 = __builtin_amdgcn_rcpf(e1);
            const float kt0 = bflo(ka[i]) * i0, kt1 = bfhi(ka[i]) * i1; lf[2 * i] = bflo(la[i]); lf[2 * i + 1] = bfhi(la[i]);
            qo[i] = pk2(bflo(qa[i]) * 0.10206207261596575f * e0, bfhi(qa[i]) * 0.10206207261596575f * e1);
            ko[i] = pk2(kt0, kt1);
        }
        v4u w; w.x = qo[0]; w.y = qo[1]; w.z = qo[2]; w.w = qo[3]; *(v4u*)(QT + (size_t)(base + c) * 384 + 8 * jg) = w;
        w.x = ko[0]; w.y = ko[1]; w.z = ko[2]; w.w = ko[3]; *(v4u*)(KT + (size_t)(base + c) * 384 + 8 * jg) = w;
        if (c == clast) { float* dp = DEC + (size_t)((b * 4 + jg / 12) * 64 + n) * 96 + (jg % 12) * 8;
            *(f32x4*)dp = (f32x4){lf[0], lf[1], lf[2], lf[3]}; *(f32x4*)(dp + 4) = (f32x4){lf[4], lf[5], lf[6], lf[7]}; }
    }
    __syncthreads();
}
constexpr int GL_QT = 0, GL_KT = 13312, GL_VT = 26624, GL_DEC = 33792, GL_BUF = 34816;
__device__ __forceinline__ void gla_main_item(const Frame& F, int item, const bf16* QTa, const bf16* KTa, const float* DECa, const bf16* v1t, bf16* OFp, bf16* OBp,
                                              const float* cwg, const float* cwu, const float* cgain, unsigned char* c8) {
    const int vs = item & 3, dir = (item >> 2) & 1, h = (item >> 3) & 3, b = item >> 5;
    const int lane = LANE(), wave = F.wave, qi = lane & 15, g = lane >> 4, ct = wave & 3, vh = wave >> 2;
    bf16* O = dir ? OBp : OFp;
    LAS unsigned char* L = F.lds;
    unsigned off[5];
#pragma unroll
    for (int jj = 0; jj < 5; ++jj) { const int k = wave + 8 * jj; unsigned o;
        if (k < 26) { const int gi = (k < 13 ? k : k - 13) * 64 + lane, row = gi / 13, col = gi % 13; o = (unsigned)(row * 768 + (col < 12 ? col * 16 : 0)); }
        else if (k < 33) { const int gi = (k - 26) * 64 + lane, row = gi / 9, col = gi % 9; o = (gi < 432) ? (unsigned)(row * NT * 2 + (col < 8 ? col * 16 : 0)) : 0u; }
        else o = (lane < 24) ? (unsigned)(lane * 16) : 0u;
        off[jj] = o; }
    const char* qtb = (const char*)(QTa + (size_t)dir * NT * 384 + h * 96); const char* ktb = (const char*)(KTa + (size_t)dir * NT * 384 + h * 96);
    const char* deb = (const char*)(DECa + (size_t)dir * 8 * 4 * 64 * 96 + (size_t)((b * 4 + h) * 64) * 96);
    const char* vtb = (const char*)(v1t + (size_t)(h * 192 + vs * 48) * NT);
#define GL_DMA(n_, bufo_) do { const int nn_ = dir ? 63 - (n_) : (n_); const size_t tb_ = (size_t)(b * SEQ + nn_ * 64); \
        _Pragma("unroll") for (int jj_ = 0; jj_ < 5; ++jj_) { const int k_ = wave + 8 * jj_; if (k_ < 34) { \
            const char* src_ = k_ < 13 ? qtb + tb_ * 768 : (k_ < 26 ? ktb + tb_ * 768 : (k_ < 33 ? vtb + tb_ * 2 : deb + (size_t)nn_ * 384)); \
            __builtin_amdgcn_global_load_lds((const unsigned*)(src_ + off[jj_]), (LAS unsigned*)(L + (bufo_) + k_ * 1024), 16, 0, 0); } } } while (0)
    constexpr int GL_SB = 3 * GL_BUF;
    int oT[3]; bool oV[3];
#pragma unroll
    for (int j = 0; j < 3; ++j) { if (wave < 4) { oT[j] = (j == 0) ? wave : (j == 1 ? 6 + wave : 6 * (wave >> 1) + 4 + (wave & 1)); oV[j] = true; } else { const int w4 = wave - 4; oV[j] = (j == 0) || (j == 1 && w4 < 2); oT[j] = (j == 1 && w4 < 2) ? 16 + w4 : 12 + w4; } }
    const unsigned vmsk = 0u - (unsigned)((wave >> 1) & 1 & (wave < 4 ? 1 : 0));
    f32x4 So[3];
#pragma unroll
    for (int j = 0; j < 3; ++j) So[j] = (f32x4){0.f, 0.f, 0.f, 0.f};
    unsigned kmw[2][4];
#pragma unroll
    for (int kk = 0; kk < 2; ++kk)
#pragma unroll
        for (int w2 = 0; w2 < 4; ++w2) { const int tp = 2 * kk + (w2 >> 1), i0 = 2 * (w2 & 1), c = 16 * ct + qi, cp = 16 * tp + 4 * g + i0;
            const bool k0 = dir ? (cp > c) : (cp <= c), k1 = dir ? (cp + 1 > c) : (cp + 1 <= c); kmw[kk][w2] = (k0 ? 0x0000ffffu : 0u) | (k1 ? 0xffff0000u : 0u); }
    for (int i = TID(); i < 18 * 512 / 8; i += NTHR) *(LAS v2u*)(L + GL_SB + i * 8) = (v2u){0u, 0u};
    GL_DMA(0, 0); GL_DMA(1, GL_BUF);
    asm volatile("s_waitcnt vmcnt(0) lgkmcnt(0)\n\ts_barrier" ::: "memory");
    int bo = 0, bo2 = 2 * GL_BUF;
    f32x4 cv[8], cg[2];
#pragma unroll
    for (int j = 0; j < 8; ++j) cv[j] = (f32x4){0.f, 0.f, 0.f, 0.f};
    cg[0] = cv[0]; cg[1] = cv[0];
    LAS unsigned* CT = (LAS unsigned*)(L + GL_SB + 18432 + wave * 2304);
#pragma unroll 1
    for (int n = 0; n < 64; ++n) {
        LAS unsigned char* Bf = L + bo;
        const LAS unsigned char* SBr = L + GL_SB + (n & 1) * 9216; LAS unsigned char* SBw = L + GL_SB + ((n + 1) & 1) * 9216;
        bf16x8 qf[3], kf[4][3], qp[3], vf[2][2], sf[2][3];
#pragma unroll
        for (int ks = 0; ks < 3; ++ks) qf[ks] = *(const LAS bf16x8*)(Bf + GL_QT + (16 * ct + qi) * 208 + (32 * ks + 8 * g) * 2);
#pragma unroll
        for (int tp = 0; tp < 4; ++tp)
#pragma unroll
            for (int ks = 0; ks < 3; ++ks) kf[tp][ks] = *(const LAS bf16x8*)(Bf + GL_KT + (16 * tp + qi) * 208 + (32 * ks + 8 * g) * 2);
#pragma unroll
        for (int kk = 0; kk < 3; ++kk) { const LAS unsigned char* qr = Bf + GL_QT + (16 * ct + qi) * 208 + (32 * kk + 4 * g) * 2;
            const s16x4 a0 = *(const LAS s16x4*)qr, a1 = *(const LAS s16x4*)(qr + 32); qp[kk] = __builtin_shufflevector(a0, a1, 0, 1, 2, 3, 4, 5, 6, 7); }
#pragma unroll
        for (int vi = 0; vi < 2; ++vi) { const int vt = vh ? 2 : vi;
#pragma unroll
            for (int kk = 0; kk < 2; ++kk) { const LAS unsigned char* vr = Bf + GL_VT + (16 * vt + qi) * 144 + (32 * kk + 4 * g) * 2;
                const s16x4 a0 = *(const LAS s16x4*)vr, a1 = *(const LAS s16x4*)(vr + 32); vf[vi][kk] = __builtin_shufflevector(a0, a1, 0, 1, 2, 3, 4, 5, 6, 7); }
#pragma unroll
            for (int kk = 0; kk < 3; ++kk) { const LAS unsigned char* sr = SBr + (vt * 6 + 2 * kk) * 512 + lane * 8;
                const s16x4 a0 = *(const LAS s16x4*)sr, a1 = *(const LAS s16x4*)(sr + 512); sf[vi][kk] = __builtin_shufflevector(a0, a1, 0, 1, 2, 3, 4, 5, 6, 7); } }
        __builtin_amdgcn_sched_barrier(0);
        f32x4 am[4];
#pragma unroll
        for (int tp = 0; tp < 4; ++tp) {
            f32x4 z = {0.f, 0.f, 0.f, 0.f};
#pragma unroll
            for (int ks = 0; ks < 3; ++ks) z = __builtin_amdgcn_mfma_f32_16x16x32_bf16(kf[tp][ks], qf[ks], z, 0, 0, 0);
            am[tp] = z;
        }
        asm volatile("s_waitcnt vmcnt(0)" ::: "memory");
        f32x4 dec[3]; bf16x8 kdf[3][2];
#pragma unroll
        for (int j = 0; j < 3; ++j) { const int T = oT[j], vt = T / 6, dt = T - 6 * vt;
            dec[j] = *(const LAS f32x4*)(Bf + GL_DEC + (16 * dt + 4 * g) * 4);
#pragma unroll
            for (int ks = 0; ks < 2; ++ks) {
                const LAS unsigned char* kr = Bf + GL_KT + (32 * ks + 4 * g + (qi >> 2)) * 208 + (16 * dt + 4 * (qi & 3)) * 2;
                const s16x4 a0 = __builtin_amdgcn_ds_read_tr16_b64_v4i16((LAS s16x4*)kr), a1 = __builtin_amdgcn_ds_read_tr16_b64_v4i16((LAS s16x4*)(kr + 16 * 208));
                kdf[j][ks] = __builtin_shufflevector(a0, a1, 0, 1, 2, 3, 4, 5, 6, 7); } }
        __builtin_amdgcn_sched_barrier(0);
        if (((n & 3) == 1) && (n < 57)) {
            const int id = F.gw + 2048 * (n >> 2), e = id / 3584, r2 = id - e * 3584, wh = r2 / 1792, it2 = r2 - wh * 1792, kb = it2 / 112, nb = it2 - kb * 112, n0 = nb * 32;
            unsigned char* dst = c8 + (size_t)e * 7168 * 1024 + (size_t)((n0 >> 7) * 256 + wh * 128 + (n0 & 127)) * 1024 + kb * 64;
            const int nq = lane & 7, kr = lane >> 3;
#pragma unroll
            for (int p = 0; p < 2; ++p) { const f32x4 gq = cg[p] * 32.0f;
                const f32x4 a = cv[4 * p], b2 = cv[4 * p + 1], c2 = cv[4 * p + 2], d2 = cv[4 * p + 3]; LAS unsigned* t = CT + (4 * nq) * 17 + 8 * p + kr;
                t[0] = pk4_fp8(a.x * gq[0], b2.x * gq[1], c2.x * gq[2], d2.x * gq[3]); t[17] = pk4_fp8(a.y * gq[0], b2.y * gq[1], c2.y * gq[2], d2.y * gq[3]);
                t[34] = pk4_fp8(a.z * gq[0], b2.z * gq[1], c2.z * gq[2], d2.z * gq[3]); t[51] = pk4_fp8(a.w * gq[0], b2.w * gq[1], c2.w * gq[2], d2.w * gq[3]); }
            LDS_WAIT(); asm volatile("" ::: "memory");
#pragma unroll
            for (int r = 0; r < 2; ++r) { const int nn2 = (lane >> 2) + 16 * r, c4 = lane & 3; const LAS unsigned* sp = CT + nn2 * 17 + 4 * c4;
                v4u o; o.x = sp[0]; o.y = sp[1]; o.z = sp[2]; o.w = sp[3];
                *(GAS v4u*)(dst + (size_t)nn2 * 1024 + 16 * c4) = o; }
        }
        { const int n2 = n + 2 < 64 ? n + 2 : 63; GL_DMA(n2, bo2); }
        const bool cld = ((n & 3) == 0) && (n < 56);
        if (cld) {
            const int id = F.gw + 2048 * (n >> 2), e = id / 3584, r2 = id - e * 3584, wh = r2 / 1792, it2 = r2 - wh * 1792, kb = it2 / 112, nb = it2 - kb * 112;
            const float* p = (wh ? cwu : cwg) + (size_t)e * 1024 * FFE + (size_t)(kb * 64 + 4 * (lane >> 3)) * FFE + nb * 32 + 4 * (lane & 7);
#pragma unroll
            for (int j = 0; j < 8; ++j) cv[j] = *(const f32x4*)(p + (size_t)(32 * (j >> 2) + (j & 3)) * FFE);
            cg[0] = *(const f32x4*)(cgain + kb * 64 + 4 * (lane >> 3)); cg[1] = *(const f32x4*)(cgain + kb * 64 + 32 + 4 * (lane >> 3));
        }
        __builtin_amdgcn_sched_barrier(0);
        bf16x8 pf[2];
#pragma unroll
        for (int kk = 0; kk < 2; ++kk) { v4u w; w.x = pk2(am[2 * kk][0], am[2 * kk][1]) & kmw[kk][0]; w.y = pk2(am[2 * kk][2], am[2 * kk][3]) & kmw[kk][1]; w.z = pk2(am[2 * kk + 1][0], am[2 * kk + 1][1]) & kmw[kk][2]; w.w = pk2(am[2 * kk + 1][2], am[2 * kk + 1][3]) & kmw[kk][3];
            pf[kk] = __builtin_bit_cast(bf16x8, w); }
        const int nn = dir ? 63 - n : n, tok = b * SEQ + nn * 64 + 16 * ct + qi;
        f32x4 oacc[2];
#pragma unroll
        for (int vi = 0; vi < 2; ++vi) {
            f32x4 acc = {0.f, 0.f, 0.f, 0.f};
#pragma unroll
            for (int kk = 0; kk < 3; ++kk) acc = __builtin_amdgcn_mfma_f32_16x16x32_bf16(sf[vi][kk], qp[kk], acc, 0, 0, 0);
#pragma unroll
            for (int kk = 0; kk < 2; ++kk) acc = __builtin_amdgcn_mfma_f32_16x16x32_bf16(vf[vi][kk], pf[kk], acc, 0, 0, 0);
            oacc[vi] = acc;
        }
#pragma unroll
        for (int j = 0; j < 3; ++j) {
            f32x4 sv = So[j];
#pragma unroll
            for (int ks = 0; ks < 2; ++ks) { bf16x8 vop;
                if (j == 0) vop = vf[0][ks]; else if (j == 1) vop = vf[1][ks];
                else { const v4u a_ = __builtin_bit_cast(v4u, vf[0][ks]), b_ = __builtin_bit_cast(v4u, vf[1][ks]); v4u r_; r_.x = (b_.x & vmsk) | (a_.x & ~vmsk); r_.y = (b_.y & vmsk) | (a_.y & ~vmsk); r_.z = (b_.z & vmsk) | (a_.z & ~vmsk); r_.w = (b_.w & vmsk) | (a_.w & ~vmsk); vop = __builtin_bit_cast(bf16x8, r_); }
                sv = __builtin_amdgcn_mfma_f32_16x16x32_bf16(kdf[j][ks], vop, sv, 0, 0, 0); }
            sv[0] *= dec[j][0]; sv[1] *= dec[j][1]; sv[2] *= dec[j][2]; sv[3] *= dec[j][3];
            So[j] = sv;
        }
        { v2u w; w.x = pk2(oacc[0][0], oacc[0][1]); w.y = pk2(oacc[0][2], oacc[0][3]);
          *(v2u*)(O + (size_t)tok * 768 + h * 192 + vs * 48 + 16 * (vh ? 2 : 0) + 4 * g) = w; }
        if (vh == 0) { v2u w; w.x = pk2(oacc[1][0], oacc[1][1]); w.y = pk2(oacc[1][2], oacc[1][3]);
          *(v2u*)(O + (size_t)tok * 768 + h * 192 + vs * 48 + 16 + 4 * g) = w; }
#pragma unroll
        for (int j = 0; j < 3; ++j) if (oV[j]) { v2u w; w.x = pk2(So[j][0], So[j][1]); w.y = pk2(So[j][2], So[j][3]); *(LAS v2u*)(SBw + oT[j] * 512 + lane * 8) = w; }
        asm volatile("s_waitcnt lgkmcnt(0)\n\ts_barrier" ::: "memory");
        { const int t_ = bo; bo = (bo == 2 * GL_BUF) ? 0 : bo + GL_BUF; bo2 = t_; }
    }
    __syncthreads();
#undef GL_DMA
}

__device__ __forceinline__ void finalize_rstd(const Frame& F, const float* rss, float* rstd) {
    for (int row = F.bid * NTHR + TID(); row < NT; row += F.G * NTHR) rstd[row] = rstd_from(rss + (size_t)row * 16);
}
__device__ __forceinline__ void gla_combine(const Frame& F, const bf16* OF, const bf16* OB, const bf16* act1, const float* gnorm, bf16* mix) {
    const int lane = LANE(), h = lane >> 4, c0 = h * 192 + 12 * (lane & 15);
    float gn[12];
#pragma unroll
    for (int j = 0; j < 12; ++j) gn[j] = gnorm[12 * (lane & 15) + j];
    for (int token = F.gw; token < NT; token += 2 * F.NGW) {
        const int tb = token + F.NGW; const bool hb = tb < NT; const int t2 = hb ? tb : token;
        v2u fa[3], ba[3], ga[3], fb[3], bb[3], gb[3];
#pragma unroll
        for (int j = 0; j < 3; ++j) { fa[j] = *(const v2u*)(OF + (size_t)token * 768 + c0 + 4 * j); ba[j] = *(const v2u*)(OB + (size_t)token * 768 + c0 + 4 * j); ga[j] = *(const v2u*)(act1 + (size_t)token * A1_LD + 768 + c0 + 4 * j); }
#pragma unroll
        for (int j = 0; j < 3; ++j) { fb[j] = *(const v2u*)(OF + (size_t)t2 * 768 + c0 + 4 * j); bb[j] = *(const v2u*)(OB + (size_t)t2 * 768 + c0 + 4 * j); gb[j] = *(const v2u*)(act1 + (size_t)t2 * A1_LD + 768 + c0 + 4 * j); }
        float oa[12], ob[12], sa = 0.f, sb = 0.f;
#pragma unroll
        for (int j = 0; j < 3; ++j) {
            oa[4 * j] = bflo(fa[j].x) + bflo(ba[j].x); oa[4 * j + 1] = bfhi(fa[j].x) + bfhi(ba[j].x); oa[4 * j + 2] = bflo(fa[j].y) + bflo(ba[j].y); oa[4 * j + 3] = bfhi(fa[j].y) + bfhi(ba[j].y);
            ob[4 * j] = bflo(fb[j].x) + bflo(bb[j].x); ob[4 * j + 1] = bfhi(fb[j].x) + bfhi(bb[j].x); ob[4 * j + 2] = bflo(fb[j].y) + bflo(bb[j].y); ob[4 * j + 3] = bfhi(fb[j].y) + bfhi(bb[j].y); }
#pragma unroll
        for (int j = 0; j < 12; ++j) { sa += oa[j] * oa[j]; sb += ob[j] * ob[j]; }
#pragma unroll
        for (int o = 1; o < 16; o <<= 1) { sa += __shfl_xor(sa, o); sb += __shfl_xor(sb, o); }
        const float ra = __builtin_amdgcn_rsqf(sa * (1.0f / 192.0f) + EPS), rb = __builtin_amdgcn_rsqf(sb * (1.0f / 192.0f) + EPS);
#pragma unroll
        for (int j = 0; j < 3; ++j) {
            const float g0 = bflo(ga[j].x), g1 = bfhi(ga[j].x), g2 = bflo(ga[j].y), g3 = bfhi(ga[j].y);
            v2u w; w.x = pk2(oa[4 * j] * ra * gn[4 * j] * g0 * __builtin_amdgcn_rcpf(1.0f + __expf(-g0)), oa[4 * j + 1] * ra * gn[4 * j + 1] * g1 * __builtin_amdgcn_rcpf(1.0f + __expf(-g1)));
            w.y = pk2(oa[4 * j + 2] * ra * gn[4 * j + 2] * g2 * __builtin_amdgcn_rcpf(1.0f + __expf(-g2)), oa[4 * j + 3] * ra * gn[4 * j + 3] * g3 * __builtin_amdgcn_rcpf(1.0f + __expf(-g3)));
            *(v2u*)(mix + (size_t)token * DM + c0 + 4 * j) = w; }
        if (hb) {
#pragma unroll
            for (int j = 0; j < 3; ++j) {
                const float g0 = bflo(gb[j].x), g1 = bfhi(gb[j].x), g2 = bflo(gb[j].y), g3 = bfhi(gb[j].y);
                v2u w; w.x = pk2(ob[4 * j] * rb * gn[4 * j] * g0 * __builtin_amdgcn_rcpf(1.0f + __expf(-g0)), ob[4 * j + 1] * rb * gn[4 * j + 1] * g1 * __builtin_amdgcn_rcpf(1.0f + __expf(-g1)));
                w.y = pk2(ob[4 * j + 2] * rb * gn[4 * j + 2] * g2 * __builtin_amdgcn_rcpf(1.0f + __expf(-g2)), ob[4 * j + 3] * rb * gn[4 * j + 3] * g3 * __builtin_amdgcn_rcpf(1.0f + __expf(-g3)));
                *(v2u*)(mix + (size_t)tb * DM + c0 + 4 * j) = w; } }
    }
}
__device__ __forceinline__ void route_pick(const float (&acc)[8], int token, int* topi, float* topw, LAS int* lc) {
    int e0 = 0; float l0 = acc[0];
#pragma unroll
    for (int e = 1; e < 8; ++e) if (acc[e] > l0) { l0 = acc[e]; e0 = e; }
    int e1 = -1; float l1 = -INFINITY;
#pragma unroll
    for (int e = 0; e < 8; ++e) if (e != e0 && acc[e] > l1) { l1 = acc[e]; e1 = e; }
    if (e1 < 0) { e1 = (e0 + 1) & 7; l1 = l0; }
    const float w0 = 1.0f / (1.0f + __expf(l1 - l0));
    topi[token] = e0 | (e1 << 8); topw[2 * token] = w0; topw[2 * token + 1] = 1.0f - w0;
    atomicAdd((int*)&lc[e0], 1); atomicAdd((int*)&lc[8 + e1], 1);
}
__device__ __forceinline__ void route1(const Frame& F, const bf16* H, const float* gain, const float* wr, int* topi, float* topw, int* cnt, float* rstd) {
    LAS int* lc = (LAS int*)F.lds;
    if (TID() < 16) lc[TID()] = 0;
    __syncthreads();
    const int lane = LANE();
    float w[4][4][8];
#pragma unroll
    for (int j = 0; j < 4; ++j) { const f32x4 g = *(const f32x4*)(gain + 256 * j + 4 * lane);
#pragma unroll
        for (int i = 0; i < 4; ++i) { const float* p = wr + (size_t)(256 * j + 4 * lane + i) * 8; const f32x4 a = *(const f32x4*)p, b = *(const f32x4*)(p + 4); const float gi = g[i];
            w[j][i][0] = a.x * gi; w[j][i][1] = a.y * gi; w[j][i][2] = a.z * gi; w[j][i][3] = a.w * gi; w[j][i][4] = b.x * gi; w[j][i][5] = b.y * gi; w[j][i][6] = b.z * gi; w[j][i][7] = b.w * gi; } }
    for (int t2 = 0; t2 < 16; t2 += 2) {
        const int token = F.bid * 128 + F.wave * 16 + t2;
        const v2u* h0 = (const v2u*)(H + (size_t)token * DM) + lane; const v2u* h1 = h0 + DM / 4;
        f32x4 x0[4], x1[4];
#pragma unroll
        for (int j = 0; j < 4; ++j) { const v2u p = h0[64 * j], q = h1[64 * j]; x0[j] = (f32x4){bflo(p.x), bfhi(p.x), bflo(p.y), bfhi(p.y)}; x1[j] = (f32x4){bflo(q.x), bfhi(q.x), bflo(q.y), bfhi(q.y)}; }
        float a0[8], a1[8], s0 = 0.f, s1 = 0.f;
#pragma unroll
        for (int e = 0; e < 8; ++e) { a0[e] = 0.f; a1[e] = 0.f; }
#pragma unroll
        for (int j = 0; j < 4; ++j)
#pragma unroll
            for (int i = 0; i < 4; ++i) { const float u = x0[j][i], v = x1[j][i]; s0 += u * u; s1 += v * v;
#pragma unroll
                for (int e = 0; e < 8; ++e) { a0[e] += u * w[j][i][e]; a1[e] += v * w[j][i][e]; } }
        s0 = wave_sum(s0); s1 = wave_sum(s1);
        const float r0 = 1.0f / sqrtf(s0 * (1.0f / DM) + EPS), r1 = 1.0f / sqrtf(s1 * (1.0f / DM) + EPS);
#pragma unroll
        for (int e = 0; e < 8; ++e) { a0[e] = wave_sum(a0[e]) * r0; a1[e] = wave_sum(a1[e]) * r1; }
        if (lane == 0) { route_pick(a0, token, topi, topw, lc); route_pick(a1, token + 1, topi, topw, lc); rstd[token] = r0; rstd[token + 1] = r1; }
    }
    __syncthreads();
    if (TID() < 16) cnt[F.bid * 16 + TID()] = lc[TID()];
    __syncthreads();
}
__device__ __forceinline__ void route2(const Frame& F, const int* topi, const float* topw, const int* cnt, int* stok, float* sw, int* blk, int* s0tab) {
    LAS int* part = (LAS int*)F.lds;
    LAS int* base = part + 1024;
    LAS int* tk = base + 64;
    const int tid = TID(), pe = tid & 15, jg = tid >> 4;
    int below = 0, tot = 0;
    for (int w = jg; w < F.G; w += 32) { const int v = cnt[w * 16 + pe]; tot += v; if (w < F.bid) below += v; }
    part[jg * 16 + pe] = below; part[512 + jg * 16 + pe] = tot;
    if (tid < 128) tk[tid] = topi[F.bid * 128 + tid];
    __syncthreads();
    if (tid < 16) { int b = 0, t = 0; for (int j = 0; j < 32; ++j) { b += part[j * 16 + tid]; t += part[512 + j * 16 + tid]; } base[tid] = b; base[16 + tid] = t; }
    __syncthreads();
    if (tid < 2) { int ps = 0; for (int e = 0; e < 8; ++e) { base[32 + tid * 8 + e] = ps; ps += (base[16 + tid * 8 + e] + 255) / 256 * 256; } base[48 + tid] = ps / 256; }
    __syncthreads();
    if (tid < 256) {
        const int p = tid >> 7, i = tid & 127; const int e = (tk[i] >> (8 * p)) & 0xff;
        int rank = 0; for (int j = 0; j < i; ++j) rank += (((tk[j] >> (8 * p)) & 0xff) == e) ? 1 : 0;
        const int slot = base[32 + p * 8 + e] + base[p * 8 + e] + rank; const int token = F.bid * 128 + i;
        stok[p * SLOT_CAP + slot] = token; sw[p * SLOT_CAP + slot] = topw[2 * token + p]; if (p == 0) s0tab[token] = slot;
    }
    if (F.bid < 16) {
        const int p = F.bid >> 3, e = F.bid & 7, ps = base[32 + F.bid], t = base[16 + F.bid], pend = ps + (t + 255) / 256 * 256;
        for (int s = ps + t + tid; s < pend; s += NTHR) { stok[p * SLOT_CAP + s] = -1; sw[p * SLOT_CAP + s] = 0.f; }
        for (int bk = ps / 256 + tid; bk < pend / 256; bk += NTHR) blk[16 + p * 256 + bk] = e;
        if (e == 0 && tid == 0) blk[p] = base[48 + p];
    }
    __syncthreads();
}
__device__ __forceinline__ void final_norm_slots(int lane, const bf16* HB, float* OUT, const bf16* YA, const int* s0tab, const bf16* Y, const bf16* Y2, const float* gain, const int* tok, int s0, int s1, int first, int stride) {
    f32x4 gv[4];
#pragma unroll
    for (int j = 0; j < 4; ++j) gv[j] = ((const f32x4*)gain + lane)[64 * j];
    for (int base = s0 + first; base < s1; base += 64 * stride) {
      const int sll = base + lane * stride; int mytok = -1; if (sll < s1) mytok = tok[sll];
      const int mys0 = s0tab[mytok < 0 ? 0 : mytok];
      const int cnt = min(64, (s1 - base + stride - 1) / stride);
      for (int i = 0; i < cnt; i += 2) {
        const int sl = base + i * stride, slb = sl + stride; const bool hb = i + 1 < cnt; const int i1 = hb ? i + 1 : i;
        const int ra = __builtin_amdgcn_readlane(mytok, i), rb = hb ? __builtin_amdgcn_readlane(mytok, i1) : -1;
        const int rowa = ra < 0 ? 0 : ra, rowb = rb < 0 ? 0 : rb;
        const v2u* xa = (const v2u*)(HB + (size_t)rowa * DM) + lane; const v2u* xb = (const v2u*)(HB + (size_t)rowb * DM) + lane;
        const v2u* ya = (const v2u*)(Y + (size_t)sl * DM) + lane; const v2u* yb = (const v2u*)(Y + (size_t)(hb ? slb : sl) * DM) + lane;
        const v2u* pa = (const v2u*)(YA + (size_t)__builtin_amdgcn_readlane(mys0, i) * DM) + lane; const v2u* pb = (const v2u*)(YA + (size_t)__builtin_amdgcn_readlane(mys0, i1) * DM) + lane;
        f32x4 va[4], vb[4]; v2u wa[4], wb[4], ua[4], ub[4], ta[4], tb[4];
#pragma unroll
        for (int j = 0; j < 4; ++j) { ua[j] = xa[64 * j]; wa[j] = ya[64 * j]; ta[j] = pa[64 * j]; }
#pragma unroll
        for (int j = 0; j < 4; ++j) { ub[j] = xb[64 * j]; wb[j] = yb[64 * j]; tb[j] = pb[64 * j]; }
#pragma unroll
        for (int j = 0; j < 4; ++j) { va[j] = (f32x4){bflo(ua[j].x) + bflo(ta[j].x), bfhi(ua[j].x) + bfhi(ta[j].x), bflo(ua[j].y) + bflo(ta[j].y), bfhi(ua[j].y) + bfhi(ta[j].y)};
            vb[j] = (f32x4){bflo(ub[j].x) + bflo(tb[j].x), bfhi(ub[j].x) + bfhi(tb[j].x), bflo(ub[j].y) + bflo(tb[j].y), bfhi(ub[j].y) + bfhi(tb[j].y)}; }
        if (Y2) {
            const v2u* za = (const v2u*)(Y2 + (size_t)(sl - s0) * DM) + lane; const v2u* zb = (const v2u*)(Y2 + (size_t)((hb ? slb : sl) - s0) * DM) + lane;
#pragma unroll
            for (int j = 0; j < 4; ++j) { const v2u p = za[64 * j], q = zb[64 * j];
                va[j].x += bflo(p.x); va[j].y += bfhi(p.x); va[j].z += bflo(p.y); va[j].w += bfhi(p.y); vb[j].x += bflo(q.x); vb[j].y += bfhi(q.x); vb[j].z += bflo(q.y); vb[j].w += bfhi(q.y); }
        }
        float sa = 0.f, sb = 0.f;
#pragma unroll
        for (int j = 0; j < 4; ++j) {
            va[j].x += bflo(wa[j].x); va[j].y += bfhi(wa[j].x); va[j].z += bflo(wa[j].y); va[j].w += bfhi(wa[j].y);
            vb[j].x += bflo(wb[j].x); vb[j].y += bfhi(wb[j].x); vb[j].z += bflo(wb[j].y); vb[j].w += bfhi(wb[j].y);
            sa += (va[j].x * va[j].x + va[j].y * va[j].y) + (va[j].z * va[j].z + va[j].w * va[j].w); sb += (vb[j].x * vb[j].x + vb[j].y * vb[j].y) + (vb[j].z * vb[j].z + vb[j].w * vb[j].w); }
        sa = wave_sum(sa); sb = wave_sum(sb);
        const float rsa = 1.0f / sqrtf(sa * (1.0f / DM) + EPS), rsb = 1.0f / sqrtf(sb * (1.0f / DM) + EPS);
        if (ra >= 0) { GAS f32x4* oa = (GAS f32x4*)(OUT + (size_t)rowa * DM) + lane;
#pragma unroll
            for (int j = 0; j < 4; ++j) { const f32x4 g = gv[j]; oa[64 * j] = (f32x4){va[j].x * rsa * g.x, va[j].y * rsa * g.y, va[j].z * rsa * g.z, va[j].w * rsa * g.w}; } }
        if (rb >= 0) { GAS f32x4* ob = (GAS f32x4*)(OUT + (size_t)rowb * DM) + lane;
#pragma unroll
            for (int j = 0; j < 4; ++j) { const f32x4 g = gv[j]; ob[64 * j] = (f32x4){vb[j].x * rsb * g.x, vb[j].y * rsb * g.y, vb[j].z * rsb * g.z, vb[j].w * rsb * g.w}; } }
      }
    }
}
__device__ __forceinline__ void final_norm(const Frame& F, float* H, const float* gain) {
    for (int row = F.gw; row < NT; row += F.NGW) {
        GAS f32x4* xr = (GAS f32x4*)(H + (size_t)row * DM) + LANE(); const f32x4* gr = (const f32x4*)gain + LANE();
        f32x4 v[4]; float s = 0.f;
#pragma unroll
        for (int j = 0; j < 4; ++j) { v[j] = xr[64 * j]; s += (v[j].x * v[j].x + v[j].y * v[j].y) + (v[j].z * v[j].z + v[j].w * v[j].w); }
        s = wave_sum(s); const float rs = 1.0f / sqrtf(s * (1.0f / DM) + EPS);
#pragma unroll
        for (int j = 0; j < 4; ++j) { const f32x4 g = gr[64 * j]; f32x4 o = {v[j].x * rs * g.x, v[j].y * rs * g.y, v[j].z * rs * g.z, v[j].w * rs * g.w}; xr[64 * j] = o; }
    }
}

constexpr int N_PHASES = 17;
__global__ void __launch_bounds__(NTHR, 2) mega(Args args) {
    extern __shared__ __attribute__((aligned(16))) unsigned char lds_raw[];
    Frame F;
    F.lds = (LAS unsigned char*)lds_raw;
    F.wave = __builtin_amdgcn_readfirstlane((int)(threadIdx.x >> 6));
    F.G = gridDim.x; F.bid = blockIdx.x; F.gw = F.bid * NWAVES + F.wave; F.NGW = F.G * NWAVES; F.ws = args.ws;
    unsigned char* ws = args.ws;
    gu32* ctl = (gu32*)(ws + WS_CTL);
    volatile LAS unsigned* MISC = (volatile LAS unsigned*)(F.lds + MISC_OFF);
    for (int u = TID(); u < (LDS_BYTES - LDSCTL_OFF) / 4; u += NTHR) ((LAS unsigned*)(F.lds + LDSCTL_OFF))[u] = 0u;
    __syncthreads();
    XcdBarrier bar = xcd_barrier_post((unsigned*)(ctl + CW_BAR), MISC + 8, F.wave);
    const int lo = args.ph_lo, hi = args.ph_hi;
#ifndef PH_MASK
#define PH_MASK 0x1ffff
#endif
#define IN(k) (((PH_MASK >> (k)) & 1) && lo <= (k) && (k) < hi)
#ifndef REPEAT_MASK
#define REPEAT_MASK 0
#endif
#define REPS(k) (1 + ((REPEAT_MASK >> (k)) & 1))
#define SEAM(k) do { if (IN(k) && IN((k) + 1)) xcd_barrier(bar); } while (0)

    float* H = args.out;
    bf16* x3 = (bf16*)args.out;
    float* rss = (float*)(ws + WS_RSS); float* rstd = (float*)(ws + WS_RSTD);
    bf16* hbf = (bf16*)(ws + WS_HBF); bf16* membf = (bf16*)(ws + WS_MEMBF); bf16* memk = (bf16*)(ws + WS_MEMK); bf16* memvt = (bf16*)(ws + WS_MEMVT);
    bf16* act0 = (bf16*)(ws + WS_ACT0); bf16* v0t = (bf16*)(ws + WS_V0T); bf16* mix = (bf16*)(ws + WS_MIX); bf16* hmid0 = (bf16*)(ws + WS_HMID0);
    bf16* act1 = (bf16*)(ws + WS_ACT1); bf16* v1t = (bf16*)(ws + WS_V1T); bf16* OF = (bf16*)(ws + WS_OF); bf16* OB = (bf16*)(ws + WS_OB);
    bf16* hmid1 = (bf16*)(ws + WS_HMID1); bf16* wgu = (bf16*)((unsigned char*)args.out + OUT_WGU); bf16* wdn = (bf16*)(ws + WS_WDN);
    int* cnt = (int*)(ws + WS_CNT); int* topi = (int*)(ws + WS_TOPI); float* topw = (float*)(ws + WS_TOPW);
    int* stok = (int*)(ws + WS_STOK); float* sw = (float*)(ws + WS_SW); int* blk = (int*)(ws + WS_BLK);
    LAS float* scr = (LAS float*)(F.lds + F.wave * 16384);

    if (IN(0)) {
        int it = F.gw; LAS unsigned* T0 = (LAS unsigned*)scr; LAS unsigned* T1 = T0 + 1088;
#define CVT(Wp, Kd, Nd, WTp, gainp, kind) do { const CvtJob J{Wp, Kd, Nd, (bf16*)(WTp), gainp, kind}; const int n_ = ((Kd) / 64) * ((Nd) / 32); \
            while (it < n_) { CvtRegs A_, B_; B_.valid = 0; cvt_load(A_, J, it, LANE()); it += F.NGW; if (it < n_) { cvt_load(B_, J, it, LANE()); it += F.NGW; } cvt_finish(A_, T0, LANE()); cvt_finish(B_, T1, LANE()); } \
            it -= n_; } while (0)
        CVT(args.in[I_EWIN], 1024, 2560, ws + WS_W0IN, args.in[I_EN1], 1);
        CVT(args.in[I_EWIN], 1024, 2560, ws + WS_WV0, args.in[I_EN1], 2);
        CVT(args.in[I_EWOUT], 1024, 1024, ws + WS_W0OUT, nullptr, 0);
        CVT(args.in[I_EWG], 1024, 2816, ws + WS_W0GU, args.in[I_EN2], 3);
        CVT(args.in[I_EWU], 1024, 2816, ws + WS_W0GU, args.in[I_EN2], 4);
        CVT(args.in[I_EWD], 2816, 1024, ws + WS_W0DN, nullptr, 0);
        CVT(args.in[I_WMKV], 1024, 512, ws + WS_WMEM, args.in[I_MNORM], 0);
        CVT(args.in[I_OWIN], 1024, 2592, ws + WS_W1IN, args.in[I_ON1], 5);
        CVT(args.in[I_OWIN], 1024, 2592, ws + WS_WV1, args.in[I_ON1], 6);
        CVT(args.in[I_OWOUT], 1024, 1024, ws + WS_W1OUT, nullptr, 0);
#undef CVT
        { v4u z = {0u, 0u, 0u, 0u}; v4u* p = (v4u*)(ws + WS_W1IN + (size_t)1824 * 2048); const int n16 = 224 * 2048 / 16;
          for (int i = F.bid * NTHR + TID(); i < n16; i += F.G * NTHR) p[i] = z; }
        { float* rp2 = (float*)(ws + WS_RPB2); for (int i2 = F.bid * NTHR + TID(); i2 < 12 * 480; i2 += F.G * NTHR) { const int hh = i2 / 480, jj = i2 - 480 * hh; rp2[i2] = jj < 465 ? args.in[I_RPB][hh * 465 + jj] * 1.4426950408889634f : 0.f; } }
        rows_to_bf16(args.in[I_X], hbf, rstd, F.gw, NT, F.NGW, LANE());
        rows_to_bf16(args.in[I_MEM], membf, rstd + NT, F.gw, MEM_ROWS, F.NGW, LANE());
    }
    SEAM(0);
    if (IN(1)) {
        { Sched S; S.init(hbf, ws + WS_W0IN, 1024, 128, 7, F.G, F.bid); EpiRowScale E{act0, A0_LD, rstd, 1.0f}; gemm_run<EpiRowScale, false>(F.lds, S, E, nullptr, F.wave); }
        { Sched S; S.init(ws + WS_WV0, hbf, 1024, 3, 128, F.G, (F.bid + 128) % F.G); EpiColScale E{v0t, NT, rstd}; gemm_run<EpiColScale, false>(F.lds, S, E, nullptr, F.wave); }
        for (int it = F.gw; it < 2048; it += F.NGW) memkv_item(it, LANE(), membf, (const bf16*)(ws + WS_WMEM), rstd + NT, memk, memvt);
    }
    SEAM(1);
    if (IN(2)) {
        { na_phase(F, act0, v0t, (const float*)(ws + WS_RPB2), mix);
          for (int it = F.bid; it < 512; it += F.G) memattn_strip(F, it, act0, A0_LD, 1536, memk, memvt, mix);
          __syncthreads(); }
    }
    SEAM(2);
    if (IN(3)) {
        Sched S; S.init(mix, ws + WS_W0OUT, 1024, 128, 4, F.G, F.bid); EpiResid<true> E{args.in[I_X], hbf, rss, nullptr}; gemm_run<EpiResid<true>, false>(F.lds, S, E, nullptr, F.wave);
    }
    SEAM(3);
    if (IN(4)) {
        Sched S; S.init(hbf, ws + WS_W0GU, 1024, 128, 22, F.G, F.bid); EpiSwiGLU<false, true> E{hmid0, FF0, rss, nullptr}; gemm_run<EpiSwiGLU<false, true>, false>(F.lds, S, E, nullptr, F.wave);
    }
    SEAM(4);
    if (IN(5)) {
        Sched S; S.init(hmid0, ws + WS_W0DN, FF0, 128, 4, F.G, F.bid); EpiResid<false> E{nullptr, hbf, rss, nullptr}; gemm_run<EpiResid<false>, false>(F.lds, S, E, nullptr, F.wave);
    }
    SEAM(5);
    if (IN(6)) {
        { Sched S; S.init(hbf, ws + WS_W1IN, 1024, 128, 8, F.G, F.bid); EpiRowScaleT<true> E{act1, A1_LD, rss, 1.0f}; gemm_run<EpiRowScaleT<true>, false>(F.lds, S, E, nullptr, F.wave); }
        { Sched S; S.init(ws + WS_WV1, hbf, 1024, 3, 128, F.G, F.bid); EpiColScaleT<true> E{v1t, NT, rss}; gemm_run<EpiColScaleT<true>, false>(F.lds, S, E, nullptr, F.wave); }
    }
    SEAM(6);
    if (IN(7)) {
        bf16x8 gwf[3]; float gbi[3]; int gdir = -1;
        for (int it = F.bid; it < 1024; it += F.G) { const int dir = (it >> 6) & 1;
            if (dir != gdir) { gla_pre_w(F.wave, LANE(), dir ? args.in[I_WGKB] : args.in[I_WGKF], dir ? args.in[I_BGKB] : args.in[I_BGKF], gwf, gbi); gdir = dir; }
            gla_pre_item(F, it, act1, gwf, gbi, (bf16*)(ws + WS_GQT) + (size_t)dir * NT * 384, (bf16*)((unsigned char*)args.out + OUT_GKT) + (size_t)dir * NT * 384,
                         (float*)((unsigned char*)args.out + OUT_GDEC) + (size_t)dir * 8 * 4 * 64 * 96); }
        for (int it = F.bid; it < 512; it += F.G) memattn_strip(F, it, act1, A1_LD, 1536, memk, memvt, mix);
        xcd_barrier(bar);
        for (int it0 = F.bid; it0 < 256; it0 += F.G) { const int it = (F.G == 256) ? ((it0 & 7) * 8 + (it0 >> 5)) * 4 + ((it0 >> 3) & 3) : it0;
            gla_main_item(F, it, (const bf16*)(ws + WS_GQT), (const bf16*)((unsigned char*)args.out + OUT_GKT), (const float*)((unsigned char*)args.out + OUT_GDEC), v1t, OF, OB, args.in[I_OWG], args.in[I_OWU], args.in[I_ON2], (unsigned char*)wgu); }
    }
    SEAM(7);
    if (IN(8)) gla_combine(F, OF, OB, act1, args.in[I_GNORM], mix);
    SEAM(8);
    if (IN(9)) {
        Sched S; S.init(mix, ws + WS_W1OUT, 1024, 128, 4, F.G, F.bid); EpiResid<false> E{nullptr, hbf, rss, x3}; gemm_run<EpiResid<false>, false>(F.lds, S, E, nullptr, F.wave);
    }
    SEAM(9);
    if (IN(10)) {
        route1(F, hbf, args.in[I_ON2], args.in[I_WR], topi, topw, cnt, rstd);
    }
    SEAM(10);
    if (IN(11)) {
        route2(F, topi, topw, cnt, stok, sw, blk, (int*)(ws + WS_S0TAB));
        { LAS unsigned* T0 = (LAS unsigned*)scr; LAS unsigned* T1 = T0 + 1088;
#define MOE_JOB(J_, it_) const int e_##J_ = (it_) / 1792; \
            const CvtJob J_{args.in[I_OWD] + (size_t)e_##J_ * FFE * 1024, FFE, 1024, (bf16*)((unsigned char*)wdn + (size_t)e_##J_ * 1024 * FFE), nullptr, 0}
          for (int it = F.gw; it < 8 * 1792; it += 2 * F.NGW) {
            CvtRegs A_, B_; B_.valid = 0;
            { MOE_JOB(Ja, it); cvt_load8(A_, Ja, it % 1792, LANE()); }
            if (it + F.NGW < 8 * 1792) { MOE_JOB(Jb, it + F.NGW); cvt_load8(B_, Jb, (it + F.NGW) % 1792, LANE()); }
            cvt_finish8(A_, T0, LANE(), 32.0f); cvt_finish8(B_, T1, LANE(), 32.0f);
          }
#undef MOE_JOB
        }
    }
    SEAM(11);
    bf16* ht0 = (bf16*)((unsigned char*)hmid1 + (size_t)NT * FFE); bf16* ht1 = (bf16*)(ws + WS_HT1);
    constexpr int KG = 512, KD = FFE / 2; constexpr size_t ESG = (size_t)7168 * 1024, ESD = (size_t)1024 * FFE;
    if (IN(12)) {
        const int nb = blk[0]; Sched S; S.init(x3, wgu, KG, nb, 28, F.G, F.bid, blk + 16, ESG); EpiSwiGLU<true> E{hmid1, FFE, rstd, ht0}; gemm_run<EpiSwiGLU<true>, true, true>(F.lds, S, E, stok, F.wave);
    }
    SEAM(12);
    if (IN(13)) {
        const int nb = blk[0], nbm = nb < 128 ? nb : 128; Sched S; S.init(hmid1, wdn, KD, nbm, 4, F.G, F.bid, blk + 16, ESD); EpiRowScale E{(bf16*)(ws + WS_YA), DM, sw, 0.03125f}; gemm_run<EpiRowScale, false, true>(F.lds, S, E, nullptr, F.wave);
    }
    SEAM(13);
    if (IN(14)) {
        const int nb = blk[1], nb0 = blk[0], rfull = (nb * 28 / F.G > 3) ? nb * 28 / F.G - 3 : 0, per = F.G / 8;
        { Sched S; S.init(x3, wgu, KG, nb, 28, F.G, F.bid, blk + 16 + 256, ESG); S.range(0, rfull * per, per);
          EpiSwiGLU<true> E{hmid1, FFE, rstd, ht1}; gemm_run<EpiSwiGLU<true>, true, true>(F.lds, S, E, stok + SLOT_CAP, F.wave); }
        { Sched S; S.init(x3, wgu, KG, nb, 28, F.G, F.bid, blk + 16 + 256, ESG); S.range(rfull * per, 0x7fffffff, per - 4);
          EpiSwiGLU<true> E{hmid1, FFE, rstd, ht1}; gemm_run<EpiSwiGLU<true>, true, true>(F.lds, S, E, stok + SLOT_CAP, F.wave); }
        if (F.bid / 8 >= per - 4 && nb0 > 128) {
            Sched S; S.init(ht0, wdn, KD, nb0 - 128, 4, 32, (F.bid / 8 - (per - 4)) * 8 + F.bid % 8, blk + 16 + 128, ESD);
            EpiRowScale E{(bf16*)(ws + WS_YA) + (size_t)NT * DM, DM, sw + NT, 0.03125f}; gemm_run<EpiRowScale, false, true>(F.lds, S, E, nullptr, F.wave); }
    }
    SEAM(14);
    if (IN(15)) {
        const int nb = blk[1], nbm = nb < 128 ? nb : 128; Sched S; S.init(hmid1, wdn, KD, nbm, 4, F.G, F.bid, blk + 16 + 256, ESD); EpiRowScale E{(bf16*)(ws + WS_YB), DM, sw + SLOT_CAP, 0.03125f}; gemm_run<EpiRowScale, false, true>(F.lds, S, E, nullptr, F.wave);
    }
    SEAM(15);
    if (IN(16)) {
        const int nb = blk[1], per = F.G / 8, nmain = (nb < 128 ? nb : 128) * 256;
        bf16* yb = (bf16*)(ws + WS_YB); bf16* yb2 = yb + (size_t)SLOT_CAP * DM;
        if (F.bid / 8 >= per - 4) {
            if (nb > 128) {
                const int sl = F.bid / 8 - (per - 4), kh = sl >> 1;
                Sched S; S.init((const bf16*)ht1 + kh * (KD / 2), (const bf16*)wdn + kh * (KD / 2), KD / 2, nb - 128, 4, 16, (sl & 1) * 8 + F.bid % 8, blk + 16 + 256 + 128, ESD); S.ld = KD;
                EpiRowScale E{kh ? yb2 : yb + (size_t)NT * DM, DM, sw + SLOT_CAP + NT, 0.03125f}; gemm_run<EpiRowScale, false, true>(F.lds, S, E, nullptr, F.wave); }
        } else {
            const int wv = (int)(blockIdx.x * NWAVES) + F.wave;
            final_norm_slots(LANE(), hbf, H, (const bf16*)(ws + WS_YA), (const int*)(ws + WS_S0TAB), yb, nullptr, args.in[I_FNORM], stok + SLOT_CAP, 0, nmain, wv, (per - 4) * 8 * NWAVES);
        }
        xcd_barrier(bar);
        if (nb > 128) final_norm_slots(LANE(), hbf, H, (const bf16*)(ws + WS_YA), (const int*)(ws + WS_S0TAB), yb, yb2, args.in[I_FNORM], stok + SLOT_CAP, NT, nb * 256, (int)(blockIdx.x * NWAVES) + F.wave, F.NGW);
    }
#undef IN
#undef SEAM
}

extern "C" void kernel_launch(void* const* d_in, const int* in_sizes, int n_in, void* d_out, int out_size, void* d_ws, size_t ws_size, hipStream_t stream) {
    static int grid = 0;
    if (grid == 0) {
        if (n_in != 26 || out_size != NT * DM || ws_size < WS_END) { fprintf(stderr, "kernel_launch: unexpected problem (n_in %d out %d ws %zu need %zu)\n", n_in, out_size, ws_size, (size_t)WS_END); grid = -1; return; }
        int dev = 0, cus = 0, per_cu = 0;
        if (hipGetDevice(&dev) != hipSuccess || hipDeviceGetAttribute(&cus, hipDeviceAttributeMultiprocessorCount, dev) != hipSuccess) { grid = -1; return; }
        if (hipFuncSetAttribute((const void*)mega, hipFuncAttributeMaxDynamicSharedMemorySize, LDS_BYTES) != hipSuccess) { fprintf(stderr, "kernel_launch: hipFuncSetAttribute failed\n"); grid = -1; return; }
        if (hipOccupancyMaxActiveBlocksPerMultiprocessor(&per_cu, (const void*)mega, NTHR, LDS_BYTES) != hipSuccess || per_cu < 1) fprintf(stderr, "kernel_launch: occupancy query reports %d\n", per_cu);
        (void)hipGetLastError();
        if (cus < 256) { fprintf(stderr, "kernel_launch: this kernel is built for a 256-CU device (one resident workgroup per CU), found %d CUs; nothing launched\n", cus); grid = -1; return; }
        grid = 256;
    }
    if (grid < 0) return;
    if (hipMemsetAsync((char*)d_ws + WS_CTL, 0, CTL_ZERO_BYTES, stream) != hipSuccess) return;
    Args a{};
    for (int i = 0; i < 26; ++i) a.in[i] = (const float*)d_in[i];
    a.out = (float*)d_out; a.ws = (unsigned char*)d_ws;
    a.ph_lo = 0; a.ph_hi = N_PHASES;
    hipLaunchKernelGGL(mega, dim3(grid), dim3(NTHR), LDS_BYTES, stream, a);
}
```

```cpp
#include <hip/hip_runtime.h>
#include <cstdio>
#include <cstdint>


#define GAS __attribute__((address_space(1)))
#define LAS __attribute__((address_space(3)))
typedef unsigned short bf16;
typedef unsigned v4u __attribute__((ext_vector_type(4)));
typedef unsigned v2u __attribute__((ext_vector_type(2)));
typedef float f32x4 __attribute__((ext_vector_type(4)));
typedef short bf16x8 __attribute__((ext_vector_type(8)));
typedef GAS unsigned gu32;
#define RLX_AGENT __ATOMIC_RELAXED, __HIP_MEMORY_SCOPE_AGENT
#define LDS_WAIT() asm volatile("s_waitcnt lgkmcnt(0)" ::: "memory")
#define VM_WAIT() asm volatile("s_waitcnt vmcnt(0)" ::: "memory")

constexpr int NT = 32768, DM = 1024, SEQ = 4096, NB = 8;
constexpr int MEM_ROWS = 2048;
constexpr int A0_LD = 1792;
constexpr int A1_LD = 2048;
constexpr int FF0 = 2816, FFE = 3584, NEXP = 8;
constexpr int SLOT_CAP = 34816;
constexpr float EPS = 1e-6f;
constexpr int NWAVES = 8, NTHR = 512;

constexpr size_t MiB = 1u << 20;
constexpr size_t WS_CTL = 0, CTL_ZERO_BYTES = 1 * MiB;
constexpr size_t WS_RSS = 1 * MiB;
constexpr size_t WS_MRSS = 3 * MiB;
constexpr size_t WS_CNT = 3 * MiB + 256 * 1024;
constexpr size_t WS_TOPI = 3 * MiB + 512 * 1024;
constexpr size_t WS_TOPW = 3 * MiB + 768 * 1024;
constexpr size_t WS_STOK = 4 * MiB;
constexpr size_t WS_SW = 4 * MiB + 512 * 1024;
constexpr size_t WS_BLK = 5 * MiB;
constexpr size_t WS_RSTD = 5 * MiB + 64 * 1024;
constexpr size_t WS_S0TAB = 5 * MiB + 512 * 1024;
constexpr size_t WS_RPB2 = 5 * MiB + 768 * 1024;
constexpr size_t WS_W0IN = 6 * MiB;
constexpr size_t WS_WV0 = WS_W0IN + 1792 * 2048;
constexpr size_t WS_W0OUT = 11 * MiB;
constexpr size_t WS_W0GU = 13 * MiB;
constexpr size_t WS_W0DN = 24 * MiB;
constexpr size_t WS_WMEM = WS_W0DN + 1024 * 2816 * 2;
constexpr size_t WS_W1IN = 31 * MiB;
constexpr size_t WS_WV1 = 35 * MiB;
constexpr size_t WS_W1OUT = 37 * MiB - 512 * 1024;
constexpr size_t WS_HBF = 39 * MiB;
constexpr size_t WS_MEMBF = 103 * MiB;
constexpr size_t WS_MEMK = 107 * MiB;
constexpr size_t WS_MEMVT = 108 * MiB;
constexpr size_t WS_ACT = 109 * MiB;
constexpr size_t WS_ACT0 = WS_ACT;
constexpr size_t WS_V0T = WS_ACT + 112 * MiB;
constexpr size_t WS_MIX = WS_ACT + 176 * MiB;
constexpr size_t WS_HMID0 = WS_ACT;
constexpr size_t WS_ACT1 = WS_ACT;
constexpr size_t WS_V1T = WS_ACT + 128 * MiB;
constexpr size_t WS_OF = WS_ACT + 240 * MiB;
constexpr size_t WS_OB = WS_ACT + 288 * MiB;
constexpr size_t WS_GQT = WS_ACT + 336 * MiB;
constexpr size_t WS_GKDT0 = WS_ACT + 384 * MiB;
constexpr size_t WS_GKDT1 = 6 * MiB;
constexpr size_t OUT_GKT = 0, OUT_GDEC = 48 * MiB, OUT_WGU = 52 * MiB;
constexpr size_t WS_E = WS_ACT + 336 * MiB;
constexpr size_t WS_HT1 = 6 * MiB;
constexpr size_t WS_YB = WS_ACT + 240 * MiB;
constexpr size_t WS_YA = WS_ACT + 128 * MiB;
constexpr size_t WS_HMID1 = WS_ACT;
constexpr size_t WS_WGU = WS_ACT + 240 * MiB;
constexpr size_t WS_WDN = WS_ACT + 352 * MiB;
constexpr size_t WS_END = WS_ACT + 408 * MiB;
static_assert(WS_W1OUT + 2 * MiB <= WS_HBF && WS_WV1 + 768 * 2048 <= WS_W1OUT && WS_W1IN + 4 * MiB <= WS_WV1 && WS_WMEM + MiB <= WS_W1IN, "weight map");
static_assert(WS_W0GU + 11 * MiB <= WS_W0DN && WS_WV0 + 768 * 2048 <= WS_W0OUT, "weight map 2");
static_assert((size_t)SLOT_CAP * 3584 * 2 <= 240 * MiB, "hmid1");

constexpr int CW_TMO = 0, CW_CODE = 1, CW_BAR = 4096;

constexpr int RING_BYTES = 131072;
constexpr int LDSCTL_OFF = 155648, MISC_OFF = LDSCTL_OFF + 320;
constexpr int LDS_BYTES = 156672;

typedef float f32x2_t __attribute__((ext_vector_type(2)));
typedef __bf16 bf16x2_t __attribute__((ext_vector_type(2)));
__device__ __forceinline__ unsigned pk2(float lo, float hi) { const f32x2_t v = {lo, hi}; const bf16x2_t b = __builtin_convertvector(v, bf16x2_t); return __builtin_bit_cast(unsigned, b); }
__device__ __forceinline__ unsigned f2bf(float f) { return pk2(f, 0.f) & 0xffffu; }
__device__ __forceinline__ float bf2f(bf16 b) { return __builtin_bit_cast(float, (unsigned)b << 16); }
__device__ __forceinline__ float bflo(unsigned u) { return __builtin_bit_cast(float, u << 16); }
__device__ __forceinline__ float bfhi(unsigned u) { return __builtin_bit_cast(float, u & 0xffff0000u); }
__device__ __forceinline__ float wave_sum(float v) {
#pragma unroll
    for (int o = 1; o < 64; o <<= 1) v += __shfl_xor(v, o);
    return v;
}
__device__ __forceinline__ float wave_max(float v) {
#pragma unroll
    for (int o = 1; o < 64; o <<= 1) v = fmaxf(v, __shfl_xor(v, o));
    return v;
}

__device__ __forceinline__ int lane_id() { unsigned z = 0u; asm volatile("" : "+v"(z)); return (int)__builtin_amdgcn_mbcnt_hi(0xffffffffu, __builtin_amdgcn_mbcnt_lo(0xffffffffu, z)); }
#define XB_TMO      128
#define XB_XCNT(j)  (256  + 64 * (j))
#define XB_XSUB(j)  (1280 + 64 * (j))
#define XB_XGEN(j)  (2304 + 64 * (j))
#define XB_TOP      3328
#define XB_TOPGEN   3392
#define XCD_BAR_WORDS 3456
#define XB_SPIN_CAP (1u << 22)

__device__ __forceinline__ unsigned xb_ld(unsigned* p)              { return __hip_atomic_load(p, __ATOMIC_RELAXED, __HIP_MEMORY_SCOPE_AGENT); }
__device__ __forceinline__ unsigned xb_add(unsigned* p, unsigned v) { return __hip_atomic_fetch_add(p, v, __ATOMIC_RELAXED, __HIP_MEMORY_SCOPE_AGENT); }
__device__ __forceinline__ unsigned xb_xcc_id() { return (unsigned)__builtin_amdgcn_s_getreg((3 << 11) | 20) & 0xFu; }
#define XB_SPIN(cond, bar) do { unsigned _sp = 0; while (cond) { __builtin_amdgcn_s_sleep(1); \
    if ((++_sp & 255u) == 0u) { if (xb_ld(&(bar)[XB_TMO])) break; if (_sp > XB_SPIN_CAP) { atomicAdd(&(bar)[XB_TMO], 1u); break; } } } } while (0)

struct XcdBarrier { unsigned* bar; unsigned x; volatile LAS unsigned* st; int w0; };

__device__ __forceinline__ XcdBarrier xcd_barrier_post(unsigned* bar, volatile LAS unsigned* st, int wave) {
    XcdBarrier b; b.bar = bar; b.x = xb_xcc_id(); b.st = st; b.w0 = (wave == 0) ? 1 : 0;
    if (b.w0 && lane_id() == 0) (void)xb_add(&bar[XB_XCNT(b.x)], 1u);
    return b;
}
__device__ __forceinline__ void xcd_barrier_complete(unsigned* bar, unsigned x, unsigned& nloc, unsigned& nx) {
    const unsigned G = gridDim.x * gridDim.y * gridDim.z;
    unsigned sum, cnt, mine, sp = 0u;
    for (;;) {
        sum = 0u; cnt = 0u; mine = 0u;
#pragma unroll
        for (unsigned j = 0; j < 16; ++j) { const unsigned c = xb_ld(&bar[XB_XCNT(j)]); sum += c; cnt += (c > 0u) ? 1u : 0u; mine = (j == x) ? c : mine; }
        if (sum == G) break;
        __builtin_amdgcn_s_sleep(1);
        if ((++sp & 255u) == 0u) { if (xb_ld(&bar[XB_TMO])) break; if (sp > XB_SPIN_CAP) { atomicAdd(&bar[XB_TMO], 1u); break; } }
    }
    nloc = mine > 0u ? mine : 1u; nx = cnt > 0u ? cnt : 1u;
}
__device__ __forceinline__ void xcd_barrier(const XcdBarrier& b) {
    asm volatile("s_waitcnt vmcnt(0)" ::: "memory");
    __syncthreads();
    if (b.w0 && lane_id() == 0) {
        unsigned* bar = b.bar;
        __builtin_amdgcn_s_waitcnt(0);
        unsigned nloc = b.st[0], nx = b.st[1];
        if (nloc == 0u) { xcd_barrier_complete(bar, b.x, nloc, nx); b.st[0] = nloc; b.st[1] = nx; }
        const unsigned old = xb_add(&bar[XB_XSUB(b.x)], 1u);
        const unsigned gen = old / nloc;
        if (old + 1u == (gen + 1u) * nloc) {
            __builtin_amdgcn_fence(__ATOMIC_RELEASE, "agent");
            asm volatile("s_waitcnt vmcnt(0)" ::: "memory");
            const unsigned og = xb_add(&bar[XB_TOP], 1u);
            const unsigned tg = og / nx;
            if (og + 1u == (tg + 1u) * nx) xb_add(&bar[XB_TOPGEN], 1u);
            else XB_SPIN(xb_ld(&bar[XB_TOPGEN]) == tg, bar);
            __builtin_amdgcn_fence(__ATOMIC_ACQUIRE, "agent");
            xb_add(&bar[XB_XGEN(b.x)], 1u);
            asm volatile("s_waitcnt vmcnt(0)" ::: "memory");
        } else {
            XB_SPIN(xb_ld(&bar[XB_XGEN(b.x)]) == gen, bar);
            __builtin_amdgcn_fence(__ATOMIC_ACQUIRE, "agent");
            asm volatile("s_waitcnt vmcnt(0)" ::: "memory");
        }
    }
    __syncthreads();
}

struct Args { const float* in[26]; float* out; unsigned char* ws; int ph_lo, ph_hi; };
enum { I_X = 0, I_MEM, I_EN1, I_EWIN, I_RPB, I_EWOUT, I_EN2, I_EWG, I_EWU, I_EWD, I_ON1, I_OWIN, I_WGKF, I_BGKF, I_WGKB, I_BGKB, I_GNORM, I_OWOUT, I_ON2, I_WR, I_OWG, I_OWU, I_OWD, I_MNORM, I_WMKV, I_FNORM };

#define LANE() lane_id()
#define TID() ((F.wave << 6) | lane_id())
struct Frame {
    LAS unsigned char* lds;
    int wave, G, bid;
    int gw, NGW;
    unsigned char* ws;
};

constexpr float QSCALE = 0.125f * 1.4426950408889634f;
struct CvtJob { const float* W; int K, N; bf16* WT; const float* gain; int kind; };
__device__ __forceinline__ bool cvt_map(int kind, int n0, int& drow, float& scale) {
    scale = 1.0f;
    switch (kind) {
    case 0: drow = n0; return true;
    case 1: if (n0 < 768) { drow = n0; scale = QSCALE; return true; } if (n0 < 1536) { drow = n0; return true; } if (n0 >= 2304) { drow = n0 - 768; scale = QSCALE; return true; } return false;
    case 2: if (n0 >= 1536 && n0 < 2304) { drow = n0 - 1536; return true; } return false;
    case 3: drow = (n0 >> 7) * 256 + (n0 & 127); return true;
    case 4: drow = (n0 >> 7) * 256 + 128 + (n0 & 127); return true;
    case 5: if (n0 < 768) { drow = n0; return true; } if (n0 < 1536) return false; if (n0 < 2304) { drow = n0 - 768; return true; }
            if (n0 < 2336) { drow = n0 - 512; return true; } drow = n0 - 800; scale = QSCALE; return true;
    case 6: if (n0 >= 768 && n0 < 1536) { drow = n0 - 768; return true; } return false;
    default: drow = n0; return true;
    }
}
__device__ __forceinline__ unsigned pk4_fp8(float a, float b, float c, float d) { a = __builtin_amdgcn_fmed3f(a, -448.f, 448.f); b = __builtin_amdgcn_fmed3f(b, -448.f, 448.f); c = __builtin_amdgcn_fmed3f(c, -448.f, 448.f); d = __builtin_amdgcn_fmed3f(d, -448.f, 448.f);
    unsigned w = 0u; w = (unsigned)__builtin_amdgcn_cvt_pk_fp8_f32(a, b, (int)w, false); w = (unsigned)__builtin_amdgcn_cvt_pk_fp8_f32(c, d, (int)w, true); return w; }
struct CvtRegs { f32x4 v[8]; const float* gain; bf16* WT; int K, k0, drow, valid; float scale; };
__device__ __forceinline__ void cvt_load(CvtRegs& R, const CvtJob& J, int item, int lane) {
    const int nblk = J.N / 32, kb = item / nblk, nb = item % nblk, n0 = nb * 32;
    R.k0 = kb * 64; R.gain = J.gain; R.WT = J.WT; R.K = J.K;
    R.valid = cvt_map(J.kind, n0, R.drow, R.scale) ? 1 : 0;
    if (R.valid) { const float* p = J.W + (size_t)(R.k0 + 2 * (lane >> 3)) * J.N + n0 + 4 * (lane & 7);
#pragma unroll
        for (int j = 0; j < 8; ++j) R.v[j] = *(const f32x4*)(p + (size_t)(16 * (j >> 1) + (j & 1)) * J.N); }
}
__device__ __forceinline__ void cvt_load8(CvtRegs& R, const CvtJob& J, int item, int lane) {
    const int nblk = J.N / 32, kb = item / nblk, nb = item % nblk, n0 = nb * 32;
    R.k0 = kb * 64; R.gain = J.gain; R.WT = J.WT; R.K = J.K;
    R.valid = cvt_map(J.kind, n0, R.drow, R.scale) ? 1 : 0;
    if (R.valid) { const float* p = J.W + (size_t)(R.k0 + 4 * (lane >> 3)) * J.N + n0 + 4 * (lane & 7);
#pragma unroll
        for (int j = 0; j < 8; ++j) R.v[j] = *(const f32x4*)(p + (size_t)(32 * (j >> 2) + (j & 3)) * J.N); }
}
__device__ __forceinline__ void cvt_finish8(const CvtRegs& R, LAS unsigned* T, int lane, float mul) {
    if (!R.valid) return;
    const int nq = lane & 7, kr = lane >> 3;
#pragma unroll
    for (int p = 0; p < 2; ++p) { const int k = R.k0 + 32 * p + 4 * kr; float g[4];
#pragma unroll
        for (int q = 0; q < 4; ++q) g[q] = R.scale * mul * (R.gain ? R.gain[k + q] : 1.0f);
        const f32x4 a = R.v[4 * p], b = R.v[4 * p + 1], c = R.v[4 * p + 2], d = R.v[4 * p + 3]; LAS unsigned* t = T + (4 * nq) * 17 + 8 * p + kr;
        t[0] = pk4_fp8(a.x * g[0], b.x * g[1], c.x * g[2], d.x * g[3]); t[17] = pk4_fp8(a.y * g[0], b.y * g[1], c.y * g[2], d.y * g[3]);
        t[34] = pk4_fp8(a.z * g[0], b.z * g[1], c.z * g[2], d.z * g[3]); t[51] = pk4_fp8(a.w * g[0], b.w * g[1], c.w * g[2], d.w * g[3]); }
    LDS_WAIT(); asm volatile("" ::: "memory");
#pragma unroll
    for (int r = 0; r < 2; ++r) { const int n = (lane >> 2) + 16 * r, c = lane & 3; const LAS unsigned* sp = T + n * 17 + 4 * c;
        v4u o; o.x = sp[0]; o.y = sp[1]; o.z = sp[2]; o.w = sp[3];
        *(GAS v4u*)((unsigned char*)R.WT + (size_t)(R.drow + n) * R.K + R.k0 + 16 * c) = o; }
    LDS_WAIT(); asm volatile("" ::: "memory");
}
__device__ __forceinline__ void cvt_finish(const CvtRegs& R, LAS unsigned* T, int lane) {
    if (!R.valid) return;
    const int nq = lane & 7, kr = lane >> 3;
#pragma unroll
    for (int p = 0; p < 4; ++p) { const int k = R.k0 + 16 * p + 2 * kr; float g0 = R.scale, g1 = R.scale; if (R.gain) { g0 *= R.gain[k]; g1 *= R.gain[k + 1]; }
        const f32x4 a = R.v[2 * p], b = R.v[2 * p + 1]; LAS unsigned* t = T + (4 * nq) * 33 + 8 * p + kr;
        t[0] = pk2(a.x * g0, b.x * g1); t[33] = pk2(a.y * g0, b.y * g1); t[66] = pk2(a.z * g0, b.z * g1); t[99] = pk2(a.w * g0, b.w * g1); }
    LDS_WAIT(); asm volatile("" ::: "memory");
#pragma unroll
    for (int r = 0; r < 4; ++r) { const int n = (lane >> 3) + 8 * r, c = lane & 7; const LAS unsigned* sp = T + n * 33 + 4 * c;
        v4u o; o.x = sp[0]; o.y = sp[1]; o.z = sp[2]; o.w = sp[3];
        *(GAS v4u*)(R.WT + (size_t)(R.drow + n) * R.K + R.k0 + 8 * c) = o; }
    LDS_WAIT(); asm volatile("" ::: "memory");
}
__device__ __forceinline__ void rows_to_bf16(const float* X, bf16* Ob, float* rstd, int first, int nrows, int stride, int lane) {
    for (int m = first; m < nrows; m += 2 * stride) {
        const int m2 = m + stride; const bool h2 = m2 < nrows;
        const GAS f32x4* xa = (const GAS f32x4*)(X + (size_t)m * DM) + lane; const GAS f32x4* xb = (const GAS f32x4*)(X + (size_t)(h2 ? m2 : m) * DM) + lane;
        f32x4 va[4], vb[4];
#pragma unroll
        for (int j = 0; j < 4; ++j) va[j] = xa[64 * j];
#pragma unroll
        for (int j = 0; j < 4; ++j) vb[j] = xb[64 * j];
        float sa = 0.f, sb = 0.f;
#pragma unroll
        for (int j = 0; j < 4; ++j) { sa += (va[j].x * va[j].x + va[j].y * va[j].y) + (va[j].z * va[j].z + va[j].w * va[j].w); sb += (vb[j].x * vb[j].x + vb[j].y * vb[j].y) + (vb[j].z * vb[j].z + vb[j].w * vb[j].w); }
        sa = wave_sum(sa); sb = wave_sum(sb);
        GAS unsigned long long* oa = (GAS unsigned long long*)(Ob + (size_t)m * DM) + lane;
#pragma unroll
        for (int j = 0; j < 4; ++j) oa[64 * j] = (unsigned long long)pk2(va[j].x, va[j].y) | ((unsigned long long)pk2(va[j].z, va[j].w) << 32);
        if (lane == 0) rstd[m] = __builtin_amdgcn_rsqf(sa * (1.0f / DM) + EPS);
        if (h2) { GAS unsigned long long* ob = (GAS unsigned long long*)(Ob + (size_t)m2 * DM) + lane;
#pragma unroll
            for (int j = 0; j < 4; ++j) ob[64 * j] = (unsigned long long)pk2(vb[j].x, vb[j].y) | ((unsigned long long)pk2(vb[j].z, vb[j].w) << 32);
            if (lane == 0) rstd[m2] = __builtin_amdgcn_rsqf(sb * (1.0f / DM) + EPS); }
    }
}

struct Unit { int pm, pn; };
struct Sched {
    int nM, nN, nwg, G, c, K, ld, off0, off1, per;
    const char* A; const char* B; const int* bexp; size_t estride;
    __device__ void init(const void* A_, const void* B_, int K_, int nM_, int nN_, int G_, int c_, const int* bexp_ = nullptr, size_t estride_ = 0) {
        A = (const char*)A_; B = (const char*)B_; K = K_; ld = K_; nM = nM_; nN = nN_; nwg = nM * nN; G = G_; c = c_; bexp = bexp_; estride = estride_; off0 = 0; off1 = 0x7fffffff; per = G_ / 8; }
    __device__ void range(int off0_, int off1_, int per_) { off0 = off0_; off1 = off1_; per = per_; }
    __device__ bool next(int i, Unit& u) const {
        const int q = nwg / 8, r = nwg % 8, xcd = c % 8, slot = c / 8, lt = (int)((unsigned)(xcd - r) >> 31), qx = q + lt;
        if (slot >= per) return false;
        const int off = off0 + i * per + slot, lim = off1 < qx ? off1 : qx;
        if (off >= lim) return false;
        const int wgid = xcd * q + (lt ? xcd : r) + off;
        const int nig = 8 * nN, gid = wgid / nig, fm = gid * 8, gsz = (nM - fm) < 8 ? (nM - fm) : 8;
        u.pm = fm + ((wgid % nig) % gsz); u.pn = (wgid % nig) / gsz; return true;
    }
    __device__ const char* a_base(const Unit& u) const { return A + (size_t)u.pm * 512 * ld; }
    __device__ const char* b_base(const Unit& u) const { return B + (bexp ? (size_t)bexp[u.pm] * estride : (size_t)0) + (size_t)u.pn * 512 * ld; }
};

struct NoAux {};
__device__ __forceinline__ float rstd_from(const float* rss16) {
    const f32x4* p = (const f32x4*)rss16; f32x4 a = p[0], b = p[1], c = p[2], d = p[3];
    const float s = ((a.x + a.y) + (a.z + a.w)) + ((b.x + b.y) + (b.z + b.w)) + ((c.x + c.y) + (c.z + c.w)) + ((d.x + d.y) + (d.z + d.w));
    return __builtin_amdgcn_rsqf(s * (1.0f / DM) + EPS);
}
__device__ __forceinline__ float rstd_from_lds(const LAS float* rss16) {
    const LAS f32x4* p = (const LAS f32x4*)rss16; f32x4 a = p[0], b = p[1], c = p[2], d = p[3];
    const float s = ((a.x + a.y) + (a.z + a.w)) + ((b.x + b.y) + (b.z + b.w)) + ((c.x + c.y) + (c.z + c.w)) + ((d.x + d.y) + (d.z + d.w));
    return __builtin_amdgcn_rsqf(s * (1.0f / DM) + EPS);
}
constexpr int RSS_LDS_REL = 2048;
struct RowCtx { float rs[2][4]; };
template <bool RSS = false> struct EpiRowScaleT {
    static constexpr bool NEED_SS = false; static constexpr int SC_MODE = RSS ? 5 : 1; typedef RowCtx Ctx; typedef NoAux Aux;
    bf16* O; int ldc; const float* sc_src; float mul;
    __device__ __forceinline__ void begin(Ctx& c, const LAS float* sc, const LAS int*, int lr0, int, int, int) const {
#pragma unroll
        for (int ai = 0; ai < 2; ++ai)
#pragma unroll
            for (int m = 0; m < 4; ++m) c.rs[ai][m] = sc[ai * 128 + lr0 + m * 16] * mul;
    }
    __device__ __forceinline__ void load_aux(Aux&, const Ctx&, int, int, int, int, int) const {}
    __device__ __forceinline__ float apply(const Ctx& c, const Aux&, int ai, int m, int row, int pn, int c128, const float (&a)[8], const float (&b)[8]) const {
        const float s = c.rs[ai][m];
        bf16* p = O + (size_t)row * ldc + pn * 256 + c128;
        v4u w; w.x = pk2(a[0] * s, a[1] * s); w.y = pk2(a[2] * s, a[3] * s); w.z = pk2(a[4] * s, a[5] * s); w.w = pk2(a[6] * s, a[7] * s); *(v4u*)p = w;
        w.x = pk2(b[0] * s, b[1] * s); w.y = pk2(b[2] * s, b[3] * s); w.z = pk2(b[4] * s, b[5] * s); w.w = pk2(b[6] * s, b[7] * s); *(v4u*)(p + 128) = w;
        return 0.f;
    }
    __device__ __forceinline__ void row_done(int, int, int, float) const {}
};
typedef EpiRowScaleT<false> EpiRowScale;
struct ColCtx { float sa[8], sb[8]; };
template <bool RSS = false> struct EpiColScaleT {
    static constexpr bool NEED_SS = false; static constexpr int SC_MODE = RSS ? 6 : 2; typedef ColCtx Ctx; typedef NoAux Aux;
    bf16* O; int ldc; const float* sc_src;
    __device__ __forceinline__ void begin(Ctx& c, const LAS float* sc, const LAS int*, int, int, int, int c128) const {
#pragma unroll
        for (int j = 0; j < 8; ++j) { c.sa[j] = sc[c128 + j]; c.sb[j] = sc[128 + c128 + j]; }
    }
    __device__ __forceinline__ void load_aux(Aux&, const Ctx&, int, int, int, int, int) const {}
    __device__ __forceinline__ float apply(const Ctx& c, const Aux&, int, int, int row, int pn, int c128, const float (&a)[8], const float (&b)[8]) const {
        bf16* p = O + (size_t)row * ldc + pn * 256 + c128;
        v4u w; w.x = pk2(a[0] * c.sa[0], a[1] * c.sa[1]); w.y = pk2(a[2] * c.sa[2], a[3] * c.sa[3]); w.z = pk2(a[4] * c.sa[4], a[5] * c.sa[5]); w.w = pk2(a[6] * c.sa[6], a[7] * c.sa[7]); *(v4u*)p = w;
        w.x = pk2(b[0] * c.sb[0], b[1] * c.sb[1]); w.y = pk2(b[2] * c.sb[2], b[3] * c.sb[3]); w.z = pk2(b[4] * c.sb[4], b[5] * c.sb[5]); w.w = pk2(b[6] * c.sb[6], b[7] * c.sb[7]); *(v4u*)(p + 128) = w;
        return 0.f;
    }
    __device__ __forceinline__ void row_done(int, int, int, float) const {}
};
typedef EpiColScaleT<false> EpiColScale;
struct Aux4 { f32x4 v[4]; };
struct NoCtx {};
struct AuxR { f32x4 v[4]; };
struct AuxB { v4u a, b; };
__device__ __forceinline__ void unpack16(const AuxB& x, f32x4 (&v)[4]) {
    v[0] = (f32x4){bflo(x.a.x), bfhi(x.a.x), bflo(x.a.y), bfhi(x.a.y)}; v[1] = (f32x4){bflo(x.a.z), bfhi(x.a.z), bflo(x.a.w), bfhi(x.a.w)};
    v[2] = (f32x4){bflo(x.b.x), bfhi(x.b.x), bflo(x.b.y), bfhi(x.b.y)}; v[3] = (f32x4){bflo(x.b.z), bfhi(x.b.z), bflo(x.b.w), bfhi(x.b.w)}; }
template <bool F32> struct AuxSel { typedef AuxR T; };
template <> struct AuxSel<false> { typedef AuxB T; };
template <bool RF32> struct EpiResid {
    static constexpr bool NEED_SS = true; static constexpr int SC_MODE = 0; typedef NoCtx Ctx; typedef typename AuxSel<RF32>::T Aux;
    const float* R; bf16* HB; float* rss; bf16* HB2;
    __device__ __forceinline__ void begin(Ctx&, const LAS float*, const LAS int*, int, int, int, int) const {}
    __device__ __forceinline__ void load_aux(Aux& x, const Ctx&, int, int, int row, int pn, int c128) const {
        const size_t off = (size_t)row * DM + pn * 256 + c128;
        if constexpr (RF32) { const float* p = R + off; x.v[0] = *(const f32x4*)p; x.v[1] = *(const f32x4*)(p + 4); x.v[2] = *(const f32x4*)(p + 128); x.v[3] = *(const f32x4*)(p + 132); }
        else { x.a = *(const v4u*)(HB + off); x.b = *(const v4u*)(HB + off + 128); }
    }
    __device__ __forceinline__ float apply(const Ctx&, const Aux& xr, int, int, int row, int pn, int c128, const float (&a)[8], const float (&b)[8]) const {
        const size_t off = (size_t)row * DM + pn * 256 + c128;
        struct { f32x4 v[4]; } x; if constexpr (RF32) { x.v[0] = xr.v[0]; x.v[1] = xr.v[1]; x.v[2] = xr.v[2]; x.v[3] = xr.v[3]; } else unpack16(xr, x.v);
        const f32x4 h0 = {x.v[0].x + a[0], x.v[0].y + a[1], x.v[0].z + a[2], x.v[0].w + a[3]}, h1 = {x.v[1].x + a[4], x.v[1].y + a[5], x.v[1].z + a[6], x.v[1].w + a[7]};
        const f32x4 h2 = {x.v[2].x + b[0], x.v[2].y + b[1], x.v[2].z + b[2], x.v[2].w + b[3]}, h3 = {x.v[3].x + b[4], x.v[3].y + b[5], x.v[3].z + b[6], x.v[3].w + b[7]};
        v4u w; w.x = pk2(h0.x, h0.y); w.y = pk2(h0.z, h0.w); w.z = pk2(h1.x, h1.y); w.w = pk2(h1.z, h1.w); *(v4u*)(HB + off) = w; if (HB2) { v2u f; f.x = pk4_fp8(h0.x, h0.y, h0.z, h0.w); f.y = pk4_fp8(h1.x, h1.y, h1.z, h1.w); *(v2u*)((unsigned char*)HB2 + off) = f; }
        w.x = pk2(h2.x, h2.y); w.y = pk2(h2.z, h2.w); w.z = pk2(h3.x, h3.y); w.w = pk2(h3.z, h3.w); *(v4u*)(HB + off + 128) = w; if (HB2) { v2u f; f.x = pk4_fp8(h2.x, h2.y, h2.z, h2.w); f.y = pk4_fp8(h3.x, h3.y, h3.z, h3.w); *(v2u*)((unsigned char*)HB2 + off + 128) = f; }
        return ((h0.x * h0.x + h0.y * h0.y) + (h0.z * h0.z + h0.w * h0.w) + (h1.x * h1.x + h1.y * h1.y) + (h1.z * h1.z + h1.w * h1.w))
             + ((h2.x * h2.x + h2.y * h2.y) + (h2.z * h2.z + h2.w * h2.w) + (h3.x * h3.x + h3.y * h3.y) + (h3.z * h3.z + h3.w * h3.w));
    }
    __device__ __forceinline__ void row_done(int row, int pn, int wc, float ss) const { rss[(size_t)row * 16 + pn * 4 + wc] = ss; }
};
__device__ __forceinline__ float silu_mul(float g, float u) { return g * __builtin_amdgcn_rcpf(1.0f + __builtin_amdgcn_exp2f(g * -1.4426950408889634f)) * u; }
template <bool MOE, bool RSS = false> struct EpiSwiGLU {
    static constexpr bool NEED_SS = false; static constexpr int SC_MODE = MOE ? 3 : (RSS ? 5 : 1); typedef RowCtx Ctx; typedef NoAux Aux;
    bf16* Hm; int ldh; const float* sc_src; bf16* Hmt;
    __device__ __forceinline__ void begin(Ctx& c, const LAS float* sc, const LAS int* tl, int lr0, int, int, int) const {
#pragma unroll
        for (int ai = 0; ai < 2; ++ai)
#pragma unroll
            for (int m = 0; m < 4; ++m) { const int i = ai * 128 + lr0 + m * 16; float r = sc[i];
                if (MOE) { r *= 0.03125f; if (tl[i] < 0) r = 0.f; } c.rs[ai][m] = r; }
    }
    __device__ __forceinline__ void load_aux(Aux&, const Ctx&, int, int, int, int, int) const {}
    __device__ __forceinline__ float apply(const Ctx& c, const Aux&, int ai, int m, int row, int pn, int c128, const float (&a)[8], const float (&b)[8]) const {
        const float s = c.rs[ai][m], s2 = s * -1.4426950408889634f, iss = __builtin_amdgcn_rcpf(s * s); float o[8];
#pragma unroll
        for (int j = 0; j < 8; ++j) o[j] = (a[j] * b[j]) * __builtin_amdgcn_rcpf(__builtin_fmaf(__builtin_amdgcn_exp2f(a[j] * s2), iss, iss));
        v4u w; w.x = pk2(o[0], o[1]); w.y = pk2(o[2], o[3]); w.z = pk2(o[4], o[5]); w.w = pk2(o[6], o[7]);
        if constexpr (MOE) {
            unsigned char* rp = (row >= NT) ? (unsigned char*)Hmt + (size_t)(row - NT) * ldh : (unsigned char*)Hm + (size_t)row * ldh;
            v2u f; f.x = pk4_fp8(o[0], o[1], o[2], o[3]); f.y = pk4_fp8(o[4], o[5], o[6], o[7]); *(v2u*)(rp + pn * 128 + c128) = f;
        } else *(v4u*)(Hm + (size_t)row * ldh + pn * 128 + c128) = w;
        return 0.f;
    }
    __device__ __forceinline__ void row_done(int, int, int, float) const {}
};

namespace pg8 {
constexpr int HTB = 16384, TOK_OFF = 132096, SC_OFF = 134144;
__device__ __forceinline__ int lds_byte(int r, int c) { const int st = (r >> 4) * 2 + (c >> 5), rr = r & 15, cc = c & 31, ob = rr * 64 + cc * 2; return st * 1024 + (ob ^ (((ob >> 9) & 1) << 5)); }
__device__ __forceinline__ void stage_rc(int b, int& R, int& C) { const int st = b / 1024, sb = b % 1024, swz = sb ^ (((sb >> 9) & 1) << 5); R = (st >> 1) * 16 + swz / 64; C = (st & 1) * 32 + (swz % 64) / 2; }
__device__ __forceinline__ int perm32(int rho) { const int n = rho >> 4, i = rho & 15; return 8 * (i >> 2) + 4 * n + (i & 3); }

template <class Epi>
__device__ __forceinline__ void run_epi(const Epi& E, const f32x4 (&acc)[2][2][4][2], const Unit& u, int wr, int wc, int fr, int fq, const LAS float* sc, const LAS int* tlp) {
    int row0 = u.pm * 256 + wr * 64 + fr, c128 = 32 * wc + 8 * fq;
    asm volatile("" : "+v"(row0), "+v"(c128));
    typename Epi::Ctx ctx; E.begin(ctx, sc, tlp, wr * 64 + fr, row0, u.pn, c128);
#pragma unroll
    for (int ai = 0; ai < 2; ++ai) {
        typename Epi::Aux aux[4];
#pragma unroll
        for (int m = 0; m < 4; ++m) E.load_aux(aux[m], ctx, ai, m, row0 + ai * 128 + m * 16, u.pn, c128);
#pragma unroll
        for (int m = 0; m < 4; ++m) {
            const int row = row0 + ai * 128 + m * 16;
            float a[8], b[8];
#pragma unroll
            for (int j = 0; j < 8; ++j) { a[j] = acc[ai][0][m][j >> 2][j & 3]; b[j] = acc[ai][1][m][j >> 2][j & 3]; }
            float ss = E.apply(ctx, aux[m], ai, m, row, u.pn, c128, a, b);
            if (Epi::NEED_SS) { ss += __shfl_xor(ss, 16); ss += __shfl_xor(ss, 32); if (fq == 0) E.row_done(row, u.pn, wc, ss); }
        }
    }
}

typedef int v8i __attribute__((ext_vector_type(8)));
template <class Epi, bool GATHER, bool FP8 = false>
__device__ __forceinline__ void gemm_fast(LAS unsigned char* lds, const Sched& S, const Epi& E, const int* gtok, int wave_) {
    int tid = (wave_ << 6) | lane_id(); asm volatile("" : "+v"(tid));
    const int wid = __builtin_amdgcn_readfirstlane(tid >> 6), lane = tid & 63, wr = wid >> 2, wc = wid & 3, fr = lane & 15, fq = lane >> 4;
    const int K = S.ld, nt = S.K / 64;
    unsigned voffB[2], vA0[2], vA1[2], nA0[2], nA1[2]; int RA[2], CA2[2];
#pragma unroll
    for (int i = 0; i < 2; ++i) { int R, C; stage_rc(tid * 16 + i * 8192, R, C); const int Rb = (R & ~31) + perm32(R & 31);
        voffB[i] = (unsigned)(Rb * K + C) * 2u; RA[i] = R; CA2[i] = C * 2; vA0[i] = (unsigned)(R * K + C) * 2u; vA1[i] = vA0[i] + (unsigned)(128 * K * 2); nA0[i] = vA0[i]; nA1[i] = vA1[i]; }
    const size_t kstep = 128;
    const size_t hstep = (size_t)128 * K * 2;
    const unsigned ldsw = (unsigned)wid * 1024u;
    const int aoff = lds_byte(wr * 64 + fr, fq * 8), boff = lds_byte(wc * 32 + fr, fq * 8);
    LAS int* tl = (LAS int*)(lds + TOK_OFF);
#define PG8_SA(b, h) (((b) * 2 + (h)) * HTB)
#define PG8_SB(b, h) ((4 + (b) * 2 + (h)) * HTB)
#define PG8_STAGE(bufoff, gbase, voff) do { _Pragma("unroll") for (int _i = 0; _i < 2; ++_i) \
        __builtin_amdgcn_global_load_lds((const unsigned*)((const char*)(gbase) + (voff)[_i]), (LAS unsigned*)(lds + (bufoff) + ldsw + _i * 8192), 16, 0, 0); } while (0)
#define PG8_LDA(dst, b, h) do { _Pragma("unroll") for (int m = 0; m < 4; ++m) _Pragma("unroll") for (int k = 0; k < 2; ++k) dst[m][k] = *(const LAS bf16x8*)(lds + PG8_SA(b, h) + aoff + m * 2048 + k * 1024); } while (0)
#define PG8_LDB(dst, b, h) do { _Pragma("unroll") for (int n = 0; n < 2; ++n) _Pragma("unroll") for (int k = 0; k < 2; ++k) dst[n][k] = *(const LAS bf16x8*)(lds + PG8_SB(b, h) + boff + n * 2048 + k * 1024); } while (0)
#define PG8_MMA(ai, bj, At, Bt) do { __builtin_amdgcn_s_setprio(1); _Pragma("unroll") for (int m = 0; m < 4; ++m) _Pragma("unroll") for (int n = 0; n < 2; ++n) { \
        if constexpr (FP8) { const v8i b8_ = __builtin_bit_cast(v8i, __builtin_shufflevector(Bt[n][0], Bt[n][1], 0, 1, 2, 3, 4, 5, 6, 7, 8, 9, 10, 11, 12, 13, 14, 15)), a8_ = __builtin_bit_cast(v8i, __builtin_shufflevector(At[m][0], At[m][1], 0, 1, 2, 3, 4, 5, 6, 7, 8, 9, 10, 11, 12, 13, 14, 15)); \
            asm volatile("v_mfma_f32_16x16x128_f8f6f4 %0, %1, %2, %0" : "+v"(acc[ai][bj][m][n]) : "v"(b8_), "v"(a8_)); }     \
        else { _Pragma("unroll") for (int k = 0; k < 2; ++k) acc[ai][bj][m][n] = __builtin_amdgcn_mfma_f32_16x16x32_bf16(Bt[n][k], At[m][k], acc[ai][bj][m][n], 0, 0, 0); } } \
        __builtin_amdgcn_s_setprio(0); } while (0)
#define PG8_WAIT_V(n) asm volatile("s_waitcnt vmcnt(" #n ")" ::: "memory")
#define PG8_WAIT_L(n) asm volatile("s_waitcnt lgkmcnt(" #n ")" ::: "memory")
#define PG8_BAR __builtin_amdgcn_s_barrier()
#define PG8_SCHED __builtin_amdgcn_sched_barrier(0)
#define PG8_IDS_DMA(pm_, par_) do { if (wid < 4) __builtin_amdgcn_global_load_lds((const unsigned*)(gtok + (pm_) * 256 + wid * 64 + lane), (LAS unsigned*)(lds + TOK_OFF + (par_) * 1024 + wid * 256), 4, 0, 0); } while (0)
#define PG8_IDS_READ(d0, d1, par_) do { _Pragma("unroll") for (int _i = 0; _i < 2; ++_i) { int t0 = tl[(par_) * 256 + RA[_i]], t1 = tl[(par_) * 256 + 128 + RA[_i]]; t0 = t0 < 0 ? 0 : t0; t1 = t1 < 0 ? 0 : t1; \
        d0[_i] = (unsigned)t0 * (unsigned)(K * 2) + (unsigned)CA2[_i]; d1[_i] = (unsigned)t1 * (unsigned)(K * 2) + (unsigned)CA2[_i]; } } while (0)
    Unit cur, nxt; int ui = 0, par = 0;
    if (!S.next(0, cur)) return;
    f32x4 acc[2][2][4][2];
#pragma unroll
    for (int a = 0; a < 2; ++a)
#pragma unroll
        for (int b = 0; b < 2; ++b)
#pragma unroll
            for (int m = 0; m < 4; ++m)
#pragma unroll
                for (int n = 0; n < 2; ++n) acc[a][b][m][n] = (f32x4){0.f, 0.f, 0.f, 0.f};
    bf16x8 At[4][2], B0[2][2], B1[2][2];
    const char* cA = GATHER ? S.A : S.a_base(cur); const char* cB = S.b_base(cur);
    if constexpr (GATHER) { PG8_IDS_DMA(cur.pm, 0); PG8_WAIT_V(0); __syncthreads(); PG8_IDS_READ(vA0, vA1, 0); }
    PG8_STAGE(PG8_SB(0, 0), cB, voffB); PG8_STAGE(PG8_SB(0, 1), cB + hstep, voffB); PG8_STAGE(PG8_SA(0, 0), cA, vA0); PG8_STAGE(PG8_SA(0, 1), cA, vA1);
    if (wr == 1) PG8_BAR;
    PG8_WAIT_V(2); PG8_BAR;
    PG8_STAGE(PG8_SB(1, 0), cB + kstep, voffB); PG8_STAGE(PG8_SA(1, 0), cA + kstep, vA0); PG8_STAGE(PG8_SB(1, 1), cB + hstep + kstep, voffB);
    PG8_WAIT_V(6); PG8_BAR;
    for (;;) {
        const bool has_next = S.next(ui + 1, nxt);
        const char* nA = has_next ? (GATHER ? S.A : S.a_base(nxt)) : cA; const char* nB = has_next ? S.b_base(nxt) : cB;
        for (int t = 0; t < nt; t += 2) {
            const bool last = (t == nt - 2);
            if constexpr (GATHER) {
                if (t == nt - 4 && has_next) PG8_IDS_DMA(nxt.pm, par ^ 1);
                if (last) { if (has_next) PG8_IDS_READ(nA0, nA1, par ^ 1); else { nA0[0] = vA0[0]; nA0[1] = vA0[1]; nA1[0] = vA1[0]; nA1[1] = vA1[1]; } }
            }
            if constexpr (Epi::SC_MODE == 5 || Epi::SC_MODE == 6) {
                if (last) { const float* src_ = E.sc_src + (size_t)(Epi::SC_MODE == 5 ? cur.pm : cur.pn) * 4096 + wid * 512 + lane * 4;
                    __builtin_amdgcn_global_load_lds((const unsigned*)src_, (LAS unsigned*)(lds + SC_OFF + RSS_LDS_REL + wid * 2048), 16, 0, 0);
                    __builtin_amdgcn_global_load_lds((const unsigned*)(src_ + 256), (LAS unsigned*)(lds + SC_OFF + RSS_LDS_REL + wid * 2048 + 1024), 16, 0, 0); }
            } else if constexpr (Epi::SC_MODE != 0) {
                if (last && wid < 4) { const int i_ = wid * 64 + lane; LAS unsigned* d_ = (LAS unsigned*)(lds + SC_OFF + wid * 256);
                    if constexpr (Epi::SC_MODE == 1) __builtin_amdgcn_global_load_lds((const unsigned*)(E.sc_src + cur.pm * 256 + i_), d_, 4, 0, 0);
                    if constexpr (Epi::SC_MODE == 2) __builtin_amdgcn_global_load_lds((const unsigned*)(E.sc_src + cur.pn * 256 + i_), d_, 4, 0, 0);
                    if constexpr (Epi::SC_MODE == 3) { int t_ = tl[par * 256 + i_]; t_ = t_ < 0 ? 0 : t_; __builtin_amdgcn_global_load_lds((const unsigned*)(E.sc_src + t_), d_, 4, 0, 0); }
                    if constexpr (Epi::SC_MODE == 4) { __builtin_amdgcn_global_load_lds((const unsigned*)(E.tok + cur.pm * 256 + i_), d_, 4, 0, 0);
                        __builtin_amdgcn_global_load_lds((const unsigned*)(E.w + cur.pm * 256 + i_), (LAS unsigned*)(lds + SC_OFF + 1024 + wid * 256), 4, 0, 0); } }
            }
            const char* a1 = cA + (size_t)(t + 1) * kstep;
            const char* a2 = last ? nA : cA + (size_t)(t + 2) * kstep; const char* b2 = last ? nB : cB + (size_t)(t + 2) * kstep;
            const char* a3 = a2 + kstep; const char* b3 = b2 + kstep;
            unsigned w0[2], w1[2];
            if (GATHER && last) { w0[0] = nA0[0]; w0[1] = nA0[1]; w1[0] = nA1[0]; w1[1] = nA1[1]; } else { w0[0] = vA0[0]; w0[1] = vA0[1]; w1[0] = vA1[0]; w1[1] = vA1[1]; }
            PG8_LDB(B0, 0, 0); PG8_LDB(B1, 0, 1); PG8_SCHED; PG8_LDA(At, 0, 0); PG8_STAGE(PG8_SA(1, 1), a1, vA1);
            PG8_WAIT_V(8); PG8_WAIT_L(0); PG8_BAR; PG8_MMA(0, 0, At, B0); PG8_MMA(0, 1, At, B1); PG8_BAR; PG8_SCHED;
            PG8_LDA(At, 0, 1); PG8_STAGE(PG8_SB(0, 0), b2, voffB); PG8_STAGE(PG8_SB(0, 1), b2 + hstep, voffB); PG8_STAGE(PG8_SA(0, 0), a2, w0);
            PG8_WAIT_V(8); PG8_WAIT_L(0); PG8_BAR; PG8_MMA(1, 0, At, B0); PG8_MMA(1, 1, At, B1); PG8_BAR; PG8_SCHED;
            PG8_LDB(B0, 1, 0); PG8_LDB(B1, 1, 1); PG8_SCHED; PG8_LDA(At, 1, 0); PG8_STAGE(PG8_SA(0, 1), a2, w1);
            PG8_WAIT_V(8); PG8_WAIT_L(0); PG8_BAR; PG8_MMA(0, 0, At, B0); PG8_MMA(0, 1, At, B1); PG8_BAR; PG8_SCHED;
            PG8_LDA(At, 1, 1); PG8_STAGE(PG8_SB(1, 0), b3, voffB); PG8_STAGE(PG8_SB(1, 1), b3 + hstep, voffB); PG8_STAGE(PG8_SA(1, 0), a3, w0);
            PG8_WAIT_V(8); PG8_WAIT_L(0); PG8_BAR; PG8_MMA(1, 0, At, B0); PG8_MMA(1, 1, At, B1); PG8_BAR; PG8_SCHED;
        }
        if constexpr (FP8) asm volatile("s_nop 15\n\ts_nop 15" ::: "memory");
        if (wr == 0) PG8_BAR;
        if constexpr (Epi::SC_MODE == 5 || Epi::SC_MODE == 6) {
            if (wid < 4) ((LAS float*)(lds + SC_OFF))[tid] = rstd_from_lds((const LAS float*)(lds + SC_OFF + RSS_LDS_REL) + tid * 16);
            PG8_WAIT_L(0); PG8_BAR;
        }
        run_epi(E, acc, cur, wr, wc, fr, fq, (const LAS float*)(lds + SC_OFF), (const LAS int*)(lds + TOK_OFF + par * 1024));
        if (!has_next) break;
#pragma unroll
        for (int a = 0; a < 2; ++a)
#pragma unroll
            for (int b = 0; b < 2; ++b)
#pragma unroll
                for (int m = 0; m < 4; ++m)
#pragma unroll
                    for (int n = 0; n < 2; ++n) acc[a][b][m][n] = (f32x4){0.f, 0.f, 0.f, 0.f};
        cur = nxt; cA = nA; cB = nB; ++ui;
        if constexpr (GATHER) { vA0[0] = nA0[0]; vA0[1] = nA0[1]; vA1[0] = nA1[0]; vA1[1] = nA1[1]; par ^= 1; }
        if (wr == 1) PG8_BAR;
    }
    PG8_WAIT_V(0);
    PG8_BAR;
#undef PG8_SA
#undef PG8_SB
#undef PG8_STAGE
#undef PG8_LDA
#undef PG8_LDB
#undef PG8_MMA
#undef PG8_WAIT_V
#undef PG8_WAIT_L
#undef PG8_BAR
#undef PG8_SCHED
#undef PG8_IDS_DMA
#undef PG8_IDS_READ
}
}

template <class Epi, bool GATHER, bool FP8 = false>
__device__ __forceinline__ void gemm_run(LAS unsigned char* lds, const Sched& S, const Epi& E, const int* gtok, int wave_) { pg8::gemm_fast<Epi, GATHER, FP8>(lds, S, E, gtok, wave_); }

typedef short s16x4 __attribute__((ext_vector_type(4)));
template <bool NA, bool KLDS = false, int VLDS = 0, int KRS = 64>
__device__ __forceinline__ void attn16(int lane, const bf16* Q, int ldq, const bf16* Kb, int ldk, const bf16* Vt, int ldv, int ktok0, int trs, bf16* O, int ldo,
                                       const LAS float* rpb_h, int r, int r0, int jb, int band0, const LAS unsigned char* Kl = nullptr, int arow0 = 0, const LAS unsigned char* Vl = nullptr, int kb0 = 0) {
    const int qi = lane & 15, g = lane >> 4;
    bf16x8 qf[2];
#pragma unroll
    for (int ks = 0; ks < 2; ++ks) qf[ks] = *(const bf16x8*)(Q + (size_t)qi * ldq + ks * 32 + 8 * g);
    f32x4 s[16];
    const int krow = 8 * (qi >> 2) + (qi & 3);
#pragma unroll
    for (int t = 0; t < 16; ++t) {
        bf16x8 k0, k1;
        if constexpr (KLDS) {
            const int kcol = kb0 + krow + 4 * (t & 1), swz = (((kcol >> 3) & 3) << 1) | ((kcol >> 1) & 1);
            const LAS unsigned char* kb = Kl + ((arow0 + (t >> 1)) * KRS + kcol) * 128;
            k0 = *(const LAS bf16x8*)(kb + ((g ^ swz) << 4)); k1 = *(const LAS bf16x8*)(kb + (((4 + g) ^ swz) << 4));
        } else {
            const bf16* kp = Kb + (size_t)(ktok0 + (t >> 1) * trs + krow + 4 * (t & 1)) * ldk + 8 * g;
            k0 = *(const bf16x8*)kp; k1 = *(const bf16x8*)(kp + 32);
        }
        f32x4 z = {0.f, 0.f, 0.f, 0.f};
        z = __builtin_amdgcn_mfma_f32_16x16x32_bf16(k0, qf[0], z, 0, 0, 0);
        z = __builtin_amdgcn_mfma_f32_16x16x32_bf16(k1, qf[1], z, 0, 0, 0);
        s[t] = z;
        if constexpr (KLDS) { if ((t & 3) == 3) __builtin_amdgcn_sched_barrier(0); }
    }
    bf16x8 vfa[VLDS ? 1 : 4][VLDS ? 1 : 8];
    if constexpr (!VLDS) {
#pragma unroll
        for (int mt = 0; mt < 4; ++mt)
#pragma unroll
            for (int kk = 0; kk < 8; ++kk) vfa[mt][kk] = *(const bf16x8*)(Vt + (size_t)(16 * mt + qi) * ldv + ktok0 + kk * trs + 8 * g);
        __builtin_amdgcn_sched_barrier(0);
    }
    float m = -INFINITY;
    if constexpr (NA) {
        const int qc = 16 * jb + qi, cs = min(max(qc - 8, 0), 48);
        const LAS float* bp = rpb_h + (r0 - r + 7) * 31 + (band0 + 8 * g - qc + 15);
        bool ok[2][4];
#pragma unroll
        for (int hh = 0; hh < 2; ++hh)
#pragma unroll
            for (int i = 0; i < 4; ++i) { const int kc = band0 + 8 * g + 4 * hh + i; ok[hh][i] = (kc >= cs) && (kc < cs + 16); }
#pragma unroll
        for (int tq = 0; tq < 4; ++tq) {
            float bv[4][4];
#pragma unroll
            for (int tt = 0; tt < 4; ++tt)
#pragma unroll
                for (int i = 0; i < 4; ++i) { const int t = 4 * tq + tt; bv[tt][i] = bp[(t >> 1) * 31 + 4 * (t & 1) + i]; }
#pragma unroll
            for (int tt = 0; tt < 4; ++tt)
#pragma unroll
                for (int i = 0; i < 4; ++i) asm volatile("" : "+v"(bv[tt][i]));
#pragma unroll
            for (int tt = 0; tt < 4; ++tt)
#pragma unroll
                for (int i = 0; i < 4; ++i) { const int t = 4 * tq + tt;
                    const float v = ok[t & 1][i] ? s[t][i] + bv[tt][i] : -INFINITY;
                    s[t][i] = v; m = fmaxf(m, v); }
        }
    } else {
#pragma unroll
        for (int t = 0; t < 16; ++t)
#pragma unroll
            for (int i = 0; i < 4; ++i) m = fmaxf(m, s[t][i]);
    }
    m = fmaxf(m, __shfl_xor(m, 16)); m = fmaxf(m, __shfl_xor(m, 32));
    float l = 0.f;
    bf16x8 pf[8];
#pragma unroll
    for (int kk = 0; kk < 8; ++kk) {
        float p[8];
#pragma unroll
        for (int i = 0; i < 4; ++i) { p[i] = __builtin_amdgcn_exp2f(s[2 * kk][i] - m); p[4 + i] = __builtin_amdgcn_exp2f(s[2 * kk + 1][i] - m); }
#pragma unroll
        for (int i = 0; i < 8; ++i) l += p[i];
        v4u w; w.x = pk2(p[0], p[1]); w.y = pk2(p[2], p[3]); w.z = pk2(p[4], p[5]); w.w = pk2(p[6], p[7]);
        pf[kk] = __builtin_bit_cast(bf16x8, w);
    }
    l += __shfl_xor(l, 16); l += __shfl_xor(l, 32);
    const float inv = __builtin_amdgcn_rcpf(l);
#pragma unroll
    for (int mt = 0; mt < 4; ++mt) {
        f32x4 acc = {0.f, 0.f, 0.f, 0.f};
#pragma unroll
        for (int kk = 0; kk < 8; ++kk) {
            bf16x8 vf; if constexpr (VLDS == 1) vf = *(const LAS bf16x8*)(Vl + (16 * mt + qi) * 512 + (((4 * kk + g) ^ qi) << 4));
            else if constexpr (VLDS == 2) vf = *(const LAS bf16x8*)(Vl + (16 * mt + qi) * 1200 + ((arow0 + kk) * 40 + kb0 + 8 * g) * 2);
            else vf = vfa[mt][kk];
            acc = __builtin_amdgcn_mfma_f32_16x16x32_bf16(vf, pf[kk], acc, 0, 0, 0);
        }
        v2u w; w.x = pk2(acc[0] * inv, acc[1] * inv); w.y = pk2(acc[2] * inv, acc[3] * inv);
        *(v2u*)(O + (size_t)qi * ldo + 16 * mt + 4 * g) = w;
        if constexpr (VLDS) __builtin_amdgcn_sched_barrier(0);
    }
}
template <bool NA, int VMODE, int KRS>
__device__ __forceinline__ void attn16_lds(int lane, const bf16* Q, int ldq, bf16* O, int ldo, const LAS float* rpb_h, int r, int r0, int jb, int band0,
                                           const LAS unsigned char* Kl, int arow0, const LAS unsigned char* Vl, int kb0) {
    const int qi = lane & 15, g = lane >> 4;
    bf16x8 qf[2];
#pragma unroll
    for (int ks = 0; ks < 2; ++ks) qf[ks] = *(const bf16x8*)(Q + (size_t)qi * ldq + ks * 32 + 8 * g);
    const int krow = 8 * (qi >> 2) + (qi & 3);
    const LAS unsigned char* kbase[2][2];
#pragma unroll
    for (int e = 0; e < 2; ++e) { const int kcol = kb0 + krow + 4 * e, swz = (((kcol >> 3) & 3) << 1) | ((kcol >> 1) & 1); const LAS unsigned char* rb = Kl + (arow0 * KRS + kcol) * 128;
        kbase[e][0] = rb + ((g ^ swz) << 4); kbase[e][1] = rb + (((4 + g) ^ swz) << 4); }
#define A16_KFR(t, hh) (*(const LAS bf16x8*)(kbase[(t) & 1][hh] + ((t) >> 1) * (KRS * 128)))
    const LAS unsigned char* vbase[VMODE == 1 ? 8 : 1];
    if constexpr (VMODE == 1) {
#pragma unroll
        for (int kk = 0; kk < 8; ++kk) vbase[kk] = Vl + qi * 512 + (((4 * kk + g) ^ qi) << 4);
    } else vbase[0] = Vl + qi * 1200 + (arow0 * 40 + kb0 + 8 * g) * 2;
#define A16_VFR(mt, kk) (VMODE == 1 ? *(const LAS bf16x8*)(vbase[VMODE == 1 ? (kk) : 0] + (mt) * 8192) : *(const LAS bf16x8*)(vbase[0] + (mt) * 19200 + (kk) * 80))
    f32x4 s[16];
    bf16x8 kb[2][4][2];
    float bv[NA ? 16 : 1][4];
    const LAS float* bp = nullptr;
    if constexpr (NA) { const int qc = 16 * jb + qi; bp = rpb_h + (r0 - r + 7) * 31 + (band0 + 8 * g - qc + 15); }
#pragma unroll
    for (int tt = 0; tt < 4; ++tt) { kb[0][tt][0] = A16_KFR(tt, 0); kb[0][tt][1] = A16_KFR(tt, 1); }
#pragma unroll
    for (int gi = 0; gi < 4; ++gi) {
        if (gi < 3) {
#pragma unroll
            for (int tt = 0; tt < 4; ++tt) { kb[(gi + 1) & 1][tt][0] = A16_KFR(4 * (gi + 1) + tt, 0); kb[(gi + 1) & 1][tt][1] = A16_KFR(4 * (gi + 1) + tt, 1); }
        } else if constexpr (NA) {
#pragma unroll
            for (int t = 0; t < 16; ++t)
#pragma unroll
                for (int i = 0; i < 4; ++i) bv[t][i] = bp[(t >> 1) * 31 + 4 * (t & 1) + i];
        }
        __builtin_amdgcn_sched_barrier(0);
#pragma unroll
        for (int tt = 0; tt < 4; ++tt) { const f32x4 z = {0.f, 0.f, 0.f, 0.f}; s[4 * gi + tt] = __builtin_amdgcn_mfma_f32_16x16x32_bf16(kb[gi & 1][tt][0], qf[0], z, 0, 0, 0); }
#pragma unroll
        for (int tt = 0; tt < 4; ++tt) s[4 * gi + tt] = __builtin_amdgcn_mfma_f32_16x16x32_bf16(kb[gi & 1][tt][1], qf[1], s[4 * gi + tt], 0, 0, 0);
        __builtin_amdgcn_sched_barrier(0);
    }
    bf16x8 vb[2][8];
#pragma unroll
    for (int kk = 0; kk < 8; ++kk) vb[0][kk] = A16_VFR(0, kk);
    __builtin_amdgcn_sched_barrier(0);
    float m = -INFINITY;
    if constexpr (NA) {
        const int qc = 16 * jb + qi, cs = min(max(qc - 8, 0), 48);
        bool ok[2][4];
#pragma unroll
        for (int hh = 0; hh < 2; ++hh)
#pragma unroll
            for (int i = 0; i < 4; ++i) { const int kc = band0 + 8 * g + 4 * hh + i; ok[hh][i] = (kc >= cs) && (kc < cs + 16); }
#pragma unroll
        for (int t = 0; t < 16; ++t)
#pragma unroll
            for (int i = 0; i < 4; ++i) asm volatile("" : "+v"(bv[t][i]));
#pragma unroll
        for (int t = 0; t < 16; ++t)
#pragma unroll
            for (int i = 0; i < 4; ++i) { const float v = ok[t & 1][i] ? s[t][i] + bv[t][i] : -INFINITY; s[t][i] = v; m = fmaxf(m, v); }
    } else {
#pragma unroll
        for (int t = 0; t < 16; ++t)
#pragma unroll
            for (int i = 0; i < 4; ++i) m = fmaxf(m, s[t][i]);
    }
    m = fmaxf(m, __shfl_xor(m, 16)); m = fmaxf(m, __shfl_xor(m, 32));
    float l = 0.f;
    bf16x8 pf[8];
#pragma unroll
    for (int kk = 0; kk < 8; ++kk) {
        float p[8];
#pragma unroll
        for (int i = 0; i < 4; ++i) { p[i] = __builtin_amdgcn_exp2f(s[2 * kk][i] - m); p[4 + i] = __builtin_amdgcn_exp2f(s[2 * kk + 1][i] - m); }
#pragma unroll
        for (int i = 0; i < 8; ++i) l += p[i];
        v4u w; w.x = pk2(p[0], p[1]); w.y = pk2(p[2], p[3]); w.z = pk2(p[4], p[5]); w.w = pk2(p[6], p[7]);
        pf[kk] = __builtin_bit_cast(bf16x8, w);
    }
    l += __shfl_xor(l, 16); l += __shfl_xor(l, 32);
    const float inv = __builtin_amdgcn_rcpf(l);
    __builtin_amdgcn_sched_barrier(0);
#pragma unroll
    for (int mt = 0; mt < 4; ++mt) {
        if (mt < 3) {
#pragma unroll
            for (int kk = 0; kk < 8; ++kk) vb[(mt + 1) & 1][kk] = A16_VFR(mt + 1, kk);
        }
        __builtin_amdgcn_sched_barrier(0);
        f32x4 a0 = {0.f, 0.f, 0.f, 0.f}, a1 = {0.f, 0.f, 0.f, 0.f};
#pragma unroll
        for (int kk = 0; kk < 8; kk += 2) { a0 = __builtin_amdgcn_mfma_f32_16x16x32_bf16(vb[mt & 1][kk], pf[kk], a0, 0, 0, 0); a1 = __builtin_amdgcn_mfma_f32_16x16x32_bf16(vb[mt & 1][kk + 1], pf[kk + 1], a1, 0, 0, 0); }
        v2u w; w.x = pk2((a0[0] + a1[0]) * inv, (a0[1] + a1[1]) * inv); w.y = pk2((a0[2] + a1[2]) * inv, (a0[3] + a1[3]) * inv);
        *(v2u*)(O + (size_t)qi * ldo + 16 * mt + 4 * g) = w;
        __builtin_amdgcn_sched_barrier(0);
    }
#undef A16_KFR
#undef A16_VFR
}
template <int KRS>
__device__ __forceinline__ void na_qk_sm(int lane, const bf16x8 (&qf)[2], const LAS float* rpb_h, int r, int r0, int jb, int band0, const LAS unsigned char* Kl, int arow0, int kb0, bf16x8 (&pf)[8], float& inv) {
    const int qi = lane & 15, g = lane >> 4;
    const int krow = 8 * (qi >> 2) + (qi & 3);
    const LAS unsigned char* kbase[2][2];
#pragma unroll
    for (int e = 0; e < 2; ++e) { const int kcol = kb0 + krow + 4 * e, swz = (((kcol >> 3) & 3) << 1) | ((kcol >> 1) & 1); const LAS unsigned char* rb = Kl + (arow0 * KRS + kcol) * 128;
        kbase[e][0] = rb + ((g ^ swz) << 4); kbase[e][1] = rb + (((4 + g) ^ swz) << 4); }
#define A16_KFR(t, hh) (*(const LAS bf16x8*)(kbase[(t) & 1][hh] + ((t) >> 1) * (KRS * 128)))
    f32x4 s[16];
    bf16x8 kb[2][4][2];
    float bv[16][4];
    const int qc = 16 * jb + qi;
    const LAS float* bp = rpb_h + (r0 - r + 7) * 31 + (band0 + 8 * g - qc + 15);
#pragma unroll
    for (int tt = 0; tt < 4; ++tt) { kb[0][tt][0] = A16_KFR(tt, 0); kb[0][tt][1] = A16_KFR(tt, 1); }
#pragma unroll
    for (int gi = 0; gi < 4; ++gi) {
        if (gi < 3) {
#pragma unroll
            for (int tt = 0; tt < 4; ++tt) { kb[(gi + 1) & 1][tt][0] = A16_KFR(4 * (gi + 1) + tt, 0); kb[(gi + 1) & 1][tt][1] = A16_KFR(4 * (gi + 1) + tt, 1); }
        } else {
#pragma unroll
            for (int t = 0; t < 16; ++t)
#pragma unroll
                for (int i = 0; i < 4; ++i) bv[t][i] = bp[(t >> 1) * 31 + 4 * (t & 1) + i];
        }
        __builtin_amdgcn_sched_barrier(0);
#pragma unroll
        for (int tt = 0; tt < 4; ++tt) { const f32x4 z = {0.f, 0.f, 0.f, 0.f}; s[4 * gi + tt] = __builtin_amdgcn_mfma_f32_16x16x32_bf16(kb[gi & 1][tt][0], qf[0], z, 0, 0, 0); }
#pragma unroll
        for (int tt = 0; tt < 4; ++tt) s[4 * gi + tt] = __builtin_amdgcn_mfma_f32_16x16x32_bf16(kb[gi & 1][tt][1], qf[1], s[4 * gi + tt], 0, 0, 0);
        __builtin_amdgcn_sched_barrier(0);
    }
#undef A16_KFR
    float m = -INFINITY;
    { const int cs = min(max(qc - 8, 0), 48);
      bool ok[2][4];
#pragma unroll
      for (int hh = 0; hh < 2; ++hh)
#pragma unroll
          for (int i = 0; i < 4; ++i) { const int kc = band0 + 8 * g + 4 * hh + i; ok[hh][i] = (kc >= cs) && (kc < cs + 16); }
#pragma unroll
      for (int t = 0; t < 16; ++t)
#pragma unroll
          for (int i = 0; i < 4; ++i) asm volatile("" : "+v"(bv[t][i]));
#pragma unroll
      for (int t = 0; t < 16; ++t)
#pragma unroll
          for (int i = 0; i < 4; ++i) { const float v = ok[t & 1][i] ? s[t][i] + bv[t][i] : -INFINITY; s[t][i] = v; m = fmaxf(m, v); } }
    m = fmaxf(m, __shfl_xor(m, 16)); m = fmaxf(m, __shfl_xor(m, 32));
    float l = 0.f;
#pragma unroll
    for (int kk = 0; kk < 8; ++kk) {
        float p[8];
#pragma unroll
        for (int i = 0; i < 4; ++i) { p[i] = __builtin_amdgcn_exp2f(s[2 * kk][i] - m); p[4 + i] = __builtin_amdgcn_exp2f(s[2 * kk + 1][i] - m); }
#pragma unroll
        for (int i = 0; i < 8; ++i) l += p[i];
        v4u w; w.x = pk2(p[0], p[1]); w.y = pk2(p[2], p[3]); w.z = pk2(p[4], p[5]); w.w = pk2(p[6], p[7]);
        pf[kk] = __builtin_bit_cast(bf16x8, w);
    }
    l += __shfl_xor(l, 16); l += __shfl_xor(l, 32);
    inv = __builtin_amdgcn_rcpf(l);
}
__device__ __forceinline__ void na_pv(int lane, const bf16x8 (&pf)[8], float inv, bf16* O, int ldo, const LAS unsigned char* Vl, int arow0, int kb0) {
    const int qi = lane & 15, g = lane >> 4;
    const LAS unsigned char* vbase = Vl + qi * 1200 + (arow0 * 40 + kb0 + 8 * g) * 2;
#define A16_VFR(mt, kk) (*(const LAS bf16x8*)(vbase + (mt) * 19200 + (kk) * 80))
    bf16x8 vb[2][8];
#pragma unroll
    for (int kk = 0; kk < 8; ++kk) vb[0][kk] = A16_VFR(0, kk);
#pragma unroll
    for (int mt = 0; mt < 4; ++mt) {
        if (mt < 3) {
#pragma unroll
            for (int kk = 0; kk < 8; ++kk) vb[(mt + 1) & 1][kk] = A16_VFR(mt + 1, kk);
        }
        __builtin_amdgcn_sched_barrier(0);
        f32x4 a0 = {0.f, 0.f, 0.f, 0.f}, a1 = {0.f, 0.f, 0.f, 0.f};
#pragma unroll
        for (int kk = 0; kk < 8; kk += 2) { a0 = __builtin_amdgcn_mfma_f32_16x16x32_bf16(vb[mt & 1][kk], pf[kk], a0, 0, 0, 0); a1 = __builtin_amdgcn_mfma_f32_16x16x32_bf16(vb[mt & 1][kk + 1], pf[kk + 1], a1, 0, 0, 0); }
        v2u w; w.x = pk2((a0[0] + a1[0]) * inv, (a0[1] + a1[1]) * inv); w.y = pk2((a0[2] + a1[2]) * inv, (a0[3] + a1[3]) * inv);
        *(v2u*)(O + (size_t)qi * ldo + 16 * mt + 4 * g) = w;
        __builtin_amdgcn_sched_barrier(0);
    }
#undef A16_VFR
}
__device__ __forceinline__ void memkv_item(int it, int lane, const bf16* membf, const bf16* wt, const float* mrstd, bf16* memk, bf16* memvt) {
    const int rt = it >> 4, ctile = it & 15, qi = lane & 15, g = lane >> 4, row0 = rt * 16, col0 = ctile * 32;
    const bf16* ap = membf + (size_t)(row0 + qi) * DM + 8 * g; const bf16* bp = wt + (size_t)(col0 + qi) * DM + 8 * g;
    f32x4 acc0 = {0.f, 0.f, 0.f, 0.f}, acc1 = {0.f, 0.f, 0.f, 0.f};
    const bool isk = col0 < 256;
    if (isk) {
#pragma unroll 1
        for (int k8 = 0; k8 < 32; k8 += 8) { bf16x8 a[8], b0[8], b1[8];
#pragma unroll
            for (int j = 0; j < 8; ++j) { a[j] = *(const bf16x8*)(ap + 32 * (k8 + j)); b0[j] = *(const bf16x8*)(bp + 32 * (k8 + j)); b1[j] = *(const bf16x8*)(bp + 16 * DM + 32 * (k8 + j)); }
#pragma unroll
            for (int j = 0; j < 8; ++j) { acc0 = __builtin_amdgcn_mfma_f32_16x16x32_bf16(b0[j], a[j], acc0, 0, 0, 0); acc1 = __builtin_amdgcn_mfma_f32_16x16x32_bf16(b1[j], a[j], acc1, 0, 0, 0); } }
    } else {
#pragma unroll 1
        for (int k8 = 0; k8 < 32; k8 += 8) { bf16x8 a[8], b0[8], b1[8];
#pragma unroll
            for (int j = 0; j < 8; ++j) { a[j] = *(const bf16x8*)(ap + 32 * (k8 + j)); b0[j] = *(const bf16x8*)(bp + 32 * (k8 + j)); b1[j] = *(const bf16x8*)(bp + 16 * DM + 32 * (k8 + j)); }
#pragma unroll
            for (int j = 0; j < 8; ++j) { acc0 = __builtin_amdgcn_mfma_f32_16x16x32_bf16(a[j], b0[j], acc0, 0, 0, 0); acc1 = __builtin_amdgcn_mfma_f32_16x16x32_bf16(a[j], b1[j], acc1, 0, 0, 0); } }
    }
    if (isk) {
        const float s = mrstd[row0 + qi]; bf16* p = memk + (size_t)(row0 + qi) * 256 + col0 + 4 * g;
        v2u w; w.x = pk2(acc0[0] * s, acc0[1] * s); w.y = pk2(acc0[2] * s, acc0[3] * s); *(v2u*)p = w;
        w.x = pk2(acc1[0] * s, acc1[1] * s); w.y = pk2(acc1[2] * s, acc1[3] * s); *(v2u*)(p + 16) = w;
    } else {
        const f32x4 s = *(const f32x4*)(mrstd + row0 + 4 * g); bf16* p = memvt + (size_t)(col0 - 256 + qi) * MEM_ROWS + row0 + 4 * g;
        v2u w; w.x = pk2(acc0[0] * s[0], acc0[1] * s[1]); w.y = pk2(acc0[2] * s[2], acc0[3] * s[3]); *(v2u*)p = w;
        w.x = pk2(acc1[0] * s[0], acc1[1] * s[1]); w.y = pk2(acc1[2] * s[2], acc1[3] * s[3]); *(v2u*)(p + (size_t)16 * MEM_ROWS) = w;
    }
}
__device__ __forceinline__ void memattn_strip(const Frame& F, int item, const bf16* act, int ld, int qoff, const bf16* memk, const bf16* memvt, bf16* mix) {
    const int tg = item & 15, h = (item >> 4) & 3, b = item >> 6, lane = LANE(), wave = F.wave;
    LAS unsigned char* Kl = F.lds; LAS unsigned char* Vl = F.lds + 32768;
#pragma unroll
    for (int j = 0; j < 4; ++j) {
        const int p = (wave * 4 + j) * 64 + lane, key = p >> 3, kpos = p & 7, kc = key & 31, swz = (((kc >> 3) & 3) << 1) | ((kc >> 1) & 1);
        __builtin_amdgcn_global_load_lds((const unsigned*)(memk + (size_t)(b * 256 + key) * 256 + h * 64 + ((kpos ^ swz) << 3)), (LAS unsigned*)(Kl + (wave * 4 + j) * 1024), 16, 0, 0);
        const int d = p >> 5, vpos = p & 31;
        __builtin_amdgcn_global_load_lds((const unsigned*)(memvt + (size_t)(h * 64 + d) * MEM_ROWS + b * 256 + ((vpos ^ (d & 15)) << 3)), (LAS unsigned*)(Vl + (wave * 4 + j) * 1024), 16, 0, 0);
    }
    asm volatile("s_waitcnt vmcnt(0)\n\ts_barrier" ::: "memory");
#pragma unroll 1
    for (int u = 0; u < 2; ++u) {
        const int tok0 = b * SEQ + tg * 256 + (wave * 2 + u) * 16;
        attn16_lds<false, 1, 32>(lane, act + (size_t)tok0 * ld + qoff + h * 64, ld, mix + (size_t)tok0 * DM + 768 + h * 64, DM, nullptr, 0, 0, 0, 0, Kl, 0, Vl, 0);
    }
    asm volatile("s_waitcnt lgkmcnt(0)\n\ts_barrier" ::: "memory");
}
__device__ __forceinline__ void memattn_item(int it, int lane, const bf16* act, int ld, int qoff, const bf16* memk, const bf16* memvt, bf16* mix) {
    const int tb = it >> 2, h = it & 3, tok0 = tb * 16, b = tok0 >> 12;
    attn16<false>(lane, act + (size_t)tok0 * ld + qoff + h * 64, ld, memk + h * 64, 256, memvt + (size_t)(h * 64) * MEM_ROWS, MEM_ROWS, b * 256, 32,
                  mix + (size_t)tok0 * DM + 768 + h * 64, DM, nullptr, 0, 0, 0, 0);
}
constexpr int NA_RPB_OFF = 122880;
__device__ __forceinline__ void na_strip(const Frame& F, int item, const bf16* act0, const bf16* v0t, bf16* mix) {
    const int s8 = item & 7, h = (item >> 3) % 12, b = (item >> 3) / 12, lane = LANE(), wave = F.wave;
    const int R0 = 8 * s8, rowbase = min(max(R0 - 4, 0), 56), rowend = min(max(R0 + 7 - 4, 0), 56) + 8, nrows = rowend - rowbase;
    LAS unsigned char* Kl = F.lds;
    {
        const int col = wave * 8 + (lane >> 3), pos = lane & 7, swz = (((col >> 3) & 3) << 1) | ((col >> 1) & 1);
        const bf16* src = act0 + (size_t)(b * SEQ + rowbase * 64 + col) * A0_LD + 768 + h * 64 + ((pos ^ swz) << 3);
        for (int j = 0; j < nrows; ++j)
            __builtin_amdgcn_global_load_lds((const unsigned*)(src + (size_t)j * 64 * A0_LD), (LAS unsigned*)(Kl + j * 8192 + wave * 1024), 16, 0, 0);
    }
    asm volatile("s_waitcnt vmcnt(0)\n\ts_barrier" ::: "memory");
    const int r = R0 + wave, r0 = min(max(r - 4, 0), 56);
    const LAS float* rpb = (const LAS float*)(F.lds + NA_RPB_OFF) + h * 465;
#pragma unroll 1
    for (int jb = 0; jb < 4; ++jb) {
        const int band0 = min(max(jb * 16 - 8, 0), 32), tok0 = b * SEQ + r * 64 + jb * 16;
        attn16<true, true>(lane, act0 + (size_t)tok0 * A0_LD + h * 64, A0_LD, nullptr, 0, v0t + (size_t)(h * 64) * NT, NT, b * SEQ + r0 * 64 + band0, 64,
                           mix + (size_t)tok0 * DM + h * 64, DM, rpb, r, r0, jb, band0, Kl, r0 - rowbase, nullptr, band0);
    }
    asm volatile("s_waitcnt lgkmcnt(0)\n\ts_barrier" ::: "memory");
}
constexpr int NAH_V = 76800, NAH_RPB = 153600;
__device__ __forceinline__ void na_hstrip(const Frame& F, int item, const bf16* act0, const bf16* v0t, const float* rpb_g, bf16* mix) {
    const int half = item & 1, s8 = (item >> 1) & 7, h = (item >> 4) % 12, b = (item >> 4) / 12, lane = LANE(), wave = F.wave;
    const int R0 = 8 * s8, rowbase = min(max(R0 - 4, 0), 56), rowend = min(max(R0 + 7 - 4, 0), 56) + 8, nrows = rowend - rowbase, cb0 = half ? 24 : 0;
    LAS unsigned char* Kl = F.lds; LAS unsigned char* Vl = F.lds + NAH_V; LAS float* rl = (LAS float*)(F.lds + NAH_RPB);
    {
        const int pos = lane & 7, nk = nrows * 5 - 1;
#pragma unroll
        for (int i = 0; i < 10; ++i) { const int k = min(wave + NWAVES * i, 74), idx = min(k, nk);
            { const int j = idx / 5, q = idx - 5 * j, lc = q * 8 + (lane >> 3), swz = (((lc >> 3) & 3) << 1) | ((lc >> 1) & 1);
              __builtin_amdgcn_global_load_lds((const unsigned*)(act0 + (size_t)(b * SEQ + (rowbase + j) * 64 + cb0 + lc) * A0_LD + 768 + h * 64 + ((pos ^ swz) << 3)), (LAS unsigned*)(Kl + idx * 1024), 16, 0, 0); }
            { const int G = k * 64 + lane, d = G / 75, rem = G - 75 * d, j0 = rem / 5, gc = rem - 5 * j0, j = min(j0, nrows - 1);
              __builtin_amdgcn_global_load_lds((const unsigned*)(v0t + (size_t)(h * 64 + d) * NT + b * SEQ + (rowbase + j) * 64 + cb0 + gc * 8), (LAS unsigned*)(Vl + k * 1024), 16, 0, 0); } }
    }
    float bias = 0.f; if (TID() < 465) bias = rpb_g[h * 465 + TID()];
    asm volatile("" : "+v"(bias));
    bias *= 1.4426950408889634f;
    if (TID() < 465) rl[TID()] = bias;
    asm volatile("s_waitcnt vmcnt(0) lgkmcnt(0)\n\ts_barrier" ::: "memory");
    const int r = R0 + wave, r0 = min(max(r - 4, 0), 56);
#pragma unroll 1
    for (int u = 0; u < 2; ++u) {
        const int jb = 2 * half + u, band0 = min(max(jb * 16 - 8, 0), 32), tok0 = b * SEQ + r * 64 + jb * 16;
        attn16_lds<true, 2, 40>(lane, act0 + (size_t)tok0 * A0_LD + h * 64, A0_LD, mix + (size_t)tok0 * DM + h * 64, DM, rl, r, r0, jb, band0, Kl, r0 - rowbase, Vl, band0 - cb0);
    }
    asm volatile("s_waitcnt lgkmcnt(0)\n\ts_barrier" ::: "memory");
}
struct NaItem { int half, h, b, R0, rowbase, nrows, cb0; };
__device__ __forceinline__ NaItem na_decode(int item) { NaItem t; t.half = item & 1; const int s8 = (item >> 1) & 7; t.h = (item >> 4) % 12; t.b = (item >> 4) / 12; t.R0 = 8 * s8;
    t.rowbase = min(max(t.R0 - 4, 0), 56); t.nrows = min(max(t.R0 + 7 - 4, 0), 56) + 8 - t.rowbase; t.cb0 = t.half ? 24 : 0; return t; }
__device__ __forceinline__ void na_issue_k(const NaItem& t, int wave, const bf16* act0, LAS unsigned char* Kl) {
    const int lane = lane_id(), pos = lane & 7, nk = t.nrows * 5 - 1;
#pragma unroll
    for (int i = 0; i < 10; ++i) { const int idx = min(wave + NWAVES * i, nk), j = idx / 5, q = idx - 5 * j, lc = q * 8 + (lane >> 3), swz = (((lc >> 3) & 3) << 1) | ((lc >> 1) & 1);
        __builtin_amdgcn_global_load_lds((const unsigned*)(act0 + (size_t)(t.b * SEQ + (t.rowbase + j) * 64 + t.cb0 + lc) * A0_LD + 768 + t.h * 64 + ((pos ^ swz) << 3)), (LAS unsigned*)(Kl + idx * 1024), 16, 0, 0); }
}
__device__ __forceinline__ void na_issue_v(const NaItem& t, int wave, const bf16* v0t, LAS unsigned char* Vl) {
    const int lane = lane_id();
#pragma unroll
    for (int i = 0; i < 10; ++i) { const int k = min(wave + NWAVES * i, 74), G = k * 64 + lane, d = G / 75, rem = G - 75 * d, j0 = rem / 5, gc = rem - 5 * j0, j = min(j0, t.nrows - 1);
        __builtin_amdgcn_global_load_lds((const unsigned*)(v0t + (size_t)(t.h * 64 + d) * NT + t.b * SEQ + (t.rowbase + j) * 64 + t.cb0 + gc * 8), (LAS unsigned*)(Vl + k * 1024), 16, 0, 0); }
}
__device__ __forceinline__ void na_phase(const Frame& F, const bf16* act0, const bf16* v0t, const float* rpb2, bf16* mix) {
    const int wave = F.wave;
    LAS unsigned char* Kl = F.lds; LAS unsigned char* Vl = F.lds + NAH_V; LAS float* rl = (LAS float*)(F.lds + NAH_RPB);
    const int item0 = (F.bid & 7) * 192 + (F.bid >> 3);
    { const NaItem t0 = na_decode(item0); na_issue_k(t0, wave, act0, Kl); }
#pragma unroll 1
    for (int i = 0; i < 6; ++i) {
        const NaItem t = na_decode(item0 + 32 * i);
        const int lane = lane_id(), qi = lane & 15, g = lane >> 4;
        const int r = t.R0 + wave, r0 = min(max(r - 4, 0), 56), arow0 = r0 - t.rowbase;
        const int tokA = t.b * SEQ + r * 64 + (2 * t.half) * 16, tokB = tokA + 16;
        v4u q0, q1;
        const bf16* qa = act0 + (size_t)(tokA + qi) * A0_LD + t.h * 64 + 8 * g;
        asm volatile("global_load_dwordx4 %0, %1, off" : "=v"(q0) : "v"(qa)); asm volatile("global_load_dwordx4 %0, %1, off offset:64" : "=v"(q1) : "v"(qa));
        if (wave < 2) __builtin_amdgcn_global_load_lds((const unsigned*)(rpb2 + t.h * 480 + 4 * min(wave * 64 + lane, 119)), (LAS unsigned*)((LAS unsigned char*)rl + wave * 1024), 16, 0, 0);
        na_issue_v(t, wave, v0t, Vl);
        asm volatile("s_waitcnt vmcnt(10)\n\ts_barrier" : "+v"(q0), "+v"(q1) :: "memory");
        bf16x8 pf[8]; float inv;
        { const bf16x8 qf[2] = {__builtin_bit_cast(bf16x8, q0), __builtin_bit_cast(bf16x8, q1)}; const int jb = 2 * t.half, band0 = min(max(jb * 16 - 8, 0), 32);
          na_qk_sm<40>(lane, qf, rl, r, r0, jb, band0, Kl, arow0, band0 - t.cb0, pf, inv); }
        asm volatile("s_waitcnt vmcnt(0)\n\ts_barrier" ::: "memory");
        { const bf16* qb = qa + (size_t)16 * A0_LD;
          asm volatile("global_load_dwordx4 %0, %1, off" : "=v"(q0) : "v"(qb)); asm volatile("global_load_dwordx4 %0, %1, off offset:64" : "=v"(q1) : "v"(qb)); }
        { const int band0 = min(max((2 * t.half) * 16 - 8, 0), 32); na_pv(lane, pf, inv, mix + (size_t)tokA * DM + t.h * 64, DM, Vl, arow0, band0 - t.cb0); }
        asm volatile("s_waitcnt vmcnt(4)" : "+v"(q0), "+v"(q1) :: "memory");
        { const bf16x8 qf[2] = {__builtin_bit_cast(bf16x8, q0), __builtin_bit_cast(bf16x8, q1)}; const int jb = 2 * t.half + 1, band0 = min(max(jb * 16 - 8, 0), 32);
          na_qk_sm<40>(lane, qf, rl, r, r0, jb, band0, Kl, arow0, band0 - t.cb0, pf, inv); }
        asm volatile("s_waitcnt lgkmcnt(0)\n\ts_barrier" ::: "memory");
        if (i + 1 < 6) { const NaItem tn = na_decode(item0 + 32 * (i + 1)); na_issue_k(tn, wave, act0, Kl); }
        { const int band0 = min(max((2 * t.half + 1) * 16 - 8, 0), 32); na_pv(lane, pf, inv, mix + (size_t)tokB * DM + t.h * 64, DM, Vl, arow0, band0 - t.cb0); }
        asm volatile("s_waitcnt lgkmcnt(0)\n\ts_barrier" ::: "memory");
    }
}
__device__ __forceinline__ void na_item(int it, int lane, const bf16* act0, const bf16* v0t, const LAS float* rpb, bf16* mix) {
    const int jb = it & 3, h = (it >> 2) % 12, br = (it >> 2) / 12, r = br & 63, b = br >> 6;
    const int r0 = min(max(r - 4, 0), 56), band0 = min(max(jb * 16 - 8, 0), 32);
    const int tok0 = b * SEQ + r * 64 + jb * 16;
    attn16<true>(lane, act0 + (size_t)tok0 * A0_LD + h * 64, A0_LD, act0 + 768 + h * 64, A0_LD, v0t + (size_t)(h * 64) * NT, NT, b * SEQ + r0 * 64 + band0, 64,
                 mix + (size_t)tok0 * DM + h * 64, DM, rpb + h * 465, r, r0, jb, band0);
}

constexpr int GP_LD = 392;
__device__ __forceinline__ void gla_pre_w(int wave, int lane, const float* W, const float* Bi, bf16x8 (&wfr)[3], float (&bias)[3]) {
    const int qi = lane & 15, g = lane >> 4;
#pragma unroll
    for (int jj = 0; jj < 3; ++jj) {
        const int j = 16 * (wave + 8 * jj) + qi;
        v4u wu = {0u, 0u, 0u, 0u};
        if (g < 2) { const float* wp = W + (size_t)(8 * g) * 384 + j;
            wu.x = pk2(wp[0], wp[384]); wu.y = pk2(wp[768], wp[1152]); wu.z = pk2(wp[1536], wp[1920]); wu.w = pk2(wp[2304], wp[2688]); }
        wfr[jj] = __builtin_bit_cast(bf16x8, wu); bias[jj] = Bi[j];
    }
}
__device__ __forceinline__ void gla_pre_item(const Frame& F, int item, const bf16* act1, const bf16x8 (&wfr)[3], const float (&bias)[3], bf16* QT, bf16* KT, float* DEC) {
    const int n = item & 63, dir = (item >> 6) & 1, b = item >> 7, base = b * SEQ + n * 64;
    const int tid = TID(), lane = LANE(), wave = F.wave, qi = lane & 15, g = lane >> 4;
    LAS bf16* EL = (LAS bf16*)F.lds;
    bf16x8 zf[4];
#pragma unroll
    for (int ct = 0; ct < 4; ++ct) { const int c = 16 * ct + qi, tok = dir ? base + 63 - c : base + c;
        bf16x8 z = {0, 0, 0, 0, 0, 0, 0, 0}; if (g < 2) z = *(const bf16x8*)(act1 + (size_t)tok * A1_LD + 1792 + dir * 16 + 8 * g); zf[ct] = z; }
    v4u q8a[6], k8a[6];
#pragma unroll
    for (int k = 0; k < 6; ++k) { const int idx = tid + 512 * k, c = idx / 48, jg = idx % 48; const bf16* arow = act1 + (size_t)(base + c) * A1_LD + 8 * jg; q8a[k] = *(const v4u*)arow; k8a[k] = *(const v4u*)(arow + 384); }
#pragma unroll
    for (int jj = 0; jj < 3; ++jj) {
        const int j = 16 * (wave + 8 * jj) + qi;
        float p[4][4], a[4], t1[4], t2[4], tot[4];
#pragma unroll
        for (int ct = 0; ct < 4; ++ct) {
            f32x4 d = {0.f, 0.f, 0.f, 0.f};
            d = __builtin_amdgcn_mfma_f32_16x16x32_bf16(zf[ct], wfr[jj], d, 0, 0, 0);
#pragma unroll
            for (int i = 0; i < 4; ++i) { const float x = d[i] + bias[jj];
                p[ct][i] = (fminf(x, 0.f) * 1.4426950408889634f - __builtin_amdgcn_logf(1.0f + __builtin_amdgcn_exp2f(fabsf(x) * -1.4426950408889634f))) * 0.0625f; }
            p[ct][1] += p[ct][0]; p[ct][2] += p[ct][1]; p[ct][3] += p[ct][2]; a[ct] = p[ct][3];
        }
#pragma unroll
        for (int ct = 0; ct < 4; ++ct) t1[ct] = __shfl_up(a[ct], 16);
#pragma unroll
        for (int ct = 0; ct < 4; ++ct) if (g >= 1) a[ct] += t1[ct];
#pragma unroll
        for (int ct = 0; ct < 4; ++ct) t2[ct] = __shfl_up(a[ct], 32);
#pragma unroll
        for (int ct = 0; ct < 4; ++ct) if (g >= 2) a[ct] += t2[ct];
#pragma unroll
        for (int ct = 0; ct < 4; ++ct) tot[ct] = __shfl(a[ct], 48 + qi);
        float carry = 0.f;
#pragma unroll
        for (int ct = 0; ct < 4; ++ct) {
            const float excl = a[ct] - p[ct][3] + carry;
            carry += tot[ct];
#pragma unroll
            for (int i = 0; i < 4; ++i) { const int c = 16 * ct + 4 * g + i, ctok = dir ? 63 - c : c; EL[ctok * GP_LD + j] = (bf16)f2bf(__builtin_amdgcn_exp2f(excl + p[ct][i])); }
        }
    }
    __syncthreads();
    const int clast = dir ? 0 : 63;
#pragma unroll
    for (int k = 0; k < 6; ++k) {
        const int idx = tid + 512 * k, c = idx / 48, jg = idx % 48;
        const v4u q8 = q8a[k], k8 = k8a[k];
        const v4u e8 = *(const LAS v4u*)(EL + c * GP_LD + 8 * jg), l8 = *(const LAS v4u*)(EL + clast * GP_LD + 8 * jg);
        const unsigned qa[4] = {q8.x, q8.y, q8.z, q8.w}, ka[4] = {k8.x, k8.y, k8.z, k8.w}, ea[4] = {e8.x, e8.y, e8.z, e8.w}, la[4] = {l8.x, l8.y, l8.z, l8.w};
        unsigned qo[4], ko[4];
        float lf[8];
#pragma unroll
        for (int i = 0; i < 4; ++i) {
            const float e0 = bflo(ea[i]), e1 = bfhi(ea[i]), i0 = __builtin_amdgcn_rcpf(e0), i1 = __builtin_amdgcn_rcpf(e1);
            const float kt0 = bflo(ka[i]) * i0, kt1 = bfhi(ka[i]) * i1; lf[2 * i] = bflo(la[i]); lf[2 * i + 1] = bfhi(la[i]);
            qo[i] = pk2(bflo(qa[i]) * 0.10206207261596575f * e0, bfhi(qa[i]) * 0.10206207261596575f * e1);
            ko[i] = pk2(kt0, kt1);
        }
        v4u w; w.x = qo[0]; w.y = qo[1]; w.z = qo[2]; w.w = qo[3]; *(v4u*)(QT + (size_t)(base + c) * 384 + 8 * jg) = w;
        w.x = ko[0]; w.y = ko[1]; w.z = ko[2]; w.w = ko[3]; *(v4u*)(KT + (size_t)(base + c) * 384 + 8 * jg) = w;
        if (c == clast) { float* dp = DEC + (size_t)((b * 4 + jg / 12) * 64 + n) * 96 + (jg % 12) * 8;
            *(f32x4*)dp = (f32x4){lf[0], lf[1], lf[2], lf[3]}; *(f32x4*)(dp + 4) = (f32x4){lf[4], lf[5], lf[6], lf[7]}; }
    }
    __syncthreads();
}
constexpr int GL_QT = 0, GL_KT = 13312, GL_VT = 26624, GL_DEC = 33792, GL_BUF = 34816;
__device__ __forceinline__ void gla_main_item(const Frame& F, int item, const bf16* QTa, const bf16* KTa, const float* DECa, const bf16* v1t, bf16* OFp, bf16* OBp,
                                              const float* cwg, const float* cwu, const float* cgain, unsigned char* c8) {
    const int vs = item & 3, dir = (item >> 2) & 1, h = (item >> 3) & 3, b = item >> 5;
    const int lane = LANE(), wave = F.wave, qi = lane & 15, g = lane >> 4;
    bf16* O = dir ? OBp : OFp;
    LAS unsigned char* L = F.lds;
    constexpr int GL_SB = 3 * GL_BUF;
    for (int i = TID(); i < 18 * 512 / 8; i += NTHR) *(LAS v2u*)(L + GL_SB + i * 8) = (v2u){0u, 0u};
    const char* qtb = (const char*)(QTa + (size_t)dir * NT * 384 + h * 96); const char* ktb = (const char*)(KTa + (size_t)dir * NT * 384 + h * 96);
    const char* deb = (const char*)(DECa + (size_t)dir * 8 * 4 * 64 * 96 + (size_t)((b * 4 + h) * 64) * 96);
    const char* vtb = (const char*)(v1t + (size_t)(h * 192 + vs * 48) * NT);
#define GL_OFF(k_) ((k_) < 26 ? (unsigned)((((k_) < 13 ? (k_) : (k_) - 13) * 64 + lane) / 13 * 768 + ((((k_) < 13 ? (k_) : (k_) - 13) * 64 + lane) % 13 < 12 ? ((((k_) < 13 ? (k_) : (k_) - 13) * 64 + lane) % 13) * 16 : 0)) \
                   : ((k_) < 33 ? ((((k_) - 26) * 64 + lane) < 432 ? (unsigned)((((k_) - 26) * 64 + lane) / 9 * NT * 2 + ((((k_) - 26) * 64 + lane) % 9 < 8 ? ((((k_) - 26) * 64 + lane) % 9) * 16 : 0)) : 0u) : ((lane < 24) ? (unsigned)(lane * 16) : 0u)))
#define GL_PIECE(k_, offv_, n_, bufo_) do { const int nn_ = dir ? 63 - (n_) : (n_); const size_t tb_ = (size_t)(b * SEQ + nn_ * 64); \
            const char* src_ = (k_) < 13 ? qtb + tb_ * 768 : ((k_) < 26 ? ktb + tb_ * 768 : ((k_) < 33 ? vtb + tb_ * 2 : deb + (size_t)nn_ * 384)); \
            __builtin_amdgcn_global_load_lds((const unsigned*)(src_ + (offv_)), (LAS unsigned*)(L + (bufo_) + (k_) * 1024), 16, 0, 0); } while (0)
    if (wave < 4) {
        const int ct = wave;
        unsigned kmw[2][4];
#pragma unroll
        for (int kk = 0; kk < 2; ++kk)
#pragma unroll
            for (int w2 = 0; w2 < 4; ++w2) { const int tp = 2 * kk + (w2 >> 1), i0 = 2 * (w2 & 1), c = 16 * ct + qi, cp = 16 * tp + 4 * g + i0;
                const bool k0 = dir ? (cp > c) : (cp <= c), k1 = dir ? (cp + 1 > c) : (cp + 1 <= c); kmw[kk][w2] = (k0 ? 0x0000ffffu : 0u) | (k1 ? 0xffff0000u : 0u); }
        unsigned offo[5];
#pragma unroll
        for (int jj = 0; jj < 5; ++jj) { const int k = wave + 4 * jj; offo[jj] = GL_OFF(k); }
#define GL_DMA_O(n_, bufo_) do { _Pragma("unroll") for (int jj_ = 0; jj_ < 5; ++jj_) { const int k_ = wave + 4 * jj_; GL_PIECE(k_, offo[jj_], n_, bufo_); } } while (0)
        GL_DMA_O(0, 0); GL_DMA_O(1, GL_BUF);
        asm volatile("s_waitcnt vmcnt(0) lgkmcnt(0)\n\ts_barrier" ::: "memory");
        int bo = 0, bo2 = 2 * GL_BUF;
#pragma unroll 1
        for (int n = 0; n < 64; ++n) {
            const LAS unsigned char* Bf = L + bo; const LAS unsigned char* SBr = L + GL_SB + (n & 1) * 9216;
            asm volatile("s_waitcnt vmcnt(0)" ::: "memory");
            { const int n2 = n + 2 < 64 ? n + 2 : 63; GL_DMA_O(n2, bo2); }
            bf16x8 qf[3], kf[4][3], qp[3], vf[3][2], sf[3][3];
#pragma unroll
            for (int ks = 0; ks < 3; ++ks) qf[ks] = *(const LAS bf16x8*)(Bf + GL_QT + (16 * ct + qi) * 208 + (32 * ks + 8 * g) * 2);
#pragma unroll
            for (int tp = 0; tp < 4; ++tp)
#pragma unroll
                for (int ks = 0; ks < 3; ++ks) kf[tp][ks] = *(const LAS bf16x8*)(Bf + GL_KT + (16 * tp + qi) * 208 + (32 * ks + 8 * g) * 2);
#pragma unroll
            for (int kk = 0; kk < 3; ++kk) { const LAS unsigned char* qr = Bf + GL_QT + (16 * ct + qi) * 208 + (32 * kk + 4 * g) * 2;
                const s16x4 a0 = *(const LAS s16x4*)qr, a1 = *(const LAS s16x4*)(qr + 32); qp[kk] = __builtin_shufflevector(a0, a1, 0, 1, 2, 3, 4, 5, 6, 7); }
#pragma unroll
            for (int vt = 0; vt < 3; ++vt) {
#pragma unroll
                for (int kk = 0; kk < 2; ++kk) { const LAS unsigned char* vr = Bf + GL_VT + (16 * vt + qi) * 144 + (32 * kk + 4 * g) * 2;
                    const s16x4 a0 = *(const LAS s16x4*)vr, a1 = *(const LAS s16x4*)(vr + 32); vf[vt][kk] = __builtin_shufflevector(a0, a1, 0, 1, 2, 3, 4, 5, 6, 7); }
#pragma unroll
                for (int kk = 0; kk < 3; ++kk) { const LAS unsigned char* sr = SBr + (vt * 6 + 2 * kk) * 512 + lane * 8;
                    const s16x4 a0 = *(const LAS s16x4*)sr, a1 = *(const LAS s16x4*)(sr + 512); sf[vt][kk] = __builtin_shufflevector(a0, a1, 0, 1, 2, 3, 4, 5, 6, 7); } }
            __builtin_amdgcn_sched_barrier(0);
            f32x4 am[4];
#pragma unroll
            for (int tp = 0; tp < 4; ++tp) {
                f32x4 z = {0.f, 0.f, 0.f, 0.f};
#pragma unroll
                for (int ks = 0; ks < 3; ++ks) z = __builtin_amdgcn_mfma_f32_16x16x32_bf16(kf[tp][ks], qf[ks], z, 0, 0, 0);
                am[tp] = z;
            }
            bf16x8 pf[2];
#pragma unroll
            for (int kk = 0; kk < 2; ++kk) { v4u w; w.x = pk2(am[2 * kk][0], am[2 * kk][1]) & kmw[kk][0]; w.y = pk2(am[2 * kk][2], am[2 * kk][3]) & kmw[kk][1]; w.z = pk2(am[2 * kk + 1][0], am[2 * kk + 1][1]) & kmw[kk][2]; w.w = pk2(am[2 * kk + 1][2], am[2 * kk + 1][3]) & kmw[kk][3];
                pf[kk] = __builtin_bit_cast(bf16x8, w); }
            const int nn = dir ? 63 - n : n, tok = b * SEQ + nn * 64 + 16 * ct + qi;
            f32x4 oacc[3];
#pragma unroll
            for (int vt = 0; vt < 3; ++vt) {
                f32x4 acc = {0.f, 0.f, 0.f, 0.f};
#pragma unroll
                for (int kk = 0; kk < 3; ++kk) acc = __builtin_amdgcn_mfma_f32_16x16x32_bf16(sf[vt][kk], qp[kk], acc, 0, 0, 0);
                oacc[vt] = acc;
            }
#pragma unroll
            for (int vt = 0; vt < 3; ++vt) {
#pragma unroll
                for (int kk = 0; kk < 2; ++kk) oacc[vt] = __builtin_amdgcn_mfma_f32_16x16x32_bf16(vf[vt][kk], pf[kk], oacc[vt], 0, 0, 0);
            }
#pragma unroll
            for (int vt = 0; vt < 3; ++vt) { v2u w; w.x = pk2(oacc[vt][0], oacc[vt][1]); w.y = pk2(oacc[vt][2], oacc[vt][3]);
                *(v2u*)(O + (size_t)tok * 768 + h * 192 + vs * 48 + 16 * vt + 4 * g) = w; }
            asm volatile("s_waitcnt lgkmcnt(0)\n\ts_barrier" ::: "memory");
            { const int t_ = bo; bo = (bo == 2 * GL_BUF) ? 0 : bo + GL_BUF; bo2 = t_; }
        }
#undef GL_DMA_O
    } else {
        const int w4 = wave - 4;
        unsigned off[4];
#pragma unroll
        for (int jj = 0; jj < 4; ++jj) { const int k = 20 + w4 + 4 * jj; off[jj] = GL_OFF(k); }
#define GL_DMA(n_, bufo_) do { _Pragma("unroll") for (int jj_ = 0; jj_ < 4; ++jj_) { const int k_ = 20 + w4 + 4 * jj_; if (k_ < 34) GL_PIECE(k_, off[jj_], n_, bufo_); } } while (0)
        int oT[5]; bool oV[5];
#pragma unroll
        for (int j = 0; j < 5; ++j) { oV[j] = (j < 4) || (w4 < 2); oT[j] = oV[j] ? w4 + 4 * j : w4 + 12; }
        const unsigned vmsk = 0u - (unsigned)(w4 >> 1);
        f32x4 So[5];
#pragma unroll
        for (int j = 0; j < 5; ++j) So[j] = (f32x4){0.f, 0.f, 0.f, 0.f};
        f32x4 cv[8], cg[2];
#pragma unroll
        for (int j = 0; j < 8; ++j) cv[j] = (f32x4){0.f, 0.f, 0.f, 0.f};
        cg[0] = cv[0]; cg[1] = cv[0];
        LAS unsigned* CT = (LAS unsigned*)(L + GL_SB + 18432 + w4 * 2304);
        const int gw2 = F.bid * 4 + w4;
        GL_DMA(0, 0); GL_DMA(1, GL_BUF);
        asm volatile("s_waitcnt vmcnt(0) lgkmcnt(0)\n\ts_barrier" ::: "memory");
        int bo = 0, bo2 = 2 * GL_BUF;
#pragma unroll 1
        for (int n = 0; n < 64; ++n) {
            const LAS unsigned char* Bf = L + bo; LAS unsigned char* SBw = L + GL_SB + ((n + 1) & 1) * 9216;
            asm volatile("s_waitcnt vmcnt(0)" ::: "memory");
            f32x4 dec[5]; bf16x8 kdf[5][2], vfr[3][2];
#pragma unroll
            for (int vt = 0; vt < 3; ++vt)
#pragma unroll
                for (int kk = 0; kk < 2; ++kk) { const LAS unsigned char* vr = Bf + GL_VT + (16 * vt + qi) * 144 + (32 * kk + 4 * g) * 2;
                    const s16x4 a0 = *(const LAS s16x4*)vr, a1 = *(const LAS s16x4*)(vr + 32); vfr[vt][kk] = __builtin_shufflevector(a0, a1, 0, 1, 2, 3, 4, 5, 6, 7); }
#pragma unroll
            for (int j = 0; j < 5; ++j) { const int T = oT[j], vt = T / 6, dt = T - 6 * vt;
                dec[j] = *(const LAS f32x4*)(Bf + GL_DEC + (16 * dt + 4 * g) * 4);
#pragma unroll
                for (int ks = 0; ks < 2; ++ks) {
                    const LAS unsigned char* kr = Bf + GL_KT + (32 * ks + 4 * g + (qi >> 2)) * 208 + (16 * dt + 4 * (qi & 3)) * 2;
                    const s16x4 a0 = __builtin_amdgcn_ds_read_tr16_b64_v4i16((LAS s16x4*)kr), a1 = __builtin_amdgcn_ds_read_tr16_b64_v4i16((LAS s16x4*)(kr + 16 * 208));
                    kdf[j][ks] = __builtin_shufflevector(a0, a1, 0, 1, 2, 3, 4, 5, 6, 7); } }
            __builtin_amdgcn_sched_barrier(0);
            if ((n & 1) && (n < 57)) {
                const int id = gw2 + 1024 * (n >> 1), e = id / 3584, r2 = id - e * 3584, wh = r2 / 1792, it2 = r2 - wh * 1792, kb = it2 / 112, nb = it2 - kb * 112, n0 = nb * 32;
                unsigned char* dst = c8 + (size_t)e * 7168 * 1024 + (size_t)((n0 >> 7) * 256 + wh * 128 + (n0 & 127)) * 1024 + kb * 64;
                const int nq = lane & 7, kr = lane >> 3;
#pragma unroll
                for (int p = 0; p < 2; ++p) { const f32x4 gq = cg[p] * 32.0f;
                    const f32x4 a = cv[4 * p], b2 = cv[4 * p + 1], c2 = cv[4 * p + 2], d2 = cv[4 * p + 3]; LAS unsigned* t = CT + (4 * nq) * 17 + 8 * p + kr;
                    t[0] = pk4_fp8(a.x * gq[0], b2.x * gq[1], c2.x * gq[2], d2.x * gq[3]); t[17] = pk4_fp8(a.y * gq[0], b2.y * gq[1], c2.y * gq[2], d2.y * gq[3]);
                    t[34] = pk4_fp8(a.z * gq[0], b2.z * gq[1], c2.z * gq[2], d2.z * gq[3]); t[51] = pk4_fp8(a.w * gq[0], b2.w * gq[1], c2.w * gq[2], d2.w * gq[3]); }
                LDS_WAIT(); asm volatile("" ::: "memory");
#pragma unroll
                for (int r = 0; r < 2; ++r) { const int nn2 = (lane >> 2) + 16 * r, c4 = lane & 3; const LAS unsigned* sp = CT + nn2 * 17 + 4 * c4;
                    v4u o; o.x = sp[0]; o.y = sp[1]; o.z = sp[2]; o.w = sp[3];
                    *(GAS v4u*)(dst + (size_t)nn2 * 1024 + 16 * c4) = o; }
            }
            { const int n2 = n + 2 < 64 ? n + 2 : 63; GL_DMA(n2, bo2); }
            if (!(n & 1) && (n < 56)) {
                const int id = gw2 + 1024 * (n >> 1), e = id / 3584, r2 = id - e * 3584, wh = r2 / 1792, it2 = r2 - wh * 1792, kb = it2 / 112, nb = it2 - kb * 112;
                const float* p = (wh ? cwu : cwg) + (size_t)e * 1024 * FFE + (size_t)(kb * 64 + 4 * (lane >> 3)) * FFE + nb * 32 + 4 * (lane & 7);
#pragma unroll
                for (int j = 0; j < 8; ++j) cv[j] = *(const f32x4*)(p + (size_t)(32 * (j >> 2) + (j & 3)) * FFE);
                cg[0] = *(const f32x4*)(cgain + kb * 64 + 4 * (lane >> 3)); cg[1] = *(const f32x4*)(cgain + kb * 64 + 32 + 4 * (lane >> 3));
            }
            __builtin_amdgcn_sched_barrier(0);
#pragma unroll
            for (int j = 0; j < 5; ++j) {
                f32x4 sv = So[j];
#pragma unroll
                for (int ks = 0; ks < 2; ++ks) { bf16x8 vop;
                    if (j == 0) vop = vfr[0][ks]; else if (j == 2) vop = vfr[1][ks]; else if (j >= 3) vop = vfr[2][ks];
                    else { const v4u a_ = __builtin_bit_cast(v4u, vfr[0][ks]), b_ = __builtin_bit_cast(v4u, vfr[1][ks]); v4u r_; r_.x = (b_.x & vmsk) | (a_.x & ~vmsk); r_.y = (b_.y & vmsk) | (a_.y & ~vmsk); r_.z = (b_.z & vmsk) | (a_.z & ~vmsk); r_.w = (b_.w & vmsk) | (a_.w & ~vmsk); vop = __builtin_bit_cast(bf16x8, r_); }
                    sv = __builtin_amdgcn_mfma_f32_16x16x32_bf16(kdf[j][ks], vop, sv, 0, 0, 0); }
                sv[0] *= dec[j][0]; sv[1] *= dec[j][1]; sv[2] *= dec[j][2]; sv[3] *= dec[j][3];
                So[j] = sv;
            }
#pragma unroll
            for (int j = 0; j < 5; ++j) if (oV[j]) { v2u w; w.x = pk2(So[j][0], So[j][1]); w.y = pk2(So[j][2], So[j][3]); *(LAS v2u*)(SBw + oT[j] * 512 + lane * 8) = w; }
            asm volatile("s_waitcnt lgkmcnt(0)\n\ts_barrier" ::: "memory");
            { const int t_ = bo; bo = (bo == 2 * GL_BUF) ? 0 : bo + GL_BUF; bo2 = t_; }
        }
#undef GL_DMA
    }
#undef GL_PIECE
#undef GL_OFF
    __syncthreads();
}

__device__ __forceinline__ void finalize_rstd(const Frame& F, const float* rss, float* rstd) {
    for (int row = F.bid * NTHR + TID(); row < NT; row += F.G * NTHR) rstd[row] = rstd_from(rss + (size_t)row * 16);
}
__device__ __forceinline__ void gla_combine(const Frame& F, const bf16* OF, const bf16* OB, const bf16* act1, const float* gnorm, bf16* mix) {
    const int lane = LANE(), h = lane >> 4, c0 = h * 192 + 12 * (lane & 15);
    float gn[12];
#pragma unroll
    for (int j = 0; j < 12; ++j) gn[j] = gnorm[12 * (lane & 15) + j];
    for (int token = F.gw; token < NT; token += 2 * F.NGW) {
        const int tb = token + F.NGW; const bool hb = tb < NT; const int t2 = hb ? tb : token;
        v2u fa[3], ba[3], ga[3], fb[3], bb[3], gb[3];
#pragma unroll
        for (int j = 0; j < 3; ++j) { fa[j] = *(const v2u*)(OF + (size_t)token * 768 + c0 + 4 * j); ba[j] = *(const v2u*)(OB + (size_t)token * 768 + c0 + 4 * j); ga[j] = *(const v2u*)(act1 + (size_t)token * A1_LD + 768 + c0 + 4 * j); }
#pragma unroll
        for (int j = 0; j < 3; ++j) { fb[j] = *(const v2u*)(OF + (size_t)t2 * 768 + c0 + 4 * j); bb[j] = *(const v2u*)(OB + (size_t)t2 * 768 + c0 + 4 * j); gb[j] = *(const v2u*)(act1 + (size_t)t2 * A1_LD + 768 + c0 + 4 * j); }
        float oa[12], ob[12], sa = 0.f, sb = 0.f;
#pragma unroll
        for (int j = 0; j < 3; ++j) {
            oa[4 * j] = bflo(fa[j].x) + bflo(ba[j].x); oa[4 * j + 1] = bfhi(fa[j].x) + bfhi(ba[j].x); oa[4 * j + 2] = bflo(fa[j].y) + bflo(ba[j].y); oa[4 * j + 3] = bfhi(fa[j].y) + bfhi(ba[j].y);
            ob[4 * j] = bflo(fb[j].x) + bflo(bb[j].x); ob[4 * j + 1] = bfhi(fb[j].x) + bfhi(bb[j].x); ob[4 * j + 2] = bflo(fb[j].y) + bflo(bb[j].y); ob[4 * j + 3] = bfhi(fb[j].y) + bfhi(bb[j].y); }
#pragma unroll
        for (int j = 0; j < 12; ++j) { sa += oa[j] * oa[j]; sb += ob[j] * ob[j]; }
#pragma unroll
        for (int o = 1; o < 16; o <<= 1) { sa += __shfl_xor(sa, o); sb += __shfl_xor(sb, o); }
        const float ra = __builtin_amdgcn_rsqf(sa * (1.0f / 192.0f) + EPS), rb = __builtin_amdgcn_rsqf(sb * (1.0f / 192.0f) + EPS);
#pragma unroll
        for (int j = 0; j < 3; ++j) {
            const float g0 = bflo(ga[j].x), g1 = bfhi(ga[j].x), g2 = bflo(ga[j].y), g3 = bfhi(ga[j].y);
            v2u w; w.x = pk2(oa[4 * j] * ra * gn[4 * j] * g0 * __builtin_amdgcn_rcpf(1.0f + __expf(-g0)), oa[4 * j + 1] * ra * gn[4 * j + 1] * g1 * __builtin_amdgcn_rcpf(1.0f + __expf(-g1)));
            w.y = pk2(oa[4 * j + 2] * ra * gn[4 * j + 2] * g2 * __builtin_amdgcn_rcpf(1.0f + __expf(-g2)), oa[4 * j + 3] * ra * gn[4 * j + 3] * g3 * __builtin_amdgcn_rcpf(1.0f + __expf(-g3)));
            *(v2u*)(mix + (size_t)token * DM + c0 + 4 * j) = w; }
        if (hb) {
#pragma unroll
            for (int j = 0; j < 3; ++j) {
                const float g0 = bflo(gb[j].x), g1 = bfhi(gb[j].x), g2 = bflo(gb[j].y), g3 = bfhi(gb[j].y);
                v2u w; w.x = pk2(ob[4 * j] * rb * gn[4 * j] * g0 * __builtin_amdgcn_rcpf(1.0f + __expf(-g0)), ob[4 * j + 1] * rb * gn[4 * j + 1] * g1 * __builtin_amdgcn_rcpf(1.0f + __expf(-g1)));
                w.y = pk2(ob[4 * j + 2] * rb * gn[4 * j + 2] * g2 * __builtin_amdgcn_rcpf(1.0f + __expf(-g2)), ob[4 * j + 3] * rb * gn[4 * j + 3] * g3 * __builtin_amdgcn_rcpf(1.0f + __expf(-g3)));
                *(v2u*)(mix + (size_t)tb * DM + c0 + 4 * j) = w; } }
    }
}
__device__ __forceinline__ void route_pick(const float (&acc)[8], int token, int* topi, float* topw, LAS int* lc) {
    int e0 = 0; float l0 = acc[0];
#pragma unroll
    for (int e = 1; e < 8; ++e) if (acc[e] > l0) { l0 = acc[e]; e0 = e; }
    int e1 = -1; float l1 = -INFINITY;
#pragma unroll
    for (int e = 0; e < 8; ++e) if (e != e0 && acc[e] > l1) { l1 = acc[e]; e1 = e; }
    if (e1 < 0) { e1 = (e0 + 1) & 7; l1 = l0; }
    const float w0 = 1.0f / (1.0f + __expf(l1 - l0));
    topi[token] = e0 | (e1 << 8); topw[2 * token] = w0; topw[2 * token + 1] = 1.0f - w0;
    atomicAdd((int*)&lc[e0], 1); atomicAdd((int*)&lc[8 + e1], 1);
}
__device__ __forceinline__ void route1(const Frame& F, const bf16* H, const float* gain, const float* wr, int* topi, float* topw, int* cnt, float* rstd) {
    LAS int* lc = (LAS int*)F.lds;
    if (TID() < 16) lc[TID()] = 0;
    __syncthreads();
    const int lane = LANE();
    float w[4][4][8];
#pragma unroll
    for (int j = 0; j < 4; ++j) { const f32x4 g = *(const f32x4*)(gain + 256 * j + 4 * lane);
#pragma unroll
        for (int i = 0; i < 4; ++i) { const float* p = wr + (size_t)(256 * j + 4 * lane + i) * 8; const f32x4 a = *(const f32x4*)p, b = *(const f32x4*)(p + 4); const float gi = g[i];
            w[j][i][0] = a.x * gi; w[j][i][1] = a.y * gi; w[j][i][2] = a.z * gi; w[j][i][3] = a.w * gi; w[j][i][4] = b.x * gi; w[j][i][5] = b.y * gi; w[j][i][6] = b.z * gi; w[j][i][7] = b.w * gi; } }
    for (int t2 = 0; t2 < 16; t2 += 2) {
        const int token = F.bid * 128 + F.wave * 16 + t2;
        const v2u* h0 = (const v2u*)(H + (size_t)token * DM) + lane; const v2u* h1 = h0 + DM / 4;
        f32x4 x0[4], x1[4];
#pragma unroll
        for (int j = 0; j < 4; ++j) { const v2u p = h0[64 * j], q = h1[64 * j]; x0[j] = (f32x4){bflo(p.x), bfhi(p.x), bflo(p.y), bfhi(p.y)}; x1[j] = (f32x4){bflo(q.x), bfhi(q.x), bflo(q.y), bfhi(q.y)}; }
        float a0[8], a1[8], s0 = 0.f, s1 = 0.f;
#pragma unroll
        for (int e = 0; e < 8; ++e) { a0[e] = 0.f; a1[e] = 0.f; }
#pragma unroll
        for (int j = 0; j < 4; ++j)
#pragma unroll
            for (int i = 0; i < 4; ++i) { const float u = x0[j][i], v = x1[j][i]; s0 += u * u; s1 += v * v;
#pragma unroll
                for (int e = 0; e < 8; ++e) { a0[e] += u * w[j][i][e]; a1[e] += v * w[j][i][e]; } }
        s0 = wave_sum(s0); s1 = wave_sum(s1);
        const float r0 = 1.0f / sqrtf(s0 * (1.0f / DM) + EPS), r1 = 1.0f / sqrtf(s1 * (1.0f / DM) + EPS);
#pragma unroll
        for (int e = 0; e < 8; ++e) { a0[e] = wave_sum(a0[e]) * r0; a1[e] = wave_sum(a1[e]) * r1; }
        if (lane == 0) { route_pick(a0, token, topi, topw, lc); route_pick(a1, token + 1, topi, topw, lc); rstd[token] = r0; rstd[token + 1] = r1; }
    }
    __syncthreads();
    if (TID() < 16) cnt[F.bid * 16 + TID()] = lc[TID()];
    __syncthreads();
}
__device__ __forceinline__ void route2(const Frame& F, const int* topi, const float* topw, const int* cnt, int* stok, float* sw, int* blk, int* s0tab) {
    LAS int* part = (LAS int*)F.lds;
    LAS int* base = part + 1024;
    LAS int* tk = base + 64;
    const int tid = TID(), pe = tid & 15, jg = tid >> 4;
    int below = 0, tot = 0;
    for (int w = jg; w < F.G; w += 32) { const int v = cnt[w * 16 + pe]; tot += v; if (w < F.bid) below += v; }
    part[jg * 16 + pe] = below; part[512 + jg * 16 + pe] = tot;
    if (tid < 128) tk[tid] = topi[F.bid * 128 + tid];
    __syncthreads();
    if (tid < 16) { int b = 0, t = 0; for (int j = 0; j < 32; ++j) { b += part[j * 16 + tid]; t += part[512 + j * 16 + tid]; } base[tid] = b; base[16 + tid] = t; }
    __syncthreads();
    if (tid < 2) { int ps = 0; for (int e = 0; e < 8; ++e) { base[32 + tid * 8 + e] = ps; ps += (base[16 + tid * 8 + e] + 255) / 256 * 256; } base[48 + tid] = ps / 256; }
    __syncthreads();
    if (tid < 256) {
        const int p = tid >> 7, i = tid & 127; const int e = (tk[i] >> (8 * p)) & 0xff;
        int rank = 0; for (int j = 0; j < i; ++j) rank += (((tk[j] >> (8 * p)) & 0xff) == e) ? 1 : 0;
        const int slot = base[32 + p * 8 + e] + base[p * 8 + e] + rank; const int token = F.bid * 128 + i;
        stok[p * SLOT_CAP + slot] = token; sw[p * SLOT_CAP + slot] = topw[2 * token + p]; if (p == 0) s0tab[token] = slot;
    }
    if (F.bid < 16) {
        const int p = F.bid >> 3, e = F.bid & 7, ps = base[32 + F.bid], t = base[16 + F.bid], pend = ps + (t + 255) / 256 * 256;
        for (int s = ps + t + tid; s < pend; s += NTHR) { stok[p * SLOT_CAP + s] = -1; sw[p * SLOT_CAP + s] = 0.f; }
        for (int bk = ps / 256 + tid; bk < pend / 256; bk += NTHR) blk[16 + p * 256 + bk] = e;
        if (e == 0 && tid == 0) blk[p] = base[48 + p];
    }
    __syncthreads();
}
__device__ __forceinline__ void final_norm_slots(int lane, const bf16* HB, float* OUT, const bf16* YA, const int* s0tab, const bf16* Y, const bf16* Y2, const float* gain, const int* tok, int s0, int s1, int first, int stride) {
    f32x4 gv[4];
#pragma unroll
    for (int j = 0; j < 4; ++j) gv[j] = ((const f32x4*)gain + lane)[64 * j];
    for (int base = s0 + first; base < s1; base += 64 * stride) {
      const int sll = base + lane * stride; int mytok = -1; if (sll < s1) mytok = tok[sll];
      const int mys0 = s0tab[mytok < 0 ? 0 : mytok];
      const int cnt = min(64, (s1 - base + stride - 1) / stride);
      for (int i = 0; i < cnt; i += 2) {
        const int sl = base + i * stride, slb = sl + stride; const bool hb = i + 1 < cnt; const int i1 = hb ? i + 1 : i;
        const int ra = __builtin_amdgcn_readlane(mytok, i), rb = hb ? __builtin_amdgcn_readlane(mytok, i1) : -1;
        const int rowa = ra < 0 ? 0 : ra, rowb = rb < 0 ? 0 : rb;
        const v2u* xa = (const v2u*)(HB + (size_t)rowa * DM) + lane; const v2u* xb = (const v2u*)(HB + (size_t)rowb * DM) + lane;
        const v2u* ya = (const v2u*)(Y + (size_t)sl * DM) + lane; const v2u* yb = (const v2u*)(Y + (size_t)(hb ? slb : sl) * DM) + lane;
        const v2u* pa = (const v2u*)(YA + (size_t)__builtin_amdgcn_readlane(mys0, i) * DM) + lane; const v2u* pb = (const v2u*)(YA + (size_t)__builtin_amdgcn_readlane(mys0, i1) * DM) + lane;
        f32x4 va[4], vb[4]; v2u wa[4], wb[4], ua[4], ub[4], ta[4], tb[4];
#pragma unroll
        for (int j = 0; j < 4; ++j) { ua[j] = xa[64 * j]; wa[j] = ya[64 * j]; ta[j] = pa[64 * j]; }
#pragma unroll
        for (int j = 0; j < 4; ++j) { ub[j] = xb[64 * j]; wb[j] = yb[64 * j]; tb[j] = pb[64 * j]; }
#pragma unroll
        for (int j = 0; j < 4; ++j) { va[j] = (f32x4){bflo(ua[j].x) + bflo(ta[j].x), bfhi(ua[j].x) + bfhi(ta[j].x), bflo(ua[j].y) + bflo(ta[j].y), bfhi(ua[j].y) + bfhi(ta[j].y)};
            vb[j] = (f32x4){bflo(ub[j].x) + bflo(tb[j].x), bfhi(ub[j].x) + bfhi(tb[j].x), bflo(ub[j].y) + bflo(tb[j].y), bfhi(ub[j].y) + bfhi(tb[j].y)}; }
        if (Y2) {
            const v2u* za = (const v2u*)(Y2 + (size_t)(sl - s0) * DM) + lane; const v2u* zb = (const v2u*)(Y2 + (size_t)((hb ? slb : sl) - s0) * DM) + lane;
#pragma unroll
            for (int j = 0; j < 4; ++j) { const v2u p = za[64 * j], q = zb[64 * j];
                va[j].x += bflo(p.x); va[j].y += bfhi(p.x); va[j].z += bflo(p.y); va[j].w += bfhi(p.y); vb[j].x += bflo(q.x); vb[j].y += bfhi(q.x); vb[j].z += bflo(q.y); vb[j].w += bfhi(q.y); }
        }
        float sa = 0.f, sb = 0.f;
#pragma unroll
        for (int j = 0; j < 4; ++j) {
            va[j].x += bflo(wa[j].x); va[j].y += bfhi(wa[j].x); va[j].z += bflo(wa[j].y); va[j].w += bfhi(wa[j].y);
            vb[j].x += bflo(wb[j].x); vb[j].y += bfhi(wb[j].x); vb[j].z += bflo(wb[j].y); vb[j].w += bfhi(wb[j].y);
            sa += (va[j].x * va[j].x + va[j].y * va[j].y) + (va[j].z * va[j].z + va[j].w * va[j].w); sb += (vb[j].x * vb[j].x + vb[j].y * vb[j].y) + (vb[j].z * vb[j].z + vb[j].w * vb[j].w); }
        sa = wave_sum(sa); sb = wave_sum(sb);
        const float rsa = 1.0f / sqrtf(sa * (1.0f / DM) + EPS), rsb = 1.0f / sqrtf(sb * (1.0f / DM) + EPS);
        if (ra >= 0) { GAS f32x4* oa = (GAS f32x4*)(OUT + (size_t)rowa * DM) + lane;
#pragma unroll
            for (int j = 0; j < 4; ++j) { const f32x4 g = gv[j]; oa[64 * j] = (f32x4){va[j].x * rsa * g.x, va[j].y * rsa * g.y, va[j].z * rsa * g.z, va[j].w * rsa * g.w}; } }
        if (rb >= 0) { GAS f32x4* ob = (GAS f32x4*)(OUT + (size_t)rowb * DM) + lane;
#pragma unroll
            for (int j = 0; j < 4; ++j) { const f32x4 g = gv[j]; ob[64 * j] = (f32x4){vb[j].x * rsb * g.x, vb[j].y * rsb * g.y, vb[j].z * rsb * g.z, vb[j].w * rsb * g.w}; } }
      }
    }
}
__device__ __forceinline__ void final_norm(const Frame& F, float* H, const float* gain) {
    for (int row = F.gw; row < NT; row += F.NGW) {
        GAS f32x4* xr = (GAS f32x4*)(H + (size_t)row * DM) + LANE(); const f32x4* gr = (const f32x4*)gain + LANE();
        f32x4 v[4]; float s = 0.f;
#pragma unroll
        for (int j = 0; j < 4; ++j) { v[j] = xr[64 * j]; s += (v[j].x * v[j].x + v[j].y * v[j].y) + (v[j].z * v[j].z + v[j].w * v[j].w); }
        s = wave_sum(s); const float rs = 1.0f / sqrtf(s * (1.0f / DM) + EPS);
#pragma unroll
        for (int j = 0; j < 4; ++j) { const f32x4 g = gr[64 * j]; f32x4 o = {v[j].x * rs * g.x, v[j].y * rs * g.y, v[j].z * rs * g.z, v[j].w * rs * g.w}; xr[64 * j] = o; }
    }
}

constexpr int N_PHASES = 17;
__global__ void __launch_bounds__(NTHR, 2) mega(Args args) {
    extern __shared__ __attribute__((aligned(16))) unsigned char lds_raw[];
    Frame F;
    F.lds = (LAS unsigned char*)lds_raw;
    F.wave = __builtin_amdgcn_readfirstlane((int)(threadIdx.x >> 6));
    F.G = gridDim.x; F.bid = blockIdx.x; F.gw = F.bid * NWAVES + F.wave; F.NGW = F.G * NWAVES; F.ws = args.ws;
    unsigned char* ws = args.ws;
    gu32* ctl = (gu32*)(ws + WS_CTL);
    volatile LAS unsigned* MISC = (volatile LAS unsigned*)(F.lds + MISC_OFF);
    for (int u = TID(); u < (LDS_BYTES - LDSCTL_OFF) / 4; u += NTHR) ((LAS unsigned*)(F.lds + LDSCTL_OFF))[u] = 0u;
    __syncthreads();
    XcdBarrier bar = xcd_barrier_post((unsigned*)(ctl + CW_BAR), MISC + 8, F.wave);
    const int lo = args.ph_lo, hi = args.ph_hi;
#ifndef PH_MASK
#define PH_MASK 0x1ffff
#endif
#define IN(k) (((PH_MASK >> (k)) & 1) && lo <= (k) && (k) < hi)
#ifndef REPEAT_MASK
#define REPEAT_MASK 0
#endif
#define REPS(k) (1 + ((REPEAT_MASK >> (k)) & 1))
#define SEAM(k) do { if (IN(k) && IN((k) + 1)) xcd_barrier(bar); } while (0)

    float* H = args.out;
    bf16* x3 = (bf16*)args.out;
    float* rss = (float*)(ws + WS_RSS); float* rstd = (float*)(ws + WS_RSTD);
    bf16* hbf = (bf16*)(ws + WS_HBF); bf16* membf = (bf16*)(ws + WS_MEMBF); bf16* memk = (bf16*)(ws + WS_MEMK); bf16* memvt = (bf16*)(ws + WS_MEMVT);
    bf16* act0 = (bf16*)(ws + WS_ACT0); bf16* v0t = (bf16*)(ws + WS_V0T); bf16* mix = (bf16*)(ws + WS_MIX); bf16* hmid0 = (bf16*)(ws + WS_HMID0);
    bf16* act1 = (bf16*)(ws + WS_ACT1); bf16* v1t = (bf16*)(ws + WS_V1T); bf16* OF = (bf16*)(ws + WS_OF); bf16* OB = (bf16*)(ws + WS_OB);
    bf16* hmid1 = (bf16*)(ws + WS_HMID1); bf16* wgu = (bf16*)((unsigned char*)args.out + OUT_WGU); bf16* wdn = (bf16*)(ws + WS_WDN);
    int* cnt = (int*)(ws + WS_CNT); int* topi = (int*)(ws + WS_TOPI); float* topw = (float*)(ws + WS_TOPW);
    int* stok = (int*)(ws + WS_STOK); float* sw = (float*)(ws + WS_SW); int* blk = (int*)(ws + WS_BLK);
    LAS float* scr = (LAS float*)(F.lds + F.wave * 16384);

    if (IN(0)) {
        int it = F.gw; LAS unsigned* T0 = (LAS unsigned*)scr; LAS unsigned* T1 = T0 + 1088;
#define CVT(Wp, Kd, Nd, WTp, gainp, kind) do { const CvtJob J{Wp, Kd, Nd, (bf16*)(WTp), gainp, kind}; const int n_ = ((Kd) / 64) * ((Nd) / 32); \
            while (it < n_) { CvtRegs A_, B_; B_.valid = 0; cvt_load(A_, J, it, LANE()); it += F.NGW; if (it < n_) { cvt_load(B_, J, it, LANE()); it += F.NGW; } cvt_finish(A_, T0, LANE()); cvt_finish(B_, T1, LANE()); } \
            it -= n_; } while (0)
        CVT(args.in[I_EWIN], 1024, 2560, ws + WS_W0IN, args.in[I_EN1], 1);
        CVT(args.in[I_EWIN], 1024, 2560, ws + WS_WV0, args.in[I_EN1], 2);
        CVT(args.in[I_EWOUT], 1024, 1024, ws + WS_W0OUT, nullptr, 0);
        CVT(args.in[I_EWG], 1024, 2816, ws + WS_W0GU, args.in[I_EN2], 3);
        CVT(args.in[I_EWU], 1024, 2816, ws + WS_W0GU, args.in[I_EN2], 4);
        CVT(args.in[I_EWD], 2816, 1024, ws + WS_W0DN, nullptr, 0);
        CVT(args.in[I_WMKV], 1024, 512, ws + WS_WMEM, args.in[I_MNORM], 0);
        CVT(args.in[I_OWIN], 1024, 2592, ws + WS_W1IN, args.in[I_ON1], 5);
        CVT(args.in[I_OWIN], 1024, 2592, ws + WS_WV1, args.in[I_ON1], 6);
        CVT(args.in[I_OWOUT], 1024, 1024, ws + WS_W1OUT, nullptr, 0);
#undef CVT
        { v4u z = {0u, 0u, 0u, 0u}; v4u* p = (v4u*)(ws + WS_W1IN + (size_t)1824 * 2048); const int n16 = 224 * 2048 / 16;
          for (int i = F.bid * NTHR + TID(); i < n16; i += F.G * NTHR) p[i] = z; }
        { float* rp2 = (float*)(ws + WS_RPB2); for (int i2 = F.bid * NTHR + TID(); i2 < 12 * 480; i2 += F.G * NTHR) { const int hh = i2 / 480, jj = i2 - 480 * hh; rp2[i2] = jj < 465 ? args.in[I_RPB][hh * 465 + jj] * 1.4426950408889634f : 0.f; } }
        rows_to_bf16(args.in[I_X], hbf, rstd, F.gw, NT, F.NGW, LANE());
        rows_to_bf16(args.in[I_MEM], membf, rstd + NT, F.gw, MEM_ROWS, F.NGW, LANE());
    }
    SEAM(0);
    if (IN(1)) {
        { Sched S; S.init(hbf, ws + WS_W0IN, 1024, 128, 7, F.G, F.bid); EpiRowScale E{act0, A0_LD, rstd, 1.0f}; gemm_run<EpiRowScale, false>(F.lds, S, E, nullptr, F.wave); }
        { Sched S; S.init(ws + WS_WV0, hbf, 1024, 3, 128, F.G, (F.bid + 128) % F.G); EpiColScale E{v0t, NT, rstd}; gemm_run<EpiColScale, false>(F.lds, S, E, nullptr, F.wave); }
        for (int it = F.gw; it < 2048; it += F.NGW) memkv_item(it, LANE(), membf, (const bf16*)(ws + WS_WMEM), rstd + NT, memk, memvt);
    }
    SEAM(1);
    if (IN(2)) {
        { na_phase(F, act0, v0t, (const float*)(ws + WS_RPB2), mix);
          for (int it = F.bid; it < 512; it += F.G) memattn_strip(F, it, act0, A0_LD, 1536, memk, memvt, mix);
          __syncthreads(); }
    }
    SEAM(2);
    if (IN(3)) {
        Sched S; S.init(mix, ws + WS_W0OUT, 1024, 128, 4, F.G, F.bid); EpiResid<true> E{args.in[I_X], hbf, rss, nullptr}; gemm_run<EpiResid<true>, false>(F.lds, S, E, nullptr, F.wave);
    }
    SEAM(3);
    if (IN(4)) {
        Sched S; S.init(hbf, ws + WS_W0GU, 1024, 128, 22, F.G, F.bid); EpiSwiGLU<false, true> E{hmid0, FF0, rss, nullptr}; gemm_run<EpiSwiGLU<false, true>, false>(F.lds, S, E, nullptr, F.wave);
    }
    SEAM(4);
    if (IN(5)) {
        Sched S; S.init(hmid0, ws + WS_W0DN, FF0, 128, 4, F.G, F.bid); EpiResid<false> E{nullptr, hbf, rss, nullptr}; gemm_run<EpiResid<false>, false>(F.lds, S, E, nullptr, F.wave);
    }
    SEAM(5);
    if (IN(6)) {
        { Sched S; S.init(hbf, ws + WS_W1IN, 1024, 128, 8, F.G, F.bid); EpiRowScaleT<true> E{act1, A1_LD, rss, 1.0f}; gemm_run<EpiRowScaleT<true>, false>(F.lds, S, E, nullptr, F.wave); }
        { Sched S; S.init(ws + WS_WV1, hbf, 1024, 3, 128, F.G, F.bid); EpiColScaleT<true> E{v1t, NT, rss}; gemm_run<EpiColScaleT<true>, false>(F.lds, S, E, nullptr, F.wave); }
    }
    SEAM(6);
    if (IN(7)) {
        bf16x8 gwf[3]; float gbi[3]; int gdir = -1;
        for (int it = F.bid; it < 1024; it += F.G) { const int dir = (it >> 6) & 1;
            if (dir != gdir) { gla_pre_w(F.wave, LANE(), dir ? args.in[I_WGKB] : args.in[I_WGKF], dir ? args.in[I_BGKB] : args.in[I_BGKF], gwf, gbi); gdir = dir; }
            gla_pre_item(F, it, act1, gwf, gbi, (bf16*)(ws + WS_GQT) + (size_t)dir * NT * 384, (bf16*)((unsigned char*)args.out + OUT_GKT) + (size_t)dir * NT * 384,
                         (float*)((unsigned char*)args.out + OUT_GDEC) + (size_t)dir * 8 * 4 * 64 * 96); }
        for (int it = F.bid; it < 512; it += F.G) memattn_strip(F, it, act1, A1_LD, 1536, memk, memvt, mix);
        xcd_barrier(bar);
        for (int it0 = F.bid; it0 < 256; it0 += F.G) { const int it = (F.G == 256) ? ((it0 & 7) * 8 + (it0 >> 5)) * 4 + ((it0 >> 3) & 3) : it0;
            gla_main_item(F, it, (const bf16*)(ws + WS_GQT), (const bf16*)((unsigned char*)args.out + OUT_GKT), (const float*)((unsigned char*)args.out + OUT_GDEC), v1t, OF, OB, args.in[I_OWG], args.in[I_OWU], args.in[I_ON2], (unsigned char*)wgu); }
    }
    SEAM(7);
    if (IN(8)) gla_combine(F, OF, OB, act1, args.in[I_GNORM], mix);
    SEAM(8);
    if (IN(9)) {
        Sched S; S.init(mix, ws + WS_W1OUT, 1024, 128, 4, F.G, F.bid); EpiResid<false> E{nullptr, hbf, rss, x3}; gemm_run<EpiResid<false>, false>(F.lds, S, E, nullptr, F.wave);
    }
    SEAM(9);
    if (IN(10)) {
        route1(F, hbf, args.in[I_ON2], args.in[I_WR], topi, topw, cnt, rstd);
    }
    SEAM(10);
    if (IN(11)) {
        route2(F, topi, topw, cnt, stok, sw, blk, (int*)(ws + WS_S0TAB));
        { LAS unsigned* T0 = (LAS unsigned*)scr; LAS unsigned* T1 = T0 + 1088;
#define MOE_JOB(J_, it_) const int e_##J_ = (it_) / 1792; \
            const CvtJob J_{args.in[I_OWD] + (size_t)e_##J_ * FFE * 1024, FFE, 1024, (bf16*)((unsigned char*)wdn + (size_t)e_##J_ * 1024 * FFE), nullptr, 0}
          for (int it = F.gw; it < 8 * 1792; it += 2 * F.NGW) {
            CvtRegs A_, B_; B_.valid = 0;
            { MOE_JOB(Ja, it); cvt_load8(A_, Ja, it % 1792, LANE()); }
            if (it + F.NGW < 8 * 1792) { MOE_JOB(Jb, it + F.NGW); cvt_load8(B_, Jb, (it + F.NGW) % 1792, LANE()); }
            cvt_finish8(A_, T0, LANE(), 32.0f); cvt_finish8(B_, T1, LANE(), 32.0f);
          }
#undef MOE_JOB
        }
    }
    SEAM(11);
    bf16* ht0 = (bf16*)((unsigned char*)hmid1 + (size_t)NT * FFE); bf16* ht1 = (bf16*)(ws + WS_HT1);
    constexpr int KG = 512, KD = FFE / 2; constexpr size_t ESG = (size_t)7168 * 1024, ESD = (size_t)1024 * FFE;
    if (IN(12)) {
        const int nb = blk[0]; Sched S; S.init(x3, wgu, KG, nb, 28, F.G, F.bid, blk + 16, ESG); EpiSwiGLU<true> E{hmid1, FFE, rstd, ht0}; gemm_run<EpiSwiGLU<true>, true, true>(F.lds, S, E, stok, F.wave);
    }
    SEAM(12);
    if (IN(13)) {
        const int nb = blk[0], nbm = nb < 128 ? nb : 128; Sched S; S.init(hmid1, wdn, KD, nbm, 4, F.G, F.bid, blk + 16, ESD); EpiRowScale E{(bf16*)(ws + WS_YA), DM, sw, 0.03125f}; gemm_run<EpiRowScale, false, true>(F.lds, S, E, nullptr, F.wave);
    }
    SEAM(13);
    if (IN(14)) {
        const int nb = blk[1], nb0 = blk[0], rfull = (nb * 28 / F.G > 3) ? nb * 28 / F.G - 3 : 0, per = F.G / 8;
        { Sched S; S.init(x3, wgu, KG, nb, 28, F.G, F.bid, blk + 16 + 256, ESG); S.range(0, rfull * per, per);
          EpiSwiGLU<true> E{hmid1, FFE, rstd, ht1}; gemm_run<EpiSwiGLU<true>, true, true>(F.lds, S, E, stok + SLOT_CAP, F.wave); }
        { Sched S; S.init(x3, wgu, KG, nb, 28, F.G, F.bid, blk + 16 + 256, ESG); S.range(rfull * per, 0x7fffffff, per - 4);
          EpiSwiGLU<true> E{hmid1, FFE, rstd, ht1}; gemm_run<EpiSwiGLU<true>, true, true>(F.lds, S, E, stok + SLOT_CAP, F.wave); }
        if (F.bid / 8 >= per - 4 && nb0 > 128) {
            Sched S; S.init(ht0, wdn, KD, nb0 - 128, 4, 32, (F.bid / 8 - (per - 4)) * 8 + F.bid % 8, blk + 16 + 128, ESD);
            EpiRowScale E{(bf16*)(ws + WS_YA) + (size_t)NT * DM, DM, sw + NT, 0.03125f}; gemm_run<EpiRowScale, false, true>(F.lds, S, E, nullptr, F.wave); }
    }
    SEAM(14);
    if (IN(15)) {
        const int nb = blk[1], nbm = nb < 128 ? nb : 128; Sched S; S.init(hmid1, wdn, KD, nbm, 4, F.G, F.bid, blk + 16 + 256, ESD); EpiRowScale E{(bf16*)(ws + WS_YB), DM, sw + SLOT_CAP, 0.03125f}; gemm_run<EpiRowScale, false, true>(F.lds, S, E, nullptr, F.wave);
    }
    SEAM(15);
    if (IN(16)) {
        const int nb = blk[1], per = F.G / 8, nmain = (nb < 128 ? nb : 128) * 256;
        bf16* yb = (bf16*)(ws + WS_YB); bf16* yb2 = yb + (size_t)SLOT_CAP * DM;
        if (F.bid / 8 >= per - 4) {
            if (nb > 128) {
                const int sl = F.bid / 8 - (per - 4), kh = sl >> 1;
                Sched S; S.init((const bf16*)ht1 + kh * (KD / 2), (const bf16*)wdn + kh * (KD / 2), KD / 2, nb - 128, 4, 16, (sl & 1) * 8 + F.bid % 8, blk + 16 + 256 + 128, ESD); S.ld = KD;
                EpiRowScale E{kh ? yb2 : yb + (size_t)NT * DM, DM, sw + SLOT_CAP + NT, 0.03125f}; gemm_run<EpiRowScale, false, true>(F.lds, S, E, nullptr, F.wave); }
        } else {
            const int wv = (int)(blockIdx.x * NWAVES) + F.wave;
            final_norm_slots(LANE(), hbf, H, (const bf16*)(ws + WS_YA), (const int*)(ws + WS_S0TAB), yb, nullptr, args.in[I_FNORM], stok + SLOT_CAP, 0, nmain, wv, (per - 4) * 8 * NWAVES);
        }
        xcd_barrier(bar);
        if (nb > 128) final_norm_slots(LANE(), hbf, H, (const bf16*)(ws + WS_YA), (const int*)(ws + WS_S0TAB), yb, yb2, args.in[I_FNORM], stok + SLOT_CAP, NT, nb * 256, (int)(blockIdx.x * NWAVES) + F.wave, F.NGW);
    }
#undef IN
#undef SEAM
}

extern "C" void kernel_launch(void* const* d_in, const int* in_sizes, int n_in, void* d_out, int out_size, void* d_ws, size_t ws_size, hipStream_t stream) {
    static int grid = 0;
    if (grid == 0) {
        if (n_in != 26 || out_size != NT * DM || ws_size < WS_END) { fprintf(stderr, "kernel_launch: unexpected problem (n_in %d out %d ws %zu need %zu)\n", n_in, out_size, ws_size, (size_t)WS_END); grid = -1; return; }
        int dev = 0, cus = 0, per_cu = 0;
        if (hipGetDevice(&dev) != hipSuccess || hipDeviceGetAttribute(&cus, hipDeviceAttributeMultiprocessorCount, dev) != hipSuccess) { grid = -1; return; }
        if (hipFuncSetAttribute((const void*)mega, hipFuncAttributeMaxDynamicSharedMemorySize, LDS_BYTES) != hipSuccess) { fprintf(stderr, "kernel_launch: hipFuncSetAttribute failed\n"); grid = -1; return; }
        if (hipOccupancyMaxActiveBlocksPerMultiprocessor(&per_cu, (const void*)mega, NTHR, LDS_BYTES) != hipSuccess || per_cu < 1) fprintf(stderr, "kernel_launch: occupancy query reports %d\n", per_cu);
        (void)hipGetLastError();
        if (cus < 256) { fprintf(stderr, "kernel_launch: this kernel is built for a 256-CU device (one resident workgroup per CU), found %d CUs; nothing launched\n", cus); grid = -1; return; }
        grid = 256;
    }
    if (grid < 0) return;
    if (hipMemsetAsync((char*)d_ws + WS_CTL, 0, CTL_ZERO_BYTES, stream) != hipSuccess) return;
    Args a{};
    for (int i = 0; i < 26; ++i) a.in[i] = (const float*)d_in[i];
    a.out = (float*)d_out; a.ws = (unsigned char*)d_ws;
    a.ph_lo = 0; a.ph_hi = N_PHASES;
    hipLaunchKernelGGL(mega, dim3(grid), dim3(NTHR), LDS_BYTES, stream, a);
}
```

```cpp
#include <hip/hip_runtime.h>
#include <cstdio>
#include <cstdint>


#define GAS __attribute__((address_space(1)))
#define LAS __attribute__((address_space(3)))
typedef unsigned short bf16;
typedef unsigned v4u __attribute__((ext_vector_type(4)));
typedef unsigned v2u __attribute__((ext_vector_type(2)));
typedef float f32x4 __attribute__((ext_vector_type(4)));
typedef short bf16x8 __attribute__((ext_vector_type(8)));
typedef GAS unsigned gu32;
#define RLX_AGENT __ATOMIC_RELAXED, __HIP_MEMORY_SCOPE_AGENT
#define LDS_WAIT() asm volatile("s_waitcnt lgkmcnt(0)" ::: "memory")
#define VM_WAIT() asm volatile("s_waitcnt vmcnt(0)" ::: "memory")

constexpr int NT = 32768, DM = 1024, SEQ = 4096, NB = 8;
constexpr int MEM_ROWS = 2048;
constexpr int A0_LD = 1792;
constexpr int A1_LD = 2048;
constexpr int FF0 = 2816, FFE = 3584, NEXP = 8;
constexpr int SLOT_CAP = 34816;
constexpr float EPS = 1e-6f;
constexpr int NWAVES = 8, NTHR = 512;

constexpr size_t MiB = 1u << 20;
constexpr size_t WS_CTL = 0, CTL_ZERO_BYTES = 1 * MiB;
constexpr size_t WS_RSS = 1 * MiB;
constexpr size_t WS_MRSS = 3 * MiB;
constexpr size_t WS_CNT = 3 * MiB + 256 * 1024;
constexpr size_t WS_TOPI = 3 * MiB + 512 * 1024;
constexpr size_t WS_TOPW = 3 * MiB + 768 * 1024;
constexpr size_t WS_STOK = 4 * MiB;
constexpr size_t WS_SW = 4 * MiB + 512 * 1024;
constexpr size_t WS_BLK = 5 * MiB;
constexpr size_t WS_RSTD = 5 * MiB + 64 * 1024;
constexpr size_t WS_S0TAB = 5 * MiB + 512 * 1024;
constexpr size_t WS_RPB2 = 5 * MiB + 768 * 1024;
constexpr size_t WS_W0IN = 6 * MiB;
constexpr size_t WS_WV0 = WS_W0IN + 1792 * 2048;
constexpr size_t WS_W0OUT = 11 * MiB;
constexpr size_t WS_W0GU = 13 * MiB;
constexpr size_t WS_W0DN = 24 * MiB;
constexpr size_t WS_WMEM = WS_W0DN + 1024 * 2816 * 2;
constexpr size_t WS_W1IN = 31 * MiB;
constexpr size_t WS_WV1 = 35 * MiB;
constexpr size_t WS_W1OUT = 37 * MiB - 512 * 1024;
constexpr size_t WS_HBF = 39 * MiB;
constexpr size_t WS_MEMBF = 103 * MiB;
constexpr size_t WS_MEMK = 107 * MiB;
constexpr size_t WS_MEMVT = 108 * MiB;
constexpr size_t WS_ACT = 109 * MiB;
constexpr size_t WS_ACT0 = WS_ACT;
constexpr size_t WS_V0T = WS_ACT + 112 * MiB;
constexpr size_t WS_MIX = WS_ACT + 176 * MiB;
constexpr size_t WS_HMID0 = WS_ACT;
constexpr size_t WS_ACT1 = WS_ACT;
constexpr size_t WS_V1T = WS_ACT + 128 * MiB;
constexpr size_t WS_OF = WS_ACT + 240 * MiB;
constexpr size_t WS_OB = WS_ACT + 288 * MiB;
constexpr size_t WS_GQT = WS_ACT + 336 * MiB;
constexpr size_t WS_GKDT0 = WS_ACT + 384 * MiB;
constexpr size_t WS_GKDT1 = 6 * MiB;
constexpr size_t OUT_GKT = 0, OUT_GDEC = 48 * MiB, OUT_WGU = 52 * MiB;
constexpr size_t WS_E = WS_ACT + 336 * MiB;
constexpr size_t WS_HT1 = 6 * MiB;
constexpr size_t WS_YB = WS_ACT + 240 * MiB;
constexpr size_t WS_YA = WS_ACT + 128 * MiB;
constexpr size_t WS_HMID1 = WS_ACT;
constexpr size_t WS_WGU = WS_ACT + 240 * MiB;
constexpr size_t WS_WDN = WS_ACT + 352 * MiB;
constexpr size_t WS_END = WS_ACT + 408 * MiB;
static_assert(WS_W1OUT + 2 * MiB <= WS_HBF && WS_WV1 + 768 * 2048 <= WS_W1OUT && WS_W1IN + 4 * MiB <= WS_WV1 && WS_WMEM + MiB <= WS_W1IN, "weight map");
static_assert(WS_W0GU + 11 * MiB <= WS_W0DN && WS_WV0 + 768 * 2048 <= WS_W0OUT, "weight map 2");
static_assert((size_t)SLOT_CAP * 3584 * 2 <= 240 * MiB, "hmid1");

constexpr int CW_TMO = 0, CW_CODE = 1, CW_BAR = 4096;

constexpr int RING_BYTES = 131072;
constexpr int LDSCTL_OFF = 155648, MISC_OFF = LDSCTL_OFF + 320;
constexpr int LDS_BYTES = 156672;

typedef float f32x2_t __attribute__((ext_vector_type(2)));
typedef __bf16 bf16x2_t __attribute__((ext_vector_type(2)));
__device__ __forceinline__ unsigned pk2(float lo, float hi) { const f32x2_t v = {lo, hi}; const bf16x2_t b = __builtin_convertvector(v, bf16x2_t); return __builtin_bit_cast(unsigned, b); }
__device__ __forceinline__ unsigned f2bf(float f) { return pk2(f, 0.f) & 0xffffu; }
__device__ __forceinline__ float bf2f(bf16 b) { return __builtin_bit_cast(float, (unsigned)b << 16); }
__device__ __forceinline__ float bflo(unsigned u) { return __builtin_bit_cast(float, u << 16); }
__device__ __forceinline__ float bfhi(unsigned u) { return __builtin_bit_cast(float, u & 0xffff0000u); }
__device__ __forceinline__ float wave_sum(float v) {
#pragma unroll
    for (int o = 1; o < 64; o <<= 1) v += __shfl_xor(v, o);
    return v;
}
__device__ __forceinline__ float wave_max(float v) {
#pragma unroll
    for (int o = 1; o < 64; o <<= 1) v = fmaxf(v, __shfl_xor(v, o));
    return v;
}

__device__ __forceinline__ int lane_id() { unsigned z = 0u; asm volatile("" : "+v"(z)); return (int)__builtin_amdgcn_mbcnt_hi(0xffffffffu, __builtin_amdgcn_mbcnt_lo(0xffffffffu, z)); }
#define XB_TMO      128
#define XB_XCNT(j)  (256  + 64 * (j))
#define XB_XSUB(j)  (1280 + 64 * (j))
#define XB_XGEN(j)  (2304 + 64 * (j))
#define XB_TOP      3328
#define XB_TOPGEN   3392
#define XCD_BAR_WORDS 3456
#define XB_SPIN_CAP (1u << 22)

__device__ __forceinline__ unsigned xb_ld(unsigned* p)              { return __hip_atomic_load(p, __ATOMIC_RELAXED, __HIP_MEMORY_SCOPE_AGENT); }
__device__ __forceinline__ unsigned xb_add(unsigned* p, unsigned v) { return __hip_atomic_fetch_add(p, v, __ATOMIC_RELAXED, __HIP_MEMORY_SCOPE_AGENT); }
__device__ __forceinline__ unsigned xb_xcc_id() { return (unsigned)__builtin_amdgcn_s_getreg((3 << 11) | 20) & 0xFu; }
#define XB_SPIN(cond, bar) do { unsigned _sp = 0; while (cond) { __builtin_amdgcn_s_sleep(1); \
    if ((++_sp & 255u) == 0u) { if (xb_ld(&(bar)[XB_TMO])) break; if (_sp > XB_SPIN_CAP) { atomicAdd(&(bar)[XB_TMO], 1u); break; } } } } while (0)

struct XcdBarrier { unsigned* bar; unsigned x; volatile LAS unsigned* st; int w0; };

__device__ __forceinline__ XcdBarrier xcd_barrier_post(unsigned* bar, volatile LAS unsigned* st, int wave) {
    XcdBarrier b; b.bar = bar; b.x = xb_xcc_id(); b.st = st; b.w0 = (wave == 0) ? 1 : 0;
    if (b.w0 && lane_id() == 0) (void)xb_add(&bar[XB_XCNT(b.x)], 1u);
    return b;
}
__device__ __forceinline__ void xcd_barrier_complete(unsigned* bar, unsigned x, unsigned& nloc, unsigned& nx) {
    const unsigned G = gridDim.x * gridDim.y * gridDim.z;
    unsigned sum, cnt, mine, sp = 0u;
    for (;;) {
        sum = 0u; cnt = 0u; mine = 0u;
#pragma unroll
        for (unsigned j = 0; j < 16; ++j) { const unsigned c = xb_ld(&bar[XB_XCNT(j)]); sum += c; cnt += (c > 0u) ? 1u : 0u; mine = (j == x) ? c : mine; }
        if (sum == G) break;
        __builtin_amdgcn_s_sleep(1);
        if ((++sp & 255u) == 0u) { if (xb_ld(&bar[XB_TMO])) break; if (sp > XB_SPIN_CAP) { atomicAdd(&bar[XB_TMO], 1u); break; } }
    }
    nloc = mine > 0u ? mine : 1u; nx = cnt > 0u ? cnt : 1u;
}
__device__ __forceinline__ void xcd_barrier(const XcdBarrier& b) {
    asm volatile("s_waitcnt vmcnt(0)" ::: "memory");
    __syncthreads();
    if (b.w0 && lane_id() == 0) {
        unsigned* bar = b.bar;
        __builtin_amdgcn_s_waitcnt(0);
        unsigned nloc = b.st[0], nx = b.st[1];
        if (nloc == 0u) { xcd_barrier_complete(bar, b.x, nloc, nx); b.st[0] = nloc; b.st[1] = nx; }
        const unsigned old = xb_add(&bar[XB_XSUB(b.x)], 1u);
        const unsigned gen = old / nloc;
        if (old + 1u == (gen + 1u) * nloc) {
            __builtin_amdgcn_fence(__ATOMIC_RELEASE, "agent");
            asm volatile("s_waitcnt vmcnt(0)" ::: "memory");
            const unsigned og = xb_add(&bar[XB_TOP], 1u);
            const unsigned tg = og / nx;
            if (og + 1u == (tg + 1u) * nx) xb_add(&bar[XB_TOPGEN], 1u);
            else XB_SPIN(xb_ld(&bar[XB_TOPGEN]) == tg, bar);
            __builtin_amdgcn_fence(__ATOMIC_ACQUIRE, "agent");
            xb_add(&bar[XB_XGEN(b.x)], 1u);
            asm volatile("s_waitcnt vmcnt(0)" ::: "memory");
        } else {
            XB_SPIN(xb_ld(&bar[XB_XGEN(b.x)]) == gen, bar);
            __builtin_amdgcn_fence(__ATOMIC_ACQUIRE, "agent");
            asm volatile("s_waitcnt vmcnt(0)" ::: "memory");
        }
    }
    __syncthreads();
}

struct Args { const float* in[26]; float* out; unsigned char* ws; int ph_lo, ph_hi; };
enum { I_X = 0, I_MEM, I_EN1, I_EWIN, I_RPB, I_EWOUT, I_EN2, I_EWG, I_EWU, I_EWD, I_ON1, I_OWIN, I_WGKF, I_BGKF, I_WGKB, I_BGKB, I_GNORM, I_OWOUT, I_ON2, I_WR, I_OWG, I_OWU, I_OWD, I_MNORM, I_WMKV, I_FNORM };

#define LANE() lane_id()
#define TID() ((F.wave << 6) | lane_id())
struct Frame {
    LAS unsigned char* lds;
    int wave, G, bid;
    int gw, NGW;
    unsigned char* ws;
};

constexpr float QSCALE = 0.125f * 1.4426950408889634f;
struct CvtJob { const float* W; int K, N; bf16* WT; const float* gain; int kind; };
__device__ __forceinline__ bool cvt_map(int kind, int n0, int& drow, float& scale) {
    scale = 1.0f;
    switch (kind) {
    case 0: drow = n0; return true;
    case 1: if (n0 < 768) { drow = n0; scale = QSCALE; return true; } if (n0 < 1536) { drow = n0; return true; } if (n0 >= 2304) { drow = n0 - 768; scale = QSCALE; return true; } return false;
    case 2: if (n0 >= 1536 && n0 < 2304) { drow = n0 - 1536; return true; } return false;
    case 3: drow = (n0 >> 7) * 256 + (n0 & 127); return true;
    case 4: drow = (n0 >> 7) * 256 + 128 + (n0 & 127); return true;
    case 5: if (n0 < 768) { drow = n0; return true; } if (n0 < 1536) return false; if (n0 < 2304) { drow = n0 - 768; return true; }
            if (n0 < 2336) { drow = n0 - 512; return true; } drow = n0 - 800; scale = QSCALE; return true;
    case 6: if (n0 >= 768 && n0 < 1536) { drow = n0 - 768; return true; } return false;
    default: drow = n0; return true;
    }
}
__device__ __forceinline__ unsigned pk4_fp8(float a, float b, float c, float d) { a = __builtin_amdgcn_fmed3f(a, -448.f, 448.f); b = __builtin_amdgcn_fmed3f(b, -448.f, 448.f); c = __builtin_amdgcn_fmed3f(c, -448.f, 448.f); d = __builtin_amdgcn_fmed3f(d, -448.f, 448.f);
    unsigned w = 0u; w = (unsigned)__builtin_amdgcn_cvt_pk_fp8_f32(a, b, (int)w, false); w = (unsigned)__builtin_amdgcn_cvt_pk_fp8_f32(c, d, (int)w, true); return w; }
struct CvtRegs { f32x4 v[8]; const float* gain; bf16* WT; int K, k0, drow, valid; float scale; };
__device__ __forceinline__ void cvt_load(CvtRegs& R, const CvtJob& J, int item, int lane) {
    const int nblk = J.N / 32, kb = item / nblk, nb = item % nblk, n0 = nb * 32;
    R.k0 = kb * 64; R.gain = J.gain; R.WT = J.WT; R.K = J.K;
    R.valid = cvt_map(J.kind, n0, R.drow, R.scale) ? 1 : 0;
    if (R.valid) { const float* p = J.W + (size_t)(R.k0 + 2 * (lane >> 3)) * J.N + n0 + 4 * (lane & 7);
#pragma unroll
        for (int j = 0; j < 8; ++j) R.v[j] = *(const f32x4*)(p + (size_t)(16 * (j >> 1) + (j & 1)) * J.N); }
}
__device__ __forceinline__ void cvt_load8(CvtRegs& R, const CvtJob& J, int item, int lane) {
    const int nblk = J.N / 32, kb = item / nblk, nb = item % nblk, n0 = nb * 32;
    R.k0 = kb * 64; R.gain = J.gain; R.WT = J.WT; R.K = J.K;
    R.valid = cvt_map(J.kind, n0, R.drow, R.scale) ? 1 : 0;
    if (R.valid) { const float* p = J.W + (size_t)(R.k0 + 4 * (lane >> 3)) * J.N + n0 + 4 * (lane & 7);
#pragma unroll
        for (int j = 0; j < 8; ++j) R.v[j] = *(const f32x4*)(p + (size_t)(32 * (j >> 2) + (j & 3)) * J.N); }
}
__device__ __forceinline__ void cvt_finish8(const CvtRegs& R, LAS unsigned* T, int lane, float mul) {
    if (!R.valid) return;
    const int nq = lane & 7, kr = lane >> 3;
#pragma unroll
    for (int p = 0; p < 2; ++p) { const int k = R.k0 + 32 * p + 4 * kr; float g[4];
#pragma unroll
        for (int q = 0; q < 4; ++q) g[q] = R.scale * mul * (R.gain ? R.gain[k + q] : 1.0f);
        const f32x4 a = R.v[4 * p], b = R.v[4 * p + 1], c = R.v[4 * p + 2], d = R.v[4 * p + 3]; LAS unsigned* t = T + (4 * nq) * 17 + 8 * p + kr;
        t[0] = pk4_fp8(a.x * g[0], b.x * g[1], c.x * g[2], d.x * g[3]); t[17] = pk4_fp8(a.y * g[0], b.y * g[1], c.y * g[2], d.y * g[3]);
        t[34] = pk4_fp8(a.z * g[0], b.z * g[1], c.z * g[2], d.z * g[3]); t[51] = pk4_fp8(a.w * g[0], b.w * g[1], c.w * g[2], d.w * g[3]); }
    LDS_WAIT(); asm volatile("" ::: "memory");
#pragma unroll
    for (int r = 0; r < 2; ++r) { const int n = (lane >> 2) + 16 * r, c = lane & 3; const LAS unsigned* sp = T + n * 17 + 4 * c;
        v4u o; o.x = sp[0]; o.y = sp[1]; o.z = sp[2]; o.w = sp[3];
        *(GAS v4u*)((unsigned char*)R.WT + (size_t)(R.drow + n) * R.K + R.k0 + 16 * c) = o; }
    LDS_WAIT(); asm volatile("" ::: "memory");
}
__device__ __forceinline__ void cvt_finish(const CvtRegs& R, LAS unsigned* T, int lane) {
    if (!R.valid) return;
    const int nq = lane & 7, kr = lane >> 3;
#pragma unroll
    for (int p = 0; p < 4; ++p) { const int k = R.k0 + 16 * p + 2 * kr; float g0 = R.scale, g1 = R.scale; if (R.gain) { g0 *= R.gain[k]; g1 *= R.gain[k + 1]; }
        const f32x4 a = R.v[2 * p], b = R.v[2 * p + 1]; LAS unsigned* t = T + (4 * nq) * 33 + 8 * p + kr;
        t[0] = pk2(a.x * g0, b.x * g1); t[33] = pk2(a.y * g0, b.y * g1); t[66] = pk2(a.z * g0, b.z * g1); t[99] = pk2(a.w * g0, b.w * g1); }
    LDS_WAIT(); asm volatile("" ::: "memory");
#pragma unroll
    for (int r = 0; r < 4; ++r) { const int n = (lane >> 3) + 8 * r, c = lane & 7; const LAS unsigned* sp = T + n * 33 + 4 * c;
        v4u o; o.x = sp[0]; o.y = sp[1]; o.z = sp[2]; o.w = sp[3];
        *(GAS v4u*)(R.WT + (size_t)(R.drow + n) * R.K + R.k0 + 8 * c) = o; }
    LDS_WAIT(); asm volatile("" ::: "memory");
}
__device__ __forceinline__ void rows_to_bf16(const float* X, bf16* Ob, float* rstd, int first, int nrows, int stride, int lane) {
    for (int m = first; m < nrows; m += 2 * stride) {
        const int m2 = m + stride; const bool h2 = m2 < nrows;
        const GAS f32x4* xa = (const GAS f32x4*)(X + (size_t)m * DM) + lane; const GAS f32x4* xb = (const GAS f32x4*)(X + (size_t)(h2 ? m2 : m) * DM) + lane;
        f32x4 va[4], vb[4];
#pragma unroll
        for (int j = 0; j < 4; ++j) va[j] = xa[64 * j];
#pragma unroll
        for (int j = 0; j < 4; ++j) vb[j] = xb[64 * j];
        float sa = 0.f, sb = 0.f;
#pragma unroll
        for (int j = 0; j < 4; ++j) { sa += (va[j].x * va[j].x + va[j].y * va[j].y) + (va[j].z * va[j].z + va[j].w * va[j].w); sb += (vb[j].x * vb[j].x + vb[j].y * vb[j].y) + (vb[j].z * vb[j].z + vb[j].w * vb[j].w); }
        sa = wave_sum(sa); sb = wave_sum(sb);
        GAS unsigned long long* oa = (GAS unsigned long long*)(Ob + (size_t)m * DM) + lane;
#pragma unroll
        for (int j = 0; j < 4; ++j) oa[64 * j] = (unsigned long long)pk2(va[j].x, va[j].y) | ((unsigned long long)pk2(va[j].z, va[j].w) << 32);
        if (lane == 0) rstd[m] = __builtin_amdgcn_rsqf(sa * (1.0f / DM) + EPS);
        if (h2) { GAS unsigned long long* ob = (GAS unsigned long long*)(Ob + (size_t)m2 * DM) + lane;
#pragma unroll
            for (int j = 0; j < 4; ++j) ob[64 * j] = (unsigned long long)pk2(vb[j].x, vb[j].y) | ((unsigned long long)pk2(vb[j].z, vb[j].w) << 32);
            if (lane == 0) rstd[m2] = __builtin_amdgcn_rsqf(sb * (1.0f / DM) + EPS); }
    }
}

struct Unit { int pm, pn; };
struct Sched {
    int nM, nN, nwg, G, c, K, ld, off0, off1, per;
    const char* A; const char* B; const int* bexp; size_t estride;
    __device__ void init(const void* A_, const void* B_, int K_, int nM_, int nN_, int G_, int c_, const int* bexp_ = nullptr, size_t estride_ = 0) {
        A = (const char*)A_; B = (const char*)B_; K = K_; ld = K_; nM = nM_; nN = nN_; nwg = nM * nN; G = G_; c = c_; bexp = bexp_; estride = estride_; off0 = 0; off1 = 0x7fffffff; per = G_ / 8; }
    __device__ void range(int off0_, int off1_, int per_) { off0 = off0_; off1 = off1_; per = per_; }
    __device__ bool next(int i, Unit& u) const {
        const int q = nwg / 8, r = nwg % 8, xcd = c % 8, slot = c / 8, lt = (int)((unsigned)(xcd - r) >> 31), qx = q + lt;
        if (slot >= per) return false;
        const int off = off0 + i * per + slot, lim = off1 < qx ? off1 : qx;
        if (off >= lim) return false;
        const int wgid = xcd * q + (lt ? xcd : r) + off;
        const int nig = 8 * nN, gid = wgid / nig, fm = gid * 8, gsz = (nM - fm) < 8 ? (nM - fm) : 8;
        u.pm = fm + ((wgid % nig) % gsz); u.pn = (wgid % nig) / gsz; return true;
    }
    __device__ const char* a_base(const Unit& u) const { return A + (size_t)u.pm * 512 * ld; }
    __device__ const char* b_base(const Unit& u) const { return B + (bexp ? (size_t)bexp[u.pm] * estride : (size_t)0) + (size_t)u.pn * 512 * ld; }
};

struct NoAux {};
__device__ __forceinline__ float rstd_from(const float* rss16) {
    const f32x4* p = (const f32x4*)rss16; f32x4 a = p[0], b = p[1], c = p[2], d = p[3];
    const float s = ((a.x + a.y) + (a.z + a.w)) + ((b.x + b.y) + (b.z + b.w)) + ((c.x + c.y) + (c.z + c.w)) + ((d.x + d.y) + (d.z + d.w));
    return __builtin_amdgcn_rsqf(s * (1.0f / DM) + EPS);
}
__device__ __forceinline__ float rstd_from_lds(const LAS float* rss16) {
    const LAS f32x4* p = (const LAS f32x4*)rss16; f32x4 a = p[0], b = p[1], c = p[2], d = p[3];
    const float s = ((a.x + a.y) + (a.z + a.w)) + ((b.x + b.y) + (b.z + b.w)) + ((c.x + c.y) + (c.z + c.w)) + ((d.x + d.y) + (d.z + d.w));
    return __builtin_amdgcn_rsqf(s * (1.0f / DM) + EPS);
}
constexpr int RSS_LDS_REL = 2048;
struct RowCtx { float rs[2][4]; };
template <bool RSS = false> struct EpiRowScaleT {
    static constexpr bool NEED_SS = false; static constexpr int SC_MODE = RSS ? 5 : 1; typedef RowCtx Ctx; typedef NoAux Aux;
    bf16* O; int ldc; const float* sc_src; float mul;
    __device__ __forceinline__ void begin(Ctx& c, const LAS float* sc, const LAS int*, int lr0, int, int, int) const {
#pragma unroll
        for (int ai = 0; ai < 2; ++ai)
#pragma unroll
            for (int m = 0; m < 4; ++m) c.rs[ai][m] = sc[ai * 128 + lr0 + m * 16] * mul;
    }
    __device__ __forceinline__ void load_aux(Aux&, const Ctx&, int, int, int, int, int) const {}
    __device__ __forceinline__ float apply(const Ctx& c, const Aux&, int ai, int m, int row, int pn, int c128, const float (&a)[8], const float (&b)[8]) const {
        const float s = c.rs[ai][m];
        bf16* p = O + (size_t)row * ldc + pn * 256 + c128;
        v4u w; w.x = pk2(a[0] * s, a[1] * s); w.y = pk2(a[2] * s, a[3] * s); w.z = pk2(a[4] * s, a[5] * s); w.w = pk2(a[6] * s, a[7] * s); *(v4u*)p = w;
        w.x = pk2(b[0] * s, b[1] * s); w.y = pk2(b[2] * s, b[3] * s); w.z = pk2(b[4] * s, b[5] * s); w.w = pk2(b[6] * s, b[7] * s); *(v4u*)(p + 128) = w;
        return 0.f;
    }
    __device__ __forceinline__ void row_done(int, int, int, float) const {}
};
typedef EpiRowScaleT<false> EpiRowScale;
struct ColCtx { float sa[8], sb[8]; };
template <bool RSS = false> struct EpiColScaleT {
    static constexpr bool NEED_SS = false; static constexpr int SC_MODE = RSS ? 6 : 2; typedef ColCtx Ctx; typedef NoAux Aux;
    bf16* O; int ldc; const float* sc_src;
    __device__ __forceinline__ void begin(Ctx& c, const LAS float* sc, const LAS int*, int, int, int, int c128) const {
#pragma unroll
        for (int j = 0; j < 8; ++j) { c.sa[j] = sc[c128 + j]; c.sb[j] = sc[128 + c128 + j]; }
    }
    __device__ __forceinline__ void load_aux(Aux&, const Ctx&, int, int, int, int, int) const {}
    __device__ __forceinline__ float apply(const Ctx& c, const Aux&, int, int, int row, int pn, int c128, const float (&a)[8], const float (&b)[8]) const {
        bf16* p = O + (size_t)row * ldc + pn * 256 + c128;
        v4u w; w.x = pk2(a[0] * c.sa[0], a[1] * c.sa[1]); w.y = pk2(a[2] * c.sa[2], a[3] * c.sa[3]); w.z = pk2(a[4] * c.sa[4], a[5] * c.sa[5]); w.w = pk2(a[6] * c.sa[6], a[7] * c.sa[7]); *(v4u*)p = w;
        w.x = pk2(b[0] * c.sb[0], b[1] * c.sb[1]); w.y = pk2(b[2] * c.sb[2], b[3] * c.sb[3]); w.z = pk2(b[4] * c.sb[4], b[5] * c.sb[5]); w.w = pk2(b[6] * c.sb[6], b[7] * c.sb[7]); *(v4u*)(p + 128) = w;
        return 0.f;
    }
    __device__ __forceinline__ void row_done(int, int, int, float) const {}
};
typedef EpiColScaleT<false> EpiColScale;
struct Aux4 { f32x4 v[4]; };
struct NoCtx {};
struct AuxR { f32x4 v[4]; };
struct AuxB { v4u a, b; };
__device__ __forceinline__ void unpack16(const AuxB& x, f32x4 (&v)[4]) {
    v[0] = (f32x4){bflo(x.a.x), bfhi(x.a.x), bflo(x.a.y), bfhi(x.a.y)}; v[1] = (f32x4){bflo(x.a.z), bfhi(x.a.z), bflo(x.a.w), bfhi(x.a.w)};
    v[2] = (f32x4){bflo(x.b.x), bfhi(x.b.x), bflo(x.b.y), bfhi(x.b.y)}; v[3] = (f32x4){bflo(x.b.z), bfhi(x.b.z), bflo(x.b.w), bfhi(x.b.w)}; }
template <bool F32> struct AuxSel { typedef AuxR T; };
template <> struct AuxSel<false> { typedef AuxB T; };
template <bool RF32> struct EpiResid {
    static constexpr bool NEED_SS = true; static constexpr int SC_MODE = 0; typedef NoCtx Ctx; typedef typename AuxSel<RF32>::T Aux;
    const float* R; bf16* HB; float* rss; bf16* HB2;
    __device__ __forceinline__ void begin(Ctx&, const LAS float*, const LAS int*, int, int, int, int) const {}
    __device__ __forceinline__ void load_aux(Aux& x, const Ctx&, int, int, int row, int pn, int c128) const {
        const size_t off = (size_t)row * DM + pn * 256 + c128;
        if constexpr (RF32) { const float* p = R + off; x.v[0] = *(const f32x4*)p; x.v[1] = *(const f32x4*)(p + 4); x.v[2] = *(const f32x4*)(p + 128); x.v[3] = *(const f32x4*)(p + 132); }
        else { x.a = *(const v4u*)(HB + off); x.b = *(const v4u*)(HB + off + 128); }
    }
    __device__ __forceinline__ float apply(const Ctx&, const Aux& xr, int, int, int row, int pn, int c128, const float (&a)[8], const float (&b)[8]) const {
        const size_t off = (size_t)row * DM + pn * 256 + c128;
        struct { f32x4 v[4]; } x; if constexpr (RF32) { x.v[0] = xr.v[0]; x.v[1] = xr.v[1]; x.v[2] = xr.v[2]; x.v[3] = xr.v[3]; } else unpack16(xr, x.v);
        const f32x4 h0 = {x.v[0].x + a[0], x.v[0].y + a[1], x.v[0].z + a[2], x.v[0].w + a[3]}, h1 = {x.v[1].x + a[4], x.v[1].y + a[5], x.v[1].z + a[6], x.v[1].w + a[7]};
        const f32x4 h2 = {x.v[2].x + b[0], x.v[2].y + b[1], x.v[2].z + b[2], x.v[2].w + b[3]}, h3 = {x.v[3].x + b[4], x.v[3].y + b[5], x.v[3].z + b[6], x.v[3].w + b[7]};
        v4u w; w.x = pk2(h0.x, h0.y); w.y = pk2(h0.z, h0.w); w.z = pk2(h1.x, h1.y); w.w = pk2(h1.z, h1.w); *(v4u*)(HB + off) = w; if (HB2) { v2u f; f.x = pk4_fp8(h0.x, h0.y, h0.z, h0.w); f.y = pk4_fp8(h1.x, h1.y, h1.z, h1.w); *(v2u*)((unsigned char*)HB2 + off) = f; }
        w.x = pk2(h2.x, h2.y); w.y = pk2(h2.z, h2.w); w.z = pk2(h3.x, h3.y); w.w = pk2(h3.z, h3.w); *(v4u*)(HB + off + 128) = w; if (HB2) { v2u f; f.x = pk4_fp8(h2.x, h2.y, h2.z, h2.w); f.y = pk4_fp8(h3.x, h3.y, h3.z, h3.w); *(v2u*)((unsigned char*)HB2 + off + 128) = f; }
        return ((h0.x * h0.x + h0.y * h0.y) + (h0.z * h0.z + h0.w * h0.w) + (h1.x * h1.x + h1.y * h1.y) + (h1.z * h1.z + h1.w * h1.w))
             + ((h2.x * h2.x + h2.y * h2.y) + (h2.z * h2.z + h2.w * h2.w) + (h3.x * h3.x + h3.y * h3.y) + (h3.z * h3.z + h3.w * h3.w));
    }
    __device__ __forceinline__ void row_done(int row, int pn, int wc, float ss) const { rss[(size_t)row * 16 + pn * 4 + wc] = ss; }
};
__device__ __forceinline__ float silu_mul(float g, float u) { return g * __builtin_amdgcn_rcpf(1.0f + __builtin_amdgcn_exp2f(g * -1.4426950408889634f)) * u; }
template <bool MOE, bool RSS = false> struct EpiSwiGLU {
    static constexpr bool NEED_SS = false; static constexpr int SC_MODE = MOE ? 3 : (RSS ? 5 : 1); typedef RowCtx Ctx; typedef NoAux Aux;
    bf16* Hm; int ldh; const float* sc_src; bf16* Hmt;
    __device__ __forceinline__ void begin(Ctx& c, const LAS float* sc, const LAS int* tl, int lr0, int, int, int) const {
#pragma unroll
        for (int ai = 0; ai < 2; ++ai)
#pragma unroll
            for (int m = 0; m < 4; ++m) { const int i = ai * 128 + lr0 + m * 16; float r = sc[i];
                if (MOE) { r *= 0.03125f; if (tl[i] < 0) r = 0.f; } c.rs[ai][m] = r; }
    }
    __device__ __forceinline__ void load_aux(Aux&, const Ctx&, int, int, int, int, int) const {}
    __device__ __forceinline__ float apply(const Ctx& c, const Aux&, int ai, int m, int row, int pn, int c128, const float (&a)[8], const float (&b)[8]) const {
        const float s = c.rs[ai][m], s2 = s * -1.4426950408889634f, iss = __builtin_amdgcn_rcpf(s * s); float o[8];
#pragma unroll
        for (int j = 0; j < 8; ++j) o[j] = (a[j] * b[j]) * __builtin_amdgcn_rcpf(__builtin_fmaf(__builtin_amdgcn_exp2f(a[j] * s2), iss, iss));
        v4u w; w.x = pk2(o[0], o[1]); w.y = pk2(o[2], o[3]); w.z = pk2(o[4], o[5]); w.w = pk2(o[6], o[7]);
        if constexpr (MOE) {
            unsigned char* rp = (row >= NT) ? (unsigned char*)Hmt + (size_t)(row - NT) * ldh : (unsigned char*)Hm + (size_t)row * ldh;
            v2u f; f.x = pk4_fp8(o[0], o[1], o[2], o[3]); f.y = pk4_fp8(o[4], o[5], o[6], o[7]); *(v2u*)(rp + pn * 128 + c128) = f;
        } else *(v4u*)(Hm + (size_t)row * ldh + pn * 128 + c128) = w;
        return 0.f;
    }
    __device__ __forceinline__ void row_done(int, int, int, float) const {}
};

namespace pg8 {
constexpr int HTB = 16384, TOK_OFF = 132096, SC_OFF = 134144;
__device__ __forceinline__ int lds_byte(int r, int c) { const int st = (r >> 4) * 2 + (c >> 5), rr = r & 15, cc = c & 31, ob = rr * 64 + cc * 2; return st * 1024 + (ob ^ (((ob >> 9) & 1) << 5)); }
__device__ __forceinline__ void stage_rc(int b, int& R, int& C) { const int st = b / 1024, sb = b % 1024, swz = sb ^ (((sb >> 9) & 1) << 5); R = (st >> 1) * 16 + swz / 64; C = (st & 1) * 32 + (swz % 64) / 2; }
__device__ __forceinline__ int perm32(int rho) { const int n = rho >> 4, i = rho & 15; return 8 * (i >> 2) + 4 * n + (i & 3); }

template <class Epi>
__device__ __forceinline__ void run_epi(const Epi& E, const f32x4 (&acc)[2][2][4][2], const Unit& u, int wr, int wc, int fr, int fq, const LAS float* sc, const LAS int* tlp) {
    int row0 = u.pm * 256 + wr * 64 + fr, c128 = 32 * wc + 8 * fq;
    asm volatile("" : "+v"(row0), "+v"(c128));
    typename Epi::Ctx ctx; E.begin(ctx, sc, tlp, wr * 64 + fr, row0, u.pn, c128);
#pragma unroll
    for (int ai = 0; ai < 2; ++ai) {
        typename Epi::Aux aux[4];
#pragma unroll
        for (int m = 0; m < 4; ++m) E.load_aux(aux[m], ctx, ai, m, row0 + ai * 128 + m * 16, u.pn, c128);
#pragma unroll
        for (int m = 0; m < 4; ++m) {
            const int row = row0 + ai * 128 + m * 16;
            float a[8], b[8];
#pragma unroll
            for (int j = 0; j < 8; ++j) { a[j] = acc[ai][0][m][j >> 2][j & 3]; b[j] = acc[ai][1][m][j >> 2][j & 3]; }
            float ss = E.apply(ctx, aux[m], ai, m, row, u.pn, c128, a, b);
            if (Epi::NEED_SS) { ss += __shfl_xor(ss, 16); ss += __shfl_xor(ss, 32); if (fq == 0) E.row_done(row, u.pn, wc, ss); }
        }
    }
}

typedef int v8i __attribute__((ext_vector_type(8)));
template <class Epi, bool GATHER, bool FP8 = false>
__device__ __forceinline__ void gemm_fast(LAS unsigned char* lds, const Sched& S, const Epi& E, const int* gtok, int wave_) {
    int tid = (wave_ << 6) | lane_id(); asm volatile("" : "+v"(tid));
    const int wid = __builtin_amdgcn_readfirstlane(tid >> 6), lane = tid & 63, wr = wid >> 2, wc = wid & 3, fr = lane & 15, fq = lane >> 4;
    const int K = S.ld, nt = S.K / 64;
    unsigned voffB[2], vA0[2], vA1[2], nA0[2], nA1[2]; int RA[2], CA2[2];
#pragma unroll
    for (int i = 0; i < 2; ++i) { int R, C; stage_rc(tid * 16 + i * 8192, R, C); const int Rb = (R & ~31) + perm32(R & 31);
        voffB[i] = (unsigned)(Rb * K + C) * 2u; RA[i] = R; CA2[i] = C * 2; vA0[i] = (unsigned)(R * K + C) * 2u; vA1[i] = vA0[i] + (unsigned)(128 * K * 2); nA0[i] = vA0[i]; nA1[i] = vA1[i]; }
    const size_t kstep = 128;
    const size_t hstep = (size_t)128 * K * 2;
    const unsigned ldsw = (unsigned)wid * 1024u;
    const int aoff = lds_byte(wr * 64 + fr, fq * 8), boff = lds_byte(wc * 32 + fr, fq * 8);
    LAS int* tl = (LAS int*)(lds + TOK_OFF);
#define PG8_SA(b, h) (((b) * 2 + (h)) * HTB)
#define PG8_SB(b, h) ((4 + (b) * 2 + (h)) * HTB)
#define PG8_STAGE(bufoff, gbase, voff) do { _Pragma("unroll") for (int _i = 0; _i < 2; ++_i) \
        __builtin_amdgcn_global_load_lds((const unsigned*)((const char*)(gbase) + (voff)[_i]), (LAS unsigned*)(lds + (bufoff) + ldsw + _i * 8192), 16, 0, 0); } while (0)
#define PG8_LDA(dst, b, h) do { _Pragma("unroll") for (int m = 0; m < 4; ++m) _Pragma("unroll") for (int k = 0; k < 2; ++k) dst[m][k] = *(const LAS bf16x8*)(lds + PG8_SA(b, h) + aoff + m * 2048 + k * 1024); } while (0)
#define PG8_LDB(dst, b, h) do { _Pragma("unroll") for (int n = 0; n < 2; ++n) _Pragma("unroll") for (int k = 0; k < 2; ++k) dst[n][k] = *(const LAS bf16x8*)(lds + PG8_SB(b, h) + boff + n * 2048 + k * 1024); } while (0)
#define PG8_MMA(ai, bj, At, Bt) do { __builtin_amdgcn_s_setprio(1); _Pragma("unroll") for (int m = 0; m < 4; ++m) _Pragma("unroll") for (int n = 0; n < 2; ++n) { \
        if constexpr (FP8) { const v8i b8_ = __builtin_bit_cast(v8i, __builtin_shufflevector(Bt[n][0], Bt[n][1], 0, 1, 2, 3, 4, 5, 6, 7, 8, 9, 10, 11, 12, 13, 14, 15)), a8_ = __builtin_bit_cast(v8i, __builtin_shufflevector(At[m][0], At[m][1], 0, 1, 2, 3, 4, 5, 6, 7, 8, 9, 10, 11, 12, 13, 14, 15)); \
            asm volatile("v_mfma_f32_16x16x128_f8f6f4 %0, %1, %2, %0" : "+v"(acc[ai][bj][m][n]) : "v"(b8_), "v"(a8_)); }     \
        else { _Pragma("unroll") for (int k = 0; k < 2; ++k) acc[ai][bj][m][n] = __builtin_amdgcn_mfma_f32_16x16x32_bf16(Bt[n][k], At[m][k], acc[ai][bj][m][n], 0, 0, 0); } } \
        __builtin_amdgcn_s_setprio(0); } while (0)
#define PG8_WAIT_V(n) asm volatile("s_waitcnt vmcnt(" #n ")" ::: "memory")
#define PG8_WAIT_L(n) asm volatile("s_waitcnt lgkmcnt(" #n ")" ::: "memory")
#define PG8_BAR __builtin_amdgcn_s_barrier()
#define PG8_SCHED __builtin_amdgcn_sched_barrier(0)
#define PG8_IDS_DMA(pm_, par_) do { if (wid < 4) __builtin_amdgcn_global_load_lds((const unsigned*)(gtok + (pm_) * 256 + wid * 64 + lane), (LAS unsigned*)(lds + TOK_OFF + (par_) * 1024 + wid * 256), 4, 0, 0); } while (0)
#define PG8_IDS_READ(d0, d1, par_) do { _Pragma("unroll") for (int _i = 0; _i < 2; ++_i) { int t0 = tl[(par_) * 256 + RA[_i]], t1 = tl[(par_) * 256 + 128 + RA[_i]]; t0 = t0 < 0 ? 0 : t0; t1 = t1 < 0 ? 0 : t1; \
        d0[_i] = (unsigned)t0 * (unsigned)(K * 2) + (unsigned)CA2[_i]; d1[_i] = (unsigned)t1 * (unsigned)(K * 2) + (unsigned)CA2[_i]; } } while (0)
    Unit cur, nxt; int ui = 0, par = 0;
    if (!S.next(0, cur)) return;
    f32x4 acc[2][2][4][2];
#pragma unroll
    for (int a = 0; a < 2; ++a)
#pragma unroll
        for (int b = 0; b < 2; ++b)
#pragma unroll
            for (int m = 0; m < 4; ++m)
#pragma unroll
                for (int n = 0; n < 2; ++n) acc[a][b][m][n] = (f32x4){0.f, 0.f, 0.f, 0.f};
    bf16x8 At[4][2], B0[2][2], B1[2][2];
    const char* cA = GATHER ? S.A : S.a_base(cur); const char* cB = S.b_base(cur);
    if constexpr (GATHER) { PG8_IDS_DMA(cur.pm, 0); PG8_WAIT_V(0); __syncthreads(); PG8_IDS_READ(vA0, vA1, 0); }
    PG8_STAGE(PG8_SB(0, 0), cB, voffB); PG8_STAGE(PG8_SB(0, 1), cB + hstep, voffB); PG8_STAGE(PG8_SA(0, 0), cA, vA0); PG8_STAGE(PG8_SA(0, 1), cA, vA1);
    if (wr == 1) PG8_BAR;
    PG8_WAIT_V(2); PG8_BAR;
    PG8_STAGE(PG8_SB(1, 0), cB + kstep, voffB); PG8_STAGE(PG8_SA(1, 0), cA + kstep, vA0); PG8_STAGE(PG8_SB(1, 1), cB + hstep + kstep, voffB);
    PG8_WAIT_V(6); PG8_BAR;
    for (;;) {
        const bool has_next = S.next(ui + 1, nxt);
        const char* nA = has_next ? (GATHER ? S.A : S.a_base(nxt)) : cA; const char* nB = has_next ? S.b_base(nxt) : cB;
        for (int t = 0; t < nt; t += 2) {
            const bool last = (t == nt - 2);
            if constexpr (GATHER) {
                if (t == nt - 4 && has_next) PG8_IDS_DMA(nxt.pm, par ^ 1);
                if (last) { if (has_next) PG8_IDS_READ(nA0, nA1, par ^ 1); else { nA0[0] = vA0[0]; nA0[1] = vA0[1]; nA1[0] = vA1[0]; nA1[1] = vA1[1]; } }
            }
            if constexpr (Epi::SC_MODE == 5 || Epi::SC_MODE == 6) {
                if (last) { const float* src_ = E.sc_src + (size_t)(Epi::SC_MODE == 5 ? cur.pm : cur.pn) * 4096 + wid * 512 + lane * 4;
                    __builtin_amdgcn_global_load_lds((const unsigned*)src_, (LAS unsigned*)(lds + SC_OFF + RSS_LDS_REL + wid * 2048), 16, 0, 0);
                    __builtin_amdgcn_global_load_lds((const unsigned*)(src_ + 256), (LAS unsigned*)(lds + SC_OFF + RSS_LDS_REL + wid * 2048 + 1024), 16, 0, 0); }
            } else if constexpr (Epi::SC_MODE != 0) {
                if (last && wid < 4) { const int i_ = wid * 64 + lane; LAS unsigned* d_ = (LAS unsigned*)(lds + SC_OFF + wid * 256);
                    if constexpr (Epi::SC_MODE == 1) __builtin_amdgcn_global_load_lds((const unsigned*)(E.sc_src + cur.pm * 256 + i_), d_, 4, 0, 0);
                    if constexpr (Epi::SC_MODE == 2) __builtin_amdgcn_global_load_lds((const unsigned*)(E.sc_src + cur.pn * 256 + i_), d_, 4, 0, 0);
                    if constexpr (Epi::SC_MODE == 3) { int t_ = tl[par * 256 + i_]; t_ = t_ < 0 ? 0 : t_; __builtin_amdgcn_global_load_lds((const unsigned*)(E.sc_src + t_), d_, 4, 0, 0); }
                    if constexpr (Epi::SC_MODE == 4) { __builtin_amdgcn_global_load_lds((const unsigned*)(E.tok + cur.pm * 256 + i_), d_, 4, 0, 0);
                        __builtin_amdgcn_global_load_lds((const unsigned*)(E.w + cur.pm * 256 + i_), (LAS unsigned*)(lds + SC_OFF + 1024 + wid * 256), 4, 0, 0); } }
            }
            const char* a1 = cA + (size_t)(t + 1) * kstep;
            const char* a2 = last ? nA : cA + (size_t)(t + 2) * kstep; const char* b2 = last ? nB : cB + (size_t)(t + 2) * kstep;
            const char* a3 = a2 + kstep; const char* b3 = b2 + kstep;
            unsigned w0[2], w1[2];
            if (GATHER && last) { w0[0] = nA0[0]; w0[1] = nA0[1]; w1[0] = nA1[0]; w1[1] = nA1[1]; } else { w0[0] = vA0[0]; w0[1] = vA0[1]; w1[0] = vA1[0]; w1[1] = vA1[1]; }
            PG8_LDB(B0, 0, 0); PG8_LDB(B1, 0, 1); PG8_SCHED; PG8_LDA(At, 0, 0); PG8_STAGE(PG8_SA(1, 1), a1, vA1);
            PG8_WAIT_V(8); PG8_WAIT_L(0); PG8_BAR; PG8_MMA(0, 0, At, B0); PG8_MMA(0, 1, At, B1); PG8_BAR; PG8_SCHED;
            PG8_LDA(At, 0, 1); PG8_STAGE(PG8_SB(0, 0), b2, voffB); PG8_STAGE(PG8_SB(0, 1), b2 + hstep, voffB); PG8_STAGE(PG8_SA(0, 0), a2, w0);
            PG8_WAIT_V(8); PG8_WAIT_L(0); PG8_BAR; PG8_MMA(1, 0, At, B0); PG8_MMA(1, 1, At, B1); PG8_BAR; PG8_SCHED;
            PG8_LDB(B0, 1, 0); PG8_LDB(B1, 1, 1); PG8_SCHED; PG8_LDA(At, 1, 0); PG8_STAGE(PG8_SA(0, 1), a2, w1);
            PG8_WAIT_V(8); PG8_WAIT_L(0); PG8_BAR; PG8_MMA(0, 0, At, B0); PG8_MMA(0, 1, At, B1); PG8_BAR; PG8_SCHED;
            PG8_LDA(At, 1, 1); PG8_STAGE(PG8_SB(1, 0), b3, voffB); PG8_STAGE(PG8_SB(1, 1), b3 + hstep, voffB); PG8_STAGE(PG8_SA(1, 0), a3, w0);
            PG8_WAIT_V(8); PG8_WAIT_L(0); PG8_BAR; PG8_MMA(1, 0, At, B0); PG8_MMA(1, 1, At, B1); PG8_BAR; PG8_SCHED;
        }
        if constexpr (FP8) asm volatile("s_nop 15\n\ts_nop 15" ::: "memory");
        if (wr == 0) PG8_BAR;
        if constexpr (Epi::SC_MODE == 5 || Epi::SC_MODE == 6) {
            if (wid < 4) ((LAS float*)(lds + SC_OFF))[tid] = rstd_from_lds((const LAS float*)(lds + SC_OFF + RSS_LDS_REL) + tid * 16);
            PG8_WAIT_L(0); PG8_BAR;
        }
        run_epi(E, acc, cur, wr, wc, fr, fq, (const LAS float*)(lds + SC_OFF), (const LAS int*)(lds + TOK_OFF + par * 1024));
        if (!has_next) break;
#pragma unroll
        for (int a = 0; a < 2; ++a)
#pragma unroll
            for (int b = 0; b < 2; ++b)
#pragma unroll
                for (int m = 0; m < 4; ++m)
#pragma unroll
                    for (int n = 0; n < 2; ++n) acc[a][b][m][n] = (f32x4){0.f, 0.f, 0.f, 0.f};
        cur = nxt; cA = nA; cB = nB; ++ui;
        if constexpr (GATHER) { vA0[0] = nA0[0]; vA0[1] = nA0[1]; vA1[0] = nA1[0]; vA1[1] = nA1[1]; par ^= 1; }
        if (wr == 1) PG8_BAR;
    }
    PG8_WAIT_V(0);
    PG8_BAR;
#undef PG8_SA
#undef PG8_SB
#undef PG8_STAGE
#undef PG8_LDA
#undef PG8_LDB
#undef PG8_MMA
#undef PG8_WAIT_V
#undef PG8_WAIT_L
#undef PG8_BAR
#undef PG8_SCHED
#undef PG8_IDS_DMA
#undef PG8_IDS_READ
}
}

template <class Epi, bool GATHER, bool FP8 = false>
__device__ __forceinline__ void gemm_run(LAS unsigned char* lds, const Sched& S, const Epi& E, const int* gtok, int wave_) { pg8::gemm_fast<Epi, GATHER, FP8>(lds, S, E, gtok, wave_); }

typedef short s16x4 __attribute__((ext_vector_type(4)));
template <bool NA, bool KLDS = false, int VLDS = 0, int KRS = 64>
__device__ __forceinline__ void attn16(int lane, const bf16* Q, int ldq, const bf16* Kb, int ldk, const bf16* Vt, int ldv, int ktok0, int trs, bf16* O, int ldo,
                                       const LAS float* rpb_h, int r, int r0, int jb, int band0, const LAS unsigned char* Kl = nullptr, int arow0 = 0, const LAS unsigned char* Vl = nullptr, int kb0 = 0) {
    const int qi = lane & 15, g = lane >> 4;
    bf16x8 qf[2];
#pragma unroll
    for (int ks = 0; ks < 2; ++ks) qf[ks] = *(const bf16x8*)(Q + (size_t)qi * ldq + ks * 32 + 8 * g);
    f32x4 s[16];
    const int krow = 8 * (qi >> 2) + (qi & 3);
#pragma unroll
    for (int t = 0; t < 16; ++t) {
        bf16x8 k0, k1;
        if constexpr (KLDS) {
            const int kcol = kb0 + krow + 4 * (t & 1), swz = (((kcol >> 3) & 3) << 1) | ((kcol >> 1) & 1);
            const LAS unsigned char* kb = Kl + ((arow0 + (t >> 1)) * KRS + kcol) * 128;
            k0 = *(const LAS bf16x8*)(kb + ((g ^ swz) << 4)); k1 = *(const LAS bf16x8*)(kb + (((4 + g) ^ swz) << 4));
        } else {
            const bf16* kp = Kb + (size_t)(ktok0 + (t >> 1) * trs + krow + 4 * (t & 1)) * ldk + 8 * g;
            k0 = *(const bf16x8*)kp; k1 = *(const bf16x8*)(kp + 32);
        }
        f32x4 z = {0.f, 0.f, 0.f, 0.f};
        z = __builtin_amdgcn_mfma_f32_16x16x32_bf16(k0, qf[0], z, 0, 0, 0);
        z = __builtin_amdgcn_mfma_f32_16x16x32_bf16(k1, qf[1], z, 0, 0, 0);
        s[t] = z;
        if constexpr (KLDS) { if ((t & 3) == 3) __builtin_amdgcn_sched_barrier(0); }
    }
    bf16x8 vfa[VLDS ? 1 : 4][VLDS ? 1 : 8];
    if constexpr (!VLDS) {
#pragma unroll
        for (int mt = 0; mt < 4; ++mt)
#pragma unroll
            for (int kk = 0; kk < 8; ++kk) vfa[mt][kk] = *(const bf16x8*)(Vt + (size_t)(16 * mt + qi) * ldv + ktok0 + kk * trs + 8 * g);
        __builtin_amdgcn_sched_barrier(0);
    }
    float m = -INFINITY;
    if constexpr (NA) {
        const int qc = 16 * jb + qi, cs = min(max(qc - 8, 0), 48);
        const LAS float* bp = rpb_h + (r0 - r + 7) * 31 + (band0 + 8 * g - qc + 15);
        bool ok[2][4];
#pragma unroll
        for (int hh = 0; hh < 2; ++hh)
#pragma unroll
            for (int i = 0; i < 4; ++i) { const int kc = band0 + 8 * g + 4 * hh + i; ok[hh][i] = (kc >= cs) && (kc < cs + 16); }
#pragma unroll
        for (int tq = 0; tq < 4; ++tq) {
            float bv[4][4];
#pragma unroll
            for (int tt = 0; tt < 4; ++tt)
#pragma unroll
                for (int i = 0; i < 4; ++i) { const int t = 4 * tq + tt; bv[tt][i] = bp[(t >> 1) * 31 + 4 * (t & 1) + i]; }
#pragma unroll
            for (int tt = 0; tt < 4; ++tt)
#pragma unroll
                for (int i = 0; i < 4; ++i) asm volatile("" : "+v"(bv[tt][i]));
#pragma unroll
            for (int tt = 0; tt < 4; ++tt)
#pragma unroll
                for (int i = 0; i < 4; ++i) { const int t = 4 * tq + tt;
                    const float v = ok[t & 1][i] ? s[t][i] + bv[tt][i] : -INFINITY;
                    s[t][i] = v; m = fmaxf(m, v); }
        }
    } else {
#pragma unroll
        for (int t = 0; t < 16; ++t)
#pragma unroll
            for (int i = 0; i < 4; ++i) m = fmaxf(m, s[t][i]);
    }
    m = fmaxf(m, __shfl_xor(m, 16)); m = fmaxf(m, __shfl_xor(m, 32));
    float l = 0.f;
    bf16x8 pf[8];
#pragma unroll
    for (int kk = 0; kk < 8; ++kk) {
        float p[8];
#pragma unroll
        for (int i = 0; i < 4; ++i) { p[i] = __builtin_amdgcn_exp2f(s[2 * kk][i] - m); p[4 + i] = __builtin_amdgcn_exp2f(s[2 * kk + 1][i] - m); }
#pragma unroll
        for (int i = 0; i < 8; ++i) l += p[i];
        v4u w; w.x = pk2(p[0], p[1]); w.y = pk2(p[2], p[3]); w.z = pk2(p[4], p[5]); w.w = pk2(p[6], p[7]);
        pf[kk] = __builtin_bit_cast(bf16x8, w);
    }
    l += __shfl_xor(l, 16); l += __shfl_xor(l, 32);
    const float inv = __builtin_amdgcn_rcpf(l);
#pragma unroll
    for (int mt = 0; mt < 4; ++mt) {
        f32x4 acc = {0.f, 0.f, 0.f, 0.f};
#pragma unroll
        for (int kk = 0; kk < 8; ++kk) {
            bf16x8 vf; if constexpr (VLDS == 1) vf = *(const LAS bf16x8*)(Vl + (16 * mt + qi) * 512 + (((4 * kk + g) ^ qi) << 4));
            else if constexpr (VLDS == 2) vf = *(const LAS bf16x8*)(Vl + (16 * mt + qi) * 1200 + ((arow0 + kk) * 40 + kb0 + 8 * g) * 2);
            else vf = vfa[mt][kk];
            acc = __builtin_amdgcn_mfma_f32_16x16x32_bf16(vf, pf[kk], acc, 0, 0, 0);
        }
        v2u w; w.x = pk2(acc[0] * inv, acc[1] * inv); w.y = pk2(acc[2] * inv, acc[3] * inv);
        *(v2u*)(O + (size_t)qi * ldo + 16 * mt + 4 * g) = w;
        if constexpr (VLDS) __builtin_amdgcn_sched_barrier(0);
    }
}
template <bool NA, int VMODE, int KRS>
__device__ __forceinline__ void attn16_lds(int lane, const bf16* Q, int ldq, bf16* O, int ldo, const LAS float* rpb_h, int r, int r0, int jb, int band0,
                                           const LAS unsigned char* Kl, int arow0, const LAS unsigned char* Vl, int kb0) {
    const int qi = lane & 15, g = lane >> 4;
    bf16x8 qf[2];
#pragma unroll
    for (int ks = 0; ks < 2; ++ks) qf[ks] = *(const bf16x8*)(Q + (size_t)qi * ldq + ks * 32 + 8 * g);
    const int krow = 8 * (qi >> 2) + (qi & 3);
    const LAS unsigned char* kbase[2][2];
#pragma unroll
    for (int e = 0; e < 2; ++e) { const int kcol = kb0 + krow + 4 * e, swz = (((kcol >> 3) & 3) << 1) | ((kcol >> 1) & 1); const LAS unsigned char* rb = Kl + (arow0 * KRS + kcol) * 128;
        kbase[e][0] = rb + ((g ^ swz) << 4); kbase[e][1] = rb + (((4 + g) ^ swz) << 4); }
#define A16_KFR(t, hh) (*(const LAS bf16x8*)(kbase[(t) & 1][hh] + ((t) >> 1) * (KRS * 128)))
    const LAS unsigned char* vbase[VMODE == 1 ? 8 : 1];
    if constexpr (VMODE == 1) {
#pragma unroll
        for (int kk = 0; kk < 8; ++kk) vbase[kk] = Vl + qi * 512 + (((4 * kk + g) ^ qi) << 4);
    } else vbase[0] = Vl + qi * 1200 + (arow0 * 40 + kb0 + 8 * g) * 2;
#define A16_VFR(mt, kk) (VMODE == 1 ? *(const LAS bf16x8*)(vbase[VMODE == 1 ? (kk) : 0] + (mt) * 8192) : *(const LAS bf16x8*)(vbase[0] + (mt) * 19200 + (kk) * 80))
    f32x4 s[16];
    bf16x8 kb[2][4][2];
    float bv[NA ? 16 : 1][4];
    const LAS float* bp = nullptr;
    if constexpr (NA) { const int qc = 16 * jb + qi; bp = rpb_h + (r0 - r + 7) * 31 + (band0 + 8 * g - qc + 15); }
#pragma unroll
    for (int tt = 0; tt < 4; ++tt) { kb[0][tt][0] = A16_KFR(tt, 0); kb[0][tt][1] = A16_KFR(tt, 1); }
#pragma unroll
    for (int gi = 0; gi < 4; ++gi) {
        if (gi < 3) {
#pragma unroll
            for (int tt = 0; tt < 4; ++tt) { kb[(gi + 1) & 1][tt][0] = A16_KFR(4 * (gi + 1) + tt, 0); kb[(gi + 1) & 1][tt][1] = A16_KFR(4 * (gi + 1) + tt, 1); }
        } else if constexpr (NA) {
#pragma unroll
            for (int t = 0; t < 16; ++t)
#pragma unroll
                for (int i = 0; i < 4; ++i) bv[t][i] = bp[(t >> 1) * 31 + 4 * (t & 1) + i];
        }
        __builtin_amdgcn_sched_barrier(0);
#pragma unroll
        for (int tt = 0; tt < 4; ++tt) { const f32x4 z = {0.f, 0.f, 0.f, 0.f}; s[4 * gi + tt] = __builtin_amdgcn_mfma_f32_16x16x32_bf16(kb[gi & 1][tt][0], qf[0], z, 0, 0, 0); }
#pragma unroll
        for (int tt = 0; tt < 4; ++tt) s[4 * gi + tt] = __builtin_amdgcn_mfma_f32_16x16x32_bf16(kb[gi & 1][tt][1], qf[1], s[4 * gi + tt], 0, 0, 0);
        __builtin_amdgcn_sched_barrier(0);
    }
    bf16x8 vb[2][8];
#pragma unroll
    for (int kk = 0; kk < 8; ++kk) vb[0][kk] = A16_VFR(0, kk);
    __builtin_amdgcn_sched_barrier(0);
    float m = -INFINITY;
    if constexpr (NA) {
        const int qc = 16 * jb + qi, cs = min(max(qc - 8, 0), 48);
        bool ok[2][4];
#pragma unroll
        for (int hh = 0; hh < 2; ++hh)
#pragma unroll
            for (int i = 0; i < 4; ++i) { const int kc = band0 + 8 * g + 4 * hh + i; ok[hh][i] = (kc >= cs) && (kc < cs + 16); }
#pragma unroll
        for (int t = 0; t < 16; ++t)
#pragma unroll
            for (int i = 0; i < 4; ++i) asm volatile("" : "+v"(bv[t][i]));
#pragma unroll
        for (int t = 0; t < 16; ++t)
#pragma unroll
            for (int i = 0; i < 4; ++i) { const float v = ok[t & 1][i] ? s[t][i] + bv[t][i] : -INFINITY; s[t][i] = v; m = fmaxf(m, v); }
    } else {
#pragma unroll
        for (int t = 0; t < 16; ++t)
#pragma unroll
            for (int i = 0; i < 4; ++i) m = fmaxf(m, s[t][i]);
    }
    m = fmaxf(m, __shfl_xor(m, 16)); m = fmaxf(m, __shfl_xor(m, 32));
    float l = 0.f;
    bf16x8 pf[8];
#pragma unroll
    for (int kk = 0; kk < 8; ++kk) {
        float p[8];
#pragma unroll
        for (int i = 0; i < 4; ++i) { p[i] = __builtin_amdgcn_exp2f(s[2 * kk][i] - m); p[4 + i] = __builtin_amdgcn_exp2f(s[2 * kk + 1][i] - m); }
#pragma unroll
        for (int i = 0; i < 8; ++i) l += p[i];
        v4u w; w.x = pk2(p[0], p[1]); w.y = pk2(p[2], p[3]); w.z = pk2(p[4], p[5]); w.w = pk2(p[6], p[7]);
        pf[kk] = __builtin_bit_cast(bf16x8, w);
    }
    l += __shfl_xor(l, 16); l += __shfl_xor(l, 32);
    const float inv = __builtin_amdgcn_rcpf(l);
    __builtin_amdgcn_sched_barrier(0);
#pragma unroll
    for (int mt = 0; mt < 4; ++mt) {
        if (mt < 3) {
#pragma unroll
            for (int kk = 0; kk < 8; ++kk) vb[(mt + 1) & 1][kk] = A16_VFR(mt + 1, kk);
        }
        __builtin_amdgcn_sched_barrier(0);
        f32x4 a0 = {0.f, 0.f, 0.f, 0.f}, a1 = {0.f, 0.f, 0.f, 0.f};
#pragma unroll
        for (int kk = 0; kk < 8; kk += 2) { a0 = __builtin_amdgcn_mfma_f32_16x16x32_bf16(vb[mt & 1][kk], pf[kk], a0, 0, 0, 0); a1 = __builtin_amdgcn_mfma_f32_16x16x32_bf16(vb[mt & 1][kk + 1], pf[kk + 1], a1, 0, 0, 0); }
        v2u w; w.x = pk2((a0[0] + a1[0]) * inv, (a0[1] + a1[1]) * inv); w.y = pk2((a0[2] + a1[2]) * inv, (a0[3] + a1[3]) * inv);
        *(v2u*)(O + (size_t)qi * ldo + 16 * mt + 4 * g) = w;
        __builtin_amdgcn_sched_barrier(0);
    }
#undef A16_KFR
#undef A16_VFR
}
template <int KRS>
__device__ __forceinline__ void na_qk_sm(int lane, const bf16x8 (&qf)[2], const LAS float* rpb_h, int r, int r0, int jb, int band0, const LAS unsigned char* Kl, int arow0, int kb0, bf16x8 (&pf)[8], float& inv) {
    const int qi = lane & 15, g = lane >> 4;
    const int krow = 8 * (qi >> 2) + (qi & 3);
    const LAS unsigned char* kbase[2][2];
#pragma unroll
    for (int e = 0; e < 2; ++e) { const int kcol = kb0 + krow + 4 * e, swz = (((kcol >> 3) & 3) << 1) | ((kcol >> 1) & 1); const LAS unsigned char* rb = Kl + (arow0 * KRS + kcol) * 128;
        kbase[e][0] = rb + ((g ^ swz) << 4); kbase[e][1] = rb + (((4 + g) ^ swz) << 4); }
#define A16_KFR(t, hh) (*(const LAS bf16x8*)(kbase[(t) & 1][hh] + ((t) >> 1) * (KRS * 128)))
    f32x4 s[16];
    bf16x8 kb[2][4][2];
    float bv[16][4];
    const int qc = 16 * jb + qi;
    const LAS float* bp = rpb_h + (r0 - r + 7) * 31 + (band0 + 8 * g - qc + 15);
#pragma unroll
    for (int tt = 0; tt < 4; ++tt) { kb[0][tt][0] = A16_KFR(tt, 0); kb[0][tt][1] = A16_KFR(tt, 1); }
#pragma unroll
    for (int gi = 0; gi < 4; ++gi) {
        if (gi < 3) {
#pragma unroll
            for (int tt = 0; tt < 4; ++tt) { kb[(gi + 1) & 1][tt][0] = A16_KFR(4 * (gi + 1) + tt, 0); kb[(gi + 1) & 1][tt][1] = A16_KFR(4 * (gi + 1) + tt, 1); }
        } else {
#pragma unroll
            for (int t = 0; t < 16; ++t)
#pragma unroll
                for (int i = 0; i < 4; ++i) bv[t][i] = bp[(t >> 1) * 31 + 4 * (t & 1) + i];
        }
        __builtin_amdgcn_sched_barrier(0);
#pragma unroll
        for (int tt = 0; tt < 4; ++tt) { const f32x4 z = {0.f, 0.f, 0.f, 0.f}; s[4 * gi + tt] = __builtin_amdgcn_mfma_f32_16x16x32_bf16(kb[gi & 1][tt][0], qf[0], z, 0, 0, 0); }
#pragma unroll
        for (int tt = 0; tt < 4; ++tt) s[4 * gi + tt] = __builtin_amdgcn_mfma_f32_16x16x32_bf16(kb[gi & 1][tt][1], qf[1], s[4 * gi + tt], 0, 0, 0);
        __builtin_amdgcn_sched_barrier(0);
    }
#undef A16_KFR
    float m = -INFINITY;
    { const int cs = min(max(qc - 8, 0), 48);
      bool ok[2][4];
#pragma unroll
      for (int hh = 0; hh < 2; ++hh)
#pragma unroll
          for (int i = 0; i < 4; ++i) { const int kc = band0 + 8 * g + 4 * hh + i; ok[hh][i] = (kc >= cs) && (kc < cs + 16); }
#pragma unroll
      for (int t = 0; t < 16; ++t)
#pragma unroll
          for (int i = 0; i < 4; ++i) asm volatile("" : "+v"(bv[t][i]));
#pragma unroll
      for (int t = 0; t < 16; ++t)
#pragma unroll
          for (int i = 0; i < 4; ++i) { const float v = ok[t & 1][i] ? s[t][i] + bv[t][i] : -INFINITY; s[t][i] = v; m = fmaxf(m, v); } }
    m = fmaxf(m, __shfl_xor(m, 16)); m = fmaxf(m, __shfl_xor(m, 32));
    float l = 0.f;
#pragma unroll
    for (int kk = 0; kk < 8; ++kk) {
        float p[8];
#pragma unroll
        for (int i = 0; i < 4; ++i) { p[i] = __builtin_amdgcn_exp2f(s[2 * kk][i] - m); p[4 + i] = __builtin_amdgcn_exp2f(s[2 * kk + 1][i] - m); }
#pragma unroll
        for (int i = 0; i < 8; ++i) l += p[i];
        v4u w; w.x = pk2(p[0], p[1]); w.y = pk2(p[2], p[3]); w.z = pk2(p[4], p[5]); w.w = pk2(p[6], p[7]);
        pf[kk] = __builtin_bit_cast(bf16x8, w);
    }
    l += __shfl_xor(l, 16); l += __shfl_xor(l, 32);
    inv = __builtin_amdgcn_rcpf(l);
}
__device__ __forceinline__ void na_pv(int lane, const bf16x8 (&pf)[8], float inv, bf16* O, int ldo, const LAS unsigned char* Vl, int arow0, int kb0) {
    const int qi = lane & 15, g = lane >> 4;
    const LAS unsigned char* vbase = Vl + qi * 1200 + (arow0 * 40 + kb0 + 8 * g) * 2;
#define A16_VFR(mt, kk) (*(const LAS bf16x8*)(vbase + (mt) * 19200 + (kk) * 80))
    bf16x8 vb[2][8];
#pragma unroll
    for (int kk = 0; kk < 8; ++kk) vb[0][kk] = A16_VFR(0, kk);
#pragma unroll
    for (int mt = 0; mt < 4; ++mt) {
        if (mt < 3) {
#pragma unroll
            for (int kk = 0; kk < 8; ++kk) vb[(mt + 1) & 1][kk] = A16_VFR(mt + 1, kk);
        }
        __builtin_amdgcn_sched_barrier(0);
        f32x4 a0 = {0.f, 0.f, 0.f, 0.f}, a1 = {0.f, 0.f, 0.f, 0.f};
#pragma unroll
        for (int kk = 0; kk < 8; kk += 2) { a0 = __builtin_amdgcn_mfma_f32_16x16x32_bf16(vb[mt & 1][kk], pf[kk], a0, 0, 0, 0); a1 = __builtin_amdgcn_mfma_f32_16x16x32_bf16(vb[mt & 1][kk + 1], pf[kk + 1], a1, 0, 0, 0); }
        v2u w; w.x = pk2((a0[0] + a1[0]) * inv, (a0[1] + a1[1]) * inv); w.y = pk2((a0[2] + a1[2]) * inv, (a0[3] + a1[3]) * inv);
        *(v2u*)(O + (size_t)qi * ldo + 16 * mt + 4 * g) = w;
        __builtin_amdgcn_sched_barrier(0);
    }
#undef A16_VFR
}
__device__ __forceinline__ void memkv_item(int it, int lane, const bf16* membf, const bf16* wt, const float* mrstd, bf16* memk, bf16* memvt) {
    const int rt = it >> 4, ctile = it & 15, qi = lane & 15, g = lane >> 4, row0 = rt * 16, col0 = ctile * 32;
    const bf16* ap = membf + (size_t)(row0 + qi) * DM + 8 * g; const bf16* bp = wt + (size_t)(col0 + qi) * DM + 8 * g;
    f32x4 acc0 = {0.f, 0.f, 0.f, 0.f}, acc1 = {0.f, 0.f, 0.f, 0.f};
    const bool isk = col0 < 256;
    if (isk) {
#pragma unroll 1
        for (int k8 = 0; k8 < 32; k8 += 8) { bf16x8 a[8], b0[8], b1[8];
#pragma unroll
            for (int j = 0; j < 8; ++j) { a[j] = *(const bf16x8*)(ap + 32 * (k8 + j)); b0[j] = *(const bf16x8*)(bp + 32 * (k8 + j)); b1[j] = *(const bf16x8*)(bp + 16 * DM + 32 * (k8 + j)); }
#pragma unroll
            for (int j = 0; j < 8; ++j) { acc0 = __builtin_amdgcn_mfma_f32_16x16x32_bf16(b0[j], a[j], acc0, 0, 0, 0); acc1 = __builtin_amdgcn_mfma_f32_16x16x32_bf16(b1[j], a[j], acc1, 0, 0, 0); } }
    } else {
#pragma unroll 1
        for (int k8 = 0; k8 < 32; k8 += 8) { bf16x8 a[8], b0[8], b1[8];
#pragma unroll
            for (int j = 0; j < 8; ++j) { a[j] = *(const bf16x8*)(ap + 32 * (k8 + j)); b0[j] = *(const bf16x8*)(bp + 32 * (k8 + j)); b1[j] = *(const bf16x8*)(bp + 16 * DM + 32 * (k8 + j)); }
#pragma unroll
            for (int j = 0; j < 8; ++j) { acc0 = __builtin_amdgcn_mfma_f32_16x16x32_bf16(a[j], b0[j], acc0, 0, 0, 0); acc1 = __builtin_amdgcn_mfma_f32_16x16x32_bf16(a[j], b1[j], acc1, 0, 0, 0); } }
    }
    if (isk) {
        const float s = mrstd[row0 + qi]; bf16* p = memk + (size_t)(row0 + qi) * 256 + col0 + 4 * g;
        v2u w; w.x = pk2(acc0[0] * s, acc0[1] * s); w.y = pk2(acc0[2] * s, acc0[3] * s); *(v2u*)p = w;
        w.x = pk2(acc1[0] * s, acc1[1] * s); w.y = pk2(acc1[2] * s, acc1[3] * s); *(v2u*)(p + 16) = w;
    } else {
        const f32x4 s = *(const f32x4*)(mrstd + row0 + 4 * g); bf16* p = memvt + (size_t)(col0 - 256 + qi) * MEM_ROWS + row0 + 4 * g;
        v2u w; w.x = pk2(acc0[0] * s[0], acc0[1] * s[1]); w.y = pk2(acc0[2] * s[2], acc0[3] * s[3]); *(v2u*)p = w;
        w.x = pk2(acc1[0] * s[0], acc1[1] * s[1]); w.y = pk2(acc1[2] * s[2], acc1[3] * s[3]); *(v2u*)(p + (size_t)16 * MEM_ROWS) = w;
    }
}
__device__ __forceinline__ void memattn_strip(const Frame& F, int item, const bf16* act, int ld, int qoff, const bf16* memk, const bf16* memvt, bf16* mix, bool load = true) {
    const int tg = item & 15, h = (item >> 4) & 3, b = item >> 6, lane = LANE(), wave = F.wave;
    LAS unsigned char* Kl = F.lds; LAS unsigned char* Vl = F.lds + 32768;
    if (load) {
#pragma unroll
    for (int j = 0; j < 4; ++j) {
        const int p = (wave * 4 + j) * 64 + lane, key = p >> 3, kpos = p & 7, kc = key & 31, swz = (((kc >> 3) & 3) << 1) | ((kc >> 1) & 1);
        __builtin_amdgcn_global_load_lds((const unsigned*)(memk + (size_t)(b * 256 + key) * 256 + h * 64 + ((kpos ^ swz) << 3)), (LAS unsigned*)(Kl + (wave * 4 + j) * 1024), 16, 0, 0);
        const int d = p >> 5, vpos = p & 31;
        __builtin_amdgcn_global_load_lds((const unsigned*)(memvt + (size_t)(h * 64 + d) * MEM_ROWS + b * 256 + ((vpos ^ (d & 15)) << 3)), (LAS unsigned*)(Vl + (wave * 4 + j) * 1024), 16, 0, 0);
    }
    asm volatile("s_waitcnt vmcnt(0)\n\ts_barrier" ::: "memory");
    }
#pragma unroll 1
    for (int u = 0; u < 2; ++u) {
        const int tok0 = b * SEQ + tg * 256 + (wave * 2 + u) * 16;
        attn16_lds<false, 1, 32>(lane, act + (size_t)tok0 * ld + qoff + h * 64, ld, mix + (size_t)tok0 * DM + 768 + h * 64, DM, nullptr, 0, 0, 0, 0, Kl, 0, Vl, 0);
    }
    asm volatile("s_waitcnt lgkmcnt(0)\n\ts_barrier" ::: "memory");
}
__device__ __forceinline__ void memattn_item(int it, int lane, const bf16* act, int ld, int qoff, const bf16* memk, const bf16* memvt, bf16* mix) {
    const int tb = it >> 2, h = it & 3, tok0 = tb * 16, b = tok0 >> 12;
    attn16<false>(lane, act + (size_t)tok0 * ld + qoff + h * 64, ld, memk + h * 64, 256, memvt + (size_t)(h * 64) * MEM_ROWS, MEM_ROWS, b * 256, 32,
                  mix + (size_t)tok0 * DM + 768 + h * 64, DM, nullptr, 0, 0, 0, 0);
}
constexpr int NA_RPB_OFF = 122880;
__device__ __forceinline__ void na_strip(const Frame& F, int item, const bf16* act0, const bf16* v0t, bf16* mix) {
    const int s8 = item & 7, h = (item >> 3) % 12, b = (item >> 3) / 12, lane = LANE(), wave = F.wave;
    const int R0 = 8 * s8, rowbase = min(max(R0 - 4, 0), 56), rowend = min(max(R0 + 7 - 4, 0), 56) + 8, nrows = rowend - rowbase;
    LAS unsigned char* Kl = F.lds;
    {
        const int col = wave * 8 + (lane >> 3), pos = lane & 7, swz = (((col >> 3) & 3) << 1) | ((col >> 1) & 1);
        const bf16* src = act0 + (size_t)(b * SEQ + rowbase * 64 + col) * A0_LD + 768 + h * 64 + ((pos ^ swz) << 3);
        for (int j = 0; j < nrows; ++j)
            __builtin_amdgcn_global_load_lds((const unsigned*)(src + (size_t)j * 64 * A0_LD), (LAS unsigned*)(Kl + j * 8192 + wave * 1024), 16, 0, 0);
    }
    asm volatile("s_waitcnt vmcnt(0)\n\ts_barrier" ::: "memory");
    const int r = R0 + wave, r0 = min(max(r - 4, 0), 56);
    const LAS float* rpb = (const LAS float*)(F.lds + NA_RPB_OFF) + h * 465;
#pragma unroll 1
    for (int jb = 0; jb < 4; ++jb) {
        const int band0 = min(max(jb * 16 - 8, 0), 32), tok0 = b * SEQ + r * 64 + jb * 16;
        attn16<true, true>(lane, act0 + (size_t)tok0 * A0_LD + h * 64, A0_LD, nullptr, 0, v0t + (size_t)(h * 64) * NT, NT, b * SEQ + r0 * 64 + band0, 64,
                           mix + (size_t)tok0 * DM + h * 64, DM, rpb, r, r0, jb, band0, Kl, r0 - rowbase, nullptr, band0);
    }
    asm volatile("s_waitcnt lgkmcnt(0)\n\ts_barrier" ::: "memory");
}
constexpr int NAH_V = 76800, NAH_RPB = 153600;
__device__ __forceinline__ void na_hstrip(const Frame& F, int item, const bf16* act0, const bf16* v0t, const float* rpb_g, bf16* mix) {
    const int half = item & 1, s8 = (item >> 1) & 7, h = (item >> 4) % 12, b = (item >> 4) / 12, lane = LANE(), wave = F.wave;
    const int R0 = 8 * s8, rowbase = min(max(R0 - 4, 0), 56), rowend = min(max(R0 + 7 - 4, 0), 56) + 8, nrows = rowend - rowbase, cb0 = half ? 24 : 0;
    LAS unsigned char* Kl = F.lds; LAS unsigned char* Vl = F.lds + NAH_V; LAS float* rl = (LAS float*)(F.lds + NAH_RPB);
    {
        const int pos = lane & 7, nk = nrows * 5 - 1;
#pragma unroll
        for (int i = 0; i < 10; ++i) { const int k = min(wave + NWAVES * i, 74), idx = min(k, nk);
            { const int j = idx / 5, q = idx - 5 * j, lc = q * 8 + (lane >> 3), swz = (((lc >> 3) & 3) << 1) | ((lc >> 1) & 1);
              __builtin_amdgcn_global_load_lds((const unsigned*)(act0 + (size_t)(b * SEQ + (rowbase + j) * 64 + cb0 + lc) * A0_LD + 768 + h * 64 + ((pos ^ swz) << 3)), (LAS unsigned*)(Kl + idx * 1024), 16, 0, 0); }
            { const int G = k * 64 + lane, d = G / 75, rem = G - 75 * d, j0 = rem / 5, gc = rem - 5 * j0, j = min(j0, nrows - 1);
              __builtin_amdgcn_global_load_lds((const unsigned*)(v0t + (size_t)(h * 64 + d) * NT + b * SEQ + (rowbase + j) * 64 + cb0 + gc * 8), (LAS unsigned*)(Vl + k * 1024), 16, 0, 0); } }
    }
    float bias = 0.f; if (TID() < 465) bias = rpb_g[h * 465 + TID()];
    asm volatile("" : "+v"(bias));
    bias *= 1.4426950408889634f;
    if (TID() < 465) rl[TID()] = bias;
    asm volatile("s_waitcnt vmcnt(0) lgkmcnt(0)\n\ts_barrier" ::: "memory");
    const int r = R0 + wave, r0 = min(max(r - 4, 0), 56);
#pragma unroll 1
    for (int u = 0; u < 2; ++u) {
        const int jb = 2 * half + u, band0 = min(max(jb * 16 - 8, 0), 32), tok0 = b * SEQ + r * 64 + jb * 16;
        attn16_lds<true, 2, 40>(lane, act0 + (size_t)tok0 * A0_LD + h * 64, A0_LD, mix + (size_t)tok0 * DM + h * 64, DM, rl, r, r0, jb, band0, Kl, r0 - rowbase, Vl, band0 - cb0);
    }
    asm volatile("s_waitcnt lgkmcnt(0)\n\ts_barrier" ::: "memory");
}
struct NaItem { int half, h, b, R0, rowbase, nrows, cb0; };
__device__ __forceinline__ NaItem na_decode(int item) { NaItem t; t.half = item & 1; const int s8 = (item >> 1) & 7; t.h = (item >> 4) % 12; t.b = (item >> 4) / 12; t.R0 = 8 * s8;
    t.rowbase = min(max(t.R0 - 4, 0), 56); t.nrows = min(max(t.R0 + 7 - 4, 0), 56) + 8 - t.rowbase; t.cb0 = t.half ? 24 : 0; return t; }
__device__ __forceinline__ void na_issue_k(const NaItem& t, int wave, const bf16* act0, LAS unsigned char* Kl) {
    const int lane = lane_id(), pos = lane & 7, nk = t.nrows * 5 - 1;
#pragma unroll
    for (int i = 0; i < 10; ++i) { const int idx = min(wave + NWAVES * i, nk), j = idx / 5, q = idx - 5 * j, lc = q * 8 + (lane >> 3), swz = (((lc >> 3) & 3) << 1) | ((lc >> 1) & 1);
        __builtin_amdgcn_global_load_lds((const unsigned*)(act0 + (size_t)(t.b * SEQ + (t.rowbase + j) * 64 + t.cb0 + lc) * A0_LD + 768 + t.h * 64 + ((pos ^ swz) << 3)), (LAS unsigned*)(Kl + idx * 1024), 16, 0, 0); }
}
__device__ __forceinline__ void na_issue_v(const NaItem& t, int wave, const bf16* v0t, LAS unsigned char* Vl) {
    const int lane = lane_id();
#pragma unroll
    for (int i = 0; i < 10; ++i) { const int k = min(wave + NWAVES * i, 74), G = k * 64 + lane, d = G / 75, rem = G - 75 * d, j0 = rem / 5, gc = rem - 5 * j0, j = min(j0, t.nrows - 1);
        __builtin_amdgcn_global_load_lds((const unsigned*)(v0t + (size_t)(t.h * 64 + d) * NT + t.b * SEQ + (t.rowbase + j) * 64 + t.cb0 + gc * 8), (LAS unsigned*)(Vl + k * 1024), 16, 0, 0); }
}
__device__ __forceinline__ void na_phase(const Frame& F, const bf16* act0, const bf16* v0t, const float* rpb2, bf16* mix) {
    const int wave = F.wave;
    LAS unsigned char* Kl = F.lds; LAS unsigned char* Vl = F.lds + NAH_V; LAS float* rl = (LAS float*)(F.lds + NAH_RPB);
    const int item0 = (F.bid & 7) * 192 + (F.bid >> 3);
    { const NaItem t0 = na_decode(item0); na_issue_k(t0, wave, act0, Kl); }
#pragma unroll 1
    for (int i = 0; i < 6; ++i) {
        const NaItem t = na_decode(item0 + 32 * i);
        const int lane = lane_id(), qi = lane & 15, g = lane >> 4;
        const int r = t.R0 + wave, r0 = min(max(r - 4, 0), 56), arow0 = r0 - t.rowbase;
        const int tokA = t.b * SEQ + r * 64 + (2 * t.half) * 16, tokB = tokA + 16;
        v4u q0, q1;
        const bf16* qa = act0 + (size_t)(tokA + qi) * A0_LD + t.h * 64 + 8 * g;
        asm volatile("global_load_dwordx4 %0, %1, off" : "=v"(q0) : "v"(qa)); asm volatile("global_load_dwordx4 %0, %1, off offset:64" : "=v"(q1) : "v"(qa));
        if (wave < 2) __builtin_amdgcn_global_load_lds((const unsigned*)(rpb2 + t.h * 480 + 4 * min(wave * 64 + lane, 119)), (LAS unsigned*)((LAS unsigned char*)rl + wave * 1024), 16, 0, 0);
        na_issue_v(t, wave, v0t, Vl);
        asm volatile("s_waitcnt vmcnt(10)\n\ts_barrier" : "+v"(q0), "+v"(q1) :: "memory");
        bf16x8 pf[8]; float inv;
        { const bf16x8 qf[2] = {__builtin_bit_cast(bf16x8, q0), __builtin_bit_cast(bf16x8, q1)}; const int jb = 2 * t.half, band0 = min(max(jb * 16 - 8, 0), 32);
          na_qk_sm<40>(lane, qf, rl, r, r0, jb, band0, Kl, arow0, band0 - t.cb0, pf, inv); }
        asm volatile("s_waitcnt vmcnt(0)\n\ts_barrier" ::: "memory");
        { const bf16* qb = qa + (size_t)16 * A0_LD;
          asm volatile("global_load_dwordx4 %0, %1, off" : "=v"(q0) : "v"(qb)); asm volatile("global_load_dwordx4 %0, %1, off offset:64" : "=v"(q1) : "v"(qb)); }
        { const int band0 = min(max((2 * t.half) * 16 - 8, 0), 32); na_pv(lane, pf, inv, mix + (size_t)tokA * DM + t.h * 64, DM, Vl, arow0, band0 - t.cb0); }
        asm volatile("s_waitcnt vmcnt(4)" : "+v"(q0), "+v"(q1) :: "memory");
        { const bf16x8 qf[2] = {__builtin_bit_cast(bf16x8, q0), __builtin_bit_cast(bf16x8, q1)}; const int jb = 2 * t.half + 1, band0 = min(max(jb * 16 - 8, 0), 32);
          na_qk_sm<40>(lane, qf, rl, r, r0, jb, band0, Kl, arow0, band0 - t.cb0, pf, inv); }
        asm volatile("s_waitcnt lgkmcnt(0)\n\ts_barrier" ::: "memory");
        if (i + 1 < 6) { const NaItem tn = na_decode(item0 + 32 * (i + 1)); na_issue_k(tn, wave, act0, Kl); }
        { const int band0 = min(max((2 * t.half + 1) * 16 - 8, 0), 32); na_pv(lane, pf, inv, mix + (size_t)tokB * DM + t.h * 64, DM, Vl, arow0, band0 - t.cb0); }
        asm volatile("s_waitcnt lgkmcnt(0)\n\ts_barrier" ::: "memory");
    }
}
__device__ __forceinline__ void na_item(int it, int lane, const bf16* act0, const bf16* v0t, const LAS float* rpb, bf16* mix) {
    const int jb = it & 3, h = (it >> 2) % 12, br = (it >> 2) / 12, r = br & 63, b = br >> 6;
    const int r0 = min(max(r - 4, 0), 56), band0 = min(max(jb * 16 - 8, 0), 32);
    const int tok0 = b * SEQ + r * 64 + jb * 16;
    attn16<true>(lane, act0 + (size_t)tok0 * A0_LD + h * 64, A0_LD, act0 + 768 + h * 64, A0_LD, v0t + (size_t)(h * 64) * NT, NT, b * SEQ + r0 * 64 + band0, 64,
                 mix + (size_t)tok0 * DM + h * 64, DM, rpb + h * 465, r, r0, jb, band0);
}

constexpr int GP_LD = 392;
__device__ __forceinline__ void gla_pre_w(int wave, int lane, const float* W, const float* Bi, bf16x8 (&wfr)[3], float (&bias)[3]) {
    const int qi = lane & 15, g = lane >> 4;
#pragma unroll
    for (int jj = 0; jj < 3; ++jj) {
        const int j = 16 * (wave + 8 * jj) + qi;
        v4u wu = {0u, 0u, 0u, 0u};
        if (g < 2) { const float* wp = W + (size_t)(8 * g) * 384 + j;
            wu.x = pk2(wp[0], wp[384]); wu.y = pk2(wp[768], wp[1152]); wu.z = pk2(wp[1536], wp[1920]); wu.w = pk2(wp[2304], wp[2688]); }
        wfr[jj] = __builtin_bit_cast(bf16x8, wu); bias[jj] = Bi[j];
    }
}
__device__ __forceinline__ void gla_pre_item(const Frame& F, int item, const bf16* act1, const bf16x8 (&wfr)[3], const float (&bias)[3], bf16* QT, bf16* KT, float* DEC) {
    const int n = item & 63, dir = (item >> 6) & 1, b = item >> 7, base = b * SEQ + n * 64;
    const int tid = TID(), lane = LANE(), wave = F.wave, qi = lane & 15, g = lane >> 4;
    LAS bf16* EL = (LAS bf16*)F.lds;
    bf16x8 zf[4];
#pragma unroll
    for (int ct = 0; ct < 4; ++ct) { const int c = 16 * ct + qi, tok = dir ? base + 63 - c : base + c;
        bf16x8 z = {0, 0, 0, 0, 0, 0, 0, 0}; if (g < 2) z = *(const bf16x8*)(act1 + (size_t)tok * A1_LD + 1792 + dir * 16 + 8 * g); zf[ct] = z; }
    v4u q8a[6], k8a[6];
#pragma unroll
    for (int k = 0; k < 6; ++k) { const int idx = tid + 512 * k, c = idx / 48, jg = idx % 48; const bf16* arow = act1 + (size_t)(base + c) * A1_LD + 8 * jg; q8a[k] = *(const v4u*)arow; k8a[k] = *(const v4u*)(arow + 384); }
#pragma unroll
    for (int jj = 0; jj < 3; ++jj) {
        const int j = 16 * (wave + 8 * jj) + qi;
        float p[4][4], a[4], t1[4], t2[4], tot[4];
#pragma unroll
        for (int ct = 0; ct < 4; ++ct) {
            f32x4 d = {0.f, 0.f, 0.f, 0.f};
            d = __builtin_amdgcn_mfma_f32_16x16x32_bf16(zf[ct], wfr[jj], d, 0, 0, 0);
#pragma unroll
            for (int i = 0; i < 4; ++i) { const float x = d[i] + bias[jj];
                p[ct][i] = (fminf(x, 0.f) * 1.4426950408889634f - __builtin_amdgcn_logf(1.0f + __builtin_amdgcn_exp2f(fabsf(x) * -1.4426950408889634f))) * 0.0625f; }
            p[ct][1] += p[ct][0]; p[ct][2] += p[ct][1]; p[ct][3] += p[ct][2]; a[ct] = p[ct][3];
        }
#pragma unroll
        for (int ct = 0; ct < 4; ++ct) t1[ct] = __shfl_up(a[ct], 16);
#pragma unroll
        for (int ct = 0; ct < 4; ++ct) if (g >= 1) a[ct] += t1[ct];
#pragma unroll
        for (int ct = 0; ct < 4; ++ct) t2[ct] = __shfl_up(a[ct], 32);
#pragma unroll
        for (int ct = 0; ct < 4; ++ct) if (g >= 2) a[ct] += t2[ct];
#pragma unroll
        for (int ct = 0; ct < 4; ++ct) tot[ct] = __shfl(a[ct], 48 + qi);
        float carry = 0.f;
#pragma unroll
        for (int ct = 0; ct < 4; ++ct) {
            const float excl = a[ct] - p[ct][3] + carry;
            carry += tot[ct];
#pragma unroll
            for (int i = 0; i < 4; ++i) { const int c = 16 * ct + 4 * g + i, ctok = dir ? 63 - c : c; EL[ctok * GP_LD + j] = (bf16)f2bf(__builtin_amdgcn_exp2f(excl + p[ct][i])); }
        }
    }
    __syncthreads();
    const int clast = dir ? 0 : 63;
#pragma unroll
    for (int k = 0; k < 6; ++k) {
        const int idx = tid + 512 * k, c = idx / 48, jg = idx % 48;
        const v4u q8 = q8a[k], k8 = k8a[k];
        const v4u e8 = *(const LAS v4u*)(EL + c * GP_LD + 8 * jg), l8 = *(const LAS v4u*)(EL + clast * GP_LD + 8 * jg);
        const unsigned qa[4] = {q8.x, q8.y, q8.z, q8.w}, ka[4] = {k8.x, k8.y, k8.z, k8.w}, ea[4] = {e8.x, e8.y, e8.z, e8.w}, la[4] = {l8.x, l8.y, l8.z, l8.w};
        unsigned qo[4], ko[4];
        float lf[8];
#pragma unroll
        for (int i = 0; i < 4; ++i) {
            const float e0 = bflo(ea[i]), e1 = bfhi(ea[i]), i0 = __builtin_amdgcn_rcpf(e0), i1 = __builtin_amdgcn_rcpf(e1);
            const float kt0 = bflo(ka[i]) * i0, kt1 = bfhi(ka[i]) * i1; lf[2 * i] = bflo(la[i]); lf[2 * i + 1] = bfhi(la[i]);
            qo[i] = pk2(bflo(qa[i]) * 0.10206207261596575f * e0, bfhi(qa[i]) * 0.10206207261596575f * e1);
            ko[i] = pk2(kt0, kt1);
        }
        v4u w; w.x = qo[0]; w.y = qo[1]; w.z = qo[2]; w.w = qo[3]; *(v4u*)(QT + (size_t)(base + c) * 384 + 8 * jg) = w;
        w.x = ko[0]; w.y = ko[1]; w.z = ko[2]; w.w = ko[3]; *(v4u*)(KT + (size_t)(base + c) * 384 + 8 * jg) = w;
        if (c == clast) { float* dp = DEC + (size_t)((b * 4 + jg / 12) * 64 + n) * 96 + (jg % 12) * 8;
            *(f32x4*)dp = (f32x4){lf[0], lf[1], lf[2], lf[3]}; *(f32x4*)(dp + 4) = (f32x4){lf[4], lf[5], lf[6], lf[7]}; }
    }
    __syncthreads();
}
constexpr int GL_QT = 0, GL_KT = 13312, GL_VT = 26624, GL_DEC = 33792, GL_BUF = 34816;
__device__ __forceinline__ void gla_main_item(const Frame& F, int item, const bf16* QTa, const bf16* KTa, const float* DECa, const bf16* v1t, bf16* OFp, bf16* OBp,
                                              const float* cwg, const float* cwu, const float* cgain, unsigned char* c8) {
    const int vs = item & 3, dir = (item >> 2) & 1, h = (item >> 3) & 3, b = item >> 5;
    const int lane = LANE(), wave = F.wave, qi = lane & 15, g = lane >> 4;
    bf16* O = dir ? OBp : OFp;
    LAS unsigned char* L = F.lds;
    constexpr int GL_SB = 3 * GL_BUF;
    for (int i = TID(); i < 18 * 512 / 8; i += NTHR) *(LAS v2u*)(L + GL_SB + i * 8) = (v2u){0u, 0u};
    const char* qtb = (const char*)(QTa + (size_t)dir * NT * 384 + h * 96); const char* ktb = (const char*)(KTa + (size_t)dir * NT * 384 + h * 96);
    const char* deb = (const char*)(DECa + (size_t)dir * 8 * 4 * 64 * 96 + (size_t)((b * 4 + h) * 64) * 96);
    const char* vtb = (const char*)(v1t + (size_t)(h * 192 + vs * 48) * NT);
#define GL_OFF(k_) ((k_) < 26 ? (unsigned)((((k_) < 13 ? (k_) : (k_) - 13) * 64 + lane) / 13 * 768 + ((((k_) < 13 ? (k_) : (k_) - 13) * 64 + lane) % 13 < 12 ? ((((k_) < 13 ? (k_) : (k_) - 13) * 64 + lane) % 13) * 16 : 0)) \
                   : ((k_) < 33 ? ((((k_) - 26) * 64 + lane) < 432 ? (unsigned)((((k_) - 26) * 64 + lane) / 9 * NT * 2 + ((((k_) - 26) * 64 + lane) % 9 < 8 ? ((((k_) - 26) * 64 + lane) % 9) * 16 : 0)) : 0u) : ((lane < 24) ? (unsigned)(lane * 16) : 0u)))
#define GL_PIECE(k_, offv_, n_, bufo_) do { const int nn_ = dir ? 63 - (n_) : (n_); const size_t tb_ = (size_t)(b * SEQ + nn_ * 64); \
            const char* src_ = (k_) < 13 ? qtb + tb_ * 768 : ((k_) < 26 ? ktb + tb_ * 768 : ((k_) < 33 ? vtb + tb_ * 2 : deb + (size_t)nn_ * 384)); \
            __builtin_amdgcn_global_load_lds((const unsigned*)(src_ + (offv_)), (LAS unsigned*)(L + (bufo_) + (k_) * 1024), 16, 0, 0); } while (0)
    if (wave < 4) {
        const int ct = wave;
        unsigned kmw[2][4];
#pragma unroll
        for (int kk = 0; kk < 2; ++kk)
#pragma unroll
            for (int w2 = 0; w2 < 4; ++w2) { const int tp = 2 * kk + (w2 >> 1), i0 = 2 * (w2 & 1), c = 16 * ct + qi, cp = 16 * tp + 4 * g + i0;
                const bool k0 = dir ? (cp > c) : (cp <= c), k1 = dir ? (cp + 1 > c) : (cp + 1 <= c); kmw[kk][w2] = (k0 ? 0x0000ffffu : 0u) | (k1 ? 0xffff0000u : 0u); }
        unsigned offo[5];
#pragma unroll
        for (int jj = 0; jj < 5; ++jj) { const int k = wave + 4 * jj; offo[jj] = GL_OFF(k); }
#define GL_DMA_O(n_, bufo_) do { _Pragma("unroll") for (int jj_ = 0; jj_ < 5; ++jj_) { const int k_ = wave + 4 * jj_; GL_PIECE(k_, offo[jj_], n_, bufo_); } } while (0)
        GL_DMA_O(0, 0); GL_DMA_O(1, GL_BUF);
        asm volatile("s_waitcnt vmcnt(0) lgkmcnt(0)\n\ts_barrier" ::: "memory");
        int bo = 0, bo2 = 2 * GL_BUF;
#pragma unroll 1
        for (int n = 0; n < 64; ++n) {
            const LAS unsigned char* Bf = L + bo; const LAS unsigned char* SBr = L + GL_SB + (n & 1) * 9216;
            asm volatile("s_waitcnt vmcnt(0)" ::: "memory");
            { const int n2 = n + 2 < 64 ? n + 2 : 63; GL_DMA_O(n2, bo2); }
            bf16x8 qf[3], kf[4][3], qp[3], vf[3][2], sf[3][3];
#pragma unroll
            for (int ks = 0; ks < 3; ++ks) qf[ks] = *(const LAS bf16x8*)(Bf + GL_QT + (16 * ct + qi) * 208 + (32 * ks + 8 * g) * 2);
#pragma unroll
            for (int tp = 0; tp < 4; ++tp)
#pragma unroll
                for (int ks = 0; ks < 3; ++ks) kf[tp][ks] = *(const LAS bf16x8*)(Bf + GL_KT + (16 * tp + qi) * 208 + (32 * ks + 8 * g) * 2);
#pragma unroll
            for (int kk = 0; kk < 3; ++kk) { const LAS unsigned char* qr = Bf + GL_QT + (16 * ct + qi) * 208 + (32 * kk + 4 * g) * 2;
                const s16x4 a0 = *(const LAS s16x4*)qr, a1 = *(const LAS s16x4*)(qr + 32); qp[kk] = __builtin_shufflevector(a0, a1, 0, 1, 2, 3, 4, 5, 6, 7); }
#pragma unroll
            for (int vt = 0; vt < 3; ++vt) {
#pragma unroll
                for (int kk = 0; kk < 2; ++kk) { const LAS unsigned char* vr = Bf + GL_VT + (16 * vt + qi) * 144 + (32 * kk + 4 * g) * 2;
                    const s16x4 a0 = *(const LAS s16x4*)vr, a1 = *(const LAS s16x4*)(vr + 32); vf[vt][kk] = __builtin_shufflevector(a0, a1, 0, 1, 2, 3, 4, 5, 6, 7); }
#pragma unroll
                for (int kk = 0; kk < 3; ++kk) { const LAS unsigned char* sr = SBr + (vt * 6 + 2 * kk) * 512 + lane * 8;
                    const s16x4 a0 = *(const LAS s16x4*)sr, a1 = *(const LAS s16x4*)(sr + 512); sf[vt][kk] = __builtin_shufflevector(a0, a1, 0, 1, 2, 3, 4, 5, 6, 7); } }
            __builtin_amdgcn_sched_barrier(0);
            f32x4 am[4];
#pragma unroll
            for (int tp = 0; tp < 4; ++tp) {
                f32x4 z = {0.f, 0.f, 0.f, 0.f};
#pragma unroll
                for (int ks = 0; ks < 3; ++ks) z = __builtin_amdgcn_mfma_f32_16x16x32_bf16(kf[tp][ks], qf[ks], z, 0, 0, 0);
                am[tp] = z;
            }
            bf16x8 pf[2];
#pragma unroll
            for (int kk = 0; kk < 2; ++kk) { v4u w; w.x = pk2(am[2 * kk][0], am[2 * kk][1]) & kmw[kk][0]; w.y = pk2(am[2 * kk][2], am[2 * kk][3]) & kmw[kk][1]; w.z = pk2(am[2 * kk + 1][0], am[2 * kk + 1][1]) & kmw[kk][2]; w.w = pk2(am[2 * kk + 1][2], am[2 * kk + 1][3]) & kmw[kk][3];
                pf[kk] = __builtin_bit_cast(bf16x8, w); }
            const int nn = dir ? 63 - n : n, tok = b * SEQ + nn * 64 + 16 * ct + qi;
            f32x4 oacc[3];
#pragma unroll
            for (int vt = 0; vt < 3; ++vt) {
                f32x4 acc = {0.f, 0.f, 0.f, 0.f};
#pragma unroll
                for (int kk = 0; kk < 3; ++kk) acc = __builtin_amdgcn_mfma_f32_16x16x32_bf16(sf[vt][kk], qp[kk], acc, 0, 0, 0);
                oacc[vt] = acc;
            }
#pragma unroll
            for (int vt = 0; vt < 3; ++vt) {
#pragma unroll
                for (int kk = 0; kk < 2; ++kk) oacc[vt] = __builtin_amdgcn_mfma_f32_16x16x32_bf16(vf[vt][kk], pf[kk], oacc[vt], 0, 0, 0);
            }
#pragma unroll
            for (int vt = 0; vt < 3; ++vt) { v2u w; w.x = pk2(oacc[vt][0], oacc[vt][1]); w.y = pk2(oacc[vt][2], oacc[vt][3]);
                *(v2u*)(O + (size_t)tok * 768 + h * 192 + vs * 48 + 16 * vt + 4 * g) = w; }
            asm volatile("s_waitcnt lgkmcnt(0)\n\ts_barrier" ::: "memory");
            { const int t_ = bo; bo = (bo == 2 * GL_BUF) ? 0 : bo + GL_BUF; bo2 = t_; }
        }
#undef GL_DMA_O
    } else {
        const int w4 = wave - 4;
        unsigned off[4];
#pragma unroll
        for (int jj = 0; jj < 4; ++jj) { const int k = 20 + w4 + 4 * jj; off[jj] = GL_OFF(k); }
#define GL_DMA(n_, bufo_) do { _Pragma("unroll") for (int jj_ = 0; jj_ < 4; ++jj_) { const int k_ = 20 + w4 + 4 * jj_; if (k_ < 34) GL_PIECE(k_, off[jj_], n_, bufo_); } } while (0)
        int oT[5]; bool oV[5];
#pragma unroll
        for (int j = 0; j < 5; ++j) { oV[j] = (j < 4) || (w4 < 2); oT[j] = oV[j] ? w4 + 4 * j : w4 + 12; }
        const unsigned vmsk = 0u - (unsigned)(w4 >> 1);
        f32x4 So[5];
#pragma unroll
        for (int j = 0; j < 5; ++j) So[j] = (f32x4){0.f, 0.f, 0.f, 0.f};
        f32x4 cv[8], cg[2];
#pragma unroll
        for (int j = 0; j < 8; ++j) cv[j] = (f32x4){0.f, 0.f, 0.f, 0.f};
        cg[0] = cv[0]; cg[1] = cv[0];
        LAS unsigned* CT = (LAS unsigned*)(L + GL_SB + 18432 + w4 * 2304);
        const int gw2 = F.bid * 4 + w4;
        GL_DMA(0, 0); GL_DMA(1, GL_BUF);
        asm volatile("s_waitcnt vmcnt(0) lgkmcnt(0)\n\ts_barrier" ::: "memory");
        int bo = 0, bo2 = 2 * GL_BUF;
#pragma unroll 1
        for (int n = 0; n < 64; ++n) {
            const LAS unsigned char* Bf = L + bo; LAS unsigned char* SBw = L + GL_SB + ((n + 1) & 1) * 9216;
            asm volatile("s_waitcnt vmcnt(0)" ::: "memory");
            f32x4 dec[5]; bf16x8 kdf[5][2], vfr[3][2];
#pragma unroll
            for (int vt = 0; vt < 3; ++vt)
#pragma unroll
                for (int kk = 0; kk < 2; ++kk) { const LAS unsigned char* vr = Bf + GL_VT + (16 * vt + qi) * 144 + (32 * kk + 4 * g) * 2;
                    const s16x4 a0 = *(const LAS s16x4*)vr, a1 = *(const LAS s16x4*)(vr + 32); vfr[vt][kk] = __builtin_shufflevector(a0, a1, 0, 1, 2, 3, 4, 5, 6, 7); }
#pragma unroll
            for (int j = 0; j < 5; ++j) { const int T = oT[j], vt = T / 6, dt = T - 6 * vt;
                dec[j] = *(const LAS f32x4*)(Bf + GL_DEC + (16 * dt + 4 * g) * 4);
#pragma unroll
                for (int ks = 0; ks < 2; ++ks) {
                    const LAS unsigned char* kr = Bf + GL_KT + (32 * ks + 4 * g + (qi >> 2)) * 208 + (16 * dt + 4 * (qi & 3)) * 2;
                    const s16x4 a0 = __builtin_amdgcn_ds_read_tr16_b64_v4i16((LAS s16x4*)kr), a1 = __builtin_amdgcn_ds_read_tr16_b64_v4i16((LAS s16x4*)(kr + 16 * 208));
                    kdf[j][ks] = __builtin_shufflevector(a0, a1, 0, 1, 2, 3, 4, 5, 6, 7); } }
            __builtin_amdgcn_sched_barrier(0);
            if ((n & 1) && (n < 57)) {
                const int id = gw2 + 1024 * (n >> 1), e = id / 3584, r2 = id - e * 3584, wh = r2 / 1792, it2 = r2 - wh * 1792, kb = it2 / 112, nb = it2 - kb * 112, n0 = nb * 32;
                unsigned char* dst = c8 + (size_t)e * 7168 * 1024 + (size_t)((n0 >> 7) * 256 + wh * 128 + (n0 & 127)) * 1024 + kb * 64;
                const int nq = lane & 7, kr = lane >> 3;
#pragma unroll
                for (int p = 0; p < 2; ++p) { const f32x4 gq = cg[p] * 32.0f;
                    const f32x4 a = cv[4 * p], b2 = cv[4 * p + 1], c2 = cv[4 * p + 2], d2 = cv[4 * p + 3]; LAS unsigned* t = CT + (4 * nq) * 17 + 8 * p + kr;
                    t[0] = pk4_fp8(a.x * gq[0], b2.x * gq[1], c2.x * gq[2], d2.x * gq[3]); t[17] = pk4_fp8(a.y * gq[0], b2.y * gq[1], c2.y * gq[2], d2.y * gq[3]);
                    t[34] = pk4_fp8(a.z * gq[0], b2.z * gq[1], c2.z * gq[2], d2.z * gq[3]); t[51] = pk4_fp8(a.w * gq[0], b2.w * gq[1], c2.w * gq[2], d2.w * gq[3]); }
                LDS_WAIT(); asm volatile("" ::: "memory");
#pragma unroll
                for (int r = 0; r < 2; ++r) { const int nn2 = (lane >> 2) + 16 * r, c4 = lane & 3; const LAS unsigned* sp = CT + nn2 * 17 + 4 * c4;
                    v4u o; o.x = sp[0]; o.y = sp[1]; o.z = sp[2]; o.w = sp[3];
                    *(GAS v4u*)(dst + (size_t)nn2 * 1024 + 16 * c4) = o; }
            }
            { const int n2 = n + 2 < 64 ? n + 2 : 63; GL_DMA(n2, bo2); }
            if (!(n & 1) && (n < 56)) {
                const int id = gw2 + 1024 * (n >> 1), e = id / 3584, r2 = id - e * 3584, wh = r2 / 1792, it2 = r2 - wh * 1792, kb = it2 / 112, nb = it2 - kb * 112;
                const float* p = (wh ? cwu : cwg) + (size_t)e * 1024 * FFE + (size_t)(kb * 64 + 4 * (lane >> 3)) * FFE + nb * 32 + 4 * (lane & 7);
#pragma unroll
                for (int j = 0; j < 8; ++j) cv[j] = *(const f32x4*)(p + (size_t)(32 * (j >> 2) + (j & 3)) * FFE);
                cg[0] = *(const f32x4*)(cgain + kb * 64 + 4 * (lane >> 3)); cg[1] = *(const f32x4*)(cgain + kb * 64 + 32 + 4 * (lane >> 3));
            }
            __builtin_amdgcn_sched_barrier(0);
#pragma unroll
            for (int j = 0; j < 5; ++j) {
                f32x4 sv = So[j];
#pragma unroll
                for (int ks = 0; ks < 2; ++ks) { bf16x8 vop;
                    if (j == 0) vop = vfr[0][ks]; else if (j == 2) vop = vfr[1][ks]; else if (j >= 3) vop = vfr[2][ks];
                    else { const v4u a_ = __builtin_bit_cast(v4u, vfr[0][ks]), b_ = __builtin_bit_cast(v4u, vfr[1][ks]); v4u r_; r_.x = (b_.x & vmsk) | (a_.x & ~vmsk); r_.y = (b_.y & vmsk) | (a_.y & ~vmsk); r_.z = (b_.z & vmsk) | (a_.z & ~vmsk); r_.w = (b_.w & vmsk) | (a_.w & ~vmsk); vop = __builtin_bit_cast(bf16x8, r_); }
                    sv = __builtin_amdgcn_mfma_f32_16x16x32_bf16(kdf[j][ks], vop, sv, 0, 0, 0); }
                sv[0] *= dec[j][0]; sv[1] *= dec[j][1]; sv[2] *= dec[j][2]; sv[3] *= dec[j][3];
                So[j] = sv;
            }
#pragma unroll
            for (int j = 0; j < 5; ++j) if (oV[j]) { v2u w; w.x = pk2(So[j][0], So[j][1]); w.y = pk2(So[j][2], So[j][3]); *(LAS v2u*)(SBw + oT[j] * 512 + lane * 8) = w; }
            asm volatile("s_waitcnt lgkmcnt(0)\n\ts_barrier" ::: "memory");
            { const int t_ = bo; bo = (bo == 2 * GL_BUF) ? 0 : bo + GL_BUF; bo2 = t_; }
        }
#undef GL_DMA
    }
#undef GL_PIECE
#undef GL_OFF
    __syncthreads();
}

__device__ __forceinline__ void finalize_rstd(const Frame& F, const float* rss, float* rstd) {
    for (int row = F.bid * NTHR + TID(); row < NT; row += F.G * NTHR) rstd[row] = rstd_from(rss + (size_t)row * 16);
}
__device__ __forceinline__ void gla_combine(const Frame& F, const bf16* OF, const bf16* OB, const bf16* act1, const float* gnorm, bf16* mix) {
    const int lane = LANE(), h = lane >> 4, c0 = h * 192 + 12 * (lane & 15);
    float gn[12];
#pragma unroll
    for (int j = 0; j < 12; ++j) gn[j] = gnorm[12 * (lane & 15) + j];
    for (int token = F.gw; token < NT; token += 2 * F.NGW) {
        const int tb = token + F.NGW; const bool hb = tb < NT; const int t2 = hb ? tb : token;
        v2u fa[3], ba[3], ga[3], fb[3], bb[3], gb[3];
#pragma unroll
        for (int j = 0; j < 3; ++j) { fa[j] = *(const v2u*)(OF + (size_t)token * 768 + c0 + 4 * j); ba[j] = *(const v2u*)(OB + (size_t)token * 768 + c0 + 4 * j); ga[j] = *(const v2u*)(act1 + (size_t)token * A1_LD + 768 + c0 + 4 * j); }
#pragma unroll
        for (int j = 0; j < 3; ++j) { fb[j] = *(const v2u*)(OF + (size_t)t2 * 768 + c0 + 4 * j); bb[j] = *(const v2u*)(OB + (size_t)t2 * 768 + c0 + 4 * j); gb[j] = *(const v2u*)(act1 + (size_t)t2 * A1_LD + 768 + c0 + 4 * j); }
        float oa[12], ob[12], sa = 0.f, sb = 0.f;
#pragma unroll
        for (int j = 0; j < 3; ++j) {
            oa[4 * j] = bflo(fa[j].x) + bflo(ba[j].x); oa[4 * j + 1] = bfhi(fa[j].x) + bfhi(ba[j].x); oa[4 * j + 2] = bflo(fa[j].y) + bflo(ba[j].y); oa[4 * j + 3] = bfhi(fa[j].y) + bfhi(ba[j].y);
            ob[4 * j] = bflo(fb[j].x) + bflo(bb[j].x); ob[4 * j + 1] = bfhi(fb[j].x) + bfhi(bb[j].x); ob[4 * j + 2] = bflo(fb[j].y) + bflo(bb[j].y); ob[4 * j + 3] = bfhi(fb[j].y) + bfhi(bb[j].y); }
#pragma unroll
        for (int j = 0; j < 12; ++j) { sa += oa[j] * oa[j]; sb += ob[j] * ob[j]; }
#pragma unroll
        for (int o = 1; o < 16; o <<= 1) { sa += __shfl_xor(sa, o); sb += __shfl_xor(sb, o); }
        const float ra = __builtin_amdgcn_rsqf(sa * (1.0f / 192.0f) + EPS), rb = __builtin_amdgcn_rsqf(sb * (1.0f / 192.0f) + EPS);
#pragma unroll
        for (int j = 0; j < 3; ++j) {
            const float g0 = bflo(ga[j].x), g1 = bfhi(ga[j].x), g2 = bflo(ga[j].y), g3 = bfhi(ga[j].y);
            v2u w; w.x = pk2(oa[4 * j] * ra * gn[4 * j] * g0 * __builtin_amdgcn_rcpf(1.0f + __expf(-g0)), oa[4 * j + 1] * ra * gn[4 * j + 1] * g1 * __builtin_amdgcn_rcpf(1.0f + __expf(-g1)));
            w.y = pk2(oa[4 * j + 2] * ra * gn[4 * j + 2] * g2 * __builtin_amdgcn_rcpf(1.0f + __expf(-g2)), oa[4 * j + 3] * ra * gn[4 * j + 3] * g3 * __builtin_amdgcn_rcpf(1.0f + __expf(-g3)));
            *(v2u*)(mix + (size_t)token * DM + c0 + 4 * j) = w; }
        if (hb) {
#pragma unroll
            for (int j = 0; j < 3; ++j) {
                const float g0 = bflo(gb[j].x), g1 = bfhi(gb[j].x), g2 = bflo(gb[j].y), g3 = bfhi(gb[j].y);
                v2u w; w.x = pk2(ob[4 * j] * rb * gn[4 * j] * g0 * __builtin_amdgcn_rcpf(1.0f + __expf(-g0)), ob[4 * j + 1] * rb * gn[4 * j + 1] * g1 * __builtin_amdgcn_rcpf(1.0f + __expf(-g1)));
                w.y = pk2(ob[4 * j + 2] * rb * gn[4 * j + 2] * g2 * __builtin_amdgcn_rcpf(1.0f + __expf(-g2)), ob[4 * j + 3] * rb * gn[4 * j + 3] * g3 * __builtin_amdgcn_rcpf(1.0f + __expf(-g3)));
                *(v2u*)(mix + (size_t)tb * DM + c0 + 4 * j) = w; } }
    }
}
__device__ __forceinline__ void route_pick(const float (&acc)[8], int token, int* topi, float* topw, LAS int* lc) {
    int e0 = 0; float l0 = acc[0];
#pragma unroll
    for (int e = 1; e < 8; ++e) if (acc[e] > l0) { l0 = acc[e]; e0 = e; }
    int e1 = -1; float l1 = -INFINITY;
#pragma unroll
    for (int e = 0; e < 8; ++e) if (e != e0 && acc[e] > l1) { l1 = acc[e]; e1 = e; }
    if (e1 < 0) { e1 = (e0 + 1) & 7; l1 = l0; }
    const float w0 = 1.0f / (1.0f + __expf(l1 - l0));
    topi[token] = e0 | (e1 << 8); topw[2 * token] = w0; topw[2 * token + 1] = 1.0f - w0;
    atomicAdd((int*)&lc[e0], 1); atomicAdd((int*)&lc[8 + e1], 1);
}
__device__ __forceinline__ void route1(const Frame& F, const bf16* H, const float* gain, const float* wr, int* topi, float* topw, int* cnt, float* rstd) {
    LAS int* lc = (LAS int*)F.lds;
    if (TID() < 16) lc[TID()] = 0;
    __syncthreads();
    const int lane = LANE();
    float w[4][4][8];
#pragma unroll
    for (int j = 0; j < 4; ++j) { const f32x4 g = *(const f32x4*)(gain + 256 * j + 4 * lane);
#pragma unroll
        for (int i = 0; i < 4; ++i) { const float* p = wr + (size_t)(256 * j + 4 * lane + i) * 8; const f32x4 a = *(const f32x4*)p, b = *(const f32x4*)(p + 4); const float gi = g[i];
            w[j][i][0] = a.x * gi; w[j][i][1] = a.y * gi; w[j][i][2] = a.z * gi; w[j][i][3] = a.w * gi; w[j][i][4] = b.x * gi; w[j][i][5] = b.y * gi; w[j][i][6] = b.z * gi; w[j][i][7] = b.w * gi; } }
    for (int t2 = 0; t2 < 16; t2 += 2) {
        const int token = F.bid * 128 + F.wave * 16 + t2;
        const v2u* h0 = (const v2u*)(H + (size_t)token * DM) + lane; const v2u* h1 = h0 + DM / 4;
        f32x4 x0[4], x1[4];
#pragma unroll
        for (int j = 0; j < 4; ++j) { const v2u p = h0[64 * j], q = h1[64 * j]; x0[j] = (f32x4){bflo(p.x), bfhi(p.x), bflo(p.y), bfhi(p.y)}; x1[j] = (f32x4){bflo(q.x), bfhi(q.x), bflo(q.y), bfhi(q.y)}; }
        float a0[8], a1[8], s0 = 0.f, s1 = 0.f;
#pragma unroll
        for (int e = 0; e < 8; ++e) { a0[e] = 0.f; a1[e] = 0.f; }
#pragma unroll
        for (int j = 0; j < 4; ++j)
#pragma unroll
            for (int i = 0; i < 4; ++i) { const float u = x0[j][i], v = x1[j][i]; s0 += u * u; s1 += v * v;
#pragma unroll
                for (int e = 0; e < 8; ++e) { a0[e] += u * w[j][i][e]; a1[e] += v * w[j][i][e]; } }
        s0 = wave_sum(s0); s1 = wave_sum(s1);
        const float r0 = 1.0f / sqrtf(s0 * (1.0f / DM) + EPS), r1 = 1.0f / sqrtf(s1 * (1.0f / DM) + EPS);
#pragma unroll
        for (int e = 0; e < 8; ++e) { a0[e] = wave_sum(a0[e]) * r0; a1[e] = wave_sum(a1[e]) * r1; }
        if (lane == 0) { route_pick(a0, token, topi, topw, lc); route_pick(a1, token + 1, topi, topw, lc); rstd[token] = r0; rstd[token + 1] = r1; }
    }
    __syncthreads();
    if (TID() < 16) cnt[F.bid * 16 + TID()] = lc[TID()];
    __syncthreads();
}
__device__ __forceinline__ void route2(const Frame& F, const int* topi, const float* topw, const int* cnt, int* stok, float* sw, int* blk, int* s0tab) {
    LAS int* part = (LAS int*)F.lds;
    LAS int* base = part + 1024;
    LAS int* tk = base + 64;
    const int tid = TID(), pe = tid & 15, jg = tid >> 4;
    int below = 0, tot = 0;
    for (int w = jg; w < F.G; w += 32) { const int v = cnt[w * 16 + pe]; tot += v; if (w < F.bid) below += v; }
    part[jg * 16 + pe] = below; part[512 + jg * 16 + pe] = tot;
    if (tid < 128) tk[tid] = topi[F.bid * 128 + tid];
    __syncthreads();
    if (tid < 16) { int b = 0, t = 0; for (int j = 0; j < 32; ++j) { b += part[j * 16 + tid]; t += part[512 + j * 16 + tid]; } base[tid] = b; base[16 + tid] = t; }
    __syncthreads();
    if (tid < 2) { int ps = 0; for (int e = 0; e < 8; ++e) { base[32 + tid * 8 + e] = ps; ps += (base[16 + tid * 8 + e] + 255) / 256 * 256; } base[48 + tid] = ps / 256; }
    __syncthreads();
    if (tid < 256) {
        const int p = tid >> 7, i = tid & 127; const int e = (tk[i] >> (8 * p)) & 0xff;
        int rank = 0; for (int j = 0; j < i; ++j) rank += (((tk[j] >> (8 * p)) & 0xff) == e) ? 1 : 0;
        const int slot = base[32 + p * 8 + e] + base[p * 8 + e] + rank; const int token = F.bid * 128 + i;
        stok[p * SLOT_CAP + slot] = token; sw[p * SLOT_CAP + slot] = topw[2 * token + p]; if (p == 0) s0tab[token] = slot;
    }
    if (F.bid < 16) {
        const int p = F.bid >> 3, e = F.bid & 7, ps = base[32 + F.bid], t = base[16 + F.bid], pend = ps + (t + 255) / 256 * 256;
        for (int s = ps + t + tid; s < pend; s += NTHR) { stok[p * SLOT_CAP + s] = -1; sw[p * SLOT_CAP + s] = 0.f; }
        for (int bk = ps / 256 + tid; bk < pend / 256; bk += NTHR) blk[16 + p * 256 + bk] = e;
        if (e == 0 && tid == 0) blk[p] = base[48 + p];
    }
    __syncthreads();
}
__device__ __forceinline__ void final_norm_slots(int lane, const bf16* HB, float* OUT, const bf16* YA, const int* s0tab, const bf16* Y, const bf16* Y2, const float* gain, const int* tok, int s0, int s1, int first, int stride) {
    f32x4 gv[4];
#pragma unroll
    for (int j = 0; j < 4; ++j) gv[j] = ((const f32x4*)gain + lane)[64 * j];
    for (int base = s0 + first; base < s1; base += 64 * stride) {
      const int sll = base + lane * stride; int mytok = -1; if (sll < s1) mytok = tok[sll];
      const int mys0 = s0tab[mytok < 0 ? 0 : mytok];
      const int cnt = min(64, (s1 - base + stride - 1) / stride);
      for (int i = 0; i < cnt; i += 2) {
        const int sl = base + i * stride, slb = sl + stride; const bool hb = i + 1 < cnt; const int i1 = hb ? i + 1 : i;
        const int ra = __builtin_amdgcn_readlane(mytok, i), rb = hb ? __builtin_amdgcn_readlane(mytok, i1) : -1;
        const int rowa = ra < 0 ? 0 : ra, rowb = rb < 0 ? 0 : rb;
        const v2u* xa = (const v2u*)(HB + (size_t)rowa * DM) + lane; const v2u* xb = (const v2u*)(HB + (size_t)rowb * DM) + lane;
        const v2u* ya = (const v2u*)(Y + (size_t)sl * DM) + lane; const v2u* yb = (const v2u*)(Y + (size_t)(hb ? slb : sl) * DM) + lane;
        const v2u* pa = (const v2u*)(YA + (size_t)__builtin_amdgcn_readlane(mys0, i) * DM) + lane; const v2u* pb = (const v2u*)(YA + (size_t)__builtin_amdgcn_readlane(mys0, i1) * DM) + lane;
        f32x4 va[4], vb[4]; v2u wa[4], wb[4], ua[4], ub[4], ta[4], tb[4];
#pragma unroll
        for (int j = 0; j < 4; ++j) { ua[j] = xa[64 * j]; wa[j] = ya[64 * j]; ta[j] = pa[64 * j]; }
#pragma unroll
        for (int j = 0; j < 4; ++j) { ub[j] = xb[64 * j]; wb[j] = yb[64 * j]; tb[j] = pb[64 * j]; }
#pragma unroll
        for (int j = 0; j < 4; ++j) { va[j] = (f32x4){bflo(ua[j].x) + bflo(ta[j].x), bfhi(ua[j].x) + bfhi(ta[j].x), bflo(ua[j].y) + bflo(ta[j].y), bfhi(ua[j].y) + bfhi(ta[j].y)};
            vb[j] = (f32x4){bflo(ub[j].x) + bflo(tb[j].x), bfhi(ub[j].x) + bfhi(tb[j].x), bflo(ub[j].y) + bflo(tb[j].y), bfhi(ub[j].y) + bfhi(tb[j].y)}; }
        if (Y2) {
            const v2u* za = (const v2u*)(Y2 + (size_t)(sl - s0) * DM) + lane; const v2u* zb = (const v2u*)(Y2 + (size_t)((hb ? slb : sl) - s0) * DM) + lane;
#pragma unroll
            for (int j = 0; j < 4; ++j) { const v2u p = za[64 * j], q = zb[64 * j];
                va[j].x += bflo(p.x); va[j].y += bfhi(p.x); va[j].z += bflo(p.y); va[j].w += bfhi(p.y); vb[j].x += bflo(q.x); vb[j].y += bfhi(q.x); vb[j].z += bflo(q.y); vb[j].w += bfhi(q.y); }
        }
        float sa = 0.f, sb = 0.f;
#pragma unroll
        for (int j = 0; j < 4; ++j) {
            va[j].x += bflo(wa[j].x); va[j].y += bfhi(wa[j].x); va[j].z += bflo(wa[j].y); va[j].w += bfhi(wa[j].y);
            vb[j].x += bflo(wb[j].x); vb[j].y += bfhi(wb[j].x); vb[j].z += bflo(wb[j].y); vb[j].w += bfhi(wb[j].y);
            sa += (va[j].x * va[j].x + va[j].y * va[j].y) + (va[j].z * va[j].z + va[j].w * va[j].w); sb += (vb[j].x * vb[j].x + vb[j].y * vb[j].y) + (vb[j].z * vb[j].z + vb[j].w * vb[j].w); }
        sa = wave_sum(sa); sb = wave_sum(sb);
        const float rsa = 1.0f / sqrtf(sa * (1.0f / DM) + EPS), rsb = 1.0f / sqrtf(sb * (1.0f / DM) + EPS);
        if (ra >= 0) { GAS f32x4* oa = (GAS f32x4*)(OUT + (size_t)rowa * DM) + lane;
#pragma unroll
            for (int j = 0; j < 4; ++j) { const f32x4 g = gv[j]; oa[64 * j] = (f32x4){va[j].x * rsa * g.x, va[j].y * rsa * g.y, va[j].z * rsa * g.z, va[j].w * rsa * g.w}; } }
        if (rb >= 0) { GAS f32x4* ob = (GAS f32x4*)(OUT + (size_t)rowb * DM) + lane;
#pragma unroll
            for (int j = 0; j < 4; ++j) { const f32x4 g = gv[j]; ob[64 * j] = (f32x4){vb[j].x * rsb * g.x, vb[j].y * rsb * g.y, vb[j].z * rsb * g.z, vb[j].w * rsb * g.w}; } }
      }
    }
}
__device__ __forceinline__ void final_norm(const Frame& F, float* H, const float* gain) {
    for (int row = F.gw; row < NT; row += F.NGW) {
        GAS f32x4* xr = (GAS f32x4*)(H + (size_t)row * DM) + LANE(); const f32x4* gr = (const f32x4*)gain + LANE();
        f32x4 v[4]; float s = 0.f;
#pragma unroll
        for (int j = 0; j < 4; ++j) { v[j] = xr[64 * j]; s += (v[j].x * v[j].x + v[j].y * v[j].y) + (v[j].z * v[j].z + v[j].w * v[j].w); }
        s = wave_sum(s); const float rs = 1.0f / sqrtf(s * (1.0f / DM) + EPS);
#pragma unroll
        for (int j = 0; j < 4; ++j) { const f32x4 g = gr[64 * j]; f32x4 o = {v[j].x * rs * g.x, v[j].y * rs * g.y, v[j].z * rs * g.z, v[j].w * rs * g.w}; xr[64 * j] = o; }
    }
}

constexpr int N_PHASES = 17;
__global__ void __launch_bounds__(NTHR, 2) mega(Args args) {
    extern __shared__ __attribute__((aligned(16))) unsigned char lds_raw[];
    Frame F;
    F.lds = (LAS unsigned char*)lds_raw;
    F.wave = __builtin_amdgcn_readfirstlane((int)(threadIdx.x >> 6));
    F.G = gridDim.x; F.bid = blockIdx.x; F.gw = F.bid * NWAVES + F.wave; F.NGW = F.G * NWAVES; F.ws = args.ws;
    unsigned char* ws = args.ws;
    gu32* ctl = (gu32*)(ws + WS_CTL);
    volatile LAS unsigned* MISC = (volatile LAS unsigned*)(F.lds + MISC_OFF);
    for (int u = TID(); u < (LDS_BYTES - LDSCTL_OFF) / 4; u += NTHR) ((LAS unsigned*)(F.lds + LDSCTL_OFF))[u] = 0u;
    __syncthreads();
    XcdBarrier bar = xcd_barrier_post((unsigned*)(ctl + CW_BAR), MISC + 8, F.wave);
    const int lo = args.ph_lo, hi = args.ph_hi;
#ifndef PH_MASK
#define PH_MASK 0x1ffff
#endif
#define IN(k) (((PH_MASK >> (k)) & 1) && lo <= (k) && (k) < hi)
#ifndef REPEAT_MASK
#define REPEAT_MASK 0
#endif
#define REPS(k) (1 + ((REPEAT_MASK >> (k)) & 1))
#define SEAM(k) do { if (IN(k) && IN((k) + 1)) xcd_barrier(bar); } while (0)

    float* H = args.out;
    bf16* x3 = (bf16*)args.out;
    float* rss = (float*)(ws + WS_RSS); float* rstd = (float*)(ws + WS_RSTD);
    bf16* hbf = (bf16*)(ws + WS_HBF); bf16* membf = (bf16*)(ws + WS_MEMBF); bf16* memk = (bf16*)(ws + WS_MEMK); bf16* memvt = (bf16*)(ws + WS_MEMVT);
    bf16* act0 = (bf16*)(ws + WS_ACT0); bf16* v0t = (bf16*)(ws + WS_V0T); bf16* mix = (bf16*)(ws + WS_MIX); bf16* hmid0 = (bf16*)(ws + WS_HMID0);
    bf16* act1 = (bf16*)(ws + WS_ACT1); bf16* v1t = (bf16*)(ws + WS_V1T); bf16* OF = (bf16*)(ws + WS_OF); bf16* OB = (bf16*)(ws + WS_OB);
    bf16* hmid1 = (bf16*)(ws + WS_HMID1); bf16* wgu = (bf16*)((unsigned char*)args.out + OUT_WGU); bf16* wdn = (bf16*)(ws + WS_WDN);
    int* cnt = (int*)(ws + WS_CNT); int* topi = (int*)(ws + WS_TOPI); float* topw = (float*)(ws + WS_TOPW);
    int* stok = (int*)(ws + WS_STOK); float* sw = (float*)(ws + WS_SW); int* blk = (int*)(ws + WS_BLK);
    LAS float* scr = (LAS float*)(F.lds + F.wave * 16384);

    if (IN(0)) {
        int it = F.gw; LAS unsigned* T0 = (LAS unsigned*)scr; LAS unsigned* T1 = T0 + 1088;
#define CVT(Wp, Kd, Nd, WTp, gainp, kind) do { const CvtJob J{Wp, Kd, Nd, (bf16*)(WTp), gainp, kind}; const int n_ = ((Kd) / 64) * ((Nd) / 32); \
            while (it < n_) { CvtRegs A_, B_; B_.valid = 0; cvt_load(A_, J, it, LANE()); it += F.NGW; if (it < n_) { cvt_load(B_, J, it, LANE()); it += F.NGW; } cvt_finish(A_, T0, LANE()); cvt_finish(B_, T1, LANE()); } \
            it -= n_; } while (0)
        CVT(args.in[I_EWIN], 1024, 2560, ws + WS_W0IN, args.in[I_EN1], 1);
        CVT(args.in[I_EWIN], 1024, 2560, ws + WS_WV0, args.in[I_EN1], 2);
        CVT(args.in[I_EWOUT], 1024, 1024, ws + WS_W0OUT, nullptr, 0);
        CVT(args.in[I_EWG], 1024, 2816, ws + WS_W0GU, args.in[I_EN2], 3);
        CVT(args.in[I_EWU], 1024, 2816, ws + WS_W0GU, args.in[I_EN2], 4);
        CVT(args.in[I_EWD], 2816, 1024, ws + WS_W0DN, nullptr, 0);
        CVT(args.in[I_WMKV], 1024, 512, ws + WS_WMEM, args.in[I_MNORM], 0);
        CVT(args.in[I_OWIN], 1024, 2592, ws + WS_W1IN, args.in[I_ON1], 5);
        CVT(args.in[I_OWIN], 1024, 2592, ws + WS_WV1, args.in[I_ON1], 6);
        CVT(args.in[I_OWOUT], 1024, 1024, ws + WS_W1OUT, nullptr, 0);
#undef CVT
        { v4u z = {0u, 0u, 0u, 0u}; v4u* p = (v4u*)(ws + WS_W1IN + (size_t)1824 * 2048); const int n16 = 224 * 2048 / 16;
          for (int i = F.bid * NTHR + TID(); i < n16; i += F.G * NTHR) p[i] = z; }
        { float* rp2 = (float*)(ws + WS_RPB2); for (int i2 = F.bid * NTHR + TID(); i2 < 12 * 480; i2 += F.G * NTHR) { const int hh = i2 / 480, jj = i2 - 480 * hh; rp2[i2] = jj < 465 ? args.in[I_RPB][hh * 465 + jj] * 1.4426950408889634f : 0.f; } }
        rows_to_bf16(args.in[I_X], hbf, rstd, F.gw, NT, F.NGW, LANE());
        rows_to_bf16(args.in[I_MEM], membf, rstd + NT, F.gw, MEM_ROWS, F.NGW, LANE());
    }
    SEAM(0);
    if (IN(1)) {
        { Sched S; S.init(hbf, ws + WS_W0IN, 1024, 128, 7, F.G, F.bid); EpiRowScale E{act0, A0_LD, rstd, 1.0f}; gemm_run<EpiRowScale, false>(F.lds, S, E, nullptr, F.wave); }
        { Sched S; S.init(ws + WS_WV0, hbf, 1024, 3, 128, F.G, (F.bid + 128) % F.G); EpiColScale E{v0t, NT, rstd}; gemm_run<EpiColScale, false>(F.lds, S, E, nullptr, F.wave); }
        for (int it = F.gw; it < 2048; it += F.NGW) memkv_item(it, LANE(), membf, (const bf16*)(ws + WS_WMEM), rstd + NT, memk, memvt);
    }
    SEAM(1);
    if (IN(2)) {
        { na_phase(F, act0, v0t, (const float*)(ws + WS_RPB2), mix);
          if (F.G == 256) { for (int i = 0; i < 2; ++i) memattn_strip(F, (F.bid >> 3) * 16 + 2 * (F.bid & 7) + i, act0, A0_LD, 1536, memk, memvt, mix, i == 0); }
          else for (int it = F.bid; it < 512; it += F.G) memattn_strip(F, it, act0, A0_LD, 1536, memk, memvt, mix);
          __syncthreads(); }
    }
    SEAM(2);
    if (IN(3)) {
        Sched S; S.init(mix, ws + WS_W0OUT, 1024, 128, 4, F.G, F.bid); EpiResid<true> E{args.in[I_X], hbf, rss, nullptr}; gemm_run<EpiResid<true>, false>(F.lds, S, E, nullptr, F.wave);
    }
    SEAM(3);
    if (IN(4)) {
        Sched S; S.init(hbf, ws + WS_W0GU, 1024, 128, 22, F.G, F.bid); EpiSwiGLU<false, true> E{hmid0, FF0, rss, nullptr}; gemm_run<EpiSwiGLU<false, true>, false>(F.lds, S, E, nullptr, F.wave);
    }
    SEAM(4);
    if (IN(5)) {
        Sched S; S.init(hmid0, ws + WS_W0DN, FF0, 128, 4, F.G, F.bid); EpiResid<false> E{nullptr, hbf, rss, nullptr}; gemm_run<EpiResid<false>, false>(F.lds, S, E, nullptr, F.wave);
    }
    SEAM(5);
    if (IN(6)) {
        { Sched S; S.init(hbf, ws + WS_W1IN, 1024, 128, 8, F.G, F.bid); EpiRowScaleT<true> E{act1, A1_LD, rss, 1.0f}; gemm_run<EpiRowScaleT<true>, false>(F.lds, S, E, nullptr, F.wave); }
        { Sched S; S.init(ws + WS_WV1, hbf, 1024, 3, 128, F.G, F.bid); EpiColScaleT<true> E{v1t, NT, rss}; gemm_run<EpiColScaleT<true>, false>(F.lds, S, E, nullptr, F.wave); }
    }
    SEAM(6);
    if (IN(7)) {
        bf16x8 gwf[3]; float gbi[3]; int gdir = -1;
        for (int it = F.bid; it < 1024; it += F.G) { const int dir = (it >> 6) & 1;
            if (dir != gdir) { gla_pre_w(F.wave, LANE(), dir ? args.in[I_WGKB] : args.in[I_WGKF], dir ? args.in[I_BGKB] : args.in[I_BGKF], gwf, gbi); gdir = dir; }
            gla_pre_item(F, it, act1, gwf, gbi, (bf16*)(ws + WS_GQT) + (size_t)dir * NT * 384, (bf16*)((unsigned char*)args.out + OUT_GKT) + (size_t)dir * NT * 384,
                         (float*)((unsigned char*)args.out + OUT_GDEC) + (size_t)dir * 8 * 4 * 64 * 96); }
        if (F.G == 256) { for (int i = 0; i < 2; ++i) memattn_strip(F, (F.bid >> 3) * 16 + 2 * (F.bid & 7) + i, act1, A1_LD, 1536, memk, memvt, mix, i == 0); }
        else for (int it = F.bid; it < 512; it += F.G) memattn_strip(F, it, act1, A1_LD, 1536, memk, memvt, mix);
        xcd_barrier(bar);
        for (int it0 = F.bid; it0 < 256; it0 += F.G) { const int it = (F.G == 256) ? ((it0 & 7) * 8 + (it0 >> 5)) * 4 + ((it0 >> 3) & 3) : it0;
            gla_main_item(F, it, (const bf16*)(ws + WS_GQT), (const bf16*)((unsigned char*)args.out + OUT_GKT), (const float*)((unsigned char*)args.out + OUT_GDEC), v1t, OF, OB, args.in[I_OWG], args.in[I_OWU], args.in[I_ON2], (unsigned char*)wgu); }
    }
    SEAM(7);
    if (IN(8)) gla_combine(F, OF, OB, act1, args.in[I_GNORM], mix);
    SEAM(8);
    if (IN(9)) {
        Sched S; S.init(mix, ws + WS_W1OUT, 1024, 128, 4, F.G, F.bid); EpiResid<false> E{nullptr, hbf, rss, x3}; gemm_run<EpiResid<false>, false>(F.lds, S, E, nullptr, F.wave);
    }
    SEAM(9);
    if (IN(10)) {
        route1(F, hbf, args.in[I_ON2], args.in[I_WR], topi, topw, cnt, rstd);
    }
    SEAM(10);
    if (IN(11)) {
        route2(F, topi, topw, cnt, stok, sw, blk, (int*)(ws + WS_S0TAB));
        { LAS unsigned* T0 = (LAS unsigned*)scr; LAS unsigned* T1 = T0 + 1088;
#define MOE_JOB(J_, it_) const int e_##J_ = (it_) / 1792; \
            const CvtJob J_{args.in[I_OWD] + (size_t)e_##J_ * FFE * 1024, FFE, 1024, (bf16*)((unsigned char*)wdn + (size_t)e_##J_ * 1024 * FFE), nullptr, 0}
          for (int it = F.gw; it < 8 * 1792; it += 2 * F.NGW) {
            CvtRegs A_, B_; B_.valid = 0;
            { MOE_JOB(Ja, it); cvt_load8(A_, Ja, it % 1792, LANE()); }
            if (it + F.NGW < 8 * 1792) { MOE_JOB(Jb, it + F.NGW); cvt_load8(B_, Jb, (it + F.NGW) % 1792, LANE()); }
            cvt_finish8(A_, T0, LANE(), 32.0f); cvt_finish8(B_, T1, LANE(), 32.0f);
          }
#undef MOE_JOB
        }
    }
    SEAM(11);
    bf16* ht0 = (bf16*)((unsigned char*)hmid1 + (size_t)NT * FFE); bf16* ht1 = (bf16*)(ws + WS_HT1);
    constexpr int KG = 512, KD = FFE / 2; constexpr size_t ESG = (size_t)7168 * 1024, ESD = (size_t)1024 * FFE;
    if (IN(12)) {
        const int nb = blk[0]; Sched S; S.init(x3, wgu, KG, nb, 28, F.G, F.bid, blk + 16, ESG); EpiSwiGLU<true> E{hmid1, FFE, rstd, ht0}; gemm_run<EpiSwiGLU<true>, true, true>(F.lds, S, E, stok, F.wave);
    }
    SEAM(12);
    if (IN(13)) {
        const int nb = blk[0], nbm = nb < 128 ? nb : 128; Sched S; S.init(hmid1, wdn, KD, nbm, 4, F.G, F.bid, blk + 16, ESD); EpiRowScale E{(bf16*)(ws + WS_YA), DM, sw, 0.03125f}; gemm_run<EpiRowScale, false, true>(F.lds, S, E, nullptr, F.wave);
    }
    SEAM(13);
    if (IN(14)) {
        const int nb = blk[1], nb0 = blk[0], rfull = (nb * 28 / F.G > 3) ? nb * 28 / F.G - 3 : 0, per = F.G / 8;
        { Sched S; S.init(x3, wgu, KG, nb, 28, F.G, F.bid, blk + 16 + 256, ESG); S.range(0, rfull * per, per);
          EpiSwiGLU<true> E{hmid1, FFE, rstd, ht1}; gemm_run<EpiSwiGLU<true>, true, true>(F.lds, S, E, stok + SLOT_CAP, F.wave); }
        { Sched S; S.init(x3, wgu, KG, nb, 28, F.G, F.bid, blk + 16 + 256, ESG); S.range(rfull * per, 0x7fffffff, per - 4);
          EpiSwiGLU<true> E{hmid1, FFE, rstd, ht1}; gemm_run<EpiSwiGLU<true>, true, true>(F.lds, S, E, stok + SLOT_CAP, F.wave); }
        if (F.bid / 8 >= per - 4 && nb0 > 128) {
            Sched S; S.init(ht0, wdn, KD, nb0 - 128, 4, 32, (F.bid / 8 - (per - 4)) * 8 + F.bid % 8, blk + 16 + 128, ESD);
            EpiRowScale E{(bf16*)(ws + WS_YA) + (size_t)NT * DM, DM, sw + NT, 0.03125f}; gemm_run<EpiRowScale, false, true>(F.lds, S, E, nullptr, F.wave); }
    }
    SEAM(14);
    if (IN(15)) {
        const int nb = blk[1], nbm = nb < 128 ? nb : 128; Sched S; S.init(hmid1, wdn, KD, nbm, 4, F.G, F.bid, blk + 16 + 256, ESD); EpiRowScale E{(bf16*)(ws + WS_YB), DM, sw + SLOT_CAP, 0.03125f}; gemm_run<EpiRowScale, false, true>(F.lds, S, E, nullptr, F.wave);
    }
    SEAM(15);
    if (IN(16)) {
        const int nb = blk[1], per = F.G / 8, nmain = (nb < 128 ? nb : 128) * 256;
        bf16* yb = (bf16*)(ws + WS_YB); bf16* yb2 = yb + (size_t)SLOT_CAP * DM;
        if (F.bid / 8 >= per - 4) {
            if (nb > 128) {
                const int sl = F.bid / 8 - (per - 4), kh = sl >> 1;
                Sched S; S.init((const bf16*)ht1 + kh * (KD / 2), (const bf16*)wdn + kh * (KD / 2), KD / 2, nb - 128, 4, 16, (sl & 1) * 8 + F.bid % 8, blk + 16 + 256 + 128, ESD); S.ld = KD;
                EpiRowScale E{kh ? yb2 : yb + (size_t)NT * DM, DM, sw + SLOT_CAP + NT, 0.03125f}; gemm_run<EpiRowScale, false, true>(F.lds, S, E, nullptr, F.wave); }
        } else {
            const int wv = (int)(blockIdx.x * NWAVES) + F.wave;
            final_norm_slots(LANE(), hbf, H, (const bf16*)(ws + WS_YA), (const int*)(ws + WS_S0TAB), yb, nullptr, args.in[I_FNORM], stok + SLOT_CAP, 0, nmain, wv, (per - 4) * 8 * NWAVES);
        }
        xcd_barrier(bar);
        if (nb > 128) final_norm_slots(LANE(), hbf, H, (const bf16*)(ws + WS_YA), (const int*)(ws + WS_S0TAB), yb, yb2, args.in[I_FNORM], stok + SLOT_CAP, NT, nb * 256, (int)(blockIdx.x * NWAVES) + F.wave, F.NGW);
    }
#undef IN
#undef SEAM
}

extern "C" void kernel_launch(void* const* d_in, const int* in_sizes, int n_in, void* d_out, int out_size, void* d_ws, size_t ws_size, hipStream_t stream) {
    static int grid = 0;
    if (grid == 0) {
        if (n_in != 26 || out_size != NT * DM || ws_size < WS_END) { fprintf(stderr, "kernel_launch: unexpected problem (n_in %d out %d ws %zu need %zu)\n", n_in, out_size, ws_size, (size_t)WS_END); grid = -1; return; }
        int dev = 0, cus = 0, per_cu = 0;
        if (hipGetDevice(&dev) != hipSuccess || hipDeviceGetAttribute(&cus, hipDeviceAttributeMultiprocessorCount, dev) != hipSuccess) { grid = -1; return; }
        if (hipFuncSetAttribute((const void*)mega, hipFuncAttributeMaxDynamicSharedMemorySize, LDS_BYTES) != hipSuccess) { fprintf(stderr, "kernel_launch: hipFuncSetAttribute failed\n"); grid = -1; return; }
        if (hipOccupancyMaxActiveBlocksPerMultiprocessor(&per_cu, (const void*)mega, NTHR, LDS_BYTES) != hipSuccess || per_cu < 1) fprintf(stderr, "kernel_launch: occupancy query reports %d\n", per_cu);
        (void)hipGetLastError();
        if (cus < 256) { fprintf(stderr, "kernel_launch: this kernel is built for a 256-CU device (one resident workgroup per CU), found %d CUs; nothing launched\n", cus); grid = -1; return; }
        grid = 256;
    }
    if (grid < 0) return;
    if (hipMemsetAsync((char*)d_ws + WS_CTL, 0, CTL_ZERO_BYTES, stream) != hipSuccess) return;
    Args a{};
    for (int i = 0; i < 26; ++i) a.in[i] = (const float*)d_in[i];
    a.out = (float*)d_out; a.ws = (unsigned char*)d_ws;
    a.ph_lo = 0; a.ph_hi = N_PHASES;
    hipLaunchKernelGGL(mega, dim3(grid), dim3(NTHR), LDS_BYTES, stream, a);
}
```

```cpp
#include <hip/hip_runtime.h>
#include <cstdio>
#include <cstdint>


#define GAS __attribute__((address_space(1)))
#define LAS __attribute__((address_space(3)))
typedef unsigned short bf16;
typedef unsigned v4u __attribute__((ext_vector_type(4)));
typedef unsigned v2u __attribute__((ext_vector_type(2)));
typedef float f32x4 __attribute__((ext_vector_type(4)));
typedef short bf16x8 __attribute__((ext_vector_type(8)));
typedef GAS unsigned gu32;
#define RLX_AGENT __ATOMIC_RELAXED, __HIP_MEMORY_SCOPE_AGENT
#define LDS_WAIT() asm volatile("s_waitcnt lgkmcnt(0)" ::: "memory")
#define VM_WAIT() asm volatile("s_waitcnt vmcnt(0)" ::: "memory")

constexpr int NT = 32768, DM = 1024, SEQ = 4096, NB = 8;
constexpr int MEM_ROWS = 2048;
constexpr int A0_LD = 1792;
constexpr int A1_LD = 2048;
constexpr int FF0 = 2816, FFE = 3584, NEXP = 8;
constexpr int SLOT_CAP = 34816;
constexpr float EPS = 1e-6f;
constexpr int NWAVES = 8, NTHR = 512;

constexpr size_t MiB = 1u << 20;
constexpr size_t WS_CTL = 0, CTL_ZERO_BYTES = 1 * MiB;
constexpr size_t WS_RSS = 1 * MiB;
constexpr size_t WS_MRSS = 3 * MiB;
constexpr size_t WS_CNT = 3 * MiB + 256 * 1024;
constexpr size_t WS_TOPI = 3 * MiB + 512 * 1024;
constexpr size_t WS_TOPW = 3 * MiB + 768 * 1024;
constexpr size_t WS_STOK = 4 * MiB;
constexpr size_t WS_SW = 4 * MiB + 512 * 1024;
constexpr size_t WS_BLK = 5 * MiB;
constexpr size_t WS_RSTD = 5 * MiB + 64 * 1024;
constexpr size_t WS_S0TAB = 5 * MiB + 512 * 1024;
constexpr size_t WS_RPB2 = 5 * MiB + 768 * 1024;
constexpr size_t WS_W0IN = 6 * MiB;
constexpr size_t WS_WV0 = WS_W0IN + 1792 * 2048;
constexpr size_t WS_W0OUT = 11 * MiB;
constexpr size_t WS_W0GU = 13 * MiB;
constexpr size_t WS_W0DN = 24 * MiB;
constexpr size_t WS_WMEM = WS_W0DN + 1024 * 2816 * 2;
constexpr size_t WS_W1IN = 31 * MiB;
constexpr size_t WS_WV1 = 35 * MiB;
constexpr size_t WS_W1OUT = 37 * MiB - 512 * 1024;
constexpr size_t WS_HBF = 39 * MiB;
constexpr size_t WS_MEMBF = 103 * MiB;
constexpr size_t WS_MEMK = 107 * MiB;
constexpr size_t WS_MEMVT = 108 * MiB;
constexpr size_t WS_ACT = 109 * MiB;
constexpr size_t WS_ACT0 = WS_ACT;
constexpr size_t WS_V0T = WS_ACT + 112 * MiB;
constexpr size_t WS_MIX = WS_ACT + 176 * MiB;
constexpr size_t WS_HMID0 = WS_ACT;
constexpr size_t WS_ACT1 = WS_ACT;
constexpr size_t WS_V1T = WS_ACT + 128 * MiB;
constexpr size_t WS_OF = WS_ACT + 240 * MiB;
constexpr size_t WS_OB = WS_ACT + 288 * MiB;
constexpr size_t WS_GQT = WS_ACT + 336 * MiB;
constexpr size_t WS_GKDT0 = WS_ACT + 384 * MiB;
constexpr size_t WS_GKDT1 = 6 * MiB;
constexpr size_t OUT_GKT = 0, OUT_GDEC = 48 * MiB, OUT_WGU = 52 * MiB;
constexpr size_t WS_E = WS_ACT + 336 * MiB;
constexpr size_t WS_HT1 = 6 * MiB;
constexpr size_t WS_YB = WS_ACT + 240 * MiB;
constexpr size_t WS_YA = WS_ACT + 128 * MiB;
constexpr size_t WS_HMID1 = WS_ACT;
constexpr size_t WS_WGU = WS_ACT + 240 * MiB;
constexpr size_t WS_WDN = WS_ACT + 352 * MiB;
constexpr size_t WS_END = WS_ACT + 408 * MiB;
static_assert(WS_W1OUT + 2 * MiB <= WS_HBF && WS_WV1 + 768 * 2048 <= WS_W1OUT && WS_W1IN + 4 * MiB <= WS_WV1 && WS_WMEM + MiB <= WS_W1IN, "weight map");
static_assert(WS_W0GU + 11 * MiB <= WS_W0DN && WS_WV0 + 768 * 2048 <= WS_W0OUT, "weight map 2");
static_assert((size_t)SLOT_CAP * 3584 * 2 <= 240 * MiB, "hmid1");

constexpr int CW_TMO = 0, CW_CODE = 1, CW_BAR = 4096;

constexpr int RING_BYTES = 131072;
constexpr int LDSCTL_OFF = 155648, MISC_OFF = LDSCTL_OFF + 320;
constexpr int LDS_BYTES = 156672;

typedef float f32x2_t __attribute__((ext_vector_type(2)));
typedef __bf16 bf16x2_t __attribute__((ext_vector_type(2)));
__device__ __forceinline__ unsigned pk2(float lo, float hi) { const f32x2_t v = {lo, hi}; const bf16x2_t b = __builtin_convertvector(v, bf16x2_t); return __builtin_bit_cast(unsigned, b); }
__device__ __forceinline__ unsigned f2bf(float f) { return pk2(f, 0.f) & 0xffffu; }
__device__ __forceinline__ float bf2f(bf16 b) { return __builtin_bit_cast(float, (unsigned)b << 16); }
__device__ __forceinline__ float bflo(unsigned u) { return __builtin_bit_cast(float, u << 16); }
__device__ __forceinline__ float bfhi(unsigned u) { return __builtin_bit_cast(float, u & 0xffff0000u); }
__device__ __forceinline__ float wave_sum(float v) {
#pragma unroll
    for (int o = 1; o < 64; o <<= 1) v += __shfl_xor(v, o);
    return v;
}
__device__ __forceinline__ float wave_max(float v) {
#pragma unroll
    for (int o = 1; o < 64; o <<= 1) v = fmaxf(v, __shfl_xor(v, o));
    return v;
}

__device__ __forceinline__ int lane_id() { unsigned z = 0u; asm volatile("" : "+v"(z)); return (int)__builtin_amdgcn_mbcnt_hi(0xffffffffu, __builtin_amdgcn_mbcnt_lo(0xffffffffu, z)); }
#define XB_TMO      128
#define XB_XCNT(j)  (256  + 64 * (j))
#define XB_XSUB(j)  (1280 + 64 * (j))
#define XB_XGEN(j)  (2304 + 64 * (j))
#define XB_TOP      3328
#define XB_TOPGEN   3392
#define XCD_BAR_WORDS 3456
#define XB_SPIN_CAP (1u << 22)

__device__ __forceinline__ unsigned xb_ld(unsigned* p)              { return __hip_atomic_load(p, __ATOMIC_RELAXED, __HIP_MEMORY_SCOPE_AGENT); }
__device__ __forceinline__ unsigned xb_add(unsigned* p, unsigned v) { return __hip_atomic_fetch_add(p, v, __ATOMIC_RELAXED, __HIP_MEMORY_SCOPE_AGENT); }
__device__ __forceinline__ unsigned xb_xcc_id() { return (unsigned)__builtin_amdgcn_s_getreg((3 << 11) | 20) & 0xFu; }
#define XB_SPIN(cond, bar) do { unsigned _sp = 0; while (cond) { __builtin_amdgcn_s_sleep(1); \
    if ((++_sp & 255u) == 0u) { if (xb_ld(&(bar)[XB_TMO])) break; if (_sp > XB_SPIN_CAP) { atomicAdd(&(bar)[XB_TMO], 1u); break; } } } } while (0)

struct XcdBarrier { unsigned* bar; unsigned x; volatile LAS unsigned* st; int w0; };

__device__ __forceinline__ XcdBarrier xcd_barrier_post(unsigned* bar, volatile LAS unsigned* st, int wave) {
    XcdBarrier b; b.bar = bar; b.x = xb_xcc_id(); b.st = st; b.w0 = (wave == 0) ? 1 : 0;
    if (b.w0 && lane_id() == 0) (void)xb_add(&bar[XB_XCNT(b.x)], 1u);
    return b;
}
__device__ __forceinline__ void xcd_barrier_complete(unsigned* bar, unsigned x, unsigned& nloc, unsigned& nx) {
    const unsigned G = gridDim.x * gridDim.y * gridDim.z;
    unsigned sum, cnt, mine, sp = 0u;
    for (;;) {
        sum = 0u; cnt = 0u; mine = 0u;
#pragma unroll
        for (unsigned j = 0; j < 16; ++j) { const unsigned c = xb_ld(&bar[XB_XCNT(j)]); sum += c; cnt += (c > 0u) ? 1u : 0u; mine = (j == x) ? c : mine; }
        if (sum == G) break;
        __builtin_amdgcn_s_sleep(1);
        if ((++sp & 255u) == 0u) { if (xb_ld(&bar[XB_TMO])) break; if (sp > XB_SPIN_CAP) { atomicAdd(&bar[XB_TMO], 1u); break; } }
    }
    nloc = mine > 0u ? mine : 1u; nx = cnt > 0u ? cnt : 1u;
}
__device__ __forceinline__ void xcd_barrier(const XcdBarrier& b) {
    asm volatile("s_waitcnt vmcnt(0)" ::: "memory");
    __syncthreads();
    if (b.w0 && lane_id() == 0) {
        unsigned* bar = b.bar;
        __builtin_amdgcn_s_waitcnt(0);
        unsigned nloc = b.st[0], nx = b.st[1];
        if (nloc == 0u) { xcd_barrier_complete(bar, b.x, nloc, nx); b.st[0] = nloc; b.st[1] = nx; }
        const unsigned old = xb_add(&bar[XB_XSUB(b.x)], 1u);
        const unsigned gen = old / nloc;
        if (old + 1u == (gen + 1u) * nloc) {
            __builtin_amdgcn_fence(__ATOMIC_RELEASE, "agent");
            asm volatile("s_waitcnt vmcnt(0)" ::: "memory");
            const unsigned og = xb_add(&bar[XB_TOP], 1u);
            const unsigned tg = og / nx;
            if (og + 1u == (tg + 1u) * nx) xb_add(&bar[XB_TOPGEN], 1u);
            else XB_SPIN(xb_ld(&bar[XB_TOPGEN]) == tg, bar);
            __builtin_amdgcn_fence(__ATOMIC_ACQUIRE, "agent");
            xb_add(&bar[XB_XGEN(b.x)], 1u);
            asm volatile("s_waitcnt vmcnt(0)" ::: "memory");
        } else {
            XB_SPIN(xb_ld(&bar[XB_XGEN(b.x)]) == gen, bar);
            __builtin_amdgcn_fence(__ATOMIC_ACQUIRE, "agent");
            asm volatile("s_waitcnt vmcnt(0)" ::: "memory");
        }
    }
    __syncthreads();
}

struct Args { const float* in[26]; float* out; unsigned char* ws; int ph_lo, ph_hi; };
enum { I_X = 0, I_MEM, I_EN1, I_EWIN, I_RPB, I_EWOUT, I_EN2, I_EWG, I_EWU, I_EWD, I_ON1, I_OWIN, I_WGKF, I_BGKF, I_WGKB, I_BGKB, I_GNORM, I_OWOUT, I_ON2, I_WR, I_OWG, I_OWU, I_OWD, I_MNORM, I_WMKV, I_FNORM };

#define LANE() lane_id()
#define TID() ((F.wave << 6) | lane_id())
struct Frame {
    LAS unsigned char* lds;
    int wave, G, bid;
    int gw, NGW;
    unsigned char* ws;
};

constexpr float QSCALE = 0.125f * 1.4426950408889634f;
struct CvtJob { const float* W; int K, N; bf16* WT; const float* gain; int kind; };
__device__ __forceinline__ bool cvt_map(int kind, int n0, int& drow, float& scale) {
    scale = 1.0f;
    switch (kind) {
    case 0: drow = n0; return true;
    case 1: if (n0 < 768) { drow = n0; scale = QSCALE; return true; } if (n0 < 1536) { drow = n0; return true; } if (n0 >= 2304) { drow = n0 - 768; scale = QSCALE; return true; } return false;
    case 2: if (n0 >= 1536 && n0 < 2304) { drow = n0 - 1536; return true; } return false;
    case 3: drow = (n0 >> 7) * 256 + (n0 & 127); return true;
    case 4: drow = (n0 >> 7) * 256 + 128 + (n0 & 127); return true;
    case 5: if (n0 < 768) { drow = n0; return true; } if (n0 < 1536) return false; if (n0 < 2304) { drow = n0 - 768; return true; }
            if (n0 < 2336) { drow = n0 - 512; return true; } drow = n0 - 800; scale = QSCALE; return true;
    case 6: if (n0 >= 768 && n0 < 1536) { drow = n0 - 768; return true; } return false;
    default: drow = n0; return true;
    }
}
__device__ __forceinline__ unsigned pk4_fp8(float a, float b, float c, float d) { a = __builtin_amdgcn_fmed3f(a, -448.f, 448.f); b = __builtin_amdgcn_fmed3f(b, -448.f, 448.f); c = __builtin_amdgcn_fmed3f(c, -448.f, 448.f); d = __builtin_amdgcn_fmed3f(d, -448.f, 448.f);
    unsigned w = 0u; w = (unsigned)__builtin_amdgcn_cvt_pk_fp8_f32(a, b, (int)w, false); w = (unsigned)__builtin_amdgcn_cvt_pk_fp8_f32(c, d, (int)w, true); return w; }
struct CvtRegs { f32x4 v[8]; const float* gain; bf16* WT; int K, k0, drow, valid; float scale; };
__device__ __forceinline__ void cvt_load(CvtRegs& R, const CvtJob& J, int item, int lane) {
    const int nblk = J.N / 32, kb = item / nblk, nb = item % nblk, n0 = nb * 32;
    R.k0 = kb * 64; R.gain = J.gain; R.WT = J.WT; R.K = J.K;
    R.valid = cvt_map(J.kind, n0, R.drow, R.scale) ? 1 : 0;
    if (R.valid) { const float* p = J.W + (size_t)(R.k0 + 2 * (lane >> 3)) * J.N + n0 + 4 * (lane & 7);
#pragma unroll
        for (int j = 0; j < 8; ++j) R.v[j] = *(const f32x4*)(p + (size_t)(16 * (j >> 1) + (j & 1)) * J.N); }
}
__device__ __forceinline__ void cvt_load8(CvtRegs& R, const CvtJob& J, int item, int lane) {
    const int nblk = J.N / 32, kb = item / nblk, nb = item % nblk, n0 = nb * 32;
    R.k0 = kb * 64; R.gain = J.gain; R.WT = J.WT; R.K = J.K;
    R.valid = cvt_map(J.kind, n0, R.drow, R.scale) ? 1 : 0;
    if (R.valid) { const float* p = J.W + (size_t)(R.k0 + 4 * (lane >> 3)) * J.N + n0 + 4 * (lane & 7);
#pragma unroll
        for (int j = 0; j < 8; ++j) R.v[j] = *(const f32x4*)(p + (size_t)(32 * (j >> 2) + (j & 3)) * J.N); }
}
__device__ __forceinline__ void cvt_finish8(const CvtRegs& R, LAS unsigned* T, int lane, float mul) {
    if (!R.valid) return;
    const int nq = lane & 7, kr = lane >> 3;
#pragma unroll
    for (int p = 0; p < 2; ++p) { const int k = R.k0 + 32 * p + 4 * kr; float g[4];
#pragma unroll
        for (int q = 0; q < 4; ++q) g[q] = R.scale * mul * (R.gain ? R.gain[k + q] : 1.0f);
        const f32x4 a = R.v[4 * p], b = R.v[4 * p + 1], c = R.v[4 * p + 2], d = R.v[4 * p + 3]; LAS unsigned* t = T + (4 * nq) * 17 + 8 * p + kr;
        t[0] = pk4_fp8(a.x * g[0], b.x * g[1], c.x * g[2], d.x * g[3]); t[17] = pk4_fp8(a.y * g[0], b.y * g[1], c.y * g[2], d.y * g[3]);
        t[34] = pk4_fp8(a.z * g[0], b.z * g[1], c.z * g[2], d.z * g[3]); t[51] = pk4_fp8(a.w * g[0], b.w * g[1], c.w * g[2], d.w * g[3]); }
    LDS_WAIT(); asm volatile("" ::: "memory");
#pragma unroll
    for (int r = 0; r < 2; ++r) { const int n = (lane >> 2) + 16 * r, c = lane & 3; const LAS unsigned* sp = T + n * 17 + 4 * c;
        v4u o; o.x = sp[0]; o.y = sp[1]; o.z = sp[2]; o.w = sp[3];
        *(GAS v4u*)((unsigned char*)R.WT + (size_t)(R.drow + n) * R.K + R.k0 + 16 * c) = o; }
    LDS_WAIT(); asm volatile("" ::: "memory");
}
__device__ __forceinline__ void cvt_finish(const CvtRegs& R, LAS unsigned* T, int lane) {
    if (!R.valid) return;
    const int nq = lane & 7, kr = lane >> 3;
#pragma unroll
    for (int p = 0; p < 4; ++p) { const int k = R.k0 + 16 * p + 2 * kr; float g0 = R.scale, g1 = R.scale; if (R.gain) { g0 *= R.gain[k]; g1 *= R.gain[k + 1]; }
        const f32x4 a = R.v[2 * p], b = R.v[2 * p + 1]; LAS unsigned* t = T + (4 * nq) * 33 + 8 * p + kr;
        t[0] = pk2(a.x * g0, b.x * g1); t[33] = pk2(a.y * g0, b.y * g1); t[66] = pk2(a.z * g0, b.z * g1); t[99] = pk2(a.w * g0, b.w * g1); }
    LDS_WAIT(); asm volatile("" ::: "memory");
#pragma unroll
    for (int r = 0; r < 4; ++r) { const int n = (lane >> 3) + 8 * r, c = lane & 7; const LAS unsigned* sp = T + n * 33 + 4 * c;
        v4u o; o.x = sp[0]; o.y = sp[1]; o.z = sp[2]; o.w = sp[3];
        *(GAS v4u*)(R.WT + (size_t)(R.drow + n) * R.K + R.k0 + 8 * c) = o; }
    LDS_WAIT(); asm volatile("" ::: "memory");
}
__device__ __forceinline__ void rows_to_bf16(const float* X, bf16* Ob, float* rstd, int first, int nrows, int stride, int lane) {
    for (int m = first; m < nrows; m += 2 * stride) {
        const int m2 = m + stride; const bool h2 = m2 < nrows;
        const GAS f32x4* xa = (const GAS f32x4*)(X + (size_t)m * DM) + lane; const GAS f32x4* xb = (const GAS f32x4*)(X + (size_t)(h2 ? m2 : m) * DM) + lane;
        f32x4 va[4], vb[4];
#pragma unroll
        for (int j = 0; j < 4; ++j) va[j] = xa[64 * j];
#pragma unroll
        for (int j = 0; j < 4; ++j) vb[j] = xb[64 * j];
        float sa = 0.f, sb = 0.f;
#pragma unroll
        for (int j = 0; j < 4; ++j) { sa += (va[j].x * va[j].x + va[j].y * va[j].y) + (va[j].z * va[j].z + va[j].w * va[j].w); sb += (vb[j].x * vb[j].x + vb[j].y * vb[j].y) + (vb[j].z * vb[j].z + vb[j].w * vb[j].w); }
        sa = wave_sum(sa); sb = wave_sum(sb);
        GAS unsigned long long* oa = (GAS unsigned long long*)(Ob + (size_t)m * DM) + lane;
#pragma unroll
        for (int j = 0; j < 4; ++j) oa[64 * j] = (unsigned long long)pk2(va[j].x, va[j].y) | ((unsigned long long)pk2(va[j].z, va[j].w) << 32);
        if (lane == 0) rstd[m] = __builtin_amdgcn_rsqf(sa * (1.0f / DM) + EPS);
        if (h2) { GAS unsigned long long* ob = (GAS unsigned long long*)(Ob + (size_t)m2 * DM) + lane;
#pragma unroll
            for (int j = 0; j < 4; ++j) ob[64 * j] = (unsigned long long)pk2(vb[j].x, vb[j].y) | ((unsigned long long)pk2(vb[j].z, vb[j].w) << 32);
            if (lane == 0) rstd[m2] = __builtin_amdgcn_rsqf(sb * (1.0f / DM) + EPS); }
    }
}

struct Unit { int pm, pn; };
struct Sched {
    int nM, nN, nwg, G, c, K, ld, off0, off1, per;
    const char* A; const char* B; const int* bexp; size_t estride;
    __device__ void init(const void* A_, const void* B_, int K_, int nM_, int nN_, int G_, int c_, const int* bexp_ = nullptr, size_t estride_ = 0) {
        A = (const char*)A_; B = (const char*)B_; K = K_; ld = K_; nM = nM_; nN = nN_; nwg = nM * nN; G = G_; c = c_; bexp = bexp_; estride = estride_; off0 = 0; off1 = 0x7fffffff; per = G_ / 8; }
    __device__ void range(int off0_, int off1_, int per_) { off0 = off0_; off1 = off1_; per = per_; }
    __device__ bool next(int i, Unit& u) const {
        const int q = nwg / 8, r = nwg % 8, xcd = c % 8, slot = c / 8, lt = (int)((unsigned)(xcd - r) >> 31), qx = q + lt;
        if (slot >= per) return false;
        const int off = off0 + i * per + slot, lim = off1 < qx ? off1 : qx;
        if (off >= lim) return false;
        const int wgid = xcd * q + (lt ? xcd : r) + off;
        const int nig = 8 * nN, gid = wgid / nig, fm = gid * 8, gsz = (nM - fm) < 8 ? (nM - fm) : 8;
        u.pm = fm + ((wgid % nig) % gsz); u.pn = (wgid % nig) / gsz; return true;
    }
    __device__ const char* a_base(const Unit& u) const { return A + (size_t)u.pm * 512 * ld; }
    __device__ const char* b_base(const Unit& u) const { return B + (bexp ? (size_t)bexp[u.pm] * estride : (size_t)0) + (size_t)u.pn * 512 * ld; }
};

struct NoAux {};
__device__ __forceinline__ float rstd_from(const float* rss16) {
    const f32x4* p = (const f32x4*)rss16; f32x4 a = p[0], b = p[1], c = p[2], d = p[3];
    const float s = ((a.x + a.y) + (a.z + a.w)) + ((b.x + b.y) + (b.z + b.w)) + ((c.x + c.y) + (c.z + c.w)) + ((d.x + d.y) + (d.z + d.w));
    return __builtin_amdgcn_rsqf(s * (1.0f / DM) + EPS);
}
__device__ __forceinline__ float rstd_from_lds(const LAS float* rss16) {
    const LAS f32x4* p = (const LAS f32x4*)rss16; f32x4 a = p[0], b = p[1], c = p[2], d = p[3];
    const float s = ((a.x + a.y) + (a.z + a.w)) + ((b.x + b.y) + (b.z + b.w)) + ((c.x + c.y) + (c.z + c.w)) + ((d.x + d.y) + (d.z + d.w));
    return __builtin_amdgcn_rsqf(s * (1.0f / DM) + EPS);
}
constexpr int RSS_LDS_REL = 2048;
struct RowCtx { float rs[2][4]; };
template <bool RSS = false> struct EpiRowScaleT {
    static constexpr bool NEED_SS = false; static constexpr int SC_MODE = RSS ? 5 : 1; typedef RowCtx Ctx; typedef NoAux Aux;
    bf16* O; int ldc; const float* sc_src; float mul;
    __device__ __forceinline__ void begin(Ctx& c, const LAS float* sc, const LAS int*, int lr0, int, int, int) const {
#pragma unroll
        for (int ai = 0; ai < 2; ++ai)
#pragma unroll
            for (int m = 0; m < 4; ++m) c.rs[ai][m] = sc[ai * 128 + lr0 + m * 16] * mul;
    }
    __device__ __forceinline__ void load_aux(Aux&, const Ctx&, int, int, int, int, int) const {}
    __device__ __forceinline__ float apply(const Ctx& c, const Aux&, int ai, int m, int row, int pn, int c128, const float (&a)[8], const float (&b)[8]) const {
        const float s = c.rs[ai][m];
        bf16* p = O + (size_t)row * ldc + pn * 256 + c128;
        v4u w; w.x = pk2(a[0] * s, a[1] * s); w.y = pk2(a[2] * s, a[3] * s); w.z = pk2(a[4] * s, a[5] * s); w.w = pk2(a[6] * s, a[7] * s); *(v4u*)p = w;
        w.x = pk2(b[0] * s, b[1] * s); w.y = pk2(b[2] * s, b[3] * s); w.z = pk2(b[4] * s, b[5] * s); w.w = pk2(b[6] * s, b[7] * s); *(v4u*)(p + 128) = w;
        return 0.f;
    }
    __device__ __forceinline__ void row_done(int, int, int, float) const {}
};
typedef EpiRowScaleT<false> EpiRowScale;
struct ColCtx { float sa[8], sb[8]; };
template <bool RSS = false> struct EpiColScaleT {
    static constexpr bool NEED_SS = false; static constexpr int SC_MODE = RSS ? 6 : 2; typedef ColCtx Ctx; typedef NoAux Aux;
    bf16* O; int ldc; const float* sc_src;
    __device__ __forceinline__ void begin(Ctx& c, const LAS float* sc, const LAS int*, int, int, int, int c128) const {
#pragma unroll
        for (int j = 0; j < 8; ++j) { c.sa[j] = sc[c128 + j]; c.sb[j] = sc[128 + c128 + j]; }
    }
    __device__ __forceinline__ void load_aux(Aux&, const Ctx&, int, int, int, int, int) const {}
    __device__ __forceinline__ float apply(const Ctx& c, const Aux&, int, int, int row, int pn, int c128, const float (&a)[8], const float (&b)[8]) const {
        bf16* p = O + (size_t)row * ldc + pn * 256 + c128;
        v4u w; w.x = pk2(a[0] * c.sa[0], a[1] * c.sa[1]); w.y = pk2(a[2] * c.sa[2], a[3] * c.sa[3]); w.z = pk2(a[4] * c.sa[4], a[5] * c.sa[5]); w.w = pk2(a[6] * c.sa[6], a[7] * c.sa[7]); *(v4u*)p = w;
        w.x = pk2(b[0] * c.sb[0], b[1] * c.sb[1]); w.y = pk2(b[2] * c.sb[2], b[3] * c.sb[3]); w.z = pk2(b[4] * c.sb[4], b[5] * c.sb[5]); w.w = pk2(b[6] * c.sb[6], b[7] * c.sb[7]); *(v4u*)(p + 128) = w;
        return 0.f;
    }
    __device__ __forceinline__ void row_done(int, int, int, float) const {}
};
typedef EpiColScaleT<false> EpiColScale;
struct Aux4 { f32x4 v[4]; };
struct NoCtx {};
struct AuxR { f32x4 v[4]; };
struct AuxB { v4u a, b; };
__device__ __forceinline__ void unpack16(const AuxB& x, f32x4 (&v)[4]) {
    v[0] = (f32x4){bflo(x.a.x), bfhi(x.a.x), bflo(x.a.y), bfhi(x.a.y)}; v[1] = (f32x4){bflo(x.a.z), bfhi(x.a.z), bflo(x.a.w), bfhi(x.a.w)};
    v[2] = (f32x4){bflo(x.b.x), bfhi(x.b.x), bflo(x.b.y), bfhi(x.b.y)}; v[3] = (f32x4){bflo(x.b.z), bfhi(x.b.z), bflo(x.b.w), bfhi(x.b.w)}; }
template <bool F32> struct AuxSel { typedef AuxR T; };
template <> struct AuxSel<false> { typedef AuxB T; };
template <bool RF32> struct EpiResid {
    static constexpr bool NEED_SS = true; static constexpr int SC_MODE = 0; typedef NoCtx Ctx; typedef typename AuxSel<RF32>::T Aux;
    const float* R; bf16* HB; float* rss; bf16* HB2;
    __device__ __forceinline__ void begin(Ctx&, const LAS float*, const LAS int*, int, int, int, int) const {}
    __device__ __forceinline__ void load_aux(Aux& x, const Ctx&, int, int, int row, int pn, int c128) const {
        const size_t off = (size_t)row * DM + pn * 256 + c128;
        if constexpr (RF32) { const float* p = R + off; x.v[0] = *(const f32x4*)p; x.v[1] = *(const f32x4*)(p + 4); x.v[2] = *(const f32x4*)(p + 128); x.v[3] = *(const f32x4*)(p + 132); }
        else { x.a = *(const v4u*)(HB + off); x.b = *(const v4u*)(HB + off + 128); }
    }
    __device__ __forceinline__ float apply(const Ctx&, const Aux& xr, int, int, int row, int pn, int c128, const float (&a)[8], const float (&b)[8]) const {
        const size_t off = (size_t)row * DM + pn * 256 + c128;
        struct { f32x4 v[4]; } x; if constexpr (RF32) { x.v[0] = xr.v[0]; x.v[1] = xr.v[1]; x.v[2] = xr.v[2]; x.v[3] = xr.v[3]; } else unpack16(xr, x.v);
        const f32x4 h0 = {x.v[0].x + a[0], x.v[0].y + a[1], x.v[0].z + a[2], x.v[0].w + a[3]}, h1 = {x.v[1].x + a[4], x.v[1].y + a[5], x.v[1].z + a[6], x.v[1].w + a[7]};
        const f32x4 h2 = {x.v[2].x + b[0], x.v[2].y + b[1], x.v[2].z + b[2], x.v[2].w + b[3]}, h3 = {x.v[3].x + b[4], x.v[3].y + b[5], x.v[3].z + b[6], x.v[3].w + b[7]};
        v4u w; w.x = pk2(h0.x, h0.y); w.y = pk2(h0.z, h0.w); w.z = pk2(h1.x, h1.y); w.w = pk2(h1.z, h1.w); *(v4u*)(HB + off) = w; if (HB2) { v2u f; f.x = pk4_fp8(h0.x, h0.y, h0.z, h0.w); f.y = pk4_fp8(h1.x, h1.y, h1.z, h1.w); *(v2u*)((unsigned char*)HB2 + off) = f; }
        w.x = pk2(h2.x, h2.y); w.y = pk2(h2.z, h2.w); w.z = pk2(h3.x, h3.y); w.w = pk2(h3.z, h3.w); *(v4u*)(HB + off + 128) = w; if (HB2) { v2u f; f.x = pk4_fp8(h2.x, h2.y, h2.z, h2.w); f.y = pk4_fp8(h3.x, h3.y, h3.z, h3.w); *(v2u*)((unsigned char*)HB2 + off + 128) = f; }
        return ((h0.x * h0.x + h0.y * h0.y) + (h0.z * h0.z + h0.w * h0.w) + (h1.x * h1.x + h1.y * h1.y) + (h1.z * h1.z + h1.w * h1.w))
             + ((h2.x * h2.x + h2.y * h2.y) + (h2.z * h2.z + h2.w * h2.w) + (h3.x * h3.x + h3.y * h3.y) + (h3.z * h3.z + h3.w * h3.w));
    }
    __device__ __forceinline__ void row_done(int row, int pn, int wc, float ss) const { rss[(size_t)row * 16 + pn * 4 + wc] = ss; }
};
__device__ __forceinline__ float silu_mul(float g, float u) { return g * __builtin_amdgcn_rcpf(1.0f + __builtin_amdgcn_exp2f(g * -1.4426950408889634f)) * u; }
template <bool MOE, bool RSS = false> struct EpiSwiGLU {
    static constexpr bool NEED_SS = false; static constexpr int SC_MODE = MOE ? 3 : (RSS ? 5 : 1); typedef RowCtx Ctx; typedef NoAux Aux;
    bf16* Hm; int ldh; const float* sc_src; bf16* Hmt;
    __device__ __forceinline__ void begin(Ctx& c, const LAS float* sc, const LAS int* tl, int lr0, int, int, int) const {
#pragma unroll
        for (int ai = 0; ai < 2; ++ai)
#pragma unroll
            for (int m = 0; m < 4; ++m) { const int i = ai * 128 + lr0 + m * 16; float r = sc[i];
                if (MOE) { r *= 0.03125f; if (tl[i] < 0) r = 0.f; } c.rs[ai][m] = r; }
    }
    __device__ __forceinline__ void load_aux(Aux&, const Ctx&, int, int, int, int, int) const {}
    __device__ __forceinline__ float apply(const Ctx& c, const Aux&, int ai, int m, int row, int pn, int c128, const float (&a)[8], const float (&b)[8]) const {
        const float s = c.rs[ai][m], s2 = s * -1.4426950408889634f, iss = __builtin_amdgcn_rcpf(s * s); float o[8];
#pragma unroll
        for (int j = 0; j < 8; ++j) o[j] = (a[j] * b[j]) * __builtin_amdgcn_rcpf(__builtin_fmaf(__builtin_amdgcn_exp2f(a[j] * s2), iss, iss));
        v4u w; w.x = pk2(o[0], o[1]); w.y = pk2(o[2], o[3]); w.z = pk2(o[4], o[5]); w.w = pk2(o[6], o[7]);
        if constexpr (MOE) {
            unsigned char* rp = (row >= NT) ? (unsigned char*)Hmt + (size_t)(row - NT) * ldh : (unsigned char*)Hm + (size_t)row * ldh;
            v2u f; f.x = pk4_fp8(o[0], o[1], o[2], o[3]); f.y = pk4_fp8(o[4], o[5], o[6], o[7]); *(v2u*)(rp + pn * 128 + c128) = f;
        } else *(v4u*)(Hm + (size_t)row * ldh + pn * 128 + c128) = w;
        return 0.f;
    }
    __device__ __forceinline__ void row_done(int, int, int, float) const {}
};

namespace pg8 {
constexpr int HTB = 16384, TOK_OFF = 132096, SC_OFF = 134144;
__device__ __forceinline__ int lds_byte(int r, int c) { const int st = (r >> 4) * 2 + (c >> 5), rr = r & 15, cc = c & 31, ob = rr * 64 + cc * 2; return st * 1024 + (ob ^ (((ob >> 9) & 1) << 5)); }
__device__ __forceinline__ void stage_rc(int b, int& R, int& C) { const int st = b / 1024, sb = b % 1024, swz = sb ^ (((sb >> 9) & 1) << 5); R = (st >> 1) * 16 + swz / 64; C = (st & 1) * 32 + (swz % 64) / 2; }
__device__ __forceinline__ int perm32(int rho) { const int n = rho >> 4, i = rho & 15; return 8 * (i >> 2) + 4 * n + (i & 3); }

template <class Epi>
__device__ __forceinline__ void run_epi(const Epi& E, const f32x4 (&acc)[2][2][4][2], const Unit& u, int wr, int wc, int fr, int fq, const LAS float* sc, const LAS int* tlp) {
    int row0 = u.pm * 256 + wr * 64 + fr, c128 = 32 * wc + 8 * fq;
    asm volatile("" : "+v"(row0), "+v"(c128));
    typename Epi::Ctx ctx; E.begin(ctx, sc, tlp, wr * 64 + fr, row0, u.pn, c128);
#pragma unroll
    for (int ai = 0; ai < 2; ++ai) {
        typename Epi::Aux aux[4];
#pragma unroll
        for (int m = 0; m < 4; ++m) E.load_aux(aux[m], ctx, ai, m, row0 + ai * 128 + m * 16, u.pn, c128);
#pragma unroll
        for (int m = 0; m < 4; ++m) {
            const int row = row0 + ai * 128 + m * 16;
            float a[8], b[8];
#pragma unroll
            for (int j = 0; j < 8; ++j) { a[j] = acc[ai][0][m][j >> 2][j & 3]; b[j] = acc[ai][1][m][j >> 2][j & 3]; }
            float ss = E.apply(ctx, aux[m], ai, m, row, u.pn, c128, a, b);
            if (Epi::NEED_SS) { ss += __shfl_xor(ss, 16); ss += __shfl_xor(ss, 32); if (fq == 0) E.row_done(row, u.pn, wc, ss); }
        }
    }
}

typedef int v8i __attribute__((ext_vector_type(8)));
template <class Epi, bool GATHER, bool FP8 = false>
__device__ __forceinline__ void gemm_fast(LAS unsigned char* lds, const Sched& S, const Epi& E, const int* gtok, int wave_) {
    int tid = (wave_ << 6) | lane_id(); asm volatile("" : "+v"(tid));
    const int wid = __builtin_amdgcn_readfirstlane(tid >> 6), lane = tid & 63, wr = wid >> 2, wc = wid & 3, fr = lane & 15, fq = lane >> 4;
    const int K = S.ld, nt = S.K / 64;
    unsigned voffB[2], vA0[2], vA1[2], nA0[2], nA1[2]; int RA[2], CA2[2];
#pragma unroll
    for (int i = 0; i < 2; ++i) { int R, C; stage_rc(tid * 16 + i * 8192, R, C); const int Rb = (R & ~31) + perm32(R & 31);
        voffB[i] = (unsigned)(Rb * K + C) * 2u; RA[i] = R; CA2[i] = C * 2; vA0[i] = (unsigned)(R * K + C) * 2u; vA1[i] = vA0[i] + (unsigned)(128 * K * 2); nA0[i] = vA0[i]; nA1[i] = vA1[i]; }
    const size_t kstep = 128;
    const size_t hstep = (size_t)128 * K * 2;
    const unsigned ldsw = (unsigned)wid * 1024u;
    const int aoff = lds_byte(wr * 64 + fr, fq * 8), boff = lds_byte(wc * 32 + fr, fq * 8);
    LAS int* tl = (LAS int*)(lds + TOK_OFF);
#define PG8_SA(b, h) (((b) * 2 + (h)) * HTB)
#define PG8_SB(b, h) ((4 + (b) * 2 + (h)) * HTB)
#define PG8_STAGE(bufoff, gbase, voff) do { _Pragma("unroll") for (int _i = 0; _i < 2; ++_i) \
        __builtin_amdgcn_global_load_lds((const unsigned*)((const char*)(gbase) + (voff)[_i]), (LAS unsigned*)(lds + (bufoff) + ldsw + _i * 8192), 16, 0, 0); } while (0)
#define PG8_LDA(dst, b, h) do { _Pragma("unroll") for (int m = 0; m < 4; ++m) _Pragma("unroll") for (int k = 0; k < 2; ++k) dst[m][k] = *(const LAS bf16x8*)(lds + PG8_SA(b, h) + aoff + m * 2048 + k * 1024); } while (0)
#define PG8_LDB(dst, b, h) do { _Pragma("unroll") for (int n = 0; n < 2; ++n) _Pragma("unroll") for (int k = 0; k < 2; ++k) dst[n][k] = *(const LAS bf16x8*)(lds + PG8_SB(b, h) + boff + n * 2048 + k * 1024); } while (0)
#define PG8_MMA(ai, bj, At, Bt) do { __builtin_amdgcn_s_setprio(1); _Pragma("unroll") for (int m = 0; m < 4; ++m) _Pragma("unroll") for (int n = 0; n < 2; ++n) { \
        if constexpr (FP8) { const v8i b8_ = __builtin_bit_cast(v8i, __builtin_shufflevector(Bt[n][0], Bt[n][1], 0, 1, 2, 3, 4, 5, 6, 7, 8, 9, 10, 11, 12, 13, 14, 15)), a8_ = __builtin_bit_cast(v8i, __builtin_shufflevector(At[m][0], At[m][1], 0, 1, 2, 3, 4, 5, 6, 7, 8, 9, 10, 11, 12, 13, 14, 15)); \
            asm volatile("v_mfma_f32_16x16x128_f8f6f4 %0, %1, %2, %0" : "+v"(acc[ai][bj][m][n]) : "v"(b8_), "v"(a8_)); }     \
        else { _Pragma("unroll") for (int k = 0; k < 2; ++k) acc[ai][bj][m][n] = __builtin_amdgcn_mfma_f32_16x16x32_bf16(Bt[n][k], At[m][k], acc[ai][bj][m][n], 0, 0, 0); } } \
        __builtin_amdgcn_s_setprio(0); } while (0)
#define PG8_WAIT_V(n) asm volatile("s_waitcnt vmcnt(" #n ")" ::: "memory")
#define PG8_WAIT_L(n) asm volatile("s_waitcnt lgkmcnt(" #n ")" ::: "memory")
#define PG8_BAR __builtin_amdgcn_s_barrier()
#define PG8_SCHED __builtin_amdgcn_sched_barrier(0)
#define PG8_IDS_DMA(pm_, par_) do { if (wid < 4) __builtin_amdgcn_global_load_lds((const unsigned*)(gtok + (pm_) * 256 + wid * 64 + lane), (LAS unsigned*)(lds + TOK_OFF + (par_) * 1024 + wid * 256), 4, 0, 0); } while (0)
#define PG8_IDS_READ(d0, d1, par_) do { _Pragma("unroll") for (int _i = 0; _i < 2; ++_i) { int t0 = tl[(par_) * 256 + RA[_i]], t1 = tl[(par_) * 256 + 128 + RA[_i]]; t0 = t0 < 0 ? 0 : t0; t1 = t1 < 0 ? 0 : t1; \
        d0[_i] = (unsigned)t0 * (unsigned)(K * 2) + (unsigned)CA2[_i]; d1[_i] = (unsigned)t1 * (unsigned)(K * 2) + (unsigned)CA2[_i]; } } while (0)
    Unit cur, nxt; int ui = 0, par = 0;
    if (!S.next(0, cur)) return;
    f32x4 acc[2][2][4][2];
#pragma unroll
    for (int a = 0; a < 2; ++a)
#pragma unroll
        for (int b = 0; b < 2; ++b)
#pragma unroll
            for (int m = 0; m < 4; ++m)
#pragma unroll
                for (int n = 0; n < 2; ++n) acc[a][b][m][n] = (f32x4){0.f, 0.f, 0.f, 0.f};
    bf16x8 At[4][2], B0[2][2], B1[2][2];
    const char* cA = GATHER ? S.A : S.a_base(cur); const char* cB = S.b_base(cur);
    if constexpr (GATHER) { PG8_IDS_DMA(cur.pm, 0); PG8_WAIT_V(0); __syncthreads(); PG8_IDS_READ(vA0, vA1, 0); }
    PG8_STAGE(PG8_SB(0, 0), cB, voffB); PG8_STAGE(PG8_SB(0, 1), cB + hstep, voffB); PG8_STAGE(PG8_SA(0, 0), cA, vA0); PG8_STAGE(PG8_SA(0, 1), cA, vA1);
    if (wr == 1) PG8_BAR;
    PG8_WAIT_V(2); PG8_BAR;
    PG8_STAGE(PG8_SB(1, 0), cB + kstep, voffB); PG8_STAGE(PG8_SA(1, 0), cA + kstep, vA0); PG8_STAGE(PG8_SB(1, 1), cB + hstep + kstep, voffB);
    PG8_WAIT_V(6); PG8_BAR;
    for (;;) {
        const bool has_next = S.next(ui + 1, nxt);
        const char* nA = has_next ? (GATHER ? S.A : S.a_base(nxt)) : cA; const char* nB = has_next ? S.b_base(nxt) : cB;
        for (int t = 0; t < nt; t += 2) {
            const bool last = (t == nt - 2);
            if constexpr (GATHER) {
                if (t == nt - 4 && has_next) PG8_IDS_DMA(nxt.pm, par ^ 1);
                if (last) { if (has_next) PG8_IDS_READ(nA0, nA1, par ^ 1); else { nA0[0] = vA0[0]; nA0[1] = vA0[1]; nA1[0] = vA1[0]; nA1[1] = vA1[1]; } }
            }
            if constexpr (Epi::SC_MODE == 5 || Epi::SC_MODE == 6) {
                if (last) { const float* src_ = E.sc_src + (size_t)(Epi::SC_MODE == 5 ? cur.pm : cur.pn) * 4096 + wid * 512 + lane * 4;
                    __builtin_amdgcn_global_load_lds((const unsigned*)src_, (LAS unsigned*)(lds + SC_OFF + RSS_LDS_REL + wid * 2048), 16, 0, 0);
                    __builtin_amdgcn_global_load_lds((const unsigned*)(src_ + 256), (LAS unsigned*)(lds + SC_OFF + RSS_LDS_REL + wid * 2048 + 1024), 16, 0, 0); }
            } else if constexpr (Epi::SC_MODE != 0) {
                if (last && wid < 4) { const int i_ = wid * 64 + lane; LAS unsigned* d_ = (LAS unsigned*)(lds + SC_OFF + wid * 256);
                    if constexpr (Epi::SC_MODE == 1) __builtin_amdgcn_global_load_lds((const unsigned*)(E.sc_src + cur.pm * 256 + i_), d_, 4, 0, 0);
                    if constexpr (Epi::SC_MODE == 2) __builtin_amdgcn_global_load_lds((const unsigned*)(E.sc_src + cur.pn * 256 + i_), d_, 4, 0, 0);
                    if constexpr (Epi::SC_MODE == 3) { int t_ = tl[par * 256 + i_]; t_ = t_ < 0 ? 0 : t_; __builtin_amdgcn_global_load_lds((const unsigned*)(E.sc_src + t_), d_, 4, 0, 0); }
                    if constexpr (Epi::SC_MODE == 4) { __builtin_amdgcn_global_load_lds((const unsigned*)(E.tok + cur.pm * 256 + i_), d_, 4, 0, 0);
                        __builtin_amdgcn_global_load_lds((const unsigned*)(E.w + cur.pm * 256 + i_), (LAS unsigned*)(lds + SC_OFF + 1024 + wid * 256), 4, 0, 0); } }
            }
            const char* a1 = cA + (size_t)(t + 1) * kstep;
            const char* a2 = last ? nA : cA + (size_t)(t + 2) * kstep; const char* b2 = last ? nB : cB + (size_t)(t + 2) * kstep;
            const char* a3 = a2 + kstep; const char* b3 = b2 + kstep;
            unsigned w0[2], w1[2];
            if (GATHER && last) { w0[0] = nA0[0]; w0[1] = nA0[1]; w1[0] = nA1[0]; w1[1] = nA1[1]; } else { w0[0] = vA0[0]; w0[1] = vA0[1]; w1[0] = vA1[0]; w1[1] = vA1[1]; }
            PG8_LDB(B0, 0, 0); PG8_LDB(B1, 0, 1); PG8_SCHED; PG8_LDA(At, 0, 0); PG8_STAGE(PG8_SA(1, 1), a1, vA1);
            PG8_WAIT_V(8); PG8_WAIT_L(0); PG8_BAR; PG8_MMA(0, 0, At, B0); PG8_MMA(0, 1, At, B1); PG8_BAR; PG8_SCHED;
            PG8_LDA(At, 0, 1); PG8_STAGE(PG8_SB(0, 0), b2, voffB); PG8_STAGE(PG8_SB(0, 1), b2 + hstep, voffB); PG8_STAGE(PG8_SA(0, 0), a2, w0);
            PG8_WAIT_V(8); PG8_WAIT_L(0); PG8_BAR; PG8_MMA(1, 0, At, B0); PG8_MMA(1, 1, At, B1); PG8_BAR; PG8_SCHED;
            PG8_LDB(B0, 1, 0); PG8_LDB(B1, 1, 1); PG8_SCHED; PG8_LDA(At, 1, 0); PG8_STAGE(PG8_SA(0, 1), a2, w1);
            PG8_WAIT_V(8); PG8_WAIT_L(0); PG8_BAR; PG8_MMA(0, 0, At, B0); PG8_MMA(0, 1, At, B1); PG8_BAR; PG8_SCHED;
            PG8_LDA(At, 1, 1); PG8_STAGE(PG8_SB(1, 0), b3, voffB); PG8_STAGE(PG8_SB(1, 1), b3 + hstep, voffB); PG8_STAGE(PG8_SA(1, 0), a3, w0);
            PG8_WAIT_V(8); PG8_WAIT_L(0); PG8_BAR; PG8_MMA(1, 0, At, B0); PG8_MMA(1, 1, At, B1); PG8_BAR; PG8_SCHED;
        }
        if constexpr (FP8) asm volatile("s_nop 15\n\ts_nop 15" ::: "memory");
        if (wr == 0) PG8_BAR;
        if constexpr (Epi::SC_MODE == 5 || Epi::SC_MODE == 6) {
            if (wid < 4) ((LAS float*)(lds + SC_OFF))[tid] = rstd_from_lds((const LAS float*)(lds + SC_OFF + RSS_LDS_REL) + tid * 16);
            PG8_WAIT_L(0); PG8_BAR;
        }
        run_epi(E, acc, cur, wr, wc, fr, fq, (const LAS float*)(lds + SC_OFF), (const LAS int*)(lds + TOK_OFF + par * 1024));
        if (!has_next) break;
#pragma unroll
        for (int a = 0; a < 2; ++a)
#pragma unroll
            for (int b = 0; b < 2; ++b)
#pragma unroll
                for (int m = 0; m < 4; ++m)
#pragma unroll
                    for (int n = 0; n < 2; ++n) acc[a][b][m][n] = (f32x4){0.f, 0.f, 0.f, 0.f};
        cur = nxt; cA = nA; cB = nB; ++ui;
        if constexpr (GATHER) { vA0[0] = nA0[0]; vA0[1] = nA0[1]; vA1[0] = nA1[0]; vA1[1] = nA1[1]; par ^= 1; }
        if (wr == 1) PG8_BAR;
    }
    PG8_WAIT_V(0);
    PG8_BAR;
#undef PG8_SA
#undef PG8_SB
#undef PG8_STAGE
#undef PG8_LDA
#undef PG8_LDB
#undef PG8_MMA
#undef PG8_WAIT_V
#undef PG8_WAIT_L
#undef PG8_BAR
#undef PG8_SCHED
#undef PG8_IDS_DMA
#undef PG8_IDS_READ
}
}

template <class Epi, bool GATHER, bool FP8 = false>
__device__ __forceinline__ void gemm_run(LAS unsigned char* lds, const Sched& S, const Epi& E, const int* gtok, int wave_) { pg8::gemm_fast<Epi, GATHER, FP8>(lds, S, E, gtok, wave_); }

typedef short s16x4 __attribute__((ext_vector_type(4)));
template <bool NA, bool KLDS = false, int VLDS = 0, int KRS = 64>
__device__ __forceinline__ void attn16(int lane, const bf16* Q, int ldq, const bf16* Kb, int ldk, const bf16* Vt, int ldv, int ktok0, int trs, bf16* O, int ldo,
                                       const LAS float* rpb_h, int r, int r0, int jb, int band0, const LAS unsigned char* Kl = nullptr, int arow0 = 0, const LAS unsigned char* Vl = nullptr, int kb0 = 0) {
    const int qi = lane & 15, g = lane >> 4;
    bf16x8 qf[2];
#pragma unroll
    for (int ks = 0; ks < 2; ++ks) qf[ks] = *(const bf16x8*)(Q + (size_t)qi * ldq + ks * 32 + 8 * g);
    f32x4 s[16];
    const int krow = 8 * (qi >> 2) + (qi & 3);
#pragma unroll
    for (int t = 0; t < 16; ++t) {
        bf16x8 k0, k1;
        if constexpr (KLDS) {
            const int kcol = kb0 + krow + 4 * (t & 1), swz = (((kcol >> 3) & 3) << 1) | ((kcol >> 1) & 1);
            const LAS unsigned char* kb = Kl + ((arow0 + (t >> 1)) * KRS + kcol) * 128;
            k0 = *(const LAS bf16x8*)(kb + ((g ^ swz) << 4)); k1 = *(const LAS bf16x8*)(kb + (((4 + g) ^ swz) << 4));
        } else {
            const bf16* kp = Kb + (size_t)(ktok0 + (t >> 1) * trs + krow + 4 * (t & 1)) * ldk + 8 * g;
            k0 = *(const bf16x8*)kp; k1 = *(const bf16x8*)(kp + 32);
        }
        f32x4 z = {0.f, 0.f, 0.f, 0.f};
        z = __builtin_amdgcn_mfma_f32_16x16x32_bf16(k0, qf[0], z, 0, 0, 0);
        z = __builtin_amdgcn_mfma_f32_16x16x32_bf16(k1, qf[1], z, 0, 0, 0);
        s[t] = z;
        if constexpr (KLDS) { if ((t & 3) == 3) __builtin_amdgcn_sched_barrier(0); }
    }
    bf16x8 vfa[VLDS ? 1 : 4][VLDS ? 1 : 8];
    if constexpr (!VLDS) {
#pragma unroll
        for (int mt = 0; mt < 4; ++mt)
#pragma unroll
            for (int kk = 0; kk < 8; ++kk) vfa[mt][kk] = *(const bf16x8*)(Vt + (size_t)(16 * mt + qi) * ldv + ktok0 + kk * trs + 8 * g);
        __builtin_amdgcn_sched_barrier(0);
    }
    float m = -INFINITY;
    if constexpr (NA) {
        const int qc = 16 * jb + qi, cs = min(max(qc - 8, 0), 48);
        const LAS float* bp = rpb_h + (r0 - r + 7) * 31 + (band0 + 8 * g - qc + 15);
        bool ok[2][4];
#pragma unroll
        for (int hh = 0; hh < 2; ++hh)
#pragma unroll
            for (int i = 0; i < 4; ++i) { const int kc = band0 + 8 * g + 4 * hh + i; ok[hh][i] = (kc >= cs) && (kc < cs + 16); }
#pragma unroll
        for (int tq = 0; tq < 4; ++tq) {
            float bv[4][4];
#pragma unroll
            for (int tt = 0; tt < 4; ++tt)
#pragma unroll
                for (int i = 0; i < 4; ++i) { const int t = 4 * tq + tt; bv[tt][i] = bp[(t >> 1) * 31 + 4 * (t & 1) + i]; }
#pragma unroll
            for (int tt = 0; tt < 4; ++tt)
#pragma unroll
                for (int i = 0; i < 4; ++i) asm volatile("" : "+v"(bv[tt][i]));
#pragma unroll
            for (int tt = 0; tt < 4; ++tt)
#pragma unroll
                for (int i = 0; i < 4; ++i) { const int t = 4 * tq + tt;
                    const float v = ok[t & 1][i] ? s[t][i] + bv[tt][i] : -INFINITY;
                    s[t][i] = v; m = fmaxf(m, v); }
        }
    } else {
#pragma unroll
        for (int t = 0; t < 16; ++t)
#pragma unroll
            for (int i = 0; i < 4; ++i) m = fmaxf(m, s[t][i]);
    }
    m = fmaxf(m, __shfl_xor(m, 16)); m = fmaxf(m, __shfl_xor(m, 32));
    float l = 0.f;
    bf16x8 pf[8];
#pragma unroll
    for (int kk = 0; kk < 8; ++kk) {
        float p[8];
#pragma unroll
        for (int i = 0; i < 4; ++i) { p[i] = __builtin_amdgcn_exp2f(s[2 * kk][i] - m); p[4 + i] = __builtin_amdgcn_exp2f(s[2 * kk + 1][i] - m); }
#pragma unroll
        for (int i = 0; i < 8; ++i) l += p[i];
        v4u w; w.x = pk2(p[0], p[1]); w.y = pk2(p[2], p[3]); w.z = pk2(p[4], p[5]); w.w = pk2(p[6], p[7]);
        pf[kk] = __builtin_bit_cast(bf16x8, w);
    }
    l += __shfl_xor(l, 16); l += __shfl_xor(l, 32);
    const float inv = __builtin_amdgcn_rcpf(l);
#pragma unroll
    for (int mt = 0; mt < 4; ++mt) {
        f32x4 acc = {0.f, 0.f, 0.f, 0.f};
#pragma unroll
        for (int kk = 0; kk < 8; ++kk) {
            bf16x8 vf; if constexpr (VLDS == 1) vf = *(const LAS bf16x8*)(Vl + (16 * mt + qi) * 512 + (((4 * kk + g) ^ qi) << 4));
            else if constexpr (VLDS == 2) vf = *(const LAS bf16x8*)(Vl + (16 * mt + qi) * 1200 + ((arow0 + kk) * 40 + kb0 + 8 * g) * 2);
            else vf = vfa[mt][kk];
            acc = __builtin_amdgcn_mfma_f32_16x16x32_bf16(vf, pf[kk], acc, 0, 0, 0);
        }
        v2u w; w.x = pk2(acc[0] * inv, acc[1] * inv); w.y = pk2(acc[2] * inv, acc[3] * inv);
        *(v2u*)(O + (size_t)qi * ldo + 16 * mt + 4 * g) = w;
        if constexpr (VLDS) __builtin_amdgcn_sched_barrier(0);
    }
}
template <bool NA, int VMODE, int KRS>
__device__ __forceinline__ void attn16_lds(int lane, const bf16* Q, int ldq, bf16* O, int ldo, const LAS float* rpb_h, int r, int r0, int jb, int band0,
                                           const LAS unsigned char* Kl, int arow0, const LAS unsigned char* Vl, int kb0) {
    const int qi = lane & 15, g = lane >> 4;
    bf16x8 qf[2];
#pragma unroll
    for (int ks = 0; ks < 2; ++ks) qf[ks] = *(const bf16x8*)(Q + (size_t)qi * ldq + ks * 32 + 8 * g);
    const int krow = 8 * (qi >> 2) + (qi & 3);
    const LAS unsigned char* kbase[2][2];
#pragma unroll
    for (int e = 0; e < 2; ++e) { const int kcol = kb0 + krow + 4 * e, swz = (((kcol >> 3) & 3) << 1) | ((kcol >> 1) & 1); const LAS unsigned char* rb = Kl + (arow0 * KRS + kcol) * 128;
        kbase[e][0] = rb + ((g ^ swz) << 4); kbase[e][1] = rb + (((4 + g) ^ swz) << 4); }
#define A16_KFR(t, hh) (*(const LAS bf16x8*)(kbase[(t) & 1][hh] + ((t) >> 1) * (KRS * 128)))
    const LAS unsigned char* vbase[VMODE == 1 ? 8 : 1];
    if constexpr (VMODE == 1) {
#pragma unroll
        for (int kk = 0; kk < 8; ++kk) vbase[kk] = Vl + qi * 512 + (((4 * kk + g) ^ qi) << 4);
    } else vbase[0] = Vl + qi * 1200 + (arow0 * 40 + kb0 + 8 * g) * 2;
#define A16_VFR(mt, kk) (VMODE == 1 ? *(const LAS bf16x8*)(vbase[VMODE == 1 ? (kk) : 0] + (mt) * 8192) : *(const LAS bf16x8*)(vbase[0] + (mt) * 19200 + (kk) * 80))
    f32x4 s[16];
    bf16x8 kb[2][4][2];
    float bv[NA ? 16 : 1][4];
    const LAS float* bp = nullptr;
    if constexpr (NA) { const int qc = 16 * jb + qi; bp = rpb_h + (r0 - r + 7) * 31 + (band0 + 8 * g - qc + 15); }
#pragma unroll
    for (int tt = 0; tt < 4; ++tt) { kb[0][tt][0] = A16_KFR(tt, 0); kb[0][tt][1] = A16_KFR(tt, 1); }
#pragma unroll
    for (int gi = 0; gi < 4; ++gi) {
        if (gi < 3) {
#pragma unroll
            for (int tt = 0; tt < 4; ++tt) { kb[(gi + 1) & 1][tt][0] = A16_KFR(4 * (gi + 1) + tt, 0); kb[(gi + 1) & 1][tt][1] = A16_KFR(4 * (gi + 1) + tt, 1); }
        } else if constexpr (NA) {
#pragma unroll
            for (int t = 0; t < 16; ++t)
#pragma unroll
                for (int i = 0; i < 4; ++i) bv[t][i] = bp[(t >> 1) * 31 + 4 * (t & 1) + i];
        }
        __builtin_amdgcn_sched_barrier(0);
#pragma unroll
        for (int tt = 0; tt < 4; ++tt) { const f32x4 z = {0.f, 0.f, 0.f, 0.f}; s[4 * gi + tt] = __builtin_amdgcn_mfma_f32_16x16x32_bf16(kb[gi & 1][tt][0], qf[0], z, 0, 0, 0); }
#pragma unroll
        for (int tt = 0; tt < 4; ++tt) s[4 * gi + tt] = __builtin_amdgcn_mfma_f32_16x16x32_bf16(kb[gi & 1][tt][1], qf[1], s[4 * gi + tt], 0, 0, 0);
        __builtin_amdgcn_sched_barrier(0);
    }
    bf16x8 vb[2][8];
#pragma unroll
    for (int kk = 0; kk < 8; ++kk) vb[0][kk] = A16_VFR(0, kk);
    __builtin_amdgcn_sched_barrier(0);
    float m = -INFINITY;
    if constexpr (NA) {
        const int qc = 16 * jb + qi, cs = min(max(qc - 8, 0), 48);
        bool ok[2][4];
#pragma unroll
        for (int hh = 0; hh < 2; ++hh)
#pragma unroll
            for (int i = 0; i < 4; ++i) { const int kc = band0 + 8 * g + 4 * hh + i; ok[hh][i] = (kc >= cs) && (kc < cs + 16); }
#pragma unroll
        for (int t = 0; t < 16; ++t)
#pragma unroll
            for (int i = 0; i < 4; ++i) asm volatile("" : "+v"(bv[t][i]));
#pragma unroll
        for (int t = 0; t < 16; ++t)
#pragma unroll
            for (int i = 0; i < 4; ++i) { const float v = ok[t & 1][i] ? s[t][i] + bv[t][i] : -INFINITY; s[t][i] = v; m = fmaxf(m, v); }
    } else {
#pragma unroll
        for (int t = 0; t < 16; ++t)
#pragma unroll
            for (int i = 0; i < 4; ++i) m = fmaxf(m, s[t][i]);
    }
    m = fmaxf(m, __shfl_xor(m, 16)); m = fmaxf(m, __shfl_xor(m, 32));
    float l = 0.f;
    bf16x8 pf[8];
#pragma unroll
    for (int kk = 0; kk < 8; ++kk) {
        float p[8];
#pragma unroll
        for (int i = 0; i < 4; ++i) { p[i] = __builtin_amdgcn_exp2f(s[2 * kk][i] - m); p[4 + i] = __builtin_amdgcn_exp2f(s[2 * kk + 1][i] - m); }
#pragma unroll
        for (int i = 0; i < 8; ++i) l += p[i];
        v4u w; w.x = pk2(p[0], p[1]); w.y = pk2(p[2], p[3]); w.z = pk2(p[4], p[5]); w.w = pk2(p[6], p[7]);
        pf[kk] = __builtin_bit_cast(bf16x8, w);
    }
    l += __shfl_xor(l, 16); l += __shfl_xor(l, 32);
    const float inv = __builtin_amdgcn_rcpf(l);
    __builtin_amdgcn_sched_barrier(0);
#pragma unroll
    for (int mt = 0; mt < 4; ++mt) {
        if (mt < 3) {
#pragma unroll
            for (int kk = 0; kk < 8; ++kk) vb[(mt + 1) & 1][kk] = A16_VFR(mt + 1, kk);
        }
        __builtin_amdgcn_sched_barrier(0);
        f32x4 a0 = {0.f, 0.f, 0.f, 0.f}, a1 = {0.f, 0.f, 0.f, 0.f};
#pragma unroll
        for (int kk = 0; kk < 8; kk += 2) { a0 = __builtin_amdgcn_mfma_f32_16x16x32_bf16(vb[mt & 1][kk], pf[kk], a0, 0, 0, 0); a1 = __builtin_amdgcn_mfma_f32_16x16x32_bf16(vb[mt & 1][kk + 1], pf[kk + 1], a1, 0, 0, 0); }
        v2u w; w.x = pk2((a0[0] + a1[0]) * inv, (a0[1] + a1[1]) * inv); w.y = pk2((a0[2] + a1[2]) * inv, (a0[3] + a1[3]) * inv);
        *(v2u*)(O + (size_t)qi * ldo + 16 * mt + 4 * g) = w;
        __builtin_amdgcn_sched_barrier(0);
    }
#undef A16_KFR
#undef A16_VFR
}
template <int KRS>
__device__ __forceinline__ void na_qk_sm(int lane, const bf16x8 (&qf)[2], const LAS float* rpb_h, int r, int r0, int jb, int band0, const LAS unsigned char* Kl, int arow0, int kb0, bf16x8 (&pf)[8], float& inv) {
    const int qi = lane & 15, g = lane >> 4;
    const int krow = 8 * (qi >> 2) + (qi & 3);
    const LAS unsigned char* kbase[2][2];
#pragma unroll
    for (int e = 0; e < 2; ++e) { const int kcol = kb0 + krow + 4 * e, swz = (((kcol >> 3) & 3) << 1) | ((kcol >> 1) & 1); const LAS unsigned char* rb = Kl + (arow0 * KRS + kcol) * 128;
        kbase[e][0] = rb + ((g ^ swz) << 4); kbase[e][1] = rb + (((4 + g) ^ swz) << 4); }
#define A16_KFR(t, hh) (*(const LAS bf16x8*)(kbase[(t) & 1][hh] + ((t) >> 1) * (KRS * 128)))
    f32x4 s[16];
    bf16x8 kb[2][4][2];
    float bv[16][4];
    const int qc = 16 * jb + qi;
    const LAS float* bp = rpb_h + (r0 - r + 7) * 31 + (band0 + 8 * g - qc + 15);
#pragma unroll
    for (int tt = 0; tt < 4; ++tt) { kb[0][tt][0] = A16_KFR(tt, 0); kb[0][tt][1] = A16_KFR(tt, 1); }
#pragma unroll
    for (int gi = 0; gi < 4; ++gi) {
        if (gi < 3) {
#pragma unroll
            for (int tt = 0; tt < 4; ++tt) { kb[(gi + 1) & 1][tt][0] = A16_KFR(4 * (gi + 1) + tt, 0); kb[(gi + 1) & 1][tt][1] = A16_KFR(4 * (gi + 1) + tt, 1); }
        } else {
#pragma unroll
            for (int t = 0; t < 16; ++t)
#pragma unroll
                for (int i = 0; i < 4; ++i) bv[t][i] = bp[(t >> 1) * 31 + 4 * (t & 1) + i];
        }
        __builtin_amdgcn_sched_barrier(0);
#pragma unroll
        for (int tt = 0; tt < 4; ++tt) { const f32x4 z = {0.f, 0.f, 0.f, 0.f}; s[4 * gi + tt] = __builtin_amdgcn_mfma_f32_16x16x32_bf16(kb[gi & 1][tt][0], qf[0], z, 0, 0, 0); }
#pragma unroll
        for (int tt = 0; tt < 4; ++tt) s[4 * gi + tt] = __builtin_amdgcn_mfma_f32_16x16x32_bf16(kb[gi & 1][tt][1], qf[1], s[4 * gi + tt], 0, 0, 0);
        __builtin_amdgcn_sched_barrier(0);
    }
#undef A16_KFR
    float m = -INFINITY;
    { const int cs = min(max(qc - 8, 0), 48);
      bool ok[2][4];
#pragma unroll
      for (int hh = 0; hh < 2; ++hh)
#pragma unroll
          for (int i = 0; i < 4; ++i) { const int kc = band0 + 8 * g + 4 * hh + i; ok[hh][i] = (kc >= cs) && (kc < cs + 16); }
#pragma unroll
      for (int t = 0; t < 16; ++t)
#pragma unroll
          for (int i = 0; i < 4; ++i) asm volatile("" : "+v"(bv[t][i]));
#pragma unroll
      for (int t = 0; t < 16; ++t)
#pragma unroll
          for (int i = 0; i < 4; ++i) { const float v = ok[t & 1][i] ? s[t][i] + bv[t][i] : -INFINITY; s[t][i] = v; m = fmaxf(m, v); } }
    m = fmaxf(m, __shfl_xor(m, 16)); m = fmaxf(m, __shfl_xor(m, 32));
    float l = 0.f;
#pragma unroll
    for (int kk = 0; kk < 8; ++kk) {
        float p[8];
#pragma unroll
        for (int i = 0; i < 4; ++i) { p[i] = __builtin_amdgcn_exp2f(s[2 * kk][i] - m); p[4 + i] = __builtin_amdgcn_exp2f(s[2 * kk + 1][i] - m); }
#pragma unroll
        for (int i = 0; i < 8; ++i) l += p[i];
        v4u w; w.x = pk2(p[0], p[1]); w.y = pk2(p[2], p[3]); w.z = pk2(p[4], p[5]); w.w = pk2(p[6], p[7]);
        pf[kk] = __builtin_bit_cast(bf16x8, w);
    }
    l += __shfl_xor(l, 16); l += __shfl_xor(l, 32);
    inv = __builtin_amdgcn_rcpf(l);
}
__device__ __forceinline__ void na_pv(int lane, const bf16x8 (&pf)[8], float inv, bf16* O, int ldo, const LAS unsigned char* Vl, int arow0, int kb0) {
    const int qi = lane & 15, g = lane >> 4;
    const LAS unsigned char* vbase = Vl + qi * 1200 + (arow0 * 40 + kb0 + 8 * g) * 2;
#define A16_VFR(mt, kk) (*(const LAS bf16x8*)(vbase + (mt) * 19200 + (kk) * 80))
    bf16x8 vb[2][8];
#pragma unroll
    for (int kk = 0; kk < 8; ++kk) vb[0][kk] = A16_VFR(0, kk);
#pragma unroll
    for (int mt = 0; mt < 4; ++mt) {
        if (mt < 3) {
#pragma unroll
            for (int kk = 0; kk < 8; ++kk) vb[(mt + 1) & 1][kk] = A16_VFR(mt + 1, kk);
        }
        __builtin_amdgcn_sched_barrier(0);
        f32x4 a0 = {0.f, 0.f, 0.f, 0.f}, a1 = {0.f, 0.f, 0.f, 0.f};
#pragma unroll
        for (int kk = 0; kk < 8; kk += 2) { a0 = __builtin_amdgcn_mfma_f32_16x16x32_bf16(vb[mt & 1][kk], pf[kk], a0, 0, 0, 0); a1 = __builtin_amdgcn_mfma_f32_16x16x32_bf16(vb[mt & 1][kk + 1], pf[kk + 1], a1, 0, 0, 0); }
        v2u w; w.x = pk2((a0[0] + a1[0]) * inv, (a0[1] + a1[1]) * inv); w.y = pk2((a0[2] + a1[2]) * inv, (a0[3] + a1[3]) * inv);
        *(v2u*)(O + (size_t)qi * ldo + 16 * mt + 4 * g) = w;
        __builtin_amdgcn_sched_barrier(0);
    }
#undef A16_VFR
}
__device__ __forceinline__ void zproj_item(int it, int lane, const bf16* hb, const bf16* wz, const float* rss, bf16* act1) {
    const int qi = lane & 15, g = lane >> 4, row0 = it * 16;
    const bf16* ap = hb + (size_t)(row0 + qi) * DM + 8 * g; const bf16* bp = wz + (size_t)qi * DM + 8 * g;
    const float rs = rstd_from(rss + (size_t)(row0 + qi) * 16);
    f32x4 acc0 = {0.f, 0.f, 0.f, 0.f}, acc1 = {0.f, 0.f, 0.f, 0.f};
#pragma unroll 1
    for (int k8 = 0; k8 < 32; k8 += 8) { bf16x8 a[8], b0[8], b1[8];
#pragma unroll
        for (int j = 0; j < 8; ++j) { a[j] = *(const bf16x8*)(ap + 32 * (k8 + j)); b0[j] = *(const bf16x8*)(bp + 32 * (k8 + j)); b1[j] = *(const bf16x8*)(bp + 16 * DM + 32 * (k8 + j)); }
#pragma unroll
        for (int j = 0; j < 8; ++j) { acc0 = __builtin_amdgcn_mfma_f32_16x16x32_bf16(b0[j], a[j], acc0, 0, 0, 0); acc1 = __builtin_amdgcn_mfma_f32_16x16x32_bf16(b1[j], a[j], acc1, 0, 0, 0); } }
    bf16* p = act1 + (size_t)(row0 + qi) * A1_LD + 1792 + 4 * g;
    v2u w; w.x = pk2(acc0[0] * rs, acc0[1] * rs); w.y = pk2(acc0[2] * rs, acc0[3] * rs); *(v2u*)p = w;
    w.x = pk2(acc1[0] * rs, acc1[1] * rs); w.y = pk2(acc1[2] * rs, acc1[3] * rs); *(v2u*)(p + 16) = w;
}
__device__ __forceinline__ void memkv_item(int it, int lane, const bf16* membf, const bf16* wt, const float* mrstd, bf16* memk, bf16* memvt) {
    const int rt = it >> 4, ctile = it & 15, qi = lane & 15, g = lane >> 4, row0 = rt * 16, col0 = ctile * 32;
    const bf16* ap = membf + (size_t)(row0 + qi) * DM + 8 * g; const bf16* bp = wt + (size_t)(col0 + qi) * DM + 8 * g;
    f32x4 acc0 = {0.f, 0.f, 0.f, 0.f}, acc1 = {0.f, 0.f, 0.f, 0.f};
    const bool isk = col0 < 256;
    if (isk) {
#pragma unroll 1
        for (int k8 = 0; k8 < 32; k8 += 8) { bf16x8 a[8], b0[8], b1[8];
#pragma unroll
            for (int j = 0; j < 8; ++j) { a[j] = *(const bf16x8*)(ap + 32 * (k8 + j)); b0[j] = *(const bf16x8*)(bp + 32 * (k8 + j)); b1[j] = *(const bf16x8*)(bp + 16 * DM + 32 * (k8 + j)); }
#pragma unroll
            for (int j = 0; j < 8; ++j) { acc0 = __builtin_amdgcn_mfma_f32_16x16x32_bf16(b0[j], a[j], acc0, 0, 0, 0); acc1 = __builtin_amdgcn_mfma_f32_16x16x32_bf16(b1[j], a[j], acc1, 0, 0, 0); } }
    } else {
#pragma unroll 1
        for (int k8 = 0; k8 < 32; k8 += 8) { bf16x8 a[8], b0[8], b1[8];
#pragma unroll
            for (int j = 0; j < 8; ++j) { a[j] = *(const bf16x8*)(ap + 32 * (k8 + j)); b0[j] = *(const bf16x8*)(bp + 32 * (k8 + j)); b1[j] = *(const bf16x8*)(bp + 16 * DM + 32 * (k8 + j)); }
#pragma unroll
            for (int j = 0; j < 8; ++j) { acc0 = __builtin_amdgcn_mfma_f32_16x16x32_bf16(a[j], b0[j], acc0, 0, 0, 0); acc1 = __builtin_amdgcn_mfma_f32_16x16x32_bf16(a[j], b1[j], acc1, 0, 0, 0); } }
    }
    if (isk) {
        const float s = mrstd[row0 + qi]; bf16* p = memk + (size_t)(row0 + qi) * 256 + col0 + 4 * g;
        v2u w; w.x = pk2(acc0[0] * s, acc0[1] * s); w.y = pk2(acc0[2] * s, acc0[3] * s); *(v2u*)p = w;
        w.x = pk2(acc1[0] * s, acc1[1] * s); w.y = pk2(acc1[2] * s, acc1[3] * s); *(v2u*)(p + 16) = w;
    } else {
        const f32x4 s = *(const f32x4*)(mrstd + row0 + 4 * g); bf16* p = memvt + (size_t)(col0 - 256 + qi) * MEM_ROWS + row0 + 4 * g;
        v2u w; w.x = pk2(acc0[0] * s[0], acc0[1] * s[1]); w.y = pk2(acc0[2] * s[2], acc0[3] * s[3]); *(v2u*)p = w;
        w.x = pk2(acc1[0] * s[0], acc1[1] * s[1]); w.y = pk2(acc1[2] * s[2], acc1[3] * s[3]); *(v2u*)(p + (size_t)16 * MEM_ROWS) = w;
    }
}
__device__ __forceinline__ void memattn_strip(const Frame& F, int item, const bf16* act, int ld, int qoff, const bf16* memk, const bf16* memvt, bf16* mix, bool load = true) {
    const int tg = item & 15, h = (item >> 4) & 3, b = item >> 6, lane = LANE(), wave = F.wave;
    LAS unsigned char* Kl = F.lds; LAS unsigned char* Vl = F.lds + 32768;
    if (load) {
#pragma unroll
    for (int j = 0; j < 4; ++j) {
        const int p = (wave * 4 + j) * 64 + lane, key = p >> 3, kpos = p & 7, kc = key & 31, swz = (((kc >> 3) & 3) << 1) | ((kc >> 1) & 1);
        __builtin_amdgcn_global_load_lds((const unsigned*)(memk + (size_t)(b * 256 + key) * 256 + h * 64 + ((kpos ^ swz) << 3)), (LAS unsigned*)(Kl + (wave * 4 + j) * 1024), 16, 0, 0);
        const int d = p >> 5, vpos = p & 31;
        __builtin_amdgcn_global_load_lds((const unsigned*)(memvt + (size_t)(h * 64 + d) * MEM_ROWS + b * 256 + ((vpos ^ (d & 15)) << 3)), (LAS unsigned*)(Vl + (wave * 4 + j) * 1024), 16, 0, 0);
    }
    asm volatile("s_waitcnt vmcnt(0)\n\ts_barrier" ::: "memory");
    }
#pragma unroll 1
    for (int u = 0; u < 2; ++u) {
        const int tok0 = b * SEQ + tg * 256 + (wave * 2 + u) * 16;
        attn16_lds<false, 1, 32>(lane, act + (size_t)tok0 * ld + qoff + h * 64, ld, mix + (size_t)tok0 * DM + 768 + h * 64, DM, nullptr, 0, 0, 0, 0, Kl, 0, Vl, 0);
    }
    asm volatile("s_waitcnt lgkmcnt(0)\n\ts_barrier" ::: "memory");
}
__device__ __forceinline__ void memattn_item(int it, int lane, const bf16* act, int ld, int qoff, const bf16* memk, const bf16* memvt, bf16* mix) {
    const int tb = it >> 2, h = it & 3, tok0 = tb * 16, b = tok0 >> 12;
    attn16<false>(lane, act + (size_t)tok0 * ld + qoff + h * 64, ld, memk + h * 64, 256, memvt + (size_t)(h * 64) * MEM_ROWS, MEM_ROWS, b * 256, 32,
                  mix + (size_t)tok0 * DM + 768 + h * 64, DM, nullptr, 0, 0, 0, 0);
}
constexpr int NA_RPB_OFF = 122880;
__device__ __forceinline__ void na_strip(const Frame& F, int item, const bf16* act0, const bf16* v0t, bf16* mix) {
    const int s8 = item & 7, h = (item >> 3) % 12, b = (item >> 3) / 12, lane = LANE(), wave = F.wave;
    const int R0 = 8 * s8, rowbase = min(max(R0 - 4, 0), 56), rowend = min(max(R0 + 7 - 4, 0), 56) + 8, nrows = rowend - rowbase;
    LAS unsigned char* Kl = F.lds;
    {
        const int col = wave * 8 + (lane >> 3), pos = lane & 7, swz = (((col >> 3) & 3) << 1) | ((col >> 1) & 1);
        const bf16* src = act0 + (size_t)(b * SEQ + rowbase * 64 + col) * A0_LD + 768 + h * 64 + ((pos ^ swz) << 3);
        for (int j = 0; j < nrows; ++j)
            __builtin_amdgcn_global_load_lds((const unsigned*)(src + (size_t)j * 64 * A0_LD), (LAS unsigned*)(Kl + j * 8192 + wave * 1024), 16, 0, 0);
    }
    asm volatile("s_waitcnt vmcnt(0)\n\ts_barrier" ::: "memory");
    const int r = R0 + wave, r0 = min(max(r - 4, 0), 56);
    const LAS float* rpb = (const LAS float*)(F.lds + NA_RPB_OFF) + h * 465;
#pragma unroll 1
    for (int jb = 0; jb < 4; ++jb) {
        const int band0 = min(max(jb * 16 - 8, 0), 32), tok0 = b * SEQ + r * 64 + jb * 16;
        attn16<true, true>(lane, act0 + (size_t)tok0 * A0_LD + h * 64, A0_LD, nullptr, 0, v0t + (size_t)(h * 64) * NT, NT, b * SEQ + r0 * 64 + band0, 64,
                           mix + (size_t)tok0 * DM + h * 64, DM, rpb, r, r0, jb, band0, Kl, r0 - rowbase, nullptr, band0);
    }
    asm volatile("s_waitcnt lgkmcnt(0)\n\ts_barrier" ::: "memory");
}
constexpr int NAH_V = 76800, NAH_RPB = 153600;
__device__ __forceinline__ void na_hstrip(const Frame& F, int item, const bf16* act0, const bf16* v0t, const float* rpb_g, bf16* mix) {
    const int half = item & 1, s8 = (item >> 1) & 7, h = (item >> 4) % 12, b = (item >> 4) / 12, lane = LANE(), wave = F.wave;
    const int R0 = 8 * s8, rowbase = min(max(R0 - 4, 0), 56), rowend = min(max(R0 + 7 - 4, 0), 56) + 8, nrows = rowend - rowbase, cb0 = half ? 24 : 0;
    LAS unsigned char* Kl = F.lds; LAS unsigned char* Vl = F.lds + NAH_V; LAS float* rl = (LAS float*)(F.lds + NAH_RPB);
    {
        const int pos = lane & 7, nk = nrows * 5 - 1;
#pragma unroll
        for (int i = 0; i < 10; ++i) { const int k = min(wave + NWAVES * i, 74), idx = min(k, nk);
            { const int j = idx / 5, q = idx - 5 * j, lc = q * 8 + (lane >> 3), swz = (((lc >> 3) & 3) << 1) | ((lc >> 1) & 1);
              __builtin_amdgcn_global_load_lds((const unsigned*)(act0 + (size_t)(b * SEQ + (rowbase + j) * 64 + cb0 + lc) * A0_LD + 768 + h * 64 + ((pos ^ swz) << 3)), (LAS unsigned*)(Kl + idx * 1024), 16, 0, 0); }
            { const int G = k * 64 + lane, d = G / 75, rem = G - 75 * d, j0 = rem / 5, gc = rem - 5 * j0, j = min(j0, nrows - 1);
              __builtin_amdgcn_global_load_lds((const unsigned*)(v0t + (size_t)(h * 64 + d) * NT + b * SEQ + (rowbase + j) * 64 + cb0 + gc * 8), (LAS unsigned*)(Vl + k * 1024), 16, 0, 0); } }
    }
    float bias = 0.f; if (TID() < 465) bias = rpb_g[h * 465 + TID()];
    asm volatile("" : "+v"(bias));
    bias *= 1.4426950408889634f;
    if (TID() < 465) rl[TID()] = bias;
    asm volatile("s_waitcnt vmcnt(0) lgkmcnt(0)\n\ts_barrier" ::: "memory");
    const int r = R0 + wave, r0 = min(max(r - 4, 0), 56);
#pragma unroll 1
    for (int u = 0; u < 2; ++u) {
        const int jb = 2 * half + u, band0 = min(max(jb * 16 - 8, 0), 32), tok0 = b * SEQ + r * 64 + jb * 16;
        attn16_lds<true, 2, 40>(lane, act0 + (size_t)tok0 * A0_LD + h * 64, A0_LD, mix + (size_t)tok0 * DM + h * 64, DM, rl, r, r0, jb, band0, Kl, r0 - rowbase, Vl, band0 - cb0);
    }
    asm volatile("s_waitcnt lgkmcnt(0)\n\ts_barrier" ::: "memory");
}
struct NaItem { int half, h, b, R0, rowbase, nrows, cb0; };
__device__ __forceinline__ NaItem na_decode(int item) { NaItem t; t.half = item & 1; const int s8 = (item >> 1) & 7; t.h = (item >> 4) % 12; t.b = (item >> 4) / 12; t.R0 = 8 * s8;
    t.rowbase = min(max(t.R0 - 4, 0), 56); t.nrows = min(max(t.R0 + 7 - 4, 0), 56) + 8 - t.rowbase; t.cb0 = t.half ? 24 : 0; return t; }
__device__ __forceinline__ void na_issue_k(const NaItem& t, int wave, const bf16* act0, LAS unsigned char* Kl) {
    const int lane = lane_id(), pos = lane & 7, nk = t.nrows * 5 - 1;
#pragma unroll
    for (int i = 0; i < 10; ++i) { const int idx = min(wave + NWAVES * i, nk), j = idx / 5, q = idx - 5 * j, lc = q * 8 + (lane >> 3), swz = (((lc >> 3) & 3) << 1) | ((lc >> 1) & 1);
        __builtin_amdgcn_global_load_lds((const unsigned*)(act0 + (size_t)(t.b * SEQ + (t.rowbase + j) * 64 + t.cb0 + lc) * A0_LD + 768 + t.h * 64 + ((pos ^ swz) << 3)), (LAS unsigned*)(Kl + idx * 1024), 16, 0, 0); }
}
__device__ __forceinline__ void na_issue_v(const NaItem& t, int wave, const bf16* v0t, LAS unsigned char* Vl) {
    const int lane = lane_id();
#pragma unroll
    for (int i = 0; i < 10; ++i) { const int k = min(wave + NWAVES * i, 74), G = k * 64 + lane, d = G / 75, rem = G - 75 * d, j0 = rem / 5, gc = rem - 5 * j0, j = min(j0, t.nrows - 1);
        __builtin_amdgcn_global_load_lds((const unsigned*)(v0t + (size_t)(t.h * 64 + d) * NT + t.b * SEQ + (t.rowbase + j) * 64 + t.cb0 + gc * 8), (LAS unsigned*)(Vl + k * 1024), 16, 0, 0); }
}
__device__ __forceinline__ void na_phase(const Frame& F, const bf16* act0, const bf16* v0t, const float* rpb2, bf16* mix) {
    const int wave = F.wave;
    LAS unsigned char* Kl = F.lds; LAS unsigned char* Vl = F.lds + NAH_V; LAS float* rl = (LAS float*)(F.lds + NAH_RPB);
    const int item0 = (F.bid & 7) * 192 + (F.bid >> 3);
    { const NaItem t0 = na_decode(item0); na_issue_k(t0, wave, act0, Kl); }
#pragma unroll 1
    for (int i = 0; i < 6; ++i) {
        const NaItem t = na_decode(item0 + 32 * i);
        const int lane = lane_id(), qi = lane & 15, g = lane >> 4;
        const int r = t.R0 + wave, r0 = min(max(r - 4, 0), 56), arow0 = r0 - t.rowbase;
        const int tokA = t.b * SEQ + r * 64 + (2 * t.half) * 16, tokB = tokA + 16;
        v4u q0, q1;
        const bf16* qa = act0 + (size_t)(tokA + qi) * A0_LD + t.h * 64 + 8 * g;
        asm volatile("global_load_dwordx4 %0, %1, off" : "=v"(q0) : "v"(qa)); asm volatile("global_load_dwordx4 %0, %1, off offset:64" : "=v"(q1) : "v"(qa));
        if (wave < 2) __builtin_amdgcn_global_load_lds((const unsigned*)(rpb2 + t.h * 480 + 4 * min(wave * 64 + lane, 119)), (LAS unsigned*)((LAS unsigned char*)rl + wave * 1024), 16, 0, 0);
        na_issue_v(t, wave, v0t, Vl);
        asm volatile("s_waitcnt vmcnt(10)\n\ts_barrier" : "+v"(q0), "+v"(q1) :: "memory");
        bf16x8 pf[8]; float inv;
        { const bf16x8 qf[2] = {__builtin_bit_cast(bf16x8, q0), __builtin_bit_cast(bf16x8, q1)}; const int jb = 2 * t.half, band0 = min(max(jb * 16 - 8, 0), 32);
          na_qk_sm<40>(lane, qf, rl, r, r0, jb, band0, Kl, arow0, band0 - t.cb0, pf, inv); }
        asm volatile("s_waitcnt vmcnt(0)\n\ts_barrier" ::: "memory");
        { const bf16* qb = qa + (size_t)16 * A0_LD;
          asm volatile("global_load_dwordx4 %0, %1, off" : "=v"(q0) : "v"(qb)); asm volatile("global_load_dwordx4 %0, %1, off offset:64" : "=v"(q1) : "v"(qb)); }
        { const int band0 = min(max((2 * t.half) * 16 - 8, 0), 32); na_pv(lane, pf, inv, mix + (size_t)tokA * DM + t.h * 64, DM, Vl, arow0, band0 - t.cb0); }
        asm volatile("s_waitcnt vmcnt(4)" : "+v"(q0), "+v"(q1) :: "memory");
        { const bf16x8 qf[2] = {__builtin_bit_cast(bf16x8, q0), __builtin_bit_cast(bf16x8, q1)}; const int jb = 2 * t.half + 1, band0 = min(max(jb * 16 - 8, 0), 32);
          na_qk_sm<40>(lane, qf, rl, r, r0, jb, band0, Kl, arow0, band0 - t.cb0, pf, inv); }
        asm volatile("s_waitcnt lgkmcnt(0)\n\ts_barrier" ::: "memory");
        if (i + 1 < 6) { const NaItem tn = na_decode(item0 + 32 * (i + 1)); na_issue_k(tn, wave, act0, Kl); }
        { const int band0 = min(max((2 * t.half + 1) * 16 - 8, 0), 32); na_pv(lane, pf, inv, mix + (size_t)tokB * DM + t.h * 64, DM, Vl, arow0, band0 - t.cb0); }
        asm volatile("s_waitcnt lgkmcnt(0)\n\ts_barrier" ::: "memory");
    }
}
__device__ __forceinline__ void na_item(int it, int lane, const bf16* act0, const bf16* v0t, const LAS float* rpb, bf16* mix) {
    const int jb = it & 3, h = (it >> 2) % 12, br = (it >> 2) / 12, r = br & 63, b = br >> 6;
    const int r0 = min(max(r - 4, 0), 56), band0 = min(max(jb * 16 - 8, 0), 32);
    const int tok0 = b * SEQ + r * 64 + jb * 16;
    attn16<true>(lane, act0 + (size_t)tok0 * A0_LD + h * 64, A0_LD, act0 + 768 + h * 64, A0_LD, v0t + (size_t)(h * 64) * NT, NT, b * SEQ + r0 * 64 + band0, 64,
                 mix + (size_t)tok0 * DM + h * 64, DM, rpb + h * 465, r, r0, jb, band0);
}

constexpr int GP_LD = 392;
__device__ __forceinline__ void gla_pre_w(int wave, int lane, const float* W, const float* Bi, bf16x8 (&wfr)[3], float (&bias)[3]) {
    const int qi = lane & 15, g = lane >> 4;
#pragma unroll
    for (int jj = 0; jj < 3; ++jj) {
        const int j = 16 * (wave + 8 * jj) + qi;
        v4u wu = {0u, 0u, 0u, 0u};
        if (g < 2) { const float* wp = W + (size_t)(8 * g) * 384 + j;
            wu.x = pk2(wp[0], wp[384]); wu.y = pk2(wp[768], wp[1152]); wu.z = pk2(wp[1536], wp[1920]); wu.w = pk2(wp[2304], wp[2688]); }
        wfr[jj] = __builtin_bit_cast(bf16x8, wu); bias[jj] = Bi[j];
    }
}
__device__ __forceinline__ void gla_pre_item(const Frame& F, int item, const bf16* act1, const bf16x8 (&wfr)[3], const float (&bias)[3], bf16* QT, bf16* KT, float* DEC) {
    const int n = item & 63, dir = (item >> 6) & 1, b = item >> 7, base = b * SEQ + n * 64;
    const int tid = TID(), lane = LANE(), wave = F.wave, qi = lane & 15, g = lane >> 4;
    LAS bf16* EL = (LAS bf16*)F.lds;
    bf16x8 zf[4];
#pragma unroll
    for (int ct = 0; ct < 4; ++ct) { const int c = 16 * ct + qi, tok = dir ? base + 63 - c : base + c;
        bf16x8 z = {0, 0, 0, 0, 0, 0, 0, 0}; if (g < 2) z = *(const bf16x8*)(act1 + (size_t)tok * A1_LD + 1792 + dir * 16 + 8 * g); zf[ct] = z; }
    v4u q8a[6], k8a[6];
#pragma unroll
    for (int k = 0; k < 6; ++k) { const int idx = tid + 512 * k, c = idx / 48, jg = idx % 48; const bf16* arow = act1 + (size_t)(base + c) * A1_LD + 8 * jg; q8a[k] = *(const v4u*)arow; k8a[k] = *(const v4u*)(arow + 384); }
#pragma unroll
    for (int jj = 0; jj < 3; ++jj) {
        const int j = 16 * (wave + 8 * jj) + qi;
        float p[4][4], a[4], t1[4], t2[4], tot[4];
#pragma unroll
        for (int ct = 0; ct < 4; ++ct) {
            f32x4 d = {0.f, 0.f, 0.f, 0.f};
            d = __builtin_amdgcn_mfma_f32_16x16x32_bf16(zf[ct], wfr[jj], d, 0, 0, 0);
#pragma unroll
            for (int i = 0; i < 4; ++i) { const float x = d[i] + bias[jj];
                p[ct][i] = (fminf(x, 0.f) * 1.4426950408889634f - __builtin_amdgcn_logf(1.0f + __builtin_amdgcn_exp2f(fabsf(x) * -1.4426950408889634f))) * 0.0625f; }
            p[ct][1] += p[ct][0]; p[ct][2] += p[ct][1]; p[ct][3] += p[ct][2]; a[ct] = p[ct][3];
        }
#pragma unroll
        for (int ct = 0; ct < 4; ++ct) t1[ct] = __shfl_up(a[ct], 16);
#pragma unroll
        for (int ct = 0; ct < 4; ++ct) if (g >= 1) a[ct] += t1[ct];
#pragma unroll
        for (int ct = 0; ct < 4; ++ct) t2[ct] = __shfl_up(a[ct], 32);
#pragma unroll
        for (int ct = 0; ct < 4; ++ct) if (g >= 2) a[ct] += t2[ct];
#pragma unroll
        for (int ct = 0; ct < 4; ++ct) tot[ct] = __shfl(a[ct], 48 + qi);
        float carry = 0.f;
#pragma unroll
        for (int ct = 0; ct < 4; ++ct) {
            const float excl = a[ct] - p[ct][3] + carry;
            carry += tot[ct];
#pragma unroll
            for (int i = 0; i < 4; ++i) { const int c = 16 * ct + 4 * g + i, ctok = dir ? 63 - c : c; EL[ctok * GP_LD + j] = (bf16)f2bf(__builtin_amdgcn_exp2f(excl + p[ct][i])); }
        }
    }
    __syncthreads();
    const int clast = dir ? 0 : 63;
#pragma unroll
    for (int k = 0; k < 6; ++k) {
        const int idx = tid + 512 * k, c = idx / 48, jg = idx % 48;
        const v4u q8 = q8a[k], k8 = k8a[k];
        const v4u e8 = *(const LAS v4u*)(EL + c * GP_LD + 8 * jg), l8 = *(const LAS v4u*)(EL + clast * GP_LD + 8 * jg);
        const unsigned qa[4] = {q8.x, q8.y, q8.z, q8.w}, ka[4] = {k8.x, k8.y, k8.z, k8.w}, ea[4] = {e8.x, e8.y, e8.z, e8.w}, la[4] = {l8.x, l8.y, l8.z, l8.w};
        unsigned qo[4], ko[4];
        float lf[8];
#pragma unroll
        for (int i = 0; i < 4; ++i) {
            const float e0 = bflo(ea[i]), e1 = bfhi(ea[i]), i0 = __builtin_amdgcn_rcpf(e0), i1 = __builtin_amdgcn_rcpf(e1);
            const float kt0 = bflo(ka[i]) * i0, kt1 = bfhi(ka[i]) * i1; lf[2 * i] = bflo(la[i]); lf[2 * i + 1] = bfhi(la[i]);
            qo[i] = pk2(bflo(qa[i]) * 0.10206207261596575f * e0, bfhi(qa[i]) * 0.10206207261596575f * e1);
            ko[i] = pk2(kt0, kt1);
        }
        v4u w; w.x = qo[0]; w.y = qo[1]; w.z = qo[2]; w.w = qo[3]; *(v4u*)(QT + (size_t)(base + c) * 384 + 8 * jg) = w;
        w.x = ko[0]; w.y = ko[1]; w.z = ko[2]; w.w = ko[3]; *(v4u*)(KT + (size_t)(base + c) * 384 + 8 * jg) = w;
        if (c == clast) { float* dp = DEC + (size_t)((b * 4 + jg / 12) * 64 + n) * 96 + (jg % 12) * 8;
            *(f32x4*)dp = (f32x4){lf[0], lf[1], lf[2], lf[3]}; *(f32x4*)(dp + 4) = (f32x4){lf[4], lf[5], lf[6], lf[7]}; }
    }
    __syncthreads();
}
constexpr int GL_QT = 0, GL_KT = 13312, GL_VT = 26624, GL_DEC = 33792, GL_BUF = 34816;
__device__ __forceinline__ void gla_main_item(const Frame& F, int item, const bf16* QTa, const bf16* KTa, const float* DECa, const bf16* v1t, bf16* OFp, bf16* OBp,
                                              const float* cwg, const float* cwu, const float* cgain, unsigned char* c8) {
    const int vs = item & 3, dir = (item >> 2) & 1, h = (item >> 3) & 3, b = item >> 5;
    const int lane = LANE(), wave = F.wave, qi = lane & 15, g = lane >> 4;
    bf16* O = dir ? OBp : OFp;
    LAS unsigned char* L = F.lds;
    constexpr int GL_SB = 3 * GL_BUF;
    for (int i = TID(); i < 18 * 512 / 8; i += NTHR) *(LAS v2u*)(L + GL_SB + i * 8) = (v2u){0u, 0u};
    const char* qtb = (const char*)(QTa + (size_t)dir * NT * 384 + h * 96); const char* ktb = (const char*)(KTa + (size_t)dir * NT * 384 + h * 96);
    const char* deb = (const char*)(DECa + (size_t)dir * 8 * 4 * 64 * 96 + (size_t)((b * 4 + h) * 64) * 96);
    const char* vtb = (const char*)(v1t + (size_t)(h * 192 + vs * 48) * NT);
#define GL_OFF(k_) ((k_) < 26 ? (unsigned)((((k_) < 13 ? (k_) : (k_) - 13) * 64 + lane) / 13 * 768 + ((((k_) < 13 ? (k_) : (k_) - 13) * 64 + lane) % 13 < 12 ? ((((k_) < 13 ? (k_) : (k_) - 13) * 64 + lane) % 13) * 16 : 0)) \
                   : ((k_) < 33 ? ((((k_) - 26) * 64 + lane) < 432 ? (unsigned)((((k_) - 26) * 64 + lane) / 9 * NT * 2 + ((((k_) - 26) * 64 + lane) % 9 < 8 ? ((((k_) - 26) * 64 + lane) % 9) * 16 : 0)) : 0u) : ((lane < 24) ? (unsigned)(lane * 16) : 0u)))
#define GL_PIECE(k_, offv_, n_, bufo_) do { const int nn_ = dir ? 63 - (n_) : (n_); const size_t tb_ = (size_t)(b * SEQ + nn_ * 64); \
            const char* src_ = (k_) < 13 ? qtb + tb_ * 768 : ((k_) < 26 ? ktb + tb_ * 768 : ((k_) < 33 ? vtb + tb_ * 2 : deb + (size_t)nn_ * 384)); \
            __builtin_amdgcn_global_load_lds((const unsigned*)(src_ + (offv_)), (LAS unsigned*)(L + (bufo_) + (k_) * 1024), 16, 0, 0); } while (0)
    if (wave < 4) {
        const int ct = wave;
        unsigned kmw[2][4];
#pragma unroll
        for (int kk = 0; kk < 2; ++kk)
#pragma unroll
            for (int w2 = 0; w2 < 4; ++w2) { const int tp = 2 * kk + (w2 >> 1), i0 = 2 * (w2 & 1), c = 16 * ct + qi, cp = 16 * tp + 4 * g + i0;
                const bool k0 = dir ? (cp > c) : (cp <= c), k1 = dir ? (cp + 1 > c) : (cp + 1 <= c); kmw[kk][w2] = (k0 ? 0x0000ffffu : 0u) | (k1 ? 0xffff0000u : 0u); }
        unsigned offo[5];
#pragma unroll
        for (int jj = 0; jj < 5; ++jj) { const int k = wave + 4 * jj; offo[jj] = GL_OFF(k); }
#define GL_DMA_O(n_, bufo_) do { _Pragma("unroll") for (int jj_ = 0; jj_ < 5; ++jj_) { const int k_ = wave + 4 * jj_; GL_PIECE(k_, offo[jj_], n_, bufo_); } } while (0)
        GL_DMA_O(0, 0); GL_DMA_O(1, GL_BUF);
        asm volatile("s_waitcnt vmcnt(0) lgkmcnt(0)\n\ts_barrier" ::: "memory");
        int bo = 0, bo2 = 2 * GL_BUF;
#pragma unroll 1
        for (int n = 0; n < 64; ++n) {
            const LAS unsigned char* Bf = L + bo; const LAS unsigned char* SBr = L + GL_SB + (n & 1) * 9216;
            asm volatile("s_waitcnt vmcnt(0)" ::: "memory");
            { const int n2 = n + 2 < 64 ? n + 2 : 63; GL_DMA_O(n2, bo2); }
            bf16x8 qf[3], kf[4][3], qp[3], vf[3][2], sf[3][3];
#pragma unroll
            for (int ks = 0; ks < 3; ++ks) qf[ks] = *(const LAS bf16x8*)(Bf + GL_QT + (16 * ct + qi) * 208 + (32 * ks + 8 * g) * 2);
#pragma unroll
            for (int tp = 0; tp < 4; ++tp)
#pragma unroll
                for (int ks = 0; ks < 3; ++ks) kf[tp][ks] = *(const LAS bf16x8*)(Bf + GL_KT + (16 * tp + qi) * 208 + (32 * ks + 8 * g) * 2);
#pragma unroll
            for (int kk = 0; kk < 3; ++kk) { const LAS unsigned char* qr = Bf + GL_QT + (16 * ct + qi) * 208 + (32 * kk + 4 * g) * 2;
                const s16x4 a0 = *(const LAS s16x4*)qr, a1 = *(const LAS s16x4*)(qr + 32); qp[kk] = __builtin_shufflevector(a0, a1, 0, 1, 2, 3, 4, 5, 6, 7); }
#pragma unroll
            for (int vt = 0; vt < 3; ++vt) {
#pragma unroll
                for (int kk = 0; kk < 2; ++kk) { const LAS unsigned char* vr = Bf + GL_VT + (16 * vt + qi) * 144 + (32 * kk + 4 * g) * 2;
                    const s16x4 a0 = *(const LAS s16x4*)vr, a1 = *(const LAS s16x4*)(vr + 32); vf[vt][kk] = __builtin_shufflevector(a0, a1, 0, 1, 2, 3, 4, 5, 6, 7); }
#pragma unroll
                for (int kk = 0; kk < 3; ++kk) { const LAS unsigned char* sr = SBr + (vt * 6 + 2 * kk) * 512 + lane * 8;
                    const s16x4 a0 = *(const LAS s16x4*)sr, a1 = *(const LAS s16x4*)(sr + 512); sf[vt][kk] = __builtin_shufflevector(a0, a1, 0, 1, 2, 3, 4, 5, 6, 7); } }
            __builtin_amdgcn_sched_barrier(0);
            f32x4 am[4];
#pragma unroll
            for (int tp = 0; tp < 4; ++tp) {
                f32x4 z = {0.f, 0.f, 0.f, 0.f};
#pragma unroll
                for (int ks = 0; ks < 3; ++ks) z = __builtin_amdgcn_mfma_f32_16x16x32_bf16(kf[tp][ks], qf[ks], z, 0, 0, 0);
                am[tp] = z;
            }
            bf16x8 pf[2];
#pragma unroll
            for (int kk = 0; kk < 2; ++kk) { v4u w; w.x = pk2(am[2 * kk][0], am[2 * kk][1]) & kmw[kk][0]; w.y = pk2(am[2 * kk][2], am[2 * kk][3]) & kmw[kk][1]; w.z = pk2(am[2 * kk + 1][0], am[2 * kk + 1][1]) & kmw[kk][2]; w.w = pk2(am[2 * kk + 1][2], am[2 * kk + 1][3]) & kmw[kk][3];
                pf[kk] = __builtin_bit_cast(bf16x8, w); }
            const int nn = dir ? 63 - n : n, tok = b * SEQ + nn * 64 + 16 * ct + qi;
            f32x4 oacc[3];
#pragma unroll
            for (int vt = 0; vt < 3; ++vt) {
                f32x4 acc = {0.f, 0.f, 0.f, 0.f};
#pragma unroll
                for (int kk = 0; kk < 3; ++kk) acc = __builtin_amdgcn_mfma_f32_16x16x32_bf16(sf[vt][kk], qp[kk], acc, 0, 0, 0);
                oacc[vt] = acc;
            }
#pragma unroll
            for (int vt = 0; vt < 3; ++vt) {
#pragma unroll
                for (int kk = 0; kk < 2; ++kk) oacc[vt] = __builtin_amdgcn_mfma_f32_16x16x32_bf16(vf[vt][kk], pf[kk], oacc[vt], 0, 0, 0);
            }
#pragma unroll
            for (int vt = 0; vt < 3; ++vt) { v2u w; w.x = pk2(oacc[vt][0], oacc[vt][1]); w.y = pk2(oacc[vt][2], oacc[vt][3]);
                *(v2u*)(O + (size_t)tok * 768 + h * 192 + vs * 48 + 16 * vt + 4 * g) = w; }
            asm volatile("s_waitcnt lgkmcnt(0)\n\ts_barrier" ::: "memory");
            { const int t_ = bo; bo = (bo == 2 * GL_BUF) ? 0 : bo + GL_BUF; bo2 = t_; }
        }
#undef GL_DMA_O
    } else {
        const int w4 = wave - 4;
        unsigned off[4];
#pragma unroll
        for (int jj = 0; jj < 4; ++jj) { const int k = 20 + w4 + 4 * jj; off[jj] = GL_OFF(k); }
#define GL_DMA(n_, bufo_) do { _Pragma("unroll") for (int jj_ = 0; jj_ < 4; ++jj_) { const int k_ = 20 + w4 + 4 * jj_; if (k_ < 34) GL_PIECE(k_, off[jj_], n_, bufo_); } } while (0)
        int oT[5]; bool oV[5];
#pragma unroll
        for (int j = 0; j < 5; ++j) { oV[j] = (j < 4) || (w4 < 2); oT[j] = oV[j] ? w4 + 4 * j : w4 + 12; }
        const unsigned vmsk = 0u - (unsigned)(w4 >> 1);
        f32x4 So[5];
#pragma unroll
        for (int j = 0; j < 5; ++j) So[j] = (f32x4){0.f, 0.f, 0.f, 0.f};
        f32x4 cv[8], cg[2];
#pragma unroll
        for (int j = 0; j < 8; ++j) cv[j] = (f32x4){0.f, 0.f, 0.f, 0.f};
        cg[0] = cv[0]; cg[1] = cv[0];
        LAS unsigned* CT = (LAS unsigned*)(L + GL_SB + 18432 + w4 * 2304);
        const int gw2 = F.bid * 4 + w4;
        GL_DMA(0, 0); GL_DMA(1, GL_BUF);
        asm volatile("s_waitcnt vmcnt(0) lgkmcnt(0)\n\ts_barrier" ::: "memory");
        int bo = 0, bo2 = 2 * GL_BUF;
#pragma unroll 1
        for (int n = 0; n < 64; ++n) {
            const LAS unsigned char* Bf = L + bo; LAS unsigned char* SBw = L + GL_SB + ((n + 1) & 1) * 9216;
            asm volatile("s_waitcnt vmcnt(0)" ::: "memory");
            f32x4 dec[5]; bf16x8 kdf[5][2], vfr[3][2];
#pragma unroll
            for (int vt = 0; vt < 3; ++vt)
#pragma unroll
                for (int kk = 0; kk < 2; ++kk) { const LAS unsigned char* vr = Bf + GL_VT + (16 * vt + qi) * 144 + (32 * kk + 4 * g) * 2;
                    const s16x4 a0 = *(const LAS s16x4*)vr, a1 = *(const LAS s16x4*)(vr + 32); vfr[vt][kk] = __builtin_shufflevector(a0, a1, 0, 1, 2, 3, 4, 5, 6, 7); }
#pragma unroll
            for (int j = 0; j < 5; ++j) { const int T = oT[j], vt = T / 6, dt = T - 6 * vt;
                dec[j] = *(const LAS f32x4*)(Bf + GL_DEC + (16 * dt + 4 * g) * 4);
#pragma unroll
                for (int ks = 0; ks < 2; ++ks) {
                    const LAS unsigned char* kr = Bf + GL_KT + (32 * ks + 4 * g + (qi >> 2)) * 208 + (16 * dt + 4 * (qi & 3)) * 2;
                    const s16x4 a0 = __builtin_amdgcn_ds_read_tr16_b64_v4i16((LAS s16x4*)kr), a1 = __builtin_amdgcn_ds_read_tr16_b64_v4i16((LAS s16x4*)(kr + 16 * 208));
                    kdf[j][ks] = __builtin_shufflevector(a0, a1, 0, 1, 2, 3, 4, 5, 6, 7); } }
            __builtin_amdgcn_sched_barrier(0);
            if ((n & 1) && (n < 57)) {
                const int id = gw2 + 1024 * (n >> 1), e = id / 3584, r2 = id - e * 3584, wh = r2 / 1792, it2 = r2 - wh * 1792, kb = it2 / 112, nb = it2 - kb * 112, n0 = nb * 32;
                unsigned char* dst = c8 + (size_t)e * 7168 * 1024 + (size_t)((n0 >> 7) * 256 + wh * 128 + (n0 & 127)) * 1024 + kb * 64;
                const int nq = lane & 7, kr = lane >> 3;
#pragma unroll
                for (int p = 0; p < 2; ++p) { const f32x4 gq = cg[p] * 32.0f;
                    const f32x4 a = cv[4 * p], b2 = cv[4 * p + 1], c2 = cv[4 * p + 2], d2 = cv[4 * p + 3]; LAS unsigned* t = CT + (4 * nq) * 17 + 8 * p + kr;
                    t[0] = pk4_fp8(a.x * gq[0], b2.x * gq[1], c2.x * gq[2], d2.x * gq[3]); t[17] = pk4_fp8(a.y * gq[0], b2.y * gq[1], c2.y * gq[2], d2.y * gq[3]);
                    t[34] = pk4_fp8(a.z * gq[0], b2.z * gq[1], c2.z * gq[2], d2.z * gq[3]); t[51] = pk4_fp8(a.w * gq[0], b2.w * gq[1], c2.w * gq[2], d2.w * gq[3]); }
                LDS_WAIT(); asm volatile("" ::: "memory");
#pragma unroll
                for (int r = 0; r < 2; ++r) { const int nn2 = (lane >> 2) + 16 * r, c4 = lane & 3; const LAS unsigned* sp = CT + nn2 * 17 + 4 * c4;
                    v4u o; o.x = sp[0]; o.y = sp[1]; o.z = sp[2]; o.w = sp[3];
                    *(GAS v4u*)(dst + (size_t)nn2 * 1024 + 16 * c4) = o; }
            }
            { const int n2 = n + 2 < 64 ? n + 2 : 63; GL_DMA(n2, bo2); }
            if (!(n & 1) && (n < 56)) {
                const int id = gw2 + 1024 * (n >> 1), e = id / 3584, r2 = id - e * 3584, wh = r2 / 1792, it2 = r2 - wh * 1792, kb = it2 / 112, nb = it2 - kb * 112;
                const float* p = (wh ? cwu : cwg) + (size_t)e * 1024 * FFE + (size_t)(kb * 64 + 4 * (lane >> 3)) * FFE + nb * 32 + 4 * (lane & 7);
#pragma unroll
                for (int j = 0; j < 8; ++j) cv[j] = *(const f32x4*)(p + (size_t)(32 * (j >> 2) + (j & 3)) * FFE);
                cg[0] = *(const f32x4*)(cgain + kb * 64 + 4 * (lane >> 3)); cg[1] = *(const f32x4*)(cgain + kb * 64 + 32 + 4 * (lane >> 3));
            }
            __builtin_amdgcn_sched_barrier(0);
#pragma unroll
            for (int j = 0; j < 5; ++j) {
                f32x4 sv = So[j];
#pragma unroll
                for (int ks = 0; ks < 2; ++ks) { bf16x8 vop;
                    if (j == 0) vop = vfr[0][ks]; else if (j == 2) vop = vfr[1][ks]; else if (j >= 3) vop = vfr[2][ks];
                    else { const v4u a_ = __builtin_bit_cast(v4u, vfr[0][ks]), b_ = __builtin_bit_cast(v4u, vfr[1][ks]); v4u r_; r_.x = (b_.x & vmsk) | (a_.x & ~vmsk); r_.y = (b_.y & vmsk) | (a_.y & ~vmsk); r_.z = (b_.z & vmsk) | (a_.z & ~vmsk); r_.w = (b_.w & vmsk) | (a_.w & ~vmsk); vop = __builtin_bit_cast(bf16x8, r_); }
                    sv = __builtin_amdgcn_mfma_f32_16x16x32_bf16(kdf[j][ks], vop, sv, 0, 0, 0); }
                sv[0] *= dec[j][0]; sv[1] *= dec[j][1]; sv[2] *= dec[j][2]; sv[3] *= dec[j][3];
                So[j] = sv;
            }
#pragma unroll
            for (int j = 0; j < 5; ++j) if (oV[j]) { v2u w; w.x = pk2(So[j][0], So[j][1]); w.y = pk2(So[j][2], So[j][3]); *(LAS v2u*)(SBw + oT[j] * 512 + lane * 8) = w; }
            asm volatile("s_waitcnt lgkmcnt(0)\n\ts_barrier" ::: "memory");
            { const int t_ = bo; bo = (bo == 2 * GL_BUF) ? 0 : bo + GL_BUF; bo2 = t_; }
        }
#undef GL_DMA
    }
#undef GL_PIECE
#undef GL_OFF
    __syncthreads();
}

__device__ __forceinline__ void finalize_rstd(const Frame& F, const float* rss, float* rstd) {
    for (int row = F.bid * NTHR + TID(); row < NT; row += F.G * NTHR) rstd[row] = rstd_from(rss + (size_t)row * 16);
}
__device__ __forceinline__ void gla_combine(const Frame& F, const bf16* OF, const bf16* OB, const bf16* act1, const float* gnorm, bf16* mix) {
    const int lane = LANE(), h = lane >> 4, c0 = h * 192 + 12 * (lane & 15);
    float gn[12];
#pragma unroll
    for (int j = 0; j < 12; ++j) gn[j] = gnorm[12 * (lane & 15) + j];
    for (int token = F.gw; token < NT; token += 2 * F.NGW) {
        const int tb = token + F.NGW; const bool hb = tb < NT; const int t2 = hb ? tb : token;
        v2u fa[3], ba[3], ga[3], fb[3], bb[3], gb[3];
#pragma unroll
        for (int j = 0; j < 3; ++j) { fa[j] = *(const v2u*)(OF + (size_t)token * 768 + c0 + 4 * j); ba[j] = *(const v2u*)(OB + (size_t)token * 768 + c0 + 4 * j); ga[j] = *(const v2u*)(act1 + (size_t)token * A1_LD + 768 + c0 + 4 * j); }
#pragma unroll
        for (int j = 0; j < 3; ++j) { fb[j] = *(const v2u*)(OF + (size_t)t2 * 768 + c0 + 4 * j); bb[j] = *(const v2u*)(OB + (size_t)t2 * 768 + c0 + 4 * j); gb[j] = *(const v2u*)(act1 + (size_t)t2 * A1_LD + 768 + c0 + 4 * j); }
        float oa[12], ob[12], sa = 0.f, sb = 0.f;
#pragma unroll
        for (int j = 0; j < 3; ++j) {
            oa[4 * j] = bflo(fa[j].x) + bflo(ba[j].x); oa[4 * j + 1] = bfhi(fa[j].x) + bfhi(ba[j].x); oa[4 * j + 2] = bflo(fa[j].y) + bflo(ba[j].y); oa[4 * j + 3] = bfhi(fa[j].y) + bfhi(ba[j].y);
            ob[4 * j] = bflo(fb[j].x) + bflo(bb[j].x); ob[4 * j + 1] = bfhi(fb[j].x) + bfhi(bb[j].x); ob[4 * j + 2] = bflo(fb[j].y) + bflo(bb[j].y); ob[4 * j + 3] = bfhi(fb[j].y) + bfhi(bb[j].y); }
#pragma unroll
        for (int j = 0; j < 12; ++j) { sa += oa[j] * oa[j]; sb += ob[j] * ob[j]; }
#pragma unroll
        for (int o = 1; o < 16; o <<= 1) { sa += __shfl_xor(sa, o); sb += __shfl_xor(sb, o); }
        const float ra = __builtin_amdgcn_rsqf(sa * (1.0f / 192.0f) + EPS), rb = __builtin_amdgcn_rsqf(sb * (1.0f / 192.0f) + EPS);
#pragma unroll
        for (int j = 0; j < 3; ++j) {
            const float g0 = bflo(ga[j].x), g1 = bfhi(ga[j].x), g2 = bflo(ga[j].y), g3 = bfhi(ga[j].y);
            v2u w; w.x = pk2(oa[4 * j] * ra * gn[4 * j] * g0 * __builtin_amdgcn_rcpf(1.0f + __expf(-g0)), oa[4 * j + 1] * ra * gn[4 * j + 1] * g1 * __builtin_amdgcn_rcpf(1.0f + __expf(-g1)));
            w.y = pk2(oa[4 * j + 2] * ra * gn[4 * j + 2] * g2 * __builtin_amdgcn_rcpf(1.0f + __expf(-g2)), oa[4 * j + 3] * ra * gn[4 * j + 3] * g3 * __builtin_amdgcn_rcpf(1.0f + __expf(-g3)));
            *(v2u*)(mix + (size_t)token * DM + c0 + 4 * j) = w; }
        if (hb) {
#pragma unroll
            for (int j = 0; j < 3; ++j) {
                const float g0 = bflo(gb[j].x), g1 = bfhi(gb[j].x), g2 = bflo(gb[j].y), g3 = bfhi(gb[j].y);
                v2u w; w.x = pk2(ob[4 * j] * rb * gn[4 * j] * g0 * __builtin_amdgcn_rcpf(1.0f + __expf(-g0)), ob[4 * j + 1] * rb * gn[4 * j + 1] * g1 * __builtin_amdgcn_rcpf(1.0f + __expf(-g1)));
                w.y = pk2(ob[4 * j + 2] * rb * gn[4 * j + 2] * g2 * __builtin_amdgcn_rcpf(1.0f + __expf(-g2)), ob[4 * j + 3] * rb * gn[4 * j + 3] * g3 * __builtin_amdgcn_rcpf(1.0f + __expf(-g3)));
                *(v2u*)(mix + (size_t)tb * DM + c0 + 4 * j) = w; } }
    }
}
__device__ __forceinline__ void route_pick(const float (&acc)[8], int token, int* topi, float* topw, LAS int* lc) {
    int e0 = 0; float l0 = acc[0];
#pragma unroll
    for (int e = 1; e < 8; ++e) if (acc[e] > l0) { l0 = acc[e]; e0 = e; }
    int e1 = -1; float l1 = -INFINITY;
#pragma unroll
    for (int e = 0; e < 8; ++e) if (e != e0 && acc[e] > l1) { l1 = acc[e]; e1 = e; }
    if (e1 < 0) { e1 = (e0 + 1) & 7; l1 = l0; }
    const float w0 = 1.0f / (1.0f + __expf(l1 - l0));
    topi[token] = e0 | (e1 << 8); topw[2 * token] = w0; topw[2 * token + 1] = 1.0f - w0;
    atomicAdd((int*)&lc[e0], 1); atomicAdd((int*)&lc[8 + e1], 1);
}
__device__ __forceinline__ void route1(const Frame& F, const bf16* H, const float* gain, const float* wr, int* topi, float* topw, int* cnt, float* rstd) {
    LAS int* lc = (LAS int*)F.lds;
    if (TID() < 16) lc[TID()] = 0;
    __syncthreads();
    const int lane = LANE();
    float w[4][4][8];
#pragma unroll
    for (int j = 0; j < 4; ++j) { const f32x4 g = *(const f32x4*)(gain + 256 * j + 4 * lane);
#pragma unroll
        for (int i = 0; i < 4; ++i) { const float* p = wr + (size_t)(256 * j + 4 * lane + i) * 8; const f32x4 a = *(const f32x4*)p, b = *(const f32x4*)(p + 4); const float gi = g[i];
            w[j][i][0] = a.x * gi; w[j][i][1] = a.y * gi; w[j][i][2] = a.z * gi; w[j][i][3] = a.w * gi; w[j][i][4] = b.x * gi; w[j][i][5] = b.y * gi; w[j][i][6] = b.z * gi; w[j][i][7] = b.w * gi; } }
    for (int t2 = 0; t2 < 16; t2 += 2) {
        const int token = F.bid * 128 + F.wave * 16 + t2;
        const v2u* h0 = (const v2u*)(H + (size_t)token * DM) + lane; const v2u* h1 = h0 + DM / 4;
        f32x4 x0[4], x1[4];
#pragma unroll
        for (int j = 0; j < 4; ++j) { const v2u p = h0[64 * j], q = h1[64 * j]; x0[j] = (f32x4){bflo(p.x), bfhi(p.x), bflo(p.y), bfhi(p.y)}; x1[j] = (f32x4){bflo(q.x), bfhi(q.x), bflo(q.y), bfhi(q.y)}; }
        float a0[8], a1[8], s0 = 0.f, s1 = 0.f;
#pragma unroll
        for (int e = 0; e < 8; ++e) { a0[e] = 0.f; a1[e] = 0.f; }
#pragma unroll
        for (int j = 0; j < 4; ++j)
#pragma unroll
            for (int i = 0; i < 4; ++i) { const float u = x0[j][i], v = x1[j][i]; s0 += u * u; s1 += v * v;
#pragma unroll
                for (int e = 0; e < 8; ++e) { a0[e] += u * w[j][i][e]; a1[e] += v * w[j][i][e]; } }
        s0 = wave_sum(s0); s1 = wave_sum(s1);
        const float r0 = 1.0f / sqrtf(s0 * (1.0f / DM) + EPS), r1 = 1.0f / sqrtf(s1 * (1.0f / DM) + EPS);
#pragma unroll
        for (int e = 0; e < 8; ++e) { a0[e] = wave_sum(a0[e]) * r0; a1[e] = wave_sum(a1[e]) * r1; }
        if (lane == 0) { route_pick(a0, token, topi, topw, lc); route_pick(a1, token + 1, topi, topw, lc); rstd[token] = r0; rstd[token + 1] = r1; }
    }
    __syncthreads();
    if (TID() < 16) cnt[F.bid * 16 + TID()] = lc[TID()];
    __syncthreads();
}
__device__ __forceinline__ void route2(const Frame& F, const int* topi, const float* topw, const int* cnt, int* stok, float* sw, int* blk, int* s0tab) {
    LAS int* part = (LAS int*)F.lds;
    LAS int* base = part + 1024;
    LAS int* tk = base + 64;
    const int tid = TID(), pe = tid & 15, jg = tid >> 4;
    int below = 0, tot = 0;
    for (int w = jg; w < F.G; w += 32) { const int v = cnt[w * 16 + pe]; tot += v; if (w < F.bid) below += v; }
    part[jg * 16 + pe] = below; part[512 + jg * 16 + pe] = tot;
    if (tid < 128) tk[tid] = topi[F.bid * 128 + tid];
    __syncthreads();
    if (tid < 16) { int b = 0, t = 0; for (int j = 0; j < 32; ++j) { b += part[j * 16 + tid]; t += part[512 + j * 16 + tid]; } base[tid] = b; base[16 + tid] = t; }
    __syncthreads();
    if (tid < 2) { int ps = 0; for (int e = 0; e < 8; ++e) { base[32 + tid * 8 + e] = ps; ps += (base[16 + tid * 8 + e] + 255) / 256 * 256; } base[48 + tid] = ps / 256; }
    __syncthreads();
    if (tid < 256) {
        const int p = tid >> 7, i = tid & 127; const int e = (tk[i] >> (8 * p)) & 0xff;
        int rank = 0; for (int j = 0; j < i; ++j) rank += (((tk[j] >> (8 * p)) & 0xff) == e) ? 1 : 0;
        const int slot = base[32 + p * 8 + e] + base[p * 8 + e] + rank; const int token = F.bid * 128 + i;
        stok[p * SLOT_CAP + slot] = token; sw[p * SLOT_CAP + slot] = topw[2 * token + p]; if (p == 0) s0tab[token] = slot;
    }
    if (F.bid < 16) {
        const int p = F.bid >> 3, e = F.bid & 7, ps = base[32 + F.bid], t = base[16 + F.bid], pend = ps + (t + 255) / 256 * 256;
        for (int s = ps + t + tid; s < pend; s += NTHR) { stok[p * SLOT_CAP + s] = -1; sw[p * SLOT_CAP + s] = 0.f; }
        for (int bk = ps / 256 + tid; bk < pend / 256; bk += NTHR) blk[16 + p * 256 + bk] = e;
        if (e == 0 && tid == 0) blk[p] = base[48 + p];
    }
    __syncthreads();
}
__device__ __forceinline__ void final_norm_slots(int lane, const bf16* HB, float* OUT, const bf16* YA, const int* s0tab, const bf16* Y, const bf16* Y2, const float* gain, const int* tok, int s0, int s1, int first, int stride) {
    f32x4 gv[4];
#pragma unroll
    for (int j = 0; j < 4; ++j) gv[j] = ((const f32x4*)gain + lane)[64 * j];
    for (int base = s0 + first; base < s1; base += 64 * stride) {
      const int sll = base + lane * stride; int mytok = -1; if (sll < s1) mytok = tok[sll];
      const int mys0 = s0tab[mytok < 0 ? 0 : mytok];
      const int cnt = min(64, (s1 - base + stride - 1) / stride);
      for (int i = 0; i < cnt; i += 2) {
        const int sl = base + i * stride, slb = sl + stride; const bool hb = i + 1 < cnt; const int i1 = hb ? i + 1 : i;
        const int ra = __builtin_amdgcn_readlane(mytok, i), rb = hb ? __builtin_amdgcn_readlane(mytok, i1) : -1;
        const int rowa = ra < 0 ? 0 : ra, rowb = rb < 0 ? 0 : rb;
        const v2u* xa = (const v2u*)(HB + (size_t)rowa * DM) + lane; const v2u* xb = (const v2u*)(HB + (size_t)rowb * DM) + lane;
        const v2u* ya = (const v2u*)(Y + (size_t)sl * DM) + lane; const v2u* yb = (const v2u*)(Y + (size_t)(hb ? slb : sl) * DM) + lane;
        const v2u* pa = (const v2u*)(YA + (size_t)__builtin_amdgcn_readlane(mys0, i) * DM) + lane; const v2u* pb = (const v2u*)(YA + (size_t)__builtin_amdgcn_readlane(mys0, i1) * DM) + lane;
        f32x4 va[4], vb[4]; v2u wa[4], wb[4], ua[4], ub[4], ta[4], tb[4];
#pragma unroll
        for (int j = 0; j < 4; ++j) { ua[j] = xa[64 * j]; wa[j] = ya[64 * j]; ta[j] = pa[64 * j]; }
#pragma unroll
        for (int j = 0; j < 4; ++j) { ub[j] = xb[64 * j]; wb[j] = yb[64 * j]; tb[j] = pb[64 * j]; }
#pragma unroll
        for (int j = 0; j < 4; ++j) { va[j] = (f32x4){bflo(ua[j].x) + bflo(ta[j].x), bfhi(ua[j].x) + bfhi(ta[j].x), bflo(ua[j].y) + bflo(ta[j].y), bfhi(ua[j].y) + bfhi(ta[j].y)};
            vb[j] = (f32x4){bflo(ub[j].x) + bflo(tb[j].x), bfhi(ub[j].x) + bfhi(tb[j].x), bflo(ub[j].y) + bflo(tb[j].y), bfhi(ub[j].y) + bfhi(tb[j].y)}; }
        if (Y2) {
            const v2u* za = (const v2u*)(Y2 + (size_t)(sl - s0) * DM) + lane; const v2u* zb = (const v2u*)(Y2 + (size_t)((hb ? slb : sl) - s0) * DM) + lane;
#pragma unroll
            for (int j = 0; j < 4; ++j) { const v2u p = za[64 * j], q = zb[64 * j];
                va[j].x += bflo(p.x); va[j].y += bfhi(p.x); va[j].z += bflo(p.y); va[j].w += bfhi(p.y); vb[j].x += bflo(q.x); vb[j].y += bfhi(q.x); vb[j].z += bflo(q.y); vb[j].w += bfhi(q.y); }
        }
        float sa = 0.f, sb = 0.f;
#pragma unroll
        for (int j = 0; j < 4; ++j) {
            va[j].x += bflo(wa[j].x); va[j].y += bfhi(wa[j].x); va[j].z += bflo(wa[j].y); va[j].w += bfhi(wa[j].y);
            vb[j].x += bflo(wb[j].x); vb[j].y += bfhi(wb[j].x); vb[j].z += bflo(wb[j].y); vb[j].w += bfhi(wb[j].y);
            sa += (va[j].x * va[j].x + va[j].y * va[j].y) + (va[j].z * va[j].z + va[j].w * va[j].w); sb += (vb[j].x * vb[j].x + vb[j].y * vb[j].y) + (vb[j].z * vb[j].z + vb[j].w * vb[j].w); }
        sa = wave_sum(sa); sb = wave_sum(sb);
        const float rsa = 1.0f / sqrtf(sa * (1.0f / DM) + EPS), rsb = 1.0f / sqrtf(sb * (1.0f / DM) + EPS);
        if (ra >= 0) { GAS f32x4* oa = (GAS f32x4*)(OUT + (size_t)rowa * DM) + lane;
#pragma unroll
            for (int j = 0; j < 4; ++j) { const f32x4 g = gv[j]; oa[64 * j] = (f32x4){va[j].x * rsa * g.x, va[j].y * rsa * g.y, va[j].z * rsa * g.z, va[j].w * rsa * g.w}; } }
        if (rb >= 0) { GAS f32x4* ob = (GAS f32x4*)(OUT + (size_t)rowb * DM) + lane;
#pragma unroll
            for (int j = 0; j < 4; ++j) { const f32x4 g = gv[j]; ob[64 * j] = (f32x4){vb[j].x * rsb * g.x, vb[j].y * rsb * g.y, vb[j].z * rsb * g.z, vb[j].w * rsb * g.w}; } }
      }
    }
}
__device__ __forceinline__ void final_norm(const Frame& F, float* H, const float* gain) {
    for (int row = F.gw; row < NT; row += F.NGW) {
        GAS f32x4* xr = (GAS f32x4*)(H + (size_t)row * DM) + LANE(); const f32x4* gr = (const f32x4*)gain + LANE();
        f32x4 v[4]; float s = 0.f;
#pragma unroll
        for (int j = 0; j < 4; ++j) { v[j] = xr[64 * j]; s += (v[j].x * v[j].x + v[j].y * v[j].y) + (v[j].z * v[j].z + v[j].w * v[j].w); }
        s = wave_sum(s); const float rs = 1.0f / sqrtf(s * (1.0f / DM) + EPS);
#pragma unroll
        for (int j = 0; j < 4; ++j) { const f32x4 g = gr[64 * j]; f32x4 o = {v[j].x * rs * g.x, v[j].y * rs * g.y, v[j].z * rs * g.z, v[j].w * rs * g.w}; xr[64 * j] = o; }
    }
}

constexpr int N_PHASES = 17;
__global__ void __launch_bounds__(NTHR, 2) mega(Args args) {
    extern __shared__ __attribute__((aligned(16))) unsigned char lds_raw[];
    Frame F;
    F.lds = (LAS unsigned char*)lds_raw;
    F.wave = __builtin_amdgcn_readfirstlane((int)(threadIdx.x >> 6));
    F.G = gridDim.x; F.bid = blockIdx.x; F.gw = F.bid * NWAVES + F.wave; F.NGW = F.G * NWAVES; F.ws = args.ws;
    unsigned char* ws = args.ws;
    gu32* ctl = (gu32*)(ws + WS_CTL);
    volatile LAS unsigned* MISC = (volatile LAS unsigned*)(F.lds + MISC_OFF);
    for (int u = TID(); u < (LDS_BYTES - LDSCTL_OFF) / 4; u += NTHR) ((LAS unsigned*)(F.lds + LDSCTL_OFF))[u] = 0u;
    __syncthreads();
    XcdBarrier bar = xcd_barrier_post((unsigned*)(ctl + CW_BAR), MISC + 8, F.wave);
    const int lo = args.ph_lo, hi = args.ph_hi;
#ifndef PH_MASK
#define PH_MASK 0x1ffff
#endif
#define IN(k) (((PH_MASK >> (k)) & 1) && lo <= (k) && (k) < hi)
#ifndef REPEAT_MASK
#define REPEAT_MASK 0
#endif
#define REPS(k) (1 + ((REPEAT_MASK >> (k)) & 1))
#define SEAM(k) do { if (IN(k) && IN((k) + 1)) xcd_barrier(bar); } while (0)

    float* H = args.out;
    bf16* x3 = (bf16*)args.out;
    float* rss = (float*)(ws + WS_RSS); float* rstd = (float*)(ws + WS_RSTD);
    bf16* hbf = (bf16*)(ws + WS_HBF); bf16* membf = (bf16*)(ws + WS_MEMBF); bf16* memk = (bf16*)(ws + WS_MEMK); bf16* memvt = (bf16*)(ws + WS_MEMVT);
    bf16* act0 = (bf16*)(ws + WS_ACT0); bf16* v0t = (bf16*)(ws + WS_V0T); bf16* mix = (bf16*)(ws + WS_MIX); bf16* hmid0 = (bf16*)(ws + WS_HMID0);
    bf16* act1 = (bf16*)(ws + WS_ACT1); bf16* v1t = (bf16*)(ws + WS_V1T); bf16* OF = (bf16*)(ws + WS_OF); bf16* OB = (bf16*)(ws + WS_OB);
    bf16* hmid1 = (bf16*)(ws + WS_HMID1); bf16* wgu = (bf16*)((unsigned char*)args.out + OUT_WGU); bf16* wdn = (bf16*)(ws + WS_WDN);
    int* cnt = (int*)(ws + WS_CNT); int* topi = (int*)(ws + WS_TOPI); float* topw = (float*)(ws + WS_TOPW);
    int* stok = (int*)(ws + WS_STOK); float* sw = (float*)(ws + WS_SW); int* blk = (int*)(ws + WS_BLK);
    LAS float* scr = (LAS float*)(F.lds + F.wave * 16384);

    if (IN(0)) {
        int it = F.gw; LAS unsigned* T0 = (LAS unsigned*)scr; LAS unsigned* T1 = T0 + 1088;
#define CVT(Wp, Kd, Nd, WTp, gainp, kind) do { const CvtJob J{Wp, Kd, Nd, (bf16*)(WTp), gainp, kind}; const int n_ = ((Kd) / 64) * ((Nd) / 32); \
            while (it < n_) { CvtRegs A_, B_; B_.valid = 0; cvt_load(A_, J, it, LANE()); it += F.NGW; if (it < n_) { cvt_load(B_, J, it, LANE()); it += F.NGW; } cvt_finish(A_, T0, LANE()); cvt_finish(B_, T1, LANE()); } \
            it -= n_; } while (0)
        CVT(args.in[I_EWIN], 1024, 2560, ws + WS_W0IN, args.in[I_EN1], 1);
        CVT(args.in[I_EWIN], 1024, 2560, ws + WS_WV0, args.in[I_EN1], 2);
        CVT(args.in[I_EWOUT], 1024, 1024, ws + WS_W0OUT, nullptr, 0);
        CVT(args.in[I_EWG], 1024, 2816, ws + WS_W0GU, args.in[I_EN2], 3);
        CVT(args.in[I_EWU], 1024, 2816, ws + WS_W0GU, args.in[I_EN2], 4);
        CVT(args.in[I_EWD], 2816, 1024, ws + WS_W0DN, nullptr, 0);
        CVT(args.in[I_WMKV], 1024, 512, ws + WS_WMEM, args.in[I_MNORM], 0);
        CVT(args.in[I_OWIN], 1024, 2592, ws + WS_W1IN, args.in[I_ON1], 5);
        CVT(args.in[I_OWIN], 1024, 2592, ws + WS_WV1, args.in[I_ON1], 6);
        CVT(args.in[I_OWOUT], 1024, 1024, ws + WS_W1OUT, nullptr, 0);
#undef CVT
        { v4u z = {0u, 0u, 0u, 0u}; v4u* p = (v4u*)(ws + WS_W1IN + (size_t)1824 * 2048); const int n16 = 224 * 2048 / 16;
          for (int i = F.bid * NTHR + TID(); i < n16; i += F.G * NTHR) p[i] = z; }
        { float* rp2 = (float*)(ws + WS_RPB2); for (int i2 = F.bid * NTHR + TID(); i2 < 12 * 480; i2 += F.G * NTHR) { const int hh = i2 / 480, jj = i2 - 480 * hh; rp2[i2] = jj < 465 ? args.in[I_RPB][hh * 465 + jj] * 1.4426950408889634f : 0.f; } }
        rows_to_bf16(args.in[I_X], hbf, rstd, F.gw, NT, F.NGW, LANE());
        rows_to_bf16(args.in[I_MEM], membf, rstd + NT, F.gw, MEM_ROWS, F.NGW, LANE());
    }
    SEAM(0);
    if (IN(1)) {
        { Sched S; S.init(hbf, ws + WS_W0IN, 1024, 128, 7, F.G, F.bid); EpiRowScale E{act0, A0_LD, rstd, 1.0f}; gemm_run<EpiRowScale, false>(F.lds, S, E, nullptr, F.wave); }
        { Sched S; S.init(ws + WS_WV0, hbf, 1024, 3, 128, F.G, (F.bid + 128) % F.G); EpiColScale E{v0t, NT, rstd}; gemm_run<EpiColScale, false>(F.lds, S, E, nullptr, F.wave); }
        for (int it = F.gw; it < 2048; it += F.NGW) memkv_item(it, LANE(), membf, (const bf16*)(ws + WS_WMEM), rstd + NT, memk, memvt);
    }
    SEAM(1);
    if (IN(2)) {
        { na_phase(F, act0, v0t, (const float*)(ws + WS_RPB2), mix);
          if (F.G == 256) { for (int i = 0; i < 2; ++i) memattn_strip(F, (F.bid >> 3) * 16 + 2 * (F.bid & 7) + i, act0, A0_LD, 1536, memk, memvt, mix, i == 0); }
          else for (int it = F.bid; it < 512; it += F.G) memattn_strip(F, it, act0, A0_LD, 1536, memk, memvt, mix);
          __syncthreads(); }
    }
    SEAM(2);
    if (IN(3)) {
        Sched S; S.init(mix, ws + WS_W0OUT, 1024, 128, 4, F.G, F.bid); EpiResid<true> E{args.in[I_X], hbf, rss, nullptr}; gemm_run<EpiResid<true>, false>(F.lds, S, E, nullptr, F.wave);
    }
    SEAM(3);
    if (IN(4)) {
        Sched S; S.init(hbf, ws + WS_W0GU, 1024, 128, 22, F.G, F.bid); EpiSwiGLU<false, true> E{hmid0, FF0, rss, nullptr}; gemm_run<EpiSwiGLU<false, true>, false>(F.lds, S, E, nullptr, F.wave);
    }
    SEAM(4);
    if (IN(5)) {
        Sched S; S.init(hmid0, ws + WS_W0DN, FF0, 128, 4, F.G, F.bid); EpiResid<false> E{nullptr, hbf, rss, nullptr}; gemm_run<EpiResid<false>, false>(F.lds, S, E, nullptr, F.wave);
    }
    SEAM(5);
    if (IN(6)) {
        { Sched S; S.init(hbf, ws + WS_W1IN, 1024, 128, 7, F.G, F.bid); EpiRowScaleT<true> E{act1, A1_LD, rss, 1.0f}; gemm_run<EpiRowScaleT<true>, false>(F.lds, S, E, nullptr, F.wave); }
        { Sched S; S.init(ws + WS_WV1, hbf, 1024, 3, 128, F.G, (F.bid + 128) % F.G); EpiColScaleT<true> E{v1t, NT, rss}; gemm_run<EpiColScaleT<true>, false>(F.lds, S, E, nullptr, F.wave); }
        for (int it = F.gw; it < 2048; it += F.NGW) zproj_item(it, LANE(), hbf, (const bf16*)(ws + WS_W1IN) + (size_t)1792 * 1024, rss, act1);
    }
    SEAM(6);
    if (IN(7)) {
        bf16x8 gwf[3]; float gbi[3]; int gdir = -1;
        for (int it = F.bid; it < 1024; it += F.G) { const int dir = (it >> 6) & 1;
            if (dir != gdir) { gla_pre_w(F.wave, LANE(), dir ? args.in[I_WGKB] : args.in[I_WGKF], dir ? args.in[I_BGKB] : args.in[I_BGKF], gwf, gbi); gdir = dir; }
            gla_pre_item(F, it, act1, gwf, gbi, (bf16*)(ws + WS_GQT) + (size_t)dir * NT * 384, (bf16*)((unsigned char*)args.out + OUT_GKT) + (size_t)dir * NT * 384,
                         (float*)((unsigned char*)args.out + OUT_GDEC) + (size_t)dir * 8 * 4 * 64 * 96); }
        if (F.G == 256) { for (int i = 0; i < 2; ++i) memattn_strip(F, (F.bid >> 3) * 16 + 2 * (F.bid & 7) + i, act1, A1_LD, 1536, memk, memvt, mix, i == 0); }
        else for (int it = F.bid; it < 512; it += F.G) memattn_strip(F, it, act1, A1_LD, 1536, memk, memvt, mix);
        xcd_barrier(bar);
        for (int it0 = F.bid; it0 < 256; it0 += F.G) { const int it = (F.G == 256) ? ((it0 & 7) * 8 + (it0 >> 5)) * 4 + ((it0 >> 3) & 3) : it0;
            gla_main_item(F, it, (const bf16*)(ws + WS_GQT), (const bf16*)((unsigned char*)args.out + OUT_GKT), (const float*)((unsigned char*)args.out + OUT_GDEC), v1t, OF, OB, args.in[I_OWG], args.in[I_OWU], args.in[I_ON2], (unsigned char*)wgu); }
    }
    SEAM(7);
    if (IN(8)) gla_combine(F, OF, OB, act1, args.in[I_GNORM], mix);
    SEAM(8);
    if (IN(9)) {
        Sched S; S.init(mix, ws + WS_W1OUT, 1024, 128, 4, F.G, F.bid); EpiResid<false> E{nullptr, hbf, rss, x3}; gemm_run<EpiResid<false>, false>(F.lds, S, E, nullptr, F.wave);
    }
    SEAM(9);
    if (IN(10)) {
        route1(F, hbf, args.in[I_ON2], args.in[I_WR], topi, topw, cnt, rstd);
    }
    SEAM(10);
    if (IN(11)) {
        route2(F, topi, topw, cnt, stok, sw, blk, (int*)(ws + WS_S0TAB));
        { LAS unsigned* T0 = (LAS unsigned*)scr; LAS unsigned* T1 = T0 + 1088;
#define MOE_JOB(J_, it_) const int e_##J_ = (it_) / 1792; \
            const CvtJob J_{args.in[I_OWD] + (size_t)e_##J_ * FFE * 1024, FFE, 1024, (bf16*)((unsigned char*)wdn + (size_t)e_##J_ * 1024 * FFE), nullptr, 0}
          for (int it = F.gw; it < 8 * 1792; it += 2 * F.NGW) {
            CvtRegs A_, B_; B_.valid = 0;
            { MOE_JOB(Ja, it); cvt_load8(A_, Ja, it % 1792, LANE()); }
            if (it + F.NGW < 8 * 1792) { MOE_JOB(Jb, it + F.NGW); cvt_load8(B_, Jb, (it + F.NGW) % 1792, LANE()); }
            cvt_finish8(A_, T0, LANE(), 32.0f); cvt_finish8(B_, T1, LANE(), 32.0f);
          }
#undef MOE_JOB
        }
    }
    SEAM(11);
    bf16* ht0 = (bf16*)((unsigned char*)hmid1 + (size_t)NT * FFE); bf16* ht1 = (bf16*)(ws + WS_HT1);
    constexpr int KG = 512, KD = FFE / 2; constexpr size_t ESG = (size_t)7168 * 1024, ESD = (size_t)1024 * FFE;
    if (IN(12)) {
        const int nb = blk[0]; Sched S; S.init(x3, wgu, KG, nb, 28, F.G, F.bid, blk + 16, ESG); EpiSwiGLU<true> E{hmid1, FFE, rstd, ht0}; gemm_run<EpiSwiGLU<true>, true, true>(F.lds, S, E, stok, F.wave);
    }
    SEAM(12);
    if (IN(13)) {
        const int nb = blk[0], nbm = nb < 128 ? nb : 128; Sched S; S.init(hmid1, wdn, KD, nbm, 4, F.G, F.bid, blk + 16, ESD); EpiRowScale E{(bf16*)(ws + WS_YA), DM, sw, 0.03125f}; gemm_run<EpiRowScale, false, true>(F.lds, S, E, nullptr, F.wave);
    }
    SEAM(13);
    if (IN(14)) {
        const int nb = blk[1], nb0 = blk[0], rfull = (nb * 28 / F.G > 3) ? nb * 28 / F.G - 3 : 0, per = F.G / 8;
        { Sched S; S.init(x3, wgu, KG, nb, 28, F.G, F.bid, blk + 16 + 256, ESG); S.range(0, rfull * per, per);
          EpiSwiGLU<true> E{hmid1, FFE, rstd, ht1}; gemm_run<EpiSwiGLU<true>, true, true>(F.lds, S, E, stok + SLOT_CAP, F.wave); }
        { Sched S; S.init(x3, wgu, KG, nb, 28, F.G, F.bid, blk + 16 + 256, ESG); S.range(rfull * per, 0x7fffffff, per - 4);
          EpiSwiGLU<true> E{hmid1, FFE, rstd, ht1}; gemm_run<EpiSwiGLU<true>, true, true>(F.lds, S, E, stok + SLOT_CAP, F.wave); }
        if (F.bid / 8 >= per - 4 && nb0 > 128) {
            Sched S; S.init(ht0, wdn, KD, nb0 - 128, 4, 32, (F.bid / 8 - (per - 4)) * 8 + F.bid % 8, blk + 16 + 128, ESD);
            EpiRowScale E{(bf16*)(ws + WS_YA) + (size_t)NT * DM, DM, sw + NT, 0.03125f}; gemm_run<EpiRowScale, false, true>(F.lds, S, E, nullptr, F.wave); }
    }
    SEAM(14);
    if (IN(15)) {
        const int nb = blk[1], nbm = nb < 128 ? nb : 128; Sched S; S.init(hmid1, wdn, KD, nbm, 4, F.G, F.bid, blk + 16 + 256, ESD); EpiRowScale E{(bf16*)(ws + WS_YB), DM, sw + SLOT_CAP, 0.03125f}; gemm_run<EpiRowScale, false, true>(F.lds, S, E, nullptr, F.wave);
    }
    SEAM(15);
    if (IN(16)) {
        const int nb = blk[1], per = F.G / 8, nmain = (nb < 128 ? nb : 128) * 256;
        bf16* yb = (bf16*)(ws + WS_YB); bf16* yb2 = yb + (size_t)SLOT_CAP * DM;
        if (F.bid / 8 >= per - 4) {
            if (nb > 128) {
                const int sl = F.bid / 8 - (per - 4), kh = sl >> 1;
                Sched S; S.init((const bf16*)ht1 + kh * (KD / 2), (const bf16*)wdn + kh * (KD / 2), KD / 2, nb - 128, 4, 16, (sl & 1) * 8 + F.bid % 8, blk + 16 + 256 + 128, ESD); S.ld = KD;
                EpiRowScale E{kh ? yb2 : yb + (size_t)NT * DM, DM, sw + SLOT_CAP + NT, 0.03125f}; gemm_run<EpiRowScale, false, true>(F.lds, S, E, nullptr, F.wave); }
        } else {
            const int wv = (int)(blockIdx.x * NWAVES) + F.wave;
            final_norm_slots(LANE(), hbf, H, (const bf16*)(ws + WS_YA), (const int*)(ws + WS_S0TAB), yb, nullptr, args.in[I_FNORM], stok + SLOT_CAP, 0, nmain, wv, (per - 4) * 8 * NWAVES);
        }
        xcd_barrier(bar);
        if (nb > 128) final_norm_slots(LANE(), hbf, H, (const bf16*)(ws + WS_YA), (const int*)(ws + WS_S0TAB), yb, yb2, args.in[I_FNORM], stok + SLOT_CAP, NT, nb * 256, (int)(blockIdx.x * NWAVES) + F.wave, F.NGW);
    }
#undef IN
#undef SEAM
}

extern "C" void kernel_launch(void* const* d_in, const int* in_sizes, int n_in, void* d_out, int out_size, void* d_ws, size_t ws_size, hipStream_t stream) {
    static int grid = 0;
    if (grid == 0) {
        if (n_in != 26 || out_size != NT * DM || ws_size < WS_END) { fprintf(stderr, "kernel_launch: unexpected problem (n_in %d out %d ws %zu need %zu)\n", n_in, out_size, ws_size, (size_t)WS_END); grid = -1; return; }
        int dev = 0, cus = 0, per_cu = 0;
        if (hipGetDevice(&dev) != hipSuccess || hipDeviceGetAttribute(&cus, hipDeviceAttributeMultiprocessorCount, dev) != hipSuccess) { grid = -1; return; }
        if (hipFuncSetAttribute((const void*)mega, hipFuncAttributeMaxDynamicSharedMemorySize, LDS_BYTES) != hipSuccess) { fprintf(stderr, "kernel_launch: hipFuncSetAttribute failed\n"); grid = -1; return; }
        if (hipOccupancyMaxActiveBlocksPerMultiprocessor(&per_cu, (const void*)mega, NTHR, LDS_BYTES) != hipSuccess || per_cu < 1) fprintf(stderr, "kernel_launch: occupancy query reports %d\n", per_cu);
        (void)hipGetLastError();
        if (cus < 256) { fprintf(stderr, "kernel_launch: this kernel is built for a 256-CU device (one resident workgroup per CU), found %d CUs; nothing launched\n", cus); grid = -1; return; }
        grid = 256;
    }
    if (grid < 0) return;
    if (hipMemsetAsync((char*)d_ws + WS_CTL, 0, CTL_ZERO_BYTES, stream) != hipSuccess) return;
    Args a{};
    for (int i = 0; i < 26; ++i) a.in[i] = (const float*)d_in[i];
    a.out = (float*)d_out; a.ws = (unsigned char*)d_ws;
    a.ph_lo = 0; a.ph_hi = N_PHASES;
    hipLaunchKernelGGL(mega, dim3(grid), dim3(NTHR), LDS_BYTES, stream, a);
}
```
